# Optimizing an MI355X kernel written in HIP

```python
import jax, jax.numpy as jnp
from jax import lax
import numpy as np


D_MODEL = 1024
BATCH = 8
SEQ = 4096
DEPTH = 1

HEAD_DIM = 64
ATTN_HEADS = 8
RWKV_HEADS = 8
ATTN_WIDTH = ATTN_HEADS * HEAD_DIM
RWKV_WIDTH = RWKV_HEADS * HEAD_DIM
MIX_WIDTH = ATTN_WIDTH + RWKV_WIDTH
ATTN_PATTERNS = ((128, 1), (512, 4), (2048, 16))
Q_BLOCK = 128
ROPE_THETA = 10000.0
DECAY_LORA = 64
AAA_LORA = 64
GATE_LORA = 160
RWKV_FEATS = 3 * RWKV_WIDTH + DECAY_LORA + AAA_LORA + GATE_LORA
IN_WIDTH = 3 * ATTN_WIDTH + RWKV_FEATS
GN_EPS = 64e-5
LN_EPS = 1e-5
N_EXPERTS = 256
TOP_K = 8
N_GROUPS = 8
TOPK_GROUPS = 4
ROUTED_SCALE = 2.5
EXPERT_FF = 256
SHARED_FF = 256
EXPERT_BLOCK = 128
ALPHA = (2.0 * DEPTH) ** 0.25
BETA = (8.0 * DEPTH) ** -0.25

kernel_name = 'hybrid_dilated_rwkv7_moe_deepnorm'


def layer_norm(x, g, b):
    xf = x.astype(jnp.float32)
    mu = xf.mean(-1, keepdims=True)
    var = jnp.square(xf - mu).mean(-1, keepdims=True)
    y = (xf - mu) * lax.rsqrt(var + LN_EPS) * g.astype(jnp.float32) + b.astype(jnp.float32)
    return y.astype(x.dtype)


def rope(z, pos):
    half = HEAD_DIM // 2
    inv_freq = ROPE_THETA ** (-jnp.arange(half, dtype=jnp.float32) * 2.0 / HEAD_DIM)
    ang = pos[:, None] * inv_freq[None, :]
    cos = jnp.cos(ang)[None, :, None, :]
    sin = jnp.sin(ang)[None, :, None, :]
    z = z.astype(jnp.float32)
    z1, z2 = z[..., :half], z[..., half:]
    return jnp.concatenate([z1 * cos - z2 * sin, z2 * cos + z1 * sin], axis=-1)


def dilated_window_attention(q, k, v, dilation, n_back):
    B, S, H, Dh = q.shape
    L = S // dilation
    nb = -(-L // Q_BLOCK)
    Lp = nb * Q_BLOCK

    def split(z):
        z = z.reshape(B, L, dilation, H, Dh).transpose(0, 2, 3, 1, 4)
        z = jnp.pad(z, ((0, 0), (0, 0), (0, 0), (0, Lp - L), (0, 0)))
        return z.reshape(B, dilation, H, nb, Q_BLOCK, Dh)

    def with_prev(z):
        prev = jnp.pad(z, ((0, 0), (0, 0), (0, 0), (1, 0), (0, 0), (0, 0)))[:, :, :, :-1]
        return jnp.concatenate([prev, z], axis=4)

    qb = split(q)
    kc = with_prev(split(k))
    vc = with_prev(split(v))
    s = jnp.einsum('brhnqc,brhnkc->brhnqk', qb, kc) * (Dh ** -0.5)
    qi = jnp.arange(Q_BLOCK)[:, None]
    ki = jnp.arange(2 * Q_BLOCK)[None, :]
    dist = Q_BLOCK + qi - ki
    blk = jnp.arange(nb)[:, None, None]
    valid = (dist >= 0) & (dist <= n_back) & (blk * Q_BLOCK + ki - Q_BLOCK >= 0)
    s = jnp.where(valid, s, -jnp.inf)
    m = s.max(-1, keepdims=True)
    p = jnp.exp(s - m)
    l = p.sum(-1, keepdims=True)
    o = jnp.einsum('brhnqk,brhnkc->brhnqc', p, vc) / l
    lse = m + jnp.log(l)

    def merge(z):
        z = z.reshape(B, dilation, H, Lp, -1)[:, :, :, :L]
        return z.transpose(0, 3, 1, 2, 4).reshape(B, S, H, -1)

    return merge(o), merge(lse)[..., 0]


def rwkv7_time_mix(feats, mu, w0, w_decay_up, a0, w_aaa_up, w_gate_up, k_k, k_a, r_k, lnx_g, lnx_b):
    B, S, _ = feats.shape
    H, N, C = RWKV_HEADS, HEAD_DIM, RWKV_WIDTH
    f = feats.astype(jnp.float32)
    prev = jnp.pad(f, ((0, 0), (1, 0), (0, 0)))[:, :-1]
    f = f + (prev - f) * mu
    r, k, v, wl, al, gl = jnp.split(
        f, [C, 2 * C, 3 * C, 3 * C + DECAY_LORA, 3 * C + DECAY_LORA + AAA_LORA], axis=-1)
    w = -jax.nn.softplus(-(w0 + jnp.tanh(wl) @ w_decay_up)) - 0.5
    decay = jnp.exp(-jnp.exp(w))
    a = jax.nn.sigmoid(a0 + al @ w_aaa_up)
    g = jax.nn.sigmoid(gl) @ w_gate_up

    def heads(z):
        return z.reshape(B, S, H, N)

    kk = heads(k * k_k)
    kk = kk / jnp.maximum(jnp.linalg.norm(kk, axis=-1, keepdims=True), 1e-12)
    k = k * (1.0 + (a - 1.0) * k_a)
    r_h, k_h, v_h, a_h = heads(r), heads(k), heads(v), heads(a)

    def step(state, inp):
        r_t, w_t, k_t, v_t, a_t, b_t = inp
        sa = jnp.einsum('bhvk,bhk->bhv', state, a_t)
        state = (state * w_t[:, :, None, :] + sa[..., None] * b_t[:, :, None, :]
                 + v_t[..., None] * k_t[:, :, None, :])
        return state, jnp.einsum('bhvk,bhk->bhv', state, r_t)

    seq = [z.transpose(1, 0, 2, 3) for z in (r_h, heads(decay), k_h, v_h, -kk, kk * a_h)]
    state0 = jnp.zeros((B, H, N, N), jnp.float32)
    _, y = lax.scan(step, state0, (seq[0], seq[1], seq[2], seq[3], seq[4], seq[5]))
    y = y.transpose(1, 0, 2, 3)
    ym = y.mean(-1, keepdims=True)
    yv = jnp.square(y - ym).mean(-1, keepdims=True)
    y = ((y - ym) * lax.rsqrt(yv + GN_EPS)).reshape(B, S, C) * lnx_g + lnx_b
    bonus = (r_h * k_h * r_k).sum(-1, keepdims=True) * v_h
    return (y + bonus.reshape(B, S, C)) * g


def hybrid_mixer(x, w_in, mu_shift, w0, w_decay_up, a0, w_aaa_up, w_gate_up, k_k, k_a, r_k,
                 lnx_g, lnx_b, w_out):
    B, S, _ = x.shape
    h = x @ w_in
    q, k, v, feats = jnp.split(h, [ATTN_WIDTH, 2 * ATTN_WIDTH, 3 * ATTN_WIDTH], axis=-1)
    pos = jnp.arange(S, dtype=jnp.float32)

    def heads(z):
        return z.reshape(B, S, ATTN_HEADS, HEAD_DIM)

    q = rope(heads(q), pos)
    k = rope(heads(k), pos)
    v = heads(v).astype(jnp.float32)
    outs, lses = [], []
    for window, dilation in ATTN_PATTERNS:
        o, lse = dilated_window_attention(q, k, v, dilation, window // dilation)
        outs.append(o)
        lses.append(lse)
    wts = jax.nn.softmax(jnp.stack(lses), axis=0)
    attn = jnp.sum(wts[..., None] * jnp.stack(outs), axis=0).reshape(B, S, ATTN_WIDTH)
    rw = rwkv7_time_mix(feats, mu_shift, w0, w_decay_up, a0, w_aaa_up, w_gate_up,
                        k_k, k_a, r_k, lnx_g, lnx_b)
    mixed = jnp.concatenate([attn, rw], axis=-1).astype(x.dtype)
    return mixed @ w_out


def moe_ffn(x, router_w, router_bias, e_gate, e_up, e_down, s_gate, s_up, s_down):
    B, S, D = x.shape
    T = B * S
    E = N_EXPERTS
    xt = x.reshape(T, D)
    aff = jax.nn.sigmoid(xt.astype(jnp.float32) @ router_w.astype(jnp.float32))
    sel = aff + router_bias.astype(jnp.float32)
    grp_score = lax.top_k(sel.reshape(T, N_GROUPS, E // N_GROUPS), 2)[0].sum(-1)
    _, top_grp = lax.top_k(grp_score, TOPK_GROUPS)
    grp_mask = jax.nn.one_hot(top_grp, N_GROUPS, dtype=jnp.float32).sum(1) > 0
    sel = jnp.where(jnp.repeat(grp_mask, E // N_GROUPS, axis=1), sel, -jnp.inf)
    _, idx = lax.top_k(sel, TOP_K)
    gate = jnp.take_along_axis(aff, idx, axis=1)
    gate = gate / gate.sum(-1, keepdims=True) * ROUTED_SCALE

    n_assign = T * TOP_K
    flat_e = idx.reshape(-1)
    order = jnp.argsort(flat_e)
    e_sorted = flat_e[order]
    tok_sorted = (order // TOP_K).astype(jnp.int32)
    gate_sorted = gate.reshape(-1)[order]
    counts = jnp.zeros((E,), jnp.int32).at[flat_e].add(1)
    padded = (counts + EXPERT_BLOCK - 1) // EXPERT_BLOCK * EXPERT_BLOCK
    pad_end = jnp.cumsum(padded)
    pad_start = pad_end - padded
    seg_start = jnp.cumsum(counts) - counts
    dest = pad_start[e_sorted] + jnp.arange(n_assign, dtype=jnp.int32) - seg_start[e_sorted]
    n_blocks = -(-(n_assign + E * (EXPERT_BLOCK - 1)) // EXPERT_BLOCK)
    n_rows = n_blocks * EXPERT_BLOCK
    row_tok = jnp.zeros((n_rows,), jnp.int32).at[dest].set(tok_sorted)
    row_gate = jnp.zeros((n_rows,), jnp.float32).at[dest].set(gate_sorted)
    blk_start = jnp.arange(n_blocks, dtype=jnp.int32) * EXPERT_BLOCK
    blk_expert = jnp.minimum(jnp.searchsorted(pad_end, blk_start, side='right'), E - 1)

    def expert_block(args):
        toks, gts, e = args
        xb = xt[toks]
        hb = jax.nn.silu(xb @ e_gate[e]) * (xb @ e_up[e])
        return (hb @ e_down[e]).astype(jnp.float32) * gts[:, None]

    y = lax.map(expert_block, (row_tok.reshape(n_blocks, EXPERT_BLOCK),
                               row_gate.reshape(n_blocks, EXPERT_BLOCK), blk_expert))
    routed = jnp.zeros((T, D), jnp.float32).at[row_tok].add(y.reshape(n_rows, D))
    shared = (jax.nn.silu(xt @ s_gate) * (xt @ s_up)) @ s_down
    return (routed.astype(x.dtype) + shared).reshape(B, S, D)


def setup_inputs(seed: int = 0) -> dict:
    key = jax.random.key(seed)
    ks = jax.random.split(key, 26)
    f32 = jnp.float32
    L, D, E = DEPTH, D_MODEL, N_EXPERTS

    def nrm(k, shape, scale):
        return jax.random.normal(k, shape, f32) * scale

    return {
        'x': nrm(ks[0], (BATCH, SEQ, D), 1.0),
        'w_in': nrm(ks[1], (L, D, IN_WIDTH), D ** -0.5),
        'mu_shift': jax.random.uniform(ks[2], (L, RWKV_FEATS), f32),
        'w0': jax.random.uniform(ks[3], (L, RWKV_WIDTH), f32, -6.5, -1.5),
        'w_decay_up': nrm(ks[4], (L, DECAY_LORA, RWKV_WIDTH), 0.1),
        'a0': nrm(ks[5], (L, RWKV_WIDTH), 0.1),
        'w_aaa_up': nrm(ks[6], (L, AAA_LORA, RWKV_WIDTH), 0.1),
        'w_gate_up': nrm(ks[7], (L, GATE_LORA, RWKV_WIDTH), GATE_LORA ** -0.5),
        'k_k': 0.85 + nrm(ks[8], (L, RWKV_WIDTH), 0.05),
        'k_a': 1.0 + nrm(ks[9], (L, RWKV_WIDTH), 0.05),
        'r_k': nrm(ks[10], (L, RWKV_HEADS, HEAD_DIM), 0.1),
        'lnx_g': 1.0 + nrm(ks[11], (L, RWKV_WIDTH), 0.05),
        'lnx_b': nrm(ks[12], (L, RWKV_WIDTH), 0.01),
        'w_out': nrm(ks[13], (L, MIX_WIDTH, D), BETA * MIX_WIDTH ** -0.5),
        'ln1_g': 1.0 + nrm(ks[14], (L, D), 0.05),
        'ln1_b': nrm(ks[15], (L, D), 0.01),
        'router_w': nrm(ks[16], (L, D, E), D ** -0.5),
        'router_bias': nrm(ks[17], (L, E), 0.01),
        'e_gate': nrm(ks[18], (L, E, D, EXPERT_FF), D ** -0.5),
        'e_up': nrm(ks[19], (L, E, D, EXPERT_FF), D ** -0.5),
        'e_down': nrm(ks[20], (L, E, EXPERT_FF, D), BETA * EXPERT_FF ** -0.5),
        's_gate': nrm(ks[21], (L, D, SHARED_FF), D ** -0.5),
        's_up': nrm(ks[22], (L, D, SHARED_FF), D ** -0.5),
        's_down': nrm(ks[23], (L, SHARED_FF, D), BETA * SHARED_FF ** -0.5),
        'ln2_g': 1.0 + nrm(ks[24], (L, D), 0.05),
        'ln2_b': nrm(ks[25], (L, D), 0.01),
    }


def reference(x, w_in, mu_shift, w0, w_decay_up, a0, w_aaa_up, w_gate_up, k_k, k_a, r_k,
              lnx_g, lnx_b, w_out, ln1_g, ln1_b, router_w, router_bias, e_gate, e_up, e_down,
              s_gate, s_up, s_down, ln2_g, ln2_b):
    for l in range(DEPTH):
        mix = hybrid_mixer(x, w_in[l], mu_shift[l], w0[l], w_decay_up[l], a0[l], w_aaa_up[l],
                           w_gate_up[l], k_k[l], k_a[l], r_k[l], lnx_g[l], lnx_b[l], w_out[l])
        x = layer_norm(ALPHA * x + mix, ln1_g[l], ln1_b[l])
        ffn = moe_ffn(x, router_w[l], router_bias[l], e_gate[l], e_up[l], e_down[l],
                      s_gate[l], s_up[l], s_down[l])
        x = layer_norm(ALPHA * x + ffn, ln2_g[l], ln2_b[l])
    return x
```

```cpp
#include <hip/hip_runtime.h>
#include <hip/hip_bf16.h>
#include <stdint.h>
#include <stdio.h>

typedef unsigned short bf16_t;

#define T_TOK 32768
#define SEQ 4096
#define DM 1024
#define INW 3360
#define FEW 1824
#define NEXP 256
#define ALPHA_F 1.189207115002721f
#define LN_EPS_F 1e-5f
#define GN_EPS_F 64e-5f

__device__ __forceinline__ float bf2f(bf16_t v) { return __uint_as_float(((unsigned)v) << 16); }
__device__ __forceinline__ bf16_t f2bf(float f) { unsigned u = __float_as_uint(f); return (bf16_t)((u + 0x7fffu + ((u >> 16) & 1u)) >> 16); }
__device__ __forceinline__ float sigmoidf_(float x) { return 1.f / (1.f + __expf(-x)); }
__device__ __forceinline__ float wave_sum(float v) {
#pragma unroll
  for (int o = 32; o >= 1; o >>= 1) v += __shfl_xor(v, o, 64);
  return v;
}

constexpr size_t SZ_T512_BF = (size_t)T_TOK * 512 * 2;
constexpr size_t OFF_Q = 0;
constexpr size_t OFF_K = OFF_Q + SZ_T512_BF;
constexpr size_t OFF_V = OFF_K + SZ_T512_BF;
constexpr size_t OFF_FEATS = OFF_V + SZ_T512_BF;
constexpr size_t OFF_R = OFF_FEATS + (size_t)T_TOK * FEW * 2;
constexpr size_t OFF_K2 = OFF_R + SZ_T512_BF;
constexpr size_t OFF_V2 = OFF_K2 + SZ_T512_BF;
constexpr size_t OFF_A = OFF_V2 + SZ_T512_BF;
constexpr size_t OFF_B = OFF_A + SZ_T512_BF;
constexpr size_t OFF_W = OFF_B + SZ_T512_BF;
constexpr size_t OFF_G = OFF_W + (size_t)T_TOK * 512 * 4;
constexpr size_t OFF_SB = OFF_G + SZ_T512_BF;
constexpr size_t OFF_YS = OFF_SB + (size_t)T_TOK * 8 * 4;
constexpr size_t OFF_ATT = OFF_YS + (size_t)T_TOK * 512 * 4;
constexpr size_t OFF_MIXED = OFF_ATT + SZ_T512_BF;
constexpr size_t OFF_ROPE = OFF_MIXED + (size_t)T_TOK * 1024 * 2;
constexpr size_t EARLY_END = OFF_ROPE + (size_t)4096 * 32 * 2 * 4;
constexpr size_t OFF_Y = 0;
constexpr size_t OFF_H = OFF_Y + (size_t)9 * T_TOK * 1024 * 2;
constexpr size_t OFF_X1B = OFF_H + (size_t)9 * T_TOK * 256 * 2;
constexpr size_t OFF_LIST = OFF_X1B + (size_t)T_TOK * 1024 * 2;
constexpr size_t OFF_GATEW = OFF_LIST + (size_t)NEXP * T_TOK * 4;
constexpr size_t OFF_CTL = OFF_GATEW + (size_t)8 * T_TOK * 4;
constexpr size_t CTL_BYTES = 1u << 20;
constexpr size_t WS_NEED = OFF_CTL + CTL_BYTES;
static_assert(EARLY_END <= OFF_X1B, "early buffers must not overlap X1B");
#define MAXTILES 4864

__device__ const double INVF[32] = {
1, 0.74989420933245587, 0.56234132519034907, 0.42169650342858223, 0.31622776601683794, 0.23713737056616552,
0.17782794100389229, 0.1333521432163324, 0.10000000000000001, 0.074989420933245579, 0.056234132519034911,
0.042169650342858224, 0.031622776601683791, 0.023713737056616554, 0.017782794100389229, 0.013335214321633241,
0.01, 0.0074989420933245579, 0.005623413251903491, 0.0042169650342858229, 0.0031622776601683794,
0.0023713737056616554, 0.0017782794100389228, 0.0013335214321633241, 0.001, 0.00074989420933245586,
0.0005623413251903491, 0.00042169650342858224, 0.00031622776601683794, 0.00023713737056616554,
0.00017782794100389227, 0.0001333521432163324};

__global__ __launch_bounds__(256) void k_rope_table(float* tab) {
  int i = blockIdx.x * 256 + threadIdx.x;
  if (i >= 4096 * 32) return;
  int pos = i >> 5, f = i & 31;
  double ang = (double)pos * INVF[f];
  const double TWO_PI = 6.283185307179586476925286766559;
  double n = rint(ang / TWO_PI);
  double r = ang - n * TWO_PI;
  double r2 = r * r;
  double sn = r, cs = 1.0, ts = r, tc = 1.0;
#pragma unroll 1
  for (int k = 1; k <= 16; ++k) {
    tc = -tc * r2 / (double)((2 * k - 1) * (2 * k));
    ts = -ts * r2 / (double)((2 * k) * (2 * k + 1));
    cs += tc; sn += ts;
  }
  tab[i * 2] = (float)cs; tab[i * 2 + 1] = (float)sn;
}

template <class AF, class BF>
__device__ __forceinline__ void gemm64_naive(float* As, float* Bs, float* Cs, int K, AF af, BF bf) {
  const int tid = threadIdx.x, tx = tid & 15, ty = tid >> 4;
  float acc[4][4];
#pragma unroll
  for (int i = 0; i < 4; ++i)
#pragma unroll
    for (int j = 0; j < 4; ++j) acc[i][j] = 0.f;
  for (int k0 = 0; k0 < K; k0 += 16) {
#pragma unroll
    for (int u = 0; u < 4; ++u) { int i = tid + u * 256; int r = i >> 4, kk = i & 15; As[kk * 68 + r] = af(r, k0 + kk); }
#pragma unroll
    for (int u = 0; u < 4; ++u) { int i = tid + u * 256; int kk = i >> 6, c = i & 63; Bs[kk * 68 + c] = bf(k0 + kk, c); }
    __syncthreads();
#pragma unroll
    for (int kk = 0; kk < 16; ++kk) {
      float a[4], b[4];
#pragma unroll
      for (int i = 0; i < 4; ++i) { a[i] = As[kk * 68 + ty * 4 + i]; b[i] = Bs[kk * 68 + tx * 4 + i]; }
#pragma unroll
      for (int i = 0; i < 4; ++i)
#pragma unroll
        for (int j = 0; j < 4; ++j) acc[i][j] += a[i] * b[j];
    }
    __syncthreads();
  }
#pragma unroll
  for (int i = 0; i < 4; ++i)
#pragma unroll
    for (int j = 0; j < 4; ++j) Cs[(ty * 4 + i) * 65 + tx * 4 + j] = acc[i][j];
  __syncthreads();
}

__global__ __launch_bounds__(256) void k_inproj(const float* __restrict__ x, const float* __restrict__ w_in, const float* __restrict__ rope,
                                                bf16_t* Q, bf16_t* K, bf16_t* V, bf16_t* FE) {
  __shared__ float As[16 * 68], Bs[16 * 68], Cs[64 * 65];
  const int row0 = blockIdx.x * 64, col0 = blockIdx.y * 64;
  gemm64_naive(As, Bs, Cs, DM,
               [&](int r, int k) { return x[(size_t)(row0 + r) * DM + k]; },
               [&](int k, int c) { int cc = col0 + c; return cc < INW ? w_in[(size_t)k * INW + cc] : 0.f; });
  for (int i = threadIdx.x; i < 4096; i += 256) {
    int r = i >> 6, c = i & 63;
    int t = row0 + r, col = col0 + c;
    if (col >= INW) continue;
    float v = Cs[r * 65 + c];
    if (col < 1024) {
      int pos = t & (SEQ - 1), f = c & 31;
      float cs = rope[(pos * 32 + f) * 2], sn = rope[(pos * 32 + f) * 2 + 1];
      float other = Cs[r * 65 + (c ^ 32)];
      float o = (c < 32) ? (v * cs - other * sn) : (v * cs + other * sn);
      if (col < 512) Q[(size_t)t * 512 + col] = f2bf(o * 0.125f);
      else K[(size_t)t * 512 + (col - 512)] = f2bf(o);
    } else if (col < 1536) {
      V[(size_t)t * 512 + (col - 1024)] = f2bf(v);
    } else {
      FE[(size_t)t * FEW + (col - 1536)] = f2bf(v);
    }
  }
}

__global__ __launch_bounds__(256) void k_prep(const bf16_t* __restrict__ FE, const float* __restrict__ mu, const float* __restrict__ w0,
                                              const float* __restrict__ Wd, const float* __restrict__ a0, const float* __restrict__ Wa,
                                              const float* __restrict__ Wg, const float* __restrict__ k_k, const float* __restrict__ k_a,
                                              const float* __restrict__ r_k, bf16_t* R, bf16_t* K2, bf16_t* V2, bf16_t* A, bf16_t* B,
                                              float* W, bf16_t* G, float* SB) {
  __shared__ float f[4][FEW];
  __shared__ float act[4][288];
  const int tid = threadIdx.x;
  const int t0 = blockIdx.x * 4;
  for (int i = tid; i < 4 * FEW; i += 256) {
    int tt = i / FEW, c = i - tt * FEW;
    int t = t0 + tt;
    float cur = bf2f(FE[(size_t)t * FEW + c]);
    float prev = ((t & (SEQ - 1)) == 0) ? 0.f : bf2f(FE[(size_t)(t - 1) * FEW + c]);
    f[tt][c] = cur + (prev - cur) * mu[c];
  }
  __syncthreads();
  for (int i = tid; i < 4 * 288; i += 256) {
    int tt = i / 288, j = i - tt * 288;
    float v = f[tt][1536 + j];
    act[tt][j] = (j < 64) ? tanhf(v) : ((j < 128) ? v : sigmoidf_(v));
  }
  __syncthreads();
#pragma unroll 1
  for (int pass = 0; pass < 2; ++pass) {
    const int c = tid + pass * 256;
    float wacc[4] = {0.f, 0.f, 0.f, 0.f}, aacc[4] = {0.f, 0.f, 0.f, 0.f}, gacc[4] = {0.f, 0.f, 0.f, 0.f};
    for (int j = 0; j < 64; ++j) {
      float wd = Wd[j * 512 + c], wa = Wa[j * 512 + c];
#pragma unroll
      for (int tt = 0; tt < 4; ++tt) { wacc[tt] += act[tt][j] * wd; aacc[tt] += act[tt][64 + j] * wa; }
    }
    for (int j = 0; j < 160; ++j) {
      float wg = Wg[j * 512 + c];
#pragma unroll
      for (int tt = 0; tt < 4; ++tt) gacc[tt] += act[tt][128 + j] * wg;
    }
    const float w0c = w0[c], a0c = a0[c], kkc = k_k[c], kac = k_a[c], rkc = r_k[c];
#pragma unroll
    for (int tt = 0; tt < 4; ++tt) {
      const int t = t0 + tt;
      float z = w0c + wacc[tt];
      float nz = -z;
      float sp = fmaxf(nz, 0.f) + log1pf(__expf(-fabsf(nz)));
      float w = -sp - 0.5f;
      float decay = __expf(-__expf(w));
      float a = sigmoidf_(a0c + aacc[tt]);
      float r = f[tt][c], k = f[tt][512 + c], v = f[tt][1024 + c];
      float kk = k * kkc;
      float ss = wave_sum(kk * kk);
      float kkn = kk / fmaxf(sqrtf(ss), 1e-12f);
      float k2 = k * (1.f + (a - 1.f) * kac);
      float sb = wave_sum(r * k2 * rkc);
      size_t o = (size_t)t * 512 + c;
      R[o] = f2bf(r); K2[o] = f2bf(k2); V2[o] = f2bf(v); A[o] = f2bf(-kkn); B[o] = f2bf(kkn * a);
      W[o] = decay; G[o] = f2bf(gacc[tt]);
      if ((tid & 63) == 0) SB[(size_t)t * 8 + (c >> 6)] = sb;
    }
  }
}

__global__ __launch_bounds__(64) void k_scan_naive(const bf16_t* __restrict__ R, const float* __restrict__ W, const bf16_t* __restrict__ K2,
                                                   const bf16_t* __restrict__ V2, const bf16_t* __restrict__ A, const bf16_t* __restrict__ B,
                                                   float* YS) {
  __shared__ float sr[64], sw[64], sk[64], sa_[64], sb_[64];
  const int bh = blockIdx.x, b = bh >> 3, h = bh & 7, v = threadIdx.x;
  float st[64];
#pragma unroll
  for (int k = 0; k < 64; ++k) st[k] = 0.f;
  for (int s = 0; s < SEQ; ++s) {
    size_t base = ((size_t)(b * SEQ + s)) * 512 + h * 64;
    sr[v] = bf2f(R[base + v]); sw[v] = W[base + v]; sk[v] = bf2f(K2[base + v]);
    sa_[v] = bf2f(A[base + v]); sb_[v] = bf2f(B[base + v]);
    float vv = bf2f(V2[base + v]);
    __syncthreads();
    float sa = 0.f;
#pragma unroll
    for (int k = 0; k < 64; ++k) sa += st[k] * sa_[k];
    float y = 0.f;
#pragma unroll
    for (int k = 0; k < 64; ++k) {
      st[k] = st[k] * sw[k] + sa * sb_[k] + vv * sk[k];
      y += st[k] * sr[k];
    }
    YS[base + v] = y;
    __syncthreads();
  }
}

__global__ __launch_bounds__(256) void k_attn_naive(const bf16_t* __restrict__ Q, const bf16_t* __restrict__ K, const bf16_t* __restrict__ V, bf16_t* ATT) {
  const int gid = blockIdx.x * 256 + threadIdx.x;
  const int t = gid >> 3, h = gid & 7;
  const int s = t & (SEQ - 1), tb = t - s;
  float q[64], o[64];
  const bf16_t* qp = Q + (size_t)t * 512 + h * 64;
#pragma unroll
  for (int c = 0; c < 64; ++c) { q[c] = bf2f(qp[c]); o[c] = 0.f; }
  float m = -INFINITY, l = 0.f;
#pragma unroll 1
  for (int p = 0; p < 3; ++p) {
    const int d = (p == 0) ? 1 : ((p == 1) ? 4 : 16);
#pragma unroll 1
    for (int j = 0; j <= 128; ++j) {
      int key = s - d * j;
      if (key < 0) break;
      const bf16_t* kp = K + (size_t)(tb + key) * 512 + h * 64;
      const bf16_t* vp = V + (size_t)(tb + key) * 512 + h * 64;
      float dot = 0.f;
#pragma unroll
      for (int c = 0; c < 64; ++c) dot += q[c] * bf2f(kp[c]);
      float mn = fmaxf(m, dot);
      float corr = __expf(m - mn);
      float pe = __expf(dot - mn);
      l = l * corr + pe;
#pragma unroll
      for (int c = 0; c < 64; ++c) o[c] = o[c] * corr + pe * bf2f(vp[c]);
      m = mn;
    }
  }
  float inv = 1.f / l;
  bf16_t* op = ATT + (size_t)t * 512 + h * 64;
#pragma unroll
  for (int c = 0; c < 64; ++c) op[c] = f2bf(o[c] * inv);
}

__global__ __launch_bounds__(256) void k_post(const float* __restrict__ YS, const bf16_t* __restrict__ V2, const bf16_t* __restrict__ G,
                                              const float* __restrict__ SB, const bf16_t* __restrict__ ATT, const float* __restrict__ lnx_g,
                                              const float* __restrict__ lnx_b, bf16_t* MIXED) {
  const int t = blockIdx.x, tid = threadIdx.x;
#pragma unroll
  for (int pass = 0; pass < 2; ++pass) {
    int c = tid + pass * 256;
    size_t o = (size_t)t * 512 + c;
    float y = YS[o];
    float mean = wave_sum(y) * (1.f / 64.f);
    float d = y - mean;
    float var = wave_sum(d * d) * (1.f / 64.f);
    float yn = d * rsqrtf(var + GN_EPS_F) * lnx_g[c] + lnx_b[c];
    float res = (yn + SB[(size_t)t * 8 + (c >> 6)] * bf2f(V2[o])) * bf2f(G[o]);
    MIXED[(size_t)t * 1024 + 512 + c] = f2bf(res);
    MIXED[(size_t)t * 1024 + c] = ATT[o];
  }
}

__global__ __launch_bounds__(256) void k_outproj(const bf16_t* __restrict__ MIXED, const float* __restrict__ w_out, const float* __restrict__ x, float* U) {
  __shared__ float As[16 * 68], Bs[16 * 68], Cs[64 * 65];
  const int row0 = blockIdx.x * 64, col0 = blockIdx.y * 64;
  gemm64_naive(As, Bs, Cs, DM,
               [&](int r, int k) { return bf2f(MIXED[(size_t)(row0 + r) * DM + k]); },
               [&](int k, int c) { return w_out[(size_t)k * DM + col0 + c]; });
  for (int i = threadIdx.x; i < 4096; i += 256) {
    int r = i >> 6, c = i & 63;
    size_t o = (size_t)(row0 + r) * DM + col0 + c;
    U[o] = ALPHA_F * x[o] + Cs[r * 65 + c];
  }
}

__global__ __launch_bounds__(256) void k_ln1_router(float* X1  , const float* __restrict__ g1, const float* __restrict__ b1,
                                                    const float* __restrict__ router_w, const float* __restrict__ router_bias,
                                                    bf16_t* X1B, int* LIST, float* GATEW, int* counts) {
  __shared__ float xs[4][DM];
  __shared__ float red[4][8];
  __shared__ float aff[4][NEXP];
  __shared__ float sel[4][NEXP];
  const int tid = threadIdx.x, lane = tid & 63, wid = tid >> 6;
  const int t0 = blockIdx.x * 4;
  for (int tt = 0; tt < 4; ++tt) {
    size_t base = (size_t)(t0 + tt) * DM;
    float v[4];
    float s = 0.f;
#pragma unroll
    for (int u = 0; u < 4; ++u) { v[u] = X1[base + tid + u * 256]; s += v[u]; }
    s = wave_sum(s);
    if (lane == 0) red[tt][wid] = s;
    __syncthreads();
    float mean = (red[tt][0] + red[tt][1] + red[tt][2] + red[tt][3]) * (1.f / DM);
    float q = 0.f;
#pragma unroll
    for (int u = 0; u < 4; ++u) { float d = v[u] - mean; q += d * d; }
    q = wave_sum(q);
    if (lane == 0) red[tt][4 + wid] = q;
    __syncthreads();
    float var = (red[tt][4] + red[tt][5] + red[tt][6] + red[tt][7]) * (1.f / DM);
    float rs = rsqrtf(var + LN_EPS_F);
#pragma unroll
    for (int u = 0; u < 4; ++u) {
      int c = tid + u * 256;
      float y = (v[u] - mean) * rs * g1[c] + b1[c];
      xs[tt][c] = y;
      X1[base + c] = y;
      X1B[base + c] = f2bf(y);
    }
  }
  __syncthreads();
  {
    const int e = tid;
    float acc[4] = {0.f, 0.f, 0.f, 0.f};
    for (int k = 0; k < DM; ++k) {
      float w = router_w[(size_t)k * NEXP + e];
#pragma unroll
      for (int tt = 0; tt < 4; ++tt) acc[tt] += xs[tt][k] * w;
    }
    float bias = router_bias[e];
#pragma unroll
    for (int tt = 0; tt < 4; ++tt) { float a = sigmoidf_(acc[tt]); aff[tt][e] = a; sel[tt][e] = a + bias; }
  }
  __syncthreads();
  if (tid < 4) {
    const int tt = tid, t = t0 + tt;
    float gs[8];
#pragma unroll
    for (int g = 0; g < 8; ++g) {
      float m1 = -INFINITY, m2 = -INFINITY;
      for (int i = 0; i < 32; ++i) {
        float v = sel[tt][g * 32 + i];
        if (v > m1) { m2 = m1; m1 = v; } else if (v > m2) m2 = v;
      }
      gs[g] = m1 + m2;
    }
    unsigned mask = 0;
#pragma unroll
    for (int it = 0; it < 4; ++it) {
      int best = -1; float bv = -INFINITY;
#pragma unroll
      for (int g = 0; g < 8; ++g) {
        bool ok = !((mask >> g) & 1u);
        if (ok && (best < 0 || gs[g] > bv)) { best = g; bv = gs[g]; }
      }
      mask |= 1u << best;
    }
    int idx[8]; float av[8]; float asum = 0.f;
#pragma unroll
    for (int it = 0; it < 8; ++it) {
      int best = -1; float bv = -INFINITY;
      for (int e = 0; e < NEXP; ++e) {
        if (!((mask >> (e >> 5)) & 1u)) continue;
        float v = sel[tt][e];
        if (best < 0 || v > bv) { best = e; bv = v; }
      }
      idx[it] = best; av[it] = aff[tt][best]; asum += av[it];
      sel[tt][best] = -INFINITY;
    }
    float sc = 2.5f / asum;
#pragma unroll
    for (int it = 0; it < 8; ++it) {
      int e = idx[it];
      int pos = atomicAdd(&counts[e], 1);
      LIST[(size_t)e * T_TOK + pos] = it * T_TOK + t;
      GATEW[(size_t)it * T_TOK + t] = av[it] * sc;
    }
  }
}

__global__ __launch_bounds__(256) void k_tiles(int* ctl) {
  __shared__ int pre[NEXP + 2];
  int* counts = ctl;
  int* ntiles = ctl + 256;
  int* tile_e = ctl + 1024;
  int* tile_r0 = ctl + 1024 + MAXTILES;
  const int tid = threadIdx.x;
  if (tid == 0) {
    int acc = 0;
    for (int e = 0; e <= NEXP; ++e) { pre[e] = acc; int c = (e < NEXP) ? counts[e] : T_TOK; acc += (c + 63) >> 6; }
    pre[NEXP + 1] = acc;
    *ntiles = acc;
  }
  __syncthreads();
  for (int e = tid; e <= NEXP; e += 256) {
    int n = pre[e + 1] - pre[e];
    for (int i = 0; i < n; ++i) { tile_e[pre[e] + i] = e; tile_r0[pre[e] + i] = i * 64; }
  }
}

__global__ __launch_bounds__(256) void k_moe1(const bf16_t* __restrict__ X1B, const float* __restrict__ e_gate, const float* __restrict__ e_up,
                                              const float* __restrict__ s_gate, const float* __restrict__ s_up, const int* __restrict__ LIST,
                                              const int* __restrict__ ctl, bf16_t* H) {
  __shared__ float As[16 * 68], Bs[16 * 68], Cg[64 * 65], Cu[64 * 65];
  __shared__ int asg[64];
  const int ti = blockIdx.x;
  if (ti >= ctl[256]) return;
  const int e = ctl[1024 + ti], r0 = ctl[1024 + MAXTILES + ti];
  const int cnt = (e < NEXP) ? ctl[e] : T_TOK;
  const int col0 = blockIdx.y * 64;
  if (threadIdx.x < 64) {
    int r = r0 + threadIdx.x;
    asg[threadIdx.x] = (r < cnt) ? ((e < NEXP) ? LIST[(size_t)e * T_TOK + r] : (8 * T_TOK + r)) : -1;
  }
  __syncthreads();
  const float* Wg = (e < NEXP) ? e_gate + (size_t)e * DM * 256 : s_gate;
  const float* Wu = (e < NEXP) ? e_up + (size_t)e * DM * 256 : s_up;
  auto af = [&](int r, int k) { int a = asg[r]; return a >= 0 ? bf2f(X1B[(size_t)(a & (T_TOK - 1)) * DM + k]) : 0.f; };
  gemm64_naive(As, Bs, Cg, DM, af, [&](int k, int c) { return Wg[(size_t)k * 256 + col0 + c]; });
  gemm64_naive(As, Bs, Cu, DM, af, [&](int k, int c) { return Wu[(size_t)k * 256 + col0 + c]; });
  for (int i = threadIdx.x; i < 4096; i += 256) {
    int r = i >> 6, c = i & 63;
    int a = asg[r];
    if (a < 0) continue;
    float g = Cg[r * 65 + c], u = Cu[r * 65 + c];
    float hv = g * sigmoidf_(g) * u;
    H[(size_t)a * 256 + col0 + c] = f2bf(hv);
  }
}

__global__ __launch_bounds__(256) void k_moe2(const bf16_t* __restrict__ H, const float* __restrict__ e_down, const float* __restrict__ s_down,
                                              const int* __restrict__ LIST, const float* __restrict__ GATEW, const int* __restrict__ ctl, bf16_t* Y) {
  __shared__ float As[16 * 68], Bs[16 * 68], Cs[64 * 65];
  __shared__ int asg[64];
  const int ti = blockIdx.x;
  if (ti >= ctl[256]) return;
  const int e = ctl[1024 + ti], r0 = ctl[1024 + MAXTILES + ti];
  const int cnt = (e < NEXP) ? ctl[e] : T_TOK;
  const int col0 = blockIdx.y * 64;
  if (threadIdx.x < 64) {
    int r = r0 + threadIdx.x;
    asg[threadIdx.x] = (r < cnt) ? ((e < NEXP) ? LIST[(size_t)e * T_TOK + r] : (8 * T_TOK + r)) : -1;
  }
  __syncthreads();
  const float* Wd = (e < NEXP) ? e_down + (size_t)e * 256 * DM : s_down;
  gemm64_naive(As, Bs, Cs, 256,
               [&](int r, int k) { int a = asg[r]; return a >= 0 ? bf2f(H[(size_t)a * 256 + k]) : 0.f; },
               [&](int k, int c) { return Wd[(size_t)k * DM + col0 + c]; });
  for (int i = threadIdx.x; i < 4096; i += 256) {
    int r = i >> 6, c = i & 63;
    int a = asg[r];
    if (a < 0) continue;
    float gw = (a < 8 * T_TOK) ? GATEW[a] : 1.f;
    Y[(size_t)a * DM + col0 + c] = f2bf(Cs[r * 65 + c] * gw);
  }
}

__global__ __launch_bounds__(256) void k_final(float* OUT  , const bf16_t* __restrict__ Y, const float* __restrict__ g2, const float* __restrict__ b2) {
  __shared__ float red[8];
  const int t = blockIdx.x, tid = threadIdx.x, lane = tid & 63, wid = tid >> 6;
  size_t base = (size_t)t * DM;
  float v[4];
  float s = 0.f;
#pragma unroll
  for (int u = 0; u < 4; ++u) {
    int c = tid + u * 256;
    float acc = 0.f;
#pragma unroll
    for (int sl = 0; sl < 9; ++sl) acc += bf2f(Y[((size_t)sl * T_TOK + t) * DM + c]);
    v[u] = ALPHA_F * OUT[base + c] + acc;
    s += v[u];
  }
  s = wave_sum(s);
  if (lane == 0) red[wid] = s;
  __syncthreads();
  float mean = (red[0] + red[1] + red[2] + red[3]) * (1.f / DM);
  float q = 0.f;
#pragma unroll
  for (int u = 0; u < 4; ++u) { float d = v[u] - mean; q += d * d; }
  q = wave_sum(q);
  if (lane == 0) red[4 + wid] = q;
  __syncthreads();
  float var = (red[4] + red[5] + red[6] + red[7]) * (1.f / DM);
  float rs = rsqrtf(var + LN_EPS_F);
#pragma unroll
  for (int u = 0; u < 4; ++u) {
    int c = tid + u * 256;
    OUT[base + c] = (v[u] - mean) * rs * g2[c] + b2[c];
  }
}

extern "C" void kernel_launch(void* const* d_in, const int* in_sizes, int n_in, void* d_out, int out_size, void* d_ws, size_t ws_size,
                              hipStream_t stream) {
  if (ws_size < WS_NEED) { fprintf(stderr, "kernel_launch: ws too small: %zu < %zu\n", ws_size, (size_t)WS_NEED); return; }
  const float* x = (const float*)d_in[0];
  const float* w_in = (const float*)d_in[1];
  const float* mu = (const float*)d_in[2];
  const float* w0 = (const float*)d_in[3];
  const float* Wd = (const float*)d_in[4];
  const float* a0 = (const float*)d_in[5];
  const float* Wa = (const float*)d_in[6];
  const float* Wg = (const float*)d_in[7];
  const float* k_k = (const float*)d_in[8];
  const float* k_a = (const float*)d_in[9];
  const float* r_k = (const float*)d_in[10];
  const float* lnx_g = (const float*)d_in[11];
  const float* lnx_b = (const float*)d_in[12];
  const float* w_out = (const float*)d_in[13];
  const float* ln1_g = (const float*)d_in[14];
  const float* ln1_b = (const float*)d_in[15];
  const float* router_w = (const float*)d_in[16];
  const float* router_bias = (const float*)d_in[17];
  const float* e_gate = (const float*)d_in[18];
  const float* e_up = (const float*)d_in[19];
  const float* e_down = (const float*)d_in[20];
  const float* s_gate = (const float*)d_in[21];
  const float* s_up = (const float*)d_in[22];
  const float* s_down = (const float*)d_in[23];
  const float* ln2_g = (const float*)d_in[24];
  const float* ln2_b = (const float*)d_in[25];
  char* ws = (char*)d_ws;
  float* out = (float*)d_out;
  bf16_t* Q = (bf16_t*)(ws + OFF_Q); bf16_t* K = (bf16_t*)(ws + OFF_K); bf16_t* V = (bf16_t*)(ws + OFF_V);
  bf16_t* FE = (bf16_t*)(ws + OFF_FEATS);
  bf16_t* R = (bf16_t*)(ws + OFF_R); bf16_t* K2 = (bf16_t*)(ws + OFF_K2); bf16_t* V2 = (bf16_t*)(ws + OFF_V2);
  bf16_t* A = (bf16_t*)(ws + OFF_A); bf16_t* B = (bf16_t*)(ws + OFF_B);
  float* W = (float*)(ws + OFF_W); bf16_t* G = (bf16_t*)(ws + OFF_G); float* SB = (float*)(ws + OFF_SB);
  float* YS = (float*)(ws + OFF_YS); bf16_t* ATT = (bf16_t*)(ws + OFF_ATT); bf16_t* MIXED = (bf16_t*)(ws + OFF_MIXED);
  float* ROPE = (float*)(ws + OFF_ROPE);
  bf16_t* Y = (bf16_t*)(ws + OFF_Y); bf16_t* H = (bf16_t*)(ws + OFF_H); bf16_t* X1B = (bf16_t*)(ws + OFF_X1B);
  int* LIST = (int*)(ws + OFF_LIST); float* GATEW = (float*)(ws + OFF_GATEW); int* ctl = (int*)(ws + OFF_CTL);

  hipMemsetAsync(ctl, 0, CTL_BYTES, stream);
  k_rope_table<<<512, 256, 0, stream>>>(ROPE);
  k_inproj<<<dim3(T_TOK / 64, 53), 256, 0, stream>>>(x, w_in, ROPE, Q, K, V, FE);
  k_prep<<<T_TOK / 4, 256, 0, stream>>>(FE, mu, w0, Wd, a0, Wa, Wg, k_k, k_a, r_k, R, K2, V2, A, B, W, G, SB);
  k_scan_naive<<<64, 64, 0, stream>>>(R, W, K2, V2, A, B, YS);
  k_attn_naive<<<T_TOK * 8 / 256, 256, 0, stream>>>(Q, K, V, ATT);
  k_post<<<T_TOK, 256, 0, stream>>>(YS, V2, G, SB, ATT, lnx_g, lnx_b, MIXED);
  k_outproj<<<dim3(T_TOK / 64, 16), 256, 0, stream>>>(MIXED, w_out, x, out);
  k_ln1_router<<<T_TOK / 4, 256, 0, stream>>>(out, ln1_g, ln1_b, router_w, router_bias, X1B, LIST, GATEW, ctl);
  k_tiles<<<1, 256, 0, stream>>>(ctl);
  k_moe1<<<dim3(MAXTILES, 4), 256, 0, stream>>>(X1B, e_gate, e_up, s_gate, s_up, LIST, ctl, H);
  k_moe2<<<dim3(MAXTILES, 16), 256, 0, stream>>>(H, e_down, s_down, LIST, GATEW, ctl, Y);
  k_final<<<T_TOK, 256, 0, stream>>>(out, Y, ln2_g, ln2_b);
}
```

```cpp
#include <hip/hip_runtime.h>
#include <hip/hip_bf16.h>
#include <hip/hip_cooperative_groups.h>
#include <stdint.h>
#include <stdio.h>

typedef unsigned short bf16_t;

#define T_TOK 32768
#define SEQ 4096
#define DM 1024
#define INW 3360
#define FEW 1824
#define NEXP 256
#define ALPHA_F 1.189207115002721f
#define LN_EPS_F 1e-5f
#define GN_EPS_F 64e-5f

__device__ __forceinline__ float bf2f(bf16_t v) { return __uint_as_float(((unsigned)v) << 16); }
__device__ __forceinline__ bf16_t f2bf(float f) { unsigned u = __float_as_uint(f); return (bf16_t)((u + 0x7fffu + ((u >> 16) & 1u)) >> 16); }
__device__ __forceinline__ float sigmoidf_(float x) { return 1.f / (1.f + __expf(-x)); }
__device__ __forceinline__ float wave_sum(float v) {
#pragma unroll
  for (int o = 32; o >= 1; o >>= 1) v += __shfl_xor(v, o, 64);
  return v;
}

constexpr size_t SZ_T512_BF = (size_t)T_TOK * 512 * 2;
constexpr size_t OFF_Q = 0;
constexpr size_t OFF_K = OFF_Q + SZ_T512_BF;
constexpr size_t OFF_V = OFF_K + SZ_T512_BF;
constexpr size_t OFF_FEATS = OFF_V + SZ_T512_BF;
constexpr size_t OFF_R = OFF_FEATS + (size_t)T_TOK * FEW * 2;
constexpr size_t OFF_K2 = OFF_R + SZ_T512_BF;
constexpr size_t OFF_V2 = OFF_K2 + SZ_T512_BF;
constexpr size_t OFF_A = OFF_V2 + SZ_T512_BF;
constexpr size_t OFF_B = OFF_A + SZ_T512_BF;
constexpr size_t OFF_W = OFF_B + SZ_T512_BF;
constexpr size_t OFF_G = OFF_W + (size_t)T_TOK * 512 * 4;
constexpr size_t OFF_SB = OFF_G + SZ_T512_BF;
constexpr size_t OFF_YS = OFF_SB + (size_t)T_TOK * 8 * 4;
constexpr size_t OFF_ATT = OFF_YS + (size_t)T_TOK * 512 * 4;
constexpr size_t OFF_MIXED = OFF_ATT + SZ_T512_BF;
constexpr size_t OFF_ROPE = OFF_MIXED + (size_t)T_TOK * 1024 * 2;
constexpr size_t EARLY_END = OFF_ROPE + (size_t)4096 * 32 * 2 * 4;
constexpr size_t OFF_Y = 0;
constexpr size_t OFF_H = OFF_Y + (size_t)9 * T_TOK * 1024 * 2;
constexpr size_t OFF_X1B = OFF_H + (size_t)9 * T_TOK * 256 * 2;
constexpr size_t OFF_LIST = OFF_X1B + (size_t)T_TOK * 1024 * 2;
constexpr size_t OFF_GATEW = OFF_LIST + (size_t)NEXP * T_TOK * 4;
constexpr size_t OFF_CTL = OFF_GATEW + (size_t)8 * T_TOK * 4;
constexpr size_t CTL_BYTES = 1u << 20;
constexpr size_t WS_NEED = OFF_CTL + CTL_BYTES;
static_assert(EARLY_END <= OFF_X1B, "early buffers must not overlap X1B");
#define MAXTILES 4864

__device__ const double INVF[32] = {
1, 0.74989420933245587, 0.56234132519034907, 0.42169650342858223, 0.31622776601683794, 0.23713737056616552,
0.17782794100389229, 0.1333521432163324, 0.10000000000000001, 0.074989420933245579, 0.056234132519034911,
0.042169650342858224, 0.031622776601683791, 0.023713737056616554, 0.017782794100389229, 0.013335214321633241,
0.01, 0.0074989420933245579, 0.005623413251903491, 0.0042169650342858229, 0.0031622776601683794,
0.0023713737056616554, 0.0017782794100389228, 0.0013335214321633241, 0.001, 0.00074989420933245586,
0.0005623413251903491, 0.00042169650342858224, 0.00031622776601683794, 0.00023713737056616554,
0.00017782794100389227, 0.0001333521432163324};

namespace cg = cooperative_groups;

struct Params {
  const float* in[26];
  float* out;
  char* ws;
};

#define NTHR 256
#define LDS_BYTES 65536

__device__ __forceinline__ void phase_rope(const Params& p) {
  float* tab = (float*)(p.ws + OFF_ROPE);
  for (int i = blockIdx.x * NTHR + threadIdx.x; i < 4096 * 32; i += gridDim.x * NTHR) {
    int pos = i >> 5, f = i & 31;
    double ang = (double)pos * INVF[f];
    const double TWO_PI = 6.283185307179586476925286766559;
    double n = rint(ang / TWO_PI);
    double r = ang - n * TWO_PI;
    double r2 = r * r;
    double sn = r, cs = 1.0, ts = r, tc = 1.0;
#pragma unroll 1
    for (int k = 1; k <= 16; ++k) {
      tc = -tc * r2 / (double)((2 * k - 1) * (2 * k));
      ts = -ts * r2 / (double)((2 * k) * (2 * k + 1));
      cs += tc; sn += ts;
    }
    tab[i * 2] = (float)cs; tab[i * 2 + 1] = (float)sn;
  }
  int* ctl = (int*)(p.ws + OFF_CTL);
  if (blockIdx.x == 0) for (int i = threadIdx.x; i < 1024; i += NTHR) ctl[i] = 0;
}

template <class AF, class BF>
__device__ __forceinline__ void gemm64_naive(float* As, float* Bs, float* Cs, int K, AF af, BF bf) {
  const int tid = threadIdx.x, tx = tid & 15, ty = tid >> 4;
  float acc[4][4];
#pragma unroll
  for (int i = 0; i < 4; ++i)
#pragma unroll
    for (int j = 0; j < 4; ++j) acc[i][j] = 0.f;
  for (int k0 = 0; k0 < K; k0 += 16) {
#pragma unroll
    for (int u = 0; u < 4; ++u) { int i = tid + u * 256; int r = i >> 4, kk = i & 15; As[kk * 68 + r] = af(r, k0 + kk); }
#pragma unroll
    for (int u = 0; u < 4; ++u) { int i = tid + u * 256; int kk = i >> 6, c = i & 63; Bs[kk * 68 + c] = bf(k0 + kk, c); }
    __syncthreads();
#pragma unroll
    for (int kk = 0; kk < 16; ++kk) {
      float a[4], b[4];
#pragma unroll
      for (int i = 0; i < 4; ++i) { a[i] = As[kk * 68 + ty * 4 + i]; b[i] = Bs[kk * 68 + tx * 4 + i]; }
#pragma unroll
      for (int i = 0; i < 4; ++i)
#pragma unroll
        for (int j = 0; j < 4; ++j) acc[i][j] += a[i] * b[j];
    }
    __syncthreads();
  }
#pragma unroll
  for (int i = 0; i < 4; ++i)
#pragma unroll
    for (int j = 0; j < 4; ++j) Cs[(ty * 4 + i) * 65 + tx * 4 + j] = acc[i][j];
  __syncthreads();
}

__device__ __forceinline__ void phase_inproj(const Params& p, char* smem) {
  float* As = (float*)smem; float* Bs = As + 16 * 68; float* Cs = Bs + 16 * 68;
  const float* __restrict__ x = p.in[0];
  const float* __restrict__ w_in = p.in[1];
  const float* __restrict__ rope = (const float*)(p.ws + OFF_ROPE);
  bf16_t* Q = (bf16_t*)(p.ws + OFF_Q); bf16_t* K = (bf16_t*)(p.ws + OFF_K); bf16_t* V = (bf16_t*)(p.ws + OFF_V);
  bf16_t* FE = (bf16_t*)(p.ws + OFF_FEATS);
  const int NT = 53, NITEM = (T_TOK / 64) * NT;
  for (int item = blockIdx.x; item < NITEM; item += gridDim.x) {
    const int row0 = (item / NT) * 64, col0 = (item % NT) * 64;
    gemm64_naive(As, Bs, Cs, DM,
                 [&](int r, int k) { return x[(size_t)(row0 + r) * DM + k]; },
                 [&](int k, int c) { int cc = col0 + c; return cc < INW ? w_in[(size_t)k * INW + cc] : 0.f; });
    for (int i = threadIdx.x; i < 4096; i += NTHR) {
      int r = i >> 6, c = i & 63;
      int t = row0 + r, col = col0 + c;
      if (col >= INW) continue;
      float v = Cs[r * 65 + c];
      if (col < 1024) {
        int pos = t & (SEQ - 1), f = c & 31;
        float cs = rope[(pos * 32 + f) * 2], sn = rope[(pos * 32 + f) * 2 + 1];
        float other = Cs[r * 65 + (c ^ 32)];
        float o = (c < 32) ? (v * cs - other * sn) : (v * cs + other * sn);
        if (col < 512) Q[(size_t)t * 512 + col] = f2bf(o * 0.125f);
        else K[(size_t)t * 512 + (col - 512)] = f2bf(o);
      } else if (col < 1536) {
        V[(size_t)t * 512 + (col - 1024)] = f2bf(v);
      } else {
        FE[(size_t)t * FEW + (col - 1536)] = f2bf(v);
      }
    }
    __syncthreads();
  }
}

__device__ __forceinline__ void phase_prep(const Params& p, char* smem) {
  float (*f)[FEW] = (float (*)[FEW])smem;
  float (*act)[288] = (float (*)[288])(smem + 4 * FEW * 4);
  const bf16_t* __restrict__ FE = (const bf16_t*)(p.ws + OFF_FEATS);
  const float* __restrict__ mu = p.in[2]; const float* __restrict__ w0 = p.in[3]; const float* __restrict__ Wd = p.in[4];
  const float* __restrict__ a0 = p.in[5]; const float* __restrict__ Wa = p.in[6]; const float* __restrict__ Wg = p.in[7];
  const float* __restrict__ k_k = p.in[8]; const float* __restrict__ k_a = p.in[9]; const float* __restrict__ r_k = p.in[10];
  bf16_t* R = (bf16_t*)(p.ws + OFF_R); bf16_t* K2 = (bf16_t*)(p.ws + OFF_K2); bf16_t* V2 = (bf16_t*)(p.ws + OFF_V2);
  bf16_t* A = (bf16_t*)(p.ws + OFF_A); bf16_t* B = (bf16_t*)(p.ws + OFF_B);
  float* W = (float*)(p.ws + OFF_W); bf16_t* G = (bf16_t*)(p.ws + OFF_G); float* SB = (float*)(p.ws + OFF_SB);
  const int tid = threadIdx.x;
  for (int item = blockIdx.x; item < T_TOK / 4; item += gridDim.x) {
    const int t0 = item * 4;
    for (int i = tid; i < 4 * FEW; i += NTHR) {
      int tt = i / FEW, c = i - tt * FEW;
      int t = t0 + tt;
      float cur = bf2f(FE[(size_t)t * FEW + c]);
      float prev = ((t & (SEQ - 1)) == 0) ? 0.f : bf2f(FE[(size_t)(t - 1) * FEW + c]);
      f[tt][c] = cur + (prev - cur) * mu[c];
    }
    __syncthreads();
    for (int i = tid; i < 4 * 288; i += NTHR) {
      int tt = i / 288, j = i - tt * 288;
      float v = f[tt][1536 + j];
      act[tt][j] = (j < 64) ? tanhf(v) : ((j < 128) ? v : sigmoidf_(v));
    }
    __syncthreads();
#pragma unroll 1
    for (int pass = 0; pass < 2; ++pass) {
      const int c = tid + pass * 256;
      float wacc[4] = {0.f, 0.f, 0.f, 0.f}, aacc[4] = {0.f, 0.f, 0.f, 0.f}, gacc[4] = {0.f, 0.f, 0.f, 0.f};
      for (int j = 0; j < 64; ++j) {
        float wd = Wd[j * 512 + c], wa = Wa[j * 512 + c];
#pragma unroll
        for (int tt = 0; tt < 4; ++tt) { wacc[tt] += act[tt][j] * wd; aacc[tt] += act[tt][64 + j] * wa; }
      }
      for (int j = 0; j < 160; ++j) {
        float wg = Wg[j * 512 + c];
#pragma unroll
        for (int tt = 0; tt < 4; ++tt) gacc[tt] += act[tt][128 + j] * wg;
      }
      const float w0c = w0[c], a0c = a0[c], kkc = k_k[c], kac = k_a[c], rkc = r_k[c];
#pragma unroll
      for (int tt = 0; tt < 4; ++tt) {
        const int t = t0 + tt;
        float z = w0c + wacc[tt];
        float nz = -z;
        float sp = fmaxf(nz, 0.f) + log1pf(__expf(-fabsf(nz)));
        float w = -sp - 0.5f;
        float decay = __expf(-__expf(w));
        float a = sigmoidf_(a0c + aacc[tt]);
        float r = f[tt][c], k = f[tt][512 + c], v = f[tt][1024 + c];
        float kk = k * kkc;
        float ss = wave_sum(kk * kk);
        float kkn = kk / fmaxf(sqrtf(ss), 1e-12f);
        float k2 = k * (1.f + (a - 1.f) * kac);
        float sb = wave_sum(r * k2 * rkc);
        size_t o = (size_t)t * 512 + c;
        R[o] = f2bf(r); K2[o] = f2bf(k2); V2[o] = f2bf(v); A[o] = f2bf(-kkn); B[o] = f2bf(kkn * a);
        W[o] = decay; G[o] = f2bf(gacc[tt]);
        if ((tid & 63) == 0) SB[(size_t)t * 8 + (c >> 6)] = sb;
      }
    }
    __syncthreads();
  }
}

__device__ __forceinline__ void phase_scan_naive(const Params& p, char* smem) {
  if (blockIdx.x >= 64) return;
  float* sr = (float*)smem; float* sw = sr + 64; float* sk = sw + 64; float* sa_ = sk + 64; float* sb_ = sa_ + 64;
  const bf16_t* __restrict__ R = (const bf16_t*)(p.ws + OFF_R); const bf16_t* __restrict__ K2 = (const bf16_t*)(p.ws + OFF_K2);
  const bf16_t* __restrict__ V2 = (const bf16_t*)(p.ws + OFF_V2); const bf16_t* __restrict__ A = (const bf16_t*)(p.ws + OFF_A);
  const bf16_t* __restrict__ B = (const bf16_t*)(p.ws + OFF_B); const float* __restrict__ W = (const float*)(p.ws + OFF_W);
  float* YS = (float*)(p.ws + OFF_YS);
  const int bh = blockIdx.x, b = bh >> 3, h = bh & 7, v = threadIdx.x & 63;
  const bool active = threadIdx.x < 64;
  float st[64];
#pragma unroll
  for (int k = 0; k < 64; ++k) st[k] = 0.f;
  for (int s = 0; s < SEQ; ++s) {
    size_t base = ((size_t)(b * SEQ + s)) * 512 + h * 64;
    float vv = 0.f;
    if (active) {
      sr[v] = bf2f(R[base + v]); sw[v] = W[base + v]; sk[v] = bf2f(K2[base + v]);
      sa_[v] = bf2f(A[base + v]); sb_[v] = bf2f(B[base + v]);
      vv = bf2f(V2[base + v]);
    }
    __syncthreads();
    if (active) {
      float sa = 0.f;
#pragma unroll
      for (int k = 0; k < 64; ++k) sa += st[k] * sa_[k];
      float y = 0.f;
#pragma unroll
      for (int k = 0; k < 64; ++k) {
        st[k] = st[k] * sw[k] + sa * sb_[k] + vv * sk[k];
        y += st[k] * sr[k];
      }
      YS[base + v] = y;
    }
    __syncthreads();
  }
}

__device__ __forceinline__ void phase_attn_naive(const Params& p) {
  const bf16_t* __restrict__ Q = (const bf16_t*)(p.ws + OFF_Q); const bf16_t* __restrict__ K = (const bf16_t*)(p.ws + OFF_K);
  const bf16_t* __restrict__ V = (const bf16_t*)(p.ws + OFF_V); bf16_t* ATT = (bf16_t*)(p.ws + OFF_ATT);
  for (int item = blockIdx.x; item < T_TOK * 8 / NTHR; item += gridDim.x) {
    const int gid = item * NTHR + threadIdx.x;
    const int t = gid >> 3, h = gid & 7;
    const int s = t & (SEQ - 1), tb = t - s;
    float q[64], o[64];
    const bf16_t* qp = Q + (size_t)t * 512 + h * 64;
#pragma unroll
    for (int c = 0; c < 64; ++c) { q[c] = bf2f(qp[c]); o[c] = 0.f; }
    float m = -INFINITY, l = 0.f;
#pragma unroll 1
    for (int pp = 0; pp < 3; ++pp) {
      const int d = (pp == 0) ? 1 : ((pp == 1) ? 4 : 16);
#pragma unroll 1
      for (int j = 0; j <= 128; ++j) {
        int key = s - d * j;
        if (key < 0) break;
        const bf16_t* kp = K + (size_t)(tb + key) * 512 + h * 64;
        const bf16_t* vp = V + (size_t)(tb + key) * 512 + h * 64;
        float dot = 0.f;
#pragma unroll
        for (int c = 0; c < 64; ++c) dot += q[c] * bf2f(kp[c]);
        float mn = fmaxf(m, dot);
        float corr = __expf(m - mn);
        float pe = __expf(dot - mn);
        l = l * corr + pe;
#pragma unroll
        for (int c = 0; c < 64; ++c) o[c] = o[c] * corr + pe * bf2f(vp[c]);
        m = mn;
      }
    }
    float inv = 1.f / l;
    bf16_t* op = ATT + (size_t)t * 512 + h * 64;
#pragma unroll
    for (int c = 0; c < 64; ++c) op[c] = f2bf(o[c] * inv);
  }
}

__device__ __forceinline__ void phase_post(const Params& p) {
  const float* __restrict__ YS = (const float*)(p.ws + OFF_YS); const bf16_t* __restrict__ V2 = (const bf16_t*)(p.ws + OFF_V2);
  const bf16_t* __restrict__ G = (const bf16_t*)(p.ws + OFF_G); const float* __restrict__ SB = (const float*)(p.ws + OFF_SB);
  const bf16_t* __restrict__ ATT = (const bf16_t*)(p.ws + OFF_ATT);
  const float* __restrict__ lnx_g = p.in[11]; const float* __restrict__ lnx_b = p.in[12];
  bf16_t* MIXED = (bf16_t*)(p.ws + OFF_MIXED);
  const int tid = threadIdx.x;
  for (int t = blockIdx.x; t < T_TOK; t += gridDim.x) {
#pragma unroll
    for (int pass = 0; pass < 2; ++pass) {
      int c = tid + pass * 256;
      size_t o = (size_t)t * 512 + c;
      float y = YS[o];
      float mean = wave_sum(y) * (1.f / 64.f);
      float d = y - mean;
      float var = wave_sum(d * d) * (1.f / 64.f);
      float yn = d * rsqrtf(var + GN_EPS_F) * lnx_g[c] + lnx_b[c];
      float res = (yn + SB[(size_t)t * 8 + (c >> 6)] * bf2f(V2[o])) * bf2f(G[o]);
      MIXED[(size_t)t * 1024 + 512 + c] = f2bf(res);
      MIXED[(size_t)t * 1024 + c] = ATT[o];
    }
  }
}

__device__ __forceinline__ void phase_outproj(const Params& p, char* smem) {
  float* As = (float*)smem; float* Bs = As + 16 * 68; float* Cs = Bs + 16 * 68;
  const bf16_t* __restrict__ MIXED = (const bf16_t*)(p.ws + OFF_MIXED);
  const float* __restrict__ w_out = p.in[13]; const float* __restrict__ x = p.in[0];
  float* U = p.out;
  for (int item = blockIdx.x; item < (T_TOK / 64) * 16; item += gridDim.x) {
    const int row0 = (item >> 4) * 64, col0 = (item & 15) * 64;
    gemm64_naive(As, Bs, Cs, DM,
                 [&](int r, int k) { return bf2f(MIXED[(size_t)(row0 + r) * DM + k]); },
                 [&](int k, int c) { return w_out[(size_t)k * DM + col0 + c]; });
    for (int i = threadIdx.x; i < 4096; i += NTHR) {
      int r = i >> 6, c = i & 63;
      size_t o = (size_t)(row0 + r) * DM + col0 + c;
      U[o] = ALPHA_F * x[o] + Cs[r * 65 + c];
    }
    __syncthreads();
  }
}

__device__ __forceinline__ void phase_ln1_router(const Params& p, char* smem) {
  float (*xs)[DM] = (float (*)[DM])smem;
  float (*red)[8] = (float (*)[8])(smem + 4 * DM * 4);
  float (*aff)[NEXP] = (float (*)[NEXP])(smem + 4 * DM * 4 + 128);
  float (*sel)[NEXP] = (float (*)[NEXP])(smem + 4 * DM * 4 + 128 + 4 * NEXP * 4);
  float* X1 = p.out;
  const float* __restrict__ g1 = p.in[14]; const float* __restrict__ b1 = p.in[15];
  const float* __restrict__ router_w = p.in[16]; const float* __restrict__ router_bias = p.in[17];
  bf16_t* X1B = (bf16_t*)(p.ws + OFF_X1B); int* LIST = (int*)(p.ws + OFF_LIST); float* GATEW = (float*)(p.ws + OFF_GATEW);
  int* counts = (int*)(p.ws + OFF_CTL);
  const int tid = threadIdx.x, lane = tid & 63, wid = tid >> 6;
  for (int item = blockIdx.x; item < T_TOK / 4; item += gridDim.x) {
    const int t0 = item * 4;
    for (int tt = 0; tt < 4; ++tt) {
      size_t base = (size_t)(t0 + tt) * DM;
      float v[4];
      float s = 0.f;
#pragma unroll
      for (int u = 0; u < 4; ++u) { v[u] = X1[base + tid + u * 256]; s += v[u]; }
      s = wave_sum(s);
      if (lane == 0) red[tt][wid] = s;
      __syncthreads();
      float mean = (red[tt][0] + red[tt][1] + red[tt][2] + red[tt][3]) * (1.f / DM);
      float q = 0.f;
#pragma unroll
      for (int u = 0; u < 4; ++u) { float d = v[u] - mean; q += d * d; }
      q = wave_sum(q);
      if (lane == 0) red[tt][4 + wid] = q;
      __syncthreads();
      float var = (red[tt][4] + red[tt][5] + red[tt][6] + red[tt][7]) * (1.f / DM);
      float rs = rsqrtf(var + LN_EPS_F);
#pragma unroll
      for (int u = 0; u < 4; ++u) {
        int c = tid + u * 256;
        float y = (v[u] - mean) * rs * g1[c] + b1[c];
        xs[tt][c] = y;
        X1[base + c] = y;
        X1B[base + c] = f2bf(y);
      }
    }
    __syncthreads();
    {
      const int e = tid;
      float acc[4] = {0.f, 0.f, 0.f, 0.f};
      for (int k = 0; k < DM; ++k) {
        float w = router_w[(size_t)k * NEXP + e];
#pragma unroll
        for (int tt = 0; tt < 4; ++tt) acc[tt] += xs[tt][k] * w;
      }
      float bias = router_bias[e];
#pragma unroll
      for (int tt = 0; tt < 4; ++tt) { float a = sigmoidf_(acc[tt]); aff[tt][e] = a; sel[tt][e] = a + bias; }
    }
    __syncthreads();
    if (tid < 4) {
      const int tt = tid, t = t0 + tt;
      float gs[8];
#pragma unroll
      for (int g = 0; g < 8; ++g) {
        float m1 = -INFINITY, m2 = -INFINITY;
        for (int i = 0; i < 32; ++i) {
          float v = sel[tt][g * 32 + i];
          if (v > m1) { m2 = m1; m1 = v; } else if (v > m2) m2 = v;
        }
        gs[g] = m1 + m2;
      }
      unsigned mask = 0;
#pragma unroll
      for (int it = 0; it < 4; ++it) {
        int best = -1; float bv = -INFINITY;
#pragma unroll
        for (int g = 0; g < 8; ++g) {
          bool ok = !((mask >> g) & 1u);
          if (ok && (best < 0 || gs[g] > bv)) { best = g; bv = gs[g]; }
        }
        mask |= 1u << best;
      }
      int idx[8]; float av[8]; float asum = 0.f;
#pragma unroll
      for (int it = 0; it < 8; ++it) {
        int best = -1; float bv = -INFINITY;
        for (int e = 0; e < NEXP; ++e) {
          if (!((mask >> (e >> 5)) & 1u)) continue;
          float v = sel[tt][e];
          if (best < 0 || v > bv) { best = e; bv = v; }
        }
        idx[it] = best; av[it] = aff[tt][best]; asum += av[it];
        sel[tt][best] = -INFINITY;
      }
      float sc = 2.5f / asum;
#pragma unroll
      for (int it = 0; it < 8; ++it) {
        int e = idx[it];
        int pos = atomicAdd(&counts[e], 1);
        LIST[(size_t)e * T_TOK + pos] = it * T_TOK + t;
        GATEW[(size_t)it * T_TOK + t] = av[it] * sc;
      }
    }
    __syncthreads();
  }
}

__device__ __forceinline__ void moe_prefix(const int* counts, int* pre) {
  if (threadIdx.x == 0) {
    int acc = 0;
    for (int e = 0; e <= NEXP; ++e) { pre[e] = acc; int c = (e < NEXP) ? counts[e] : T_TOK; acc += (c + 63) >> 6; }
    pre[NEXP + 1] = acc;
  }
  __syncthreads();
}
__device__ __forceinline__ int moe_find(const int* pre, int ti) {
  int lo = 0, hi = NEXP;
  while (lo < hi) { int mid = (lo + hi + 1) >> 1; if (pre[mid] <= ti) lo = mid; else hi = mid - 1; }
  return lo;
}

__device__ __forceinline__ void phase_moe1(const Params& p, char* smem) {
  float* As = (float*)smem; float* Bs = As + 16 * 68; float* Cg = Bs + 16 * 68; float* Cu = Cg + 64 * 65;
  int* asg = (int*)(Cu + 64 * 65); int* pre = asg + 64;
  const bf16_t* __restrict__ X1B = (const bf16_t*)(p.ws + OFF_X1B);
  const int* __restrict__ LIST = (const int*)(p.ws + OFF_LIST);
  const int* counts = (const int*)(p.ws + OFF_CTL);
  bf16_t* H = (bf16_t*)(p.ws + OFF_H);
  moe_prefix(counts, pre);
  const int ntiles = pre[NEXP + 1];
  for (int item = blockIdx.x; item < ntiles * 4; item += gridDim.x) {
    const int ti = item >> 2, col0 = (item & 3) * 64;
    const int e = moe_find(pre, ti);
    const int r0 = (ti - pre[e]) * 64;
    const int cnt = (e < NEXP) ? counts[e] : T_TOK;
    if (threadIdx.x < 64) {
      int r = r0 + threadIdx.x;
      asg[threadIdx.x] = (r < cnt) ? ((e < NEXP) ? LIST[(size_t)e * T_TOK + r] : (8 * T_TOK + r)) : -1;
    }
    __syncthreads();
    const float* __restrict__ Wg = (e < NEXP) ? p.in[18] + (size_t)e * DM * 256 : p.in[21];
    const float* __restrict__ Wu = (e < NEXP) ? p.in[19] + (size_t)e * DM * 256 : p.in[22];
    auto af = [&](int r, int k) { int a = asg[r]; return a >= 0 ? bf2f(X1B[(size_t)(a & (T_TOK - 1)) * DM + k]) : 0.f; };
    gemm64_naive(As, Bs, Cg, DM, af, [&](int k, int c) { return Wg[(size_t)k * 256 + col0 + c]; });
    gemm64_naive(As, Bs, Cu, DM, af, [&](int k, int c) { return Wu[(size_t)k * 256 + col0 + c]; });
    for (int i = threadIdx.x; i < 4096; i += NTHR) {
      int r = i >> 6, c = i & 63;
      int a = asg[r];
      if (a < 0) continue;
      float g = Cg[r * 65 + c], u = Cu[r * 65 + c];
      H[(size_t)a * 256 + col0 + c] = f2bf(g * sigmoidf_(g) * u);
    }
    __syncthreads();
  }
}

__device__ __forceinline__ void phase_moe2(const Params& p, char* smem) {
  float* As = (float*)smem; float* Bs = As + 16 * 68; float* Cs = Bs + 16 * 68;
  int* asg = (int*)(Cs + 64 * 65); int* pre = asg + 64;
  const bf16_t* __restrict__ H = (const bf16_t*)(p.ws + OFF_H);
  const int* __restrict__ LIST = (const int*)(p.ws + OFF_LIST);
  const float* __restrict__ GATEW = (const float*)(p.ws + OFF_GATEW);
  const int* counts = (const int*)(p.ws + OFF_CTL);
  bf16_t* Y = (bf16_t*)(p.ws + OFF_Y);
  moe_prefix(counts, pre);
  const int ntiles = pre[NEXP + 1];
  for (int item = blockIdx.x; item < ntiles * 16; item += gridDim.x) {
    const int ti = item >> 4, col0 = (item & 15) * 64;
    const int e = moe_find(pre, ti);
    const int r0 = (ti - pre[e]) * 64;
    const int cnt = (e < NEXP) ? counts[e] : T_TOK;
    if (threadIdx.x < 64) {
      int r = r0 + threadIdx.x;
      asg[threadIdx.x] = (r < cnt) ? ((e < NEXP) ? LIST[(size_t)e * T_TOK + r] : (8 * T_TOK + r)) : -1;
    }
    __syncthreads();
    const float* __restrict__ Wd = (e < NEXP) ? p.in[20] + (size_t)e * 256 * DM : p.in[23];
    gemm64_naive(As, Bs, Cs, 256,
                 [&](int r, int k) { int a = asg[r]; return a >= 0 ? bf2f(H[(size_t)a * 256 + k]) : 0.f; },
                 [&](int k, int c) { return Wd[(size_t)k * DM + col0 + c]; });
    for (int i = threadIdx.x; i < 4096; i += NTHR) {
      int r = i >> 6, c = i & 63;
      int a = asg[r];
      if (a < 0) continue;
      float gw = (a < 8 * T_TOK) ? GATEW[a] : 1.f;
      Y[(size_t)a * DM + col0 + c] = f2bf(Cs[r * 65 + c] * gw);
    }
    __syncthreads();
  }
}

__device__ __forceinline__ void phase_final(const Params& p, char* smem) {
  float* red = (float*)smem;
  float* OUT = p.out;
  const bf16_t* __restrict__ Y = (const bf16_t*)(p.ws + OFF_Y);
  const float* __restrict__ g2 = p.in[24]; const float* __restrict__ b2 = p.in[25];
  const int tid = threadIdx.x, lane = tid & 63, wid = tid >> 6;
  for (int t = blockIdx.x; t < T_TOK; t += gridDim.x) {
    size_t base = (size_t)t * DM;
    float v[4];
    float s = 0.f;
#pragma unroll
    for (int u = 0; u < 4; ++u) {
      int c = tid + u * 256;
      float acc = 0.f;
#pragma unroll
      for (int sl = 0; sl < 9; ++sl) acc += bf2f(Y[((size_t)sl * T_TOK + t) * DM + c]);
      v[u] = ALPHA_F * OUT[base + c] + acc;
      s += v[u];
    }
    s = wave_sum(s);
    if (lane == 0) red[wid] = s;
    __syncthreads();
    float mean = (red[0] + red[1] + red[2] + red[3]) * (1.f / DM);
    float q = 0.f;
#pragma unroll
    for (int u = 0; u < 4; ++u) { float d = v[u] - mean; q += d * d; }
    q = wave_sum(q);
    if (lane == 0) red[4 + wid] = q;
    __syncthreads();
    float var = (red[4] + red[5] + red[6] + red[7]) * (1.f / DM);
    float rs = rsqrtf(var + LN_EPS_F);
#pragma unroll
    for (int u = 0; u < 4; ++u) {
      int c = tid + u * 256;
      OUT[base + c] = (v[u] - mean) * rs * g2[c] + b2[c];
    }
    __syncthreads();
  }
}

__global__ void __launch_bounds__(NTHR, 2) mega(Params p) {
  extern __shared__ __attribute__((aligned(16))) char smem[];
  cg::grid_group grid = cg::this_grid();
  phase_rope(p);
  grid.sync();
  phase_inproj(p, smem);
  grid.sync();
  phase_prep(p, smem);
  grid.sync();
  phase_scan_naive(p, smem);
  phase_attn_naive(p);
  grid.sync();
  phase_post(p);
  grid.sync();
  phase_outproj(p, smem);
  grid.sync();
  phase_ln1_router(p, smem);
  grid.sync();
  phase_moe1(p, smem);
  grid.sync();
  phase_moe2(p, smem);
  grid.sync();
  phase_final(p, smem);
}

extern "C" void kernel_launch(void* const* d_in, const int* in_sizes, int n_in, void* d_out, int out_size, void* d_ws, size_t ws_size,
                              hipStream_t stream) {
  static int grid_blocks = 0;
  if (grid_blocks == 0) {
    if (ws_size < WS_NEED || n_in != 26) { fprintf(stderr, "kernel_launch: bad ws/n_in: %zu < %zu, n_in %d\n", ws_size, (size_t)WS_NEED, n_in); grid_blocks = -1; return; }
    int dev = 0, cus = 0, per_cu = 0;
    (void)hipGetDevice(&dev);
    (void)hipDeviceGetAttribute(&cus, hipDeviceAttributeMultiprocessorCount, dev);
    (void)hipFuncSetAttribute((const void*)mega, hipFuncAttributeMaxDynamicSharedMemorySize, LDS_BYTES);
    (void)hipOccupancyMaxActiveBlocksPerMultiprocessor(&per_cu, (const void*)mega, NTHR, LDS_BYTES);
    if (per_cu < 1) { fprintf(stderr, "kernel_launch: occupancy query returned %d\n", per_cu); grid_blocks = -1; return; }
    if (per_cu > 2) per_cu = 2;
    grid_blocks = cus * per_cu;
    fprintf(stderr, "kernel_launch: cus %d per_cu %d grid %d\n", cus, per_cu, grid_blocks);
  }
  if (grid_blocks < 0) return;
  Params p{};
  for (int i = 0; i < 26; ++i) p.in[i] = (const float*)d_in[i];
  p.out = (float*)d_out;
  p.ws = (char*)d_ws;
  void* args[] = {&p};
  hipError_t e = hipLaunchCooperativeKernel((const void*)mega, dim3(grid_blocks), dim3(NTHR), args, LDS_BYTES, stream);
  if (e != hipSuccess) fprintf(stderr, "cooperative launch failed: %s (grid %d)\n", hipGetErrorString(e), grid_blocks);
}
```

```cpp
#include <hip/hip_runtime.h>
#include <hip/hip_bf16.h>
#include <hip/hip_cooperative_groups.h>
#include <stdint.h>
#include <stdio.h>

typedef unsigned short bf16_t;

#define T_TOK 32768
#define SEQ 4096
#define DM 1024
#define INW 3360
#define FEW 1824
#define NEXP 256
#define ALPHA_F 1.189207115002721f
#define LN_EPS_F 1e-5f
#define GN_EPS_F 64e-5f

__device__ __forceinline__ float bf2f(bf16_t v) { return __uint_as_float(((unsigned)v) << 16); }
__device__ __forceinline__ bf16_t f2bf(float f) { unsigned u = __float_as_uint(f); return (bf16_t)((u + 0x7fffu + ((u >> 16) & 1u)) >> 16); }
__device__ __forceinline__ float sigmoidf_(float x) { return 1.f / (1.f + __expf(-x)); }
__device__ __forceinline__ float wave_sum(float v) {
#pragma unroll
  for (int o = 32; o >= 1; o >>= 1) v += __shfl_xor(v, o, 64);
  return v;
}

constexpr size_t SZ_T512_BF = (size_t)T_TOK * 512 * 2;
constexpr size_t OFF_Q = 0;
constexpr size_t OFF_K = OFF_Q + SZ_T512_BF;
constexpr size_t OFF_V = OFF_K + SZ_T512_BF;
constexpr size_t OFF_FEATS = OFF_V + SZ_T512_BF;
constexpr size_t OFF_R = OFF_FEATS + (size_t)T_TOK * FEW * 2;
constexpr size_t OFF_K2 = OFF_R + SZ_T512_BF;
constexpr size_t OFF_V2 = OFF_K2 + SZ_T512_BF;
constexpr size_t OFF_A = OFF_V2 + SZ_T512_BF;
constexpr size_t OFF_B = OFF_A + SZ_T512_BF;
constexpr size_t OFF_W = OFF_B + SZ_T512_BF;
constexpr size_t OFF_G = OFF_W + (size_t)T_TOK * 512 * 4;
constexpr size_t OFF_SB = OFF_G + SZ_T512_BF;
constexpr size_t OFF_YS = OFF_SB + (size_t)T_TOK * 8 * 4;
constexpr size_t OFF_ATT = OFF_YS + (size_t)T_TOK * 512 * 4;
constexpr size_t OFF_MIXED = OFF_ATT + SZ_T512_BF;
constexpr size_t OFF_ROPE = OFF_MIXED + (size_t)T_TOK * 1024 * 2;
constexpr size_t EARLY_END = OFF_ROPE + (size_t)4096 * 32 * 2 * 4;
constexpr size_t OFF_Y = 0;
constexpr size_t OFF_H = OFF_Y + (size_t)9 * T_TOK * 1024 * 2;
constexpr size_t OFF_X1B = OFF_H + (size_t)9 * T_TOK * 256 * 2;
constexpr size_t OFF_LIST = OFF_X1B + (size_t)T_TOK * 1024 * 2;
constexpr size_t OFF_GATEW = OFF_LIST + (size_t)NEXP * T_TOK * 4;
constexpr size_t OFF_CTL = OFF_GATEW + (size_t)8 * T_TOK * 4;
constexpr size_t CTL_BYTES = 1u << 20;
constexpr size_t WS_NEED = OFF_CTL + CTL_BYTES;
static_assert(EARLY_END <= OFF_X1B, "early buffers must not overlap X1B");
#define MAXTILES 4864
constexpr size_t OFF_XB = OFF_X1B;

typedef short bf16x8 __attribute__((ext_vector_type(8)));
typedef float f32x4 __attribute__((ext_vector_type(4)));
typedef float f32x2_t __attribute__((ext_vector_type(2)));
typedef __bf16 bf16x2_t __attribute__((ext_vector_type(2)));
__device__ __forceinline__ unsigned cvtpk(float lo, float hi) { f32x2_t v = {lo, hi}; bf16x2_t b = __builtin_convertvector(v, bf16x2_t); return __builtin_bit_cast(unsigned, b); }

__device__ const double INVF[32] = {
1, 0.74989420933245587, 0.56234132519034907, 0.42169650342858223, 0.31622776601683794, 0.23713737056616552,
0.17782794100389229, 0.1333521432163324, 0.10000000000000001, 0.074989420933245579, 0.056234132519034911,
0.042169650342858224, 0.031622776601683791, 0.023713737056616554, 0.017782794100389229, 0.013335214321633241,
0.01, 0.0074989420933245579, 0.005623413251903491, 0.0042169650342858229, 0.0031622776601683794,
0.0023713737056616554, 0.0017782794100389228, 0.0013335214321633241, 0.001, 0.00074989420933245586,
0.0005623413251903491, 0.00042169650342858224, 0.00031622776601683794, 0.00023713737056616554,
0.00017782794100389227, 0.0001333521432163324};

namespace cg = cooperative_groups;

struct Params {
  const float* in[26];
  float* out;
  char* ws;
};

#define NTHR 256
#define LDS_BYTES 65536

__device__ __forceinline__ void phase_rope(const Params& p) {
  float* tab = (float*)(p.ws + OFF_ROPE);
  for (int i = blockIdx.x * NTHR + threadIdx.x; i < 4096 * 32; i += gridDim.x * NTHR) {
    int pos = i >> 5, f = i & 31;
    double ang = (double)pos * INVF[f];
    const double TWO_PI = 6.283185307179586476925286766559;
    double n = rint(ang / TWO_PI);
    double r = ang - n * TWO_PI;
    double r2 = r * r;
    double sn = r, cs = 1.0, ts = r, tc = 1.0;
#pragma unroll 1
    for (int k = 1; k <= 16; ++k) {
      tc = -tc * r2 / (double)((2 * k - 1) * (2 * k));
      ts = -ts * r2 / (double)((2 * k) * (2 * k + 1));
      cs += tc; sn += ts;
    }
    tab[i * 2] = (float)cs; tab[i * 2 + 1] = (float)sn;
  }
  int* ctl = (int*)(p.ws + OFF_CTL);
  if (blockIdx.x == 0) for (int i = threadIdx.x; i < 1024; i += NTHR) ctl[i] = 0;
  {
    const float4* __restrict__ x4 = (const float4*)p.in[0];
    uint4* xb = (uint4*)(p.ws + OFF_XB);
    for (size_t i = (size_t)blockIdx.x * NTHR + threadIdx.x; i < (size_t)T_TOK * DM / 8; i += (size_t)gridDim.x * NTHR) {
      float4 a = x4[2 * i], b = x4[2 * i + 1];
      uint4 w; w.x = cvtpk(a.x, a.y); w.y = cvtpk(a.z, a.w); w.z = cvtpk(b.x, b.y); w.w = cvtpk(b.z, b.w);
      xb[i] = w;
    }
  }
}

template <class AF, class BF>
__device__ __forceinline__ void gemm64_naive(float* As, float* Bs, float* Cs, int K, AF af, BF bf) {
  const int tid = threadIdx.x, tx = tid & 15, ty = tid >> 4;
  float acc[4][4];
#pragma unroll
  for (int i = 0; i < 4; ++i)
#pragma unroll
    for (int j = 0; j < 4; ++j) acc[i][j] = 0.f;
  for (int k0 = 0; k0 < K; k0 += 16) {
#pragma unroll
    for (int u = 0; u < 4; ++u) { int i = tid + u * 256; int r = i >> 4, kk = i & 15; As[kk * 68 + r] = af(r, k0 + kk); }
#pragma unroll
    for (int u = 0; u < 4; ++u) { int i = tid + u * 256; int kk = i >> 6, c = i & 63; Bs[kk * 68 + c] = bf(k0 + kk, c); }
    __syncthreads();
#pragma unroll
    for (int kk = 0; kk < 16; ++kk) {
      float a[4], b[4];
#pragma unroll
      for (int i = 0; i < 4; ++i) { a[i] = As[kk * 68 + ty * 4 + i]; b[i] = Bs[kk * 68 + tx * 4 + i]; }
#pragma unroll
      for (int i = 0; i < 4; ++i)
#pragma unroll
        for (int j = 0; j < 4; ++j) acc[i][j] += a[i] * b[j];
    }
    __syncthreads();
  }
#pragma unroll
  for (int i = 0; i < 4; ++i)
#pragma unroll
    for (int j = 0; j < 4; ++j) Cs[(ty * 4 + i) * 65 + tx * 4 + j] = acc[i][j];
  __syncthreads();
}


__device__ __forceinline__ int lds_off(int row, int chunk) { return row * 128 + ((chunk ^ ((row >> 1) & 7)) << 4); }

template <class ARow, class BPtr, class Epi>
__device__ __forceinline__ void gemm128(char* smem, const int K, ARow arow, BPtr bptr, const int ldb, Epi epi) {
  const int tid = threadIdx.x, lane = tid & 63, wid = tid >> 6;
  const int wr = wid >> 1, wc = wid & 1, fr = lane & 15, fq = lane >> 4;
  const int achunk = tid & 7, arow0 = tid >> 3;
  const int nq = tid & 31, ko = tid >> 5;
  const bf16_t* ap0 = arow(arow0) + achunk * 8;
  const bf16_t* ap1 = arow(arow0 + 32) + achunk * 8;
  const bf16_t* ap2 = arow(arow0 + 64) + achunk * 8;
  const bf16_t* ap3 = arow(arow0 + 96) + achunk * 8;
  const float* bp = bptr(nq) + (size_t)(ko * 8) * ldb;
  char* const la0 = smem + lds_off(arow0, achunk);
  char* const la1 = smem + lds_off(arow0 + 32, achunk);
  char* const la2 = smem + lds_off(arow0 + 64, achunk);
  char* const la3 = smem + lds_off(arow0 + 96, achunk);
  char* const lb0 = smem + 16384 + lds_off(nq * 4 + 0, ko);
  char* const lb1 = smem + 16384 + lds_off(nq * 4 + 1, ko);
  char* const lb2 = smem + 16384 + lds_off(nq * 4 + 2, ko);
  char* const lb3 = smem + 16384 + lds_off(nq * 4 + 3, ko);
  f32x4 acc[4][4];
#pragma unroll
  for (int m = 0; m < 4; ++m)
#pragma unroll
    for (int n = 0; n < 4; ++n) acc[m][n] = (f32x4){0.f, 0.f, 0.f, 0.f};
  const int nk = K >> 6;
  uint4 ra0 = *(const uint4*)(ap0), ra1 = *(const uint4*)(ap1), ra2 = *(const uint4*)(ap2), ra3 = *(const uint4*)(ap3);
  float4 rb0 = *(const float4*)(bp), rb1 = *(const float4*)(bp + (size_t)1 * ldb), rb2 = *(const float4*)(bp + (size_t)2 * ldb),
         rb3 = *(const float4*)(bp + (size_t)3 * ldb), rb4 = *(const float4*)(bp + (size_t)4 * ldb), rb5 = *(const float4*)(bp + (size_t)5 * ldb),
         rb6 = *(const float4*)(bp + (size_t)6 * ldb), rb7 = *(const float4*)(bp + (size_t)7 * ldb);
  for (int kt = 0; kt < nk; ++kt) {
    __syncthreads();
    *(uint4*)la0 = ra0; *(uint4*)la1 = ra1; *(uint4*)la2 = ra2; *(uint4*)la3 = ra3;
    {
      uint4 w;
      w.x = cvtpk(rb0.x, rb1.x); w.y = cvtpk(rb2.x, rb3.x); w.z = cvtpk(rb4.x, rb5.x); w.w = cvtpk(rb6.x, rb7.x);
      *(uint4*)lb0 = w;
      w.x = cvtpk(rb0.y, rb1.y); w.y = cvtpk(rb2.y, rb3.y); w.z = cvtpk(rb4.y, rb5.y); w.w = cvtpk(rb6.y, rb7.y);
      *(uint4*)lb1 = w;
      w.x = cvtpk(rb0.z, rb1.z); w.y = cvtpk(rb2.z, rb3.z); w.z = cvtpk(rb4.z, rb5.z); w.w = cvtpk(rb6.z, rb7.z);
      *(uint4*)lb2 = w;
      w.x = cvtpk(rb0.w, rb1.w); w.y = cvtpk(rb2.w, rb3.w); w.z = cvtpk(rb4.w, rb5.w); w.w = cvtpk(rb6.w, rb7.w);
      *(uint4*)lb3 = w;
    }
    __syncthreads();
    if (kt + 1 < nk) {
      const int ko2 = (kt + 1) * 64;
      ra0 = *(const uint4*)(ap0 + ko2); ra1 = *(const uint4*)(ap1 + ko2); ra2 = *(const uint4*)(ap2 + ko2); ra3 = *(const uint4*)(ap3 + ko2);
      const float* b2 = bp + (size_t)ko2 * ldb;
      rb0 = *(const float4*)(b2); rb1 = *(const float4*)(b2 + (size_t)1 * ldb); rb2 = *(const float4*)(b2 + (size_t)2 * ldb);
      rb3 = *(const float4*)(b2 + (size_t)3 * ldb); rb4 = *(const float4*)(b2 + (size_t)4 * ldb); rb5 = *(const float4*)(b2 + (size_t)5 * ldb);
      rb6 = *(const float4*)(b2 + (size_t)6 * ldb); rb7 = *(const float4*)(b2 + (size_t)7 * ldb);
    }
#pragma unroll
    for (int kk = 0; kk < 2; ++kk) {
      bf16x8 af[4], bfr[4];
#pragma unroll
      for (int m = 0; m < 4; ++m) af[m] = *(const bf16x8*)(smem + lds_off(wr * 64 + m * 16 + fr, kk * 4 + fq));
#pragma unroll
      for (int n = 0; n < 4; ++n) bfr[n] = *(const bf16x8*)(smem + 16384 + lds_off(wc * 64 + n * 16 + fr, kk * 4 + fq));
#pragma unroll
      for (int m = 0; m < 4; ++m)
#pragma unroll
        for (int n = 0; n < 4; ++n) acc[m][n] = __builtin_amdgcn_mfma_f32_16x16x32_bf16(af[m], bfr[n], acc[m][n], 0, 0, 0);
    }
  }
  epi(acc, wr, wc, fr, fq);
}

__device__ __forceinline__ void phase_inproj(const Params& p, char* smem) {
  const bf16_t* __restrict__ XB = (const bf16_t*)(p.ws + OFF_XB);
  const float* __restrict__ w_in = p.in[1];
  const float* __restrict__ rope = (const float*)(p.ws + OFF_ROPE);
  bf16_t* Q = (bf16_t*)(p.ws + OFF_Q); bf16_t* K = (bf16_t*)(p.ws + OFF_K); bf16_t* V = (bf16_t*)(p.ws + OFF_V);
  bf16_t* FE = (bf16_t*)(p.ws + OFF_FEATS);
  const int NT = 27, NITEM = (T_TOK / 128) * NT;
  for (int item = blockIdx.x; item < NITEM; item += gridDim.x) {
    const int row0 = (item / NT) * 128, col0 = (item % NT) * 128;
    gemm128(smem, DM,
            [=](int r) { return XB + (size_t)(row0 + r) * DM; },
            [=](int nq) { int c = col0 + nq * 4; if (c >= INW) c = 0; return w_in + c; },
            INW,
            [=](f32x4 (&acc)[4][4], int wr, int wc, int fr, int fq) {
              const int cb = col0 + wc * 64;
              if (cb >= INW) return;
#pragma unroll
              for (int m = 0; m < 4; ++m)
#pragma unroll
                for (int j = 0; j < 4; ++j) {
                  const int t = row0 + wr * 64 + m * 16 + fq * 4 + j;
                  if (cb < 1024) {
                    const int pos = t & (SEQ - 1);
#pragma unroll
                    for (int n = 0; n < 2; ++n) {
                      const int f = n * 16 + fr;
                      const float2 cs = *(const float2*)(rope + (size_t)(pos * 32 + f) * 2);
                      const float z1 = acc[m][n][j], z2 = acc[m][n + 2][j];
                      const float o1 = z1 * cs.x - z2 * cs.y, o2 = z2 * cs.x + z1 * cs.y;
                      if (cb < 512) {
                        Q[(size_t)t * 512 + cb + f] = f2bf(o1 * 0.125f); Q[(size_t)t * 512 + cb + f + 32] = f2bf(o2 * 0.125f);
                      } else {
                        K[(size_t)t * 512 + (cb - 512) + f] = f2bf(o1); K[(size_t)t * 512 + (cb - 512) + f + 32] = f2bf(o2);
                      }
                    }
                  } else if (cb < 1536) {
#pragma unroll
                    for (int n = 0; n < 4; ++n) V[(size_t)t * 512 + (cb - 1024) + n * 16 + fr] = f2bf(acc[m][n][j]);
                  } else {
#pragma unroll
                    for (int n = 0; n < 4; ++n) { int c = cb + n * 16 + fr; if (c < INW) FE[(size_t)t * FEW + (c - 1536)] = f2bf(acc[m][n][j]); }
                  }
                }
            });
  }
}

__device__ __forceinline__ void phase_prep(const Params& p, char* smem) {
  float (*f)[FEW] = (float (*)[FEW])smem;
  float (*act)[288] = (float (*)[288])(smem + 4 * FEW * 4);
  const bf16_t* __restrict__ FE = (const bf16_t*)(p.ws + OFF_FEATS);
  const float* __restrict__ mu = p.in[2]; const float* __restrict__ w0 = p.in[3]; const float* __restrict__ Wd = p.in[4];
  const float* __restrict__ a0 = p.in[5]; const float* __restrict__ Wa = p.in[6]; const float* __restrict__ Wg = p.in[7];
  const float* __restrict__ k_k = p.in[8]; const float* __restrict__ k_a = p.in[9]; const float* __restrict__ r_k = p.in[10];
  bf16_t* R = (bf16_t*)(p.ws + OFF_R); bf16_t* K2 = (bf16_t*)(p.ws + OFF_K2); bf16_t* V2 = (bf16_t*)(p.ws + OFF_V2);
  bf16_t* A = (bf16_t*)(p.ws + OFF_A); bf16_t* B = (bf16_t*)(p.ws + OFF_B);
  float* W = (float*)(p.ws + OFF_W); bf16_t* G = (bf16_t*)(p.ws + OFF_G); float* SB = (float*)(p.ws + OFF_SB);
  const int tid = threadIdx.x;
  for (int item = blockIdx.x; item < T_TOK / 4; item += gridDim.x) {
    const int t0 = item * 4;
    for (int i = tid; i < 4 * FEW; i += NTHR) {
      int tt = i / FEW, c = i - tt * FEW;
      int t = t0 + tt;
      float cur = bf2f(FE[(size_t)t * FEW + c]);
      float prev = ((t & (SEQ - 1)) == 0) ? 0.f : bf2f(FE[(size_t)(t - 1) * FEW + c]);
      f[tt][c] = cur + (prev - cur) * mu[c];
    }
    __syncthreads();
    for (int i = tid; i < 4 * 288; i += NTHR) {
      int tt = i / 288, j = i - tt * 288;
      float v = f[tt][1536 + j];
      act[tt][j] = (j < 64) ? tanhf(v) : ((j < 128) ? v : sigmoidf_(v));
    }
    __syncthreads();
#pragma unroll 1
    for (int pass = 0; pass < 2; ++pass) {
      const int c = tid + pass * 256;
      float wacc[4] = {0.f, 0.f, 0.f, 0.f}, aacc[4] = {0.f, 0.f, 0.f, 0.f}, gacc[4] = {0.f, 0.f, 0.f, 0.f};
      for (int j = 0; j < 64; ++j) {
        float wd = Wd[j * 512 + c], wa = Wa[j * 512 + c];
#pragma unroll
        for (int tt = 0; tt < 4; ++tt) { wacc[tt] += act[tt][j] * wd; aacc[tt] += act[tt][64 + j] * wa; }
      }
      for (int j = 0; j < 160; ++j) {
        float wg = Wg[j * 512 + c];
#pragma unroll
        for (int tt = 0; tt < 4; ++tt) gacc[tt] += act[tt][128 + j] * wg;
      }
      const float w0c = w0[c], a0c = a0[c], kkc = k_k[c], kac = k_a[c], rkc = r_k[c];
#pragma unroll
      for (int tt = 0; tt < 4; ++tt) {
        const int t = t0 + tt;
        float z = w0c + wacc[tt];
        float nz = -z;
        float sp = fmaxf(nz, 0.f) + log1pf(__expf(-fabsf(nz)));
        float w = -sp - 0.5f;
        float decay = __expf(-__expf(w));
        float a = sigmoidf_(a0c + aacc[tt]);
        float r = f[tt][c], k = f[tt][512 + c], v = f[tt][1024 + c];
        float kk = k * kkc;
        float ss = wave_sum(kk * kk);
        float kkn = kk / fmaxf(sqrtf(ss), 1e-12f);
        float k2 = k * (1.f + (a - 1.f) * kac);
        float sb = wave_sum(r * k2 * rkc);
        size_t o = (size_t)t * 512 + c;
        R[o] = f2bf(r); K2[o] = f2bf(k2); V2[o] = f2bf(v); A[o] = f2bf(-kkn); B[o] = f2bf(kkn * a);
        W[o] = decay; G[o] = f2bf(gacc[tt]);
        if ((tid & 63) == 0) SB[(size_t)t * 8 + (c >> 6)] = sb;
      }
    }
    __syncthreads();
  }
}

__device__ __forceinline__ void phase_scan_naive(const Params& p, char* smem) {
  if (blockIdx.x >= 64) return;
  float* sr = (float*)smem; float* sw = sr + 64; float* sk = sw + 64; float* sa_ = sk + 64; float* sb_ = sa_ + 64;
  const bf16_t* __restrict__ R = (const bf16_t*)(p.ws + OFF_R); const bf16_t* __restrict__ K2 = (const bf16_t*)(p.ws + OFF_K2);
  const bf16_t* __restrict__ V2 = (const bf16_t*)(p.ws + OFF_V2); const bf16_t* __restrict__ A = (const bf16_t*)(p.ws + OFF_A);
  const bf16_t* __restrict__ B = (const bf16_t*)(p.ws + OFF_B); const float* __restrict__ W = (const float*)(p.ws + OFF_W);
  float* YS = (float*)(p.ws + OFF_YS);
  const int bh = blockIdx.x, b = bh >> 3, h = bh & 7, v = threadIdx.x & 63;
  const bool active = threadIdx.x < 64;
  float st[64];
#pragma unroll
  for (int k = 0; k < 64; ++k) st[k] = 0.f;
  for (int s = 0; s < SEQ; ++s) {
    size_t base = ((size_t)(b * SEQ + s)) * 512 + h * 64;
    float vv = 0.f;
    if (active) {
      sr[v] = bf2f(R[base + v]); sw[v] = W[base + v]; sk[v] = bf2f(K2[base + v]);
      sa_[v] = bf2f(A[base + v]); sb_[v] = bf2f(B[base + v]);
      vv = bf2f(V2[base + v]);
    }
    __syncthreads();
    if (active) {
      float sa = 0.f;
#pragma unroll
      for (int k = 0; k < 64; ++k) sa += st[k] * sa_[k];
      float y = 0.f;
#pragma unroll
      for (int k = 0; k < 64; ++k) {
        st[k] = st[k] * sw[k] + sa * sb_[k] + vv * sk[k];
        y += st[k] * sr[k];
      }
      YS[base + v] = y;
    }
    __syncthreads();
  }
}

__device__ __forceinline__ void phase_attn_naive(const Params& p) {
  const bf16_t* __restrict__ Q = (const bf16_t*)(p.ws + OFF_Q); const bf16_t* __restrict__ K = (const bf16_t*)(p.ws + OFF_K);
  const bf16_t* __restrict__ V = (const bf16_t*)(p.ws + OFF_V); bf16_t* ATT = (bf16_t*)(p.ws + OFF_ATT);
  for (int item = blockIdx.x; item < T_TOK * 8 / NTHR; item += gridDim.x) {
    const int gid = item * NTHR + threadIdx.x;
    const int t = gid >> 3, h = gid & 7;
    const int s = t & (SEQ - 1), tb = t - s;
    float q[64], o[64];
    const bf16_t* qp = Q + (size_t)t * 512 + h * 64;
#pragma unroll
    for (int c = 0; c < 64; ++c) { q[c] = bf2f(qp[c]); o[c] = 0.f; }
    float m = -INFINITY, l = 0.f;
#pragma unroll 1
    for (int pp = 0; pp < 3; ++pp) {
      const int d = (pp == 0) ? 1 : ((pp == 1) ? 4 : 16);
#pragma unroll 1
      for (int j = 0; j <= 128; ++j) {
        int key = s - d * j;
        if (key < 0) break;
        const bf16_t* kp = K + (size_t)(tb + key) * 512 + h * 64;
        const bf16_t* vp = V + (size_t)(tb + key) * 512 + h * 64;
        float dot = 0.f;
#pragma unroll
        for (int c = 0; c < 64; ++c) dot += q[c] * bf2f(kp[c]);
        float mn = fmaxf(m, dot);
        float corr = __expf(m - mn);
        float pe = __expf(dot - mn);
        l = l * corr + pe;
#pragma unroll
        for (int c = 0; c < 64; ++c) o[c] = o[c] * corr + pe * bf2f(vp[c]);
        m = mn;
      }
    }
    float inv = 1.f / l;
    bf16_t* op = ATT + (size_t)t * 512 + h * 64;
#pragma unroll
    for (int c = 0; c < 64; ++c) op[c] = f2bf(o[c] * inv);
  }
}

__device__ __forceinline__ void phase_post(const Params& p) {
  const float* __restrict__ YS = (const float*)(p.ws + OFF_YS); const bf16_t* __restrict__ V2 = (const bf16_t*)(p.ws + OFF_V2);
  const bf16_t* __restrict__ G = (const bf16_t*)(p.ws + OFF_G); const float* __restrict__ SB = (const float*)(p.ws + OFF_SB);
  const bf16_t* __restrict__ ATT = (const bf16_t*)(p.ws + OFF_ATT);
  const float* __restrict__ lnx_g = p.in[11]; const float* __restrict__ lnx_b = p.in[12];
  bf16_t* MIXED = (bf16_t*)(p.ws + OFF_MIXED);
  const int tid = threadIdx.x;
  for (int t = blockIdx.x; t < T_TOK; t += gridDim.x) {
#pragma unroll
    for (int pass = 0; pass < 2; ++pass) {
      int c = tid + pass * 256;
      size_t o = (size_t)t * 512 + c;
      float y = YS[o];
      float mean = wave_sum(y) * (1.f / 64.f);
      float d = y - mean;
      float var = wave_sum(d * d) * (1.f / 64.f);
      float yn = d * rsqrtf(var + GN_EPS_F) * lnx_g[c] + lnx_b[c];
      float res = (yn + SB[(size_t)t * 8 + (c >> 6)] * bf2f(V2[o])) * bf2f(G[o]);
      MIXED[(size_t)t * 1024 + 512 + c] = f2bf(res);
      MIXED[(size_t)t * 1024 + c] = ATT[o];
    }
  }
}

__device__ __forceinline__ void phase_outproj(const Params& p, char* smem) {
  const bf16_t* __restrict__ MIXED = (const bf16_t*)(p.ws + OFF_MIXED);
  const float* __restrict__ w_out = p.in[13]; const float* __restrict__ x = p.in[0];
  float* U = p.out;
  for (int item = blockIdx.x; item < (T_TOK / 128) * 8; item += gridDim.x) {
    const int row0 = (item >> 3) * 128, col0 = (item & 7) * 128;
    gemm128(smem, DM,
            [=](int r) { return MIXED + (size_t)(row0 + r) * DM; },
            [=](int nq) { return w_out + col0 + nq * 4; },
            DM,
            [=](f32x4 (&acc)[4][4], int wr, int wc, int fr, int fq) {
#pragma unroll
              for (int m = 0; m < 4; ++m)
#pragma unroll
                for (int j = 0; j < 4; ++j) {
                  const int t = row0 + wr * 64 + m * 16 + fq * 4 + j;
#pragma unroll
                  for (int n = 0; n < 4; ++n) {
                    size_t o = (size_t)t * DM + col0 + wc * 64 + n * 16 + fr;
                    U[o] = ALPHA_F * x[o] + acc[m][n][j];
                  }
                }
            });
  }
}

__device__ __forceinline__ void phase_ln1_router(const Params& p, char* smem) {
  float (*xs)[DM] = (float (*)[DM])smem;
  float (*red)[8] = (float (*)[8])(smem + 4 * DM * 4);
  float (*aff)[NEXP] = (float (*)[NEXP])(smem + 4 * DM * 4 + 128);
  float (*sel)[NEXP] = (float (*)[NEXP])(smem + 4 * DM * 4 + 128 + 4 * NEXP * 4);
  float* X1 = p.out;
  const float* __restrict__ g1 = p.in[14]; const float* __restrict__ b1 = p.in[15];
  const float* __restrict__ router_w = p.in[16]; const float* __restrict__ router_bias = p.in[17];
  bf16_t* X1B = (bf16_t*)(p.ws + OFF_X1B); int* LIST = (int*)(p.ws + OFF_LIST); float* GATEW = (float*)(p.ws + OFF_GATEW);
  int* counts = (int*)(p.ws + OFF_CTL);
  const int tid = threadIdx.x, lane = tid & 63, wid = tid >> 6;
  for (int item = blockIdx.x; item < T_TOK / 4; item += gridDim.x) {
    const int t0 = item * 4;
    for (int tt = 0; tt < 4; ++tt) {
      size_t base = (size_t)(t0 + tt) * DM;
      float v[4];
      float s = 0.f;
#pragma unroll
      for (int u = 0; u < 4; ++u) { v[u] = X1[base + tid + u * 256]; s += v[u]; }
      s = wave_sum(s);
      if (lane == 0) red[tt][wid] = s;
      __syncthreads();
      float mean = (red[tt][0] + red[tt][1] + red[tt][2] + red[tt][3]) * (1.f / DM);
      float q = 0.f;
#pragma unroll
      for (int u = 0; u < 4; ++u) { float d = v[u] - mean; q += d * d; }
      q = wave_sum(q);
      if (lane == 0) red[tt][4 + wid] = q;
      __syncthreads();
      float var = (red[tt][4] + red[tt][5] + red[tt][6] + red[tt][7]) * (1.f / DM);
      float rs = rsqrtf(var + LN_EPS_F);
#pragma unroll
      for (int u = 0; u < 4; ++u) {
        int c = tid + u * 256;
        float y = (v[u] - mean) * rs * g1[c] + b1[c];
        xs[tt][c] = y;
        X1[base + c] = y;
        X1B[base + c] = f2bf(y);
      }
    }
    __syncthreads();
    {
      const int e = tid;
      float acc[4] = {0.f, 0.f, 0.f, 0.f};
      for (int k = 0; k < DM; ++k) {
        float w = router_w[(size_t)k * NEXP + e];
#pragma unroll
        for (int tt = 0; tt < 4; ++tt) acc[tt] += xs[tt][k] * w;
      }
      float bias = router_bias[e];
#pragma unroll
      for (int tt = 0; tt < 4; ++tt) { float a = sigmoidf_(acc[tt]); aff[tt][e] = a; sel[tt][e] = a + bias; }
    }
    __syncthreads();
    if (tid < 4) {
      const int tt = tid, t = t0 + tt;
      float gs[8];
#pragma unroll
      for (int g = 0; g < 8; ++g) {
        float m1 = -INFINITY, m2 = -INFINITY;
        for (int i = 0; i < 32; ++i) {
          float v = sel[tt][g * 32 + i];
          if (v > m1) { m2 = m1; m1 = v; } else if (v > m2) m2 = v;
        }
        gs[g] = m1 + m2;
      }
      unsigned mask = 0;
#pragma unroll
      for (int it = 0; it < 4; ++it) {
        int best = -1; float bv = -INFINITY;
#pragma unroll
        for (int g = 0; g < 8; ++g) {
          bool ok = !((mask >> g) & 1u);
          if (ok && (best < 0 || gs[g] > bv)) { best = g; bv = gs[g]; }
        }
        mask |= 1u << best;
      }
      int idx[8]; float av[8]; float asum = 0.f;
#pragma unroll
      for (int it = 0; it < 8; ++it) {
        int best = -1; float bv = -INFINITY;
        for (int e = 0; e < NEXP; ++e) {
          if (!((mask >> (e >> 5)) & 1u)) continue;
          float v = sel[tt][e];
          if (best < 0 || v > bv) { best = e; bv = v; }
        }
        idx[it] = best; av[it] = aff[tt][best]; asum += av[it];
        sel[tt][best] = -INFINITY;
      }
      float sc = 2.5f / asum;
#pragma unroll
      for (int it = 0; it < 8; ++it) {
        int e = idx[it];
        int pos = atomicAdd(&counts[e], 1);
        LIST[(size_t)e * T_TOK + pos] = it * T_TOK + t;
        GATEW[(size_t)it * T_TOK + t] = av[it] * sc;
      }
    }
    __syncthreads();
  }
}

__device__ __forceinline__ void moe_prefix(const int* counts, int* pre) {
  if (threadIdx.x == 0) {
    int acc = 0;
    for (int e = 0; e <= NEXP; ++e) { pre[e] = acc; int c = (e < NEXP) ? counts[e] : T_TOK; acc += (c + 127) >> 7; }
    pre[NEXP + 1] = acc;
  }
  __syncthreads();
}
__device__ __forceinline__ int moe_find(const int* pre, int ti) {
  int lo = 0, hi = NEXP;
  while (lo < hi) { int mid = (lo + hi + 1) >> 1; if (pre[mid] <= ti) lo = mid; else hi = mid - 1; }
  return lo;
}

__device__ __forceinline__ void phase_moe1(const Params& p, char* smem) {
  int* asg = (int*)(smem + 32768); int* pre = asg + 128;
  const bf16_t* __restrict__ X1B = (const bf16_t*)(p.ws + OFF_X1B);
  const int* __restrict__ LIST = (const int*)(p.ws + OFF_LIST);
  const int* counts = (const int*)(p.ws + OFF_CTL);
  bf16_t* H = (bf16_t*)(p.ws + OFF_H);
  moe_prefix(counts, pre);
  const int ntiles = pre[NEXP + 1];
  for (int item = blockIdx.x; item < ntiles * 4; item += gridDim.x) {
    const int ti = item >> 2, nt = item & 3;
    const int e = moe_find(pre, ti);
    const int r0 = (ti - pre[e]) * 128;
    const int cnt = (e < NEXP) ? counts[e] : T_TOK;
    __syncthreads();
    if (threadIdx.x < 128) {
      int r = r0 + threadIdx.x;
      asg[threadIdx.x] = (r < cnt) ? ((e < NEXP) ? LIST[(size_t)e * T_TOK + r] : (8 * T_TOK + r)) : -1;
    }
    __syncthreads();
    const float* __restrict__ Wg = (e < NEXP) ? p.in[18] + (size_t)e * DM * 256 : p.in[21];
    const float* __restrict__ Wu = (e < NEXP) ? p.in[19] + (size_t)e * DM * 256 : p.in[22];
    gemm128(smem, DM,
            [=](int r) { int a = asg[r]; return X1B + (size_t)((a >= 0 ? a : 0) & (T_TOK - 1)) * DM; },
            [=](int nq) { const long long dlt = ((nq >> 2) & 2) ? (long long)(Wu - Wg) : 0ll; return Wg + dlt + nt * 64 + (nq >> 4) * 32 + ((nq >> 2) & 1) * 16 + (nq & 3) * 4; },
            256,
            [=](f32x4 (&acc)[4][4], int wr, int wc, int fr, int fq) {
#pragma unroll
              for (int m = 0; m < 4; ++m)
#pragma unroll
                for (int j = 0; j < 4; ++j) {
                  const int a = asg[wr * 64 + m * 16 + fq * 4 + j];
                  if (a < 0) continue;
#pragma unroll
                  for (int n = 0; n < 2; ++n) {
                    float g = acc[m][n][j], u = acc[m][n + 2][j];
                    H[(size_t)a * 256 + nt * 64 + wc * 32 + n * 16 + fr] = f2bf(g * sigmoidf_(g) * u);
                  }
                }
            });
  }
}

__device__ __forceinline__ void phase_moe2(const Params& p, char* smem) {
  int* asg = (int*)(smem + 32768); int* pre = asg + 128;
  const bf16_t* __restrict__ H = (const bf16_t*)(p.ws + OFF_H);
  const int* __restrict__ LIST = (const int*)(p.ws + OFF_LIST);
  const float* __restrict__ GATEW = (const float*)(p.ws + OFF_GATEW);
  const int* counts = (const int*)(p.ws + OFF_CTL);
  bf16_t* Y = (bf16_t*)(p.ws + OFF_Y);
  moe_prefix(counts, pre);
  const int ntiles = pre[NEXP + 1];
  for (int item = blockIdx.x; item < ntiles * 8; item += gridDim.x) {
    const int ti = item >> 3, nt = item & 7;
    const int e = moe_find(pre, ti);
    const int r0 = (ti - pre[e]) * 128;
    const int cnt = (e < NEXP) ? counts[e] : T_TOK;
    __syncthreads();
    if (threadIdx.x < 128) {
      int r = r0 + threadIdx.x;
      asg[threadIdx.x] = (r < cnt) ? ((e < NEXP) ? LIST[(size_t)e * T_TOK + r] : (8 * T_TOK + r)) : -1;
    }
    __syncthreads();
    const float* __restrict__ Wd = (e < NEXP) ? p.in[20] + (size_t)e * 256 * DM : p.in[23];
    gemm128(smem, 256,
            [=](int r) { int a = asg[r]; return H + (size_t)(a >= 0 ? a : 0) * 256; },
            [=](int nq) { return Wd + nt * 128 + nq * 4; },
            DM,
            [=](f32x4 (&acc)[4][4], int wr, int wc, int fr, int fq) {
#pragma unroll
              for (int m = 0; m < 4; ++m)
#pragma unroll
                for (int j = 0; j < 4; ++j) {
                  const int a = asg[wr * 64 + m * 16 + fq * 4 + j];
                  if (a < 0) continue;
                  const float gw = (a < 8 * T_TOK) ? GATEW[a] : 1.f;
#pragma unroll
                  for (int n = 0; n < 4; ++n) Y[(size_t)a * DM + nt * 128 + wc * 64 + n * 16 + fr] = f2bf(acc[m][n][j] * gw);
                }
            });
  }
}

__device__ __forceinline__ void phase_final(const Params& p, char* smem) {
  float* red = (float*)smem;
  float* OUT = p.out;
  const bf16_t* __restrict__ Y = (const bf16_t*)(p.ws + OFF_Y);
  const float* __restrict__ g2 = p.in[24]; const float* __restrict__ b2 = p.in[25];
  const int tid = threadIdx.x, lane = tid & 63, wid = tid >> 6;
  for (int t = blockIdx.x; t < T_TOK; t += gridDim.x) {
    size_t base = (size_t)t * DM;
    float v[4];
    float s = 0.f;
#pragma unroll
    for (int u = 0; u < 4; ++u) {
      int c = tid + u * 256;
      float acc = 0.f;
#pragma unroll
      for (int sl = 0; sl < 9; ++sl) acc += bf2f(Y[((size_t)sl * T_TOK + t) * DM + c]);
      v[u] = ALPHA_F * OUT[base + c] + acc;
      s += v[u];
    }
    s = wave_sum(s);
    if (lane == 0) red[wid] = s;
    __syncthreads();
    float mean = (red[0] + red[1] + red[2] + red[3]) * (1.f / DM);
    float q = 0.f;
#pragma unroll
    for (int u = 0; u < 4; ++u) { float d = v[u] - mean; q += d * d; }
    q = wave_sum(q);
    if (lane == 0) red[4 + wid] = q;
    __syncthreads();
    float var = (red[4] + red[5] + red[6] + red[7]) * (1.f / DM);
    float rs = rsqrtf(var + LN_EPS_F);
#pragma unroll
    for (int u = 0; u < 4; ++u) {
      int c = tid + u * 256;
      OUT[base + c] = (v[u] - mean) * rs * g2[c] + b2[c];
    }
    __syncthreads();
  }
}

__global__ void __launch_bounds__(NTHR, 2) mega(Params p) {
  extern __shared__ __attribute__((aligned(16))) char smem[];
  cg::grid_group grid = cg::this_grid();
  phase_rope(p);
  grid.sync();
  phase_inproj(p, smem);
  grid.sync();
  phase_prep(p, smem);
  grid.sync();
  phase_scan_naive(p, smem);
  phase_attn_naive(p);
  grid.sync();
  phase_post(p);
  grid.sync();
  phase_outproj(p, smem);
  grid.sync();
  phase_ln1_router(p, smem);
  grid.sync();
  phase_moe1(p, smem);
  grid.sync();
  phase_moe2(p, smem);
  grid.sync();
  phase_final(p, smem);
}

extern "C" void kernel_launch(void* const* d_in, const int* in_sizes, int n_in, void* d_out, int out_size, void* d_ws, size_t ws_size,
                              hipStream_t stream) {
  static int grid_blocks = 0;
  if (grid_blocks == 0) {
    if (ws_size < WS_NEED || n_in != 26) { fprintf(stderr, "kernel_launch: bad ws/n_in: %zu < %zu, n_in %d\n", ws_size, (size_t)WS_NEED, n_in); grid_blocks = -1; return; }
    int dev = 0, cus = 0, per_cu = 0;
    (void)hipGetDevice(&dev);
    (void)hipDeviceGetAttribute(&cus, hipDeviceAttributeMultiprocessorCount, dev);
    (void)hipFuncSetAttribute((const void*)mega, hipFuncAttributeMaxDynamicSharedMemorySize, LDS_BYTES);
    (void)hipOccupancyMaxActiveBlocksPerMultiprocessor(&per_cu, (const void*)mega, NTHR, LDS_BYTES);
    if (per_cu < 1) { fprintf(stderr, "kernel_launch: occupancy query returned %d\n", per_cu); grid_blocks = -1; return; }
    if (per_cu > 2) per_cu = 2;
    grid_blocks = cus * per_cu;
    fprintf(stderr, "kernel_launch: cus %d per_cu %d grid %d\n", cus, per_cu, grid_blocks);
  }
  if (grid_blocks < 0) return;
  Params p{};
  for (int i = 0; i < 26; ++i) p.in[i] = (const float*)d_in[i];
  p.out = (float*)d_out;
  p.ws = (char*)d_ws;
  void* args[] = {&p};
  hipError_t e = hipLaunchCooperativeKernel((const void*)mega, dim3(grid_blocks), dim3(NTHR), args, LDS_BYTES, stream);
  if (e != hipSuccess) fprintf(stderr, "cooperative launch failed: %s (grid %d)\n", hipGetErrorString(e), grid_blocks);
}
```

```cpp
#include <hip/hip_runtime.h>
#include <hip/hip_bf16.h>
#include <hip/hip_cooperative_groups.h>
#include <stdint.h>
#include <stdio.h>

typedef unsigned short bf16_t;

#define T_TOK 32768
#define SEQ 4096
#define DM 1024
#define INW 3360
#define FEW 1824
#define NEXP 256
#define ALPHA_F 1.189207115002721f
#define LN_EPS_F 1e-5f
#define GN_EPS_F 64e-5f

__device__ __forceinline__ float bf2f(bf16_t v) { return __uint_as_float(((unsigned)v) << 16); }
__device__ __forceinline__ bf16_t f2bf(float f) { unsigned u = __float_as_uint(f); return (bf16_t)((u + 0x7fffu + ((u >> 16) & 1u)) >> 16); }
__device__ __forceinline__ float sigmoidf_(float x) { return 1.f / (1.f + __expf(-x)); }
__device__ __forceinline__ float wave_sum(float v) {
#pragma unroll
  for (int o = 32; o >= 1; o >>= 1) v += __shfl_xor(v, o, 64);
  return v;
}

constexpr size_t SZ_T512_BF = (size_t)T_TOK * 512 * 2;
constexpr size_t OFF_Q = 0;
constexpr size_t OFF_K = OFF_Q + SZ_T512_BF;
constexpr size_t OFF_V = OFF_K + SZ_T512_BF;
constexpr size_t OFF_FEATS = OFF_V + SZ_T512_BF;
constexpr size_t OFF_R = OFF_FEATS + (size_t)T_TOK * FEW * 2;
constexpr size_t OFF_K2 = OFF_R + SZ_T512_BF;
constexpr size_t OFF_V2 = OFF_K2 + SZ_T512_BF;
constexpr size_t OFF_A = OFF_V2 + SZ_T512_BF;
constexpr size_t OFF_B = OFF_A + SZ_T512_BF;
constexpr size_t OFF_W = OFF_B + SZ_T512_BF;
constexpr size_t OFF_G = OFF_W + (size_t)T_TOK * 512 * 4;
constexpr size_t OFF_SB = OFF_G + SZ_T512_BF;
constexpr size_t OFF_YS = OFF_SB + (size_t)T_TOK * 8 * 4;
constexpr size_t OFF_OP = OFF_YS + (size_t)T_TOK * 512 * 4;
constexpr size_t OFF_LSE = OFF_OP + 3 * SZ_T512_BF;
constexpr size_t OFF_MIXED = OFF_LSE + (size_t)3 * T_TOK * 8 * 4;
constexpr size_t OFF_ROPE = OFF_MIXED + (size_t)T_TOK * 1024 * 2;
constexpr size_t EARLY_END = OFF_ROPE + (size_t)4096 * 32 * 2 * 4;
constexpr size_t OFF_Y = 0;
constexpr size_t OFF_H = OFF_Y + (size_t)9 * T_TOK * 1024 * 2;
constexpr size_t OFF_X1B = OFF_H + (size_t)9 * T_TOK * 256 * 2;
constexpr size_t OFF_LIST = OFF_X1B + (size_t)T_TOK * 1024 * 2;
constexpr size_t OFF_GATEW = OFF_LIST + (size_t)NEXP * T_TOK * 4;
constexpr size_t OFF_CTL = OFF_GATEW + (size_t)8 * T_TOK * 4;
constexpr size_t CTL_BYTES = 1u << 20;
constexpr size_t WS_NEED = OFF_CTL + CTL_BYTES;
static_assert(EARLY_END <= OFF_X1B, "early buffers must not overlap X1B");
#define MAXTILES 4864
constexpr size_t OFF_XL = 0;
constexpr size_t OFF_AFF = (size_t)T_TOK * 1024 * 2;
constexpr size_t OFF_XB = OFF_X1B;

typedef short bf16x8 __attribute__((ext_vector_type(8)));
typedef float f32x4 __attribute__((ext_vector_type(4)));
typedef float f32x16 __attribute__((ext_vector_type(16)));
typedef float f32x2_t __attribute__((ext_vector_type(2)));
typedef __bf16 bf16x2_t __attribute__((ext_vector_type(2)));
__device__ __forceinline__ unsigned cvtpk(float lo, float hi) { f32x2_t v = {lo, hi}; bf16x2_t b = __builtin_convertvector(v, bf16x2_t); return __builtin_bit_cast(unsigned, b); }

__device__ const double INVF[32] = {
1, 0.74989420933245587, 0.56234132519034907, 0.42169650342858223, 0.31622776601683794, 0.23713737056616552,
0.17782794100389229, 0.1333521432163324, 0.10000000000000001, 0.074989420933245579, 0.056234132519034911,
0.042169650342858224, 0.031622776601683791, 0.023713737056616554, 0.017782794100389229, 0.013335214321633241,
0.01, 0.0074989420933245579, 0.005623413251903491, 0.0042169650342858229, 0.0031622776601683794,
0.0023713737056616554, 0.0017782794100389228, 0.0013335214321633241, 0.001, 0.00074989420933245586,
0.0005623413251903491, 0.00042169650342858224, 0.00031622776601683794, 0.00023713737056616554,
0.00017782794100389227, 0.0001333521432163324};

namespace cg = cooperative_groups;

struct Params {
  const float* in[26];
  float* out;
  char* ws;
};

#define NTHR 256
#define LDS_BYTES 66560

__device__ __forceinline__ void phase_rope(const Params& p) {
  float* tab = (float*)(p.ws + OFF_ROPE);
  for (int i = blockIdx.x * NTHR + threadIdx.x; i < 4096 * 32; i += gridDim.x * NTHR) {
    int pos = i >> 5, f = i & 31;
    double ang = (double)pos * INVF[f];
    const double TWO_PI = 6.283185307179586476925286766559;
    double n = rint(ang / TWO_PI);
    double r = ang - n * TWO_PI;
    double r2 = r * r;
    double sn = r, cs = 1.0, ts = r, tc = 1.0;
#pragma unroll 1
    for (int k = 1; k <= 16; ++k) {
      tc = -tc * r2 / (double)((2 * k - 1) * (2 * k));
      ts = -ts * r2 / (double)((2 * k) * (2 * k + 1));
      cs += tc; sn += ts;
    }
    tab[i * 2] = (float)cs; tab[i * 2 + 1] = (float)sn;
  }
  int* ctl = (int*)(p.ws + OFF_CTL);
  if (blockIdx.x == 0) for (int i = threadIdx.x; i < 1024; i += NTHR) ctl[i] = 0;
  {
    const float4* __restrict__ x4 = (const float4*)p.in[0];
    uint4* xb = (uint4*)(p.ws + OFF_XB);
    for (size_t i = (size_t)blockIdx.x * NTHR + threadIdx.x; i < (size_t)T_TOK * DM / 8; i += (size_t)gridDim.x * NTHR) {
      float4 a = x4[2 * i], b = x4[2 * i + 1];
      uint4 w; w.x = cvtpk(a.x, a.y); w.y = cvtpk(a.z, a.w); w.z = cvtpk(b.x, b.y); w.w = cvtpk(b.z, b.w);
      xb[i] = w;
    }
  }
}

template <class AF, class BF>
__device__ __forceinline__ void gemm64_naive(float* As, float* Bs, float* Cs, int K, AF af, BF bf) {
  const int tid = threadIdx.x, tx = tid & 15, ty = tid >> 4;
  float acc[4][4];
#pragma unroll
  for (int i = 0; i < 4; ++i)
#pragma unroll
    for (int j = 0; j < 4; ++j) acc[i][j] = 0.f;
  for (int k0 = 0; k0 < K; k0 += 16) {
#pragma unroll
    for (int u = 0; u < 4; ++u) { int i = tid + u * 256; int r = i >> 4, kk = i & 15; As[kk * 68 + r] = af(r, k0 + kk); }
#pragma unroll
    for (int u = 0; u < 4; ++u) { int i = tid + u * 256; int kk = i >> 6, c = i & 63; Bs[kk * 68 + c] = bf(k0 + kk, c); }
    __syncthreads();
#pragma unroll
    for (int kk = 0; kk < 16; ++kk) {
      float a[4], b[4];
#pragma unroll
      for (int i = 0; i < 4; ++i) { a[i] = As[kk * 68 + ty * 4 + i]; b[i] = Bs[kk * 68 + tx * 4 + i]; }
#pragma unroll
      for (int i = 0; i < 4; ++i)
#pragma unroll
        for (int j = 0; j < 4; ++j) acc[i][j] += a[i] * b[j];
    }
    __syncthreads();
  }
#pragma unroll
  for (int i = 0; i < 4; ++i)
#pragma unroll
    for (int j = 0; j < 4; ++j) Cs[(ty * 4 + i) * 65 + tx * 4 + j] = acc[i][j];
  __syncthreads();
}


__device__ __forceinline__ int lds_off(int row, int chunk) { return row * 128 + ((chunk ^ ((row >> 1) & 7)) << 4); }

template <int BMODE>
__device__ __forceinline__ unsigned cvtpk_m(float a, float b) {
  if (BMODE == 0) return cvtpk(a, b);
  const unsigned h = cvtpk(a, b);
  const float ah = __uint_as_float(h << 16), bh = __uint_as_float(h & 0xffff0000u);
  return cvtpk(a - ah, b - bh);
}
template <int BMODE, bool KCLAMP, class ALoad, class BPtr>
__device__ __forceinline__ void gemm128_acc(f32x4 (&acc)[4][4], char* smem, const int nk, ALoad aload, BPtr bptr, const int ldb, const int kvalid) {
  const int tid = threadIdx.x, lane = tid & 63, wid = tid >> 6;
  const int wr = wid >> 1, wc = wid & 1, fr = lane & 15, fq = lane >> 4;
  const int achunk = tid & 7, arow0 = tid >> 3;
  const int nq = tid & 31, ko = tid >> 5;
  const float* bp0 = bptr(nq);
  char* const la0 = smem + lds_off(arow0, achunk);
  char* const la1 = smem + lds_off(arow0 + 32, achunk);
  char* const la2 = smem + lds_off(arow0 + 64, achunk);
  char* const la3 = smem + lds_off(arow0 + 96, achunk);
  char* const lb0 = smem + 16384 + lds_off(nq * 4 + 0, ko);
  char* const lb1 = smem + 16384 + lds_off(nq * 4 + 1, ko);
  char* const lb2 = smem + 16384 + lds_off(nq * 4 + 2, ko);
  char* const lb3 = smem + 16384 + lds_off(nq * 4 + 3, ko);
  uint4 ra0, ra1, ra2, ra3; float4 rb0, rb1, rb2, rb3, rb4, rb5, rb6, rb7;
#define G128_LOAD(kt) { \
    ra0 = aload(0, arow0, (kt) * 8 + achunk); ra1 = aload(1, arow0 + 32, (kt) * 8 + achunk); \
    ra2 = aload(2, arow0 + 64, (kt) * 8 + achunk); ra3 = aload(3, arow0 + 96, (kt) * 8 + achunk); \
    const int kr_ = (kt) * 64 + ko * 8; \
    if (KCLAMP) { \
      rb0 = *(const float4*)(bp0 + (size_t)min(kr_ + 0, kvalid - 1) * ldb); rb1 = *(const float4*)(bp0 + (size_t)min(kr_ + 1, kvalid - 1) * ldb); \
      rb2 = *(const float4*)(bp0 + (size_t)min(kr_ + 2, kvalid - 1) * ldb); rb3 = *(const float4*)(bp0 + (size_t)min(kr_ + 3, kvalid - 1) * ldb); \
      rb4 = *(const float4*)(bp0 + (size_t)min(kr_ + 4, kvalid - 1) * ldb); rb5 = *(const float4*)(bp0 + (size_t)min(kr_ + 5, kvalid - 1) * ldb); \
      rb6 = *(const float4*)(bp0 + (size_t)min(kr_ + 6, kvalid - 1) * ldb); rb7 = *(const float4*)(bp0 + (size_t)min(kr_ + 7, kvalid - 1) * ldb); \
    } else { \
      const float* b2_ = bp0 + (size_t)kr_ * ldb; \
      rb0 = *(const float4*)(b2_); rb1 = *(const float4*)(b2_ + (size_t)1 * ldb); rb2 = *(const float4*)(b2_ + (size_t)2 * ldb); \
      rb3 = *(const float4*)(b2_ + (size_t)3 * ldb); rb4 = *(const float4*)(b2_ + (size_t)4 * ldb); rb5 = *(const float4*)(b2_ + (size_t)5 * ldb); \
      rb6 = *(const float4*)(b2_ + (size_t)6 * ldb); rb7 = *(const float4*)(b2_ + (size_t)7 * ldb); \
    } }
  G128_LOAD(0)
  for (int kt = 0; kt < nk; ++kt) {
    __syncthreads();
    *(uint4*)la0 = ra0; *(uint4*)la1 = ra1; *(uint4*)la2 = ra2; *(uint4*)la3 = ra3;
    {
      uint4 w;
      w.x = cvtpk_m<BMODE>(rb0.x, rb1.x); w.y = cvtpk_m<BMODE>(rb2.x, rb3.x); w.z = cvtpk_m<BMODE>(rb4.x, rb5.x); w.w = cvtpk_m<BMODE>(rb6.x, rb7.x);
      *(uint4*)lb0 = w;
      w.x = cvtpk_m<BMODE>(rb0.y, rb1.y); w.y = cvtpk_m<BMODE>(rb2.y, rb3.y); w.z = cvtpk_m<BMODE>(rb4.y, rb5.y); w.w = cvtpk_m<BMODE>(rb6.y, rb7.y);
      *(uint4*)lb1 = w;
      w.x = cvtpk_m<BMODE>(rb0.z, rb1.z); w.y = cvtpk_m<BMODE>(rb2.z, rb3.z); w.z = cvtpk_m<BMODE>(rb4.z, rb5.z); w.w = cvtpk_m<BMODE>(rb6.z, rb7.z);
      *(uint4*)lb2 = w;
      w.x = cvtpk_m<BMODE>(rb0.w, rb1.w); w.y = cvtpk_m<BMODE>(rb2.w, rb3.w); w.z = cvtpk_m<BMODE>(rb4.w, rb5.w); w.w = cvtpk_m<BMODE>(rb6.w, rb7.w);
      *(uint4*)lb3 = w;
    }
    __syncthreads();
    if (kt + 1 < nk) G128_LOAD(kt + 1)
#pragma unroll
    for (int kk = 0; kk < 2; ++kk) {
      bf16x8 af[4], bfr[4];
#pragma unroll
      for (int m = 0; m < 4; ++m) af[m] = *(const bf16x8*)(smem + lds_off(wr * 64 + m * 16 + fr, kk * 4 + fq));
#pragma unroll
      for (int n = 0; n < 4; ++n) bfr[n] = *(const bf16x8*)(smem + 16384 + lds_off(wc * 64 + n * 16 + fr, kk * 4 + fq));
#pragma unroll
      for (int m = 0; m < 4; ++m)
#pragma unroll
        for (int n = 0; n < 4; ++n) acc[m][n] = __builtin_amdgcn_mfma_f32_16x16x32_bf16(af[m], bfr[n], acc[m][n], 0, 0, 0);
    }
  }
#undef G128_LOAD
}
__device__ __forceinline__ void acc_zero(f32x4 (&acc)[4][4]) {
#pragma unroll
  for (int m = 0; m < 4; ++m)
#pragma unroll
    for (int n = 0; n < 4; ++n) acc[m][n] = (f32x4){0.f, 0.f, 0.f, 0.f};
}
template <class ARow, class BPtr, class Epi>
__device__ __forceinline__ void gemm128(char* smem, const int K, ARow arow, BPtr bptr, const int ldb, Epi epi) {
  const int tid = threadIdx.x, lane = tid & 63, wid = tid >> 6;
  const int arow0 = tid >> 3;
  const bf16_t* ap0 = arow(arow0);
  const bf16_t* ap1 = arow(arow0 + 32);
  const bf16_t* ap2 = arow(arow0 + 64);
  const bf16_t* ap3 = arow(arow0 + 96);
  f32x4 acc[4][4];
  acc_zero(acc);
  gemm128_acc<0, false>(acc, smem, K >> 6,
      [=](int u, int, int kc) { const bf16_t* q = (u == 0) ? ap0 : (u == 1) ? ap1 : (u == 2) ? ap2 : ap3; return *(const uint4*)(q + kc * 8); },
      bptr, ldb, 0);
  epi(acc, wid >> 1, wid & 1, lane & 15, lane >> 4);
}


#define DPP_F(v, ctrl) __builtin_bit_cast(float, __builtin_amdgcn_update_dpp(0, __builtin_bit_cast(int, (v)), (ctrl), 0xF, 0xF, true))
__device__ __forceinline__ float rdlane_f(float v, int l) { return __builtin_bit_cast(float, __builtin_amdgcn_readlane(__builtin_bit_cast(int, v), l)); }
__device__ __forceinline__ float dpp_sum16x(float v) {
  v += DPP_F(v, 0xB1); v += DPP_F(v, 0x4E); v += DPP_F(v, 0x141); v += DPP_F(v, 0x140);
  return v;
}
__device__ __forceinline__ float dpp_max16x(float v) {
  v = fmaxf(v, DPP_F(v, 0xB1)); v = fmaxf(v, DPP_F(v, 0x4E)); v = fmaxf(v, DPP_F(v, 0x141)); v = fmaxf(v, DPP_F(v, 0x140));
  return v;
}
__device__ __forceinline__ float wave_sum_fast(float v) {
  v = dpp_sum16x(v);
  return (rdlane_f(v, 0) + rdlane_f(v, 16)) + (rdlane_f(v, 32) + rdlane_f(v, 48));
}
__device__ __forceinline__ float wave_max_fast(float v) {
  v = dpp_max16x(v);
  return fmaxf(fmaxf(rdlane_f(v, 0), rdlane_f(v, 16)), fmaxf(rdlane_f(v, 32), rdlane_f(v, 48)));
}
__device__ __forceinline__ float fast_tanh(float x) { const float e = __expf(2.f * x); return 1.f - 2.f / (e + 1.f); }

__device__ __forceinline__ void phase_inproj(const Params& p, char* smem) {
  const bf16_t* __restrict__ XB = (const bf16_t*)(p.ws + OFF_XB);
  const float* __restrict__ w_in = p.in[1];
  const float* __restrict__ rope = (const float*)(p.ws + OFF_ROPE);
  bf16_t* Q = (bf16_t*)(p.ws + OFF_Q); bf16_t* K = (bf16_t*)(p.ws + OFF_K); bf16_t* V = (bf16_t*)(p.ws + OFF_V);
  bf16_t* FE = (bf16_t*)(p.ws + OFF_FEATS);
  const int NT = 27, NITEM = (T_TOK / 128) * NT;
  for (int item = blockIdx.x; item < NITEM; item += gridDim.x) {
    const int row0 = (item / NT) * 128, col0 = (item % NT) * 128;
    gemm128(smem, DM,
            [=](int r) { return XB + (size_t)(row0 + r) * DM; },
            [=](int nq) { int c = col0 + nq * 4; if (c >= INW) c = 0; return w_in + c; },
            INW,
            [=](f32x4 (&acc)[4][4], int wr, int wc, int fr, int fq) {
              const int cb = col0 + wc * 64;
              if (cb >= INW) return;
#pragma unroll
              for (int m = 0; m < 4; ++m)
#pragma unroll
                for (int j = 0; j < 4; ++j) {
                  const int t = row0 + wr * 64 + m * 16 + fq * 4 + j;
                  if (cb < 1024) {
                    const int pos = t & (SEQ - 1);
#pragma unroll
                    for (int n = 0; n < 2; ++n) {
                      const int f = n * 16 + fr;
                      const float2 cs = *(const float2*)(rope + (size_t)(pos * 32 + f) * 2);
                      const float z1 = acc[m][n][j], z2 = acc[m][n + 2][j];
                      const float o1 = z1 * cs.x - z2 * cs.y, o2 = z2 * cs.x + z1 * cs.y;
                      if (cb < 512) {
                        Q[(size_t)t * 512 + cb + f] = f2bf(o1 * 0.125f); Q[(size_t)t * 512 + cb + f + 32] = f2bf(o2 * 0.125f);
                      } else {
                        K[(size_t)t * 512 + (cb - 512) + f] = f2bf(o1); K[(size_t)t * 512 + (cb - 512) + f + 32] = f2bf(o2);
                      }
                    }
                  } else if (cb < 1536) {
#pragma unroll
                    for (int n = 0; n < 4; ++n) V[(size_t)t * 512 + (cb - 1024) + n * 16 + fr] = f2bf(acc[m][n][j]);
                  } else {
#pragma unroll
                    for (int n = 0; n < 4; ++n) { int c = cb + n * 16 + fr; if (c < INW) FE[(size_t)t * FEW + (c - 1536)] = f2bf(acc[m][n][j]); }
                  }
                }
            });
  }
}

__device__ __forceinline__ float lerp_bf(const bf16_t* FE, int t, int col, float muc) {
  const float cur = bf2f(FE[(size_t)t * FEW + col]);
  const float prev = ((t & (SEQ - 1)) == 0) ? 0.f : bf2f(FE[(size_t)(t - 1) * FEW + col]);
  return cur + (prev - cur) * muc;
}
template <int PASS>
__device__ __forceinline__ void prep_item(const Params& p, char* smem, const int row0, const int col0) {
  const bf16_t* __restrict__ FE = (const bf16_t*)(p.ws + OFF_FEATS);
  const float* __restrict__ mu = p.in[2];
  constexpr int ACOL = 1536 + PASS * 64;
  constexpr int NK = (PASS == 2) ? 3 : 1;
  const float* __restrict__ Wm = (PASS == 0) ? p.in[4] : (PASS == 1) ? p.in[6] : p.in[7];
  f32x4 acc[4][4];
  acc_zero(acc);
  gemm128_acc<0, (PASS == 2)>(acc, smem, NK,
      [=](int, int rowl, int kc) {
        uint4 out = make_uint4(0u, 0u, 0u, 0u);
        const int j0 = kc * 8;
        if (PASS != 2 || j0 < 160) {
          const int t = row0 + rowl, col = ACOL + j0;
          const uint4 cu = *(const uint4*)(FE + (size_t)t * FEW + col);
          uint4 pv = make_uint4(0u, 0u, 0u, 0u);
          if ((t & (SEQ - 1)) != 0) pv = *(const uint4*)(FE + (size_t)(t - 1) * FEW + col);
          const float4 m0 = *(const float4*)(mu + col), m1 = *(const float4*)(mu + col + 4);
          float f[8];
          const unsigned cw[4] = {cu.x, cu.y, cu.z, cu.w}, pw[4] = {pv.x, pv.y, pv.z, pv.w};
          const float mm[8] = {m0.x, m0.y, m0.z, m0.w, m1.x, m1.y, m1.z, m1.w};
#pragma unroll
          for (int i = 0; i < 4; ++i) {
            const float c0 = __uint_as_float(cw[i] << 16), c1 = __uint_as_float(cw[i] & 0xffff0000u);
            const float p0 = __uint_as_float(pw[i] << 16), p1 = __uint_as_float(pw[i] & 0xffff0000u);
            f[2 * i] = c0 + (p0 - c0) * mm[2 * i];
            f[2 * i + 1] = c1 + (p1 - c1) * mm[2 * i + 1];
          }
#pragma unroll
          for (int i = 0; i < 8; ++i) f[i] = (PASS == 0) ? fast_tanh(f[i]) : ((PASS == 1) ? f[i] : sigmoidf_(f[i]));
          out.x = cvtpk(f[0], f[1]); out.y = cvtpk(f[2], f[3]); out.z = cvtpk(f[4], f[5]); out.w = cvtpk(f[6], f[7]);
        }
        return out;
      },
      [=](int nq) { return Wm + col0 + nq * 4; }, 512, 160);
  const int tid = threadIdx.x, lane = tid & 63, wid = tid >> 6;
  const int wr = wid >> 1, wc = wid & 1, fr = lane & 15, fq = lane >> 4;
  const int cb = col0 + wc * 64;
  if (PASS == 0) {
    const float* __restrict__ w0 = p.in[3];
    float* W = (float*)(p.ws + OFF_W);
#pragma unroll
    for (int n = 0; n < 4; ++n) {
      const int c = cb + n * 16 + fr;
      const float w0c = w0[c];
#pragma unroll
      for (int m = 0; m < 4; ++m)
#pragma unroll
        for (int j = 0; j < 4; ++j) {
          const int t = row0 + wr * 64 + m * 16 + fq * 4 + j;
          const float nz = -(w0c + acc[m][n][j]);
          const float sp = fmaxf(nz, 0.f) + __logf(1.f + __expf(-fabsf(nz)));
          W[(size_t)t * 512 + c] = __expf(-__expf(-sp - 0.5f));
        }
    }
  } else if (PASS == 2) {
    bf16_t* G = (bf16_t*)(p.ws + OFF_G);
#pragma unroll
    for (int m = 0; m < 4; ++m)
#pragma unroll
      for (int j = 0; j < 4; ++j) {
        const int t = row0 + wr * 64 + m * 16 + fq * 4 + j;
#pragma unroll
        for (int n = 0; n < 4; ++n) G[(size_t)t * 512 + cb + n * 16 + fr] = f2bf(acc[m][n][j]);
      }
  } else {
    const float* __restrict__ a0 = p.in[5]; const float* __restrict__ k_k = p.in[8]; const float* __restrict__ k_a = p.in[9];
    const float* __restrict__ r_k = p.in[10];
    bf16_t* R = (bf16_t*)(p.ws + OFF_R); bf16_t* K2 = (bf16_t*)(p.ws + OFF_K2); bf16_t* V2 = (bf16_t*)(p.ws + OFF_V2);
    bf16_t* A = (bf16_t*)(p.ws + OFF_A); bf16_t* B = (bf16_t*)(p.ws + OFF_B); float* SB = (float*)(p.ws + OFF_SB);
    float a0c[4], kkc[4], kac[4], rkc[4], mur[4], muk[4], muv[4];
#pragma unroll
    for (int n = 0; n < 4; ++n) {
      const int c = cb + n * 16 + fr;
      a0c[n] = a0[c]; kkc[n] = k_k[c]; kac[n] = k_a[c]; rkc[n] = r_k[c]; mur[n] = mu[c]; muk[n] = mu[512 + c]; muv[n] = mu[1024 + c];
    }
#pragma unroll
    for (int m = 0; m < 4; ++m)
#pragma unroll
      for (int j = 0; j < 4; ++j) {
        const int t = row0 + wr * 64 + m * 16 + fq * 4 + j;
        float rr[4], k2[4], vv[4], kk[4], aa[4];
        float ssp = 0.f, sbp = 0.f;
#pragma unroll
        for (int n = 0; n < 4; ++n) {
          const int c = cb + n * 16 + fr;
          rr[n] = lerp_bf(FE, t, c, mur[n]);
          const float k = lerp_bf(FE, t, 512 + c, muk[n]);
          vv[n] = lerp_bf(FE, t, 1024 + c, muv[n]);
          aa[n] = sigmoidf_(a0c[n] + acc[m][n][j]);
          kk[n] = k * kkc[n];
          k2[n] = k * (1.f + (aa[n] - 1.f) * kac[n]);
          ssp += kk[n] * kk[n];
          sbp += rr[n] * k2[n] * rkc[n];
        }
        const float ss = dpp_sum16x(ssp), sb = dpp_sum16x(sbp);
        const float inv = 1.f / fmaxf(sqrtf(ss), 1e-12f);
#pragma unroll
        for (int n = 0; n < 4; ++n) {
          const size_t o = (size_t)t * 512 + cb + n * 16 + fr;
          const float kkn = kk[n] * inv;
          R[o] = f2bf(rr[n]); K2[o] = f2bf(k2[n]); V2[o] = f2bf(vv[n]); A[o] = f2bf(-kkn); B[o] = f2bf(kkn * aa[n]);
        }
        if (fr == 0) SB[(size_t)t * 8 + (cb >> 6)] = sb;
      }
  }
}
__device__ __forceinline__ void phase_prep(const Params& p, char* smem) {
  for (int item = blockIdx.x; item < (T_TOK / 128) * 12; item += gridDim.x) {
    const int mt = item / 12, sub = item - mt * 12, pass = sub >> 2, nt = sub & 3;
    if (pass == 0) prep_item<0>(p, smem, mt * 128, nt * 128);
    else if (pass == 1) prep_item<1>(p, smem, mt * 128, nt * 128);
    else prep_item<2>(p, smem, mt * 128, nt * 128);
  }
}

__device__ __forceinline__ float dpp_sum16(float v) {
  v += __builtin_bit_cast(float, __builtin_amdgcn_update_dpp(0, __builtin_bit_cast(int, v), 0xB1, 0xF, 0xF, true));
  v += __builtin_bit_cast(float, __builtin_amdgcn_update_dpp(0, __builtin_bit_cast(int, v), 0x4E, 0xF, 0xF, true));
  v += __builtin_bit_cast(float, __builtin_amdgcn_update_dpp(0, __builtin_bit_cast(int, v), 0x141, 0xF, 0xF, true));
  v += __builtin_bit_cast(float, __builtin_amdgcn_update_dpp(0, __builtin_bit_cast(int, v), 0x140, 0xF, 0xF, true));
  return v;
}
__device__ __forceinline__ float4 bf4_to_f4(uint2 u) {
  float4 r;
  r.x = __uint_as_float(u.x << 16); r.y = __uint_as_float(u.x & 0xffff0000u);
  r.z = __uint_as_float(u.y << 16); r.w = __uint_as_float(u.y & 0xffff0000u);
  return r;
}
#define SC_CH 16
#define SC_ARR (SC_CH * 64 * 4)
#define SC_BUF (5 * SC_ARR + SC_CH * 16 * 4)
__device__ __forceinline__ void phase_scan(const Params& p, char* smem) {
  if (blockIdx.x >= 256) return;
  const bf16_t* __restrict__ R = (const bf16_t*)(p.ws + OFF_R); const bf16_t* __restrict__ K2 = (const bf16_t*)(p.ws + OFF_K2);
  const bf16_t* __restrict__ V2 = (const bf16_t*)(p.ws + OFF_V2); const bf16_t* __restrict__ A = (const bf16_t*)(p.ws + OFF_A);
  const bf16_t* __restrict__ B = (const bf16_t*)(p.ws + OFF_B); const float* __restrict__ W = (const float*)(p.ws + OFF_W);
  float* YS = (float*)(p.ws + OFF_YS);
  const int bh = blockIdx.x >> 2, rg = blockIdx.x & 3, b = bh >> 3, h = bh & 7;
  const int tid = threadIdx.x, lane = tid & 63, wid = tid >> 6, j = lane & 15, rq = lane >> 4;
  const int rowl = wid * 4 + rq;
  const int ls = tid >> 4, lc = tid & 15;
  const int vs = (tid >> 2) & 15, vq = tid & 3;
  const size_t tb = (size_t)b * SEQ;
  const size_t goff = (tb + ls) * 512 + h * 64 + lc * 4;
  const size_t voff = (tb + vs) * 512 + h * 64 + rg * 16 + vq * 4;
  uint2 ga, gb, gk, gr, gv; float4 gw;
  gv = make_uint2(0u, 0u);
  ga = *(const uint2*)(A + goff); gb = *(const uint2*)(B + goff); gk = *(const uint2*)(K2 + goff); gr = *(const uint2*)(R + goff);
  gw = *(const float4*)(W + goff);
  if (tid < 64) gv = *(const uint2*)(V2 + voff);
  {
    char* bf = smem;
    *(float4*)(bf + 0 * SC_ARR + ls * 256 + lc * 16) = bf4_to_f4(ga);
    *(float4*)(bf + 1 * SC_ARR + ls * 256 + lc * 16) = gw;
    *(float4*)(bf + 2 * SC_ARR + ls * 256 + lc * 16) = bf4_to_f4(gb);
    *(float4*)(bf + 3 * SC_ARR + ls * 256 + lc * 16) = bf4_to_f4(gk);
    *(float4*)(bf + 4 * SC_ARR + ls * 256 + lc * 16) = bf4_to_f4(gr);
    if (tid < 64) *(float4*)(bf + 5 * SC_ARR + vs * 64 + vq * 16) = bf4_to_f4(gv);
  }
  __syncthreads();
  float s0 = 0.f, s1 = 0.f, s2 = 0.f, s3 = 0.f;
  const int NCH = SEQ / SC_CH;
  for (int c = 0; c < NCH; ++c) {
    if (c + 1 < NCH) {
      const size_t o2 = goff + (size_t)(c + 1) * SC_CH * 512;
      ga = *(const uint2*)(A + o2); gb = *(const uint2*)(B + o2); gk = *(const uint2*)(K2 + o2); gr = *(const uint2*)(R + o2);
      gw = *(const float4*)(W + o2);
      if (tid < 64) gv = *(const uint2*)(V2 + voff + (size_t)(c + 1) * SC_CH * 512);
    }
    const char* bf = smem + (c & 1) * SC_BUF;
    float ykeep = 0.f;
#pragma unroll
    for (int s = 0; s < SC_CH; ++s) {
      const float4 a4 = *(const float4*)(bf + 0 * SC_ARR + s * 256 + j * 16);
      const float4 w4 = *(const float4*)(bf + 1 * SC_ARR + s * 256 + j * 16);
      const float4 b4 = *(const float4*)(bf + 2 * SC_ARR + s * 256 + j * 16);
      const float4 k4 = *(const float4*)(bf + 3 * SC_ARR + s * 256 + j * 16);
      const float4 r4 = *(const float4*)(bf + 4 * SC_ARR + s * 256 + j * 16);
      const float vv = *(const float*)(bf + 5 * SC_ARR + s * 64 + rowl * 4);
      float sa = (s0 * a4.x + s1 * a4.y) + (s2 * a4.z + s3 * a4.w);
      sa = dpp_sum16(sa);
      s0 = s0 * w4.x + (sa * b4.x + vv * k4.x);
      s1 = s1 * w4.y + (sa * b4.y + vv * k4.y);
      s2 = s2 * w4.z + (sa * b4.z + vv * k4.z);
      s3 = s3 * w4.w + (sa * b4.w + vv * k4.w);
      float y = (s0 * r4.x + s1 * r4.y) + (s2 * r4.z + s3 * r4.w);
      y = dpp_sum16(y);
      ykeep = (j == s) ? y : ykeep;
    }
    YS[(tb + (size_t)c * SC_CH + j) * 512 + h * 64 + rg * 16 + rowl] = ykeep;
    if (c + 1 < NCH) {
      char* bn = smem + ((c + 1) & 1) * SC_BUF;
      *(float4*)(bn + 0 * SC_ARR + ls * 256 + lc * 16) = bf4_to_f4(ga);
      *(float4*)(bn + 1 * SC_ARR + ls * 256 + lc * 16) = gw;
      *(float4*)(bn + 2 * SC_ARR + ls * 256 + lc * 16) = bf4_to_f4(gb);
      *(float4*)(bn + 3 * SC_ARR + ls * 256 + lc * 16) = bf4_to_f4(gk);
      *(float4*)(bn + 4 * SC_ARR + ls * 256 + lc * 16) = bf4_to_f4(gr);
      if (tid < 64) *(float4*)(bn + 5 * SC_ARR + vs * 64 + vq * 16) = bf4_to_f4(gv);
    }
    __syncthreads();
  }
}

__device__ __forceinline__ int vt_off(int d, int key) { const int swz = ((d >> 2) & 15) ^ ((d & 3) << 3); return d * 512 + (((key >> 2) ^ swz) << 3); }
__device__ __forceinline__ void phase_attn(const Params& p, char* smem) {
  const bf16_t* __restrict__ Q = (const bf16_t*)(p.ws + OFF_Q); const bf16_t* __restrict__ K = (const bf16_t*)(p.ws + OFF_K);
  const bf16_t* __restrict__ V = (const bf16_t*)(p.ws + OFF_V);
  bf16_t* OP = (bf16_t*)(p.ws + OFF_OP); float* LSE = (float*)(p.ws + OFF_LSE);
  char* Ks = smem; char* VT = smem + 32768; float* linv_s = (float*)(smem + 65536);
  const int tid = threadIdx.x, lane = tid & 63, wid = tid >> 6, l31 = lane & 31, hi = lane >> 5;
  for (int item = blockIdx.x; item < 6144; item += gridDim.x) {
    const int pp = item >> 11, rem = item & 2047, bh = rem >> 5, sub = rem & 31;
    const int dsh = pp * 2, nbsh = 5 - dsh;
    const int r = sub >> nbsh, n = sub & ((1 << nbsh) - 1);
    const int b = bh >> 3, h = bh & 7, tb = b * SEQ;
    __syncthreads();
#pragma unroll
    for (int u = 0; u < 8; ++u) {
      const int row = (tid >> 3) + 32 * u, chunk = tid & 7;
      int ik = n * 128 - 128 + row; ik = ik < 0 ? 0 : ik;
      const int tok = tb + (ik << dsh) + r;
      *(uint4*)(Ks + lds_off(row, chunk)) = *(const uint4*)(K + (size_t)tok * 512 + h * 64 + chunk * 8);
    }
#pragma unroll
    for (int ps = 0; ps < 2; ++ps) {
      const int dq = tid & 15, kbase = ps * 128 + (tid >> 4) * 8;
      uint2 v0, v1, v2, v3, v4, v5, v6, v7;
#define LDV(i, dst) { int ik = n * 128 - 128 + kbase + i; ik = ik < 0 ? 0 : ik; const int tok = tb + (ik << dsh) + r; dst = *(const uint2*)(V + (size_t)tok * 512 + h * 64 + dq * 4); }
      LDV(0, v0) LDV(1, v1) LDV(2, v2) LDV(3, v3) LDV(4, v4) LDV(5, v5) LDV(6, v6) LDV(7, v7)
#undef LDV
      {
        uint2 w;
        w.x = (v0.x & 0xffffu) | (v1.x << 16); w.y = (v2.x & 0xffffu) | (v3.x << 16);
        *(uint2*)(VT + vt_off(dq * 4 + 0, kbase)) = w;
        w.x = (v4.x & 0xffffu) | (v5.x << 16); w.y = (v6.x & 0xffffu) | (v7.x << 16);
        *(uint2*)(VT + vt_off(dq * 4 + 0, kbase + 4)) = w;
        w.x = (v0.x >> 16) | (v1.x & 0xffff0000u); w.y = (v2.x >> 16) | (v3.x & 0xffff0000u);
        *(uint2*)(VT + vt_off(dq * 4 + 1, kbase)) = w;
        w.x = (v4.x >> 16) | (v5.x & 0xffff0000u); w.y = (v6.x >> 16) | (v7.x & 0xffff0000u);
        *(uint2*)(VT + vt_off(dq * 4 + 1, kbase + 4)) = w;
        w.x = (v0.y & 0xffffu) | (v1.y << 16); w.y = (v2.y & 0xffffu) | (v3.y << 16);
        *(uint2*)(VT + vt_off(dq * 4 + 2, kbase)) = w;
        w.x = (v4.y & 0xffffu) | (v5.y << 16); w.y = (v6.y & 0xffffu) | (v7.y << 16);
        *(uint2*)(VT + vt_off(dq * 4 + 2, kbase + 4)) = w;
        w.x = (v0.y >> 16) | (v1.y & 0xffff0000u); w.y = (v2.y >> 16) | (v3.y & 0xffff0000u);
        *(uint2*)(VT + vt_off(dq * 4 + 3, kbase)) = w;
        w.x = (v4.y >> 16) | (v5.y & 0xffff0000u); w.y = (v6.y >> 16) | (v7.y & 0xffff0000u);
        *(uint2*)(VT + vt_off(dq * 4 + 3, kbase + 4)) = w;
      }
    }
    __syncthreads();
    const int iq = n * 128 + wid * 32 + l31;
    const int tq = tb + (iq << dsh) + r;
    bf16x8 qf[4];
#pragma unroll
    for (int ks = 0; ks < 4; ++ks) qf[ks] = *(const bf16x8*)(Q + (size_t)tq * 512 + h * 64 + ks * 16 + hi * 8);
    f32x16 st[5];
#pragma unroll
    for (int kb = 0; kb < 5; ++kb) {
      st[kb] = (f32x16){0.f, 0.f, 0.f, 0.f, 0.f, 0.f, 0.f, 0.f, 0.f, 0.f, 0.f, 0.f, 0.f, 0.f, 0.f, 0.f};
#pragma unroll
      for (int ks = 0; ks < 4; ++ks) {
        const bf16x8 kf = *(const bf16x8*)(Ks + lds_off(32 * (wid + kb) + l31, 2 * ks + hi));
        st[kb] = __builtin_amdgcn_mfma_f32_32x32x16_bf16(kf, qf[ks], st[kb], 0, 0, 0);
      }
    }
    float m = -INFINITY;
#pragma unroll
    for (int kb = 0; kb < 5; ++kb)
#pragma unroll
      for (int i = 0; i < 16; ++i) {
        const int kirel = 32 * kb + (i & 3) + 8 * (i >> 2) + 4 * hi;
        const bool valid = (kirel >= l31) && (kirel <= l31 + 128) && (n > 0 || (32 * wid + kirel) >= 128);
        const float s = valid ? st[kb][i] : -INFINITY;
        st[kb][i] = s;
        m = fmaxf(m, s);
      }
    m = fmaxf(m, __shfl_xor(m, 32, 64));
    float l = 0.f;
#pragma unroll
    for (int kb = 0; kb < 5; ++kb)
#pragma unroll
      for (int i = 0; i < 16; ++i) { const float pe = __expf(st[kb][i] - m); st[kb][i] = pe; l += pe; }
    l += __shfl_xor(l, 32, 64);
    f32x16 o0 = (f32x16){0.f, 0.f, 0.f, 0.f, 0.f, 0.f, 0.f, 0.f, 0.f, 0.f, 0.f, 0.f, 0.f, 0.f, 0.f, 0.f};
    f32x16 o1 = o0;
#pragma unroll
    for (int kb = 0; kb < 5; ++kb)
#pragma unroll
      for (int s = 0; s < 2; ++s) {
        union { unsigned u[4]; bf16x8 v; } pa;
        pa.u[0] = cvtpk(st[kb][8 * s + 0], st[kb][8 * s + 1]); pa.u[1] = cvtpk(st[kb][8 * s + 2], st[kb][8 * s + 3]);
        pa.u[2] = cvtpk(st[kb][8 * s + 4], st[kb][8 * s + 5]); pa.u[3] = cvtpk(st[kb][8 * s + 6], st[kb][8 * s + 7]);
        const int key0 = 32 * (wid + kb) + 16 * s + 4 * hi;
        {
          union { uint2 u[2]; bf16x8 v; } vb;
          vb.u[0] = *(const uint2*)(VT + vt_off(l31, key0)); vb.u[1] = *(const uint2*)(VT + vt_off(l31, key0 + 8));
          o0 = __builtin_amdgcn_mfma_f32_32x32x16_bf16(pa.v, vb.v, o0, 0, 0, 0);
        }
        {
          union { uint2 u[2]; bf16x8 v; } vb;
          vb.u[0] = *(const uint2*)(VT + vt_off(32 + l31, key0)); vb.u[1] = *(const uint2*)(VT + vt_off(32 + l31, key0 + 8));
          o1 = __builtin_amdgcn_mfma_f32_32x32x16_bf16(pa.v, vb.v, o1, 0, 0, 0);
        }
      }
    if (hi == 0) {
      linv_s[wid * 32 + l31] = 1.f / l;
      LSE[((size_t)pp * T_TOK + tq) * 8 + h] = m + __logf(l);
    }
#pragma unroll
    for (int i = 0; i < 16; ++i) {
      const int qrel = (i & 3) + 8 * (i >> 2) + 4 * hi;
      const int iq2 = n * 128 + wid * 32 + qrel;
      const int tq2 = tb + (iq2 << dsh) + r;
      const float li = linv_s[wid * 32 + qrel];
      bf16_t* op = OP + ((size_t)pp * T_TOK + tq2) * 512 + h * 64 + l31;
      op[0] = f2bf(o0[i] * li);
      op[32] = f2bf(o1[i] * li);
    }
  }
}

__device__ __forceinline__ void phase_post(const Params& p) {
  const float* __restrict__ YS = (const float*)(p.ws + OFF_YS); const bf16_t* __restrict__ V2 = (const bf16_t*)(p.ws + OFF_V2);
  const bf16_t* __restrict__ G = (const bf16_t*)(p.ws + OFF_G); const float* __restrict__ SB = (const float*)(p.ws + OFF_SB);
  const bf16_t* __restrict__ OP = (const bf16_t*)(p.ws + OFF_OP); const float* __restrict__ LSE = (const float*)(p.ws + OFF_LSE);
  const float* __restrict__ lnx_g = p.in[11]; const float* __restrict__ lnx_b = p.in[12];
  bf16_t* MIXED = (bf16_t*)(p.ws + OFF_MIXED);
  const int tid = threadIdx.x;
  for (int t = blockIdx.x; t < T_TOK; t += gridDim.x) {
#pragma unroll
    for (int pass = 0; pass < 2; ++pass) {
      int c = tid + pass * 256;
      size_t o = (size_t)t * 512 + c;
      float y = YS[o];
      float mean = wave_sum(y) * (1.f / 64.f);
      float d = y - mean;
      float var = wave_sum(d * d) * (1.f / 64.f);
      float yn = d * rsqrtf(var + GN_EPS_F) * lnx_g[c] + lnx_b[c];
      float res = (yn + SB[(size_t)t * 8 + (c >> 6)] * bf2f(V2[o])) * bf2f(G[o]);
      MIXED[(size_t)t * 1024 + 512 + c] = f2bf(res);
      {
        const int hh = c >> 6;
        const float l0 = LSE[((size_t)0 * T_TOK + t) * 8 + hh], l1 = LSE[((size_t)1 * T_TOK + t) * 8 + hh], l2 = LSE[((size_t)2 * T_TOK + t) * 8 + hh];
        const float mx = fmaxf(l0, fmaxf(l1, l2));
        const float e0 = __expf(l0 - mx), e1 = __expf(l1 - mx), e2 = __expf(l2 - mx);
        const float inv = 1.f / (e0 + e1 + e2);
        const float av = (e0 * bf2f(OP[(size_t)0 * T_TOK * 512 + o]) + e1 * bf2f(OP[(size_t)1 * T_TOK * 512 + o]) + e2 * bf2f(OP[(size_t)2 * T_TOK * 512 + o])) * inv;
        MIXED[(size_t)t * 1024 + c] = f2bf(av);
      }
    }
  }
}

__device__ __forceinline__ void phase_outproj(const Params& p, char* smem) {
  const bf16_t* __restrict__ MIXED = (const bf16_t*)(p.ws + OFF_MIXED);
  const float* __restrict__ w_out = p.in[13]; const float* __restrict__ x = p.in[0];
  float* U = p.out;
  for (int item = blockIdx.x; item < (T_TOK / 128) * 8; item += gridDim.x) {
    const int row0 = (item >> 3) * 128, col0 = (item & 7) * 128;
    gemm128(smem, DM,
            [=](int r) { return MIXED + (size_t)(row0 + r) * DM; },
            [=](int nq) { return w_out + col0 + nq * 4; },
            DM,
            [=](f32x4 (&acc)[4][4], int wr, int wc, int fr, int fq) {
#pragma unroll
              for (int m = 0; m < 4; ++m)
#pragma unroll
                for (int j = 0; j < 4; ++j) {
                  const int t = row0 + wr * 64 + m * 16 + fq * 4 + j;
#pragma unroll
                  for (int n = 0; n < 4; ++n) {
                    size_t o = (size_t)t * DM + col0 + wc * 64 + n * 16 + fr;
                    U[o] = ALPHA_F * x[o] + acc[m][n][j];
                  }
                }
            });
  }
}

__device__ __forceinline__ void phase_ln1(const Params& p) {
  float* X1 = p.out;
  const float* __restrict__ g1 = p.in[14]; const float* __restrict__ b1 = p.in[15];
  bf16_t* X1B = (bf16_t*)(p.ws + OFF_X1B); bf16_t* XL = (bf16_t*)(p.ws + OFF_XL);
  const int lane = threadIdx.x & 63, wid = threadIdx.x >> 6;
  for (int t = blockIdx.x * 4 + wid; t < T_TOK; t += gridDim.x * 4) {
    const size_t base = (size_t)t * DM;
    float4 v[4];
    float s = 0.f;
#pragma unroll
    for (int u = 0; u < 4; ++u) { v[u] = *(const float4*)(X1 + base + u * 256 + lane * 4); s += (v[u].x + v[u].y) + (v[u].z + v[u].w); }
    const float mean = wave_sum_fast(s) * (1.f / DM);
    float q = 0.f;
#pragma unroll
    for (int u = 0; u < 4; ++u) {
      const float d0 = v[u].x - mean, d1 = v[u].y - mean, d2 = v[u].z - mean, d3 = v[u].w - mean;
      q += (d0 * d0 + d1 * d1) + (d2 * d2 + d3 * d3);
    }
    const float rs = rsqrtf(wave_sum_fast(q) * (1.f / DM) + LN_EPS_F);
#pragma unroll
    for (int u = 0; u < 4; ++u) {
      const int c = u * 256 + lane * 4;
      const float4 g = *(const float4*)(g1 + c), bb = *(const float4*)(b1 + c);
      float4 y;
      y.x = (v[u].x - mean) * rs * g.x + bb.x; y.y = (v[u].y - mean) * rs * g.y + bb.y;
      y.z = (v[u].z - mean) * rs * g.z + bb.z; y.w = (v[u].w - mean) * rs * g.w + bb.w;
      *(float4*)(X1 + base + c) = y;
      uint2 hi; hi.x = cvtpk(y.x, y.y); hi.y = cvtpk(y.z, y.w);
      *(uint2*)(X1B + base + c) = hi;
      uint2 lo;
      lo.x = cvtpk(y.x - __uint_as_float(hi.x << 16), y.y - __uint_as_float(hi.x & 0xffff0000u));
      lo.y = cvtpk(y.z - __uint_as_float(hi.y << 16), y.w - __uint_as_float(hi.y & 0xffff0000u));
      *(uint2*)(XL + base + c) = lo;
    }
  }
}

__device__ __forceinline__ void phase_router_gemm(const Params& p, char* smem) {
  const bf16_t* __restrict__ X1B = (const bf16_t*)(p.ws + OFF_X1B); const bf16_t* __restrict__ XL = (const bf16_t*)(p.ws + OFF_XL);
  const float* __restrict__ router_w = p.in[16];
  float* AFF = (float*)(p.ws + OFF_AFF);
  for (int item = blockIdx.x; item < (T_TOK / 128) * 2; item += gridDim.x) {
    const int row0 = (item >> 1) * 128, col0 = (item & 1) * 128;
    f32x4 acc[4][4];
    acc_zero(acc);
    auto ah = [=](int, int rowl, int kc) { return *(const uint4*)(X1B + (size_t)(row0 + rowl) * DM + kc * 8); };
    auto al = [=](int, int rowl, int kc) { return *(const uint4*)(XL + (size_t)(row0 + rowl) * DM + kc * 8); };
    auto bp = [=](int nq) { return router_w + col0 + nq * 4; };
    gemm128_acc<0, false>(acc, smem, 16, ah, bp, NEXP, 0);
    gemm128_acc<0, false>(acc, smem, 16, al, bp, NEXP, 0);
    gemm128_acc<1, false>(acc, smem, 16, ah, bp, NEXP, 0);
    const int tid = threadIdx.x, lane = tid & 63, wid = tid >> 6;
    const int wr = wid >> 1, wc = wid & 1, fr = lane & 15, fq = lane >> 4;
#pragma unroll
    for (int m = 0; m < 4; ++m)
#pragma unroll
      for (int j = 0; j < 4; ++j) {
        const int t = row0 + wr * 64 + m * 16 + fq * 4 + j;
#pragma unroll
        for (int n = 0; n < 4; ++n) AFF[(size_t)t * NEXP + col0 + wc * 64 + n * 16 + fr] = sigmoidf_(acc[m][n][j]);
      }
  }
}

__device__ __forceinline__ void phase_topk(const Params& p) {
  const float* __restrict__ AFF = (const float*)(p.ws + OFF_AFF);
  const float* __restrict__ router_bias = p.in[17];
  int* LIST = (int*)(p.ws + OFF_LIST); float* GATEW = (float*)(p.ws + OFF_GATEW);
  int* counts = (int*)(p.ws + OFF_CTL);
  const int lane = threadIdx.x & 63, wid = threadIdx.x >> 6;
  const float4 b4 = *(const float4*)(router_bias + lane * 4);
  for (int t = blockIdx.x * 4 + wid; t < T_TOK; t += gridDim.x * 4) {
    const float4 a4 = *(const float4*)(AFF + (size_t)t * NEXP + lane * 4);
    float s0 = a4.x + b4.x, s1 = a4.y + b4.y, s2 = a4.z + b4.z, s3 = a4.w + b4.w;
    const float hi01 = fmaxf(s0, s1), lo01 = fminf(s0, s1), hi23 = fmaxf(s2, s3), lo23 = fminf(s2, s3);
    float m1 = fmaxf(hi01, hi23), m2 = fmaxf(fminf(hi01, hi23), fmaxf(lo01, lo23));
    { const float o1 = DPP_F(m1, 0xB1), o2 = DPP_F(m2, 0xB1); const float n1 = fmaxf(m1, o1); m2 = fmaxf(fminf(m1, o1), fmaxf(m2, o2)); m1 = n1; }
    { const float o1 = DPP_F(m1, 0x4E), o2 = DPP_F(m2, 0x4E); const float n1 = fmaxf(m1, o1); m2 = fmaxf(fminf(m1, o1), fmaxf(m2, o2)); m1 = n1; }
    { const float o1 = DPP_F(m1, 0x141), o2 = DPP_F(m2, 0x141); const float n1 = fmaxf(m1, o1); m2 = fmaxf(fminf(m1, o1), fmaxf(m2, o2)); m1 = n1; }
    const float gs = m1 + m2;
    const int g = lane >> 3;
    int rank = 0;
#pragma unroll
    for (int gg = 0; gg < 8; ++gg) { const float G = rdlane_f(gs, gg * 8); rank += ((G > gs) || (G == gs && gg < g)) ? 1 : 0; }
    if (rank >= 4) { s0 = -INFINITY; s1 = -INFINITY; s2 = -INFINITY; s3 = -INFINITY; }
    int my_e = 0; float my_a = 0.f;
#pragma unroll 1
    for (int it = 0; it < 8; ++it) {
      const float lm = fmaxf(fmaxf(s0, s1), fmaxf(s2, s3));
      const float wm = wave_max_fast(lm);
      const unsigned long long bal = __ballot(lm == wm);
      const int win = __ffsll((long long)bal) - 1;
      const int wi = (s0 == wm) ? 0 : ((s1 == wm) ? 1 : ((s2 == wm) ? 2 : 3));
      const float wa = (wi == 0) ? a4.x : ((wi == 1) ? a4.y : ((wi == 2) ? a4.z : a4.w));
      const int e_w = __builtin_amdgcn_readlane(lane * 4 + wi, win);
      const float a_w = rdlane_f(wa, win);
      if (lane == win) { if (wi == 0) s0 = -INFINITY; else if (wi == 1) s1 = -INFINITY; else if (wi == 2) s2 = -INFINITY; else s3 = -INFINITY; }
      if (lane == it) { my_e = e_w; my_a = a_w; }
    }
    const float asum = rdlane_f(dpp_sum16x(my_a), 0);
    if (lane < 8) {
      const int pos = atomicAdd(&counts[my_e], 1);
      LIST[(size_t)my_e * T_TOK + pos] = lane * T_TOK + t;
      GATEW[(size_t)lane * T_TOK + t] = my_a * 2.5f / asum;
    }
  }
}

__device__ __forceinline__ void moe_prefix(const int* counts, int* pre) {
  if (threadIdx.x == 0) {
    int acc = 0;
    for (int e = 0; e <= NEXP; ++e) { pre[e] = acc; int c = (e < NEXP) ? counts[e] : T_TOK; acc += (c + 127) >> 7; }
    pre[NEXP + 1] = acc;
  }
  __syncthreads();
}
__device__ __forceinline__ int moe_find(const int* pre, int ti) {
  int lo = 0, hi = NEXP;
  while (lo < hi) { int mid = (lo + hi + 1) >> 1; if (pre[mid] <= ti) lo = mid; else hi = mid - 1; }
  return lo;
}

__device__ __forceinline__ void phase_moe1(const Params& p, char* smem) {
  int* asg = (int*)(smem + 32768); int* pre = asg + 128;
  const bf16_t* __restrict__ X1B = (const bf16_t*)(p.ws + OFF_X1B);
  const int* __restrict__ LIST = (const int*)(p.ws + OFF_LIST);
  const int* counts = (const int*)(p.ws + OFF_CTL);
  bf16_t* H = (bf16_t*)(p.ws + OFF_H);
  moe_prefix(counts, pre);
  const int ntiles = pre[NEXP + 1];
  for (int item = blockIdx.x; item < ntiles * 4; item += gridDim.x) {
    const int ti = item >> 2, nt = item & 3;
    const int e = moe_find(pre, ti);
    const int r0 = (ti - pre[e]) * 128;
    const int cnt = (e < NEXP) ? counts[e] : T_TOK;
    __syncthreads();
    if (threadIdx.x < 128) {
      int r = r0 + threadIdx.x;
      asg[threadIdx.x] = (r < cnt) ? ((e < NEXP) ? LIST[(size_t)e * T_TOK + r] : (8 * T_TOK + r)) : -1;
    }
    __syncthreads();
    const float* __restrict__ Wg = (e < NEXP) ? p.in[18] + (size_t)e * DM * 256 : p.in[21];
    const float* __restrict__ Wu = (e < NEXP) ? p.in[19] + (size_t)e * DM * 256 : p.in[22];
    gemm128(smem, DM,
            [=](int r) { int a = asg[r]; return X1B + (size_t)((a >= 0 ? a : 0) & (T_TOK - 1)) * DM; },
            [=](int nq) { const long long dlt = ((nq >> 2) & 2) ? (long long)(Wu - Wg) : 0ll; return Wg + dlt + nt * 64 + (nq >> 4) * 32 + ((nq >> 2) & 1) * 16 + (nq & 3) * 4; },
            256,
            [=](f32x4 (&acc)[4][4], int wr, int wc, int fr, int fq) {
#pragma unroll
              for (int m = 0; m < 4; ++m)
#pragma unroll
                for (int j = 0; j < 4; ++j) {
                  const int a = asg[wr * 64 + m * 16 + fq * 4 + j];
                  if (a < 0) continue;
#pragma unroll
                  for (int n = 0; n < 2; ++n) {
                    float g = acc[m][n][j], u = acc[m][n + 2][j];
                    H[(size_t)a * 256 + nt * 64 + wc * 32 + n * 16 + fr] = f2bf(g * sigmoidf_(g) * u);
                  }
                }
            });
  }
}

__device__ __forceinline__ void phase_moe2(const Params& p, char* smem) {
  int* asg = (int*)(smem + 32768); int* pre = asg + 128;
  const bf16_t* __restrict__ H = (const bf16_t*)(p.ws + OFF_H);
  const int* __restrict__ LIST = (const int*)(p.ws + OFF_LIST);
  const float* __restrict__ GATEW = (const float*)(p.ws + OFF_GATEW);
  const int* counts = (const int*)(p.ws + OFF_CTL);
  bf16_t* Y = (bf16_t*)(p.ws + OFF_Y);
  moe_prefix(counts, pre);
  const int ntiles = pre[NEXP + 1];
  for (int item = blockIdx.x; item < ntiles * 8; item += gridDim.x) {
    const int ti = item >> 3, nt = item & 7;
    const int e = moe_find(pre, ti);
    const int r0 = (ti - pre[e]) * 128;
    const int cnt = (e < NEXP) ? counts[e] : T_TOK;
    __syncthreads();
    if (threadIdx.x < 128) {
      int r = r0 + threadIdx.x;
      asg[threadIdx.x] = (r < cnt) ? ((e < NEXP) ? LIST[(size_t)e * T_TOK + r] : (8 * T_TOK + r)) : -1;
    }
    __syncthreads();
    const float* __restrict__ Wd = (e < NEXP) ? p.in[20] + (size_t)e * 256 * DM : p.in[23];
    gemm128(smem, 256,
            [=](int r) { int a = asg[r]; return H + (size_t)(a >= 0 ? a : 0) * 256; },
            [=](int nq) { return Wd + nt * 128 + nq * 4; },
            DM,
            [=](f32x4 (&acc)[4][4], int wr, int wc, int fr, int fq) {
#pragma unroll
              for (int m = 0; m < 4; ++m)
#pragma unroll
                for (int j = 0; j < 4; ++j) {
                  const int a = asg[wr * 64 + m * 16 + fq * 4 + j];
                  if (a < 0) continue;
                  const float gw = (a < 8 * T_TOK) ? GATEW[a] : 1.f;
#pragma unroll
                  for (int n = 0; n < 4; ++n) Y[(size_t)a * DM + nt * 128 + wc * 64 + n * 16 + fr] = f2bf(acc[m][n][j] * gw);
                }
            });
  }
}

__device__ __forceinline__ void phase_final(const Params& p, char* smem) {
  float* red = (float*)smem;
  float* OUT = p.out;
  const bf16_t* __restrict__ Y = (const bf16_t*)(p.ws + OFF_Y);
  const float* __restrict__ g2 = p.in[24]; const float* __restrict__ b2 = p.in[25];
  const int tid = threadIdx.x, lane = tid & 63, wid = tid >> 6;
  for (int t = blockIdx.x; t < T_TOK; t += gridDim.x) {
    size_t base = (size_t)t * DM;
    float v[4];
    float s = 0.f;
#pragma unroll
    for (int u = 0; u < 4; ++u) {
      int c = tid + u * 256;
      float acc = 0.f;
#pragma unroll
      for (int sl = 0; sl < 9; ++sl) acc += bf2f(Y[((size_t)sl * T_TOK + t) * DM + c]);
      v[u] = ALPHA_F * OUT[base + c] + acc;
      s += v[u];
    }
    s = wave_sum(s);
    if (lane == 0) red[wid] = s;
    __syncthreads();
    float mean = (red[0] + red[1] + red[2] + red[3]) * (1.f / DM);
    float q = 0.f;
#pragma unroll
    for (int u = 0; u < 4; ++u) { float d = v[u] - mean; q += d * d; }
    q = wave_sum(q);
    if (lane == 0) red[4 + wid] = q;
    __syncthreads();
    float var = (red[4] + red[5] + red[6] + red[7]) * (1.f / DM);
    float rs = rsqrtf(var + LN_EPS_F);
#pragma unroll
    for (int u = 0; u < 4; ++u) {
      int c = tid + u * 256;
      OUT[base + c] = (v[u] - mean) * rs * g2[c] + b2[c];
    }
    __syncthreads();
  }
}

__global__ void __launch_bounds__(NTHR, 2) mega(Params p) {
  extern __shared__ __attribute__((aligned(16))) char smem[];
  cg::grid_group grid = cg::this_grid();
  phase_rope(p);
  grid.sync();
  phase_inproj(p, smem);
  grid.sync();
  phase_prep(p, smem);
  grid.sync();
  phase_scan(p, smem);
  phase_attn(p, smem);
  grid.sync();
  phase_post(p);
  grid.sync();
  phase_outproj(p, smem);
  grid.sync();
  phase_ln1(p);
  grid.sync();
  phase_router_gemm(p, smem);
  grid.sync();
  phase_topk(p);
  grid.sync();
  phase_moe1(p, smem);
  grid.sync();
  phase_moe2(p, smem);
  grid.sync();
  phase_final(p, smem);
}

extern "C" void kernel_launch(void* const* d_in, const int* in_sizes, int n_in, void* d_out, int out_size, void* d_ws, size_t ws_size,
                              hipStream_t stream) {
  static int grid_blocks = 0;
  if (grid_blocks == 0) {
    if (ws_size < WS_NEED || n_in != 26) { fprintf(stderr, "kernel_launch: bad ws/n_in: %zu < %zu, n_in %d\n", ws_size, (size_t)WS_NEED, n_in); grid_blocks = -1; return; }
    int dev = 0, cus = 0, per_cu = 0;
    (void)hipGetDevice(&dev);
    (void)hipDeviceGetAttribute(&cus, hipDeviceAttributeMultiprocessorCount, dev);
    (void)hipFuncSetAttribute((const void*)mega, hipFuncAttributeMaxDynamicSharedMemorySize, LDS_BYTES);
    (void)hipOccupancyMaxActiveBlocksPerMultiprocessor(&per_cu, (const void*)mega, NTHR, LDS_BYTES);
    if (per_cu < 1) { fprintf(stderr, "kernel_launch: occupancy query returned %d\n", per_cu); grid_blocks = -1; return; }
    if (per_cu > 2) per_cu = 2;
    grid_blocks = cus * per_cu;
    fprintf(stderr, "kernel_launch: cus %d per_cu %d grid %d\n", cus, per_cu, grid_blocks);
  }
  if (grid_blocks < 0) return;
  Params p{};
  for (int i = 0; i < 26; ++i) p.in[i] = (const float*)d_in[i];
  p.out = (float*)d_out;
  p.ws = (char*)d_ws;
  void* args[] = {&p};
  hipError_t e = hipLaunchCooperativeKernel((const void*)mega, dim3(grid_blocks), dim3(NTHR), args, LDS_BYTES, stream);
  if (e != hipSuccess) fprintf(stderr, "cooperative launch failed: %s (grid %d)\n", hipGetErrorString(e), grid_blocks);
}
```

```cpp
#include <hip/hip_runtime.h>
#include <hip/hip_bf16.h>
#include <hip/hip_cooperative_groups.h>
#include <stdint.h>
#include <stdio.h>

typedef unsigned short bf16_t;

#define T_TOK 32768
#define SEQ 4096
#define DM 1024
#define INW 3360
#define FEW 1824
#define NEXP 256
#define ALPHA_F 1.189207115002721f
#define LN_EPS_F 1e-5f
#define GN_EPS_F 64e-5f

__device__ __forceinline__ float bf2f(bf16_t v) { return __uint_as_float(((unsigned)v) << 16); }
__device__ __forceinline__ bf16_t f2bf(float f) { unsigned u = __float_as_uint(f); return (bf16_t)((u + 0x7fffu + ((u >> 16) & 1u)) >> 16); }
__device__ __forceinline__ float sigmoidf_(float x) { return 1.f / (1.f + __expf(-x)); }
__device__ __forceinline__ float wave_sum(float v) {
#pragma unroll
  for (int o = 32; o >= 1; o >>= 1) v += __shfl_xor(v, o, 64);
  return v;
}

constexpr size_t SZ_T512_BF = (size_t)T_TOK * 512 * 2;
constexpr size_t OFF_Q = 0;
constexpr size_t OFF_K = OFF_Q + SZ_T512_BF;
constexpr size_t OFF_V = OFF_K + SZ_T512_BF;
constexpr size_t OFF_FEATS = OFF_V + SZ_T512_BF;
constexpr size_t OFF_R = OFF_FEATS + (size_t)T_TOK * FEW * 2;
constexpr size_t OFF_K2 = OFF_R + SZ_T512_BF;
constexpr size_t OFF_V2 = OFF_K2 + SZ_T512_BF;
constexpr size_t OFF_A = OFF_V2 + SZ_T512_BF;
constexpr size_t OFF_B = OFF_A + SZ_T512_BF;
constexpr size_t OFF_W = OFF_B + SZ_T512_BF;
constexpr size_t OFF_G = OFF_W + (size_t)T_TOK * 512 * 4;
constexpr size_t OFF_SB = OFF_G + SZ_T512_BF;
constexpr size_t OFF_YS = OFF_SB + (size_t)T_TOK * 8 * 4;
constexpr size_t OFF_OP = OFF_YS + (size_t)T_TOK * 512 * 4;
constexpr size_t OFF_LSE = OFF_OP + 3 * SZ_T512_BF;
constexpr size_t OFF_MIXED = OFF_LSE + (size_t)3 * T_TOK * 8 * 4;
constexpr size_t OFF_ROPE = OFF_MIXED + (size_t)T_TOK * 1024 * 2;
constexpr size_t EARLY_END = OFF_ROPE + (size_t)4096 * 32 * 2 * 4;
constexpr size_t OFF_Y = 0;
constexpr size_t OFF_H = OFF_Y + (size_t)9 * T_TOK * 1024 * 2;
constexpr size_t OFF_X1B = OFF_H + (size_t)9 * T_TOK * 256 * 2;
constexpr size_t OFF_LIST = OFF_X1B + (size_t)T_TOK * 1024 * 2;
constexpr size_t OFF_GATEW = OFF_LIST + (size_t)NEXP * T_TOK * 4;
constexpr size_t OFF_CTL = OFF_GATEW + (size_t)8 * T_TOK * 4;
constexpr size_t CTL_BYTES = 1u << 20;
constexpr size_t WS_NEED = OFF_CTL + CTL_BYTES;
static_assert(EARLY_END <= OFF_X1B, "early buffers must not overlap X1B");
#define MAXTILES 4864
constexpr size_t OFF_XL = 0;
constexpr size_t OFF_AFF = (size_t)T_TOK * 1024 * 2;
constexpr size_t OFF_XB = OFF_X1B;

typedef short bf16x8 __attribute__((ext_vector_type(8)));
typedef float f32x4 __attribute__((ext_vector_type(4)));
typedef float f32x16 __attribute__((ext_vector_type(16)));
typedef float f32x2_t __attribute__((ext_vector_type(2)));
typedef __bf16 bf16x2_t __attribute__((ext_vector_type(2)));
__device__ __forceinline__ unsigned cvtpk(float lo, float hi) { f32x2_t v = {lo, hi}; bf16x2_t b = __builtin_convertvector(v, bf16x2_t); return __builtin_bit_cast(unsigned, b); }

__device__ const double INVF[32] = {
1, 0.74989420933245587, 0.56234132519034907, 0.42169650342858223, 0.31622776601683794, 0.23713737056616552,
0.17782794100389229, 0.1333521432163324, 0.10000000000000001, 0.074989420933245579, 0.056234132519034911,
0.042169650342858224, 0.031622776601683791, 0.023713737056616554, 0.017782794100389229, 0.013335214321633241,
0.01, 0.0074989420933245579, 0.005623413251903491, 0.0042169650342858229, 0.0031622776601683794,
0.0023713737056616554, 0.0017782794100389228, 0.0013335214321633241, 0.001, 0.00074989420933245586,
0.0005623413251903491, 0.00042169650342858224, 0.00031622776601683794, 0.00023713737056616554,
0.00017782794100389227, 0.0001333521432163324};

namespace cg = cooperative_groups;

struct Params {
  const float* in[26];
  float* out;
  char* ws;
};

#define NTHR 256
#define LDS_BYTES 66560

__device__ __forceinline__ void phase_rope(const Params& p) {
  float* tab = (float*)(p.ws + OFF_ROPE);
  for (int i = blockIdx.x * NTHR + threadIdx.x; i < 4096 * 32; i += gridDim.x * NTHR) {
    int pos = i >> 5, f = i & 31;
    double ang = (double)pos * INVF[f];
    const double TWO_PI = 6.283185307179586476925286766559;
    double n = rint(ang / TWO_PI);
    double r = ang - n * TWO_PI;
    double r2 = r * r;
    double sn = r, cs = 1.0, ts = r, tc = 1.0;
#pragma unroll 1
    for (int k = 1; k <= 16; ++k) {
      tc = -tc * r2 / (double)((2 * k - 1) * (2 * k));
      ts = -ts * r2 / (double)((2 * k) * (2 * k + 1));
      cs += tc; sn += ts;
    }
    tab[i * 2] = (float)cs; tab[i * 2 + 1] = (float)sn;
  }
  {
    const float4* __restrict__ x4 = (const float4*)p.in[0];
    uint4* xb = (uint4*)(p.ws + OFF_XB);
    for (size_t i = (size_t)blockIdx.x * NTHR + threadIdx.x; i < (size_t)T_TOK * DM / 8; i += (size_t)gridDim.x * NTHR) {
      float4 a = x4[2 * i], b = x4[2 * i + 1];
      uint4 w; w.x = cvtpk(a.x, a.y); w.y = cvtpk(a.z, a.w); w.z = cvtpk(b.x, b.y); w.w = cvtpk(b.z, b.w);
      xb[i] = w;
    }
  }
}

template <class AF, class BF>
__device__ __forceinline__ void gemm64_naive(float* As, float* Bs, float* Cs, int K, AF af, BF bf) {
  const int tid = threadIdx.x, tx = tid & 15, ty = tid >> 4;
  float acc[4][4];
#pragma unroll
  for (int i = 0; i < 4; ++i)
#pragma unroll
    for (int j = 0; j < 4; ++j) acc[i][j] = 0.f;
  for (int k0 = 0; k0 < K; k0 += 16) {
#pragma unroll
    for (int u = 0; u < 4; ++u) { int i = tid + u * 256; int r = i >> 4, kk = i & 15; As[kk * 68 + r] = af(r, k0 + kk); }
#pragma unroll
    for (int u = 0; u < 4; ++u) { int i = tid + u * 256; int kk = i >> 6, c = i & 63; Bs[kk * 68 + c] = bf(k0 + kk, c); }
    __syncthreads();
#pragma unroll
    for (int kk = 0; kk < 16; ++kk) {
      float a[4], b[4];
#pragma unroll
      for (int i = 0; i < 4; ++i) { a[i] = As[kk * 68 + ty * 4 + i]; b[i] = Bs[kk * 68 + tx * 4 + i]; }
#pragma unroll
      for (int i = 0; i < 4; ++i)
#pragma unroll
        for (int j = 0; j < 4; ++j) acc[i][j] += a[i] * b[j];
    }
    __syncthreads();
  }
#pragma unroll
  for (int i = 0; i < 4; ++i)
#pragma unroll
    for (int j = 0; j < 4; ++j) Cs[(ty * 4 + i) * 65 + tx * 4 + j] = acc[i][j];
  __syncthreads();
}


__device__ __forceinline__ int lds_off(int row, int chunk) { return row * 128 + ((chunk ^ ((row >> 1) & 7)) << 4); }

template <int BMODE>
__device__ __forceinline__ unsigned cvtpk_m(float a, float b) {
  if (BMODE == 0) return cvtpk(a, b);
  const unsigned h = cvtpk(a, b);
  const float ah = __uint_as_float(h << 16), bh = __uint_as_float(h & 0xffff0000u);
  return cvtpk(a - ah, b - bh);
}
template <int BMODE, bool KCLAMP, class ALoad, class BPtr>
__device__ __forceinline__ void gemm128_acc(f32x4 (&acc)[4][4], char* smem, const int nk, ALoad aload, BPtr bptr, const int ldb, const int kvalid) {
  const int tid = threadIdx.x, lane = tid & 63, wid = tid >> 6;
  const int wr = wid >> 1, wc = wid & 1, fr = lane & 15, fq = lane >> 4;
  const int achunk = tid & 7, arow0 = tid >> 3;
  const int nq = tid & 31, ko = tid >> 5;
  const float* bp0 = bptr(nq);
  char* const la0 = smem + lds_off(arow0, achunk);
  char* const la1 = smem + lds_off(arow0 + 32, achunk);
  char* const la2 = smem + lds_off(arow0 + 64, achunk);
  char* const la3 = smem + lds_off(arow0 + 96, achunk);
  char* const lb0 = smem + 16384 + lds_off(nq * 4 + 0, ko);
  char* const lb1 = smem + 16384 + lds_off(nq * 4 + 1, ko);
  char* const lb2 = smem + 16384 + lds_off(nq * 4 + 2, ko);
  char* const lb3 = smem + 16384 + lds_off(nq * 4 + 3, ko);
  uint4 ra0, ra1, ra2, ra3; float4 rb0, rb1, rb2, rb3, rb4, rb5, rb6, rb7;
#define G128_LOAD(kt) { \
    ra0 = aload(0, arow0, (kt) * 8 + achunk); ra1 = aload(1, arow0 + 32, (kt) * 8 + achunk); \
    ra2 = aload(2, arow0 + 64, (kt) * 8 + achunk); ra3 = aload(3, arow0 + 96, (kt) * 8 + achunk); \
    const int kr_ = (kt) * 64 + ko * 8; \
    if (KCLAMP) { \
      rb0 = *(const float4*)(bp0 + (size_t)min(kr_ + 0, kvalid - 1) * ldb); rb1 = *(const float4*)(bp0 + (size_t)min(kr_ + 1, kvalid - 1) * ldb); \
      rb2 = *(const float4*)(bp0 + (size_t)min(kr_ + 2, kvalid - 1) * ldb); rb3 = *(const float4*)(bp0 + (size_t)min(kr_ + 3, kvalid - 1) * ldb); \
      rb4 = *(const float4*)(bp0 + (size_t)min(kr_ + 4, kvalid - 1) * ldb); rb5 = *(const float4*)(bp0 + (size_t)min(kr_ + 5, kvalid - 1) * ldb); \
      rb6 = *(const float4*)(bp0 + (size_t)min(kr_ + 6, kvalid - 1) * ldb); rb7 = *(const float4*)(bp0 + (size_t)min(kr_ + 7, kvalid - 1) * ldb); \
    } else { \
      const float* b2_ = bp0 + (size_t)kr_ * ldb; \
      rb0 = *(const float4*)(b2_); rb1 = *(const float4*)(b2_ + (size_t)1 * ldb); rb2 = *(const float4*)(b2_ + (size_t)2 * ldb); \
      rb3 = *(const float4*)(b2_ + (size_t)3 * ldb); rb4 = *(const float4*)(b2_ + (size_t)4 * ldb); rb5 = *(const float4*)(b2_ + (size_t)5 * ldb); \
      rb6 = *(const float4*)(b2_ + (size_t)6 * ldb); rb7 = *(const float4*)(b2_ + (size_t)7 * ldb); \
    } }
  G128_LOAD(0)
  for (int kt = 0; kt < nk; ++kt) {
    __syncthreads();
    *(uint4*)la0 = ra0; *(uint4*)la1 = ra1; *(uint4*)la2 = ra2; *(uint4*)la3 = ra3;
    {
      uint4 w;
      w.x = cvtpk_m<BMODE>(rb0.x, rb1.x); w.y = cvtpk_m<BMODE>(rb2.x, rb3.x); w.z = cvtpk_m<BMODE>(rb4.x, rb5.x); w.w = cvtpk_m<BMODE>(rb6.x, rb7.x);
      *(uint4*)lb0 = w;
      w.x = cvtpk_m<BMODE>(rb0.y, rb1.y); w.y = cvtpk_m<BMODE>(rb2.y, rb3.y); w.z = cvtpk_m<BMODE>(rb4.y, rb5.y); w.w = cvtpk_m<BMODE>(rb6.y, rb7.y);
      *(uint4*)lb1 = w;
      w.x = cvtpk_m<BMODE>(rb0.z, rb1.z); w.y = cvtpk_m<BMODE>(rb2.z, rb3.z); w.z = cvtpk_m<BMODE>(rb4.z, rb5.z); w.w = cvtpk_m<BMODE>(rb6.z, rb7.z);
      *(uint4*)lb2 = w;
      w.x = cvtpk_m<BMODE>(rb0.w, rb1.w); w.y = cvtpk_m<BMODE>(rb2.w, rb3.w); w.z = cvtpk_m<BMODE>(rb4.w, rb5.w); w.w = cvtpk_m<BMODE>(rb6.w, rb7.w);
      *(uint4*)lb3 = w;
    }
    __syncthreads();
    if (kt + 1 < nk) G128_LOAD(kt + 1)
#pragma unroll
    for (int kk = 0; kk < 2; ++kk) {
      bf16x8 af[4], bfr[4];
#pragma unroll
      for (int m = 0; m < 4; ++m) af[m] = *(const bf16x8*)(smem + lds_off(wr * 64 + m * 16 + fr, kk * 4 + fq));
#pragma unroll
      for (int n = 0; n < 4; ++n) bfr[n] = *(const bf16x8*)(smem + 16384 + lds_off(wc * 64 + n * 16 + fr, kk * 4 + fq));
#pragma unroll
      for (int m = 0; m < 4; ++m)
#pragma unroll
        for (int n = 0; n < 4; ++n) acc[m][n] = __builtin_amdgcn_mfma_f32_16x16x32_bf16(bfr[n], af[m], acc[m][n], 0, 0, 0);
    }
  }
#undef G128_LOAD
}
__device__ __forceinline__ void acc_zero(f32x4 (&acc)[4][4]) {
#pragma unroll
  for (int m = 0; m < 4; ++m)
#pragma unroll
    for (int n = 0; n < 4; ++n) acc[m][n] = (f32x4){0.f, 0.f, 0.f, 0.f};
}
template <class ARow, class BPtr, class Epi>
__device__ __forceinline__ void gemm128(char* smem, const int K, ARow arow, BPtr bptr, const int ldb, Epi epi) {
  const int tid = threadIdx.x, lane = tid & 63, wid = tid >> 6;
  const int arow0 = tid >> 3;
  const bf16_t* ap0 = arow(arow0);
  const bf16_t* ap1 = arow(arow0 + 32);
  const bf16_t* ap2 = arow(arow0 + 64);
  const bf16_t* ap3 = arow(arow0 + 96);
  f32x4 acc[4][4];
  acc_zero(acc);
  gemm128_acc<0, false>(acc, smem, K >> 6,
      [=](int u, int, int kc) { const bf16_t* q = (u == 0) ? ap0 : (u == 1) ? ap1 : (u == 2) ? ap2 : ap3; return *(const uint4*)(q + kc * 8); },
      bptr, ldb, 0);
  epi(acc, wid >> 1, wid & 1, lane & 15, lane >> 4);
}


#define DPP_F(v, ctrl) __builtin_bit_cast(float, __builtin_amdgcn_update_dpp(0, __builtin_bit_cast(int, (v)), (ctrl), 0xF, 0xF, true))
__device__ __forceinline__ float rdlane_f(float v, int l) { return __builtin_bit_cast(float, __builtin_amdgcn_readlane(__builtin_bit_cast(int, v), l)); }
__device__ __forceinline__ float dpp_sum16x(float v) {
  v += DPP_F(v, 0xB1); v += DPP_F(v, 0x4E); v += DPP_F(v, 0x141); v += DPP_F(v, 0x140);
  return v;
}
__device__ __forceinline__ float dpp_max16x(float v) {
  v = fmaxf(v, DPP_F(v, 0xB1)); v = fmaxf(v, DPP_F(v, 0x4E)); v = fmaxf(v, DPP_F(v, 0x141)); v = fmaxf(v, DPP_F(v, 0x140));
  return v;
}
__device__ __forceinline__ float wave_sum_fast(float v) {
  v = dpp_sum16x(v);
  return (rdlane_f(v, 0) + rdlane_f(v, 16)) + (rdlane_f(v, 32) + rdlane_f(v, 48));
}
__device__ __forceinline__ float wave_max_fast(float v) {
  v = dpp_max16x(v);
  return fmaxf(fmaxf(rdlane_f(v, 0), rdlane_f(v, 16)), fmaxf(rdlane_f(v, 32), rdlane_f(v, 48)));
}
__device__ __forceinline__ float fast_tanh(float x) { const float e = __expf(2.f * x); return 1.f - 2.f / (e + 1.f); }


__device__ __forceinline__ float4 bf4_to_f4(uint2 u) {
  float4 r;
  r.x = __uint_as_float(u.x << 16); r.y = __uint_as_float(u.x & 0xffff0000u);
  r.z = __uint_as_float(u.y << 16); r.w = __uint_as_float(u.y & 0xffff0000u);
  return r;
}
__device__ __forceinline__ uint2 pack4(float a, float b, float c, float d) { uint2 r; r.x = cvtpk(a, b); r.y = cvtpk(c, d); return r; }
#define XCD_GROUP (blockIdx.x & 7)
#define XCD_LB (blockIdx.x >> 3)
#define XCD_NB ((gridDim.x + 7 - (blockIdx.x & 7)) >> 3)

__device__ __forceinline__ void phase_inproj(const Params& p, char* smem) {
  const bf16_t* __restrict__ XB = (const bf16_t*)(p.ws + OFF_XB);
  const float* __restrict__ w_in = p.in[1];
  const float* __restrict__ rope = (const float*)(p.ws + OFF_ROPE);
  bf16_t* Q = (bf16_t*)(p.ws + OFF_Q); bf16_t* K = (bf16_t*)(p.ws + OFF_K); bf16_t* V = (bf16_t*)(p.ws + OFF_V);
  bf16_t* FE = (bf16_t*)(p.ws + OFF_FEATS);
  const int NT = 27, NITEM = (T_TOK / 128) * NT, CHUNK = NITEM / 8;
  for (int i = XCD_LB; i < CHUNK; i += XCD_NB) {
    const int item = XCD_GROUP * CHUNK + i;
    const int row0 = (item & 255) * 128, col0 = (item >> 8) * 128;
    gemm128(smem, DM,
            [=](int r) { return XB + (size_t)(row0 + r) * DM; },
            [=](int nq) { int c = col0 + nq * 4; if (c >= INW) c = 0; return w_in + c; },
            INW,
            [=](f32x4 (&acc)[4][4], int wr, int wc, int fr, int fq) {
              const int cb = col0 + wc * 64;
              if (cb >= INW) return;
#pragma unroll
              for (int m = 0; m < 4; ++m) {
                const int t = row0 + wr * 64 + m * 16 + fr;
                if (cb < 1024) {
                  const int pos = t & (SEQ - 1);
                  bf16_t* dst = (cb < 512) ? (Q + (size_t)t * 512 + cb) : (K + (size_t)t * 512 + (cb - 512));
                  const float sc = (cb < 512) ? 0.125f : 1.f;
#pragma unroll
                  for (int n = 0; n < 2; ++n) {
                    const int f0 = n * 16 + fq * 4;
                    const float4 c01 = *(const float4*)(rope + (size_t)(pos * 32 + f0) * 2);
                    const float4 c23 = *(const float4*)(rope + (size_t)(pos * 32 + f0) * 2 + 4);
                    const float cs[4] = {c01.x, c01.z, c23.x, c23.z}, sn[4] = {c01.y, c01.w, c23.y, c23.w};
                    float o1[4], o2[4];
#pragma unroll
                    for (int j = 0; j < 4; ++j) {
                      const float z1 = acc[m][n][j], z2 = acc[m][n + 2][j];
                      o1[j] = (z1 * cs[j] - z2 * sn[j]) * sc; o2[j] = (z2 * cs[j] + z1 * sn[j]) * sc;
                    }
                    *(uint2*)(dst + f0) = pack4(o1[0], o1[1], o1[2], o1[3]);
                    *(uint2*)(dst + 32 + f0) = pack4(o2[0], o2[1], o2[2], o2[3]);
                  }
                } else if (cb < 1536) {
#pragma unroll
                  for (int n = 0; n < 4; ++n)
                    *(uint2*)(V + (size_t)t * 512 + (cb - 1024) + n * 16 + fq * 4) = pack4(acc[m][n][0], acc[m][n][1], acc[m][n][2], acc[m][n][3]);
                } else {
#pragma unroll
                  for (int n = 0; n < 4; ++n) {
                    const int c = cb + n * 16 + fq * 4;
                    if (c < INW) *(uint2*)(FE + (size_t)t * FEW + (c - 1536)) = pack4(acc[m][n][0], acc[m][n][1], acc[m][n][2], acc[m][n][3]);
                  }
                }
              }
            });
  }
}

__device__ __forceinline__ float lerp_bf(const bf16_t* FE, int t, int col, float muc) {
  const float cur = bf2f(FE[(size_t)t * FEW + col]);
  const float prev = ((t & (SEQ - 1)) == 0) ? 0.f : bf2f(FE[(size_t)(t - 1) * FEW + col]);
  return cur + (prev - cur) * muc;
}
template <int PASS>
__device__ __forceinline__ void prep_item(const Params& p, char* smem, const int row0, const int col0) {
  const bf16_t* __restrict__ FE = (const bf16_t*)(p.ws + OFF_FEATS);
  const float* __restrict__ mu = p.in[2];
  constexpr int ACOL = 1536 + PASS * 64;
  constexpr int NK = (PASS == 2) ? 3 : 1;
  const float* __restrict__ Wm = (PASS == 0) ? p.in[4] : (PASS == 1) ? p.in[6] : p.in[7];
  f32x4 acc[4][4];
  acc_zero(acc);
  gemm128_acc<0, (PASS == 2)>(acc, smem, NK,
      [=](int, int rowl, int kc) {
        uint4 out = make_uint4(0u, 0u, 0u, 0u);
        const int j0 = kc * 8;
        if (PASS != 2 || j0 < 160) {
          const int t = row0 + rowl, col = ACOL + j0;
          const uint4 cu = *(const uint4*)(FE + (size_t)t * FEW + col);
          uint4 pv = make_uint4(0u, 0u, 0u, 0u);
          if ((t & (SEQ - 1)) != 0) pv = *(const uint4*)(FE + (size_t)(t - 1) * FEW + col);
          const float4 m0 = *(const float4*)(mu + col), m1 = *(const float4*)(mu + col + 4);
          float f[8];
          const unsigned cw[4] = {cu.x, cu.y, cu.z, cu.w}, pw[4] = {pv.x, pv.y, pv.z, pv.w};
          const float mm[8] = {m0.x, m0.y, m0.z, m0.w, m1.x, m1.y, m1.z, m1.w};
#pragma unroll
          for (int i = 0; i < 4; ++i) {
            const float c0 = __uint_as_float(cw[i] << 16), c1 = __uint_as_float(cw[i] & 0xffff0000u);
            const float p0 = __uint_as_float(pw[i] << 16), p1 = __uint_as_float(pw[i] & 0xffff0000u);
            f[2 * i] = c0 + (p0 - c0) * mm[2 * i];
            f[2 * i + 1] = c1 + (p1 - c1) * mm[2 * i + 1];
          }
#pragma unroll
          for (int i = 0; i < 8; ++i) f[i] = (PASS == 0) ? fast_tanh(f[i]) : ((PASS == 1) ? f[i] : sigmoidf_(f[i]));
          out.x = cvtpk(f[0], f[1]); out.y = cvtpk(f[2], f[3]); out.z = cvtpk(f[4], f[5]); out.w = cvtpk(f[6], f[7]);
        }
        return out;
      },
      [=](int nq) { return Wm + col0 + nq * 4; }, 512, 160);
  const int tid = threadIdx.x, lane = tid & 63, wid = tid >> 6;
  const int wr = wid >> 1, wc = wid & 1, fr = lane & 15, fq = lane >> 4;
  const int cb = col0 + wc * 64;
  if (PASS == 0) {
    const float* __restrict__ w0 = p.in[3];
    float* W = (float*)(p.ws + OFF_W);
#pragma unroll
    for (int n = 0; n < 4; ++n) {
      const int c = cb + n * 16 + fq * 4;
      const float4 w04 = *(const float4*)(w0 + c);
      const float w0c[4] = {w04.x, w04.y, w04.z, w04.w};
#pragma unroll
      for (int m = 0; m < 4; ++m) {
        const int t = row0 + wr * 64 + m * 16 + fr;
        float d[4];
#pragma unroll
        for (int j = 0; j < 4; ++j) {
          const float nz = -(w0c[j] + acc[m][n][j]);
          const float sp = fmaxf(nz, 0.f) + __logf(1.f + __expf(-fabsf(nz)));
          d[j] = __expf(-__expf(-sp - 0.5f));
        }
        *(float4*)(W + (size_t)t * 512 + c) = make_float4(d[0], d[1], d[2], d[3]);
      }
    }
  } else if (PASS == 2) {
    bf16_t* G = (bf16_t*)(p.ws + OFF_G);
#pragma unroll
    for (int m = 0; m < 4; ++m) {
      const int t = row0 + wr * 64 + m * 16 + fr;
#pragma unroll
      for (int n = 0; n < 4; ++n)
        *(uint2*)(G + (size_t)t * 512 + cb + n * 16 + fq * 4) = pack4(acc[m][n][0], acc[m][n][1], acc[m][n][2], acc[m][n][3]);
    }
  } else {
    const float* __restrict__ a0 = p.in[5]; const float* __restrict__ k_k = p.in[8]; const float* __restrict__ k_a = p.in[9];
    const float* __restrict__ r_k = p.in[10];
    bf16_t* R = (bf16_t*)(p.ws + OFF_R); bf16_t* K2 = (bf16_t*)(p.ws + OFF_K2); bf16_t* V2 = (bf16_t*)(p.ws + OFF_V2);
    bf16_t* A = (bf16_t*)(p.ws + OFF_A); bf16_t* B = (bf16_t*)(p.ws + OFF_B); float* SB = (float*)(p.ws + OFF_SB);
#pragma unroll
    for (int m = 0; m < 4; ++m) {
      __builtin_amdgcn_sched_barrier(0);
      const int t = row0 + wr * 64 + m * 16 + fr;
      const bool first = (t & (SEQ - 1)) == 0;
      float kk[4][4], aa[4][4];
      float ssp = 0.f, sbp = 0.f;
#pragma unroll
      for (int n = 0; n < 4; ++n) {
        const int c = cb + n * 16 + fq * 4;
        const size_t o = (size_t)t * 512 + c;
        const uint2 z2 = make_uint2(0u, 0u);
        float rr[4], kx[4];
        {
          const float4 mr4 = *(const float4*)(mu + c);
          const float4 rcf = bf4_to_f4(*(const uint2*)(FE + (size_t)t * FEW + c));
          const float4 rpf = bf4_to_f4(first ? z2 : *(const uint2*)(FE + (size_t)(t - 1) * FEW + c));
          rr[0] = rcf.x + (rpf.x - rcf.x) * mr4.x; rr[1] = rcf.y + (rpf.y - rcf.y) * mr4.y;
          rr[2] = rcf.z + (rpf.z - rcf.z) * mr4.z; rr[3] = rcf.w + (rpf.w - rcf.w) * mr4.w;
          *(uint2*)(R + o) = pack4(rr[0], rr[1], rr[2], rr[3]);
        }
        {
          const float4 mv4 = *(const float4*)(mu + 1024 + c);
          const float4 vcf = bf4_to_f4(*(const uint2*)(FE + (size_t)t * FEW + 1024 + c));
          const float4 vpf = bf4_to_f4(first ? z2 : *(const uint2*)(FE + (size_t)(t - 1) * FEW + 1024 + c));
          *(uint2*)(V2 + o) = pack4(vcf.x + (vpf.x - vcf.x) * mv4.x, vcf.y + (vpf.y - vcf.y) * mv4.y,
                                    vcf.z + (vpf.z - vcf.z) * mv4.z, vcf.w + (vpf.w - vcf.w) * mv4.w);
        }
        {
          const float4 mk4 = *(const float4*)(mu + 512 + c);
          const float4 kcf = bf4_to_f4(*(const uint2*)(FE + (size_t)t * FEW + 512 + c));
          const float4 kpf = bf4_to_f4(first ? z2 : *(const uint2*)(FE + (size_t)(t - 1) * FEW + 512 + c));
          kx[0] = kcf.x + (kpf.x - kcf.x) * mk4.x; kx[1] = kcf.y + (kpf.y - kcf.y) * mk4.y;
          kx[2] = kcf.z + (kpf.z - kcf.z) * mk4.z; kx[3] = kcf.w + (kpf.w - kcf.w) * mk4.w;
        }
        const float4 a04 = *(const float4*)(a0 + c), kk4 = *(const float4*)(k_k + c), ka4 = *(const float4*)(k_a + c), rk4 = *(const float4*)(r_k + c);
        const float a0c[4] = {a04.x, a04.y, a04.z, a04.w}, kkc[4] = {kk4.x, kk4.y, kk4.z, kk4.w}, kac[4] = {ka4.x, ka4.y, ka4.z, ka4.w};
        const float rkc[4] = {rk4.x, rk4.y, rk4.z, rk4.w};
        float k2[4];
#pragma unroll
        for (int j = 0; j < 4; ++j) {
          aa[n][j] = sigmoidf_(a0c[j] + acc[m][n][j]);
          kk[n][j] = kx[j] * kkc[j];
          k2[j] = kx[j] * (1.f + (aa[n][j] - 1.f) * kac[j]);
          ssp += kk[n][j] * kk[n][j];
          sbp += rr[j] * k2[j] * rkc[j];
        }
        *(uint2*)(K2 + o) = pack4(k2[0], k2[1], k2[2], k2[3]);
      }
      ssp += __shfl_xor(ssp, 16, 64); ssp += __shfl_xor(ssp, 32, 64);
      sbp += __shfl_xor(sbp, 16, 64); sbp += __shfl_xor(sbp, 32, 64);
      const float inv = 1.f / fmaxf(sqrtf(ssp), 1e-12f);
#pragma unroll
      for (int n = 0; n < 4; ++n) {
        const size_t o = (size_t)t * 512 + cb + n * 16 + fq * 4;
        *(uint2*)(A + o) = pack4(-kk[n][0] * inv, -kk[n][1] * inv, -kk[n][2] * inv, -kk[n][3] * inv);
        *(uint2*)(B + o) = pack4(kk[n][0] * inv * aa[n][0], kk[n][1] * inv * aa[n][1], kk[n][2] * inv * aa[n][2], kk[n][3] * inv * aa[n][3]);
      }
      if (fq == 0) SB[(size_t)t * 8 + (cb >> 6)] = sbp;
    }
  }
}
__device__ __forceinline__ void phase_prep(const Params& p, char* smem) {
  for (int item = blockIdx.x; item < (T_TOK / 128) * 12; item += gridDim.x) {
    const int mt = item / 12, sub = item - mt * 12, pass = sub >> 2, nt = sub & 3;
    if (pass == 0) prep_item<0>(p, smem, mt * 128, nt * 128);
    else if (pass == 1) prep_item<1>(p, smem, mt * 128, nt * 128);
    else prep_item<2>(p, smem, mt * 128, nt * 128);
  }
}

__device__ __forceinline__ float dpp_sum16(float v) {
  v += __builtin_bit_cast(float, __builtin_amdgcn_update_dpp(0, __builtin_bit_cast(int, v), 0xB1, 0xF, 0xF, true));
  v += __builtin_bit_cast(float, __builtin_amdgcn_update_dpp(0, __builtin_bit_cast(int, v), 0x4E, 0xF, 0xF, true));
  v += __builtin_bit_cast(float, __builtin_amdgcn_update_dpp(0, __builtin_bit_cast(int, v), 0x141, 0xF, 0xF, true));
  v += __builtin_bit_cast(float, __builtin_amdgcn_update_dpp(0, __builtin_bit_cast(int, v), 0x140, 0xF, 0xF, true));
  return v;
}
#define SC_CH 16
#define SC_ARR (SC_CH * 64 * 4)
#define SC_BUF (5 * SC_ARR + SC_CH * 16 * 4)
__device__ __forceinline__ void phase_scan(const Params& p, char* smem) {
  if (blockIdx.x >= 256) return;
  const bf16_t* __restrict__ R = (const bf16_t*)(p.ws + OFF_R); const bf16_t* __restrict__ K2 = (const bf16_t*)(p.ws + OFF_K2);
  const bf16_t* __restrict__ V2 = (const bf16_t*)(p.ws + OFF_V2); const bf16_t* __restrict__ A = (const bf16_t*)(p.ws + OFF_A);
  const bf16_t* __restrict__ B = (const bf16_t*)(p.ws + OFF_B); const float* __restrict__ W = (const float*)(p.ws + OFF_W);
  float* YS = (float*)(p.ws + OFF_YS);
  const int bh = blockIdx.x >> 2, rg = blockIdx.x & 3, b = bh >> 3, h = bh & 7;
  const int tid = threadIdx.x, lane = tid & 63, wid = tid >> 6, j = lane & 15, rq = lane >> 4;
  const int rowl = wid * 4 + rq;
  const int ls = tid >> 4, lc = tid & 15;
  const int vs = (tid >> 2) & 15, vq = tid & 3;
  const size_t tb = (size_t)b * SEQ;
  const size_t goff = (tb + ls) * 512 + h * 64 + lc * 4;
  const size_t voff = (tb + vs) * 512 + h * 64 + rg * 16 + vq * 4;
  uint2 ga, gb, gk, gr, gv; float4 gw;
  gv = make_uint2(0u, 0u);
  ga = *(const uint2*)(A + goff); gb = *(const uint2*)(B + goff); gk = *(const uint2*)(K2 + goff); gr = *(const uint2*)(R + goff);
  gw = *(const float4*)(W + goff);
  if (tid < 64) gv = *(const uint2*)(V2 + voff);
  {
    char* bf = smem;
    *(float4*)(bf + 0 * SC_ARR + ls * 256 + lc * 16) = bf4_to_f4(ga);
    *(float4*)(bf + 1 * SC_ARR + ls * 256 + lc * 16) = gw;
    *(float4*)(bf + 2 * SC_ARR + ls * 256 + lc * 16) = bf4_to_f4(gb);
    *(float4*)(bf + 3 * SC_ARR + ls * 256 + lc * 16) = bf4_to_f4(gk);
    *(float4*)(bf + 4 * SC_ARR + ls * 256 + lc * 16) = bf4_to_f4(gr);
    if (tid < 64) *(float4*)(bf + 5 * SC_ARR + vs * 64 + vq * 16) = bf4_to_f4(gv);
  }
  __syncthreads();
  float s0 = 0.f, s1 = 0.f, s2 = 0.f, s3 = 0.f;
  const int NCH = SEQ / SC_CH;
  for (int c = 0; c < NCH; ++c) {
    if (c + 1 < NCH) {
      const size_t o2 = goff + (size_t)(c + 1) * SC_CH * 512;
      ga = *(const uint2*)(A + o2); gb = *(const uint2*)(B + o2); gk = *(const uint2*)(K2 + o2); gr = *(const uint2*)(R + o2);
      gw = *(const float4*)(W + o2);
      if (tid < 64) gv = *(const uint2*)(V2 + voff + (size_t)(c + 1) * SC_CH * 512);
    }
    const char* bf = smem + (c & 1) * SC_BUF;
    float ykeep = 0.f;
#pragma unroll
    for (int s = 0; s < SC_CH; ++s) {
      const float4 a4 = *(const float4*)(bf + 0 * SC_ARR + s * 256 + j * 16);
      const float4 w4 = *(const float4*)(bf + 1 * SC_ARR + s * 256 + j * 16);
      const float4 b4 = *(const float4*)(bf + 2 * SC_ARR + s * 256 + j * 16);
      const float4 k4 = *(const float4*)(bf + 3 * SC_ARR + s * 256 + j * 16);
      const float4 r4 = *(const float4*)(bf + 4 * SC_ARR + s * 256 + j * 16);
      const float vv = *(const float*)(bf + 5 * SC_ARR + s * 64 + rowl * 4);
      float sa = (s0 * a4.x + s1 * a4.y) + (s2 * a4.z + s3 * a4.w);
      sa = dpp_sum16(sa);
      s0 = s0 * w4.x + (sa * b4.x + vv * k4.x);
      s1 = s1 * w4.y + (sa * b4.y + vv * k4.y);
      s2 = s2 * w4.z + (sa * b4.z + vv * k4.z);
      s3 = s3 * w4.w + (sa * b4.w + vv * k4.w);
      float y = (s0 * r4.x + s1 * r4.y) + (s2 * r4.z + s3 * r4.w);
      y = dpp_sum16(y);
      ykeep = (j == s) ? y : ykeep;
    }
    YS[(tb + (size_t)c * SC_CH + j) * 512 + h * 64 + rg * 16 + rowl] = ykeep;
    if (c + 1 < NCH) {
      char* bn = smem + ((c + 1) & 1) * SC_BUF;
      *(float4*)(bn + 0 * SC_ARR + ls * 256 + lc * 16) = bf4_to_f4(ga);
      *(float4*)(bn + 1 * SC_ARR + ls * 256 + lc * 16) = gw;
      *(float4*)(bn + 2 * SC_ARR + ls * 256 + lc * 16) = bf4_to_f4(gb);
      *(float4*)(bn + 3 * SC_ARR + ls * 256 + lc * 16) = bf4_to_f4(gk);
      *(float4*)(bn + 4 * SC_ARR + ls * 256 + lc * 16) = bf4_to_f4(gr);
      if (tid < 64) *(float4*)(bn + 5 * SC_ARR + vs * 64 + vq * 16) = bf4_to_f4(gv);
    }
    __syncthreads();
  }
}

__device__ __forceinline__ int vt_off(int d, int key) { const int swz = ((d >> 2) & 15) ^ ((d & 3) << 3); return d * 512 + (((key >> 2) ^ swz) << 3); }
__device__ __forceinline__ void phase_attn(const Params& p, char* smem) {
  const bf16_t* __restrict__ Q = (const bf16_t*)(p.ws + OFF_Q); const bf16_t* __restrict__ K = (const bf16_t*)(p.ws + OFF_K);
  const bf16_t* __restrict__ V = (const bf16_t*)(p.ws + OFF_V);
  bf16_t* OP = (bf16_t*)(p.ws + OFF_OP); float* LSE = (float*)(p.ws + OFF_LSE);
  char* Ks = smem; char* VT = smem + 32768; float* linv_s = (float*)(smem + 65536);
  const int tid = threadIdx.x, lane = tid & 63, wid = tid >> 6, l31 = lane & 31, hi = lane >> 5;
  for (int item = blockIdx.x; item < 6144; item += gridDim.x) {
    const int pp = item >> 11, rem = item & 2047, bh = rem >> 5, sub = rem & 31;
    const int dsh = pp * 2, nbsh = 5 - dsh;
    const int r = sub >> nbsh, n = sub & ((1 << nbsh) - 1);
    const int b = bh >> 3, h = bh & 7, tb = b * SEQ;
    __syncthreads();
#pragma unroll
    for (int u = 0; u < 8; ++u) {
      const int row = (tid >> 3) + 32 * u, chunk = tid & 7;
      int ik = n * 128 - 128 + row; ik = ik < 0 ? 0 : ik;
      const int tok = tb + (ik << dsh) + r;
      *(uint4*)(Ks + lds_off(row, chunk)) = *(const uint4*)(K + (size_t)tok * 512 + h * 64 + chunk * 8);
    }
#pragma unroll
    for (int ps = 0; ps < 2; ++ps) {
      const int dq = tid & 15, kbase = ps * 128 + (tid >> 4) * 8;
      uint2 v0, v1, v2, v3, v4, v5, v6, v7;
#define LDV(i, dst) { int ik = n * 128 - 128 + kbase + i; ik = ik < 0 ? 0 : ik; const int tok = tb + (ik << dsh) + r; dst = *(const uint2*)(V + (size_t)tok * 512 + h * 64 + dq * 4); }
      LDV(0, v0) LDV(1, v1) LDV(2, v2) LDV(3, v3) LDV(4, v4) LDV(5, v5) LDV(6, v6) LDV(7, v7)
#undef LDV
      {
        uint2 w;
        w.x = (v0.x & 0xffffu) | (v1.x << 16); w.y = (v2.x & 0xffffu) | (v3.x << 16);
        *(uint2*)(VT + vt_off(dq * 4 + 0, kbase)) = w;
        w.x = (v4.x & 0xffffu) | (v5.x << 16); w.y = (v6.x & 0xffffu) | (v7.x << 16);
        *(uint2*)(VT + vt_off(dq * 4 + 0, kbase + 4)) = w;
        w.x = (v0.x >> 16) | (v1.x & 0xffff0000u); w.y = (v2.x >> 16) | (v3.x & 0xffff0000u);
        *(uint2*)(VT + vt_off(dq * 4 + 1, kbase)) = w;
        w.x = (v4.x >> 16) | (v5.x & 0xffff0000u); w.y = (v6.x >> 16) | (v7.x & 0xffff0000u);
        *(uint2*)(VT + vt_off(dq * 4 + 1, kbase + 4)) = w;
        w.x = (v0.y & 0xffffu) | (v1.y << 16); w.y = (v2.y & 0xffffu) | (v3.y << 16);
        *(uint2*)(VT + vt_off(dq * 4 + 2, kbase)) = w;
        w.x = (v4.y & 0xffffu) | (v5.y << 16); w.y = (v6.y & 0xffffu) | (v7.y << 16);
        *(uint2*)(VT + vt_off(dq * 4 + 2, kbase + 4)) = w;
        w.x = (v0.y >> 16) | (v1.y & 0xffff0000u); w.y = (v2.y >> 16) | (v3.y & 0xffff0000u);
        *(uint2*)(VT + vt_off(dq * 4 + 3, kbase)) = w;
        w.x = (v4.y >> 16) | (v5.y & 0xffff0000u); w.y = (v6.y >> 16) | (v7.y & 0xffff0000u);
        *(uint2*)(VT + vt_off(dq * 4 + 3, kbase + 4)) = w;
      }
    }
    __syncthreads();
    const int iq = n * 128 + wid * 32 + l31;
    const int tq = tb + (iq << dsh) + r;
    bf16x8 qf[4];
#pragma unroll
    for (int ks = 0; ks < 4; ++ks) qf[ks] = *(const bf16x8*)(Q + (size_t)tq * 512 + h * 64 + ks * 16 + hi * 8);
    f32x16 st[5];
#pragma unroll
    for (int kb = 0; kb < 5; ++kb) {
      st[kb] = (f32x16){0.f, 0.f, 0.f, 0.f, 0.f, 0.f, 0.f, 0.f, 0.f, 0.f, 0.f, 0.f, 0.f, 0.f, 0.f, 0.f};
#pragma unroll
      for (int ks = 0; ks < 4; ++ks) {
        const bf16x8 kf = *(const bf16x8*)(Ks + lds_off(32 * (wid + kb) + l31, 2 * ks + hi));
        st[kb] = __builtin_amdgcn_mfma_f32_32x32x16_bf16(kf, qf[ks], st[kb], 0, 0, 0);
      }
    }
    float m = -INFINITY;
#pragma unroll
    for (int kb = 0; kb < 5; ++kb)
#pragma unroll
      for (int i = 0; i < 16; ++i) {
        const int kirel = 32 * kb + (i & 3) + 8 * (i >> 2) + 4 * hi;
        const bool valid = (kirel >= l31) && (kirel <= l31 + 128) && (n > 0 || (32 * wid + kirel) >= 128);
        const float s = valid ? st[kb][i] : -INFINITY;
        st[kb][i] = s;
        m = fmaxf(m, s);
      }
    m = fmaxf(m, __shfl_xor(m, 32, 64));
    float l = 0.f;
#pragma unroll
    for (int kb = 0; kb < 5; ++kb)
#pragma unroll
      for (int i = 0; i < 16; ++i) { const float pe = __expf(st[kb][i] - m); st[kb][i] = pe; l += pe; }
    l += __shfl_xor(l, 32, 64);
    f32x16 o0 = (f32x16){0.f, 0.f, 0.f, 0.f, 0.f, 0.f, 0.f, 0.f, 0.f, 0.f, 0.f, 0.f, 0.f, 0.f, 0.f, 0.f};
    f32x16 o1 = o0;
#pragma unroll
    for (int kb = 0; kb < 5; ++kb)
#pragma unroll
      for (int s = 0; s < 2; ++s) {
        union { unsigned u[4]; bf16x8 v; } pa;
        pa.u[0] = cvtpk(st[kb][8 * s + 0], st[kb][8 * s + 1]); pa.u[1] = cvtpk(st[kb][8 * s + 2], st[kb][8 * s + 3]);
        pa.u[2] = cvtpk(st[kb][8 * s + 4], st[kb][8 * s + 5]); pa.u[3] = cvtpk(st[kb][8 * s + 6], st[kb][8 * s + 7]);
        const int key0 = 32 * (wid + kb) + 16 * s + 4 * hi;
        {
          union { uint2 u[2]; bf16x8 v; } vb;
          vb.u[0] = *(const uint2*)(VT + vt_off(l31, key0)); vb.u[1] = *(const uint2*)(VT + vt_off(l31, key0 + 8));
          o0 = __builtin_amdgcn_mfma_f32_32x32x16_bf16(pa.v, vb.v, o0, 0, 0, 0);
        }
        {
          union { uint2 u[2]; bf16x8 v; } vb;
          vb.u[0] = *(const uint2*)(VT + vt_off(32 + l31, key0)); vb.u[1] = *(const uint2*)(VT + vt_off(32 + l31, key0 + 8));
          o1 = __builtin_amdgcn_mfma_f32_32x32x16_bf16(pa.v, vb.v, o1, 0, 0, 0);
        }
      }
    if (hi == 0) {
      linv_s[wid * 32 + l31] = 1.f / l;
      LSE[((size_t)pp * T_TOK + tq) * 8 + h] = m + __logf(l);
    }
#pragma unroll
    for (int i = 0; i < 16; ++i) {
      const int qrel = (i & 3) + 8 * (i >> 2) + 4 * hi;
      const int iq2 = n * 128 + wid * 32 + qrel;
      const int tq2 = tb + (iq2 << dsh) + r;
      const float li = linv_s[wid * 32 + qrel];
      bf16_t* op = OP + ((size_t)pp * T_TOK + tq2) * 512 + h * 64 + l31;
      op[0] = f2bf(o0[i] * li);
      op[32] = f2bf(o1[i] * li);
    }
  }
}

__device__ __forceinline__ void phase_post(const Params& p) {
  const float* __restrict__ YS = (const float*)(p.ws + OFF_YS); const bf16_t* __restrict__ V2 = (const bf16_t*)(p.ws + OFF_V2);
  const bf16_t* __restrict__ G = (const bf16_t*)(p.ws + OFF_G); const float* __restrict__ SB = (const float*)(p.ws + OFF_SB);
  const bf16_t* __restrict__ OP = (const bf16_t*)(p.ws + OFF_OP); const float* __restrict__ LSE = (const float*)(p.ws + OFF_LSE);
  const float* __restrict__ lnx_g = p.in[11]; const float* __restrict__ lnx_b = p.in[12];
  bf16_t* MIXED = (bf16_t*)(p.ws + OFF_MIXED);
  const int tid = threadIdx.x;
  for (int t = blockIdx.x; t < T_TOK; t += gridDim.x) {
#pragma unroll
    for (int pass = 0; pass < 2; ++pass) {
      int c = tid + pass * 256;
      size_t o = (size_t)t * 512 + c;
      float y = YS[o];
      float mean = wave_sum(y) * (1.f / 64.f);
      float d = y - mean;
      float var = wave_sum(d * d) * (1.f / 64.f);
      float yn = d * rsqrtf(var + GN_EPS_F) * lnx_g[c] + lnx_b[c];
      float res = (yn + SB[(size_t)t * 8 + (c >> 6)] * bf2f(V2[o])) * bf2f(G[o]);
      MIXED[(size_t)t * 1024 + 512 + c] = f2bf(res);
      {
        const int hh = c >> 6;
        const float l0 = LSE[((size_t)0 * T_TOK + t) * 8 + hh], l1 = LSE[((size_t)1 * T_TOK + t) * 8 + hh], l2 = LSE[((size_t)2 * T_TOK + t) * 8 + hh];
        const float mx = fmaxf(l0, fmaxf(l1, l2));
        const float e0 = __expf(l0 - mx), e1 = __expf(l1 - mx), e2 = __expf(l2 - mx);
        const float inv = 1.f / (e0 + e1 + e2);
        const float av = (e0 * bf2f(OP[(size_t)0 * T_TOK * 512 + o]) + e1 * bf2f(OP[(size_t)1 * T_TOK * 512 + o]) + e2 * bf2f(OP[(size_t)2 * T_TOK * 512 + o])) * inv;
        MIXED[(size_t)t * 1024 + c] = f2bf(av);
      }
    }
  }
}

__device__ __forceinline__ void phase_outproj(const Params& p, char* smem) {
  const bf16_t* __restrict__ MIXED = (const bf16_t*)(p.ws + OFF_MIXED);
  const float* __restrict__ w_out = p.in[13]; const float* __restrict__ x = p.in[0];
  float* U = p.out;
  for (int i = XCD_LB; i < T_TOK / 128; i += XCD_NB) {
    const int row0 = i * 128, col0 = XCD_GROUP * 128;
    gemm128(smem, DM,
            [=](int r) { return MIXED + (size_t)(row0 + r) * DM; },
            [=](int nq) { return w_out + col0 + nq * 4; },
            DM,
            [=](f32x4 (&acc)[4][4], int wr, int wc, int fr, int fq) {
#pragma unroll
              for (int m = 0; m < 4; ++m) {
                const int t = row0 + wr * 64 + m * 16 + fr;
#pragma unroll
                for (int n = 0; n < 4; ++n) {
                  const size_t o = (size_t)t * DM + col0 + wc * 64 + n * 16 + fq * 4;
                  const float4 xv = *(const float4*)(x + o);
                  *(float4*)(U + o) = make_float4(ALPHA_F * xv.x + acc[m][n][0], ALPHA_F * xv.y + acc[m][n][1], ALPHA_F * xv.z + acc[m][n][2], ALPHA_F * xv.w + acc[m][n][3]);
                }
              }
            });
  }
}

__device__ __forceinline__ void phase_ln1(const Params& p) {
  float* X1 = p.out;
  const float* __restrict__ g1 = p.in[14]; const float* __restrict__ b1 = p.in[15];
  bf16_t* X1B = (bf16_t*)(p.ws + OFF_X1B); bf16_t* XL = (bf16_t*)(p.ws + OFF_XL);
  const int lane = threadIdx.x & 63, wid = threadIdx.x >> 6;
  for (int t = blockIdx.x * 4 + wid; t < T_TOK; t += gridDim.x * 4) {
    const size_t base = (size_t)t * DM;
    float4 v[4];
    float s = 0.f;
#pragma unroll
    for (int u = 0; u < 4; ++u) { v[u] = *(const float4*)(X1 + base + u * 256 + lane * 4); s += (v[u].x + v[u].y) + (v[u].z + v[u].w); }
    const float mean = wave_sum_fast(s) * (1.f / DM);
    float q = 0.f;
#pragma unroll
    for (int u = 0; u < 4; ++u) {
      const float d0 = v[u].x - mean, d1 = v[u].y - mean, d2 = v[u].z - mean, d3 = v[u].w - mean;
      q += (d0 * d0 + d1 * d1) + (d2 * d2 + d3 * d3);
    }
    const float rs = rsqrtf(wave_sum_fast(q) * (1.f / DM) + LN_EPS_F);
#pragma unroll
    for (int u = 0; u < 4; ++u) {
      const int c = u * 256 + lane * 4;
      const float4 g = *(const float4*)(g1 + c), bb = *(const float4*)(b1 + c);
      float4 y;
      y.x = (v[u].x - mean) * rs * g.x + bb.x; y.y = (v[u].y - mean) * rs * g.y + bb.y;
      y.z = (v[u].z - mean) * rs * g.z + bb.z; y.w = (v[u].w - mean) * rs * g.w + bb.w;
      *(float4*)(X1 + base + c) = y;
      uint2 hi; hi.x = cvtpk(y.x, y.y); hi.y = cvtpk(y.z, y.w);
      *(uint2*)(X1B + base + c) = hi;
      uint2 lo;
      lo.x = cvtpk(y.x - __uint_as_float(hi.x << 16), y.y - __uint_as_float(hi.x & 0xffff0000u));
      lo.y = cvtpk(y.z - __uint_as_float(hi.y << 16), y.w - __uint_as_float(hi.y & 0xffff0000u));
      *(uint2*)(XL + base + c) = lo;
    }
  }
}

__device__ __forceinline__ void phase_router_gemm(const Params& p, char* smem) {
  const bf16_t* __restrict__ X1B = (const bf16_t*)(p.ws + OFF_X1B); const bf16_t* __restrict__ XL = (const bf16_t*)(p.ws + OFF_XL);
  const float* __restrict__ router_w = p.in[16];
  float* AFF = (float*)(p.ws + OFF_AFF);
  for (int item = blockIdx.x; item < (T_TOK / 128) * 2; item += gridDim.x) {
    const int row0 = (item >> 1) * 128, col0 = (item & 1) * 128;
    f32x4 acc[4][4];
    acc_zero(acc);
    auto ah = [=](int, int rowl, int kc) { return *(const uint4*)(X1B + (size_t)(row0 + rowl) * DM + kc * 8); };
    auto al = [=](int, int rowl, int kc) { return *(const uint4*)(XL + (size_t)(row0 + rowl) * DM + kc * 8); };
    auto bp = [=](int nq) { return router_w + col0 + nq * 4; };
    gemm128_acc<0, false>(acc, smem, 16, ah, bp, NEXP, 0);
    gemm128_acc<0, false>(acc, smem, 16, al, bp, NEXP, 0);
    gemm128_acc<1, false>(acc, smem, 16, ah, bp, NEXP, 0);
    const int tid = threadIdx.x, lane = tid & 63, wid = tid >> 6;
    const int wr = wid >> 1, wc = wid & 1, fr = lane & 15, fq = lane >> 4;
#pragma unroll
    for (int m = 0; m < 4; ++m) {
      const int t = row0 + wr * 64 + m * 16 + fr;
#pragma unroll
      for (int n = 0; n < 4; ++n)
        *(float4*)(AFF + (size_t)t * NEXP + col0 + wc * 64 + n * 16 + fq * 4) =
            make_float4(sigmoidf_(acc[m][n][0]), sigmoidf_(acc[m][n][1]), sigmoidf_(acc[m][n][2]), sigmoidf_(acc[m][n][3]));
    }
  }
}

__device__ __forceinline__ void phase_topk(const Params& p) {
  const float* __restrict__ AFF = (const float*)(p.ws + OFF_AFF);
  const float* __restrict__ router_bias = p.in[17];
  int* LIST = (int*)(p.ws + OFF_LIST); float* GATEW = (float*)(p.ws + OFF_GATEW);
  int* counts = (int*)(p.ws + OFF_CTL);
  const int lane = threadIdx.x & 63, wid = threadIdx.x >> 6;
  const float4 b4 = *(const float4*)(router_bias + lane * 4);
  for (int t = blockIdx.x * 4 + wid; t < T_TOK; t += gridDim.x * 4) {
    const float4 a4 = *(const float4*)(AFF + (size_t)t * NEXP + lane * 4);
    float s0 = a4.x + b4.x, s1 = a4.y + b4.y, s2 = a4.z + b4.z, s3 = a4.w + b4.w;
    const float hi01 = fmaxf(s0, s1), lo01 = fminf(s0, s1), hi23 = fmaxf(s2, s3), lo23 = fminf(s2, s3);
    float m1 = fmaxf(hi01, hi23), m2 = fmaxf(fminf(hi01, hi23), fmaxf(lo01, lo23));
    { const float o1 = DPP_F(m1, 0xB1), o2 = DPP_F(m2, 0xB1); const float n1 = fmaxf(m1, o1); m2 = fmaxf(fminf(m1, o1), fmaxf(m2, o2)); m1 = n1; }
    { const float o1 = DPP_F(m1, 0x4E), o2 = DPP_F(m2, 0x4E); const float n1 = fmaxf(m1, o1); m2 = fmaxf(fminf(m1, o1), fmaxf(m2, o2)); m1 = n1; }
    { const float o1 = DPP_F(m1, 0x141), o2 = DPP_F(m2, 0x141); const float n1 = fmaxf(m1, o1); m2 = fmaxf(fminf(m1, o1), fmaxf(m2, o2)); m1 = n1; }
    const float gs = m1 + m2;
    const int g = lane >> 3;
    int rank = 0;
#pragma unroll
    for (int gg = 0; gg < 8; ++gg) { const float G = rdlane_f(gs, gg * 8); rank += ((G > gs) || (G == gs && gg < g)) ? 1 : 0; }
    if (rank >= 4) { s0 = -INFINITY; s1 = -INFINITY; s2 = -INFINITY; s3 = -INFINITY; }
    int my_e = 0; float my_a = 0.f;
#pragma unroll 1
    for (int it = 0; it < 8; ++it) {
      const float lm = fmaxf(fmaxf(s0, s1), fmaxf(s2, s3));
      const float wm = wave_max_fast(lm);
      const unsigned long long bal = __ballot(lm == wm);
      const int win = __ffsll((long long)bal) - 1;
      const int wi = (s0 == wm) ? 0 : ((s1 == wm) ? 1 : ((s2 == wm) ? 2 : 3));
      const float wa = (wi == 0) ? a4.x : ((wi == 1) ? a4.y : ((wi == 2) ? a4.z : a4.w));
      const int e_w = __builtin_amdgcn_readlane(lane * 4 + wi, win);
      const float a_w = rdlane_f(wa, win);
      if (lane == win) { if (wi == 0) s0 = -INFINITY; else if (wi == 1) s1 = -INFINITY; else if (wi == 2) s2 = -INFINITY; else s3 = -INFINITY; }
      if (lane == it) { my_e = e_w; my_a = a_w; }
    }
    const float asum = rdlane_f(dpp_sum16x(my_a), 0);
    if (lane < 8) {
      const int pos = atomicAdd(&counts[my_e], 1);
      LIST[(size_t)my_e * T_TOK + pos] = lane * T_TOK + t;
      GATEW[(size_t)lane * T_TOK + t] = my_a * 2.5f / asum;
    }
  }
}

__device__ __forceinline__ int moe_group_setup(const int* counts, int* pre, const int NT) {
  __syncthreads();
  if (threadIdx.x == 0) {
    const int g = XCD_GROUP;
    int acc = 0;
    for (int j = 0; j < 32; ++j) { pre[j] = acc; acc += ((counts[g + 8 * j] + 127) >> 7) * NT; }
    pre[32] = acc; acc += 32 * NT;
    pre[33] = acc;
  }
  __syncthreads();
  return pre[33];
}
struct MoeItem { int e, nt, r0, cnt; };
__device__ __forceinline__ MoeItem moe_item(const int* counts, const int* pre, const int i) {
  int j = 0;
#pragma unroll 1
  for (int q = 1; q <= 32; ++q) j = (pre[q] <= i) ? q : j;
  MoeItem it;
  const int w = i - pre[j];
  if (j < 32) {
    it.e = XCD_GROUP + 8 * j; it.cnt = counts[it.e];
    const int tiles = (it.cnt + 127) >> 7;
    it.nt = w / tiles; it.r0 = (w - it.nt * tiles) * 128;
  } else {
    it.e = NEXP; it.cnt = T_TOK; it.nt = w >> 5; it.r0 = (XCD_GROUP * 32 + (w & 31)) * 128;
  }
  return it;
}

__device__ __forceinline__ void phase_moe1(const Params& p, char* smem) {
  int* asg = (int*)(smem + 32768); int* pre = asg + 128;
  const bf16_t* __restrict__ X1B = (const bf16_t*)(p.ws + OFF_X1B);
  const int* __restrict__ LIST = (const int*)(p.ws + OFF_LIST);
  const int* counts = (const int*)(p.ws + OFF_CTL);
  bf16_t* H = (bf16_t*)(p.ws + OFF_H);
  const int nitems = moe_group_setup(counts, pre, 4);
  for (int i = XCD_LB; i < nitems; i += XCD_NB) {
    const MoeItem it = moe_item(counts, pre, i);
    const int e = it.e, nt = it.nt, r0 = it.r0, cnt = it.cnt;
    __syncthreads();
    if (threadIdx.x < 128) {
      int r = r0 + threadIdx.x;
      asg[threadIdx.x] = (r < cnt) ? ((e < NEXP) ? LIST[(size_t)e * T_TOK + r] : (8 * T_TOK + r)) : -1;
    }
    __syncthreads();
    const float* __restrict__ Wg = (e < NEXP) ? p.in[18] + (size_t)e * DM * 256 : p.in[21];
    const float* __restrict__ Wu = (e < NEXP) ? p.in[19] + (size_t)e * DM * 256 : p.in[22];
    gemm128(smem, DM,
            [=](int r) { int a = asg[r]; return X1B + (size_t)((a >= 0 ? a : 0) & (T_TOK - 1)) * DM; },
            [=](int nq) { const long long dlt = ((nq >> 2) & 2) ? (long long)(Wu - Wg) : 0ll; return Wg + dlt + nt * 64 + (nq >> 4) * 32 + ((nq >> 2) & 1) * 16 + (nq & 3) * 4; },
            256,
            [=](f32x4 (&acc)[4][4], int wr, int wc, int fr, int fq) {
#pragma unroll
              for (int m = 0; m < 4; ++m) {
                const int a = asg[wr * 64 + m * 16 + fr];
                if (a < 0) continue;
#pragma unroll
                for (int n = 0; n < 2; ++n) {
                  float hv[4];
#pragma unroll
                  for (int j = 0; j < 4; ++j) { const float g = acc[m][n][j], u = acc[m][n + 2][j]; hv[j] = g * sigmoidf_(g) * u; }
                  *(uint2*)(H + (size_t)a * 256 + nt * 64 + wc * 32 + n * 16 + fq * 4) = pack4(hv[0], hv[1], hv[2], hv[3]);
                }
              }
            });
  }
}

__device__ __forceinline__ void phase_moe2(const Params& p, char* smem) {
  int* asg = (int*)(smem + 32768); int* pre = asg + 128;
  const bf16_t* __restrict__ H = (const bf16_t*)(p.ws + OFF_H);
  const int* __restrict__ LIST = (const int*)(p.ws + OFF_LIST);
  const float* __restrict__ GATEW = (const float*)(p.ws + OFF_GATEW);
  const int* counts = (const int*)(p.ws + OFF_CTL);
  bf16_t* Y = (bf16_t*)(p.ws + OFF_Y);
  const int nitems = moe_group_setup(counts, pre, 8);
  for (int i = XCD_LB; i < nitems; i += XCD_NB) {
    const MoeItem it = moe_item(counts, pre, i);
    const int e = it.e, nt = it.nt, r0 = it.r0, cnt = it.cnt;
    __syncthreads();
    if (threadIdx.x < 128) {
      int r = r0 + threadIdx.x;
      asg[threadIdx.x] = (r < cnt) ? ((e < NEXP) ? LIST[(size_t)e * T_TOK + r] : (8 * T_TOK + r)) : -1;
    }
    __syncthreads();
    const float* __restrict__ Wd = (e < NEXP) ? p.in[20] + (size_t)e * 256 * DM : p.in[23];
    gemm128(smem, 256,
            [=](int r) { int a = asg[r]; return H + (size_t)(a >= 0 ? a : 0) * 256; },
            [=](int nq) { return Wd + nt * 128 + nq * 4; },
            DM,
            [=](f32x4 (&acc)[4][4], int wr, int wc, int fr, int fq) {
#pragma unroll
              for (int m = 0; m < 4; ++m) {
                const int a = asg[wr * 64 + m * 16 + fr];
                if (a < 0) continue;
                const float gw = (a < 8 * T_TOK) ? GATEW[a] : 1.f;
#pragma unroll
                for (int n = 0; n < 4; ++n)
                  *(uint2*)(Y + (size_t)a * DM + nt * 128 + wc * 64 + n * 16 + fq * 4) =
                      pack4(acc[m][n][0] * gw, acc[m][n][1] * gw, acc[m][n][2] * gw, acc[m][n][3] * gw);
              }
            });
  }
}

__device__ __forceinline__ void phase_final(const Params& p, char* smem) {
  float* red = (float*)smem;
  float* OUT = p.out;
  const bf16_t* __restrict__ Y = (const bf16_t*)(p.ws + OFF_Y);
  const float* __restrict__ g2 = p.in[24]; const float* __restrict__ b2 = p.in[25];
  const int tid = threadIdx.x, lane = tid & 63, wid = tid >> 6;
  for (int t = blockIdx.x; t < T_TOK; t += gridDim.x) {
    size_t base = (size_t)t * DM;
    float v[4];
    float s = 0.f;
#pragma unroll
    for (int u = 0; u < 4; ++u) {
      int c = tid + u * 256;
      float acc = 0.f;
#pragma unroll
      for (int sl = 0; sl < 9; ++sl) acc += bf2f(Y[((size_t)sl * T_TOK + t) * DM + c]);
      v[u] = ALPHA_F * OUT[base + c] + acc;
      s += v[u];
    }
    s = wave_sum(s);
    if (lane == 0) red[wid] = s;
    __syncthreads();
    float mean = (red[0] + red[1] + red[2] + red[3]) * (1.f / DM);
    float q = 0.f;
#pragma unroll
    for (int u = 0; u < 4; ++u) { float d = v[u] - mean; q += d * d; }
    q = wave_sum(q);
    if (lane == 0) red[4 + wid] = q;
    __syncthreads();
    float var = (red[4] + red[5] + red[6] + red[7]) * (1.f / DM);
    float rs = rsqrtf(var + LN_EPS_F);
#pragma unroll
    for (int u = 0; u < 4; ++u) {
      int c = tid + u * 256;
      OUT[base + c] = (v[u] - mean) * rs * g2[c] + b2[c];
    }
    __syncthreads();
  }
}


#define LAS __attribute__((address_space(3)))
#define XB_TMO      128
#define XB_XCNT(j)  (256  + 64 * (j))
#define XB_XSUB(j)  (1280 + 64 * (j))
#define XB_XGEN(j)  (2304 + 64 * (j))
#define XB_TOP      3328
#define XB_TOPGEN   3392
#define XCD_BAR_WORDS 3456
#define XB_SPIN_CAP (1u << 22)
__device__ __forceinline__ unsigned xb_ld(unsigned* p)              { return __hip_atomic_load(p, __ATOMIC_RELAXED, __HIP_MEMORY_SCOPE_AGENT); }
__device__ __forceinline__ unsigned xb_add(unsigned* p, unsigned v) { return __hip_atomic_fetch_add(p, v, __ATOMIC_RELAXED, __HIP_MEMORY_SCOPE_AGENT); }
__device__ __forceinline__ unsigned xb_xcc_id() { return (unsigned)__builtin_amdgcn_s_getreg((3 << 11) | 20) & 0xFu; }
#define XB_SPIN(cond, bar) do { unsigned _sp = 0; while (cond) { __builtin_amdgcn_s_sleep(1); \
    if ((++_sp & 255u) == 0u) { if (xb_ld(&(bar)[XB_TMO])) break; if (_sp > XB_SPIN_CAP) { atomicAdd(&(bar)[XB_TMO], 1u); break; } } } } while (0)
struct XcdBarrier { unsigned* bar; unsigned x; volatile LAS unsigned* st; };
__device__ __forceinline__ XcdBarrier xcd_barrier_post(unsigned* bar, volatile LAS unsigned* st) {
  XcdBarrier b; b.bar = bar; b.x = xb_xcc_id(); b.st = st;
  if (threadIdx.x == 0) (void)xb_add(&bar[XB_XCNT(b.x)], 1u);
  return b;
}
__device__ __forceinline__ void xcd_barrier_complete(unsigned* bar, unsigned x, unsigned& nloc, unsigned& nx) {
  const unsigned G = gridDim.x * gridDim.y * gridDim.z;
  unsigned sum, cnt, mine, sp = 0u;
  for (;;) {
    sum = 0u; cnt = 0u; mine = 0u;
#pragma unroll
    for (unsigned j = 0; j < 16; ++j) { const unsigned c = xb_ld(&bar[XB_XCNT(j)]); sum += c; cnt += (c > 0u) ? 1u : 0u; mine = (j == x) ? c : mine; }
    if (sum == G) break;
    __builtin_amdgcn_s_sleep(1);
    if ((++sp & 255u) == 0u) { if (xb_ld(&bar[XB_TMO])) break; if (sp > XB_SPIN_CAP) { atomicAdd(&bar[XB_TMO], 1u); break; } }
  }
  nloc = mine > 0u ? mine : 1u; nx = cnt > 0u ? cnt : 1u;
}
__device__ __forceinline__ void xcd_barrier(const XcdBarrier& b) {
  asm volatile("s_waitcnt vmcnt(0)" ::: "memory");
  __syncthreads();
  if (threadIdx.x == 0) {
    unsigned* bar = b.bar;
    __builtin_amdgcn_s_waitcnt(0);
    unsigned nloc = b.st[0], nx = b.st[1];
    if (nloc == 0u) { xcd_barrier_complete(bar, b.x, nloc, nx); b.st[0] = nloc; b.st[1] = nx; }
    const unsigned old = xb_add(&bar[XB_XSUB(b.x)], 1u);
    const unsigned gen = old / nloc;
    if (old + 1u == (gen + 1u) * nloc) {
      __builtin_amdgcn_fence(__ATOMIC_RELEASE, "agent");
      asm volatile("s_waitcnt vmcnt(0)" ::: "memory");
      const unsigned og = xb_add(&bar[XB_TOP], 1u);
      const unsigned tg = og / nx;
      if (og + 1u == (tg + 1u) * nx) xb_add(&bar[XB_TOPGEN], 1u);
      else XB_SPIN(xb_ld(&bar[XB_TOPGEN]) == tg, bar);
      __builtin_amdgcn_fence(__ATOMIC_ACQUIRE, "agent");
      xb_add(&bar[XB_XGEN(b.x)], 1u);
      asm volatile("s_waitcnt vmcnt(0)" ::: "memory");
    } else {
      XB_SPIN(xb_ld(&bar[XB_XGEN(b.x)]) == gen, bar);
      __builtin_amdgcn_fence(__ATOMIC_ACQUIRE, "agent");
      asm volatile("s_waitcnt vmcnt(0)" ::: "memory");
    }
  }
  __syncthreads();
}
#define CTL_BAR_WORD 4096
#define CTL_ZERO_BYTES 32768
#define LDS_BAR_OFF 66432

__global__ void __launch_bounds__(NTHR, 2) mega(Params p) {
  extern __shared__ __attribute__((aligned(16))) char smem[];
  cg::grid_group grid = cg::this_grid();
  volatile LAS unsigned* bst = (volatile LAS unsigned*)(LAS char*)(smem + LDS_BAR_OFF);
  if (threadIdx.x < 2) bst[threadIdx.x] = 0u;
  __syncthreads();
  const XcdBarrier bar = xcd_barrier_post((unsigned*)(p.ws + OFF_CTL) + CTL_BAR_WORD, bst);
  phase_rope(p);
  grid.sync();
  phase_inproj(p, smem);
  xcd_barrier(bar);
  phase_prep(p, smem);
  xcd_barrier(bar);
  phase_scan(p, smem);
  phase_attn(p, smem);
  xcd_barrier(bar);
  phase_post(p);
  xcd_barrier(bar);
  phase_outproj(p, smem);
  xcd_barrier(bar);
  phase_ln1(p);
  xcd_barrier(bar);
  phase_router_gemm(p, smem);
  xcd_barrier(bar);
  phase_topk(p);
  xcd_barrier(bar);
  phase_moe1(p, smem);
  xcd_barrier(bar);
  phase_moe2(p, smem);
  xcd_barrier(bar);
  phase_final(p, smem);
}

extern "C" void kernel_launch(void* const* d_in, const int* in_sizes, int n_in, void* d_out, int out_size, void* d_ws, size_t ws_size,
                              hipStream_t stream) {
  static int grid_blocks = 0;
  if (grid_blocks == 0) {
    if (ws_size < WS_NEED || n_in != 26) { fprintf(stderr, "kernel_launch: bad ws/n_in: %zu < %zu, n_in %d\n", ws_size, (size_t)WS_NEED, n_in); grid_blocks = -1; return; }
    int dev = 0, cus = 0, per_cu = 0;
    (void)hipGetDevice(&dev);
    (void)hipDeviceGetAttribute(&cus, hipDeviceAttributeMultiprocessorCount, dev);
    (void)hipFuncSetAttribute((const void*)mega, hipFuncAttributeMaxDynamicSharedMemorySize, LDS_BYTES);
    (void)hipOccupancyMaxActiveBlocksPerMultiprocessor(&per_cu, (const void*)mega, NTHR, LDS_BYTES);
    if (per_cu < 1) { fprintf(stderr, "kernel_launch: occupancy query returned %d\n", per_cu); grid_blocks = -1; return; }
    if (per_cu > 2) per_cu = 2;
    grid_blocks = cus * per_cu;
    fprintf(stderr, "kernel_launch: cus %d per_cu %d grid %d\n", cus, per_cu, grid_blocks);
  }
  if (grid_blocks < 0) return;
  if (hipMemsetAsync((char*)d_ws + OFF_CTL, 0, CTL_ZERO_BYTES, stream) != hipSuccess) { fprintf(stderr, "kernel_launch: memset failed\n"); return; }
  Params p{};
  for (int i = 0; i < 26; ++i) p.in[i] = (const float*)d_in[i];
  p.out = (float*)d_out;
  p.ws = (char*)d_ws;
  void* args[] = {&p};
  hipError_t e = hipLaunchCooperativeKernel((const void*)mega, dim3(grid_blocks), dim3(NTHR), args, LDS_BYTES, stream);
  if (e != hipSuccess) fprintf(stderr, "cooperative launch failed: %s (grid %d)\n", hipGetErrorString(e), grid_blocks);
}
```

```cpp
#include <hip/hip_runtime.h>
#include <hip/hip_bf16.h>
#include <hip/hip_cooperative_groups.h>
#include <stdint.h>
#include <stdio.h>

typedef unsigned short bf16_t;

#define T_TOK 32768
#define SEQ 4096
#define DM 1024
#define INW 3360
#define FEW 1824
#define NEXP 256
#define ALPHA_F 1.189207115002721f
#define LN_EPS_F 1e-5f
#define GN_EPS_F 64e-5f

__device__ __forceinline__ float bf2f(bf16_t v) { return __uint_as_float(((unsigned)v) << 16); }
__device__ __forceinline__ bf16_t f2bf(float f) { unsigned u = __float_as_uint(f); return (bf16_t)((u + 0x7fffu + ((u >> 16) & 1u)) >> 16); }
__device__ __forceinline__ float sigmoidf_(float x) { return 1.f / (1.f + __expf(-x)); }
__device__ __forceinline__ float wave_sum(float v) {
#pragma unroll
  for (int o = 32; o >= 1; o >>= 1) v += __shfl_xor(v, o, 64);
  return v;
}

constexpr size_t SZ_T512_BF = (size_t)T_TOK * 512 * 2;
constexpr size_t OFF_Q = 0;
constexpr size_t OFF_K = OFF_Q + SZ_T512_BF;
constexpr size_t OFF_V = OFF_K + SZ_T512_BF;
constexpr size_t OFF_FEATS = OFF_V + SZ_T512_BF;
constexpr size_t OFF_R = OFF_FEATS + (size_t)T_TOK * FEW * 2;
constexpr size_t OFF_K2 = OFF_R + SZ_T512_BF;
constexpr size_t OFF_V2 = OFF_K2 + SZ_T512_BF;
constexpr size_t OFF_A = OFF_V2 + SZ_T512_BF;
constexpr size_t OFF_B = OFF_A + SZ_T512_BF;
constexpr size_t OFF_W = OFF_B + SZ_T512_BF;
constexpr size_t OFF_G = OFF_W + (size_t)T_TOK * 512 * 4;
constexpr size_t OFF_SB = OFF_G + SZ_T512_BF;
constexpr size_t OFF_YS = OFF_SB + (size_t)T_TOK * 8 * 4;
constexpr size_t OFF_OP = OFF_YS + (size_t)T_TOK * 512 * 4;
constexpr size_t OFF_LSE = OFF_OP + 3 * SZ_T512_BF;
constexpr size_t OFF_MIXED = OFF_LSE + (size_t)3 * T_TOK * 8 * 4;
constexpr size_t OFF_ROPE = OFF_MIXED + (size_t)T_TOK * 1024 * 2;
constexpr size_t OFF_WINT = OFF_ROPE + (size_t)4096 * 32 * 2 * 4;
constexpr size_t OFF_WOUTT = OFF_WINT + (size_t)3456 * 1024 * 2;
constexpr size_t OFF_ACT = OFF_WOUTT + (size_t)1024 * 1024 * 2;
constexpr size_t EARLY_END = OFF_ACT + (size_t)T_TOK * 320 * 2;
constexpr size_t OFF_Y = 0;
constexpr size_t OFF_H = OFF_Y + (size_t)9 * T_TOK * 1024 * 2;
constexpr size_t OFF_X1B = OFF_H + (size_t)9 * T_TOK * 256 * 2;
constexpr size_t OFF_LIST = OFF_X1B + (size_t)T_TOK * 1024 * 2;
constexpr size_t OFF_GATEW = OFF_LIST + (size_t)NEXP * T_TOK * 4;
constexpr size_t OFF_CTL = OFF_GATEW + (size_t)8 * T_TOK * 4;
constexpr size_t CTL_BYTES = 1u << 20;
constexpr size_t WS_NEED = OFF_CTL + CTL_BYTES;
static_assert(OFF_ACT <= OFF_X1B, "P0 buffers (rope, w^T) must not overlap XB; ACT may (XB is dead by then)");
#define MAXTILES 4864
constexpr size_t OFF_XL = 0;
constexpr size_t OFF_AFF = (size_t)T_TOK * 1024 * 2;
constexpr size_t OFF_XB = OFF_X1B;

typedef short bf16x8 __attribute__((ext_vector_type(8)));
typedef float f32x4 __attribute__((ext_vector_type(4)));
typedef float f32x16 __attribute__((ext_vector_type(16)));
typedef float f32x2_t __attribute__((ext_vector_type(2)));
typedef __bf16 bf16x2_t __attribute__((ext_vector_type(2)));
__device__ __forceinline__ unsigned cvtpk(float lo, float hi) { f32x2_t v = {lo, hi}; bf16x2_t b = __builtin_convertvector(v, bf16x2_t); return __builtin_bit_cast(unsigned, b); }

__device__ const double INVF[32] = {
1, 0.74989420933245587, 0.56234132519034907, 0.42169650342858223, 0.31622776601683794, 0.23713737056616552,
0.17782794100389229, 0.1333521432163324, 0.10000000000000001, 0.074989420933245579, 0.056234132519034911,
0.042169650342858224, 0.031622776601683791, 0.023713737056616554, 0.017782794100389229, 0.013335214321633241,
0.01, 0.0074989420933245579, 0.005623413251903491, 0.0042169650342858229, 0.0031622776601683794,
0.0023713737056616554, 0.0017782794100389228, 0.0013335214321633241, 0.001, 0.00074989420933245586,
0.0005623413251903491, 0.00042169650342858224, 0.00031622776601683794, 0.00023713737056616554,
0.00017782794100389227, 0.0001333521432163324};

namespace cg = cooperative_groups;

struct Params {
  const float* in[26];
  float* out;
  char* ws;
};

#define NTHR 256
#define LDS_BYTES 66560

__device__ __forceinline__ void phase_rope(const Params& p) {
  float* tab = (float*)(p.ws + OFF_ROPE);
  for (int i = blockIdx.x * NTHR + threadIdx.x; i < 4096 * 32; i += gridDim.x * NTHR) {
    int pos = i >> 5, f = i & 31;
    double ang = (double)pos * INVF[f];
    const double TWO_PI = 6.283185307179586476925286766559;
    double n = rint(ang / TWO_PI);
    double r = ang - n * TWO_PI;
    double r2 = r * r;
    double sn = r, cs = 1.0, ts = r, tc = 1.0;
#pragma unroll 1
    for (int k = 1; k <= 16; ++k) {
      tc = -tc * r2 / (double)((2 * k - 1) * (2 * k));
      ts = -ts * r2 / (double)((2 * k) * (2 * k + 1));
      cs += tc; sn += ts;
    }
    tab[i * 2] = (float)cs; tab[i * 2 + 1] = (float)sn;
  }
  {
    const float* __restrict__ w_in = p.in[1]; const float* __restrict__ w_out = p.in[13];
    uint4* wint = (uint4*)(p.ws + OFF_WINT); uint4* woutt = (uint4*)(p.ws + OFF_WOUTT);
    const int NJ1 = 3456 * 128, NJ2 = 1024 * 128;
    for (int i = blockIdx.x * NTHR + threadIdx.x; i < NJ1 + NJ2; i += gridDim.x * NTHR) {
      const bool second = i >= NJ1;
      const int q = second ? i - NJ1 : i;
      const int N = second ? 1024 : 3456, NV = second ? 1024 : INW;
      const int n = q % N, ko = q / N;
      const float* __restrict__ src = second ? w_out : w_in;
      float f[8];
#pragma unroll
      for (int u = 0; u < 8; ++u) f[u] = (n < NV) ? src[(size_t)(ko * 8 + u) * NV + n] : 0.f;
      uint4 w; w.x = cvtpk(f[0], f[1]); w.y = cvtpk(f[2], f[3]); w.z = cvtpk(f[4], f[5]); w.w = cvtpk(f[6], f[7]);
      (second ? woutt : wint)[(size_t)n * 128 + ko] = w;
    }
  }
  {
    const float4* __restrict__ x4 = (const float4*)p.in[0];
    uint4* xb = (uint4*)(p.ws + OFF_XB);
    for (size_t i = (size_t)blockIdx.x * NTHR + threadIdx.x; i < (size_t)T_TOK * DM / 8; i += (size_t)gridDim.x * NTHR) {
      float4 a = x4[2 * i], b = x4[2 * i + 1];
      uint4 w; w.x = cvtpk(a.x, a.y); w.y = cvtpk(a.z, a.w); w.z = cvtpk(b.x, b.y); w.w = cvtpk(b.z, b.w);
      xb[i] = w;
    }
  }
}

template <class AF, class BF>
__device__ __forceinline__ void gemm64_naive(float* As, float* Bs, float* Cs, int K, AF af, BF bf) {
  const int tid = threadIdx.x, tx = tid & 15, ty = tid >> 4;
  float acc[4][4];
#pragma unroll
  for (int i = 0; i < 4; ++i)
#pragma unroll
    for (int j = 0; j < 4; ++j) acc[i][j] = 0.f;
  for (int k0 = 0; k0 < K; k0 += 16) {
#pragma unroll
    for (int u = 0; u < 4; ++u) { int i = tid + u * 256; int r = i >> 4, kk = i & 15; As[kk * 68 + r] = af(r, k0 + kk); }
#pragma unroll
    for (int u = 0; u < 4; ++u) { int i = tid + u * 256; int kk = i >> 6, c = i & 63; Bs[kk * 68 + c] = bf(k0 + kk, c); }
    __syncthreads();
#pragma unroll
    for (int kk = 0; kk < 16; ++kk) {
      float a[4], b[4];
#pragma unroll
      for (int i = 0; i < 4; ++i) { a[i] = As[kk * 68 + ty * 4 + i]; b[i] = Bs[kk * 68 + tx * 4 + i]; }
#pragma unroll
      for (int i = 0; i < 4; ++i)
#pragma unroll
        for (int j = 0; j < 4; ++j) acc[i][j] += a[i] * b[j];
    }
    __syncthreads();
  }
#pragma unroll
  for (int i = 0; i < 4; ++i)
#pragma unroll
    for (int j = 0; j < 4; ++j) Cs[(ty * 4 + i) * 65 + tx * 4 + j] = acc[i][j];
  __syncthreads();
}


__device__ __forceinline__ int lds_off(int row, int chunk) { return row * 128 + ((chunk ^ ((row >> 1) & 7)) << 4); }

template <int BMODE>
__device__ __forceinline__ unsigned cvtpk_m(float a, float b, const bool lo = false) {
  if (BMODE == 0 || (BMODE == 2 && !lo)) return cvtpk(a, b);
  const unsigned h = cvtpk(a, b);
  const float ah = __uint_as_float(h << 16), bh = __uint_as_float(h & 0xffff0000u);
  return cvtpk(a - ah, b - bh);
}
#define G128_MMA(bufoff) { \
    _Pragma("unroll") for (int kk = 0; kk < 2; ++kk) { \
      bf16x8 af[4], bfr[4]; \
      _Pragma("unroll") for (int m = 0; m < 4; ++m) af[m] = *(const bf16x8*)(smem + (bufoff) + lds_off(wr * 64 + m * 16 + fr, kk * 4 + fq)); \
      _Pragma("unroll") for (int n = 0; n < 4; ++n) bfr[n] = *(const bf16x8*)(smem + (bufoff) + 16384 + lds_off(wc * 64 + n * 16 + fr, kk * 4 + fq)); \
      _Pragma("unroll") for (int m = 0; m < 4; ++m) \
        _Pragma("unroll") for (int n = 0; n < 4; ++n) acc[m][n] = __builtin_amdgcn_mfma_f32_16x16x32_bf16(bfr[n], af[m], acc[m][n], 0, 0, 0); \
    } }
template <int BMODE, bool KCLAMP, class ALoad, class BPtr>
__device__ __forceinline__ void gemm128_acc(f32x4 (&acc)[4][4], char* smem, const int nk, ALoad aload, BPtr bptr, const int ldb, const int kvalid) {
  const int tid = threadIdx.x, lane = tid & 63, wid = tid >> 6;
  const int wr = wid >> 1, wc = wid & 1, fr = lane & 15, fq = lane >> 4;
  const int achunk = tid & 7, arow0 = tid >> 3;
  const int nq = tid & 31, ko = tid >> 5;
  const float* bp0 = bptr(nq);
  const int oa0 = lds_off(arow0, achunk), oa1 = lds_off(arow0 + 32, achunk), oa2 = lds_off(arow0 + 64, achunk), oa3 = lds_off(arow0 + 96, achunk);
  const int ob0 = 16384 + lds_off(nq * 4 + 0, ko), ob1 = 16384 + lds_off(nq * 4 + 1, ko), ob2 = 16384 + lds_off(nq * 4 + 2, ko), ob3 = 16384 + lds_off(nq * 4 + 3, ko);
  uint4 ra0, ra1, ra2, ra3; float4 rb0, rb1, rb2, rb3, rb4, rb5, rb6, rb7;
#define G128_LOAD(kt) { \
    ra0 = aload(0, arow0, (kt) * 8 + achunk); ra1 = aload(1, arow0 + 32, (kt) * 8 + achunk); \
    ra2 = aload(2, arow0 + 64, (kt) * 8 + achunk); ra3 = aload(3, arow0 + 96, (kt) * 8 + achunk); \
    int kr_ = (kt) * 64 + ko * 8; \
    if (KCLAMP) kr_ = min(kr_, kvalid - 8);     \
    { \
      const float* b2_ = bp0 + (size_t)((BMODE == 2) ? (kr_ & 1023) : kr_) * ldb; \
      rb0 = *(const float4*)(b2_); rb1 = *(const float4*)(b2_ + (size_t)1 * ldb); rb2 = *(const float4*)(b2_ + (size_t)2 * ldb); \
      rb3 = *(const float4*)(b2_ + (size_t)3 * ldb); rb4 = *(const float4*)(b2_ + (size_t)4 * ldb); rb5 = *(const float4*)(b2_ + (size_t)5 * ldb); \
      rb6 = *(const float4*)(b2_ + (size_t)6 * ldb); rb7 = *(const float4*)(b2_ + (size_t)7 * ldb); \
    } }
#define G128_STORE(bufoff, lo_) { \
    char* const sb_ = smem + (bufoff); \
    *(uint4*)(sb_ + oa0) = ra0; *(uint4*)(sb_ + oa1) = ra1; *(uint4*)(sb_ + oa2) = ra2; *(uint4*)(sb_ + oa3) = ra3; \
    uint4 w; \
    w.x = cvtpk_m<BMODE>(rb0.x, rb1.x, lo_); w.y = cvtpk_m<BMODE>(rb2.x, rb3.x, lo_); w.z = cvtpk_m<BMODE>(rb4.x, rb5.x, lo_); w.w = cvtpk_m<BMODE>(rb6.x, rb7.x, lo_); \
    *(uint4*)(sb_ + ob0) = w; \
    w.x = cvtpk_m<BMODE>(rb0.y, rb1.y, lo_); w.y = cvtpk_m<BMODE>(rb2.y, rb3.y, lo_); w.z = cvtpk_m<BMODE>(rb4.y, rb5.y, lo_); w.w = cvtpk_m<BMODE>(rb6.y, rb7.y, lo_); \
    *(uint4*)(sb_ + ob1) = w; \
    w.x = cvtpk_m<BMODE>(rb0.z, rb1.z, lo_); w.y = cvtpk_m<BMODE>(rb2.z, rb3.z, lo_); w.z = cvtpk_m<BMODE>(rb4.z, rb5.z, lo_); w.w = cvtpk_m<BMODE>(rb6.z, rb7.z, lo_); \
    *(uint4*)(sb_ + ob2) = w; \
    w.x = cvtpk_m<BMODE>(rb0.w, rb1.w, lo_); w.y = cvtpk_m<BMODE>(rb2.w, rb3.w, lo_); w.z = cvtpk_m<BMODE>(rb4.w, rb5.w, lo_); w.w = cvtpk_m<BMODE>(rb6.w, rb7.w, lo_); \
    *(uint4*)(sb_ + ob3) = w; }
  G128_LOAD(0)
  G128_STORE(0, false)
  if (nk > 1) G128_LOAD(1)
  __syncthreads();
  for (int kt = 0; kt < nk; ++kt) {
    const int cur = (kt & 1) * 32768;
    __builtin_amdgcn_sched_barrier(0);
    G128_MMA(cur)
    __builtin_amdgcn_sched_barrier(0);
    if (kt + 1 < nk) {
      G128_STORE(cur ^ 32768, (kt + 1) >= 32)
      __builtin_amdgcn_sched_barrier(0);
      if (kt + 2 < nk) G128_LOAD(kt + 2)
    }
    __builtin_amdgcn_sched_barrier(0);
    __syncthreads();
  }
#undef G128_LOAD
#undef G128_STORE
}
__device__ __forceinline__ void acc_zero(f32x4 (&acc)[4][4]) {
#pragma unroll
  for (int m = 0; m < 4; ++m)
#pragma unroll
    for (int n = 0; n < 4; ++n) acc[m][n] = (f32x4){0.f, 0.f, 0.f, 0.f};
}
template <class ARow, class BPtr, class Epi>
__device__ __forceinline__ void gemm128(char* smem, const int K, ARow arow, BPtr bptr, const int ldb, Epi epi) {
  const int tid = threadIdx.x, lane = tid & 63, wid = tid >> 6;
  const int arow0 = tid >> 3;
  const bf16_t* ap0 = arow(arow0);
  const bf16_t* ap1 = arow(arow0 + 32);
  const bf16_t* ap2 = arow(arow0 + 64);
  const bf16_t* ap3 = arow(arow0 + 96);
  f32x4 acc[4][4];
  acc_zero(acc);
  gemm128_acc<0, false>(acc, smem, K >> 6,
      [=](int u, int, int kc) { const bf16_t* q = (u == 0) ? ap0 : (u == 1) ? ap1 : (u == 2) ? ap2 : ap3; return *(const uint4*)(q + kc * 8); },
      bptr, ldb, 0);
  epi(acc, wid >> 1, wid & 1, lane & 15, lane >> 4);
}


template <class ALoad, class BLoad>
__device__ __forceinline__ void gemm128_acc_bb(f32x4 (&acc)[4][4], char* smem, const int nk, ALoad aload, BLoad bload) {
  const int tid = threadIdx.x, lane = tid & 63, wid = tid >> 6;
  const int wr = wid >> 1, wc = wid & 1, fr = lane & 15, fq = lane >> 4;
  const int achunk = tid & 7, arow0 = tid >> 3;
  const int oa0 = lds_off(arow0, achunk), oa1 = lds_off(arow0 + 32, achunk), oa2 = lds_off(arow0 + 64, achunk), oa3 = lds_off(arow0 + 96, achunk);
  uint4 ra0, ra1, ra2, ra3, rb0, rb1, rb2, rb3;
#define G128_LOADBB(kt) { \
    ra0 = aload(0, arow0, (kt) * 8 + achunk); ra1 = aload(1, arow0 + 32, (kt) * 8 + achunk); \
    ra2 = aload(2, arow0 + 64, (kt) * 8 + achunk); ra3 = aload(3, arow0 + 96, (kt) * 8 + achunk); \
    rb0 = bload(0, arow0, (kt) * 8 + achunk); rb1 = bload(1, arow0 + 32, (kt) * 8 + achunk); \
    rb2 = bload(2, arow0 + 64, (kt) * 8 + achunk); rb3 = bload(3, arow0 + 96, (kt) * 8 + achunk); }
#define G128_STOREBB(bufoff) { \
    char* const sb_ = smem + (bufoff); \
    *(uint4*)(sb_ + oa0) = ra0; *(uint4*)(sb_ + oa1) = ra1; *(uint4*)(sb_ + oa2) = ra2; *(uint4*)(sb_ + oa3) = ra3; \
    *(uint4*)(sb_ + 16384 + oa0) = rb0; *(uint4*)(sb_ + 16384 + oa1) = rb1; *(uint4*)(sb_ + 16384 + oa2) = rb2; *(uint4*)(sb_ + 16384 + oa3) = rb3; }
  G128_LOADBB(0)
  G128_STOREBB(0)
  if (nk > 1) G128_LOADBB(1)
  __syncthreads();
  for (int kt = 0; kt < nk; ++kt) {
    const int cur = (kt & 1) * 32768;
    __builtin_amdgcn_sched_barrier(0);
    G128_MMA(cur)
    __builtin_amdgcn_sched_barrier(0);
    if (kt + 1 < nk) {
      G128_STOREBB(cur ^ 32768)
      __builtin_amdgcn_sched_barrier(0);
      if (kt + 2 < nk) G128_LOADBB(kt + 2)
    }
    __builtin_amdgcn_sched_barrier(0);
    __syncthreads();
  }
#undef G128_LOADBB
#undef G128_STOREBB
}
template <class ARow, class BRow, class Epi>
__device__ __forceinline__ void gemm128_bb(char* smem, const int K, ARow arow, BRow brow, Epi epi) {
  const int tid = threadIdx.x, lane = tid & 63, wid = tid >> 6;
  const int arow0 = tid >> 3;
  const bf16_t* ap0 = arow(arow0); const bf16_t* ap1 = arow(arow0 + 32); const bf16_t* ap2 = arow(arow0 + 64); const bf16_t* ap3 = arow(arow0 + 96);
  const bf16_t* bp0 = brow(arow0); const bf16_t* bp1 = brow(arow0 + 32); const bf16_t* bp2 = brow(arow0 + 64); const bf16_t* bp3 = brow(arow0 + 96);
  f32x4 acc[4][4];
  acc_zero(acc);
  gemm128_acc_bb(acc, smem, K >> 6,
      [=](int u, int, int kc) { const bf16_t* q = (u == 0) ? ap0 : (u == 1) ? ap1 : (u == 2) ? ap2 : ap3; return *(const uint4*)(q + kc * 8); },
      [=](int u, int, int kc) { const bf16_t* q = (u == 0) ? bp0 : (u == 1) ? bp1 : (u == 2) ? bp2 : bp3; return *(const uint4*)(q + kc * 8); });
  epi(acc, wid >> 1, wid & 1, lane & 15, lane >> 4);
}

#define DPP_F(v, ctrl) __builtin_bit_cast(float, __builtin_amdgcn_update_dpp(0, __builtin_bit_cast(int, (v)), (ctrl), 0xF, 0xF, true))
__device__ __forceinline__ float rdlane_f(float v, int l) { return __builtin_bit_cast(float, __builtin_amdgcn_readlane(__builtin_bit_cast(int, v), l)); }
__device__ __forceinline__ float dpp_sum16x(float v) {
  v += DPP_F(v, 0xB1); v += DPP_F(v, 0x4E); v += DPP_F(v, 0x141); v += DPP_F(v, 0x140);
  return v;
}
__device__ __forceinline__ float dpp_max16x(float v) {
  v = fmaxf(v, DPP_F(v, 0xB1)); v = fmaxf(v, DPP_F(v, 0x4E)); v = fmaxf(v, DPP_F(v, 0x141)); v = fmaxf(v, DPP_F(v, 0x140));
  return v;
}
__device__ __forceinline__ float wave_sum_fast(float v) {
  v = dpp_sum16x(v);
  return (rdlane_f(v, 0) + rdlane_f(v, 16)) + (rdlane_f(v, 32) + rdlane_f(v, 48));
}
__device__ __forceinline__ float wave_max_fast(float v) {
  v = dpp_max16x(v);
  return fmaxf(fmaxf(rdlane_f(v, 0), rdlane_f(v, 16)), fmaxf(rdlane_f(v, 32), rdlane_f(v, 48)));
}
__device__ __forceinline__ float fast_tanh(float x) { const float e = __expf(2.f * x); return 1.f - 2.f / (e + 1.f); }


__device__ __forceinline__ float4 bf4_to_f4(uint2 u) {
  float4 r;
  r.x = __uint_as_float(u.x << 16); r.y = __uint_as_float(u.x & 0xffff0000u);
  r.z = __uint_as_float(u.y << 16); r.w = __uint_as_float(u.y & 0xffff0000u);
  return r;
}
__device__ __forceinline__ uint2 pack4(float a, float b, float c, float d) { uint2 r; r.x = cvtpk(a, b); r.y = cvtpk(c, d); return r; }
#define XCD_GROUP (blockIdx.x & 7)
#define XCD_LB (blockIdx.x >> 3)
#define XCD_NB ((gridDim.x + 7 - (blockIdx.x & 7)) >> 3)

__device__ __forceinline__ void phase_inproj(const Params& p, char* smem) {
  const bf16_t* __restrict__ XB = (const bf16_t*)(p.ws + OFF_XB);
  const bf16_t* __restrict__ WINT = (const bf16_t*)(p.ws + OFF_WINT);
  const float* __restrict__ rope = (const float*)(p.ws + OFF_ROPE);
  bf16_t* Q = (bf16_t*)(p.ws + OFF_Q); bf16_t* K = (bf16_t*)(p.ws + OFF_K); bf16_t* V = (bf16_t*)(p.ws + OFF_V);
  bf16_t* FE = (bf16_t*)(p.ws + OFF_FEATS);
  const int NT = 27, NITEM = (T_TOK / 128) * NT, CHUNK = NITEM / 8;
  for (int i = XCD_LB; i < CHUNK; i += XCD_NB) {
    const int item = XCD_GROUP * CHUNK + i;
    const int row0 = (item & 255) * 128, col0 = (item >> 8) * 128;
    gemm128_bb(smem, DM,
            [=](int r) { return XB + (size_t)(row0 + r) * DM; },
            [=](int r) { return WINT + (size_t)(col0 + r) * DM; },
            [=](f32x4 (&acc)[4][4], int wr, int wc, int fr, int fq) {
              const int cb = col0 + wc * 64;
              if (cb >= INW) return;
#pragma unroll
              for (int m = 0; m < 4; ++m) {
                const int t = row0 + wr * 64 + m * 16 + fr;
                if (cb < 1024) {
                  const int pos = t & (SEQ - 1);
                  bf16_t* dst = (cb < 512) ? (Q + (size_t)t * 512 + cb) : (K + (size_t)t * 512 + (cb - 512));
                  const float sc = (cb < 512) ? 0.125f : 1.f;
#pragma unroll
                  for (int n = 0; n < 2; ++n) {
                    const int f0 = n * 16 + fq * 4;
                    const float4 c01 = *(const float4*)(rope + (size_t)(pos * 32 + f0) * 2);
                    const float4 c23 = *(const float4*)(rope + (size_t)(pos * 32 + f0) * 2 + 4);
                    const float cs[4] = {c01.x, c01.z, c23.x, c23.z}, sn[4] = {c01.y, c01.w, c23.y, c23.w};
                    float o1[4], o2[4];
#pragma unroll
                    for (int j = 0; j < 4; ++j) {
                      const float z1 = acc[m][n][j], z2 = acc[m][n + 2][j];
                      o1[j] = (z1 * cs[j] - z2 * sn[j]) * sc; o2[j] = (z2 * cs[j] + z1 * sn[j]) * sc;
                    }
                    *(uint2*)(dst + f0) = pack4(o1[0], o1[1], o1[2], o1[3]);
                    *(uint2*)(dst + 32 + f0) = pack4(o2[0], o2[1], o2[2], o2[3]);
                  }
                } else if (cb < 1536) {
#pragma unroll
                  for (int n = 0; n < 4; ++n)
                    *(uint2*)(V + (size_t)t * 512 + (cb - 1024) + n * 16 + fq * 4) = pack4(acc[m][n][0], acc[m][n][1], acc[m][n][2], acc[m][n][3]);
                } else {
#pragma unroll
                  for (int n = 0; n < 4; ++n) {
                    const int c = cb + n * 16 + fq * 4;
                    if (c < INW) *(uint2*)(FE + (size_t)t * FEW + (c - 1536)) = pack4(acc[m][n][0], acc[m][n][1], acc[m][n][2], acc[m][n][3]);
                  }
                }
              }
            });
  }
}

__device__ __forceinline__ void phase_prep_a(const Params& p) {
  const bf16_t* __restrict__ FE = (const bf16_t*)(p.ws + OFF_FEATS);
  const float* __restrict__ mu = p.in[2];
  bf16_t* R = (bf16_t*)(p.ws + OFF_R); bf16_t* K2 = (bf16_t*)(p.ws + OFF_K2); bf16_t* V2 = (bf16_t*)(p.ws + OFF_V2);
  bf16_t* ACT = (bf16_t*)(p.ws + OFF_ACT);
  for (size_t i = (size_t)blockIdx.x * NTHR + threadIdx.x; i < (size_t)T_TOK * 232; i += (size_t)gridDim.x * NTHR) {
    const int t = (int)(i / 232), ch = (int)(i - (size_t)t * 232);
    if (ch >= 228) { *(uint4*)(ACT + (size_t)t * 320 + 288 + (ch - 228) * 8) = make_uint4(0u, 0u, 0u, 0u); continue; }
    const int col = ch * 8;
    const uint4 cu = *(const uint4*)(FE + (size_t)t * FEW + col);
    uint4 pv = make_uint4(0u, 0u, 0u, 0u);
    if ((t & (SEQ - 1)) != 0) pv = *(const uint4*)(FE + (size_t)(t - 1) * FEW + col);
    const float4 m0 = *(const float4*)(mu + col), m1 = *(const float4*)(mu + col + 4);
    const unsigned cw[4] = {cu.x, cu.y, cu.z, cu.w}, pw[4] = {pv.x, pv.y, pv.z, pv.w};
    const float mm[8] = {m0.x, m0.y, m0.z, m0.w, m1.x, m1.y, m1.z, m1.w};
    float f[8];
#pragma unroll
    for (int q = 0; q < 4; ++q) {
      const float c0 = __uint_as_float(cw[q] << 16), c1 = __uint_as_float(cw[q] & 0xffff0000u);
      const float p0 = __uint_as_float(pw[q] << 16), p1 = __uint_as_float(pw[q] & 0xffff0000u);
      f[2 * q] = c0 + (p0 - c0) * mm[2 * q];
      f[2 * q + 1] = c1 + (p1 - c1) * mm[2 * q + 1];
    }
    bf16_t* dst;
    if (col < 512) dst = R + (size_t)t * 512 + col;
    else if (col < 1024) dst = K2 + (size_t)t * 512 + (col - 512);
    else if (col < 1536) dst = V2 + (size_t)t * 512 + (col - 1024);
    else {
      dst = ACT + (size_t)t * 320 + (col - 1536);
      if (col < 1600) {
#pragma unroll
        for (int q = 0; q < 8; ++q) f[q] = fast_tanh(f[q]);
      } else if (col >= 1664) {
#pragma unroll
        for (int q = 0; q < 8; ++q) f[q] = sigmoidf_(f[q]);
      }
    }
    uint4 w; w.x = cvtpk(f[0], f[1]); w.y = cvtpk(f[2], f[3]); w.z = cvtpk(f[4], f[5]); w.w = cvtpk(f[6], f[7]);
    *(uint4*)dst = w;
  }
}

template <int PASS>
__device__ __forceinline__ void prep_item(const Params& p, char* smem, const int row0, const int col0) {
  const bf16_t* __restrict__ ACT = (const bf16_t*)(p.ws + OFF_ACT);
  constexpr int ACOL = PASS * 64;
  constexpr int NK = (PASS == 2) ? 3 : 1;
  const float* __restrict__ Wm = (PASS == 0) ? p.in[4] : (PASS == 1) ? p.in[6] : p.in[7];
  f32x4 acc[4][4];
  acc_zero(acc);
  gemm128_acc<0, (PASS == 2)>(acc, smem, NK,
      [=](int, int rowl, int kc) { return *(const uint4*)(ACT + (size_t)(row0 + rowl) * 320 + ACOL + kc * 8); },
      [=](int nq) { return Wm + col0 + nq * 4; }, 512, 160);
  const int tid = threadIdx.x, lane = tid & 63, wid = tid >> 6;
  const int wr = wid >> 1, wc = wid & 1, fr = lane & 15, fq = lane >> 4;
  const int cb = col0 + wc * 64;
  if (PASS == 0) {
    const float* __restrict__ w0 = p.in[3];
    float* W = (float*)(p.ws + OFF_W);
#pragma unroll
    for (int n = 0; n < 4; ++n) {
      const int c = cb + n * 16 + fq * 4;
      const float4 w04 = *(const float4*)(w0 + c);
      const float w0c[4] = {w04.x, w04.y, w04.z, w04.w};
#pragma unroll
      for (int m = 0; m < 4; ++m) {
        const int t = row0 + wr * 64 + m * 16 + fr;
        float d[4];
#pragma unroll
        for (int j = 0; j < 4; ++j) {
          const float nz = -(w0c[j] + acc[m][n][j]);
          const float sp = fmaxf(nz, 0.f) + __logf(1.f + __expf(-fabsf(nz)));
          d[j] = __expf(-__expf(-sp - 0.5f));
        }
        *(float4*)(W + (size_t)t * 512 + c) = make_float4(d[0], d[1], d[2], d[3]);
      }
    }
  } else if (PASS == 2) {
    bf16_t* G = (bf16_t*)(p.ws + OFF_G);
#pragma unroll
    for (int m = 0; m < 4; ++m) {
      const int t = row0 + wr * 64 + m * 16 + fr;
#pragma unroll
      for (int n = 0; n < 4; ++n)
        *(uint2*)(G + (size_t)t * 512 + cb + n * 16 + fq * 4) = pack4(acc[m][n][0], acc[m][n][1], acc[m][n][2], acc[m][n][3]);
    }
  } else {
    const float* __restrict__ a0 = p.in[5]; const float* __restrict__ k_k = p.in[8]; const float* __restrict__ k_a = p.in[9];
    const float* __restrict__ r_k = p.in[10];
    const bf16_t* __restrict__ R = (const bf16_t*)(p.ws + OFF_R); bf16_t* K2 = (bf16_t*)(p.ws + OFF_K2);
    bf16_t* A = (bf16_t*)(p.ws + OFF_A); bf16_t* B = (bf16_t*)(p.ws + OFF_B); float* SB = (float*)(p.ws + OFF_SB);
#pragma unroll
    for (int m = 0; m < 4; ++m) {
      __builtin_amdgcn_sched_barrier(0);
      const int t = row0 + wr * 64 + m * 16 + fr;
      float kk[4][4];
      float ssp = 0.f, sbp = 0.f;
#pragma unroll
      for (int n = 0; n < 4; ++n) {
        const int c = cb + n * 16 + fq * 4;
        const size_t o = (size_t)t * 512 + c;
        const float4 rr4 = bf4_to_f4(*(const uint2*)(R + o)), kx4 = bf4_to_f4(*(const uint2*)(K2 + o));
        const float rr[4] = {rr4.x, rr4.y, rr4.z, rr4.w}, kx[4] = {kx4.x, kx4.y, kx4.z, kx4.w};
        const float4 a04 = *(const float4*)(a0 + c), kk4 = *(const float4*)(k_k + c), ka4 = *(const float4*)(k_a + c), rk4 = *(const float4*)(r_k + c);
        const float a0c[4] = {a04.x, a04.y, a04.z, a04.w}, kkc[4] = {kk4.x, kk4.y, kk4.z, kk4.w}, kac[4] = {ka4.x, ka4.y, ka4.z, ka4.w};
        const float rkc[4] = {rk4.x, rk4.y, rk4.z, rk4.w};
        float k2[4];
#pragma unroll
        for (int j = 0; j < 4; ++j) {
          const float av = sigmoidf_(a0c[j] + acc[m][n][j]);
          acc[m][n][j] = av;
          kk[n][j] = kx[j] * kkc[j];
          k2[j] = kx[j] * (1.f + (av - 1.f) * kac[j]);
          ssp += kk[n][j] * kk[n][j];
          sbp += rr[j] * k2[j] * rkc[j];
        }
        *(uint2*)(K2 + o) = pack4(k2[0], k2[1], k2[2], k2[3]);
      }
      ssp += __shfl_xor(ssp, 16, 64); ssp += __shfl_xor(ssp, 32, 64);
      sbp += __shfl_xor(sbp, 16, 64); sbp += __shfl_xor(sbp, 32, 64);
      const float inv = 1.f / fmaxf(sqrtf(ssp), 1e-12f);
#pragma unroll
      for (int n = 0; n < 4; ++n) {
        const size_t o = (size_t)t * 512 + cb + n * 16 + fq * 4;
        *(uint2*)(A + o) = pack4(-kk[n][0] * inv, -kk[n][1] * inv, -kk[n][2] * inv, -kk[n][3] * inv);
        *(uint2*)(B + o) = pack4(kk[n][0] * inv * acc[m][n][0], kk[n][1] * inv * acc[m][n][1], kk[n][2] * inv * acc[m][n][2], kk[n][3] * inv * acc[m][n][3]);
      }
      if (fq == 0) SB[(size_t)t * 8 + (cb >> 6)] = sbp;
    }
  }
}
__device__ __forceinline__ void phase_prep(const Params& p, char* smem) {
  for (int item = blockIdx.x; item < (T_TOK / 128) * 12; item += gridDim.x) {
    const int mt = item / 12, sub = item - mt * 12, pass = sub >> 2, nt = sub & 3;
    if (pass == 0) prep_item<0>(p, smem, mt * 128, nt * 128);
    else if (pass == 1) prep_item<1>(p, smem, mt * 128, nt * 128);
    else prep_item<2>(p, smem, mt * 128, nt * 128);
  }
}

__device__ __forceinline__ float dpp_sum16(float v) {
  v += __builtin_bit_cast(float, __builtin_amdgcn_update_dpp(0, __builtin_bit_cast(int, v), 0xB1, 0xF, 0xF, true));
  v += __builtin_bit_cast(float, __builtin_amdgcn_update_dpp(0, __builtin_bit_cast(int, v), 0x4E, 0xF, 0xF, true));
  v += __builtin_bit_cast(float, __builtin_amdgcn_update_dpp(0, __builtin_bit_cast(int, v), 0x141, 0xF, 0xF, true));
  v += __builtin_bit_cast(float, __builtin_amdgcn_update_dpp(0, __builtin_bit_cast(int, v), 0x140, 0xF, 0xF, true));
  return v;
}
#define SC_CH 16
#define SC_ARR (SC_CH * 64 * 4)
#define SC_BUF (5 * SC_ARR + SC_CH * 16 * 4)
__device__ __forceinline__ void phase_scan(const Params& p, char* smem) {
  if (blockIdx.x >= 256) return;
  const bf16_t* __restrict__ R = (const bf16_t*)(p.ws + OFF_R); const bf16_t* __restrict__ K2 = (const bf16_t*)(p.ws + OFF_K2);
  const bf16_t* __restrict__ V2 = (const bf16_t*)(p.ws + OFF_V2); const bf16_t* __restrict__ A = (const bf16_t*)(p.ws + OFF_A);
  const bf16_t* __restrict__ B = (const bf16_t*)(p.ws + OFF_B); const float* __restrict__ W = (const float*)(p.ws + OFF_W);
  float* YS = (float*)(p.ws + OFF_YS);
  const int bh = blockIdx.x >> 2, rg = blockIdx.x & 3, b = bh >> 3, h = bh & 7;
  const int tid = threadIdx.x, lane = tid & 63, wid = tid >> 6, j = lane & 15, rq = lane >> 4;
  const int rowl = wid * 4 + rq;
  const int ls = tid >> 4, lc = tid & 15;
  const int vs = (tid >> 2) & 15, vq = tid & 3;
  const size_t tb = (size_t)b * SEQ;
  const size_t goff = (tb + ls) * 512 + h * 64 + lc * 4;
  const size_t voff = (tb + vs) * 512 + h * 64 + rg * 16 + vq * 4;
  uint2 ga, gb, gk, gr, gv; float4 gw;
  gv = make_uint2(0u, 0u);
  ga = *(const uint2*)(A + goff); gb = *(const uint2*)(B + goff); gk = *(const uint2*)(K2 + goff); gr = *(const uint2*)(R + goff);
  gw = *(const float4*)(W + goff);
  if (tid < 64) gv = *(const uint2*)(V2 + voff);
  {
    char* bf = smem;
    *(float4*)(bf + 0 * SC_ARR + ls * 256 + lc * 16) = bf4_to_f4(ga);
    *(float4*)(bf + 1 * SC_ARR + ls * 256 + lc * 16) = gw;
    *(float4*)(bf + 2 * SC_ARR + ls * 256 + lc * 16) = bf4_to_f4(gb);
    *(float4*)(bf + 3 * SC_ARR + ls * 256 + lc * 16) = bf4_to_f4(gk);
    *(float4*)(bf + 4 * SC_ARR + ls * 256 + lc * 16) = bf4_to_f4(gr);
    if (tid < 64) *(float4*)(bf + 5 * SC_ARR + vs * 64 + vq * 16) = bf4_to_f4(gv);
  }
  __syncthreads();
  float s0 = 0.f, s1 = 0.f, s2 = 0.f, s3 = 0.f;
  const int NCH = SEQ / SC_CH;
  for (int c = 0; c < NCH; ++c) {
    if (c + 1 < NCH) {
      const size_t o2 = goff + (size_t)(c + 1) * SC_CH * 512;
      ga = *(const uint2*)(A + o2); gb = *(const uint2*)(B + o2); gk = *(const uint2*)(K2 + o2); gr = *(const uint2*)(R + o2);
      gw = *(const float4*)(W + o2);
      if (tid < 64) gv = *(const uint2*)(V2 + voff + (size_t)(c + 1) * SC_CH * 512);
    }
    const char* bf = smem + (c & 1) * SC_BUF;
    float ykeep = 0.f;
#pragma unroll
    for (int s = 0; s < SC_CH; ++s) {
      const float4 a4 = *(const float4*)(bf + 0 * SC_ARR + s * 256 + j * 16);
      const float4 w4 = *(const float4*)(bf + 1 * SC_ARR + s * 256 + j * 16);
      const float4 b4 = *(const float4*)(bf + 2 * SC_ARR + s * 256 + j * 16);
      const float4 k4 = *(const float4*)(bf + 3 * SC_ARR + s * 256 + j * 16);
      const float4 r4 = *(const float4*)(bf + 4 * SC_ARR + s * 256 + j * 16);
      const float vv = *(const float*)(bf + 5 * SC_ARR + s * 64 + rowl * 4);
      float sa = (s0 * a4.x + s1 * a4.y) + (s2 * a4.z + s3 * a4.w);
      sa = dpp_sum16(sa);
      s0 = s0 * w4.x + (sa * b4.x + vv * k4.x);
      s1 = s1 * w4.y + (sa * b4.y + vv * k4.y);
      s2 = s2 * w4.z + (sa * b4.z + vv * k4.z);
      s3 = s3 * w4.w + (sa * b4.w + vv * k4.w);
      float y = (s0 * r4.x + s1 * r4.y) + (s2 * r4.z + s3 * r4.w);
      y = dpp_sum16(y);
      ykeep = (j == s) ? y : ykeep;
    }
    YS[(tb + (size_t)c * SC_CH + j) * 512 + h * 64 + rg * 16 + rowl] = ykeep;
    if (c + 1 < NCH) {
      char* bn = smem + ((c + 1) & 1) * SC_BUF;
      *(float4*)(bn + 0 * SC_ARR + ls * 256 + lc * 16) = bf4_to_f4(ga);
      *(float4*)(bn + 1 * SC_ARR + ls * 256 + lc * 16) = gw;
      *(float4*)(bn + 2 * SC_ARR + ls * 256 + lc * 16) = bf4_to_f4(gb);
      *(float4*)(bn + 3 * SC_ARR + ls * 256 + lc * 16) = bf4_to_f4(gk);
      *(float4*)(bn + 4 * SC_ARR + ls * 256 + lc * 16) = bf4_to_f4(gr);
      if (tid < 64) *(float4*)(bn + 5 * SC_ARR + vs * 64 + vq * 16) = bf4_to_f4(gv);
    }
    __syncthreads();
  }
}

__device__ __forceinline__ int vt_off(int d, int key) { const int swz = ((d >> 2) & 15) ^ ((d & 3) << 3); return d * 512 + (((key >> 2) ^ swz) << 3); }
__device__ __forceinline__ void phase_attn(const Params& p, char* smem) {
  const bf16_t* __restrict__ Q = (const bf16_t*)(p.ws + OFF_Q); const bf16_t* __restrict__ K = (const bf16_t*)(p.ws + OFF_K);
  const bf16_t* __restrict__ V = (const bf16_t*)(p.ws + OFF_V);
  bf16_t* OP = (bf16_t*)(p.ws + OFF_OP); float* LSE = (float*)(p.ws + OFF_LSE);
  char* Ks = smem; char* VT = smem + 32768; float* linv_s = (float*)(smem + 65536);
  const int tid = threadIdx.x, lane = tid & 63, wid = tid >> 6, l31 = lane & 31, hi = lane >> 5;
  for (int item = blockIdx.x; item < 6144; item += gridDim.x) {
    const int pp = item >> 11, rem = item & 2047, bh = rem >> 5, sub = rem & 31;
    const int dsh = pp * 2, nbsh = 5 - dsh;
    const int r = sub >> nbsh, n = sub & ((1 << nbsh) - 1);
    const int b = bh >> 3, h = bh & 7, tb = b * SEQ;
    __syncthreads();
#pragma unroll
    for (int u = 0; u < 8; ++u) {
      const int row = (tid >> 3) + 32 * u, chunk = tid & 7;
      int ik = n * 128 - 128 + row; ik = ik < 0 ? 0 : ik;
      const int tok = tb + (ik << dsh) + r;
      *(uint4*)(Ks + lds_off(row, chunk)) = *(const uint4*)(K + (size_t)tok * 512 + h * 64 + chunk * 8);
    }
#pragma unroll
    for (int ps = 0; ps < 2; ++ps) {
      const int dq = tid & 15, kbase = ps * 128 + (tid >> 4) * 8;
      uint2 v0, v1, v2, v3, v4, v5, v6, v7;
#define LDV(i, dst) { int ik = n * 128 - 128 + kbase + i; ik = ik < 0 ? 0 : ik; const int tok = tb + (ik << dsh) + r; dst = *(const uint2*)(V + (size_t)tok * 512 + h * 64 + dq * 4); }
      LDV(0, v0) LDV(1, v1) LDV(2, v2) LDV(3, v3) LDV(4, v4) LDV(5, v5) LDV(6, v6) LDV(7, v7)
#undef LDV
      {
        uint2 w;
        w.x = (v0.x & 0xffffu) | (v1.x << 16); w.y = (v2.x & 0xffffu) | (v3.x << 16);
        *(uint2*)(VT + vt_off(dq * 4 + 0, kbase)) = w;
        w.x = (v4.x & 0xffffu) | (v5.x << 16); w.y = (v6.x & 0xffffu) | (v7.x << 16);
        *(uint2*)(VT + vt_off(dq * 4 + 0, kbase + 4)) = w;
        w.x = (v0.x >> 16) | (v1.x & 0xffff0000u); w.y = (v2.x >> 16) | (v3.x & 0xffff0000u);
        *(uint2*)(VT + vt_off(dq * 4 + 1, kbase)) = w;
        w.x = (v4.x >> 16) | (v5.x & 0xffff0000u); w.y = (v6.x >> 16) | (v7.x & 0xffff0000u);
        *(uint2*)(VT + vt_off(dq * 4 + 1, kbase + 4)) = w;
        w.x = (v0.y & 0xffffu) | (v1.y << 16); w.y = (v2.y & 0xffffu) | (v3.y << 16);
        *(uint2*)(VT + vt_off(dq * 4 + 2, kbase)) = w;
        w.x = (v4.y & 0xffffu) | (v5.y << 16); w.y = (v6.y & 0xffffu) | (v7.y << 16);
        *(uint2*)(VT + vt_off(dq * 4 + 2, kbase + 4)) = w;
        w.x = (v0.y >> 16) | (v1.y & 0xffff0000u); w.y = (v2.y >> 16) | (v3.y & 0xffff0000u);
        *(uint2*)(VT + vt_off(dq * 4 + 3, kbase)) = w;
        w.x = (v4.y >> 16) | (v5.y & 0xffff0000u); w.y = (v6.y >> 16) | (v7.y & 0xffff0000u);
        *(uint2*)(VT + vt_off(dq * 4 + 3, kbase + 4)) = w;
      }
    }
    __syncthreads();
    const int iq = n * 128 + wid * 32 + l31;
    const int tq = tb + (iq << dsh) + r;
    bf16x8 qf[4];
#pragma unroll
    for (int ks = 0; ks < 4; ++ks) qf[ks] = *(const bf16x8*)(Q + (size_t)tq * 512 + h * 64 + ks * 16 + hi * 8);
    f32x16 st[5];
#pragma unroll
    for (int kb = 0; kb < 5; ++kb) {
      st[kb] = (f32x16){0.f, 0.f, 0.f, 0.f, 0.f, 0.f, 0.f, 0.f, 0.f, 0.f, 0.f, 0.f, 0.f, 0.f, 0.f, 0.f};
#pragma unroll
      for (int ks = 0; ks < 4; ++ks) {
        const bf16x8 kf = *(const bf16x8*)(Ks + lds_off(32 * (wid + kb) + l31, 2 * ks + hi));
        st[kb] = __builtin_amdgcn_mfma_f32_32x32x16_bf16(kf, qf[ks], st[kb], 0, 0, 0);
      }
    }
    float m = -INFINITY;
#pragma unroll
    for (int kb = 0; kb < 5; ++kb)
#pragma unroll
      for (int i = 0; i < 16; ++i) {
        const int kirel = 32 * kb + (i & 3) + 8 * (i >> 2) + 4 * hi;
        const bool valid = (kirel >= l31) && (kirel <= l31 + 128) && (n > 0 || (32 * wid + kirel) >= 128);
        const float s = valid ? st[kb][i] : -INFINITY;
        st[kb][i] = s;
        m = fmaxf(m, s);
      }
    m = fmaxf(m, __shfl_xor(m, 32, 64));
    float l = 0.f;
#pragma unroll
    for (int kb = 0; kb < 5; ++kb)
#pragma unroll
      for (int i = 0; i < 16; ++i) { const float pe = __expf(st[kb][i] - m); st[kb][i] = pe; l += pe; }
    l += __shfl_xor(l, 32, 64);
    f32x16 o0 = (f32x16){0.f, 0.f, 0.f, 0.f, 0.f, 0.f, 0.f, 0.f, 0.f, 0.f, 0.f, 0.f, 0.f, 0.f, 0.f, 0.f};
    f32x16 o1 = o0;
#pragma unroll
    for (int kb = 0; kb < 5; ++kb)
#pragma unroll
      for (int s = 0; s < 2; ++s) {
        union { unsigned u[4]; bf16x8 v; } pa;
        pa.u[0] = cvtpk(st[kb][8 * s + 0], st[kb][8 * s + 1]); pa.u[1] = cvtpk(st[kb][8 * s + 2], st[kb][8 * s + 3]);
        pa.u[2] = cvtpk(st[kb][8 * s + 4], st[kb][8 * s + 5]); pa.u[3] = cvtpk(st[kb][8 * s + 6], st[kb][8 * s + 7]);
        const int key0 = 32 * (wid + kb) + 16 * s + 4 * hi;
        {
          union { uint2 u[2]; bf16x8 v; } vb;
          vb.u[0] = *(const uint2*)(VT + vt_off(l31, key0)); vb.u[1] = *(const uint2*)(VT + vt_off(l31, key0 + 8));
          o0 = __builtin_amdgcn_mfma_f32_32x32x16_bf16(pa.v, vb.v, o0, 0, 0, 0);
        }
        {
          union { uint2 u[2]; bf16x8 v; } vb;
          vb.u[0] = *(const uint2*)(VT + vt_off(32 + l31, key0)); vb.u[1] = *(const uint2*)(VT + vt_off(32 + l31, key0 + 8));
          o1 = __builtin_amdgcn_mfma_f32_32x32x16_bf16(pa.v, vb.v, o1, 0, 0, 0);
        }
      }
    if (hi == 0) {
      linv_s[wid * 32 + l31] = 1.f / l;
      LSE[((size_t)pp * T_TOK + tq) * 8 + h] = m + __logf(l);
    }
#pragma unroll
    for (int i = 0; i < 16; ++i) {
      const int qrel = (i & 3) + 8 * (i >> 2) + 4 * hi;
      const int iq2 = n * 128 + wid * 32 + qrel;
      const int tq2 = tb + (iq2 << dsh) + r;
      const float li = linv_s[wid * 32 + qrel];
      bf16_t* op = OP + ((size_t)pp * T_TOK + tq2) * 512 + h * 64 + l31;
      op[0] = f2bf(o0[i] * li);
      op[32] = f2bf(o1[i] * li);
    }
  }
}

__device__ __forceinline__ void phase_post(const Params& p) {
  const float* __restrict__ YS = (const float*)(p.ws + OFF_YS); const bf16_t* __restrict__ V2 = (const bf16_t*)(p.ws + OFF_V2);
  const bf16_t* __restrict__ G = (const bf16_t*)(p.ws + OFF_G); const float* __restrict__ SB = (const float*)(p.ws + OFF_SB);
  const bf16_t* __restrict__ OP = (const bf16_t*)(p.ws + OFF_OP); const float* __restrict__ LSE = (const float*)(p.ws + OFF_LSE);
  const float* __restrict__ lnx_g = p.in[11]; const float* __restrict__ lnx_b = p.in[12];
  bf16_t* MIXED = (bf16_t*)(p.ws + OFF_MIXED);
  const int tid = threadIdx.x;
  for (int t = blockIdx.x; t < T_TOK; t += gridDim.x) {
#pragma unroll
    for (int pass = 0; pass < 2; ++pass) {
      int c = tid + pass * 256;
      size_t o = (size_t)t * 512 + c;
      float y = YS[o];
      float mean = wave_sum(y) * (1.f / 64.f);
      float d = y - mean;
      float var = wave_sum(d * d) * (1.f / 64.f);
      float yn = d * rsqrtf(var + GN_EPS_F) * lnx_g[c] + lnx_b[c];
      float res = (yn + SB[(size_t)t * 8 + (c >> 6)] * bf2f(V2[o])) * bf2f(G[o]);
      MIXED[(size_t)t * 1024 + 512 + c] = f2bf(res);
      {
        const int hh = c >> 6;
        const float l0 = LSE[((size_t)0 * T_TOK + t) * 8 + hh], l1 = LSE[((size_t)1 * T_TOK + t) * 8 + hh], l2 = LSE[((size_t)2 * T_TOK + t) * 8 + hh];
        const float mx = fmaxf(l0, fmaxf(l1, l2));
        const float e0 = __expf(l0 - mx), e1 = __expf(l1 - mx), e2 = __expf(l2 - mx);
        const float inv = 1.f / (e0 + e1 + e2);
        const float av = (e0 * bf2f(OP[(size_t)0 * T_TOK * 512 + o]) + e1 * bf2f(OP[(size_t)1 * T_TOK * 512 + o]) + e2 * bf2f(OP[(size_t)2 * T_TOK * 512 + o])) * inv;
        MIXED[(size_t)t * 1024 + c] = f2bf(av);
      }
    }
  }
}

__device__ __forceinline__ void phase_outproj(const Params& p, char* smem) {
  const bf16_t* __restrict__ MIXED = (const bf16_t*)(p.ws + OFF_MIXED);
  const bf16_t* __restrict__ WOUTT = (const bf16_t*)(p.ws + OFF_WOUTT); const float* __restrict__ x = p.in[0];
  float* U = p.out;
  for (int i = XCD_LB; i < T_TOK / 128; i += XCD_NB) {
    const int row0 = i * 128, col0 = XCD_GROUP * 128;
    gemm128_bb(smem, DM,
            [=](int r) { return MIXED + (size_t)(row0 + r) * DM; },
            [=](int r) { return WOUTT + (size_t)(col0 + r) * DM; },
            [=](f32x4 (&acc)[4][4], int wr, int wc, int fr, int fq) {
#pragma unroll
              for (int m = 0; m < 4; ++m) {
                const int t = row0 + wr * 64 + m * 16 + fr;
#pragma unroll
                for (int n = 0; n < 4; ++n) {
                  const size_t o = (size_t)t * DM + col0 + wc * 64 + n * 16 + fq * 4;
                  const float4 xv = *(const float4*)(x + o);
                  *(float4*)(U + o) = make_float4(ALPHA_F * xv.x + acc[m][n][0], ALPHA_F * xv.y + acc[m][n][1], ALPHA_F * xv.z + acc[m][n][2], ALPHA_F * xv.w + acc[m][n][3]);
                }
              }
            });
  }
}

__device__ __forceinline__ void phase_ln1(const Params& p) {
  float* X1 = p.out;
  const float* __restrict__ g1 = p.in[14]; const float* __restrict__ b1 = p.in[15];
  bf16_t* X1B = (bf16_t*)(p.ws + OFF_X1B); bf16_t* XL = (bf16_t*)(p.ws + OFF_XL);
  const int lane = threadIdx.x & 63, wid = threadIdx.x >> 6;
  for (int t = blockIdx.x * 4 + wid; t < T_TOK; t += gridDim.x * 4) {
    const size_t base = (size_t)t * DM;
    float4 v[4];
    float s = 0.f;
#pragma unroll
    for (int u = 0; u < 4; ++u) { v[u] = *(const float4*)(X1 + base + u * 256 + lane * 4); s += (v[u].x + v[u].y) + (v[u].z + v[u].w); }
    const float mean = wave_sum_fast(s) * (1.f / DM);
    float q = 0.f;
#pragma unroll
    for (int u = 0; u < 4; ++u) {
      const float d0 = v[u].x - mean, d1 = v[u].y - mean, d2 = v[u].z - mean, d3 = v[u].w - mean;
      q += (d0 * d0 + d1 * d1) + (d2 * d2 + d3 * d3);
    }
    const float rs = rsqrtf(wave_sum_fast(q) * (1.f / DM) + LN_EPS_F);
#pragma unroll
    for (int u = 0; u < 4; ++u) {
      const int c = u * 256 + lane * 4;
      const float4 g = *(const float4*)(g1 + c), bb = *(const float4*)(b1 + c);
      float4 y;
      y.x = (v[u].x - mean) * rs * g.x + bb.x; y.y = (v[u].y - mean) * rs * g.y + bb.y;
      y.z = (v[u].z - mean) * rs * g.z + bb.z; y.w = (v[u].w - mean) * rs * g.w + bb.w;
      *(float4*)(X1 + base + c) = y;
      uint2 hi; hi.x = cvtpk(y.x, y.y); hi.y = cvtpk(y.z, y.w);
      *(uint2*)(X1B + base + c) = hi;
      uint2 lo;
      lo.x = cvtpk(y.x - __uint_as_float(hi.x << 16), y.y - __uint_as_float(hi.x & 0xffff0000u));
      lo.y = cvtpk(y.z - __uint_as_float(hi.y << 16), y.w - __uint_as_float(hi.y & 0xffff0000u));
      *(uint2*)(XL + base + c) = lo;
    }
  }
}

__device__ __forceinline__ void phase_router_gemm(const Params& p, char* smem) {
  const bf16_t* __restrict__ X1B = (const bf16_t*)(p.ws + OFF_X1B); const bf16_t* __restrict__ XL = (const bf16_t*)(p.ws + OFF_XL);
  const float* __restrict__ router_w = p.in[16];
  float* AFF = (float*)(p.ws + OFF_AFF);
  for (int item = blockIdx.x; item < (T_TOK / 128) * 2; item += gridDim.x) {
    const int row0 = (item >> 1) * 128, col0 = (item & 1) * 128;
    f32x4 acc[4][4];
    acc_zero(acc);
    gemm128_acc<2, false>(acc, smem, 48,
        [=](int, int rowl, int kc) { const bf16_t* base = ((kc >> 7) == 1) ? XL : X1B; return *(const uint4*)(base + (size_t)(row0 + rowl) * DM + (kc & 127) * 8); },
        [=](int nq) { return router_w + col0 + nq * 4; }, NEXP, 0);
    const int tid = threadIdx.x, lane = tid & 63, wid = tid >> 6;
    const int wr = wid >> 1, wc = wid & 1, fr = lane & 15, fq = lane >> 4;
#pragma unroll
    for (int m = 0; m < 4; ++m) {
      const int t = row0 + wr * 64 + m * 16 + fr;
#pragma unroll
      for (int n = 0; n < 4; ++n)
        *(float4*)(AFF + (size_t)t * NEXP + col0 + wc * 64 + n * 16 + fq * 4) =
            make_float4(sigmoidf_(acc[m][n][0]), sigmoidf_(acc[m][n][1]), sigmoidf_(acc[m][n][2]), sigmoidf_(acc[m][n][3]));
    }
  }
}

__device__ __forceinline__ void phase_topk(const Params& p) {
  const float* __restrict__ AFF = (const float*)(p.ws + OFF_AFF);
  const float* __restrict__ router_bias = p.in[17];
  int* LIST = (int*)(p.ws + OFF_LIST); float* GATEW = (float*)(p.ws + OFF_GATEW);
  int* counts = (int*)(p.ws + OFF_CTL);
  const int lane = threadIdx.x & 63, wid = threadIdx.x >> 6;
  const float4 b4 = *(const float4*)(router_bias + lane * 4);
  for (int t = blockIdx.x * 4 + wid; t < T_TOK; t += gridDim.x * 4) {
    const float4 a4 = *(const float4*)(AFF + (size_t)t * NEXP + lane * 4);
    float s0 = a4.x + b4.x, s1 = a4.y + b4.y, s2 = a4.z + b4.z, s3 = a4.w + b4.w;
    const float hi01 = fmaxf(s0, s1), lo01 = fminf(s0, s1), hi23 = fmaxf(s2, s3), lo23 = fminf(s2, s3);
    float m1 = fmaxf(hi01, hi23), m2 = fmaxf(fminf(hi01, hi23), fmaxf(lo01, lo23));
    { const float o1 = DPP_F(m1, 0xB1), o2 = DPP_F(m2, 0xB1); const float n1 = fmaxf(m1, o1); m2 = fmaxf(fminf(m1, o1), fmaxf(m2, o2)); m1 = n1; }
    { const float o1 = DPP_F(m1, 0x4E), o2 = DPP_F(m2, 0x4E); const float n1 = fmaxf(m1, o1); m2 = fmaxf(fminf(m1, o1), fmaxf(m2, o2)); m1 = n1; }
    { const float o1 = DPP_F(m1, 0x141), o2 = DPP_F(m2, 0x141); const float n1 = fmaxf(m1, o1); m2 = fmaxf(fminf(m1, o1), fmaxf(m2, o2)); m1 = n1; }
    const float gs = m1 + m2;
    const int g = lane >> 3;
    int rank = 0;
#pragma unroll
    for (int gg = 0; gg < 8; ++gg) { const float G = rdlane_f(gs, gg * 8); rank += ((G > gs) || (G == gs && gg < g)) ? 1 : 0; }
    if (rank >= 4) { s0 = -INFINITY; s1 = -INFINITY; s2 = -INFINITY; s3 = -INFINITY; }
    int my_e = 0; float my_a = 0.f;
#pragma unroll 1
    for (int it = 0; it < 8; ++it) {
      const float lm = fmaxf(fmaxf(s0, s1), fmaxf(s2, s3));
      const float wm = wave_max_fast(lm);
      const unsigned long long bal = __ballot(lm == wm);
      const int win = __ffsll((long long)bal) - 1;
      const int wi = (s0 == wm) ? 0 : ((s1 == wm) ? 1 : ((s2 == wm) ? 2 : 3));
      const float wa = (wi == 0) ? a4.x : ((wi == 1) ? a4.y : ((wi == 2) ? a4.z : a4.w));
      const int e_w = __builtin_amdgcn_readlane(lane * 4 + wi, win);
      const float a_w = rdlane_f(wa, win);
      if (lane == win) { if (wi == 0) s0 = -INFINITY; else if (wi == 1) s1 = -INFINITY; else if (wi == 2) s2 = -INFINITY; else s3 = -INFINITY; }
      if (lane == it) { my_e = e_w; my_a = a_w; }
    }
    const float asum = rdlane_f(dpp_sum16x(my_a), 0);
    if (lane < 8) {
      const int pos = atomicAdd(&counts[my_e], 1);
      LIST[(size_t)my_e * T_TOK + pos] = lane * T_TOK + t;
      GATEW[(size_t)lane * T_TOK + t] = my_a * 2.5f / asum;
    }
  }
}

__device__ __forceinline__ int moe_group_setup(const int* counts, int* pre, const int NT) {
  __syncthreads();
  if (threadIdx.x == 0) {
    const int g = XCD_GROUP;
    int acc = 0;
    for (int j = 0; j < 32; ++j) { pre[j] = acc; acc += ((counts[g + 8 * j] + 127) >> 7) * NT; }
    pre[32] = acc; acc += 32 * NT;
    pre[33] = acc;
  }
  __syncthreads();
  return pre[33];
}
struct MoeItem { int e, nt, r0, cnt; };
__device__ __forceinline__ MoeItem moe_item(const int* counts, const int* pre, const int i) {
  int j = 0;
#pragma unroll 1
  for (int q = 1; q <= 32; ++q) j = (pre[q] <= i) ? q : j;
  MoeItem it;
  const int w = i - pre[j];
  if (j < 32) {
    it.e = XCD_GROUP + 8 * j; it.cnt = counts[it.e];
    const int tiles = (it.cnt + 127) >> 7;
    it.nt = w / tiles; it.r0 = (w - it.nt * tiles) * 128;
  } else {
    it.e = NEXP; it.cnt = T_TOK; it.nt = w >> 5; it.r0 = (XCD_GROUP * 32 + (w & 31)) * 128;
  }
  return it;
}

__device__ __forceinline__ void phase_moe1(const Params& p, char* smem) {
  int* asg = (int*)(smem + 65536); int* pre = asg + 128;
  const bf16_t* __restrict__ X1B = (const bf16_t*)(p.ws + OFF_X1B);
  const int* __restrict__ LIST = (const int*)(p.ws + OFF_LIST);
  const int* counts = (const int*)(p.ws + OFF_CTL);
  bf16_t* H = (bf16_t*)(p.ws + OFF_H);
  const int nitems = moe_group_setup(counts, pre, 4);
  for (int i = XCD_LB; i < nitems; i += XCD_NB) {
    const MoeItem it = moe_item(counts, pre, i);
    const int e = it.e, nt = it.nt, r0 = it.r0, cnt = it.cnt;
    __syncthreads();
    if (threadIdx.x < 128) {
      int r = r0 + threadIdx.x;
      asg[threadIdx.x] = (r < cnt) ? ((e < NEXP) ? LIST[(size_t)e * T_TOK + r] : (8 * T_TOK + r)) : -1;
    }
    __syncthreads();
    const float* __restrict__ Wg = (e < NEXP) ? p.in[18] + (size_t)e * DM * 256 : p.in[21];
    const float* __restrict__ Wu = (e < NEXP) ? p.in[19] + (size_t)e * DM * 256 : p.in[22];
    gemm128(smem, DM,
            [=](int r) { int a = asg[r]; return X1B + (size_t)((a >= 0 ? a : 0) & (T_TOK - 1)) * DM; },
            [=](int nq) { const long long dlt = ((nq >> 2) & 2) ? (long long)(Wu - Wg) : 0ll; return Wg + dlt + nt * 64 + (nq >> 4) * 32 + ((nq >> 2) & 1) * 16 + (nq & 3) * 4; },
            256,
            [=](f32x4 (&acc)[4][4], int wr, int wc, int fr, int fq) {
#pragma unroll
              for (int m = 0; m < 4; ++m) {
                const int a = asg[wr * 64 + m * 16 + fr];
                if (a < 0) continue;
#pragma unroll
                for (int n = 0; n < 2; ++n) {
                  float hv[4];
#pragma unroll
                  for (int j = 0; j < 4; ++j) { const float g = acc[m][n][j], u = acc[m][n + 2][j]; hv[j] = g * sigmoidf_(g) * u; }
                  *(uint2*)(H + (size_t)a * 256 + nt * 64 + wc * 32 + n * 16 + fq * 4) = pack4(hv[0], hv[1], hv[2], hv[3]);
                }
              }
            });
  }
}

__device__ __forceinline__ void phase_moe2(const Params& p, char* smem) {
  int* asg = (int*)(smem + 65536); int* pre = asg + 128;
  const bf16_t* __restrict__ H = (const bf16_t*)(p.ws + OFF_H);
  const int* __restrict__ LIST = (const int*)(p.ws + OFF_LIST);
  const float* __restrict__ GATEW = (const float*)(p.ws + OFF_GATEW);
  const int* counts = (const int*)(p.ws + OFF_CTL);
  bf16_t* Y = (bf16_t*)(p.ws + OFF_Y);
  const int nitems = moe_group_setup(counts, pre, 8);
  for (int i = XCD_LB; i < nitems; i += XCD_NB) {
    const MoeItem it = moe_item(counts, pre, i);
    const int e = it.e, nt = it.nt, r0 = it.r0, cnt = it.cnt;
    __syncthreads();
    if (threadIdx.x < 128) {
      int r = r0 + threadIdx.x;
      asg[threadIdx.x] = (r < cnt) ? ((e < NEXP) ? LIST[(size_t)e * T_TOK + r] : (8 * T_TOK + r)) : -1;
    }
    __syncthreads();
    const float* __restrict__ Wd = (e < NEXP) ? p.in[20] + (size_t)e * 256 * DM : p.in[23];
    gemm128(smem, 256,
            [=](int r) { int a = asg[r]; return H + (size_t)(a >= 0 ? a : 0) * 256; },
            [=](int nq) { return Wd + nt * 128 + nq * 4; },
            DM,
            [=](f32x4 (&acc)[4][4], int wr, int wc, int fr, int fq) {
#pragma unroll
              for (int m = 0; m < 4; ++m) {
                const int a = asg[wr * 64 + m * 16 + fr];
                if (a < 0) continue;
                const float gw = (a < 8 * T_TOK) ? GATEW[a] : 1.f;
#pragma unroll
                for (int n = 0; n < 4; ++n)
                  *(uint2*)(Y + (size_t)a * DM + nt * 128 + wc * 64 + n * 16 + fq * 4) =
                      pack4(acc[m][n][0] * gw, acc[m][n][1] * gw, acc[m][n][2] * gw, acc[m][n][3] * gw);
              }
            });
  }
}

__device__ __forceinline__ void phase_final(const Params& p, char* smem) {
  float* red = (float*)smem;
  float* OUT = p.out;
  const bf16_t* __restrict__ Y = (const bf16_t*)(p.ws + OFF_Y);
  const float* __restrict__ g2 = p.in[24]; const float* __restrict__ b2 = p.in[25];
  const int tid = threadIdx.x, lane = tid & 63, wid = tid >> 6;
  for (int t = blockIdx.x; t < T_TOK; t += gridDim.x) {
    size_t base = (size_t)t * DM;
    float v[4];
    float s = 0.f;
#pragma unroll
    for (int u = 0; u < 4; ++u) {
      int c = tid + u * 256;
      float acc = 0.f;
#pragma unroll
      for (int sl = 0; sl < 9; ++sl) acc += bf2f(Y[((size_t)sl * T_TOK + t) * DM + c]);
      v[u] = ALPHA_F * OUT[base + c] + acc;
      s += v[u];
    }
    s = wave_sum(s);
    if (lane == 0) red[wid] = s;
    __syncthreads();
    float mean = (red[0] + red[1] + red[2] + red[3]) * (1.f / DM);
    float q = 0.f;
#pragma unroll
    for (int u = 0; u < 4; ++u) { float d = v[u] - mean; q += d * d; }
    q = wave_sum(q);
    if (lane == 0) red[4 + wid] = q;
    __syncthreads();
    float var = (red[4] + red[5] + red[6] + red[7]) * (1.f / DM);
    float rs = rsqrtf(var + LN_EPS_F);
#pragma unroll
    for (int u = 0; u < 4; ++u) {
      int c = tid + u * 256;
      OUT[base + c] = (v[u] - mean) * rs * g2[c] + b2[c];
    }
    __syncthreads();
  }
}


#define LAS __attribute__((address_space(3)))
#define XB_TMO      128
#define XB_XCNT(j)  (256  + 64 * (j))
#define XB_XSUB(j)  (1280 + 64 * (j))
#define XB_XGEN(j)  (2304 + 64 * (j))
#define XB_TOP      3328
#define XB_TOPGEN   3392
#define XCD_BAR_WORDS 3456
#define XB_SPIN_CAP (1u << 22)
__device__ __forceinline__ unsigned xb_ld(unsigned* p)              { return __hip_atomic_load(p, __ATOMIC_RELAXED, __HIP_MEMORY_SCOPE_AGENT); }
__device__ __forceinline__ unsigned xb_add(unsigned* p, unsigned v) { return __hip_atomic_fetch_add(p, v, __ATOMIC_RELAXED, __HIP_MEMORY_SCOPE_AGENT); }
__device__ __forceinline__ unsigned xb_xcc_id() { return (unsigned)__builtin_amdgcn_s_getreg((3 << 11) | 20) & 0xFu; }
#define XB_SPIN(cond, bar) do { unsigned _sp = 0; while (cond) { __builtin_amdgcn_s_sleep(1); \
    if ((++_sp & 255u) == 0u) { if (xb_ld(&(bar)[XB_TMO])) break; if (_sp > XB_SPIN_CAP) { atomicAdd(&(bar)[XB_TMO], 1u); break; } } } } while (0)
struct XcdBarrier { unsigned* bar; unsigned x; volatile LAS unsigned* st; };
__device__ __forceinline__ XcdBarrier xcd_barrier_post(unsigned* bar, volatile LAS unsigned* st) {
  XcdBarrier b; b.bar = bar; b.x = xb_xcc_id(); b.st = st;
  if (threadIdx.x == 0) (void)xb_add(&bar[XB_XCNT(b.x)], 1u);
  return b;
}
__device__ __forceinline__ void xcd_barrier_complete(unsigned* bar, unsigned x, unsigned& nloc, unsigned& nx) {
  const unsigned G = gridDim.x * gridDim.y * gridDim.z;
  unsigned sum, cnt, mine, sp = 0u;
  for (;;) {
    sum = 0u; cnt = 0u; mine = 0u;
#pragma unroll
    for (unsigned j = 0; j < 16; ++j) { const unsigned c = xb_ld(&bar[XB_XCNT(j)]); sum += c; cnt += (c > 0u) ? 1u : 0u; mine = (j == x) ? c : mine; }
    if (sum == G) break;
    __builtin_amdgcn_s_sleep(1);
    if ((++sp & 255u) == 0u) { if (xb_ld(&bar[XB_TMO])) break; if (sp > XB_SPIN_CAP) { atomicAdd(&bar[XB_TMO], 1u); break; } }
  }
  nloc = mine > 0u ? mine : 1u; nx = cnt > 0u ? cnt : 1u;
}
__device__ __forceinline__ void xcd_barrier(const XcdBarrier& b) {
  asm volatile("s_waitcnt vmcnt(0)" ::: "memory");
  __syncthreads();
  if (threadIdx.x == 0) {
    unsigned* bar = b.bar;
    __builtin_amdgcn_s_waitcnt(0);
    unsigned nloc = b.st[0], nx = b.st[1];
    if (nloc == 0u) { xcd_barrier_complete(bar, b.x, nloc, nx); b.st[0] = nloc; b.st[1] = nx; }
    const unsigned old = xb_add(&bar[XB_XSUB(b.x)], 1u);
    const unsigned gen = old / nloc;
    if (old + 1u == (gen + 1u) * nloc) {
      __builtin_amdgcn_fence(__ATOMIC_RELEASE, "agent");
      asm volatile("s_waitcnt vmcnt(0)" ::: "memory");
      const unsigned og = xb_add(&bar[XB_TOP], 1u);
      const unsigned tg = og / nx;
      if (og + 1u == (tg + 1u) * nx) xb_add(&bar[XB_TOPGEN], 1u);
      else XB_SPIN(xb_ld(&bar[XB_TOPGEN]) == tg, bar);
      __builtin_amdgcn_fence(__ATOMIC_ACQUIRE, "agent");
      xb_add(&bar[XB_XGEN(b.x)], 1u);
      asm volatile("s_waitcnt vmcnt(0)" ::: "memory");
    } else {
      XB_SPIN(xb_ld(&bar[XB_XGEN(b.x)]) == gen, bar);
      __builtin_amdgcn_fence(__ATOMIC_ACQUIRE, "agent");
      asm volatile("s_waitcnt vmcnt(0)" ::: "memory");
    }
  }
  __syncthreads();
}
#define CTL_BAR_WORD 4096
#define CTL_ZERO_BYTES 32768
#define LDS_BAR_OFF 66432

__global__ void __launch_bounds__(NTHR, 2) mega(Params p) {
  extern __shared__ __attribute__((aligned(16))) char smem[];
  cg::grid_group grid = cg::this_grid();
  volatile LAS unsigned* bst = (volatile LAS unsigned*)(LAS char*)(smem + LDS_BAR_OFF);
  if (threadIdx.x < 2) bst[threadIdx.x] = 0u;
  __syncthreads();
  const XcdBarrier bar = xcd_barrier_post((unsigned*)(p.ws + OFF_CTL) + CTL_BAR_WORD, bst);
  phase_rope(p);
  grid.sync();
  phase_inproj(p, smem);
  xcd_barrier(bar);
  phase_prep_a(p);
  xcd_barrier(bar);
  phase_prep(p, smem);
  xcd_barrier(bar);
  phase_scan(p, smem);
  phase_attn(p, smem);
  xcd_barrier(bar);
  phase_post(p);
  xcd_barrier(bar);
  phase_outproj(p, smem);
  xcd_barrier(bar);
  phase_ln1(p);
  xcd_barrier(bar);
  phase_router_gemm(p, smem);
  xcd_barrier(bar);
  phase_topk(p);
  xcd_barrier(bar);
  phase_moe1(p, smem);
  xcd_barrier(bar);
  phase_moe2(p, smem);
  xcd_barrier(bar);
  phase_final(p, smem);
}

extern "C" void kernel_launch(void* const* d_in, const int* in_sizes, int n_in, void* d_out, int out_size, void* d_ws, size_t ws_size,
                              hipStream_t stream) {
  static int grid_blocks = 0;
  if (grid_blocks == 0) {
    if (ws_size < WS_NEED || n_in != 26) { fprintf(stderr, "kernel_launch: bad ws/n_in: %zu < %zu, n_in %d\n", ws_size, (size_t)WS_NEED, n_in); grid_blocks = -1; return; }
    int dev = 0, cus = 0, per_cu = 0;
    (void)hipGetDevice(&dev);
    (void)hipDeviceGetAttribute(&cus, hipDeviceAttributeMultiprocessorCount, dev);
    (void)hipFuncSetAttribute((const void*)mega, hipFuncAttributeMaxDynamicSharedMemorySize, LDS_BYTES);
    (void)hipOccupancyMaxActiveBlocksPerMultiprocessor(&per_cu, (const void*)mega, NTHR, LDS_BYTES);
    if (per_cu < 1) { fprintf(stderr, "kernel_launch: occupancy query returned %d\n", per_cu); grid_blocks = -1; return; }
    if (per_cu > 2) per_cu = 2;
    grid_blocks = cus * per_cu;
    fprintf(stderr, "kernel_launch: cus %d per_cu %d grid %d\n", cus, per_cu, grid_blocks);
  }
  if (grid_blocks < 0) return;
  if (hipMemsetAsync((char*)d_ws + OFF_CTL, 0, CTL_ZERO_BYTES, stream) != hipSuccess) { fprintf(stderr, "kernel_launch: memset failed\n"); return; }
  Params p{};
  for (int i = 0; i < 26; ++i) p.in[i] = (const float*)d_in[i];
  p.out = (float*)d_out;
  p.ws = (char*)d_ws;
  void* args[] = {&p};
  hipError_t e = hipLaunchCooperativeKernel((const void*)mega, dim3(grid_blocks), dim3(NTHR), args, LDS_BYTES, stream);
  if (e != hipSuccess) fprintf(stderr, "cooperative launch failed: %s (grid %d)\n", hipGetErrorString(e), grid_blocks);
}
```

```cpp
#include <hip/hip_runtime.h>
#include <hip/hip_bf16.h>
#include <hip/hip_cooperative_groups.h>
#include <stdint.h>
#include <stdio.h>

typedef unsigned short bf16_t;

#define T_TOK 32768
#define SEQ 4096
#define DM 1024
#define INW 3360
#define FEW 1824
#define NEXP 256
#define ALPHA_F 1.189207115002721f
#define LN_EPS_F 1e-5f
#define GN_EPS_F 64e-5f

__device__ __forceinline__ float bf2f(bf16_t v) { return __uint_as_float(((unsigned)v) << 16); }
__device__ __forceinline__ bf16_t f2bf(float f) { unsigned u = __float_as_uint(f); return (bf16_t)((u + 0x7fffu + ((u >> 16) & 1u)) >> 16); }
__device__ __forceinline__ float sigmoidf_(float x) { return 1.f / (1.f + __expf(-x)); }
__device__ __forceinline__ float wave_sum(float v) {
#pragma unroll
  for (int o = 32; o >= 1; o >>= 1) v += __shfl_xor(v, o, 64);
  return v;
}

constexpr size_t SZ_T512_BF = (size_t)T_TOK * 512 * 2;
constexpr size_t OFF_Q = 0;
constexpr size_t OFF_K = OFF_Q + SZ_T512_BF;
constexpr size_t OFF_V = OFF_K + SZ_T512_BF;
constexpr size_t OFF_FEATS = OFF_V + SZ_T512_BF;
constexpr size_t OFF_R = OFF_FEATS + (size_t)T_TOK * FEW * 2;
constexpr size_t OFF_K2 = OFF_R + SZ_T512_BF;
constexpr size_t OFF_V2 = OFF_K2 + SZ_T512_BF;
constexpr size_t OFF_A = OFF_V2 + SZ_T512_BF;
constexpr size_t OFF_B = OFF_A + SZ_T512_BF;
constexpr size_t OFF_W = OFF_B + SZ_T512_BF;
constexpr size_t OFF_G = OFF_W + (size_t)T_TOK * 512 * 4;
constexpr size_t OFF_SB = OFF_G + SZ_T512_BF;
constexpr size_t OFF_YS = OFF_SB + (size_t)T_TOK * 8 * 4;
constexpr size_t OFF_OP = OFF_YS + (size_t)T_TOK * 512 * 4;
constexpr size_t OFF_LSE = OFF_OP + 3 * SZ_T512_BF;
constexpr size_t OFF_MIXED = OFF_LSE + (size_t)3 * T_TOK * 8 * 4;
constexpr size_t OFF_ROPE = OFF_MIXED + (size_t)T_TOK * 1024 * 2;
constexpr size_t OFF_WINT = OFF_ROPE + (size_t)4096 * 32 * 2 * 4;
constexpr size_t OFF_WOUTT = OFF_WINT + (size_t)3456 * 1024 * 2;
constexpr size_t OFF_ACT = OFF_WOUTT + (size_t)1024 * 1024 * 2;
constexpr size_t EARLY_END = OFF_ACT + (size_t)T_TOK * 320 * 2;
constexpr size_t OFF_Y = 0;
constexpr size_t OFF_H = OFF_Y + (size_t)9 * T_TOK * 1024 * 2;
constexpr size_t OFF_X1B = OFF_H + (size_t)9 * T_TOK * 256 * 2;
constexpr size_t OFF_LIST = OFF_X1B + (size_t)T_TOK * 1024 * 2;
constexpr size_t OFF_GATEW = OFF_LIST + (size_t)NEXP * T_TOK * 4;
constexpr size_t OFF_CTL = OFF_GATEW + (size_t)8 * T_TOK * 4;
constexpr size_t CTL_BYTES = 1u << 20;
constexpr size_t WS_NEED = OFF_CTL + CTL_BYTES;
static_assert(OFF_ACT <= OFF_X1B, "P0 buffers (rope, w^T) must not overlap XB; ACT may (XB is dead by then)");
#define MAXTILES 4864
constexpr size_t OFF_XL = 0;
constexpr size_t OFF_AFF = (size_t)T_TOK * 1024 * 2;
constexpr size_t OFF_XB = OFF_X1B;

typedef short bf16x8 __attribute__((ext_vector_type(8)));
typedef float f32x4 __attribute__((ext_vector_type(4)));
typedef float f32x16 __attribute__((ext_vector_type(16)));
typedef float f32x2_t __attribute__((ext_vector_type(2)));
typedef __bf16 bf16x2_t __attribute__((ext_vector_type(2)));
__device__ __forceinline__ unsigned cvtpk(float lo, float hi) { f32x2_t v = {lo, hi}; bf16x2_t b = __builtin_convertvector(v, bf16x2_t); return __builtin_bit_cast(unsigned, b); }

__device__ const double INVF[32] = {
1, 0.74989420933245587, 0.56234132519034907, 0.42169650342858223, 0.31622776601683794, 0.23713737056616552,
0.17782794100389229, 0.1333521432163324, 0.10000000000000001, 0.074989420933245579, 0.056234132519034911,
0.042169650342858224, 0.031622776601683791, 0.023713737056616554, 0.017782794100389229, 0.013335214321633241,
0.01, 0.0074989420933245579, 0.005623413251903491, 0.0042169650342858229, 0.0031622776601683794,
0.0023713737056616554, 0.0017782794100389228, 0.0013335214321633241, 0.001, 0.00074989420933245586,
0.0005623413251903491, 0.00042169650342858224, 0.00031622776601683794, 0.00023713737056616554,
0.00017782794100389227, 0.0001333521432163324};

namespace cg = cooperative_groups;

struct Params {
  const float* in[26];
  float* out;
  char* ws;
};

#define NTHR 256
#define LDS_BYTES 66560

__device__ __forceinline__ void phase_rope(const Params& p) {
  float* tab = (float*)(p.ws + OFF_ROPE);
  for (int i = blockIdx.x * NTHR + threadIdx.x; i < 4096 * 32; i += gridDim.x * NTHR) {
    int pos = i >> 5, f = i & 31;
    double ang = (double)pos * INVF[f];
    const double TWO_PI = 6.283185307179586476925286766559;
    double n = rint(ang / TWO_PI);
    double r = ang - n * TWO_PI;
    double r2 = r * r;
    double sn = r, cs = 1.0, ts = r, tc = 1.0;
#pragma unroll 1
    for (int k = 1; k <= 16; ++k) {
      tc = -tc * r2 / (double)((2 * k - 1) * (2 * k));
      ts = -ts * r2 / (double)((2 * k) * (2 * k + 1));
      cs += tc; sn += ts;
    }
    tab[i * 2] = (float)cs; tab[i * 2 + 1] = (float)sn;
  }
  {
    const float* __restrict__ w_in = p.in[1]; const float* __restrict__ w_out = p.in[13];
    uint4* wint = (uint4*)(p.ws + OFF_WINT); uint4* woutt = (uint4*)(p.ws + OFF_WOUTT);
    const int NJ1 = 3456 * 128, NJ2 = 1024 * 128;
    for (int i = blockIdx.x * NTHR + threadIdx.x; i < NJ1 + NJ2; i += gridDim.x * NTHR) {
      const bool second = i >= NJ1;
      const int q = second ? i - NJ1 : i;
      const int N = second ? 1024 : 3456, NV = second ? 1024 : INW;
      const int n = q % N, ko = q / N;
      const float* __restrict__ src = second ? w_out : w_in;
      float f[8];
#pragma unroll
      for (int u = 0; u < 8; ++u) f[u] = (n < NV) ? src[(size_t)(ko * 8 + u) * NV + n] : 0.f;
      uint4 w; w.x = cvtpk(f[0], f[1]); w.y = cvtpk(f[2], f[3]); w.z = cvtpk(f[4], f[5]); w.w = cvtpk(f[6], f[7]);
      (second ? woutt : wint)[(size_t)n * 128 + ko] = w;
    }
  }
  {
    const float4* __restrict__ x4 = (const float4*)p.in[0];
    uint4* xb = (uint4*)(p.ws + OFF_XB);
    for (size_t i = (size_t)blockIdx.x * NTHR + threadIdx.x; i < (size_t)T_TOK * DM / 8; i += (size_t)gridDim.x * NTHR) {
      float4 a = x4[2 * i], b = x4[2 * i + 1];
      uint4 w; w.x = cvtpk(a.x, a.y); w.y = cvtpk(a.z, a.w); w.z = cvtpk(b.x, b.y); w.w = cvtpk(b.z, b.w);
      xb[i] = w;
    }
  }
}

template <class AF, class BF>
__device__ __forceinline__ void gemm64_naive(float* As, float* Bs, float* Cs, int K, AF af, BF bf) {
  const int tid = threadIdx.x, tx = tid & 15, ty = tid >> 4;
  float acc[4][4];
#pragma unroll
  for (int i = 0; i < 4; ++i)
#pragma unroll
    for (int j = 0; j < 4; ++j) acc[i][j] = 0.f;
  for (int k0 = 0; k0 < K; k0 += 16) {
#pragma unroll
    for (int u = 0; u < 4; ++u) { int i = tid + u * 256; int r = i >> 4, kk = i & 15; As[kk * 68 + r] = af(r, k0 + kk); }
#pragma unroll
    for (int u = 0; u < 4; ++u) { int i = tid + u * 256; int kk = i >> 6, c = i & 63; Bs[kk * 68 + c] = bf(k0 + kk, c); }
    __syncthreads();
#pragma unroll
    for (int kk = 0; kk < 16; ++kk) {
      float a[4], b[4];
#pragma unroll
      for (int i = 0; i < 4; ++i) { a[i] = As[kk * 68 + ty * 4 + i]; b[i] = Bs[kk * 68 + tx * 4 + i]; }
#pragma unroll
      for (int i = 0; i < 4; ++i)
#pragma unroll
        for (int j = 0; j < 4; ++j) acc[i][j] += a[i] * b[j];
    }
    __syncthreads();
  }
#pragma unroll
  for (int i = 0; i < 4; ++i)
#pragma unroll
    for (int j = 0; j < 4; ++j) Cs[(ty * 4 + i) * 65 + tx * 4 + j] = acc[i][j];
  __syncthreads();
}


__device__ __forceinline__ int lds_off(int row, int chunk) { return row * 128 + ((chunk ^ ((row >> 1) & 7)) << 4); }

template <int BMODE>
__device__ __forceinline__ unsigned cvtpk_m(float a, float b, const bool lo = false) {
  if (BMODE == 0 || (BMODE == 2 && !lo)) return cvtpk(a, b);
  const unsigned h = cvtpk(a, b);
  const float ah = __uint_as_float(h << 16), bh = __uint_as_float(h & 0xffff0000u);
  return cvtpk(a - ah, b - bh);
}
#define G128_MMA(bufoff) { \
    _Pragma("unroll") for (int kk = 0; kk < 2; ++kk) { \
      bf16x8 af[4], bfr[4]; \
      _Pragma("unroll") for (int m = 0; m < 4; ++m) af[m] = *(const bf16x8*)(smem + (bufoff) + lds_off(wr * 64 + m * 16 + fr, kk * 4 + fq)); \
      _Pragma("unroll") for (int n = 0; n < 4; ++n) bfr[n] = *(const bf16x8*)(smem + (bufoff) + 16384 + lds_off(wc * 64 + n * 16 + fr, kk * 4 + fq)); \
      _Pragma("unroll") for (int m = 0; m < 4; ++m) \
        _Pragma("unroll") for (int n = 0; n < 4; ++n) acc[m][n] = __builtin_amdgcn_mfma_f32_16x16x32_bf16(bfr[n], af[m], acc[m][n], 0, 0, 0); \
    } }
template <int BMODE, bool KCLAMP, class ALoad, class BPtr>
__device__ __forceinline__ void gemm128_acc(f32x4 (&acc)[4][4], char* smem, const int nk, ALoad aload, BPtr bptr, const int ldb, const int kvalid) {
  const int tid = threadIdx.x, lane = tid & 63, wid = tid >> 6;
  const int wr = wid >> 1, wc = wid & 1, fr = lane & 15, fq = lane >> 4;
  const int achunk = tid & 7, arow0 = tid >> 3;
  const int nq = tid & 31, ko = tid >> 5;
  const float* bp0 = bptr(nq);
  const int oa0 = lds_off(arow0, achunk), oa1 = lds_off(arow0 + 32, achunk), oa2 = lds_off(arow0 + 64, achunk), oa3 = lds_off(arow0 + 96, achunk);
  const int ob0 = 16384 + lds_off(nq * 4 + 0, ko), ob1 = 16384 + lds_off(nq * 4 + 1, ko), ob2 = 16384 + lds_off(nq * 4 + 2, ko), ob3 = 16384 + lds_off(nq * 4 + 3, ko);
  uint4 ra0, ra1, ra2, ra3; float4 rb0, rb1, rb2, rb3, rb4, rb5, rb6, rb7;
#define G128_LOAD(kt) { \
    ra0 = aload(0, arow0, (kt) * 8 + achunk); ra1 = aload(1, arow0 + 32, (kt) * 8 + achunk); \
    ra2 = aload(2, arow0 + 64, (kt) * 8 + achunk); ra3 = aload(3, arow0 + 96, (kt) * 8 + achunk); \
    int kr_ = (kt) * 64 + ko * 8; \
    if (KCLAMP) kr_ = min(kr_, kvalid - 8);     \
    { \
      const float* b2_ = bp0 + (size_t)((BMODE == 2) ? (kr_ & 1023) : kr_) * ldb; \
      rb0 = *(const float4*)(b2_); rb1 = *(const float4*)(b2_ + (size_t)1 * ldb); rb2 = *(const float4*)(b2_ + (size_t)2 * ldb); \
      rb3 = *(const float4*)(b2_ + (size_t)3 * ldb); rb4 = *(const float4*)(b2_ + (size_t)4 * ldb); rb5 = *(const float4*)(b2_ + (size_t)5 * ldb); \
      rb6 = *(const float4*)(b2_ + (size_t)6 * ldb); rb7 = *(const float4*)(b2_ + (size_t)7 * ldb); \
    } }
#define G128_STORE(bufoff, lo_) { \
    char* const sb_ = smem + (bufoff); \
    *(uint4*)(sb_ + oa0) = ra0; *(uint4*)(sb_ + oa1) = ra1; *(uint4*)(sb_ + oa2) = ra2; *(uint4*)(sb_ + oa3) = ra3; \
    uint4 w; \
    w.x = cvtpk_m<BMODE>(rb0.x, rb1.x, lo_); w.y = cvtpk_m<BMODE>(rb2.x, rb3.x, lo_); w.z = cvtpk_m<BMODE>(rb4.x, rb5.x, lo_); w.w = cvtpk_m<BMODE>(rb6.x, rb7.x, lo_); \
    *(uint4*)(sb_ + ob0) = w; \
    w.x = cvtpk_m<BMODE>(rb0.y, rb1.y, lo_); w.y = cvtpk_m<BMODE>(rb2.y, rb3.y, lo_); w.z = cvtpk_m<BMODE>(rb4.y, rb5.y, lo_); w.w = cvtpk_m<BMODE>(rb6.y, rb7.y, lo_); \
    *(uint4*)(sb_ + ob1) = w; \
    w.x = cvtpk_m<BMODE>(rb0.z, rb1.z, lo_); w.y = cvtpk_m<BMODE>(rb2.z, rb3.z, lo_); w.z = cvtpk_m<BMODE>(rb4.z, rb5.z, lo_); w.w = cvtpk_m<BMODE>(rb6.z, rb7.z, lo_); \
    *(uint4*)(sb_ + ob2) = w; \
    w.x = cvtpk_m<BMODE>(rb0.w, rb1.w, lo_); w.y = cvtpk_m<BMODE>(rb2.w, rb3.w, lo_); w.z = cvtpk_m<BMODE>(rb4.w, rb5.w, lo_); w.w = cvtpk_m<BMODE>(rb6.w, rb7.w, lo_); \
    *(uint4*)(sb_ + ob3) = w; }
  G128_LOAD(0)
  G128_STORE(0, false)
  if (nk > 1) G128_LOAD(1)
  __syncthreads();
  for (int kt = 0; kt < nk; ++kt) {
    const int cur = (kt & 1) * 32768;
    __builtin_amdgcn_sched_barrier(0);
    G128_MMA(cur)
    __builtin_amdgcn_sched_barrier(0);
    if (kt + 1 < nk) {
      G128_STORE(cur ^ 32768, (kt + 1) >= 32)
      __builtin_amdgcn_sched_barrier(0);
      if (kt + 2 < nk) G128_LOAD(kt + 2)
    }
    __builtin_amdgcn_sched_barrier(0);
    __syncthreads();
  }
#undef G128_LOAD
#undef G128_STORE
}
__device__ __forceinline__ void acc_zero(f32x4 (&acc)[4][4]) {
#pragma unroll
  for (int m = 0; m < 4; ++m)
#pragma unroll
    for (int n = 0; n < 4; ++n) acc[m][n] = (f32x4){0.f, 0.f, 0.f, 0.f};
}
template <class ARow, class BPtr, class Epi>
__device__ __forceinline__ void gemm128(char* smem, const int K, ARow arow, BPtr bptr, const int ldb, Epi epi) {
  const int tid = threadIdx.x, lane = tid & 63, wid = tid >> 6;
  const int arow0 = tid >> 3;
  const bf16_t* ap0 = arow(arow0);
  const bf16_t* ap1 = arow(arow0 + 32);
  const bf16_t* ap2 = arow(arow0 + 64);
  const bf16_t* ap3 = arow(arow0 + 96);
  f32x4 acc[4][4];
  acc_zero(acc);
  gemm128_acc<0, false>(acc, smem, K >> 6,
      [=](int u, int, int kc) { const bf16_t* q = (u == 0) ? ap0 : (u == 1) ? ap1 : (u == 2) ? ap2 : ap3; return *(const uint4*)(q + kc * 8); },
      bptr, ldb, 0);
  epi(acc, wid >> 1, wid & 1, lane & 15, lane >> 4);
}


template <class ALoad, class BLoad>
__device__ __forceinline__ void gemm128_acc_bb(f32x4 (&acc)[4][4], char* smem, const int nk, ALoad aload, BLoad bload) {
  const int tid = threadIdx.x, lane = tid & 63, wid = tid >> 6;
  const int wr = wid >> 1, wc = wid & 1, fr = lane & 15, fq = lane >> 4;
  const int achunk = tid & 7, arow0 = tid >> 3;
  const int oa0 = lds_off(arow0, achunk), oa1 = lds_off(arow0 + 32, achunk), oa2 = lds_off(arow0 + 64, achunk), oa3 = lds_off(arow0 + 96, achunk);
  uint4 ra0, ra1, ra2, ra3, rb0, rb1, rb2, rb3;
#define G128_LOADBB(kt) { \
    ra0 = aload(0, arow0, (kt) * 8 + achunk); ra1 = aload(1, arow0 + 32, (kt) * 8 + achunk); \
    ra2 = aload(2, arow0 + 64, (kt) * 8 + achunk); ra3 = aload(3, arow0 + 96, (kt) * 8 + achunk); \
    rb0 = bload(0, arow0, (kt) * 8 + achunk); rb1 = bload(1, arow0 + 32, (kt) * 8 + achunk); \
    rb2 = bload(2, arow0 + 64, (kt) * 8 + achunk); rb3 = bload(3, arow0 + 96, (kt) * 8 + achunk); }
#define G128_STOREBB(bufoff) { \
    char* const sb_ = smem + (bufoff); \
    *(uint4*)(sb_ + oa0) = ra0; *(uint4*)(sb_ + oa1) = ra1; *(uint4*)(sb_ + oa2) = ra2; *(uint4*)(sb_ + oa3) = ra3; \
    *(uint4*)(sb_ + 16384 + oa0) = rb0; *(uint4*)(sb_ + 16384 + oa1) = rb1; *(uint4*)(sb_ + 16384 + oa2) = rb2; *(uint4*)(sb_ + 16384 + oa3) = rb3; }
  G128_LOADBB(0)
  G128_STOREBB(0)
  if (nk > 1) G128_LOADBB(1)
  __syncthreads();
  for (int kt = 0; kt < nk; ++kt) {
    const int cur = (kt & 1) * 32768;
    __builtin_amdgcn_sched_barrier(0);
    G128_MMA(cur)
    __builtin_amdgcn_sched_barrier(0);
    if (kt + 1 < nk) {
      G128_STOREBB(cur ^ 32768)
      __builtin_amdgcn_sched_barrier(0);
      if (kt + 2 < nk) G128_LOADBB(kt + 2)
    }
    __builtin_amdgcn_sched_barrier(0);
    __syncthreads();
  }
#undef G128_LOADBB
#undef G128_STOREBB
}
template <class ARow, class BRow, class Epi>
__device__ __forceinline__ void gemm128_bb(char* smem, const int K, ARow arow, BRow brow, Epi epi) {
  const int tid = threadIdx.x, lane = tid & 63, wid = tid >> 6;
  const int arow0 = tid >> 3;
  const bf16_t* ap0 = arow(arow0); const bf16_t* ap1 = arow(arow0 + 32); const bf16_t* ap2 = arow(arow0 + 64); const bf16_t* ap3 = arow(arow0 + 96);
  const bf16_t* bp0 = brow(arow0); const bf16_t* bp1 = brow(arow0 + 32); const bf16_t* bp2 = brow(arow0 + 64); const bf16_t* bp3 = brow(arow0 + 96);
  f32x4 acc[4][4];
  acc_zero(acc);
  gemm128_acc_bb(acc, smem, K >> 6,
      [=](int u, int, int kc) { const bf16_t* q = (u == 0) ? ap0 : (u == 1) ? ap1 : (u == 2) ? ap2 : ap3; return *(const uint4*)(q + kc * 8); },
      [=](int u, int, int kc) { const bf16_t* q = (u == 0) ? bp0 : (u == 1) ? bp1 : (u == 2) ? bp2 : bp3; return *(const uint4*)(q + kc * 8); });
  epi(acc, wid >> 1, wid & 1, lane & 15, lane >> 4);
}


#define GAS1 __attribute__((address_space(1)))
#define LAS3 __attribute__((address_space(3)))
__device__ __forceinline__ void glds16(const void* g, char* l) {
  __builtin_amdgcn_global_load_lds((const GAS1 void*)g, (LAS3 void*)l, 16, 0, 0);
}
template <class ARow, class BRow, class Epi>
__device__ __forceinline__ void gemm128_glds(char* smem, const int K, ARow arow, BRow brow, Epi epi) {
  const int tid = threadIdx.x, lane = tid & 63, wid = tid >> 6;
  const int wr = wid >> 1, wc = wid & 1, fr = lane & 15, fq = lane >> 4;
  const int r0 = tid >> 3;
  const int cl = (tid & 7) ^ ((tid >> 4) & 7);
  const bf16_t* ga0 = arow(r0) + cl * 8; const bf16_t* ga1 = arow(r0 + 32) + cl * 8; const bf16_t* ga2 = arow(r0 + 64) + cl * 8; const bf16_t* ga3 = arow(r0 + 96) + cl * 8;
  const bf16_t* gb0 = brow(r0) + cl * 8; const bf16_t* gb1 = brow(r0 + 32) + cl * 8; const bf16_t* gb2 = brow(r0 + 64) + cl * 8; const bf16_t* gb3 = brow(r0 + 96) + cl * 8;
  char* const lbase = smem + tid * 16;
#define GL_STAGE(bufoff, kt) { \
    char* const d_ = lbase + (bufoff); const int ko_ = (kt) * 64; \
    glds16(ga0 + ko_, d_); glds16(ga1 + ko_, d_ + 4096); glds16(ga2 + ko_, d_ + 8192); glds16(ga3 + ko_, d_ + 12288); \
    glds16(gb0 + ko_, d_ + 16384); glds16(gb1 + ko_, d_ + 20480); glds16(gb2 + ko_, d_ + 24576); glds16(gb3 + ko_, d_ + 28672); }
  f32x4 acc[4][4];
  acc_zero(acc);
  const int nk = K >> 6;
  GL_STAGE(0, 0)
  asm volatile("s_waitcnt vmcnt(0)" ::: "memory");
  __syncthreads();
  for (int kt = 0; kt < nk; ++kt) {
    const int cur = (kt & 1) * 32768;
    if (kt + 1 < nk) GL_STAGE(cur ^ 32768, kt + 1)
    G128_MMA(cur)
    asm volatile("s_waitcnt vmcnt(0)" ::: "memory");
    __syncthreads();
  }
#undef GL_STAGE
  epi(acc, wr, wc, fr, fq);
}

#define DPP_F(v, ctrl) __builtin_bit_cast(float, __builtin_amdgcn_update_dpp(0, __builtin_bit_cast(int, (v)), (ctrl), 0xF, 0xF, true))
__device__ __forceinline__ float rdlane_f(float v, int l) { return __builtin_bit_cast(float, __builtin_amdgcn_readlane(__builtin_bit_cast(int, v), l)); }
__device__ __forceinline__ float dpp_sum16x(float v) {
  v += DPP_F(v, 0xB1); v += DPP_F(v, 0x4E); v += DPP_F(v, 0x141); v += DPP_F(v, 0x140);
  return v;
}
__device__ __forceinline__ float dpp_max16x(float v) {
  v = fmaxf(v, DPP_F(v, 0xB1)); v = fmaxf(v, DPP_F(v, 0x4E)); v = fmaxf(v, DPP_F(v, 0x141)); v = fmaxf(v, DPP_F(v, 0x140));
  return v;
}
__device__ __forceinline__ float wave_sum_fast(float v) {
  v = dpp_sum16x(v);
  return (rdlane_f(v, 0) + rdlane_f(v, 16)) + (rdlane_f(v, 32) + rdlane_f(v, 48));
}
__device__ __forceinline__ float wave_max_fast(float v) {
  v = dpp_max16x(v);
  return fmaxf(fmaxf(rdlane_f(v, 0), rdlane_f(v, 16)), fmaxf(rdlane_f(v, 32), rdlane_f(v, 48)));
}
__device__ __forceinline__ float fast_tanh(float x) { const float e = __expf(2.f * x); return 1.f - 2.f / (e + 1.f); }


__device__ __forceinline__ float4 bf4_to_f4(uint2 u) {
  float4 r;
  r.x = __uint_as_float(u.x << 16); r.y = __uint_as_float(u.x & 0xffff0000u);
  r.z = __uint_as_float(u.y << 16); r.w = __uint_as_float(u.y & 0xffff0000u);
  return r;
}
__device__ __forceinline__ uint2 pack4(float a, float b, float c, float d) { uint2 r; r.x = cvtpk(a, b); r.y = cvtpk(c, d); return r; }
#define XCD_GROUP (blockIdx.x & 7)
#define XCD_LB (blockIdx.x >> 3)
#define XCD_NB ((gridDim.x + 7 - (blockIdx.x & 7)) >> 3)

__device__ __forceinline__ void phase_inproj(const Params& p, char* smem) {
  const bf16_t* __restrict__ XB = (const bf16_t*)(p.ws + OFF_XB);
  const bf16_t* __restrict__ WINT = (const bf16_t*)(p.ws + OFF_WINT);
  const float* __restrict__ rope = (const float*)(p.ws + OFF_ROPE);
  bf16_t* Q = (bf16_t*)(p.ws + OFF_Q); bf16_t* K = (bf16_t*)(p.ws + OFF_K); bf16_t* V = (bf16_t*)(p.ws + OFF_V);
  bf16_t* FE = (bf16_t*)(p.ws + OFF_FEATS);
  const int NT = 27, NITEM = (T_TOK / 128) * NT, CHUNK = NITEM / 8;
  for (int i = XCD_LB; i < CHUNK; i += XCD_NB) {
    const int item = XCD_GROUP * CHUNK + i;
    const int row0 = (item & 255) * 128, col0 = (item >> 8) * 128;
    gemm128_glds(smem, DM,
            [=](int r) { return XB + (size_t)(row0 + r) * DM; },
            [=](int r) { return WINT + (size_t)(col0 + r) * DM; },
            [=](f32x4 (&acc)[4][4], int wr, int wc, int fr, int fq) {
              const int cb = col0 + wc * 64;
              if (cb >= INW) return;
#pragma unroll
              for (int m = 0; m < 4; ++m) {
                const int t = row0 + wr * 64 + m * 16 + fr;
                if (cb < 1024) {
                  const int pos = t & (SEQ - 1);
                  bf16_t* dst = (cb < 512) ? (Q + (size_t)t * 512 + cb) : (K + (size_t)t * 512 + (cb - 512));
                  const float sc = (cb < 512) ? 0.125f : 1.f;
#pragma unroll
                  for (int n = 0; n < 2; ++n) {
                    const int f0 = n * 16 + fq * 4;
                    const float4 c01 = *(const float4*)(rope + (size_t)(pos * 32 + f0) * 2);
                    const float4 c23 = *(const float4*)(rope + (size_t)(pos * 32 + f0) * 2 + 4);
                    const float cs[4] = {c01.x, c01.z, c23.x, c23.z}, sn[4] = {c01.y, c01.w, c23.y, c23.w};
                    float o1[4], o2[4];
#pragma unroll
                    for (int j = 0; j < 4; ++j) {
                      const float z1 = acc[m][n][j], z2 = acc[m][n + 2][j];
                      o1[j] = (z1 * cs[j] - z2 * sn[j]) * sc; o2[j] = (z2 * cs[j] + z1 * sn[j]) * sc;
                    }
                    *(uint2*)(dst + f0) = pack4(o1[0], o1[1], o1[2], o1[3]);
                    *(uint2*)(dst + 32 + f0) = pack4(o2[0], o2[1], o2[2], o2[3]);
                  }
                } else if (cb < 1536) {
#pragma unroll
                  for (int n = 0; n < 4; ++n)
                    *(uint2*)(V + (size_t)t * 512 + (cb - 1024) + n * 16 + fq * 4) = pack4(acc[m][n][0], acc[m][n][1], acc[m][n][2], acc[m][n][3]);
                } else {
#pragma unroll
                  for (int n = 0; n < 4; ++n) {
                    const int c = cb + n * 16 + fq * 4;
                    if (c < INW) *(uint2*)(FE + (size_t)t * FEW + (c - 1536)) = pack4(acc[m][n][0], acc[m][n][1], acc[m][n][2], acc[m][n][3]);
                  }
                }
              }
            });
  }
}

__device__ __forceinline__ void phase_prep_a(const Params& p) {
  const bf16_t* __restrict__ FE = (const bf16_t*)(p.ws + OFF_FEATS);
  const float* __restrict__ mu = p.in[2];
  bf16_t* R = (bf16_t*)(p.ws + OFF_R); bf16_t* K2 = (bf16_t*)(p.ws + OFF_K2); bf16_t* V2 = (bf16_t*)(p.ws + OFF_V2);
  bf16_t* ACT = (bf16_t*)(p.ws + OFF_ACT);
  for (size_t i = (size_t)blockIdx.x * NTHR + threadIdx.x; i < (size_t)T_TOK * 232; i += (size_t)gridDim.x * NTHR) {
    const int t = (int)(i / 232), ch = (int)(i - (size_t)t * 232);
    if (ch >= 228) { *(uint4*)(ACT + (size_t)t * 320 + 288 + (ch - 228) * 8) = make_uint4(0u, 0u, 0u, 0u); continue; }
    const int col = ch * 8;
    const uint4 cu = *(const uint4*)(FE + (size_t)t * FEW + col);
    uint4 pv = make_uint4(0u, 0u, 0u, 0u);
    if ((t & (SEQ - 1)) != 0) pv = *(const uint4*)(FE + (size_t)(t - 1) * FEW + col);
    const float4 m0 = *(const float4*)(mu + col), m1 = *(const float4*)(mu + col + 4);
    const unsigned cw[4] = {cu.x, cu.y, cu.z, cu.w}, pw[4] = {pv.x, pv.y, pv.z, pv.w};
    const float mm[8] = {m0.x, m0.y, m0.z, m0.w, m1.x, m1.y, m1.z, m1.w};
    float f[8];
#pragma unroll
    for (int q = 0; q < 4; ++q) {
      const float c0 = __uint_as_float(cw[q] << 16), c1 = __uint_as_float(cw[q] & 0xffff0000u);
      const float p0 = __uint_as_float(pw[q] << 16), p1 = __uint_as_float(pw[q] & 0xffff0000u);
      f[2 * q] = c0 + (p0 - c0) * mm[2 * q];
      f[2 * q + 1] = c1 + (p1 - c1) * mm[2 * q + 1];
    }
    bf16_t* dst;
    if (col < 512) dst = R + (size_t)t * 512 + col;
    else if (col < 1024) dst = K2 + (size_t)t * 512 + (col - 512);
    else if (col < 1536) dst = V2 + (size_t)t * 512 + (col - 1024);
    else {
      dst = ACT + (size_t)t * 320 + (col - 1536);
      if (col < 1600) {
#pragma unroll
        for (int q = 0; q < 8; ++q) f[q] = fast_tanh(f[q]);
      } else if (col >= 1664) {
#pragma unroll
        for (int q = 0; q < 8; ++q) f[q] = sigmoidf_(f[q]);
      }
    }
    uint4 w; w.x = cvtpk(f[0], f[1]); w.y = cvtpk(f[2], f[3]); w.z = cvtpk(f[4], f[5]); w.w = cvtpk(f[6], f[7]);
    *(uint4*)dst = w;
  }
}

template <int PASS>
__device__ __forceinline__ void prep_item(const Params& p, char* smem, const int row0, const int col0) {
  const bf16_t* __restrict__ ACT = (const bf16_t*)(p.ws + OFF_ACT);
  constexpr int ACOL = PASS * 64;
  constexpr int NK = (PASS == 2) ? 3 : 1;
  const float* __restrict__ Wm = (PASS == 0) ? p.in[4] : (PASS == 1) ? p.in[6] : p.in[7];
  f32x4 acc[4][4];
  acc_zero(acc);
  gemm128_acc<0, (PASS == 2)>(acc, smem, NK,
      [=](int, int rowl, int kc) { return *(const uint4*)(ACT + (size_t)(row0 + rowl) * 320 + ACOL + kc * 8); },
      [=](int nq) { return Wm + col0 + nq * 4; }, 512, 160);
  const int tid = threadIdx.x, lane = tid & 63, wid = tid >> 6;
  const int wr = wid >> 1, wc = wid & 1, fr = lane & 15, fq = lane >> 4;
  const int cb = col0 + wc * 64;
  if (PASS == 0) {
    const float* __restrict__ w0 = p.in[3];
    float* W = (float*)(p.ws + OFF_W);
#pragma unroll
    for (int n = 0; n < 4; ++n) {
      const int c = cb + n * 16 + fq * 4;
      const float4 w04 = *(const float4*)(w0 + c);
      const float w0c[4] = {w04.x, w04.y, w04.z, w04.w};
#pragma unroll
      for (int m = 0; m < 4; ++m) {
        const int t = row0 + wr * 64 + m * 16 + fr;
        float d[4];
#pragma unroll
        for (int j = 0; j < 4; ++j) {
          const float nz = -(w0c[j] + acc[m][n][j]);
          const float sp = fmaxf(nz, 0.f) + __logf(1.f + __expf(-fabsf(nz)));
          d[j] = __expf(-__expf(-sp - 0.5f));
        }
        *(float4*)(W + (size_t)t * 512 + c) = make_float4(d[0], d[1], d[2], d[3]);
      }
    }
  } else if (PASS == 2) {
    bf16_t* G = (bf16_t*)(p.ws + OFF_G);
#pragma unroll
    for (int m = 0; m < 4; ++m) {
      const int t = row0 + wr * 64 + m * 16 + fr;
#pragma unroll
      for (int n = 0; n < 4; ++n)
        *(uint2*)(G + (size_t)t * 512 + cb + n * 16 + fq * 4) = pack4(acc[m][n][0], acc[m][n][1], acc[m][n][2], acc[m][n][3]);
    }
  } else {
    const float* __restrict__ a0 = p.in[5]; const float* __restrict__ k_k = p.in[8]; const float* __restrict__ k_a = p.in[9];
    const float* __restrict__ r_k = p.in[10];
    const bf16_t* __restrict__ R = (const bf16_t*)(p.ws + OFF_R); bf16_t* K2 = (bf16_t*)(p.ws + OFF_K2);
    bf16_t* A = (bf16_t*)(p.ws + OFF_A); bf16_t* B = (bf16_t*)(p.ws + OFF_B); float* SB = (float*)(p.ws + OFF_SB);
#pragma unroll
    for (int m = 0; m < 4; ++m) {
      __builtin_amdgcn_sched_barrier(0);
      const int t = row0 + wr * 64 + m * 16 + fr;
      float kk[4][4];
      float ssp = 0.f, sbp = 0.f;
#pragma unroll
      for (int n = 0; n < 4; ++n) {
        const int c = cb + n * 16 + fq * 4;
        const size_t o = (size_t)t * 512 + c;
        const float4 rr4 = bf4_to_f4(*(const uint2*)(R + o)), kx4 = bf4_to_f4(*(const uint2*)(K2 + o));
        const float rr[4] = {rr4.x, rr4.y, rr4.z, rr4.w}, kx[4] = {kx4.x, kx4.y, kx4.z, kx4.w};
        const float4 a04 = *(const float4*)(a0 + c), kk4 = *(const float4*)(k_k + c), ka4 = *(const float4*)(k_a + c), rk4 = *(const float4*)(r_k + c);
        const float a0c[4] = {a04.x, a04.y, a04.z, a04.w}, kkc[4] = {kk4.x, kk4.y, kk4.z, kk4.w}, kac[4] = {ka4.x, ka4.y, ka4.z, ka4.w};
        const float rkc[4] = {rk4.x, rk4.y, rk4.z, rk4.w};
        float k2[4];
#pragma unroll
        for (int j = 0; j < 4; ++j) {
          const float av = sigmoidf_(a0c[j] + acc[m][n][j]);
          acc[m][n][j] = av;
          kk[n][j] = kx[j] * kkc[j];
          k2[j] = kx[j] * (1.f + (av - 1.f) * kac[j]);
          ssp += kk[n][j] * kk[n][j];
          sbp += rr[j] * k2[j] * rkc[j];
        }
        *(uint2*)(K2 + o) = pack4(k2[0], k2[1], k2[2], k2[3]);
      }
      ssp += __shfl_xor(ssp, 16, 64); ssp += __shfl_xor(ssp, 32, 64);
      sbp += __shfl_xor(sbp, 16, 64); sbp += __shfl_xor(sbp, 32, 64);
      const float inv = 1.f / fmaxf(sqrtf(ssp), 1e-12f);
#pragma unroll
      for (int n = 0; n < 4; ++n) {
        const size_t o = (size_t)t * 512 + cb + n * 16 + fq * 4;
        *(uint2*)(A + o) = pack4(-kk[n][0] * inv, -kk[n][1] * inv, -kk[n][2] * inv, -kk[n][3] * inv);
        *(uint2*)(B + o) = pack4(kk[n][0] * inv * acc[m][n][0], kk[n][1] * inv * acc[m][n][1], kk[n][2] * inv * acc[m][n][2], kk[n][3] * inv * acc[m][n][3]);
      }
      if (fq == 0) SB[(size_t)t * 8 + (cb >> 6)] = sbp;
    }
  }
}
__device__ __forceinline__ void phase_prep(const Params& p, char* smem) {
  for (int item = blockIdx.x; item < (T_TOK / 128) * 12; item += gridDim.x) {
    const int mt = item / 12, sub = item - mt * 12, pass = sub >> 2, nt = sub & 3;
    if (pass == 0) prep_item<0>(p, smem, mt * 128, nt * 128);
    else if (pass == 1) prep_item<1>(p, smem, mt * 128, nt * 128);
    else prep_item<2>(p, smem, mt * 128, nt * 128);
  }
}

__device__ __forceinline__ float dpp_sum16(float v) {
  v += __builtin_bit_cast(float, __builtin_amdgcn_update_dpp(0, __builtin_bit_cast(int, v), 0xB1, 0xF, 0xF, true));
  v += __builtin_bit_cast(float, __builtin_amdgcn_update_dpp(0, __builtin_bit_cast(int, v), 0x4E, 0xF, 0xF, true));
  v += __builtin_bit_cast(float, __builtin_amdgcn_update_dpp(0, __builtin_bit_cast(int, v), 0x141, 0xF, 0xF, true));
  v += __builtin_bit_cast(float, __builtin_amdgcn_update_dpp(0, __builtin_bit_cast(int, v), 0x140, 0xF, 0xF, true));
  return v;
}
#define SC_CH 16
#define SC_ARR (SC_CH * 64 * 4)
#define SC_BUF (5 * SC_ARR + SC_CH * 16 * 4)
__device__ __forceinline__ void phase_scan(const Params& p, char* smem) {
  if (blockIdx.x >= 256) return;
  const bf16_t* __restrict__ R = (const bf16_t*)(p.ws + OFF_R); const bf16_t* __restrict__ K2 = (const bf16_t*)(p.ws + OFF_K2);
  const bf16_t* __restrict__ V2 = (const bf16_t*)(p.ws + OFF_V2); const bf16_t* __restrict__ A = (const bf16_t*)(p.ws + OFF_A);
  const bf16_t* __restrict__ B = (const bf16_t*)(p.ws + OFF_B); const float* __restrict__ W = (const float*)(p.ws + OFF_W);
  float* YS = (float*)(p.ws + OFF_YS);
  const int bh = blockIdx.x >> 2, rg = blockIdx.x & 3, b = bh >> 3, h = bh & 7;
  const int tid = threadIdx.x, lane = tid & 63, wid = tid >> 6, j = lane & 15, rq = lane >> 4;
  const int rowl = wid * 4 + rq;
  const int ls = tid >> 4, lc = tid & 15;
  const int vs = (tid >> 2) & 15, vq = tid & 3;
  const size_t tb = (size_t)b * SEQ;
  const size_t goff = (tb + ls) * 512 + h * 64 + lc * 4;
  const size_t voff = (tb + vs) * 512 + h * 64 + rg * 16 + vq * 4;
  uint2 ga, gb, gk, gr, gv; float4 gw;
  gv = make_uint2(0u, 0u);
  ga = *(const uint2*)(A + goff); gb = *(const uint2*)(B + goff); gk = *(const uint2*)(K2 + goff); gr = *(const uint2*)(R + goff);
  gw = *(const float4*)(W + goff);
  if (tid < 64) gv = *(const uint2*)(V2 + voff);
  {
    char* bf = smem;
    *(float4*)(bf + 0 * SC_ARR + ls * 256 + lc * 16) = bf4_to_f4(ga);
    *(float4*)(bf + 1 * SC_ARR + ls * 256 + lc * 16) = gw;
    *(float4*)(bf + 2 * SC_ARR + ls * 256 + lc * 16) = bf4_to_f4(gb);
    *(float4*)(bf + 3 * SC_ARR + ls * 256 + lc * 16) = bf4_to_f4(gk);
    *(float4*)(bf + 4 * SC_ARR + ls * 256 + lc * 16) = bf4_to_f4(gr);
    if (tid < 64) *(float4*)(bf + 5 * SC_ARR + vs * 64 + vq * 16) = bf4_to_f4(gv);
  }
  __syncthreads();
  float s0 = 0.f, s1 = 0.f, s2 = 0.f, s3 = 0.f;
  const int NCH = SEQ / SC_CH;
  for (int c = 0; c < NCH; ++c) {
    if (c + 1 < NCH) {
      const size_t o2 = goff + (size_t)(c + 1) * SC_CH * 512;
      ga = *(const uint2*)(A + o2); gb = *(const uint2*)(B + o2); gk = *(const uint2*)(K2 + o2); gr = *(const uint2*)(R + o2);
      gw = *(const float4*)(W + o2);
      if (tid < 64) gv = *(const uint2*)(V2 + voff + (size_t)(c + 1) * SC_CH * 512);
    }
    const char* bf = smem + (c & 1) * SC_BUF;
    float ykeep = 0.f;
#pragma unroll
    for (int s = 0; s < SC_CH; ++s) {
      const float4 a4 = *(const float4*)(bf + 0 * SC_ARR + s * 256 + j * 16);
      const float4 w4 = *(const float4*)(bf + 1 * SC_ARR + s * 256 + j * 16);
      const float4 b4 = *(const float4*)(bf + 2 * SC_ARR + s * 256 + j * 16);
      const float4 k4 = *(const float4*)(bf + 3 * SC_ARR + s * 256 + j * 16);
      const float4 r4 = *(const float4*)(bf + 4 * SC_ARR + s * 256 + j * 16);
      const float vv = *(const float*)(bf + 5 * SC_ARR + s * 64 + rowl * 4);
      float sa = (s0 * a4.x + s1 * a4.y) + (s2 * a4.z + s3 * a4.w);
      sa = dpp_sum16(sa);
      s0 = s0 * w4.x + (sa * b4.x + vv * k4.x);
      s1 = s1 * w4.y + (sa * b4.y + vv * k4.y);
      s2 = s2 * w4.z + (sa * b4.z + vv * k4.z);
      s3 = s3 * w4.w + (sa * b4.w + vv * k4.w);
      float y = (s0 * r4.x + s1 * r4.y) + (s2 * r4.z + s3 * r4.w);
      y = dpp_sum16(y);
      ykeep = (j == s) ? y : ykeep;
    }
    YS[(tb + (size_t)c * SC_CH + j) * 512 + h * 64 + rg * 16 + rowl] = ykeep;
    if (c + 1 < NCH) {
      char* bn = smem + ((c + 1) & 1) * SC_BUF;
      *(float4*)(bn + 0 * SC_ARR + ls * 256 + lc * 16) = bf4_to_f4(ga);
      *(float4*)(bn + 1 * SC_ARR + ls * 256 + lc * 16) = gw;
      *(float4*)(bn + 2 * SC_ARR + ls * 256 + lc * 16) = bf4_to_f4(gb);
      *(float4*)(bn + 3 * SC_ARR + ls * 256 + lc * 16) = bf4_to_f4(gk);
      *(float4*)(bn + 4 * SC_ARR + ls * 256 + lc * 16) = bf4_to_f4(gr);
      if (tid < 64) *(float4*)(bn + 5 * SC_ARR + vs * 64 + vq * 16) = bf4_to_f4(gv);
    }
    __syncthreads();
  }
}

__device__ __forceinline__ int vt_off(int d, int key) { const int swz = ((d >> 2) & 15) ^ ((d & 3) << 3); return d * 512 + (((key >> 2) ^ swz) << 3); }
__device__ __forceinline__ void phase_attn(const Params& p, char* smem) {
  const bf16_t* __restrict__ Q = (const bf16_t*)(p.ws + OFF_Q); const bf16_t* __restrict__ K = (const bf16_t*)(p.ws + OFF_K);
  const bf16_t* __restrict__ V = (const bf16_t*)(p.ws + OFF_V);
  bf16_t* OP = (bf16_t*)(p.ws + OFF_OP); float* LSE = (float*)(p.ws + OFF_LSE);
  char* Ks = smem; char* VT = smem + 32768; float* linv_s = (float*)(smem + 65536);
  const int tid = threadIdx.x, lane = tid & 63, wid = tid >> 6, l31 = lane & 31, hi = lane >> 5;
  for (int item = blockIdx.x; item < 6144; item += gridDim.x) {
    const int pp = item >> 11, rem = item & 2047, bh = rem >> 5, sub = rem & 31;
    const int dsh = pp * 2, nbsh = 5 - dsh;
    const int r = sub >> nbsh, n = sub & ((1 << nbsh) - 1);
    const int b = bh >> 3, h = bh & 7, tb = b * SEQ;
    __syncthreads();
#pragma unroll
    for (int u = 0; u < 8; ++u) {
      const int row = (tid >> 3) + 32 * u, chunk = tid & 7;
      int ik = n * 128 - 128 + row; ik = ik < 0 ? 0 : ik;
      const int tok = tb + (ik << dsh) + r;
      *(uint4*)(Ks + lds_off(row, chunk)) = *(const uint4*)(K + (size_t)tok * 512 + h * 64 + chunk * 8);
    }
#pragma unroll
    for (int ps = 0; ps < 2; ++ps) {
      const int dq = tid & 15, kbase = ps * 128 + (tid >> 4) * 8;
      uint2 v0, v1, v2, v3, v4, v5, v6, v7;
#define LDV(i, dst) { int ik = n * 128 - 128 + kbase + i; ik = ik < 0 ? 0 : ik; const int tok = tb + (ik << dsh) + r; dst = *(const uint2*)(V + (size_t)tok * 512 + h * 64 + dq * 4); }
      LDV(0, v0) LDV(1, v1) LDV(2, v2) LDV(3, v3) LDV(4, v4) LDV(5, v5) LDV(6, v6) LDV(7, v7)
#undef LDV
      {
        uint2 w;
        w.x = (v0.x & 0xffffu) | (v1.x << 16); w.y = (v2.x & 0xffffu) | (v3.x << 16);
        *(uint2*)(VT + vt_off(dq * 4 + 0, kbase)) = w;
        w.x = (v4.x & 0xffffu) | (v5.x << 16); w.y = (v6.x & 0xffffu) | (v7.x << 16);
        *(uint2*)(VT + vt_off(dq * 4 + 0, kbase + 4)) = w;
        w.x = (v0.x >> 16) | (v1.x & 0xffff0000u); w.y = (v2.x >> 16) | (v3.x & 0xffff0000u);
        *(uint2*)(VT + vt_off(dq * 4 + 1, kbase)) = w;
        w.x = (v4.x >> 16) | (v5.x & 0xffff0000u); w.y = (v6.x >> 16) | (v7.x & 0xffff0000u);
        *(uint2*)(VT + vt_off(dq * 4 + 1, kbase + 4)) = w;
        w.x = (v0.y & 0xffffu) | (v1.y << 16); w.y = (v2.y & 0xffffu) | (v3.y << 16);
        *(uint2*)(VT + vt_off(dq * 4 + 2, kbase)) = w;
        w.x = (v4.y & 0xffffu) | (v5.y << 16); w.y = (v6.y & 0xffffu) | (v7.y << 16);
        *(uint2*)(VT + vt_off(dq * 4 + 2, kbase + 4)) = w;
        w.x = (v0.y >> 16) | (v1.y & 0xffff0000u); w.y = (v2.y >> 16) | (v3.y & 0xffff0000u);
        *(uint2*)(VT + vt_off(dq * 4 + 3, kbase)) = w;
        w.x = (v4.y >> 16) | (v5.y & 0xffff0000u); w.y = (v6.y >> 16) | (v7.y & 0xffff0000u);
        *(uint2*)(VT + vt_off(dq * 4 + 3, kbase + 4)) = w;
      }
    }
    __syncthreads();
    const int iq = n * 128 + wid * 32 + l31;
    const int tq = tb + (iq << dsh) + r;
    bf16x8 qf[4];
#pragma unroll
    for (int ks = 0; ks < 4; ++ks) qf[ks] = *(const bf16x8*)(Q + (size_t)tq * 512 + h * 64 + ks * 16 + hi * 8);
    f32x16 st[5];
#pragma unroll
    for (int kb = 0; kb < 5; ++kb) {
      st[kb] = (f32x16){0.f, 0.f, 0.f, 0.f, 0.f, 0.f, 0.f, 0.f, 0.f, 0.f, 0.f, 0.f, 0.f, 0.f, 0.f, 0.f};
#pragma unroll
      for (int ks = 0; ks < 4; ++ks) {
        const bf16x8 kf = *(const bf16x8*)(Ks + lds_off(32 * (wid + kb) + l31, 2 * ks + hi));
        st[kb] = __builtin_amdgcn_mfma_f32_32x32x16_bf16(kf, qf[ks], st[kb], 0, 0, 0);
      }
    }
    float m = -INFINITY;
#pragma unroll
    for (int kb = 0; kb < 5; ++kb)
#pragma unroll
      for (int i = 0; i < 16; ++i) {
        const int kirel = 32 * kb + (i & 3) + 8 * (i >> 2) + 4 * hi;
        const bool valid = (kirel >= l31) && (kirel <= l31 + 128) && (n > 0 || (32 * wid + kirel) >= 128);
        const float s = valid ? st[kb][i] : -INFINITY;
        st[kb][i] = s;
        m = fmaxf(m, s);
      }
    m = fmaxf(m, __shfl_xor(m, 32, 64));
    float l = 0.f;
#pragma unroll
    for (int kb = 0; kb < 5; ++kb)
#pragma unroll
      for (int i = 0; i < 16; ++i) { const float pe = __expf(st[kb][i] - m); st[kb][i] = pe; l += pe; }
    l += __shfl_xor(l, 32, 64);
    f32x16 o0 = (f32x16){0.f, 0.f, 0.f, 0.f, 0.f, 0.f, 0.f, 0.f, 0.f, 0.f, 0.f, 0.f, 0.f, 0.f, 0.f, 0.f};
    f32x16 o1 = o0;
#pragma unroll
    for (int kb = 0; kb < 5; ++kb)
#pragma unroll
      for (int s = 0; s < 2; ++s) {
        union { unsigned u[4]; bf16x8 v; } pa;
        pa.u[0] = cvtpk(st[kb][8 * s + 0], st[kb][8 * s + 1]); pa.u[1] = cvtpk(st[kb][8 * s + 2], st[kb][8 * s + 3]);
        pa.u[2] = cvtpk(st[kb][8 * s + 4], st[kb][8 * s + 5]); pa.u[3] = cvtpk(st[kb][8 * s + 6], st[kb][8 * s + 7]);
        const int key0 = 32 * (wid + kb) + 16 * s + 4 * hi;
        {
          union { uint2 u[2]; bf16x8 v; } vb;
          vb.u[0] = *(const uint2*)(VT + vt_off(l31, key0)); vb.u[1] = *(const uint2*)(VT + vt_off(l31, key0 + 8));
          o0 = __builtin_amdgcn_mfma_f32_32x32x16_bf16(pa.v, vb.v, o0, 0, 0, 0);
        }
        {
          union { uint2 u[2]; bf16x8 v; } vb;
          vb.u[0] = *(const uint2*)(VT + vt_off(32 + l31, key0)); vb.u[1] = *(const uint2*)(VT + vt_off(32 + l31, key0 + 8));
          o1 = __builtin_amdgcn_mfma_f32_32x32x16_bf16(pa.v, vb.v, o1, 0, 0, 0);
        }
      }
    if (hi == 0) {
      linv_s[wid * 32 + l31] = 1.f / l;
      LSE[((size_t)pp * T_TOK + tq) * 8 + h] = m + __logf(l);
    }
#pragma unroll
    for (int i = 0; i < 16; ++i) {
      const int qrel = (i & 3) + 8 * (i >> 2) + 4 * hi;
      const int iq2 = n * 128 + wid * 32 + qrel;
      const int tq2 = tb + (iq2 << dsh) + r;
      const float li = linv_s[wid * 32 + qrel];
      bf16_t* op = OP + ((size_t)pp * T_TOK + tq2) * 512 + h * 64 + l31;
      op[0] = f2bf(o0[i] * li);
      op[32] = f2bf(o1[i] * li);
    }
  }
}

__device__ __forceinline__ void unpack8(const uint4 u, float (&f)[8]) {
  f[0] = __uint_as_float(u.x << 16); f[1] = __uint_as_float(u.x & 0xffff0000u); f[2] = __uint_as_float(u.y << 16); f[3] = __uint_as_float(u.y & 0xffff0000u);
  f[4] = __uint_as_float(u.z << 16); f[5] = __uint_as_float(u.z & 0xffff0000u); f[6] = __uint_as_float(u.w << 16); f[7] = __uint_as_float(u.w & 0xffff0000u);
}
__device__ __forceinline__ float dpp_sum8(float v) {
  v += DPP_F(v, 0xB1); v += DPP_F(v, 0x4E); v += DPP_F(v, 0x141);
  return v;
}
__device__ __forceinline__ void phase_post(const Params& p) {
  const float* __restrict__ YS = (const float*)(p.ws + OFF_YS); const bf16_t* __restrict__ V2 = (const bf16_t*)(p.ws + OFF_V2);
  const bf16_t* __restrict__ G = (const bf16_t*)(p.ws + OFF_G); const float* __restrict__ SB = (const float*)(p.ws + OFF_SB);
  const bf16_t* __restrict__ OP = (const bf16_t*)(p.ws + OFF_OP); const float* __restrict__ LSE = (const float*)(p.ws + OFF_LSE);
  const float* __restrict__ lnx_g = p.in[11]; const float* __restrict__ lnx_b = p.in[12];
  bf16_t* MIXED = (bf16_t*)(p.ws + OFF_MIXED);
  const int lane = threadIdx.x & 63, wid = threadIdx.x >> 6;
  const int c = lane * 8, hh = lane >> 3;
  const float4 g0 = *(const float4*)(lnx_g + c), g1 = *(const float4*)(lnx_g + c + 4), b0 = *(const float4*)(lnx_b + c), b1 = *(const float4*)(lnx_b + c + 4);
  const float gg[8] = {g0.x, g0.y, g0.z, g0.w, g1.x, g1.y, g1.z, g1.w}, bb[8] = {b0.x, b0.y, b0.z, b0.w, b1.x, b1.y, b1.z, b1.w};
  for (int t = blockIdx.x * 4 + wid; t < T_TOK; t += gridDim.x * 4) {
    const size_t o = (size_t)t * 512 + c;
    const float4 y0 = *(const float4*)(YS + o), y1 = *(const float4*)(YS + o + 4);
    const float y[8] = {y0.x, y0.y, y0.z, y0.w, y1.x, y1.y, y1.z, y1.w};
    float s = 0.f;
#pragma unroll
    for (int i = 0; i < 8; ++i) s += y[i];
    const float mean = dpp_sum8(s) * (1.f / 64.f);
    float q = 0.f;
#pragma unroll
    for (int i = 0; i < 8; ++i) { const float d = y[i] - mean; q += d * d; }
    const float rs = rsqrtf(dpp_sum8(q) * (1.f / 64.f) + GN_EPS_F);
    float v2[8], gt[8];
    unpack8(*(const uint4*)(V2 + o), v2); unpack8(*(const uint4*)(G + o), gt);
    const float sb = SB[(size_t)t * 8 + hh];
    float res[8];
#pragma unroll
    for (int i = 0; i < 8; ++i) res[i] = ((y[i] - mean) * rs * gg[i] + bb[i] + sb * v2[i]) * gt[i];
    uint4 w; w.x = cvtpk(res[0], res[1]); w.y = cvtpk(res[2], res[3]); w.z = cvtpk(res[4], res[5]); w.w = cvtpk(res[6], res[7]);
    *(uint4*)(MIXED + (size_t)t * 1024 + 512 + c) = w;
    const float l0 = LSE[((size_t)0 * T_TOK + t) * 8 + hh], l1 = LSE[((size_t)1 * T_TOK + t) * 8 + hh], l2 = LSE[((size_t)2 * T_TOK + t) * 8 + hh];
    const float mx = fmaxf(l0, fmaxf(l1, l2));
    float e0 = __expf(l0 - mx), e1 = __expf(l1 - mx), e2 = __expf(l2 - mx);
    const float inv = 1.f / (e0 + e1 + e2);
    e0 *= inv; e1 *= inv; e2 *= inv;
    float o0[8], o1[8], o2[8];
    unpack8(*(const uint4*)(OP + (size_t)0 * T_TOK * 512 + o), o0); unpack8(*(const uint4*)(OP + (size_t)1 * T_TOK * 512 + o), o1);
    unpack8(*(const uint4*)(OP + (size_t)2 * T_TOK * 512 + o), o2);
    float av[8];
#pragma unroll
    for (int i = 0; i < 8; ++i) av[i] = e0 * o0[i] + e1 * o1[i] + e2 * o2[i];
    w.x = cvtpk(av[0], av[1]); w.y = cvtpk(av[2], av[3]); w.z = cvtpk(av[4], av[5]); w.w = cvtpk(av[6], av[7]);
    *(uint4*)(MIXED + (size_t)t * 1024 + c) = w;
  }
}

__device__ __forceinline__ void phase_outproj(const Params& p, char* smem) {
  const bf16_t* __restrict__ MIXED = (const bf16_t*)(p.ws + OFF_MIXED);
  const bf16_t* __restrict__ WOUTT = (const bf16_t*)(p.ws + OFF_WOUTT); const float* __restrict__ x = p.in[0];
  float* U = p.out;
  for (int i = XCD_LB; i < T_TOK / 128; i += XCD_NB) {
    const int row0 = i * 128, col0 = XCD_GROUP * 128;
    gemm128_glds(smem, DM,
            [=](int r) { return MIXED + (size_t)(row0 + r) * DM; },
            [=](int r) { return WOUTT + (size_t)(col0 + r) * DM; },
            [=](f32x4 (&acc)[4][4], int wr, int wc, int fr, int fq) {
#pragma unroll
              for (int m = 0; m < 4; ++m) {
                const int t = row0 + wr * 64 + m * 16 + fr;
#pragma unroll
                for (int n = 0; n < 4; ++n) {
                  const size_t o = (size_t)t * DM + col0 + wc * 64 + n * 16 + fq * 4;
                  const float4 xv = *(const float4*)(x + o);
                  *(float4*)(U + o) = make_float4(ALPHA_F * xv.x + acc[m][n][0], ALPHA_F * xv.y + acc[m][n][1], ALPHA_F * xv.z + acc[m][n][2], ALPHA_F * xv.w + acc[m][n][3]);
                }
              }
            });
  }
}

__device__ __forceinline__ void phase_ln1(const Params& p) {
  float* X1 = p.out;
  const float* __restrict__ g1 = p.in[14]; const float* __restrict__ b1 = p.in[15];
  bf16_t* X1B = (bf16_t*)(p.ws + OFF_X1B); bf16_t* XL = (bf16_t*)(p.ws + OFF_XL);
  const int lane = threadIdx.x & 63, wid = threadIdx.x >> 6;
  for (int t = blockIdx.x * 4 + wid; t < T_TOK; t += gridDim.x * 4) {
    const size_t base = (size_t)t * DM;
    float4 v[4];
    float s = 0.f;
#pragma unroll
    for (int u = 0; u < 4; ++u) { v[u] = *(const float4*)(X1 + base + u * 256 + lane * 4); s += (v[u].x + v[u].y) + (v[u].z + v[u].w); }
    const float mean = wave_sum_fast(s) * (1.f / DM);
    float q = 0.f;
#pragma unroll
    for (int u = 0; u < 4; ++u) {
      const float d0 = v[u].x - mean, d1 = v[u].y - mean, d2 = v[u].z - mean, d3 = v[u].w - mean;
      q += (d0 * d0 + d1 * d1) + (d2 * d2 + d3 * d3);
    }
    const float rs = rsqrtf(wave_sum_fast(q) * (1.f / DM) + LN_EPS_F);
#pragma unroll
    for (int u = 0; u < 4; ++u) {
      const int c = u * 256 + lane * 4;
      const float4 g = *(const float4*)(g1 + c), bb = *(const float4*)(b1 + c);
      float4 y;
      y.x = (v[u].x - mean) * rs * g.x + bb.x; y.y = (v[u].y - mean) * rs * g.y + bb.y;
      y.z = (v[u].z - mean) * rs * g.z + bb.z; y.w = (v[u].w - mean) * rs * g.w + bb.w;
      *(float4*)(X1 + base + c) = y;
      uint2 hi; hi.x = cvtpk(y.x, y.y); hi.y = cvtpk(y.z, y.w);
      *(uint2*)(X1B + base + c) = hi;
      uint2 lo;
      lo.x = cvtpk(y.x - __uint_as_float(hi.x << 16), y.y - __uint_as_float(hi.x & 0xffff0000u));
      lo.y = cvtpk(y.z - __uint_as_float(hi.y << 16), y.w - __uint_as_float(hi.y & 0xffff0000u));
      *(uint2*)(XL + base + c) = lo;
    }
  }
}

__device__ __forceinline__ void phase_router_gemm(const Params& p, char* smem) {
  const bf16_t* __restrict__ X1B = (const bf16_t*)(p.ws + OFF_X1B); const bf16_t* __restrict__ XL = (const bf16_t*)(p.ws + OFF_XL);
  const float* __restrict__ router_w = p.in[16];
  float* AFF = (float*)(p.ws + OFF_AFF);
  for (int item = blockIdx.x; item < (T_TOK / 128) * 2; item += gridDim.x) {
    const int row0 = (item >> 1) * 128, col0 = (item & 1) * 128;
    f32x4 acc[4][4];
    acc_zero(acc);
    gemm128_acc<2, false>(acc, smem, 48,
        [=](int, int rowl, int kc) { const bf16_t* base = ((kc >> 7) == 1) ? XL : X1B; return *(const uint4*)(base + (size_t)(row0 + rowl) * DM + (kc & 127) * 8); },
        [=](int nq) { return router_w + col0 + nq * 4; }, NEXP, 0);
    const int tid = threadIdx.x, lane = tid & 63, wid = tid >> 6;
    const int wr = wid >> 1, wc = wid & 1, fr = lane & 15, fq = lane >> 4;
#pragma unroll
    for (int m = 0; m < 4; ++m) {
      const int t = row0 + wr * 64 + m * 16 + fr;
#pragma unroll
      for (int n = 0; n < 4; ++n)
        *(float4*)(AFF + (size_t)t * NEXP + col0 + wc * 64 + n * 16 + fq * 4) =
            make_float4(sigmoidf_(acc[m][n][0]), sigmoidf_(acc[m][n][1]), sigmoidf_(acc[m][n][2]), sigmoidf_(acc[m][n][3]));
    }
  }
}

__device__ __forceinline__ void phase_topk(const Params& p) {
  const float* __restrict__ AFF = (const float*)(p.ws + OFF_AFF);
  const float* __restrict__ router_bias = p.in[17];
  int* LIST = (int*)(p.ws + OFF_LIST); float* GATEW = (float*)(p.ws + OFF_GATEW);
  int* counts = (int*)(p.ws + OFF_CTL);
  const int lane = threadIdx.x & 63, wid = threadIdx.x >> 6;
  const float4 b4 = *(const float4*)(router_bias + lane * 4);
  for (int t = blockIdx.x * 4 + wid; t < T_TOK; t += gridDim.x * 4) {
    const float4 a4 = *(const float4*)(AFF + (size_t)t * NEXP + lane * 4);
    float s0 = a4.x + b4.x, s1 = a4.y + b4.y, s2 = a4.z + b4.z, s3 = a4.w + b4.w;
    const float hi01 = fmaxf(s0, s1), lo01 = fminf(s0, s1), hi23 = fmaxf(s2, s3), lo23 = fminf(s2, s3);
    float m1 = fmaxf(hi01, hi23), m2 = fmaxf(fminf(hi01, hi23), fmaxf(lo01, lo23));
    { const float o1 = DPP_F(m1, 0xB1), o2 = DPP_F(m2, 0xB1); const float n1 = fmaxf(m1, o1); m2 = fmaxf(fminf(m1, o1), fmaxf(m2, o2)); m1 = n1; }
    { const float o1 = DPP_F(m1, 0x4E), o2 = DPP_F(m2, 0x4E); const float n1 = fmaxf(m1, o1); m2 = fmaxf(fminf(m1, o1), fmaxf(m2, o2)); m1 = n1; }
    { const float o1 = DPP_F(m1, 0x141), o2 = DPP_F(m2, 0x141); const float n1 = fmaxf(m1, o1); m2 = fmaxf(fminf(m1, o1), fmaxf(m2, o2)); m1 = n1; }
    const float gs = m1 + m2;
    const int g = lane >> 3;
    int rank = 0;
#pragma unroll
    for (int gg = 0; gg < 8; ++gg) { const float G = rdlane_f(gs, gg * 8); rank += ((G > gs) || (G == gs && gg < g)) ? 1 : 0; }
    if (rank >= 4) { s0 = -INFINITY; s1 = -INFINITY; s2 = -INFINITY; s3 = -INFINITY; }
    int my_e = 0; float my_a = 0.f;
#pragma unroll 1
    for (int it = 0; it < 8; ++it) {
      const float lm = fmaxf(fmaxf(s0, s1), fmaxf(s2, s3));
      const float wm = wave_max_fast(lm);
      const unsigned long long bal = __ballot(lm == wm);
      const int win = __ffsll((long long)bal) - 1;
      const int wi = (s0 == wm) ? 0 : ((s1 == wm) ? 1 : ((s2 == wm) ? 2 : 3));
      const float wa = (wi == 0) ? a4.x : ((wi == 1) ? a4.y : ((wi == 2) ? a4.z : a4.w));
      const int e_w = __builtin_amdgcn_readlane(lane * 4 + wi, win);
      const float a_w = rdlane_f(wa, win);
      if (lane == win) { if (wi == 0) s0 = -INFINITY; else if (wi == 1) s1 = -INFINITY; else if (wi == 2) s2 = -INFINITY; else s3 = -INFINITY; }
      if (lane == it) { my_e = e_w; my_a = a_w; }
    }
    const float asum = rdlane_f(dpp_sum16x(my_a), 0);
    if (lane < 8) {
      const int pos = atomicAdd(&counts[my_e], 1);
      LIST[(size_t)my_e * T_TOK + pos] = lane * T_TOK + t;
      GATEW[(size_t)lane * T_TOK + t] = my_a * 2.5f / asum;
    }
  }
}

__device__ __forceinline__ int moe_group_setup(const int* counts, int* pre, const int NT) {
  __syncthreads();
  if (threadIdx.x == 0) {
    const int g = XCD_GROUP;
    int acc = 0;
    for (int j = 0; j < 32; ++j) { pre[j] = acc; acc += ((counts[g + 8 * j] + 127) >> 7) * NT; }
    pre[32] = acc; acc += 32 * NT;
    pre[33] = acc;
  }
  __syncthreads();
  return pre[33];
}
struct MoeItem { int e, nt, r0, cnt; };
__device__ __forceinline__ MoeItem moe_item(const int* counts, const int* pre, const int i) {
  int j = 0;
#pragma unroll 1
  for (int q = 1; q <= 32; ++q) j = (pre[q] <= i) ? q : j;
  MoeItem it;
  const int w = i - pre[j];
  if (j < 32) {
    it.e = XCD_GROUP + 8 * j; it.cnt = counts[it.e];
    const int tiles = (it.cnt + 127) >> 7;
    it.nt = w / tiles; it.r0 = (w - it.nt * tiles) * 128;
  } else {
    it.e = NEXP; it.cnt = T_TOK; it.nt = w >> 5; it.r0 = (XCD_GROUP * 32 + (w & 31)) * 128;
  }
  return it;
}

__device__ __forceinline__ void phase_moe1(const Params& p, char* smem) {
  int* asg = (int*)(smem + 65536); int* pre = asg + 128;
  const bf16_t* __restrict__ X1B = (const bf16_t*)(p.ws + OFF_X1B);
  const int* __restrict__ LIST = (const int*)(p.ws + OFF_LIST);
  const int* counts = (const int*)(p.ws + OFF_CTL);
  bf16_t* H = (bf16_t*)(p.ws + OFF_H);
  const int nitems = moe_group_setup(counts, pre, 4);
  for (int i = XCD_LB; i < nitems; i += XCD_NB) {
    const MoeItem it = moe_item(counts, pre, i);
    const int e = it.e, nt = it.nt, r0 = it.r0, cnt = it.cnt;
    __syncthreads();
    if (threadIdx.x < 128) {
      int r = r0 + threadIdx.x;
      asg[threadIdx.x] = (r < cnt) ? ((e < NEXP) ? LIST[(size_t)e * T_TOK + r] : (8 * T_TOK + r)) : -1;
    }
    __syncthreads();
    const float* __restrict__ Wg = (e < NEXP) ? p.in[18] + (size_t)e * DM * 256 : p.in[21];
    const float* __restrict__ Wu = (e < NEXP) ? p.in[19] + (size_t)e * DM * 256 : p.in[22];
    gemm128(smem, DM,
            [=](int r) { int a = asg[r]; return X1B + (size_t)((a >= 0 ? a : 0) & (T_TOK - 1)) * DM; },
            [=](int nq) { const long long dlt = ((nq >> 2) & 2) ? (long long)(Wu - Wg) : 0ll; return Wg + dlt + nt * 64 + (nq >> 4) * 32 + ((nq >> 2) & 1) * 16 + (nq & 3) * 4; },
            256,
            [=](f32x4 (&acc)[4][4], int wr, int wc, int fr, int fq) {
#pragma unroll
              for (int m = 0; m < 4; ++m) {
                const int a = asg[wr * 64 + m * 16 + fr];
                if (a < 0) continue;
#pragma unroll
                for (int n = 0; n < 2; ++n) {
                  float hv[4];
#pragma unroll
                  for (int j = 0; j < 4; ++j) { const float g = acc[m][n][j], u = acc[m][n + 2][j]; hv[j] = g * sigmoidf_(g) * u; }
                  *(uint2*)(H + (size_t)a * 256 + nt * 64 + wc * 32 + n * 16 + fq * 4) = pack4(hv[0], hv[1], hv[2], hv[3]);
                }
              }
            });
  }
}

__device__ __forceinline__ void phase_moe2(const Params& p, char* smem) {
  int* asg = (int*)(smem + 65536); int* pre = asg + 128;
  const bf16_t* __restrict__ H = (const bf16_t*)(p.ws + OFF_H);
  const int* __restrict__ LIST = (const int*)(p.ws + OFF_LIST);
  const float* __restrict__ GATEW = (const float*)(p.ws + OFF_GATEW);
  const int* counts = (const int*)(p.ws + OFF_CTL);
  bf16_t* Y = (bf16_t*)(p.ws + OFF_Y);
  const int nitems = moe_group_setup(counts, pre, 8);
  for (int i = XCD_LB; i < nitems; i += XCD_NB) {
    const MoeItem it = moe_item(counts, pre, i);
    const int e = it.e, nt = it.nt, r0 = it.r0, cnt = it.cnt;
    __syncthreads();
    if (threadIdx.x < 128) {
      int r = r0 + threadIdx.x;
      asg[threadIdx.x] = (r < cnt) ? ((e < NEXP) ? LIST[(size_t)e * T_TOK + r] : (8 * T_TOK + r)) : -1;
    }
    __syncthreads();
    const float* __restrict__ Wd = (e < NEXP) ? p.in[20] + (size_t)e * 256 * DM : p.in[23];
    gemm128(smem, 256,
            [=](int r) { int a = asg[r]; return H + (size_t)(a >= 0 ? a : 0) * 256; },
            [=](int nq) { return Wd + nt * 128 + nq * 4; },
            DM,
            [=](f32x4 (&acc)[4][4], int wr, int wc, int fr, int fq) {
#pragma unroll
              for (int m = 0; m < 4; ++m) {
                const int a = asg[wr * 64 + m * 16 + fr];
                if (a < 0) continue;
                const float gw = (a < 8 * T_TOK) ? GATEW[a] : 1.f;
#pragma unroll
                for (int n = 0; n < 4; ++n)
                  *(uint2*)(Y + (size_t)a * DM + nt * 128 + wc * 64 + n * 16 + fq * 4) =
                      pack4(acc[m][n][0] * gw, acc[m][n][1] * gw, acc[m][n][2] * gw, acc[m][n][3] * gw);
              }
            });
  }
}

__device__ __forceinline__ void phase_final(const Params& p, char* smem) {
  float* OUT = p.out;
  const bf16_t* __restrict__ Y = (const bf16_t*)(p.ws + OFF_Y);
  const float* __restrict__ g2 = p.in[24]; const float* __restrict__ b2 = p.in[25];
  const int lane = threadIdx.x & 63, wid = threadIdx.x >> 6;
  for (int t = blockIdx.x * 4 + wid; t < T_TOK; t += gridDim.x * 4) {
    const size_t base = (size_t)t * DM;
    float4 v[4];
    float s = 0.f;
#pragma unroll
    for (int u = 0; u < 4; ++u) {
      const int c = u * 256 + lane * 4;
      const float4 xv = *(const float4*)(OUT + base + c);
      float a0 = 0.f, a1 = 0.f, a2 = 0.f, a3 = 0.f;
#pragma unroll
      for (int sl = 0; sl < 9; ++sl) {
        const float4 yv = bf4_to_f4(*(const uint2*)(Y + ((size_t)sl * T_TOK + t) * DM + c));
        a0 += yv.x; a1 += yv.y; a2 += yv.z; a3 += yv.w;
      }
      v[u] = make_float4(ALPHA_F * xv.x + a0, ALPHA_F * xv.y + a1, ALPHA_F * xv.z + a2, ALPHA_F * xv.w + a3);
      s += (v[u].x + v[u].y) + (v[u].z + v[u].w);
    }
    const float mean = wave_sum_fast(s) * (1.f / DM);
    float q = 0.f;
#pragma unroll
    for (int u = 0; u < 4; ++u) {
      const float d0 = v[u].x - mean, d1 = v[u].y - mean, d2 = v[u].z - mean, d3 = v[u].w - mean;
      q += (d0 * d0 + d1 * d1) + (d2 * d2 + d3 * d3);
    }
    const float rs = rsqrtf(wave_sum_fast(q) * (1.f / DM) + LN_EPS_F);
#pragma unroll
    for (int u = 0; u < 4; ++u) {
      const int c = u * 256 + lane * 4;
      const float4 g = *(const float4*)(g2 + c), bb = *(const float4*)(b2 + c);
      *(float4*)(OUT + base + c) = make_float4((v[u].x - mean) * rs * g.x + bb.x, (v[u].y - mean) * rs * g.y + bb.y,
                                               (v[u].z - mean) * rs * g.z + bb.z, (v[u].w - mean) * rs * g.w + bb.w);
    }
  }
}

#define LAS __attribute__((address_space(3)))
#define XB_TMO      128
#define XB_XCNT(j)  (256  + 64 * (j))
#define XB_XSUB(j)  (1280 + 64 * (j))
#define XB_XGEN(j)  (2304 + 64 * (j))
#define XB_TOP      3328
#define XB_TOPGEN   3392
#define XCD_BAR_WORDS 3456
#define XB_SPIN_CAP (1u << 22)
__device__ __forceinline__ unsigned xb_ld(unsigned* p)              { return __hip_atomic_load(p, __ATOMIC_RELAXED, __HIP_MEMORY_SCOPE_AGENT); }
__device__ __forceinline__ unsigned xb_add(unsigned* p, unsigned v) { return __hip_atomic_fetch_add(p, v, __ATOMIC_RELAXED, __HIP_MEMORY_SCOPE_AGENT); }
__device__ __forceinline__ unsigned xb_xcc_id() { return (unsigned)__builtin_amdgcn_s_getreg((3 << 11) | 20) & 0xFu; }
#define XB_SPIN(cond, bar) do { unsigned _sp = 0; while (cond) { __builtin_amdgcn_s_sleep(1); \
    if ((++_sp & 255u) == 0u) { if (xb_ld(&(bar)[XB_TMO])) break; if (_sp > XB_SPIN_CAP) { atomicAdd(&(bar)[XB_TMO], 1u); break; } } } } while (0)
struct XcdBarrier { unsigned* bar; unsigned x; volatile LAS unsigned* st; };
__device__ __forceinline__ XcdBarrier xcd_barrier_post(unsigned* bar, volatile LAS unsigned* st) {
  XcdBarrier b; b.bar = bar; b.x = xb_xcc_id(); b.st = st;
  if (threadIdx.x == 0) (void)xb_add(&bar[XB_XCNT(b.x)], 1u);
  return b;
}
__device__ __forceinline__ void xcd_barrier_complete(unsigned* bar, unsigned x, unsigned& nloc, unsigned& nx) {
  const unsigned G = gridDim.x * gridDim.y * gridDim.z;
  unsigned sum, cnt, mine, sp = 0u;
  for (;;) {
    sum = 0u; cnt = 0u; mine = 0u;
#pragma unroll
    for (unsigned j = 0; j < 16; ++j) { const unsigned c = xb_ld(&bar[XB_XCNT(j)]); sum += c; cnt += (c > 0u) ? 1u : 0u; mine = (j == x) ? c : mine; }
    if (sum == G) break;
    __builtin_amdgcn_s_sleep(1);
    if ((++sp & 255u) == 0u) { if (xb_ld(&bar[XB_TMO])) break; if (sp > XB_SPIN_CAP) { atomicAdd(&bar[XB_TMO], 1u); break; } }
  }
  nloc = mine > 0u ? mine : 1u; nx = cnt > 0u ? cnt : 1u;
}
__device__ __forceinline__ void xcd_barrier(const XcdBarrier& b) {
  asm volatile("s_waitcnt vmcnt(0)" ::: "memory");
  __syncthreads();
  if (threadIdx.x == 0) {
    unsigned* bar = b.bar;
    __builtin_amdgcn_s_waitcnt(0);
    unsigned nloc = b.st[0], nx = b.st[1];
    if (nloc == 0u) { xcd_barrier_complete(bar, b.x, nloc, nx); b.st[0] = nloc; b.st[1] = nx; }
    const unsigned old = xb_add(&bar[XB_XSUB(b.x)], 1u);
    const unsigned gen = old / nloc;
    if (old + 1u == (gen + 1u) * nloc) {
      __builtin_amdgcn_fence(__ATOMIC_RELEASE, "agent");
      asm volatile("s_waitcnt vmcnt(0)" ::: "memory");
      const unsigned og = xb_add(&bar[XB_TOP], 1u);
      const unsigned tg = og / nx;
      if (og + 1u == (tg + 1u) * nx) xb_add(&bar[XB_TOPGEN], 1u);
      else XB_SPIN(xb_ld(&bar[XB_TOPGEN]) == tg, bar);
      __builtin_amdgcn_fence(__ATOMIC_ACQUIRE, "agent");
      xb_add(&bar[XB_XGEN(b.x)], 1u);
      asm volatile("s_waitcnt vmcnt(0)" ::: "memory");
    } else {
      XB_SPIN(xb_ld(&bar[XB_XGEN(b.x)]) == gen, bar);
      __builtin_amdgcn_fence(__ATOMIC_ACQUIRE, "agent");
      asm volatile("s_waitcnt vmcnt(0)" ::: "memory");
    }
  }
  __syncthreads();
}
#define CTL_BAR_WORD 4096
#define CTL_ZERO_BYTES 32768
#define LDS_BAR_OFF 66432

__global__ void __launch_bounds__(NTHR, 2) mega(Params p) {
  extern __shared__ __attribute__((aligned(16))) char smem[];
  cg::grid_group grid = cg::this_grid();
  volatile LAS unsigned* bst = (volatile LAS unsigned*)(LAS char*)(smem + LDS_BAR_OFF);
  if (threadIdx.x < 2) bst[threadIdx.x] = 0u;
  __syncthreads();
  const XcdBarrier bar = xcd_barrier_post((unsigned*)(p.ws + OFF_CTL) + CTL_BAR_WORD, bst);
  phase_rope(p);
  grid.sync();
  phase_inproj(p, smem);
  xcd_barrier(bar);
  phase_prep_a(p);
  xcd_barrier(bar);
  phase_prep(p, smem);
  xcd_barrier(bar);
  phase_scan(p, smem);
  phase_attn(p, smem);
  xcd_barrier(bar);
  phase_post(p);
  xcd_barrier(bar);
  phase_outproj(p, smem);
  xcd_barrier(bar);
  phase_ln1(p);
  xcd_barrier(bar);
  phase_router_gemm(p, smem);
  xcd_barrier(bar);
  phase_topk(p);
  xcd_barrier(bar);
  phase_moe1(p, smem);
  xcd_barrier(bar);
  phase_moe2(p, smem);
  xcd_barrier(bar);
  phase_final(p, smem);
}

extern "C" void kernel_launch(void* const* d_in, const int* in_sizes, int n_in, void* d_out, int out_size, void* d_ws, size_t ws_size,
                              hipStream_t stream) {
  static int grid_blocks = 0;
  if (grid_blocks == 0) {
    if (ws_size < WS_NEED || n_in != 26) { fprintf(stderr, "kernel_launch: bad ws/n_in: %zu < %zu, n_in %d\n", ws_size, (size_t)WS_NEED, n_in); grid_blocks = -1; return; }
    int dev = 0, cus = 0, per_cu = 0;
    (void)hipGetDevice(&dev);
    (void)hipDeviceGetAttribute(&cus, hipDeviceAttributeMultiprocessorCount, dev);
    (void)hipFuncSetAttribute((const void*)mega, hipFuncAttributeMaxDynamicSharedMemorySize, LDS_BYTES);
    (void)hipOccupancyMaxActiveBlocksPerMultiprocessor(&per_cu, (const void*)mega, NTHR, LDS_BYTES);
    if (per_cu < 1) { fprintf(stderr, "kernel_launch: occupancy query returned %d\n", per_cu); grid_blocks = -1; return; }
    if (per_cu > 2) per_cu = 2;
    grid_blocks = cus * per_cu;
    fprintf(stderr, "kernel_launch: cus %d per_cu %d grid %d\n", cus, per_cu, grid_blocks);
  }
  if (grid_blocks < 0) return;
  if (hipMemsetAsync((char*)d_ws + OFF_CTL, 0, CTL_ZERO_BYTES, stream) != hipSuccess) { fprintf(stderr, "kernel_launch: memset failed\n"); return; }
  Params p{};
  for (int i = 0; i < 26; ++i) p.in[i] = (const float*)d_in[i];
  p.out = (float*)d_out;
  p.ws = (char*)d_ws;
  void* args[] = {&p};
  hipError_t e = hipLaunchCooperativeKernel((const void*)mega, dim3(grid_blocks), dim3(NTHR), args, LDS_BYTES, stream);
  if (e != hipSuccess) fprintf(stderr, "cooperative launch failed: %s (grid %d)\n", hipGetErrorString(e), grid_blocks);
}
```

```cpp
#include <hip/hip_runtime.h>
#include <hip/hip_bf16.h>
#include <hip/hip_cooperative_groups.h>
#include <stdint.h>
#include <stdio.h>

typedef unsigned short bf16_t;

#define T_TOK 32768
#define SEQ 4096
#define DM 1024
#define INW 3360
#define FEW 1824
#define NEXP 256
#define ALPHA_F 1.189207115002721f
#define LN_EPS_F 1e-5f
#define GN_EPS_F 64e-5f

__device__ __forceinline__ float bf2f(bf16_t v) { return __uint_as_float(((unsigned)v) << 16); }
__device__ __forceinline__ bf16_t f2bf(float f) { unsigned u = __float_as_uint(f); return (bf16_t)((u + 0x7fffu + ((u >> 16) & 1u)) >> 16); }
__device__ __forceinline__ float sigmoidf_(float x) { return 1.f / (1.f + __expf(-x)); }
__device__ __forceinline__ float wave_sum(float v) {
#pragma unroll
  for (int o = 32; o >= 1; o >>= 1) v += __shfl_xor(v, o, 64);
  return v;
}

constexpr size_t SZ_T512_BF = (size_t)T_TOK * 512 * 2;
constexpr size_t OFF_EW1 = 0;
constexpr size_t OFF_EW2 = OFF_EW1 + (size_t)257 * 512 * 1024 * 2;
constexpr size_t LBASE = OFF_EW2 + (size_t)257 * 1024 * 256 * 2;
constexpr size_t OFF_XB = 0;
constexpr size_t OFF_FEATS = OFF_XB + (size_t)T_TOK * 1024 * 2;
constexpr size_t OFF_ACT = OFF_FEATS + (size_t)T_TOK * FEW * 2;
constexpr size_t OFF_WINT = OFF_ACT + (size_t)T_TOK * 320 * 2;
constexpr size_t OFF_ROPE = OFF_WINT + (size_t)3456 * 1024 * 2;
static_assert(OFF_ROPE + (size_t)4096 * 32 * 2 * 4 <= LBASE, "early region E overlay");
constexpr size_t OFF_Q = LBASE;
constexpr size_t OFF_K = OFF_Q + SZ_T512_BF;
constexpr size_t OFF_V = OFF_K + SZ_T512_BF;
constexpr size_t OFF_R = OFF_V + SZ_T512_BF;
constexpr size_t OFF_K2 = OFF_R + SZ_T512_BF;
constexpr size_t OFF_V2 = OFF_K2 + SZ_T512_BF;
constexpr size_t OFF_A = OFF_V2 + SZ_T512_BF;
constexpr size_t OFF_B = OFF_A + SZ_T512_BF;
constexpr size_t OFF_W = OFF_B + SZ_T512_BF;
constexpr size_t OFF_G = OFF_W + (size_t)T_TOK * 512 * 4;
constexpr size_t OFF_SB = OFF_G + SZ_T512_BF;
constexpr size_t OFF_YS = OFF_SB + (size_t)T_TOK * 8 * 4;
constexpr size_t OFF_OP = OFF_YS + (size_t)T_TOK * 512 * 4;
constexpr size_t OFF_LSE = OFF_OP + 3 * SZ_T512_BF;
constexpr size_t OFF_MIXED = OFF_LSE + (size_t)3 * T_TOK * 8 * 4;
constexpr size_t OFF_WOUTT = OFF_MIXED + (size_t)T_TOK * 1024 * 2;
constexpr size_t EARLY_END = OFF_WOUTT + (size_t)1024 * 1024 * 2;
constexpr size_t OFF_Y = LBASE;
constexpr size_t OFF_XL = LBASE;
constexpr size_t OFF_AFF = LBASE + (size_t)T_TOK * 1024 * 2;
constexpr size_t OFF_X1B = OFF_Y + (size_t)8 * T_TOK * 1024 * 2;
#define LCAP 16384
constexpr size_t OFF_LIST = OFF_X1B + (size_t)T_TOK * 1024 * 2;
constexpr size_t OFF_GATEW = OFF_LIST + (size_t)NEXP * LCAP * 4;
constexpr size_t OFF_HSCR = OFF_GATEW + (size_t)8 * T_TOK * 4;
constexpr size_t OFF_CTL = OFF_HSCR + (size_t)512 * 128 * 256 * 2;
constexpr size_t CTL_BYTES = 1u << 20;
constexpr size_t WS_NEED = OFF_CTL + CTL_BYTES;
static_assert(EARLY_END <= OFF_HSCR, "early buffers must stay below the per-block scratch / control words");
static_assert(WS_NEED <= (size_t)1073741824, "workspace must fit 1 GiB");
#define CTL_CONVQ 512

typedef short bf16x8 __attribute__((ext_vector_type(8)));
typedef float f32x4 __attribute__((ext_vector_type(4)));
typedef float f32x16 __attribute__((ext_vector_type(16)));
typedef float f32x2_t __attribute__((ext_vector_type(2)));
typedef __bf16 bf16x2_t __attribute__((ext_vector_type(2)));
__device__ __forceinline__ unsigned cvtpk(float lo, float hi) { f32x2_t v = {lo, hi}; bf16x2_t b = __builtin_convertvector(v, bf16x2_t); return __builtin_bit_cast(unsigned, b); }

__device__ const double INVF[32] = {
1, 0.74989420933245587, 0.56234132519034907, 0.42169650342858223, 0.31622776601683794, 0.23713737056616552,
0.17782794100389229, 0.1333521432163324, 0.10000000000000001, 0.074989420933245579, 0.056234132519034911,
0.042169650342858224, 0.031622776601683791, 0.023713737056616554, 0.017782794100389229, 0.013335214321633241,
0.01, 0.0074989420933245579, 0.005623413251903491, 0.0042169650342858229, 0.0031622776601683794,
0.0023713737056616554, 0.0017782794100389228, 0.0013335214321633241, 0.001, 0.00074989420933245586,
0.0005623413251903491, 0.00042169650342858224, 0.00031622776601683794, 0.00023713737056616554,
0.00017782794100389227, 0.0001333521432163324};

namespace cg = cooperative_groups;

struct Params {
  const float* in[26];
  float* out;
  char* ws;
};

#define NTHR 256
#define LDS_BYTES 66560

__device__ __forceinline__ void phase_rope(const Params& p) {
  float* tab = (float*)(p.ws + OFF_ROPE);
  for (int i = blockIdx.x * NTHR + threadIdx.x; i < 4096 * 32; i += gridDim.x * NTHR) {
    int pos = i >> 5, f = i & 31;
    double ang = (double)pos * INVF[f];
    const double TWO_PI = 6.283185307179586476925286766559;
    double n = rint(ang / TWO_PI);
    double r = ang - n * TWO_PI;
    double r2 = r * r;
    double sn = r, cs = 1.0, ts = r, tc = 1.0;
#pragma unroll 1
    for (int k = 1; k <= 16; ++k) {
      tc = -tc * r2 / (double)((2 * k - 1) * (2 * k));
      ts = -ts * r2 / (double)((2 * k) * (2 * k + 1));
      cs += tc; sn += ts;
    }
    tab[i * 2] = (float)cs; tab[i * 2 + 1] = (float)sn;
  }
  {
    const float* __restrict__ w_in = p.in[1]; const float* __restrict__ w_out = p.in[13];
    uint4* wint = (uint4*)(p.ws + OFF_WINT); uint4* woutt = (uint4*)(p.ws + OFF_WOUTT);
    const int NJ1 = 3456 * 128, NJ2 = 1024 * 128;
    for (int i = blockIdx.x * NTHR + threadIdx.x; i < NJ1 + NJ2; i += gridDim.x * NTHR) {
      const bool second = i >= NJ1;
      const int q = second ? i - NJ1 : i;
      const int N = second ? 1024 : 3456, NV = second ? 1024 : INW;
      const int n = q % N, ko = q / N;
      const float* __restrict__ src = second ? w_out : w_in;
      float f[8];
#pragma unroll
      for (int u = 0; u < 8; ++u) f[u] = (n < NV) ? src[(size_t)(ko * 8 + u) * NV + n] : 0.f;
      uint4 w; w.x = cvtpk(f[0], f[1]); w.y = cvtpk(f[2], f[3]); w.z = cvtpk(f[4], f[5]); w.w = cvtpk(f[6], f[7]);
      (second ? woutt : wint)[(size_t)n * 128 + ko] = w;
    }
  }
  {
    const float4* __restrict__ x4 = (const float4*)p.in[0];
    uint4* xb = (uint4*)(p.ws + OFF_XB);
    for (size_t i = (size_t)blockIdx.x * NTHR + threadIdx.x; i < (size_t)T_TOK * DM / 8; i += (size_t)gridDim.x * NTHR) {
      float4 a = x4[2 * i], b = x4[2 * i + 1];
      uint4 w; w.x = cvtpk(a.x, a.y); w.y = cvtpk(a.z, a.w); w.z = cvtpk(b.x, b.y); w.w = cvtpk(b.z, b.w);
      xb[i] = w;
    }
  }
}

template <class AF, class BF>
__device__ __forceinline__ void gemm64_naive(float* As, float* Bs, float* Cs, int K, AF af, BF bf) {
  const int tid = threadIdx.x, tx = tid & 15, ty = tid >> 4;
  float acc[4][4];
#pragma unroll
  for (int i = 0; i < 4; ++i)
#pragma unroll
    for (int j = 0; j < 4; ++j) acc[i][j] = 0.f;
  for (int k0 = 0; k0 < K; k0 += 16) {
#pragma unroll
    for (int u = 0; u < 4; ++u) { int i = tid + u * 256; int r = i >> 4, kk = i & 15; As[kk * 68 + r] = af(r, k0 + kk); }
#pragma unroll
    for (int u = 0; u < 4; ++u) { int i = tid + u * 256; int kk = i >> 6, c = i & 63; Bs[kk * 68 + c] = bf(k0 + kk, c); }
    __syncthreads();
#pragma unroll
    for (int kk = 0; kk < 16; ++kk) {
      float a[4], b[4];
#pragma unroll
      for (int i = 0; i < 4; ++i) { a[i] = As[kk * 68 + ty * 4 + i]; b[i] = Bs[kk * 68 + tx * 4 + i]; }
#pragma unroll
      for (int i = 0; i < 4; ++i)
#pragma unroll
        for (int j = 0; j < 4; ++j) acc[i][j] += a[i] * b[j];
    }
    __syncthreads();
  }
#pragma unroll
  for (int i = 0; i < 4; ++i)
#pragma unroll
    for (int j = 0; j < 4; ++j) Cs[(ty * 4 + i) * 65 + tx * 4 + j] = acc[i][j];
  __syncthreads();
}


__device__ __forceinline__ int lds_off(int row, int chunk) { return row * 128 + ((chunk ^ ((row >> 1) & 7)) << 4); }

template <int BMODE>
__device__ __forceinline__ unsigned cvtpk_m(float a, float b, const bool lo = false) {
  if (BMODE == 0 || (BMODE == 2 && !lo)) return cvtpk(a, b);
  const unsigned h = cvtpk(a, b);
  const float ah = __uint_as_float(h << 16), bh = __uint_as_float(h & 0xffff0000u);
  return cvtpk(a - ah, b - bh);
}
#define G128_MMA(bufoff) { \
    _Pragma("unroll") for (int kk = 0; kk < 2; ++kk) { \
      bf16x8 af[4], bfr[4]; \
      _Pragma("unroll") for (int m = 0; m < 4; ++m) af[m] = *(const bf16x8*)(smem + (bufoff) + lds_off(wr * 64 + m * 16 + fr, kk * 4 + fq)); \
      _Pragma("unroll") for (int n = 0; n < 4; ++n) bfr[n] = *(const bf16x8*)(smem + (bufoff) + 16384 + lds_off(wc * 64 + n * 16 + fr, kk * 4 + fq)); \
      _Pragma("unroll") for (int m = 0; m < 4; ++m) \
        _Pragma("unroll") for (int n = 0; n < 4; ++n) acc[m][n] = __builtin_amdgcn_mfma_f32_16x16x32_bf16(bfr[n], af[m], acc[m][n], 0, 0, 0); \
    } }
template <int BMODE, bool KCLAMP, class ALoad, class BPtr>
__device__ __forceinline__ void gemm128_acc(f32x4 (&acc)[4][4], char* smem, const int nk, ALoad aload, BPtr bptr, const int ldb, const int kvalid) {
  const int tid = threadIdx.x, lane = tid & 63, wid = tid >> 6;
  const int wr = wid >> 1, wc = wid & 1, fr = lane & 15, fq = lane >> 4;
  const int achunk = tid & 7, arow0 = tid >> 3;
  const int nq = tid & 31, ko = tid >> 5;
  const float* bp0 = bptr(nq);
  const int oa0 = lds_off(arow0, achunk), oa1 = lds_off(arow0 + 32, achunk), oa2 = lds_off(arow0 + 64, achunk), oa3 = lds_off(arow0 + 96, achunk);
  const int ob0 = 16384 + lds_off(nq * 4 + 0, ko), ob1 = 16384 + lds_off(nq * 4 + 1, ko), ob2 = 16384 + lds_off(nq * 4 + 2, ko), ob3 = 16384 + lds_off(nq * 4 + 3, ko);
  uint4 ra0, ra1, ra2, ra3; float4 rb0, rb1, rb2, rb3, rb4, rb5, rb6, rb7;
#define G128_LOAD(kt) { \
    ra0 = aload(0, arow0, (kt) * 8 + achunk); ra1 = aload(1, arow0 + 32, (kt) * 8 + achunk); \
    ra2 = aload(2, arow0 + 64, (kt) * 8 + achunk); ra3 = aload(3, arow0 + 96, (kt) * 8 + achunk); \
    int kr_ = (kt) * 64 + ko * 8; \
    if (KCLAMP) kr_ = min(kr_, kvalid - 8);     \
    { \
      const float* b2_ = bp0 + (size_t)((BMODE == 2) ? (kr_ & 1023) : kr_) * ldb; \
      rb0 = *(const float4*)(b2_); rb1 = *(const float4*)(b2_ + (size_t)1 * ldb); rb2 = *(const float4*)(b2_ + (size_t)2 * ldb); \
      rb3 = *(const float4*)(b2_ + (size_t)3 * ldb); rb4 = *(const float4*)(b2_ + (size_t)4 * ldb); rb5 = *(const float4*)(b2_ + (size_t)5 * ldb); \
      rb6 = *(const float4*)(b2_ + (size_t)6 * ldb); rb7 = *(const float4*)(b2_ + (size_t)7 * ldb); \
    } }
#define G128_STORE(bufoff, lo_) { \
    char* const sb_ = smem + (bufoff); \
    *(uint4*)(sb_ + oa0) = ra0; *(uint4*)(sb_ + oa1) = ra1; *(uint4*)(sb_ + oa2) = ra2; *(uint4*)(sb_ + oa3) = ra3; \
    uint4 w; \
    w.x = cvtpk_m<BMODE>(rb0.x, rb1.x, lo_); w.y = cvtpk_m<BMODE>(rb2.x, rb3.x, lo_); w.z = cvtpk_m<BMODE>(rb4.x, rb5.x, lo_); w.w = cvtpk_m<BMODE>(rb6.x, rb7.x, lo_); \
    *(uint4*)(sb_ + ob0) = w; \
    w.x = cvtpk_m<BMODE>(rb0.y, rb1.y, lo_); w.y = cvtpk_m<BMODE>(rb2.y, rb3.y, lo_); w.z = cvtpk_m<BMODE>(rb4.y, rb5.y, lo_); w.w = cvtpk_m<BMODE>(rb6.y, rb7.y, lo_); \
    *(uint4*)(sb_ + ob1) = w; \
    w.x = cvtpk_m<BMODE>(rb0.z, rb1.z, lo_); w.y = cvtpk_m<BMODE>(rb2.z, rb3.z, lo_); w.z = cvtpk_m<BMODE>(rb4.z, rb5.z, lo_); w.w = cvtpk_m<BMODE>(rb6.z, rb7.z, lo_); \
    *(uint4*)(sb_ + ob2) = w; \
    w.x = cvtpk_m<BMODE>(rb0.w, rb1.w, lo_); w.y = cvtpk_m<BMODE>(rb2.w, rb3.w, lo_); w.z = cvtpk_m<BMODE>(rb4.w, rb5.w, lo_); w.w = cvtpk_m<BMODE>(rb6.w, rb7.w, lo_); \
    *(uint4*)(sb_ + ob3) = w; }
  G128_LOAD(0)
  G128_STORE(0, false)
  if (nk > 1) G128_LOAD(1)
  __syncthreads();
  for (int kt = 0; kt < nk; ++kt) {
    const int cur = (kt & 1) * 32768;
    __builtin_amdgcn_sched_barrier(0);
    G128_MMA(cur)
    __builtin_amdgcn_sched_barrier(0);
    if (kt + 1 < nk) {
      G128_STORE(cur ^ 32768, (kt + 1) >= 32)
      __builtin_amdgcn_sched_barrier(0);
      if (kt + 2 < nk) G128_LOAD(kt + 2)
    }
    __builtin_amdgcn_sched_barrier(0);
    __syncthreads();
  }
#undef G128_LOAD
#undef G128_STORE
}
__device__ __forceinline__ void acc_zero(f32x4 (&acc)[4][4]) {
#pragma unroll
  for (int m = 0; m < 4; ++m)
#pragma unroll
    for (int n = 0; n < 4; ++n) acc[m][n] = (f32x4){0.f, 0.f, 0.f, 0.f};
}
template <class ARow, class BPtr, class Epi>
__device__ __forceinline__ void gemm128(char* smem, const int K, ARow arow, BPtr bptr, const int ldb, Epi epi) {
  const int tid = threadIdx.x, lane = tid & 63, wid = tid >> 6;
  const int arow0 = tid >> 3;
  const bf16_t* ap0 = arow(arow0);
  const bf16_t* ap1 = arow(arow0 + 32);
  const bf16_t* ap2 = arow(arow0 + 64);
  const bf16_t* ap3 = arow(arow0 + 96);
  f32x4 acc[4][4];
  acc_zero(acc);
  gemm128_acc<0, false>(acc, smem, K >> 6,
      [=](int u, int, int kc) { const bf16_t* q = (u == 0) ? ap0 : (u == 1) ? ap1 : (u == 2) ? ap2 : ap3; return *(const uint4*)(q + kc * 8); },
      bptr, ldb, 0);
  epi(acc, wid >> 1, wid & 1, lane & 15, lane >> 4);
}


template <class ALoad, class BLoad>
__device__ __forceinline__ void gemm128_acc_bb(f32x4 (&acc)[4][4], char* smem, const int nk, ALoad aload, BLoad bload) {
  const int tid = threadIdx.x, lane = tid & 63, wid = tid >> 6;
  const int wr = wid >> 1, wc = wid & 1, fr = lane & 15, fq = lane >> 4;
  const int achunk = tid & 7, arow0 = tid >> 3;
  const int oa0 = lds_off(arow0, achunk), oa1 = lds_off(arow0 + 32, achunk), oa2 = lds_off(arow0 + 64, achunk), oa3 = lds_off(arow0 + 96, achunk);
  uint4 ra0, ra1, ra2, ra3, rb0, rb1, rb2, rb3;
#define G128_LOADBB(kt) { \
    ra0 = aload(0, arow0, (kt) * 8 + achunk); ra1 = aload(1, arow0 + 32, (kt) * 8 + achunk); \
    ra2 = aload(2, arow0 + 64, (kt) * 8 + achunk); ra3 = aload(3, arow0 + 96, (kt) * 8 + achunk); \
    rb0 = bload(0, arow0, (kt) * 8 + achunk); rb1 = bload(1, arow0 + 32, (kt) * 8 + achunk); \
    rb2 = bload(2, arow0 + 64, (kt) * 8 + achunk); rb3 = bload(3, arow0 + 96, (kt) * 8 + achunk); }
#define G128_STOREBB(bufoff) { \
    char* const sb_ = smem + (bufoff); \
    *(uint4*)(sb_ + oa0) = ra0; *(uint4*)(sb_ + oa1) = ra1; *(uint4*)(sb_ + oa2) = ra2; *(uint4*)(sb_ + oa3) = ra3; \
    *(uint4*)(sb_ + 16384 + oa0) = rb0; *(uint4*)(sb_ + 16384 + oa1) = rb1; *(uint4*)(sb_ + 16384 + oa2) = rb2; *(uint4*)(sb_ + 16384 + oa3) = rb3; }
  G128_LOADBB(0)
  G128_STOREBB(0)
  if (nk > 1) G128_LOADBB(1)
  __syncthreads();
  for (int kt = 0; kt < nk; ++kt) {
    const int cur = (kt & 1) * 32768;
    __builtin_amdgcn_sched_barrier(0);
    G128_MMA(cur)
    __builtin_amdgcn_sched_barrier(0);
    if (kt + 1 < nk) {
      G128_STOREBB(cur ^ 32768)
      __builtin_amdgcn_sched_barrier(0);
      if (kt + 2 < nk) G128_LOADBB(kt + 2)
    }
    __builtin_amdgcn_sched_barrier(0);
    __syncthreads();
  }
#undef G128_LOADBB
#undef G128_STOREBB
}
template <class ARow, class BRow, class Epi>
__device__ __forceinline__ void gemm128_bb(char* smem, const int K, ARow arow, BRow brow, Epi epi) {
  const int tid = threadIdx.x, lane = tid & 63, wid = tid >> 6;
  const int arow0 = tid >> 3;
  const bf16_t* ap0 = arow(arow0); const bf16_t* ap1 = arow(arow0 + 32); const bf16_t* ap2 = arow(arow0 + 64); const bf16_t* ap3 = arow(arow0 + 96);
  const bf16_t* bp0 = brow(arow0); const bf16_t* bp1 = brow(arow0 + 32); const bf16_t* bp2 = brow(arow0 + 64); const bf16_t* bp3 = brow(arow0 + 96);
  f32x4 acc[4][4];
  acc_zero(acc);
  gemm128_acc_bb(acc, smem, K >> 6,
      [=](int u, int, int kc) { const bf16_t* q = (u == 0) ? ap0 : (u == 1) ? ap1 : (u == 2) ? ap2 : ap3; return *(const uint4*)(q + kc * 8); },
      [=](int u, int, int kc) { const bf16_t* q = (u == 0) ? bp0 : (u == 1) ? bp1 : (u == 2) ? bp2 : bp3; return *(const uint4*)(q + kc * 8); });
  epi(acc, wid >> 1, wid & 1, lane & 15, lane >> 4);
}


#define GAS1 __attribute__((address_space(1)))
#define LAS3 __attribute__((address_space(3)))
__device__ __forceinline__ void glds16(const void* g, char* l) {
  __builtin_amdgcn_global_load_lds((const GAS1 void*)g, (LAS3 void*)l, 16, 0, 0);
}
template <class ARow, class BRow, class Epi>
__device__ __forceinline__ void gemm128_glds(char* smem, const int K, ARow arow, BRow brow, Epi epi) {
  const int tid = threadIdx.x, lane = tid & 63, wid = tid >> 6;
  const int wr = wid >> 1, wc = wid & 1, fr = lane & 15, fq = lane >> 4;
  const int r0 = tid >> 3;
  const int cl = (tid & 7) ^ ((tid >> 4) & 7);
  const bf16_t* ga0 = arow(r0) + cl * 8; const bf16_t* ga1 = arow(r0 + 32) + cl * 8; const bf16_t* ga2 = arow(r0 + 64) + cl * 8; const bf16_t* ga3 = arow(r0 + 96) + cl * 8;
  const bf16_t* gb0 = brow(r0) + cl * 8; const bf16_t* gb1 = brow(r0 + 32) + cl * 8; const bf16_t* gb2 = brow(r0 + 64) + cl * 8; const bf16_t* gb3 = brow(r0 + 96) + cl * 8;
  char* const lbase = smem + tid * 16;
#define GL_STAGE(bufoff, kt) { \
    char* const d_ = lbase + (bufoff); const int ko_ = (kt) * 64; \
    glds16(ga0 + ko_, d_); glds16(ga1 + ko_, d_ + 4096); glds16(ga2 + ko_, d_ + 8192); glds16(ga3 + ko_, d_ + 12288); \
    glds16(gb0 + ko_, d_ + 16384); glds16(gb1 + ko_, d_ + 20480); glds16(gb2 + ko_, d_ + 24576); glds16(gb3 + ko_, d_ + 28672); }
  f32x4 acc[4][4];
  acc_zero(acc);
  const int nk = K >> 6;
  GL_STAGE(0, 0)
  asm volatile("s_waitcnt vmcnt(0)" ::: "memory");
  __syncthreads();
  for (int kt = 0; kt < nk; ++kt) {
    const int cur = (kt & 1) * 32768;
    if (kt + 1 < nk) GL_STAGE(cur ^ 32768, kt + 1)
    G128_MMA(cur)
    asm volatile("s_waitcnt vmcnt(0)" ::: "memory");
    __syncthreads();
  }
#undef GL_STAGE
  epi(acc, wr, wc, fr, fq);
}

#define DPP_F(v, ctrl) __builtin_bit_cast(float, __builtin_amdgcn_update_dpp(0, __builtin_bit_cast(int, (v)), (ctrl), 0xF, 0xF, true))
__device__ __forceinline__ float rdlane_f(float v, int l) { return __builtin_bit_cast(float, __builtin_amdgcn_readlane(__builtin_bit_cast(int, v), l)); }
__device__ __forceinline__ float dpp_sum16x(float v) {
  v += DPP_F(v, 0xB1); v += DPP_F(v, 0x4E); v += DPP_F(v, 0x141); v += DPP_F(v, 0x140);
  return v;
}
__device__ __forceinline__ float dpp_max16x(float v) {
  v = fmaxf(v, DPP_F(v, 0xB1)); v = fmaxf(v, DPP_F(v, 0x4E)); v = fmaxf(v, DPP_F(v, 0x141)); v = fmaxf(v, DPP_F(v, 0x140));
  return v;
}
__device__ __forceinline__ float wave_sum_fast(float v) {
  v = dpp_sum16x(v);
  return (rdlane_f(v, 0) + rdlane_f(v, 16)) + (rdlane_f(v, 32) + rdlane_f(v, 48));
}
__device__ __forceinline__ float wave_max_fast(float v) {
  v = dpp_max16x(v);
  return fmaxf(fmaxf(rdlane_f(v, 0), rdlane_f(v, 16)), fmaxf(rdlane_f(v, 32), rdlane_f(v, 48)));
}
__device__ __forceinline__ float fast_tanh(float x) { const float e = __expf(2.f * x); return 1.f - 2.f / (e + 1.f); }


__device__ __forceinline__ float4 bf4_to_f4(uint2 u) {
  float4 r;
  r.x = __uint_as_float(u.x << 16); r.y = __uint_as_float(u.x & 0xffff0000u);
  r.z = __uint_as_float(u.y << 16); r.w = __uint_as_float(u.y & 0xffff0000u);
  return r;
}
__device__ __forceinline__ uint2 pack4(float a, float b, float c, float d) { uint2 r; r.x = cvtpk(a, b); r.y = cvtpk(c, d); return r; }
#define XCD_GROUP (blockIdx.x & 7)
#define XCD_LB (blockIdx.x >> 3)
#define XCD_NB ((gridDim.x + 7 - (blockIdx.x & 7)) >> 3)

__device__ __forceinline__ void phase_inproj(const Params& p, char* smem) {
  const bf16_t* __restrict__ XB = (const bf16_t*)(p.ws + OFF_XB);
  const bf16_t* __restrict__ WINT = (const bf16_t*)(p.ws + OFF_WINT);
  const float* __restrict__ rope = (const float*)(p.ws + OFF_ROPE);
  bf16_t* Q = (bf16_t*)(p.ws + OFF_Q); bf16_t* K = (bf16_t*)(p.ws + OFF_K); bf16_t* V = (bf16_t*)(p.ws + OFF_V);
  bf16_t* FE = (bf16_t*)(p.ws + OFF_FEATS);
  const int NT = 27, NITEM = (T_TOK / 128) * NT, CHUNK = NITEM / 8;
  for (int i = XCD_LB; i < CHUNK; i += XCD_NB) {
    const int item = XCD_GROUP * CHUNK + i;
    const int row0 = (item & 255) * 128, col0 = (item >> 8) * 128;
    gemm128_glds(smem, DM,
            [=](int r) { return XB + (size_t)(row0 + r) * DM; },
            [=](int r) { return WINT + (size_t)(col0 + r) * DM; },
            [=](f32x4 (&acc)[4][4], int wr, int wc, int fr, int fq) {
              const int cb = col0 + wc * 64;
              if (cb >= INW) return;
#pragma unroll
              for (int m = 0; m < 4; ++m) {
                const int t = row0 + wr * 64 + m * 16 + fr;
                if (cb < 1024) {
                  const int pos = t & (SEQ - 1);
                  bf16_t* dst = (cb < 512) ? (Q + (size_t)t * 512 + cb) : (K + (size_t)t * 512 + (cb - 512));
                  const float sc = (cb < 512) ? 0.125f : 1.f;
#pragma unroll
                  for (int n = 0; n < 2; ++n) {
                    const int f0 = n * 16 + fq * 4;
                    const float4 c01 = *(const float4*)(rope + (size_t)(pos * 32 + f0) * 2);
                    const float4 c23 = *(const float4*)(rope + (size_t)(pos * 32 + f0) * 2 + 4);
                    const float cs[4] = {c01.x, c01.z, c23.x, c23.z}, sn[4] = {c01.y, c01.w, c23.y, c23.w};
                    float o1[4], o2[4];
#pragma unroll
                    for (int j = 0; j < 4; ++j) {
                      const float z1 = acc[m][n][j], z2 = acc[m][n + 2][j];
                      o1[j] = (z1 * cs[j] - z2 * sn[j]) * sc; o2[j] = (z2 * cs[j] + z1 * sn[j]) * sc;
                    }
                    *(uint2*)(dst + f0) = pack4(o1[0], o1[1], o1[2], o1[3]);
                    *(uint2*)(dst + 32 + f0) = pack4(o2[0], o2[1], o2[2], o2[3]);
                  }
                } else if (cb < 1536) {
#pragma unroll
                  for (int n = 0; n < 4; ++n)
                    *(uint2*)(V + (size_t)t * 512 + (cb - 1024) + n * 16 + fq * 4) = pack4(acc[m][n][0], acc[m][n][1], acc[m][n][2], acc[m][n][3]);
                } else {
#pragma unroll
                  for (int n = 0; n < 4; ++n) {
                    const int c = cb + n * 16 + fq * 4;
                    if (c < INW) *(uint2*)(FE + (size_t)t * FEW + (c - 1536)) = pack4(acc[m][n][0], acc[m][n][1], acc[m][n][2], acc[m][n][3]);
                  }
                }
              }
            });
  }
}

__device__ __forceinline__ void phase_prep_a(const Params& p) {
  const bf16_t* __restrict__ FE = (const bf16_t*)(p.ws + OFF_FEATS);
  const float* __restrict__ mu = p.in[2];
  bf16_t* R = (bf16_t*)(p.ws + OFF_R); bf16_t* K2 = (bf16_t*)(p.ws + OFF_K2); bf16_t* V2 = (bf16_t*)(p.ws + OFF_V2);
  bf16_t* ACT = (bf16_t*)(p.ws + OFF_ACT);
  for (size_t i = (size_t)blockIdx.x * NTHR + threadIdx.x; i < (size_t)T_TOK * 232; i += (size_t)gridDim.x * NTHR) {
    const int t = (int)(i / 232), ch = (int)(i - (size_t)t * 232);
    if (ch >= 228) { *(uint4*)(ACT + (size_t)t * 320 + 288 + (ch - 228) * 8) = make_uint4(0u, 0u, 0u, 0u); continue; }
    const int col = ch * 8;
    const uint4 cu = *(const uint4*)(FE + (size_t)t * FEW + col);
    uint4 pv = make_uint4(0u, 0u, 0u, 0u);
    if ((t & (SEQ - 1)) != 0) pv = *(const uint4*)(FE + (size_t)(t - 1) * FEW + col);
    const float4 m0 = *(const float4*)(mu + col), m1 = *(const float4*)(mu + col + 4);
    const unsigned cw[4] = {cu.x, cu.y, cu.z, cu.w}, pw[4] = {pv.x, pv.y, pv.z, pv.w};
    const float mm[8] = {m0.x, m0.y, m0.z, m0.w, m1.x, m1.y, m1.z, m1.w};
    float f[8];
#pragma unroll
    for (int q = 0; q < 4; ++q) {
      const float c0 = __uint_as_float(cw[q] << 16), c1 = __uint_as_float(cw[q] & 0xffff0000u);
      const float p0 = __uint_as_float(pw[q] << 16), p1 = __uint_as_float(pw[q] & 0xffff0000u);
      f[2 * q] = c0 + (p0 - c0) * mm[2 * q];
      f[2 * q + 1] = c1 + (p1 - c1) * mm[2 * q + 1];
    }
    bf16_t* dst;
    if (col < 512) dst = R + (size_t)t * 512 + col;
    else if (col < 1024) dst = K2 + (size_t)t * 512 + (col - 512);
    else if (col < 1536) dst = V2 + (size_t)t * 512 + (col - 1024);
    else {
      dst = ACT + (size_t)t * 320 + (col - 1536);
      if (col < 1600) {
#pragma unroll
        for (int q = 0; q < 8; ++q) f[q] = fast_tanh(f[q]);
      } else if (col >= 1664) {
#pragma unroll
        for (int q = 0; q < 8; ++q) f[q] = sigmoidf_(f[q]);
      }
    }
    uint4 w; w.x = cvtpk(f[0], f[1]); w.y = cvtpk(f[2], f[3]); w.z = cvtpk(f[4], f[5]); w.w = cvtpk(f[6], f[7]);
    *(uint4*)dst = w;
  }
}

template <int PASS>
__device__ __forceinline__ void prep_item(const Params& p, char* smem, const int row0, const int col0) {
  const bf16_t* __restrict__ ACT = (const bf16_t*)(p.ws + OFF_ACT);
  constexpr int ACOL = PASS * 64;
  constexpr int NK = (PASS == 2) ? 3 : 1;
  const float* __restrict__ Wm = (PASS == 0) ? p.in[4] : (PASS == 1) ? p.in[6] : p.in[7];
  f32x4 acc[4][4];
  acc_zero(acc);
  gemm128_acc<0, (PASS == 2)>(acc, smem, NK,
      [=](int, int rowl, int kc) { return *(const uint4*)(ACT + (size_t)(row0 + rowl) * 320 + ACOL + kc * 8); },
      [=](int nq) { return Wm + col0 + nq * 4; }, 512, 160);
  const int tid = threadIdx.x, lane = tid & 63, wid = tid >> 6;
  const int wr = wid >> 1, wc = wid & 1, fr = lane & 15, fq = lane >> 4;
  const int cb = col0 + wc * 64;
  if (PASS == 0) {
    const float* __restrict__ w0 = p.in[3];
    float* W = (float*)(p.ws + OFF_W);
#pragma unroll
    for (int n = 0; n < 4; ++n) {
      const int c = cb + n * 16 + fq * 4;
      const float4 w04 = *(const float4*)(w0 + c);
      const float w0c[4] = {w04.x, w04.y, w04.z, w04.w};
#pragma unroll
      for (int m = 0; m < 4; ++m) {
        const int t = row0 + wr * 64 + m * 16 + fr;
        float d[4];
#pragma unroll
        for (int j = 0; j < 4; ++j) {
          const float nz = -(w0c[j] + acc[m][n][j]);
          const float sp = fmaxf(nz, 0.f) + __logf(1.f + __expf(-fabsf(nz)));
          d[j] = __expf(-__expf(-sp - 0.5f));
        }
        *(float4*)(W + (size_t)t * 512 + c) = make_float4(d[0], d[1], d[2], d[3]);
      }
    }
  } else if (PASS == 2) {
    bf16_t* G = (bf16_t*)(p.ws + OFF_G);
#pragma unroll
    for (int m = 0; m < 4; ++m) {
      const int t = row0 + wr * 64 + m * 16 + fr;
#pragma unroll
      for (int n = 0; n < 4; ++n)
        *(uint2*)(G + (size_t)t * 512 + cb + n * 16 + fq * 4) = pack4(acc[m][n][0], acc[m][n][1], acc[m][n][2], acc[m][n][3]);
    }
  } else {
    const float* __restrict__ a0 = p.in[5]; const float* __restrict__ k_k = p.in[8]; const float* __restrict__ k_a = p.in[9];
    const float* __restrict__ r_k = p.in[10];
    const bf16_t* __restrict__ R = (const bf16_t*)(p.ws + OFF_R); bf16_t* K2 = (bf16_t*)(p.ws + OFF_K2);
    bf16_t* A = (bf16_t*)(p.ws + OFF_A); bf16_t* B = (bf16_t*)(p.ws + OFF_B); float* SB = (float*)(p.ws + OFF_SB);
#pragma unroll
    for (int m = 0; m < 4; ++m) {
      __builtin_amdgcn_sched_barrier(0);
      const int t = row0 + wr * 64 + m * 16 + fr;
      float kk[4][4];
      float ssp = 0.f, sbp = 0.f;
#pragma unroll
      for (int n = 0; n < 4; ++n) {
        const int c = cb + n * 16 + fq * 4;
        const size_t o = (size_t)t * 512 + c;
        const float4 rr4 = bf4_to_f4(*(const uint2*)(R + o)), kx4 = bf4_to_f4(*(const uint2*)(K2 + o));
        const float rr[4] = {rr4.x, rr4.y, rr4.z, rr4.w}, kx[4] = {kx4.x, kx4.y, kx4.z, kx4.w};
        const float4 a04 = *(const float4*)(a0 + c), kk4 = *(const float4*)(k_k + c), ka4 = *(const float4*)(k_a + c), rk4 = *(const float4*)(r_k + c);
        const float a0c[4] = {a04.x, a04.y, a04.z, a04.w}, kkc[4] = {kk4.x, kk4.y, kk4.z, kk4.w}, kac[4] = {ka4.x, ka4.y, ka4.z, ka4.w};
        const float rkc[4] = {rk4.x, rk4.y, rk4.z, rk4.w};
        float k2[4];
#pragma unroll
        for (int j = 0; j < 4; ++j) {
          const float av = sigmoidf_(a0c[j] + acc[m][n][j]);
          acc[m][n][j] = av;
          kk[n][j] = kx[j] * kkc[j];
          k2[j] = kx[j] * (1.f + (av - 1.f) * kac[j]);
          ssp += kk[n][j] * kk[n][j];
          sbp += rr[j] * k2[j] * rkc[j];
        }
        *(uint2*)(K2 + o) = pack4(k2[0], k2[1], k2[2], k2[3]);
      }
      ssp += __shfl_xor(ssp, 16, 64); ssp += __shfl_xor(ssp, 32, 64);
      sbp += __shfl_xor(sbp, 16, 64); sbp += __shfl_xor(sbp, 32, 64);
      const float inv = 1.f / fmaxf(sqrtf(ssp), 1e-12f);
#pragma unroll
      for (int n = 0; n < 4; ++n) {
        const size_t o = (size_t)t * 512 + cb + n * 16 + fq * 4;
        *(uint2*)(A + o) = pack4(-kk[n][0] * inv, -kk[n][1] * inv, -kk[n][2] * inv, -kk[n][3] * inv);
        *(uint2*)(B + o) = pack4(kk[n][0] * inv * acc[m][n][0], kk[n][1] * inv * acc[m][n][1], kk[n][2] * inv * acc[m][n][2], kk[n][3] * inv * acc[m][n][3]);
      }
      if (fq == 0) SB[(size_t)t * 8 + (cb >> 6)] = sbp;
    }
  }
}
__device__ __forceinline__ void phase_prep(const Params& p, char* smem) {
  for (int item = blockIdx.x; item < (T_TOK / 128) * 12; item += gridDim.x) {
    const int mt = item / 12, sub = item - mt * 12, pass = sub >> 2, nt = sub & 3;
    if (pass == 0) prep_item<0>(p, smem, mt * 128, nt * 128);
    else if (pass == 1) prep_item<1>(p, smem, mt * 128, nt * 128);
    else prep_item<2>(p, smem, mt * 128, nt * 128);
  }
}

__device__ __forceinline__ float dpp_sum16(float v) {
  v += __builtin_bit_cast(float, __builtin_amdgcn_update_dpp(0, __builtin_bit_cast(int, v), 0xB1, 0xF, 0xF, true));
  v += __builtin_bit_cast(float, __builtin_amdgcn_update_dpp(0, __builtin_bit_cast(int, v), 0x4E, 0xF, 0xF, true));
  v += __builtin_bit_cast(float, __builtin_amdgcn_update_dpp(0, __builtin_bit_cast(int, v), 0x141, 0xF, 0xF, true));
  v += __builtin_bit_cast(float, __builtin_amdgcn_update_dpp(0, __builtin_bit_cast(int, v), 0x140, 0xF, 0xF, true));
  return v;
}
#define SC_CH 16
#define SC_ARR (SC_CH * 64 * 4)
#define SC_BUF (5 * SC_ARR + SC_CH * 16 * 4)
__device__ __forceinline__ void phase_scan(const Params& p, char* smem) {
  if (blockIdx.x >= 256) return;
  const bf16_t* __restrict__ R = (const bf16_t*)(p.ws + OFF_R); const bf16_t* __restrict__ K2 = (const bf16_t*)(p.ws + OFF_K2);
  const bf16_t* __restrict__ V2 = (const bf16_t*)(p.ws + OFF_V2); const bf16_t* __restrict__ A = (const bf16_t*)(p.ws + OFF_A);
  const bf16_t* __restrict__ B = (const bf16_t*)(p.ws + OFF_B); const float* __restrict__ W = (const float*)(p.ws + OFF_W);
  float* YS = (float*)(p.ws + OFF_YS);
  const int bh = blockIdx.x >> 2, rg = blockIdx.x & 3, b = bh >> 3, h = bh & 7;
  const int tid = threadIdx.x, lane = tid & 63, wid = tid >> 6, j = lane & 15, rq = lane >> 4;
  const int rowl = wid * 4 + rq;
  const int ls = tid >> 4, lc = tid & 15;
  const int vs = (tid >> 2) & 15, vq = tid & 3;
  const size_t tb = (size_t)b * SEQ;
  const size_t goff = (tb + ls) * 512 + h * 64 + lc * 4;
  const size_t voff = (tb + vs) * 512 + h * 64 + rg * 16 + vq * 4;
  uint2 ga, gb, gk, gr, gv; float4 gw;
  gv = make_uint2(0u, 0u);
  ga = *(const uint2*)(A + goff); gb = *(const uint2*)(B + goff); gk = *(const uint2*)(K2 + goff); gr = *(const uint2*)(R + goff);
  gw = *(const float4*)(W + goff);
  if (tid < 64) gv = *(const uint2*)(V2 + voff);
  {
    char* bf = smem;
    *(float4*)(bf + 0 * SC_ARR + ls * 256 + lc * 16) = bf4_to_f4(ga);
    *(float4*)(bf + 1 * SC_ARR + ls * 256 + lc * 16) = gw;
    *(float4*)(bf + 2 * SC_ARR + ls * 256 + lc * 16) = bf4_to_f4(gb);
    *(float4*)(bf + 3 * SC_ARR + ls * 256 + lc * 16) = bf4_to_f4(gk);
    *(float4*)(bf + 4 * SC_ARR + ls * 256 + lc * 16) = bf4_to_f4(gr);
    if (tid < 64) *(float4*)(bf + 5 * SC_ARR + vs * 64 + vq * 16) = bf4_to_f4(gv);
  }
  __syncthreads();
  float s0 = 0.f, s1 = 0.f, s2 = 0.f, s3 = 0.f;
  const int NCH = SEQ / SC_CH;
  for (int c = 0; c < NCH; ++c) {
    if (c + 1 < NCH) {
      const size_t o2 = goff + (size_t)(c + 1) * SC_CH * 512;
      ga = *(const uint2*)(A + o2); gb = *(const uint2*)(B + o2); gk = *(const uint2*)(K2 + o2); gr = *(const uint2*)(R + o2);
      gw = *(const float4*)(W + o2);
      if (tid < 64) gv = *(const uint2*)(V2 + voff + (size_t)(c + 1) * SC_CH * 512);
    }
    const char* bf = smem + (c & 1) * SC_BUF;
    float ykeep = 0.f;
#pragma unroll
    for (int s = 0; s < SC_CH; ++s) {
      const float4 a4 = *(const float4*)(bf + 0 * SC_ARR + s * 256 + j * 16);
      const float4 w4 = *(const float4*)(bf + 1 * SC_ARR + s * 256 + j * 16);
      const float4 b4 = *(const float4*)(bf + 2 * SC_ARR + s * 256 + j * 16);
      const float4 k4 = *(const float4*)(bf + 3 * SC_ARR + s * 256 + j * 16);
      const float4 r4 = *(const float4*)(bf + 4 * SC_ARR + s * 256 + j * 16);
      const float vv = *(const float*)(bf + 5 * SC_ARR + s * 64 + rowl * 4);
      float sa = (s0 * a4.x + s1 * a4.y) + (s2 * a4.z + s3 * a4.w);
      sa = dpp_sum16(sa);
      s0 = s0 * w4.x + (sa * b4.x + vv * k4.x);
      s1 = s1 * w4.y + (sa * b4.y + vv * k4.y);
      s2 = s2 * w4.z + (sa * b4.z + vv * k4.z);
      s3 = s3 * w4.w + (sa * b4.w + vv * k4.w);
      float y = (s0 * r4.x + s1 * r4.y) + (s2 * r4.z + s3 * r4.w);
      y = dpp_sum16(y);
      ykeep = (j == s) ? y : ykeep;
    }
    YS[(tb + (size_t)c * SC_CH + j) * 512 + h * 64 + rg * 16 + rowl] = ykeep;
    if (c + 1 < NCH) {
      char* bn = smem + ((c + 1) & 1) * SC_BUF;
      *(float4*)(bn + 0 * SC_ARR + ls * 256 + lc * 16) = bf4_to_f4(ga);
      *(float4*)(bn + 1 * SC_ARR + ls * 256 + lc * 16) = gw;
      *(float4*)(bn + 2 * SC_ARR + ls * 256 + lc * 16) = bf4_to_f4(gb);
      *(float4*)(bn + 3 * SC_ARR + ls * 256 + lc * 16) = bf4_to_f4(gk);
      *(float4*)(bn + 4 * SC_ARR + ls * 256 + lc * 16) = bf4_to_f4(gr);
      if (tid < 64) *(float4*)(bn + 5 * SC_ARR + vs * 64 + vq * 16) = bf4_to_f4(gv);
    }
    __syncthreads();
  }
}


#define CONV_TILES (257 * 96)
__device__ __forceinline__ void convert_tile(const Params& p, char* smem, const int ti) {
  const int e = ti / 96, q = ti - e * 96, part = q >> 5, w = q & 31;
  const float* src; int ldn, k0, n0; bf16_t* dst; int kdim;
  if (part < 2) {
    src = (e < NEXP) ? p.in[18 + part] + (size_t)e * DM * 256 : p.in[21 + part];
    ldn = 256; k0 = (w >> 1) * 64; n0 = (w & 1) * 128; kdim = 1024;
    dst = (bf16_t*)(p.ws + OFF_EW1) + (size_t)e * 512 * 1024;
  } else {
    src = (e < NEXP) ? p.in[20] + (size_t)e * 256 * DM : p.in[23];
    ldn = 1024; k0 = (w >> 3) * 64; n0 = (w & 7) * 128; kdim = 256;
    dst = (bf16_t*)(p.ws + OFF_EW2) + (size_t)e * 1024 * 256;
  }
  const int tid = threadIdx.x, nq = tid & 31, ko = tid >> 5;
  const float* bp = src + (size_t)(k0 + ko * 8) * ldn + n0 + nq * 4;
  const float4 rb0 = *(const float4*)(bp), rb1 = *(const float4*)(bp + (size_t)1 * ldn), rb2 = *(const float4*)(bp + (size_t)2 * ldn),
               rb3 = *(const float4*)(bp + (size_t)3 * ldn), rb4 = *(const float4*)(bp + (size_t)4 * ldn), rb5 = *(const float4*)(bp + (size_t)5 * ldn),
               rb6 = *(const float4*)(bp + (size_t)6 * ldn), rb7 = *(const float4*)(bp + (size_t)7 * ldn);
  {
    uint4 v;
    v.x = cvtpk(rb0.x, rb1.x); v.y = cvtpk(rb2.x, rb3.x); v.z = cvtpk(rb4.x, rb5.x); v.w = cvtpk(rb6.x, rb7.x); *(uint4*)(smem + lds_off(nq * 4 + 0, ko)) = v;
    v.x = cvtpk(rb0.y, rb1.y); v.y = cvtpk(rb2.y, rb3.y); v.z = cvtpk(rb4.y, rb5.y); v.w = cvtpk(rb6.y, rb7.y); *(uint4*)(smem + lds_off(nq * 4 + 1, ko)) = v;
    v.x = cvtpk(rb0.z, rb1.z); v.y = cvtpk(rb2.z, rb3.z); v.z = cvtpk(rb4.z, rb5.z); v.w = cvtpk(rb6.z, rb7.z); *(uint4*)(smem + lds_off(nq * 4 + 2, ko)) = v;
    v.x = cvtpk(rb0.w, rb1.w); v.y = cvtpk(rb2.w, rb3.w); v.z = cvtpk(rb4.w, rb5.w); v.w = cvtpk(rb6.w, rb7.w); *(uint4*)(smem + lds_off(nq * 4 + 3, ko)) = v;
  }
  __syncthreads();
#pragma unroll
  for (int u = 0; u < 4; ++u) {
    const int row = (tid >> 3) + 32 * u, chunk = tid & 7;
    const int c = n0 + row;
    int orow;
    if (part < 2) orow = (c >> 6) * 128 + ((c >> 5) & 1) * 64 + (part * 2 + ((c >> 4) & 1)) * 16 + (c & 15);
    else orow = c;
    *(uint4*)(dst + (size_t)orow * kdim + k0 + chunk * 8) = *(const uint4*)(smem + lds_off(row, chunk));
  }
  __syncthreads();
}
__device__ __forceinline__ void phase_convert(const Params& p, char* smem) {
  int* ctl = (int*)(p.ws + OFF_CTL);
  int* slot = (int*)(smem + 32768);
  __syncthreads();
  for (;;) {
    if (threadIdx.x == 0) *slot = atomicAdd(&ctl[CTL_CONVQ], 1);
    __syncthreads();
    const int ti = *slot;
    __syncthreads();
    if (ti >= CONV_TILES) break;
    convert_tile(p, smem, ti);
  }
}

__device__ __forceinline__ int vt_off(int d, int key) { const int swz = ((d >> 2) & 15) ^ ((d & 3) << 3); return d * 512 + (((key >> 2) ^ swz) << 3); }
__device__ __forceinline__ void phase_attn(const Params& p, char* smem) {
  const bf16_t* __restrict__ Q = (const bf16_t*)(p.ws + OFF_Q); const bf16_t* __restrict__ K = (const bf16_t*)(p.ws + OFF_K);
  const bf16_t* __restrict__ V = (const bf16_t*)(p.ws + OFF_V);
  bf16_t* OP = (bf16_t*)(p.ws + OFF_OP); float* LSE = (float*)(p.ws + OFF_LSE);
  char* Ks = smem; char* VT = smem + 32768; float* linv_s = (float*)(smem + 65536);
  const int tid = threadIdx.x, lane = tid & 63, wid = tid >> 6, l31 = lane & 31, hi = lane >> 5;
  for (int item = blockIdx.x; item < 6144; item += gridDim.x) {
    const int pp = item >> 11, rem = item & 2047, bh = rem >> 5, sub = rem & 31;
    const int dsh = pp * 2, nbsh = 5 - dsh;
    const int r = sub >> nbsh, n = sub & ((1 << nbsh) - 1);
    const int b = bh >> 3, h = bh & 7, tb = b * SEQ;
    __syncthreads();
#pragma unroll
    for (int u = 0; u < 8; ++u) {
      const int row = (tid >> 3) + 32 * u, chunk = tid & 7;
      int ik = n * 128 - 128 + row; ik = ik < 0 ? 0 : ik;
      const int tok = tb + (ik << dsh) + r;
      *(uint4*)(Ks + lds_off(row, chunk)) = *(const uint4*)(K + (size_t)tok * 512 + h * 64 + chunk * 8);
    }
#pragma unroll
    for (int ps = 0; ps < 2; ++ps) {
      const int dq = tid & 15, kbase = ps * 128 + (tid >> 4) * 8;
      uint2 v0, v1, v2, v3, v4, v5, v6, v7;
#define LDV(i, dst) { int ik = n * 128 - 128 + kbase + i; ik = ik < 0 ? 0 : ik; const int tok = tb + (ik << dsh) + r; dst = *(const uint2*)(V + (size_t)tok * 512 + h * 64 + dq * 4); }
      LDV(0, v0) LDV(1, v1) LDV(2, v2) LDV(3, v3) LDV(4, v4) LDV(5, v5) LDV(6, v6) LDV(7, v7)
#undef LDV
      {
        uint2 w;
        w.x = (v0.x & 0xffffu) | (v1.x << 16); w.y = (v2.x & 0xffffu) | (v3.x << 16);
        *(uint2*)(VT + vt_off(dq * 4 + 0, kbase)) = w;
        w.x = (v4.x & 0xffffu) | (v5.x << 16); w.y = (v6.x & 0xffffu) | (v7.x << 16);
        *(uint2*)(VT + vt_off(dq * 4 + 0, kbase + 4)) = w;
        w.x = (v0.x >> 16) | (v1.x & 0xffff0000u); w.y = (v2.x >> 16) | (v3.x & 0xffff0000u);
        *(uint2*)(VT + vt_off(dq * 4 + 1, kbase)) = w;
        w.x = (v4.x >> 16) | (v5.x & 0xffff0000u); w.y = (v6.x >> 16) | (v7.x & 0xffff0000u);
        *(uint2*)(VT + vt_off(dq * 4 + 1, kbase + 4)) = w;
        w.x = (v0.y & 0xffffu) | (v1.y << 16); w.y = (v2.y & 0xffffu) | (v3.y << 16);
        *(uint2*)(VT + vt_off(dq * 4 + 2, kbase)) = w;
        w.x = (v4.y & 0xffffu) | (v5.y << 16); w.y = (v6.y & 0xffffu) | (v7.y << 16);
        *(uint2*)(VT + vt_off(dq * 4 + 2, kbase + 4)) = w;
        w.x = (v0.y >> 16) | (v1.y & 0xffff0000u); w.y = (v2.y >> 16) | (v3.y & 0xffff0000u);
        *(uint2*)(VT + vt_off(dq * 4 + 3, kbase)) = w;
        w.x = (v4.y >> 16) | (v5.y & 0xffff0000u); w.y = (v6.y >> 16) | (v7.y & 0xffff0000u);
        *(uint2*)(VT + vt_off(dq * 4 + 3, kbase + 4)) = w;
      }
    }
    __syncthreads();
    const int iq = n * 128 + wid * 32 + l31;
    const int tq = tb + (iq << dsh) + r;
    bf16x8 qf[4];
#pragma unroll
    for (int ks = 0; ks < 4; ++ks) qf[ks] = *(const bf16x8*)(Q + (size_t)tq * 512 + h * 64 + ks * 16 + hi * 8);
    f32x16 st[5];
#pragma unroll
    for (int kb = 0; kb < 5; ++kb) {
      st[kb] = (f32x16){0.f, 0.f, 0.f, 0.f, 0.f, 0.f, 0.f, 0.f, 0.f, 0.f, 0.f, 0.f, 0.f, 0.f, 0.f, 0.f};
#pragma unroll
      for (int ks = 0; ks < 4; ++ks) {
        const bf16x8 kf = *(const bf16x8*)(Ks + lds_off(32 * (wid + kb) + l31, 2 * ks + hi));
        st[kb] = __builtin_amdgcn_mfma_f32_32x32x16_bf16(kf, qf[ks], st[kb], 0, 0, 0);
      }
    }
    float m = -INFINITY;
#pragma unroll
    for (int kb = 0; kb < 5; ++kb)
#pragma unroll
      for (int i = 0; i < 16; ++i) {
        const int kirel = 32 * kb + (i & 3) + 8 * (i >> 2) + 4 * hi;
        const bool valid = (kirel >= l31) && (kirel <= l31 + 128) && (n > 0 || (32 * wid + kirel) >= 128);
        const float s = valid ? st[kb][i] : -INFINITY;
        st[kb][i] = s;
        m = fmaxf(m, s);
      }
    m = fmaxf(m, __shfl_xor(m, 32, 64));
    float l = 0.f;
#pragma unroll
    for (int kb = 0; kb < 5; ++kb)
#pragma unroll
      for (int i = 0; i < 16; ++i) { const float pe = __expf(st[kb][i] - m); st[kb][i] = pe; l += pe; }
    l += __shfl_xor(l, 32, 64);
    f32x16 o0 = (f32x16){0.f, 0.f, 0.f, 0.f, 0.f, 0.f, 0.f, 0.f, 0.f, 0.f, 0.f, 0.f, 0.f, 0.f, 0.f, 0.f};
    f32x16 o1 = o0;
#pragma unroll
    for (int kb = 0; kb < 5; ++kb)
#pragma unroll
      for (int s = 0; s < 2; ++s) {
        union { unsigned u[4]; bf16x8 v; } pa;
        pa.u[0] = cvtpk(st[kb][8 * s + 0], st[kb][8 * s + 1]); pa.u[1] = cvtpk(st[kb][8 * s + 2], st[kb][8 * s + 3]);
        pa.u[2] = cvtpk(st[kb][8 * s + 4], st[kb][8 * s + 5]); pa.u[3] = cvtpk(st[kb][8 * s + 6], st[kb][8 * s + 7]);
        const int key0 = 32 * (wid + kb) + 16 * s + 4 * hi;
        {
          union { uint2 u[2]; bf16x8 v; } vb;
          vb.u[0] = *(const uint2*)(VT + vt_off(l31, key0)); vb.u[1] = *(const uint2*)(VT + vt_off(l31, key0 + 8));
          o0 = __builtin_amdgcn_mfma_f32_32x32x16_bf16(pa.v, vb.v, o0, 0, 0, 0);
        }
        {
          union { uint2 u[2]; bf16x8 v; } vb;
          vb.u[0] = *(const uint2*)(VT + vt_off(32 + l31, key0)); vb.u[1] = *(const uint2*)(VT + vt_off(32 + l31, key0 + 8));
          o1 = __builtin_amdgcn_mfma_f32_32x32x16_bf16(pa.v, vb.v, o1, 0, 0, 0);
        }
      }
    if (hi == 0) {
      linv_s[wid * 32 + l31] = 1.f / l;
      LSE[((size_t)pp * T_TOK + tq) * 8 + h] = m + __logf(l);
    }
#pragma unroll
    for (int i = 0; i < 16; ++i) {
      const int qrel = (i & 3) + 8 * (i >> 2) + 4 * hi;
      const int iq2 = n * 128 + wid * 32 + qrel;
      const int tq2 = tb + (iq2 << dsh) + r;
      const float li = linv_s[wid * 32 + qrel];
      bf16_t* op = OP + ((size_t)pp * T_TOK + tq2) * 512 + h * 64 + l31;
      op[0] = f2bf(o0[i] * li);
      op[32] = f2bf(o1[i] * li);
    }
  }
}

__device__ __forceinline__ void unpack8(const uint4 u, float (&f)[8]) {
  f[0] = __uint_as_float(u.x << 16); f[1] = __uint_as_float(u.x & 0xffff0000u); f[2] = __uint_as_float(u.y << 16); f[3] = __uint_as_float(u.y & 0xffff0000u);
  f[4] = __uint_as_float(u.z << 16); f[5] = __uint_as_float(u.z & 0xffff0000u); f[6] = __uint_as_float(u.w << 16); f[7] = __uint_as_float(u.w & 0xffff0000u);
}
__device__ __forceinline__ float dpp_sum8(float v) {
  v += DPP_F(v, 0xB1); v += DPP_F(v, 0x4E); v += DPP_F(v, 0x141);
  return v;
}
__device__ __forceinline__ void phase_post(const Params& p) {
  const float* __restrict__ YS = (const float*)(p.ws + OFF_YS); const bf16_t* __restrict__ V2 = (const bf16_t*)(p.ws + OFF_V2);
  const bf16_t* __restrict__ G = (const bf16_t*)(p.ws + OFF_G); const float* __restrict__ SB = (const float*)(p.ws + OFF_SB);
  const bf16_t* __restrict__ OP = (const bf16_t*)(p.ws + OFF_OP); const float* __restrict__ LSE = (const float*)(p.ws + OFF_LSE);
  const float* __restrict__ lnx_g = p.in[11]; const float* __restrict__ lnx_b = p.in[12];
  bf16_t* MIXED = (bf16_t*)(p.ws + OFF_MIXED);
  const int lane = threadIdx.x & 63, wid = threadIdx.x >> 6;
  const int c = lane * 8, hh = lane >> 3;
  const float4 g0 = *(const float4*)(lnx_g + c), g1 = *(const float4*)(lnx_g + c + 4), b0 = *(const float4*)(lnx_b + c), b1 = *(const float4*)(lnx_b + c + 4);
  const float gg[8] = {g0.x, g0.y, g0.z, g0.w, g1.x, g1.y, g1.z, g1.w}, bb[8] = {b0.x, b0.y, b0.z, b0.w, b1.x, b1.y, b1.z, b1.w};
  for (int t = blockIdx.x * 4 + wid; t < T_TOK; t += gridDim.x * 4) {
    const size_t o = (size_t)t * 512 + c;
    const float4 y0 = *(const float4*)(YS + o), y1 = *(const float4*)(YS + o + 4);
    const float y[8] = {y0.x, y0.y, y0.z, y0.w, y1.x, y1.y, y1.z, y1.w};
    float s = 0.f;
#pragma unroll
    for (int i = 0; i < 8; ++i) s += y[i];
    const float mean = dpp_sum8(s) * (1.f / 64.f);
    float q = 0.f;
#pragma unroll
    for (int i = 0; i < 8; ++i) { const float d = y[i] - mean; q += d * d; }
    const float rs = rsqrtf(dpp_sum8(q) * (1.f / 64.f) + GN_EPS_F);
    float v2[8], gt[8];
    unpack8(*(const uint4*)(V2 + o), v2); unpack8(*(const uint4*)(G + o), gt);
    const float sb = SB[(size_t)t * 8 + hh];
    float res[8];
#pragma unroll
    for (int i = 0; i < 8; ++i) res[i] = ((y[i] - mean) * rs * gg[i] + bb[i] + sb * v2[i]) * gt[i];
    uint4 w; w.x = cvtpk(res[0], res[1]); w.y = cvtpk(res[2], res[3]); w.z = cvtpk(res[4], res[5]); w.w = cvtpk(res[6], res[7]);
    *(uint4*)(MIXED + (size_t)t * 1024 + 512 + c) = w;
    const float l0 = LSE[((size_t)0 * T_TOK + t) * 8 + hh], l1 = LSE[((size_t)1 * T_TOK + t) * 8 + hh], l2 = LSE[((size_t)2 * T_TOK + t) * 8 + hh];
    const float mx = fmaxf(l0, fmaxf(l1, l2));
    float e0 = __expf(l0 - mx), e1 = __expf(l1 - mx), e2 = __expf(l2 - mx);
    const float inv = 1.f / (e0 + e1 + e2);
    e0 *= inv; e1 *= inv; e2 *= inv;
    float o0[8], o1[8], o2[8];
    unpack8(*(const uint4*)(OP + (size_t)0 * T_TOK * 512 + o), o0); unpack8(*(const uint4*)(OP + (size_t)1 * T_TOK * 512 + o), o1);
    unpack8(*(const uint4*)(OP + (size_t)2 * T_TOK * 512 + o), o2);
    float av[8];
#pragma unroll
    for (int i = 0; i < 8; ++i) av[i] = e0 * o0[i] + e1 * o1[i] + e2 * o2[i];
    w.x = cvtpk(av[0], av[1]); w.y = cvtpk(av[2], av[3]); w.z = cvtpk(av[4], av[5]); w.w = cvtpk(av[6], av[7]);
    *(uint4*)(MIXED + (size_t)t * 1024 + c) = w;
  }
}

__device__ __forceinline__ void phase_outproj(const Params& p, char* smem) {
  const bf16_t* __restrict__ MIXED = (const bf16_t*)(p.ws + OFF_MIXED);
  const bf16_t* __restrict__ WOUTT = (const bf16_t*)(p.ws + OFF_WOUTT); const float* __restrict__ x = p.in[0];
  float* U = p.out;
  for (int i = XCD_LB; i < T_TOK / 128; i += XCD_NB) {
    const int row0 = i * 128, col0 = XCD_GROUP * 128;
    gemm128_glds(smem, DM,
            [=](int r) { return MIXED + (size_t)(row0 + r) * DM; },
            [=](int r) { return WOUTT + (size_t)(col0 + r) * DM; },
            [=](f32x4 (&acc)[4][4], int wr, int wc, int fr, int fq) {
#pragma unroll
              for (int m = 0; m < 4; ++m) {
                const int t = row0 + wr * 64 + m * 16 + fr;
#pragma unroll
                for (int n = 0; n < 4; ++n) {
                  const size_t o = (size_t)t * DM + col0 + wc * 64 + n * 16 + fq * 4;
                  const float4 xv = *(const float4*)(x + o);
                  *(float4*)(U + o) = make_float4(ALPHA_F * xv.x + acc[m][n][0], ALPHA_F * xv.y + acc[m][n][1], ALPHA_F * xv.z + acc[m][n][2], ALPHA_F * xv.w + acc[m][n][3]);
                }
              }
            });
  }
}

__device__ __forceinline__ void phase_ln1(const Params& p) {
  float* X1 = p.out;
  const float* __restrict__ g1 = p.in[14]; const float* __restrict__ b1 = p.in[15];
  bf16_t* X1B = (bf16_t*)(p.ws + OFF_X1B); bf16_t* XL = (bf16_t*)(p.ws + OFF_XL);
  const int lane = threadIdx.x & 63, wid = threadIdx.x >> 6;
  for (int t = blockIdx.x * 4 + wid; t < T_TOK; t += gridDim.x * 4) {
    const size_t base = (size_t)t * DM;
    float4 v[4];
    float s = 0.f;
#pragma unroll
    for (int u = 0; u < 4; ++u) { v[u] = *(const float4*)(X1 + base + u * 256 + lane * 4); s += (v[u].x + v[u].y) + (v[u].z + v[u].w); }
    const float mean = wave_sum_fast(s) * (1.f / DM);
    float q = 0.f;
#pragma unroll
    for (int u = 0; u < 4; ++u) {
      const float d0 = v[u].x - mean, d1 = v[u].y - mean, d2 = v[u].z - mean, d3 = v[u].w - mean;
      q += (d0 * d0 + d1 * d1) + (d2 * d2 + d3 * d3);
    }
    const float rs = rsqrtf(wave_sum_fast(q) * (1.f / DM) + LN_EPS_F);
#pragma unroll
    for (int u = 0; u < 4; ++u) {
      const int c = u * 256 + lane * 4;
      const float4 g = *(const float4*)(g1 + c), bb = *(const float4*)(b1 + c);
      float4 y;
      y.x = (v[u].x - mean) * rs * g.x + bb.x; y.y = (v[u].y - mean) * rs * g.y + bb.y;
      y.z = (v[u].z - mean) * rs * g.z + bb.z; y.w = (v[u].w - mean) * rs * g.w + bb.w;
      *(float4*)(X1 + base + c) = y;
      uint2 hi; hi.x = cvtpk(y.x, y.y); hi.y = cvtpk(y.z, y.w);
      *(uint2*)(X1B + base + c) = hi;
      uint2 lo;
      lo.x = cvtpk(y.x - __uint_as_float(hi.x << 16), y.y - __uint_as_float(hi.x & 0xffff0000u));
      lo.y = cvtpk(y.z - __uint_as_float(hi.y << 16), y.w - __uint_as_float(hi.y & 0xffff0000u));
      *(uint2*)(XL + base + c) = lo;
    }
  }
}

__device__ __forceinline__ void phase_router_gemm(const Params& p, char* smem) {
  const bf16_t* __restrict__ X1B = (const bf16_t*)(p.ws + OFF_X1B); const bf16_t* __restrict__ XL = (const bf16_t*)(p.ws + OFF_XL);
  const float* __restrict__ router_w = p.in[16];
  float* AFF = (float*)(p.ws + OFF_AFF);
  for (int item = blockIdx.x; item < (T_TOK / 128) * 2; item += gridDim.x) {
    const int row0 = (item >> 1) * 128, col0 = (item & 1) * 128;
    f32x4 acc[4][4];
    acc_zero(acc);
    gemm128_acc<2, false>(acc, smem, 48,
        [=](int, int rowl, int kc) { const bf16_t* base = ((kc >> 7) == 1) ? XL : X1B; return *(const uint4*)(base + (size_t)(row0 + rowl) * DM + (kc & 127) * 8); },
        [=](int nq) { return router_w + col0 + nq * 4; }, NEXP, 0);
    const int tid = threadIdx.x, lane = tid & 63, wid = tid >> 6;
    const int wr = wid >> 1, wc = wid & 1, fr = lane & 15, fq = lane >> 4;
#pragma unroll
    for (int m = 0; m < 4; ++m) {
      const int t = row0 + wr * 64 + m * 16 + fr;
#pragma unroll
      for (int n = 0; n < 4; ++n)
        *(float4*)(AFF + (size_t)t * NEXP + col0 + wc * 64 + n * 16 + fq * 4) =
            make_float4(sigmoidf_(acc[m][n][0]), sigmoidf_(acc[m][n][1]), sigmoidf_(acc[m][n][2]), sigmoidf_(acc[m][n][3]));
    }
  }
}

__device__ __forceinline__ void phase_topk(const Params& p) {
  const float* __restrict__ AFF = (const float*)(p.ws + OFF_AFF);
  const float* __restrict__ router_bias = p.in[17];
  int* LIST = (int*)(p.ws + OFF_LIST); float* GATEW = (float*)(p.ws + OFF_GATEW);
  int* counts = (int*)(p.ws + OFF_CTL);
  const int lane = threadIdx.x & 63, wid = threadIdx.x >> 6;
  const float4 b4 = *(const float4*)(router_bias + lane * 4);
  for (int t = blockIdx.x * 4 + wid; t < T_TOK; t += gridDim.x * 4) {
    const float4 a4 = *(const float4*)(AFF + (size_t)t * NEXP + lane * 4);
    float s0 = a4.x + b4.x, s1 = a4.y + b4.y, s2 = a4.z + b4.z, s3 = a4.w + b4.w;
    const float hi01 = fmaxf(s0, s1), lo01 = fminf(s0, s1), hi23 = fmaxf(s2, s3), lo23 = fminf(s2, s3);
    float m1 = fmaxf(hi01, hi23), m2 = fmaxf(fminf(hi01, hi23), fmaxf(lo01, lo23));
    { const float o1 = DPP_F(m1, 0xB1), o2 = DPP_F(m2, 0xB1); const float n1 = fmaxf(m1, o1); m2 = fmaxf(fminf(m1, o1), fmaxf(m2, o2)); m1 = n1; }
    { const float o1 = DPP_F(m1, 0x4E), o2 = DPP_F(m2, 0x4E); const float n1 = fmaxf(m1, o1); m2 = fmaxf(fminf(m1, o1), fmaxf(m2, o2)); m1 = n1; }
    { const float o1 = DPP_F(m1, 0x141), o2 = DPP_F(m2, 0x141); const float n1 = fmaxf(m1, o1); m2 = fmaxf(fminf(m1, o1), fmaxf(m2, o2)); m1 = n1; }
    const float gs = m1 + m2;
    const int g = lane >> 3;
    int rank = 0;
#pragma unroll
    for (int gg = 0; gg < 8; ++gg) { const float G = rdlane_f(gs, gg * 8); rank += ((G > gs) || (G == gs && gg < g)) ? 1 : 0; }
    if (rank >= 4) { s0 = -INFINITY; s1 = -INFINITY; s2 = -INFINITY; s3 = -INFINITY; }
    int my_e = 0; float my_a = 0.f;
#pragma unroll 1
    for (int it = 0; it < 8; ++it) {
      const float lm = fmaxf(fmaxf(s0, s1), fmaxf(s2, s3));
      const float wm = wave_max_fast(lm);
      const unsigned long long bal = __ballot(lm == wm);
      const int win = __ffsll((long long)bal) - 1;
      const int wi = (s0 == wm) ? 0 : ((s1 == wm) ? 1 : ((s2 == wm) ? 2 : 3));
      const float wa = (wi == 0) ? a4.x : ((wi == 1) ? a4.y : ((wi == 2) ? a4.z : a4.w));
      const int e_w = __builtin_amdgcn_readlane(lane * 4 + wi, win);
      const float a_w = rdlane_f(wa, win);
      if (lane == win) { if (wi == 0) s0 = -INFINITY; else if (wi == 1) s1 = -INFINITY; else if (wi == 2) s2 = -INFINITY; else s3 = -INFINITY; }
      if (lane == it) { my_e = e_w; my_a = a_w; }
    }
    const float asum = rdlane_f(dpp_sum16x(my_a), 0);
    if (lane < 8) {
      const int pos = atomicAdd(&counts[my_e], 1);
      if (pos < LCAP) LIST[(size_t)my_e * LCAP + pos] = lane * T_TOK + t;
      GATEW[(size_t)lane * T_TOK + t] = my_a * 2.5f / asum;
    }
  }
}

__device__ __forceinline__ int moe_group_setup(const int* counts, int* pre) {
  __syncthreads();
  if (threadIdx.x == 0) {
    const int g = XCD_GROUP;
    int acc = 0;
    for (int j = 0; j < 32; ++j) { pre[j] = acc; acc += (min(counts[g + 8 * j], LCAP) + 127) >> 7; }
    pre[32] = acc; acc += 32;
    pre[33] = acc;
  }
  __syncthreads();
  return pre[33];
}
__device__ __forceinline__ void phase_moe(const Params& p, char* smem) {
  int* asg = (int*)(smem + 65536); int* pre = asg + 128;
  const bf16_t* __restrict__ X1B = (const bf16_t*)(p.ws + OFF_X1B);
  const bf16_t* __restrict__ EW1 = (const bf16_t*)(p.ws + OFF_EW1); const bf16_t* __restrict__ EW2 = (const bf16_t*)(p.ws + OFF_EW2);
  const int* __restrict__ LIST = (const int*)(p.ws + OFF_LIST);
  const float* __restrict__ GATEW = (const float*)(p.ws + OFF_GATEW);
  const int* counts = (const int*)(p.ws + OFF_CTL);
  bf16_t* Y = (bf16_t*)(p.ws + OFF_Y);
  bf16_t* HS = (bf16_t*)(p.ws + OFF_HSCR) + (size_t)blockIdx.x * 128 * 256;
  float* X1 = p.out;
  const int nitems = moe_group_setup(counts, pre);
  for (int i = XCD_LB; i < nitems; i += XCD_NB) {
    int j = 0;
#pragma unroll 1
    for (int q = 1; q <= 32; ++q) j = (pre[q] <= i) ? q : j;
    const int w = i - pre[j];
    const int e = (j < 32) ? (XCD_GROUP + 8 * j) : NEXP;
    const int cnt = (j < 32) ? min(counts[e], LCAP) : T_TOK;
    const int r0 = (j < 32) ? w * 128 : (XCD_GROUP * 32 + w) * 128;
    __syncthreads();
    if (threadIdx.x < 128) {
      const int r = r0 + threadIdx.x;
      asg[threadIdx.x] = (r < cnt) ? ((e < NEXP) ? LIST[(size_t)e * LCAP + r] : (8 * T_TOK + r)) : -1;
    }
    __syncthreads();
    const bf16_t* __restrict__ W1 = EW1 + (size_t)e * 512 * 1024;
    const bf16_t* __restrict__ W2 = EW2 + (size_t)e * 1024 * 256;
#pragma unroll 1
    for (int nt = 0; nt < 4; ++nt) {
      gemm128_glds(smem, DM,
              [=](int r) { int a = asg[r]; return X1B + (size_t)((a >= 0 ? a : 0) & (T_TOK - 1)) * DM; },
              [=](int r) { return W1 + (size_t)(nt * 128 + r) * DM; },
              [=](f32x4 (&acc)[4][4], int wr, int wc, int fr, int fq) {
#pragma unroll
                for (int m = 0; m < 4; ++m) {
                  const int row = wr * 64 + m * 16 + fr;
#pragma unroll
                  for (int n = 0; n < 2; ++n) {
                    float hv[4];
#pragma unroll
                    for (int jj = 0; jj < 4; ++jj) { const float g = acc[m][n][jj], u = acc[m][n + 2][jj]; hv[jj] = g * sigmoidf_(g) * u; }
                    *(uint2*)(HS + (size_t)row * 256 + nt * 64 + wc * 32 + n * 16 + fq * 4) = pack4(hv[0], hv[1], hv[2], hv[3]);
                  }
                }
              });
    }
    __syncthreads();
#pragma unroll 1
    for (int nt = 0; nt < 8; ++nt) {
      gemm128_glds(smem, 256,
              [=](int r) { return HS + (size_t)r * 256; },
              [=](int r) { return W2 + (size_t)(nt * 128 + r) * 256; },
              [=](f32x4 (&acc)[4][4], int wr, int wc, int fr, int fq) {
#pragma unroll
                for (int m = 0; m < 4; ++m) {
                  const int a = asg[wr * 64 + m * 16 + fr];
                  if (a < 0) continue;
                  if (a < 8 * T_TOK) {
                    const float gw = GATEW[a];
#pragma unroll
                    for (int n = 0; n < 4; ++n)
                      *(uint2*)(Y + (size_t)a * DM + nt * 128 + wc * 64 + n * 16 + fq * 4) =
                          pack4(acc[m][n][0] * gw, acc[m][n][1] * gw, acc[m][n][2] * gw, acc[m][n][3] * gw);
                  } else {
                    const int t = a - 8 * T_TOK;
#pragma unroll
                    for (int n = 0; n < 4; ++n) {
                      float* xp = X1 + (size_t)t * DM + nt * 128 + wc * 64 + n * 16 + fq * 4;
                      const float4 xv = *(const float4*)xp;
                      *(float4*)xp = make_float4(ALPHA_F * xv.x + acc[m][n][0], ALPHA_F * xv.y + acc[m][n][1], ALPHA_F * xv.z + acc[m][n][2], ALPHA_F * xv.w + acc[m][n][3]);
                    }
                  }
                }
              });
    }
  }
}

__device__ __forceinline__ void phase_final(const Params& p, char* smem) {
  float* OUT = p.out;
  const bf16_t* __restrict__ Y = (const bf16_t*)(p.ws + OFF_Y);
  const float* __restrict__ g2 = p.in[24]; const float* __restrict__ b2 = p.in[25];
  const int lane = threadIdx.x & 63, wid = threadIdx.x >> 6;
  for (int t = blockIdx.x * 4 + wid; t < T_TOK; t += gridDim.x * 4) {
    const size_t base = (size_t)t * DM;
    float4 v[4];
    float s = 0.f;
#pragma unroll
    for (int u = 0; u < 4; ++u) {
      const int c = u * 256 + lane * 4;
      const float4 xv = *(const float4*)(OUT + base + c);
      float a0 = 0.f, a1 = 0.f, a2 = 0.f, a3 = 0.f;
#pragma unroll
      for (int sl = 0; sl < 8; ++sl) {
        const float4 yv = bf4_to_f4(*(const uint2*)(Y + ((size_t)sl * T_TOK + t) * DM + c));
        a0 += yv.x; a1 += yv.y; a2 += yv.z; a3 += yv.w;
      }
      v[u] = make_float4(xv.x + a0, xv.y + a1, xv.z + a2, xv.w + a3);
      s += (v[u].x + v[u].y) + (v[u].z + v[u].w);
    }
    const float mean = wave_sum_fast(s) * (1.f / DM);
    float q = 0.f;
#pragma unroll
    for (int u = 0; u < 4; ++u) {
      const float d0 = v[u].x - mean, d1 = v[u].y - mean, d2 = v[u].z - mean, d3 = v[u].w - mean;
      q += (d0 * d0 + d1 * d1) + (d2 * d2 + d3 * d3);
    }
    const float rs = rsqrtf(wave_sum_fast(q) * (1.f / DM) + LN_EPS_F);
#pragma unroll
    for (int u = 0; u < 4; ++u) {
      const int c = u * 256 + lane * 4;
      const float4 g = *(const float4*)(g2 + c), bb = *(const float4*)(b2 + c);
      *(float4*)(OUT + base + c) = make_float4((v[u].x - mean) * rs * g.x + bb.x, (v[u].y - mean) * rs * g.y + bb.y,
                                               (v[u].z - mean) * rs * g.z + bb.z, (v[u].w - mean) * rs * g.w + bb.w);
    }
  }
}

#define LAS __attribute__((address_space(3)))
#define XB_TMO      128
#define XB_XCNT(j)  (256  + 64 * (j))
#define XB_XSUB(j)  (1280 + 64 * (j))
#define XB_XGEN(j)  (2304 + 64 * (j))
#define XB_TOP      3328
#define XB_TOPGEN   3392
#define XCD_BAR_WORDS 3456
#define XB_SPIN_CAP (1u << 22)
__device__ __forceinline__ unsigned xb_ld(unsigned* p)              { return __hip_atomic_load(p, __ATOMIC_RELAXED, __HIP_MEMORY_SCOPE_AGENT); }
__device__ __forceinline__ unsigned xb_add(unsigned* p, unsigned v) { return __hip_atomic_fetch_add(p, v, __ATOMIC_RELAXED, __HIP_MEMORY_SCOPE_AGENT); }
__device__ __forceinline__ unsigned xb_xcc_id() { return (unsigned)__builtin_amdgcn_s_getreg((3 << 11) | 20) & 0xFu; }
#define XB_SPIN(cond, bar) do { unsigned _sp = 0; while (cond) { __builtin_amdgcn_s_sleep(1); \
    if ((++_sp & 255u) == 0u) { if (xb_ld(&(bar)[XB_TMO])) break; if (_sp > XB_SPIN_CAP) { atomicAdd(&(bar)[XB_TMO], 1u); break; } } } } while (0)
struct XcdBarrier { unsigned* bar; unsigned x; volatile LAS unsigned* st; };
__device__ __forceinline__ XcdBarrier xcd_barrier_post(unsigned* bar, volatile LAS unsigned* st) {
  XcdBarrier b; b.bar = bar; b.x = xb_xcc_id(); b.st = st;
  if (threadIdx.x == 0) (void)xb_add(&bar[XB_XCNT(b.x)], 1u);
  return b;
}
__device__ __forceinline__ void xcd_barrier_complete(unsigned* bar, unsigned x, unsigned& nloc, unsigned& nx) {
  const unsigned G = gridDim.x * gridDim.y * gridDim.z;
  unsigned sum, cnt, mine, sp = 0u;
  for (;;) {
    sum = 0u; cnt = 0u; mine = 0u;
#pragma unroll
    for (unsigned j = 0; j < 16; ++j) { const unsigned c = xb_ld(&bar[XB_XCNT(j)]); sum += c; cnt += (c > 0u) ? 1u : 0u; mine = (j == x) ? c : mine; }
    if (sum == G) break;
    __builtin_amdgcn_s_sleep(1);
    if ((++sp & 255u) == 0u) { if (xb_ld(&bar[XB_TMO])) break; if (sp > XB_SPIN_CAP) { atomicAdd(&bar[XB_TMO], 1u); break; } }
  }
  nloc = mine > 0u ? mine : 1u; nx = cnt > 0u ? cnt : 1u;
}
__device__ __forceinline__ void xcd_barrier(const XcdBarrier& b) {
  asm volatile("s_waitcnt vmcnt(0)" ::: "memory");
  __syncthreads();
  if (threadIdx.x == 0) {
    unsigned* bar = b.bar;
    __builtin_amdgcn_s_waitcnt(0);
    unsigned nloc = b.st[0], nx = b.st[1];
    if (nloc == 0u) { xcd_barrier_complete(bar, b.x, nloc, nx); b.st[0] = nloc; b.st[1] = nx; }
    const unsigned old = xb_add(&bar[XB_XSUB(b.x)], 1u);
    const unsigned gen = old / nloc;
    if (old + 1u == (gen + 1u) * nloc) {
      __builtin_amdgcn_fence(__ATOMIC_RELEASE, "agent");
      asm volatile("s_waitcnt vmcnt(0)" ::: "memory");
      const unsigned og = xb_add(&bar[XB_TOP], 1u);
      const unsigned tg = og / nx;
      if (og + 1u == (tg + 1u) * nx) xb_add(&bar[XB_TOPGEN], 1u);
      else XB_SPIN(xb_ld(&bar[XB_TOPGEN]) == tg, bar);
      __builtin_amdgcn_fence(__ATOMIC_ACQUIRE, "agent");
      xb_add(&bar[XB_XGEN(b.x)], 1u);
      asm volatile("s_waitcnt vmcnt(0)" ::: "memory");
    } else {
      XB_SPIN(xb_ld(&bar[XB_XGEN(b.x)]) == gen, bar);
      __builtin_amdgcn_fence(__ATOMIC_ACQUIRE, "agent");
      asm volatile("s_waitcnt vmcnt(0)" ::: "memory");
    }
  }
  __syncthreads();
}
#define CTL_BAR_WORD 4096
#define CTL_ZERO_BYTES 32768
#define LDS_BAR_OFF 66432

__global__ void __launch_bounds__(NTHR, 2) mega(Params p) {
  extern __shared__ __attribute__((aligned(16))) char smem[];
  cg::grid_group grid = cg::this_grid();
  volatile LAS unsigned* bst = (volatile LAS unsigned*)(LAS char*)(smem + LDS_BAR_OFF);
  if (threadIdx.x < 2) bst[threadIdx.x] = 0u;
  __syncthreads();
  const XcdBarrier bar = xcd_barrier_post((unsigned*)(p.ws + OFF_CTL) + CTL_BAR_WORD, bst);
  phase_rope(p);
  grid.sync();
  phase_inproj(p, smem);
  xcd_barrier(bar);
  phase_prep_a(p);
  xcd_barrier(bar);
  phase_prep(p, smem);
  xcd_barrier(bar);
  phase_scan(p, smem);
  phase_attn(p, smem);
  phase_convert(p, smem);
  xcd_barrier(bar);
  phase_post(p);
  xcd_barrier(bar);
  phase_outproj(p, smem);
  xcd_barrier(bar);
  phase_ln1(p);
  xcd_barrier(bar);
  phase_router_gemm(p, smem);
  xcd_barrier(bar);
  phase_topk(p);
  xcd_barrier(bar);
  phase_moe(p, smem);
  xcd_barrier(bar);
  phase_final(p, smem);
}

extern "C" void kernel_launch(void* const* d_in, const int* in_sizes, int n_in, void* d_out, int out_size, void* d_ws, size_t ws_size,
                              hipStream_t stream) {
  static int grid_blocks = 0;
  if (grid_blocks == 0) {
    if (ws_size < WS_NEED || n_in != 26) { fprintf(stderr, "kernel_launch: bad ws/n_in: %zu < %zu, n_in %d\n", ws_size, (size_t)WS_NEED, n_in); grid_blocks = -1; return; }
    int dev = 0, cus = 0, per_cu = 0;
    (void)hipGetDevice(&dev);
    (void)hipDeviceGetAttribute(&cus, hipDeviceAttributeMultiprocessorCount, dev);
    (void)hipFuncSetAttribute((const void*)mega, hipFuncAttributeMaxDynamicSharedMemorySize, LDS_BYTES);
    (void)hipOccupancyMaxActiveBlocksPerMultiprocessor(&per_cu, (const void*)mega, NTHR, LDS_BYTES);
    if (per_cu < 1) { fprintf(stderr, "kernel_launch: occupancy query returned %d\n", per_cu); grid_blocks = -1; return; }
    if (per_cu > 2) per_cu = 2;
    grid_blocks = cus * per_cu;
    if (grid_blocks > 512) grid_blocks = 512;
    fprintf(stderr, "kernel_launch: cus %d per_cu %d grid %d\n", cus, per_cu, grid_blocks);
  }
  if (grid_blocks < 0) return;
  if (hipMemsetAsync((char*)d_ws + OFF_CTL, 0, CTL_ZERO_BYTES, stream) != hipSuccess) { fprintf(stderr, "kernel_launch: memset failed\n"); return; }
  Params p{};
  for (int i = 0; i < 26; ++i) p.in[i] = (const float*)d_in[i];
  p.out = (float*)d_out;
  p.ws = (char*)d_ws;
  void* args[] = {&p};
  hipError_t e = hipLaunchCooperativeKernel((const void*)mega, dim3(grid_blocks), dim3(NTHR), args, LDS_BYTES, stream);
  if (e != hipSuccess) fprintf(stderr, "cooperative launch failed: %s (grid %d)\n", hipGetErrorString(e), grid_blocks);
}
```

```cpp
#include <hip/hip_runtime.h>
#include <hip/hip_bf16.h>
#include <hip/hip_cooperative_groups.h>
#include <stdint.h>
#include <stdio.h>

typedef unsigned short bf16_t;

#define T_TOK 32768
#define SEQ 4096
#define DM 1024
#define INW 3360
#define FEW 1824
#define NEXP 256
#define ALPHA_F 1.189207115002721f
#define LN_EPS_F 1e-5f
#define GN_EPS_F 64e-5f

__device__ __forceinline__ float bf2f(bf16_t v) { return __uint_as_float(((unsigned)v) << 16); }
__device__ __forceinline__ bf16_t f2bf(float f) { unsigned u = __float_as_uint(f); return (bf16_t)((u + 0x7fffu + ((u >> 16) & 1u)) >> 16); }
__device__ __forceinline__ float sigmoidf_(float x) { return 1.f / (1.f + __expf(-x)); }
__device__ __forceinline__ float wave_sum(float v) {
#pragma unroll
  for (int o = 32; o >= 1; o >>= 1) v += __shfl_xor(v, o, 64);
  return v;
}

constexpr size_t SZ_T512_BF = (size_t)T_TOK * 512 * 2;
constexpr size_t OFF_EW1 = 0;
constexpr size_t OFF_EW2 = OFF_EW1 + (size_t)257 * 512 * 1024 * 2;
constexpr size_t LBASE = OFF_EW2 + (size_t)257 * 1024 * 256 * 2;
constexpr size_t OFF_XB = 0;
constexpr size_t OFF_FEATS = OFF_XB + (size_t)T_TOK * 1024 * 2;
constexpr size_t OFF_ACT = OFF_FEATS + (size_t)T_TOK * FEW * 2;
constexpr size_t OFF_WINT = OFF_ACT + (size_t)T_TOK * 320 * 2;
constexpr size_t OFF_ROPE = OFF_WINT + (size_t)3456 * 1024 * 2;
static_assert(OFF_ROPE + (size_t)4096 * 32 * 2 * 4 <= LBASE, "early region E overlay");
constexpr size_t OFF_Q = LBASE;
constexpr size_t OFF_K = OFF_Q + SZ_T512_BF;
constexpr size_t OFF_V = OFF_K + SZ_T512_BF;
constexpr size_t OFF_R = OFF_V + SZ_T512_BF;
constexpr size_t OFF_K2 = OFF_R + SZ_T512_BF;
constexpr size_t OFF_V2 = OFF_K2 + SZ_T512_BF;
constexpr size_t OFF_A = OFF_V2 + SZ_T512_BF;
constexpr size_t OFF_B = OFF_A + SZ_T512_BF;
constexpr size_t OFF_W = OFF_B + SZ_T512_BF;
constexpr size_t OFF_G = OFF_W + (size_t)T_TOK * 512 * 4;
constexpr size_t OFF_SB = OFF_G + SZ_T512_BF;
constexpr size_t OFF_YS = OFF_SB + (size_t)T_TOK * 8 * 4;
constexpr size_t OFF_OP = OFF_YS + (size_t)T_TOK * 512 * 4;
constexpr size_t OFF_LSE = OFF_OP + 3 * SZ_T512_BF;
constexpr size_t OFF_MIXED = OFF_LSE + (size_t)3 * T_TOK * 8 * 4;
constexpr size_t OFF_WOUTT = OFF_MIXED + (size_t)T_TOK * 1024 * 2;
constexpr size_t EARLY_END = OFF_WOUTT + (size_t)1024 * 1024 * 2;
constexpr size_t OFF_Y = LBASE;
constexpr size_t OFF_XL = LBASE;
constexpr size_t OFF_AFF = LBASE + (size_t)T_TOK * 1024 * 2;
constexpr size_t OFF_X1B = OFF_Y + (size_t)8 * T_TOK * 1024 * 2;
#define LCAP 16384
constexpr size_t OFF_LIST = OFF_X1B + (size_t)T_TOK * 1024 * 2;
constexpr size_t OFF_GATEW = OFF_LIST + (size_t)NEXP * LCAP * 4;
constexpr size_t OFF_HSCR = OFF_GATEW + (size_t)8 * T_TOK * 4;
constexpr size_t OFF_CTL = OFF_HSCR + (size_t)512 * 128 * 256 * 2;
constexpr size_t CTL_BYTES = 1u << 20;
constexpr size_t WS_NEED = OFF_CTL + CTL_BYTES;
static_assert(EARLY_END <= OFF_HSCR, "early buffers must stay below the per-block scratch / control words");
static_assert(WS_NEED <= (size_t)1073741824, "workspace must fit 1 GiB");
#define CTL_CONVQ 512

typedef short bf16x8 __attribute__((ext_vector_type(8)));
typedef float f32x4 __attribute__((ext_vector_type(4)));
typedef float f32x16 __attribute__((ext_vector_type(16)));
typedef float f32x2_t __attribute__((ext_vector_type(2)));
typedef __bf16 bf16x2_t __attribute__((ext_vector_type(2)));
__device__ __forceinline__ unsigned cvtpk(float lo, float hi) { f32x2_t v = {lo, hi}; bf16x2_t b = __builtin_convertvector(v, bf16x2_t); return __builtin_bit_cast(unsigned, b); }

__device__ const double INVF[32] = {
1, 0.74989420933245587, 0.56234132519034907, 0.42169650342858223, 0.31622776601683794, 0.23713737056616552,
0.17782794100389229, 0.1333521432163324, 0.10000000000000001, 0.074989420933245579, 0.056234132519034911,
0.042169650342858224, 0.031622776601683791, 0.023713737056616554, 0.017782794100389229, 0.013335214321633241,
0.01, 0.0074989420933245579, 0.005623413251903491, 0.0042169650342858229, 0.0031622776601683794,
0.0023713737056616554, 0.0017782794100389228, 0.0013335214321633241, 0.001, 0.00074989420933245586,
0.0005623413251903491, 0.00042169650342858224, 0.00031622776601683794, 0.00023713737056616554,
0.00017782794100389227, 0.0001333521432163324};

namespace cg = cooperative_groups;

struct Params {
  const float* in[26];
  float* out;
  char* ws;
};

#define NTHR 256
#define LDS_BYTES 66560

__device__ __forceinline__ void phase_rope(const Params& p) {
  float* tab = (float*)(p.ws + OFF_ROPE);
  for (int i = blockIdx.x * NTHR + threadIdx.x; i < 4096 * 32; i += gridDim.x * NTHR) {
    int pos = i >> 5, f = i & 31;
    double ang = (double)pos * INVF[f];
    const double TWO_PI = 6.283185307179586476925286766559;
    double n = rint(ang / TWO_PI);
    double r = ang - n * TWO_PI;
    double r2 = r * r;
    double sn = r, cs = 1.0, ts = r, tc = 1.0;
#pragma unroll 1
    for (int k = 1; k <= 16; ++k) {
      tc = -tc * r2 / (double)((2 * k - 1) * (2 * k));
      ts = -ts * r2 / (double)((2 * k) * (2 * k + 1));
      cs += tc; sn += ts;
    }
    tab[i * 2] = (float)cs; tab[i * 2 + 1] = (float)sn;
  }
  {
    const float* __restrict__ w_in = p.in[1]; const float* __restrict__ w_out = p.in[13];
    uint4* wint = (uint4*)(p.ws + OFF_WINT); uint4* woutt = (uint4*)(p.ws + OFF_WOUTT);
    const int NJ1 = 3456 * 128, NJ2 = 1024 * 128;
    for (int i = blockIdx.x * NTHR + threadIdx.x; i < NJ1 + NJ2; i += gridDim.x * NTHR) {
      const bool second = i >= NJ1;
      const int q = second ? i - NJ1 : i;
      const int N = second ? 1024 : 3456, NV = second ? 1024 : INW;
      const int n = q % N, ko = q / N;
      const float* __restrict__ src = second ? w_out : w_in;
      float f[8];
#pragma unroll
      for (int u = 0; u < 8; ++u) f[u] = (n < NV) ? src[(size_t)(ko * 8 + u) * NV + n] : 0.f;
      uint4 w; w.x = cvtpk(f[0], f[1]); w.y = cvtpk(f[2], f[3]); w.z = cvtpk(f[4], f[5]); w.w = cvtpk(f[6], f[7]);
      (second ? woutt : wint)[(size_t)n * 128 + ko] = w;
    }
  }
  {
    const float4* __restrict__ x4 = (const float4*)p.in[0];
    uint4* xb = (uint4*)(p.ws + OFF_XB);
    for (size_t i = (size_t)blockIdx.x * NTHR + threadIdx.x; i < (size_t)T_TOK * DM / 8; i += (size_t)gridDim.x * NTHR) {
      float4 a = x4[2 * i], b = x4[2 * i + 1];
      uint4 w; w.x = cvtpk(a.x, a.y); w.y = cvtpk(a.z, a.w); w.z = cvtpk(b.x, b.y); w.w = cvtpk(b.z, b.w);
      xb[i] = w;
    }
  }
}

template <class AF, class BF>
__device__ __forceinline__ void gemm64_naive(float* As, float* Bs, float* Cs, int K, AF af, BF bf) {
  const int tid = threadIdx.x, tx = tid & 15, ty = tid >> 4;
  float acc[4][4];
#pragma unroll
  for (int i = 0; i < 4; ++i)
#pragma unroll
    for (int j = 0; j < 4; ++j) acc[i][j] = 0.f;
  for (int k0 = 0; k0 < K; k0 += 16) {
#pragma unroll
    for (int u = 0; u < 4; ++u) { int i = tid + u * 256; int r = i >> 4, kk = i & 15; As[kk * 68 + r] = af(r, k0 + kk); }
#pragma unroll
    for (int u = 0; u < 4; ++u) { int i = tid + u * 256; int kk = i >> 6, c = i & 63; Bs[kk * 68 + c] = bf(k0 + kk, c); }
    __syncthreads();
#pragma unroll
    for (int kk = 0; kk < 16; ++kk) {
      float a[4], b[4];
#pragma unroll
      for (int i = 0; i < 4; ++i) { a[i] = As[kk * 68 + ty * 4 + i]; b[i] = Bs[kk * 68 + tx * 4 + i]; }
#pragma unroll
      for (int i = 0; i < 4; ++i)
#pragma unroll
        for (int j = 0; j < 4; ++j) acc[i][j] += a[i] * b[j];
    }
    __syncthreads();
  }
#pragma unroll
  for (int i = 0; i < 4; ++i)
#pragma unroll
    for (int j = 0; j < 4; ++j) Cs[(ty * 4 + i) * 65 + tx * 4 + j] = acc[i][j];
  __syncthreads();
}


__device__ __forceinline__ int lds_off(int row, int chunk) { return row * 128 + ((chunk ^ ((row >> 1) & 7)) << 4); }

template <int BMODE>
__device__ __forceinline__ unsigned cvtpk_m(float a, float b, const bool lo = false) {
  if (BMODE == 0 || (BMODE == 2 && !lo)) return cvtpk(a, b);
  const unsigned h = cvtpk(a, b);
  const float ah = __uint_as_float(h << 16), bh = __uint_as_float(h & 0xffff0000u);
  return cvtpk(a - ah, b - bh);
}
#define G128_MMA(bufoff) { \
    _Pragma("unroll") for (int kk = 0; kk < 2; ++kk) { \
      bf16x8 af[4], bfr[4]; \
      _Pragma("unroll") for (int m = 0; m < 4; ++m) af[m] = *(const bf16x8*)(smem + (bufoff) + lds_off(wr * 64 + m * 16 + fr, kk * 4 + fq)); \
      _Pragma("unroll") for (int n = 0; n < 4; ++n) bfr[n] = *(const bf16x8*)(smem + (bufoff) + 16384 + lds_off(wc * 64 + n * 16 + fr, kk * 4 + fq)); \
      _Pragma("unroll") for (int m = 0; m < 4; ++m) \
        _Pragma("unroll") for (int n = 0; n < 4; ++n) acc[m][n] = __builtin_amdgcn_mfma_f32_16x16x32_bf16(bfr[n], af[m], acc[m][n], 0, 0, 0); \
    } }
template <int BMODE, bool KCLAMP, class ALoad, class BPtr>
__device__ __forceinline__ void gemm128_acc(f32x4 (&acc)[4][4], char* smem, const int nk, ALoad aload, BPtr bptr, const int ldb, const int kvalid) {
  const int tid = threadIdx.x, lane = tid & 63, wid = tid >> 6;
  const int wr = wid >> 1, wc = wid & 1, fr = lane & 15, fq = lane >> 4;
  const int achunk = tid & 7, arow0 = tid >> 3;
  const int nq = tid & 31, ko = tid >> 5;
  const float* bp0 = bptr(nq);
  const int oa0 = lds_off(arow0, achunk), oa1 = lds_off(arow0 + 32, achunk), oa2 = lds_off(arow0 + 64, achunk), oa3 = lds_off(arow0 + 96, achunk);
  const int ob0 = 16384 + lds_off(nq * 4 + 0, ko), ob1 = 16384 + lds_off(nq * 4 + 1, ko), ob2 = 16384 + lds_off(nq * 4 + 2, ko), ob3 = 16384 + lds_off(nq * 4 + 3, ko);
  uint4 ra0, ra1, ra2, ra3; float4 rb0, rb1, rb2, rb3, rb4, rb5, rb6, rb7;
#define G128_LOAD(kt) { \
    ra0 = aload(0, arow0, (kt) * 8 + achunk); ra1 = aload(1, arow0 + 32, (kt) * 8 + achunk); \
    ra2 = aload(2, arow0 + 64, (kt) * 8 + achunk); ra3 = aload(3, arow0 + 96, (kt) * 8 + achunk); \
    int kr_ = (kt) * 64 + ko * 8; \
    if (KCLAMP) kr_ = min(kr_, kvalid - 8);     \
    { \
      const float* b2_ = bp0 + (size_t)((BMODE == 2) ? (kr_ & 1023) : kr_) * ldb; \
      rb0 = *(const float4*)(b2_); rb1 = *(const float4*)(b2_ + (size_t)1 * ldb); rb2 = *(const float4*)(b2_ + (size_t)2 * ldb); \
      rb3 = *(const float4*)(b2_ + (size_t)3 * ldb); rb4 = *(const float4*)(b2_ + (size_t)4 * ldb); rb5 = *(const float4*)(b2_ + (size_t)5 * ldb); \
      rb6 = *(const float4*)(b2_ + (size_t)6 * ldb); rb7 = *(const float4*)(b2_ + (size_t)7 * ldb); \
    } }
#define G128_STORE(bufoff, lo_) { \
    char* const sb_ = smem + (bufoff); \
    *(uint4*)(sb_ + oa0) = ra0; *(uint4*)(sb_ + oa1) = ra1; *(uint4*)(sb_ + oa2) = ra2; *(uint4*)(sb_ + oa3) = ra3; \
    uint4 w; \
    w.x = cvtpk_m<BMODE>(rb0.x, rb1.x, lo_); w.y = cvtpk_m<BMODE>(rb2.x, rb3.x, lo_); w.z = cvtpk_m<BMODE>(rb4.x, rb5.x, lo_); w.w = cvtpk_m<BMODE>(rb6.x, rb7.x, lo_); \
    *(uint4*)(sb_ + ob0) = w; \
    w.x = cvtpk_m<BMODE>(rb0.y, rb1.y, lo_); w.y = cvtpk_m<BMODE>(rb2.y, rb3.y, lo_); w.z = cvtpk_m<BMODE>(rb4.y, rb5.y, lo_); w.w = cvtpk_m<BMODE>(rb6.y, rb7.y, lo_); \
    *(uint4*)(sb_ + ob1) = w; \
    w.x = cvtpk_m<BMODE>(rb0.z, rb1.z, lo_); w.y = cvtpk_m<BMODE>(rb2.z, rb3.z, lo_); w.z = cvtpk_m<BMODE>(rb4.z, rb5.z, lo_); w.w = cvtpk_m<BMODE>(rb6.z, rb7.z, lo_); \
    *(uint4*)(sb_ + ob2) = w; \
    w.x = cvtpk_m<BMODE>(rb0.w, rb1.w, lo_); w.y = cvtpk_m<BMODE>(rb2.w, rb3.w, lo_); w.z = cvtpk_m<BMODE>(rb4.w, rb5.w, lo_); w.w = cvtpk_m<BMODE>(rb6.w, rb7.w, lo_); \
    *(uint4*)(sb_ + ob3) = w; }
  G128_LOAD(0)
  G128_STORE(0, false)
  if (nk > 1) G128_LOAD(1)
  __syncthreads();
  for (int kt = 0; kt < nk; ++kt) {
    const int cur = (kt & 1) * 32768;
    __builtin_amdgcn_sched_barrier(0);
    G128_MMA(cur)
    __builtin_amdgcn_sched_barrier(0);
    if (kt + 1 < nk) {
      G128_STORE(cur ^ 32768, (kt + 1) >= 32)
      __builtin_amdgcn_sched_barrier(0);
      if (kt + 2 < nk) G128_LOAD(kt + 2)
    }
    __builtin_amdgcn_sched_barrier(0);
    __syncthreads();
  }
#undef G128_LOAD
#undef G128_STORE
}
__device__ __forceinline__ void acc_zero(f32x4 (&acc)[4][4]) {
#pragma unroll
  for (int m = 0; m < 4; ++m)
#pragma unroll
    for (int n = 0; n < 4; ++n) acc[m][n] = (f32x4){0.f, 0.f, 0.f, 0.f};
}
template <class ARow, class BPtr, class Epi>
__device__ __forceinline__ void gemm128(char* smem, const int K, ARow arow, BPtr bptr, const int ldb, Epi epi) {
  const int tid = threadIdx.x, lane = tid & 63, wid = tid >> 6;
  const int arow0 = tid >> 3;
  const bf16_t* ap0 = arow(arow0);
  const bf16_t* ap1 = arow(arow0 + 32);
  const bf16_t* ap2 = arow(arow0 + 64);
  const bf16_t* ap3 = arow(arow0 + 96);
  f32x4 acc[4][4];
  acc_zero(acc);
  gemm128_acc<0, false>(acc, smem, K >> 6,
      [=](int u, int, int kc) { const bf16_t* q = (u == 0) ? ap0 : (u == 1) ? ap1 : (u == 2) ? ap2 : ap3; return *(const uint4*)(q + kc * 8); },
      bptr, ldb, 0);
  epi(acc, wid >> 1, wid & 1, lane & 15, lane >> 4);
}


template <class ALoad, class BLoad>
__device__ __forceinline__ void gemm128_acc_bb(f32x4 (&acc)[4][4], char* smem, const int nk, ALoad aload, BLoad bload) {
  const int tid = threadIdx.x, lane = tid & 63, wid = tid >> 6;
  const int wr = wid >> 1, wc = wid & 1, fr = lane & 15, fq = lane >> 4;
  const int achunk = tid & 7, arow0 = tid >> 3;
  const int oa0 = lds_off(arow0, achunk), oa1 = lds_off(arow0 + 32, achunk), oa2 = lds_off(arow0 + 64, achunk), oa3 = lds_off(arow0 + 96, achunk);
  uint4 ra0, ra1, ra2, ra3, rb0, rb1, rb2, rb3;
#define G128_LOADBB(kt) { \
    ra0 = aload(0, arow0, (kt) * 8 + achunk); ra1 = aload(1, arow0 + 32, (kt) * 8 + achunk); \
    ra2 = aload(2, arow0 + 64, (kt) * 8 + achunk); ra3 = aload(3, arow0 + 96, (kt) * 8 + achunk); \
    rb0 = bload(0, arow0, (kt) * 8 + achunk); rb1 = bload(1, arow0 + 32, (kt) * 8 + achunk); \
    rb2 = bload(2, arow0 + 64, (kt) * 8 + achunk); rb3 = bload(3, arow0 + 96, (kt) * 8 + achunk); }
#define G128_STOREBB(bufoff) { \
    char* const sb_ = smem + (bufoff); \
    *(uint4*)(sb_ + oa0) = ra0; *(uint4*)(sb_ + oa1) = ra1; *(uint4*)(sb_ + oa2) = ra2; *(uint4*)(sb_ + oa3) = ra3; \
    *(uint4*)(sb_ + 16384 + oa0) = rb0; *(uint4*)(sb_ + 16384 + oa1) = rb1; *(uint4*)(sb_ + 16384 + oa2) = rb2; *(uint4*)(sb_ + 16384 + oa3) = rb3; }
  G128_LOADBB(0)
  G128_STOREBB(0)
  if (nk > 1) G128_LOADBB(1)
  __syncthreads();
  for (int kt = 0; kt < nk; ++kt) {
    const int cur = (kt & 1) * 32768;
    __builtin_amdgcn_sched_barrier(0);
    G128_MMA(cur)
    __builtin_amdgcn_sched_barrier(0);
    if (kt + 1 < nk) {
      G128_STOREBB(cur ^ 32768)
      __builtin_amdgcn_sched_barrier(0);
      if (kt + 2 < nk) G128_LOADBB(kt + 2)
    }
    __builtin_amdgcn_sched_barrier(0);
    __syncthreads();
  }
#undef G128_LOADBB
#undef G128_STOREBB
}
template <class ARow, class BRow, class Epi>
__device__ __forceinline__ void gemm128_bb(char* smem, const int K, ARow arow, BRow brow, Epi epi) {
  const int tid = threadIdx.x, lane = tid & 63, wid = tid >> 6;
  const int arow0 = tid >> 3;
  const bf16_t* ap0 = arow(arow0); const bf16_t* ap1 = arow(arow0 + 32); const bf16_t* ap2 = arow(arow0 + 64); const bf16_t* ap3 = arow(arow0 + 96);
  const bf16_t* bp0 = brow(arow0); const bf16_t* bp1 = brow(arow0 + 32); const bf16_t* bp2 = brow(arow0 + 64); const bf16_t* bp3 = brow(arow0 + 96);
  f32x4 acc[4][4];
  acc_zero(acc);
  gemm128_acc_bb(acc, smem, K >> 6,
      [=](int u, int, int kc) { const bf16_t* q = (u == 0) ? ap0 : (u == 1) ? ap1 : (u == 2) ? ap2 : ap3; return *(const uint4*)(q + kc * 8); },
      [=](int u, int, int kc) { const bf16_t* q = (u == 0) ? bp0 : (u == 1) ? bp1 : (u == 2) ? bp2 : bp3; return *(const uint4*)(q + kc * 8); });
  epi(acc, wid >> 1, wid & 1, lane & 15, lane >> 4);
}


#define GAS1 __attribute__((address_space(1)))
#define LAS3 __attribute__((address_space(3)))
__device__ __forceinline__ void glds16(const void* g, char* l) {
  __builtin_amdgcn_global_load_lds((const GAS1 void*)g, (LAS3 void*)l, 16, 0, 0);
}
template <class ARow, class BRow, class Epi>
__device__ __forceinline__ void gemm128_glds(char* smem, const int K, ARow arow, BRow brow, Epi epi) {
  const int tid = threadIdx.x, lane = tid & 63, wid = tid >> 6;
  const int wr = wid >> 1, wc = wid & 1, fr = lane & 15, fq = lane >> 4;
  const int r0 = tid >> 3;
  const int cl = (tid & 7) ^ ((tid >> 4) & 7);
  const bf16_t* ga0 = arow(r0) + cl * 8; const bf16_t* ga1 = arow(r0 + 32) + cl * 8; const bf16_t* ga2 = arow(r0 + 64) + cl * 8; const bf16_t* ga3 = arow(r0 + 96) + cl * 8;
  const bf16_t* gb0 = brow(r0) + cl * 8; const bf16_t* gb1 = brow(r0 + 32) + cl * 8; const bf16_t* gb2 = brow(r0 + 64) + cl * 8; const bf16_t* gb3 = brow(r0 + 96) + cl * 8;
  char* const lbase = smem + tid * 16;
#define GL_STAGE(bufoff, kt) { \
    char* const d_ = lbase + (bufoff); const int ko_ = (kt) * 64; \
    glds16(ga0 + ko_, d_); glds16(ga1 + ko_, d_ + 4096); glds16(ga2 + ko_, d_ + 8192); glds16(ga3 + ko_, d_ + 12288); \
    glds16(gb0 + ko_, d_ + 16384); glds16(gb1 + ko_, d_ + 20480); glds16(gb2 + ko_, d_ + 24576); glds16(gb3 + ko_, d_ + 28672); }
  f32x4 acc[4][4];
  acc_zero(acc);
  const int nk = K >> 6;
  GL_STAGE(0, 0)
  asm volatile("s_waitcnt vmcnt(0)" ::: "memory");
  __syncthreads();
  for (int kt = 0; kt < nk; ++kt) {
    const int cur = (kt & 1) * 32768;
    if (kt + 1 < nk) GL_STAGE(cur ^ 32768, kt + 1)
    G128_MMA(cur)
    asm volatile("s_waitcnt vmcnt(0)" ::: "memory");
    __syncthreads();
  }
#undef GL_STAGE
  epi(acc, wr, wc, fr, fq);
}


template <int NCALL, int NK, class ARow, class BRow, class Epi>
__device__ __forceinline__ void gemm128_glds_multi(char* smem, ARow arow, BRow brow, const size_t bstride, Epi epi) {
  const int tid = threadIdx.x, lane = tid & 63, wid = tid >> 6;
  const int wr = wid >> 1, wc = wid & 1, fr = lane & 15, fq = lane >> 4;
  const int r0 = tid >> 3;
  const int cl = (tid & 7) ^ ((tid >> 4) & 7);
  const bf16_t* ga0 = arow(r0) + cl * 8; const bf16_t* ga1 = arow(r0 + 32) + cl * 8; const bf16_t* ga2 = arow(r0 + 64) + cl * 8; const bf16_t* ga3 = arow(r0 + 96) + cl * 8;
  const bf16_t* gb0 = brow(r0) + cl * 8; const bf16_t* gb1 = brow(r0 + 32) + cl * 8; const bf16_t* gb2 = brow(r0 + 64) + cl * 8; const bf16_t* gb3 = brow(r0 + 96) + cl * 8;
  char* const lbase = smem + tid * 16;
#define GM_STAGE(bufoff, g) { \
    char* const d_ = lbase + (bufoff); const int ko_ = ((g) % NK) * 64; const size_t bo_ = (size_t)((g) / NK) * bstride + ko_; \
    glds16(ga0 + ko_, d_); glds16(ga1 + ko_, d_ + 4096); glds16(ga2 + ko_, d_ + 8192); glds16(ga3 + ko_, d_ + 12288); \
    glds16(gb0 + bo_, d_ + 16384); glds16(gb1 + bo_, d_ + 20480); glds16(gb2 + bo_, d_ + 24576); glds16(gb3 + bo_, d_ + 28672); }
  f32x4 acc[4][4];
  acc_zero(acc);
  constexpr int G = NCALL * NK;
  GM_STAGE(0, 0)
  asm volatile("s_waitcnt vmcnt(0)" ::: "memory");
  __syncthreads();
#pragma unroll 1
  for (int g = 0; g < G; ++g) {
    const int cur = (g & 1) * 32768;
    if (g + 1 < G) GM_STAGE(cur ^ 32768, g + 1)
    G128_MMA(cur)
    if ((g % NK) == NK - 1) {
      epi(g / NK, acc, wr, wc, fr, fq);
      acc_zero(acc);
    }
    asm volatile("s_waitcnt vmcnt(0)" ::: "memory");
    __syncthreads();
  }
#undef GM_STAGE
}

#define DPP_F(v, ctrl) __builtin_bit_cast(float, __builtin_amdgcn_update_dpp(0, __builtin_bit_cast(int, (v)), (ctrl), 0xF, 0xF, true))
__device__ __forceinline__ float rdlane_f(float v, int l) { return __builtin_bit_cast(float, __builtin_amdgcn_readlane(__builtin_bit_cast(int, v), l)); }
__device__ __forceinline__ float dpp_sum16x(float v) {
  v += DPP_F(v, 0xB1); v += DPP_F(v, 0x4E); v += DPP_F(v, 0x141); v += DPP_F(v, 0x140);
  return v;
}
__device__ __forceinline__ float dpp_max16x(float v) {
  v = fmaxf(v, DPP_F(v, 0xB1)); v = fmaxf(v, DPP_F(v, 0x4E)); v = fmaxf(v, DPP_F(v, 0x141)); v = fmaxf(v, DPP_F(v, 0x140));
  return v;
}
__device__ __forceinline__ float wave_sum_fast(float v) {
  v = dpp_sum16x(v);
  return (rdlane_f(v, 0) + rdlane_f(v, 16)) + (rdlane_f(v, 32) + rdlane_f(v, 48));
}
__device__ __forceinline__ float wave_max_fast(float v) {
  v = dpp_max16x(v);
  return fmaxf(fmaxf(rdlane_f(v, 0), rdlane_f(v, 16)), fmaxf(rdlane_f(v, 32), rdlane_f(v, 48)));
}
__device__ __forceinline__ float fast_tanh(float x) { const float e = __expf(2.f * x); return 1.f - 2.f / (e + 1.f); }


__device__ __forceinline__ float4 bf4_to_f4(uint2 u) {
  float4 r;
  r.x = __uint_as_float(u.x << 16); r.y = __uint_as_float(u.x & 0xffff0000u);
  r.z = __uint_as_float(u.y << 16); r.w = __uint_as_float(u.y & 0xffff0000u);
  return r;
}
__device__ __forceinline__ uint2 pack4(float a, float b, float c, float d) { uint2 r; r.x = cvtpk(a, b); r.y = cvtpk(c, d); return r; }
#define XCD_GROUP (blockIdx.x & 7)
#define XCD_LB (blockIdx.x >> 3)
#define XCD_NB ((gridDim.x + 7 - (blockIdx.x & 7)) >> 3)

__device__ __forceinline__ void phase_inproj(const Params& p, char* smem) {
  const bf16_t* __restrict__ XB = (const bf16_t*)(p.ws + OFF_XB);
  const bf16_t* __restrict__ WINT = (const bf16_t*)(p.ws + OFF_WINT);
  const float* __restrict__ rope = (const float*)(p.ws + OFF_ROPE);
  bf16_t* Q = (bf16_t*)(p.ws + OFF_Q); bf16_t* K = (bf16_t*)(p.ws + OFF_K); bf16_t* V = (bf16_t*)(p.ws + OFF_V);
  bf16_t* FE = (bf16_t*)(p.ws + OFF_FEATS);
  const int NT = 27, NITEM = (T_TOK / 128) * NT, CHUNK = NITEM / 8;
  for (int i = XCD_LB; i < CHUNK; i += XCD_NB) {
    const int item = XCD_GROUP * CHUNK + i;
    const int row0 = (item & 255) * 128, col0 = (item >> 8) * 128;
    gemm128_glds(smem, DM,
            [=](int r) { return XB + (size_t)(row0 + r) * DM; },
            [=](int r) { return WINT + (size_t)(col0 + r) * DM; },
            [=](f32x4 (&acc)[4][4], int wr, int wc, int fr, int fq) {
              const int cb = col0 + wc * 64;
              if (cb >= INW) return;
#pragma unroll
              for (int m = 0; m < 4; ++m) {
                const int t = row0 + wr * 64 + m * 16 + fr;
                if (cb < 1024) {
                  const int pos = t & (SEQ - 1);
                  bf16_t* dst = (cb < 512) ? (Q + (size_t)t * 512 + cb) : (K + (size_t)t * 512 + (cb - 512));
                  const float sc = (cb < 512) ? 0.125f : 1.f;
#pragma unroll
                  for (int n = 0; n < 2; ++n) {
                    const int f0 = n * 16 + fq * 4;
                    const float4 c01 = *(const float4*)(rope + (size_t)(pos * 32 + f0) * 2);
                    const float4 c23 = *(const float4*)(rope + (size_t)(pos * 32 + f0) * 2 + 4);
                    const float cs[4] = {c01.x, c01.z, c23.x, c23.z}, sn[4] = {c01.y, c01.w, c23.y, c23.w};
                    float o1[4], o2[4];
#pragma unroll
                    for (int j = 0; j < 4; ++j) {
                      const float z1 = acc[m][n][j], z2 = acc[m][n + 2][j];
                      o1[j] = (z1 * cs[j] - z2 * sn[j]) * sc; o2[j] = (z2 * cs[j] + z1 * sn[j]) * sc;
                    }
                    *(uint2*)(dst + f0) = pack4(o1[0], o1[1], o1[2], o1[3]);
                    *(uint2*)(dst + 32 + f0) = pack4(o2[0], o2[1], o2[2], o2[3]);
                  }
                } else if (cb < 1536) {
#pragma unroll
                  for (int n = 0; n < 4; ++n)
                    *(uint2*)(V + (size_t)t * 512 + (cb - 1024) + n * 16 + fq * 4) = pack4(acc[m][n][0], acc[m][n][1], acc[m][n][2], acc[m][n][3]);
                } else {
#pragma unroll
                  for (int n = 0; n < 4; ++n) {
                    const int c = cb + n * 16 + fq * 4;
                    if (c < INW) *(uint2*)(FE + (size_t)t * FEW + (c - 1536)) = pack4(acc[m][n][0], acc[m][n][1], acc[m][n][2], acc[m][n][3]);
                  }
                }
              }
            });
  }
}

__device__ __forceinline__ void phase_prep_a(const Params& p) {
  const bf16_t* __restrict__ FE = (const bf16_t*)(p.ws + OFF_FEATS);
  const float* __restrict__ mu = p.in[2];
  bf16_t* R = (bf16_t*)(p.ws + OFF_R); bf16_t* K2 = (bf16_t*)(p.ws + OFF_K2); bf16_t* V2 = (bf16_t*)(p.ws + OFF_V2);
  bf16_t* ACT = (bf16_t*)(p.ws + OFF_ACT);
  for (size_t i = (size_t)blockIdx.x * NTHR + threadIdx.x; i < (size_t)T_TOK * 232; i += (size_t)gridDim.x * NTHR) {
    const int t = (int)(i / 232), ch = (int)(i - (size_t)t * 232);
    if (ch >= 228) { *(uint4*)(ACT + (size_t)t * 320 + 288 + (ch - 228) * 8) = make_uint4(0u, 0u, 0u, 0u); continue; }
    const int col = ch * 8;
    const uint4 cu = *(const uint4*)(FE + (size_t)t * FEW + col);
    uint4 pv = make_uint4(0u, 0u, 0u, 0u);
    if ((t & (SEQ - 1)) != 0) pv = *(const uint4*)(FE + (size_t)(t - 1) * FEW + col);
    const float4 m0 = *(const float4*)(mu + col), m1 = *(const float4*)(mu + col + 4);
    const unsigned cw[4] = {cu.x, cu.y, cu.z, cu.w}, pw[4] = {pv.x, pv.y, pv.z, pv.w};
    const float mm[8] = {m0.x, m0.y, m0.z, m0.w, m1.x, m1.y, m1.z, m1.w};
    float f[8];
#pragma unroll
    for (int q = 0; q < 4; ++q) {
      const float c0 = __uint_as_float(cw[q] << 16), c1 = __uint_as_float(cw[q] & 0xffff0000u);
      const float p0 = __uint_as_float(pw[q] << 16), p1 = __uint_as_float(pw[q] & 0xffff0000u);
      f[2 * q] = c0 + (p0 - c0) * mm[2 * q];
      f[2 * q + 1] = c1 + (p1 - c1) * mm[2 * q + 1];
    }
    bf16_t* dst;
    if (col < 512) dst = R + (size_t)t * 512 + col;
    else if (col < 1024) dst = K2 + (size_t)t * 512 + (col - 512);
    else if (col < 1536) dst = V2 + (size_t)t * 512 + (col - 1024);
    else {
      dst = ACT + (size_t)t * 320 + (col - 1536);
      if (col < 1600) {
#pragma unroll
        for (int q = 0; q < 8; ++q) f[q] = fast_tanh(f[q]);
      } else if (col >= 1664) {
#pragma unroll
        for (int q = 0; q < 8; ++q) f[q] = sigmoidf_(f[q]);
      }
    }
    uint4 w; w.x = cvtpk(f[0], f[1]); w.y = cvtpk(f[2], f[3]); w.z = cvtpk(f[4], f[5]); w.w = cvtpk(f[6], f[7]);
    *(uint4*)dst = w;
  }
}

template <int PASS>
__device__ __forceinline__ void prep_item(const Params& p, char* smem, const int row0, const int col0) {
  const bf16_t* __restrict__ ACT = (const bf16_t*)(p.ws + OFF_ACT);
  constexpr int ACOL = PASS * 64;
  constexpr int NK = (PASS == 2) ? 3 : 1;
  const float* __restrict__ Wm = (PASS == 0) ? p.in[4] : (PASS == 1) ? p.in[6] : p.in[7];
  f32x4 acc[4][4];
  acc_zero(acc);
  gemm128_acc<0, (PASS == 2)>(acc, smem, NK,
      [=](int, int rowl, int kc) { return *(const uint4*)(ACT + (size_t)(row0 + rowl) * 320 + ACOL + kc * 8); },
      [=](int nq) { return Wm + col0 + nq * 4; }, 512, 160);
  const int tid = threadIdx.x, lane = tid & 63, wid = tid >> 6;
  const int wr = wid >> 1, wc = wid & 1, fr = lane & 15, fq = lane >> 4;
  const int cb = col0 + wc * 64;
  if (PASS == 0) {
    const float* __restrict__ w0 = p.in[3];
    float* W = (float*)(p.ws + OFF_W);
#pragma unroll
    for (int n = 0; n < 4; ++n) {
      const int c = cb + n * 16 + fq * 4;
      const float4 w04 = *(const float4*)(w0 + c);
      const float w0c[4] = {w04.x, w04.y, w04.z, w04.w};
#pragma unroll
      for (int m = 0; m < 4; ++m) {
        const int t = row0 + wr * 64 + m * 16 + fr;
        float d[4];
#pragma unroll
        for (int j = 0; j < 4; ++j) {
          const float nz = -(w0c[j] + acc[m][n][j]);
          const float sp = fmaxf(nz, 0.f) + __logf(1.f + __expf(-fabsf(nz)));
          d[j] = __expf(-__expf(-sp - 0.5f));
        }
        *(float4*)(W + (size_t)t * 512 + c) = make_float4(d[0], d[1], d[2], d[3]);
      }
    }
  } else if (PASS == 2) {
    bf16_t* G = (bf16_t*)(p.ws + OFF_G);
#pragma unroll
    for (int m = 0; m < 4; ++m) {
      const int t = row0 + wr * 64 + m * 16 + fr;
#pragma unroll
      for (int n = 0; n < 4; ++n)
        *(uint2*)(G + (size_t)t * 512 + cb + n * 16 + fq * 4) = pack4(acc[m][n][0], acc[m][n][1], acc[m][n][2], acc[m][n][3]);
    }
  } else {
    const float* __restrict__ a0 = p.in[5]; const float* __restrict__ k_k = p.in[8]; const float* __restrict__ k_a = p.in[9];
    const float* __restrict__ r_k = p.in[10];
    const bf16_t* __restrict__ R = (const bf16_t*)(p.ws + OFF_R); bf16_t* K2 = (bf16_t*)(p.ws + OFF_K2);
    bf16_t* A = (bf16_t*)(p.ws + OFF_A); bf16_t* B = (bf16_t*)(p.ws + OFF_B); float* SB = (float*)(p.ws + OFF_SB);
#pragma unroll
    for (int m = 0; m < 4; ++m) {
      __builtin_amdgcn_sched_barrier(0);
      const int t = row0 + wr * 64 + m * 16 + fr;
      float kk[4][4];
      float ssp = 0.f, sbp = 0.f;
#pragma unroll
      for (int n = 0; n < 4; ++n) {
        const int c = cb + n * 16 + fq * 4;
        const size_t o = (size_t)t * 512 + c;
        const float4 rr4 = bf4_to_f4(*(const uint2*)(R + o)), kx4 = bf4_to_f4(*(const uint2*)(K2 + o));
        const float rr[4] = {rr4.x, rr4.y, rr4.z, rr4.w}, kx[4] = {kx4.x, kx4.y, kx4.z, kx4.w};
        const float4 a04 = *(const float4*)(a0 + c), kk4 = *(const float4*)(k_k + c), ka4 = *(const float4*)(k_a + c), rk4 = *(const float4*)(r_k + c);
        const float a0c[4] = {a04.x, a04.y, a04.z, a04.w}, kkc[4] = {kk4.x, kk4.y, kk4.z, kk4.w}, kac[4] = {ka4.x, ka4.y, ka4.z, ka4.w};
        const float rkc[4] = {rk4.x, rk4.y, rk4.z, rk4.w};
        float k2[4];
#pragma unroll
        for (int j = 0; j < 4; ++j) {
          const float av = sigmoidf_(a0c[j] + acc[m][n][j]);
          acc[m][n][j] = av;
          kk[n][j] = kx[j] * kkc[j];
          k2[j] = kx[j] * (1.f + (av - 1.f) * kac[j]);
          ssp += kk[n][j] * kk[n][j];
          sbp += rr[j] * k2[j] * rkc[j];
        }
        *(uint2*)(K2 + o) = pack4(k2[0], k2[1], k2[2], k2[3]);
      }
      ssp += __shfl_xor(ssp, 16, 64); ssp += __shfl_xor(ssp, 32, 64);
      sbp += __shfl_xor(sbp, 16, 64); sbp += __shfl_xor(sbp, 32, 64);
      const float inv = 1.f / fmaxf(sqrtf(ssp), 1e-12f);
#pragma unroll
      for (int n = 0; n < 4; ++n) {
        const size_t o = (size_t)t * 512 + cb + n * 16 + fq * 4;
        *(uint2*)(A + o) = pack4(-kk[n][0] * inv, -kk[n][1] * inv, -kk[n][2] * inv, -kk[n][3] * inv);
        *(uint2*)(B + o) = pack4(kk[n][0] * inv * acc[m][n][0], kk[n][1] * inv * acc[m][n][1], kk[n][2] * inv * acc[m][n][2], kk[n][3] * inv * acc[m][n][3]);
      }
      if (fq == 0) SB[(size_t)t * 8 + (cb >> 6)] = sbp;
    }
  }
}
__device__ __forceinline__ void phase_prep(const Params& p, char* smem) {
  for (int item = blockIdx.x; item < (T_TOK / 128) * 12; item += gridDim.x) {
    const int mt = item / 12, sub = item - mt * 12, pass = sub >> 2, nt = sub & 3;
    if (pass == 0) prep_item<0>(p, smem, mt * 128, nt * 128);
    else if (pass == 1) prep_item<1>(p, smem, mt * 128, nt * 128);
    else prep_item<2>(p, smem, mt * 128, nt * 128);
  }
}

__device__ __forceinline__ float dpp_sum16(float v) {
  v += __builtin_bit_cast(float, __builtin_amdgcn_update_dpp(0, __builtin_bit_cast(int, v), 0xB1, 0xF, 0xF, true));
  v += __builtin_bit_cast(float, __builtin_amdgcn_update_dpp(0, __builtin_bit_cast(int, v), 0x4E, 0xF, 0xF, true));
  v += __builtin_bit_cast(float, __builtin_amdgcn_update_dpp(0, __builtin_bit_cast(int, v), 0x141, 0xF, 0xF, true));
  v += __builtin_bit_cast(float, __builtin_amdgcn_update_dpp(0, __builtin_bit_cast(int, v), 0x140, 0xF, 0xF, true));
  return v;
}
#define SC_CH 16
#define SC_ARR (SC_CH * 64 * 4)
#define SC_BUF (5 * SC_ARR + SC_CH * 16 * 4)
__device__ __forceinline__ void phase_scan(const Params& p, char* smem) {
  if (blockIdx.x >= 256) return;
  const bf16_t* __restrict__ R = (const bf16_t*)(p.ws + OFF_R); const bf16_t* __restrict__ K2 = (const bf16_t*)(p.ws + OFF_K2);
  const bf16_t* __restrict__ V2 = (const bf16_t*)(p.ws + OFF_V2); const bf16_t* __restrict__ A = (const bf16_t*)(p.ws + OFF_A);
  const bf16_t* __restrict__ B = (const bf16_t*)(p.ws + OFF_B); const float* __restrict__ W = (const float*)(p.ws + OFF_W);
  float* YS = (float*)(p.ws + OFF_YS);
  const int bh = blockIdx.x >> 2, rg = blockIdx.x & 3, b = bh >> 3, h = bh & 7;
  const int tid = threadIdx.x, lane = tid & 63, wid = tid >> 6, j = lane & 15, rq = lane >> 4;
  const int rowl = wid * 4 + rq;
  const int ls = tid >> 4, lc = tid & 15;
  const int vs = (tid >> 2) & 15, vq = tid & 3;
  const size_t tb = (size_t)b * SEQ;
  const size_t goff = (tb + ls) * 512 + h * 64 + lc * 4;
  const size_t voff = (tb + vs) * 512 + h * 64 + rg * 16 + vq * 4;
  uint2 ga, gb, gk, gr, gv; float4 gw;
  gv = make_uint2(0u, 0u);
  ga = *(const uint2*)(A + goff); gb = *(const uint2*)(B + goff); gk = *(const uint2*)(K2 + goff); gr = *(const uint2*)(R + goff);
  gw = *(const float4*)(W + goff);
  if (tid < 64) gv = *(const uint2*)(V2 + voff);
  {
    char* bf = smem;
    *(float4*)(bf + 0 * SC_ARR + ls * 256 + lc * 16) = bf4_to_f4(ga);
    *(float4*)(bf + 1 * SC_ARR + ls * 256 + lc * 16) = gw;
    *(float4*)(bf + 2 * SC_ARR + ls * 256 + lc * 16) = bf4_to_f4(gb);
    *(float4*)(bf + 3 * SC_ARR + ls * 256 + lc * 16) = bf4_to_f4(gk);
    *(float4*)(bf + 4 * SC_ARR + ls * 256 + lc * 16) = bf4_to_f4(gr);
    if (tid < 64) *(float4*)(bf + 5 * SC_ARR + vs * 64 + vq * 16) = bf4_to_f4(gv);
  }
  __syncthreads();
  float s0 = 0.f, s1 = 0.f, s2 = 0.f, s3 = 0.f;
  const int NCH = SEQ / SC_CH;
  for (int c = 0; c < NCH; ++c) {
    if (c + 1 < NCH) {
      const size_t o2 = goff + (size_t)(c + 1) * SC_CH * 512;
      ga = *(const uint2*)(A + o2); gb = *(const uint2*)(B + o2); gk = *(const uint2*)(K2 + o2); gr = *(const uint2*)(R + o2);
      gw = *(const float4*)(W + o2);
      if (tid < 64) gv = *(const uint2*)(V2 + voff + (size_t)(c + 1) * SC_CH * 512);
    }
    const char* bf = smem + (c & 1) * SC_BUF;
    float ykeep = 0.f;
#pragma unroll
    for (int s = 0; s < SC_CH; ++s) {
      const float4 a4 = *(const float4*)(bf + 0 * SC_ARR + s * 256 + j * 16);
      const float4 w4 = *(const float4*)(bf + 1 * SC_ARR + s * 256 + j * 16);
      const float4 b4 = *(const float4*)(bf + 2 * SC_ARR + s * 256 + j * 16);
      const float4 k4 = *(const float4*)(bf + 3 * SC_ARR + s * 256 + j * 16);
      const float4 r4 = *(const float4*)(bf + 4 * SC_ARR + s * 256 + j * 16);
      const float vv = *(const float*)(bf + 5 * SC_ARR + s * 64 + rowl * 4);
      float sa = (s0 * a4.x + s1 * a4.y) + (s2 * a4.z + s3 * a4.w);
      sa = dpp_sum16(sa);
      s0 = s0 * w4.x + (sa * b4.x + vv * k4.x);
      s1 = s1 * w4.y + (sa * b4.y + vv * k4.y);
      s2 = s2 * w4.z + (sa * b4.z + vv * k4.z);
      s3 = s3 * w4.w + (sa * b4.w + vv * k4.w);
      float y = (s0 * r4.x + s1 * r4.y) + (s2 * r4.z + s3 * r4.w);
      y = dpp_sum16(y);
      ykeep = (j == s) ? y : ykeep;
    }
    YS[(tb + (size_t)c * SC_CH + j) * 512 + h * 64 + rg * 16 + rowl] = ykeep;
    if (c + 1 < NCH) {
      char* bn = smem + ((c + 1) & 1) * SC_BUF;
      *(float4*)(bn + 0 * SC_ARR + ls * 256 + lc * 16) = bf4_to_f4(ga);
      *(float4*)(bn + 1 * SC_ARR + ls * 256 + lc * 16) = gw;
      *(float4*)(bn + 2 * SC_ARR + ls * 256 + lc * 16) = bf4_to_f4(gb);
      *(float4*)(bn + 3 * SC_ARR + ls * 256 + lc * 16) = bf4_to_f4(gk);
      *(float4*)(bn + 4 * SC_ARR + ls * 256 + lc * 16) = bf4_to_f4(gr);
      if (tid < 64) *(float4*)(bn + 5 * SC_ARR + vs * 64 + vq * 16) = bf4_to_f4(gv);
    }
    __syncthreads();
  }
}


#define CONV_TILES (257 * 96)
__device__ __forceinline__ void convert_tile(const Params& p, char* smem, const int ti) {
  const int e = ti / 96, q = ti - e * 96, part = q >> 5, w = q & 31;
  const float* src; int ldn, k0, n0; bf16_t* dst; int kdim;
  if (part < 2) {
    src = (e < NEXP) ? p.in[18 + part] + (size_t)e * DM * 256 : p.in[21 + part];
    ldn = 256; k0 = (w >> 1) * 64; n0 = (w & 1) * 128; kdim = 1024;
    dst = (bf16_t*)(p.ws + OFF_EW1) + (size_t)e * 512 * 1024;
  } else {
    src = (e < NEXP) ? p.in[20] + (size_t)e * 256 * DM : p.in[23];
    ldn = 1024; k0 = (w >> 3) * 64; n0 = (w & 7) * 128; kdim = 256;
    dst = (bf16_t*)(p.ws + OFF_EW2) + (size_t)e * 1024 * 256;
  }
  const int tid = threadIdx.x, nq = tid & 31, ko = tid >> 5;
  const float* bp = src + (size_t)(k0 + ko * 8) * ldn + n0 + nq * 4;
  const float4 rb0 = *(const float4*)(bp), rb1 = *(const float4*)(bp + (size_t)1 * ldn), rb2 = *(const float4*)(bp + (size_t)2 * ldn),
               rb3 = *(const float4*)(bp + (size_t)3 * ldn), rb4 = *(const float4*)(bp + (size_t)4 * ldn), rb5 = *(const float4*)(bp + (size_t)5 * ldn),
               rb6 = *(const float4*)(bp + (size_t)6 * ldn), rb7 = *(const float4*)(bp + (size_t)7 * ldn);
  {
    uint4 v;
    v.x = cvtpk(rb0.x, rb1.x); v.y = cvtpk(rb2.x, rb3.x); v.z = cvtpk(rb4.x, rb5.x); v.w = cvtpk(rb6.x, rb7.x); *(uint4*)(smem + lds_off(nq * 4 + 0, ko)) = v;
    v.x = cvtpk(rb0.y, rb1.y); v.y = cvtpk(rb2.y, rb3.y); v.z = cvtpk(rb4.y, rb5.y); v.w = cvtpk(rb6.y, rb7.y); *(uint4*)(smem + lds_off(nq * 4 + 1, ko)) = v;
    v.x = cvtpk(rb0.z, rb1.z); v.y = cvtpk(rb2.z, rb3.z); v.z = cvtpk(rb4.z, rb5.z); v.w = cvtpk(rb6.z, rb7.z); *(uint4*)(smem + lds_off(nq * 4 + 2, ko)) = v;
    v.x = cvtpk(rb0.w, rb1.w); v.y = cvtpk(rb2.w, rb3.w); v.z = cvtpk(rb4.w, rb5.w); v.w = cvtpk(rb6.w, rb7.w); *(uint4*)(smem + lds_off(nq * 4 + 3, ko)) = v;
  }
  __syncthreads();
#pragma unroll
  for (int u = 0; u < 4; ++u) {
    const int row = (tid >> 3) + 32 * u, chunk = tid & 7;
    const int c = n0 + row;
    int orow;
    if (part < 2) orow = (c >> 6) * 128 + ((c >> 5) & 1) * 64 + (part * 2 + ((c >> 4) & 1)) * 16 + (c & 15);
    else orow = c;
    *(uint4*)(dst + (size_t)orow * kdim + k0 + chunk * 8) = *(const uint4*)(smem + lds_off(row, chunk));
  }
  __syncthreads();
}
__device__ __forceinline__ void phase_convert(const Params& p, char* smem) {
  int* ctl = (int*)(p.ws + OFF_CTL);
  int* slot = (int*)(smem + 32768);
  __syncthreads();
  for (;;) {
    if (threadIdx.x == 0) *slot = atomicAdd(&ctl[CTL_CONVQ], 1);
    __syncthreads();
    const int ti = *slot;
    __syncthreads();
    if (ti >= CONV_TILES) break;
    convert_tile(p, smem, ti);
  }
}

__device__ __forceinline__ int vt_off(int d, int key) { const int swz = ((d >> 2) & 15) ^ ((d & 3) << 3); return d * 512 + (((key >> 2) ^ swz) << 3); }
__device__ __forceinline__ void phase_attn(const Params& p, char* smem) {
  const bf16_t* __restrict__ Q = (const bf16_t*)(p.ws + OFF_Q); const bf16_t* __restrict__ K = (const bf16_t*)(p.ws + OFF_K);
  const bf16_t* __restrict__ V = (const bf16_t*)(p.ws + OFF_V);
  bf16_t* OP = (bf16_t*)(p.ws + OFF_OP); float* LSE = (float*)(p.ws + OFF_LSE);
  char* Ks = smem; char* VT = smem + 32768; float* linv_s = (float*)(smem + 65536);
  const int tid = threadIdx.x, lane = tid & 63, wid = tid >> 6, l31 = lane & 31, hi = lane >> 5;
  for (int item = blockIdx.x; item < 6144; item += gridDim.x) {
    const int pp = item >> 11, rem = item & 2047, bh = rem >> 5, sub = rem & 31;
    const int dsh = pp * 2, nbsh = 5 - dsh;
    const int r = sub >> nbsh, n = sub & ((1 << nbsh) - 1);
    const int b = bh >> 3, h = bh & 7, tb = b * SEQ;
    __syncthreads();
#pragma unroll
    for (int u = 0; u < 8; ++u) {
      const int row = (tid >> 3) + 32 * u, chunk = tid & 7;
      int ik = n * 128 - 128 + row; ik = ik < 0 ? 0 : ik;
      const int tok = tb + (ik << dsh) + r;
      *(uint4*)(Ks + lds_off(row, chunk)) = *(const uint4*)(K + (size_t)tok * 512 + h * 64 + chunk * 8);
    }
#pragma unroll
    for (int ps = 0; ps < 2; ++ps) {
      const int dq = tid & 15, kbase = ps * 128 + (tid >> 4) * 8;
      uint2 v0, v1, v2, v3, v4, v5, v6, v7;
#define LDV(i, dst) { int ik = n * 128 - 128 + kbase + i; ik = ik < 0 ? 0 : ik; const int tok = tb + (ik << dsh) + r; dst = *(const uint2*)(V + (size_t)tok * 512 + h * 64 + dq * 4); }
      LDV(0, v0) LDV(1, v1) LDV(2, v2) LDV(3, v3) LDV(4, v4) LDV(5, v5) LDV(6, v6) LDV(7, v7)
#undef LDV
      {
        uint2 w;
        w.x = (v0.x & 0xffffu) | (v1.x << 16); w.y = (v2.x & 0xffffu) | (v3.x << 16);
        *(uint2*)(VT + vt_off(dq * 4 + 0, kbase)) = w;
        w.x = (v4.x & 0xffffu) | (v5.x << 16); w.y = (v6.x & 0xffffu) | (v7.x << 16);
        *(uint2*)(VT + vt_off(dq * 4 + 0, kbase + 4)) = w;
        w.x = (v0.x >> 16) | (v1.x & 0xffff0000u); w.y = (v2.x >> 16) | (v3.x & 0xffff0000u);
        *(uint2*)(VT + vt_off(dq * 4 + 1, kbase)) = w;
        w.x = (v4.x >> 16) | (v5.x & 0xffff0000u); w.y = (v6.x >> 16) | (v7.x & 0xffff0000u);
        *(uint2*)(VT + vt_off(dq * 4 + 1, kbase + 4)) = w;
        w.x = (v0.y & 0xffffu) | (v1.y << 16); w.y = (v2.y & 0xffffu) | (v3.y << 16);
        *(uint2*)(VT + vt_off(dq * 4 + 2, kbase)) = w;
        w.x = (v4.y & 0xffffu) | (v5.y << 16); w.y = (v6.y & 0xffffu) | (v7.y << 16);
        *(uint2*)(VT + vt_off(dq * 4 + 2, kbase + 4)) = w;
        w.x = (v0.y >> 16) | (v1.y & 0xffff0000u); w.y = (v2.y >> 16) | (v3.y & 0xffff0000u);
        *(uint2*)(VT + vt_off(dq * 4 + 3, kbase)) = w;
        w.x = (v4.y >> 16) | (v5.y & 0xffff0000u); w.y = (v6.y >> 16) | (v7.y & 0xffff0000u);
        *(uint2*)(VT + vt_off(dq * 4 + 3, kbase + 4)) = w;
      }
    }
    __syncthreads();
    const int iq = n * 128 + wid * 32 + l31;
    const int tq = tb + (iq << dsh) + r;
    bf16x8 qf[4];
#pragma unroll
    for (int ks = 0; ks < 4; ++ks) qf[ks] = *(const bf16x8*)(Q + (size_t)tq * 512 + h * 64 + ks * 16 + hi * 8);
    f32x16 st[5];
#pragma unroll
    for (int kb = 0; kb < 5; ++kb) {
      st[kb] = (f32x16){0.f, 0.f, 0.f, 0.f, 0.f, 0.f, 0.f, 0.f, 0.f, 0.f, 0.f, 0.f, 0.f, 0.f, 0.f, 0.f};
#pragma unroll
      for (int ks = 0; ks < 4; ++ks) {
        const bf16x8 kf = *(const bf16x8*)(Ks + lds_off(32 * (wid + kb) + l31, 2 * ks + hi));
        st[kb] = __builtin_amdgcn_mfma_f32_32x32x16_bf16(kf, qf[ks], st[kb], 0, 0, 0);
      }
    }
    float m = -INFINITY;
#pragma unroll
    for (int kb = 0; kb < 5; ++kb)
#pragma unroll
      for (int i = 0; i < 16; ++i) {
        const int kirel = 32 * kb + (i & 3) + 8 * (i >> 2) + 4 * hi;
        const bool valid = (kirel >= l31) && (kirel <= l31 + 128) && (n > 0 || (32 * wid + kirel) >= 128);
        const float s = valid ? st[kb][i] : -INFINITY;
        st[kb][i] = s;
        m = fmaxf(m, s);
      }
    m = fmaxf(m, __shfl_xor(m, 32, 64));
    float l = 0.f;
#pragma unroll
    for (int kb = 0; kb < 5; ++kb)
#pragma unroll
      for (int i = 0; i < 16; ++i) { const float pe = __expf(st[kb][i] - m); st[kb][i] = pe; l += pe; }
    l += __shfl_xor(l, 32, 64);
    f32x16 o0 = (f32x16){0.f, 0.f, 0.f, 0.f, 0.f, 0.f, 0.f, 0.f, 0.f, 0.f, 0.f, 0.f, 0.f, 0.f, 0.f, 0.f};
    f32x16 o1 = o0;
#pragma unroll
    for (int kb = 0; kb < 5; ++kb)
#pragma unroll
      for (int s = 0; s < 2; ++s) {
        union { unsigned u[4]; bf16x8 v; } pa;
        pa.u[0] = cvtpk(st[kb][8 * s + 0], st[kb][8 * s + 1]); pa.u[1] = cvtpk(st[kb][8 * s + 2], st[kb][8 * s + 3]);
        pa.u[2] = cvtpk(st[kb][8 * s + 4], st[kb][8 * s + 5]); pa.u[3] = cvtpk(st[kb][8 * s + 6], st[kb][8 * s + 7]);
        const int key0 = 32 * (wid + kb) + 16 * s + 4 * hi;
        {
          union { uint2 u[2]; bf16x8 v; } vb;
          vb.u[0] = *(const uint2*)(VT + vt_off(l31, key0)); vb.u[1] = *(const uint2*)(VT + vt_off(l31, key0 + 8));
          o0 = __builtin_amdgcn_mfma_f32_32x32x16_bf16(pa.v, vb.v, o0, 0, 0, 0);
        }
        {
          union { uint2 u[2]; bf16x8 v; } vb;
          vb.u[0] = *(const uint2*)(VT + vt_off(32 + l31, key0)); vb.u[1] = *(const uint2*)(VT + vt_off(32 + l31, key0 + 8));
          o1 = __builtin_amdgcn_mfma_f32_32x32x16_bf16(pa.v, vb.v, o1, 0, 0, 0);
        }
      }
    if (hi == 0) {
      linv_s[wid * 32 + l31] = 1.f / l;
      LSE[((size_t)pp * T_TOK + tq) * 8 + h] = m + __logf(l);
    }
#pragma unroll
    for (int i = 0; i < 16; ++i) {
      const int qrel = (i & 3) + 8 * (i >> 2) + 4 * hi;
      const int iq2 = n * 128 + wid * 32 + qrel;
      const int tq2 = tb + (iq2 << dsh) + r;
      const float li = linv_s[wid * 32 + qrel];
      bf16_t* op = OP + ((size_t)pp * T_TOK + tq2) * 512 + h * 64 + l31;
      op[0] = f2bf(o0[i] * li);
      op[32] = f2bf(o1[i] * li);
    }
  }
}

__device__ __forceinline__ void unpack8(const uint4 u, float (&f)[8]) {
  f[0] = __uint_as_float(u.x << 16); f[1] = __uint_as_float(u.x & 0xffff0000u); f[2] = __uint_as_float(u.y << 16); f[3] = __uint_as_float(u.y & 0xffff0000u);
  f[4] = __uint_as_float(u.z << 16); f[5] = __uint_as_float(u.z & 0xffff0000u); f[6] = __uint_as_float(u.w << 16); f[7] = __uint_as_float(u.w & 0xffff0000u);
}
__device__ __forceinline__ float dpp_sum8(float v) {
  v += DPP_F(v, 0xB1); v += DPP_F(v, 0x4E); v += DPP_F(v, 0x141);
  return v;
}
__device__ __forceinline__ void phase_post(const Params& p) {
  const float* __restrict__ YS = (const float*)(p.ws + OFF_YS); const bf16_t* __restrict__ V2 = (const bf16_t*)(p.ws + OFF_V2);
  const bf16_t* __restrict__ G = (const bf16_t*)(p.ws + OFF_G); const float* __restrict__ SB = (const float*)(p.ws + OFF_SB);
  const bf16_t* __restrict__ OP = (const bf16_t*)(p.ws + OFF_OP); const float* __restrict__ LSE = (const float*)(p.ws + OFF_LSE);
  const float* __restrict__ lnx_g = p.in[11]; const float* __restrict__ lnx_b = p.in[12];
  bf16_t* MIXED = (bf16_t*)(p.ws + OFF_MIXED);
  const int lane = threadIdx.x & 63, wid = threadIdx.x >> 6;
  const int c = lane * 8, hh = lane >> 3;
  const float4 g0 = *(const float4*)(lnx_g + c), g1 = *(const float4*)(lnx_g + c + 4), b0 = *(const float4*)(lnx_b + c), b1 = *(const float4*)(lnx_b + c + 4);
  const float gg[8] = {g0.x, g0.y, g0.z, g0.w, g1.x, g1.y, g1.z, g1.w}, bb[8] = {b0.x, b0.y, b0.z, b0.w, b1.x, b1.y, b1.z, b1.w};
  for (int t = blockIdx.x * 4 + wid; t < T_TOK; t += gridDim.x * 4) {
    const size_t o = (size_t)t * 512 + c;
    const float4 y0 = *(const float4*)(YS + o), y1 = *(const float4*)(YS + o + 4);
    const float y[8] = {y0.x, y0.y, y0.z, y0.w, y1.x, y1.y, y1.z, y1.w};
    float s = 0.f;
#pragma unroll
    for (int i = 0; i < 8; ++i) s += y[i];
    const float mean = dpp_sum8(s) * (1.f / 64.f);
    float q = 0.f;
#pragma unroll
    for (int i = 0; i < 8; ++i) { const float d = y[i] - mean; q += d * d; }
    const float rs = rsqrtf(dpp_sum8(q) * (1.f / 64.f) + GN_EPS_F);
    float v2[8], gt[8];
    unpack8(*(const uint4*)(V2 + o), v2); unpack8(*(const uint4*)(G + o), gt);
    const float sb = SB[(size_t)t * 8 + hh];
    float res[8];
#pragma unroll
    for (int i = 0; i < 8; ++i) res[i] = ((y[i] - mean) * rs * gg[i] + bb[i] + sb * v2[i]) * gt[i];
    uint4 w; w.x = cvtpk(res[0], res[1]); w.y = cvtpk(res[2], res[3]); w.z = cvtpk(res[4], res[5]); w.w = cvtpk(res[6], res[7]);
    *(uint4*)(MIXED + (size_t)t * 1024 + 512 + c) = w;
    const float l0 = LSE[((size_t)0 * T_TOK + t) * 8 + hh], l1 = LSE[((size_t)1 * T_TOK + t) * 8 + hh], l2 = LSE[((size_t)2 * T_TOK + t) * 8 + hh];
    const float mx = fmaxf(l0, fmaxf(l1, l2));
    float e0 = __expf(l0 - mx), e1 = __expf(l1 - mx), e2 = __expf(l2 - mx);
    const float inv = 1.f / (e0 + e1 + e2);
    e0 *= inv; e1 *= inv; e2 *= inv;
    float o0[8], o1[8], o2[8];
    unpack8(*(const uint4*)(OP + (size_t)0 * T_TOK * 512 + o), o0); unpack8(*(const uint4*)(OP + (size_t)1 * T_TOK * 512 + o), o1);
    unpack8(*(const uint4*)(OP + (size_t)2 * T_TOK * 512 + o), o2);
    float av[8];
#pragma unroll
    for (int i = 0; i < 8; ++i) av[i] = e0 * o0[i] + e1 * o1[i] + e2 * o2[i];
    w.x = cvtpk(av[0], av[1]); w.y = cvtpk(av[2], av[3]); w.z = cvtpk(av[4], av[5]); w.w = cvtpk(av[6], av[7]);
    *(uint4*)(MIXED + (size_t)t * 1024 + c) = w;
  }
}

__device__ __forceinline__ void phase_outproj(const Params& p, char* smem) {
  const bf16_t* __restrict__ MIXED = (const bf16_t*)(p.ws + OFF_MIXED);
  const bf16_t* __restrict__ WOUTT = (const bf16_t*)(p.ws + OFF_WOUTT); const float* __restrict__ x = p.in[0];
  float* U = p.out;
  for (int i = XCD_LB; i < T_TOK / 128; i += XCD_NB) {
    const int row0 = i * 128, col0 = XCD_GROUP * 128;
    gemm128_glds(smem, DM,
            [=](int r) { return MIXED + (size_t)(row0 + r) * DM; },
            [=](int r) { return WOUTT + (size_t)(col0 + r) * DM; },
            [=](f32x4 (&acc)[4][4], int wr, int wc, int fr, int fq) {
#pragma unroll
              for (int m = 0; m < 4; ++m) {
                const int t = row0 + wr * 64 + m * 16 + fr;
#pragma unroll
                for (int n = 0; n < 4; ++n) {
                  const size_t o = (size_t)t * DM + col0 + wc * 64 + n * 16 + fq * 4;
                  const float4 xv = *(const float4*)(x + o);
                  *(float4*)(U + o) = make_float4(ALPHA_F * xv.x + acc[m][n][0], ALPHA_F * xv.y + acc[m][n][1], ALPHA_F * xv.z + acc[m][n][2], ALPHA_F * xv.w + acc[m][n][3]);
                }
              }
            });
  }
}

__device__ __forceinline__ void phase_ln1(const Params& p) {
  float* X1 = p.out;
  const float* __restrict__ g1 = p.in[14]; const float* __restrict__ b1 = p.in[15];
  bf16_t* X1B = (bf16_t*)(p.ws + OFF_X1B); bf16_t* XL = (bf16_t*)(p.ws + OFF_XL);
  const int lane = threadIdx.x & 63, wid = threadIdx.x >> 6;
  for (int t = blockIdx.x * 4 + wid; t < T_TOK; t += gridDim.x * 4) {
    const size_t base = (size_t)t * DM;
    float4 v[4];
    float s = 0.f;
#pragma unroll
    for (int u = 0; u < 4; ++u) { v[u] = *(const float4*)(X1 + base + u * 256 + lane * 4); s += (v[u].x + v[u].y) + (v[u].z + v[u].w); }
    const float mean = wave_sum_fast(s) * (1.f / DM);
    float q = 0.f;
#pragma unroll
    for (int u = 0; u < 4; ++u) {
      const float d0 = v[u].x - mean, d1 = v[u].y - mean, d2 = v[u].z - mean, d3 = v[u].w - mean;
      q += (d0 * d0 + d1 * d1) + (d2 * d2 + d3 * d3);
    }
    const float rs = rsqrtf(wave_sum_fast(q) * (1.f / DM) + LN_EPS_F);
#pragma unroll
    for (int u = 0; u < 4; ++u) {
      const int c = u * 256 + lane * 4;
      const float4 g = *(const float4*)(g1 + c), bb = *(const float4*)(b1 + c);
      float4 y;
      y.x = (v[u].x - mean) * rs * g.x + bb.x; y.y = (v[u].y - mean) * rs * g.y + bb.y;
      y.z = (v[u].z - mean) * rs * g.z + bb.z; y.w = (v[u].w - mean) * rs * g.w + bb.w;
      *(float4*)(X1 + base + c) = y;
      uint2 hi; hi.x = cvtpk(y.x, y.y); hi.y = cvtpk(y.z, y.w);
      *(uint2*)(X1B + base + c) = hi;
      uint2 lo;
      lo.x = cvtpk(y.x - __uint_as_float(hi.x << 16), y.y - __uint_as_float(hi.x & 0xffff0000u));
      lo.y = cvtpk(y.z - __uint_as_float(hi.y << 16), y.w - __uint_as_float(hi.y & 0xffff0000u));
      *(uint2*)(XL + base + c) = lo;
    }
  }
}

__device__ __forceinline__ void phase_router_gemm(const Params& p, char* smem) {
  const bf16_t* __restrict__ X1B = (const bf16_t*)(p.ws + OFF_X1B); const bf16_t* __restrict__ XL = (const bf16_t*)(p.ws + OFF_XL);
  const float* __restrict__ router_w = p.in[16];
  float* AFF = (float*)(p.ws + OFF_AFF);
  for (int item = blockIdx.x; item < (T_TOK / 128) * 2; item += gridDim.x) {
    const int row0 = (item >> 1) * 128, col0 = (item & 1) * 128;
    f32x4 acc[4][4];
    acc_zero(acc);
    gemm128_acc<2, false>(acc, smem, 48,
        [=](int, int rowl, int kc) { const bf16_t* base = ((kc >> 7) == 1) ? XL : X1B; return *(const uint4*)(base + (size_t)(row0 + rowl) * DM + (kc & 127) * 8); },
        [=](int nq) { return router_w + col0 + nq * 4; }, NEXP, 0);
    const int tid = threadIdx.x, lane = tid & 63, wid = tid >> 6;
    const int wr = wid >> 1, wc = wid & 1, fr = lane & 15, fq = lane >> 4;
#pragma unroll
    for (int m = 0; m < 4; ++m) {
      const int t = row0 + wr * 64 + m * 16 + fr;
#pragma unroll
      for (int n = 0; n < 4; ++n)
        *(float4*)(AFF + (size_t)t * NEXP + col0 + wc * 64 + n * 16 + fq * 4) =
            make_float4(sigmoidf_(acc[m][n][0]), sigmoidf_(acc[m][n][1]), sigmoidf_(acc[m][n][2]), sigmoidf_(acc[m][n][3]));
    }
  }
}

__device__ __forceinline__ void phase_topk(const Params& p) {
  const float* __restrict__ AFF = (const float*)(p.ws + OFF_AFF);
  const float* __restrict__ router_bias = p.in[17];
  int* LIST = (int*)(p.ws + OFF_LIST); float* GATEW = (float*)(p.ws + OFF_GATEW);
  int* counts = (int*)(p.ws + OFF_CTL);
  const int lane = threadIdx.x & 63, wid = threadIdx.x >> 6;
  const float4 b4 = *(const float4*)(router_bias + lane * 4);
  for (int t = blockIdx.x * 4 + wid; t < T_TOK; t += gridDim.x * 4) {
    const float4 a4 = *(const float4*)(AFF + (size_t)t * NEXP + lane * 4);
    float s0 = a4.x + b4.x, s1 = a4.y + b4.y, s2 = a4.z + b4.z, s3 = a4.w + b4.w;
    const float hi01 = fmaxf(s0, s1), lo01 = fminf(s0, s1), hi23 = fmaxf(s2, s3), lo23 = fminf(s2, s3);
    float m1 = fmaxf(hi01, hi23), m2 = fmaxf(fminf(hi01, hi23), fmaxf(lo01, lo23));
    { const float o1 = DPP_F(m1, 0xB1), o2 = DPP_F(m2, 0xB1); const float n1 = fmaxf(m1, o1); m2 = fmaxf(fminf(m1, o1), fmaxf(m2, o2)); m1 = n1; }
    { const float o1 = DPP_F(m1, 0x4E), o2 = DPP_F(m2, 0x4E); const float n1 = fmaxf(m1, o1); m2 = fmaxf(fminf(m1, o1), fmaxf(m2, o2)); m1 = n1; }
    { const float o1 = DPP_F(m1, 0x141), o2 = DPP_F(m2, 0x141); const float n1 = fmaxf(m1, o1); m2 = fmaxf(fminf(m1, o1), fmaxf(m2, o2)); m1 = n1; }
    const float gs = m1 + m2;
    const int g = lane >> 3;
    int rank = 0;
#pragma unroll
    for (int gg = 0; gg < 8; ++gg) { const float G = rdlane_f(gs, gg * 8); rank += ((G > gs) || (G == gs && gg < g)) ? 1 : 0; }
    if (rank >= 4) { s0 = -INFINITY; s1 = -INFINITY; s2 = -INFINITY; s3 = -INFINITY; }
    int my_e = 0; float my_a = 0.f;
#pragma unroll 1
    for (int it = 0; it < 8; ++it) {
      const float lm = fmaxf(fmaxf(s0, s1), fmaxf(s2, s3));
      const float wm = wave_max_fast(lm);
      const unsigned long long bal = __ballot(lm == wm);
      const int win = __ffsll((long long)bal) - 1;
      const int wi = (s0 == wm) ? 0 : ((s1 == wm) ? 1 : ((s2 == wm) ? 2 : 3));
      const float wa = (wi == 0) ? a4.x : ((wi == 1) ? a4.y : ((wi == 2) ? a4.z : a4.w));
      const int e_w = __builtin_amdgcn_readlane(lane * 4 + wi, win);
      const float a_w = rdlane_f(wa, win);
      if (lane == win) { if (wi == 0) s0 = -INFINITY; else if (wi == 1) s1 = -INFINITY; else if (wi == 2) s2 = -INFINITY; else s3 = -INFINITY; }
      if (lane == it) { my_e = e_w; my_a = a_w; }
    }
    const float asum = rdlane_f(dpp_sum16x(my_a), 0);
    if (lane < 8) {
      const int pos = atomicAdd(&counts[my_e], 1);
      if (pos < LCAP) LIST[(size_t)my_e * LCAP + pos] = lane * T_TOK + t;
      GATEW[(size_t)lane * T_TOK + t] = my_a * 2.5f / asum;
    }
  }
}

__device__ __forceinline__ int moe_group_setup(const int* counts, int* pre) {
  __syncthreads();
  if (threadIdx.x == 0) {
    const int g = XCD_GROUP;
    int acc = 0;
    for (int j = 0; j < 32; ++j) { pre[j] = acc; acc += (min(counts[g + 8 * j], LCAP) + 127) >> 7; }
    pre[32] = acc; acc += 32;
    pre[33] = acc;
  }
  __syncthreads();
  return pre[33];
}
__device__ __forceinline__ void phase_moe(const Params& p, char* smem) {
  int* asg = (int*)(smem + 65536); int* pre = asg + 128;
  const bf16_t* __restrict__ X1B = (const bf16_t*)(p.ws + OFF_X1B);
  const bf16_t* __restrict__ EW1 = (const bf16_t*)(p.ws + OFF_EW1); const bf16_t* __restrict__ EW2 = (const bf16_t*)(p.ws + OFF_EW2);
  const int* __restrict__ LIST = (const int*)(p.ws + OFF_LIST);
  const float* __restrict__ GATEW = (const float*)(p.ws + OFF_GATEW);
  const int* counts = (const int*)(p.ws + OFF_CTL);
  bf16_t* Y = (bf16_t*)(p.ws + OFF_Y);
  bf16_t* HS = (bf16_t*)(p.ws + OFF_HSCR) + (size_t)blockIdx.x * 128 * 256;
  float* X1 = p.out;
  const int nitems = moe_group_setup(counts, pre);
  for (int i = XCD_LB; i < nitems; i += XCD_NB) {
    int j = 0;
#pragma unroll 1
    for (int q = 1; q <= 32; ++q) j = (pre[q] <= i) ? q : j;
    const int w = i - pre[j];
    const int e = (j < 32) ? (XCD_GROUP + 8 * j) : NEXP;
    const int cnt = (j < 32) ? min(counts[e], LCAP) : T_TOK;
    const int r0 = (j < 32) ? w * 128 : (XCD_GROUP * 32 + w) * 128;
    __syncthreads();
    if (threadIdx.x < 128) {
      const int r = r0 + threadIdx.x;
      asg[threadIdx.x] = (r < cnt) ? ((e < NEXP) ? LIST[(size_t)e * LCAP + r] : (8 * T_TOK + r)) : -1;
    }
    __syncthreads();
    const bf16_t* __restrict__ W1 = EW1 + (size_t)e * 512 * 1024;
    const bf16_t* __restrict__ W2 = EW2 + (size_t)e * 1024 * 256;
    gemm128_glds_multi<4, 16>(smem,
            [=](int r) { int a = asg[r]; return X1B + (size_t)((a >= 0 ? a : 0) & (T_TOK - 1)) * DM; },
            [=](int r) { return W1 + (size_t)r * DM; }, (size_t)128 * DM,
            [=](int nt, f32x4 (&acc)[4][4], int wr, int wc, int fr, int fq) {
#pragma unroll
              for (int m = 0; m < 4; ++m) {
                const int row = wr * 64 + m * 16 + fr;
#pragma unroll
                for (int n = 0; n < 2; ++n) {
                  float hv[4];
#pragma unroll
                  for (int jj = 0; jj < 4; ++jj) { const float g = acc[m][n][jj], u = acc[m][n + 2][jj]; hv[jj] = g * sigmoidf_(g) * u; }
                  *(uint2*)(HS + (size_t)row * 256 + nt * 64 + wc * 32 + n * 16 + fq * 4) = pack4(hv[0], hv[1], hv[2], hv[3]);
                }
              }
            });
    __syncthreads();
    gemm128_glds_multi<8, 4>(smem,
            [=](int r) { return HS + (size_t)r * 256; },
            [=](int r) { return W2 + (size_t)r * 256; }, (size_t)128 * 256,
            [=](int nt, f32x4 (&acc)[4][4], int wr, int wc, int fr, int fq) {
#pragma unroll
              for (int m = 0; m < 4; ++m) {
                const int a = asg[wr * 64 + m * 16 + fr];
                if (a < 0) continue;
                if (a < 8 * T_TOK) {
                  const float gw = GATEW[a];
#pragma unroll
                  for (int n = 0; n < 4; ++n)
                    *(uint2*)(Y + (size_t)a * DM + nt * 128 + wc * 64 + n * 16 + fq * 4) =
                        pack4(acc[m][n][0] * gw, acc[m][n][1] * gw, acc[m][n][2] * gw, acc[m][n][3] * gw);
                } else {
                  const int t = a - 8 * T_TOK;
#pragma unroll
                  for (int n = 0; n < 4; ++n) {
                    float* xp = X1 + (size_t)t * DM + nt * 128 + wc * 64 + n * 16 + fq * 4;
                    const float4 xv = *(const float4*)xp;
                    *(float4*)xp = make_float4(ALPHA_F * xv.x + acc[m][n][0], ALPHA_F * xv.y + acc[m][n][1], ALPHA_F * xv.z + acc[m][n][2], ALPHA_F * xv.w + acc[m][n][3]);
                  }
                }
              }
            });
  }
}

__device__ __forceinline__ void phase_final(const Params& p, char* smem) {
  float* OUT = p.out;
  const bf16_t* __restrict__ Y = (const bf16_t*)(p.ws + OFF_Y);
  const float* __restrict__ g2 = p.in[24]; const float* __restrict__ b2 = p.in[25];
  const int lane = threadIdx.x & 63, wid = threadIdx.x >> 6;
  for (int t = blockIdx.x * 4 + wid; t < T_TOK; t += gridDim.x * 4) {
    const size_t base = (size_t)t * DM;
    float4 v[4];
    float s = 0.f;
#pragma unroll
    for (int u = 0; u < 4; ++u) {
      const int c = u * 256 + lane * 4;
      const float4 xv = *(const float4*)(OUT + base + c);
      float a0 = 0.f, a1 = 0.f, a2 = 0.f, a3 = 0.f;
#pragma unroll
      for (int sl = 0; sl < 8; ++sl) {
        const float4 yv = bf4_to_f4(*(const uint2*)(Y + ((size_t)sl * T_TOK + t) * DM + c));
        a0 += yv.x; a1 += yv.y; a2 += yv.z; a3 += yv.w;
      }
      v[u] = make_float4(xv.x + a0, xv.y + a1, xv.z + a2, xv.w + a3);
      s += (v[u].x + v[u].y) + (v[u].z + v[u].w);
    }
    const float mean = wave_sum_fast(s) * (1.f / DM);
    float q = 0.f;
#pragma unroll
    for (int u = 0; u < 4; ++u) {
      const float d0 = v[u].x - mean, d1 = v[u].y - mean, d2 = v[u].z - mean, d3 = v[u].w - mean;
      q += (d0 * d0 + d1 * d1) + (d2 * d2 + d3 * d3);
    }
    const float rs = rsqrtf(wave_sum_fast(q) * (1.f / DM) + LN_EPS_F);
#pragma unroll
    for (int u = 0; u < 4; ++u) {
      const int c = u * 256 + lane * 4;
      const float4 g = *(const float4*)(g2 + c), bb = *(const float4*)(b2 + c);
      *(float4*)(OUT + base + c) = make_float4((v[u].x - mean) * rs * g.x + bb.x, (v[u].y - mean) * rs * g.y + bb.y,
                                               (v[u].z - mean) * rs * g.z + bb.z, (v[u].w - mean) * rs * g.w + bb.w);
    }
  }
}

#define LAS __attribute__((address_space(3)))
#define XB_TMO      128
#define XB_XCNT(j)  (256  + 64 * (j))
#define XB_XSUB(j)  (1280 + 64 * (j))
#define XB_XGEN(j)  (2304 + 64 * (j))
#define XB_TOP      3328
#define XB_TOPGEN   3392
#define XCD_BAR_WORDS 3456
#define XB_SPIN_CAP (1u << 22)
__device__ __forceinline__ unsigned xb_ld(unsigned* p)              { return __hip_atomic_load(p, __ATOMIC_RELAXED, __HIP_MEMORY_SCOPE_AGENT); }
__device__ __forceinline__ unsigned xb_add(unsigned* p, unsigned v) { return __hip_atomic_fetch_add(p, v, __ATOMIC_RELAXED, __HIP_MEMORY_SCOPE_AGENT); }
__device__ __forceinline__ unsigned xb_xcc_id() { return (unsigned)__builtin_amdgcn_s_getreg((3 << 11) | 20) & 0xFu; }
#define XB_SPIN(cond, bar) do { unsigned _sp = 0; while (cond) { __builtin_amdgcn_s_sleep(1); \
    if ((++_sp & 255u) == 0u) { if (xb_ld(&(bar)[XB_TMO])) break; if (_sp > XB_SPIN_CAP) { atomicAdd(&(bar)[XB_TMO], 1u); break; } } } } while (0)
struct XcdBarrier { unsigned* bar; unsigned x; volatile LAS unsigned* st; };
__device__ __forceinline__ XcdBarrier xcd_barrier_post(unsigned* bar, volatile LAS unsigned* st) {
  XcdBarrier b; b.bar = bar; b.x = xb_xcc_id(); b.st = st;
  if (threadIdx.x == 0) (void)xb_add(&bar[XB_XCNT(b.x)], 1u);
  return b;
}
__device__ __forceinline__ void xcd_barrier_complete(unsigned* bar, unsigned x, unsigned& nloc, unsigned& nx) {
  const unsigned G = gridDim.x * gridDim.y * gridDim.z;
  unsigned sum, cnt, mine, sp = 0u;
  for (;;) {
    sum = 0u; cnt = 0u; mine = 0u;
#pragma unroll
    for (unsigned j = 0; j < 16; ++j) { const unsigned c = xb_ld(&bar[XB_XCNT(j)]); sum += c; cnt += (c > 0u) ? 1u : 0u; mine = (j == x) ? c : mine; }
    if (sum == G) break;
    __builtin_amdgcn_s_sleep(1);
    if ((++sp & 255u) == 0u) { if (xb_ld(&bar[XB_TMO])) break; if (sp > XB_SPIN_CAP) { atomicAdd(&bar[XB_TMO], 1u); break; } }
  }
  nloc = mine > 0u ? mine : 1u; nx = cnt > 0u ? cnt : 1u;
}
__device__ __forceinline__ void xcd_barrier(const XcdBarrier& b) {
  asm volatile("s_waitcnt vmcnt(0)" ::: "memory");
  __syncthreads();
  if (threadIdx.x == 0) {
    unsigned* bar = b.bar;
    __builtin_amdgcn_s_waitcnt(0);
    unsigned nloc = b.st[0], nx = b.st[1];
    if (nloc == 0u) { xcd_barrier_complete(bar, b.x, nloc, nx); b.st[0] = nloc; b.st[1] = nx; }
    const unsigned old = xb_add(&bar[XB_XSUB(b.x)], 1u);
    const unsigned gen = old / nloc;
    if (old + 1u == (gen + 1u) * nloc) {
      __builtin_amdgcn_fence(__ATOMIC_RELEASE, "agent");
      asm volatile("s_waitcnt vmcnt(0)" ::: "memory");
      const unsigned og = xb_add(&bar[XB_TOP], 1u);
      const unsigned tg = og / nx;
      if (og + 1u == (tg + 1u) * nx) xb_add(&bar[XB_TOPGEN], 1u);
      else XB_SPIN(xb_ld(&bar[XB_TOPGEN]) == tg, bar);
      __builtin_amdgcn_fence(__ATOMIC_ACQUIRE, "agent");
      xb_add(&bar[XB_XGEN(b.x)], 1u);
      asm volatile("s_waitcnt vmcnt(0)" ::: "memory");
    } else {
      XB_SPIN(xb_ld(&bar[XB_XGEN(b.x)]) == gen, bar);
      __builtin_amdgcn_fence(__ATOMIC_ACQUIRE, "agent");
      asm volatile("s_waitcnt vmcnt(0)" ::: "memory");
    }
  }
  __syncthreads();
}
#define CTL_BAR_WORD 4096
#define CTL_ZERO_BYTES 32768
#define LDS_BAR_OFF 66432

__global__ void __launch_bounds__(NTHR, 2) mega(Params p) {
  extern __shared__ __attribute__((aligned(16))) char smem[];
  cg::grid_group grid = cg::this_grid();
  volatile LAS unsigned* bst = (volatile LAS unsigned*)(LAS char*)(smem + LDS_BAR_OFF);
  if (threadIdx.x < 2) bst[threadIdx.x] = 0u;
  __syncthreads();
  const XcdBarrier bar = xcd_barrier_post((unsigned*)(p.ws + OFF_CTL) + CTL_BAR_WORD, bst);
  phase_rope(p);
  grid.sync();
  phase_inproj(p, smem);
  xcd_barrier(bar);
  phase_prep_a(p);
  xcd_barrier(bar);
  phase_prep(p, smem);
  xcd_barrier(bar);
  phase_scan(p, smem);
  phase_attn(p, smem);
  phase_convert(p, smem);
  xcd_barrier(bar);
  phase_post(p);
  xcd_barrier(bar);
  phase_outproj(p, smem);
  xcd_barrier(bar);
  phase_ln1(p);
  xcd_barrier(bar);
  phase_router_gemm(p, smem);
  xcd_barrier(bar);
  phase_topk(p);
  xcd_barrier(bar);
  phase_moe(p, smem);
  xcd_barrier(bar);
  phase_final(p, smem);
}

extern "C" void kernel_launch(void* const* d_in, const int* in_sizes, int n_in, void* d_out, int out_size, void* d_ws, size_t ws_size,
                              hipStream_t stream) {
  static int grid_blocks = 0;
  if (grid_blocks == 0) {
    if (ws_size < WS_NEED || n_in != 26) { fprintf(stderr, "kernel_launch: bad ws/n_in: %zu < %zu, n_in %d\n", ws_size, (size_t)WS_NEED, n_in); grid_blocks = -1; return; }
    int dev = 0, cus = 0, per_cu = 0;
    (void)hipGetDevice(&dev);
    (void)hipDeviceGetAttribute(&cus, hipDeviceAttributeMultiprocessorCount, dev);
    (void)hipFuncSetAttribute((const void*)mega, hipFuncAttributeMaxDynamicSharedMemorySize, LDS_BYTES);
    (void)hipOccupancyMaxActiveBlocksPerMultiprocessor(&per_cu, (const void*)mega, NTHR, LDS_BYTES);
    if (per_cu < 1) { fprintf(stderr, "kernel_launch: occupancy query returned %d\n", per_cu); grid_blocks = -1; return; }
    if (per_cu > 2) per_cu = 2;
    grid_blocks = cus * per_cu;
    if (grid_blocks > 512) grid_blocks = 512;
    fprintf(stderr, "kernel_launch: cus %d per_cu %d grid %d\n", cus, per_cu, grid_blocks);
  }
  if (grid_blocks < 0) return;
  if (hipMemsetAsync((char*)d_ws + OFF_CTL, 0, CTL_ZERO_BYTES, stream) != hipSuccess) { fprintf(stderr, "kernel_launch: memset failed\n"); return; }
  Params p{};
  for (int i = 0; i < 26; ++i) p.in[i] = (const float*)d_in[i];
  p.out = (float*)d_out;
  p.ws = (char*)d_ws;
  void* args[] = {&p};
  hipError_t e = hipLaunchCooperativeKernel((const void*)mega, dim3(grid_blocks), dim3(NTHR), args, LDS_BYTES, stream);
  if (e != hipSuccess) fprintf(stderr, "cooperative launch failed: %s (grid %d)\n", hipGetErrorString(e), grid_blocks);
}
```

```cpp
#include <hip/hip_runtime.h>
#include <hip/hip_bf16.h>
#include <hip/hip_cooperative_groups.h>
#include <stdint.h>
#include <stdio.h>

typedef unsigned short bf16_t;

#define T_TOK 32768
#define SEQ 4096
#define DM 1024
#define INW 3360
#define FEW 1824
#define NEXP 256
#define ALPHA_F 1.189207115002721f
#define LN_EPS_F 1e-5f
#define GN_EPS_F 64e-5f

__device__ __forceinline__ float bf2f(bf16_t v) { return __uint_as_float(((unsigned)v) << 16); }
__device__ __forceinline__ bf16_t f2bf(float f) { unsigned u = __float_as_uint(f); return (bf16_t)((u + 0x7fffu + ((u >> 16) & 1u)) >> 16); }
__device__ __forceinline__ float sigmoidf_(float x) { return 1.f / (1.f + __expf(-x)); }
__device__ __forceinline__ float wave_sum(float v) {
#pragma unroll
  for (int o = 32; o >= 1; o >>= 1) v += __shfl_xor(v, o, 64);
  return v;
}

constexpr size_t SZ_T512_BF = (size_t)T_TOK * 512 * 2;
constexpr size_t OFF_EW1 = 0;
constexpr size_t OFF_EW2 = OFF_EW1 + (size_t)257 * 512 * 1024 * 2;
constexpr size_t LBASE = OFF_EW2 + (size_t)257 * 1024 * 256 * 2;
constexpr size_t OFF_XB = 0;
constexpr size_t OFF_FEATS = OFF_XB + (size_t)T_TOK * 1024 * 2;
constexpr size_t OFF_ACT = OFF_FEATS + (size_t)T_TOK * FEW * 2;
constexpr size_t OFF_WINT = OFF_ACT + (size_t)T_TOK * 320 * 2;
constexpr size_t OFF_ROPE = OFF_WINT + (size_t)3456 * 1024 * 2;
static_assert(OFF_ROPE + (size_t)4096 * 32 * 2 * 4 <= LBASE, "early region E overlay");
constexpr size_t OFF_Q = LBASE;
constexpr size_t OFF_K = OFF_Q + SZ_T512_BF;
constexpr size_t OFF_V = OFF_K + SZ_T512_BF;
constexpr size_t OFF_R = OFF_V + SZ_T512_BF;
constexpr size_t OFF_K2 = OFF_R + SZ_T512_BF;
constexpr size_t OFF_V2 = OFF_K2 + SZ_T512_BF;
constexpr size_t OFF_A = OFF_V2 + SZ_T512_BF;
constexpr size_t OFF_B = OFF_A + SZ_T512_BF;
constexpr size_t OFF_W = OFF_B + SZ_T512_BF;
constexpr size_t OFF_G = OFF_W + (size_t)T_TOK * 512 * 4;
constexpr size_t OFF_SB = OFF_G + SZ_T512_BF;
constexpr size_t OFF_YS = OFF_SB + (size_t)T_TOK * 8 * 4;
constexpr size_t OFF_OP = OFF_YS + (size_t)T_TOK * 512 * 4;
constexpr size_t OFF_LSE = OFF_OP + 3 * SZ_T512_BF;
constexpr size_t OFF_MIXED = OFF_LSE + (size_t)3 * T_TOK * 8 * 4;
constexpr size_t OFF_WOUTT = OFF_MIXED + (size_t)T_TOK * 1024 * 2;
constexpr size_t EARLY_END = OFF_WOUTT + (size_t)1024 * 1024 * 2;
constexpr size_t OFF_Y = LBASE;
constexpr size_t OFF_XL = LBASE;
constexpr size_t OFF_AFF = LBASE + (size_t)T_TOK * 1024 * 2;
constexpr size_t OFF_X1B = OFF_Y + (size_t)8 * T_TOK * 1024 * 2;
#define LCAP 16384
constexpr size_t OFF_LIST = OFF_X1B + (size_t)T_TOK * 1024 * 2;
constexpr size_t OFF_GATEW = OFF_LIST + (size_t)NEXP * LCAP * 4;
constexpr size_t OFF_HSCR = OFF_GATEW + (size_t)8 * T_TOK * 4;
constexpr size_t OFF_CTL = OFF_HSCR + (size_t)512 * 128 * 256 * 2;
constexpr size_t CTL_BYTES = 1u << 20;
constexpr size_t WS_NEED = OFF_CTL + CTL_BYTES;
static_assert(EARLY_END <= OFF_HSCR, "early buffers must stay below the per-block scratch / control words");
static_assert(WS_NEED <= (size_t)1073741824, "workspace must fit 1 GiB");
#define CTL_CONVQ 512

typedef short bf16x8 __attribute__((ext_vector_type(8)));
typedef float f32x4 __attribute__((ext_vector_type(4)));
typedef float f32x16 __attribute__((ext_vector_type(16)));
typedef float f32x2_t __attribute__((ext_vector_type(2)));
typedef __bf16 bf16x2_t __attribute__((ext_vector_type(2)));
__device__ __forceinline__ unsigned cvtpk(float lo, float hi) { f32x2_t v = {lo, hi}; bf16x2_t b = __builtin_convertvector(v, bf16x2_t); return __builtin_bit_cast(unsigned, b); }

__device__ const double INVF[32] = {
1, 0.74989420933245587, 0.56234132519034907, 0.42169650342858223, 0.31622776601683794, 0.23713737056616552,
0.17782794100389229, 0.1333521432163324, 0.10000000000000001, 0.074989420933245579, 0.056234132519034911,
0.042169650342858224, 0.031622776601683791, 0.023713737056616554, 0.017782794100389229, 0.013335214321633241,
0.01, 0.0074989420933245579, 0.005623413251903491, 0.0042169650342858229, 0.0031622776601683794,
0.0023713737056616554, 0.0017782794100389228, 0.0013335214321633241, 0.001, 0.00074989420933245586,
0.0005623413251903491, 0.00042169650342858224, 0.00031622776601683794, 0.00023713737056616554,
0.00017782794100389227, 0.0001333521432163324};

namespace cg = cooperative_groups;

struct Params {
  const float* in[26];
  float* out;
  char* ws;
};

#define NTHR 256
#define LDS_BYTES 66560

__device__ __forceinline__ void phase_rope(const Params& p) {
  float* tab = (float*)(p.ws + OFF_ROPE);
  for (int i = blockIdx.x * NTHR + threadIdx.x; i < 4096 * 32; i += gridDim.x * NTHR) {
    int pos = i >> 5, f = i & 31;
    double ang = (double)pos * INVF[f];
    const double TWO_PI = 6.283185307179586476925286766559;
    double n = rint(ang / TWO_PI);
    double r = ang - n * TWO_PI;
    double r2 = r * r;
    double sn = r, cs = 1.0, ts = r, tc = 1.0;
#pragma unroll 1
    for (int k = 1; k <= 16; ++k) {
      tc = -tc * r2 / (double)((2 * k - 1) * (2 * k));
      ts = -ts * r2 / (double)((2 * k) * (2 * k + 1));
      cs += tc; sn += ts;
    }
    tab[i * 2] = (float)cs; tab[i * 2 + 1] = (float)sn;
  }
  {
    const float* __restrict__ w_in = p.in[1]; const float* __restrict__ w_out = p.in[13];
    uint4* wint = (uint4*)(p.ws + OFF_WINT); uint4* woutt = (uint4*)(p.ws + OFF_WOUTT);
    const int NJ1 = 3456 * 128, NJ2 = 1024 * 128;
    for (int i = blockIdx.x * NTHR + threadIdx.x; i < NJ1 + NJ2; i += gridDim.x * NTHR) {
      const bool second = i >= NJ1;
      const int q = second ? i - NJ1 : i;
      const int N = second ? 1024 : 3456, NV = second ? 1024 : INW;
      const int n = q % N, ko = q / N;
      const float* __restrict__ src = second ? w_out : w_in;
      float f[8];
#pragma unroll
      for (int u = 0; u < 8; ++u) f[u] = (n < NV) ? src[(size_t)(ko * 8 + u) * NV + n] : 0.f;
      uint4 w; w.x = cvtpk(f[0], f[1]); w.y = cvtpk(f[2], f[3]); w.z = cvtpk(f[4], f[5]); w.w = cvtpk(f[6], f[7]);
      (second ? woutt : wint)[(size_t)n * 128 + ko] = w;
    }
  }
  {
    const float4* __restrict__ x4 = (const float4*)p.in[0];
    uint4* xb = (uint4*)(p.ws + OFF_XB);
    for (size_t i = (size_t)blockIdx.x * NTHR + threadIdx.x; i < (size_t)T_TOK * DM / 8; i += (size_t)gridDim.x * NTHR) {
      float4 a = x4[2 * i], b = x4[2 * i + 1];
      uint4 w; w.x = cvtpk(a.x, a.y); w.y = cvtpk(a.z, a.w); w.z = cvtpk(b.x, b.y); w.w = cvtpk(b.z, b.w);
      xb[i] = w;
    }
  }
}

template <class AF, class BF>
__device__ __forceinline__ void gemm64_naive(float* As, float* Bs, float* Cs, int K, AF af, BF bf) {
  const int tid = threadIdx.x, tx = tid & 15, ty = tid >> 4;
  float acc[4][4];
#pragma unroll
  for (int i = 0; i < 4; ++i)
#pragma unroll
    for (int j = 0; j < 4; ++j) acc[i][j] = 0.f;
  for (int k0 = 0; k0 < K; k0 += 16) {
#pragma unroll
    for (int u = 0; u < 4; ++u) { int i = tid + u * 256; int r = i >> 4, kk = i & 15; As[kk * 68 + r] = af(r, k0 + kk); }
#pragma unroll
    for (int u = 0; u < 4; ++u) { int i = tid + u * 256; int kk = i >> 6, c = i & 63; Bs[kk * 68 + c] = bf(k0 + kk, c); }
    __syncthreads();
#pragma unroll
    for (int kk = 0; kk < 16; ++kk) {
      float a[4], b[4];
#pragma unroll
      for (int i = 0; i < 4; ++i) { a[i] = As[kk * 68 + ty * 4 + i]; b[i] = Bs[kk * 68 + tx * 4 + i]; }
#pragma unroll
      for (int i = 0; i < 4; ++i)
#pragma unroll
        for (int j = 0; j < 4; ++j) acc[i][j] += a[i] * b[j];
    }
    __syncthreads();
  }
#pragma unroll
  for (int i = 0; i < 4; ++i)
#pragma unroll
    for (int j = 0; j < 4; ++j) Cs[(ty * 4 + i) * 65 + tx * 4 + j] = acc[i][j];
  __syncthreads();
}


__device__ __forceinline__ int lds_off(int row, int chunk) { return row * 128 + ((chunk ^ ((row >> 1) & 7)) << 4); }

template <int BMODE>
__device__ __forceinline__ unsigned cvtpk_m(float a, float b, const bool lo = false) {
  if (BMODE == 0 || (BMODE == 2 && !lo)) return cvtpk(a, b);
  const unsigned h = cvtpk(a, b);
  const float ah = __uint_as_float(h << 16), bh = __uint_as_float(h & 0xffff0000u);
  return cvtpk(a - ah, b - bh);
}
#define G128_MMA(bufoff) { \
    _Pragma("unroll") for (int kk = 0; kk < 2; ++kk) { \
      bf16x8 af[4], bfr[4]; \
      _Pragma("unroll") for (int m = 0; m < 4; ++m) af[m] = *(const bf16x8*)(smem + (bufoff) + lds_off(wr * 64 + m * 16 + fr, kk * 4 + fq)); \
      _Pragma("unroll") for (int n = 0; n < 4; ++n) bfr[n] = *(const bf16x8*)(smem + (bufoff) + 16384 + lds_off(wc * 64 + n * 16 + fr, kk * 4 + fq)); \
      _Pragma("unroll") for (int m = 0; m < 4; ++m) \
        _Pragma("unroll") for (int n = 0; n < 4; ++n) acc[m][n] = __builtin_amdgcn_mfma_f32_16x16x32_bf16(bfr[n], af[m], acc[m][n], 0, 0, 0); \
    } }
template <int BMODE, bool KCLAMP, class ALoad, class BPtr>
__device__ __forceinline__ void gemm128_acc(f32x4 (&acc)[4][4], char* smem, const int nk, ALoad aload, BPtr bptr, const int ldb, const int kvalid) {
  const int tid = threadIdx.x, lane = tid & 63, wid = tid >> 6;
  const int wr = wid >> 1, wc = wid & 1, fr = lane & 15, fq = lane >> 4;
  const int achunk = tid & 7, arow0 = tid >> 3;
  const int nq = tid & 31, ko = tid >> 5;
  const float* bp0 = bptr(nq);
  const int oa0 = lds_off(arow0, achunk), oa1 = lds_off(arow0 + 32, achunk), oa2 = lds_off(arow0 + 64, achunk), oa3 = lds_off(arow0 + 96, achunk);
  const int ob0 = 16384 + lds_off(nq * 4 + 0, ko), ob1 = 16384 + lds_off(nq * 4 + 1, ko), ob2 = 16384 + lds_off(nq * 4 + 2, ko), ob3 = 16384 + lds_off(nq * 4 + 3, ko);
  uint4 ra0, ra1, ra2, ra3; float4 rb0, rb1, rb2, rb3, rb4, rb5, rb6, rb7;
#define G128_LOAD(kt) { \
    ra0 = aload(0, arow0, (kt) * 8 + achunk); ra1 = aload(1, arow0 + 32, (kt) * 8 + achunk); \
    ra2 = aload(2, arow0 + 64, (kt) * 8 + achunk); ra3 = aload(3, arow0 + 96, (kt) * 8 + achunk); \
    int kr_ = (kt) * 64 + ko * 8; \
    if (KCLAMP) kr_ = min(kr_, kvalid - 8);     \
    { \
      const float* b2_ = bp0 + (size_t)((BMODE == 2) ? (kr_ & 1023) : kr_) * ldb; \
      rb0 = *(const float4*)(b2_); rb1 = *(const float4*)(b2_ + (size_t)1 * ldb); rb2 = *(const float4*)(b2_ + (size_t)2 * ldb); \
      rb3 = *(const float4*)(b2_ + (size_t)3 * ldb); rb4 = *(const float4*)(b2_ + (size_t)4 * ldb); rb5 = *(const float4*)(b2_ + (size_t)5 * ldb); \
      rb6 = *(const float4*)(b2_ + (size_t)6 * ldb); rb7 = *(const float4*)(b2_ + (size_t)7 * ldb); \
    } }
#define G128_STORE(bufoff, lo_) { \
    char* const sb_ = smem + (bufoff); \
    *(uint4*)(sb_ + oa0) = ra0; *(uint4*)(sb_ + oa1) = ra1; *(uint4*)(sb_ + oa2) = ra2; *(uint4*)(sb_ + oa3) = ra3; \
    uint4 w; \
    w.x = cvtpk_m<BMODE>(rb0.x, rb1.x, lo_); w.y = cvtpk_m<BMODE>(rb2.x, rb3.x, lo_); w.z = cvtpk_m<BMODE>(rb4.x, rb5.x, lo_); w.w = cvtpk_m<BMODE>(rb6.x, rb7.x, lo_); \
    *(uint4*)(sb_ + ob0) = w; \
    w.x = cvtpk_m<BMODE>(rb0.y, rb1.y, lo_); w.y = cvtpk_m<BMODE>(rb2.y, rb3.y, lo_); w.z = cvtpk_m<BMODE>(rb4.y, rb5.y, lo_); w.w = cvtpk_m<BMODE>(rb6.y, rb7.y, lo_); \
    *(uint4*)(sb_ + ob1) = w; \
    w.x = cvtpk_m<BMODE>(rb0.z, rb1.z, lo_); w.y = cvtpk_m<BMODE>(rb2.z, rb3.z, lo_); w.z = cvtpk_m<BMODE>(rb4.z, rb5.z, lo_); w.w = cvtpk_m<BMODE>(rb6.z, rb7.z, lo_); \
    *(uint4*)(sb_ + ob2) = w; \
    w.x = cvtpk_m<BMODE>(rb0.w, rb1.w, lo_); w.y = cvtpk_m<BMODE>(rb2.w, rb3.w, lo_); w.z = cvtpk_m<BMODE>(rb4.w, rb5.w, lo_); w.w = cvtpk_m<BMODE>(rb6.w, rb7.w, lo_); \
    *(uint4*)(sb_ + ob3) = w; }
  G128_LOAD(0)
  G128_STORE(0, false)
  if (nk > 1) G128_LOAD(1)
  __syncthreads();
  for (int kt = 0; kt < nk; ++kt) {
    const int cur = (kt & 1) * 32768;
    __builtin_amdgcn_sched_barrier(0);
    G128_MMA(cur)
    __builtin_amdgcn_sched_barrier(0);
    if (kt + 1 < nk) {
      G128_STORE(cur ^ 32768, (kt + 1) >= kvalid)
      __builtin_amdgcn_sched_barrier(0);
      if (kt + 2 < nk) G128_LOAD(kt + 2)
    }
    __builtin_amdgcn_sched_barrier(0);
    __syncthreads();
  }
#undef G128_LOAD
#undef G128_STORE
}
__device__ __forceinline__ void acc_zero(f32x4 (&acc)[4][4]) {
#pragma unroll
  for (int m = 0; m < 4; ++m)
#pragma unroll
    for (int n = 0; n < 4; ++n) acc[m][n] = (f32x4){0.f, 0.f, 0.f, 0.f};
}
template <class ARow, class BPtr, class Epi>
__device__ __forceinline__ void gemm128(char* smem, const int K, ARow arow, BPtr bptr, const int ldb, Epi epi) {
  const int tid = threadIdx.x, lane = tid & 63, wid = tid >> 6;
  const int arow0 = tid >> 3;
  const bf16_t* ap0 = arow(arow0);
  const bf16_t* ap1 = arow(arow0 + 32);
  const bf16_t* ap2 = arow(arow0 + 64);
  const bf16_t* ap3 = arow(arow0 + 96);
  f32x4 acc[4][4];
  acc_zero(acc);
  gemm128_acc<0, false>(acc, smem, K >> 6,
      [=](int u, int, int kc) { const bf16_t* q = (u == 0) ? ap0 : (u == 1) ? ap1 : (u == 2) ? ap2 : ap3; return *(const uint4*)(q + kc * 8); },
      bptr, ldb, 0);
  epi(acc, wid >> 1, wid & 1, lane & 15, lane >> 4);
}


template <class ALoad, class BLoad>
__device__ __forceinline__ void gemm128_acc_bb(f32x4 (&acc)[4][4], char* smem, const int nk, ALoad aload, BLoad bload) {
  const int tid = threadIdx.x, lane = tid & 63, wid = tid >> 6;
  const int wr = wid >> 1, wc = wid & 1, fr = lane & 15, fq = lane >> 4;
  const int achunk = tid & 7, arow0 = tid >> 3;
  const int oa0 = lds_off(arow0, achunk), oa1 = lds_off(arow0 + 32, achunk), oa2 = lds_off(arow0 + 64, achunk), oa3 = lds_off(arow0 + 96, achunk);
  uint4 ra0, ra1, ra2, ra3, rb0, rb1, rb2, rb3;
#define G128_LOADBB(kt) { \
    ra0 = aload(0, arow0, (kt) * 8 + achunk); ra1 = aload(1, arow0 + 32, (kt) * 8 + achunk); \
    ra2 = aload(2, arow0 + 64, (kt) * 8 + achunk); ra3 = aload(3, arow0 + 96, (kt) * 8 + achunk); \
    rb0 = bload(0, arow0, (kt) * 8 + achunk); rb1 = bload(1, arow0 + 32, (kt) * 8 + achunk); \
    rb2 = bload(2, arow0 + 64, (kt) * 8 + achunk); rb3 = bload(3, arow0 + 96, (kt) * 8 + achunk); }
#define G128_STOREBB(bufoff) { \
    char* const sb_ = smem + (bufoff); \
    *(uint4*)(sb_ + oa0) = ra0; *(uint4*)(sb_ + oa1) = ra1; *(uint4*)(sb_ + oa2) = ra2; *(uint4*)(sb_ + oa3) = ra3; \
    *(uint4*)(sb_ + 16384 + oa0) = rb0; *(uint4*)(sb_ + 16384 + oa1) = rb1; *(uint4*)(sb_ + 16384 + oa2) = rb2; *(uint4*)(sb_ + 16384 + oa3) = rb3; }
  G128_LOADBB(0)
  G128_STOREBB(0)
  if (nk > 1) G128_LOADBB(1)
  __syncthreads();
  for (int kt = 0; kt < nk; ++kt) {
    const int cur = (kt & 1) * 32768;
    __builtin_amdgcn_sched_barrier(0);
    G128_MMA(cur)
    __builtin_amdgcn_sched_barrier(0);
    if (kt + 1 < nk) {
      G128_STOREBB(cur ^ 32768)
      __builtin_amdgcn_sched_barrier(0);
      if (kt + 2 < nk) G128_LOADBB(kt + 2)
    }
    __builtin_amdgcn_sched_barrier(0);
    __syncthreads();
  }
#undef G128_LOADBB
#undef G128_STOREBB
}
template <class ARow, class BRow, class Epi>
__device__ __forceinline__ void gemm128_bb(char* smem, const int K, ARow arow, BRow brow, Epi epi) {
  const int tid = threadIdx.x, lane = tid & 63, wid = tid >> 6;
  const int arow0 = tid >> 3;
  const bf16_t* ap0 = arow(arow0); const bf16_t* ap1 = arow(arow0 + 32); const bf16_t* ap2 = arow(arow0 + 64); const bf16_t* ap3 = arow(arow0 + 96);
  const bf16_t* bp0 = brow(arow0); const bf16_t* bp1 = brow(arow0 + 32); const bf16_t* bp2 = brow(arow0 + 64); const bf16_t* bp3 = brow(arow0 + 96);
  f32x4 acc[4][4];
  acc_zero(acc);
  gemm128_acc_bb(acc, smem, K >> 6,
      [=](int u, int, int kc) { const bf16_t* q = (u == 0) ? ap0 : (u == 1) ? ap1 : (u == 2) ? ap2 : ap3; return *(const uint4*)(q + kc * 8); },
      [=](int u, int, int kc) { const bf16_t* q = (u == 0) ? bp0 : (u == 1) ? bp1 : (u == 2) ? bp2 : bp3; return *(const uint4*)(q + kc * 8); });
  epi(acc, wid >> 1, wid & 1, lane & 15, lane >> 4);
}


#define GAS1 __attribute__((address_space(1)))
#define LAS3 __attribute__((address_space(3)))
__device__ __forceinline__ void glds16(const void* g, char* l) {
  __builtin_amdgcn_global_load_lds((const GAS1 void*)g, (LAS3 void*)l, 16, 0, 0);
}
template <class ARow, class BRow, class Epi>
__device__ __forceinline__ void gemm128_glds(char* smem, const int K, ARow arow, BRow brow, Epi epi) {
  const int tid = threadIdx.x, lane = tid & 63, wid = tid >> 6;
  const int wr = wid >> 1, wc = wid & 1, fr = lane & 15, fq = lane >> 4;
  const int r0 = tid >> 3;
  const int cl = (tid & 7) ^ ((tid >> 4) & 7);
  const bf16_t* ga0 = arow(r0) + cl * 8; const bf16_t* ga1 = arow(r0 + 32) + cl * 8; const bf16_t* ga2 = arow(r0 + 64) + cl * 8; const bf16_t* ga3 = arow(r0 + 96) + cl * 8;
  const bf16_t* gb0 = brow(r0) + cl * 8; const bf16_t* gb1 = brow(r0 + 32) + cl * 8; const bf16_t* gb2 = brow(r0 + 64) + cl * 8; const bf16_t* gb3 = brow(r0 + 96) + cl * 8;
  char* const lbase = smem + tid * 16;
#define GL_STAGE(bufoff, kt) { \
    char* const d_ = lbase + (bufoff); const int ko_ = (kt) * 64; \
    glds16(ga0 + ko_, d_); glds16(ga1 + ko_, d_ + 4096); glds16(ga2 + ko_, d_ + 8192); glds16(ga3 + ko_, d_ + 12288); \
    glds16(gb0 + ko_, d_ + 16384); glds16(gb1 + ko_, d_ + 20480); glds16(gb2 + ko_, d_ + 24576); glds16(gb3 + ko_, d_ + 28672); }
  f32x4 acc[4][4];
  acc_zero(acc);
  const int nk = K >> 6;
  GL_STAGE(0, 0)
  asm volatile("s_waitcnt vmcnt(0)" ::: "memory");
  __syncthreads();
  for (int kt = 0; kt < nk; ++kt) {
    const int cur = (kt & 1) * 32768;
    if (kt + 1 < nk) GL_STAGE(cur ^ 32768, kt + 1)
    G128_MMA(cur)
    asm volatile("s_waitcnt vmcnt(0)" ::: "memory");
    __syncthreads();
  }
#undef GL_STAGE
  epi(acc, wr, wc, fr, fq);
}


template <int NCALL, int NK, class ARow, class BRow, class Epi>
__device__ __forceinline__ void gemm128_glds_multi(char* smem, ARow arow, BRow brow, const size_t bstride, Epi epi) {
  const int tid = threadIdx.x, lane = tid & 63, wid = tid >> 6;
  const int wr = wid >> 1, wc = wid & 1, fr = lane & 15, fq = lane >> 4;
  const int r0 = tid >> 3;
  const int cl = (tid & 7) ^ ((tid >> 4) & 7);
  const bf16_t* ga0 = arow(r0) + cl * 8; const bf16_t* ga1 = arow(r0 + 32) + cl * 8; const bf16_t* ga2 = arow(r0 + 64) + cl * 8; const bf16_t* ga3 = arow(r0 + 96) + cl * 8;
  const bf16_t* gb0 = brow(r0) + cl * 8; const bf16_t* gb1 = brow(r0 + 32) + cl * 8; const bf16_t* gb2 = brow(r0 + 64) + cl * 8; const bf16_t* gb3 = brow(r0 + 96) + cl * 8;
  char* const lbase = smem + tid * 16;
#define GM_STAGE(bufoff, g) { \
    char* const d_ = lbase + (bufoff); const int ko_ = ((g) % NK) * 64; const size_t bo_ = (size_t)((g) / NK) * bstride + ko_; \
    glds16(ga0 + ko_, d_); glds16(ga1 + ko_, d_ + 4096); glds16(ga2 + ko_, d_ + 8192); glds16(ga3 + ko_, d_ + 12288); \
    glds16(gb0 + bo_, d_ + 16384); glds16(gb1 + bo_, d_ + 20480); glds16(gb2 + bo_, d_ + 24576); glds16(gb3 + bo_, d_ + 28672); }
  f32x4 acc[4][4];
  acc_zero(acc);
  constexpr int G = NCALL * NK;
  GM_STAGE(0, 0)
  asm volatile("s_waitcnt vmcnt(0)" ::: "memory");
  __syncthreads();
#pragma unroll 1
  for (int g = 0; g < G; ++g) {
    const int cur = (g & 1) * 32768;
    if (g + 1 < G) GM_STAGE(cur ^ 32768, g + 1)
    G128_MMA(cur)
    if ((g % NK) == NK - 1) {
      epi(g / NK, acc, wr, wc, fr, fq);
      acc_zero(acc);
    }
    asm volatile("s_waitcnt vmcnt(0)" ::: "memory");
    __syncthreads();
  }
#undef GM_STAGE
}

#define DPP_F(v, ctrl) __builtin_bit_cast(float, __builtin_amdgcn_update_dpp(0, __builtin_bit_cast(int, (v)), (ctrl), 0xF, 0xF, true))
__device__ __forceinline__ float rdlane_f(float v, int l) { return __builtin_bit_cast(float, __builtin_amdgcn_readlane(__builtin_bit_cast(int, v), l)); }
__device__ __forceinline__ float dpp_sum16x(float v) {
  v += DPP_F(v, 0xB1); v += DPP_F(v, 0x4E); v += DPP_F(v, 0x141); v += DPP_F(v, 0x140);
  return v;
}
__device__ __forceinline__ float dpp_max16x(float v) {
  v = fmaxf(v, DPP_F(v, 0xB1)); v = fmaxf(v, DPP_F(v, 0x4E)); v = fmaxf(v, DPP_F(v, 0x141)); v = fmaxf(v, DPP_F(v, 0x140));
  return v;
}
__device__ __forceinline__ float wave_sum_fast(float v) {
  v = dpp_sum16x(v);
  return (rdlane_f(v, 0) + rdlane_f(v, 16)) + (rdlane_f(v, 32) + rdlane_f(v, 48));
}
__device__ __forceinline__ float wave_max_fast(float v) {
  v = dpp_max16x(v);
  return fmaxf(fmaxf(rdlane_f(v, 0), rdlane_f(v, 16)), fmaxf(rdlane_f(v, 32), rdlane_f(v, 48)));
}
__device__ __forceinline__ float fast_tanh(float x) { const float e = __expf(2.f * x); return 1.f - 2.f / (e + 1.f); }


__device__ __forceinline__ float4 bf4_to_f4(uint2 u) {
  float4 r;
  r.x = __uint_as_float(u.x << 16); r.y = __uint_as_float(u.x & 0xffff0000u);
  r.z = __uint_as_float(u.y << 16); r.w = __uint_as_float(u.y & 0xffff0000u);
  return r;
}
__device__ __forceinline__ uint2 pack4(float a, float b, float c, float d) { uint2 r; r.x = cvtpk(a, b); r.y = cvtpk(c, d); return r; }
#define XCD_GROUP (blockIdx.x & 7)
#define XCD_LB (blockIdx.x >> 3)
#define XCD_NB ((gridDim.x + 7 - (blockIdx.x & 7)) >> 3)

__device__ __forceinline__ void phase_inproj(const Params& p, char* smem) {
  const bf16_t* __restrict__ XB = (const bf16_t*)(p.ws + OFF_XB);
  const bf16_t* __restrict__ WINT = (const bf16_t*)(p.ws + OFF_WINT);
  const float* __restrict__ rope = (const float*)(p.ws + OFF_ROPE);
  bf16_t* Q = (bf16_t*)(p.ws + OFF_Q); bf16_t* K = (bf16_t*)(p.ws + OFF_K); bf16_t* V = (bf16_t*)(p.ws + OFF_V);
  bf16_t* FE = (bf16_t*)(p.ws + OFF_FEATS);
  const int NT = 27, NITEM = (T_TOK / 128) * NT, CHUNK = NITEM / 8;
  for (int i = XCD_LB; i < CHUNK; i += XCD_NB) {
    const int item = XCD_GROUP * CHUNK + i;
    const int row0 = (item & 255) * 128, col0 = (item >> 8) * 128;
    gemm128_glds(smem, DM,
            [=](int r) { return XB + (size_t)(row0 + r) * DM; },
            [=](int r) { return WINT + (size_t)(col0 + r) * DM; },
            [=](f32x4 (&acc)[4][4], int wr, int wc, int fr, int fq) {
              const int cb = col0 + wc * 64;
              if (cb >= INW) return;
#pragma unroll
              for (int m = 0; m < 4; ++m) {
                const int t = row0 + wr * 64 + m * 16 + fr;
                if (cb < 1024) {
                  const int pos = t & (SEQ - 1);
                  bf16_t* dst = (cb < 512) ? (Q + (size_t)t * 512 + cb) : (K + (size_t)t * 512 + (cb - 512));
                  const float sc = (cb < 512) ? 0.125f : 1.f;
#pragma unroll
                  for (int n = 0; n < 2; ++n) {
                    const int f0 = n * 16 + fq * 4;
                    const float4 c01 = *(const float4*)(rope + (size_t)(pos * 32 + f0) * 2);
                    const float4 c23 = *(const float4*)(rope + (size_t)(pos * 32 + f0) * 2 + 4);
                    const float cs[4] = {c01.x, c01.z, c23.x, c23.z}, sn[4] = {c01.y, c01.w, c23.y, c23.w};
                    float o1[4], o2[4];
#pragma unroll
                    for (int j = 0; j < 4; ++j) {
                      const float z1 = acc[m][n][j], z2 = acc[m][n + 2][j];
                      o1[j] = (z1 * cs[j] - z2 * sn[j]) * sc; o2[j] = (z2 * cs[j] + z1 * sn[j]) * sc;
                    }
                    *(uint2*)(dst + f0) = pack4(o1[0], o1[1], o1[2], o1[3]);
                    *(uint2*)(dst + 32 + f0) = pack4(o2[0], o2[1], o2[2], o2[3]);
                  }
                } else if (cb < 1536) {
#pragma unroll
                  for (int n = 0; n < 4; ++n)
                    *(uint2*)(V + (size_t)t * 512 + (cb - 1024) + n * 16 + fq * 4) = pack4(acc[m][n][0], acc[m][n][1], acc[m][n][2], acc[m][n][3]);
                } else {
#pragma unroll
                  for (int n = 0; n < 4; ++n) {
                    const int c = cb + n * 16 + fq * 4;
                    if (c < INW) *(uint2*)(FE + (size_t)t * FEW + (c - 1536)) = pack4(acc[m][n][0], acc[m][n][1], acc[m][n][2], acc[m][n][3]);
                  }
                }
              }
            });
  }
}

__device__ __forceinline__ void phase_prep_a(const Params& p) {
  const bf16_t* __restrict__ FE = (const bf16_t*)(p.ws + OFF_FEATS);
  const float* __restrict__ mu = p.in[2];
  bf16_t* R = (bf16_t*)(p.ws + OFF_R); bf16_t* K2 = (bf16_t*)(p.ws + OFF_K2); bf16_t* V2 = (bf16_t*)(p.ws + OFF_V2);
  bf16_t* ACT = (bf16_t*)(p.ws + OFF_ACT);
  for (size_t i = (size_t)blockIdx.x * NTHR + threadIdx.x; i < (size_t)T_TOK * 232; i += (size_t)gridDim.x * NTHR) {
    const int t = (int)(i / 232), ch = (int)(i - (size_t)t * 232);
    if (ch >= 228) { *(uint4*)(ACT + (size_t)t * 320 + 288 + (ch - 228) * 8) = make_uint4(0u, 0u, 0u, 0u); continue; }
    const int col = ch * 8;
    const uint4 cu = *(const uint4*)(FE + (size_t)t * FEW + col);
    uint4 pv = make_uint4(0u, 0u, 0u, 0u);
    if ((t & (SEQ - 1)) != 0) pv = *(const uint4*)(FE + (size_t)(t - 1) * FEW + col);
    const float4 m0 = *(const float4*)(mu + col), m1 = *(const float4*)(mu + col + 4);
    const unsigned cw[4] = {cu.x, cu.y, cu.z, cu.w}, pw[4] = {pv.x, pv.y, pv.z, pv.w};
    const float mm[8] = {m0.x, m0.y, m0.z, m0.w, m1.x, m1.y, m1.z, m1.w};
    float f[8];
#pragma unroll
    for (int q = 0; q < 4; ++q) {
      const float c0 = __uint_as_float(cw[q] << 16), c1 = __uint_as_float(cw[q] & 0xffff0000u);
      const float p0 = __uint_as_float(pw[q] << 16), p1 = __uint_as_float(pw[q] & 0xffff0000u);
      f[2 * q] = c0 + (p0 - c0) * mm[2 * q];
      f[2 * q + 1] = c1 + (p1 - c1) * mm[2 * q + 1];
    }
    bf16_t* dst;
    if (col < 512) dst = R + (size_t)t * 512 + col;
    else if (col < 1024) dst = K2 + (size_t)t * 512 + (col - 512);
    else if (col < 1536) dst = V2 + (size_t)t * 512 + (col - 1024);
    else {
      dst = ACT + (size_t)t * 320 + (col - 1536);
      if (col < 1600) {
#pragma unroll
        for (int q = 0; q < 8; ++q) f[q] = fast_tanh(f[q]);
      } else if (col >= 1664) {
#pragma unroll
        for (int q = 0; q < 8; ++q) f[q] = sigmoidf_(f[q]);
      }
    }
    uint4 w; w.x = cvtpk(f[0], f[1]); w.y = cvtpk(f[2], f[3]); w.z = cvtpk(f[4], f[5]); w.w = cvtpk(f[6], f[7]);
    *(uint4*)dst = w;
  }
}

template <int PASS>
__device__ __forceinline__ void prep_item(const Params& p, char* smem, const int row0, const int col0) {
  const bf16_t* __restrict__ ACT = (const bf16_t*)(p.ws + OFF_ACT);
  constexpr int ACOL = PASS * 64;
  constexpr int NK = (PASS == 2) ? 3 : 1;
  const float* __restrict__ Wm = (PASS == 0) ? p.in[4] : (PASS == 1) ? p.in[6] : p.in[7];
  f32x4 acc[4][4];
  acc_zero(acc);
  gemm128_acc<0, (PASS == 2)>(acc, smem, NK,
      [=](int, int rowl, int kc) { return *(const uint4*)(ACT + (size_t)(row0 + rowl) * 320 + ACOL + kc * 8); },
      [=](int nq) { return Wm + col0 + nq * 4; }, 512, 160);
  const int tid = threadIdx.x, lane = tid & 63, wid = tid >> 6;
  const int wr = wid >> 1, wc = wid & 1, fr = lane & 15, fq = lane >> 4;
  const int cb = col0 + wc * 64;
  if (PASS == 0) {
    const float* __restrict__ w0 = p.in[3];
    float* W = (float*)(p.ws + OFF_W);
#pragma unroll
    for (int n = 0; n < 4; ++n) {
      const int c = cb + n * 16 + fq * 4;
      const float4 w04 = *(const float4*)(w0 + c);
      const float w0c[4] = {w04.x, w04.y, w04.z, w04.w};
#pragma unroll
      for (int m = 0; m < 4; ++m) {
        const int t = row0 + wr * 64 + m * 16 + fr;
        float d[4];
#pragma unroll
        for (int j = 0; j < 4; ++j) {
          const float nz = -(w0c[j] + acc[m][n][j]);
          const float sp = fmaxf(nz, 0.f) + __logf(1.f + __expf(-fabsf(nz)));
          d[j] = __expf(-__expf(-sp - 0.5f));
        }
        *(float4*)(W + (size_t)t * 512 + c) = make_float4(d[0], d[1], d[2], d[3]);
      }
    }
  } else if (PASS == 2) {
    bf16_t* G = (bf16_t*)(p.ws + OFF_G);
#pragma unroll
    for (int m = 0; m < 4; ++m) {
      const int t = row0 + wr * 64 + m * 16 + fr;
#pragma unroll
      for (int n = 0; n < 4; ++n)
        *(uint2*)(G + (size_t)t * 512 + cb + n * 16 + fq * 4) = pack4(acc[m][n][0], acc[m][n][1], acc[m][n][2], acc[m][n][3]);
    }
  } else {
    const float* __restrict__ a0 = p.in[5]; const float* __restrict__ k_k = p.in[8]; const float* __restrict__ k_a = p.in[9];
    const float* __restrict__ r_k = p.in[10];
    const bf16_t* __restrict__ R = (const bf16_t*)(p.ws + OFF_R); bf16_t* K2 = (bf16_t*)(p.ws + OFF_K2);
    bf16_t* A = (bf16_t*)(p.ws + OFF_A); bf16_t* B = (bf16_t*)(p.ws + OFF_B); float* SB = (float*)(p.ws + OFF_SB);
#pragma unroll
    for (int m = 0; m < 4; ++m) {
      __builtin_amdgcn_sched_barrier(0);
      const int t = row0 + wr * 64 + m * 16 + fr;
      float kk[4][4];
      float ssp = 0.f, sbp = 0.f;
#pragma unroll
      for (int n = 0; n < 4; ++n) {
        const int c = cb + n * 16 + fq * 4;
        const size_t o = (size_t)t * 512 + c;
        const float4 rr4 = bf4_to_f4(*(const uint2*)(R + o)), kx4 = bf4_to_f4(*(const uint2*)(K2 + o));
        const float rr[4] = {rr4.x, rr4.y, rr4.z, rr4.w}, kx[4] = {kx4.x, kx4.y, kx4.z, kx4.w};
        const float4 a04 = *(const float4*)(a0 + c), kk4 = *(const float4*)(k_k + c), ka4 = *(const float4*)(k_a + c), rk4 = *(const float4*)(r_k + c);
        const float a0c[4] = {a04.x, a04.y, a04.z, a04.w}, kkc[4] = {kk4.x, kk4.y, kk4.z, kk4.w}, kac[4] = {ka4.x, ka4.y, ka4.z, ka4.w};
        const float rkc[4] = {rk4.x, rk4.y, rk4.z, rk4.w};
        float k2[4];
#pragma unroll
        for (int j = 0; j < 4; ++j) {
          const float av = sigmoidf_(a0c[j] + acc[m][n][j]);
          acc[m][n][j] = av;
          kk[n][j] = kx[j] * kkc[j];
          k2[j] = kx[j] * (1.f + (av - 1.f) * kac[j]);
          ssp += kk[n][j] * kk[n][j];
          sbp += rr[j] * k2[j] * rkc[j];
        }
        *(uint2*)(K2 + o) = pack4(k2[0], k2[1], k2[2], k2[3]);
      }
      ssp += __shfl_xor(ssp, 16, 64); ssp += __shfl_xor(ssp, 32, 64);
      sbp += __shfl_xor(sbp, 16, 64); sbp += __shfl_xor(sbp, 32, 64);
      const float inv = 1.f / fmaxf(sqrtf(ssp), 1e-12f);
#pragma unroll
      for (int n = 0; n < 4; ++n) {
        const size_t o = (size_t)t * 512 + cb + n * 16 + fq * 4;
        *(uint2*)(A + o) = pack4(-kk[n][0] * inv, -kk[n][1] * inv, -kk[n][2] * inv, -kk[n][3] * inv);
        *(uint2*)(B + o) = pack4(kk[n][0] * inv * acc[m][n][0], kk[n][1] * inv * acc[m][n][1], kk[n][2] * inv * acc[m][n][2], kk[n][3] * inv * acc[m][n][3]);
      }
      if (fq == 0) SB[(size_t)t * 8 + (cb >> 6)] = sbp;
    }
  }
}
__device__ __forceinline__ void phase_prep(const Params& p, char* smem) {
  for (int item = blockIdx.x; item < (T_TOK / 128) * 12; item += gridDim.x) {
    const int mt = item / 12, sub = item - mt * 12, pass = sub >> 2, nt = sub & 3;
    if (pass == 0) prep_item<0>(p, smem, mt * 128, nt * 128);
    else if (pass == 1) prep_item<1>(p, smem, mt * 128, nt * 128);
    else prep_item<2>(p, smem, mt * 128, nt * 128);
  }
}

__device__ __forceinline__ float dpp_sum16(float v) {
  v += __builtin_bit_cast(float, __builtin_amdgcn_update_dpp(0, __builtin_bit_cast(int, v), 0xB1, 0xF, 0xF, true));
  v += __builtin_bit_cast(float, __builtin_amdgcn_update_dpp(0, __builtin_bit_cast(int, v), 0x4E, 0xF, 0xF, true));
  v += __builtin_bit_cast(float, __builtin_amdgcn_update_dpp(0, __builtin_bit_cast(int, v), 0x141, 0xF, 0xF, true));
  v += __builtin_bit_cast(float, __builtin_amdgcn_update_dpp(0, __builtin_bit_cast(int, v), 0x140, 0xF, 0xF, true));
  return v;
}
#define SC_CH 16
#define SC_ARR (SC_CH * 64 * 4)
#define SC_BUF (5 * SC_ARR + SC_CH * 16 * 4)
__device__ __forceinline__ void phase_scan(const Params& p, char* smem) {
  if (blockIdx.x >= 256) return;
  const bf16_t* __restrict__ R = (const bf16_t*)(p.ws + OFF_R); const bf16_t* __restrict__ K2 = (const bf16_t*)(p.ws + OFF_K2);
  const bf16_t* __restrict__ V2 = (const bf16_t*)(p.ws + OFF_V2); const bf16_t* __restrict__ A = (const bf16_t*)(p.ws + OFF_A);
  const bf16_t* __restrict__ B = (const bf16_t*)(p.ws + OFF_B); const float* __restrict__ W = (const float*)(p.ws + OFF_W);
  float* YS = (float*)(p.ws + OFF_YS);
  const int bh = blockIdx.x >> 2, rg = blockIdx.x & 3, b = bh >> 3, h = bh & 7;
  const int tid = threadIdx.x, lane = tid & 63, wid = tid >> 6, j = lane & 15, rq = lane >> 4;
  const int rowl = wid * 4 + rq;
  const int ls = tid >> 4, lc = tid & 15;
  const int vs = (tid >> 2) & 15, vq = tid & 3;
  const size_t tb = (size_t)b * SEQ;
  const size_t goff = (tb + ls) * 512 + h * 64 + lc * 4;
  const size_t voff = (tb + vs) * 512 + h * 64 + rg * 16 + vq * 4;
  uint2 ga, gb, gk, gr, gv; float4 gw;
  gv = make_uint2(0u, 0u);
  ga = *(const uint2*)(A + goff); gb = *(const uint2*)(B + goff); gk = *(const uint2*)(K2 + goff); gr = *(const uint2*)(R + goff);
  gw = *(const float4*)(W + goff);
  if (tid < 64) gv = *(const uint2*)(V2 + voff);
  {
    char* bf = smem;
    *(float4*)(bf + 0 * SC_ARR + ls * 256 + lc * 16) = bf4_to_f4(ga);
    *(float4*)(bf + 1 * SC_ARR + ls * 256 + lc * 16) = gw;
    *(float4*)(bf + 2 * SC_ARR + ls * 256 + lc * 16) = bf4_to_f4(gb);
    *(float4*)(bf + 3 * SC_ARR + ls * 256 + lc * 16) = bf4_to_f4(gk);
    *(float4*)(bf + 4 * SC_ARR + ls * 256 + lc * 16) = bf4_to_f4(gr);
    if (tid < 64) *(float4*)(bf + 5 * SC_ARR + vs * 64 + vq * 16) = bf4_to_f4(gv);
  }
  __syncthreads();
  float s0 = 0.f, s1 = 0.f, s2 = 0.f, s3 = 0.f;
  const int NCH = SEQ / SC_CH;
  for (int c = 0; c < NCH; ++c) {
    if (c + 1 < NCH) {
      const size_t o2 = goff + (size_t)(c + 1) * SC_CH * 512;
      ga = *(const uint2*)(A + o2); gb = *(const uint2*)(B + o2); gk = *(const uint2*)(K2 + o2); gr = *(const uint2*)(R + o2);
      gw = *(const float4*)(W + o2);
      if (tid < 64) gv = *(const uint2*)(V2 + voff + (size_t)(c + 1) * SC_CH * 512);
    }
    const char* bf = smem + (c & 1) * SC_BUF;
    float ykeep = 0.f;
#pragma unroll
    for (int s = 0; s < SC_CH; ++s) {
      const float4 a4 = *(const float4*)(bf + 0 * SC_ARR + s * 256 + j * 16);
      const float4 w4 = *(const float4*)(bf + 1 * SC_ARR + s * 256 + j * 16);
      const float4 b4 = *(const float4*)(bf + 2 * SC_ARR + s * 256 + j * 16);
      const float4 k4 = *(const float4*)(bf + 3 * SC_ARR + s * 256 + j * 16);
      const float4 r4 = *(const float4*)(bf + 4 * SC_ARR + s * 256 + j * 16);
      const float vv = *(const float*)(bf + 5 * SC_ARR + s * 64 + rowl * 4);
      float sa = (s0 * a4.x + s1 * a4.y) + (s2 * a4.z + s3 * a4.w);
      sa = dpp_sum16(sa);
      s0 = s0 * w4.x + (sa * b4.x + vv * k4.x);
      s1 = s1 * w4.y + (sa * b4.y + vv * k4.y);
      s2 = s2 * w4.z + (sa * b4.z + vv * k4.z);
      s3 = s3 * w4.w + (sa * b4.w + vv * k4.w);
      float y = (s0 * r4.x + s1 * r4.y) + (s2 * r4.z + s3 * r4.w);
      y = dpp_sum16(y);
      ykeep = (j == s) ? y : ykeep;
    }
    YS[(tb + (size_t)c * SC_CH + j) * 512 + h * 64 + rg * 16 + rowl] = ykeep;
    if (c + 1 < NCH) {
      char* bn = smem + ((c + 1) & 1) * SC_BUF;
      *(float4*)(bn + 0 * SC_ARR + ls * 256 + lc * 16) = bf4_to_f4(ga);
      *(float4*)(bn + 1 * SC_ARR + ls * 256 + lc * 16) = gw;
      *(float4*)(bn + 2 * SC_ARR + ls * 256 + lc * 16) = bf4_to_f4(gb);
      *(float4*)(bn + 3 * SC_ARR + ls * 256 + lc * 16) = bf4_to_f4(gk);
      *(float4*)(bn + 4 * SC_ARR + ls * 256 + lc * 16) = bf4_to_f4(gr);
      if (tid < 64) *(float4*)(bn + 5 * SC_ARR + vs * 64 + vq * 16) = bf4_to_f4(gv);
    }
    __syncthreads();
  }
}


#define CONV_TILES (257 * 96)
__device__ __forceinline__ void convert_tile(const Params& p, char* smem, const int ti) {
  const int e = ti / 96, q = ti - e * 96, part = q >> 5, w = q & 31;
  const float* src; int ldn, k0, n0; bf16_t* dst; int kdim;
  if (part < 2) {
    src = (e < NEXP) ? p.in[18 + part] + (size_t)e * DM * 256 : p.in[21 + part];
    ldn = 256; k0 = (w >> 1) * 64; n0 = (w & 1) * 128; kdim = 1024;
    dst = (bf16_t*)(p.ws + OFF_EW1) + (size_t)e * 512 * 1024;
  } else {
    src = (e < NEXP) ? p.in[20] + (size_t)e * 256 * DM : p.in[23];
    ldn = 1024; k0 = (w >> 3) * 64; n0 = (w & 7) * 128; kdim = 256;
    dst = (bf16_t*)(p.ws + OFF_EW2) + (size_t)e * 1024 * 256;
  }
  const int tid = threadIdx.x, nq = tid & 31, ko = tid >> 5;
  const float* bp = src + (size_t)(k0 + ko * 8) * ldn + n0 + nq * 4;
  const float4 rb0 = *(const float4*)(bp), rb1 = *(const float4*)(bp + (size_t)1 * ldn), rb2 = *(const float4*)(bp + (size_t)2 * ldn),
               rb3 = *(const float4*)(bp + (size_t)3 * ldn), rb4 = *(const float4*)(bp + (size_t)4 * ldn), rb5 = *(const float4*)(bp + (size_t)5 * ldn),
               rb6 = *(const float4*)(bp + (size_t)6 * ldn), rb7 = *(const float4*)(bp + (size_t)7 * ldn);
  {
    uint4 v;
    v.x = cvtpk(rb0.x, rb1.x); v.y = cvtpk(rb2.x, rb3.x); v.z = cvtpk(rb4.x, rb5.x); v.w = cvtpk(rb6.x, rb7.x); *(uint4*)(smem + lds_off(nq * 4 + 0, ko)) = v;
    v.x = cvtpk(rb0.y, rb1.y); v.y = cvtpk(rb2.y, rb3.y); v.z = cvtpk(rb4.y, rb5.y); v.w = cvtpk(rb6.y, rb7.y); *(uint4*)(smem + lds_off(nq * 4 + 1, ko)) = v;
    v.x = cvtpk(rb0.z, rb1.z); v.y = cvtpk(rb2.z, rb3.z); v.z = cvtpk(rb4.z, rb5.z); v.w = cvtpk(rb6.z, rb7.z); *(uint4*)(smem + lds_off(nq * 4 + 2, ko)) = v;
    v.x = cvtpk(rb0.w, rb1.w); v.y = cvtpk(rb2.w, rb3.w); v.z = cvtpk(rb4.w, rb5.w); v.w = cvtpk(rb6.w, rb7.w); *(uint4*)(smem + lds_off(nq * 4 + 3, ko)) = v;
  }
  __syncthreads();
#pragma unroll
  for (int u = 0; u < 4; ++u) {
    const int row = (tid >> 3) + 32 * u, chunk = tid & 7;
    const int c = n0 + row;
    int orow;
    if (part < 2) orow = (c >> 6) * 128 + ((c >> 5) & 1) * 64 + (part * 2 + ((c >> 4) & 1)) * 16 + (c & 15);
    else orow = c;
    *(uint4*)(dst + (size_t)orow * kdim + k0 + chunk * 8) = *(const uint4*)(smem + lds_off(row, chunk));
  }
  __syncthreads();
}
__device__ __forceinline__ void phase_convert(const Params& p, char* smem) {
  int* ctl = (int*)(p.ws + OFF_CTL);
  int* slot = (int*)(smem + 32768);
  __syncthreads();
  for (;;) {
    if (threadIdx.x == 0) *slot = atomicAdd(&ctl[CTL_CONVQ], 1);
    __syncthreads();
    const int ti = *slot;
    __syncthreads();
    if (ti >= CONV_TILES) break;
    convert_tile(p, smem, ti);
  }
}

__device__ __forceinline__ int vt_off(int d, int key) { const int swz = ((d >> 2) & 15) ^ ((d & 3) << 3); return d * 512 + (((key >> 2) ^ swz) << 3); }
__device__ __forceinline__ void phase_attn(const Params& p, char* smem) {
  const bf16_t* __restrict__ Q = (const bf16_t*)(p.ws + OFF_Q); const bf16_t* __restrict__ K = (const bf16_t*)(p.ws + OFF_K);
  const bf16_t* __restrict__ V = (const bf16_t*)(p.ws + OFF_V);
  bf16_t* OP = (bf16_t*)(p.ws + OFF_OP); float* LSE = (float*)(p.ws + OFF_LSE);
  char* Ks = smem; char* VT = smem + 32768; float* linv_s = (float*)(smem + 65536);
  const int tid = threadIdx.x, lane = tid & 63, wid = tid >> 6, l31 = lane & 31, hi = lane >> 5;
  for (int item = blockIdx.x; item < 6144; item += gridDim.x) {
    const int pp = item >> 11, rem = item & 2047, bh = rem >> 5, sub = rem & 31;
    const int dsh = pp * 2, nbsh = 5 - dsh;
    const int r = sub >> nbsh, n = sub & ((1 << nbsh) - 1);
    const int b = bh >> 3, h = bh & 7, tb = b * SEQ;
    __syncthreads();
#pragma unroll
    for (int u = 0; u < 8; ++u) {
      const int row = (tid >> 3) + 32 * u, chunk = tid & 7;
      int ik = n * 128 - 128 + row; ik = ik < 0 ? 0 : ik;
      const int tok = tb + (ik << dsh) + r;
      *(uint4*)(Ks + lds_off(row, chunk)) = *(const uint4*)(K + (size_t)tok * 512 + h * 64 + chunk * 8);
    }
#pragma unroll
    for (int ps = 0; ps < 2; ++ps) {
      const int dq = tid & 15, kbase = ps * 128 + (tid >> 4) * 8;
      uint2 v0, v1, v2, v3, v4, v5, v6, v7;
#define LDV(i, dst) { int ik = n * 128 - 128 + kbase + i; ik = ik < 0 ? 0 : ik; const int tok = tb + (ik << dsh) + r; dst = *(const uint2*)(V + (size_t)tok * 512 + h * 64 + dq * 4); }
      LDV(0, v0) LDV(1, v1) LDV(2, v2) LDV(3, v3) LDV(4, v4) LDV(5, v5) LDV(6, v6) LDV(7, v7)
#undef LDV
      {
        uint2 w;
        w.x = (v0.x & 0xffffu) | (v1.x << 16); w.y = (v2.x & 0xffffu) | (v3.x << 16);
        *(uint2*)(VT + vt_off(dq * 4 + 0, kbase)) = w;
        w.x = (v4.x & 0xffffu) | (v5.x << 16); w.y = (v6.x & 0xffffu) | (v7.x << 16);
        *(uint2*)(VT + vt_off(dq * 4 + 0, kbase + 4)) = w;
        w.x = (v0.x >> 16) | (v1.x & 0xffff0000u); w.y = (v2.x >> 16) | (v3.x & 0xffff0000u);
        *(uint2*)(VT + vt_off(dq * 4 + 1, kbase)) = w;
        w.x = (v4.x >> 16) | (v5.x & 0xffff0000u); w.y = (v6.x >> 16) | (v7.x & 0xffff0000u);
        *(uint2*)(VT + vt_off(dq * 4 + 1, kbase + 4)) = w;
        w.x = (v0.y & 0xffffu) | (v1.y << 16); w.y = (v2.y & 0xffffu) | (v3.y << 16);
        *(uint2*)(VT + vt_off(dq * 4 + 2, kbase)) = w;
        w.x = (v4.y & 0xffffu) | (v5.y << 16); w.y = (v6.y & 0xffffu) | (v7.y << 16);
        *(uint2*)(VT + vt_off(dq * 4 + 2, kbase + 4)) = w;
        w.x = (v0.y >> 16) | (v1.y & 0xffff0000u); w.y = (v2.y >> 16) | (v3.y & 0xffff0000u);
        *(uint2*)(VT + vt_off(dq * 4 + 3, kbase)) = w;
        w.x = (v4.y >> 16) | (v5.y & 0xffff0000u); w.y = (v6.y >> 16) | (v7.y & 0xffff0000u);
        *(uint2*)(VT + vt_off(dq * 4 + 3, kbase + 4)) = w;
      }
    }
    __syncthreads();
    const int iq = n * 128 + wid * 32 + l31;
    const int tq = tb + (iq << dsh) + r;
    bf16x8 qf[4];
#pragma unroll
    for (int ks = 0; ks < 4; ++ks) qf[ks] = *(const bf16x8*)(Q + (size_t)tq * 512 + h * 64 + ks * 16 + hi * 8);
    f32x16 st[5];
#pragma unroll
    for (int kb = 0; kb < 5; ++kb) {
      st[kb] = (f32x16){0.f, 0.f, 0.f, 0.f, 0.f, 0.f, 0.f, 0.f, 0.f, 0.f, 0.f, 0.f, 0.f, 0.f, 0.f, 0.f};
#pragma unroll
      for (int ks = 0; ks < 4; ++ks) {
        const bf16x8 kf = *(const bf16x8*)(Ks + lds_off(32 * (wid + kb) + l31, 2 * ks + hi));
        st[kb] = __builtin_amdgcn_mfma_f32_32x32x16_bf16(kf, qf[ks], st[kb], 0, 0, 0);
      }
    }
    float m = -INFINITY;
#pragma unroll
    for (int kb = 0; kb < 5; ++kb)
#pragma unroll
      for (int i = 0; i < 16; ++i) {
        const int kirel = 32 * kb + (i & 3) + 8 * (i >> 2) + 4 * hi;
        const bool valid = (kirel >= l31) && (kirel <= l31 + 128) && (n > 0 || (32 * wid + kirel) >= 128);
        const float s = valid ? st[kb][i] : -INFINITY;
        st[kb][i] = s;
        m = fmaxf(m, s);
      }
    m = fmaxf(m, __shfl_xor(m, 32, 64));
    float l = 0.f;
#pragma unroll
    for (int kb = 0; kb < 5; ++kb)
#pragma unroll
      for (int i = 0; i < 16; ++i) { const float pe = __expf(st[kb][i] - m); st[kb][i] = pe; l += pe; }
    l += __shfl_xor(l, 32, 64);
    f32x16 o0 = (f32x16){0.f, 0.f, 0.f, 0.f, 0.f, 0.f, 0.f, 0.f, 0.f, 0.f, 0.f, 0.f, 0.f, 0.f, 0.f, 0.f};
    f32x16 o1 = o0;
#pragma unroll
    for (int kb = 0; kb < 5; ++kb)
#pragma unroll
      for (int s = 0; s < 2; ++s) {
        union { unsigned u[4]; bf16x8 v; } pa;
        pa.u[0] = cvtpk(st[kb][8 * s + 0], st[kb][8 * s + 1]); pa.u[1] = cvtpk(st[kb][8 * s + 2], st[kb][8 * s + 3]);
        pa.u[2] = cvtpk(st[kb][8 * s + 4], st[kb][8 * s + 5]); pa.u[3] = cvtpk(st[kb][8 * s + 6], st[kb][8 * s + 7]);
        const int key0 = 32 * (wid + kb) + 16 * s + 4 * hi;
        {
          union { uint2 u[2]; bf16x8 v; } vb;
          vb.u[0] = *(const uint2*)(VT + vt_off(l31, key0)); vb.u[1] = *(const uint2*)(VT + vt_off(l31, key0 + 8));
          o0 = __builtin_amdgcn_mfma_f32_32x32x16_bf16(pa.v, vb.v, o0, 0, 0, 0);
        }
        {
          union { uint2 u[2]; bf16x8 v; } vb;
          vb.u[0] = *(const uint2*)(VT + vt_off(32 + l31, key0)); vb.u[1] = *(const uint2*)(VT + vt_off(32 + l31, key0 + 8));
          o1 = __builtin_amdgcn_mfma_f32_32x32x16_bf16(pa.v, vb.v, o1, 0, 0, 0);
        }
      }
    if (hi == 0) {
      linv_s[wid * 32 + l31] = 1.f / l;
      LSE[((size_t)pp * T_TOK + tq) * 8 + h] = m + __logf(l);
    }
#pragma unroll
    for (int i = 0; i < 16; ++i) {
      const int qrel = (i & 3) + 8 * (i >> 2) + 4 * hi;
      const int iq2 = n * 128 + wid * 32 + qrel;
      const int tq2 = tb + (iq2 << dsh) + r;
      const float li = linv_s[wid * 32 + qrel];
      bf16_t* op = OP + ((size_t)pp * T_TOK + tq2) * 512 + h * 64 + l31;
      op[0] = f2bf(o0[i] * li);
      op[32] = f2bf(o1[i] * li);
    }
  }
}

__device__ __forceinline__ void unpack8(const uint4 u, float (&f)[8]) {
  f[0] = __uint_as_float(u.x << 16); f[1] = __uint_as_float(u.x & 0xffff0000u); f[2] = __uint_as_float(u.y << 16); f[3] = __uint_as_float(u.y & 0xffff0000u);
  f[4] = __uint_as_float(u.z << 16); f[5] = __uint_as_float(u.z & 0xffff0000u); f[6] = __uint_as_float(u.w << 16); f[7] = __uint_as_float(u.w & 0xffff0000u);
}
__device__ __forceinline__ float dpp_sum8(float v) {
  v += DPP_F(v, 0xB1); v += DPP_F(v, 0x4E); v += DPP_F(v, 0x141);
  return v;
}
__device__ __forceinline__ void phase_post(const Params& p) {
  const float* __restrict__ YS = (const float*)(p.ws + OFF_YS); const bf16_t* __restrict__ V2 = (const bf16_t*)(p.ws + OFF_V2);
  const bf16_t* __restrict__ G = (const bf16_t*)(p.ws + OFF_G); const float* __restrict__ SB = (const float*)(p.ws + OFF_SB);
  const bf16_t* __restrict__ OP = (const bf16_t*)(p.ws + OFF_OP); const float* __restrict__ LSE = (const float*)(p.ws + OFF_LSE);
  const float* __restrict__ lnx_g = p.in[11]; const float* __restrict__ lnx_b = p.in[12];
  bf16_t* MIXED = (bf16_t*)(p.ws + OFF_MIXED);
  const int lane = threadIdx.x & 63, wid = threadIdx.x >> 6;
  const int c = lane * 8, hh = lane >> 3;
  const float4 g0 = *(const float4*)(lnx_g + c), g1 = *(const float4*)(lnx_g + c + 4), b0 = *(const float4*)(lnx_b + c), b1 = *(const float4*)(lnx_b + c + 4);
  const float gg[8] = {g0.x, g0.y, g0.z, g0.w, g1.x, g1.y, g1.z, g1.w}, bb[8] = {b0.x, b0.y, b0.z, b0.w, b1.x, b1.y, b1.z, b1.w};
  for (int t = blockIdx.x * 4 + wid; t < T_TOK; t += gridDim.x * 4) {
    const size_t o = (size_t)t * 512 + c;
    const float4 y0 = *(const float4*)(YS + o), y1 = *(const float4*)(YS + o + 4);
    const float y[8] = {y0.x, y0.y, y0.z, y0.w, y1.x, y1.y, y1.z, y1.w};
    float s = 0.f;
#pragma unroll
    for (int i = 0; i < 8; ++i) s += y[i];
    const float mean = dpp_sum8(s) * (1.f / 64.f);
    float q = 0.f;
#pragma unroll
    for (int i = 0; i < 8; ++i) { const float d = y[i] - mean; q += d * d; }
    const float rs = rsqrtf(dpp_sum8(q) * (1.f / 64.f) + GN_EPS_F);
    float v2[8], gt[8];
    unpack8(*(const uint4*)(V2 + o), v2); unpack8(*(const uint4*)(G + o), gt);
    const float sb = SB[(size_t)t * 8 + hh];
    float res[8];
#pragma unroll
    for (int i = 0; i < 8; ++i) res[i] = ((y[i] - mean) * rs * gg[i] + bb[i] + sb * v2[i]) * gt[i];
    uint4 w; w.x = cvtpk(res[0], res[1]); w.y = cvtpk(res[2], res[3]); w.z = cvtpk(res[4], res[5]); w.w = cvtpk(res[6], res[7]);
    *(uint4*)(MIXED + (size_t)t * 1024 + 512 + c) = w;
    const float l0 = LSE[((size_t)0 * T_TOK + t) * 8 + hh], l1 = LSE[((size_t)1 * T_TOK + t) * 8 + hh], l2 = LSE[((size_t)2 * T_TOK + t) * 8 + hh];
    const float mx = fmaxf(l0, fmaxf(l1, l2));
    float e0 = __expf(l0 - mx), e1 = __expf(l1 - mx), e2 = __expf(l2 - mx);
    const float inv = 1.f / (e0 + e1 + e2);
    e0 *= inv; e1 *= inv; e2 *= inv;
    float o0[8], o1[8], o2[8];
    unpack8(*(const uint4*)(OP + (size_t)0 * T_TOK * 512 + o), o0); unpack8(*(const uint4*)(OP + (size_t)1 * T_TOK * 512 + o), o1);
    unpack8(*(const uint4*)(OP + (size_t)2 * T_TOK * 512 + o), o2);
    float av[8];
#pragma unroll
    for (int i = 0; i < 8; ++i) av[i] = e0 * o0[i] + e1 * o1[i] + e2 * o2[i];
    w.x = cvtpk(av[0], av[1]); w.y = cvtpk(av[2], av[3]); w.z = cvtpk(av[4], av[5]); w.w = cvtpk(av[6], av[7]);
    *(uint4*)(MIXED + (size_t)t * 1024 + c) = w;
  }
}

__device__ __forceinline__ void phase_outproj(const Params& p, char* smem) {
  const bf16_t* __restrict__ MIXED = (const bf16_t*)(p.ws + OFF_MIXED);
  const bf16_t* __restrict__ WOUTT = (const bf16_t*)(p.ws + OFF_WOUTT); const float* __restrict__ x = p.in[0];
  float* U = p.out;
  for (int i = XCD_LB; i < T_TOK / 128; i += XCD_NB) {
    const int row0 = i * 128, col0 = XCD_GROUP * 128;
    gemm128_glds(smem, DM,
            [=](int r) { return MIXED + (size_t)(row0 + r) * DM; },
            [=](int r) { return WOUTT + (size_t)(col0 + r) * DM; },
            [=](f32x4 (&acc)[4][4], int wr, int wc, int fr, int fq) {
#pragma unroll
              for (int m = 0; m < 4; ++m) {
                const int t = row0 + wr * 64 + m * 16 + fr;
#pragma unroll
                for (int n = 0; n < 4; ++n) {
                  const size_t o = (size_t)t * DM + col0 + wc * 64 + n * 16 + fq * 4;
                  const float4 xv = *(const float4*)(x + o);
                  *(float4*)(U + o) = make_float4(ALPHA_F * xv.x + acc[m][n][0], ALPHA_F * xv.y + acc[m][n][1], ALPHA_F * xv.z + acc[m][n][2], ALPHA_F * xv.w + acc[m][n][3]);
                }
              }
            });
  }
}

__device__ __forceinline__ void phase_ln1(const Params& p) {
  float* X1 = p.out;
  const float* __restrict__ g1 = p.in[14]; const float* __restrict__ b1 = p.in[15];
  bf16_t* X1B = (bf16_t*)(p.ws + OFF_X1B);
  const int lane = threadIdx.x & 63, wid = threadIdx.x >> 6;
  for (int t = blockIdx.x * 4 + wid; t < T_TOK; t += gridDim.x * 4) {
    const size_t base = (size_t)t * DM;
    float4 v[4];
    float s = 0.f;
#pragma unroll
    for (int u = 0; u < 4; ++u) { v[u] = *(const float4*)(X1 + base + u * 256 + lane * 4); s += (v[u].x + v[u].y) + (v[u].z + v[u].w); }
    const float mean = wave_sum_fast(s) * (1.f / DM);
    float q = 0.f;
#pragma unroll
    for (int u = 0; u < 4; ++u) {
      const float d0 = v[u].x - mean, d1 = v[u].y - mean, d2 = v[u].z - mean, d3 = v[u].w - mean;
      q += (d0 * d0 + d1 * d1) + (d2 * d2 + d3 * d3);
    }
    const float rs = rsqrtf(wave_sum_fast(q) * (1.f / DM) + LN_EPS_F);
#pragma unroll
    for (int u = 0; u < 4; ++u) {
      const int c = u * 256 + lane * 4;
      const float4 g = *(const float4*)(g1 + c), bb = *(const float4*)(b1 + c);
      float4 y;
      y.x = (v[u].x - mean) * rs * g.x + bb.x; y.y = (v[u].y - mean) * rs * g.y + bb.y;
      y.z = (v[u].z - mean) * rs * g.z + bb.z; y.w = (v[u].w - mean) * rs * g.w + bb.w;
      *(float4*)(X1 + base + c) = y;
      uint2 hi; hi.x = cvtpk(y.x, y.y); hi.y = cvtpk(y.z, y.w);
      *(uint2*)(X1B + base + c) = hi;
    }
  }
}

__device__ __forceinline__ void phase_router_gemm(const Params& p, char* smem) {
  const bf16_t* __restrict__ X1B = (const bf16_t*)(p.ws + OFF_X1B);
  const float* __restrict__ router_w = p.in[16];
  float* AFF = (float*)(p.ws + OFF_AFF);
  for (int item = blockIdx.x; item < (T_TOK / 128) * 2; item += gridDim.x) {
    const int row0 = (item >> 1) * 128, col0 = (item & 1) * 128;
    f32x4 acc[4][4];
    acc_zero(acc);
    gemm128_acc<2, false>(acc, smem, 32,
        [=](int, int rowl, int kc) { return *(const uint4*)(X1B + (size_t)(row0 + rowl) * DM + (kc & 127) * 8); },
        [=](int nq) { return router_w + col0 + nq * 4; }, NEXP, 16);
    const int tid = threadIdx.x, lane = tid & 63, wid = tid >> 6;
    const int wr = wid >> 1, wc = wid & 1, fr = lane & 15, fq = lane >> 4;
#pragma unroll
    for (int m = 0; m < 4; ++m) {
      const int t = row0 + wr * 64 + m * 16 + fr;
#pragma unroll
      for (int n = 0; n < 4; ++n)
        *(float4*)(AFF + (size_t)t * NEXP + col0 + wc * 64 + n * 16 + fq * 4) =
            make_float4(sigmoidf_(acc[m][n][0]), sigmoidf_(acc[m][n][1]), sigmoidf_(acc[m][n][2]), sigmoidf_(acc[m][n][3]));
    }
  }
}

__device__ __forceinline__ void phase_topk(const Params& p) {
  const float* __restrict__ AFF = (const float*)(p.ws + OFF_AFF);
  const float* __restrict__ router_bias = p.in[17];
  int* LIST = (int*)(p.ws + OFF_LIST); float* GATEW = (float*)(p.ws + OFF_GATEW);
  int* counts = (int*)(p.ws + OFF_CTL);
  const int lane = threadIdx.x & 63, wid = threadIdx.x >> 6;
  const float4 b4 = *(const float4*)(router_bias + lane * 4);
  for (int t = blockIdx.x * 4 + wid; t < T_TOK; t += gridDim.x * 4) {
    const float4 a4 = *(const float4*)(AFF + (size_t)t * NEXP + lane * 4);
    float s0 = a4.x + b4.x, s1 = a4.y + b4.y, s2 = a4.z + b4.z, s3 = a4.w + b4.w;
    const float hi01 = fmaxf(s0, s1), lo01 = fminf(s0, s1), hi23 = fmaxf(s2, s3), lo23 = fminf(s2, s3);
    float m1 = fmaxf(hi01, hi23), m2 = fmaxf(fminf(hi01, hi23), fmaxf(lo01, lo23));
    { const float o1 = DPP_F(m1, 0xB1), o2 = DPP_F(m2, 0xB1); const float n1 = fmaxf(m1, o1); m2 = fmaxf(fminf(m1, o1), fmaxf(m2, o2)); m1 = n1; }
    { const float o1 = DPP_F(m1, 0x4E), o2 = DPP_F(m2, 0x4E); const float n1 = fmaxf(m1, o1); m2 = fmaxf(fminf(m1, o1), fmaxf(m2, o2)); m1 = n1; }
    { const float o1 = DPP_F(m1, 0x141), o2 = DPP_F(m2, 0x141); const float n1 = fmaxf(m1, o1); m2 = fmaxf(fminf(m1, o1), fmaxf(m2, o2)); m1 = n1; }
    const float gs = m1 + m2;
    const int g = lane >> 3;
    int rank = 0;
#pragma unroll
    for (int gg = 0; gg < 8; ++gg) { const float G = rdlane_f(gs, gg * 8); rank += ((G > gs) || (G == gs && gg < g)) ? 1 : 0; }
    if (rank >= 4) { s0 = -INFINITY; s1 = -INFINITY; s2 = -INFINITY; s3 = -INFINITY; }
    int my_e = 0; float my_a = 0.f;
#pragma unroll 1
    for (int it = 0; it < 8; ++it) {
      const float lm = fmaxf(fmaxf(s0, s1), fmaxf(s2, s3));
      const float wm = wave_max_fast(lm);
      const unsigned long long bal = __ballot(lm == wm);
      const int win = __ffsll((long long)bal) - 1;
      const int wi = (s0 == wm) ? 0 : ((s1 == wm) ? 1 : ((s2 == wm) ? 2 : 3));
      const float wa = (wi == 0) ? a4.x : ((wi == 1) ? a4.y : ((wi == 2) ? a4.z : a4.w));
      const int e_w = __builtin_amdgcn_readlane(lane * 4 + wi, win);
      const float a_w = rdlane_f(wa, win);
      if (lane == win) { if (wi == 0) s0 = -INFINITY; else if (wi == 1) s1 = -INFINITY; else if (wi == 2) s2 = -INFINITY; else s3 = -INFINITY; }
      if (lane == it) { my_e = e_w; my_a = a_w; }
    }
    const float asum = rdlane_f(dpp_sum16x(my_a), 0);
    if (lane < 8) {
      const int pos = atomicAdd(&counts[my_e], 1);
      if (pos < LCAP) LIST[(size_t)my_e * LCAP + pos] = lane * T_TOK + t;
      GATEW[(size_t)lane * T_TOK + t] = my_a * 2.5f / asum;
    }
  }
}

__device__ __forceinline__ int moe_group_setup(const int* counts, int* pre) {
  __syncthreads();
  if (threadIdx.x == 0) {
    const int g = XCD_GROUP;
    int acc = 0;
    for (int j = 0; j < 32; ++j) { pre[j] = acc; acc += (min(counts[g + 8 * j], LCAP) + 127) >> 7; }
    pre[32] = acc; acc += 32;
    pre[33] = acc;
  }
  __syncthreads();
  return pre[33];
}
__device__ __forceinline__ void phase_moe(const Params& p, char* smem) {
  int* asg = (int*)(smem + 65536); int* pre = asg + 128;
  const bf16_t* __restrict__ X1B = (const bf16_t*)(p.ws + OFF_X1B);
  const bf16_t* __restrict__ EW1 = (const bf16_t*)(p.ws + OFF_EW1); const bf16_t* __restrict__ EW2 = (const bf16_t*)(p.ws + OFF_EW2);
  const int* __restrict__ LIST = (const int*)(p.ws + OFF_LIST);
  const float* __restrict__ GATEW = (const float*)(p.ws + OFF_GATEW);
  const int* counts = (const int*)(p.ws + OFF_CTL);
  bf16_t* Y = (bf16_t*)(p.ws + OFF_Y);
  bf16_t* HS = (bf16_t*)(p.ws + OFF_HSCR) + (size_t)blockIdx.x * 128 * 256;
  float* X1 = p.out;
  const int nitems = moe_group_setup(counts, pre);
  for (int i = XCD_LB; i < nitems; i += XCD_NB) {
    int j = 0;
#pragma unroll 1
    for (int q = 1; q <= 32; ++q) j = (pre[q] <= i) ? q : j;
    const int w = i - pre[j];
    const int e = (j < 32) ? (XCD_GROUP + 8 * j) : NEXP;
    const int cnt = (j < 32) ? min(counts[e], LCAP) : T_TOK;
    const int r0 = (j < 32) ? w * 128 : (XCD_GROUP * 32 + w) * 128;
    __syncthreads();
    if (threadIdx.x < 128) {
      const int r = r0 + threadIdx.x;
      asg[threadIdx.x] = (r < cnt) ? ((e < NEXP) ? LIST[(size_t)e * LCAP + r] : (8 * T_TOK + r)) : -1;
    }
    __syncthreads();
    const bf16_t* __restrict__ W1 = EW1 + (size_t)e * 512 * 1024;
    const bf16_t* __restrict__ W2 = EW2 + (size_t)e * 1024 * 256;
    gemm128_glds_multi<4, 16>(smem,
            [=](int r) { int a = asg[r]; return X1B + (size_t)((a >= 0 ? a : 0) & (T_TOK - 1)) * DM; },
            [=](int r) { return W1 + (size_t)r * DM; }, (size_t)128 * DM,
            [=](int nt, f32x4 (&acc)[4][4], int wr, int wc, int fr, int fq) {
#pragma unroll
              for (int m = 0; m < 4; ++m) {
                const int row = wr * 64 + m * 16 + fr;
#pragma unroll
                for (int n = 0; n < 2; ++n) {
                  float hv[4];
#pragma unroll
                  for (int jj = 0; jj < 4; ++jj) { const float g = acc[m][n][jj], u = acc[m][n + 2][jj]; hv[jj] = g * sigmoidf_(g) * u; }
                  *(uint2*)(HS + (size_t)row * 256 + nt * 64 + wc * 32 + n * 16 + fq * 4) = pack4(hv[0], hv[1], hv[2], hv[3]);
                }
              }
            });
    __syncthreads();
    gemm128_glds_multi<8, 4>(smem,
            [=](int r) { return HS + (size_t)r * 256; },
            [=](int r) { return W2 + (size_t)r * 256; }, (size_t)128 * 256,
            [=](int nt, f32x4 (&acc)[4][4], int wr, int wc, int fr, int fq) {
#pragma unroll
              for (int m = 0; m < 4; ++m) {
                const int a = asg[wr * 64 + m * 16 + fr];
                if (a < 0) continue;
                if (a < 8 * T_TOK) {
                  const float gw = GATEW[a];
#pragma unroll
                  for (int n = 0; n < 4; ++n)
                    *(uint2*)(Y + (size_t)a * DM + nt * 128 + wc * 64 + n * 16 + fq * 4) =
                        pack4(acc[m][n][0] * gw, acc[m][n][1] * gw, acc[m][n][2] * gw, acc[m][n][3] * gw);
                } else {
                  const int t = a - 8 * T_TOK;
#pragma unroll
                  for (int n = 0; n < 4; ++n) {
                    float* xp = X1 + (size_t)t * DM + nt * 128 + wc * 64 + n * 16 + fq * 4;
                    const float4 xv = *(const float4*)xp;
                    *(float4*)xp = make_float4(ALPHA_F * xv.x + acc[m][n][0], ALPHA_F * xv.y + acc[m][n][1], ALPHA_F * xv.z + acc[m][n][2], ALPHA_F * xv.w + acc[m][n][3]);
                  }
                }
              }
            });
  }
}

__device__ __forceinline__ void phase_final(const Params& p, char* smem) {
  float* OUT = p.out;
  const bf16_t* __restrict__ Y = (const bf16_t*)(p.ws + OFF_Y);
  const float* __restrict__ g2 = p.in[24]; const float* __restrict__ b2 = p.in[25];
  const int lane = threadIdx.x & 63, wid = threadIdx.x >> 6;
  for (int t = blockIdx.x * 4 + wid; t < T_TOK; t += gridDim.x * 4) {
    const size_t base = (size_t)t * DM;
    float4 v[4];
    float s = 0.f;
#pragma unroll
    for (int u = 0; u < 4; ++u) {
      const int c = u * 256 + lane * 4;
      const float4 xv = *(const float4*)(OUT + base + c);
      float a0 = 0.f, a1 = 0.f, a2 = 0.f, a3 = 0.f;
#pragma unroll
      for (int sl = 0; sl < 8; ++sl) {
        const float4 yv = bf4_to_f4(*(const uint2*)(Y + ((size_t)sl * T_TOK + t) * DM + c));
        a0 += yv.x; a1 += yv.y; a2 += yv.z; a3 += yv.w;
      }
      v[u] = make_float4(xv.x + a0, xv.y + a1, xv.z + a2, xv.w + a3);
      s += (v[u].x + v[u].y) + (v[u].z + v[u].w);
    }
    const float mean = wave_sum_fast(s) * (1.f / DM);
    float q = 0.f;
#pragma unroll
    for (int u = 0; u < 4; ++u) {
      const float d0 = v[u].x - mean, d1 = v[u].y - mean, d2 = v[u].z - mean, d3 = v[u].w - mean;
      q += (d0 * d0 + d1 * d1) + (d2 * d2 + d3 * d3);
    }
    const float rs = rsqrtf(wave_sum_fast(q) * (1.f / DM) + LN_EPS_F);
#pragma unroll
    for (int u = 0; u < 4; ++u) {
      const int c = u * 256 + lane * 4;
      const float4 g = *(const float4*)(g2 + c), bb = *(const float4*)(b2 + c);
      *(float4*)(OUT + base + c) = make_float4((v[u].x - mean) * rs * g.x + bb.x, (v[u].y - mean) * rs * g.y + bb.y,
                                               (v[u].z - mean) * rs * g.z + bb.z, (v[u].w - mean) * rs * g.w + bb.w);
    }
  }
}

#define LAS __attribute__((address_space(3)))
#define XB_TMO      128
#define XB_XCNT(j)  (256  + 64 * (j))
#define XB_XSUB(j)  (1280 + 64 * (j))
#define XB_XGEN(j)  (2304 + 64 * (j))
#define XB_TOP      3328
#define XB_TOPGEN   3392
#define XCD_BAR_WORDS 3456
#define XB_SPIN_CAP (1u << 22)
__device__ __forceinline__ unsigned xb_ld(unsigned* p)              { return __hip_atomic_load(p, __ATOMIC_RELAXED, __HIP_MEMORY_SCOPE_AGENT); }
__device__ __forceinline__ unsigned xb_add(unsigned* p, unsigned v) { return __hip_atomic_fetch_add(p, v, __ATOMIC_RELAXED, __HIP_MEMORY_SCOPE_AGENT); }
__device__ __forceinline__ unsigned xb_xcc_id() { return (unsigned)__builtin_amdgcn_s_getreg((3 << 11) | 20) & 0xFu; }
#define XB_SPIN(cond, bar) do { unsigned _sp = 0; while (cond) { __builtin_amdgcn_s_sleep(1); \
    if ((++_sp & 255u) == 0u) { if (xb_ld(&(bar)[XB_TMO])) break; if (_sp > XB_SPIN_CAP) { atomicAdd(&(bar)[XB_TMO], 1u); break; } } } } while (0)
struct XcdBarrier { unsigned* bar; unsigned x; volatile LAS unsigned* st; };
__device__ __forceinline__ XcdBarrier xcd_barrier_post(unsigned* bar, volatile LAS unsigned* st) {
  XcdBarrier b; b.bar = bar; b.x = xb_xcc_id(); b.st = st;
  if (threadIdx.x == 0) (void)xb_add(&bar[XB_XCNT(b.x)], 1u);
  return b;
}
__device__ __forceinline__ void xcd_barrier_complete(unsigned* bar, unsigned x, unsigned& nloc, unsigned& nx) {
  const unsigned G = gridDim.x * gridDim.y * gridDim.z;
  unsigned sum, cnt, mine, sp = 0u;
  for (;;) {
    sum = 0u; cnt = 0u; mine = 0u;
#pragma unroll
    for (unsigned j = 0; j < 16; ++j) { const unsigned c = xb_ld(&bar[XB_XCNT(j)]); sum += c; cnt += (c > 0u) ? 1u : 0u; mine = (j == x) ? c : mine; }
    if (sum == G) break;
    __builtin_amdgcn_s_sleep(1);
    if ((++sp & 255u) == 0u) { if (xb_ld(&bar[XB_TMO])) break; if (sp > XB_SPIN_CAP) { atomicAdd(&bar[XB_TMO], 1u); break; } }
  }
  nloc = mine > 0u ? mine : 1u; nx = cnt > 0u ? cnt : 1u;
}
__device__ __forceinline__ void xcd_barrier(const XcdBarrier& b) {
  asm volatile("s_waitcnt vmcnt(0)" ::: "memory");
  __syncthreads();
  if (threadIdx.x == 0) {
    unsigned* bar = b.bar;
    __builtin_amdgcn_s_waitcnt(0);
    unsigned nloc = b.st[0], nx = b.st[1];
    if (nloc == 0u) { xcd_barrier_complete(bar, b.x, nloc, nx); b.st[0] = nloc; b.st[1] = nx; }
    const unsigned old = xb_add(&bar[XB_XSUB(b.x)], 1u);
    const unsigned gen = old / nloc;
    if (old + 1u == (gen + 1u) * nloc) {
      __builtin_amdgcn_fence(__ATOMIC_RELEASE, "agent");
      asm volatile("s_waitcnt vmcnt(0)" ::: "memory");
      const unsigned og = xb_add(&bar[XB_TOP], 1u);
      const unsigned tg = og / nx;
      if (og + 1u == (tg + 1u) * nx) xb_add(&bar[XB_TOPGEN], 1u);
      else XB_SPIN(xb_ld(&bar[XB_TOPGEN]) == tg, bar);
      __builtin_amdgcn_fence(__ATOMIC_ACQUIRE, "agent");
      xb_add(&bar[XB_XGEN(b.x)], 1u);
      asm volatile("s_waitcnt vmcnt(0)" ::: "memory");
    } else {
      XB_SPIN(xb_ld(&bar[XB_XGEN(b.x)]) == gen, bar);
      __builtin_amdgcn_fence(__ATOMIC_ACQUIRE, "agent");
      asm volatile("s_waitcnt vmcnt(0)" ::: "memory");
    }
  }
  __syncthreads();
}
#define CTL_BAR_WORD 4096
#define CTL_ZERO_BYTES 32768
#define LDS_BAR_OFF 66432

__global__ void __launch_bounds__(NTHR, 2) mega(Params p) {
  extern __shared__ __attribute__((aligned(16))) char smem[];
  cg::grid_group grid = cg::this_grid();
  volatile LAS unsigned* bst = (volatile LAS unsigned*)(LAS char*)(smem + LDS_BAR_OFF);
  if (threadIdx.x < 2) bst[threadIdx.x] = 0u;
  __syncthreads();
  const XcdBarrier bar = xcd_barrier_post((unsigned*)(p.ws + OFF_CTL) + CTL_BAR_WORD, bst);
  phase_rope(p);
  if (p.ws == nullptr) grid.sync();
  xcd_barrier(bar);
  phase_inproj(p, smem);
  xcd_barrier(bar);
  phase_prep_a(p);
  xcd_barrier(bar);
  phase_prep(p, smem);
  xcd_barrier(bar);
  phase_scan(p, smem);
  phase_attn(p, smem);
  phase_convert(p, smem);
  xcd_barrier(bar);
  phase_post(p);
  xcd_barrier(bar);
  phase_outproj(p, smem);
  xcd_barrier(bar);
  phase_ln1(p);
  xcd_barrier(bar);
  phase_router_gemm(p, smem);
  xcd_barrier(bar);
  phase_topk(p);
  xcd_barrier(bar);
  phase_moe(p, smem);
  xcd_barrier(bar);
  phase_final(p, smem);
}

extern "C" void kernel_launch(void* const* d_in, const int* in_sizes, int n_in, void* d_out, int out_size, void* d_ws, size_t ws_size,
                              hipStream_t stream) {
  static int grid_blocks = 0;
  if (grid_blocks == 0) {
    if (ws_size < WS_NEED || n_in != 26) { fprintf(stderr, "kernel_launch: bad ws/n_in: %zu < %zu, n_in %d\n", ws_size, (size_t)WS_NEED, n_in); grid_blocks = -1; return; }
    int dev = 0, cus = 0, per_cu = 0;
    (void)hipGetDevice(&dev);
    (void)hipDeviceGetAttribute(&cus, hipDeviceAttributeMultiprocessorCount, dev);
    (void)hipFuncSetAttribute((const void*)mega, hipFuncAttributeMaxDynamicSharedMemorySize, LDS_BYTES);
    (void)hipOccupancyMaxActiveBlocksPerMultiprocessor(&per_cu, (const void*)mega, NTHR, LDS_BYTES);
    if (per_cu < 1) { fprintf(stderr, "kernel_launch: occupancy query returned %d\n", per_cu); grid_blocks = -1; return; }
    if (per_cu > 2) per_cu = 2;
    grid_blocks = cus * per_cu;
    if (grid_blocks > 512) grid_blocks = 512;
    fprintf(stderr, "kernel_launch: cus %d per_cu %d grid %d\n", cus, per_cu, grid_blocks);
  }
  if (grid_blocks < 0) return;
  if (hipMemsetAsync((char*)d_ws + OFF_CTL, 0, CTL_ZERO_BYTES, stream) != hipSuccess) { fprintf(stderr, "kernel_launch: memset failed\n"); return; }
  Params p{};
  for (int i = 0; i < 26; ++i) p.in[i] = (const float*)d_in[i];
  p.out = (float*)d_out;
  p.ws = (char*)d_ws;
  void* args[] = {&p};
  hipError_t e = hipLaunchCooperativeKernel((const void*)mega, dim3(grid_blocks), dim3(NTHR), args, LDS_BYTES, stream);
  if (e != hipSuccess) fprintf(stderr, "cooperative launch failed: %s (grid %d)\n", hipGetErrorString(e), grid_blocks);
}
```

```cpp
#include <hip/hip_runtime.h>
#include <hip/hip_bf16.h>
#include <hip/hip_cooperative_groups.h>
#include <stdint.h>
#include <stdio.h>

typedef unsigned short bf16_t;

#define T_TOK 32768
#define SEQ 4096
#define DM 1024
#define INW 3360
#define FEW 1824
#define NEXP 256
#define ALPHA_F 1.189207115002721f
#define LN_EPS_F 1e-5f
#define GN_EPS_F 64e-5f

__device__ __forceinline__ float bf2f(bf16_t v) { return __uint_as_float(((unsigned)v) << 16); }
__device__ __forceinline__ bf16_t f2bf(float f) { unsigned u = __float_as_uint(f); return (bf16_t)((u + 0x7fffu + ((u >> 16) & 1u)) >> 16); }
__device__ __forceinline__ float sigmoidf_(float x) { return 1.f / (1.f + __expf(-x)); }
__device__ __forceinline__ float wave_sum(float v) {
#pragma unroll
  for (int o = 32; o >= 1; o >>= 1) v += __shfl_xor(v, o, 64);
  return v;
}

constexpr size_t SZ_T512_BF = (size_t)T_TOK * 512 * 2;
constexpr size_t OFF_EW1 = 0;
constexpr size_t OFF_EW2 = OFF_EW1 + (size_t)257 * 512 * 1024 * 2;
constexpr size_t LBASE = OFF_EW2 + (size_t)257 * 1024 * 256 * 2;
constexpr size_t OFF_XB = 0;
constexpr size_t OFF_FEATS = OFF_XB + (size_t)T_TOK * 1024 * 2;
constexpr size_t OFF_ACT = OFF_FEATS + (size_t)T_TOK * FEW * 2;
constexpr size_t OFF_WINT = OFF_ACT + (size_t)T_TOK * 320 * 2;
constexpr size_t OFF_ROPE = OFF_WINT + (size_t)3456 * 1024 * 2;
static_assert(OFF_ROPE + (size_t)4096 * 32 * 2 * 4 <= LBASE, "early region E overlay");
constexpr size_t OFF_Q = LBASE;
constexpr size_t OFF_K = OFF_Q + SZ_T512_BF;
constexpr size_t OFF_V = OFF_K + SZ_T512_BF;
constexpr size_t OFF_R = OFF_V + SZ_T512_BF;
constexpr size_t OFF_K2 = OFF_R + SZ_T512_BF;
constexpr size_t OFF_V2 = OFF_K2 + SZ_T512_BF;
constexpr size_t OFF_A = OFF_V2 + SZ_T512_BF;
constexpr size_t OFF_B = OFF_A + SZ_T512_BF;
constexpr size_t OFF_W = OFF_B + SZ_T512_BF;
constexpr size_t OFF_G = OFF_W + (size_t)T_TOK * 512 * 4;
constexpr size_t OFF_SB = OFF_G + SZ_T512_BF;
constexpr size_t OFF_YS = OFF_SB + (size_t)T_TOK * 8 * 4;
constexpr size_t OFF_OP = OFF_YS + (size_t)T_TOK * 512 * 4;
constexpr size_t OFF_LSE = OFF_OP + 3 * SZ_T512_BF;
constexpr size_t OFF_MIXED = OFF_LSE + (size_t)3 * T_TOK * 8 * 4;
constexpr size_t OFF_WOUTT = OFF_MIXED + (size_t)T_TOK * 1024 * 2;
constexpr size_t EARLY_END = OFF_WOUTT + (size_t)1024 * 1024 * 2;
constexpr size_t OFF_Y = LBASE;
constexpr size_t OFF_XL = LBASE;
constexpr size_t OFF_AFF = LBASE + (size_t)T_TOK * 1024 * 2;
constexpr size_t OFF_X1B = OFF_Y + (size_t)8 * T_TOK * 1024 * 2;
#define LCAP 16384
constexpr size_t OFF_LIST = OFF_X1B + (size_t)T_TOK * 1024 * 2;
constexpr size_t OFF_GATEW = OFF_LIST + (size_t)NEXP * LCAP * 4;
constexpr size_t OFF_HSCR = OFF_GATEW + (size_t)8 * T_TOK * 4;
constexpr size_t OFF_CTL = OFF_HSCR + (size_t)512 * 128 * 256 * 2;
constexpr size_t CTL_BYTES = 1u << 20;
constexpr size_t WS_NEED = OFF_CTL + CTL_BYTES;
static_assert(EARLY_END <= OFF_HSCR, "early buffers must stay below the per-block scratch / control words");
static_assert(WS_NEED <= (size_t)1073741824, "workspace must fit 1 GiB");
#define CTL_CONVQ 512

typedef short bf16x8 __attribute__((ext_vector_type(8)));
typedef float f32x4 __attribute__((ext_vector_type(4)));
typedef float f32x16 __attribute__((ext_vector_type(16)));
typedef float f32x2_t __attribute__((ext_vector_type(2)));
typedef __bf16 bf16x2_t __attribute__((ext_vector_type(2)));
__device__ __forceinline__ unsigned cvtpk(float lo, float hi) { f32x2_t v = {lo, hi}; bf16x2_t b = __builtin_convertvector(v, bf16x2_t); return __builtin_bit_cast(unsigned, b); }

__device__ const double INVF[32] = {
1, 0.74989420933245587, 0.56234132519034907, 0.42169650342858223, 0.31622776601683794, 0.23713737056616552,
0.17782794100389229, 0.1333521432163324, 0.10000000000000001, 0.074989420933245579, 0.056234132519034911,
0.042169650342858224, 0.031622776601683791, 0.023713737056616554, 0.017782794100389229, 0.013335214321633241,
0.01, 0.0074989420933245579, 0.005623413251903491, 0.0042169650342858229, 0.0031622776601683794,
0.0023713737056616554, 0.0017782794100389228, 0.0013335214321633241, 0.001, 0.00074989420933245586,
0.0005623413251903491, 0.00042169650342858224, 0.00031622776601683794, 0.00023713737056616554,
0.00017782794100389227, 0.0001333521432163324};

namespace cg = cooperative_groups;

struct Params {
  const float* in[26];
  float* out;
  char* ws;
};

#define NTHR 256
#define LDS_BYTES 66560

__device__ __forceinline__ void phase_rope(const Params& p) {
  float* tab = (float*)(p.ws + OFF_ROPE);
  for (int i = blockIdx.x * NTHR + threadIdx.x; i < 4096 * 32; i += gridDim.x * NTHR) {
    int pos = i >> 5, f = i & 31;
    double ang = (double)pos * INVF[f];
    const double TWO_PI = 6.283185307179586476925286766559;
    double n = rint(ang / TWO_PI);
    double r = ang - n * TWO_PI;
    double r2 = r * r;
    double sn = r, cs = 1.0, ts = r, tc = 1.0;
#pragma unroll 1
    for (int k = 1; k <= 16; ++k) {
      tc = -tc * r2 / (double)((2 * k - 1) * (2 * k));
      ts = -ts * r2 / (double)((2 * k) * (2 * k + 1));
      cs += tc; sn += ts;
    }
    tab[i * 2] = (float)cs; tab[i * 2 + 1] = (float)sn;
  }
  {
    const float* __restrict__ w_in = p.in[1]; const float* __restrict__ w_out = p.in[13];
    uint4* wint = (uint4*)(p.ws + OFF_WINT); uint4* woutt = (uint4*)(p.ws + OFF_WOUTT);
    const int NJ1 = 3456 * 128, NJ2 = 1024 * 128;
    for (int i = blockIdx.x * NTHR + threadIdx.x; i < NJ1 + NJ2; i += gridDim.x * NTHR) {
      const bool second = i >= NJ1;
      const int q = second ? i - NJ1 : i;
      const int N = second ? 1024 : 3456, NV = second ? 1024 : INW;
      const int n = q % N, ko = q / N;
      const float* __restrict__ src = second ? w_out : w_in;
      float f[8];
#pragma unroll
      for (int u = 0; u < 8; ++u) f[u] = (n < NV) ? src[(size_t)(ko * 8 + u) * NV + n] : 0.f;
      uint4 w; w.x = cvtpk(f[0], f[1]); w.y = cvtpk(f[2], f[3]); w.z = cvtpk(f[4], f[5]); w.w = cvtpk(f[6], f[7]);
      (second ? woutt : wint)[(size_t)n * 128 + ko] = w;
    }
  }
  {
    const float4* __restrict__ x4 = (const float4*)p.in[0];
    uint4* xb = (uint4*)(p.ws + OFF_XB);
    for (size_t i = (size_t)blockIdx.x * NTHR + threadIdx.x; i < (size_t)T_TOK * DM / 8; i += (size_t)gridDim.x * NTHR) {
      float4 a = x4[2 * i], b = x4[2 * i + 1];
      uint4 w; w.x = cvtpk(a.x, a.y); w.y = cvtpk(a.z, a.w); w.z = cvtpk(b.x, b.y); w.w = cvtpk(b.z, b.w);
      xb[i] = w;
    }
  }
}

template <class AF, class BF>
__device__ __forceinline__ void gemm64_naive(float* As, float* Bs, float* Cs, int K, AF af, BF bf) {
  const int tid = threadIdx.x, tx = tid & 15, ty = tid >> 4;
  float acc[4][4];
#pragma unroll
  for (int i = 0; i < 4; ++i)
#pragma unroll
    for (int j = 0; j < 4; ++j) acc[i][j] = 0.f;
  for (int k0 = 0; k0 < K; k0 += 16) {
#pragma unroll
    for (int u = 0; u < 4; ++u) { int i = tid + u * 256; int r = i >> 4, kk = i & 15; As[kk * 68 + r] = af(r, k0 + kk); }
#pragma unroll
    for (int u = 0; u < 4; ++u) { int i = tid + u * 256; int kk = i >> 6, c = i & 63; Bs[kk * 68 + c] = bf(k0 + kk, c); }
    __syncthreads();
#pragma unroll
    for (int kk = 0; kk < 16; ++kk) {
      float a[4], b[4];
#pragma unroll
      for (int i = 0; i < 4; ++i) { a[i] = As[kk * 68 + ty * 4 + i]; b[i] = Bs[kk * 68 + tx * 4 + i]; }
#pragma unroll
      for (int i = 0; i < 4; ++i)
#pragma unroll
        for (int j = 0; j < 4; ++j) acc[i][j] += a[i] * b[j];
    }
    __syncthreads();
  }
#pragma unroll
  for (int i = 0; i < 4; ++i)
#pragma unroll
    for (int j = 0; j < 4; ++j) Cs[(ty * 4 + i) * 65 + tx * 4 + j] = acc[i][j];
  __syncthreads();
}


__device__ __forceinline__ int lds_off(int row, int chunk) { return row * 128 + ((chunk ^ ((row >> 1) & 7)) << 4); }

template <int BMODE>
__device__ __forceinline__ unsigned cvtpk_m(float a, float b, const bool lo = false) {
  if (BMODE == 0 || (BMODE == 2 && !lo)) return cvtpk(a, b);
  const unsigned h = cvtpk(a, b);
  const float ah = __uint_as_float(h << 16), bh = __uint_as_float(h & 0xffff0000u);
  return cvtpk(a - ah, b - bh);
}
#define G128_MMA(bufoff) { \
    _Pragma("unroll") for (int kk = 0; kk < 2; ++kk) { \
      bf16x8 af[4], bfr[4]; \
      _Pragma("unroll") for (int m = 0; m < 4; ++m) af[m] = *(const bf16x8*)(smem + (bufoff) + lds_off(wr * 64 + m * 16 + fr, kk * 4 + fq)); \
      _Pragma("unroll") for (int n = 0; n < 4; ++n) bfr[n] = *(const bf16x8*)(smem + (bufoff) + 16384 + lds_off(wc * 64 + n * 16 + fr, kk * 4 + fq)); \
      _Pragma("unroll") for (int m = 0; m < 4; ++m) \
        _Pragma("unroll") for (int n = 0; n < 4; ++n) acc[m][n] = __builtin_amdgcn_mfma_f32_16x16x32_bf16(bfr[n], af[m], acc[m][n], 0, 0, 0); \
    } }
template <int BMODE, bool KCLAMP, class ALoad, class BPtr>
__device__ __forceinline__ void gemm128_acc(f32x4 (&acc)[4][4], char* smem, const int nk, ALoad aload, BPtr bptr, const int ldb, const int kvalid) {
  const int tid = threadIdx.x, lane = tid & 63, wid = tid >> 6;
  const int wr = wid >> 1, wc = wid & 1, fr = lane & 15, fq = lane >> 4;
  const int achunk = tid & 7, arow0 = tid >> 3;
  const int nq = tid & 31, ko = tid >> 5;
  const float* bp0 = bptr(nq);
  const int oa0 = lds_off(arow0, achunk), oa1 = lds_off(arow0 + 32, achunk), oa2 = lds_off(arow0 + 64, achunk), oa3 = lds_off(arow0 + 96, achunk);
  const int ob0 = 16384 + lds_off(nq * 4 + 0, ko), ob1 = 16384 + lds_off(nq * 4 + 1, ko), ob2 = 16384 + lds_off(nq * 4 + 2, ko), ob3 = 16384 + lds_off(nq * 4 + 3, ko);
  uint4 ra0, ra1, ra2, ra3; float4 rb0, rb1, rb2, rb3, rb4, rb5, rb6, rb7;
#define G128_LOAD(kt) { \
    ra0 = aload(0, arow0, (kt) * 8 + achunk); ra1 = aload(1, arow0 + 32, (kt) * 8 + achunk); \
    ra2 = aload(2, arow0 + 64, (kt) * 8 + achunk); ra3 = aload(3, arow0 + 96, (kt) * 8 + achunk); \
    int kr_ = (kt) * 64 + ko * 8; \
    if (KCLAMP) kr_ = min(kr_, kvalid - 8);     \
    { \
      const float* b2_ = bp0 + (size_t)((BMODE == 2) ? (kr_ & 1023) : kr_) * ldb; \
      rb0 = *(const float4*)(b2_); rb1 = *(const float4*)(b2_ + (size_t)1 * ldb); rb2 = *(const float4*)(b2_ + (size_t)2 * ldb); \
      rb3 = *(const float4*)(b2_ + (size_t)3 * ldb); rb4 = *(const float4*)(b2_ + (size_t)4 * ldb); rb5 = *(const float4*)(b2_ + (size_t)5 * ldb); \
      rb6 = *(const float4*)(b2_ + (size_t)6 * ldb); rb7 = *(const float4*)(b2_ + (size_t)7 * ldb); \
    } }
#define G128_STORE(bufoff, lo_) { \
    char* const sb_ = smem + (bufoff); \
    *(uint4*)(sb_ + oa0) = ra0; *(uint4*)(sb_ + oa1) = ra1; *(uint4*)(sb_ + oa2) = ra2; *(uint4*)(sb_ + oa3) = ra3; \
    uint4 w; \
    w.x = cvtpk_m<BMODE>(rb0.x, rb1.x, lo_); w.y = cvtpk_m<BMODE>(rb2.x, rb3.x, lo_); w.z = cvtpk_m<BMODE>(rb4.x, rb5.x, lo_); w.w = cvtpk_m<BMODE>(rb6.x, rb7.x, lo_); \
    *(uint4*)(sb_ + ob0) = w; \
    w.x = cvtpk_m<BMODE>(rb0.y, rb1.y, lo_); w.y = cvtpk_m<BMODE>(rb2.y, rb3.y, lo_); w.z = cvtpk_m<BMODE>(rb4.y, rb5.y, lo_); w.w = cvtpk_m<BMODE>(rb6.y, rb7.y, lo_); \
    *(uint4*)(sb_ + ob1) = w; \
    w.x = cvtpk_m<BMODE>(rb0.z, rb1.z, lo_); w.y = cvtpk_m<BMODE>(rb2.z, rb3.z, lo_); w.z = cvtpk_m<BMODE>(rb4.z, rb5.z, lo_); w.w = cvtpk_m<BMODE>(rb6.z, rb7.z, lo_); \
    *(uint4*)(sb_ + ob2) = w; \
    w.x = cvtpk_m<BMODE>(rb0.w, rb1.w, lo_); w.y = cvtpk_m<BMODE>(rb2.w, rb3.w, lo_); w.z = cvtpk_m<BMODE>(rb4.w, rb5.w, lo_); w.w = cvtpk_m<BMODE>(rb6.w, rb7.w, lo_); \
    *(uint4*)(sb_ + ob3) = w; }
  G128_LOAD(0)
  G128_STORE(0, false)
  if (nk > 1) G128_LOAD(1)
  __syncthreads();
  for (int kt = 0; kt < nk; ++kt) {
    const int cur = (kt & 1) * 32768;
    __builtin_amdgcn_sched_barrier(0);
    G128_MMA(cur)
    __builtin_amdgcn_sched_barrier(0);
    if (kt + 1 < nk) {
      G128_STORE(cur ^ 32768, (kt + 1) >= kvalid)
      __builtin_amdgcn_sched_barrier(0);
      if (kt + 2 < nk) G128_LOAD(kt + 2)
    }
    __builtin_amdgcn_sched_barrier(0);
    __syncthreads();
  }
#undef G128_LOAD
#undef G128_STORE
}
__device__ __forceinline__ void acc_zero(f32x4 (&acc)[4][4]) {
#pragma unroll
  for (int m = 0; m < 4; ++m)
#pragma unroll
    for (int n = 0; n < 4; ++n) acc[m][n] = (f32x4){0.f, 0.f, 0.f, 0.f};
}
template <class ARow, class BPtr, class Epi>
__device__ __forceinline__ void gemm128(char* smem, const int K, ARow arow, BPtr bptr, const int ldb, Epi epi) {
  const int tid = threadIdx.x, lane = tid & 63, wid = tid >> 6;
  const int arow0 = tid >> 3;
  const bf16_t* ap0 = arow(arow0);
  const bf16_t* ap1 = arow(arow0 + 32);
  const bf16_t* ap2 = arow(arow0 + 64);
  const bf16_t* ap3 = arow(arow0 + 96);
  f32x4 acc[4][4];
  acc_zero(acc);
  gemm128_acc<0, false>(acc, smem, K >> 6,
      [=](int u, int, int kc) { const bf16_t* q = (u == 0) ? ap0 : (u == 1) ? ap1 : (u == 2) ? ap2 : ap3; return *(const uint4*)(q + kc * 8); },
      bptr, ldb, 0);
  epi(acc, wid >> 1, wid & 1, lane & 15, lane >> 4);
}


template <class ALoad, class BLoad>
__device__ __forceinline__ void gemm128_acc_bb(f32x4 (&acc)[4][4], char* smem, const int nk, ALoad aload, BLoad bload) {
  const int tid = threadIdx.x, lane = tid & 63, wid = tid >> 6;
  const int wr = wid >> 1, wc = wid & 1, fr = lane & 15, fq = lane >> 4;
  const int achunk = tid & 7, arow0 = tid >> 3;
  const int oa0 = lds_off(arow0, achunk), oa1 = lds_off(arow0 + 32, achunk), oa2 = lds_off(arow0 + 64, achunk), oa3 = lds_off(arow0 + 96, achunk);
  uint4 ra0, ra1, ra2, ra3, rb0, rb1, rb2, rb3;
#define G128_LOADBB(kt) { \
    ra0 = aload(0, arow0, (kt) * 8 + achunk); ra1 = aload(1, arow0 + 32, (kt) * 8 + achunk); \
    ra2 = aload(2, arow0 + 64, (kt) * 8 + achunk); ra3 = aload(3, arow0 + 96, (kt) * 8 + achunk); \
    rb0 = bload(0, arow0, (kt) * 8 + achunk); rb1 = bload(1, arow0 + 32, (kt) * 8 + achunk); \
    rb2 = bload(2, arow0 + 64, (kt) * 8 + achunk); rb3 = bload(3, arow0 + 96, (kt) * 8 + achunk); }
#define G128_STOREBB(bufoff) { \
    char* const sb_ = smem + (bufoff); \
    *(uint4*)(sb_ + oa0) = ra0; *(uint4*)(sb_ + oa1) = ra1; *(uint4*)(sb_ + oa2) = ra2; *(uint4*)(sb_ + oa3) = ra3; \
    *(uint4*)(sb_ + 16384 + oa0) = rb0; *(uint4*)(sb_ + 16384 + oa1) = rb1; *(uint4*)(sb_ + 16384 + oa2) = rb2; *(uint4*)(sb_ + 16384 + oa3) = rb3; }
  G128_LOADBB(0)
  G128_STOREBB(0)
  if (nk > 1) G128_LOADBB(1)
  __syncthreads();
  for (int kt = 0; kt < nk; ++kt) {
    const int cur = (kt & 1) * 32768;
    __builtin_amdgcn_sched_barrier(0);
    G128_MMA(cur)
    __builtin_amdgcn_sched_barrier(0);
    if (kt + 1 < nk) {
      G128_STOREBB(cur ^ 32768)
      __builtin_amdgcn_sched_barrier(0);
      if (kt + 2 < nk) G128_LOADBB(kt + 2)
    }
    __builtin_amdgcn_sched_barrier(0);
    __syncthreads();
  }
#undef G128_LOADBB
#undef G128_STOREBB
}
template <class ARow, class BRow, class Epi>
__device__ __forceinline__ void gemm128_bb(char* smem, const int K, ARow arow, BRow brow, Epi epi) {
  const int tid = threadIdx.x, lane = tid & 63, wid = tid >> 6;
  const int arow0 = tid >> 3;
  const bf16_t* ap0 = arow(arow0); const bf16_t* ap1 = arow(arow0 + 32); const bf16_t* ap2 = arow(arow0 + 64); const bf16_t* ap3 = arow(arow0 + 96);
  const bf16_t* bp0 = brow(arow0); const bf16_t* bp1 = brow(arow0 + 32); const bf16_t* bp2 = brow(arow0 + 64); const bf16_t* bp3 = brow(arow0 + 96);
  f32x4 acc[4][4];
  acc_zero(acc);
  gemm128_acc_bb(acc, smem, K >> 6,
      [=](int u, int, int kc) { const bf16_t* q = (u == 0) ? ap0 : (u == 1) ? ap1 : (u == 2) ? ap2 : ap3; return *(const uint4*)(q + kc * 8); },
      [=](int u, int, int kc) { const bf16_t* q = (u == 0) ? bp0 : (u == 1) ? bp1 : (u == 2) ? bp2 : bp3; return *(const uint4*)(q + kc * 8); });
  epi(acc, wid >> 1, wid & 1, lane & 15, lane >> 4);
}


#define GAS1 __attribute__((address_space(1)))
#define LAS3 __attribute__((address_space(3)))
__device__ __forceinline__ void glds16(const void* g, char* l) {
  __builtin_amdgcn_global_load_lds((const GAS1 void*)g, (LAS3 void*)l, 16, 0, 0);
}
template <class ARow, class BRow, class Epi>
__device__ __forceinline__ void gemm128_glds(char* smem, const int K, ARow arow, BRow brow, Epi epi) {
  const int tid = threadIdx.x, lane = tid & 63, wid = tid >> 6;
  const int wr = wid >> 1, wc = wid & 1, fr = lane & 15, fq = lane >> 4;
  const int r0 = tid >> 3;
  const int cl = (tid & 7) ^ ((tid >> 4) & 7);
  const bf16_t* ga0 = arow(r0) + cl * 8; const bf16_t* ga1 = arow(r0 + 32) + cl * 8; const bf16_t* ga2 = arow(r0 + 64) + cl * 8; const bf16_t* ga3 = arow(r0 + 96) + cl * 8;
  const bf16_t* gb0 = brow(r0) + cl * 8; const bf16_t* gb1 = brow(r0 + 32) + cl * 8; const bf16_t* gb2 = brow(r0 + 64) + cl * 8; const bf16_t* gb3 = brow(r0 + 96) + cl * 8;
  char* const lbase = smem + tid * 16;
#define GL_STAGE(bufoff, kt) { \
    char* const d_ = lbase + (bufoff); const int ko_ = (kt) * 64; \
    glds16(ga0 + ko_, d_); glds16(ga1 + ko_, d_ + 4096); glds16(ga2 + ko_, d_ + 8192); glds16(ga3 + ko_, d_ + 12288); \
    glds16(gb0 + ko_, d_ + 16384); glds16(gb1 + ko_, d_ + 20480); glds16(gb2 + ko_, d_ + 24576); glds16(gb3 + ko_, d_ + 28672); }
  f32x4 acc[4][4];
  acc_zero(acc);
  const int nk = K >> 6;
  GL_STAGE(0, 0)
  asm volatile("s_waitcnt vmcnt(0)" ::: "memory");
  __syncthreads();
  for (int kt = 0; kt < nk; ++kt) {
    const int cur = (kt & 1) * 32768;
    if (kt + 1 < nk) GL_STAGE(cur ^ 32768, kt + 1)
    G128_MMA(cur)
    asm volatile("s_waitcnt vmcnt(0)" ::: "memory");
    __syncthreads();
  }
#undef GL_STAGE
  epi(acc, wr, wc, fr, fq);
}


template <int NCALL, int NK, class ARow, class BRow, class Epi>
__device__ __forceinline__ void gemm128_glds_multi(char* smem, ARow arow, BRow brow, const size_t bstride, Epi epi) {
  const int tid = threadIdx.x, lane = tid & 63, wid = tid >> 6;
  const int wr = wid >> 1, wc = wid & 1, fr = lane & 15, fq = lane >> 4;
  const int r0 = tid >> 3;
  const int cl = (tid & 7) ^ ((tid >> 4) & 7);
  const bf16_t* ga0 = arow(r0) + cl * 8; const bf16_t* ga1 = arow(r0 + 32) + cl * 8; const bf16_t* ga2 = arow(r0 + 64) + cl * 8; const bf16_t* ga3 = arow(r0 + 96) + cl * 8;
  const bf16_t* gb0 = brow(r0) + cl * 8; const bf16_t* gb1 = brow(r0 + 32) + cl * 8; const bf16_t* gb2 = brow(r0 + 64) + cl * 8; const bf16_t* gb3 = brow(r0 + 96) + cl * 8;
  char* const lbase = smem + tid * 16;
#define GM_STAGE(bufoff, g) { \
    char* const d_ = lbase + (bufoff); const int ko_ = ((g) % NK) * 64; const size_t bo_ = (size_t)((g) / NK) * bstride + ko_; \
    glds16(ga0 + ko_, d_); glds16(ga1 + ko_, d_ + 4096); glds16(ga2 + ko_, d_ + 8192); glds16(ga3 + ko_, d_ + 12288); \
    glds16(gb0 + bo_, d_ + 16384); glds16(gb1 + bo_, d_ + 20480); glds16(gb2 + bo_, d_ + 24576); glds16(gb3 + bo_, d_ + 28672); }
  f32x4 acc[4][4];
  acc_zero(acc);
  constexpr int G = NCALL * NK;
  GM_STAGE(0, 0)
  asm volatile("s_waitcnt vmcnt(0)" ::: "memory");
  __syncthreads();
#pragma unroll 1
  for (int g = 0; g < G; ++g) {
    const int cur = (g & 1) * 32768;
    if (g + 1 < G) GM_STAGE(cur ^ 32768, g + 1)
    G128_MMA(cur)
    if ((g % NK) == NK - 1) {
      epi(g / NK, acc, wr, wc, fr, fq);
      acc_zero(acc);
    }
    asm volatile("s_waitcnt vmcnt(0)" ::: "memory");
    __syncthreads();
  }
#undef GM_STAGE
}

#define DPP_F(v, ctrl) __builtin_bit_cast(float, __builtin_amdgcn_update_dpp(0, __builtin_bit_cast(int, (v)), (ctrl), 0xF, 0xF, true))
__device__ __forceinline__ float rdlane_f(float v, int l) { return __builtin_bit_cast(float, __builtin_amdgcn_readlane(__builtin_bit_cast(int, v), l)); }
__device__ __forceinline__ float dpp_sum16x(float v) {
  v += DPP_F(v, 0xB1); v += DPP_F(v, 0x4E); v += DPP_F(v, 0x141); v += DPP_F(v, 0x140);
  return v;
}
__device__ __forceinline__ float dpp_max16x(float v) {
  v = fmaxf(v, DPP_F(v, 0xB1)); v = fmaxf(v, DPP_F(v, 0x4E)); v = fmaxf(v, DPP_F(v, 0x141)); v = fmaxf(v, DPP_F(v, 0x140));
  return v;
}
__device__ __forceinline__ float wave_sum_fast(float v) {
  v = dpp_sum16x(v);
  return (rdlane_f(v, 0) + rdlane_f(v, 16)) + (rdlane_f(v, 32) + rdlane_f(v, 48));
}
__device__ __forceinline__ float wave_max_fast(float v) {
  v = dpp_max16x(v);
  return fmaxf(fmaxf(rdlane_f(v, 0), rdlane_f(v, 16)), fmaxf(rdlane_f(v, 32), rdlane_f(v, 48)));
}
__device__ __forceinline__ float fast_tanh(float x) { const float e = __expf(2.f * x); return 1.f - 2.f / (e + 1.f); }


__device__ __forceinline__ float4 bf4_to_f4(uint2 u) {
  float4 r;
  r.x = __uint_as_float(u.x << 16); r.y = __uint_as_float(u.x & 0xffff0000u);
  r.z = __uint_as_float(u.y << 16); r.w = __uint_as_float(u.y & 0xffff0000u);
  return r;
}
__device__ __forceinline__ uint2 pack4(float a, float b, float c, float d) { uint2 r; r.x = cvtpk(a, b); r.y = cvtpk(c, d); return r; }
#define XCD_GROUP (blockIdx.x & 7)
#define XCD_LB (blockIdx.x >> 3)
#define XCD_NB ((gridDim.x + 7 - (blockIdx.x & 7)) >> 3)

__device__ __forceinline__ void phase_inproj(const Params& p, char* smem) {
  const bf16_t* __restrict__ XB = (const bf16_t*)(p.ws + OFF_XB);
  const bf16_t* __restrict__ WINT = (const bf16_t*)(p.ws + OFF_WINT);
  const float* __restrict__ rope = (const float*)(p.ws + OFF_ROPE);
  bf16_t* Q = (bf16_t*)(p.ws + OFF_Q); bf16_t* K = (bf16_t*)(p.ws + OFF_K); bf16_t* V = (bf16_t*)(p.ws + OFF_V);
  bf16_t* FE = (bf16_t*)(p.ws + OFF_FEATS);
  const int NT = 27, NITEM = (T_TOK / 128) * NT, CHUNK = NITEM / 8;
  for (int i = XCD_LB; i < CHUNK; i += XCD_NB) {
    const int item = XCD_GROUP * CHUNK + i;
    const int row0 = (item & 255) * 128, col0 = (item >> 8) * 128;
    gemm128_glds(smem, DM,
            [=](int r) { return XB + (size_t)(row0 + r) * DM; },
            [=](int r) { return WINT + (size_t)(col0 + r) * DM; },
            [=](f32x4 (&acc)[4][4], int wr, int wc, int fr, int fq) {
              const int cb = col0 + wc * 64;
              if (cb >= INW) return;
#pragma unroll
              for (int m = 0; m < 4; ++m) {
                const int t = row0 + wr * 64 + m * 16 + fr;
                if (cb < 1024) {
                  const int pos = t & (SEQ - 1);
                  bf16_t* dst = (cb < 512) ? (Q + (size_t)t * 512 + cb) : (K + (size_t)t * 512 + (cb - 512));
                  const float sc = (cb < 512) ? 0.125f : 1.f;
#pragma unroll
                  for (int n = 0; n < 2; ++n) {
                    const int f0 = n * 16 + fq * 4;
                    const float4 c01 = *(const float4*)(rope + (size_t)(pos * 32 + f0) * 2);
                    const float4 c23 = *(const float4*)(rope + (size_t)(pos * 32 + f0) * 2 + 4);
                    const float cs[4] = {c01.x, c01.z, c23.x, c23.z}, sn[4] = {c01.y, c01.w, c23.y, c23.w};
                    float o1[4], o2[4];
#pragma unroll
                    for (int j = 0; j < 4; ++j) {
                      const float z1 = acc[m][n][j], z2 = acc[m][n + 2][j];
                      o1[j] = (z1 * cs[j] - z2 * sn[j]) * sc; o2[j] = (z2 * cs[j] + z1 * sn[j]) * sc;
                    }
                    *(uint2*)(dst + f0) = pack4(o1[0], o1[1], o1[2], o1[3]);
                    *(uint2*)(dst + 32 + f0) = pack4(o2[0], o2[1], o2[2], o2[3]);
                  }
                } else if (cb < 1536) {
#pragma unroll
                  for (int n = 0; n < 4; ++n)
                    *(uint2*)(V + (size_t)t * 512 + (cb - 1024) + n * 16 + fq * 4) = pack4(acc[m][n][0], acc[m][n][1], acc[m][n][2], acc[m][n][3]);
                } else {
#pragma unroll
                  for (int n = 0; n < 4; ++n) {
                    const int c = cb + n * 16 + fq * 4;
                    if (c < INW) *(uint2*)(FE + (size_t)t * FEW + (c - 1536)) = pack4(acc[m][n][0], acc[m][n][1], acc[m][n][2], acc[m][n][3]);
                  }
                }
              }
            });
  }
}

__device__ __forceinline__ void phase_prep_a(const Params& p) {
  const bf16_t* __restrict__ FE = (const bf16_t*)(p.ws + OFF_FEATS);
  const float* __restrict__ mu = p.in[2];
  bf16_t* R = (bf16_t*)(p.ws + OFF_R); bf16_t* K2 = (bf16_t*)(p.ws + OFF_K2); bf16_t* V2 = (bf16_t*)(p.ws + OFF_V2);
  bf16_t* ACT = (bf16_t*)(p.ws + OFF_ACT);
  for (size_t i = (size_t)blockIdx.x * NTHR + threadIdx.x; i < (size_t)T_TOK * 232; i += (size_t)gridDim.x * NTHR) {
    const int t = (int)(i / 232), ch = (int)(i - (size_t)t * 232);
    if (ch >= 228) { *(uint4*)(ACT + (size_t)t * 320 + 288 + (ch - 228) * 8) = make_uint4(0u, 0u, 0u, 0u); continue; }
    const int col = ch * 8;
    const uint4 cu = *(const uint4*)(FE + (size_t)t * FEW + col);
    uint4 pv = make_uint4(0u, 0u, 0u, 0u);
    if ((t & (SEQ - 1)) != 0) pv = *(const uint4*)(FE + (size_t)(t - 1) * FEW + col);
    const float4 m0 = *(const float4*)(mu + col), m1 = *(const float4*)(mu + col + 4);
    const unsigned cw[4] = {cu.x, cu.y, cu.z, cu.w}, pw[4] = {pv.x, pv.y, pv.z, pv.w};
    const float mm[8] = {m0.x, m0.y, m0.z, m0.w, m1.x, m1.y, m1.z, m1.w};
    float f[8];
#pragma unroll
    for (int q = 0; q < 4; ++q) {
      const float c0 = __uint_as_float(cw[q] << 16), c1 = __uint_as_float(cw[q] & 0xffff0000u);
      const float p0 = __uint_as_float(pw[q] << 16), p1 = __uint_as_float(pw[q] & 0xffff0000u);
      f[2 * q] = c0 + (p0 - c0) * mm[2 * q];
      f[2 * q + 1] = c1 + (p1 - c1) * mm[2 * q + 1];
    }
    bf16_t* dst;
    if (col < 512) dst = R + (size_t)t * 512 + col;
    else if (col < 1024) dst = K2 + (size_t)t * 512 + (col - 512);
    else if (col < 1536) dst = V2 + (size_t)t * 512 + (col - 1024);
    else {
      dst = ACT + (size_t)t * 320 + (col - 1536);
      if (col < 1600) {
#pragma unroll
        for (int q = 0; q < 8; ++q) f[q] = fast_tanh(f[q]);
      } else if (col >= 1664) {
#pragma unroll
        for (int q = 0; q < 8; ++q) f[q] = sigmoidf_(f[q]);
      }
    }
    uint4 w; w.x = cvtpk(f[0], f[1]); w.y = cvtpk(f[2], f[3]); w.z = cvtpk(f[4], f[5]); w.w = cvtpk(f[6], f[7]);
    *(uint4*)dst = w;
  }
}

template <int PASS>
__device__ __forceinline__ void prep_item(const Params& p, char* smem, const int row0, const int col0) {
  const bf16_t* __restrict__ ACT = (const bf16_t*)(p.ws + OFF_ACT);
  constexpr int ACOL = PASS * 64;
  constexpr int NK = (PASS == 2) ? 3 : 1;
  const float* __restrict__ Wm = (PASS == 0) ? p.in[4] : (PASS == 1) ? p.in[6] : p.in[7];
  f32x4 acc[4][4];
  acc_zero(acc);
  gemm128_acc<0, (PASS == 2)>(acc, smem, NK,
      [=](int, int rowl, int kc) { return *(const uint4*)(ACT + (size_t)(row0 + rowl) * 320 + ACOL + kc * 8); },
      [=](int nq) { return Wm + col0 + nq * 4; }, 512, 160);
  const int tid = threadIdx.x, lane = tid & 63, wid = tid >> 6;
  const int wr = wid >> 1, wc = wid & 1, fr = lane & 15, fq = lane >> 4;
  const int cb = col0 + wc * 64;
  if (PASS == 0) {
    const float* __restrict__ w0 = p.in[3];
    float* W = (float*)(p.ws + OFF_W);
#pragma unroll
    for (int n = 0; n < 4; ++n) {
      const int c = cb + n * 16 + fq * 4;
      const float4 w04 = *(const float4*)(w0 + c);
      const float w0c[4] = {w04.x, w04.y, w04.z, w04.w};
#pragma unroll
      for (int m = 0; m < 4; ++m) {
        const int t = row0 + wr * 64 + m * 16 + fr;
        float d[4];
#pragma unroll
        for (int j = 0; j < 4; ++j) {
          const float nz = -(w0c[j] + acc[m][n][j]);
          const float sp = fmaxf(nz, 0.f) + __logf(1.f + __expf(-fabsf(nz)));
          d[j] = __expf(-__expf(-sp - 0.5f));
        }
        *(float4*)(W + (size_t)t * 512 + c) = make_float4(d[0], d[1], d[2], d[3]);
      }
    }
  } else if (PASS == 2) {
    bf16_t* G = (bf16_t*)(p.ws + OFF_G);
#pragma unroll
    for (int m = 0; m < 4; ++m) {
      const int t = row0 + wr * 64 + m * 16 + fr;
#pragma unroll
      for (int n = 0; n < 4; ++n)
        *(uint2*)(G + (size_t)t * 512 + cb + n * 16 + fq * 4) = pack4(acc[m][n][0], acc[m][n][1], acc[m][n][2], acc[m][n][3]);
    }
  } else {
    const float* __restrict__ a0 = p.in[5]; const float* __restrict__ k_k = p.in[8]; const float* __restrict__ k_a = p.in[9];
    const float* __restrict__ r_k = p.in[10];
    const bf16_t* __restrict__ R = (const bf16_t*)(p.ws + OFF_R); bf16_t* K2 = (bf16_t*)(p.ws + OFF_K2);
    bf16_t* A = (bf16_t*)(p.ws + OFF_A); bf16_t* B = (bf16_t*)(p.ws + OFF_B); float* SB = (float*)(p.ws + OFF_SB);
#pragma unroll
    for (int m = 0; m < 4; ++m) {
      __builtin_amdgcn_sched_barrier(0);
      const int t = row0 + wr * 64 + m * 16 + fr;
      float kk[4][4];
      float ssp = 0.f, sbp = 0.f;
#pragma unroll
      for (int n = 0; n < 4; ++n) {
        const int c = cb + n * 16 + fq * 4;
        const size_t o = (size_t)t * 512 + c;
        const float4 rr4 = bf4_to_f4(*(const uint2*)(R + o)), kx4 = bf4_to_f4(*(const uint2*)(K2 + o));
        const float rr[4] = {rr4.x, rr4.y, rr4.z, rr4.w}, kx[4] = {kx4.x, kx4.y, kx4.z, kx4.w};
        const float4 a04 = *(const float4*)(a0 + c), kk4 = *(const float4*)(k_k + c), ka4 = *(const float4*)(k_a + c), rk4 = *(const float4*)(r_k + c);
        const float a0c[4] = {a04.x, a04.y, a04.z, a04.w}, kkc[4] = {kk4.x, kk4.y, kk4.z, kk4.w}, kac[4] = {ka4.x, ka4.y, ka4.z, ka4.w};
        const float rkc[4] = {rk4.x, rk4.y, rk4.z, rk4.w};
        float k2[4];
#pragma unroll
        for (int j = 0; j < 4; ++j) {
          const float av = sigmoidf_(a0c[j] + acc[m][n][j]);
          acc[m][n][j] = av;
          kk[n][j] = kx[j] * kkc[j];
          k2[j] = kx[j] * (1.f + (av - 1.f) * kac[j]);
          ssp += kk[n][j] * kk[n][j];
          sbp += rr[j] * k2[j] * rkc[j];
        }
        *(uint2*)(K2 + o) = pack4(k2[0], k2[1], k2[2], k2[3]);
      }
      ssp += __shfl_xor(ssp, 16, 64); ssp += __shfl_xor(ssp, 32, 64);
      sbp += __shfl_xor(sbp, 16, 64); sbp += __shfl_xor(sbp, 32, 64);
      const float inv = 1.f / fmaxf(sqrtf(ssp), 1e-12f);
#pragma unroll
      for (int n = 0; n < 4; ++n) {
        const size_t o = (size_t)t * 512 + cb + n * 16 + fq * 4;
        *(uint2*)(A + o) = pack4(-kk[n][0] * inv, -kk[n][1] * inv, -kk[n][2] * inv, -kk[n][3] * inv);
        *(uint2*)(B + o) = pack4(kk[n][0] * inv * acc[m][n][0], kk[n][1] * inv * acc[m][n][1], kk[n][2] * inv * acc[m][n][2], kk[n][3] * inv * acc[m][n][3]);
      }
      if (fq == 0) SB[(size_t)t * 8 + (cb >> 6)] = sbp;
    }
  }
}
__device__ __forceinline__ void phase_prep(const Params& p, char* smem) {
  for (int item = blockIdx.x; item < (T_TOK / 128) * 12; item += gridDim.x) {
    const int mt = item / 12, sub = item - mt * 12, pass = sub >> 2, nt = sub & 3;
    if (pass == 0) prep_item<0>(p, smem, mt * 128, nt * 128);
    else if (pass == 1) prep_item<1>(p, smem, mt * 128, nt * 128);
    else prep_item<2>(p, smem, mt * 128, nt * 128);
  }
}

__device__ __forceinline__ float dpp_sum16(float v) {
  v += __builtin_bit_cast(float, __builtin_amdgcn_update_dpp(0, __builtin_bit_cast(int, v), 0xB1, 0xF, 0xF, true));
  v += __builtin_bit_cast(float, __builtin_amdgcn_update_dpp(0, __builtin_bit_cast(int, v), 0x4E, 0xF, 0xF, true));
  v += __builtin_bit_cast(float, __builtin_amdgcn_update_dpp(0, __builtin_bit_cast(int, v), 0x141, 0xF, 0xF, true));
  v += __builtin_bit_cast(float, __builtin_amdgcn_update_dpp(0, __builtin_bit_cast(int, v), 0x140, 0xF, 0xF, true));
  return v;
}
#define SC_CH 16
#define SC_ARR (SC_CH * 64 * 4)
#define SC_BUF (5 * SC_ARR + SC_CH * 16 * 4)
__device__ __forceinline__ void phase_scan(const Params& p, char* smem) {
  if (blockIdx.x >= 256) return;
  const bf16_t* __restrict__ R = (const bf16_t*)(p.ws + OFF_R); const bf16_t* __restrict__ K2 = (const bf16_t*)(p.ws + OFF_K2);
  const bf16_t* __restrict__ V2 = (const bf16_t*)(p.ws + OFF_V2); const bf16_t* __restrict__ A = (const bf16_t*)(p.ws + OFF_A);
  const bf16_t* __restrict__ B = (const bf16_t*)(p.ws + OFF_B); const float* __restrict__ W = (const float*)(p.ws + OFF_W);
  float* YS = (float*)(p.ws + OFF_YS);
  const int bh = blockIdx.x >> 2, rg = blockIdx.x & 3, b = bh >> 3, h = bh & 7;
  const int tid = threadIdx.x, lane = tid & 63, wid = tid >> 6, j = lane & 15, rq = lane >> 4;
  const int rowl = wid * 4 + rq;
  const int ls = tid >> 4, lc = tid & 15;
  const int vs = (tid >> 2) & 15, vq = tid & 3;
  const size_t tb = (size_t)b * SEQ;
  const size_t goff = (tb + ls) * 512 + h * 64 + lc * 4;
  const size_t voff = (tb + vs) * 512 + h * 64 + rg * 16 + vq * 4;
  uint2 ga, gb, gk, gr, gv; float4 gw;
  gv = make_uint2(0u, 0u);
  ga = *(const uint2*)(A + goff); gb = *(const uint2*)(B + goff); gk = *(const uint2*)(K2 + goff); gr = *(const uint2*)(R + goff);
  gw = *(const float4*)(W + goff);
  if (tid < 64) gv = *(const uint2*)(V2 + voff);
  {
    char* bf = smem;
    *(float4*)(bf + 0 * SC_ARR + ls * 256 + lc * 16) = bf4_to_f4(ga);
    *(float4*)(bf + 1 * SC_ARR + ls * 256 + lc * 16) = gw;
    *(float4*)(bf + 2 * SC_ARR + ls * 256 + lc * 16) = bf4_to_f4(gb);
    *(float4*)(bf + 3 * SC_ARR + ls * 256 + lc * 16) = bf4_to_f4(gk);
    *(float4*)(bf + 4 * SC_ARR + ls * 256 + lc * 16) = bf4_to_f4(gr);
    if (tid < 64) *(float4*)(bf + 5 * SC_ARR + vs * 64 + vq * 16) = bf4_to_f4(gv);
  }
  __syncthreads();
  float s0 = 0.f, s1 = 0.f, s2 = 0.f, s3 = 0.f;
  const int NCH = SEQ / SC_CH;
  for (int c = 0; c < NCH; ++c) {
    if (c + 1 < NCH) {
      const size_t o2 = goff + (size_t)(c + 1) * SC_CH * 512;
      ga = *(const uint2*)(A + o2); gb = *(const uint2*)(B + o2); gk = *(const uint2*)(K2 + o2); gr = *(const uint2*)(R + o2);
      gw = *(const float4*)(W + o2);
      if (tid < 64) gv = *(const uint2*)(V2 + voff + (size_t)(c + 1) * SC_CH * 512);
    }
    const char* bf = smem + (c & 1) * SC_BUF;
    float ykeep = 0.f;
#pragma unroll
    for (int s = 0; s < SC_CH; ++s) {
      const float4 a4 = *(const float4*)(bf + 0 * SC_ARR + s * 256 + j * 16);
      const float4 w4 = *(const float4*)(bf + 1 * SC_ARR + s * 256 + j * 16);
      const float4 b4 = *(const float4*)(bf + 2 * SC_ARR + s * 256 + j * 16);
      const float4 k4 = *(const float4*)(bf + 3 * SC_ARR + s * 256 + j * 16);
      const float4 r4 = *(const float4*)(bf + 4 * SC_ARR + s * 256 + j * 16);
      const float vv = *(const float*)(bf + 5 * SC_ARR + s * 64 + rowl * 4);
      float sa = (s0 * a4.x + s1 * a4.y) + (s2 * a4.z + s3 * a4.w);
      sa = dpp_sum16(sa);
      s0 = s0 * w4.x + (sa * b4.x + vv * k4.x);
      s1 = s1 * w4.y + (sa * b4.y + vv * k4.y);
      s2 = s2 * w4.z + (sa * b4.z + vv * k4.z);
      s3 = s3 * w4.w + (sa * b4.w + vv * k4.w);
      float y = (s0 * r4.x + s1 * r4.y) + (s2 * r4.z + s3 * r4.w);
      y = dpp_sum16(y);
      ykeep = (j == s) ? y : ykeep;
    }
    YS[(tb + (size_t)c * SC_CH + j) * 512 + h * 64 + rg * 16 + rowl] = ykeep;
    if (c + 1 < NCH) {
      char* bn = smem + ((c + 1) & 1) * SC_BUF;
      *(float4*)(bn + 0 * SC_ARR + ls * 256 + lc * 16) = bf4_to_f4(ga);
      *(float4*)(bn + 1 * SC_ARR + ls * 256 + lc * 16) = gw;
      *(float4*)(bn + 2 * SC_ARR + ls * 256 + lc * 16) = bf4_to_f4(gb);
      *(float4*)(bn + 3 * SC_ARR + ls * 256 + lc * 16) = bf4_to_f4(gk);
      *(float4*)(bn + 4 * SC_ARR + ls * 256 + lc * 16) = bf4_to_f4(gr);
      if (tid < 64) *(float4*)(bn + 5 * SC_ARR + vs * 64 + vq * 16) = bf4_to_f4(gv);
    }
    __syncthreads();
  }
}


#define CONV_TILES (257 * 96)
struct ConvDesc { const float* src; bf16_t* dst; int ldn, k0, n0, kdim, part; };
__device__ __forceinline__ ConvDesc conv_desc(const Params& p, const int ti) {
  ConvDesc d;
  const int e = ti / 96, q = ti - e * 96, part = q >> 5, w = q & 31;
  d.part = part;
  if (part < 2) {
    d.src = (e < NEXP) ? p.in[18 + part] + (size_t)e * DM * 256 : p.in[21 + part];
    d.ldn = 256; d.k0 = (w >> 1) * 64; d.n0 = (w & 1) * 128; d.kdim = 1024;
    d.dst = (bf16_t*)(p.ws + OFF_EW1) + (size_t)e * 512 * 1024;
  } else {
    d.src = (e < NEXP) ? p.in[20] + (size_t)e * 256 * DM : p.in[23];
    d.ldn = 1024; d.k0 = (w >> 3) * 64; d.n0 = (w & 7) * 128; d.kdim = 256;
    d.dst = (bf16_t*)(p.ws + OFF_EW2) + (size_t)e * 1024 * 256;
  }
  return d;
}
#define CV_LOAD(d, r) { \
    const float* bp_ = (d).src + (size_t)((d).k0 + ko * 8) * (d).ldn + (d).n0 + nq * 4; \
    r##0 = *(const float4*)(bp_); r##1 = *(const float4*)(bp_ + (size_t)1 * (d).ldn); r##2 = *(const float4*)(bp_ + (size_t)2 * (d).ldn); \
    r##3 = *(const float4*)(bp_ + (size_t)3 * (d).ldn); r##4 = *(const float4*)(bp_ + (size_t)4 * (d).ldn); r##5 = *(const float4*)(bp_ + (size_t)5 * (d).ldn); \
    r##6 = *(const float4*)(bp_ + (size_t)6 * (d).ldn); r##7 = *(const float4*)(bp_ + (size_t)7 * (d).ldn); }
#define CV_LDS(r, base) { \
    uint4 v; \
    v.x = cvtpk((r##0).x, (r##1).x); v.y = cvtpk((r##2).x, (r##3).x); v.z = cvtpk((r##4).x, (r##5).x); v.w = cvtpk((r##6).x, (r##7).x); *(uint4*)((base) + lds_off(nq * 4 + 0, ko)) = v; \
    v.x = cvtpk((r##0).y, (r##1).y); v.y = cvtpk((r##2).y, (r##3).y); v.z = cvtpk((r##4).y, (r##5).y); v.w = cvtpk((r##6).y, (r##7).y); *(uint4*)((base) + lds_off(nq * 4 + 1, ko)) = v; \
    v.x = cvtpk((r##0).z, (r##1).z); v.y = cvtpk((r##2).z, (r##3).z); v.z = cvtpk((r##4).z, (r##5).z); v.w = cvtpk((r##6).z, (r##7).z); *(uint4*)((base) + lds_off(nq * 4 + 2, ko)) = v; \
    v.x = cvtpk((r##0).w, (r##1).w); v.y = cvtpk((r##2).w, (r##3).w); v.z = cvtpk((r##4).w, (r##5).w); v.w = cvtpk((r##6).w, (r##7).w); *(uint4*)((base) + lds_off(nq * 4 + 3, ko)) = v; }
#define CV_OUT(d, base) { \
    _Pragma("unroll") for (int u = 0; u < 4; ++u) { \
      const int row = (tid >> 3) + 32 * u, chunk = tid & 7; \
      const int c = (d).n0 + row; \
      const int orow = ((d).part < 2) ? ((c >> 6) * 128 + ((c >> 5) & 1) * 64 + ((d).part * 2 + ((c >> 4) & 1)) * 16 + (c & 15)) : c; \
      *(uint4*)((d).dst + (size_t)orow * (d).kdim + (d).k0 + chunk * 8) = *(const uint4*)((base) + lds_off(row, chunk)); } }
__device__ __forceinline__ void convert_tile2(const Params& p, char* smem, const int t2) {
  const int tid = threadIdx.x, nq = tid & 31, ko = tid >> 5;
  const ConvDesc da = conv_desc(p, 2 * t2), db = conv_desc(p, 2 * t2 + 1);
  float4 ra0, ra1, ra2, ra3, ra4, ra5, ra6, ra7, rb0, rb1, rb2, rb3, rb4, rb5, rb6, rb7;
  CV_LOAD(da, ra)
  CV_LOAD(db, rb)
  CV_LDS(ra, smem)
  CV_LDS(rb, smem + 16384)
  __syncthreads();
  CV_OUT(da, smem)
  CV_OUT(db, smem + 16384)
  __syncthreads();
}
#undef CV_LOAD
#undef CV_LDS
#undef CV_OUT

__device__ __forceinline__ int vt_off(int d, int key) { const int swz = ((d >> 2) & 15) ^ ((d & 3) << 3); return d * 512 + (((key >> 2) ^ swz) << 3); }
__device__ __forceinline__ void attn_item(const Params& p, char* smem, const int item) {
  const bf16_t* __restrict__ Q = (const bf16_t*)(p.ws + OFF_Q); const bf16_t* __restrict__ K = (const bf16_t*)(p.ws + OFF_K);
  const bf16_t* __restrict__ V = (const bf16_t*)(p.ws + OFF_V);
  bf16_t* OP = (bf16_t*)(p.ws + OFF_OP); float* LSE = (float*)(p.ws + OFF_LSE);
  char* Ks = smem; char* VT = smem + 32768; float* linv_s = (float*)(smem + 65536);
  const int tid = threadIdx.x, lane = tid & 63, wid = tid >> 6, l31 = lane & 31, hi = lane >> 5;
  {
    const int pp = item >> 11, rem = item & 2047, bh = rem >> 5, sub = rem & 31;
    const int dsh = pp * 2, nbsh = 5 - dsh;
    const int r = sub >> nbsh, n = sub & ((1 << nbsh) - 1);
    const int b = bh >> 3, h = bh & 7, tb = b * SEQ;
    __syncthreads();
#pragma unroll
    for (int u = 0; u < 8; ++u) {
      const int row = (tid >> 3) + 32 * u, chunk = tid & 7;
      int ik = n * 128 - 128 + row; ik = ik < 0 ? 0 : ik;
      const int tok = tb + (ik << dsh) + r;
      *(uint4*)(Ks + lds_off(row, chunk)) = *(const uint4*)(K + (size_t)tok * 512 + h * 64 + chunk * 8);
    }
#pragma unroll
    for (int ps = 0; ps < 2; ++ps) {
      const int dq = tid & 15, kbase = ps * 128 + (tid >> 4) * 8;
      uint2 v0, v1, v2, v3, v4, v5, v6, v7;
#define LDV(i, dst) { int ik = n * 128 - 128 + kbase + i; ik = ik < 0 ? 0 : ik; const int tok = tb + (ik << dsh) + r; dst = *(const uint2*)(V + (size_t)tok * 512 + h * 64 + dq * 4); }
      LDV(0, v0) LDV(1, v1) LDV(2, v2) LDV(3, v3) LDV(4, v4) LDV(5, v5) LDV(6, v6) LDV(7, v7)
#undef LDV
      {
        uint2 w;
        w.x = (v0.x & 0xffffu) | (v1.x << 16); w.y = (v2.x & 0xffffu) | (v3.x << 16);
        *(uint2*)(VT + vt_off(dq * 4 + 0, kbase)) = w;
        w.x = (v4.x & 0xffffu) | (v5.x << 16); w.y = (v6.x & 0xffffu) | (v7.x << 16);
        *(uint2*)(VT + vt_off(dq * 4 + 0, kbase + 4)) = w;
        w.x = (v0.x >> 16) | (v1.x & 0xffff0000u); w.y = (v2.x >> 16) | (v3.x & 0xffff0000u);
        *(uint2*)(VT + vt_off(dq * 4 + 1, kbase)) = w;
        w.x = (v4.x >> 16) | (v5.x & 0xffff0000u); w.y = (v6.x >> 16) | (v7.x & 0xffff0000u);
        *(uint2*)(VT + vt_off(dq * 4 + 1, kbase + 4)) = w;
        w.x = (v0.y & 0xffffu) | (v1.y << 16); w.y = (v2.y & 0xffffu) | (v3.y << 16);
        *(uint2*)(VT + vt_off(dq * 4 + 2, kbase)) = w;
        w.x = (v4.y & 0xffffu) | (v5.y << 16); w.y = (v6.y & 0xffffu) | (v7.y << 16);
        *(uint2*)(VT + vt_off(dq * 4 + 2, kbase + 4)) = w;
        w.x = (v0.y >> 16) | (v1.y & 0xffff0000u); w.y = (v2.y >> 16) | (v3.y & 0xffff0000u);
        *(uint2*)(VT + vt_off(dq * 4 + 3, kbase)) = w;
        w.x = (v4.y >> 16) | (v5.y & 0xffff0000u); w.y = (v6.y >> 16) | (v7.y & 0xffff0000u);
        *(uint2*)(VT + vt_off(dq * 4 + 3, kbase + 4)) = w;
      }
    }
    __syncthreads();
    const int iq = n * 128 + wid * 32 + l31;
    const int tq = tb + (iq << dsh) + r;
    bf16x8 qf[4];
#pragma unroll
    for (int ks = 0; ks < 4; ++ks) qf[ks] = *(const bf16x8*)(Q + (size_t)tq * 512 + h * 64 + ks * 16 + hi * 8);
    f32x16 st[5];
#pragma unroll
    for (int kb = 0; kb < 5; ++kb) {
      st[kb] = (f32x16){0.f, 0.f, 0.f, 0.f, 0.f, 0.f, 0.f, 0.f, 0.f, 0.f, 0.f, 0.f, 0.f, 0.f, 0.f, 0.f};
#pragma unroll
      for (int ks = 0; ks < 4; ++ks) {
        const bf16x8 kf = *(const bf16x8*)(Ks + lds_off(32 * (wid + kb) + l31, 2 * ks + hi));
        st[kb] = __builtin_amdgcn_mfma_f32_32x32x16_bf16(kf, qf[ks], st[kb], 0, 0, 0);
      }
    }
    float m = -INFINITY;
#pragma unroll
    for (int kb = 0; kb < 5; ++kb)
#pragma unroll
      for (int i = 0; i < 16; ++i) {
        const int kirel = 32 * kb + (i & 3) + 8 * (i >> 2) + 4 * hi;
        const bool valid = (kirel >= l31) && (kirel <= l31 + 128) && (n > 0 || (32 * wid + kirel) >= 128);
        const float s = valid ? st[kb][i] : -INFINITY;
        st[kb][i] = s;
        m = fmaxf(m, s);
      }
    m = fmaxf(m, __shfl_xor(m, 32, 64));
    float l = 0.f;
#pragma unroll
    for (int kb = 0; kb < 5; ++kb)
#pragma unroll
      for (int i = 0; i < 16; ++i) { const float pe = __expf(st[kb][i] - m); st[kb][i] = pe; l += pe; }
    l += __shfl_xor(l, 32, 64);
    f32x16 o0 = (f32x16){0.f, 0.f, 0.f, 0.f, 0.f, 0.f, 0.f, 0.f, 0.f, 0.f, 0.f, 0.f, 0.f, 0.f, 0.f, 0.f};
    f32x16 o1 = o0;
#pragma unroll
    for (int kb = 0; kb < 5; ++kb)
#pragma unroll
      for (int s = 0; s < 2; ++s) {
        union { unsigned u[4]; bf16x8 v; } pa;
        pa.u[0] = cvtpk(st[kb][8 * s + 0], st[kb][8 * s + 1]); pa.u[1] = cvtpk(st[kb][8 * s + 2], st[kb][8 * s + 3]);
        pa.u[2] = cvtpk(st[kb][8 * s + 4], st[kb][8 * s + 5]); pa.u[3] = cvtpk(st[kb][8 * s + 6], st[kb][8 * s + 7]);
        const int key0 = 32 * (wid + kb) + 16 * s + 4 * hi;
        {
          union { uint2 u[2]; bf16x8 v; } vb;
          vb.u[0] = *(const uint2*)(VT + vt_off(l31, key0)); vb.u[1] = *(const uint2*)(VT + vt_off(l31, key0 + 8));
          o0 = __builtin_amdgcn_mfma_f32_32x32x16_bf16(pa.v, vb.v, o0, 0, 0, 0);
        }
        {
          union { uint2 u[2]; bf16x8 v; } vb;
          vb.u[0] = *(const uint2*)(VT + vt_off(32 + l31, key0)); vb.u[1] = *(const uint2*)(VT + vt_off(32 + l31, key0 + 8));
          o1 = __builtin_amdgcn_mfma_f32_32x32x16_bf16(pa.v, vb.v, o1, 0, 0, 0);
        }
      }
    if (hi == 0) {
      linv_s[wid * 32 + l31] = 1.f / l;
      LSE[((size_t)pp * T_TOK + tq) * 8 + h] = m + __logf(l);
    }
#pragma unroll
    for (int i = 0; i < 16; ++i) {
      const int qrel = (i & 3) + 8 * (i >> 2) + 4 * hi;
      const int iq2 = n * 128 + wid * 32 + qrel;
      const int tq2 = tb + (iq2 << dsh) + r;
      const float li = linv_s[wid * 32 + qrel];
      bf16_t* op = OP + ((size_t)pp * T_TOK + tq2) * 512 + h * 64 + l31;
      op[0] = f2bf(o0[i] * li);
      op[32] = f2bf(o1[i] * li);
    }
  }
}

__device__ __forceinline__ void phase_convert(const Params& p, char* smem) {
  int* ctl = (int*)(p.ws + OFF_CTL);
  int* slot = (int*)(smem + 66304);
  __syncthreads();
  int ti;
  for (;;) {
    if (threadIdx.x == 0) *slot = atomicAdd(&ctl[CTL_CONVQ], 1);
    __syncthreads();
    ti = *slot;
    __syncthreads();
    if (ti >= 6144) break;
    attn_item(p, smem, ti);
  }
  __builtin_amdgcn_sched_barrier(0);
  for (;;) {
    if (ti >= 6144 + CONV_TILES / 2) break;
    convert_tile2(p, smem, ti - 6144);
    if (threadIdx.x == 0) *slot = atomicAdd(&ctl[CTL_CONVQ], 1);
    __syncthreads();
    ti = *slot;
    __syncthreads();
  }
}

__device__ __forceinline__ void unpack8(const uint4 u, float (&f)[8]) {
  f[0] = __uint_as_float(u.x << 16); f[1] = __uint_as_float(u.x & 0xffff0000u); f[2] = __uint_as_float(u.y << 16); f[3] = __uint_as_float(u.y & 0xffff0000u);
  f[4] = __uint_as_float(u.z << 16); f[5] = __uint_as_float(u.z & 0xffff0000u); f[6] = __uint_as_float(u.w << 16); f[7] = __uint_as_float(u.w & 0xffff0000u);
}
__device__ __forceinline__ float dpp_sum8(float v) {
  v += DPP_F(v, 0xB1); v += DPP_F(v, 0x4E); v += DPP_F(v, 0x141);
  return v;
}
__device__ __forceinline__ void phase_post(const Params& p) {
  const float* __restrict__ YS = (const float*)(p.ws + OFF_YS); const bf16_t* __restrict__ V2 = (const bf16_t*)(p.ws + OFF_V2);
  const bf16_t* __restrict__ G = (const bf16_t*)(p.ws + OFF_G); const float* __restrict__ SB = (const float*)(p.ws + OFF_SB);
  const bf16_t* __restrict__ OP = (const bf16_t*)(p.ws + OFF_OP); const float* __restrict__ LSE = (const float*)(p.ws + OFF_LSE);
  const float* __restrict__ lnx_g = p.in[11]; const float* __restrict__ lnx_b = p.in[12];
  bf16_t* MIXED = (bf16_t*)(p.ws + OFF_MIXED);
  const int lane = threadIdx.x & 63, wid = threadIdx.x >> 6;
  const int c = lane * 8, hh = lane >> 3;
  const float4 g0 = *(const float4*)(lnx_g + c), g1 = *(const float4*)(lnx_g + c + 4), b0 = *(const float4*)(lnx_b + c), b1 = *(const float4*)(lnx_b + c + 4);
  const float gg[8] = {g0.x, g0.y, g0.z, g0.w, g1.x, g1.y, g1.z, g1.w}, bb[8] = {b0.x, b0.y, b0.z, b0.w, b1.x, b1.y, b1.z, b1.w};
  for (int t = blockIdx.x * 4 + wid; t < T_TOK; t += gridDim.x * 4) {
    const size_t o = (size_t)t * 512 + c;
    const float4 y0 = *(const float4*)(YS + o), y1 = *(const float4*)(YS + o + 4);
    const float y[8] = {y0.x, y0.y, y0.z, y0.w, y1.x, y1.y, y1.z, y1.w};
    float s = 0.f;
#pragma unroll
    for (int i = 0; i < 8; ++i) s += y[i];
    const float mean = dpp_sum8(s) * (1.f / 64.f);
    float q = 0.f;
#pragma unroll
    for (int i = 0; i < 8; ++i) { const float d = y[i] - mean; q += d * d; }
    const float rs = rsqrtf(dpp_sum8(q) * (1.f / 64.f) + GN_EPS_F);
    float v2[8], gt[8];
    unpack8(*(const uint4*)(V2 + o), v2); unpack8(*(const uint4*)(G + o), gt);
    const float sb = SB[(size_t)t * 8 + hh];
    float res[8];
#pragma unroll
    for (int i = 0; i < 8; ++i) res[i] = ((y[i] - mean) * rs * gg[i] + bb[i] + sb * v2[i]) * gt[i];
    uint4 w; w.x = cvtpk(res[0], res[1]); w.y = cvtpk(res[2], res[3]); w.z = cvtpk(res[4], res[5]); w.w = cvtpk(res[6], res[7]);
    *(uint4*)(MIXED + (size_t)t * 1024 + 512 + c) = w;
    const float l0 = LSE[((size_t)0 * T_TOK + t) * 8 + hh], l1 = LSE[((size_t)1 * T_TOK + t) * 8 + hh], l2 = LSE[((size_t)2 * T_TOK + t) * 8 + hh];
    const float mx = fmaxf(l0, fmaxf(l1, l2));
    float e0 = __expf(l0 - mx), e1 = __expf(l1 - mx), e2 = __expf(l2 - mx);
    const float inv = 1.f / (e0 + e1 + e2);
    e0 *= inv; e1 *= inv; e2 *= inv;
    float o0[8], o1[8], o2[8];
    unpack8(*(const uint4*)(OP + (size_t)0 * T_TOK * 512 + o), o0); unpack8(*(const uint4*)(OP + (size_t)1 * T_TOK * 512 + o), o1);
    unpack8(*(const uint4*)(OP + (size_t)2 * T_TOK * 512 + o), o2);
    float av[8];
#pragma unroll
    for (int i = 0; i < 8; ++i) av[i] = e0 * o0[i] + e1 * o1[i] + e2 * o2[i];
    w.x = cvtpk(av[0], av[1]); w.y = cvtpk(av[2], av[3]); w.z = cvtpk(av[4], av[5]); w.w = cvtpk(av[6], av[7]);
    *(uint4*)(MIXED + (size_t)t * 1024 + c) = w;
  }
}

__device__ __forceinline__ void phase_outproj(const Params& p, char* smem) {
  const bf16_t* __restrict__ MIXED = (const bf16_t*)(p.ws + OFF_MIXED);
  const bf16_t* __restrict__ WOUTT = (const bf16_t*)(p.ws + OFF_WOUTT); const float* __restrict__ x = p.in[0];
  float* U = p.out;
  for (int i = XCD_LB; i < T_TOK / 128; i += XCD_NB) {
    const int row0 = i * 128, col0 = XCD_GROUP * 128;
    gemm128_glds(smem, DM,
            [=](int r) { return MIXED + (size_t)(row0 + r) * DM; },
            [=](int r) { return WOUTT + (size_t)(col0 + r) * DM; },
            [=](f32x4 (&acc)[4][4], int wr, int wc, int fr, int fq) {
#pragma unroll
              for (int m = 0; m < 4; ++m) {
                const int t = row0 + wr * 64 + m * 16 + fr;
#pragma unroll
                for (int n = 0; n < 4; ++n) {
                  const size_t o = (size_t)t * DM + col0 + wc * 64 + n * 16 + fq * 4;
                  const float4 xv = *(const float4*)(x + o);
                  *(float4*)(U + o) = make_float4(ALPHA_F * xv.x + acc[m][n][0], ALPHA_F * xv.y + acc[m][n][1], ALPHA_F * xv.z + acc[m][n][2], ALPHA_F * xv.w + acc[m][n][3]);
                }
              }
            });
  }
}

__device__ __forceinline__ void phase_ln1(const Params& p) {
  float* X1 = p.out;
  const float* __restrict__ g1 = p.in[14]; const float* __restrict__ b1 = p.in[15];
  bf16_t* X1B = (bf16_t*)(p.ws + OFF_X1B);
  const int lane = threadIdx.x & 63, wid = threadIdx.x >> 6;
  for (int t = blockIdx.x * 4 + wid; t < T_TOK; t += gridDim.x * 4) {
    const size_t base = (size_t)t * DM;
    float4 v[4];
    float s = 0.f;
#pragma unroll
    for (int u = 0; u < 4; ++u) { v[u] = *(const float4*)(X1 + base + u * 256 + lane * 4); s += (v[u].x + v[u].y) + (v[u].z + v[u].w); }
    const float mean = wave_sum_fast(s) * (1.f / DM);
    float q = 0.f;
#pragma unroll
    for (int u = 0; u < 4; ++u) {
      const float d0 = v[u].x - mean, d1 = v[u].y - mean, d2 = v[u].z - mean, d3 = v[u].w - mean;
      q += (d0 * d0 + d1 * d1) + (d2 * d2 + d3 * d3);
    }
    const float rs = rsqrtf(wave_sum_fast(q) * (1.f / DM) + LN_EPS_F);
#pragma unroll
    for (int u = 0; u < 4; ++u) {
      const int c = u * 256 + lane * 4;
      const float4 g = *(const float4*)(g1 + c), bb = *(const float4*)(b1 + c);
      float4 y;
      y.x = (v[u].x - mean) * rs * g.x + bb.x; y.y = (v[u].y - mean) * rs * g.y + bb.y;
      y.z = (v[u].z - mean) * rs * g.z + bb.z; y.w = (v[u].w - mean) * rs * g.w + bb.w;
      *(float4*)(X1 + base + c) = y;
      uint2 hi; hi.x = cvtpk(y.x, y.y); hi.y = cvtpk(y.z, y.w);
      *(uint2*)(X1B + base + c) = hi;
    }
  }
}

__device__ __forceinline__ void phase_router_gemm(const Params& p, char* smem) {
  const bf16_t* __restrict__ X1B = (const bf16_t*)(p.ws + OFF_X1B);
  const float* __restrict__ router_w = p.in[16];
  float* AFF = (float*)(p.ws + OFF_AFF);
  for (int item = blockIdx.x; item < (T_TOK / 128) * 2; item += gridDim.x) {
    const int row0 = (item >> 1) * 128, col0 = (item & 1) * 128;
    f32x4 acc[4][4];
    acc_zero(acc);
    gemm128_acc<2, false>(acc, smem, 32,
        [=](int, int rowl, int kc) { return *(const uint4*)(X1B + (size_t)(row0 + rowl) * DM + (kc & 127) * 8); },
        [=](int nq) { return router_w + col0 + nq * 4; }, NEXP, 16);
    const int tid = threadIdx.x, lane = tid & 63, wid = tid >> 6;
    const int wr = wid >> 1, wc = wid & 1, fr = lane & 15, fq = lane >> 4;
#pragma unroll
    for (int m = 0; m < 4; ++m) {
      const int t = row0 + wr * 64 + m * 16 + fr;
#pragma unroll
      for (int n = 0; n < 4; ++n)
        *(float4*)(AFF + (size_t)t * NEXP + col0 + wc * 64 + n * 16 + fq * 4) =
            make_float4(sigmoidf_(acc[m][n][0]), sigmoidf_(acc[m][n][1]), sigmoidf_(acc[m][n][2]), sigmoidf_(acc[m][n][3]));
    }
  }
}

__device__ __forceinline__ void phase_topk(const Params& p) {
  const float* __restrict__ AFF = (const float*)(p.ws + OFF_AFF);
  const float* __restrict__ router_bias = p.in[17];
  int* LIST = (int*)(p.ws + OFF_LIST); float* GATEW = (float*)(p.ws + OFF_GATEW);
  int* counts = (int*)(p.ws + OFF_CTL);
  const int lane = threadIdx.x & 63, wid = threadIdx.x >> 6;
  const float4 b4 = *(const float4*)(router_bias + lane * 4);
  for (int t = blockIdx.x * 4 + wid; t < T_TOK; t += gridDim.x * 4) {
    const float4 a4 = *(const float4*)(AFF + (size_t)t * NEXP + lane * 4);
    float s0 = a4.x + b4.x, s1 = a4.y + b4.y, s2 = a4.z + b4.z, s3 = a4.w + b4.w;
    const float hi01 = fmaxf(s0, s1), lo01 = fminf(s0, s1), hi23 = fmaxf(s2, s3), lo23 = fminf(s2, s3);
    float m1 = fmaxf(hi01, hi23), m2 = fmaxf(fminf(hi01, hi23), fmaxf(lo01, lo23));
    { const float o1 = DPP_F(m1, 0xB1), o2 = DPP_F(m2, 0xB1); const float n1 = fmaxf(m1, o1); m2 = fmaxf(fminf(m1, o1), fmaxf(m2, o2)); m1 = n1; }
    { const float o1 = DPP_F(m1, 0x4E), o2 = DPP_F(m2, 0x4E); const float n1 = fmaxf(m1, o1); m2 = fmaxf(fminf(m1, o1), fmaxf(m2, o2)); m1 = n1; }
    { const float o1 = DPP_F(m1, 0x141), o2 = DPP_F(m2, 0x141); const float n1 = fmaxf(m1, o1); m2 = fmaxf(fminf(m1, o1), fmaxf(m2, o2)); m1 = n1; }
    const float gs = m1 + m2;
    const int g = lane >> 3;
    int rank = 0;
#pragma unroll
    for (int gg = 0; gg < 8; ++gg) { const float G = rdlane_f(gs, gg * 8); rank += ((G > gs) || (G == gs && gg < g)) ? 1 : 0; }
    if (rank >= 4) { s0 = -INFINITY; s1 = -INFINITY; s2 = -INFINITY; s3 = -INFINITY; }
    int my_e = 0; float my_a = 0.f;
#pragma unroll 1
    for (int it = 0; it < 8; ++it) {
      const float lm = fmaxf(fmaxf(s0, s1), fmaxf(s2, s3));
      const float wm = wave_max_fast(lm);
      const unsigned long long bal = __ballot(lm == wm);
      const int win = __ffsll((long long)bal) - 1;
      const int wi = (s0 == wm) ? 0 : ((s1 == wm) ? 1 : ((s2 == wm) ? 2 : 3));
      const float wa = (wi == 0) ? a4.x : ((wi == 1) ? a4.y : ((wi == 2) ? a4.z : a4.w));
      const int e_w = __builtin_amdgcn_readlane(lane * 4 + wi, win);
      const float a_w = rdlane_f(wa, win);
      if (lane == win) { if (wi == 0) s0 = -INFINITY; else if (wi == 1) s1 = -INFINITY; else if (wi == 2) s2 = -INFINITY; else s3 = -INFINITY; }
      if (lane == it) { my_e = e_w; my_a = a_w; }
    }
    const float asum = rdlane_f(dpp_sum16x(my_a), 0);
    if (lane < 8) {
      const int pos = atomicAdd(&counts[my_e], 1);
      if (pos < LCAP) LIST[(size_t)my_e * LCAP + pos] = lane * T_TOK + t;
      GATEW[(size_t)lane * T_TOK + t] = my_a * 2.5f / asum;
    }
  }
}

__device__ __forceinline__ int moe_group_setup(const int* counts, int* pre) {
  __syncthreads();
  if (threadIdx.x == 0) {
    const int g = XCD_GROUP;
    int acc = 0;
    for (int j = 0; j < 32; ++j) { pre[j] = acc; acc += (min(counts[g + 8 * j], LCAP) + 127) >> 7; }
    pre[32] = acc; acc += 32;
    pre[33] = acc;
  }
  __syncthreads();
  return pre[33];
}
__device__ __forceinline__ void phase_moe(const Params& p, char* smem) {
  int* asg = (int*)(smem + 65536); int* pre = asg + 128;
  const bf16_t* __restrict__ X1B = (const bf16_t*)(p.ws + OFF_X1B);
  const bf16_t* __restrict__ EW1 = (const bf16_t*)(p.ws + OFF_EW1); const bf16_t* __restrict__ EW2 = (const bf16_t*)(p.ws + OFF_EW2);
  const int* __restrict__ LIST = (const int*)(p.ws + OFF_LIST);
  const float* __restrict__ GATEW = (const float*)(p.ws + OFF_GATEW);
  const int* counts = (const int*)(p.ws + OFF_CTL);
  bf16_t* Y = (bf16_t*)(p.ws + OFF_Y);
  bf16_t* HS = (bf16_t*)(p.ws + OFF_HSCR) + (size_t)blockIdx.x * 128 * 256;
  float* X1 = p.out;
  const int nitems = moe_group_setup(counts, pre);
  for (int i = XCD_LB; i < nitems; i += XCD_NB) {
    int j = 0;
#pragma unroll 1
    for (int q = 1; q <= 32; ++q) j = (pre[q] <= i) ? q : j;
    const int w = i - pre[j];
    const int e = (j < 32) ? (XCD_GROUP + 8 * j) : NEXP;
    const int cnt = (j < 32) ? min(counts[e], LCAP) : T_TOK;
    const int r0 = (j < 32) ? w * 128 : (XCD_GROUP * 32 + w) * 128;
    __syncthreads();
    if (threadIdx.x < 128) {
      const int r = r0 + threadIdx.x;
      asg[threadIdx.x] = (r < cnt) ? ((e < NEXP) ? LIST[(size_t)e * LCAP + r] : (8 * T_TOK + r)) : -1;
    }
    __syncthreads();
    const bf16_t* __restrict__ W1 = EW1 + (size_t)e * 512 * 1024;
    const bf16_t* __restrict__ W2 = EW2 + (size_t)e * 1024 * 256;
    gemm128_glds_multi<4, 16>(smem,
            [=](int r) { int a = asg[r]; return X1B + (size_t)((a >= 0 ? a : 0) & (T_TOK - 1)) * DM; },
            [=](int r) { return W1 + (size_t)r * DM; }, (size_t)128 * DM,
            [=](int nt, f32x4 (&acc)[4][4], int wr, int wc, int fr, int fq) {
#pragma unroll
              for (int m = 0; m < 4; ++m) {
                const int row = wr * 64 + m * 16 + fr;
#pragma unroll
                for (int n = 0; n < 2; ++n) {
                  float hv[4];
#pragma unroll
                  for (int jj = 0; jj < 4; ++jj) { const float g = acc[m][n][jj], u = acc[m][n + 2][jj]; hv[jj] = g * sigmoidf_(g) * u; }
                  *(uint2*)(HS + (size_t)row * 256 + nt * 64 + wc * 32 + n * 16 + fq * 4) = pack4(hv[0], hv[1], hv[2], hv[3]);
                }
              }
            });
    __syncthreads();
    gemm128_glds_multi<8, 4>(smem,
            [=](int r) { return HS + (size_t)r * 256; },
            [=](int r) { return W2 + (size_t)r * 256; }, (size_t)128 * 256,
            [=](int nt, f32x4 (&acc)[4][4], int wr, int wc, int fr, int fq) {
#pragma unroll
              for (int m = 0; m < 4; ++m) {
                const int a = asg[wr * 64 + m * 16 + fr];
                if (a < 0) continue;
                if (a < 8 * T_TOK) {
                  const float gw = GATEW[a];
#pragma unroll
                  for (int n = 0; n < 4; ++n)
                    *(uint2*)(Y + (size_t)a * DM + nt * 128 + wc * 64 + n * 16 + fq * 4) =
                        pack4(acc[m][n][0] * gw, acc[m][n][1] * gw, acc[m][n][2] * gw, acc[m][n][3] * gw);
                } else {
                  const int t = a - 8 * T_TOK;
#pragma unroll
                  for (int n = 0; n < 4; ++n) {
                    float* xp = X1 + (size_t)t * DM + nt * 128 + wc * 64 + n * 16 + fq * 4;
                    const float4 xv = *(const float4*)xp;
                    *(float4*)xp = make_float4(ALPHA_F * xv.x + acc[m][n][0], ALPHA_F * xv.y + acc[m][n][1], ALPHA_F * xv.z + acc[m][n][2], ALPHA_F * xv.w + acc[m][n][3]);
                  }
                }
              }
            });
  }
}

__device__ __forceinline__ void phase_final(const Params& p, char* smem) {
  float* OUT = p.out;
  const bf16_t* __restrict__ Y = (const bf16_t*)(p.ws + OFF_Y);
  const float* __restrict__ g2 = p.in[24]; const float* __restrict__ b2 = p.in[25];
  const int lane = threadIdx.x & 63, wid = threadIdx.x >> 6;
  for (int t = blockIdx.x * 4 + wid; t < T_TOK; t += gridDim.x * 4) {
    const size_t base = (size_t)t * DM;
    float4 v[4];
    float s = 0.f;
#pragma unroll
    for (int u = 0; u < 4; ++u) {
      const int c = u * 256 + lane * 4;
      const float4 xv = *(const float4*)(OUT + base + c);
      float a0 = 0.f, a1 = 0.f, a2 = 0.f, a3 = 0.f;
#pragma unroll
      for (int sl = 0; sl < 8; ++sl) {
        const float4 yv = bf4_to_f4(*(const uint2*)(Y + ((size_t)sl * T_TOK + t) * DM + c));
        a0 += yv.x; a1 += yv.y; a2 += yv.z; a3 += yv.w;
      }
      v[u] = make_float4(xv.x + a0, xv.y + a1, xv.z + a2, xv.w + a3);
      s += (v[u].x + v[u].y) + (v[u].z + v[u].w);
    }
    const float mean = wave_sum_fast(s) * (1.f / DM);
    float q = 0.f;
#pragma unroll
    for (int u = 0; u < 4; ++u) {
      const float d0 = v[u].x - mean, d1 = v[u].y - mean, d2 = v[u].z - mean, d3 = v[u].w - mean;
      q += (d0 * d0 + d1 * d1) + (d2 * d2 + d3 * d3);
    }
    const float rs = rsqrtf(wave_sum_fast(q) * (1.f / DM) + LN_EPS_F);
#pragma unroll
    for (int u = 0; u < 4; ++u) {
      const int c = u * 256 + lane * 4;
      const float4 g = *(const float4*)(g2 + c), bb = *(const float4*)(b2 + c);
      *(float4*)(OUT + base + c) = make_float4((v[u].x - mean) * rs * g.x + bb.x, (v[u].y - mean) * rs * g.y + bb.y,
                                               (v[u].z - mean) * rs * g.z + bb.z, (v[u].w - mean) * rs * g.w + bb.w);
    }
  }
}

#define LAS __attribute__((address_space(3)))
#define XB_TMO      128
#define XB_XCNT(j)  (256  + 64 * (j))
#define XB_XSUB(j)  (1280 + 64 * (j))
#define XB_XGEN(j)  (2304 + 64 * (j))
#define XB_TOP      3328
#define XB_TOPGEN   3392
#define XCD_BAR_WORDS 3456
#define XB_SPIN_CAP (1u << 22)
__device__ __forceinline__ unsigned xb_ld(unsigned* p)              { return __hip_atomic_load(p, __ATOMIC_RELAXED, __HIP_MEMORY_SCOPE_AGENT); }
__device__ __forceinline__ unsigned xb_add(unsigned* p, unsigned v) { return __hip_atomic_fetch_add(p, v, __ATOMIC_RELAXED, __HIP_MEMORY_SCOPE_AGENT); }
__device__ __forceinline__ unsigned xb_xcc_id() { return (unsigned)__builtin_amdgcn_s_getreg((3 << 11) | 20) & 0xFu; }
#define XB_SPIN(cond, bar) do { unsigned _sp = 0; while (cond) { __builtin_amdgcn_s_sleep(1); \
    if ((++_sp & 255u) == 0u) { if (xb_ld(&(bar)[XB_TMO])) break; if (_sp > XB_SPIN_CAP) { atomicAdd(&(bar)[XB_TMO], 1u); break; } } } } while (0)
struct XcdBarrier { unsigned* bar; unsigned x; volatile LAS unsigned* st; };
__device__ __forceinline__ XcdBarrier xcd_barrier_post(unsigned* bar, volatile LAS unsigned* st) {
  XcdBarrier b; b.bar = bar; b.x = xb_xcc_id(); b.st = st;
  if (threadIdx.x == 0) (void)xb_add(&bar[XB_XCNT(b.x)], 1u);
  return b;
}
__device__ __forceinline__ void xcd_barrier_complete(unsigned* bar, unsigned x, unsigned& nloc, unsigned& nx) {
  const unsigned G = gridDim.x * gridDim.y * gridDim.z;
  unsigned sum, cnt, mine, sp = 0u;
  for (;;) {
    sum = 0u; cnt = 0u; mine = 0u;
#pragma unroll
    for (unsigned j = 0; j < 16; ++j) { const unsigned c = xb_ld(&bar[XB_XCNT(j)]); sum += c; cnt += (c > 0u) ? 1u : 0u; mine = (j == x) ? c : mine; }
    if (sum == G) break;
    __builtin_amdgcn_s_sleep(1);
    if ((++sp & 255u) == 0u) { if (xb_ld(&bar[XB_TMO])) break; if (sp > XB_SPIN_CAP) { atomicAdd(&bar[XB_TMO], 1u); break; } }
  }
  nloc = mine > 0u ? mine : 1u; nx = cnt > 0u ? cnt : 1u;
}
__device__ __forceinline__ void xcd_barrier(const XcdBarrier& b) {
  asm volatile("s_waitcnt vmcnt(0)" ::: "memory");
  __syncthreads();
  if (threadIdx.x == 0) {
    unsigned* bar = b.bar;
    __builtin_amdgcn_s_waitcnt(0);
    unsigned nloc = b.st[0], nx = b.st[1];
    if (nloc == 0u) { xcd_barrier_complete(bar, b.x, nloc, nx); b.st[0] = nloc; b.st[1] = nx; }
    const unsigned old = xb_add(&bar[XB_XSUB(b.x)], 1u);
    const unsigned gen = old / nloc;
    if (old + 1u == (gen + 1u) * nloc) {
      __builtin_amdgcn_fence(__ATOMIC_RELEASE, "agent");
      asm volatile("s_waitcnt vmcnt(0)" ::: "memory");
      const unsigned og = xb_add(&bar[XB_TOP], 1u);
      const unsigned tg = og / nx;
      if (og + 1u == (tg + 1u) * nx) xb_add(&bar[XB_TOPGEN], 1u);
      else XB_SPIN(xb_ld(&bar[XB_TOPGEN]) == tg, bar);
      __builtin_amdgcn_fence(__ATOMIC_ACQUIRE, "agent");
      xb_add(&bar[XB_XGEN(b.x)], 1u);
      asm volatile("s_waitcnt vmcnt(0)" ::: "memory");
    } else {
      XB_SPIN(xb_ld(&bar[XB_XGEN(b.x)]) == gen, bar);
      __builtin_amdgcn_fence(__ATOMIC_ACQUIRE, "agent");
      asm volatile("s_waitcnt vmcnt(0)" ::: "memory");
    }
  }
  __syncthreads();
}
#define CTL_BAR_WORD 4096
#define CTL_ZERO_BYTES 32768
#define LDS_BAR_OFF 66432

__global__ void __launch_bounds__(NTHR, 2) mega(Params p) {
  extern __shared__ __attribute__((aligned(16))) char smem[];
  cg::grid_group grid = cg::this_grid();
  volatile LAS unsigned* bst = (volatile LAS unsigned*)(LAS char*)(smem + LDS_BAR_OFF);
  if (threadIdx.x < 2) bst[threadIdx.x] = 0u;
  __syncthreads();
  const XcdBarrier bar = xcd_barrier_post((unsigned*)(p.ws + OFF_CTL) + CTL_BAR_WORD, bst);
  phase_rope(p);
  if (p.ws == nullptr) grid.sync();
  xcd_barrier(bar);
  phase_inproj(p, smem);
  xcd_barrier(bar);
  phase_prep_a(p);
  xcd_barrier(bar);
  phase_prep(p, smem);
  xcd_barrier(bar);
  phase_scan(p, smem);
  phase_convert(p, smem);
  xcd_barrier(bar);
  phase_post(p);
  xcd_barrier(bar);
  phase_outproj(p, smem);
  xcd_barrier(bar);
  phase_ln1(p);
  xcd_barrier(bar);
  phase_router_gemm(p, smem);
  xcd_barrier(bar);
  phase_topk(p);
  xcd_barrier(bar);
  phase_moe(p, smem);
  xcd_barrier(bar);
  phase_final(p, smem);
}

extern "C" void kernel_launch(void* const* d_in, const int* in_sizes, int n_in, void* d_out, int out_size, void* d_ws, size_t ws_size,
                              hipStream_t stream) {
  static int grid_blocks = 0;
  if (grid_blocks == 0) {
    if (ws_size < WS_NEED || n_in != 26) { fprintf(stderr, "kernel_launch: bad ws/n_in: %zu < %zu, n_in %d\n", ws_size, (size_t)WS_NEED, n_in); grid_blocks = -1; return; }
    int dev = 0, cus = 0, per_cu = 0;
    (void)hipGetDevice(&dev);
    (void)hipDeviceGetAttribute(&cus, hipDeviceAttributeMultiprocessorCount, dev);
    (void)hipFuncSetAttribute((const void*)mega, hipFuncAttributeMaxDynamicSharedMemorySize, LDS_BYTES);
    (void)hipOccupancyMaxActiveBlocksPerMultiprocessor(&per_cu, (const void*)mega, NTHR, LDS_BYTES);
    if (per_cu < 1) { fprintf(stderr, "kernel_launch: occupancy query returned %d\n", per_cu); grid_blocks = -1; return; }
    if (per_cu > 2) per_cu = 2;
    grid_blocks = cus * per_cu;
    if (grid_blocks > 512) grid_blocks = 512;
    fprintf(stderr, "kernel_launch: cus %d per_cu %d grid %d\n", cus, per_cu, grid_blocks);
  }
  if (grid_blocks < 0) return;
  if (hipMemsetAsync((char*)d_ws + OFF_CTL, 0, CTL_ZERO_BYTES, stream) != hipSuccess) { fprintf(stderr, "kernel_launch: memset failed\n"); return; }
  Params p{};
  for (int i = 0; i < 26; ++i) p.in[i] = (const float*)d_in[i];
  p.out = (float*)d_out;
  p.ws = (char*)d_ws;
  void* args[] = {&p};
  hipError_t e = hipLaunchCooperativeKernel((const void*)mega, dim3(grid_blocks), dim3(NTHR), args, LDS_BYTES, stream);
  if (e != hipSuccess) fprintf(stderr, "cooperative launch failed: %s (grid %d)\n", hipGetErrorString(e), grid_blocks);
}
```

```cpp
#include <hip/hip_runtime.h>
#include <hip/hip_bf16.h>
#include <hip/hip_cooperative_groups.h>
#include <stdint.h>
#include <stdio.h>

typedef unsigned short bf16_t;

#define T_TOK 32768
#define SEQ 4096
#define DM 1024
#define INW 3360
#define FEW 1824
#define NEXP 256
#define ALPHA_F 1.189207115002721f
#define LN_EPS_F 1e-5f
#define GN_EPS_F 64e-5f

__device__ __forceinline__ float bf2f(bf16_t v) { return __uint_as_float(((unsigned)v) << 16); }
__device__ __forceinline__ bf16_t f2bf(float f) { unsigned u = __float_as_uint(f); return (bf16_t)((u + 0x7fffu + ((u >> 16) & 1u)) >> 16); }
__device__ __forceinline__ float sigmoidf_(float x) { return 1.f / (1.f + __expf(-x)); }
__device__ __forceinline__ float wave_sum(float v) {
#pragma unroll
  for (int o = 32; o >= 1; o >>= 1) v += __shfl_xor(v, o, 64);
  return v;
}

constexpr size_t SZ_T512_BF = (size_t)T_TOK * 512 * 2;
constexpr size_t OFF_EW1 = 0;
constexpr size_t OFF_EW2 = OFF_EW1 + (size_t)257 * 512 * 1024 * 2;
constexpr size_t LBASE = OFF_EW2 + (size_t)257 * 1024 * 256 * 2;
constexpr size_t OFF_XB = 0;
constexpr size_t OFF_FEATS = OFF_XB + (size_t)T_TOK * 1024 * 2;
constexpr size_t OFF_ACT = OFF_FEATS + (size_t)T_TOK * FEW * 2;
constexpr size_t OFF_WINT = OFF_ACT + (size_t)T_TOK * 320 * 2;
constexpr size_t OFF_ROPE = OFF_WINT + (size_t)3456 * 1024 * 2;
static_assert(OFF_ROPE + (size_t)4096 * 32 * 2 * 4 <= LBASE, "early region E overlay");
constexpr size_t OFF_Q = LBASE;
constexpr size_t OFF_K = OFF_Q + SZ_T512_BF;
constexpr size_t OFF_V = OFF_K + SZ_T512_BF;
constexpr size_t OFF_R = OFF_V + SZ_T512_BF;
constexpr size_t OFF_K2 = OFF_R + SZ_T512_BF;
constexpr size_t OFF_V2 = OFF_K2 + SZ_T512_BF;
constexpr size_t OFF_A = OFF_V2 + SZ_T512_BF;
constexpr size_t OFF_B = OFF_A + SZ_T512_BF;
constexpr size_t OFF_W = OFF_B + SZ_T512_BF;
constexpr size_t OFF_G = OFF_W + (size_t)T_TOK * 512 * 4;
constexpr size_t OFF_SB = OFF_G + SZ_T512_BF;
constexpr size_t OFF_YS = OFF_SB + (size_t)T_TOK * 8 * 4;
constexpr size_t OFF_OP = OFF_YS + (size_t)T_TOK * 512 * 4;
constexpr size_t OFF_LSE = OFF_OP + 3 * SZ_T512_BF;
constexpr size_t OFF_MIXED = OFF_LSE + (size_t)3 * T_TOK * 8 * 4;
constexpr size_t OFF_WOUTT = OFF_MIXED + (size_t)T_TOK * 1024 * 2;
constexpr size_t EARLY_END = OFF_WOUTT + (size_t)1024 * 1024 * 2;
constexpr size_t OFF_Y = LBASE;
constexpr size_t OFF_AFF = LBASE + (size_t)T_TOK * 1024 * 2;
constexpr size_t OFF_X1B = OFF_Y + (size_t)8 * T_TOK * 1024 * 2;
#define LCAP 16384
constexpr size_t OFF_LIST = OFF_X1B + (size_t)T_TOK * 1024 * 2;
constexpr size_t OFF_GATEW = OFF_LIST + (size_t)NEXP * LCAP * 4;
constexpr size_t OFF_HSCR = OFF_GATEW + (size_t)8 * T_TOK * 4;
constexpr size_t OFF_CTL = OFF_HSCR + (size_t)512 * 128 * 256 * 2;
constexpr size_t CTL_BYTES = 1u << 20;
constexpr size_t WS_NEED = OFF_CTL + CTL_BYTES;
static_assert(EARLY_END <= OFF_HSCR, "early buffers must stay below the per-block scratch / control words");
static_assert(WS_NEED <= (size_t)1073741824, "workspace must fit 1 GiB");
#define CTL_CONVQ 512

typedef short bf16x8 __attribute__((ext_vector_type(8)));
typedef float f32x4 __attribute__((ext_vector_type(4)));
typedef float f32x16 __attribute__((ext_vector_type(16)));
typedef float f32x2_t __attribute__((ext_vector_type(2)));
typedef __bf16 bf16x2_t __attribute__((ext_vector_type(2)));
__device__ __forceinline__ unsigned cvtpk(float lo, float hi) { f32x2_t v = {lo, hi}; bf16x2_t b = __builtin_convertvector(v, bf16x2_t); return __builtin_bit_cast(unsigned, b); }

__device__ const double INVF[32] = {
1, 0.74989420933245587, 0.56234132519034907, 0.42169650342858223, 0.31622776601683794, 0.23713737056616552,
0.17782794100389229, 0.1333521432163324, 0.10000000000000001, 0.074989420933245579, 0.056234132519034911,
0.042169650342858224, 0.031622776601683791, 0.023713737056616554, 0.017782794100389229, 0.013335214321633241,
0.01, 0.0074989420933245579, 0.005623413251903491, 0.0042169650342858229, 0.0031622776601683794,
0.0023713737056616554, 0.0017782794100389228, 0.0013335214321633241, 0.001, 0.00074989420933245586,
0.0005623413251903491, 0.00042169650342858224, 0.00031622776601683794, 0.00023713737056616554,
0.00017782794100389227, 0.0001333521432163324};

namespace cg = cooperative_groups;

struct Params {
  const float* in[26];
  float* out;
  char* ws;
};

#define NTHR 256
#define LDS_BYTES 66560

__device__ __forceinline__ void phase_rope(const Params& p) {
  float* tab = (float*)(p.ws + OFF_ROPE);
  for (int i = blockIdx.x * NTHR + threadIdx.x; i < 4096 * 32; i += gridDim.x * NTHR) {
    int pos = i >> 5, f = i & 31;
    double ang = (double)pos * INVF[f];
    const double TWO_PI = 6.283185307179586476925286766559;
    double n = rint(ang / TWO_PI);
    double r = ang - n * TWO_PI;
    double r2 = r * r;
    double sn = r, cs = 1.0, ts = r, tc = 1.0;
#pragma unroll 1
    for (int k = 1; k <= 16; ++k) {
      tc = -tc * r2 / (double)((2 * k - 1) * (2 * k));
      ts = -ts * r2 / (double)((2 * k) * (2 * k + 1));
      cs += tc; sn += ts;
    }
    tab[i * 2] = (float)cs; tab[i * 2 + 1] = (float)sn;
  }
  {
    const float* __restrict__ w_in = p.in[1]; const float* __restrict__ w_out = p.in[13];
    uint4* wint = (uint4*)(p.ws + OFF_WINT); uint4* woutt = (uint4*)(p.ws + OFF_WOUTT);
    const int NJ1 = 3456 * 128, NJ2 = 1024 * 128;
    for (int i = blockIdx.x * NTHR + threadIdx.x; i < NJ1 + NJ2; i += gridDim.x * NTHR) {
      const bool second = i >= NJ1;
      const int q = second ? i - NJ1 : i;
      const int N = second ? 1024 : 3456, NV = second ? 1024 : INW;
      const int n = q % N, ko = q / N;
      const float* __restrict__ src = second ? w_out : w_in;
      float f[8];
#pragma unroll
      for (int u = 0; u < 8; ++u) f[u] = (n < NV) ? src[(size_t)(ko * 8 + u) * NV + n] : 0.f;
      uint4 w; w.x = cvtpk(f[0], f[1]); w.y = cvtpk(f[2], f[3]); w.z = cvtpk(f[4], f[5]); w.w = cvtpk(f[6], f[7]);
      (second ? woutt : wint)[(size_t)n * 128 + ko] = w;
    }
  }
  {
    const float4* __restrict__ x4 = (const float4*)p.in[0];
    uint4* xb = (uint4*)(p.ws + OFF_XB);
    for (size_t i = (size_t)blockIdx.x * NTHR + threadIdx.x; i < (size_t)T_TOK * DM / 8; i += (size_t)gridDim.x * NTHR) {
      float4 a = x4[2 * i], b = x4[2 * i + 1];
      uint4 w; w.x = cvtpk(a.x, a.y); w.y = cvtpk(a.z, a.w); w.z = cvtpk(b.x, b.y); w.w = cvtpk(b.z, b.w);
      xb[i] = w;
    }
  }
}

template <class AF, class BF>
__device__ __forceinline__ void gemm64_naive(float* As, float* Bs, float* Cs, int K, AF af, BF bf) {
  const int tid = threadIdx.x, tx = tid & 15, ty = tid >> 4;
  float acc[4][4];
#pragma unroll
  for (int i = 0; i < 4; ++i)
#pragma unroll
    for (int j = 0; j < 4; ++j) acc[i][j] = 0.f;
  for (int k0 = 0; k0 < K; k0 += 16) {
#pragma unroll
    for (int u = 0; u < 4; ++u) { int i = tid + u * 256; int r = i >> 4, kk = i & 15; As[kk * 68 + r] = af(r, k0 + kk); }
#pragma unroll
    for (int u = 0; u < 4; ++u) { int i = tid + u * 256; int kk = i >> 6, c = i & 63; Bs[kk * 68 + c] = bf(k0 + kk, c); }
    __syncthreads();
#pragma unroll
    for (int kk = 0; kk < 16; ++kk) {
      float a[4], b[4];
#pragma unroll
      for (int i = 0; i < 4; ++i) { a[i] = As[kk * 68 + ty * 4 + i]; b[i] = Bs[kk * 68 + tx * 4 + i]; }
#pragma unroll
      for (int i = 0; i < 4; ++i)
#pragma unroll
        for (int j = 0; j < 4; ++j) acc[i][j] += a[i] * b[j];
    }
    __syncthreads();
  }
#pragma unroll
  for (int i = 0; i < 4; ++i)
#pragma unroll
    for (int j = 0; j < 4; ++j) Cs[(ty * 4 + i) * 65 + tx * 4 + j] = acc[i][j];
  __syncthreads();
}


__device__ __forceinline__ int lds_off(int row, int chunk) { return row * 128 + ((chunk ^ ((row >> 1) & 7)) << 4); }

template <int BMODE>
__device__ __forceinline__ unsigned cvtpk_m(float a, float b, const bool lo = false) {
  if (BMODE == 0 || (BMODE == 2 && !lo)) return cvtpk(a, b);
  const unsigned h = cvtpk(a, b);
  const float ah = __uint_as_float(h << 16), bh = __uint_as_float(h & 0xffff0000u);
  return cvtpk(a - ah, b - bh);
}
#define G128_MMA(bufoff) { \
    _Pragma("unroll") for (int kk = 0; kk < 2; ++kk) { \
      bf16x8 af[4], bfr[4]; \
      _Pragma("unroll") for (int m = 0; m < 4; ++m) af[m] = *(const bf16x8*)(smem + (bufoff) + lds_off(wr * 64 + m * 16 + fr, kk * 4 + fq)); \
      _Pragma("unroll") for (int n = 0; n < 4; ++n) bfr[n] = *(const bf16x8*)(smem + (bufoff) + 16384 + lds_off(wc * 64 + n * 16 + fr, kk * 4 + fq)); \
      _Pragma("unroll") for (int m = 0; m < 4; ++m) \
        _Pragma("unroll") for (int n = 0; n < 4; ++n) acc[m][n] = __builtin_amdgcn_mfma_f32_16x16x32_bf16(bfr[n], af[m], acc[m][n], 0, 0, 0); \
    } }
template <int BMODE, bool KCLAMP, class ALoad, class BPtr>
__device__ __forceinline__ void gemm128_acc(f32x4 (&acc)[4][4], char* smem, const int nk, ALoad aload, BPtr bptr, const int ldb, const int kvalid) {
  const int tid = threadIdx.x, lane = tid & 63, wid = tid >> 6;
  const int wr = wid >> 1, wc = wid & 1, fr = lane & 15, fq = lane >> 4;
  const int achunk = tid & 7, arow0 = tid >> 3;
  const int nq = tid & 31, ko = tid >> 5;
  const float* bp0 = bptr(nq);
  const int oa0 = lds_off(arow0, achunk), oa1 = lds_off(arow0 + 32, achunk), oa2 = lds_off(arow0 + 64, achunk), oa3 = lds_off(arow0 + 96, achunk);
  const int ob0 = 16384 + lds_off(nq * 4 + 0, ko), ob1 = 16384 + lds_off(nq * 4 + 1, ko), ob2 = 16384 + lds_off(nq * 4 + 2, ko), ob3 = 16384 + lds_off(nq * 4 + 3, ko);
  uint4 ra0, ra1, ra2, ra3; float4 rb0, rb1, rb2, rb3, rb4, rb5, rb6, rb7;
#define G128_LOAD(kt) { \
    ra0 = aload(0, arow0, (kt) * 8 + achunk); ra1 = aload(1, arow0 + 32, (kt) * 8 + achunk); \
    ra2 = aload(2, arow0 + 64, (kt) * 8 + achunk); ra3 = aload(3, arow0 + 96, (kt) * 8 + achunk); \
    int kr_ = (kt) * 64 + ko * 8; \
    if (KCLAMP) kr_ = min(kr_, kvalid - 8);     \
    { \
      const float* b2_ = bp0 + (size_t)((BMODE == 2) ? (kr_ & 1023) : kr_) * ldb; \
      rb0 = *(const float4*)(b2_); rb1 = *(const float4*)(b2_ + (size_t)1 * ldb); rb2 = *(const float4*)(b2_ + (size_t)2 * ldb); \
      rb3 = *(const float4*)(b2_ + (size_t)3 * ldb); rb4 = *(const float4*)(b2_ + (size_t)4 * ldb); rb5 = *(const float4*)(b2_ + (size_t)5 * ldb); \
      rb6 = *(const float4*)(b2_ + (size_t)6 * ldb); rb7 = *(const float4*)(b2_ + (size_t)7 * ldb); \
    } }
#define G128_STORE(bufoff, lo_) { \
    char* const sb_ = smem + (bufoff); \
    *(uint4*)(sb_ + oa0) = ra0; *(uint4*)(sb_ + oa1) = ra1; *(uint4*)(sb_ + oa2) = ra2; *(uint4*)(sb_ + oa3) = ra3; \
    uint4 w; \
    w.x = cvtpk_m<BMODE>(rb0.x, rb1.x, lo_); w.y = cvtpk_m<BMODE>(rb2.x, rb3.x, lo_); w.z = cvtpk_m<BMODE>(rb4.x, rb5.x, lo_); w.w = cvtpk_m<BMODE>(rb6.x, rb7.x, lo_); \
    *(uint4*)(sb_ + ob0) = w; \
    w.x = cvtpk_m<BMODE>(rb0.y, rb1.y, lo_); w.y = cvtpk_m<BMODE>(rb2.y, rb3.y, lo_); w.z = cvtpk_m<BMODE>(rb4.y, rb5.y, lo_); w.w = cvtpk_m<BMODE>(rb6.y, rb7.y, lo_); \
    *(uint4*)(sb_ + ob1) = w; \
    w.x = cvtpk_m<BMODE>(rb0.z, rb1.z, lo_); w.y = cvtpk_m<BMODE>(rb2.z, rb3.z, lo_); w.z = cvtpk_m<BMODE>(rb4.z, rb5.z, lo_); w.w = cvtpk_m<BMODE>(rb6.z, rb7.z, lo_); \
    *(uint4*)(sb_ + ob2) = w; \
    w.x = cvtpk_m<BMODE>(rb0.w, rb1.w, lo_); w.y = cvtpk_m<BMODE>(rb2.w, rb3.w, lo_); w.z = cvtpk_m<BMODE>(rb4.w, rb5.w, lo_); w.w = cvtpk_m<BMODE>(rb6.w, rb7.w, lo_); \
    *(uint4*)(sb_ + ob3) = w; }
  G128_LOAD(0)
  G128_STORE(0, false)
  if (nk > 1) G128_LOAD(1)
  __syncthreads();
  for (int kt = 0; kt < nk; ++kt) {
    const int cur = (kt & 1) * 32768;
    __builtin_amdgcn_sched_barrier(0);
    G128_MMA(cur)
    __builtin_amdgcn_sched_barrier(0);
    if (kt + 1 < nk) {
      G128_STORE(cur ^ 32768, (kt + 1) >= kvalid)
      __builtin_amdgcn_sched_barrier(0);
      if (kt + 2 < nk) G128_LOAD(kt + 2)
    }
    __builtin_amdgcn_sched_barrier(0);
    __syncthreads();
  }
#undef G128_LOAD
#undef G128_STORE
}
__device__ __forceinline__ void acc_zero(f32x4 (&acc)[4][4]) {
#pragma unroll
  for (int m = 0; m < 4; ++m)
#pragma unroll
    for (int n = 0; n < 4; ++n) acc[m][n] = (f32x4){0.f, 0.f, 0.f, 0.f};
}
template <class ARow, class BPtr, class Epi>
__device__ __forceinline__ void gemm128(char* smem, const int K, ARow arow, BPtr bptr, const int ldb, Epi epi) {
  const int tid = threadIdx.x, lane = tid & 63, wid = tid >> 6;
  const int arow0 = tid >> 3;
  const bf16_t* ap0 = arow(arow0);
  const bf16_t* ap1 = arow(arow0 + 32);
  const bf16_t* ap2 = arow(arow0 + 64);
  const bf16_t* ap3 = arow(arow0 + 96);
  f32x4 acc[4][4];
  acc_zero(acc);
  gemm128_acc<0, false>(acc, smem, K >> 6,
      [=](int u, int, int kc) { const bf16_t* q = (u == 0) ? ap0 : (u == 1) ? ap1 : (u == 2) ? ap2 : ap3; return *(const uint4*)(q + kc * 8); },
      bptr, ldb, 0);
  epi(acc, wid >> 1, wid & 1, lane & 15, lane >> 4);
}


template <class ALoad, class BLoad>
__device__ __forceinline__ void gemm128_acc_bb(f32x4 (&acc)[4][4], char* smem, const int nk, ALoad aload, BLoad bload) {
  const int tid = threadIdx.x, lane = tid & 63, wid = tid >> 6;
  const int wr = wid >> 1, wc = wid & 1, fr = lane & 15, fq = lane >> 4;
  const int achunk = tid & 7, arow0 = tid >> 3;
  const int oa0 = lds_off(arow0, achunk), oa1 = lds_off(arow0 + 32, achunk), oa2 = lds_off(arow0 + 64, achunk), oa3 = lds_off(arow0 + 96, achunk);
  uint4 ra0, ra1, ra2, ra3, rb0, rb1, rb2, rb3;
#define G128_LOADBB(kt) { \
    ra0 = aload(0, arow0, (kt) * 8 + achunk); ra1 = aload(1, arow0 + 32, (kt) * 8 + achunk); \
    ra2 = aload(2, arow0 + 64, (kt) * 8 + achunk); ra3 = aload(3, arow0 + 96, (kt) * 8 + achunk); \
    rb0 = bload(0, arow0, (kt) * 8 + achunk); rb1 = bload(1, arow0 + 32, (kt) * 8 + achunk); \
    rb2 = bload(2, arow0 + 64, (kt) * 8 + achunk); rb3 = bload(3, arow0 + 96, (kt) * 8 + achunk); }
#define G128_STOREBB(bufoff) { \
    char* const sb_ = smem + (bufoff); \
    *(uint4*)(sb_ + oa0) = ra0; *(uint4*)(sb_ + oa1) = ra1; *(uint4*)(sb_ + oa2) = ra2; *(uint4*)(sb_ + oa3) = ra3; \
    *(uint4*)(sb_ + 16384 + oa0) = rb0; *(uint4*)(sb_ + 16384 + oa1) = rb1; *(uint4*)(sb_ + 16384 + oa2) = rb2; *(uint4*)(sb_ + 16384 + oa3) = rb3; }
  G128_LOADBB(0)
  G128_STOREBB(0)
  if (nk > 1) G128_LOADBB(1)
  __syncthreads();
  for (int kt = 0; kt < nk; ++kt) {
    const int cur = (kt & 1) * 32768;
    __builtin_amdgcn_sched_barrier(0);
    G128_MMA(cur)
    __builtin_amdgcn_sched_barrier(0);
    if (kt + 1 < nk) {
      G128_STOREBB(cur ^ 32768)
      __builtin_amdgcn_sched_barrier(0);
      if (kt + 2 < nk) G128_LOADBB(kt + 2)
    }
    __builtin_amdgcn_sched_barrier(0);
    __syncthreads();
  }
#undef G128_LOADBB
#undef G128_STOREBB
}
template <class ARow, class BRow, class Epi>
__device__ __forceinline__ void gemm128_bb(char* smem, const int K, ARow arow, BRow brow, Epi epi) {
  const int tid = threadIdx.x, lane = tid & 63, wid = tid >> 6;
  const int arow0 = tid >> 3;
  const bf16_t* ap0 = arow(arow0); const bf16_t* ap1 = arow(arow0 + 32); const bf16_t* ap2 = arow(arow0 + 64); const bf16_t* ap3 = arow(arow0 + 96);
  const bf16_t* bp0 = brow(arow0); const bf16_t* bp1 = brow(arow0 + 32); const bf16_t* bp2 = brow(arow0 + 64); const bf16_t* bp3 = brow(arow0 + 96);
  f32x4 acc[4][4];
  acc_zero(acc);
  gemm128_acc_bb(acc, smem, K >> 6,
      [=](int u, int, int kc) { const bf16_t* q = (u == 0) ? ap0 : (u == 1) ? ap1 : (u == 2) ? ap2 : ap3; return *(const uint4*)(q + kc * 8); },
      [=](int u, int, int kc) { const bf16_t* q = (u == 0) ? bp0 : (u == 1) ? bp1 : (u == 2) ? bp2 : bp3; return *(const uint4*)(q + kc * 8); });
  epi(acc, wid >> 1, wid & 1, lane & 15, lane >> 4);
}


#define GAS1 __attribute__((address_space(1)))
#define LAS3 __attribute__((address_space(3)))
__device__ __forceinline__ void glds16(const void* g, char* l) {
  __builtin_amdgcn_global_load_lds((const GAS1 void*)g, (LAS3 void*)l, 16, 0, 0);
}
template <class ARow, class BRow, class Epi>
__device__ __forceinline__ void gemm128_glds(char* smem, const int K, ARow arow, BRow brow, Epi epi) {
  const int tid = threadIdx.x, lane = tid & 63, wid = tid >> 6;
  const int wr = wid >> 1, wc = wid & 1, fr = lane & 15, fq = lane >> 4;
  const int r0 = tid >> 3;
  const int cl = (tid & 7) ^ ((tid >> 4) & 7);
  const bf16_t* ga0 = arow(r0) + cl * 8; const bf16_t* ga1 = arow(r0 + 32) + cl * 8; const bf16_t* ga2 = arow(r0 + 64) + cl * 8; const bf16_t* ga3 = arow(r0 + 96) + cl * 8;
  const bf16_t* gb0 = brow(r0) + cl * 8; const bf16_t* gb1 = brow(r0 + 32) + cl * 8; const bf16_t* gb2 = brow(r0 + 64) + cl * 8; const bf16_t* gb3 = brow(r0 + 96) + cl * 8;
  char* const lbase = smem + tid * 16;
#define GL_STAGE(bufoff, kt) { \
    char* const d_ = lbase + (bufoff); const int ko_ = (kt) * 64; \
    glds16(ga0 + ko_, d_); glds16(ga1 + ko_, d_ + 4096); glds16(ga2 + ko_, d_ + 8192); glds16(ga3 + ko_, d_ + 12288); \
    glds16(gb0 + ko_, d_ + 16384); glds16(gb1 + ko_, d_ + 20480); glds16(gb2 + ko_, d_ + 24576); glds16(gb3 + ko_, d_ + 28672); }
  f32x4 acc[4][4];
  acc_zero(acc);
  const int nk = K >> 6;
  GL_STAGE(0, 0)
  asm volatile("s_waitcnt vmcnt(0)" ::: "memory");
  __syncthreads();
  for (int kt = 0; kt < nk; ++kt) {
    const int cur = (kt & 1) * 32768;
    if (kt + 1 < nk) GL_STAGE(cur ^ 32768, kt + 1)
    G128_MMA(cur)
    asm volatile("s_waitcnt vmcnt(0)" ::: "memory");
    __syncthreads();
  }
#undef GL_STAGE
  epi(acc, wr, wc, fr, fq);
}


template <int NCALL, int NK, class ARow, class BRow, class Epi>
__device__ __forceinline__ void gemm128_glds_multi(char* smem, ARow arow, BRow brow, const size_t bstride, Epi epi) {
  const int tid = threadIdx.x, lane = tid & 63, wid = tid >> 6;
  const int wr = wid >> 1, wc = wid & 1, fr = lane & 15, fq = lane >> 4;
  const int r0 = tid >> 3;
  const int cl = (tid & 7) ^ ((tid >> 4) & 7);
  const bf16_t* ga0 = arow(r0) + cl * 8; const bf16_t* ga1 = arow(r0 + 32) + cl * 8; const bf16_t* ga2 = arow(r0 + 64) + cl * 8; const bf16_t* ga3 = arow(r0 + 96) + cl * 8;
  const bf16_t* gb0 = brow(r0) + cl * 8; const bf16_t* gb1 = brow(r0 + 32) + cl * 8; const bf16_t* gb2 = brow(r0 + 64) + cl * 8; const bf16_t* gb3 = brow(r0 + 96) + cl * 8;
  char* const lbase = smem + tid * 16;
#define GM_STAGE(bufoff, g) { \
    char* const d_ = lbase + (bufoff); const int ko_ = ((g) % NK) * 64; const size_t bo_ = (size_t)((g) / NK) * bstride + ko_; \
    glds16(ga0 + ko_, d_); glds16(ga1 + ko_, d_ + 4096); glds16(ga2 + ko_, d_ + 8192); glds16(ga3 + ko_, d_ + 12288); \
    glds16(gb0 + bo_, d_ + 16384); glds16(gb1 + bo_, d_ + 20480); glds16(gb2 + bo_, d_ + 24576); glds16(gb3 + bo_, d_ + 28672); }
  f32x4 acc[4][4];
  acc_zero(acc);
  constexpr int G = NCALL * NK;
  GM_STAGE(0, 0)
  asm volatile("s_waitcnt vmcnt(0)" ::: "memory");
  __syncthreads();
#pragma unroll 1
  for (int g = 0; g < G; ++g) {
    const int cur = (g & 1) * 32768;
    if (g + 1 < G) GM_STAGE(cur ^ 32768, g + 1)
    G128_MMA(cur)
    if ((g % NK) == NK - 1) {
      epi(g / NK, acc, wr, wc, fr, fq);
      acc_zero(acc);
    }
    asm volatile("s_waitcnt vmcnt(0)" ::: "memory");
    __syncthreads();
  }
#undef GM_STAGE
}

#define DPP_F(v, ctrl) __builtin_bit_cast(float, __builtin_amdgcn_update_dpp(0, __builtin_bit_cast(int, (v)), (ctrl), 0xF, 0xF, true))
__device__ __forceinline__ float rdlane_f(float v, int l) { return __builtin_bit_cast(float, __builtin_amdgcn_readlane(__builtin_bit_cast(int, v), l)); }
__device__ __forceinline__ float dpp_sum16x(float v) {
  v += DPP_F(v, 0xB1); v += DPP_F(v, 0x4E); v += DPP_F(v, 0x141); v += DPP_F(v, 0x140);
  return v;
}
__device__ __forceinline__ float dpp_max16x(float v) {
  v = fmaxf(v, DPP_F(v, 0xB1)); v = fmaxf(v, DPP_F(v, 0x4E)); v = fmaxf(v, DPP_F(v, 0x141)); v = fmaxf(v, DPP_F(v, 0x140));
  return v;
}
__device__ __forceinline__ float wave_sum_fast(float v) {
  v = dpp_sum16x(v);
  return (rdlane_f(v, 0) + rdlane_f(v, 16)) + (rdlane_f(v, 32) + rdlane_f(v, 48));
}
__device__ __forceinline__ float wave_max_fast(float v) {
  v = dpp_max16x(v);
  return fmaxf(fmaxf(rdlane_f(v, 0), rdlane_f(v, 16)), fmaxf(rdlane_f(v, 32), rdlane_f(v, 48)));
}
__device__ __forceinline__ float fast_tanh(float x) { const float e = __expf(2.f * x); return 1.f - 2.f / (e + 1.f); }


__device__ __forceinline__ float4 bf4_to_f4(uint2 u) {
  float4 r;
  r.x = __uint_as_float(u.x << 16); r.y = __uint_as_float(u.x & 0xffff0000u);
  r.z = __uint_as_float(u.y << 16); r.w = __uint_as_float(u.y & 0xffff0000u);
  return r;
}
__device__ __forceinline__ uint2 pack4(float a, float b, float c, float d) { uint2 r; r.x = cvtpk(a, b); r.y = cvtpk(c, d); return r; }
#define XCD_GROUP (blockIdx.x & 7)
#define XCD_LB (blockIdx.x >> 3)
#define XCD_NB ((gridDim.x + 7 - (blockIdx.x & 7)) >> 3)

__device__ __forceinline__ void phase_inproj(const Params& p, char* smem) {
  const bf16_t* __restrict__ XB = (const bf16_t*)(p.ws + OFF_XB);
  const bf16_t* __restrict__ WINT = (const bf16_t*)(p.ws + OFF_WINT);
  const float* __restrict__ rope = (const float*)(p.ws + OFF_ROPE);
  bf16_t* Q = (bf16_t*)(p.ws + OFF_Q); bf16_t* K = (bf16_t*)(p.ws + OFF_K); bf16_t* V = (bf16_t*)(p.ws + OFF_V);
  bf16_t* FE = (bf16_t*)(p.ws + OFF_FEATS);
  const int NT = 27, NITEM = (T_TOK / 128) * NT, CHUNK = NITEM / 8;
  for (int i = XCD_LB; i < CHUNK; i += XCD_NB) {
    const int item = XCD_GROUP * CHUNK + i;
    const int row0 = (item & 255) * 128, col0 = (item >> 8) * 128;
    gemm128_glds(smem, DM,
            [=](int r) { return XB + (size_t)(row0 + r) * DM; },
            [=](int r) { return WINT + (size_t)(col0 + r) * DM; },
            [=](f32x4 (&acc)[4][4], int wr, int wc, int fr, int fq) {
              const int cb = col0 + wc * 64;
              if (cb >= INW) return;
#pragma unroll
              for (int m = 0; m < 4; ++m) {
                const int t = row0 + wr * 64 + m * 16 + fr;
                if (cb < 1024) {
                  const int pos = t & (SEQ - 1);
                  bf16_t* dst = (cb < 512) ? (Q + (size_t)t * 512 + cb) : (K + (size_t)t * 512 + (cb - 512));
                  const float sc = (cb < 512) ? 0.125f : 1.f;
#pragma unroll
                  for (int n = 0; n < 2; ++n) {
                    const int f0 = n * 16 + fq * 4;
                    const float4 c01 = *(const float4*)(rope + (size_t)(pos * 32 + f0) * 2);
                    const float4 c23 = *(const float4*)(rope + (size_t)(pos * 32 + f0) * 2 + 4);
                    const float cs[4] = {c01.x, c01.z, c23.x, c23.z}, sn[4] = {c01.y, c01.w, c23.y, c23.w};
                    float o1[4], o2[4];
#pragma unroll
                    for (int j = 0; j < 4; ++j) {
                      const float z1 = acc[m][n][j], z2 = acc[m][n + 2][j];
                      o1[j] = (z1 * cs[j] - z2 * sn[j]) * sc; o2[j] = (z2 * cs[j] + z1 * sn[j]) * sc;
                    }
                    *(uint2*)(dst + f0) = pack4(o1[0], o1[1], o1[2], o1[3]);
                    *(uint2*)(dst + 32 + f0) = pack4(o2[0], o2[1], o2[2], o2[3]);
                  }
                } else if (cb < 1536) {
#pragma unroll
                  for (int n = 0; n < 4; ++n)
                    *(uint2*)(V + (size_t)t * 512 + (cb - 1024) + n * 16 + fq * 4) = pack4(acc[m][n][0], acc[m][n][1], acc[m][n][2], acc[m][n][3]);
                } else {
#pragma unroll
                  for (int n = 0; n < 4; ++n) {
                    const int c = cb + n * 16 + fq * 4;
                    if (c < INW) *(uint2*)(FE + (size_t)t * FEW + (c - 1536)) = pack4(acc[m][n][0], acc[m][n][1], acc[m][n][2], acc[m][n][3]);
                  }
                }
              }
            });
  }
}

__device__ __forceinline__ void phase_prep_a(const Params& p) {
  const bf16_t* __restrict__ FE = (const bf16_t*)(p.ws + OFF_FEATS);
  const float* __restrict__ mu = p.in[2];
  bf16_t* R = (bf16_t*)(p.ws + OFF_R); bf16_t* K2 = (bf16_t*)(p.ws + OFF_K2); bf16_t* V2 = (bf16_t*)(p.ws + OFF_V2);
  bf16_t* ACT = (bf16_t*)(p.ws + OFF_ACT);
  for (size_t i = (size_t)blockIdx.x * NTHR + threadIdx.x; i < (size_t)T_TOK * 232; i += (size_t)gridDim.x * NTHR) {
    const int t = (int)(i / 232), ch = (int)(i - (size_t)t * 232);
    if (ch >= 228) { *(uint4*)(ACT + (size_t)t * 320 + 288 + (ch - 228) * 8) = make_uint4(0u, 0u, 0u, 0u); continue; }
    const int col = ch * 8;
    const uint4 cu = *(const uint4*)(FE + (size_t)t * FEW + col);
    uint4 pv = make_uint4(0u, 0u, 0u, 0u);
    if ((t & (SEQ - 1)) != 0) pv = *(const uint4*)(FE + (size_t)(t - 1) * FEW + col);
    const float4 m0 = *(const float4*)(mu + col), m1 = *(const float4*)(mu + col + 4);
    const unsigned cw[4] = {cu.x, cu.y, cu.z, cu.w}, pw[4] = {pv.x, pv.y, pv.z, pv.w};
    const float mm[8] = {m0.x, m0.y, m0.z, m0.w, m1.x, m1.y, m1.z, m1.w};
    float f[8];
#pragma unroll
    for (int q = 0; q < 4; ++q) {
      const float c0 = __uint_as_float(cw[q] << 16), c1 = __uint_as_float(cw[q] & 0xffff0000u);
      const float p0 = __uint_as_float(pw[q] << 16), p1 = __uint_as_float(pw[q] & 0xffff0000u);
      f[2 * q] = c0 + (p0 - c0) * mm[2 * q];
      f[2 * q + 1] = c1 + (p1 - c1) * mm[2 * q + 1];
    }
    bf16_t* dst;
    if (col < 512) dst = R + (size_t)t * 512 + col;
    else if (col < 1024) dst = K2 + (size_t)t * 512 + (col - 512);
    else if (col < 1536) dst = V2 + (size_t)t * 512 + (col - 1024);
    else {
      dst = ACT + (size_t)t * 320 + (col - 1536);
      if (col < 1600) {
#pragma unroll
        for (int q = 0; q < 8; ++q) f[q] = fast_tanh(f[q]);
      } else if (col >= 1664) {
#pragma unroll
        for (int q = 0; q < 8; ++q) f[q] = sigmoidf_(f[q]);
      }
    }
    uint4 w; w.x = cvtpk(f[0], f[1]); w.y = cvtpk(f[2], f[3]); w.z = cvtpk(f[4], f[5]); w.w = cvtpk(f[6], f[7]);
    *(uint4*)dst = w;
  }
}

template <int PASS>
__device__ __forceinline__ void prep_item(const Params& p, char* smem, const int row0, const int col0) {
  const bf16_t* __restrict__ ACT = (const bf16_t*)(p.ws + OFF_ACT);
  constexpr int ACOL = PASS * 64;
  constexpr int NK = (PASS == 2) ? 3 : 1;
  const float* __restrict__ Wm = (PASS == 0) ? p.in[4] : (PASS == 1) ? p.in[6] : p.in[7];
  f32x4 acc[4][4];
  acc_zero(acc);
  gemm128_acc<0, (PASS == 2)>(acc, smem, NK,
      [=](int, int rowl, int kc) { return *(const uint4*)(ACT + (size_t)(row0 + rowl) * 320 + ACOL + kc * 8); },
      [=](int nq) { return Wm + col0 + nq * 4; }, 512, 160);
  const int tid = threadIdx.x, lane = tid & 63, wid = tid >> 6;
  const int wr = wid >> 1, wc = wid & 1, fr = lane & 15, fq = lane >> 4;
  const int cb = col0 + wc * 64;
  if (PASS == 0) {
    const float* __restrict__ w0 = p.in[3];
    float* W = (float*)(p.ws + OFF_W);
#pragma unroll
    for (int n = 0; n < 4; ++n) {
      const int c = cb + n * 16 + fq * 4;
      const float4 w04 = *(const float4*)(w0 + c);
      const float w0c[4] = {w04.x, w04.y, w04.z, w04.w};
#pragma unroll
      for (int m = 0; m < 4; ++m) {
        const int t = row0 + wr * 64 + m * 16 + fr;
        float d[4];
#pragma unroll
        for (int j = 0; j < 4; ++j) {
          const float nz = -(w0c[j] + acc[m][n][j]);
          const float sp = fmaxf(nz, 0.f) + __logf(1.f + __expf(-fabsf(nz)));
          d[j] = __expf(-__expf(-sp - 0.5f));
        }
        *(float4*)(W + (size_t)t * 512 + c) = make_float4(d[0], d[1], d[2], d[3]);
      }
    }
  } else if (PASS == 2) {
    bf16_t* G = (bf16_t*)(p.ws + OFF_G);
#pragma unroll
    for (int m = 0; m < 4; ++m) {
      const int t = row0 + wr * 64 + m * 16 + fr;
#pragma unroll
      for (int n = 0; n < 4; ++n)
        *(uint2*)(G + (size_t)t * 512 + cb + n * 16 + fq * 4) = pack4(acc[m][n][0], acc[m][n][1], acc[m][n][2], acc[m][n][3]);
    }
  } else {
    const float* __restrict__ a0 = p.in[5]; const float* __restrict__ k_k = p.in[8]; const float* __restrict__ k_a = p.in[9];
    const float* __restrict__ r_k = p.in[10];
    const bf16_t* __restrict__ R = (const bf16_t*)(p.ws + OFF_R); bf16_t* K2 = (bf16_t*)(p.ws + OFF_K2);
    bf16_t* A = (bf16_t*)(p.ws + OFF_A); bf16_t* B = (bf16_t*)(p.ws + OFF_B); float* SB = (float*)(p.ws + OFF_SB);
#pragma unroll
    for (int m = 0; m < 4; ++m) {
      __builtin_amdgcn_sched_barrier(0);
      const int t = row0 + wr * 64 + m * 16 + fr;
      float kk[4][4];
      float ssp = 0.f, sbp = 0.f;
#pragma unroll
      for (int n = 0; n < 4; ++n) {
        const int c = cb + n * 16 + fq * 4;
        const size_t o = (size_t)t * 512 + c;
        const float4 rr4 = bf4_to_f4(*(const uint2*)(R + o)), kx4 = bf4_to_f4(*(const uint2*)(K2 + o));
        const float rr[4] = {rr4.x, rr4.y, rr4.z, rr4.w}, kx[4] = {kx4.x, kx4.y, kx4.z, kx4.w};
        const float4 a04 = *(const float4*)(a0 + c), kk4 = *(const float4*)(k_k + c), ka4 = *(const float4*)(k_a + c), rk4 = *(const float4*)(r_k + c);
        const float a0c[4] = {a04.x, a04.y, a04.z, a04.w}, kkc[4] = {kk4.x, kk4.y, kk4.z, kk4.w}, kac[4] = {ka4.x, ka4.y, ka4.z, ka4.w};
        const float rkc[4] = {rk4.x, rk4.y, rk4.z, rk4.w};
        float k2[4];
#pragma unroll
        for (int j = 0; j < 4; ++j) {
          const float av = sigmoidf_(a0c[j] + acc[m][n][j]);
          acc[m][n][j] = av;
          kk[n][j] = kx[j] * kkc[j];
          k2[j] = kx[j] * (1.f + (av - 1.f) * kac[j]);
          ssp += kk[n][j] * kk[n][j];
          sbp += rr[j] * k2[j] * rkc[j];
        }
        *(uint2*)(K2 + o) = pack4(k2[0], k2[1], k2[2], k2[3]);
      }
      ssp += __shfl_xor(ssp, 16, 64); ssp += __shfl_xor(ssp, 32, 64);
      sbp += __shfl_xor(sbp, 16, 64); sbp += __shfl_xor(sbp, 32, 64);
      const float inv = 1.f / fmaxf(sqrtf(ssp), 1e-12f);
#pragma unroll
      for (int n = 0; n < 4; ++n) {
        const size_t o = (size_t)t * 512 + cb + n * 16 + fq * 4;
        *(uint2*)(A + o) = pack4(-kk[n][0] * inv, -kk[n][1] * inv, -kk[n][2] * inv, -kk[n][3] * inv);
        *(uint2*)(B + o) = pack4(kk[n][0] * inv * acc[m][n][0], kk[n][1] * inv * acc[m][n][1], kk[n][2] * inv * acc[m][n][2], kk[n][3] * inv * acc[m][n][3]);
      }
      if (fq == 0) SB[(size_t)t * 8 + (cb >> 6)] = sbp;
    }
  }
}
__device__ __forceinline__ void phase_prep(const Params& p, char* smem) {
  for (int item = blockIdx.x; item < (T_TOK / 128) * 12; item += gridDim.x) {
    const int mt = item / 12, sub = item - mt * 12, pass = sub >> 2, nt = sub & 3;
    if (pass == 0) prep_item<0>(p, smem, mt * 128, nt * 128);
    else if (pass == 1) prep_item<1>(p, smem, mt * 128, nt * 128);
    else prep_item<2>(p, smem, mt * 128, nt * 128);
  }
}

__device__ __forceinline__ float dpp_sum16(float v) {
  v += __builtin_bit_cast(float, __builtin_amdgcn_update_dpp(0, __builtin_bit_cast(int, v), 0xB1, 0xF, 0xF, true));
  v += __builtin_bit_cast(float, __builtin_amdgcn_update_dpp(0, __builtin_bit_cast(int, v), 0x4E, 0xF, 0xF, true));
  v += __builtin_bit_cast(float, __builtin_amdgcn_update_dpp(0, __builtin_bit_cast(int, v), 0x141, 0xF, 0xF, true));
  v += __builtin_bit_cast(float, __builtin_amdgcn_update_dpp(0, __builtin_bit_cast(int, v), 0x140, 0xF, 0xF, true));
  return v;
}
#define SC_CH 16
#define SC_ARR (SC_CH * 64 * 4)
#define SC_BUF (5 * SC_ARR + SC_CH * 16 * 4)
__device__ __forceinline__ void phase_scan(const Params& p, char* smem) {
  if (blockIdx.x >= 256) return;
  const bf16_t* __restrict__ R = (const bf16_t*)(p.ws + OFF_R); const bf16_t* __restrict__ K2 = (const bf16_t*)(p.ws + OFF_K2);
  const bf16_t* __restrict__ V2 = (const bf16_t*)(p.ws + OFF_V2); const bf16_t* __restrict__ A = (const bf16_t*)(p.ws + OFF_A);
  const bf16_t* __restrict__ B = (const bf16_t*)(p.ws + OFF_B); const float* __restrict__ W = (const float*)(p.ws + OFF_W);
  float* YS = (float*)(p.ws + OFF_YS);
  const int bh = blockIdx.x >> 2, rg = blockIdx.x & 3, b = bh >> 3, h = bh & 7;
  const int tid = threadIdx.x, lane = tid & 63, wid = tid >> 6, j = lane & 15, rq = lane >> 4;
  const int rowl = wid * 4 + rq;
  const int ls = tid >> 4, lc = tid & 15;
  const int vs = (tid >> 2) & 15, vq = tid & 3;
  const size_t tb = (size_t)b * SEQ;
  const size_t goff = (tb + ls) * 512 + h * 64 + lc * 4;
  const size_t voff = (tb + vs) * 512 + h * 64 + rg * 16 + vq * 4;
  uint2 ga, gb, gk, gr, gv; float4 gw;
  gv = make_uint2(0u, 0u);
  ga = *(const uint2*)(A + goff); gb = *(const uint2*)(B + goff); gk = *(const uint2*)(K2 + goff); gr = *(const uint2*)(R + goff);
  gw = *(const float4*)(W + goff);
  if (tid < 64) gv = *(const uint2*)(V2 + voff);
  {
    char* bf = smem;
    *(float4*)(bf + 0 * SC_ARR + ls * 256 + lc * 16) = bf4_to_f4(ga);
    *(float4*)(bf + 1 * SC_ARR + ls * 256 + lc * 16) = gw;
    *(float4*)(bf + 2 * SC_ARR + ls * 256 + lc * 16) = bf4_to_f4(gb);
    *(float4*)(bf + 3 * SC_ARR + ls * 256 + lc * 16) = bf4_to_f4(gk);
    *(float4*)(bf + 4 * SC_ARR + ls * 256 + lc * 16) = bf4_to_f4(gr);
    if (tid < 64) *(float4*)(bf + 5 * SC_ARR + vs * 64 + vq * 16) = bf4_to_f4(gv);
  }
  __syncthreads();
  float s0 = 0.f, s1 = 0.f, s2 = 0.f, s3 = 0.f;
  const int NCH = SEQ / SC_CH;
  for (int c = 0; c < NCH; ++c) {
    if (c + 1 < NCH) {
      const size_t o2 = goff + (size_t)(c + 1) * SC_CH * 512;
      ga = *(const uint2*)(A + o2); gb = *(const uint2*)(B + o2); gk = *(const uint2*)(K2 + o2); gr = *(const uint2*)(R + o2);
      gw = *(const float4*)(W + o2);
      if (tid < 64) gv = *(const uint2*)(V2 + voff + (size_t)(c + 1) * SC_CH * 512);
    }
    const char* bf = smem + (c & 1) * SC_BUF;
    float ykeep = 0.f;
#pragma unroll
    for (int s = 0; s < SC_CH; ++s) {
      const float4 a4 = *(const float4*)(bf + 0 * SC_ARR + s * 256 + j * 16);
      const float4 w4 = *(const float4*)(bf + 1 * SC_ARR + s * 256 + j * 16);
      const float4 b4 = *(const float4*)(bf + 2 * SC_ARR + s * 256 + j * 16);
      const float4 k4 = *(const float4*)(bf + 3 * SC_ARR + s * 256 + j * 16);
      const float4 r4 = *(const float4*)(bf + 4 * SC_ARR + s * 256 + j * 16);
      const float vv = *(const float*)(bf + 5 * SC_ARR + s * 64 + rowl * 4);
      float sa = (s0 * a4.x + s1 * a4.y) + (s2 * a4.z + s3 * a4.w);
      sa = dpp_sum16(sa);
      s0 = s0 * w4.x + (sa * b4.x + vv * k4.x);
      s1 = s1 * w4.y + (sa * b4.y + vv * k4.y);
      s2 = s2 * w4.z + (sa * b4.z + vv * k4.z);
      s3 = s3 * w4.w + (sa * b4.w + vv * k4.w);
      float y = (s0 * r4.x + s1 * r4.y) + (s2 * r4.z + s3 * r4.w);
      y = dpp_sum16(y);
      ykeep = (j == s) ? y : ykeep;
    }
    YS[(tb + (size_t)c * SC_CH + j) * 512 + h * 64 + rg * 16 + rowl] = ykeep;
    if (c + 1 < NCH) {
      char* bn = smem + ((c + 1) & 1) * SC_BUF;
      *(float4*)(bn + 0 * SC_ARR + ls * 256 + lc * 16) = bf4_to_f4(ga);
      *(float4*)(bn + 1 * SC_ARR + ls * 256 + lc * 16) = gw;
      *(float4*)(bn + 2 * SC_ARR + ls * 256 + lc * 16) = bf4_to_f4(gb);
      *(float4*)(bn + 3 * SC_ARR + ls * 256 + lc * 16) = bf4_to_f4(gk);
      *(float4*)(bn + 4 * SC_ARR + ls * 256 + lc * 16) = bf4_to_f4(gr);
      if (tid < 64) *(float4*)(bn + 5 * SC_ARR + vs * 64 + vq * 16) = bf4_to_f4(gv);
    }
    __syncthreads();
  }
}


#define CONV_TILES (257 * 96)
struct ConvDesc { const float* src; bf16_t* dst; int ldn, k0, n0, kdim, part; };
__device__ __forceinline__ ConvDesc conv_desc(const Params& p, const int ti) {
  ConvDesc d;
  const int e = ti / 96, q = ti - e * 96, part = q >> 5, w = q & 31;
  d.part = part;
  if (part < 2) {
    d.src = (e < NEXP) ? p.in[18 + part] + (size_t)e * DM * 256 : p.in[21 + part];
    d.ldn = 256; d.k0 = (w >> 1) * 64; d.n0 = (w & 1) * 128; d.kdim = 1024;
    d.dst = (bf16_t*)(p.ws + OFF_EW1) + (size_t)e * 512 * 1024;
  } else {
    d.src = (e < NEXP) ? p.in[20] + (size_t)e * 256 * DM : p.in[23];
    d.ldn = 1024; d.k0 = (w >> 3) * 64; d.n0 = (w & 7) * 128; d.kdim = 256;
    d.dst = (bf16_t*)(p.ws + OFF_EW2) + (size_t)e * 1024 * 256;
  }
  return d;
}
#define CV_LOAD(d, r) { \
    const float* bp_ = (d).src + (size_t)((d).k0 + ko * 8) * (d).ldn + (d).n0 + nq * 4; \
    r##0 = *(const float4*)(bp_); r##1 = *(const float4*)(bp_ + (size_t)1 * (d).ldn); r##2 = *(const float4*)(bp_ + (size_t)2 * (d).ldn); \
    r##3 = *(const float4*)(bp_ + (size_t)3 * (d).ldn); r##4 = *(const float4*)(bp_ + (size_t)4 * (d).ldn); r##5 = *(const float4*)(bp_ + (size_t)5 * (d).ldn); \
    r##6 = *(const float4*)(bp_ + (size_t)6 * (d).ldn); r##7 = *(const float4*)(bp_ + (size_t)7 * (d).ldn); }
#define CV_LDS(r, base) { \
    uint4 v; \
    v.x = cvtpk((r##0).x, (r##1).x); v.y = cvtpk((r##2).x, (r##3).x); v.z = cvtpk((r##4).x, (r##5).x); v.w = cvtpk((r##6).x, (r##7).x); *(uint4*)((base) + lds_off(nq * 4 + 0, ko)) = v; \
    v.x = cvtpk((r##0).y, (r##1).y); v.y = cvtpk((r##2).y, (r##3).y); v.z = cvtpk((r##4).y, (r##5).y); v.w = cvtpk((r##6).y, (r##7).y); *(uint4*)((base) + lds_off(nq * 4 + 1, ko)) = v; \
    v.x = cvtpk((r##0).z, (r##1).z); v.y = cvtpk((r##2).z, (r##3).z); v.z = cvtpk((r##4).z, (r##5).z); v.w = cvtpk((r##6).z, (r##7).z); *(uint4*)((base) + lds_off(nq * 4 + 2, ko)) = v; \
    v.x = cvtpk((r##0).w, (r##1).w); v.y = cvtpk((r##2).w, (r##3).w); v.z = cvtpk((r##4).w, (r##5).w); v.w = cvtpk((r##6).w, (r##7).w); *(uint4*)((base) + lds_off(nq * 4 + 3, ko)) = v; }
#define CV_OUT(d, base) { \
    _Pragma("unroll") for (int u = 0; u < 4; ++u) { \
      const int row = (tid >> 3) + 32 * u, chunk = tid & 7; \
      const int c = (d).n0 + row; \
      const int orow = ((d).part < 2) ? ((c >> 6) * 128 + ((c >> 5) & 1) * 64 + ((d).part * 2 + ((c >> 4) & 1)) * 16 + (c & 15)) : c; \
      *(uint4*)((d).dst + (size_t)orow * (d).kdim + (d).k0 + chunk * 8) = *(const uint4*)((base) + lds_off(row, chunk)); } }
__device__ __forceinline__ void convert_tile2(const Params& p, char* smem, const int t2) {
  const int tid = threadIdx.x, nq = tid & 31, ko = tid >> 5;
  const ConvDesc da = conv_desc(p, 2 * t2), db = conv_desc(p, 2 * t2 + 1);
  float4 ra0, ra1, ra2, ra3, ra4, ra5, ra6, ra7, rb0, rb1, rb2, rb3, rb4, rb5, rb6, rb7;
  CV_LOAD(da, ra)
  CV_LOAD(db, rb)
  CV_LDS(ra, smem)
  CV_LDS(rb, smem + 16384)
  __syncthreads();
  CV_OUT(da, smem)
  CV_OUT(db, smem + 16384)
  __syncthreads();
}
#undef CV_LOAD
#undef CV_LDS
#undef CV_OUT

__device__ __forceinline__ int vt_off(int d, int key) { const int swz = ((d >> 2) & 15) ^ ((d & 3) << 3); return d * 512 + (((key >> 2) ^ swz) << 3); }
__device__ __forceinline__ void attn_item(const Params& p, char* smem, const int item) {
  const bf16_t* __restrict__ Q = (const bf16_t*)(p.ws + OFF_Q); const bf16_t* __restrict__ K = (const bf16_t*)(p.ws + OFF_K);
  const bf16_t* __restrict__ V = (const bf16_t*)(p.ws + OFF_V);
  bf16_t* OP = (bf16_t*)(p.ws + OFF_OP); float* LSE = (float*)(p.ws + OFF_LSE);
  char* Ks = smem; char* VT = smem + 32768; float* linv_s = (float*)(smem + 65536);
  const int tid = threadIdx.x, lane = tid & 63, wid = tid >> 6, l31 = lane & 31, hi = lane >> 5;
  {
    const int pp = item >> 11, rem = item & 2047, bh = rem >> 5, sub = rem & 31;
    const int dsh = pp * 2, nbsh = 5 - dsh;
    const int r = sub >> nbsh, n = sub & ((1 << nbsh) - 1);
    const int b = bh >> 3, h = bh & 7, tb = b * SEQ;
    __syncthreads();
#pragma unroll
    for (int u = 0; u < 8; ++u) {
      const int row = (tid >> 3) + 32 * u, chunk = tid & 7;
      int ik = n * 128 - 128 + row; ik = ik < 0 ? 0 : ik;
      const int tok = tb + (ik << dsh) + r;
      *(uint4*)(Ks + lds_off(row, chunk)) = *(const uint4*)(K + (size_t)tok * 512 + h * 64 + chunk * 8);
    }
#pragma unroll
    for (int ps = 0; ps < 2; ++ps) {
      const int dq = tid & 15, kbase = ps * 128 + (tid >> 4) * 8;
      uint2 v0, v1, v2, v3, v4, v5, v6, v7;
#define LDV(i, dst) { int ik = n * 128 - 128 + kbase + i; ik = ik < 0 ? 0 : ik; const int tok = tb + (ik << dsh) + r; dst = *(const uint2*)(V + (size_t)tok * 512 + h * 64 + dq * 4); }
      LDV(0, v0) LDV(1, v1) LDV(2, v2) LDV(3, v3) LDV(4, v4) LDV(5, v5) LDV(6, v6) LDV(7, v7)
#undef LDV
      {
        uint2 w;
        w.x = (v0.x & 0xffffu) | (v1.x << 16); w.y = (v2.x & 0xffffu) | (v3.x << 16);
        *(uint2*)(VT + vt_off(dq * 4 + 0, kbase)) = w;
        w.x = (v4.x & 0xffffu) | (v5.x << 16); w.y = (v6.x & 0xffffu) | (v7.x << 16);
        *(uint2*)(VT + vt_off(dq * 4 + 0, kbase + 4)) = w;
        w.x = (v0.x >> 16) | (v1.x & 0xffff0000u); w.y = (v2.x >> 16) | (v3.x & 0xffff0000u);
        *(uint2*)(VT + vt_off(dq * 4 + 1, kbase)) = w;
        w.x = (v4.x >> 16) | (v5.x & 0xffff0000u); w.y = (v6.x >> 16) | (v7.x & 0xffff0000u);
        *(uint2*)(VT + vt_off(dq * 4 + 1, kbase + 4)) = w;
        w.x = (v0.y & 0xffffu) | (v1.y << 16); w.y = (v2.y & 0xffffu) | (v3.y << 16);
        *(uint2*)(VT + vt_off(dq * 4 + 2, kbase)) = w;
        w.x = (v4.y & 0xffffu) | (v5.y << 16); w.y = (v6.y & 0xffffu) | (v7.y << 16);
        *(uint2*)(VT + vt_off(dq * 4 + 2, kbase + 4)) = w;
        w.x = (v0.y >> 16) | (v1.y & 0xffff0000u); w.y = (v2.y >> 16) | (v3.y & 0xffff0000u);
        *(uint2*)(VT + vt_off(dq * 4 + 3, kbase)) = w;
        w.x = (v4.y >> 16) | (v5.y & 0xffff0000u); w.y = (v6.y >> 16) | (v7.y & 0xffff0000u);
        *(uint2*)(VT + vt_off(dq * 4 + 3, kbase + 4)) = w;
      }
    }
    __syncthreads();
    const int iq = n * 128 + wid * 32 + l31;
    const int tq = tb + (iq << dsh) + r;
    bf16x8 qf[4];
#pragma unroll
    for (int ks = 0; ks < 4; ++ks) qf[ks] = *(const bf16x8*)(Q + (size_t)tq * 512 + h * 64 + ks * 16 + hi * 8);
    f32x16 st[5];
#pragma unroll
    for (int kb = 0; kb < 5; ++kb) {
      st[kb] = (f32x16){0.f, 0.f, 0.f, 0.f, 0.f, 0.f, 0.f, 0.f, 0.f, 0.f, 0.f, 0.f, 0.f, 0.f, 0.f, 0.f};
#pragma unroll
      for (int ks = 0; ks < 4; ++ks) {
        const bf16x8 kf = *(const bf16x8*)(Ks + lds_off(32 * (wid + kb) + l31, 2 * ks + hi));
        st[kb] = __builtin_amdgcn_mfma_f32_32x32x16_bf16(kf, qf[ks], st[kb], 0, 0, 0);
      }
    }
    float m = -INFINITY;
#pragma unroll
    for (int kb = 0; kb < 5; ++kb)
#pragma unroll
      for (int i = 0; i < 16; ++i) {
        const int kirel = 32 * kb + (i & 3) + 8 * (i >> 2) + 4 * hi;
        const bool valid = (kirel >= l31) && (kirel <= l31 + 128) && (n > 0 || (32 * wid + kirel) >= 128);
        const float s = valid ? st[kb][i] : -INFINITY;
        st[kb][i] = s;
        m = fmaxf(m, s);
      }
    m = fmaxf(m, __shfl_xor(m, 32, 64));
    float l = 0.f;
#pragma unroll
    for (int kb = 0; kb < 5; ++kb)
#pragma unroll
      for (int i = 0; i < 16; ++i) { const float pe = __expf(st[kb][i] - m); st[kb][i] = pe; l += pe; }
    l += __shfl_xor(l, 32, 64);
    f32x16 o0 = (f32x16){0.f, 0.f, 0.f, 0.f, 0.f, 0.f, 0.f, 0.f, 0.f, 0.f, 0.f, 0.f, 0.f, 0.f, 0.f, 0.f};
    f32x16 o1 = o0;
#pragma unroll
    for (int kb = 0; kb < 5; ++kb)
#pragma unroll
      for (int s = 0; s < 2; ++s) {
        union { unsigned u[4]; bf16x8 v; } pa;
        pa.u[0] = cvtpk(st[kb][8 * s + 0], st[kb][8 * s + 1]); pa.u[1] = cvtpk(st[kb][8 * s + 2], st[kb][8 * s + 3]);
        pa.u[2] = cvtpk(st[kb][8 * s + 4], st[kb][8 * s + 5]); pa.u[3] = cvtpk(st[kb][8 * s + 6], st[kb][8 * s + 7]);
        const int key0 = 32 * (wid + kb) + 16 * s + 4 * hi;
        {
          union { uint2 u[2]; bf16x8 v; } vb;
          vb.u[0] = *(const uint2*)(VT + vt_off(l31, key0)); vb.u[1] = *(const uint2*)(VT + vt_off(l31, key0 + 8));
          o0 = __builtin_amdgcn_mfma_f32_32x32x16_bf16(pa.v, vb.v, o0, 0, 0, 0);
        }
        {
          union { uint2 u[2]; bf16x8 v; } vb;
          vb.u[0] = *(const uint2*)(VT + vt_off(32 + l31, key0)); vb.u[1] = *(const uint2*)(VT + vt_off(32 + l31, key0 + 8));
          o1 = __builtin_amdgcn_mfma_f32_32x32x16_bf16(pa.v, vb.v, o1, 0, 0, 0);
        }
      }
    if (hi == 0) {
      linv_s[wid * 32 + l31] = 1.f / l;
      LSE[((size_t)pp * T_TOK + tq) * 8 + h] = m + __logf(l);
    }
#pragma unroll
    for (int i = 0; i < 16; ++i) {
      const int qrel = (i & 3) + 8 * (i >> 2) + 4 * hi;
      const int iq2 = n * 128 + wid * 32 + qrel;
      const int tq2 = tb + (iq2 << dsh) + r;
      const float li = linv_s[wid * 32 + qrel];
      bf16_t* op = OP + ((size_t)pp * T_TOK + tq2) * 512 + h * 64 + l31;
      op[0] = f2bf(o0[i] * li);
      op[32] = f2bf(o1[i] * li);
    }
  }
}

__device__ __forceinline__ void phase_convert(const Params& p, char* smem) {
  int* ctl = (int*)(p.ws + OFF_CTL);
  int* slot = (int*)(smem + 66304);
  __syncthreads();
  int ti;
  for (;;) {
    if (threadIdx.x == 0) *slot = atomicAdd(&ctl[CTL_CONVQ], 1);
    __syncthreads();
    ti = *slot;
    __syncthreads();
    if (ti >= 6144) break;
    attn_item(p, smem, ti);
  }
  __builtin_amdgcn_sched_barrier(0);
  for (;;) {
    if (ti >= 6144 + CONV_TILES / 2) break;
    convert_tile2(p, smem, ti - 6144);
    if (threadIdx.x == 0) *slot = atomicAdd(&ctl[CTL_CONVQ], 1);
    __syncthreads();
    ti = *slot;
    __syncthreads();
  }
}

__device__ __forceinline__ void unpack8(const uint4 u, float (&f)[8]) {
  f[0] = __uint_as_float(u.x << 16); f[1] = __uint_as_float(u.x & 0xffff0000u); f[2] = __uint_as_float(u.y << 16); f[3] = __uint_as_float(u.y & 0xffff0000u);
  f[4] = __uint_as_float(u.z << 16); f[5] = __uint_as_float(u.z & 0xffff0000u); f[6] = __uint_as_float(u.w << 16); f[7] = __uint_as_float(u.w & 0xffff0000u);
}
__device__ __forceinline__ float dpp_sum8(float v) {
  v += DPP_F(v, 0xB1); v += DPP_F(v, 0x4E); v += DPP_F(v, 0x141);
  return v;
}
__device__ __forceinline__ void phase_post(const Params& p) {
  const float* __restrict__ YS = (const float*)(p.ws + OFF_YS); const bf16_t* __restrict__ V2 = (const bf16_t*)(p.ws + OFF_V2);
  const bf16_t* __restrict__ G = (const bf16_t*)(p.ws + OFF_G); const float* __restrict__ SB = (const float*)(p.ws + OFF_SB);
  const bf16_t* __restrict__ OP = (const bf16_t*)(p.ws + OFF_OP); const float* __restrict__ LSE = (const float*)(p.ws + OFF_LSE);
  const float* __restrict__ lnx_g = p.in[11]; const float* __restrict__ lnx_b = p.in[12];
  bf16_t* MIXED = (bf16_t*)(p.ws + OFF_MIXED);
  const int lane = threadIdx.x & 63, wid = threadIdx.x >> 6;
  const int c = lane * 8, hh = lane >> 3;
  const float4 g0 = *(const float4*)(lnx_g + c), g1 = *(const float4*)(lnx_g + c + 4), b0 = *(const float4*)(lnx_b + c), b1 = *(const float4*)(lnx_b + c + 4);
  const float gg[8] = {g0.x, g0.y, g0.z, g0.w, g1.x, g1.y, g1.z, g1.w}, bb[8] = {b0.x, b0.y, b0.z, b0.w, b1.x, b1.y, b1.z, b1.w};
  for (int t = blockIdx.x * 4 + wid; t < T_TOK; t += gridDim.x * 4) {
    const size_t o = (size_t)t * 512 + c;
    const float4 y0 = *(const float4*)(YS + o), y1 = *(const float4*)(YS + o + 4);
    const float y[8] = {y0.x, y0.y, y0.z, y0.w, y1.x, y1.y, y1.z, y1.w};
    float s = 0.f;
#pragma unroll
    for (int i = 0; i < 8; ++i) s += y[i];
    const float mean = dpp_sum8(s) * (1.f / 64.f);
    float q = 0.f;
#pragma unroll
    for (int i = 0; i < 8; ++i) { const float d = y[i] - mean; q += d * d; }
    const float rs = rsqrtf(dpp_sum8(q) * (1.f / 64.f) + GN_EPS_F);
    float v2[8], gt[8];
    unpack8(*(const uint4*)(V2 + o), v2); unpack8(*(const uint4*)(G + o), gt);
    const float sb = SB[(size_t)t * 8 + hh];
    float res[8];
#pragma unroll
    for (int i = 0; i < 8; ++i) res[i] = ((y[i] - mean) * rs * gg[i] + bb[i] + sb * v2[i]) * gt[i];
    uint4 w; w.x = cvtpk(res[0], res[1]); w.y = cvtpk(res[2], res[3]); w.z = cvtpk(res[4], res[5]); w.w = cvtpk(res[6], res[7]);
    *(uint4*)(MIXED + (size_t)t * 1024 + 512 + c) = w;
    const float l0 = LSE[((size_t)0 * T_TOK + t) * 8 + hh], l1 = LSE[((size_t)1 * T_TOK + t) * 8 + hh], l2 = LSE[((size_t)2 * T_TOK + t) * 8 + hh];
    const float mx = fmaxf(l0, fmaxf(l1, l2));
    float e0 = __expf(l0 - mx), e1 = __expf(l1 - mx), e2 = __expf(l2 - mx);
    const float inv = 1.f / (e0 + e1 + e2);
    e0 *= inv; e1 *= inv; e2 *= inv;
    float o0[8], o1[8], o2[8];
    unpack8(*(const uint4*)(OP + (size_t)0 * T_TOK * 512 + o), o0); unpack8(*(const uint4*)(OP + (size_t)1 * T_TOK * 512 + o), o1);
    unpack8(*(const uint4*)(OP + (size_t)2 * T_TOK * 512 + o), o2);
    float av[8];
#pragma unroll
    for (int i = 0; i < 8; ++i) av[i] = e0 * o0[i] + e1 * o1[i] + e2 * o2[i];
    w.x = cvtpk(av[0], av[1]); w.y = cvtpk(av[2], av[3]); w.z = cvtpk(av[4], av[5]); w.w = cvtpk(av[6], av[7]);
    *(uint4*)(MIXED + (size_t)t * 1024 + c) = w;
  }
}

__device__ __forceinline__ void phase_outproj(const Params& p, char* smem) {
  const bf16_t* __restrict__ MIXED = (const bf16_t*)(p.ws + OFF_MIXED);
  const bf16_t* __restrict__ WOUTT = (const bf16_t*)(p.ws + OFF_WOUTT); const float* __restrict__ x = p.in[0];
  float* U = p.out;
  for (int i = XCD_LB; i < T_TOK / 128; i += XCD_NB) {
    const int row0 = i * 128, col0 = XCD_GROUP * 128;
    gemm128_glds(smem, DM,
            [=](int r) { return MIXED + (size_t)(row0 + r) * DM; },
            [=](int r) { return WOUTT + (size_t)(col0 + r) * DM; },
            [=](f32x4 (&acc)[4][4], int wr, int wc, int fr, int fq) {
#pragma unroll
              for (int m = 0; m < 4; ++m) {
                const int t = row0 + wr * 64 + m * 16 + fr;
#pragma unroll
                for (int n = 0; n < 4; ++n) {
                  const size_t o = (size_t)t * DM + col0 + wc * 64 + n * 16 + fq * 4;
                  const float4 xv = *(const float4*)(x + o);
                  *(float4*)(U + o) = make_float4(ALPHA_F * xv.x + acc[m][n][0], ALPHA_F * xv.y + acc[m][n][1], ALPHA_F * xv.z + acc[m][n][2], ALPHA_F * xv.w + acc[m][n][3]);
                }
              }
            });
  }
}

__device__ __forceinline__ void phase_ln1(const Params& p) {
  float* X1 = p.out;
  const float* __restrict__ g1 = p.in[14]; const float* __restrict__ b1 = p.in[15];
  bf16_t* X1B = (bf16_t*)(p.ws + OFF_X1B);
  const int lane = threadIdx.x & 63, wid = threadIdx.x >> 6;
  for (int t = blockIdx.x * 4 + wid; t < T_TOK; t += gridDim.x * 4) {
    const size_t base = (size_t)t * DM;
    float4 v[4];
    float s = 0.f;
#pragma unroll
    for (int u = 0; u < 4; ++u) { v[u] = *(const float4*)(X1 + base + u * 256 + lane * 4); s += (v[u].x + v[u].y) + (v[u].z + v[u].w); }
    const float mean = wave_sum_fast(s) * (1.f / DM);
    float q = 0.f;
#pragma unroll
    for (int u = 0; u < 4; ++u) {
      const float d0 = v[u].x - mean, d1 = v[u].y - mean, d2 = v[u].z - mean, d3 = v[u].w - mean;
      q += (d0 * d0 + d1 * d1) + (d2 * d2 + d3 * d3);
    }
    const float rs = rsqrtf(wave_sum_fast(q) * (1.f / DM) + LN_EPS_F);
#pragma unroll
    for (int u = 0; u < 4; ++u) {
      const int c = u * 256 + lane * 4;
      const float4 g = *(const float4*)(g1 + c), bb = *(const float4*)(b1 + c);
      float4 y;
      y.x = (v[u].x - mean) * rs * g.x + bb.x; y.y = (v[u].y - mean) * rs * g.y + bb.y;
      y.z = (v[u].z - mean) * rs * g.z + bb.z; y.w = (v[u].w - mean) * rs * g.w + bb.w;
      *(float4*)(X1 + base + c) = y;
      uint2 hi; hi.x = cvtpk(y.x, y.y); hi.y = cvtpk(y.z, y.w);
      *(uint2*)(X1B + base + c) = hi;
    }
  }
}

__device__ __forceinline__ void phase_router_gemm(const Params& p, char* smem) {
  const bf16_t* __restrict__ X1B = (const bf16_t*)(p.ws + OFF_X1B);
  const float* __restrict__ router_w = p.in[16];
  float* AFF = (float*)(p.ws + OFF_AFF);
  for (int item = blockIdx.x; item < (T_TOK / 128) * 2; item += gridDim.x) {
    const int row0 = (item >> 1) * 128, col0 = (item & 1) * 128;
    f32x4 acc[4][4];
    acc_zero(acc);
    gemm128_acc<2, false>(acc, smem, 32,
        [=](int, int rowl, int kc) { return *(const uint4*)(X1B + (size_t)(row0 + rowl) * DM + (kc & 127) * 8); },
        [=](int nq) { return router_w + col0 + nq * 4; }, NEXP, 16);
    const int tid = threadIdx.x, lane = tid & 63, wid = tid >> 6;
    const int wr = wid >> 1, wc = wid & 1, fr = lane & 15, fq = lane >> 4;
#pragma unroll
    for (int m = 0; m < 4; ++m) {
      const int t = row0 + wr * 64 + m * 16 + fr;
#pragma unroll
      for (int n = 0; n < 4; ++n)
        *(float4*)(AFF + (size_t)t * NEXP + col0 + wc * 64 + n * 16 + fq * 4) =
            make_float4(sigmoidf_(acc[m][n][0]), sigmoidf_(acc[m][n][1]), sigmoidf_(acc[m][n][2]), sigmoidf_(acc[m][n][3]));
    }
  }
}

__device__ __forceinline__ void phase_topk(const Params& p) {
  const float* __restrict__ AFF = (const float*)(p.ws + OFF_AFF);
  const float* __restrict__ router_bias = p.in[17];
  int* LIST = (int*)(p.ws + OFF_LIST); float* GATEW = (float*)(p.ws + OFF_GATEW);
  int* counts = (int*)(p.ws + OFF_CTL);
  const int lane = threadIdx.x & 63, wid = threadIdx.x >> 6;
  const float4 b4 = *(const float4*)(router_bias + lane * 4);
  for (int t = blockIdx.x * 4 + wid; t < T_TOK; t += gridDim.x * 4) {
    const float4 a4 = *(const float4*)(AFF + (size_t)t * NEXP + lane * 4);
    float s0 = a4.x + b4.x, s1 = a4.y + b4.y, s2 = a4.z + b4.z, s3 = a4.w + b4.w;
    const float hi01 = fmaxf(s0, s1), lo01 = fminf(s0, s1), hi23 = fmaxf(s2, s3), lo23 = fminf(s2, s3);
    float m1 = fmaxf(hi01, hi23), m2 = fmaxf(fminf(hi01, hi23), fmaxf(lo01, lo23));
    { const float o1 = DPP_F(m1, 0xB1), o2 = DPP_F(m2, 0xB1); const float n1 = fmaxf(m1, o1); m2 = fmaxf(fminf(m1, o1), fmaxf(m2, o2)); m1 = n1; }
    { const float o1 = DPP_F(m1, 0x4E), o2 = DPP_F(m2, 0x4E); const float n1 = fmaxf(m1, o1); m2 = fmaxf(fminf(m1, o1), fmaxf(m2, o2)); m1 = n1; }
    { const float o1 = DPP_F(m1, 0x141), o2 = DPP_F(m2, 0x141); const float n1 = fmaxf(m1, o1); m2 = fmaxf(fminf(m1, o1), fmaxf(m2, o2)); m1 = n1; }
    const float gs = m1 + m2;
    const int g = lane >> 3;
    int rank = 0;
#pragma unroll
    for (int gg = 0; gg < 8; ++gg) { const float G = rdlane_f(gs, gg * 8); rank += ((G > gs) || (G == gs && gg < g)) ? 1 : 0; }
    if (rank >= 4) { s0 = -INFINITY; s1 = -INFINITY; s2 = -INFINITY; s3 = -INFINITY; }
    int my_e = 0; float my_a = 0.f;
#pragma unroll 1
    for (int it = 0; it < 8; ++it) {
      const float lm = fmaxf(fmaxf(s0, s1), fmaxf(s2, s3));
      const float wm = wave_max_fast(lm);
      const unsigned long long bal = __ballot(lm == wm);
      const int win = __ffsll((long long)bal) - 1;
      const int wi = (s0 == wm) ? 0 : ((s1 == wm) ? 1 : ((s2 == wm) ? 2 : 3));
      const float wa = (wi == 0) ? a4.x : ((wi == 1) ? a4.y : ((wi == 2) ? a4.z : a4.w));
      const int e_w = __builtin_amdgcn_readlane(lane * 4 + wi, win);
      const float a_w = rdlane_f(wa, win);
      if (lane == win) { if (wi == 0) s0 = -INFINITY; else if (wi == 1) s1 = -INFINITY; else if (wi == 2) s2 = -INFINITY; else s3 = -INFINITY; }
      if (lane == it) { my_e = e_w; my_a = a_w; }
    }
    const float asum = rdlane_f(dpp_sum16x(my_a), 0);
    if (lane < 8) {
      const int pos = atomicAdd(&counts[my_e], 1);
      if (pos < LCAP) LIST[(size_t)my_e * LCAP + pos] = lane * T_TOK + t;
      GATEW[(size_t)lane * T_TOK + t] = my_a * 2.5f / asum;
    }
  }
}

__device__ __forceinline__ int moe_group_setup(const int* counts, int* pre) {
  __syncthreads();
  if (threadIdx.x == 0) {
    const int g = XCD_GROUP;
    int acc = 0;
    for (int j = 0; j < 32; ++j) { pre[j] = acc; acc += (min(counts[g + 8 * j], LCAP) + 127) >> 7; }
    pre[32] = acc; acc += 32;
    pre[33] = acc;
  }
  __syncthreads();
  return pre[33];
}
__device__ __forceinline__ void phase_moe(const Params& p, char* smem) {
  int* asg = (int*)(smem + 65536); int* pre = asg + 128;
  const bf16_t* __restrict__ X1B = (const bf16_t*)(p.ws + OFF_X1B);
  const bf16_t* __restrict__ EW1 = (const bf16_t*)(p.ws + OFF_EW1); const bf16_t* __restrict__ EW2 = (const bf16_t*)(p.ws + OFF_EW2);
  const int* __restrict__ LIST = (const int*)(p.ws + OFF_LIST);
  const float* __restrict__ GATEW = (const float*)(p.ws + OFF_GATEW);
  const int* counts = (const int*)(p.ws + OFF_CTL);
  bf16_t* Y = (bf16_t*)(p.ws + OFF_Y);
  bf16_t* HS = (bf16_t*)(p.ws + OFF_HSCR) + (size_t)blockIdx.x * 128 * 256;
  float* X1 = p.out;
  const int nitems = moe_group_setup(counts, pre);
  for (int i = XCD_LB; i < nitems; i += XCD_NB) {
    int j = 0;
#pragma unroll 1
    for (int q = 1; q <= 32; ++q) j = (pre[q] <= i) ? q : j;
    const int w = i - pre[j];
    const int e = (j < 32) ? (XCD_GROUP + 8 * j) : NEXP;
    const int cnt = (j < 32) ? min(counts[e], LCAP) : T_TOK;
    const int r0 = (j < 32) ? w * 128 : (XCD_GROUP * 32 + w) * 128;
    __syncthreads();
    if (threadIdx.x < 128) {
      const int r = r0 + threadIdx.x;
      asg[threadIdx.x] = (r < cnt) ? ((e < NEXP) ? LIST[(size_t)e * LCAP + r] : (8 * T_TOK + r)) : -1;
    }
    __syncthreads();
    const bf16_t* __restrict__ W1 = EW1 + (size_t)e * 512 * 1024;
    const bf16_t* __restrict__ W2 = EW2 + (size_t)e * 1024 * 256;
    gemm128_glds_multi<4, 16>(smem,
            [=](int r) { int a = asg[r]; return X1B + (size_t)((a >= 0 ? a : 0) & (T_TOK - 1)) * DM; },
            [=](int r) { return W1 + (size_t)r * DM; }, (size_t)128 * DM,
            [=](int nt, f32x4 (&acc)[4][4], int wr, int wc, int fr, int fq) {
#pragma unroll
              for (int m = 0; m < 4; ++m) {
                const int row = wr * 64 + m * 16 + fr;
#pragma unroll
                for (int n = 0; n < 2; ++n) {
                  float hv[4];
#pragma unroll
                  for (int jj = 0; jj < 4; ++jj) { const float g = acc[m][n][jj], u = acc[m][n + 2][jj]; hv[jj] = g * sigmoidf_(g) * u; }
                  *(uint2*)(HS + (size_t)row * 256 + nt * 64 + wc * 32 + n * 16 + fq * 4) = pack4(hv[0], hv[1], hv[2], hv[3]);
                }
              }
            });
    __syncthreads();
    gemm128_glds_multi<8, 4>(smem,
            [=](int r) { return HS + (size_t)r * 256; },
            [=](int r) { return W2 + (size_t)r * 256; }, (size_t)128 * 256,
            [=](int nt, f32x4 (&acc)[4][4], int wr, int wc, int fr, int fq) {
#pragma unroll
              for (int m = 0; m < 4; ++m) {
                const int a = asg[wr * 64 + m * 16 + fr];
                if (a < 0) continue;
                if (a < 8 * T_TOK) {
                  const float gw = GATEW[a];
#pragma unroll
                  for (int n = 0; n < 4; ++n)
                    *(uint2*)(Y + (size_t)a * DM + nt * 128 + wc * 64 + n * 16 + fq * 4) =
                        pack4(acc[m][n][0] * gw, acc[m][n][1] * gw, acc[m][n][2] * gw, acc[m][n][3] * gw);
                } else {
                  const int t = a - 8 * T_TOK;
#pragma unroll
                  for (int n = 0; n < 4; ++n) {
                    float* xp = X1 + (size_t)t * DM + nt * 128 + wc * 64 + n * 16 + fq * 4;
                    const float4 xv = *(const float4*)xp;
                    *(float4*)xp = make_float4(ALPHA_F * xv.x + acc[m][n][0], ALPHA_F * xv.y + acc[m][n][1], ALPHA_F * xv.z + acc[m][n][2], ALPHA_F * xv.w + acc[m][n][3]);
                  }
                }
              }
            });
  }
}

__device__ __forceinline__ void phase_final(const Params& p, char* smem) {
  float* OUT = p.out;
  const bf16_t* __restrict__ Y = (const bf16_t*)(p.ws + OFF_Y);
  const float* __restrict__ g2 = p.in[24]; const float* __restrict__ b2 = p.in[25];
  const int lane = threadIdx.x & 63, wid = threadIdx.x >> 6;
  for (int t = blockIdx.x * 4 + wid; t < T_TOK; t += gridDim.x * 4) {
    const size_t base = (size_t)t * DM;
    float4 v[4];
    float s = 0.f;
#pragma unroll
    for (int u = 0; u < 4; ++u) {
      const int c = u * 256 + lane * 4;
      const float4 xv = *(const float4*)(OUT + base + c);
      float a0 = 0.f, a1 = 0.f, a2 = 0.f, a3 = 0.f;
#pragma unroll
      for (int sl = 0; sl < 8; ++sl) {
        const float4 yv = bf4_to_f4(*(const uint2*)(Y + ((size_t)sl * T_TOK + t) * DM + c));
        a0 += yv.x; a1 += yv.y; a2 += yv.z; a3 += yv.w;
      }
      v[u] = make_float4(xv.x + a0, xv.y + a1, xv.z + a2, xv.w + a3);
      s += (v[u].x + v[u].y) + (v[u].z + v[u].w);
    }
    const float mean = wave_sum_fast(s) * (1.f / DM);
    float q = 0.f;
#pragma unroll
    for (int u = 0; u < 4; ++u) {
      const float d0 = v[u].x - mean, d1 = v[u].y - mean, d2 = v[u].z - mean, d3 = v[u].w - mean;
      q += (d0 * d0 + d1 * d1) + (d2 * d2 + d3 * d3);
    }
    const float rs = rsqrtf(wave_sum_fast(q) * (1.f / DM) + LN_EPS_F);
#pragma unroll
    for (int u = 0; u < 4; ++u) {
      const int c = u * 256 + lane * 4;
      const float4 g = *(const float4*)(g2 + c), bb = *(const float4*)(b2 + c);
      *(float4*)(OUT + base + c) = make_float4((v[u].x - mean) * rs * g.x + bb.x, (v[u].y - mean) * rs * g.y + bb.y,
                                               (v[u].z - mean) * rs * g.z + bb.z, (v[u].w - mean) * rs * g.w + bb.w);
    }
  }
}

#define LAS __attribute__((address_space(3)))
#define XB_TMO      128
#define XB_XCNT(j)  (256  + 64 * (j))
#define XB_XSUB(j)  (1280 + 64 * (j))
#define XB_XGEN(j)  (2304 + 64 * (j))
#define XB_TOP      3328
#define XB_TOPGEN   3392
#define XCD_BAR_WORDS 3456
#define XB_SPIN_CAP (1u << 22)
__device__ __forceinline__ unsigned xb_ld(unsigned* p)              { return __hip_atomic_load(p, __ATOMIC_RELAXED, __HIP_MEMORY_SCOPE_AGENT); }
__device__ __forceinline__ unsigned xb_add(unsigned* p, unsigned v) { return __hip_atomic_fetch_add(p, v, __ATOMIC_RELAXED, __HIP_MEMORY_SCOPE_AGENT); }
__device__ __forceinline__ unsigned xb_xcc_id() { return (unsigned)__builtin_amdgcn_s_getreg((3 << 11) | 20) & 0xFu; }
#define XB_SPIN(cond, bar) do { unsigned _sp = 0; while (cond) { __builtin_amdgcn_s_sleep(1); \
    if ((++_sp & 255u) == 0u) { if (xb_ld(&(bar)[XB_TMO])) break; if (_sp > XB_SPIN_CAP) { atomicAdd(&(bar)[XB_TMO], 1u); break; } } } } while (0)
struct XcdBarrier { unsigned* bar; unsigned x; volatile LAS unsigned* st; };
__device__ __forceinline__ XcdBarrier xcd_barrier_post(unsigned* bar, volatile LAS unsigned* st) {
  XcdBarrier b; b.bar = bar; b.x = xb_xcc_id(); b.st = st;
  if (threadIdx.x == 0) (void)xb_add(&bar[XB_XCNT(b.x)], 1u);
  return b;
}
__device__ __forceinline__ void xcd_barrier_complete(unsigned* bar, unsigned x, unsigned& nloc, unsigned& nx) {
  const unsigned G = gridDim.x * gridDim.y * gridDim.z;
  unsigned sum, cnt, mine, sp = 0u;
  for (;;) {
    sum = 0u; cnt = 0u; mine = 0u;
#pragma unroll
    for (unsigned j = 0; j < 16; ++j) { const unsigned c = xb_ld(&bar[XB_XCNT(j)]); sum += c; cnt += (c > 0u) ? 1u : 0u; mine = (j == x) ? c : mine; }
    if (sum == G) break;
    __builtin_amdgcn_s_sleep(1);
    if ((++sp & 255u) == 0u) { if (xb_ld(&bar[XB_TMO])) break; if (sp > XB_SPIN_CAP) { atomicAdd(&bar[XB_TMO], 1u); break; } }
  }
  nloc = mine > 0u ? mine : 1u; nx = cnt > 0u ? cnt : 1u;
}
__device__ __forceinline__ void xcd_barrier(const XcdBarrier& b) {
  asm volatile("s_waitcnt vmcnt(0)" ::: "memory");
  __syncthreads();
  if (threadIdx.x == 0) {
    unsigned* bar = b.bar;
    __builtin_amdgcn_s_waitcnt(0);
    unsigned nloc = b.st[0], nx = b.st[1];
    if (nloc == 0u) { xcd_barrier_complete(bar, b.x, nloc, nx); b.st[0] = nloc; b.st[1] = nx; }
    const unsigned old = xb_add(&bar[XB_XSUB(b.x)], 1u);
    const unsigned gen = old / nloc;
    if (old + 1u == (gen + 1u) * nloc) {
      __builtin_amdgcn_fence(__ATOMIC_RELEASE, "agent");
      asm volatile("s_waitcnt vmcnt(0)" ::: "memory");
      const unsigned og = xb_add(&bar[XB_TOP], 1u);
      const unsigned tg = og / nx;
      if (og + 1u == (tg + 1u) * nx) xb_add(&bar[XB_TOPGEN], 1u);
      else XB_SPIN(xb_ld(&bar[XB_TOPGEN]) == tg, bar);
      __builtin_amdgcn_fence(__ATOMIC_ACQUIRE, "agent");
      xb_add(&bar[XB_XGEN(b.x)], 1u);
      asm volatile("s_waitcnt vmcnt(0)" ::: "memory");
    } else {
      XB_SPIN(xb_ld(&bar[XB_XGEN(b.x)]) == gen, bar);
      __builtin_amdgcn_fence(__ATOMIC_ACQUIRE, "agent");
      asm volatile("s_waitcnt vmcnt(0)" ::: "memory");
    }
  }
  __syncthreads();
}
#define CTL_BAR_WORD 4096
#define CTL_ZERO_BYTES 32768
#define LDS_BAR_OFF 66432

__global__ void __launch_bounds__(NTHR, 2) mega(Params p) {
  extern __shared__ __attribute__((aligned(16))) char smem[];
  cg::grid_group grid = cg::this_grid();
  volatile LAS unsigned* bst = (volatile LAS unsigned*)(LAS char*)(smem + LDS_BAR_OFF);
  if (threadIdx.x < 2) bst[threadIdx.x] = 0u;
  __syncthreads();
  const XcdBarrier bar = xcd_barrier_post((unsigned*)(p.ws + OFF_CTL) + CTL_BAR_WORD, bst);
  phase_rope(p);
  if (p.ws == nullptr) grid.sync();
  xcd_barrier(bar);
  phase_inproj(p, smem);
  xcd_barrier(bar);
  phase_prep_a(p);
  xcd_barrier(bar);
  phase_prep(p, smem);
  xcd_barrier(bar);
  phase_scan(p, smem);
  phase_convert(p, smem);
  xcd_barrier(bar);
  phase_post(p);
  xcd_barrier(bar);
  phase_outproj(p, smem);
  xcd_barrier(bar);
  phase_ln1(p);
  xcd_barrier(bar);
  phase_router_gemm(p, smem);
  xcd_barrier(bar);
  phase_topk(p);
  xcd_barrier(bar);
  phase_moe(p, smem);
  xcd_barrier(bar);
  phase_final(p, smem);
}

extern "C" void kernel_launch(void* const* d_in, const int* in_sizes, int n_in, void* d_out, int out_size, void* d_ws, size_t ws_size,
                              hipStream_t stream) {
  static int grid_blocks = 0;
  if (grid_blocks == 0) {
    if (ws_size < WS_NEED || n_in != 26) { fprintf(stderr, "kernel_launch: bad ws/n_in: %zu < %zu, n_in %d\n", ws_size, (size_t)WS_NEED, n_in); grid_blocks = -1; return; }
    int dev = 0, cus = 0, per_cu = 0;
    (void)hipGetDevice(&dev);
    (void)hipDeviceGetAttribute(&cus, hipDeviceAttributeMultiprocessorCount, dev);
    (void)hipFuncSetAttribute((const void*)mega, hipFuncAttributeMaxDynamicSharedMemorySize, LDS_BYTES);
    (void)hipOccupancyMaxActiveBlocksPerMultiprocessor(&per_cu, (const void*)mega, NTHR, LDS_BYTES);
    if (per_cu < 1) { fprintf(stderr, "kernel_launch: occupancy query returned %d\n", per_cu); grid_blocks = -1; return; }
    if (per_cu > 2) per_cu = 2;
    grid_blocks = cus * per_cu;
    if (grid_blocks > 512) grid_blocks = 512;
    fprintf(stderr, "kernel_launch: cus %d per_cu %d grid %d\n", cus, per_cu, grid_blocks);
  }
  if (grid_blocks < 0) return;
  if (hipMemsetAsync((char*)d_ws + OFF_CTL, 0, CTL_ZERO_BYTES, stream) != hipSuccess) { fprintf(stderr, "kernel_launch: memset failed\n"); return; }
  Params p{};
  for (int i = 0; i < 26; ++i) p.in[i] = (const float*)d_in[i];
  p.out = (float*)d_out;
  p.ws = (char*)d_ws;
  void* args[] = {&p};
  hipError_t e = hipLaunchCooperativeKernel((const void*)mega, dim3(grid_blocks), dim3(NTHR), args, LDS_BYTES, stream);
  if (e != hipSuccess) fprintf(stderr, "cooperative launch failed: %s (grid %d)\n", hipGetErrorString(e), grid_blocks);
}
```

```cpp
#include <hip/hip_runtime.h>
#include <hip/hip_bf16.h>
#include <hip/hip_cooperative_groups.h>
#include <stdint.h>
#include <stdio.h>

typedef unsigned short bf16_t;

#define T_TOK 32768
#define SEQ 4096
#define DM 1024
#define INW 3360
#define FEW 1824
#define NEXP 256
#define ALPHA_F 1.189207115002721f
#define LN_EPS_F 1e-5f
#define GN_EPS_F 64e-5f

__device__ __forceinline__ float bf2f(bf16_t v) { return __uint_as_float(((unsigned)v) << 16); }
__device__ __forceinline__ bf16_t f2bf(float f) { unsigned u = __float_as_uint(f); return (bf16_t)((u + 0x7fffu + ((u >> 16) & 1u)) >> 16); }
__device__ __forceinline__ float sigmoidf_(float x) { return 1.f / (1.f + __expf(-x)); }
__device__ __forceinline__ float wave_sum(float v) {
#pragma unroll
  for (int o = 32; o >= 1; o >>= 1) v += __shfl_xor(v, o, 64);
  return v;
}

constexpr size_t SZ_T512_BF = (size_t)T_TOK * 512 * 2;
constexpr size_t OFF_EW1 = 0;
constexpr size_t OFF_EW2 = OFF_EW1 + (size_t)257 * 512 * 1024 * 2;
constexpr size_t LBASE = OFF_EW2 + (size_t)257 * 1024 * 256 * 2;
constexpr size_t OFF_XB = 0;
constexpr size_t OFF_FEATS = OFF_XB + (size_t)T_TOK * 1024 * 2;
constexpr size_t OFF_ACT = OFF_FEATS + (size_t)T_TOK * FEW * 2;
constexpr size_t OFF_WINT = OFF_ACT + (size_t)T_TOK * 320 * 2;
constexpr size_t OFF_ROPE = OFF_WINT + (size_t)3456 * 1024 * 2;
static_assert(OFF_ROPE + (size_t)4096 * 32 * 2 * 4 <= LBASE, "early region E overlay");
constexpr size_t OFF_Q = LBASE;
constexpr size_t OFF_K = OFF_Q + SZ_T512_BF;
constexpr size_t OFF_V = OFF_K + SZ_T512_BF;
constexpr size_t OFF_R = OFF_V + SZ_T512_BF;
constexpr size_t OFF_K2 = OFF_R + SZ_T512_BF;
constexpr size_t OFF_V2 = OFF_K2 + SZ_T512_BF;
constexpr size_t OFF_A = OFF_V2 + SZ_T512_BF;
constexpr size_t OFF_B = OFF_A + SZ_T512_BF;
constexpr size_t OFF_W = OFF_B + SZ_T512_BF;
constexpr size_t OFF_G = OFF_W + (size_t)T_TOK * 512 * 4;
constexpr size_t OFF_SB = OFF_G + SZ_T512_BF;
constexpr size_t OFF_YS = OFF_SB + (size_t)T_TOK * 8 * 4;
constexpr size_t OFF_OP = OFF_YS + (size_t)T_TOK * 512 * 4;
constexpr size_t OFF_LSE = OFF_OP + 3 * SZ_T512_BF;
constexpr size_t OFF_MIXED = OFF_LSE + (size_t)3 * T_TOK * 8 * 4;
constexpr size_t OFF_WOUTT = OFF_MIXED + (size_t)T_TOK * 1024 * 2;
constexpr size_t EARLY_END = OFF_WOUTT + (size_t)1024 * 1024 * 2;
constexpr size_t OFF_Y = LBASE;
constexpr size_t OFF_AFF = LBASE + (size_t)T_TOK * 1024 * 2;
constexpr size_t OFF_X1B = OFF_Y + (size_t)8 * T_TOK * 1024 * 2;
#define LCAP 16384
constexpr size_t OFF_LIST = OFF_X1B + (size_t)T_TOK * 1024 * 2;
constexpr size_t OFF_GATEW = OFF_LIST + (size_t)NEXP * LCAP * 4;
constexpr size_t OFF_HSCR = OFF_GATEW + (size_t)8 * T_TOK * 4;
constexpr size_t OFF_CTL = OFF_HSCR + (size_t)512 * 128 * 256 * 2;
constexpr size_t CTL_BYTES = 1u << 20;
constexpr size_t WS_NEED = OFF_CTL + CTL_BYTES;
static_assert(EARLY_END <= OFF_HSCR, "early buffers must stay below the per-block scratch / control words");
static_assert(WS_NEED <= (size_t)1073741824, "workspace must fit 1 GiB");
#define CTL_CONVQ 512

typedef short bf16x8 __attribute__((ext_vector_type(8)));
typedef float f32x4 __attribute__((ext_vector_type(4)));
typedef float f32x16 __attribute__((ext_vector_type(16)));
typedef float f32x2_t __attribute__((ext_vector_type(2)));
typedef __bf16 bf16x2_t __attribute__((ext_vector_type(2)));
__device__ __forceinline__ unsigned cvtpk(float lo, float hi) { f32x2_t v = {lo, hi}; bf16x2_t b = __builtin_convertvector(v, bf16x2_t); return __builtin_bit_cast(unsigned, b); }

__device__ const double INVF[32] = {
1, 0.74989420933245587, 0.56234132519034907, 0.42169650342858223, 0.31622776601683794, 0.23713737056616552,
0.17782794100389229, 0.1333521432163324, 0.10000000000000001, 0.074989420933245579, 0.056234132519034911,
0.042169650342858224, 0.031622776601683791, 0.023713737056616554, 0.017782794100389229, 0.013335214321633241,
0.01, 0.0074989420933245579, 0.005623413251903491, 0.0042169650342858229, 0.0031622776601683794,
0.0023713737056616554, 0.0017782794100389228, 0.0013335214321633241, 0.001, 0.00074989420933245586,
0.0005623413251903491, 0.00042169650342858224, 0.00031622776601683794, 0.00023713737056616554,
0.00017782794100389227, 0.0001333521432163324};

namespace cg = cooperative_groups;

struct Params {
  const float* in[26];
  float* out;
  char* ws;
};

#define NTHR 256
#define LDS_BYTES 66560

__device__ __forceinline__ void phase_rope(const Params& p) {
  float* tab = (float*)(p.ws + OFF_ROPE);
  for (int i = blockIdx.x * NTHR + threadIdx.x; i < 4096 * 32; i += gridDim.x * NTHR) {
    int pos = i >> 5, f = i & 31;
    double ang = (double)pos * INVF[f];
    const double TWO_PI = 6.283185307179586476925286766559;
    double n = rint(ang / TWO_PI);
    double r = ang - n * TWO_PI;
    double r2 = r * r;
    double sn = r, cs = 1.0, ts = r, tc = 1.0;
#pragma unroll 1
    for (int k = 1; k <= 16; ++k) {
      tc = -tc * r2 / (double)((2 * k - 1) * (2 * k));
      ts = -ts * r2 / (double)((2 * k) * (2 * k + 1));
      cs += tc; sn += ts;
    }
    tab[i * 2] = (float)cs; tab[i * 2 + 1] = (float)sn;
  }
  {
    const float* __restrict__ w_in = p.in[1]; const float* __restrict__ w_out = p.in[13];
    uint4* wint = (uint4*)(p.ws + OFF_WINT); uint4* woutt = (uint4*)(p.ws + OFF_WOUTT);
    const int NJ1 = 3456 * 128, NJ2 = 1024 * 128;
    for (int i = blockIdx.x * NTHR + threadIdx.x; i < NJ1 + NJ2; i += gridDim.x * NTHR) {
      const bool second = i >= NJ1;
      const int q = second ? i - NJ1 : i;
      const int N = second ? 1024 : 3456, NV = second ? 1024 : INW;
      const int n = q % N, ko = q / N;
      const float* __restrict__ src = second ? w_out : w_in;
      float f[8];
#pragma unroll
      for (int u = 0; u < 8; ++u) f[u] = (n < NV) ? src[(size_t)(ko * 8 + u) * NV + n] : 0.f;
      uint4 w; w.x = cvtpk(f[0], f[1]); w.y = cvtpk(f[2], f[3]); w.z = cvtpk(f[4], f[5]); w.w = cvtpk(f[6], f[7]);
      (second ? woutt : wint)[(size_t)n * 128 + ko] = w;
    }
  }
  {
    const float4* __restrict__ x4 = (const float4*)p.in[0];
    uint4* xb = (uint4*)(p.ws + OFF_XB);
    for (size_t i = (size_t)blockIdx.x * NTHR + threadIdx.x; i < (size_t)T_TOK * DM / 8; i += (size_t)gridDim.x * NTHR) {
      float4 a = x4[2 * i], b = x4[2 * i + 1];
      uint4 w; w.x = cvtpk(a.x, a.y); w.y = cvtpk(a.z, a.w); w.z = cvtpk(b.x, b.y); w.w = cvtpk(b.z, b.w);
      xb[i] = w;
    }
  }
}

template <class AF, class BF>
__device__ __forceinline__ void gemm64_naive(float* As, float* Bs, float* Cs, int K, AF af, BF bf) {
  const int tid = threadIdx.x, tx = tid & 15, ty = tid >> 4;
  float acc[4][4];
#pragma unroll
  for (int i = 0; i < 4; ++i)
#pragma unroll
    for (int j = 0; j < 4; ++j) acc[i][j] = 0.f;
  for (int k0 = 0; k0 < K; k0 += 16) {
#pragma unroll
    for (int u = 0; u < 4; ++u) { int i = tid + u * 256; int r = i >> 4, kk = i & 15; As[kk * 68 + r] = af(r, k0 + kk); }
#pragma unroll
    for (int u = 0; u < 4; ++u) { int i = tid + u * 256; int kk = i >> 6, c = i & 63; Bs[kk * 68 + c] = bf(k0 + kk, c); }
    __syncthreads();
#pragma unroll
    for (int kk = 0; kk < 16; ++kk) {
      float a[4], b[4];
#pragma unroll
      for (int i = 0; i < 4; ++i) { a[i] = As[kk * 68 + ty * 4 + i]; b[i] = Bs[kk * 68 + tx * 4 + i]; }
#pragma unroll
      for (int i = 0; i < 4; ++i)
#pragma unroll
        for (int j = 0; j < 4; ++j) acc[i][j] += a[i] * b[j];
    }
    __syncthreads();
  }
#pragma unroll
  for (int i = 0; i < 4; ++i)
#pragma unroll
    for (int j = 0; j < 4; ++j) Cs[(ty * 4 + i) * 65 + tx * 4 + j] = acc[i][j];
  __syncthreads();
}


__device__ __forceinline__ int lds_off(int row, int chunk) { return row * 128 + ((chunk ^ ((row >> 1) & 7)) << 4); }

template <int BMODE>
__device__ __forceinline__ unsigned cvtpk_m(float a, float b, const bool lo = false) {
  if (BMODE == 0 || (BMODE == 2 && !lo)) return cvtpk(a, b);
  const unsigned h = cvtpk(a, b);
  const float ah = __uint_as_float(h << 16), bh = __uint_as_float(h & 0xffff0000u);
  return cvtpk(a - ah, b - bh);
}
#define G128_MMA(bufoff) { \
    _Pragma("unroll") for (int kk = 0; kk < 2; ++kk) { \
      bf16x8 af[4], bfr[4]; \
      _Pragma("unroll") for (int m = 0; m < 4; ++m) af[m] = *(const bf16x8*)(smem + (bufoff) + lds_off(wr * 64 + m * 16 + fr, kk * 4 + fq)); \
      _Pragma("unroll") for (int n = 0; n < 4; ++n) bfr[n] = *(const bf16x8*)(smem + (bufoff) + 16384 + lds_off(wc * 64 + n * 16 + fr, kk * 4 + fq)); \
      _Pragma("unroll") for (int m = 0; m < 4; ++m) \
        _Pragma("unroll") for (int n = 0; n < 4; ++n) acc[m][n] = __builtin_amdgcn_mfma_f32_16x16x32_bf16(bfr[n], af[m], acc[m][n], 0, 0, 0); \
    } }
template <int BMODE, bool KCLAMP, class ALoad, class BPtr>
__device__ __forceinline__ void gemm128_acc(f32x4 (&acc)[4][4], char* smem, const int nk, ALoad aload, BPtr bptr, const int ldb, const int kvalid) {
  const int tid = threadIdx.x, lane = tid & 63, wid = tid >> 6;
  const int wr = wid >> 1, wc = wid & 1, fr = lane & 15, fq = lane >> 4;
  const int achunk = tid & 7, arow0 = tid >> 3;
  const int nq = tid & 31, ko = tid >> 5;
  const float* bp0 = bptr(nq);
  const int oa0 = lds_off(arow0, achunk), oa1 = lds_off(arow0 + 32, achunk), oa2 = lds_off(arow0 + 64, achunk), oa3 = lds_off(arow0 + 96, achunk);
  const int ob0 = 16384 + lds_off(nq * 4 + 0, ko), ob1 = 16384 + lds_off(nq * 4 + 1, ko), ob2 = 16384 + lds_off(nq * 4 + 2, ko), ob3 = 16384 + lds_off(nq * 4 + 3, ko);
  uint4 ra0, ra1, ra2, ra3; float4 rb0, rb1, rb2, rb3, rb4, rb5, rb6, rb7;
#define G128_LOAD(kt) { \
    ra0 = aload(0, arow0, (kt) * 8 + achunk); ra1 = aload(1, arow0 + 32, (kt) * 8 + achunk); \
    ra2 = aload(2, arow0 + 64, (kt) * 8 + achunk); ra3 = aload(3, arow0 + 96, (kt) * 8 + achunk); \
    int kr_ = (kt) * 64 + ko * 8; \
    if (KCLAMP) kr_ = min(kr_, kvalid - 8);     \
    { \
      const float* b2_ = bp0 + (size_t)((BMODE == 2) ? (kr_ & 1023) : kr_) * ldb; \
      rb0 = *(const float4*)(b2_); rb1 = *(const float4*)(b2_ + (size_t)1 * ldb); rb2 = *(const float4*)(b2_ + (size_t)2 * ldb); \
      rb3 = *(const float4*)(b2_ + (size_t)3 * ldb); rb4 = *(const float4*)(b2_ + (size_t)4 * ldb); rb5 = *(const float4*)(b2_ + (size_t)5 * ldb); \
      rb6 = *(const float4*)(b2_ + (size_t)6 * ldb); rb7 = *(const float4*)(b2_ + (size_t)7 * ldb); \
    } }
#define G128_STORE(bufoff, lo_) { \
    char* const sb_ = smem + (bufoff); \
    *(uint4*)(sb_ + oa0) = ra0; *(uint4*)(sb_ + oa1) = ra1; *(uint4*)(sb_ + oa2) = ra2; *(uint4*)(sb_ + oa3) = ra3; \
    uint4 w; \
    w.x = cvtpk_m<BMODE>(rb0.x, rb1.x, lo_); w.y = cvtpk_m<BMODE>(rb2.x, rb3.x, lo_); w.z = cvtpk_m<BMODE>(rb4.x, rb5.x, lo_); w.w = cvtpk_m<BMODE>(rb6.x, rb7.x, lo_); \
    *(uint4*)(sb_ + ob0) = w; \
    w.x = cvtpk_m<BMODE>(rb0.y, rb1.y, lo_); w.y = cvtpk_m<BMODE>(rb2.y, rb3.y, lo_); w.z = cvtpk_m<BMODE>(rb4.y, rb5.y, lo_); w.w = cvtpk_m<BMODE>(rb6.y, rb7.y, lo_); \
    *(uint4*)(sb_ + ob1) = w; \
    w.x = cvtpk_m<BMODE>(rb0.z, rb1.z, lo_); w.y = cvtpk_m<BMODE>(rb2.z, rb3.z, lo_); w.z = cvtpk_m<BMODE>(rb4.z, rb5.z, lo_); w.w = cvtpk_m<BMODE>(rb6.z, rb7.z, lo_); \
    *(uint4*)(sb_ + ob2) = w; \
    w.x = cvtpk_m<BMODE>(rb0.w, rb1.w, lo_); w.y = cvtpk_m<BMODE>(rb2.w, rb3.w, lo_); w.z = cvtpk_m<BMODE>(rb4.w, rb5.w, lo_); w.w = cvtpk_m<BMODE>(rb6.w, rb7.w, lo_); \
    *(uint4*)(sb_ + ob3) = w; }
  G128_LOAD(0)
  G128_STORE(0, false)
  if (nk > 1) G128_LOAD(1)
  __syncthreads();
  for (int kt = 0; kt < nk; ++kt) {
    const int cur = (kt & 1) * 32768;
    __builtin_amdgcn_sched_barrier(0);
    G128_MMA(cur)
    __builtin_amdgcn_sched_barrier(0);
    if (kt + 1 < nk) {
      G128_STORE(cur ^ 32768, (kt + 1) >= kvalid)
      __builtin_amdgcn_sched_barrier(0);
      if (kt + 2 < nk) G128_LOAD(kt + 2)
    }
    __builtin_amdgcn_sched_barrier(0);
    __syncthreads();
  }
#undef G128_LOAD
#undef G128_STORE
}
__device__ __forceinline__ void acc_zero(f32x4 (&acc)[4][4]) {
#pragma unroll
  for (int m = 0; m < 4; ++m)
#pragma unroll
    for (int n = 0; n < 4; ++n) acc[m][n] = (f32x4){0.f, 0.f, 0.f, 0.f};
}
template <class ARow, class BPtr, class Epi>
__device__ __forceinline__ void gemm128(char* smem, const int K, ARow arow, BPtr bptr, const int ldb, Epi epi) {
  const int tid = threadIdx.x, lane = tid & 63, wid = tid >> 6;
  const int arow0 = tid >> 3;
  const bf16_t* ap0 = arow(arow0);
  const bf16_t* ap1 = arow(arow0 + 32);
  const bf16_t* ap2 = arow(arow0 + 64);
  const bf16_t* ap3 = arow(arow0 + 96);
  f32x4 acc[4][4];
  acc_zero(acc);
  gemm128_acc<0, false>(acc, smem, K >> 6,
      [=](int u, int, int kc) { const bf16_t* q = (u == 0) ? ap0 : (u == 1) ? ap1 : (u == 2) ? ap2 : ap3; return *(const uint4*)(q + kc * 8); },
      bptr, ldb, 0);
  epi(acc, wid >> 1, wid & 1, lane & 15, lane >> 4);
}


template <class ALoad, class BLoad>
__device__ __forceinline__ void gemm128_acc_bb(f32x4 (&acc)[4][4], char* smem, const int nk, ALoad aload, BLoad bload) {
  const int tid = threadIdx.x, lane = tid & 63, wid = tid >> 6;
  const int wr = wid >> 1, wc = wid & 1, fr = lane & 15, fq = lane >> 4;
  const int achunk = tid & 7, arow0 = tid >> 3;
  const int oa0 = lds_off(arow0, achunk), oa1 = lds_off(arow0 + 32, achunk), oa2 = lds_off(arow0 + 64, achunk), oa3 = lds_off(arow0 + 96, achunk);
  uint4 ra0, ra1, ra2, ra3, rb0, rb1, rb2, rb3;
#define G128_LOADBB(kt) { \
    ra0 = aload(0, arow0, (kt) * 8 + achunk); ra1 = aload(1, arow0 + 32, (kt) * 8 + achunk); \
    ra2 = aload(2, arow0 + 64, (kt) * 8 + achunk); ra3 = aload(3, arow0 + 96, (kt) * 8 + achunk); \
    rb0 = bload(0, arow0, (kt) * 8 + achunk); rb1 = bload(1, arow0 + 32, (kt) * 8 + achunk); \
    rb2 = bload(2, arow0 + 64, (kt) * 8 + achunk); rb3 = bload(3, arow0 + 96, (kt) * 8 + achunk); }
#define G128_STOREBB(bufoff) { \
    char* const sb_ = smem + (bufoff); \
    *(uint4*)(sb_ + oa0) = ra0; *(uint4*)(sb_ + oa1) = ra1; *(uint4*)(sb_ + oa2) = ra2; *(uint4*)(sb_ + oa3) = ra3; \
    *(uint4*)(sb_ + 16384 + oa0) = rb0; *(uint4*)(sb_ + 16384 + oa1) = rb1; *(uint4*)(sb_ + 16384 + oa2) = rb2; *(uint4*)(sb_ + 16384 + oa3) = rb3; }
  G128_LOADBB(0)
  G128_STOREBB(0)
  if (nk > 1) G128_LOADBB(1)
  __syncthreads();
  for (int kt = 0; kt < nk; ++kt) {
    const int cur = (kt & 1) * 32768;
    __builtin_amdgcn_sched_barrier(0);
    G128_MMA(cur)
    __builtin_amdgcn_sched_barrier(0);
    if (kt + 1 < nk) {
      G128_STOREBB(cur ^ 32768)
      __builtin_amdgcn_sched_barrier(0);
      if (kt + 2 < nk) G128_LOADBB(kt + 2)
    }
    __builtin_amdgcn_sched_barrier(0);
    __syncthreads();
  }
#undef G128_LOADBB
#undef G128_STOREBB
}
template <class ARow, class BRow, class Epi>
__device__ __forceinline__ void gemm128_bb(char* smem, const int K, ARow arow, BRow brow, Epi epi) {
  const int tid = threadIdx.x, lane = tid & 63, wid = tid >> 6;
  const int arow0 = tid >> 3;
  const bf16_t* ap0 = arow(arow0); const bf16_t* ap1 = arow(arow0 + 32); const bf16_t* ap2 = arow(arow0 + 64); const bf16_t* ap3 = arow(arow0 + 96);
  const bf16_t* bp0 = brow(arow0); const bf16_t* bp1 = brow(arow0 + 32); const bf16_t* bp2 = brow(arow0 + 64); const bf16_t* bp3 = brow(arow0 + 96);
  f32x4 acc[4][4];
  acc_zero(acc);
  gemm128_acc_bb(acc, smem, K >> 6,
      [=](int u, int, int kc) { const bf16_t* q = (u == 0) ? ap0 : (u == 1) ? ap1 : (u == 2) ? ap2 : ap3; return *(const uint4*)(q + kc * 8); },
      [=](int u, int, int kc) { const bf16_t* q = (u == 0) ? bp0 : (u == 1) ? bp1 : (u == 2) ? bp2 : bp3; return *(const uint4*)(q + kc * 8); });
  epi(acc, wid >> 1, wid & 1, lane & 15, lane >> 4);
}


#define GAS1 __attribute__((address_space(1)))
#define LAS3 __attribute__((address_space(3)))
__device__ __forceinline__ void glds16(const void* g, char* l) {
  __builtin_amdgcn_global_load_lds((const GAS1 void*)g, (LAS3 void*)l, 16, 0, 0);
}
template <class ARow, class BRow, class Epi>
__device__ __forceinline__ void gemm128_glds(char* smem, const int K, ARow arow, BRow brow, Epi epi) {
  const int tid = threadIdx.x, lane = tid & 63, wid = tid >> 6;
  const int wr = wid >> 1, wc = wid & 1, fr = lane & 15, fq = lane >> 4;
  const int r0 = tid >> 3;
  const int cl = (tid & 7) ^ ((tid >> 4) & 7);
  const bf16_t* ga0 = arow(r0) + cl * 8; const bf16_t* ga1 = arow(r0 + 32) + cl * 8; const bf16_t* ga2 = arow(r0 + 64) + cl * 8; const bf16_t* ga3 = arow(r0 + 96) + cl * 8;
  const bf16_t* gb0 = brow(r0) + cl * 8; const bf16_t* gb1 = brow(r0 + 32) + cl * 8; const bf16_t* gb2 = brow(r0 + 64) + cl * 8; const bf16_t* gb3 = brow(r0 + 96) + cl * 8;
  char* const lbase = smem + tid * 16;
#define GL_STAGE(bufoff, kt) { \
    char* const d_ = lbase + (bufoff); const int ko_ = (kt) * 64; \
    glds16(ga0 + ko_, d_); glds16(ga1 + ko_, d_ + 4096); glds16(ga2 + ko_, d_ + 8192); glds16(ga3 + ko_, d_ + 12288); \
    glds16(gb0 + ko_, d_ + 16384); glds16(gb1 + ko_, d_ + 20480); glds16(gb2 + ko_, d_ + 24576); glds16(gb3 + ko_, d_ + 28672); }
  f32x4 acc[4][4];
  acc_zero(acc);
  const int nk = K >> 6;
  GL_STAGE(0, 0)
  asm volatile("s_waitcnt vmcnt(0)" ::: "memory");
  __syncthreads();
  for (int kt = 0; kt < nk; ++kt) {
    const int cur = (kt & 1) * 32768;
    if (kt + 1 < nk) GL_STAGE(cur ^ 32768, kt + 1)
    G128_MMA(cur)
    asm volatile("s_waitcnt vmcnt(0)" ::: "memory");
    __syncthreads();
  }
#undef GL_STAGE
  epi(acc, wr, wc, fr, fq);
}


template <int NCALL, int NK, class ARow, class BRow, class Epi>
__device__ __forceinline__ void gemm128_glds_multi(char* smem, ARow arow, BRow brow, const size_t bstride, Epi epi) {
  const int tid = threadIdx.x, lane = tid & 63, wid = tid >> 6;
  const int wr = wid >> 1, wc = wid & 1, fr = lane & 15, fq = lane >> 4;
  const int r0 = tid >> 3;
  const int cl = (tid & 7) ^ ((tid >> 4) & 7);
  const bf16_t* ga0 = arow(r0) + cl * 8; const bf16_t* ga1 = arow(r0 + 32) + cl * 8; const bf16_t* ga2 = arow(r0 + 64) + cl * 8; const bf16_t* ga3 = arow(r0 + 96) + cl * 8;
  const bf16_t* gb0 = brow(r0) + cl * 8; const bf16_t* gb1 = brow(r0 + 32) + cl * 8; const bf16_t* gb2 = brow(r0 + 64) + cl * 8; const bf16_t* gb3 = brow(r0 + 96) + cl * 8;
  char* const lbase = smem + tid * 16;
#define GM_STAGE(bufoff, g) { \
    char* const d_ = lbase + (bufoff); const int ko_ = ((g) % NK) * 64; const size_t bo_ = (size_t)((g) / NK) * bstride + ko_; \
    glds16(ga0 + ko_, d_); glds16(ga1 + ko_, d_ + 4096); glds16(ga2 + ko_, d_ + 8192); glds16(ga3 + ko_, d_ + 12288); \
    glds16(gb0 + bo_, d_ + 16384); glds16(gb1 + bo_, d_ + 20480); glds16(gb2 + bo_, d_ + 24576); glds16(gb3 + bo_, d_ + 28672); }
  f32x4 acc[4][4];
  acc_zero(acc);
  constexpr int G = NCALL * NK;
  GM_STAGE(0, 0)
  asm volatile("s_waitcnt vmcnt(0)" ::: "memory");
  __syncthreads();
#pragma unroll 1
  for (int g = 0; g < G; ++g) {
    const int cur = (g & 1) * 32768;
    if (g + 1 < G) GM_STAGE(cur ^ 32768, g + 1)
    G128_MMA(cur)
    if ((g % NK) == NK - 1) {
      epi(g / NK, acc, wr, wc, fr, fq);
      acc_zero(acc);
    }
    asm volatile("s_waitcnt vmcnt(0)" ::: "memory");
    __syncthreads();
  }
#undef GM_STAGE
}

#define DPP_F(v, ctrl) __builtin_bit_cast(float, __builtin_amdgcn_update_dpp(0, __builtin_bit_cast(int, (v)), (ctrl), 0xF, 0xF, true))
__device__ __forceinline__ float rdlane_f(float v, int l) { return __builtin_bit_cast(float, __builtin_amdgcn_readlane(__builtin_bit_cast(int, v), l)); }
__device__ __forceinline__ float dpp_sum16x(float v) {
  v += DPP_F(v, 0xB1); v += DPP_F(v, 0x4E); v += DPP_F(v, 0x141); v += DPP_F(v, 0x140);
  return v;
}
__device__ __forceinline__ float dpp_max16x(float v) {
  v = fmaxf(v, DPP_F(v, 0xB1)); v = fmaxf(v, DPP_F(v, 0x4E)); v = fmaxf(v, DPP_F(v, 0x141)); v = fmaxf(v, DPP_F(v, 0x140));
  return v;
}
__device__ __forceinline__ float wave_sum_fast(float v) {
  v = dpp_sum16x(v);
  return (rdlane_f(v, 0) + rdlane_f(v, 16)) + (rdlane_f(v, 32) + rdlane_f(v, 48));
}
__device__ __forceinline__ float wave_max_fast(float v) {
  v = dpp_max16x(v);
  return fmaxf(fmaxf(rdlane_f(v, 0), rdlane_f(v, 16)), fmaxf(rdlane_f(v, 32), rdlane_f(v, 48)));
}
__device__ __forceinline__ float fast_tanh(float x) { const float e = __expf(2.f * x); return 1.f - 2.f / (e + 1.f); }


__device__ __forceinline__ float4 bf4_to_f4(uint2 u) {
  float4 r;
  r.x = __uint_as_float(u.x << 16); r.y = __uint_as_float(u.x & 0xffff0000u);
  r.z = __uint_as_float(u.y << 16); r.w = __uint_as_float(u.y & 0xffff0000u);
  return r;
}
__device__ __forceinline__ uint2 pack4(float a, float b, float c, float d) { uint2 r; r.x = cvtpk(a, b); r.y = cvtpk(c, d); return r; }
#define XCD_GROUP (blockIdx.x & 7)
#define XCD_LB (blockIdx.x >> 3)
#define XCD_NB ((gridDim.x + 7 - (blockIdx.x & 7)) >> 3)

__device__ __forceinline__ void phase_inproj(const Params& p, char* smem) {
  const bf16_t* __restrict__ XB = (const bf16_t*)(p.ws + OFF_XB);
  const bf16_t* __restrict__ WINT = (const bf16_t*)(p.ws + OFF_WINT);
  const float* __restrict__ rope = (const float*)(p.ws + OFF_ROPE);
  bf16_t* Q = (bf16_t*)(p.ws + OFF_Q); bf16_t* K = (bf16_t*)(p.ws + OFF_K); bf16_t* V = (bf16_t*)(p.ws + OFF_V);
  bf16_t* FE = (bf16_t*)(p.ws + OFF_FEATS);
  const int NT = 27, NITEM = (T_TOK / 128) * NT, CHUNK = NITEM / 8;
  for (int i = XCD_LB; i < CHUNK; i += XCD_NB) {
    const int item = XCD_GROUP * CHUNK + i;
    const int row0 = (item & 255) * 128, col0 = (item >> 8) * 128;
    gemm128_glds(smem, DM,
            [=](int r) { return XB + (size_t)(row0 + r) * DM; },
            [=](int r) { return WINT + (size_t)(col0 + r) * DM; },
            [=](f32x4 (&acc)[4][4], int wr, int wc, int fr, int fq) {
              const int cb = col0 + wc * 64;
              if (cb >= INW) return;
#pragma unroll
              for (int m = 0; m < 4; ++m) {
                const int t = row0 + wr * 64 + m * 16 + fr;
                if (cb < 1024) {
                  const int pos = t & (SEQ - 1);
                  bf16_t* dst = (cb < 512) ? (Q + (size_t)t * 512 + cb) : (K + (size_t)t * 512 + (cb - 512));
                  const float sc = (cb < 512) ? 0.125f : 1.f;
#pragma unroll
                  for (int n = 0; n < 2; ++n) {
                    const int f0 = n * 16 + fq * 4;
                    const float4 c01 = *(const float4*)(rope + (size_t)(pos * 32 + f0) * 2);
                    const float4 c23 = *(const float4*)(rope + (size_t)(pos * 32 + f0) * 2 + 4);
                    const float cs[4] = {c01.x, c01.z, c23.x, c23.z}, sn[4] = {c01.y, c01.w, c23.y, c23.w};
                    float o1[4], o2[4];
#pragma unroll
                    for (int j = 0; j < 4; ++j) {
                      const float z1 = acc[m][n][j], z2 = acc[m][n + 2][j];
                      o1[j] = (z1 * cs[j] - z2 * sn[j]) * sc; o2[j] = (z2 * cs[j] + z1 * sn[j]) * sc;
                    }
                    *(uint2*)(dst + f0) = pack4(o1[0], o1[1], o1[2], o1[3]);
                    *(uint2*)(dst + 32 + f0) = pack4(o2[0], o2[1], o2[2], o2[3]);
                  }
                } else if (cb < 1536) {
#pragma unroll
                  for (int n = 0; n < 4; ++n)
                    *(uint2*)(V + (size_t)t * 512 + (cb - 1024) + n * 16 + fq * 4) = pack4(acc[m][n][0], acc[m][n][1], acc[m][n][2], acc[m][n][3]);
                } else {
#pragma unroll
                  for (int n = 0; n < 4; ++n) {
                    const int c = cb + n * 16 + fq * 4;
                    if (c < INW) *(uint2*)(FE + (size_t)t * FEW + (c - 1536)) = pack4(acc[m][n][0], acc[m][n][1], acc[m][n][2], acc[m][n][3]);
                  }
                }
              }
            });
  }
}

__device__ __forceinline__ void phase_prep_a(const Params& p) {
  const bf16_t* __restrict__ FE = (const bf16_t*)(p.ws + OFF_FEATS);
  const float* __restrict__ mu = p.in[2];
  bf16_t* R = (bf16_t*)(p.ws + OFF_R); bf16_t* K2 = (bf16_t*)(p.ws + OFF_K2); bf16_t* V2 = (bf16_t*)(p.ws + OFF_V2);
  bf16_t* ACT = (bf16_t*)(p.ws + OFF_ACT);
  for (size_t i = (size_t)blockIdx.x * NTHR + threadIdx.x; i < (size_t)T_TOK * 232; i += (size_t)gridDim.x * NTHR) {
    const int t = (int)(i / 232), ch = (int)(i - (size_t)t * 232);
    if (ch >= 228) { *(uint4*)(ACT + (size_t)t * 320 + 288 + (ch - 228) * 8) = make_uint4(0u, 0u, 0u, 0u); continue; }
    const int col = ch * 8;
    const uint4 cu = *(const uint4*)(FE + (size_t)t * FEW + col);
    uint4 pv = make_uint4(0u, 0u, 0u, 0u);
    if ((t & (SEQ - 1)) != 0) pv = *(const uint4*)(FE + (size_t)(t - 1) * FEW + col);
    const float4 m0 = *(const float4*)(mu + col), m1 = *(const float4*)(mu + col + 4);
    const unsigned cw[4] = {cu.x, cu.y, cu.z, cu.w}, pw[4] = {pv.x, pv.y, pv.z, pv.w};
    const float mm[8] = {m0.x, m0.y, m0.z, m0.w, m1.x, m1.y, m1.z, m1.w};
    float f[8];
#pragma unroll
    for (int q = 0; q < 4; ++q) {
      const float c0 = __uint_as_float(cw[q] << 16), c1 = __uint_as_float(cw[q] & 0xffff0000u);
      const float p0 = __uint_as_float(pw[q] << 16), p1 = __uint_as_float(pw[q] & 0xffff0000u);
      f[2 * q] = c0 + (p0 - c0) * mm[2 * q];
      f[2 * q + 1] = c1 + (p1 - c1) * mm[2 * q + 1];
    }
    bf16_t* dst;
    if (col < 512) dst = R + (size_t)t * 512 + col;
    else if (col < 1024) dst = K2 + (size_t)t * 512 + (col - 512);
    else if (col < 1536) dst = V2 + (size_t)t * 512 + (col - 1024);
    else {
      dst = ACT + (size_t)t * 320 + (col - 1536);
      if (col < 1600) {
#pragma unroll
        for (int q = 0; q < 8; ++q) f[q] = fast_tanh(f[q]);
      } else if (col >= 1664) {
#pragma unroll
        for (int q = 0; q < 8; ++q) f[q] = sigmoidf_(f[q]);
      }
    }
    uint4 w; w.x = cvtpk(f[0], f[1]); w.y = cvtpk(f[2], f[3]); w.z = cvtpk(f[4], f[5]); w.w = cvtpk(f[6], f[7]);
    *(uint4*)dst = w;
  }
}

template <int PASS>
__device__ __forceinline__ void prep_item(const Params& p, char* smem, const int row0, const int col0) {
  const bf16_t* __restrict__ ACT = (const bf16_t*)(p.ws + OFF_ACT);
  constexpr int ACOL = PASS * 64;
  constexpr int NK = (PASS == 2) ? 3 : 1;
  const float* __restrict__ Wm = (PASS == 0) ? p.in[4] : (PASS == 1) ? p.in[6] : p.in[7];
  f32x4 acc[4][4];
  acc_zero(acc);
  gemm128_acc<0, (PASS == 2)>(acc, smem, NK,
      [=](int, int rowl, int kc) { return *(const uint4*)(ACT + (size_t)(row0 + rowl) * 320 + ACOL + kc * 8); },
      [=](int nq) { return Wm + col0 + nq * 4; }, 512, 160);
  const int tid = threadIdx.x, lane = tid & 63, wid = tid >> 6;
  const int wr = wid >> 1, wc = wid & 1, fr = lane & 15, fq = lane >> 4;
  const int cb = col0 + wc * 64;
  if (PASS == 0) {
    const float* __restrict__ w0 = p.in[3];
    float* W = (float*)(p.ws + OFF_W);
#pragma unroll
    for (int n = 0; n < 4; ++n) {
      const int c = cb + n * 16 + fq * 4;
      const float4 w04 = *(const float4*)(w0 + c);
      const float w0c[4] = {w04.x, w04.y, w04.z, w04.w};
#pragma unroll
      for (int m = 0; m < 4; ++m) {
        const int t = row0 + wr * 64 + m * 16 + fr;
        float d[4];
#pragma unroll
        for (int j = 0; j < 4; ++j) {
          const float nz = -(w0c[j] + acc[m][n][j]);
          const float sp = fmaxf(nz, 0.f) + __logf(1.f + __expf(-fabsf(nz)));
          d[j] = __expf(-__expf(-sp - 0.5f));
        }
        *(float4*)(W + (size_t)t * 512 + c) = make_float4(d[0], d[1], d[2], d[3]);
      }
    }
  } else if (PASS == 2) {
    bf16_t* G = (bf16_t*)(p.ws + OFF_G);
#pragma unroll
    for (int m = 0; m < 4; ++m) {
      const int t = row0 + wr * 64 + m * 16 + fr;
#pragma unroll
      for (int n = 0; n < 4; ++n)
        *(uint2*)(G + (size_t)t * 512 + cb + n * 16 + fq * 4) = pack4(acc[m][n][0], acc[m][n][1], acc[m][n][2], acc[m][n][3]);
    }
  } else {
    const float* __restrict__ a0 = p.in[5]; const float* __restrict__ k_k = p.in[8]; const float* __restrict__ k_a = p.in[9];
    const float* __restrict__ r_k = p.in[10];
    const bf16_t* __restrict__ R = (const bf16_t*)(p.ws + OFF_R); bf16_t* K2 = (bf16_t*)(p.ws + OFF_K2);
    bf16_t* A = (bf16_t*)(p.ws + OFF_A); bf16_t* B = (bf16_t*)(p.ws + OFF_B); float* SB = (float*)(p.ws + OFF_SB);
#pragma unroll
    for (int m = 0; m < 4; ++m) {
      __builtin_amdgcn_sched_barrier(0);
      const int t = row0 + wr * 64 + m * 16 + fr;
      float kk[4][4];
      float ssp = 0.f, sbp = 0.f;
#pragma unroll
      for (int n = 0; n < 4; ++n) {
        const int c = cb + n * 16 + fq * 4;
        const size_t o = (size_t)t * 512 + c;
        const float4 rr4 = bf4_to_f4(*(const uint2*)(R + o)), kx4 = bf4_to_f4(*(const uint2*)(K2 + o));
        const float rr[4] = {rr4.x, rr4.y, rr4.z, rr4.w}, kx[4] = {kx4.x, kx4.y, kx4.z, kx4.w};
        const float4 a04 = *(const float4*)(a0 + c), kk4 = *(const float4*)(k_k + c), ka4 = *(const float4*)(k_a + c), rk4 = *(const float4*)(r_k + c);
        const float a0c[4] = {a04.x, a04.y, a04.z, a04.w}, kkc[4] = {kk4.x, kk4.y, kk4.z, kk4.w}, kac[4] = {ka4.x, ka4.y, ka4.z, ka4.w};
        const float rkc[4] = {rk4.x, rk4.y, rk4.z, rk4.w};
        float k2[4];
#pragma unroll
        for (int j = 0; j < 4; ++j) {
          const float av = sigmoidf_(a0c[j] + acc[m][n][j]);
          acc[m][n][j] = av;
          kk[n][j] = kx[j] * kkc[j];
          k2[j] = kx[j] * (1.f + (av - 1.f) * kac[j]);
          ssp += kk[n][j] * kk[n][j];
          sbp += rr[j] * k2[j] * rkc[j];
        }
        *(uint2*)(K2 + o) = pack4(k2[0], k2[1], k2[2], k2[3]);
      }
      ssp += __shfl_xor(ssp, 16, 64); ssp += __shfl_xor(ssp, 32, 64);
      sbp += __shfl_xor(sbp, 16, 64); sbp += __shfl_xor(sbp, 32, 64);
      const float inv = 1.f / fmaxf(sqrtf(ssp), 1e-12f);
#pragma unroll
      for (int n = 0; n < 4; ++n) {
        const size_t o = (size_t)t * 512 + cb + n * 16 + fq * 4;
        *(uint2*)(A + o) = pack4(-kk[n][0] * inv, -kk[n][1] * inv, -kk[n][2] * inv, -kk[n][3] * inv);
        *(uint2*)(B + o) = pack4(kk[n][0] * inv * acc[m][n][0], kk[n][1] * inv * acc[m][n][1], kk[n][2] * inv * acc[m][n][2], kk[n][3] * inv * acc[m][n][3]);
      }
      if (fq == 0) SB[(size_t)t * 8 + (cb >> 6)] = sbp;
    }
  }
}
__device__ __forceinline__ void phase_prep(const Params& p, char* smem) {
  for (int item = blockIdx.x; item < (T_TOK / 128) * 12; item += gridDim.x) {
    const int mt = item / 12, sub = item - mt * 12, pass = sub >> 2, nt = sub & 3;
    if (pass == 0) prep_item<0>(p, smem, mt * 128, nt * 128);
    else if (pass == 1) prep_item<1>(p, smem, mt * 128, nt * 128);
    else prep_item<2>(p, smem, mt * 128, nt * 128);
  }
}

__device__ __forceinline__ float dpp_sum16(float v) {
  v += __builtin_bit_cast(float, __builtin_amdgcn_update_dpp(0, __builtin_bit_cast(int, v), 0xB1, 0xF, 0xF, true));
  v += __builtin_bit_cast(float, __builtin_amdgcn_update_dpp(0, __builtin_bit_cast(int, v), 0x4E, 0xF, 0xF, true));
  v += __builtin_bit_cast(float, __builtin_amdgcn_update_dpp(0, __builtin_bit_cast(int, v), 0x141, 0xF, 0xF, true));
  v += __builtin_bit_cast(float, __builtin_amdgcn_update_dpp(0, __builtin_bit_cast(int, v), 0x140, 0xF, 0xF, true));
  return v;
}
#define SC_CH 16
#define SC_ARR (SC_CH * 64 * 4)
#define SC_BUF (5 * SC_ARR + SC_CH * 16 * 4)
__device__ __forceinline__ void phase_scan(const Params& p, char* smem) {
  if (blockIdx.x >= 256) return;
  const bf16_t* __restrict__ R = (const bf16_t*)(p.ws + OFF_R); const bf16_t* __restrict__ K2 = (const bf16_t*)(p.ws + OFF_K2);
  const bf16_t* __restrict__ V2 = (const bf16_t*)(p.ws + OFF_V2); const bf16_t* __restrict__ A = (const bf16_t*)(p.ws + OFF_A);
  const bf16_t* __restrict__ B = (const bf16_t*)(p.ws + OFF_B); const float* __restrict__ W = (const float*)(p.ws + OFF_W);
  float* YS = (float*)(p.ws + OFF_YS);
  const int bh = blockIdx.x >> 2, rg = blockIdx.x & 3, b = bh >> 3, h = bh & 7;
  const int tid = threadIdx.x, lane = tid & 63, wid = tid >> 6, j = lane & 15, rq = lane >> 4;
  const int rowl = wid * 4 + rq;
  const int ls = tid >> 4, lc = tid & 15;
  const int vs = (tid >> 2) & 15, vq = tid & 3;
  const size_t tb = (size_t)b * SEQ;
  const size_t goff = (tb + ls) * 512 + h * 64 + lc * 4;
  const size_t voff = (tb + vs) * 512 + h * 64 + rg * 16 + vq * 4;
  uint2 ga, gb, gk, gr, gv; float4 gw;
  gv = make_uint2(0u, 0u);
  ga = *(const uint2*)(A + goff); gb = *(const uint2*)(B + goff); gk = *(const uint2*)(K2 + goff); gr = *(const uint2*)(R + goff);
  gw = *(const float4*)(W + goff);
  if (tid < 64) gv = *(const uint2*)(V2 + voff);
  {
    char* bf = smem;
    *(float4*)(bf + 0 * SC_ARR + ls * 256 + lc * 16) = bf4_to_f4(ga);
    *(float4*)(bf + 1 * SC_ARR + ls * 256 + lc * 16) = gw;
    *(float4*)(bf + 2 * SC_ARR + ls * 256 + lc * 16) = bf4_to_f4(gb);
    *(float4*)(bf + 3 * SC_ARR + ls * 256 + lc * 16) = bf4_to_f4(gk);
    *(float4*)(bf + 4 * SC_ARR + ls * 256 + lc * 16) = bf4_to_f4(gr);
    if (tid < 64) *(float4*)(bf + 5 * SC_ARR + vs * 64 + vq * 16) = bf4_to_f4(gv);
  }
  __syncthreads();
  float s0 = 0.f, s1 = 0.f, s2 = 0.f, s3 = 0.f;
  const int NCH = SEQ / SC_CH;
  for (int c = 0; c < NCH; ++c) {
    if (c + 1 < NCH) {
      const size_t o2 = goff + (size_t)(c + 1) * SC_CH * 512;
      ga = *(const uint2*)(A + o2); gb = *(const uint2*)(B + o2); gk = *(const uint2*)(K2 + o2); gr = *(const uint2*)(R + o2);
      gw = *(const float4*)(W + o2);
      if (tid < 64) gv = *(const uint2*)(V2 + voff + (size_t)(c + 1) * SC_CH * 512);
    }
    const char* bf = smem + (c & 1) * SC_BUF;
    float ykeep = 0.f;
#pragma unroll
    for (int s = 0; s < SC_CH; ++s) {
      const float4 a4 = *(const float4*)(bf + 0 * SC_ARR + s * 256 + j * 16);
      const float4 w4 = *(const float4*)(bf + 1 * SC_ARR + s * 256 + j * 16);
      const float4 b4 = *(const float4*)(bf + 2 * SC_ARR + s * 256 + j * 16);
      const float4 k4 = *(const float4*)(bf + 3 * SC_ARR + s * 256 + j * 16);
      const float4 r4 = *(const float4*)(bf + 4 * SC_ARR + s * 256 + j * 16);
      const float vv = *(const float*)(bf + 5 * SC_ARR + s * 64 + rowl * 4);
      float sa = (s0 * a4.x + s1 * a4.y) + (s2 * a4.z + s3 * a4.w);
      sa = dpp_sum16(sa);
      s0 = s0 * w4.x + (sa * b4.x + vv * k4.x);
      s1 = s1 * w4.y + (sa * b4.y + vv * k4.y);
      s2 = s2 * w4.z + (sa * b4.z + vv * k4.z);
      s3 = s3 * w4.w + (sa * b4.w + vv * k4.w);
      float y = (s0 * r4.x + s1 * r4.y) + (s2 * r4.z + s3 * r4.w);
      y = dpp_sum16(y);
      ykeep = (j == s) ? y : ykeep;
    }
    YS[(tb + (size_t)c * SC_CH + j) * 512 + h * 64 + rg * 16 + rowl] = ykeep;
    if (c + 1 < NCH) {
      char* bn = smem + ((c + 1) & 1) * SC_BUF;
      *(float4*)(bn + 0 * SC_ARR + ls * 256 + lc * 16) = bf4_to_f4(ga);
      *(float4*)(bn + 1 * SC_ARR + ls * 256 + lc * 16) = gw;
      *(float4*)(bn + 2 * SC_ARR + ls * 256 + lc * 16) = bf4_to_f4(gb);
      *(float4*)(bn + 3 * SC_ARR + ls * 256 + lc * 16) = bf4_to_f4(gk);
      *(float4*)(bn + 4 * SC_ARR + ls * 256 + lc * 16) = bf4_to_f4(gr);
      if (tid < 64) *(float4*)(bn + 5 * SC_ARR + vs * 64 + vq * 16) = bf4_to_f4(gv);
    }
    __syncthreads();
  }
}


#define CONV_TILES (257 * 96)
struct ConvDesc { const float* src; bf16_t* dst; int ldn, k0, n0, kdim, part; };
__device__ __forceinline__ ConvDesc conv_desc(const Params& p, const int ti) {
  ConvDesc d;
  const int e = ti / 96, q = ti - e * 96, part = q >> 5, w = q & 31;
  d.part = part;
  if (part < 2) {
    d.src = (e < NEXP) ? p.in[18 + part] + (size_t)e * DM * 256 : p.in[21 + part];
    d.ldn = 256; d.k0 = (w >> 1) * 64; d.n0 = (w & 1) * 128; d.kdim = 1024;
    d.dst = (bf16_t*)(p.ws + OFF_EW1) + (size_t)e * 512 * 1024;
  } else {
    d.src = (e < NEXP) ? p.in[20] + (size_t)e * 256 * DM : p.in[23];
    d.ldn = 1024; d.k0 = (w >> 3) * 64; d.n0 = (w & 7) * 128; d.kdim = 256;
    d.dst = (bf16_t*)(p.ws + OFF_EW2) + (size_t)e * 1024 * 256;
  }
  return d;
}
#define CV_LOAD(d, r) { \
    const float* bp_ = (d).src + (size_t)((d).k0 + ko * 8) * (d).ldn + (d).n0 + nq * 4; \
    r##0 = *(const float4*)(bp_); r##1 = *(const float4*)(bp_ + (size_t)1 * (d).ldn); r##2 = *(const float4*)(bp_ + (size_t)2 * (d).ldn); \
    r##3 = *(const float4*)(bp_ + (size_t)3 * (d).ldn); r##4 = *(const float4*)(bp_ + (size_t)4 * (d).ldn); r##5 = *(const float4*)(bp_ + (size_t)5 * (d).ldn); \
    r##6 = *(const float4*)(bp_ + (size_t)6 * (d).ldn); r##7 = *(const float4*)(bp_ + (size_t)7 * (d).ldn); }
#define CV_LDS(r, base) { \
    uint4 v; \
    v.x = cvtpk((r##0).x, (r##1).x); v.y = cvtpk((r##2).x, (r##3).x); v.z = cvtpk((r##4).x, (r##5).x); v.w = cvtpk((r##6).x, (r##7).x); *(uint4*)((base) + lds_off(nq * 4 + 0, ko)) = v; \
    v.x = cvtpk((r##0).y, (r##1).y); v.y = cvtpk((r##2).y, (r##3).y); v.z = cvtpk((r##4).y, (r##5).y); v.w = cvtpk((r##6).y, (r##7).y); *(uint4*)((base) + lds_off(nq * 4 + 1, ko)) = v; \
    v.x = cvtpk((r##0).z, (r##1).z); v.y = cvtpk((r##2).z, (r##3).z); v.z = cvtpk((r##4).z, (r##5).z); v.w = cvtpk((r##6).z, (r##7).z); *(uint4*)((base) + lds_off(nq * 4 + 2, ko)) = v; \
    v.x = cvtpk((r##0).w, (r##1).w); v.y = cvtpk((r##2).w, (r##3).w); v.z = cvtpk((r##4).w, (r##5).w); v.w = cvtpk((r##6).w, (r##7).w); *(uint4*)((base) + lds_off(nq * 4 + 3, ko)) = v; }
#define CV_OUT(d, base) { \
    _Pragma("unroll") for (int u = 0; u < 4; ++u) { \
      const int row = (tid >> 3) + 32 * u, chunk = tid & 7; \
      const int c = (d).n0 + row; \
      const int orow = ((d).part < 2) ? ((c >> 6) * 128 + ((c >> 5) & 1) * 64 + ((d).part * 2 + ((c >> 4) & 1)) * 16 + (c & 15)) : c; \
      *(uint4*)((d).dst + (size_t)orow * (d).kdim + (d).k0 + chunk * 8) = *(const uint4*)((base) + lds_off(row, chunk)); } }
__device__ __forceinline__ void convert_tile2(const Params& p, char* smem, const int t2) {
  const int tid = threadIdx.x, nq = tid & 31, ko = tid >> 5;
  const ConvDesc da = conv_desc(p, 2 * t2), db = conv_desc(p, 2 * t2 + 1);
  float4 ra0, ra1, ra2, ra3, ra4, ra5, ra6, ra7, rb0, rb1, rb2, rb3, rb4, rb5, rb6, rb7;
  CV_LOAD(da, ra)
  CV_LOAD(db, rb)
  CV_LDS(ra, smem)
  CV_LDS(rb, smem + 16384)
  __syncthreads();
  CV_OUT(da, smem)
  CV_OUT(db, smem + 16384)
  __syncthreads();
}
#undef CV_LOAD
#undef CV_LDS
#undef CV_OUT

__device__ __forceinline__ int vt_off(int d, int key) { const int swz = ((d >> 2) & 15) ^ ((d & 3) << 3); return d * 512 + (((key >> 2) ^ swz) << 3); }
__device__ __forceinline__ void attn_item(const Params& p, char* smem, const int item) {
  const bf16_t* __restrict__ Q = (const bf16_t*)(p.ws + OFF_Q); const bf16_t* __restrict__ K = (const bf16_t*)(p.ws + OFF_K);
  const bf16_t* __restrict__ V = (const bf16_t*)(p.ws + OFF_V);
  bf16_t* OP = (bf16_t*)(p.ws + OFF_OP); float* LSE = (float*)(p.ws + OFF_LSE);
  char* Ks = smem; char* VT = smem + 32768; float* linv_s = (float*)(smem + 65536);
  const int tid = threadIdx.x, lane = tid & 63, wid = tid >> 6, l31 = lane & 31, hi = lane >> 5;
  {
    const int pp = item >> 11, rem = item & 2047, bh = rem >> 5, sub = rem & 31;
    const int dsh = pp * 2, nbsh = 5 - dsh;
    const int r = sub >> nbsh, n = sub & ((1 << nbsh) - 1);
    const int b = bh >> 3, h = bh & 7, tb = b * SEQ;
    __syncthreads();
#pragma unroll
    for (int u = 0; u < 8; ++u) {
      const int row = (tid >> 3) + 32 * u, chunk = tid & 7;
      int ik = n * 128 - 128 + row; ik = ik < 0 ? 0 : ik;
      const int tok = tb + (ik << dsh) + r;
      *(uint4*)(Ks + lds_off(row, chunk)) = *(const uint4*)(K + (size_t)tok * 512 + h * 64 + chunk * 8);
    }
#pragma unroll
    for (int ps = 0; ps < 2; ++ps) {
      const int dq = tid & 15, kbase = ps * 128 + (tid >> 4) * 8;
      uint2 v0, v1, v2, v3, v4, v5, v6, v7;
#define LDV(i, dst) { int ik = n * 128 - 128 + kbase + i; ik = ik < 0 ? 0 : ik; const int tok = tb + (ik << dsh) + r; dst = *(const uint2*)(V + (size_t)tok * 512 + h * 64 + dq * 4); }
      LDV(0, v0) LDV(1, v1) LDV(2, v2) LDV(3, v3) LDV(4, v4) LDV(5, v5) LDV(6, v6) LDV(7, v7)
#undef LDV
      {
        uint2 w;
        w.x = (v0.x & 0xffffu) | (v1.x << 16); w.y = (v2.x & 0xffffu) | (v3.x << 16);
        *(uint2*)(VT + vt_off(dq * 4 + 0, kbase)) = w;
        w.x = (v4.x & 0xffffu) | (v5.x << 16); w.y = (v6.x & 0xffffu) | (v7.x << 16);
        *(uint2*)(VT + vt_off(dq * 4 + 0, kbase + 4)) = w;
        w.x = (v0.x >> 16) | (v1.x & 0xffff0000u); w.y = (v2.x >> 16) | (v3.x & 0xffff0000u);
        *(uint2*)(VT + vt_off(dq * 4 + 1, kbase)) = w;
        w.x = (v4.x >> 16) | (v5.x & 0xffff0000u); w.y = (v6.x >> 16) | (v7.x & 0xffff0000u);
        *(uint2*)(VT + vt_off(dq * 4 + 1, kbase + 4)) = w;
        w.x = (v0.y & 0xffffu) | (v1.y << 16); w.y = (v2.y & 0xffffu) | (v3.y << 16);
        *(uint2*)(VT + vt_off(dq * 4 + 2, kbase)) = w;
        w.x = (v4.y & 0xffffu) | (v5.y << 16); w.y = (v6.y & 0xffffu) | (v7.y << 16);
        *(uint2*)(VT + vt_off(dq * 4 + 2, kbase + 4)) = w;
        w.x = (v0.y >> 16) | (v1.y & 0xffff0000u); w.y = (v2.y >> 16) | (v3.y & 0xffff0000u);
        *(uint2*)(VT + vt_off(dq * 4 + 3, kbase)) = w;
        w.x = (v4.y >> 16) | (v5.y & 0xffff0000u); w.y = (v6.y >> 16) | (v7.y & 0xffff0000u);
        *(uint2*)(VT + vt_off(dq * 4 + 3, kbase + 4)) = w;
      }
    }
    __syncthreads();
    const int iq = n * 128 + wid * 32 + l31;
    const int tq = tb + (iq << dsh) + r;
    bf16x8 qf[4];
#pragma unroll
    for (int ks = 0; ks < 4; ++ks) qf[ks] = *(const bf16x8*)(Q + (size_t)tq * 512 + h * 64 + ks * 16 + hi * 8);
    f32x16 st[5];
#pragma unroll
    for (int kb = 0; kb < 5; ++kb) {
      st[kb] = (f32x16){0.f, 0.f, 0.f, 0.f, 0.f, 0.f, 0.f, 0.f, 0.f, 0.f, 0.f, 0.f, 0.f, 0.f, 0.f, 0.f};
#pragma unroll
      for (int ks = 0; ks < 4; ++ks) {
        const bf16x8 kf = *(const bf16x8*)(Ks + lds_off(32 * (wid + kb) + l31, 2 * ks + hi));
        st[kb] = __builtin_amdgcn_mfma_f32_32x32x16_bf16(kf, qf[ks], st[kb], 0, 0, 0);
      }
    }
    float m = -INFINITY;
#pragma unroll
    for (int kb = 0; kb < 5; ++kb)
#pragma unroll
      for (int i = 0; i < 16; ++i) {
        const int kirel = 32 * kb + (i & 3) + 8 * (i >> 2) + 4 * hi;
        const bool valid = (kirel >= l31) && (kirel <= l31 + 128) && (n > 0 || (32 * wid + kirel) >= 128);
        const float s = valid ? st[kb][i] : -INFINITY;
        st[kb][i] = s;
        m = fmaxf(m, s);
      }
    m = fmaxf(m, __shfl_xor(m, 32, 64));
    float l = 0.f;
#pragma unroll
    for (int kb = 0; kb < 5; ++kb)
#pragma unroll
      for (int i = 0; i < 16; ++i) { const float pe = __expf(st[kb][i] - m); st[kb][i] = pe; l += pe; }
    l += __shfl_xor(l, 32, 64);
    f32x16 o0 = (f32x16){0.f, 0.f, 0.f, 0.f, 0.f, 0.f, 0.f, 0.f, 0.f, 0.f, 0.f, 0.f, 0.f, 0.f, 0.f, 0.f};
    f32x16 o1 = o0;
#pragma unroll
    for (int kb = 0; kb < 5; ++kb)
#pragma unroll
      for (int s = 0; s < 2; ++s) {
        union { unsigned u[4]; bf16x8 v; } pa;
        pa.u[0] = cvtpk(st[kb][8 * s + 0], st[kb][8 * s + 1]); pa.u[1] = cvtpk(st[kb][8 * s + 2], st[kb][8 * s + 3]);
        pa.u[2] = cvtpk(st[kb][8 * s + 4], st[kb][8 * s + 5]); pa.u[3] = cvtpk(st[kb][8 * s + 6], st[kb][8 * s + 7]);
        const int key0 = 32 * (wid + kb) + 16 * s + 4 * hi;
        {
          union { uint2 u[2]; bf16x8 v; } vb;
          vb.u[0] = *(const uint2*)(VT + vt_off(l31, key0)); vb.u[1] = *(const uint2*)(VT + vt_off(l31, key0 + 8));
          o0 = __builtin_amdgcn_mfma_f32_32x32x16_bf16(pa.v, vb.v, o0, 0, 0, 0);
        }
        {
          union { uint2 u[2]; bf16x8 v; } vb;
          vb.u[0] = *(const uint2*)(VT + vt_off(32 + l31, key0)); vb.u[1] = *(const uint2*)(VT + vt_off(32 + l31, key0 + 8));
          o1 = __builtin_amdgcn_mfma_f32_32x32x16_bf16(pa.v, vb.v, o1, 0, 0, 0);
        }
      }
    if (hi == 0) {
      linv_s[wid * 32 + l31] = 1.f / l;
      LSE[((size_t)pp * T_TOK + tq) * 8 + h] = m + __logf(l);
    }
#pragma unroll
    for (int i = 0; i < 16; ++i) {
      const int qrel = (i & 3) + 8 * (i >> 2) + 4 * hi;
      const int iq2 = n * 128 + wid * 32 + qrel;
      const int tq2 = tb + (iq2 << dsh) + r;
      const float li = linv_s[wid * 32 + qrel];
      bf16_t* op = OP + ((size_t)pp * T_TOK + tq2) * 512 + h * 64 + l31;
      op[0] = f2bf(o0[i] * li);
      op[32] = f2bf(o1[i] * li);
    }
  }
}

__device__ __forceinline__ void phase_convert(const Params& p, char* smem) {
  int* ctl = (int*)(p.ws + OFF_CTL);
  int* slot = (int*)(smem + 66304);
  __syncthreads();
  int ti;
  for (;;) {
    if (threadIdx.x == 0) *slot = atomicAdd(&ctl[CTL_CONVQ], 1);
    __syncthreads();
    ti = *slot;
    __syncthreads();
    if (ti >= 6144) break;
    attn_item(p, smem, ti);
  }
  __builtin_amdgcn_sched_barrier(0);
  for (;;) {
    if (ti >= 6144 + CONV_TILES / 2) break;
    convert_tile2(p, smem, ti - 6144);
    if (threadIdx.x == 0) *slot = atomicAdd(&ctl[CTL_CONVQ], 1);
    __syncthreads();
    ti = *slot;
    __syncthreads();
  }
}

__device__ __forceinline__ void unpack8(const uint4 u, float (&f)[8]) {
  f[0] = __uint_as_float(u.x << 16); f[1] = __uint_as_float(u.x & 0xffff0000u); f[2] = __uint_as_float(u.y << 16); f[3] = __uint_as_float(u.y & 0xffff0000u);
  f[4] = __uint_as_float(u.z << 16); f[5] = __uint_as_float(u.z & 0xffff0000u); f[6] = __uint_as_float(u.w << 16); f[7] = __uint_as_float(u.w & 0xffff0000u);
}
__device__ __forceinline__ float dpp_sum8(float v) {
  v += DPP_F(v, 0xB1); v += DPP_F(v, 0x4E); v += DPP_F(v, 0x141);
  return v;
}
__device__ __forceinline__ void phase_post(const Params& p) {
  const float* __restrict__ YS = (const float*)(p.ws + OFF_YS); const bf16_t* __restrict__ V2 = (const bf16_t*)(p.ws + OFF_V2);
  const bf16_t* __restrict__ G = (const bf16_t*)(p.ws + OFF_G); const float* __restrict__ SB = (const float*)(p.ws + OFF_SB);
  const bf16_t* __restrict__ OP = (const bf16_t*)(p.ws + OFF_OP); const float* __restrict__ LSE = (const float*)(p.ws + OFF_LSE);
  const float* __restrict__ lnx_g = p.in[11]; const float* __restrict__ lnx_b = p.in[12];
  bf16_t* MIXED = (bf16_t*)(p.ws + OFF_MIXED);
  const int lane = threadIdx.x & 63, wid = threadIdx.x >> 6;
  const int c = lane * 8, hh = lane >> 3;
  const float4 g0 = *(const float4*)(lnx_g + c), g1 = *(const float4*)(lnx_g + c + 4), b0 = *(const float4*)(lnx_b + c), b1 = *(const float4*)(lnx_b + c + 4);
  const float gg[8] = {g0.x, g0.y, g0.z, g0.w, g1.x, g1.y, g1.z, g1.w}, bb[8] = {b0.x, b0.y, b0.z, b0.w, b1.x, b1.y, b1.z, b1.w};
  for (int t = blockIdx.x * 4 + wid; t < T_TOK; t += gridDim.x * 4) {
    const size_t o = (size_t)t * 512 + c;
    const float4 y0 = *(const float4*)(YS + o), y1 = *(const float4*)(YS + o + 4);
    const float y[8] = {y0.x, y0.y, y0.z, y0.w, y1.x, y1.y, y1.z, y1.w};
    float s = 0.f;
#pragma unroll
    for (int i = 0; i < 8; ++i) s += y[i];
    const float mean = dpp_sum8(s) * (1.f / 64.f);
    float q = 0.f;
#pragma unroll
    for (int i = 0; i < 8; ++i) { const float d = y[i] - mean; q += d * d; }
    const float rs = rsqrtf(dpp_sum8(q) * (1.f / 64.f) + GN_EPS_F);
    float v2[8], gt[8];
    unpack8(*(const uint4*)(V2 + o), v2); unpack8(*(const uint4*)(G + o), gt);
    const float sb = SB[(size_t)t * 8 + hh];
    float res[8];
#pragma unroll
    for (int i = 0; i < 8; ++i) res[i] = ((y[i] - mean) * rs * gg[i] + bb[i] + sb * v2[i]) * gt[i];
    uint4 w; w.x = cvtpk(res[0], res[1]); w.y = cvtpk(res[2], res[3]); w.z = cvtpk(res[4], res[5]); w.w = cvtpk(res[6], res[7]);
    *(uint4*)(MIXED + (size_t)t * 1024 + 512 + c) = w;
    const float l0 = LSE[((size_t)0 * T_TOK + t) * 8 + hh], l1 = LSE[((size_t)1 * T_TOK + t) * 8 + hh], l2 = LSE[((size_t)2 * T_TOK + t) * 8 + hh];
    const float mx = fmaxf(l0, fmaxf(l1, l2));
    float e0 = __expf(l0 - mx), e1 = __expf(l1 - mx), e2 = __expf(l2 - mx);
    const float inv = 1.f / (e0 + e1 + e2);
    e0 *= inv; e1 *= inv; e2 *= inv;
    float o0[8], o1[8], o2[8];
    unpack8(*(const uint4*)(OP + (size_t)0 * T_TOK * 512 + o), o0); unpack8(*(const uint4*)(OP + (size_t)1 * T_TOK * 512 + o), o1);
    unpack8(*(const uint4*)(OP + (size_t)2 * T_TOK * 512 + o), o2);
    float av[8];
#pragma unroll
    for (int i = 0; i < 8; ++i) av[i] = e0 * o0[i] + e1 * o1[i] + e2 * o2[i];
    w.x = cvtpk(av[0], av[1]); w.y = cvtpk(av[2], av[3]); w.z = cvtpk(av[4], av[5]); w.w = cvtpk(av[6], av[7]);
    *(uint4*)(MIXED + (size_t)t * 1024 + c) = w;
  }
}

__device__ __forceinline__ void phase_outproj(const Params& p, char* smem) {
  const bf16_t* __restrict__ MIXED = (const bf16_t*)(p.ws + OFF_MIXED);
  const bf16_t* __restrict__ WOUTT = (const bf16_t*)(p.ws + OFF_WOUTT); const float* __restrict__ x = p.in[0];
  float* U = p.out;
  for (int i = XCD_LB; i < T_TOK / 128; i += XCD_NB) {
    const int row0 = i * 128, col0 = XCD_GROUP * 128;
    gemm128_glds(smem, DM,
            [=](int r) { return MIXED + (size_t)(row0 + r) * DM; },
            [=](int r) { return WOUTT + (size_t)(col0 + r) * DM; },
            [=](f32x4 (&acc)[4][4], int wr, int wc, int fr, int fq) {
#pragma unroll
              for (int m = 0; m < 4; ++m) {
                const int t = row0 + wr * 64 + m * 16 + fr;
#pragma unroll
                for (int n = 0; n < 4; ++n) {
                  const size_t o = (size_t)t * DM + col0 + wc * 64 + n * 16 + fq * 4;
                  const float4 xv = *(const float4*)(x + o);
                  *(float4*)(U + o) = make_float4(ALPHA_F * xv.x + acc[m][n][0], ALPHA_F * xv.y + acc[m][n][1], ALPHA_F * xv.z + acc[m][n][2], ALPHA_F * xv.w + acc[m][n][3]);
                }
              }
            });
  }
}

__device__ __forceinline__ void phase_ln1(const Params& p) {
  float* X1 = p.out;
  const float* __restrict__ g1 = p.in[14]; const float* __restrict__ b1 = p.in[15];
  bf16_t* X1B = (bf16_t*)(p.ws + OFF_X1B);
  const int lane = threadIdx.x & 63, wid = threadIdx.x >> 6;
  for (int t = blockIdx.x * 4 + wid; t < T_TOK; t += gridDim.x * 4) {
    const size_t base = (size_t)t * DM;
    float4 v[4];
    float s = 0.f;
#pragma unroll
    for (int u = 0; u < 4; ++u) { v[u] = *(const float4*)(X1 + base + u * 256 + lane * 4); s += (v[u].x + v[u].y) + (v[u].z + v[u].w); }
    const float mean = wave_sum_fast(s) * (1.f / DM);
    float q = 0.f;
#pragma unroll
    for (int u = 0; u < 4; ++u) {
      const float d0 = v[u].x - mean, d1 = v[u].y - mean, d2 = v[u].z - mean, d3 = v[u].w - mean;
      q += (d0 * d0 + d1 * d1) + (d2 * d2 + d3 * d3);
    }
    const float rs = rsqrtf(wave_sum_fast(q) * (1.f / DM) + LN_EPS_F);
#pragma unroll
    for (int u = 0; u < 4; ++u) {
      const int c = u * 256 + lane * 4;
      const float4 g = *(const float4*)(g1 + c), bb = *(const float4*)(b1 + c);
      float4 y;
      y.x = (v[u].x - mean) * rs * g.x + bb.x; y.y = (v[u].y - mean) * rs * g.y + bb.y;
      y.z = (v[u].z - mean) * rs * g.z + bb.z; y.w = (v[u].w - mean) * rs * g.w + bb.w;
      *(float4*)(X1 + base + c) = y;
      uint2 hi; hi.x = cvtpk(y.x, y.y); hi.y = cvtpk(y.z, y.w);
      *(uint2*)(X1B + base + c) = hi;
    }
  }
}

__device__ __forceinline__ void phase_router_gemm(const Params& p, char* smem) {
  const bf16_t* __restrict__ X1B = (const bf16_t*)(p.ws + OFF_X1B);
  const float* __restrict__ router_w = p.in[16];
  float* AFF = (float*)(p.ws + OFF_AFF);
  for (int item = blockIdx.x; item < (T_TOK / 128) * 2; item += gridDim.x) {
    const int row0 = (item >> 1) * 128, col0 = (item & 1) * 128;
    f32x4 acc[4][4];
    acc_zero(acc);
    gemm128_acc<0, false>(acc, smem, 16,
        [=](int, int rowl, int kc) { return *(const uint4*)(X1B + (size_t)(row0 + rowl) * DM + kc * 8); },
        [=](int nq) { return router_w + col0 + nq * 4; }, NEXP, 0);
    const int tid = threadIdx.x, lane = tid & 63, wid = tid >> 6;
    const int wr = wid >> 1, wc = wid & 1, fr = lane & 15, fq = lane >> 4;
#pragma unroll
    for (int m = 0; m < 4; ++m) {
      const int t = row0 + wr * 64 + m * 16 + fr;
#pragma unroll
      for (int n = 0; n < 4; ++n)
        *(float4*)(AFF + (size_t)t * NEXP + col0 + wc * 64 + n * 16 + fq * 4) =
            make_float4(sigmoidf_(acc[m][n][0]), sigmoidf_(acc[m][n][1]), sigmoidf_(acc[m][n][2]), sigmoidf_(acc[m][n][3]));
    }
  }
}

__device__ __forceinline__ void phase_topk(const Params& p) {
  const float* __restrict__ AFF = (const float*)(p.ws + OFF_AFF);
  const float* __restrict__ router_bias = p.in[17];
  int* LIST = (int*)(p.ws + OFF_LIST); float* GATEW = (float*)(p.ws + OFF_GATEW);
  int* counts = (int*)(p.ws + OFF_CTL);
  const int lane = threadIdx.x & 63, wid = threadIdx.x >> 6;
  const float4 b4 = *(const float4*)(router_bias + lane * 4);
  for (int t = blockIdx.x * 4 + wid; t < T_TOK; t += gridDim.x * 4) {
    const float4 a4 = *(const float4*)(AFF + (size_t)t * NEXP + lane * 4);
    float s0 = a4.x + b4.x, s1 = a4.y + b4.y, s2 = a4.z + b4.z, s3 = a4.w + b4.w;
    const float hi01 = fmaxf(s0, s1), lo01 = fminf(s0, s1), hi23 = fmaxf(s2, s3), lo23 = fminf(s2, s3);
    float m1 = fmaxf(hi01, hi23), m2 = fmaxf(fminf(hi01, hi23), fmaxf(lo01, lo23));
    { const float o1 = DPP_F(m1, 0xB1), o2 = DPP_F(m2, 0xB1); const float n1 = fmaxf(m1, o1); m2 = fmaxf(fminf(m1, o1), fmaxf(m2, o2)); m1 = n1; }
    { const float o1 = DPP_F(m1, 0x4E), o2 = DPP_F(m2, 0x4E); const float n1 = fmaxf(m1, o1); m2 = fmaxf(fminf(m1, o1), fmaxf(m2, o2)); m1 = n1; }
    { const float o1 = DPP_F(m1, 0x141), o2 = DPP_F(m2, 0x141); const float n1 = fmaxf(m1, o1); m2 = fmaxf(fminf(m1, o1), fmaxf(m2, o2)); m1 = n1; }
    const float gs = m1 + m2;
    const int g = lane >> 3;
    int rank = 0;
#pragma unroll
    for (int gg = 0; gg < 8; ++gg) { const float G = rdlane_f(gs, gg * 8); rank += ((G > gs) || (G == gs && gg < g)) ? 1 : 0; }
    if (rank >= 4) { s0 = -INFINITY; s1 = -INFINITY; s2 = -INFINITY; s3 = -INFINITY; }
    int my_e = 0; float my_a = 0.f;
#pragma unroll 1
    for (int it = 0; it < 8; ++it) {
      const float lm = fmaxf(fmaxf(s0, s1), fmaxf(s2, s3));
      const float wm = wave_max_fast(lm);
      const unsigned long long bal = __ballot(lm == wm);
      const int win = __ffsll((long long)bal) - 1;
      const int wi = (s0 == wm) ? 0 : ((s1 == wm) ? 1 : ((s2 == wm) ? 2 : 3));
      const float wa = (wi == 0) ? a4.x : ((wi == 1) ? a4.y : ((wi == 2) ? a4.z : a4.w));
      const int e_w = __builtin_amdgcn_readlane(lane * 4 + wi, win);
      const float a_w = rdlane_f(wa, win);
      if (lane == win) { if (wi == 0) s0 = -INFINITY; else if (wi == 1) s1 = -INFINITY; else if (wi == 2) s2 = -INFINITY; else s3 = -INFINITY; }
      if (lane == it) { my_e = e_w; my_a = a_w; }
    }
    const float asum = rdlane_f(dpp_sum16x(my_a), 0);
    if (lane < 8) {
      const int pos = atomicAdd(&counts[my_e], 1);
      if (pos < LCAP) LIST[(size_t)my_e * LCAP + pos] = lane * T_TOK + t;
      GATEW[(size_t)lane * T_TOK + t] = my_a * 2.5f / asum;
    }
  }
}

__device__ __forceinline__ int moe_group_setup(const int* counts, int* pre) {
  __syncthreads();
  if (threadIdx.x == 0) {
    const int g = XCD_GROUP;
    int acc = 0;
    for (int j = 0; j < 32; ++j) { pre[j] = acc; acc += (min(counts[g + 8 * j], LCAP) + 127) >> 7; }
    pre[32] = acc; acc += 32;
    pre[33] = acc;
  }
  __syncthreads();
  return pre[33];
}
__device__ __forceinline__ void phase_moe(const Params& p, char* smem) {
  int* asg = (int*)(smem + 65536); int* pre = asg + 128;
  const bf16_t* __restrict__ X1B = (const bf16_t*)(p.ws + OFF_X1B);
  const bf16_t* __restrict__ EW1 = (const bf16_t*)(p.ws + OFF_EW1); const bf16_t* __restrict__ EW2 = (const bf16_t*)(p.ws + OFF_EW2);
  const int* __restrict__ LIST = (const int*)(p.ws + OFF_LIST);
  const float* __restrict__ GATEW = (const float*)(p.ws + OFF_GATEW);
  const int* counts = (const int*)(p.ws + OFF_CTL);
  bf16_t* Y = (bf16_t*)(p.ws + OFF_Y);
  bf16_t* HS = (bf16_t*)(p.ws + OFF_HSCR) + (size_t)blockIdx.x * 128 * 256;
  float* X1 = p.out;
  const int nitems = moe_group_setup(counts, pre);
  for (int i = XCD_LB; i < nitems; i += XCD_NB) {
    int j = 0;
#pragma unroll 1
    for (int q = 1; q <= 32; ++q) j = (pre[q] <= i) ? q : j;
    const int w = i - pre[j];
    const int e = (j < 32) ? (XCD_GROUP + 8 * j) : NEXP;
    const int cnt = (j < 32) ? min(counts[e], LCAP) : T_TOK;
    const int r0 = (j < 32) ? w * 128 : (XCD_GROUP * 32 + w) * 128;
    __syncthreads();
    if (threadIdx.x < 128) {
      const int r = r0 + threadIdx.x;
      asg[threadIdx.x] = (r < cnt) ? ((e < NEXP) ? LIST[(size_t)e * LCAP + r] : (8 * T_TOK + r)) : -1;
    }
    __syncthreads();
    const bf16_t* __restrict__ W1 = EW1 + (size_t)e * 512 * 1024;
    const bf16_t* __restrict__ W2 = EW2 + (size_t)e * 1024 * 256;
    gemm128_glds_multi<4, 16>(smem,
            [=](int r) { int a = asg[r]; return X1B + (size_t)((a >= 0 ? a : 0) & (T_TOK - 1)) * DM; },
            [=](int r) { return W1 + (size_t)r * DM; }, (size_t)128 * DM,
            [=](int nt, f32x4 (&acc)[4][4], int wr, int wc, int fr, int fq) {
#pragma unroll
              for (int m = 0; m < 4; ++m) {
                const int row = wr * 64 + m * 16 + fr;
#pragma unroll
                for (int n = 0; n < 2; ++n) {
                  float hv[4];
#pragma unroll
                  for (int jj = 0; jj < 4; ++jj) { const float g = acc[m][n][jj], u = acc[m][n + 2][jj]; hv[jj] = g * sigmoidf_(g) * u; }
                  *(uint2*)(HS + (size_t)row * 256 + nt * 64 + wc * 32 + n * 16 + fq * 4) = pack4(hv[0], hv[1], hv[2], hv[3]);
                }
              }
            });
    __syncthreads();
    gemm128_glds_multi<8, 4>(smem,
            [=](int r) { return HS + (size_t)r * 256; },
            [=](int r) { return W2 + (size_t)r * 256; }, (size_t)128 * 256,
            [=](int nt, f32x4 (&acc)[4][4], int wr, int wc, int fr, int fq) {
#pragma unroll
              for (int m = 0; m < 4; ++m) {
                const int a = asg[wr * 64 + m * 16 + fr];
                if (a < 0) continue;
                if (a < 8 * T_TOK) {
                  const float gw = GATEW[a];
#pragma unroll
                  for (int n = 0; n < 4; ++n)
                    *(uint2*)(Y + (size_t)a * DM + nt * 128 + wc * 64 + n * 16 + fq * 4) =
                        pack4(acc[m][n][0] * gw, acc[m][n][1] * gw, acc[m][n][2] * gw, acc[m][n][3] * gw);
                } else {
                  const int t = a - 8 * T_TOK;
#pragma unroll
                  for (int n = 0; n < 4; ++n) {
                    float* xp = X1 + (size_t)t * DM + nt * 128 + wc * 64 + n * 16 + fq * 4;
                    const float4 xv = *(const float4*)xp;
                    *(float4*)xp = make_float4(ALPHA_F * xv.x + acc[m][n][0], ALPHA_F * xv.y + acc[m][n][1], ALPHA_F * xv.z + acc[m][n][2], ALPHA_F * xv.w + acc[m][n][3]);
                  }
                }
              }
            });
  }
}

__device__ __forceinline__ void phase_final(const Params& p, char* smem) {
  float* OUT = p.out;
  const bf16_t* __restrict__ Y = (const bf16_t*)(p.ws + OFF_Y);
  const float* __restrict__ g2 = p.in[24]; const float* __restrict__ b2 = p.in[25];
  const int lane = threadIdx.x & 63, wid = threadIdx.x >> 6;
  for (int t = blockIdx.x * 4 + wid; t < T_TOK; t += gridDim.x * 4) {
    const size_t base = (size_t)t * DM;
    float4 v[4];
    float s = 0.f;
#pragma unroll
    for (int u = 0; u < 4; ++u) {
      const int c = u * 256 + lane * 4;
      const float4 xv = *(const float4*)(OUT + base + c);
      float a0 = 0.f, a1 = 0.f, a2 = 0.f, a3 = 0.f;
#pragma unroll
      for (int sl = 0; sl < 8; ++sl) {
        const float4 yv = bf4_to_f4(*(const uint2*)(Y + ((size_t)sl * T_TOK + t) * DM + c));
        a0 += yv.x; a1 += yv.y; a2 += yv.z; a3 += yv.w;
      }
      v[u] = make_float4(xv.x + a0, xv.y + a1, xv.z + a2, xv.w + a3);
      s += (v[u].x + v[u].y) + (v[u].z + v[u].w);
    }
    const float mean = wave_sum_fast(s) * (1.f / DM);
    float q = 0.f;
#pragma unroll
    for (int u = 0; u < 4; ++u) {
      const float d0 = v[u].x - mean, d1 = v[u].y - mean, d2 = v[u].z - mean, d3 = v[u].w - mean;
      q += (d0 * d0 + d1 * d1) + (d2 * d2 + d3 * d3);
    }
    const float rs = rsqrtf(wave_sum_fast(q) * (1.f / DM) + LN_EPS_F);
#pragma unroll
    for (int u = 0; u < 4; ++u) {
      const int c = u * 256 + lane * 4;
      const float4 g = *(const float4*)(g2 + c), bb = *(const float4*)(b2 + c);
      *(float4*)(OUT + base + c) = make_float4((v[u].x - mean) * rs * g.x + bb.x, (v[u].y - mean) * rs * g.y + bb.y,
                                               (v[u].z - mean) * rs * g.z + bb.z, (v[u].w - mean) * rs * g.w + bb.w);
    }
  }
}

#define LAS __attribute__((address_space(3)))
#define XB_TMO      128
#define XB_XCNT(j)  (256  + 64 * (j))
#define XB_XSUB(j)  (1280 + 64 * (j))
#define XB_XGEN(j)  (2304 + 64 * (j))
#define XB_TOP      3328
#define XB_TOPGEN   3392
#define XCD_BAR_WORDS 3456
#define XB_SPIN_CAP (1u << 22)
__device__ __forceinline__ unsigned xb_ld(unsigned* p)              { return __hip_atomic_load(p, __ATOMIC_RELAXED, __HIP_MEMORY_SCOPE_AGENT); }
__device__ __forceinline__ unsigned xb_add(unsigned* p, unsigned v) { return __hip_atomic_fetch_add(p, v, __ATOMIC_RELAXED, __HIP_MEMORY_SCOPE_AGENT); }
__device__ __forceinline__ unsigned xb_xcc_id() { return (unsigned)__builtin_amdgcn_s_getreg((3 << 11) | 20) & 0xFu; }
#define XB_SPIN(cond, bar) do { unsigned _sp = 0; while (cond) { __builtin_amdgcn_s_sleep(1); \
    if ((++_sp & 255u) == 0u) { if (xb_ld(&(bar)[XB_TMO])) break; if (_sp > XB_SPIN_CAP) { atomicAdd(&(bar)[XB_TMO], 1u); break; } } } } while (0)
struct XcdBarrier { unsigned* bar; unsigned x; volatile LAS unsigned* st; };
__device__ __forceinline__ XcdBarrier xcd_barrier_post(unsigned* bar, volatile LAS unsigned* st) {
  XcdBarrier b; b.bar = bar; b.x = xb_xcc_id(); b.st = st;
  if (threadIdx.x == 0) (void)xb_add(&bar[XB_XCNT(b.x)], 1u);
  return b;
}
__device__ __forceinline__ void xcd_barrier_complete(unsigned* bar, unsigned x, unsigned& nloc, unsigned& nx) {
  const unsigned G = gridDim.x * gridDim.y * gridDim.z;
  unsigned sum, cnt, mine, sp = 0u;
  for (;;) {
    sum = 0u; cnt = 0u; mine = 0u;
#pragma unroll
    for (unsigned j = 0; j < 16; ++j) { const unsigned c = xb_ld(&bar[XB_XCNT(j)]); sum += c; cnt += (c > 0u) ? 1u : 0u; mine = (j == x) ? c : mine; }
    if (sum == G) break;
    __builtin_amdgcn_s_sleep(1);
    if ((++sp & 255u) == 0u) { if (xb_ld(&bar[XB_TMO])) break; if (sp > XB_SPIN_CAP) { atomicAdd(&bar[XB_TMO], 1u); break; } }
  }
  nloc = mine > 0u ? mine : 1u; nx = cnt > 0u ? cnt : 1u;
}
__device__ __forceinline__ void xcd_barrier(const XcdBarrier& b) {
  asm volatile("s_waitcnt vmcnt(0)" ::: "memory");
  __syncthreads();
  if (threadIdx.x == 0) {
    unsigned* bar = b.bar;
    __builtin_amdgcn_s_waitcnt(0);
    unsigned nloc = b.st[0], nx = b.st[1];
    if (nloc == 0u) { xcd_barrier_complete(bar, b.x, nloc, nx); b.st[0] = nloc; b.st[1] = nx; }
    const unsigned old = xb_add(&bar[XB_XSUB(b.x)], 1u);
    const unsigned gen = old / nloc;
    if (old + 1u == (gen + 1u) * nloc) {
      __builtin_amdgcn_fence(__ATOMIC_RELEASE, "agent");
      asm volatile("s_waitcnt vmcnt(0)" ::: "memory");
      const unsigned og = xb_add(&bar[XB_TOP], 1u);
      const unsigned tg = og / nx;
      if (og + 1u == (tg + 1u) * nx) xb_add(&bar[XB_TOPGEN], 1u);
      else XB_SPIN(xb_ld(&bar[XB_TOPGEN]) == tg, bar);
      __builtin_amdgcn_fence(__ATOMIC_ACQUIRE, "agent");
      xb_add(&bar[XB_XGEN(b.x)], 1u);
      asm volatile("s_waitcnt vmcnt(0)" ::: "memory");
    } else {
      XB_SPIN(xb_ld(&bar[XB_XGEN(b.x)]) == gen, bar);
      __builtin_amdgcn_fence(__ATOMIC_ACQUIRE, "agent");
      asm volatile("s_waitcnt vmcnt(0)" ::: "memory");
    }
  }
  __syncthreads();
}
#define CTL_BAR_WORD 4096
#define CTL_ZERO_BYTES 32768
#define LDS_BAR_OFF 66432

__global__ void __launch_bounds__(NTHR, 2) mega(Params p) {
  extern __shared__ __attribute__((aligned(16))) char smem[];
  cg::grid_group grid = cg::this_grid();
  volatile LAS unsigned* bst = (volatile LAS unsigned*)(LAS char*)(smem + LDS_BAR_OFF);
  if (threadIdx.x < 2) bst[threadIdx.x] = 0u;
  __syncthreads();
  const XcdBarrier bar = xcd_barrier_post((unsigned*)(p.ws + OFF_CTL) + CTL_BAR_WORD, bst);
  phase_rope(p);
  if (p.ws == nullptr) grid.sync();
  xcd_barrier(bar);
  phase_inproj(p, smem);
  xcd_barrier(bar);
  phase_prep_a(p);
  xcd_barrier(bar);
  phase_prep(p, smem);
  xcd_barrier(bar);
  phase_scan(p, smem);
  phase_convert(p, smem);
  xcd_barrier(bar);
  phase_post(p);
  xcd_barrier(bar);
  phase_outproj(p, smem);
  xcd_barrier(bar);
  phase_ln1(p);
  xcd_barrier(bar);
  phase_router_gemm(p, smem);
  xcd_barrier(bar);
  phase_topk(p);
  xcd_barrier(bar);
  phase_moe(p, smem);
  xcd_barrier(bar);
  phase_final(p, smem);
}

extern "C" void kernel_launch(void* const* d_in, const int* in_sizes, int n_in, void* d_out, int out_size, void* d_ws, size_t ws_size,
                              hipStream_t stream) {
  static int grid_blocks = 0;
  if (grid_blocks == 0) {
    if (ws_size < WS_NEED || n_in != 26) { fprintf(stderr, "kernel_launch: bad ws/n_in: %zu < %zu, n_in %d\n", ws_size, (size_t)WS_NEED, n_in); grid_blocks = -1; return; }
    int dev = 0, cus = 0, per_cu = 0;
    (void)hipGetDevice(&dev);
    (void)hipDeviceGetAttribute(&cus, hipDeviceAttributeMultiprocessorCount, dev);
    (void)hipFuncSetAttribute((const void*)mega, hipFuncAttributeMaxDynamicSharedMemorySize, LDS_BYTES);
    (void)hipOccupancyMaxActiveBlocksPerMultiprocessor(&per_cu, (const void*)mega, NTHR, LDS_BYTES);
    if (per_cu < 1) { fprintf(stderr, "kernel_launch: occupancy query returned %d\n", per_cu); grid_blocks = -1; return; }
    if (per_cu > 2) per_cu = 2;
    grid_blocks = cus * per_cu;
    if (grid_blocks > 512) grid_blocks = 512;
    fprintf(stderr, "kernel_launch: cus %d per_cu %d grid %d\n", cus, per_cu, grid_blocks);
  }
  if (grid_blocks < 0) return;
  if (hipMemsetAsync((char*)d_ws + OFF_CTL, 0, CTL_ZERO_BYTES, stream) != hipSuccess) { fprintf(stderr, "kernel_launch: memset failed\n"); return; }
  Params p{};
  for (int i = 0; i < 26; ++i) p.in[i] = (const float*)d_in[i];
  p.out = (float*)d_out;
  p.ws = (char*)d_ws;
  void* args[] = {&p};
  hipError_t e = hipLaunchCooperativeKernel((const void*)mega, dim3(grid_blocks), dim3(NTHR), args, LDS_BYTES, stream);
  if (e != hipSuccess) fprintf(stderr, "cooperative launch failed: %s (grid %d)\n", hipGetErrorString(e), grid_blocks);
}
```

```cpp
#include <hip/hip_runtime.h>
#include <hip/hip_bf16.h>
#include <hip/hip_cooperative_groups.h>
#include <stdint.h>
#include <stdio.h>

typedef unsigned short bf16_t;

#define T_TOK 32768
#define SEQ 4096
#define DM 1024
#define INW 3360
#define FEW 1824
#define NEXP 256
#define ALPHA_F 1.189207115002721f
#define LN_EPS_F 1e-5f
#define GN_EPS_F 64e-5f

__device__ __forceinline__ float bf2f(bf16_t v) { return __uint_as_float(((unsigned)v) << 16); }
__device__ __forceinline__ bf16_t f2bf(float f) { unsigned u = __float_as_uint(f); return (bf16_t)((u + 0x7fffu + ((u >> 16) & 1u)) >> 16); }
__device__ __forceinline__ float sigmoidf_(float x) { return 1.f / (1.f + __expf(-x)); }
__device__ __forceinline__ float wave_sum(float v) {
#pragma unroll
  for (int o = 32; o >= 1; o >>= 1) v += __shfl_xor(v, o, 64);
  return v;
}

constexpr size_t SZ_T512_BF = (size_t)T_TOK * 512 * 2;
constexpr size_t OFF_EW1 = 0;
constexpr size_t OFF_EW2 = OFF_EW1 + (size_t)257 * 512 * 1024 * 2;
constexpr size_t LBASE = OFF_EW2 + (size_t)257 * 1024 * 256 * 2;
constexpr size_t OFF_XB = 0;
constexpr size_t OFF_FEATS = OFF_XB + (size_t)T_TOK * 1024 * 2;
constexpr size_t OFF_ACT = OFF_FEATS + (size_t)T_TOK * FEW * 2;
constexpr size_t OFF_WINT = OFF_ACT + (size_t)T_TOK * 320 * 2;
constexpr size_t OFF_ROPE = OFF_WINT + (size_t)3584 * 1024 * 2;
static_assert(OFF_ROPE + (size_t)4096 * 32 * 2 * 4 <= LBASE, "early region E overlay");
constexpr size_t OFF_Q = LBASE;
constexpr size_t OFF_K = OFF_Q + SZ_T512_BF;
constexpr size_t OFF_V = OFF_K + SZ_T512_BF;
constexpr size_t OFF_R = OFF_V + SZ_T512_BF;
constexpr size_t OFF_K2 = OFF_R + SZ_T512_BF;
constexpr size_t OFF_V2 = OFF_K2 + SZ_T512_BF;
constexpr size_t OFF_A = OFF_V2 + SZ_T512_BF;
constexpr size_t OFF_B = OFF_A + SZ_T512_BF;
constexpr size_t OFF_W = OFF_B + SZ_T512_BF;
constexpr size_t OFF_G = OFF_W + (size_t)T_TOK * 512 * 4;
constexpr size_t OFF_SB = OFF_G + SZ_T512_BF;
constexpr size_t OFF_YS = OFF_SB + (size_t)T_TOK * 8 * 4;
constexpr size_t OFF_OP = OFF_YS + (size_t)T_TOK * 512 * 4;
constexpr size_t OFF_LSE = OFF_OP + 3 * SZ_T512_BF;
constexpr size_t OFF_MIXED = OFF_LSE + (size_t)3 * T_TOK * 8 * 4;
constexpr size_t OFF_WOUTT = OFF_MIXED + (size_t)T_TOK * 1024 * 2;
constexpr size_t EARLY_END = OFF_WOUTT + (size_t)1024 * 1024 * 2;
constexpr size_t OFF_Y = LBASE;
constexpr size_t OFF_AFF = LBASE + (size_t)T_TOK * 1024 * 2;
constexpr size_t OFF_X1B = OFF_Y + (size_t)8 * T_TOK * 1024 * 2;
#define LCAP 16384
constexpr size_t OFF_LIST = OFF_X1B + (size_t)T_TOK * 1024 * 2;
constexpr size_t OFF_GATEW = OFF_LIST + (size_t)NEXP * LCAP * 4;
constexpr size_t OFF_HSCR = OFF_GATEW + (size_t)8 * T_TOK * 4;
constexpr size_t OFF_CTL = OFF_HSCR + (size_t)512 * 128 * 256 * 2;
constexpr size_t CTL_BYTES = 1u << 20;
constexpr size_t WS_NEED = OFF_CTL + CTL_BYTES;
static_assert(EARLY_END <= OFF_HSCR, "early buffers must stay below the per-block scratch / control words");
static_assert(WS_NEED <= (size_t)1073741824, "workspace must fit 1 GiB");
#define CTL_CONVQ 512

typedef short bf16x8 __attribute__((ext_vector_type(8)));
typedef float f32x4 __attribute__((ext_vector_type(4)));
typedef float f32x16 __attribute__((ext_vector_type(16)));
typedef float f32x2_t __attribute__((ext_vector_type(2)));
typedef __bf16 bf16x2_t __attribute__((ext_vector_type(2)));
__device__ __forceinline__ unsigned cvtpk(float lo, float hi) { f32x2_t v = {lo, hi}; bf16x2_t b = __builtin_convertvector(v, bf16x2_t); return __builtin_bit_cast(unsigned, b); }

__device__ const double INVF[32] = {
1, 0.74989420933245587, 0.56234132519034907, 0.42169650342858223, 0.31622776601683794, 0.23713737056616552,
0.17782794100389229, 0.1333521432163324, 0.10000000000000001, 0.074989420933245579, 0.056234132519034911,
0.042169650342858224, 0.031622776601683791, 0.023713737056616554, 0.017782794100389229, 0.013335214321633241,
0.01, 0.0074989420933245579, 0.005623413251903491, 0.0042169650342858229, 0.0031622776601683794,
0.0023713737056616554, 0.0017782794100389228, 0.0013335214321633241, 0.001, 0.00074989420933245586,
0.0005623413251903491, 0.00042169650342858224, 0.00031622776601683794, 0.00023713737056616554,
0.00017782794100389227, 0.0001333521432163324};

namespace cg = cooperative_groups;

struct Params {
  const float* in[26];
  float* out;
  char* ws;
};

#define NTHR 256
#define VTID ((int)(threadIdx.x & 255))
#define VHALF (__builtin_amdgcn_readfirstlane((int)(threadIdx.x >> 8)))
#define VBID ((int)(blockIdx.x * 2) + VHALF)
#define VGRID ((int)(gridDim.x * 2))
#define HALF_LDS 66560
#define LDS_BYTES 66560

__device__ __forceinline__ void phase_rope(const Params& p) {
  float* tab = (float*)(p.ws + OFF_ROPE);
  for (int i = VBID * NTHR + VTID; i < 4096 * 32; i += VGRID * NTHR) {
    int pos = i >> 5, f = i & 31;
    double ang = (double)pos * INVF[f];
    const double TWO_PI = 6.283185307179586476925286766559;
    double n = rint(ang / TWO_PI);
    double r = ang - n * TWO_PI;
    double r2 = r * r;
    double sn = r, cs = 1.0, ts = r, tc = 1.0;
#pragma unroll 1
    for (int k = 1; k <= 16; ++k) {
      tc = -tc * r2 / (double)((2 * k - 1) * (2 * k));
      ts = -ts * r2 / (double)((2 * k) * (2 * k + 1));
      cs += tc; sn += ts;
    }
    tab[i * 2] = (float)cs; tab[i * 2 + 1] = (float)sn;
  }
  {
    const float* __restrict__ w_in = p.in[1]; const float* __restrict__ w_out = p.in[13];
    uint4* wint = (uint4*)(p.ws + OFF_WINT); uint4* woutt = (uint4*)(p.ws + OFF_WOUTT);
    const int NJ1 = 3584 * 128, NJ2 = 1024 * 128;
    for (int i = VBID * NTHR + VTID; i < NJ1 + NJ2; i += VGRID * NTHR) {
      const bool second = i >= NJ1;
      const int q = second ? i - NJ1 : i;
      const int N = second ? 1024 : 3584, NV = second ? 1024 : INW;
      const int s = q % N, ko = q / N;
      const int n = second ? s : ((s & ~63) + (((s & 63) >> 3) << 2) + (s & 3) + (((s >> 2) & 1) << 5));
      const float* __restrict__ src = second ? w_out : w_in;
      float f[8];
#pragma unroll
      for (int u = 0; u < 8; ++u) f[u] = (n < NV) ? src[(size_t)(ko * 8 + u) * NV + n] : 0.f;
      uint4 w; w.x = cvtpk(f[0], f[1]); w.y = cvtpk(f[2], f[3]); w.z = cvtpk(f[4], f[5]); w.w = cvtpk(f[6], f[7]);
      (second ? woutt : wint)[(size_t)s * 128 + ko] = w;
    }
  }
  {
    const float4* __restrict__ x4 = (const float4*)p.in[0];
    uint4* xb = (uint4*)(p.ws + OFF_XB);
    for (size_t i = (size_t)VBID * NTHR + VTID; i < (size_t)T_TOK * DM / 8; i += (size_t)VGRID * NTHR) {
      float4 a = x4[2 * i], b = x4[2 * i + 1];
      uint4 w; w.x = cvtpk(a.x, a.y); w.y = cvtpk(a.z, a.w); w.z = cvtpk(b.x, b.y); w.w = cvtpk(b.z, b.w);
      xb[i] = w;
    }
  }
}

template <class AF, class BF>
__device__ __forceinline__ void gemm64_naive(float* As, float* Bs, float* Cs, int K, AF af, BF bf) {
  int tid_l_ = VTID; asm volatile("" : "+v"(tid_l_)); const int tid = tid_l_, tx = tid & 15, ty = tid >> 4;
  float acc[4][4];
#pragma unroll
  for (int i = 0; i < 4; ++i)
#pragma unroll
    for (int j = 0; j < 4; ++j) acc[i][j] = 0.f;
  for (int k0 = 0; k0 < K; k0 += 16) {
#pragma unroll
    for (int u = 0; u < 4; ++u) { int i = tid + u * 256; int r = i >> 4, kk = i & 15; As[kk * 68 + r] = af(r, k0 + kk); }
#pragma unroll
    for (int u = 0; u < 4; ++u) { int i = tid + u * 256; int kk = i >> 6, c = i & 63; Bs[kk * 68 + c] = bf(k0 + kk, c); }
    __syncthreads();
#pragma unroll
    for (int kk = 0; kk < 16; ++kk) {
      float a[4], b[4];
#pragma unroll
      for (int i = 0; i < 4; ++i) { a[i] = As[kk * 68 + ty * 4 + i]; b[i] = Bs[kk * 68 + tx * 4 + i]; }
#pragma unroll
      for (int i = 0; i < 4; ++i)
#pragma unroll
        for (int j = 0; j < 4; ++j) acc[i][j] += a[i] * b[j];
    }
    __syncthreads();
  }
#pragma unroll
  for (int i = 0; i < 4; ++i)
#pragma unroll
    for (int j = 0; j < 4; ++j) Cs[(ty * 4 + i) * 65 + tx * 4 + j] = acc[i][j];
  __syncthreads();
}


__device__ __forceinline__ int lds_off(int row, int chunk) { return row * 128 + ((chunk ^ ((row >> 1) & 7)) << 4); }

template <int BMODE>
__device__ __forceinline__ unsigned cvtpk_m(float a, float b, const bool lo = false) {
  if (BMODE == 0 || (BMODE == 2 && !lo)) return cvtpk(a, b);
  const unsigned h = cvtpk(a, b);
  const float ah = __uint_as_float(h << 16), bh = __uint_as_float(h & 0xffff0000u);
  return cvtpk(a - ah, b - bh);
}
#define G128_MMA(bufoff) { \
    _Pragma("unroll") for (int kk = 0; kk < 2; ++kk) { \
      bf16x8 af[4], bfr[4]; \
      _Pragma("unroll") for (int m = 0; m < 4; ++m) af[m] = *(const bf16x8*)(smem + (bufoff) + lds_off(wr * 64 + m * 16 + fr, kk * 4 + fq)); \
      _Pragma("unroll") for (int n = 0; n < 4; ++n) bfr[n] = *(const bf16x8*)(smem + (bufoff) + 16384 + lds_off(wc * 64 + n * 16 + fr, kk * 4 + fq)); \
      _Pragma("unroll") for (int m = 0; m < 4; ++m) \
        _Pragma("unroll") for (int n = 0; n < 4; ++n) acc[m][n] = __builtin_amdgcn_mfma_f32_16x16x32_bf16(bfr[n], af[m], acc[m][n], 0, 0, 0); \
    } }
template <int BMODE, bool KCLAMP, class ALoad, class BPtr>
__device__ __forceinline__ void gemm128_acc(f32x4 (&acc)[4][4], char* smem, const int nk, ALoad aload, BPtr bptr, const int ldb, const int kvalid) {
  int tid_l_ = VTID; asm volatile("" : "+v"(tid_l_)); const int tid = tid_l_, lane = tid & 63, wid = tid >> 6;
  const int wr = wid >> 1, wc = wid & 1, fr = lane & 15, fq = lane >> 4;
  const int achunk = tid & 7, arow0 = tid >> 3;
  const int nq = tid & 31, ko = tid >> 5;
  const float* bp0 = bptr(nq);
  const int oa0 = lds_off(arow0, achunk), oa1 = lds_off(arow0 + 32, achunk), oa2 = lds_off(arow0 + 64, achunk), oa3 = lds_off(arow0 + 96, achunk);
  const int ob0 = 16384 + lds_off(nq * 4 + 0, ko), ob1 = 16384 + lds_off(nq * 4 + 1, ko), ob2 = 16384 + lds_off(nq * 4 + 2, ko), ob3 = 16384 + lds_off(nq * 4 + 3, ko);
  uint4 ra0, ra1, ra2, ra3; float4 rb0, rb1, rb2, rb3, rb4, rb5, rb6, rb7;
#define G128_LOAD(kt) { \
    ra0 = aload(0, arow0, (kt) * 8 + achunk); ra1 = aload(1, arow0 + 32, (kt) * 8 + achunk); \
    ra2 = aload(2, arow0 + 64, (kt) * 8 + achunk); ra3 = aload(3, arow0 + 96, (kt) * 8 + achunk); \
    int kr_ = (kt) * 64 + ko * 8; \
    if (KCLAMP) kr_ = min(kr_, kvalid - 8);     \
    { \
      const float* b2_ = bp0 + (size_t)((BMODE == 2) ? (kr_ & 1023) : kr_) * ldb; \
      rb0 = *(const float4*)(b2_); rb1 = *(const float4*)(b2_ + (size_t)1 * ldb); rb2 = *(const float4*)(b2_ + (size_t)2 * ldb); \
      rb3 = *(const float4*)(b2_ + (size_t)3 * ldb); rb4 = *(const float4*)(b2_ + (size_t)4 * ldb); rb5 = *(const float4*)(b2_ + (size_t)5 * ldb); \
      rb6 = *(const float4*)(b2_ + (size_t)6 * ldb); rb7 = *(const float4*)(b2_ + (size_t)7 * ldb); \
    } }
#define G128_STORE(bufoff, lo_) { \
    char* const sb_ = smem + (bufoff); \
    *(uint4*)(sb_ + oa0) = ra0; *(uint4*)(sb_ + oa1) = ra1; *(uint4*)(sb_ + oa2) = ra2; *(uint4*)(sb_ + oa3) = ra3; \
    uint4 w; \
    w.x = cvtpk_m<BMODE>(rb0.x, rb1.x, lo_); w.y = cvtpk_m<BMODE>(rb2.x, rb3.x, lo_); w.z = cvtpk_m<BMODE>(rb4.x, rb5.x, lo_); w.w = cvtpk_m<BMODE>(rb6.x, rb7.x, lo_); \
    *(uint4*)(sb_ + ob0) = w; \
    w.x = cvtpk_m<BMODE>(rb0.y, rb1.y, lo_); w.y = cvtpk_m<BMODE>(rb2.y, rb3.y, lo_); w.z = cvtpk_m<BMODE>(rb4.y, rb5.y, lo_); w.w = cvtpk_m<BMODE>(rb6.y, rb7.y, lo_); \
    *(uint4*)(sb_ + ob1) = w; \
    w.x = cvtpk_m<BMODE>(rb0.z, rb1.z, lo_); w.y = cvtpk_m<BMODE>(rb2.z, rb3.z, lo_); w.z = cvtpk_m<BMODE>(rb4.z, rb5.z, lo_); w.w = cvtpk_m<BMODE>(rb6.z, rb7.z, lo_); \
    *(uint4*)(sb_ + ob2) = w; \
    w.x = cvtpk_m<BMODE>(rb0.w, rb1.w, lo_); w.y = cvtpk_m<BMODE>(rb2.w, rb3.w, lo_); w.z = cvtpk_m<BMODE>(rb4.w, rb5.w, lo_); w.w = cvtpk_m<BMODE>(rb6.w, rb7.w, lo_); \
    *(uint4*)(sb_ + ob3) = w; }
  G128_LOAD(0)
  G128_STORE(0, false)
  if (nk > 1) G128_LOAD(1)
  __syncthreads();
  for (int kt = 0; kt < nk; ++kt) {
    const int cur = (kt & 1) * 32768;
    __builtin_amdgcn_sched_barrier(0);
    G128_MMA(cur)
    __builtin_amdgcn_sched_barrier(0);
    if (kt + 1 < nk) {
      G128_STORE(cur ^ 32768, (kt + 1) >= kvalid)
      __builtin_amdgcn_sched_barrier(0);
      if (kt + 2 < nk) G128_LOAD(kt + 2)
    }
    __builtin_amdgcn_sched_barrier(0);
    __syncthreads();
  }
#undef G128_LOAD
#undef G128_STORE
}
__device__ __forceinline__ void acc_zero(f32x4 (&acc)[4][4]) {
#pragma unroll
  for (int m = 0; m < 4; ++m)
#pragma unroll
    for (int n = 0; n < 4; ++n) acc[m][n] = (f32x4){0.f, 0.f, 0.f, 0.f};
}
template <class ARow, class BPtr, class Epi>
__device__ __forceinline__ void gemm128(char* smem, const int K, ARow arow, BPtr bptr, const int ldb, Epi epi) {
  int tid_l_ = VTID; asm volatile("" : "+v"(tid_l_)); const int tid = tid_l_, lane = tid & 63, wid = tid >> 6;
  const int arow0 = tid >> 3;
  const bf16_t* ap0 = arow(arow0);
  const bf16_t* ap1 = arow(arow0 + 32);
  const bf16_t* ap2 = arow(arow0 + 64);
  const bf16_t* ap3 = arow(arow0 + 96);
  f32x4 acc[4][4];
  acc_zero(acc);
  gemm128_acc<0, false>(acc, smem, K >> 6,
      [=](int u, int, int kc) { const bf16_t* q = (u == 0) ? ap0 : (u == 1) ? ap1 : (u == 2) ? ap2 : ap3; return *(const uint4*)(q + kc * 8); },
      bptr, ldb, 0);
  epi(acc, wid >> 1, wid & 1, lane & 15, lane >> 4);
}


template <class ALoad, class BLoad>
__device__ __forceinline__ void gemm128_acc_bb(f32x4 (&acc)[4][4], char* smem, const int nk, ALoad aload, BLoad bload) {
  int tid_l_ = VTID; asm volatile("" : "+v"(tid_l_)); const int tid = tid_l_, lane = tid & 63, wid = tid >> 6;
  const int wr = wid >> 1, wc = wid & 1, fr = lane & 15, fq = lane >> 4;
  const int achunk = tid & 7, arow0 = tid >> 3;
  const int oa0 = lds_off(arow0, achunk), oa1 = lds_off(arow0 + 32, achunk), oa2 = lds_off(arow0 + 64, achunk), oa3 = lds_off(arow0 + 96, achunk);
  uint4 ra0, ra1, ra2, ra3, rb0, rb1, rb2, rb3;
#define G128_LOADBB(kt) { \
    ra0 = aload(0, arow0, (kt) * 8 + achunk); ra1 = aload(1, arow0 + 32, (kt) * 8 + achunk); \
    ra2 = aload(2, arow0 + 64, (kt) * 8 + achunk); ra3 = aload(3, arow0 + 96, (kt) * 8 + achunk); \
    rb0 = bload(0, arow0, (kt) * 8 + achunk); rb1 = bload(1, arow0 + 32, (kt) * 8 + achunk); \
    rb2 = bload(2, arow0 + 64, (kt) * 8 + achunk); rb3 = bload(3, arow0 + 96, (kt) * 8 + achunk); }
#define G128_STOREBB(bufoff) { \
    char* const sb_ = smem + (bufoff); \
    *(uint4*)(sb_ + oa0) = ra0; *(uint4*)(sb_ + oa1) = ra1; *(uint4*)(sb_ + oa2) = ra2; *(uint4*)(sb_ + oa3) = ra3; \
    *(uint4*)(sb_ + 16384 + oa0) = rb0; *(uint4*)(sb_ + 16384 + oa1) = rb1; *(uint4*)(sb_ + 16384 + oa2) = rb2; *(uint4*)(sb_ + 16384 + oa3) = rb3; }
  G128_LOADBB(0)
  G128_STOREBB(0)
  if (nk > 1) G128_LOADBB(1)
  __syncthreads();
  for (int kt = 0; kt < nk; ++kt) {
    const int cur = (kt & 1) * 32768;
    __builtin_amdgcn_sched_barrier(0);
    G128_MMA(cur)
    __builtin_amdgcn_sched_barrier(0);
    if (kt + 1 < nk) {
      G128_STOREBB(cur ^ 32768)
      __builtin_amdgcn_sched_barrier(0);
      if (kt + 2 < nk) G128_LOADBB(kt + 2)
    }
    __builtin_amdgcn_sched_barrier(0);
    __syncthreads();
  }
#undef G128_LOADBB
#undef G128_STOREBB
}
template <class ARow, class BRow, class Epi>
__device__ __forceinline__ void gemm128_bb(char* smem, const int K, ARow arow, BRow brow, Epi epi) {
  int tid_l_ = VTID; asm volatile("" : "+v"(tid_l_)); const int tid = tid_l_, lane = tid & 63, wid = tid >> 6;
  const int arow0 = tid >> 3;
  const bf16_t* ap0 = arow(arow0); const bf16_t* ap1 = arow(arow0 + 32); const bf16_t* ap2 = arow(arow0 + 64); const bf16_t* ap3 = arow(arow0 + 96);
  const bf16_t* bp0 = brow(arow0); const bf16_t* bp1 = brow(arow0 + 32); const bf16_t* bp2 = brow(arow0 + 64); const bf16_t* bp3 = brow(arow0 + 96);
  f32x4 acc[4][4];
  acc_zero(acc);
  gemm128_acc_bb(acc, smem, K >> 6,
      [=](int u, int, int kc) { const bf16_t* q = (u == 0) ? ap0 : (u == 1) ? ap1 : (u == 2) ? ap2 : ap3; return *(const uint4*)(q + kc * 8); },
      [=](int u, int, int kc) { const bf16_t* q = (u == 0) ? bp0 : (u == 1) ? bp1 : (u == 2) ? bp2 : bp3; return *(const uint4*)(q + kc * 8); });
  epi(acc, wid >> 1, wid & 1, lane & 15, lane >> 4);
}


#define GAS1 __attribute__((address_space(1)))
#define LAS3 __attribute__((address_space(3)))
__device__ __forceinline__ void glds16(const void* g, char* l) {
  __builtin_amdgcn_global_load_lds((const GAS1 void*)g, (LAS3 void*)l, 16, 0, 0);
}
template <class ARow, class BRow, class Epi>
__device__ __forceinline__ void gemm128_glds(char* smem, const int K, ARow arow, BRow brow, Epi epi) {
  int tid_l_ = VTID; asm volatile("" : "+v"(tid_l_)); const int tid = tid_l_, lane = tid & 63, wid = tid >> 6;
  const int wr = wid >> 1, wc = wid & 1, fr = lane & 15, fq = lane >> 4;
  const int r0 = tid >> 3;
  const int cl = (tid & 7) ^ ((tid >> 4) & 7);
  const bf16_t* ga0 = arow(r0) + cl * 8; const bf16_t* ga1 = arow(r0 + 32) + cl * 8; const bf16_t* ga2 = arow(r0 + 64) + cl * 8; const bf16_t* ga3 = arow(r0 + 96) + cl * 8;
  const bf16_t* gb0 = brow(r0) + cl * 8; const bf16_t* gb1 = brow(r0 + 32) + cl * 8; const bf16_t* gb2 = brow(r0 + 64) + cl * 8; const bf16_t* gb3 = brow(r0 + 96) + cl * 8;
  char* const lbase = smem + tid * 16;
#define GL_STAGE(bufoff, kt) { \
    char* const d_ = lbase + (bufoff); const int ko_ = (kt) * 64; \
    glds16(ga0 + ko_, d_); glds16(ga1 + ko_, d_ + 4096); glds16(ga2 + ko_, d_ + 8192); glds16(ga3 + ko_, d_ + 12288); \
    glds16(gb0 + ko_, d_ + 16384); glds16(gb1 + ko_, d_ + 20480); glds16(gb2 + ko_, d_ + 24576); glds16(gb3 + ko_, d_ + 28672); }
  f32x4 acc[4][4];
  acc_zero(acc);
  const int nk = K >> 6;
  GL_STAGE(0, 0)
  asm volatile("s_waitcnt vmcnt(0)" ::: "memory");
  __syncthreads();
  for (int kt = 0; kt < nk; ++kt) {
    const int cur = (kt & 1) * 32768;
    if (kt + 1 < nk) GL_STAGE(cur ^ 32768, kt + 1)
    G128_MMA(cur)
    asm volatile("s_waitcnt vmcnt(0)" ::: "memory");
    __syncthreads();
  }
#undef GL_STAGE
  epi(acc, wr, wc, fr, fq);
}


template <int NCALL, int NK, class ARow, class BRow, class Epi>
__device__ __forceinline__ void gemm128_glds_multi(char* smem, ARow arow, BRow brow, const size_t bstride, Epi epi) {
  int tid_l_ = VTID; asm volatile("" : "+v"(tid_l_)); const int tid = tid_l_, lane = tid & 63, wid = tid >> 6;
  const int wr = wid >> 1, wc = wid & 1, fr = lane & 15, fq = lane >> 4;
  const int r0 = tid >> 3;
  const int cl = (tid & 7) ^ ((tid >> 4) & 7);
  const bf16_t* ga0 = arow(r0) + cl * 8; const bf16_t* ga1 = arow(r0 + 32) + cl * 8; const bf16_t* ga2 = arow(r0 + 64) + cl * 8; const bf16_t* ga3 = arow(r0 + 96) + cl * 8;
  const bf16_t* gb0 = brow(r0) + cl * 8; const bf16_t* gb1 = brow(r0 + 32) + cl * 8; const bf16_t* gb2 = brow(r0 + 64) + cl * 8; const bf16_t* gb3 = brow(r0 + 96) + cl * 8;
  char* const lbase = smem + tid * 16;
#define GM_STAGE(bufoff, g) { \
    char* const d_ = lbase + (bufoff); const int ko_ = ((g) % NK) * 64; const size_t bo_ = (size_t)((g) / NK) * bstride + ko_; \
    glds16(ga0 + ko_, d_); glds16(ga1 + ko_, d_ + 4096); glds16(ga2 + ko_, d_ + 8192); glds16(ga3 + ko_, d_ + 12288); \
    glds16(gb0 + bo_, d_ + 16384); glds16(gb1 + bo_, d_ + 20480); glds16(gb2 + bo_, d_ + 24576); glds16(gb3 + bo_, d_ + 28672); }
  f32x4 acc[4][4];
  acc_zero(acc);
  constexpr int G = NCALL * NK;
  GM_STAGE(0, 0)
  asm volatile("s_waitcnt vmcnt(0)" ::: "memory");
  __syncthreads();
#pragma unroll 1
  for (int g = 0; g < G; ++g) {
    const int cur = (g & 1) * 32768;
    if (g + 1 < G) GM_STAGE(cur ^ 32768, g + 1)
    G128_MMA(cur)
    if ((g % NK) == NK - 1) {
      epi(g / NK, acc, wr, wc, fr, fq);
      acc_zero(acc);
    }
    asm volatile("s_waitcnt vmcnt(0)" ::: "memory");
    __syncthreads();
  }
#undef GM_STAGE
}


namespace pg8 {
#define PG8_LAS __attribute__((address_space(3)))
typedef unsigned short bf16_t;
typedef short bf16x8 __attribute__((ext_vector_type(8)));
typedef float f32x4 __attribute__((ext_vector_type(4)));
typedef unsigned u32x4 __attribute__((ext_vector_type(4)));
constexpr int BM = 256, BK = 64, HALF = 128, HTB = HALF * BK * 2  , STAGE_BYTES = 8 * HTB, NXCD = 8, WGM = 8;

__host__ __device__ __forceinline__ int lds_byte(int r, int c) { const int st = (r >> 4) * 2 + (c >> 5), rr = r & 15, cc = c & 31, ob = rr * 64 + cc * 2; return st * 1024 + (ob ^ (((ob >> 9) & 1) << 5)); }
__host__ __device__ __forceinline__ void stage_rc(int b, int& R, int& C) { const int st = b / 1024, sb = b % 1024, swz = sb ^ (((sb >> 9) & 1) << 5); R = (st >> 1) * 16 + swz / 64; C = (st & 1) * 32 + (swz % 64) / 2; }
__host__ __device__ __forceinline__ int perm32(int rho) { const int n = rho >> 4, i = rho & 15; return 8 * (i >> 2) + 4 * n + (i & 3); }

struct Unit { int pm, pn; };
struct Gemm { const bf16_t* A; const bf16_t* Bt; int M, N, K; };

struct StaticOrder {
    int nM, nN, nwg, G, c;
    __host__ __device__ void init(int M, int N, int G_, int c_) { nM = M / BM; nN = N / BM; nwg = nM * nN; G = G_; c = c_; }
    __host__ __device__ bool next(int i, Unit& u) const {
        const long L = (long)i * G + c; if (L >= nwg) return false;
        int wgid = (int)L; { const int q = nwg / NXCD, r = nwg % NXCD, xcd = wgid % NXCD, off = wgid / NXCD; wgid = (xcd < r ? xcd * (q + 1) : r * (q + 1) + (xcd - r) * q) + off; }
        const int nig = WGM * nN, gid = wgid / nig, fm = gid * WGM, gsz = (nM - fm) < WGM ? (nM - fm) : WGM;
        u.pm = fm + ((wgid % nig) % gsz); u.pn = (wgid % nig) / gsz; return true;
    }
    __device__ __forceinline__ void a_ready(const Unit&) const {}
    __device__ __forceinline__ void done(const Unit&) const {}
};
template <class Epi, class Sched, bool ALIGN_EPI = false, bool SP2 = false, bool GATHER = false>
__device__ __forceinline__ void gemm_phase(PG8_LAS unsigned char* lds, const Gemm g, const Sched& S, const Epi& E, const int* rowidx = nullptr) {
    int tid_ = threadIdx.x; asm volatile("" : "+v"(tid_));
    const int tid = tid_, wid = __builtin_amdgcn_readfirstlane(tid >> 6), lane = tid & 63, wr = wid >> 2, wc = wid & 3, fr = lane & 15, fq = lane >> 4;
    const int K = g.K, nt = K / BK;
    unsigned voffA[2], voffA1[2], voffB[2];
#pragma unroll
    for (int i = 0; i < 2; ++i) { int R, C; stage_rc(tid * 16 + i * 8192, R, C); const int Rb = Epi::PERM ? ((R & ~31) + perm32(R & 31)) : R;
        if (GATHER) { voffA[i] = ((unsigned)rowidx[R] * (unsigned)K + (unsigned)C) * 2u; voffA1[i] = ((unsigned)rowidx[128 + R] * (unsigned)K + (unsigned)C) * 2u; }
        else { voffA[i] = (unsigned)(R * K + C) * 2u; voffA1[i] = voffA[i]; }
        voffB[i] = (unsigned)(Rb * K + C) * 2u; }
    const size_t hstepA = GATHER ? (size_t)0 : (size_t)HALF * K * 2;
    const size_t kstep = (size_t)(BK * 2);
    const size_t hstep = (size_t)HALF * K * 2;
    const size_t tstep = 2 * hstep;
    const unsigned ldsw = (unsigned)wid * 1024u;
    const int aoff = lds_byte(wr * 64 + fr, fq * 8), boff = lds_byte(wc * 32 + fr, fq * 8);
#define PG8_SA(b, h) (((b) * 2 + (h)) * HTB)
#define PG8_SB(b, h) ((4 + (b) * 2 + (h)) * HTB)
#define PG8_STAGE(bufoff, gbase, voff) do { _Pragma("unroll") for (int _i = 0; _i < 2; ++_i) \
        __builtin_amdgcn_global_load_lds((const unsigned*)((const char*)(gbase) + (voff)[_i]), (PG8_LAS unsigned*)(lds + (bufoff) + ldsw + _i * 8192), 16, 0, 0); } while (0)
#define PG8_LDA(dst, b, h) do { _Pragma("unroll") for (int m = 0; m < 4; ++m) _Pragma("unroll") for (int k = 0; k < 2; ++k) dst[m][k] = *(const PG8_LAS bf16x8*)(lds + PG8_SA(b, h) + aoff + m * 2048 + k * 1024); } while (0)
#define PG8_LDB(dst, b, h) do { _Pragma("unroll") for (int n = 0; n < 2; ++n) _Pragma("unroll") for (int k = 0; k < 2; ++k) dst[n][k] = *(const PG8_LAS bf16x8*)(lds + PG8_SB(b, h) + boff + n * 2048 + k * 1024); } while (0)
#define PG8_MMA(ai, bj, At, Bt) do { __builtin_amdgcn_s_setprio(1); _Pragma("unroll") for (int m = 0; m < 4; ++m) _Pragma("unroll") for (int n = 0; n < 2; ++n) _Pragma("unroll") for (int k = 0; k < 2; ++k) \
        acc[ai][bj][m][n] = __builtin_amdgcn_mfma_f32_16x16x32_bf16(Bt[n][k], At[m][k], acc[ai][bj][m][n], 0, 0, 0); __builtin_amdgcn_s_setprio(0); } while (0)
#define PG8_WAIT_V(n) asm volatile("s_waitcnt vmcnt(" #n ")" ::: "memory")
#define PG8_WAIT_L(n) asm volatile("s_waitcnt lgkmcnt(" #n ")" ::: "memory")
#define PG8_BAR __builtin_amdgcn_s_barrier()
#define PG8_SCHED __builtin_amdgcn_sched_barrier(0)
    Unit cur, nxt; int ui = 0;
    if (!S.next(0, cur)) return;
    f32x4 acc[2][2][4][2];
#pragma unroll
    for (int a = 0; a < 2; ++a)
#pragma unroll
        for (int b = 0; b < 2; ++b)
#pragma unroll
            for (int m = 0; m < 4; ++m)
#pragma unroll
                for (int n = 0; n < 2; ++n) acc[a][b][m][n] = (f32x4){0.f, 0.f, 0.f, 0.f};
    bf16x8 At[4][2], B0[2][2], B1[2][2];
    const char* cA = (const char*)g.A + (size_t)cur.pm * tstep; const char* cB = (const char*)g.Bt + (size_t)cur.pn * tstep;
    S.a_ready(cur);
    if constexpr (SP2) {
        PG8_STAGE(PG8_SB(0, 0), cB, voffB); PG8_STAGE(PG8_SB(0, 1), cB + hstep, voffB); PG8_STAGE(PG8_SA(0, 0), cA, voffA); PG8_STAGE(PG8_SA(0, 1), cA + hstepA, voffA1);
        if (wr == 1) PG8_BAR;
        PG8_WAIT_V(2); PG8_BAR;
        PG8_STAGE(PG8_SB(1, 0), cB + kstep, voffB); PG8_STAGE(PG8_SA(1, 0), cA + kstep, voffA); PG8_STAGE(PG8_SB(1, 1), cB + hstep + kstep, voffB);
        PG8_WAIT_V(6); PG8_BAR;
    } else {
        PG8_STAGE(PG8_SB(0, 0), cB, voffB); PG8_STAGE(PG8_SA(0, 0), cA, voffA); PG8_STAGE(PG8_SB(0, 1), cB + hstep, voffB); PG8_STAGE(PG8_SA(0, 1), cA + hstepA, voffA1);
        if (wr == 1) PG8_BAR;
        PG8_WAIT_V(4); PG8_BAR;
        PG8_STAGE(PG8_SB(1, 0), cB + kstep, voffB); PG8_STAGE(PG8_SA(1, 0), cA + kstep, voffA); PG8_STAGE(PG8_SB(1, 1), cB + hstep + kstep, voffB);
        PG8_WAIT_V(6); PG8_BAR;
    }
    for (;;) {
        const bool has_next = S.next(ui + 1, nxt);
        const char* nA = has_next ? (const char*)g.A + (size_t)nxt.pm * tstep : cA; const char* nB = has_next ? (const char*)g.Bt + (size_t)nxt.pn * tstep : cB;
        for (int t = 0; t < nt; t += 2) {
            const bool last = (t == nt - 2);
            const char* a1 = cA + (size_t)(t + 1) * kstep;
            const char* a2 = last ? nA : cA + (size_t)(t + 2) * kstep; const char* b2 = last ? nB : cB + (size_t)(t + 2) * kstep;
            const char* a3 = a2 + kstep; const char* b3 = b2 + kstep;
            if (last && has_next) S.a_ready(nxt);
            if constexpr (SP2) {
            PG8_LDB(B0, 0, 0); PG8_LDB(B1, 0, 1); PG8_SCHED; PG8_LDA(At, 0, 0); PG8_STAGE(PG8_SA(1, 1), a1 + hstepA, voffA1);
            PG8_WAIT_V(8); PG8_WAIT_L(0); PG8_BAR; PG8_MMA(0, 0, At, B0); PG8_MMA(0, 1, At, B1); PG8_BAR; PG8_SCHED;
            PG8_LDA(At, 0, 1); PG8_STAGE(PG8_SB(0, 0), b2, voffB); PG8_STAGE(PG8_SB(0, 1), b2 + hstep, voffB); PG8_STAGE(PG8_SA(0, 0), a2, voffA);
            PG8_WAIT_V(8); PG8_WAIT_L(0); PG8_BAR; PG8_MMA(1, 0, At, B0); PG8_MMA(1, 1, At, B1); PG8_BAR; PG8_SCHED;
            PG8_LDB(B0, 1, 0); PG8_LDB(B1, 1, 1); PG8_SCHED; PG8_LDA(At, 1, 0); PG8_STAGE(PG8_SA(0, 1), a2 + hstepA, voffA1);
            PG8_WAIT_V(8); PG8_WAIT_L(0); PG8_BAR; PG8_MMA(0, 0, At, B0); PG8_MMA(0, 1, At, B1); PG8_BAR; PG8_SCHED;
            PG8_LDA(At, 1, 1); PG8_STAGE(PG8_SB(1, 0), b3, voffB); PG8_STAGE(PG8_SB(1, 1), b3 + hstep, voffB); PG8_STAGE(PG8_SA(1, 0), a3, voffA);
            PG8_WAIT_V(8); PG8_WAIT_L(0); PG8_BAR; PG8_MMA(1, 0, At, B0); PG8_MMA(1, 1, At, B1); PG8_BAR; PG8_SCHED;
            } else {
            PG8_LDB(B0, 0, 0); PG8_SCHED; PG8_LDA(At, 0, 0); PG8_STAGE(PG8_SA(1, 1), a1 + hstepA, voffA1);
            PG8_WAIT_L(8); PG8_BAR; PG8_WAIT_L(0); PG8_MMA(0, 0, At, B0); PG8_BAR; PG8_SCHED;
            PG8_LDB(B1, 0, 1); PG8_STAGE(PG8_SB(0, 0), b2, voffB);
            PG8_BAR; PG8_WAIT_L(0); PG8_MMA(0, 1, At, B1); PG8_BAR;
            PG8_LDA(At, 0, 1); PG8_STAGE(PG8_SA(0, 0), a2, voffA);
            PG8_BAR; PG8_WAIT_L(0); PG8_MMA(1, 0, At, B0); PG8_BAR; PG8_SCHED;
            PG8_STAGE(PG8_SB(0, 1), b2 + hstep, voffB);
            PG8_WAIT_V(6); PG8_BAR; PG8_MMA(1, 1, At, B1); PG8_BAR;
            PG8_LDB(B0, 1, 0); PG8_SCHED; PG8_LDA(At, 1, 0); PG8_STAGE(PG8_SA(0, 1), a2 + hstepA, voffA1);
            PG8_WAIT_L(8); PG8_BAR; PG8_WAIT_L(0); PG8_MMA(0, 0, At, B0); PG8_BAR; PG8_SCHED;
            PG8_LDB(B1, 1, 1); PG8_STAGE(PG8_SB(1, 0), b3, voffB);
            PG8_BAR; PG8_WAIT_L(0); PG8_MMA(0, 1, At, B1); PG8_BAR;
            PG8_LDA(At, 1, 1); PG8_STAGE(PG8_SA(1, 0), a3, voffA);
            PG8_BAR; PG8_WAIT_L(0); PG8_MMA(1, 0, At, B0); PG8_BAR; PG8_SCHED;
            PG8_STAGE(PG8_SB(1, 1), b3 + hstep, voffB);
            PG8_WAIT_V(6); PG8_BAR; PG8_MMA(1, 1, At, B1); PG8_BAR;
            }
        }
        if constexpr (ALIGN_EPI) { if (wr == 0) PG8_BAR; }
        if constexpr (!Epi::AFTER_DRAIN) { E(acc, cur, wr, wc, fr, fq); S.done(cur); }
        if (!has_next) break;
#pragma unroll
        for (int a = 0; a < 2; ++a)
#pragma unroll
            for (int b = 0; b < 2; ++b)
#pragma unroll
                for (int m = 0; m < 4; ++m)
#pragma unroll
                    for (int n = 0; n < 2; ++n) acc[a][b][m][n] = (f32x4){0.f, 0.f, 0.f, 0.f};
        cur = nxt; cA = nA; cB = nB; ++ui;
        if constexpr (ALIGN_EPI) { if (wr == 1) PG8_BAR; }
    }
    PG8_WAIT_V(0);
    if constexpr (!ALIGN_EPI) { if (wr == 0) PG8_BAR; }
    PG8_BAR;
    if constexpr (Epi::AFTER_DRAIN) { E.fused(acc, cur, wr, wc, fr, fq, lds, wid, lane); S.done(cur); }
#undef PG8_SA
#undef PG8_SB
#undef PG8_STAGE
#undef PG8_LDA
#undef PG8_LDB
#undef PG8_MMA
#undef PG8_WAIT_V
#undef PG8_WAIT_L
#undef PG8_BAR
#undef PG8_SCHED
}
}
#define DPP_F(v, ctrl) __builtin_bit_cast(float, __builtin_amdgcn_update_dpp(0, __builtin_bit_cast(int, (v)), (ctrl), 0xF, 0xF, true))
__device__ __forceinline__ float rdlane_f(float v, int l) { return __builtin_bit_cast(float, __builtin_amdgcn_readlane(__builtin_bit_cast(int, v), l)); }
__device__ __forceinline__ float dpp_sum16x(float v) {
  v += DPP_F(v, 0xB1); v += DPP_F(v, 0x4E); v += DPP_F(v, 0x141); v += DPP_F(v, 0x140);
  return v;
}
__device__ __forceinline__ float dpp_max16x(float v) {
  v = fmaxf(v, DPP_F(v, 0xB1)); v = fmaxf(v, DPP_F(v, 0x4E)); v = fmaxf(v, DPP_F(v, 0x141)); v = fmaxf(v, DPP_F(v, 0x140));
  return v;
}
__device__ __forceinline__ float wave_sum_fast(float v) {
  v = dpp_sum16x(v);
  return (rdlane_f(v, 0) + rdlane_f(v, 16)) + (rdlane_f(v, 32) + rdlane_f(v, 48));
}
__device__ __forceinline__ float wave_max_fast(float v) {
  v = dpp_max16x(v);
  return fmaxf(fmaxf(rdlane_f(v, 0), rdlane_f(v, 16)), fmaxf(rdlane_f(v, 32), rdlane_f(v, 48)));
}
__device__ __forceinline__ float fast_tanh(float x) { const float e = __expf(2.f * x); return 1.f - 2.f / (e + 1.f); }


__device__ __forceinline__ float4 bf4_to_f4(uint2 u) {
  float4 r;
  r.x = __uint_as_float(u.x << 16); r.y = __uint_as_float(u.x & 0xffff0000u);
  r.z = __uint_as_float(u.y << 16); r.w = __uint_as_float(u.y & 0xffff0000u);
  return r;
}
__device__ __forceinline__ uint2 pack4(float a, float b, float c, float d) { uint2 r; r.x = cvtpk(a, b); r.y = cvtpk(c, d); return r; }
#define XCD_GROUP (VBID & 7)
#define XCD_LB (VBID >> 3)
#define XCD_NB ((VGRID + 7 - (VBID & 7)) >> 3)

struct EpiInproj {
  static constexpr bool PERM = true, AFTER_DRAIN = false;
  const float* rope; bf16_t* Q; bf16_t* K; bf16_t* V; bf16_t* FE;
  __device__ __forceinline__ void operator()(const pg8::f32x4 (&acc)[2][2][4][2], const pg8::Unit& u, int wr, int wc, int fr, int fq) const {
#pragma unroll
    for (int bj = 0; bj < 2; ++bj) {
      const int s0 = u.pn * 256 + bj * 128 + wc * 32 + 8 * fq;
      const int hb = s0 & ~63, f0 = ((s0 & 63) >> 3) << 2;
      if (hb + f0 >= INW) continue;
#pragma unroll
      for (int ai = 0; ai < 2; ++ai)
#pragma unroll
        for (int m = 0; m < 4; ++m) {
          const int t = u.pm * 256 + ai * 128 + wr * 64 + m * 16 + fr;
          const pg8::f32x4 v0 = acc[ai][bj][m][0], v1 = acc[ai][bj][m][1];
          if (hb < 1024) {
            const int pos = t & (SEQ - 1);
            const float4 c01 = *(const float4*)(rope + (size_t)(pos * 32 + f0) * 2);
            const float4 c23 = *(const float4*)(rope + (size_t)(pos * 32 + f0) * 2 + 4);
            const float cs[4] = {c01.x, c01.z, c23.x, c23.z}, sn[4] = {c01.y, c01.w, c23.y, c23.w};
            const float sc = (hb < 512) ? 0.125f : 1.f;
            float o1[4], o2[4];
#pragma unroll
            for (int j = 0; j < 4; ++j) { o1[j] = (v0[j] * cs[j] - v1[j] * sn[j]) * sc; o2[j] = (v1[j] * cs[j] + v0[j] * sn[j]) * sc; }
            bf16_t* dst = (hb < 512) ? (Q + (size_t)t * 512 + hb + f0) : (K + (size_t)t * 512 + (hb - 512) + f0);
            *(uint2*)dst = pack4(o1[0], o1[1], o1[2], o1[3]);
            *(uint2*)(dst + 32) = pack4(o2[0], o2[1], o2[2], o2[3]);
          } else if (hb < 1536) {
            bf16_t* dst = V + (size_t)t * 512 + (hb - 1024) + f0;
            *(uint2*)dst = pack4(v0[0], v0[1], v0[2], v0[3]);
            *(uint2*)(dst + 32) = pack4(v1[0], v1[1], v1[2], v1[3]);
          } else {
            bf16_t* dst = FE + (size_t)t * FEW + (hb - 1536) + f0;
            *(uint2*)dst = pack4(v0[0], v0[1], v0[2], v0[3]);
            if (hb + f0 + 32 < INW) *(uint2*)(dst + 32) = pack4(v1[0], v1[1], v1[2], v1[3]);
          }
        }
    }
  }
};
__device__ __forceinline__ void phase_inproj(const Params& p, char* smem_all) {
  pg8::Gemm g{(const pg8::bf16_t*)(p.ws + OFF_XB), (const pg8::bf16_t*)(p.ws + OFF_WINT), T_TOK, 3584, DM};
  pg8::StaticOrder S; S.init(T_TOK, 3584, (int)gridDim.x, (int)blockIdx.x);
  EpiInproj E{(const float*)(p.ws + OFF_ROPE), (bf16_t*)(p.ws + OFF_Q), (bf16_t*)(p.ws + OFF_K), (bf16_t*)(p.ws + OFF_V), (bf16_t*)(p.ws + OFF_FEATS)};
  pg8::gemm_phase<EpiInproj, pg8::StaticOrder, true, true>((PG8_LAS unsigned char*)smem_all, g, S, E);
}

__device__ __forceinline__ void phase_prep_a(const Params& p) {
  const bf16_t* __restrict__ FE = (const bf16_t*)(p.ws + OFF_FEATS);
  const float* __restrict__ mu = p.in[2];
  bf16_t* R = (bf16_t*)(p.ws + OFF_R); bf16_t* K2 = (bf16_t*)(p.ws + OFF_K2); bf16_t* V2 = (bf16_t*)(p.ws + OFF_V2);
  bf16_t* ACT = (bf16_t*)(p.ws + OFF_ACT);
  for (size_t i = (size_t)VBID * NTHR + VTID; i < (size_t)T_TOK * 232; i += (size_t)VGRID * NTHR) {
    const int t = (int)(i / 232), ch = (int)(i - (size_t)t * 232);
    if (ch >= 228) { *(uint4*)(ACT + (size_t)t * 320 + 288 + (ch - 228) * 8) = make_uint4(0u, 0u, 0u, 0u); continue; }
    const int col = ch * 8;
    const uint4 cu = *(const uint4*)(FE + (size_t)t * FEW + col);
    uint4 pv = make_uint4(0u, 0u, 0u, 0u);
    if ((t & (SEQ - 1)) != 0) pv = *(const uint4*)(FE + (size_t)(t - 1) * FEW + col);
    const float4 m0 = *(const float4*)(mu + col), m1 = *(const float4*)(mu + col + 4);
    const unsigned cw[4] = {cu.x, cu.y, cu.z, cu.w}, pw[4] = {pv.x, pv.y, pv.z, pv.w};
    const float mm[8] = {m0.x, m0.y, m0.z, m0.w, m1.x, m1.y, m1.z, m1.w};
    float f[8];
#pragma unroll
    for (int q = 0; q < 4; ++q) {
      const float c0 = __uint_as_float(cw[q] << 16), c1 = __uint_as_float(cw[q] & 0xffff0000u);
      const float p0 = __uint_as_float(pw[q] << 16), p1 = __uint_as_float(pw[q] & 0xffff0000u);
      f[2 * q] = c0 + (p0 - c0) * mm[2 * q];
      f[2 * q + 1] = c1 + (p1 - c1) * mm[2 * q + 1];
    }
    bf16_t* dst;
    if (col < 512) dst = R + (size_t)t * 512 + col;
    else if (col < 1024) dst = K2 + (size_t)t * 512 + (col - 512);
    else if (col < 1536) dst = V2 + (size_t)t * 512 + (col - 1024);
    else {
      dst = ACT + (size_t)t * 320 + (col - 1536);
      if (col < 1600) {
#pragma unroll
        for (int q = 0; q < 8; ++q) f[q] = fast_tanh(f[q]);
      } else if (col >= 1664) {
#pragma unroll
        for (int q = 0; q < 8; ++q) f[q] = sigmoidf_(f[q]);
      }
    }
    uint4 w; w.x = cvtpk(f[0], f[1]); w.y = cvtpk(f[2], f[3]); w.z = cvtpk(f[4], f[5]); w.w = cvtpk(f[6], f[7]);
    *(uint4*)dst = w;
  }
}

template <int PASS>
__device__ __forceinline__ void prep_item(const Params& p, char* smem, const int row0, const int col0) {
  const bf16_t* __restrict__ ACT = (const bf16_t*)(p.ws + OFF_ACT);
  constexpr int ACOL = PASS * 64;
  constexpr int NK = (PASS == 2) ? 3 : 1;
  const float* __restrict__ Wm = (PASS == 0) ? p.in[4] : (PASS == 1) ? p.in[6] : p.in[7];
  f32x4 acc[4][4];
  acc_zero(acc);
  gemm128_acc<0, (PASS == 2)>(acc, smem, NK,
      [=](int, int rowl, int kc) { return *(const uint4*)(ACT + (size_t)(row0 + rowl) * 320 + ACOL + kc * 8); },
      [=](int nq) { return Wm + col0 + nq * 4; }, 512, 160);
  int tid_l_ = VTID; asm volatile("" : "+v"(tid_l_)); const int tid = tid_l_, lane = tid & 63, wid = tid >> 6;
  const int wr = wid >> 1, wc = wid & 1, fr = lane & 15, fq = lane >> 4;
  const int cb = col0 + wc * 64;
  if (PASS == 0) {
    const float* __restrict__ w0 = p.in[3];
    float* W = (float*)(p.ws + OFF_W);
#pragma unroll
    for (int n = 0; n < 4; ++n) {
      const int c = cb + n * 16 + fq * 4;
      const float4 w04 = *(const float4*)(w0 + c);
      const float w0c[4] = {w04.x, w04.y, w04.z, w04.w};
#pragma unroll
      for (int m = 0; m < 4; ++m) {
        const int t = row0 + wr * 64 + m * 16 + fr;
        float d[4];
#pragma unroll
        for (int j = 0; j < 4; ++j) {
          const float nz = -(w0c[j] + acc[m][n][j]);
          const float sp = fmaxf(nz, 0.f) + __logf(1.f + __expf(-fabsf(nz)));
          d[j] = __expf(-__expf(-sp - 0.5f));
        }
        *(float4*)(W + (size_t)t * 512 + c) = make_float4(d[0], d[1], d[2], d[3]);
      }
    }
  } else if (PASS == 2) {
    bf16_t* G = (bf16_t*)(p.ws + OFF_G);
#pragma unroll
    for (int m = 0; m < 4; ++m) {
      const int t = row0 + wr * 64 + m * 16 + fr;
#pragma unroll
      for (int n = 0; n < 4; ++n)
        *(uint2*)(G + (size_t)t * 512 + cb + n * 16 + fq * 4) = pack4(acc[m][n][0], acc[m][n][1], acc[m][n][2], acc[m][n][3]);
    }
  } else {
    const float* __restrict__ a0 = p.in[5]; const float* __restrict__ k_k = p.in[8]; const float* __restrict__ k_a = p.in[9];
    const float* __restrict__ r_k = p.in[10];
    const bf16_t* __restrict__ R = (const bf16_t*)(p.ws + OFF_R); bf16_t* K2 = (bf16_t*)(p.ws + OFF_K2);
    bf16_t* A = (bf16_t*)(p.ws + OFF_A); bf16_t* B = (bf16_t*)(p.ws + OFF_B); float* SB = (float*)(p.ws + OFF_SB);
#pragma unroll
    for (int m = 0; m < 4; ++m) {
      __builtin_amdgcn_sched_barrier(0);
      const int t = row0 + wr * 64 + m * 16 + fr;
      float kk[4][4];
      float ssp = 0.f, sbp = 0.f;
#pragma unroll
      for (int n = 0; n < 4; ++n) {
        const int c = cb + n * 16 + fq * 4;
        const size_t o = (size_t)t * 512 + c;
        const float4 rr4 = bf4_to_f4(*(const uint2*)(R + o)), kx4 = bf4_to_f4(*(const uint2*)(K2 + o));
        const float rr[4] = {rr4.x, rr4.y, rr4.z, rr4.w}, kx[4] = {kx4.x, kx4.y, kx4.z, kx4.w};
        const float4 a04 = *(const float4*)(a0 + c), kk4 = *(const float4*)(k_k + c), ka4 = *(const float4*)(k_a + c), rk4 = *(const float4*)(r_k + c);
        const float a0c[4] = {a04.x, a04.y, a04.z, a04.w}, kkc[4] = {kk4.x, kk4.y, kk4.z, kk4.w}, kac[4] = {ka4.x, ka4.y, ka4.z, ka4.w};
        const float rkc[4] = {rk4.x, rk4.y, rk4.z, rk4.w};
        float k2[4];
#pragma unroll
        for (int j = 0; j < 4; ++j) {
          const float av = sigmoidf_(a0c[j] + acc[m][n][j]);
          acc[m][n][j] = av;
          kk[n][j] = kx[j] * kkc[j];
          k2[j] = kx[j] * (1.f + (av - 1.f) * kac[j]);
          ssp += kk[n][j] * kk[n][j];
          sbp += rr[j] * k2[j] * rkc[j];
        }
        *(uint2*)(K2 + o) = pack4(k2[0], k2[1], k2[2], k2[3]);
      }
      ssp += __shfl_xor(ssp, 16, 64); ssp += __shfl_xor(ssp, 32, 64);
      sbp += __shfl_xor(sbp, 16, 64); sbp += __shfl_xor(sbp, 32, 64);
      const float inv = 1.f / fmaxf(sqrtf(ssp), 1e-12f);
#pragma unroll
      for (int n = 0; n < 4; ++n) {
        const size_t o = (size_t)t * 512 + cb + n * 16 + fq * 4;
        *(uint2*)(A + o) = pack4(-kk[n][0] * inv, -kk[n][1] * inv, -kk[n][2] * inv, -kk[n][3] * inv);
        *(uint2*)(B + o) = pack4(kk[n][0] * inv * acc[m][n][0], kk[n][1] * inv * acc[m][n][1], kk[n][2] * inv * acc[m][n][2], kk[n][3] * inv * acc[m][n][3]);
      }
      if (fq == 0) SB[(size_t)t * 8 + (cb >> 6)] = sbp;
    }
  }
}
__device__ __forceinline__ void phase_prep(const Params& p, char* smem) {
  for (int item = VBID; item < (T_TOK / 128) * 12; item += VGRID) {
    const int pass = item >> 10, mt = (item & 1023) >> 2, nt = item & 3;
    if (pass == 0) prep_item<0>(p, smem, mt * 128, nt * 128);
    else if (pass == 1) prep_item<1>(p, smem, mt * 128, nt * 128);
    else prep_item<2>(p, smem, mt * 128, nt * 128);
  }
}

__device__ __forceinline__ float dpp_sum16(float v) {
  v += __builtin_bit_cast(float, __builtin_amdgcn_update_dpp(0, __builtin_bit_cast(int, v), 0xB1, 0xF, 0xF, true));
  v += __builtin_bit_cast(float, __builtin_amdgcn_update_dpp(0, __builtin_bit_cast(int, v), 0x4E, 0xF, 0xF, true));
  v += __builtin_bit_cast(float, __builtin_amdgcn_update_dpp(0, __builtin_bit_cast(int, v), 0x141, 0xF, 0xF, true));
  v += __builtin_bit_cast(float, __builtin_amdgcn_update_dpp(0, __builtin_bit_cast(int, v), 0x140, 0xF, 0xF, true));
  return v;
}
#define SC_CH 16
#define SC_ARR (SC_CH * 64 * 4)
#define SC_BUF (5 * SC_ARR + SC_CH * 16 * 4)
__device__ __forceinline__ void phase_scan(const Params& p, char* smem) {
  if (VBID >= 256) return;
  const bf16_t* __restrict__ R = (const bf16_t*)(p.ws + OFF_R); const bf16_t* __restrict__ K2 = (const bf16_t*)(p.ws + OFF_K2);
  const bf16_t* __restrict__ V2 = (const bf16_t*)(p.ws + OFF_V2); const bf16_t* __restrict__ A = (const bf16_t*)(p.ws + OFF_A);
  const bf16_t* __restrict__ B = (const bf16_t*)(p.ws + OFF_B); const float* __restrict__ W = (const float*)(p.ws + OFF_W);
  float* YS = (float*)(p.ws + OFF_YS);
  const int bh = VBID >> 2, rg = VBID & 3, b = bh >> 3, h = bh & 7;
  int tid_l_ = VTID; asm volatile("" : "+v"(tid_l_)); const int tid = tid_l_, lane = tid & 63, wid = tid >> 6, j = lane & 15, rq = lane >> 4;
  const int rowl = wid * 4 + rq;
  const int ls = tid >> 4, lc = tid & 15;
  const int vs = (tid >> 2) & 15, vq = tid & 3;
  const size_t tb = (size_t)b * SEQ;
  const size_t goff = (tb + ls) * 512 + h * 64 + lc * 4;
  const size_t voff = (tb + vs) * 512 + h * 64 + rg * 16 + vq * 4;
  uint2 ga, gb, gk, gr, gv; float4 gw;
  gv = make_uint2(0u, 0u);
  ga = *(const uint2*)(A + goff); gb = *(const uint2*)(B + goff); gk = *(const uint2*)(K2 + goff); gr = *(const uint2*)(R + goff);
  gw = *(const float4*)(W + goff);
  if (tid < 64) gv = *(const uint2*)(V2 + voff);
  {
    char* bf = smem;
    *(float4*)(bf + 0 * SC_ARR + ls * 256 + lc * 16) = bf4_to_f4(ga);
    *(float4*)(bf + 1 * SC_ARR + ls * 256 + lc * 16) = gw;
    *(float4*)(bf + 2 * SC_ARR + ls * 256 + lc * 16) = bf4_to_f4(gb);
    *(float4*)(bf + 3 * SC_ARR + ls * 256 + lc * 16) = bf4_to_f4(gk);
    *(float4*)(bf + 4 * SC_ARR + ls * 256 + lc * 16) = bf4_to_f4(gr);
    if (tid < 64) *(float4*)(bf + 5 * SC_ARR + vs * 64 + vq * 16) = bf4_to_f4(gv);
  }
  __syncthreads();
  float s0 = 0.f, s1 = 0.f, s2 = 0.f, s3 = 0.f;
  const int NCH = SEQ / SC_CH;
  for (int c = 0; c < NCH; ++c) {
    if (c + 1 < NCH) {
      const size_t o2 = goff + (size_t)(c + 1) * SC_CH * 512;
      ga = *(const uint2*)(A + o2); gb = *(const uint2*)(B + o2); gk = *(const uint2*)(K2 + o2); gr = *(const uint2*)(R + o2);
      gw = *(const float4*)(W + o2);
      if (tid < 64) gv = *(const uint2*)(V2 + voff + (size_t)(c + 1) * SC_CH * 512);
    }
    const char* bf = smem + (c & 1) * SC_BUF;
    float ykeep = 0.f;
#pragma unroll
    for (int s = 0; s < SC_CH; ++s) {
      const float4 a4 = *(const float4*)(bf + 0 * SC_ARR + s * 256 + j * 16);
      const float4 w4 = *(const float4*)(bf + 1 * SC_ARR + s * 256 + j * 16);
      const float4 b4 = *(const float4*)(bf + 2 * SC_ARR + s * 256 + j * 16);
      const float4 k4 = *(const float4*)(bf + 3 * SC_ARR + s * 256 + j * 16);
      const float4 r4 = *(const float4*)(bf + 4 * SC_ARR + s * 256 + j * 16);
      const float vv = *(const float*)(bf + 5 * SC_ARR + s * 64 + rowl * 4);
      float sa = (s0 * a4.x + s1 * a4.y) + (s2 * a4.z + s3 * a4.w);
      sa = dpp_sum16(sa);
      s0 = s0 * w4.x + (sa * b4.x + vv * k4.x);
      s1 = s1 * w4.y + (sa * b4.y + vv * k4.y);
      s2 = s2 * w4.z + (sa * b4.z + vv * k4.z);
      s3 = s3 * w4.w + (sa * b4.w + vv * k4.w);
      float y = (s0 * r4.x + s1 * r4.y) + (s2 * r4.z + s3 * r4.w);
      y = dpp_sum16(y);
      ykeep = (j == s) ? y : ykeep;
    }
    YS[(tb + (size_t)c * SC_CH + j) * 512 + h * 64 + rg * 16 + rowl] = ykeep;
    if (c + 1 < NCH) {
      char* bn = smem + ((c + 1) & 1) * SC_BUF;
      *(float4*)(bn + 0 * SC_ARR + ls * 256 + lc * 16) = bf4_to_f4(ga);
      *(float4*)(bn + 1 * SC_ARR + ls * 256 + lc * 16) = gw;
      *(float4*)(bn + 2 * SC_ARR + ls * 256 + lc * 16) = bf4_to_f4(gb);
      *(float4*)(bn + 3 * SC_ARR + ls * 256 + lc * 16) = bf4_to_f4(gk);
      *(float4*)(bn + 4 * SC_ARR + ls * 256 + lc * 16) = bf4_to_f4(gr);
      if (tid < 64) *(float4*)(bn + 5 * SC_ARR + vs * 64 + vq * 16) = bf4_to_f4(gv);
    }
    __syncthreads();
  }
}


#define CONV_TILES (257 * 96)
struct ConvDesc { const float* src; bf16_t* dst; int ldn, k0, n0, kdim, part; };
__device__ __forceinline__ ConvDesc conv_desc(const Params& p, const int ti) {
  ConvDesc d;
  const int e = ti / 96, q = ti - e * 96, part = q >> 5, w = q & 31;
  d.part = part;
  if (part < 2) {
    d.src = (e < NEXP) ? p.in[18 + part] + (size_t)e * DM * 256 : p.in[21 + part];
    d.ldn = 256; d.k0 = (w >> 1) * 64; d.n0 = (w & 1) * 128; d.kdim = 1024;
    d.dst = (bf16_t*)(p.ws + OFF_EW1) + (size_t)e * 512 * 1024;
  } else {
    d.src = (e < NEXP) ? p.in[20] + (size_t)e * 256 * DM : p.in[23];
    d.ldn = 1024; d.k0 = (w >> 3) * 64; d.n0 = (w & 7) * 128; d.kdim = 256;
    d.dst = (bf16_t*)(p.ws + OFF_EW2) + (size_t)e * 1024 * 256;
  }
  return d;
}
#define CV_LOAD(d, r) { \
    const float* bp_ = (d).src + (size_t)((d).k0 + ko * 8) * (d).ldn + (d).n0 + nq * 4; \
    r##0 = *(const float4*)(bp_); r##1 = *(const float4*)(bp_ + (size_t)1 * (d).ldn); r##2 = *(const float4*)(bp_ + (size_t)2 * (d).ldn); \
    r##3 = *(const float4*)(bp_ + (size_t)3 * (d).ldn); r##4 = *(const float4*)(bp_ + (size_t)4 * (d).ldn); r##5 = *(const float4*)(bp_ + (size_t)5 * (d).ldn); \
    r##6 = *(const float4*)(bp_ + (size_t)6 * (d).ldn); r##7 = *(const float4*)(bp_ + (size_t)7 * (d).ldn); }
#define CV_LDS(r, base) { \
    uint4 v; \
    v.x = cvtpk((r##0).x, (r##1).x); v.y = cvtpk((r##2).x, (r##3).x); v.z = cvtpk((r##4).x, (r##5).x); v.w = cvtpk((r##6).x, (r##7).x); *(uint4*)((base) + lds_off(nq * 4 + 0, ko)) = v; \
    v.x = cvtpk((r##0).y, (r##1).y); v.y = cvtpk((r##2).y, (r##3).y); v.z = cvtpk((r##4).y, (r##5).y); v.w = cvtpk((r##6).y, (r##7).y); *(uint4*)((base) + lds_off(nq * 4 + 1, ko)) = v; \
    v.x = cvtpk((r##0).z, (r##1).z); v.y = cvtpk((r##2).z, (r##3).z); v.z = cvtpk((r##4).z, (r##5).z); v.w = cvtpk((r##6).z, (r##7).z); *(uint4*)((base) + lds_off(nq * 4 + 2, ko)) = v; \
    v.x = cvtpk((r##0).w, (r##1).w); v.y = cvtpk((r##2).w, (r##3).w); v.z = cvtpk((r##4).w, (r##5).w); v.w = cvtpk((r##6).w, (r##7).w); *(uint4*)((base) + lds_off(nq * 4 + 3, ko)) = v; }
#define CV_OUT(d, base) { \
    _Pragma("unroll") for (int u = 0; u < 4; ++u) { \
      const int row = (tid >> 3) + 32 * u, chunk = tid & 7; \
      const int c = (d).n0 + row; \
      const int orow = ((d).part < 2) ? ((c >> 7) * 256 + (d).part * 128 + (c & 127)) : c;     \
      *(uint4*)((d).dst + (size_t)orow * (d).kdim + (d).k0 + chunk * 8) = *(const uint4*)((base) + lds_off(row, chunk)); } }
__device__ __forceinline__ void convert_tile2(const Params& p, char* smem, const int t2) {
  int tid_l_ = VTID; asm volatile("" : "+v"(tid_l_)); const int tid = tid_l_, nq = tid & 31, ko = tid >> 5;
  const ConvDesc da = conv_desc(p, 2 * t2), db = conv_desc(p, 2 * t2 + 1);
  float4 ra0, ra1, ra2, ra3, ra4, ra5, ra6, ra7, rb0, rb1, rb2, rb3, rb4, rb5, rb6, rb7;
  CV_LOAD(da, ra)
  CV_LOAD(db, rb)
  CV_LDS(ra, smem)
  CV_LDS(rb, smem + 16384)
  __syncthreads();
  CV_OUT(da, smem)
  CV_OUT(db, smem + 16384)
  __syncthreads();
}
#undef CV_LOAD
#undef CV_LDS
#undef CV_OUT

__device__ __forceinline__ int vt_off(int d, int key) { const int swz = ((d >> 2) & 15) ^ ((d & 3) << 3); return d * 512 + (((key >> 2) ^ swz) << 3); }
__device__ __forceinline__ void attn_item(const Params& p, char* smem, const int item) {
  const bf16_t* __restrict__ Q = (const bf16_t*)(p.ws + OFF_Q); const bf16_t* __restrict__ K = (const bf16_t*)(p.ws + OFF_K);
  const bf16_t* __restrict__ V = (const bf16_t*)(p.ws + OFF_V);
  bf16_t* OP = (bf16_t*)(p.ws + OFF_OP); float* LSE = (float*)(p.ws + OFF_LSE);
  char* Ks = smem; char* VT = smem + 32768; float* linv_s = (float*)(smem + 65536);
  int tid_l_ = VTID; asm volatile("" : "+v"(tid_l_)); const int tid = tid_l_, lane = tid & 63, wid = tid >> 6, l31 = lane & 31, hi = lane >> 5;
  {
    const int pp = item >> 11, rem = item & 2047, bh = rem >> 5, sub = rem & 31;
    const int dsh = pp * 2, nbsh = 5 - dsh;
    const int r = sub >> nbsh, n = sub & ((1 << nbsh) - 1);
    const int b = bh >> 3, h = bh & 7, tb = b * SEQ;
    __syncthreads();
#pragma unroll
    for (int u = 0; u < 8; ++u) {
      if (u == 4) __builtin_amdgcn_sched_barrier(0);
      const int row = (tid >> 3) + 32 * u, chunk = tid & 7;
      int ik = n * 128 - 128 + row; ik = ik < 0 ? 0 : ik;
      const int tok = tb + (ik << dsh) + r;
      *(uint4*)(Ks + lds_off(row, chunk)) = *(const uint4*)(K + (size_t)tok * 512 + h * 64 + chunk * 8);
    }
#pragma unroll
    for (int ps = 0; ps < 2; ++ps) {
      const int dq = tid & 15, kbase = ps * 128 + (tid >> 4) * 8;
      uint2 v0, v1, v2, v3, v4, v5, v6, v7;
#define LDV(i, dst) { int ik = n * 128 - 128 + kbase + i; ik = ik < 0 ? 0 : ik; const int tok = tb + (ik << dsh) + r; dst = *(const uint2*)(V + (size_t)tok * 512 + h * 64 + dq * 4); }
      LDV(0, v0) LDV(1, v1) LDV(2, v2) LDV(3, v3) LDV(4, v4) LDV(5, v5) LDV(6, v6) LDV(7, v7)
#undef LDV
      {
        uint2 w;
        w.x = (v0.x & 0xffffu) | (v1.x << 16); w.y = (v2.x & 0xffffu) | (v3.x << 16);
        *(uint2*)(VT + vt_off(dq * 4 + 0, kbase)) = w;
        w.x = (v4.x & 0xffffu) | (v5.x << 16); w.y = (v6.x & 0xffffu) | (v7.x << 16);
        *(uint2*)(VT + vt_off(dq * 4 + 0, kbase + 4)) = w;
        w.x = (v0.x >> 16) | (v1.x & 0xffff0000u); w.y = (v2.x >> 16) | (v3.x & 0xffff0000u);
        *(uint2*)(VT + vt_off(dq * 4 + 1, kbase)) = w;
        w.x = (v4.x >> 16) | (v5.x & 0xffff0000u); w.y = (v6.x >> 16) | (v7.x & 0xffff0000u);
        *(uint2*)(VT + vt_off(dq * 4 + 1, kbase + 4)) = w;
        w.x = (v0.y & 0xffffu) | (v1.y << 16); w.y = (v2.y & 0xffffu) | (v3.y << 16);
        *(uint2*)(VT + vt_off(dq * 4 + 2, kbase)) = w;
        w.x = (v4.y & 0xffffu) | (v5.y << 16); w.y = (v6.y & 0xffffu) | (v7.y << 16);
        *(uint2*)(VT + vt_off(dq * 4 + 2, kbase + 4)) = w;
        w.x = (v0.y >> 16) | (v1.y & 0xffff0000u); w.y = (v2.y >> 16) | (v3.y & 0xffff0000u);
        *(uint2*)(VT + vt_off(dq * 4 + 3, kbase)) = w;
        w.x = (v4.y >> 16) | (v5.y & 0xffff0000u); w.y = (v6.y >> 16) | (v7.y & 0xffff0000u);
        *(uint2*)(VT + vt_off(dq * 4 + 3, kbase + 4)) = w;
      }
    }
    __syncthreads();
    const int iq = n * 128 + wid * 32 + l31;
    const int tq = tb + (iq << dsh) + r;
    bf16x8 qf[4];
#pragma unroll
    for (int ks = 0; ks < 4; ++ks) qf[ks] = *(const bf16x8*)(Q + (size_t)tq * 512 + h * 64 + ks * 16 + hi * 8);
    f32x16 st[5];
#pragma unroll
    for (int kb = 0; kb < 5; ++kb) {
      st[kb] = (f32x16){0.f, 0.f, 0.f, 0.f, 0.f, 0.f, 0.f, 0.f, 0.f, 0.f, 0.f, 0.f, 0.f, 0.f, 0.f, 0.f};
#pragma unroll
      for (int ks = 0; ks < 4; ++ks) {
        const bf16x8 kf = *(const bf16x8*)(Ks + lds_off(32 * (wid + kb) + l31, 2 * ks + hi));
        st[kb] = __builtin_amdgcn_mfma_f32_32x32x16_bf16(kf, qf[ks], st[kb], 0, 0, 0);
      }
    }
    float m = -INFINITY;
#pragma unroll
    for (int kb = 0; kb < 5; ++kb)
#pragma unroll
      for (int i = 0; i < 16; ++i) {
        const int kirel = 32 * kb + (i & 3) + 8 * (i >> 2) + 4 * hi;
        const bool valid = (kirel >= l31) && (kirel <= l31 + 128) && (n > 0 || (32 * wid + kirel) >= 128);
        const float s = valid ? st[kb][i] : -INFINITY;
        st[kb][i] = s;
        m = fmaxf(m, s);
      }
    m = fmaxf(m, __shfl_xor(m, 32, 64));
    float l = 0.f;
#pragma unroll
    for (int kb = 0; kb < 5; ++kb)
#pragma unroll
      for (int i = 0; i < 16; ++i) { const float pe = __expf(st[kb][i] - m); st[kb][i] = pe; l += pe; }
    l += __shfl_xor(l, 32, 64);
    f32x16 o0 = (f32x16){0.f, 0.f, 0.f, 0.f, 0.f, 0.f, 0.f, 0.f, 0.f, 0.f, 0.f, 0.f, 0.f, 0.f, 0.f, 0.f};
    f32x16 o1 = o0;
#pragma unroll
    for (int kb = 0; kb < 5; ++kb)
#pragma unroll
      for (int s = 0; s < 2; ++s) {
        union { unsigned u[4]; bf16x8 v; } pa;
        pa.u[0] = cvtpk(st[kb][8 * s + 0], st[kb][8 * s + 1]); pa.u[1] = cvtpk(st[kb][8 * s + 2], st[kb][8 * s + 3]);
        pa.u[2] = cvtpk(st[kb][8 * s + 4], st[kb][8 * s + 5]); pa.u[3] = cvtpk(st[kb][8 * s + 6], st[kb][8 * s + 7]);
        const int key0 = 32 * (wid + kb) + 16 * s + 4 * hi;
        {
          union { uint2 u[2]; bf16x8 v; } vb;
          vb.u[0] = *(const uint2*)(VT + vt_off(l31, key0)); vb.u[1] = *(const uint2*)(VT + vt_off(l31, key0 + 8));
          o0 = __builtin_amdgcn_mfma_f32_32x32x16_bf16(pa.v, vb.v, o0, 0, 0, 0);
        }
        {
          union { uint2 u[2]; bf16x8 v; } vb;
          vb.u[0] = *(const uint2*)(VT + vt_off(32 + l31, key0)); vb.u[1] = *(const uint2*)(VT + vt_off(32 + l31, key0 + 8));
          o1 = __builtin_amdgcn_mfma_f32_32x32x16_bf16(pa.v, vb.v, o1, 0, 0, 0);
        }
      }
    if (hi == 0) {
      linv_s[wid * 32 + l31] = 1.f / l;
      LSE[((size_t)pp * T_TOK + tq) * 8 + h] = m + __logf(l);
    }
#pragma unroll
    for (int i = 0; i < 16; ++i) {
      const int qrel = (i & 3) + 8 * (i >> 2) + 4 * hi;
      const int iq2 = n * 128 + wid * 32 + qrel;
      const int tq2 = tb + (iq2 << dsh) + r;
      const float li = linv_s[wid * 32 + qrel];
      bf16_t* op = OP + ((size_t)pp * T_TOK + tq2) * 512 + h * 64 + l31;
      op[0] = f2bf(o0[i] * li);
      op[32] = f2bf(o1[i] * li);
    }
  }
}

__device__ __forceinline__ void phase_convert(const Params& p, char* smem, int* slot) {
  int* ctl = (int*)(p.ws + OFF_CTL);
  const int half = VHALF;
  __syncthreads();
  int tk;
  for (;;) {
    if (threadIdx.x == 0) *slot = atomicAdd(&ctl[CTL_CONVQ], 1);
    __syncthreads();
    tk = *slot;
    __syncthreads();
    if (tk >= 3072) break;
    attn_item(p, smem, 2 * tk + half);
  }
  __builtin_amdgcn_sched_barrier(0);
  for (;;) {
    if (tk >= 3072 + CONV_TILES / 4) break;
    convert_tile2(p, smem, 2 * (tk - 3072) + half);
    if (threadIdx.x == 0) *slot = atomicAdd(&ctl[CTL_CONVQ], 1);
    __syncthreads();
    tk = *slot;
    __syncthreads();
  }
}

__device__ __forceinline__ void unpack8(const uint4 u, float (&f)[8]) {
  f[0] = __uint_as_float(u.x << 16); f[1] = __uint_as_float(u.x & 0xffff0000u); f[2] = __uint_as_float(u.y << 16); f[3] = __uint_as_float(u.y & 0xffff0000u);
  f[4] = __uint_as_float(u.z << 16); f[5] = __uint_as_float(u.z & 0xffff0000u); f[6] = __uint_as_float(u.w << 16); f[7] = __uint_as_float(u.w & 0xffff0000u);
}
__device__ __forceinline__ float dpp_sum8(float v) {
  v += DPP_F(v, 0xB1); v += DPP_F(v, 0x4E); v += DPP_F(v, 0x141);
  return v;
}
__device__ __forceinline__ void phase_post(const Params& p) {
  const float* __restrict__ YS = (const float*)(p.ws + OFF_YS); const bf16_t* __restrict__ V2 = (const bf16_t*)(p.ws + OFF_V2);
  const bf16_t* __restrict__ G = (const bf16_t*)(p.ws + OFF_G); const float* __restrict__ SB = (const float*)(p.ws + OFF_SB);
  const bf16_t* __restrict__ OP = (const bf16_t*)(p.ws + OFF_OP); const float* __restrict__ LSE = (const float*)(p.ws + OFF_LSE);
  const float* __restrict__ lnx_g = p.in[11]; const float* __restrict__ lnx_b = p.in[12];
  bf16_t* MIXED = (bf16_t*)(p.ws + OFF_MIXED);
  const int lane = VTID & 63, wid = VTID >> 6;
  const int c = lane * 8, hh = lane >> 3;
  const float4 g0 = *(const float4*)(lnx_g + c), g1 = *(const float4*)(lnx_g + c + 4), b0 = *(const float4*)(lnx_b + c), b1 = *(const float4*)(lnx_b + c + 4);
  const float gg[8] = {g0.x, g0.y, g0.z, g0.w, g1.x, g1.y, g1.z, g1.w}, bb[8] = {b0.x, b0.y, b0.z, b0.w, b1.x, b1.y, b1.z, b1.w};
  for (int t = VBID * 4 + wid; t < T_TOK; t += VGRID * 4) {
    const size_t o = (size_t)t * 512 + c;
    const float4 y0 = *(const float4*)(YS + o), y1 = *(const float4*)(YS + o + 4);
    const float y[8] = {y0.x, y0.y, y0.z, y0.w, y1.x, y1.y, y1.z, y1.w};
    float s = 0.f;
#pragma unroll
    for (int i = 0; i < 8; ++i) s += y[i];
    const float mean = dpp_sum8(s) * (1.f / 64.f);
    float q = 0.f;
#pragma unroll
    for (int i = 0; i < 8; ++i) { const float d = y[i] - mean; q += d * d; }
    const float rs = rsqrtf(dpp_sum8(q) * (1.f / 64.f) + GN_EPS_F);
    float v2[8], gt[8];
    unpack8(*(const uint4*)(V2 + o), v2); unpack8(*(const uint4*)(G + o), gt);
    const float sb = SB[(size_t)t * 8 + hh];
    float res[8];
#pragma unroll
    for (int i = 0; i < 8; ++i) res[i] = ((y[i] - mean) * rs * gg[i] + bb[i] + sb * v2[i]) * gt[i];
    uint4 w; w.x = cvtpk(res[0], res[1]); w.y = cvtpk(res[2], res[3]); w.z = cvtpk(res[4], res[5]); w.w = cvtpk(res[6], res[7]);
    *(uint4*)(MIXED + (size_t)t * 1024 + 512 + c) = w;
    const float l0 = LSE[((size_t)0 * T_TOK + t) * 8 + hh], l1 = LSE[((size_t)1 * T_TOK + t) * 8 + hh], l2 = LSE[((size_t)2 * T_TOK + t) * 8 + hh];
    const float mx = fmaxf(l0, fmaxf(l1, l2));
    float e0 = __expf(l0 - mx), e1 = __expf(l1 - mx), e2 = __expf(l2 - mx);
    const float inv = 1.f / (e0 + e1 + e2);
    e0 *= inv; e1 *= inv; e2 *= inv;
    float o0[8], o1[8], o2[8];
    unpack8(*(const uint4*)(OP + (size_t)0 * T_TOK * 512 + o), o0); unpack8(*(const uint4*)(OP + (size_t)1 * T_TOK * 512 + o), o1);
    unpack8(*(const uint4*)(OP + (size_t)2 * T_TOK * 512 + o), o2);
    float av[8];
#pragma unroll
    for (int i = 0; i < 8; ++i) av[i] = e0 * o0[i] + e1 * o1[i] + e2 * o2[i];
    w.x = cvtpk(av[0], av[1]); w.y = cvtpk(av[2], av[3]); w.z = cvtpk(av[4], av[5]); w.w = cvtpk(av[6], av[7]);
    *(uint4*)(MIXED + (size_t)t * 1024 + c) = w;
  }
}

struct EpiOutproj {
  static constexpr bool PERM = true, AFTER_DRAIN = false;
  const float* x; float* U;
  __device__ __forceinline__ void operator()(const pg8::f32x4 (&acc)[2][2][4][2], const pg8::Unit& u, int wr, int wc, int fr, int fq) const {
#pragma unroll
    for (int ai = 0; ai < 2; ++ai)
#pragma unroll
      for (int m = 0; m < 4; ++m) {
        const int t = u.pm * 256 + ai * 128 + wr * 64 + m * 16 + fr;
#pragma unroll
        for (int bj = 0; bj < 2; ++bj) {
          const size_t o = (size_t)t * DM + u.pn * 256 + bj * 128 + wc * 32 + 8 * fq;
          const float4 x0 = *(const float4*)(x + o), x1 = *(const float4*)(x + o + 4);
          const pg8::f32x4 v0 = acc[ai][bj][m][0], v1 = acc[ai][bj][m][1];
          *(float4*)(U + o) = make_float4(ALPHA_F * x0.x + v0[0], ALPHA_F * x0.y + v0[1], ALPHA_F * x0.z + v0[2], ALPHA_F * x0.w + v0[3]);
          *(float4*)(U + o + 4) = make_float4(ALPHA_F * x1.x + v1[0], ALPHA_F * x1.y + v1[1], ALPHA_F * x1.z + v1[2], ALPHA_F * x1.w + v1[3]);
        }
      }
  }
};
__device__ __forceinline__ void phase_outproj(const Params& p, char* smem_all) {
  pg8::Gemm g{(const pg8::bf16_t*)(p.ws + OFF_MIXED), (const pg8::bf16_t*)(p.ws + OFF_WOUTT), T_TOK, DM, DM};
  pg8::StaticOrder S; S.init(T_TOK, DM, (int)gridDim.x, (int)blockIdx.x);
  EpiOutproj E{p.in[0], p.out};
  pg8::gemm_phase<EpiOutproj, pg8::StaticOrder, true, true>((PG8_LAS unsigned char*)smem_all, g, S, E);
}

__device__ __forceinline__ void phase_ln1(const Params& p) {
  float* X1 = p.out;
  const float* __restrict__ g1 = p.in[14]; const float* __restrict__ b1 = p.in[15];
  bf16_t* X1B = (bf16_t*)(p.ws + OFF_X1B);
  const int lane = VTID & 63, wid = VTID >> 6;
  for (int t = VBID * 4 + wid; t < T_TOK; t += VGRID * 4) {
    const size_t base = (size_t)t * DM;
    float4 v[4];
    float s = 0.f;
#pragma unroll
    for (int u = 0; u < 4; ++u) { v[u] = *(const float4*)(X1 + base + u * 256 + lane * 4); s += (v[u].x + v[u].y) + (v[u].z + v[u].w); }
    const float mean = wave_sum_fast(s) * (1.f / DM);
    float q = 0.f;
#pragma unroll
    for (int u = 0; u < 4; ++u) {
      const float d0 = v[u].x - mean, d1 = v[u].y - mean, d2 = v[u].z - mean, d3 = v[u].w - mean;
      q += (d0 * d0 + d1 * d1) + (d2 * d2 + d3 * d3);
    }
    const float rs = rsqrtf(wave_sum_fast(q) * (1.f / DM) + LN_EPS_F);
#pragma unroll
    for (int u = 0; u < 4; ++u) {
      const int c = u * 256 + lane * 4;
      const float4 g = *(const float4*)(g1 + c), bb = *(const float4*)(b1 + c);
      float4 y;
      y.x = (v[u].x - mean) * rs * g.x + bb.x; y.y = (v[u].y - mean) * rs * g.y + bb.y;
      y.z = (v[u].z - mean) * rs * g.z + bb.z; y.w = (v[u].w - mean) * rs * g.w + bb.w;
      *(float4*)(X1 + base + c) = y;
      uint2 hi; hi.x = cvtpk(y.x, y.y); hi.y = cvtpk(y.z, y.w);
      *(uint2*)(X1B + base + c) = hi;
    }
  }
}

__device__ __forceinline__ void phase_router_gemm(const Params& p, char* smem) {
  const bf16_t* __restrict__ X1B = (const bf16_t*)(p.ws + OFF_X1B);
  const float* __restrict__ router_w = p.in[16];
  float* AFF = (float*)(p.ws + OFF_AFF);
  for (int item = VBID; item < (T_TOK / 128) * 2; item += VGRID) {
    const int row0 = (item >> 1) * 128, col0 = (item & 1) * 128;
    f32x4 acc[4][4];
    acc_zero(acc);
    gemm128_acc<0, false>(acc, smem, 16,
        [=](int, int rowl, int kc) { return *(const uint4*)(X1B + (size_t)(row0 + rowl) * DM + kc * 8); },
        [=](int nq) { return router_w + col0 + nq * 4; }, NEXP, 0);
    int tid_l_ = VTID; asm volatile("" : "+v"(tid_l_)); const int tid = tid_l_, lane = tid & 63, wid = tid >> 6;
    const int wr = wid >> 1, wc = wid & 1, fr = lane & 15, fq = lane >> 4;
#pragma unroll
    for (int m = 0; m < 4; ++m) {
      const int t = row0 + wr * 64 + m * 16 + fr;
#pragma unroll
      for (int n = 0; n < 4; ++n)
        *(float4*)(AFF + (size_t)t * NEXP + col0 + wc * 64 + n * 16 + fq * 4) =
            make_float4(sigmoidf_(acc[m][n][0]), sigmoidf_(acc[m][n][1]), sigmoidf_(acc[m][n][2]), sigmoidf_(acc[m][n][3]));
    }
  }
}

__device__ __forceinline__ void phase_topk(const Params& p) {
  const float* __restrict__ AFF = (const float*)(p.ws + OFF_AFF);
  const float* __restrict__ router_bias = p.in[17];
  int* LIST = (int*)(p.ws + OFF_LIST); float* GATEW = (float*)(p.ws + OFF_GATEW);
  int* counts = (int*)(p.ws + OFF_CTL);
  const int lane = VTID & 63, wid = VTID >> 6;
  const float4 b4 = *(const float4*)(router_bias + lane * 4);
  for (int t = VBID * 4 + wid; t < T_TOK; t += VGRID * 4) {
    const float4 a4 = *(const float4*)(AFF + (size_t)t * NEXP + lane * 4);
    float s0 = a4.x + b4.x, s1 = a4.y + b4.y, s2 = a4.z + b4.z, s3 = a4.w + b4.w;
    const float hi01 = fmaxf(s0, s1), lo01 = fminf(s0, s1), hi23 = fmaxf(s2, s3), lo23 = fminf(s2, s3);
    float m1 = fmaxf(hi01, hi23), m2 = fmaxf(fminf(hi01, hi23), fmaxf(lo01, lo23));
    { const float o1 = DPP_F(m1, 0xB1), o2 = DPP_F(m2, 0xB1); const float n1 = fmaxf(m1, o1); m2 = fmaxf(fminf(m1, o1), fmaxf(m2, o2)); m1 = n1; }
    { const float o1 = DPP_F(m1, 0x4E), o2 = DPP_F(m2, 0x4E); const float n1 = fmaxf(m1, o1); m2 = fmaxf(fminf(m1, o1), fmaxf(m2, o2)); m1 = n1; }
    { const float o1 = DPP_F(m1, 0x141), o2 = DPP_F(m2, 0x141); const float n1 = fmaxf(m1, o1); m2 = fmaxf(fminf(m1, o1), fmaxf(m2, o2)); m1 = n1; }
    const float gs = m1 + m2;
    const int g = lane >> 3;
    int rank = 0;
#pragma unroll
    for (int gg = 0; gg < 8; ++gg) { const float G = rdlane_f(gs, gg * 8); rank += ((G > gs) || (G == gs && gg < g)) ? 1 : 0; }
    if (rank >= 4) { s0 = -INFINITY; s1 = -INFINITY; s2 = -INFINITY; s3 = -INFINITY; }
    int my_e = 0; float my_a = 0.f;
#pragma unroll 1
    for (int it = 0; it < 8; ++it) {
      const float lm = fmaxf(fmaxf(s0, s1), fmaxf(s2, s3));
      const float wm = wave_max_fast(lm);
      const unsigned long long bal = __ballot(lm == wm);
      const int win = __ffsll((long long)bal) - 1;
      const int wi = (s0 == wm) ? 0 : ((s1 == wm) ? 1 : ((s2 == wm) ? 2 : 3));
      const float wa = (wi == 0) ? a4.x : ((wi == 1) ? a4.y : ((wi == 2) ? a4.z : a4.w));
      const int e_w = __builtin_amdgcn_readlane(lane * 4 + wi, win);
      const float a_w = rdlane_f(wa, win);
      if (lane == win) { if (wi == 0) s0 = -INFINITY; else if (wi == 1) s1 = -INFINITY; else if (wi == 2) s2 = -INFINITY; else s3 = -INFINITY; }
      if (lane == it) { my_e = e_w; my_a = a_w; }
    }
    const float asum = rdlane_f(dpp_sum16x(my_a), 0);
    if (lane < 8) {
      const int pos = atomicAdd(&counts[my_e], 1);
      if (pos < LCAP) LIST[(size_t)my_e * LCAP + pos] = lane * T_TOK + t;
      GATEW[(size_t)lane * T_TOK + t] = my_a * 2.5f / asum;
    }
  }
}

#define CTL_MOEPRE 1536
__device__ __forceinline__ void phase_moe_prefix(const Params& p) {
  if (VBID == 0 && VTID == 0) {
    int* ctl = (int*)(p.ws + OFF_CTL);
    int acc = 0;
    for (int e = 0; e < NEXP; ++e) { ctl[CTL_MOEPRE + e] = acc; acc += (min(ctl[e], LCAP) + 255) >> 8; }
    ctl[CTL_MOEPRE + NEXP] = acc; acc += T_TOK / 256;
    ctl[CTL_MOEPRE + NEXP + 1] = acc;
  }
}
struct SeqOrder {
  int n;
  __device__ __forceinline__ bool next(int i, pg8::Unit& u) const { if (i >= n) return false; u.pm = 0; u.pn = i; return true; }
  __device__ __forceinline__ void a_ready(const pg8::Unit&) const {}
  __device__ __forceinline__ void done(const pg8::Unit&) const {}
};
struct EpiMoe1 {
  static constexpr bool PERM = true, AFTER_DRAIN = false;
  bf16_t* HS;
  __device__ __forceinline__ void operator()(const pg8::f32x4 (&acc)[2][2][4][2], const pg8::Unit& u, int wr, int wc, int fr, int fq) const {
#pragma unroll
    for (int ai = 0; ai < 2; ++ai)
#pragma unroll
      for (int m = 0; m < 4; ++m) {
        __builtin_amdgcn_sched_barrier(0);
        const int row = ai * 128 + wr * 64 + m * 16 + fr;
        const pg8::f32x4 g0 = acc[ai][0][m][0], g1 = acc[ai][0][m][1], u0 = acc[ai][1][m][0], u1 = acc[ai][1][m][1];
        uint4 w;
        w.x = cvtpk(g0[0] * sigmoidf_(g0[0]) * u0[0], g0[1] * sigmoidf_(g0[1]) * u0[1]);
        w.y = cvtpk(g0[2] * sigmoidf_(g0[2]) * u0[2], g0[3] * sigmoidf_(g0[3]) * u0[3]);
        w.z = cvtpk(g1[0] * sigmoidf_(g1[0]) * u1[0], g1[1] * sigmoidf_(g1[1]) * u1[1]);
        w.w = cvtpk(g1[2] * sigmoidf_(g1[2]) * u1[2], g1[3] * sigmoidf_(g1[3]) * u1[3]);
        *(uint4*)(HS + (size_t)row * 256 + u.pn * 128 + wc * 32 + 8 * fq) = w;
      }
  }
};
struct EpiMoe2 {
  static constexpr bool PERM = true, AFTER_DRAIN = false;
  const int* asg; const float* GATEW; bf16_t* Y; float* X1;
  __device__ __forceinline__ void operator()(const pg8::f32x4 (&acc)[2][2][4][2], const pg8::Unit& u, int wr, int wc, int fr, int fq) const {
#pragma unroll
    for (int ai = 0; ai < 2; ++ai)
#pragma unroll
      for (int m = 0; m < 4; ++m) {
        __builtin_amdgcn_sched_barrier(0);
        const int a = asg[256 + ai * 128 + wr * 64 + m * 16 + fr];
        if (a < 0) continue;
        if (a < 8 * T_TOK) {
          const float gw = GATEW[a];
#pragma unroll
          for (int bj = 0; bj < 2; ++bj) {
            const pg8::f32x4 v0 = acc[ai][bj][m][0], v1 = acc[ai][bj][m][1];
            uint4 w; w.x = cvtpk(v0[0] * gw, v0[1] * gw); w.y = cvtpk(v0[2] * gw, v0[3] * gw); w.z = cvtpk(v1[0] * gw, v1[1] * gw); w.w = cvtpk(v1[2] * gw, v1[3] * gw);
            *(uint4*)(Y + (size_t)a * DM + u.pn * 256 + bj * 128 + wc * 32 + 8 * fq) = w;
          }
        } else {
          const int t = a - 8 * T_TOK;
#pragma unroll
          for (int bj = 0; bj < 2; ++bj) {
            float* xp = X1 + (size_t)t * DM + u.pn * 256 + bj * 128 + wc * 32 + 8 * fq;
            const float4 x0 = *(const float4*)xp, x1 = *(const float4*)(xp + 4);
            const pg8::f32x4 v0 = acc[ai][bj][m][0], v1 = acc[ai][bj][m][1];
            *(float4*)xp = make_float4(ALPHA_F * x0.x + v0[0], ALPHA_F * x0.y + v0[1], ALPHA_F * x0.z + v0[2], ALPHA_F * x0.w + v0[3]);
            *(float4*)(xp + 4) = make_float4(ALPHA_F * x1.x + v1[0], ALPHA_F * x1.y + v1[1], ALPHA_F * x1.z + v1[2], ALPHA_F * x1.w + v1[3]);
          }
        }
      }
  }
};
#define MOE_TAB_OFF 131072
__device__ __forceinline__ void phase_moe(const Params& p, char* smem_all, int* slot) {
  int* tab = (int*)(smem_all + MOE_TAB_OFF);
  const int* __restrict__ LIST = (const int*)(p.ws + OFF_LIST);
  const int* counts = (const int*)(p.ws + OFF_CTL);
  const int* pre = counts + CTL_MOEPRE;
  int* ctl = (int*)(p.ws + OFF_CTL);
  bf16_t* HS = (bf16_t*)(p.ws + OFF_HSCR) + (size_t)blockIdx.x * 256 * 256;
  const int nitems = pre[NEXP + 1];
  for (;;) {
    __syncthreads();
    if (threadIdx.x == 0) *slot = atomicAdd(&ctl[CTL_CONVQ + 1], 1);
    __syncthreads();
    const int i = *slot;
    if (i >= nitems) break;
    int lo = 0, hi = NEXP;
    while (lo < hi) { const int mid = (lo + hi + 1) >> 1; if (pre[mid] <= i) lo = mid; else hi = mid - 1; }
    const int e = lo;
    const int cnt = (e < NEXP) ? min(counts[e], LCAP) : T_TOK;
    const int r0 = (i - pre[e]) * 256;
    if (threadIdx.x < 256) {
      const int r = r0 + (int)threadIdx.x;
      const int a = (r < cnt) ? ((e < NEXP) ? LIST[(size_t)e * LCAP + r] : (8 * T_TOK + r)) : -1;
      tab[256 + threadIdx.x] = a;
      tab[threadIdx.x] = (a >= 0 ? a : 0) & (T_TOK - 1);
    }
    __syncthreads();
    {
      int k1 = DM; asm volatile("" : "+s"(k1));
      pg8::Gemm g{(const pg8::bf16_t*)(p.ws + OFF_X1B), (const pg8::bf16_t*)(p.ws + OFF_EW1) + (size_t)e * 512 * 1024, 256, 512, k1};
      SeqOrder S{2};
      EpiMoe1 E{HS};
      pg8::gemm_phase<EpiMoe1, SeqOrder, false, true, true>((PG8_LAS unsigned char*)smem_all, g, S, E, tab);
    }
    __syncthreads();
    if (threadIdx.x < 256) tab[threadIdx.x] = threadIdx.x;
    __syncthreads();
    {
      int k2 = 256; asm volatile("" : "+s"(k2));
      pg8::Gemm g{(const pg8::bf16_t*)HS, (const pg8::bf16_t*)(p.ws + OFF_EW2) + (size_t)e * 1024 * 256, 256, DM, k2};
      SeqOrder S{4};
      EpiMoe2 E{tab, (const float*)(p.ws + OFF_GATEW), (bf16_t*)(p.ws + OFF_Y), p.out};
      pg8::gemm_phase<EpiMoe2, SeqOrder, false, true, true>((PG8_LAS unsigned char*)smem_all, g, S, E, tab);
    }
  }
}

__device__ __forceinline__ void phase_final(const Params& p, char* smem) {
  float* OUT = p.out;
  const bf16_t* __restrict__ Y = (const bf16_t*)(p.ws + OFF_Y);
  const float* __restrict__ g2 = p.in[24]; const float* __restrict__ b2 = p.in[25];
  const int lane = VTID & 63, wid = VTID >> 6;
  for (int t = VBID * 4 + wid; t < T_TOK; t += VGRID * 4) {
    const size_t base = (size_t)t * DM;
    float4 v[4];
    float s = 0.f;
#pragma unroll
    for (int u = 0; u < 4; ++u) {
      const int c = u * 256 + lane * 4;
      const float4 xv = *(const float4*)(OUT + base + c);
      float a0 = 0.f, a1 = 0.f, a2 = 0.f, a3 = 0.f;
#pragma unroll
      for (int sl = 0; sl < 8; ++sl) {
        const float4 yv = bf4_to_f4(*(const uint2*)(Y + ((size_t)sl * T_TOK + t) * DM + c));
        a0 += yv.x; a1 += yv.y; a2 += yv.z; a3 += yv.w;
      }
      v[u] = make_float4(xv.x + a0, xv.y + a1, xv.z + a2, xv.w + a3);
      s += (v[u].x + v[u].y) + (v[u].z + v[u].w);
    }
    const float mean = wave_sum_fast(s) * (1.f / DM);
    float q = 0.f;
#pragma unroll
    for (int u = 0; u < 4; ++u) {
      const float d0 = v[u].x - mean, d1 = v[u].y - mean, d2 = v[u].z - mean, d3 = v[u].w - mean;
      q += (d0 * d0 + d1 * d1) + (d2 * d2 + d3 * d3);
    }
    const float rs = rsqrtf(wave_sum_fast(q) * (1.f / DM) + LN_EPS_F);
#pragma unroll
    for (int u = 0; u < 4; ++u) {
      const int c = u * 256 + lane * 4;
      const float4 g = *(const float4*)(g2 + c), bb = *(const float4*)(b2 + c);
      *(float4*)(OUT + base + c) = make_float4((v[u].x - mean) * rs * g.x + bb.x, (v[u].y - mean) * rs * g.y + bb.y,
                                               (v[u].z - mean) * rs * g.z + bb.z, (v[u].w - mean) * rs * g.w + bb.w);
    }
  }
}

#define LAS __attribute__((address_space(3)))
#define XB_TMO      128
#define XB_XCNT(j)  (256  + 64 * (j))
#define XB_XSUB(j)  (1280 + 64 * (j))
#define XB_XGEN(j)  (2304 + 64 * (j))
#define XB_TOP      3328
#define XB_TOPGEN   3392
#define XCD_BAR_WORDS 3456
#define XB_SPIN_CAP (1u << 22)
__device__ __forceinline__ unsigned xb_ld(unsigned* p)              { return __hip_atomic_load(p, __ATOMIC_RELAXED, __HIP_MEMORY_SCOPE_AGENT); }
__device__ __forceinline__ unsigned xb_add(unsigned* p, unsigned v) { return __hip_atomic_fetch_add(p, v, __ATOMIC_RELAXED, __HIP_MEMORY_SCOPE_AGENT); }
__device__ __forceinline__ unsigned xb_xcc_id() { return (unsigned)__builtin_amdgcn_s_getreg((3 << 11) | 20) & 0xFu; }
#define XB_SPIN(cond, bar) do { unsigned _sp = 0; while (cond) { __builtin_amdgcn_s_sleep(1); \
    if ((++_sp & 255u) == 0u) { if (xb_ld(&(bar)[XB_TMO])) break; if (_sp > XB_SPIN_CAP) { atomicAdd(&(bar)[XB_TMO], 1u); break; } } } } while (0)
struct XcdBarrier { unsigned* bar; unsigned x; volatile LAS unsigned* st; };
__device__ __forceinline__ XcdBarrier xcd_barrier_post(unsigned* bar, volatile LAS unsigned* st) {
  XcdBarrier b; b.bar = bar; b.x = xb_xcc_id(); b.st = st;
  if (threadIdx.x == 0) (void)xb_add(&bar[XB_XCNT(b.x)], 1u);
  return b;
}
__device__ __forceinline__ void xcd_barrier_complete(unsigned* bar, unsigned x, unsigned& nloc, unsigned& nx) {
  const unsigned G = gridDim.x * gridDim.y * gridDim.z;
  unsigned sum, cnt, mine, sp = 0u;
  for (;;) {
    sum = 0u; cnt = 0u; mine = 0u;
#pragma unroll
    for (unsigned j = 0; j < 16; ++j) { const unsigned c = xb_ld(&bar[XB_XCNT(j)]); sum += c; cnt += (c > 0u) ? 1u : 0u; mine = (j == x) ? c : mine; }
    if (sum == G) break;
    __builtin_amdgcn_s_sleep(1);
    if ((++sp & 255u) == 0u) { if (xb_ld(&bar[XB_TMO])) break; if (sp > XB_SPIN_CAP) { atomicAdd(&bar[XB_TMO], 1u); break; } }
  }
  nloc = mine > 0u ? mine : 1u; nx = cnt > 0u ? cnt : 1u;
}
__device__ __forceinline__ void xcd_barrier(const XcdBarrier& b) {
  asm volatile("s_waitcnt vmcnt(0)" ::: "memory");
  __syncthreads();
  if (threadIdx.x == 0) {
    unsigned* bar = b.bar;
    __builtin_amdgcn_s_waitcnt(0);
    unsigned nloc = b.st[0], nx = b.st[1];
    if (nloc == 0u) { xcd_barrier_complete(bar, b.x, nloc, nx); b.st[0] = nloc; b.st[1] = nx; }
    const unsigned old = xb_add(&bar[XB_XSUB(b.x)], 1u);
    const unsigned gen = old / nloc;
    if (old + 1u == (gen + 1u) * nloc) {
      __builtin_amdgcn_fence(__ATOMIC_RELEASE, "agent");
      asm volatile("s_waitcnt vmcnt(0)" ::: "memory");
      const unsigned og = xb_add(&bar[XB_TOP], 1u);
      const unsigned tg = og / nx;
      if (og + 1u == (tg + 1u) * nx) xb_add(&bar[XB_TOPGEN], 1u);
      else XB_SPIN(xb_ld(&bar[XB_TOPGEN]) == tg, bar);
      __builtin_amdgcn_fence(__ATOMIC_ACQUIRE, "agent");
      xb_add(&bar[XB_XGEN(b.x)], 1u);
      asm volatile("s_waitcnt vmcnt(0)" ::: "memory");
    } else {
      XB_SPIN(xb_ld(&bar[XB_XGEN(b.x)]) == gen, bar);
      __builtin_amdgcn_fence(__ATOMIC_ACQUIRE, "agent");
      asm volatile("s_waitcnt vmcnt(0)" ::: "memory");
    }
  }
  __syncthreads();
}
#define CTL_BAR_WORD 4096
#define CTL_ZERO_BYTES 32768
#define LDS_BAR_OFF 66432

#define WG_LDS_OFF (2 * HALF_LDS)
#define LDS_TOTAL (2 * HALF_LDS + 128)
__global__ void __launch_bounds__(512, 2) mega(Params p) {
  extern __shared__ __attribute__((aligned(16))) char smem_all[];
  cg::grid_group grid = cg::this_grid();
  char* const smem = smem_all + VHALF * HALF_LDS;
  volatile LAS unsigned* bst = (volatile LAS unsigned*)(LAS char*)(smem_all + WG_LDS_OFF);
  int* const slot = (int*)(smem_all + WG_LDS_OFF + 16);
  if (threadIdx.x < 2) bst[threadIdx.x] = 0u;
  __syncthreads();
  const XcdBarrier bar = xcd_barrier_post((unsigned*)(p.ws + OFF_CTL) + CTL_BAR_WORD, bst);
  phase_rope(p);
  if (p.ws == nullptr) grid.sync();
  xcd_barrier(bar);
  phase_inproj(p, smem_all);
  xcd_barrier(bar);
  phase_prep_a(p);
  xcd_barrier(bar);
  phase_prep(p, smem);
  xcd_barrier(bar);
  phase_scan(p, smem);
  phase_convert(p, smem, slot);
  xcd_barrier(bar);
  phase_post(p);
  xcd_barrier(bar);
  phase_outproj(p, smem_all);
  xcd_barrier(bar);
  phase_ln1(p);
  xcd_barrier(bar);
  phase_router_gemm(p, smem);
  xcd_barrier(bar);
  phase_topk(p);
  xcd_barrier(bar);
  phase_moe_prefix(p);
  xcd_barrier(bar);
  phase_moe(p, smem_all, slot);
  xcd_barrier(bar);
  phase_final(p, smem);
}

extern "C" void kernel_launch(void* const* d_in, const int* in_sizes, int n_in, void* d_out, int out_size, void* d_ws, size_t ws_size,
                              hipStream_t stream) {
  static int grid_blocks = 0;
  if (grid_blocks == 0) {
    if (ws_size < WS_NEED || n_in != 26) { fprintf(stderr, "kernel_launch: bad ws/n_in: %zu < %zu, n_in %d\n", ws_size, (size_t)WS_NEED, n_in); grid_blocks = -1; return; }
    int dev = 0, cus = 0, per_cu = 0;
    (void)hipGetDevice(&dev);
    (void)hipDeviceGetAttribute(&cus, hipDeviceAttributeMultiprocessorCount, dev);
    (void)hipFuncSetAttribute((const void*)mega, hipFuncAttributeMaxDynamicSharedMemorySize, LDS_TOTAL);
    (void)hipOccupancyMaxActiveBlocksPerMultiprocessor(&per_cu, (const void*)mega, 512, LDS_TOTAL);
    if (per_cu < 1) { fprintf(stderr, "kernel_launch: occupancy query returned %d\n", per_cu); grid_blocks = -1; return; }
    if (per_cu > 1) per_cu = 1;
    grid_blocks = cus * per_cu;
    if (grid_blocks > 256) grid_blocks = 256;
    fprintf(stderr, "kernel_launch: cus %d per_cu %d grid %d\n", cus, per_cu, grid_blocks);
  }
  if (grid_blocks < 0) return;
  if (hipMemsetAsync((char*)d_ws + OFF_CTL, 0, CTL_ZERO_BYTES, stream) != hipSuccess) { fprintf(stderr, "kernel_launch: memset failed\n"); return; }
  Params p{};
  for (int i = 0; i < 26; ++i) p.in[i] = (const float*)d_in[i];
  p.out = (float*)d_out;
  p.ws = (char*)d_ws;
  void* args[] = {&p};
  hipError_t e = hipLaunchCooperativeKernel((const void*)mega, dim3(grid_blocks), dim3(512), args, LDS_TOTAL, stream);
  if (e != hipSuccess) fprintf(stderr, "cooperative launch failed: %s (grid %d)\n", hipGetErrorString(e), grid_blocks);
}
```

```cpp
#include <hip/hip_runtime.h>
#include <hip/hip_bf16.h>
#include <hip/hip_cooperative_groups.h>
#include <stdint.h>
#include <stdio.h>

typedef unsigned short bf16_t;

#define T_TOK 32768
#define SEQ 4096
#define DM 1024
#define INW 3360
#define FEW 1824
#define NEXP 256
#define ALPHA_F 1.189207115002721f
#define LN_EPS_F 1e-5f
#define GN_EPS_F 64e-5f

__device__ __forceinline__ float bf2f(bf16_t v) { return __uint_as_float(((unsigned)v) << 16); }
__device__ __forceinline__ bf16_t f2bf(float f) { unsigned u = __float_as_uint(f); return (bf16_t)((u + 0x7fffu + ((u >> 16) & 1u)) >> 16); }
__device__ __forceinline__ float sigmoidf_(float x) { return 1.f / (1.f + __expf(-x)); }
__device__ __forceinline__ float wave_sum(float v) {
#pragma unroll
  for (int o = 32; o >= 1; o >>= 1) v += __shfl_xor(v, o, 64);
  return v;
}

constexpr size_t SZ_T512_BF = (size_t)T_TOK * 512 * 2;
constexpr size_t OFF_EW1 = 0;
constexpr size_t OFF_EW2 = OFF_EW1 + (size_t)257 * 512 * 1024 * 2;
constexpr size_t LBASE = OFF_EW2 + (size_t)257 * 1024 * 256 * 2;
constexpr size_t OFF_XB = 0;
constexpr size_t OFF_FEATS = OFF_XB + (size_t)T_TOK * 1024 * 2;
constexpr size_t OFF_WINT = OFF_FEATS + (size_t)T_TOK * FEW * 2;
constexpr size_t OFF_ROPE = OFF_WINT + (size_t)3584 * 1024 * 2;
static_assert(OFF_ROPE + (size_t)4096 * 32 * 2 * 4 <= LBASE, "early region E overlay");
constexpr size_t OFF_Q = LBASE;
constexpr size_t OFF_K = OFF_Q + SZ_T512_BF;
constexpr size_t OFF_V = OFF_K + SZ_T512_BF;
constexpr size_t OFF_R = OFF_V + SZ_T512_BF;
constexpr size_t OFF_K2 = OFF_R + SZ_T512_BF;
constexpr size_t OFF_V2 = OFF_K2 + SZ_T512_BF;
constexpr size_t OFF_A = OFF_V2 + SZ_T512_BF;
constexpr size_t OFF_B = OFF_A + SZ_T512_BF;
constexpr size_t OFF_W = OFF_B + SZ_T512_BF;
constexpr size_t OFF_G = OFF_W + (size_t)T_TOK * 512 * 4;
constexpr size_t OFF_SB = OFF_G + SZ_T512_BF;
constexpr size_t OFF_YS = OFF_SB + (size_t)T_TOK * 8 * 4;
constexpr size_t OFF_OP = OFF_YS + (size_t)T_TOK * 512 * 4;
constexpr size_t OFF_LSE = OFF_OP + 3 * SZ_T512_BF;
constexpr size_t OFF_MIXED = OFF_LSE + (size_t)3 * T_TOK * 8 * 4;
constexpr size_t OFF_WOUTT = OFF_MIXED + (size_t)T_TOK * 1024 * 2;
constexpr size_t EARLY_END = OFF_WOUTT + (size_t)1024 * 1024 * 2;
constexpr size_t OFF_Y = LBASE;
constexpr size_t OFF_AFF = LBASE + (size_t)T_TOK * 1024 * 2;
constexpr size_t OFF_X1B = OFF_Y + (size_t)8 * T_TOK * 1024 * 2;
#define LCAP 16384
constexpr size_t OFF_LIST = OFF_X1B + (size_t)T_TOK * 1024 * 2;
constexpr size_t OFF_GATEW = OFF_LIST + (size_t)NEXP * LCAP * 4;
constexpr size_t OFF_HSCR = OFF_GATEW + (size_t)8 * T_TOK * 4;
constexpr size_t OFF_ACT = OFF_HSCR;
static_assert((size_t)T_TOK * 320 * 2 <= (size_t)512 * 128 * 256 * 2, "ACT fits the HSCR space");
constexpr size_t OFF_CTL = OFF_HSCR + (size_t)512 * 128 * 256 * 2;
constexpr size_t CTL_BYTES = 1u << 20;
constexpr size_t WS_NEED = OFF_CTL + CTL_BYTES;
static_assert(EARLY_END <= OFF_HSCR, "early buffers must stay below the per-block scratch / control words");
static_assert(WS_NEED <= (size_t)1073741824, "workspace must fit 1 GiB");
#define CTL_CONVQ 512
#define CTL_CNT 8192
#define CNT(e) (CTL_CNT + 32 * (e))

typedef short bf16x8 __attribute__((ext_vector_type(8)));
typedef float f32x4 __attribute__((ext_vector_type(4)));
typedef float f32x16 __attribute__((ext_vector_type(16)));
typedef float f32x2_t __attribute__((ext_vector_type(2)));
typedef __bf16 bf16x2_t __attribute__((ext_vector_type(2)));
__device__ __forceinline__ unsigned cvtpk(float lo, float hi) { f32x2_t v = {lo, hi}; bf16x2_t b = __builtin_convertvector(v, bf16x2_t); return __builtin_bit_cast(unsigned, b); }

__device__ const double INVF[32] = {
1, 0.74989420933245587, 0.56234132519034907, 0.42169650342858223, 0.31622776601683794, 0.23713737056616552,
0.17782794100389229, 0.1333521432163324, 0.10000000000000001, 0.074989420933245579, 0.056234132519034911,
0.042169650342858224, 0.031622776601683791, 0.023713737056616554, 0.017782794100389229, 0.013335214321633241,
0.01, 0.0074989420933245579, 0.005623413251903491, 0.0042169650342858229, 0.0031622776601683794,
0.0023713737056616554, 0.0017782794100389228, 0.0013335214321633241, 0.001, 0.00074989420933245586,
0.0005623413251903491, 0.00042169650342858224, 0.00031622776601683794, 0.00023713737056616554,
0.00017782794100389227, 0.0001333521432163324};

namespace cg = cooperative_groups;

struct Params {
  const float* in[26];
  float* out;
  char* ws;
};

#define NTHR 256
#define VTID ((int)(threadIdx.x & 255))
#define VHALF (__builtin_amdgcn_readfirstlane((int)(threadIdx.x >> 8)))
#define VBID ((int)(blockIdx.x * 2) + VHALF)
#define VGRID ((int)(gridDim.x * 2))
#define HALF_LDS 66560
extern __shared__ __attribute__((aligned(16))) char g_lds[];
#define WG_LDS_OFF (2 * HALF_LDS)
__device__ __forceinline__ void half_sync() {
  asm volatile("s_waitcnt vmcnt(0) lgkmcnt(0)" ::: "memory");
  int* cnt = (int*)(g_lds + WG_LDS_OFF + 32) + VHALF;
  if ((threadIdx.x & 63) == 0) {
    const int old = __hip_atomic_fetch_add(cnt, 1, __ATOMIC_RELAXED, __HIP_MEMORY_SCOPE_WORKGROUP);
    const int target = (old & ~3) + 4;
    while (__hip_atomic_load(cnt, __ATOMIC_RELAXED, __HIP_MEMORY_SCOPE_WORKGROUP) < target) __builtin_amdgcn_s_sleep(1);
  }
  __builtin_amdgcn_fence(__ATOMIC_ACQUIRE, "workgroup");
  asm volatile("s_waitcnt lgkmcnt(0)" ::: "memory");
}
#define HSYNC() half_sync()

#define LDS_BYTES 66560

__device__ __forceinline__ void phase_rope(const Params& p) {
  float* tab = (float*)(p.ws + OFF_ROPE);
  for (int i = VBID * NTHR + VTID; i < 4096 * 32; i += VGRID * NTHR) {
    int pos = i >> 5, f = i & 31;
    double ang = (double)pos * INVF[f];
    const double TWO_PI = 6.283185307179586476925286766559;
    double n = rint(ang / TWO_PI);
    double r = ang - n * TWO_PI;
    double r2 = r * r;
    double sn = r, cs = 1.0, ts = r, tc = 1.0;
#pragma unroll 1
    for (int k = 1; k <= 16; ++k) {
      tc = -tc * r2 / (double)((2 * k - 1) * (2 * k));
      ts = -ts * r2 / (double)((2 * k) * (2 * k + 1));
      cs += tc; sn += ts;
    }
    tab[i * 2] = (float)cs; tab[i * 2 + 1] = (float)sn;
  }
  {
    const float* __restrict__ w_in = p.in[1]; const float* __restrict__ w_out = p.in[13];
    uint4* wint = (uint4*)(p.ws + OFF_WINT); uint4* woutt = (uint4*)(p.ws + OFF_WOUTT);
    const int NJ1 = 3584 * 128, NJ2 = 1024 * 128;
    for (int i = VBID * NTHR + VTID; i < NJ1 + NJ2; i += VGRID * NTHR) {
      const bool second = i >= NJ1;
      const int q = second ? i - NJ1 : i;
      const int N = second ? 1024 : 3584, NV = second ? 1024 : INW;
      const int s = q % N, ko = q / N;
      const int n = second ? s : ((s & ~63) + (((s & 63) >> 3) << 2) + (s & 3) + (((s >> 2) & 1) << 5));
      const float* __restrict__ src = second ? w_out : w_in;
      float f[8];
#pragma unroll
      for (int u = 0; u < 8; ++u) f[u] = (n < NV) ? src[(size_t)(ko * 8 + u) * NV + n] : 0.f;
      uint4 w; w.x = cvtpk(f[0], f[1]); w.y = cvtpk(f[2], f[3]); w.z = cvtpk(f[4], f[5]); w.w = cvtpk(f[6], f[7]);
      (second ? woutt : wint)[(size_t)s * 128 + ko] = w;
    }
  }
  {
    const float4* __restrict__ x4 = (const float4*)p.in[0];
    uint4* xb = (uint4*)(p.ws + OFF_XB);
    for (size_t i = (size_t)VBID * NTHR + VTID; i < (size_t)T_TOK * DM / 8; i += (size_t)VGRID * NTHR) {
      float4 a = x4[2 * i], b = x4[2 * i + 1];
      uint4 w; w.x = cvtpk(a.x, a.y); w.y = cvtpk(a.z, a.w); w.z = cvtpk(b.x, b.y); w.w = cvtpk(b.z, b.w);
      xb[i] = w;
    }
  }
}

template <class AF, class BF>
__device__ __forceinline__ void gemm64_naive(float* As, float* Bs, float* Cs, int K, AF af, BF bf) {
  int tid_l_ = VTID; asm volatile("" : "+v"(tid_l_)); const int tid = tid_l_, tx = tid & 15, ty = tid >> 4;
  float acc[4][4];
#pragma unroll
  for (int i = 0; i < 4; ++i)
#pragma unroll
    for (int j = 0; j < 4; ++j) acc[i][j] = 0.f;
  for (int k0 = 0; k0 < K; k0 += 16) {
#pragma unroll
    for (int u = 0; u < 4; ++u) { int i = tid + u * 256; int r = i >> 4, kk = i & 15; As[kk * 68 + r] = af(r, k0 + kk); }
#pragma unroll
    for (int u = 0; u < 4; ++u) { int i = tid + u * 256; int kk = i >> 6, c = i & 63; Bs[kk * 68 + c] = bf(k0 + kk, c); }
    HSYNC();
#pragma unroll
    for (int kk = 0; kk < 16; ++kk) {
      float a[4], b[4];
#pragma unroll
      for (int i = 0; i < 4; ++i) { a[i] = As[kk * 68 + ty * 4 + i]; b[i] = Bs[kk * 68 + tx * 4 + i]; }
#pragma unroll
      for (int i = 0; i < 4; ++i)
#pragma unroll
        for (int j = 0; j < 4; ++j) acc[i][j] += a[i] * b[j];
    }
    HSYNC();
  }
#pragma unroll
  for (int i = 0; i < 4; ++i)
#pragma unroll
    for (int j = 0; j < 4; ++j) Cs[(ty * 4 + i) * 65 + tx * 4 + j] = acc[i][j];
  HSYNC();
}


__device__ __forceinline__ int lds_off(int row, int chunk) { return row * 128 + ((chunk ^ ((row >> 1) & 7)) << 4); }

template <int BMODE>
__device__ __forceinline__ unsigned cvtpk_m(float a, float b, const bool lo = false) {
  if (BMODE == 0 || (BMODE == 2 && !lo)) return cvtpk(a, b);
  const unsigned h = cvtpk(a, b);
  const float ah = __uint_as_float(h << 16), bh = __uint_as_float(h & 0xffff0000u);
  return cvtpk(a - ah, b - bh);
}
#define G128_MMA(bufoff) { \
    _Pragma("unroll") for (int kk = 0; kk < 2; ++kk) { \
      bf16x8 af[4], bfr[4]; \
      _Pragma("unroll") for (int m = 0; m < 4; ++m) af[m] = *(const bf16x8*)(smem + (bufoff) + lds_off(wr * 64 + m * 16 + fr, kk * 4 + fq)); \
      _Pragma("unroll") for (int n = 0; n < 4; ++n) bfr[n] = *(const bf16x8*)(smem + (bufoff) + 16384 + lds_off(wc * 64 + n * 16 + fr, kk * 4 + fq)); \
      _Pragma("unroll") for (int m = 0; m < 4; ++m) \
        _Pragma("unroll") for (int n = 0; n < 4; ++n) acc[m][n] = __builtin_amdgcn_mfma_f32_16x16x32_bf16(bfr[n], af[m], acc[m][n], 0, 0, 0); \
    } }
template <int BMODE, bool KCLAMP, class ALoad, class BPtr>
__device__ __forceinline__ void gemm128_acc(f32x4 (&acc)[4][4], char* smem, const int nk, ALoad aload, BPtr bptr, const int ldb, const int kvalid) {
  int tid_l_ = VTID; asm volatile("" : "+v"(tid_l_)); const int tid = tid_l_, lane = tid & 63, wid = tid >> 6;
  const int wr = wid >> 1, wc = wid & 1, fr = lane & 15, fq = lane >> 4;
  const int achunk = tid & 7, arow0 = tid >> 3;
  const int nq = tid & 31, ko = tid >> 5;
  const float* bp0 = bptr(nq);
  const int oa0 = lds_off(arow0, achunk), oa1 = lds_off(arow0 + 32, achunk), oa2 = lds_off(arow0 + 64, achunk), oa3 = lds_off(arow0 + 96, achunk);
  const int ob0 = 16384 + lds_off(nq * 4 + 0, ko), ob1 = 16384 + lds_off(nq * 4 + 1, ko), ob2 = 16384 + lds_off(nq * 4 + 2, ko), ob3 = 16384 + lds_off(nq * 4 + 3, ko);
  uint4 ra0, ra1, ra2, ra3; float4 rb0, rb1, rb2, rb3, rb4, rb5, rb6, rb7;
#define G128_LOAD(kt) { \
    ra0 = aload(0, arow0, (kt) * 8 + achunk); ra1 = aload(1, arow0 + 32, (kt) * 8 + achunk); \
    ra2 = aload(2, arow0 + 64, (kt) * 8 + achunk); ra3 = aload(3, arow0 + 96, (kt) * 8 + achunk); \
    int kr_ = (kt) * 64 + ko * 8; \
    if (KCLAMP) kr_ = min(kr_, kvalid - 8);     \
    { \
      const float* b2_ = bp0 + (size_t)((BMODE == 2) ? (kr_ & 1023) : kr_) * ldb; \
      rb0 = *(const float4*)(b2_); rb1 = *(const float4*)(b2_ + (size_t)1 * ldb); rb2 = *(const float4*)(b2_ + (size_t)2 * ldb); \
      rb3 = *(const float4*)(b2_ + (size_t)3 * ldb); rb4 = *(const float4*)(b2_ + (size_t)4 * ldb); rb5 = *(const float4*)(b2_ + (size_t)5 * ldb); \
      rb6 = *(const float4*)(b2_ + (size_t)6 * ldb); rb7 = *(const float4*)(b2_ + (size_t)7 * ldb); \
    } }
#define G128_STORE(bufoff, lo_) { \
    char* const sb_ = smem + (bufoff); \
    *(uint4*)(sb_ + oa0) = ra0; *(uint4*)(sb_ + oa1) = ra1; *(uint4*)(sb_ + oa2) = ra2; *(uint4*)(sb_ + oa3) = ra3; \
    uint4 w; \
    w.x = cvtpk_m<BMODE>(rb0.x, rb1.x, lo_); w.y = cvtpk_m<BMODE>(rb2.x, rb3.x, lo_); w.z = cvtpk_m<BMODE>(rb4.x, rb5.x, lo_); w.w = cvtpk_m<BMODE>(rb6.x, rb7.x, lo_); \
    *(uint4*)(sb_ + ob0) = w; \
    w.x = cvtpk_m<BMODE>(rb0.y, rb1.y, lo_); w.y = cvtpk_m<BMODE>(rb2.y, rb3.y, lo_); w.z = cvtpk_m<BMODE>(rb4.y, rb5.y, lo_); w.w = cvtpk_m<BMODE>(rb6.y, rb7.y, lo_); \
    *(uint4*)(sb_ + ob1) = w; \
    w.x = cvtpk_m<BMODE>(rb0.z, rb1.z, lo_); w.y = cvtpk_m<BMODE>(rb2.z, rb3.z, lo_); w.z = cvtpk_m<BMODE>(rb4.z, rb5.z, lo_); w.w = cvtpk_m<BMODE>(rb6.z, rb7.z, lo_); \
    *(uint4*)(sb_ + ob2) = w; \
    w.x = cvtpk_m<BMODE>(rb0.w, rb1.w, lo_); w.y = cvtpk_m<BMODE>(rb2.w, rb3.w, lo_); w.z = cvtpk_m<BMODE>(rb4.w, rb5.w, lo_); w.w = cvtpk_m<BMODE>(rb6.w, rb7.w, lo_); \
    *(uint4*)(sb_ + ob3) = w; }
  G128_LOAD(0)
  G128_STORE(0, false)
  if (nk > 1) G128_LOAD(1)
  HSYNC();
  for (int kt = 0; kt < nk; ++kt) {
    const int cur = (kt & 1) * 32768;
    __builtin_amdgcn_sched_barrier(0);
    G128_MMA(cur)
    __builtin_amdgcn_sched_barrier(0);
    if (kt + 1 < nk) {
      G128_STORE(cur ^ 32768, (kt + 1) >= kvalid)
      __builtin_amdgcn_sched_barrier(0);
      if (kt + 2 < nk) G128_LOAD(kt + 2)
    }
    __builtin_amdgcn_sched_barrier(0);
    HSYNC();
  }
#undef G128_LOAD
#undef G128_STORE
}
__device__ __forceinline__ void acc_zero(f32x4 (&acc)[4][4]) {
#pragma unroll
  for (int m = 0; m < 4; ++m)
#pragma unroll
    for (int n = 0; n < 4; ++n) acc[m][n] = (f32x4){0.f, 0.f, 0.f, 0.f};
}
template <class ARow, class BPtr, class Epi>
__device__ __forceinline__ void gemm128(char* smem, const int K, ARow arow, BPtr bptr, const int ldb, Epi epi) {
  int tid_l_ = VTID; asm volatile("" : "+v"(tid_l_)); const int tid = tid_l_, lane = tid & 63, wid = tid >> 6;
  const int arow0 = tid >> 3;
  const bf16_t* ap0 = arow(arow0);
  const bf16_t* ap1 = arow(arow0 + 32);
  const bf16_t* ap2 = arow(arow0 + 64);
  const bf16_t* ap3 = arow(arow0 + 96);
  f32x4 acc[4][4];
  acc_zero(acc);
  gemm128_acc<0, false>(acc, smem, K >> 6,
      [=](int u, int, int kc) { const bf16_t* q = (u == 0) ? ap0 : (u == 1) ? ap1 : (u == 2) ? ap2 : ap3; return *(const uint4*)(q + kc * 8); },
      bptr, ldb, 0);
  epi(acc, wid >> 1, wid & 1, lane & 15, lane >> 4);
}


template <class ALoad, class BLoad>
__device__ __forceinline__ void gemm128_acc_bb(f32x4 (&acc)[4][4], char* smem, const int nk, ALoad aload, BLoad bload) {
  int tid_l_ = VTID; asm volatile("" : "+v"(tid_l_)); const int tid = tid_l_, lane = tid & 63, wid = tid >> 6;
  const int wr = wid >> 1, wc = wid & 1, fr = lane & 15, fq = lane >> 4;
  const int achunk = tid & 7, arow0 = tid >> 3;
  const int oa0 = lds_off(arow0, achunk), oa1 = lds_off(arow0 + 32, achunk), oa2 = lds_off(arow0 + 64, achunk), oa3 = lds_off(arow0 + 96, achunk);
  uint4 ra0, ra1, ra2, ra3, rb0, rb1, rb2, rb3;
#define G128_LOADBB(kt) { \
    ra0 = aload(0, arow0, (kt) * 8 + achunk); ra1 = aload(1, arow0 + 32, (kt) * 8 + achunk); \
    ra2 = aload(2, arow0 + 64, (kt) * 8 + achunk); ra3 = aload(3, arow0 + 96, (kt) * 8 + achunk); \
    rb0 = bload(0, arow0, (kt) * 8 + achunk); rb1 = bload(1, arow0 + 32, (kt) * 8 + achunk); \
    rb2 = bload(2, arow0 + 64, (kt) * 8 + achunk); rb3 = bload(3, arow0 + 96, (kt) * 8 + achunk); }
#define G128_STOREBB(bufoff) { \
    char* const sb_ = smem + (bufoff); \
    *(uint4*)(sb_ + oa0) = ra0; *(uint4*)(sb_ + oa1) = ra1; *(uint4*)(sb_ + oa2) = ra2; *(uint4*)(sb_ + oa3) = ra3; \
    *(uint4*)(sb_ + 16384 + oa0) = rb0; *(uint4*)(sb_ + 16384 + oa1) = rb1; *(uint4*)(sb_ + 16384 + oa2) = rb2; *(uint4*)(sb_ + 16384 + oa3) = rb3; }
  G128_LOADBB(0)
  G128_STOREBB(0)
  if (nk > 1) G128_LOADBB(1)
  HSYNC();
  for (int kt = 0; kt < nk; ++kt) {
    const int cur = (kt & 1) * 32768;
    __builtin_amdgcn_sched_barrier(0);
    G128_MMA(cur)
    __builtin_amdgcn_sched_barrier(0);
    if (kt + 1 < nk) {
      G128_STOREBB(cur ^ 32768)
      __builtin_amdgcn_sched_barrier(0);
      if (kt + 2 < nk) G128_LOADBB(kt + 2)
    }
    __builtin_amdgcn_sched_barrier(0);
    HSYNC();
  }
#undef G128_LOADBB
#undef G128_STOREBB
}
template <class ARow, class BRow, class Epi>
__device__ __forceinline__ void gemm128_bb(char* smem, const int K, ARow arow, BRow brow, Epi epi) {
  int tid_l_ = VTID; asm volatile("" : "+v"(tid_l_)); const int tid = tid_l_, lane = tid & 63, wid = tid >> 6;
  const int arow0 = tid >> 3;
  const bf16_t* ap0 = arow(arow0); const bf16_t* ap1 = arow(arow0 + 32); const bf16_t* ap2 = arow(arow0 + 64); const bf16_t* ap3 = arow(arow0 + 96);
  const bf16_t* bp0 = brow(arow0); const bf16_t* bp1 = brow(arow0 + 32); const bf16_t* bp2 = brow(arow0 + 64); const bf16_t* bp3 = brow(arow0 + 96);
  f32x4 acc[4][4];
  acc_zero(acc);
  gemm128_acc_bb(acc, smem, K >> 6,
      [=](int u, int, int kc) { const bf16_t* q = (u == 0) ? ap0 : (u == 1) ? ap1 : (u == 2) ? ap2 : ap3; return *(const uint4*)(q + kc * 8); },
      [=](int u, int, int kc) { const bf16_t* q = (u == 0) ? bp0 : (u == 1) ? bp1 : (u == 2) ? bp2 : bp3; return *(const uint4*)(q + kc * 8); });
  epi(acc, wid >> 1, wid & 1, lane & 15, lane >> 4);
}


#define GAS1 __attribute__((address_space(1)))
#define LAS3 __attribute__((address_space(3)))
__device__ __forceinline__ void glds16(const void* g, char* l) {
  __builtin_amdgcn_global_load_lds((const GAS1 void*)g, (LAS3 void*)l, 16, 0, 0);
}
template <class ARow, class BRow, class Epi>
__device__ __forceinline__ void gemm128_glds(char* smem, const int K, ARow arow, BRow brow, Epi epi) {
  int tid_l_ = VTID; asm volatile("" : "+v"(tid_l_)); const int tid = tid_l_, lane = tid & 63, wid = tid >> 6;
  const int wr = wid >> 1, wc = wid & 1, fr = lane & 15, fq = lane >> 4;
  const int r0 = tid >> 3;
  const int cl = (tid & 7) ^ ((tid >> 4) & 7);
  const bf16_t* ga0 = arow(r0) + cl * 8; const bf16_t* ga1 = arow(r0 + 32) + cl * 8; const bf16_t* ga2 = arow(r0 + 64) + cl * 8; const bf16_t* ga3 = arow(r0 + 96) + cl * 8;
  const bf16_t* gb0 = brow(r0) + cl * 8; const bf16_t* gb1 = brow(r0 + 32) + cl * 8; const bf16_t* gb2 = brow(r0 + 64) + cl * 8; const bf16_t* gb3 = brow(r0 + 96) + cl * 8;
  char* const lbase = smem + tid * 16;
#define GL_STAGE(bufoff, kt) { \
    char* const d_ = lbase + (bufoff); const int ko_ = (kt) * 64; \
    glds16(ga0 + ko_, d_); glds16(ga1 + ko_, d_ + 4096); glds16(ga2 + ko_, d_ + 8192); glds16(ga3 + ko_, d_ + 12288); \
    glds16(gb0 + ko_, d_ + 16384); glds16(gb1 + ko_, d_ + 20480); glds16(gb2 + ko_, d_ + 24576); glds16(gb3 + ko_, d_ + 28672); }
  f32x4 acc[4][4];
  acc_zero(acc);
  const int nk = K >> 6;
  GL_STAGE(0, 0)
  asm volatile("s_waitcnt vmcnt(0)" ::: "memory");
  HSYNC();
  for (int kt = 0; kt < nk; ++kt) {
    const int cur = (kt & 1) * 32768;
    if (kt + 1 < nk) GL_STAGE(cur ^ 32768, kt + 1)
    G128_MMA(cur)
    asm volatile("s_waitcnt vmcnt(0)" ::: "memory");
    HSYNC();
  }
#undef GL_STAGE
  epi(acc, wr, wc, fr, fq);
}


template <int NCALL, int NK, class ARow, class BRow, class Epi>
__device__ __forceinline__ void gemm128_glds_multi(char* smem, ARow arow, BRow brow, const size_t bstride, Epi epi) {
  int tid_l_ = VTID; asm volatile("" : "+v"(tid_l_)); const int tid = tid_l_, lane = tid & 63, wid = tid >> 6;
  const int wr = wid >> 1, wc = wid & 1, fr = lane & 15, fq = lane >> 4;
  const int r0 = tid >> 3;
  const int cl = (tid & 7) ^ ((tid >> 4) & 7);
  const bf16_t* ga0 = arow(r0) + cl * 8; const bf16_t* ga1 = arow(r0 + 32) + cl * 8; const bf16_t* ga2 = arow(r0 + 64) + cl * 8; const bf16_t* ga3 = arow(r0 + 96) + cl * 8;
  const bf16_t* gb0 = brow(r0) + cl * 8; const bf16_t* gb1 = brow(r0 + 32) + cl * 8; const bf16_t* gb2 = brow(r0 + 64) + cl * 8; const bf16_t* gb3 = brow(r0 + 96) + cl * 8;
  char* const lbase = smem + tid * 16;
#define GM_STAGE(bufoff, g) { \
    char* const d_ = lbase + (bufoff); const int ko_ = ((g) % NK) * 64; const size_t bo_ = (size_t)((g) / NK) * bstride + ko_; \
    glds16(ga0 + ko_, d_); glds16(ga1 + ko_, d_ + 4096); glds16(ga2 + ko_, d_ + 8192); glds16(ga3 + ko_, d_ + 12288); \
    glds16(gb0 + bo_, d_ + 16384); glds16(gb1 + bo_, d_ + 20480); glds16(gb2 + bo_, d_ + 24576); glds16(gb3 + bo_, d_ + 28672); }
  f32x4 acc[4][4];
  acc_zero(acc);
  constexpr int G = NCALL * NK;
  GM_STAGE(0, 0)
  asm volatile("s_waitcnt vmcnt(0)" ::: "memory");
  HSYNC();
#pragma unroll 1
  for (int g = 0; g < G; ++g) {
    const int cur = (g & 1) * 32768;
    if (g + 1 < G) GM_STAGE(cur ^ 32768, g + 1)
    G128_MMA(cur)
    if ((g % NK) == NK - 1) {
      epi(g / NK, acc, wr, wc, fr, fq);
      acc_zero(acc);
    }
    asm volatile("s_waitcnt vmcnt(0)" ::: "memory");
    HSYNC();
  }
#undef GM_STAGE
}


namespace pg8 {
#define PG8_LAS __attribute__((address_space(3)))
typedef unsigned short bf16_t;
typedef short bf16x8 __attribute__((ext_vector_type(8)));
typedef float f32x4 __attribute__((ext_vector_type(4)));
typedef unsigned u32x4 __attribute__((ext_vector_type(4)));
constexpr int BM = 256, BK = 64, HALF = 128, HTB = HALF * BK * 2  , STAGE_BYTES = 8 * HTB, NXCD = 8, WGM = 8;

__host__ __device__ __forceinline__ int lds_byte(int r, int c) { const int st = (r >> 4) * 2 + (c >> 5), rr = r & 15, cc = c & 31, ob = rr * 64 + cc * 2; return st * 1024 + (ob ^ (((ob >> 9) & 1) << 5)); }
__host__ __device__ __forceinline__ void stage_rc(int b, int& R, int& C) { const int st = b / 1024, sb = b % 1024, swz = sb ^ (((sb >> 9) & 1) << 5); R = (st >> 1) * 16 + swz / 64; C = (st & 1) * 32 + (swz % 64) / 2; }
__host__ __device__ __forceinline__ int perm32(int rho) { const int n = rho >> 4, i = rho & 15; return 8 * (i >> 2) + 4 * n + (i & 3); }

struct Unit { int pm, pn; };
struct Gemm { const bf16_t* A; const bf16_t* Bt; int M, N, K; };

struct StaticOrder {
    int nM, nN, nwg, G, c;
    __host__ __device__ void init(int M, int N, int G_, int c_) { nM = M / BM; nN = N / BM; nwg = nM * nN; G = G_; c = c_; }
    __host__ __device__ bool next(int i, Unit& u) const {
        const long L = (long)i * G + c; if (L >= nwg) return false;
        int wgid = (int)L; { const int q = nwg / NXCD, r = nwg % NXCD, xcd = wgid % NXCD, off = wgid / NXCD; wgid = (xcd < r ? xcd * (q + 1) : r * (q + 1) + (xcd - r) * q) + off; }
        const int nig = WGM * nN, gid = wgid / nig, fm = gid * WGM, gsz = (nM - fm) < WGM ? (nM - fm) : WGM;
        u.pm = fm + ((wgid % nig) % gsz); u.pn = (wgid % nig) / gsz; return true;
    }
    __device__ __forceinline__ void a_ready(const Unit&) const {}
    __device__ __forceinline__ void done(const Unit&) const {}
};
template <class Epi, class Sched, bool ALIGN_EPI = false, bool SP2 = false, bool GATHER = false>
__device__ __forceinline__ void gemm_phase(PG8_LAS unsigned char* lds, const Gemm g, const Sched& S, const Epi& E, const int* rowidx = nullptr) {
    int tid_ = threadIdx.x; asm volatile("" : "+v"(tid_));
    const int tid = tid_, wid = __builtin_amdgcn_readfirstlane(tid >> 6), lane = tid & 63, wr = wid >> 2, wc = wid & 3, fr = lane & 15, fq = lane >> 4;
    const int K = g.K, nt = K / BK;
    unsigned voffA[2], voffA1[2], voffB[2];
#pragma unroll
    for (int i = 0; i < 2; ++i) { int R, C; stage_rc(tid * 16 + i * 8192, R, C); const int Rb = Epi::PERM ? ((R & ~31) + perm32(R & 31)) : R;
        if (GATHER) { voffA[i] = ((unsigned)rowidx[R] * (unsigned)K + (unsigned)C) * 2u; voffA1[i] = ((unsigned)rowidx[128 + R] * (unsigned)K + (unsigned)C) * 2u; }
        else { voffA[i] = (unsigned)(R * K + C) * 2u; voffA1[i] = voffA[i]; }
        voffB[i] = (unsigned)(Rb * K + C) * 2u; }
    const size_t hstepA = GATHER ? (size_t)0 : (size_t)HALF * K * 2;
    const size_t kstep = (size_t)(BK * 2);
    const size_t hstep = (size_t)HALF * K * 2;
    const size_t tstep = 2 * hstep;
    const unsigned ldsw = (unsigned)wid * 1024u;
    const int aoff = lds_byte(wr * 64 + fr, fq * 8), boff = lds_byte(wc * 32 + fr, fq * 8);
#define PG8_SA(b, h) (((b) * 2 + (h)) * HTB)
#define PG8_SB(b, h) ((4 + (b) * 2 + (h)) * HTB)
#define PG8_STAGE(bufoff, gbase, voff) do { _Pragma("unroll") for (int _i = 0; _i < 2; ++_i) \
        __builtin_amdgcn_global_load_lds((const unsigned*)((const char*)(gbase) + (voff)[_i]), (PG8_LAS unsigned*)(lds + (bufoff) + ldsw + _i * 8192), 16, 0, 0); } while (0)
#define PG8_LDA(dst, b, h) do { _Pragma("unroll") for (int m = 0; m < 4; ++m) _Pragma("unroll") for (int k = 0; k < 2; ++k) dst[m][k] = *(const PG8_LAS bf16x8*)(lds + PG8_SA(b, h) + aoff + m * 2048 + k * 1024); } while (0)
#define PG8_LDB(dst, b, h) do { _Pragma("unroll") for (int n = 0; n < 2; ++n) _Pragma("unroll") for (int k = 0; k < 2; ++k) dst[n][k] = *(const PG8_LAS bf16x8*)(lds + PG8_SB(b, h) + boff + n * 2048 + k * 1024); } while (0)
#define PG8_MMA(ai, bj, At, Bt) do { __builtin_amdgcn_s_setprio(1); _Pragma("unroll") for (int m = 0; m < 4; ++m) _Pragma("unroll") for (int n = 0; n < 2; ++n) _Pragma("unroll") for (int k = 0; k < 2; ++k) \
        acc[ai][bj][m][n] = __builtin_amdgcn_mfma_f32_16x16x32_bf16(Bt[n][k], At[m][k], acc[ai][bj][m][n], 0, 0, 0); __builtin_amdgcn_s_setprio(0); } while (0)
#define PG8_WAIT_V(n) asm volatile("s_waitcnt vmcnt(" #n ")" ::: "memory")
#define PG8_WAIT_L(n) asm volatile("s_waitcnt lgkmcnt(" #n ")" ::: "memory")
#define PG8_BAR __builtin_amdgcn_s_barrier()
#define PG8_SCHED __builtin_amdgcn_sched_barrier(0)
    Unit cur, nxt; int ui = 0;
    if (!S.next(0, cur)) return;
    f32x4 acc[2][2][4][2];
#pragma unroll
    for (int a = 0; a < 2; ++a)
#pragma unroll
        for (int b = 0; b < 2; ++b)
#pragma unroll
            for (int m = 0; m < 4; ++m)
#pragma unroll
                for (int n = 0; n < 2; ++n) acc[a][b][m][n] = (f32x4){0.f, 0.f, 0.f, 0.f};
    bf16x8 At[4][2], B0[2][2], B1[2][2];
    const char* cA = (const char*)g.A + (size_t)cur.pm * tstep; const char* cB = (const char*)g.Bt + (size_t)cur.pn * tstep;
    S.a_ready(cur);
    if constexpr (SP2) {
        PG8_STAGE(PG8_SB(0, 0), cB, voffB); PG8_STAGE(PG8_SB(0, 1), cB + hstep, voffB); PG8_STAGE(PG8_SA(0, 0), cA, voffA); PG8_STAGE(PG8_SA(0, 1), cA + hstepA, voffA1);
        if (wr == 1) PG8_BAR;
        PG8_WAIT_V(2); PG8_BAR;
        PG8_STAGE(PG8_SB(1, 0), cB + kstep, voffB); PG8_STAGE(PG8_SA(1, 0), cA + kstep, voffA); PG8_STAGE(PG8_SB(1, 1), cB + hstep + kstep, voffB);
        PG8_WAIT_V(6); PG8_BAR;
    } else {
        PG8_STAGE(PG8_SB(0, 0), cB, voffB); PG8_STAGE(PG8_SA(0, 0), cA, voffA); PG8_STAGE(PG8_SB(0, 1), cB + hstep, voffB); PG8_STAGE(PG8_SA(0, 1), cA + hstepA, voffA1);
        if (wr == 1) PG8_BAR;
        PG8_WAIT_V(4); PG8_BAR;
        PG8_STAGE(PG8_SB(1, 0), cB + kstep, voffB); PG8_STAGE(PG8_SA(1, 0), cA + kstep, voffA); PG8_STAGE(PG8_SB(1, 1), cB + hstep + kstep, voffB);
        PG8_WAIT_V(6); PG8_BAR;
    }
    for (;;) {
        const bool has_next = S.next(ui + 1, nxt);
        const char* nA = has_next ? (const char*)g.A + (size_t)nxt.pm * tstep : cA; const char* nB = has_next ? (const char*)g.Bt + (size_t)nxt.pn * tstep : cB;
        for (int t = 0; t < nt; t += 2) {
            const bool last = (t == nt - 2);
            const char* a1 = cA + (size_t)(t + 1) * kstep;
            const char* a2 = last ? nA : cA + (size_t)(t + 2) * kstep; const char* b2 = last ? nB : cB + (size_t)(t + 2) * kstep;
            const char* a3 = a2 + kstep; const char* b3 = b2 + kstep;
            if (last && has_next) S.a_ready(nxt);
            if constexpr (SP2) {
            PG8_LDB(B0, 0, 0); PG8_LDB(B1, 0, 1); PG8_SCHED; PG8_LDA(At, 0, 0); PG8_STAGE(PG8_SA(1, 1), a1 + hstepA, voffA1);
            PG8_WAIT_V(8); PG8_WAIT_L(0); PG8_BAR; PG8_MMA(0, 0, At, B0); PG8_MMA(0, 1, At, B1); PG8_BAR; PG8_SCHED;
            PG8_LDA(At, 0, 1); PG8_STAGE(PG8_SB(0, 0), b2, voffB); PG8_STAGE(PG8_SB(0, 1), b2 + hstep, voffB); PG8_STAGE(PG8_SA(0, 0), a2, voffA);
            PG8_WAIT_V(8); PG8_WAIT_L(0); PG8_BAR; PG8_MMA(1, 0, At, B0); PG8_MMA(1, 1, At, B1); PG8_BAR; PG8_SCHED;
            PG8_LDB(B0, 1, 0); PG8_LDB(B1, 1, 1); PG8_SCHED; PG8_LDA(At, 1, 0); PG8_STAGE(PG8_SA(0, 1), a2 + hstepA, voffA1);
            PG8_WAIT_V(8); PG8_WAIT_L(0); PG8_BAR; PG8_MMA(0, 0, At, B0); PG8_MMA(0, 1, At, B1); PG8_BAR; PG8_SCHED;
            PG8_LDA(At, 1, 1); PG8_STAGE(PG8_SB(1, 0), b3, voffB); PG8_STAGE(PG8_SB(1, 1), b3 + hstep, voffB); PG8_STAGE(PG8_SA(1, 0), a3, voffA);
            PG8_WAIT_V(8); PG8_WAIT_L(0); PG8_BAR; PG8_MMA(1, 0, At, B0); PG8_MMA(1, 1, At, B1); PG8_BAR; PG8_SCHED;
            } else {
            PG8_LDB(B0, 0, 0); PG8_SCHED; PG8_LDA(At, 0, 0); PG8_STAGE(PG8_SA(1, 1), a1 + hstepA, voffA1);
            PG8_WAIT_L(8); PG8_BAR; PG8_WAIT_L(0); PG8_MMA(0, 0, At, B0); PG8_BAR; PG8_SCHED;
            PG8_LDB(B1, 0, 1); PG8_STAGE(PG8_SB(0, 0), b2, voffB);
            PG8_BAR; PG8_WAIT_L(0); PG8_MMA(0, 1, At, B1); PG8_BAR;
            PG8_LDA(At, 0, 1); PG8_STAGE(PG8_SA(0, 0), a2, voffA);
            PG8_BAR; PG8_WAIT_L(0); PG8_MMA(1, 0, At, B0); PG8_BAR; PG8_SCHED;
            PG8_STAGE(PG8_SB(0, 1), b2 + hstep, voffB);
            PG8_WAIT_V(6); PG8_BAR; PG8_MMA(1, 1, At, B1); PG8_BAR;
            PG8_LDB(B0, 1, 0); PG8_SCHED; PG8_LDA(At, 1, 0); PG8_STAGE(PG8_SA(0, 1), a2 + hstepA, voffA1);
            PG8_WAIT_L(8); PG8_BAR; PG8_WAIT_L(0); PG8_MMA(0, 0, At, B0); PG8_BAR; PG8_SCHED;
            PG8_LDB(B1, 1, 1); PG8_STAGE(PG8_SB(1, 0), b3, voffB);
            PG8_BAR; PG8_WAIT_L(0); PG8_MMA(0, 1, At, B1); PG8_BAR;
            PG8_LDA(At, 1, 1); PG8_STAGE(PG8_SA(1, 0), a3, voffA);
            PG8_BAR; PG8_WAIT_L(0); PG8_MMA(1, 0, At, B0); PG8_BAR; PG8_SCHED;
            PG8_STAGE(PG8_SB(1, 1), b3 + hstep, voffB);
            PG8_WAIT_V(6); PG8_BAR; PG8_MMA(1, 1, At, B1); PG8_BAR;
            }
        }
        if constexpr (ALIGN_EPI) { if (wr == 0) PG8_BAR; }
        if constexpr (!Epi::AFTER_DRAIN) { E(acc, cur, wr, wc, fr, fq); S.done(cur); }
        if (!has_next) break;
#pragma unroll
        for (int a = 0; a < 2; ++a)
#pragma unroll
            for (int b = 0; b < 2; ++b)
#pragma unroll
                for (int m = 0; m < 4; ++m)
#pragma unroll
                    for (int n = 0; n < 2; ++n) acc[a][b][m][n] = (f32x4){0.f, 0.f, 0.f, 0.f};
        cur = nxt; cA = nA; cB = nB; ++ui;
        if constexpr (ALIGN_EPI) { if (wr == 1) PG8_BAR; }
    }
    PG8_WAIT_V(0);
    if constexpr (!ALIGN_EPI) { if (wr == 0) PG8_BAR; }
    PG8_BAR;
    if constexpr (Epi::AFTER_DRAIN) { E.fused(acc, cur, wr, wc, fr, fq, lds, wid, lane); S.done(cur); }
#undef PG8_SA
#undef PG8_SB
#undef PG8_STAGE
#undef PG8_LDA
#undef PG8_LDB
#undef PG8_MMA
#undef PG8_WAIT_V
#undef PG8_WAIT_L
#undef PG8_BAR
#undef PG8_SCHED
}
}
#define DPP_F(v, ctrl) __builtin_bit_cast(float, __builtin_amdgcn_update_dpp(0, __builtin_bit_cast(int, (v)), (ctrl), 0xF, 0xF, true))
__device__ __forceinline__ float rdlane_f(float v, int l) { return __builtin_bit_cast(float, __builtin_amdgcn_readlane(__builtin_bit_cast(int, v), l)); }
__device__ __forceinline__ float dpp_sum16x(float v) {
  v += DPP_F(v, 0xB1); v += DPP_F(v, 0x4E); v += DPP_F(v, 0x141); v += DPP_F(v, 0x140);
  return v;
}
__device__ __forceinline__ float dpp_max16x(float v) {
  v = fmaxf(v, DPP_F(v, 0xB1)); v = fmaxf(v, DPP_F(v, 0x4E)); v = fmaxf(v, DPP_F(v, 0x141)); v = fmaxf(v, DPP_F(v, 0x140));
  return v;
}
__device__ __forceinline__ float wave_sum_fast(float v) {
  v = dpp_sum16x(v);
  return (rdlane_f(v, 0) + rdlane_f(v, 16)) + (rdlane_f(v, 32) + rdlane_f(v, 48));
}
__device__ __forceinline__ float wave_max_fast(float v) {
  v = dpp_max16x(v);
  return fmaxf(fmaxf(rdlane_f(v, 0), rdlane_f(v, 16)), fmaxf(rdlane_f(v, 32), rdlane_f(v, 48)));
}
__device__ __forceinline__ float fast_tanh(float x) { const float e = __expf(2.f * x); return 1.f - 2.f / (e + 1.f); }


__device__ __forceinline__ float4 bf4_to_f4(uint2 u) {
  float4 r;
  r.x = __uint_as_float(u.x << 16); r.y = __uint_as_float(u.x & 0xffff0000u);
  r.z = __uint_as_float(u.y << 16); r.w = __uint_as_float(u.y & 0xffff0000u);
  return r;
}
__device__ __forceinline__ uint2 pack4(float a, float b, float c, float d) { uint2 r; r.x = cvtpk(a, b); r.y = cvtpk(c, d); return r; }
#define XCD_GROUP (VBID & 7)
#define XCD_LB (VBID >> 3)
#define XCD_NB ((VGRID + 7 - (VBID & 7)) >> 3)

struct EpiInproj {
  static constexpr bool PERM = true, AFTER_DRAIN = false;
  const float* rope; bf16_t* Q; bf16_t* K; bf16_t* V; bf16_t* FE;
  __device__ __forceinline__ void operator()(const pg8::f32x4 (&acc)[2][2][4][2], const pg8::Unit& u, int wr, int wc, int fr, int fq) const {
#pragma unroll
    for (int bj = 0; bj < 2; ++bj) {
      const int s0 = u.pn * 256 + bj * 128 + wc * 32 + 8 * fq;
      const int hb = s0 & ~63, f0 = ((s0 & 63) >> 3) << 2;
      if (hb + f0 >= INW) continue;
#pragma unroll
      for (int ai = 0; ai < 2; ++ai)
#pragma unroll
        for (int m = 0; m < 4; ++m) {
          const int t = u.pm * 256 + ai * 128 + wr * 64 + m * 16 + fr;
          const pg8::f32x4 v0 = acc[ai][bj][m][0], v1 = acc[ai][bj][m][1];
          if (hb < 1024) {
            const int pos = t & (SEQ - 1);
            const float4 c01 = *(const float4*)(rope + (size_t)(pos * 32 + f0) * 2);
            const float4 c23 = *(const float4*)(rope + (size_t)(pos * 32 + f0) * 2 + 4);
            const float cs[4] = {c01.x, c01.z, c23.x, c23.z}, sn[4] = {c01.y, c01.w, c23.y, c23.w};
            const float sc = (hb < 512) ? 0.125f : 1.f;
            float o1[4], o2[4];
#pragma unroll
            for (int j = 0; j < 4; ++j) { o1[j] = (v0[j] * cs[j] - v1[j] * sn[j]) * sc; o2[j] = (v1[j] * cs[j] + v0[j] * sn[j]) * sc; }
            bf16_t* dst = (hb < 512) ? (Q + (size_t)t * 512 + hb + f0) : (K + (size_t)t * 512 + (hb - 512) + f0);
            *(uint2*)dst = pack4(o1[0], o1[1], o1[2], o1[3]);
            *(uint2*)(dst + 32) = pack4(o2[0], o2[1], o2[2], o2[3]);
          } else if (hb < 1536) {
            bf16_t* dst = V + (size_t)t * 512 + (hb - 1024) + f0;
            *(uint2*)dst = pack4(v0[0], v0[1], v0[2], v0[3]);
            *(uint2*)(dst + 32) = pack4(v1[0], v1[1], v1[2], v1[3]);
          } else {
            bf16_t* dst = FE + (size_t)t * FEW + (hb - 1536) + f0;
            *(uint2*)dst = pack4(v0[0], v0[1], v0[2], v0[3]);
            if (hb + f0 + 32 < INW) *(uint2*)(dst + 32) = pack4(v1[0], v1[1], v1[2], v1[3]);
          }
        }
    }
  }
};
__device__ __forceinline__ void phase_inproj(const Params& p, char* smem_all) {
  pg8::Gemm g{(const pg8::bf16_t*)(p.ws + OFF_XB), (const pg8::bf16_t*)(p.ws + OFF_WINT), T_TOK, 3584, DM};
  pg8::StaticOrder S; S.init(T_TOK, 3584, (int)gridDim.x, (int)blockIdx.x);
  EpiInproj E{(const float*)(p.ws + OFF_ROPE), (bf16_t*)(p.ws + OFF_Q), (bf16_t*)(p.ws + OFF_K), (bf16_t*)(p.ws + OFF_V), (bf16_t*)(p.ws + OFF_FEATS)};
  pg8::gemm_phase<EpiInproj, pg8::StaticOrder, true, true>((PG8_LAS unsigned char*)smem_all, g, S, E);
}

__device__ __forceinline__ void phase_prep_a(const Params& p) {
  const bf16_t* __restrict__ FE = (const bf16_t*)(p.ws + OFF_FEATS);
  const float* __restrict__ mu = p.in[2];
  bf16_t* R = (bf16_t*)(p.ws + OFF_R); bf16_t* K2 = (bf16_t*)(p.ws + OFF_K2); bf16_t* V2 = (bf16_t*)(p.ws + OFF_V2);
  bf16_t* ACT = (bf16_t*)(p.ws + OFF_ACT);
  for (size_t i = (size_t)VBID * NTHR + VTID; i < (size_t)T_TOK * 232; i += (size_t)VGRID * NTHR) {
    const int t = (int)(i / 232), ch = (int)(i - (size_t)t * 232);
    if (ch >= 228) { *(uint4*)(ACT + (size_t)t * 320 + 288 + (ch - 228) * 8) = make_uint4(0u, 0u, 0u, 0u); continue; }
    const int col = ch * 8;
    const uint4 cu = *(const uint4*)(FE + (size_t)t * FEW + col);
    uint4 pv = make_uint4(0u, 0u, 0u, 0u);
    if ((t & (SEQ - 1)) != 0) pv = *(const uint4*)(FE + (size_t)(t - 1) * FEW + col);
    const float4 m0 = *(const float4*)(mu + col), m1 = *(const float4*)(mu + col + 4);
    const unsigned cw[4] = {cu.x, cu.y, cu.z, cu.w}, pw[4] = {pv.x, pv.y, pv.z, pv.w};
    const float mm[8] = {m0.x, m0.y, m0.z, m0.w, m1.x, m1.y, m1.z, m1.w};
    float f[8];
#pragma unroll
    for (int q = 0; q < 4; ++q) {
      const float c0 = __uint_as_float(cw[q] << 16), c1 = __uint_as_float(cw[q] & 0xffff0000u);
      const float p0 = __uint_as_float(pw[q] << 16), p1 = __uint_as_float(pw[q] & 0xffff0000u);
      f[2 * q] = c0 + (p0 - c0) * mm[2 * q];
      f[2 * q + 1] = c1 + (p1 - c1) * mm[2 * q + 1];
    }
    bf16_t* dst;
    if (col < 512) dst = R + (size_t)t * 512 + col;
    else if (col < 1024) dst = K2 + (size_t)t * 512 + (col - 512);
    else if (col < 1536) dst = V2 + (size_t)t * 512 + (col - 1024);
    else {
      dst = ACT + (size_t)t * 320 + (col - 1536);
      if (col < 1600) {
#pragma unroll
        for (int q = 0; q < 8; ++q) f[q] = fast_tanh(f[q]);
      } else if (col >= 1664) {
#pragma unroll
        for (int q = 0; q < 8; ++q) f[q] = sigmoidf_(f[q]);
      }
    }
    uint4 w; w.x = cvtpk(f[0], f[1]); w.y = cvtpk(f[2], f[3]); w.z = cvtpk(f[4], f[5]); w.w = cvtpk(f[6], f[7]);
    *(uint4*)dst = w;
  }
}

template <int PASS>
__device__ __forceinline__ void prep_item(const Params& p, char* smem, const int row0, const int col0) {
  const bf16_t* __restrict__ ACT = (const bf16_t*)(p.ws + OFF_ACT);
  constexpr int ACOL = PASS * 64;
  constexpr int NK = (PASS == 2) ? 3 : 1;
  const float* __restrict__ Wm = (PASS == 0) ? p.in[4] : (PASS == 1) ? p.in[6] : p.in[7];
  f32x4 acc[4][4];
  acc_zero(acc);
  gemm128_acc<0, (PASS == 2)>(acc, smem, NK,
      [=](int, int rowl, int kc) { return *(const uint4*)(ACT + (size_t)(row0 + rowl) * 320 + ACOL + kc * 8); },
      [=](int nq) { return Wm + col0 + nq * 4; }, 512, 160);
  int tid_l_ = VTID; asm volatile("" : "+v"(tid_l_)); const int tid = tid_l_, lane = tid & 63, wid = tid >> 6;
  const int wr = wid >> 1, wc = wid & 1, fr = lane & 15, fq = lane >> 4;
  const int cb = col0 + wc * 64;
  if (PASS == 0) {
    const float* __restrict__ w0 = p.in[3];
    float* W = (float*)(p.ws + OFF_W);
#pragma unroll
    for (int n = 0; n < 4; ++n) {
      const int c = cb + n * 16 + fq * 4;
      const float4 w04 = *(const float4*)(w0 + c);
      const float w0c[4] = {w04.x, w04.y, w04.z, w04.w};
#pragma unroll
      for (int m = 0; m < 4; ++m) {
        const int t = row0 + wr * 64 + m * 16 + fr;
        float d[4];
#pragma unroll
        for (int j = 0; j < 4; ++j) {
          const float nz = -(w0c[j] + acc[m][n][j]);
          const float sp = fmaxf(nz, 0.f) + __logf(1.f + __expf(-fabsf(nz)));
          d[j] = __expf(-__expf(-sp - 0.5f));
        }
        *(float4*)(W + (size_t)t * 512 + c) = make_float4(d[0], d[1], d[2], d[3]);
      }
    }
  } else if (PASS == 2) {
    bf16_t* G = (bf16_t*)(p.ws + OFF_G);
#pragma unroll
    for (int m = 0; m < 4; ++m) {
      const int t = row0 + wr * 64 + m * 16 + fr;
#pragma unroll
      for (int n = 0; n < 4; ++n)
        *(uint2*)(G + (size_t)t * 512 + cb + n * 16 + fq * 4) = pack4(acc[m][n][0], acc[m][n][1], acc[m][n][2], acc[m][n][3]);
    }
  } else {
    const float* __restrict__ a0 = p.in[5]; const float* __restrict__ k_k = p.in[8]; const float* __restrict__ k_a = p.in[9];
    const float* __restrict__ r_k = p.in[10];
    const bf16_t* __restrict__ R = (const bf16_t*)(p.ws + OFF_R); bf16_t* K2 = (bf16_t*)(p.ws + OFF_K2);
    bf16_t* A = (bf16_t*)(p.ws + OFF_A); bf16_t* B = (bf16_t*)(p.ws + OFF_B); float* SB = (float*)(p.ws + OFF_SB);
#pragma unroll
    for (int m = 0; m < 4; ++m) {
      __builtin_amdgcn_sched_barrier(0);
      const int t = row0 + wr * 64 + m * 16 + fr;
      float kk[4][4];
      float ssp = 0.f, sbp = 0.f;
#pragma unroll
      for (int n = 0; n < 4; ++n) {
        const int c = cb + n * 16 + fq * 4;
        const size_t o = (size_t)t * 512 + c;
        const float4 rr4 = bf4_to_f4(*(const uint2*)(R + o)), kx4 = bf4_to_f4(*(const uint2*)(K2 + o));
        const float rr[4] = {rr4.x, rr4.y, rr4.z, rr4.w}, kx[4] = {kx4.x, kx4.y, kx4.z, kx4.w};
        const float4 a04 = *(const float4*)(a0 + c), kk4 = *(const float4*)(k_k + c), ka4 = *(const float4*)(k_a + c), rk4 = *(const float4*)(r_k + c);
        const float a0c[4] = {a04.x, a04.y, a04.z, a04.w}, kkc[4] = {kk4.x, kk4.y, kk4.z, kk4.w}, kac[4] = {ka4.x, ka4.y, ka4.z, ka4.w};
        const float rkc[4] = {rk4.x, rk4.y, rk4.z, rk4.w};
        float k2[4];
#pragma unroll
        for (int j = 0; j < 4; ++j) {
          const float av = sigmoidf_(a0c[j] + acc[m][n][j]);
          acc[m][n][j] = av;
          kk[n][j] = kx[j] * kkc[j];
          k2[j] = kx[j] * (1.f + (av - 1.f) * kac[j]);
          ssp += kk[n][j] * kk[n][j];
          sbp += rr[j] * k2[j] * rkc[j];
        }
        *(uint2*)(K2 + o) = pack4(k2[0], k2[1], k2[2], k2[3]);
      }
      ssp += __shfl_xor(ssp, 16, 64); ssp += __shfl_xor(ssp, 32, 64);
      sbp += __shfl_xor(sbp, 16, 64); sbp += __shfl_xor(sbp, 32, 64);
      const float inv = 1.f / fmaxf(sqrtf(ssp), 1e-12f);
#pragma unroll
      for (int n = 0; n < 4; ++n) {
        const size_t o = (size_t)t * 512 + cb + n * 16 + fq * 4;
        *(uint2*)(A + o) = pack4(-kk[n][0] * inv, -kk[n][1] * inv, -kk[n][2] * inv, -kk[n][3] * inv);
        *(uint2*)(B + o) = pack4(kk[n][0] * inv * acc[m][n][0], kk[n][1] * inv * acc[m][n][1], kk[n][2] * inv * acc[m][n][2], kk[n][3] * inv * acc[m][n][3]);
      }
      if (fq == 0) SB[(size_t)t * 8 + (cb >> 6)] = sbp;
    }
  }
}
__device__ __forceinline__ void phase_prep(const Params& p, char* smem) {
  for (int item = VBID; item < (T_TOK / 128) * 8; item += VGRID) {
    const int pass = item >> 10, mt = (item & 1023) >> 2, nt = item & 3;
    if (pass == 0) prep_item<0>(p, smem, mt * 128, nt * 128);
    else prep_item<1>(p, smem, mt * 128, nt * 128);
  }
}

__device__ __forceinline__ float dpp_sum16(float v) {
  v += __builtin_bit_cast(float, __builtin_amdgcn_update_dpp(0, __builtin_bit_cast(int, v), 0xB1, 0xF, 0xF, true));
  v += __builtin_bit_cast(float, __builtin_amdgcn_update_dpp(0, __builtin_bit_cast(int, v), 0x4E, 0xF, 0xF, true));
  v += __builtin_bit_cast(float, __builtin_amdgcn_update_dpp(0, __builtin_bit_cast(int, v), 0x141, 0xF, 0xF, true));
  v += __builtin_bit_cast(float, __builtin_amdgcn_update_dpp(0, __builtin_bit_cast(int, v), 0x140, 0xF, 0xF, true));
  return v;
}
#define SC_CH 16
#define SC_ARR (SC_CH * 64 * 4)
#define SC_BUF (5 * SC_ARR + SC_CH * 16 * 4)
__device__ __forceinline__ void phase_scan(const Params& p, char* smem) {
  if (VHALF != 0 || blockIdx.x >= 256) return;
  const bf16_t* __restrict__ R = (const bf16_t*)(p.ws + OFF_R); const bf16_t* __restrict__ K2 = (const bf16_t*)(p.ws + OFF_K2);
  const bf16_t* __restrict__ V2 = (const bf16_t*)(p.ws + OFF_V2); const bf16_t* __restrict__ A = (const bf16_t*)(p.ws + OFF_A);
  const bf16_t* __restrict__ B = (const bf16_t*)(p.ws + OFF_B); const float* __restrict__ W = (const float*)(p.ws + OFF_W);
  float* YS = (float*)(p.ws + OFF_YS);
  const int bh = (int)blockIdx.x >> 2, rg = (int)blockIdx.x & 3, b = bh >> 3, h = bh & 7;
  int tid_l_ = VTID; asm volatile("" : "+v"(tid_l_)); const int tid = tid_l_, lane = tid & 63, wid = tid >> 6, j = lane & 15, rq = lane >> 4;
  const int rowl = wid * 4 + rq;
  const int ls = tid >> 4, lc = tid & 15;
  const int vs = (tid >> 2) & 15, vq = tid & 3;
  const size_t tb = (size_t)b * SEQ;
  const size_t goff = (tb + ls) * 512 + h * 64 + lc * 4;
  const size_t voff = (tb + vs) * 512 + h * 64 + rg * 16 + vq * 4;
  uint2 ga, gb, gk, gr, gv; float4 gw;
  gv = make_uint2(0u, 0u);
  ga = *(const uint2*)(A + goff); gb = *(const uint2*)(B + goff); gk = *(const uint2*)(K2 + goff); gr = *(const uint2*)(R + goff);
  gw = *(const float4*)(W + goff);
  if (tid < 64) gv = *(const uint2*)(V2 + voff);
  {
    char* bf = smem;
    *(float4*)(bf + 0 * SC_ARR + ls * 256 + lc * 16) = bf4_to_f4(ga);
    *(float4*)(bf + 1 * SC_ARR + ls * 256 + lc * 16) = gw;
    *(float4*)(bf + 2 * SC_ARR + ls * 256 + lc * 16) = bf4_to_f4(gb);
    *(float4*)(bf + 3 * SC_ARR + ls * 256 + lc * 16) = bf4_to_f4(gk);
    *(float4*)(bf + 4 * SC_ARR + ls * 256 + lc * 16) = bf4_to_f4(gr);
    if (tid < 64) *(float4*)(bf + 5 * SC_ARR + vs * 64 + vq * 16) = bf4_to_f4(gv);
  }
  HSYNC();
  float s0 = 0.f, s1 = 0.f, s2 = 0.f, s3 = 0.f;
  const int NCH = SEQ / SC_CH;
  for (int c = 0; c < NCH; ++c) {
    if (c + 1 < NCH) {
      const size_t o2 = goff + (size_t)(c + 1) * SC_CH * 512;
      ga = *(const uint2*)(A + o2); gb = *(const uint2*)(B + o2); gk = *(const uint2*)(K2 + o2); gr = *(const uint2*)(R + o2);
      gw = *(const float4*)(W + o2);
      if (tid < 64) gv = *(const uint2*)(V2 + voff + (size_t)(c + 1) * SC_CH * 512);
    }
    const char* bf = smem + (c & 1) * SC_BUF;
    float ykeep = 0.f;
#pragma unroll
    for (int s = 0; s < SC_CH; ++s) {
      const float4 a4 = *(const float4*)(bf + 0 * SC_ARR + s * 256 + j * 16);
      const float4 w4 = *(const float4*)(bf + 1 * SC_ARR + s * 256 + j * 16);
      const float4 b4 = *(const float4*)(bf + 2 * SC_ARR + s * 256 + j * 16);
      const float4 k4 = *(const float4*)(bf + 3 * SC_ARR + s * 256 + j * 16);
      const float4 r4 = *(const float4*)(bf + 4 * SC_ARR + s * 256 + j * 16);
      const float vv = *(const float*)(bf + 5 * SC_ARR + s * 64 + rowl * 4);
      float sa = (s0 * a4.x + s1 * a4.y) + (s2 * a4.z + s3 * a4.w);
      sa = dpp_sum16(sa);
      s0 = s0 * w4.x + (sa * b4.x + vv * k4.x);
      s1 = s1 * w4.y + (sa * b4.y + vv * k4.y);
      s2 = s2 * w4.z + (sa * b4.z + vv * k4.z);
      s3 = s3 * w4.w + (sa * b4.w + vv * k4.w);
      float y = (s0 * r4.x + s1 * r4.y) + (s2 * r4.z + s3 * r4.w);
      y = dpp_sum16(y);
      ykeep = (j == s) ? y : ykeep;
    }
    YS[(tb + (size_t)c * SC_CH + j) * 512 + h * 64 + rg * 16 + rowl] = ykeep;
    if (c + 1 < NCH) {
      char* bn = smem + ((c + 1) & 1) * SC_BUF;
      *(float4*)(bn + 0 * SC_ARR + ls * 256 + lc * 16) = bf4_to_f4(ga);
      *(float4*)(bn + 1 * SC_ARR + ls * 256 + lc * 16) = gw;
      *(float4*)(bn + 2 * SC_ARR + ls * 256 + lc * 16) = bf4_to_f4(gb);
      *(float4*)(bn + 3 * SC_ARR + ls * 256 + lc * 16) = bf4_to_f4(gk);
      *(float4*)(bn + 4 * SC_ARR + ls * 256 + lc * 16) = bf4_to_f4(gr);
      if (tid < 64) *(float4*)(bn + 5 * SC_ARR + vs * 64 + vq * 16) = bf4_to_f4(gv);
    }
    HSYNC();
  }
}


#define CONV_TILES (257 * 96)
struct ConvDesc { const float* src; bf16_t* dst; int ldn, k0, n0, kdim, part; };
__device__ __forceinline__ ConvDesc conv_desc(const Params& p, const int ti) {
  ConvDesc d;
  const int e = ti / 96, q = ti - e * 96, part = q >> 5, w = q & 31;
  d.part = part;
  if (part < 2) {
    d.src = (e < NEXP) ? p.in[18 + part] + (size_t)e * DM * 256 : p.in[21 + part];
    d.ldn = 256; d.k0 = (w >> 1) * 64; d.n0 = (w & 1) * 128; d.kdim = 1024;
    d.dst = (bf16_t*)(p.ws + OFF_EW1) + (size_t)e * 512 * 1024;
  } else {
    d.src = (e < NEXP) ? p.in[20] + (size_t)e * 256 * DM : p.in[23];
    d.ldn = 1024; d.k0 = (w >> 3) * 64; d.n0 = (w & 7) * 128; d.kdim = 256;
    d.dst = (bf16_t*)(p.ws + OFF_EW2) + (size_t)e * 1024 * 256;
  }
  return d;
}
#define CV_LOAD(d, r) { \
    const float* bp_ = (d).src + (size_t)((d).k0 + ko * 8) * (d).ldn + (d).n0 + nq * 4; \
    r##0 = *(const float4*)(bp_); r##1 = *(const float4*)(bp_ + (size_t)1 * (d).ldn); r##2 = *(const float4*)(bp_ + (size_t)2 * (d).ldn); \
    r##3 = *(const float4*)(bp_ + (size_t)3 * (d).ldn); r##4 = *(const float4*)(bp_ + (size_t)4 * (d).ldn); r##5 = *(const float4*)(bp_ + (size_t)5 * (d).ldn); \
    r##6 = *(const float4*)(bp_ + (size_t)6 * (d).ldn); r##7 = *(const float4*)(bp_ + (size_t)7 * (d).ldn); }
#define CV_LDS(r, base) { \
    uint4 v; \
    v.x = cvtpk((r##0).x, (r##1).x); v.y = cvtpk((r##2).x, (r##3).x); v.z = cvtpk((r##4).x, (r##5).x); v.w = cvtpk((r##6).x, (r##7).x); *(uint4*)((base) + lds_off(nq * 4 + 0, ko)) = v; \
    v.x = cvtpk((r##0).y, (r##1).y); v.y = cvtpk((r##2).y, (r##3).y); v.z = cvtpk((r##4).y, (r##5).y); v.w = cvtpk((r##6).y, (r##7).y); *(uint4*)((base) + lds_off(nq * 4 + 1, ko)) = v; \
    v.x = cvtpk((r##0).z, (r##1).z); v.y = cvtpk((r##2).z, (r##3).z); v.z = cvtpk((r##4).z, (r##5).z); v.w = cvtpk((r##6).z, (r##7).z); *(uint4*)((base) + lds_off(nq * 4 + 2, ko)) = v; \
    v.x = cvtpk((r##0).w, (r##1).w); v.y = cvtpk((r##2).w, (r##3).w); v.z = cvtpk((r##4).w, (r##5).w); v.w = cvtpk((r##6).w, (r##7).w); *(uint4*)((base) + lds_off(nq * 4 + 3, ko)) = v; }
#define CV_OUT(d, base) { \
    _Pragma("unroll") for (int u = 0; u < 4; ++u) { \
      const int row = (tid >> 3) + 32 * u, chunk = tid & 7; \
      const int c = (d).n0 + row; \
      const int orow = ((d).part < 2) ? ((c >> 7) * 256 + (d).part * 128 + (c & 127)) : c;     \
      *(uint4*)((d).dst + (size_t)orow * (d).kdim + (d).k0 + chunk * 8) = *(const uint4*)((base) + lds_off(row, chunk)); } }
__device__ __forceinline__ void convert_tile2(const Params& p, char* smem, const int t2) {
  int tid_l_ = VTID; asm volatile("" : "+v"(tid_l_)); const int tid = tid_l_, nq = tid & 31, ko = tid >> 5;
  const ConvDesc da = conv_desc(p, 2 * t2), db = conv_desc(p, 2 * t2 + 1);
  float4 ra0, ra1, ra2, ra3, ra4, ra5, ra6, ra7, rb0, rb1, rb2, rb3, rb4, rb5, rb6, rb7;
  CV_LOAD(da, ra)
  CV_LOAD(db, rb)
  CV_LDS(ra, smem)
  CV_LDS(rb, smem + 16384)
  HSYNC();
  CV_OUT(da, smem)
  CV_OUT(db, smem + 16384)
  HSYNC();
}
#undef CV_LOAD
#undef CV_LDS
#undef CV_OUT

__device__ __forceinline__ int vt_off(int d, int key) { const int swz = ((d >> 2) & 15) ^ ((d & 3) << 3); return d * 512 + (((key >> 2) ^ swz) << 3); }
__device__ __forceinline__ void attn_item(const Params& p, char* smem, const int item) {
  const bf16_t* __restrict__ Q = (const bf16_t*)(p.ws + OFF_Q); const bf16_t* __restrict__ K = (const bf16_t*)(p.ws + OFF_K);
  const bf16_t* __restrict__ V = (const bf16_t*)(p.ws + OFF_V);
  bf16_t* OP = (bf16_t*)(p.ws + OFF_OP); float* LSE = (float*)(p.ws + OFF_LSE);
  char* Ks = smem; char* VT = smem + 32768; float* linv_s = (float*)(smem + 65536);
  int tid_l_ = VTID; asm volatile("" : "+v"(tid_l_)); const int tid = tid_l_, lane = tid & 63, wid = tid >> 6, l31 = lane & 31, hi = lane >> 5;
  {
    const int pp = item >> 11, rem = item & 2047, bh = rem >> 5, sub = rem & 31;
    const int dsh = pp * 2, nbsh = 5 - dsh;
    const int r = sub >> nbsh, n = sub & ((1 << nbsh) - 1);
    const int b = bh >> 3, h = bh & 7, tb = b * SEQ;
    HSYNC();
#pragma unroll
    for (int u = 0; u < 8; ++u) {
      if (u == 4) __builtin_amdgcn_sched_barrier(0);
      const int row = (tid >> 3) + 32 * u, chunk = tid & 7;
      int ik = n * 128 - 128 + row; ik = ik < 0 ? 0 : ik;
      const int tok = tb + (ik << dsh) + r;
      *(uint4*)(Ks + lds_off(row, chunk)) = *(const uint4*)(K + (size_t)tok * 512 + h * 64 + chunk * 8);
    }
#pragma unroll
    for (int ps = 0; ps < 2; ++ps) {
      const int dq = tid & 15, kbase = ps * 128 + (tid >> 4) * 8;
      uint2 v0, v1, v2, v3, v4, v5, v6, v7;
#define LDV(i, dst) { int ik = n * 128 - 128 + kbase + i; ik = ik < 0 ? 0 : ik; const int tok = tb + (ik << dsh) + r; dst = *(const uint2*)(V + (size_t)tok * 512 + h * 64 + dq * 4); }
      LDV(0, v0) LDV(1, v1) LDV(2, v2) LDV(3, v3) LDV(4, v4) LDV(5, v5) LDV(6, v6) LDV(7, v7)
#undef LDV
      {
        uint2 w;
        w.x = (v0.x & 0xffffu) | (v1.x << 16); w.y = (v2.x & 0xffffu) | (v3.x << 16);
        *(uint2*)(VT + vt_off(dq * 4 + 0, kbase)) = w;
        w.x = (v4.x & 0xffffu) | (v5.x << 16); w.y = (v6.x & 0xffffu) | (v7.x << 16);
        *(uint2*)(VT + vt_off(dq * 4 + 0, kbase + 4)) = w;
        w.x = (v0.x >> 16) | (v1.x & 0xffff0000u); w.y = (v2.x >> 16) | (v3.x & 0xffff0000u);
        *(uint2*)(VT + vt_off(dq * 4 + 1, kbase)) = w;
        w.x = (v4.x >> 16) | (v5.x & 0xffff0000u); w.y = (v6.x >> 16) | (v7.x & 0xffff0000u);
        *(uint2*)(VT + vt_off(dq * 4 + 1, kbase + 4)) = w;
        w.x = (v0.y & 0xffffu) | (v1.y << 16); w.y = (v2.y & 0xffffu) | (v3.y << 16);
        *(uint2*)(VT + vt_off(dq * 4 + 2, kbase)) = w;
        w.x = (v4.y & 0xffffu) | (v5.y << 16); w.y = (v6.y & 0xffffu) | (v7.y << 16);
        *(uint2*)(VT + vt_off(dq * 4 + 2, kbase + 4)) = w;
        w.x = (v0.y >> 16) | (v1.y & 0xffff0000u); w.y = (v2.y >> 16) | (v3.y & 0xffff0000u);
        *(uint2*)(VT + vt_off(dq * 4 + 3, kbase)) = w;
        w.x = (v4.y >> 16) | (v5.y & 0xffff0000u); w.y = (v6.y >> 16) | (v7.y & 0xffff0000u);
        *(uint2*)(VT + vt_off(dq * 4 + 3, kbase + 4)) = w;
      }
    }
    HSYNC();
    const int iq = n * 128 + wid * 32 + l31;
    const int tq = tb + (iq << dsh) + r;
    bf16x8 qf[4];
#pragma unroll
    for (int ks = 0; ks < 4; ++ks) qf[ks] = *(const bf16x8*)(Q + (size_t)tq * 512 + h * 64 + ks * 16 + hi * 8);
    f32x16 st[5];
#pragma unroll
    for (int kb = 0; kb < 5; ++kb) {
      st[kb] = (f32x16){0.f, 0.f, 0.f, 0.f, 0.f, 0.f, 0.f, 0.f, 0.f, 0.f, 0.f, 0.f, 0.f, 0.f, 0.f, 0.f};
#pragma unroll
      for (int ks = 0; ks < 4; ++ks) {
        const bf16x8 kf = *(const bf16x8*)(Ks + lds_off(32 * (wid + kb) + l31, 2 * ks + hi));
        st[kb] = __builtin_amdgcn_mfma_f32_32x32x16_bf16(kf, qf[ks], st[kb], 0, 0, 0);
      }
    }
    float m = -INFINITY;
#pragma unroll
    for (int kb = 0; kb < 5; ++kb)
#pragma unroll
      for (int i = 0; i < 16; ++i) {
        const int kirel = 32 * kb + (i & 3) + 8 * (i >> 2) + 4 * hi;
        const bool valid = (kirel >= l31) && (kirel <= l31 + 128) && (n > 0 || (32 * wid + kirel) >= 128);
        const float s = valid ? st[kb][i] : -INFINITY;
        st[kb][i] = s;
        m = fmaxf(m, s);
      }
    m = fmaxf(m, __shfl_xor(m, 32, 64));
    float l = 0.f;
#pragma unroll
    for (int kb = 0; kb < 5; ++kb)
#pragma unroll
      for (int i = 0; i < 16; ++i) { const float pe = __expf(st[kb][i] - m); st[kb][i] = pe; l += pe; }
    l += __shfl_xor(l, 32, 64);
    f32x16 o0 = (f32x16){0.f, 0.f, 0.f, 0.f, 0.f, 0.f, 0.f, 0.f, 0.f, 0.f, 0.f, 0.f, 0.f, 0.f, 0.f, 0.f};
    f32x16 o1 = o0;
#pragma unroll
    for (int kb = 0; kb < 5; ++kb)
#pragma unroll
      for (int s = 0; s < 2; ++s) {
        union { unsigned u[4]; bf16x8 v; } pa;
        pa.u[0] = cvtpk(st[kb][8 * s + 0], st[kb][8 * s + 1]); pa.u[1] = cvtpk(st[kb][8 * s + 2], st[kb][8 * s + 3]);
        pa.u[2] = cvtpk(st[kb][8 * s + 4], st[kb][8 * s + 5]); pa.u[3] = cvtpk(st[kb][8 * s + 6], st[kb][8 * s + 7]);
        const int key0 = 32 * (wid + kb) + 16 * s + 4 * hi;
        {
          union { uint2 u[2]; bf16x8 v; } vb;
          vb.u[0] = *(const uint2*)(VT + vt_off(l31, key0)); vb.u[1] = *(const uint2*)(VT + vt_off(l31, key0 + 8));
          o0 = __builtin_amdgcn_mfma_f32_32x32x16_bf16(pa.v, vb.v, o0, 0, 0, 0);
        }
        {
          union { uint2 u[2]; bf16x8 v; } vb;
          vb.u[0] = *(const uint2*)(VT + vt_off(32 + l31, key0)); vb.u[1] = *(const uint2*)(VT + vt_off(32 + l31, key0 + 8));
          o1 = __builtin_amdgcn_mfma_f32_32x32x16_bf16(pa.v, vb.v, o1, 0, 0, 0);
        }
      }
    if (hi == 0) {
      linv_s[wid * 32 + l31] = 1.f / l;
      LSE[((size_t)pp * T_TOK + tq) * 8 + h] = m + __logf(l);
    }
#pragma unroll
    for (int i = 0; i < 16; ++i) {
      const int qrel = (i & 3) + 8 * (i >> 2) + 4 * hi;
      const int iq2 = n * 128 + wid * 32 + qrel;
      const int tq2 = tb + (iq2 << dsh) + r;
      const float li = linv_s[wid * 32 + qrel];
      bf16_t* op = OP + ((size_t)pp * T_TOK + tq2) * 512 + h * 64 + l31;
      op[0] = f2bf(o0[i] * li);
      op[32] = f2bf(o1[i] * li);
    }
  }
}

__device__ __forceinline__ void phase_convert(const Params& p, char* smem) {
  int* ctl = (int*)(p.ws + OFF_CTL);
  int* slot = (int*)(smem + 66304);
  HSYNC();
  int ti;
  for (;;) {
    if (VTID == 0) *slot = atomicAdd(&ctl[CTL_CONVQ], 1);
    HSYNC();
    ti = *slot;
    HSYNC();
    if (ti >= 6144) break;
    attn_item(p, smem, ti);
  }
  __builtin_amdgcn_sched_barrier(0);
  for (;;) {
    if (ti >= 7168 + CONV_TILES / 2) break;
    if (ti < 7168) prep_item<2>(p, smem, ((ti - 6144) >> 2) * 128, ((ti - 6144) & 3) * 128);
    else convert_tile2(p, smem, ti - 7168);
    if (VTID == 0) *slot = atomicAdd(&ctl[CTL_CONVQ], 1);
    HSYNC();
    ti = *slot;
    HSYNC();
  }
}

__device__ __forceinline__ void unpack8(const uint4 u, float (&f)[8]) {
  f[0] = __uint_as_float(u.x << 16); f[1] = __uint_as_float(u.x & 0xffff0000u); f[2] = __uint_as_float(u.y << 16); f[3] = __uint_as_float(u.y & 0xffff0000u);
  f[4] = __uint_as_float(u.z << 16); f[5] = __uint_as_float(u.z & 0xffff0000u); f[6] = __uint_as_float(u.w << 16); f[7] = __uint_as_float(u.w & 0xffff0000u);
}
__device__ __forceinline__ float dpp_sum8(float v) {
  v += DPP_F(v, 0xB1); v += DPP_F(v, 0x4E); v += DPP_F(v, 0x141);
  return v;
}
__device__ __forceinline__ void phase_post(const Params& p) {
  const float* __restrict__ YS = (const float*)(p.ws + OFF_YS); const bf16_t* __restrict__ V2 = (const bf16_t*)(p.ws + OFF_V2);
  const bf16_t* __restrict__ G = (const bf16_t*)(p.ws + OFF_G); const float* __restrict__ SB = (const float*)(p.ws + OFF_SB);
  const bf16_t* __restrict__ OP = (const bf16_t*)(p.ws + OFF_OP); const float* __restrict__ LSE = (const float*)(p.ws + OFF_LSE);
  const float* __restrict__ lnx_g = p.in[11]; const float* __restrict__ lnx_b = p.in[12];
  bf16_t* MIXED = (bf16_t*)(p.ws + OFF_MIXED);
  const int lane = VTID & 63, wid = VTID >> 6;
  const int c = lane * 8, hh = lane >> 3;
  const float4 g0 = *(const float4*)(lnx_g + c), g1 = *(const float4*)(lnx_g + c + 4), b0 = *(const float4*)(lnx_b + c), b1 = *(const float4*)(lnx_b + c + 4);
  const float gg[8] = {g0.x, g0.y, g0.z, g0.w, g1.x, g1.y, g1.z, g1.w}, bb[8] = {b0.x, b0.y, b0.z, b0.w, b1.x, b1.y, b1.z, b1.w};
  for (int t = VBID * 4 + wid; t < T_TOK; t += VGRID * 4) {
    const size_t o = (size_t)t * 512 + c;
    const float4 y0 = *(const float4*)(YS + o), y1 = *(const float4*)(YS + o + 4);
    const float y[8] = {y0.x, y0.y, y0.z, y0.w, y1.x, y1.y, y1.z, y1.w};
    float s = 0.f;
#pragma unroll
    for (int i = 0; i < 8; ++i) s += y[i];
    const float mean = dpp_sum8(s) * (1.f / 64.f);
    float q = 0.f;
#pragma unroll
    for (int i = 0; i < 8; ++i) { const float d = y[i] - mean; q += d * d; }
    const float rs = rsqrtf(dpp_sum8(q) * (1.f / 64.f) + GN_EPS_F);
    float v2[8], gt[8];
    unpack8(*(const uint4*)(V2 + o), v2); unpack8(*(const uint4*)(G + o), gt);
    const float sb = SB[(size_t)t * 8 + hh];
    float res[8];
#pragma unroll
    for (int i = 0; i < 8; ++i) res[i] = ((y[i] - mean) * rs * gg[i] + bb[i] + sb * v2[i]) * gt[i];
    uint4 w; w.x = cvtpk(res[0], res[1]); w.y = cvtpk(res[2], res[3]); w.z = cvtpk(res[4], res[5]); w.w = cvtpk(res[6], res[7]);
    *(uint4*)(MIXED + (size_t)t * 1024 + 512 + c) = w;
    const float l0 = LSE[((size_t)0 * T_TOK + t) * 8 + hh], l1 = LSE[((size_t)1 * T_TOK + t) * 8 + hh], l2 = LSE[((size_t)2 * T_TOK + t) * 8 + hh];
    const float mx = fmaxf(l0, fmaxf(l1, l2));
    float e0 = __expf(l0 - mx), e1 = __expf(l1 - mx), e2 = __expf(l2 - mx);
    const float inv = 1.f / (e0 + e1 + e2);
    e0 *= inv; e1 *= inv; e2 *= inv;
    float o0[8], o1[8], o2[8];
    unpack8(*(const uint4*)(OP + (size_t)0 * T_TOK * 512 + o), o0); unpack8(*(const uint4*)(OP + (size_t)1 * T_TOK * 512 + o), o1);
    unpack8(*(const uint4*)(OP + (size_t)2 * T_TOK * 512 + o), o2);
    float av[8];
#pragma unroll
    for (int i = 0; i < 8; ++i) av[i] = e0 * o0[i] + e1 * o1[i] + e2 * o2[i];
    w.x = cvtpk(av[0], av[1]); w.y = cvtpk(av[2], av[3]); w.z = cvtpk(av[4], av[5]); w.w = cvtpk(av[6], av[7]);
    *(uint4*)(MIXED + (size_t)t * 1024 + c) = w;
  }
}

struct EpiOutproj {
  static constexpr bool PERM = true, AFTER_DRAIN = false;
  const float* x; float* U;
  __device__ __forceinline__ void operator()(const pg8::f32x4 (&acc)[2][2][4][2], const pg8::Unit& u, int wr, int wc, int fr, int fq) const {
#pragma unroll
    for (int ai = 0; ai < 2; ++ai)
#pragma unroll
      for (int m = 0; m < 4; ++m) {
        const int t = u.pm * 256 + ai * 128 + wr * 64 + m * 16 + fr;
#pragma unroll
        for (int bj = 0; bj < 2; ++bj) {
          const size_t o = (size_t)t * DM + u.pn * 256 + bj * 128 + wc * 32 + 8 * fq;
          const float4 x0 = *(const float4*)(x + o), x1 = *(const float4*)(x + o + 4);
          const pg8::f32x4 v0 = acc[ai][bj][m][0], v1 = acc[ai][bj][m][1];
          *(float4*)(U + o) = make_float4(ALPHA_F * x0.x + v0[0], ALPHA_F * x0.y + v0[1], ALPHA_F * x0.z + v0[2], ALPHA_F * x0.w + v0[3]);
          *(float4*)(U + o + 4) = make_float4(ALPHA_F * x1.x + v1[0], ALPHA_F * x1.y + v1[1], ALPHA_F * x1.z + v1[2], ALPHA_F * x1.w + v1[3]);
        }
      }
  }
};
__device__ __forceinline__ void phase_outproj(const Params& p, char* smem_all) {
  pg8::Gemm g{(const pg8::bf16_t*)(p.ws + OFF_MIXED), (const pg8::bf16_t*)(p.ws + OFF_WOUTT), T_TOK, DM, DM};
  pg8::StaticOrder S; S.init(T_TOK, DM, (int)gridDim.x, (int)blockIdx.x);
  EpiOutproj E{p.in[0], p.out};
  pg8::gemm_phase<EpiOutproj, pg8::StaticOrder, true, true>((PG8_LAS unsigned char*)smem_all, g, S, E);
}

__device__ __forceinline__ void phase_ln1(const Params& p) {
  float* X1 = p.out;
  const float* __restrict__ g1 = p.in[14]; const float* __restrict__ b1 = p.in[15];
  bf16_t* X1B = (bf16_t*)(p.ws + OFF_X1B);
  const int lane = VTID & 63, wid = VTID >> 6;
  for (int t = VBID * 4 + wid; t < T_TOK; t += VGRID * 4) {
    const size_t base = (size_t)t * DM;
    float4 v[4];
    float s = 0.f;
#pragma unroll
    for (int u = 0; u < 4; ++u) { v[u] = *(const float4*)(X1 + base + u * 256 + lane * 4); s += (v[u].x + v[u].y) + (v[u].z + v[u].w); }
    const float mean = wave_sum_fast(s) * (1.f / DM);
    float q = 0.f;
#pragma unroll
    for (int u = 0; u < 4; ++u) {
      const float d0 = v[u].x - mean, d1 = v[u].y - mean, d2 = v[u].z - mean, d3 = v[u].w - mean;
      q += (d0 * d0 + d1 * d1) + (d2 * d2 + d3 * d3);
    }
    const float rs = rsqrtf(wave_sum_fast(q) * (1.f / DM) + LN_EPS_F);
#pragma unroll
    for (int u = 0; u < 4; ++u) {
      const int c = u * 256 + lane * 4;
      const float4 g = *(const float4*)(g1 + c), bb = *(const float4*)(b1 + c);
      float4 y;
      y.x = (v[u].x - mean) * rs * g.x + bb.x; y.y = (v[u].y - mean) * rs * g.y + bb.y;
      y.z = (v[u].z - mean) * rs * g.z + bb.z; y.w = (v[u].w - mean) * rs * g.w + bb.w;
      *(float4*)(X1 + base + c) = y;
      uint2 hi; hi.x = cvtpk(y.x, y.y); hi.y = cvtpk(y.z, y.w);
      *(uint2*)(X1B + base + c) = hi;
    }
  }
}

__device__ __forceinline__ void phase_router_gemm(const Params& p, char* smem) {
  const bf16_t* __restrict__ X1B = (const bf16_t*)(p.ws + OFF_X1B);
  const float* __restrict__ router_w = p.in[16];
  float* AFF = (float*)(p.ws + OFF_AFF);
  for (int item = VBID; item < (T_TOK / 128) * 2; item += VGRID) {
    const int row0 = (item >> 1) * 128, col0 = (item & 1) * 128;
    f32x4 acc[4][4];
    acc_zero(acc);
    gemm128_acc<0, false>(acc, smem, 16,
        [=](int, int rowl, int kc) { return *(const uint4*)(X1B + (size_t)(row0 + rowl) * DM + kc * 8); },
        [=](int nq) { return router_w + col0 + nq * 4; }, NEXP, 0);
    int tid_l_ = VTID; asm volatile("" : "+v"(tid_l_)); const int tid = tid_l_, lane = tid & 63, wid = tid >> 6;
    const int wr = wid >> 1, wc = wid & 1, fr = lane & 15, fq = lane >> 4;
#pragma unroll
    for (int m = 0; m < 4; ++m) {
      const int t = row0 + wr * 64 + m * 16 + fr;
#pragma unroll
      for (int n = 0; n < 4; ++n)
        *(float4*)(AFF + (size_t)t * NEXP + col0 + wc * 64 + n * 16 + fq * 4) =
            make_float4(sigmoidf_(acc[m][n][0]), sigmoidf_(acc[m][n][1]), sigmoidf_(acc[m][n][2]), sigmoidf_(acc[m][n][3]));
    }
  }
}

__device__ __forceinline__ void phase_topk(const Params& p) {
  const float* __restrict__ AFF = (const float*)(p.ws + OFF_AFF);
  const float* __restrict__ router_bias = p.in[17];
  int* LIST = (int*)(p.ws + OFF_LIST); float* GATEW = (float*)(p.ws + OFF_GATEW);
  int* counts = (int*)(p.ws + OFF_CTL);
  const int lane = VTID & 63, wid = VTID >> 6;
  const float4 b4 = *(const float4*)(router_bias + lane * 4);
  for (int t = VBID * 4 + wid; t < T_TOK; t += VGRID * 4) {
    const float4 a4 = *(const float4*)(AFF + (size_t)t * NEXP + lane * 4);
    float s0 = a4.x + b4.x, s1 = a4.y + b4.y, s2 = a4.z + b4.z, s3 = a4.w + b4.w;
    const float hi01 = fmaxf(s0, s1), lo01 = fminf(s0, s1), hi23 = fmaxf(s2, s3), lo23 = fminf(s2, s3);
    float m1 = fmaxf(hi01, hi23), m2 = fmaxf(fminf(hi01, hi23), fmaxf(lo01, lo23));
    { const float o1 = DPP_F(m1, 0xB1), o2 = DPP_F(m2, 0xB1); const float n1 = fmaxf(m1, o1); m2 = fmaxf(fminf(m1, o1), fmaxf(m2, o2)); m1 = n1; }
    { const float o1 = DPP_F(m1, 0x4E), o2 = DPP_F(m2, 0x4E); const float n1 = fmaxf(m1, o1); m2 = fmaxf(fminf(m1, o1), fmaxf(m2, o2)); m1 = n1; }
    { const float o1 = DPP_F(m1, 0x141), o2 = DPP_F(m2, 0x141); const float n1 = fmaxf(m1, o1); m2 = fmaxf(fminf(m1, o1), fmaxf(m2, o2)); m1 = n1; }
    const float gs = m1 + m2;
    const int g = lane >> 3;
    int rank = 0;
#pragma unroll
    for (int gg = 0; gg < 8; ++gg) { const float G = rdlane_f(gs, gg * 8); rank += ((G > gs) || (G == gs && gg < g)) ? 1 : 0; }
    if (rank >= 4) { s0 = -INFINITY; s1 = -INFINITY; s2 = -INFINITY; s3 = -INFINITY; }
    int my_e = 0; float my_a = 0.f;
#pragma unroll 1
    for (int it = 0; it < 8; ++it) {
      const float lm = fmaxf(fmaxf(s0, s1), fmaxf(s2, s3));
      const float wm = wave_max_fast(lm);
      const unsigned long long bal = __ballot(lm == wm);
      const int win = __ffsll((long long)bal) - 1;
      const int wi = (s0 == wm) ? 0 : ((s1 == wm) ? 1 : ((s2 == wm) ? 2 : 3));
      const float wa = (wi == 0) ? a4.x : ((wi == 1) ? a4.y : ((wi == 2) ? a4.z : a4.w));
      const int e_w = __builtin_amdgcn_readlane(lane * 4 + wi, win);
      const float a_w = rdlane_f(wa, win);
      if (lane == win) { if (wi == 0) s0 = -INFINITY; else if (wi == 1) s1 = -INFINITY; else if (wi == 2) s2 = -INFINITY; else s3 = -INFINITY; }
      if (lane == it) { my_e = e_w; my_a = a_w; }
    }
    const float asum = rdlane_f(dpp_sum16x(my_a), 0);
    if (lane < 8) {
      const int pos = atomicAdd(&counts[CNT(my_e)], 1);
      if (pos < LCAP) LIST[(size_t)my_e * LCAP + pos] = lane * T_TOK + t;
      GATEW[(size_t)lane * T_TOK + t] = my_a * 2.5f / asum;
    }
  }
}

#define CTL_MOEPRE 1536
__device__ __forceinline__ void phase_moe_prefix(const Params& p) {
  if (VBID == 0 && VTID == 0) {
    int* ctl = (int*)(p.ws + OFF_CTL);
    int acc = 0;
    for (int e = 0; e < NEXP; ++e) { ctl[CTL_MOEPRE + e] = acc; acc += (min(ctl[CNT(e)], LCAP) + 255) >> 8; }
    ctl[CTL_MOEPRE + NEXP] = acc; acc += T_TOK / 256;
    ctl[CTL_MOEPRE + NEXP + 1] = acc;
  }
}
struct SeqOrder {
  int n;
  __device__ __forceinline__ bool next(int i, pg8::Unit& u) const { if (i >= n) return false; u.pm = 0; u.pn = i; return true; }
  __device__ __forceinline__ void a_ready(const pg8::Unit&) const {}
  __device__ __forceinline__ void done(const pg8::Unit&) const {}
};
struct EpiMoe1 {
  static constexpr bool PERM = true, AFTER_DRAIN = false;
  bf16_t* HS;
  __device__ __forceinline__ void operator()(const pg8::f32x4 (&acc)[2][2][4][2], const pg8::Unit& u, int wr, int wc, int fr, int fq) const {
#pragma unroll
    for (int ai = 0; ai < 2; ++ai)
#pragma unroll
      for (int m = 0; m < 4; ++m) {
        __builtin_amdgcn_sched_barrier(0);
        const int row = ai * 128 + wr * 64 + m * 16 + fr;
        const pg8::f32x4 g0 = acc[ai][0][m][0], g1 = acc[ai][0][m][1], u0 = acc[ai][1][m][0], u1 = acc[ai][1][m][1];
        uint4 w;
        w.x = cvtpk(g0[0] * sigmoidf_(g0[0]) * u0[0], g0[1] * sigmoidf_(g0[1]) * u0[1]);
        w.y = cvtpk(g0[2] * sigmoidf_(g0[2]) * u0[2], g0[3] * sigmoidf_(g0[3]) * u0[3]);
        w.z = cvtpk(g1[0] * sigmoidf_(g1[0]) * u1[0], g1[1] * sigmoidf_(g1[1]) * u1[1]);
        w.w = cvtpk(g1[2] * sigmoidf_(g1[2]) * u1[2], g1[3] * sigmoidf_(g1[3]) * u1[3]);
        *(uint4*)(HS + (size_t)row * 256 + u.pn * 128 + wc * 32 + 8 * fq) = w;
      }
  }
};
struct EpiMoe2 {
  static constexpr bool PERM = true, AFTER_DRAIN = false;
  const int* asg; const float* GATEW; bf16_t* Y; float* X1;
  __device__ __forceinline__ void operator()(const pg8::f32x4 (&acc)[2][2][4][2], const pg8::Unit& u, int wr, int wc, int fr, int fq) const {
#pragma unroll
    for (int ai = 0; ai < 2; ++ai)
#pragma unroll
      for (int m = 0; m < 4; ++m) {
        __builtin_amdgcn_sched_barrier(0);
        const int a = asg[256 + ai * 128 + wr * 64 + m * 16 + fr];
        if (a < 0) continue;
        if (a < 8 * T_TOK) {
          const float gw = GATEW[a];
#pragma unroll
          for (int bj = 0; bj < 2; ++bj) {
            const pg8::f32x4 v0 = acc[ai][bj][m][0], v1 = acc[ai][bj][m][1];
            uint4 w; w.x = cvtpk(v0[0] * gw, v0[1] * gw); w.y = cvtpk(v0[2] * gw, v0[3] * gw); w.z = cvtpk(v1[0] * gw, v1[1] * gw); w.w = cvtpk(v1[2] * gw, v1[3] * gw);
            *(uint4*)(Y + (size_t)a * DM + u.pn * 256 + bj * 128 + wc * 32 + 8 * fq) = w;
          }
        } else {
          const int t = a - 8 * T_TOK;
#pragma unroll
          for (int bj = 0; bj < 2; ++bj) {
            float* xp = X1 + (size_t)t * DM + u.pn * 256 + bj * 128 + wc * 32 + 8 * fq;
            const float4 x0 = *(const float4*)xp, x1 = *(const float4*)(xp + 4);
            const pg8::f32x4 v0 = acc[ai][bj][m][0], v1 = acc[ai][bj][m][1];
            *(float4*)xp = make_float4(ALPHA_F * x0.x + v0[0], ALPHA_F * x0.y + v0[1], ALPHA_F * x0.z + v0[2], ALPHA_F * x0.w + v0[3]);
            *(float4*)(xp + 4) = make_float4(ALPHA_F * x1.x + v1[0], ALPHA_F * x1.y + v1[1], ALPHA_F * x1.z + v1[2], ALPHA_F * x1.w + v1[3]);
          }
        }
      }
  }
};
#define MOE_TAB_OFF 131072
__device__ __forceinline__ void phase_moe(const Params& p, char* smem_all, int* slot) {
  int* tab = (int*)(smem_all + MOE_TAB_OFF);
  const int* __restrict__ LIST = (const int*)(p.ws + OFF_LIST);
  const int* counts = (const int*)(p.ws + OFF_CTL);
  const int* pre = counts + CTL_MOEPRE;
  int* ctl = (int*)(p.ws + OFF_CTL);
  bf16_t* HS = (bf16_t*)(p.ws + OFF_HSCR) + (size_t)blockIdx.x * 256 * 256;
  const int nitems = pre[NEXP + 1];
  for (;;) {
    __syncthreads();
    if (threadIdx.x == 0) *slot = atomicAdd(&ctl[CTL_CONVQ + 1], 1);
    __syncthreads();
    const int i = *slot;
    if (i >= nitems) break;
    int lo = 0, hi = NEXP;
    while (lo < hi) { const int mid = (lo + hi + 1) >> 1; if (pre[mid] <= i) lo = mid; else hi = mid - 1; }
    const int e = lo;
    const int cnt = (e < NEXP) ? min(counts[CNT(e)], LCAP) : T_TOK;
    const int r0 = (i - pre[e]) * 256;
    if (threadIdx.x < 256) {
      const int r = r0 + (int)threadIdx.x;
      const int a = (r < cnt) ? ((e < NEXP) ? LIST[(size_t)e * LCAP + r] : (8 * T_TOK + r)) : -1;
      tab[256 + threadIdx.x] = a;
      tab[threadIdx.x] = (a >= 0 ? a : 0) & (T_TOK - 1);
    }
    __syncthreads();
    {
      int k1 = DM; asm volatile("" : "+s"(k1));
      pg8::Gemm g{(const pg8::bf16_t*)(p.ws + OFF_X1B), (const pg8::bf16_t*)(p.ws + OFF_EW1) + (size_t)e * 512 * 1024, 256, 512, k1};
      SeqOrder S{2};
      EpiMoe1 E{HS};
      pg8::gemm_phase<EpiMoe1, SeqOrder, false, true, true>((PG8_LAS unsigned char*)smem_all, g, S, E, tab);
    }
    __syncthreads();
    if (threadIdx.x < 256) tab[threadIdx.x] = threadIdx.x;
    __syncthreads();
    {
      int k2 = 256; asm volatile("" : "+s"(k2));
      pg8::Gemm g{(const pg8::bf16_t*)HS, (const pg8::bf16_t*)(p.ws + OFF_EW2) + (size_t)e * 1024 * 256, 256, DM, k2};
      SeqOrder S{4};
      EpiMoe2 E{tab, (const float*)(p.ws + OFF_GATEW), (bf16_t*)(p.ws + OFF_Y), p.out};
      pg8::gemm_phase<EpiMoe2, SeqOrder, false, true, true>((PG8_LAS unsigned char*)smem_all, g, S, E, tab);
    }
  }
}

__device__ __forceinline__ void phase_final(const Params& p, char* smem) {
  float* OUT = p.out;
  const bf16_t* __restrict__ Y = (const bf16_t*)(p.ws + OFF_Y);
  const float* __restrict__ g2 = p.in[24]; const float* __restrict__ b2 = p.in[25];
  const int lane = VTID & 63, wid = VTID >> 6;
  for (int t = VBID * 4 + wid; t < T_TOK; t += VGRID * 4) {
    const size_t base = (size_t)t * DM;
    float4 v[4];
    float s = 0.f;
#pragma unroll
    for (int u = 0; u < 4; ++u) {
      const int c = u * 256 + lane * 4;
      const float4 xv = *(const float4*)(OUT + base + c);
      float a0 = 0.f, a1 = 0.f, a2 = 0.f, a3 = 0.f;
#pragma unroll
      for (int sl = 0; sl < 8; ++sl) {
        const float4 yv = bf4_to_f4(*(const uint2*)(Y + ((size_t)sl * T_TOK + t) * DM + c));
        a0 += yv.x; a1 += yv.y; a2 += yv.z; a3 += yv.w;
      }
      v[u] = make_float4(xv.x + a0, xv.y + a1, xv.z + a2, xv.w + a3);
      s += (v[u].x + v[u].y) + (v[u].z + v[u].w);
    }
    const float mean = wave_sum_fast(s) * (1.f / DM);
    float q = 0.f;
#pragma unroll
    for (int u = 0; u < 4; ++u) {
      const float d0 = v[u].x - mean, d1 = v[u].y - mean, d2 = v[u].z - mean, d3 = v[u].w - mean;
      q += (d0 * d0 + d1 * d1) + (d2 * d2 + d3 * d3);
    }
    const float rs = rsqrtf(wave_sum_fast(q) * (1.f / DM) + LN_EPS_F);
#pragma unroll
    for (int u = 0; u < 4; ++u) {
      const int c = u * 256 + lane * 4;
      const float4 g = *(const float4*)(g2 + c), bb = *(const float4*)(b2 + c);
      *(float4*)(OUT + base + c) = make_float4((v[u].x - mean) * rs * g.x + bb.x, (v[u].y - mean) * rs * g.y + bb.y,
                                               (v[u].z - mean) * rs * g.z + bb.z, (v[u].w - mean) * rs * g.w + bb.w);
    }
  }
}

#define LAS __attribute__((address_space(3)))
#define XB_TMO      128
#define XB_XCNT(j)  (256  + 64 * (j))
#define XB_XSUB(j)  (1280 + 64 * (j))
#define XB_XGEN(j)  (2304 + 64 * (j))
#define XB_TOP      3328
#define XB_TOPGEN   3392
#define XCD_BAR_WORDS 3456
#define XB_SPIN_CAP (1u << 22)
__device__ __forceinline__ unsigned xb_ld(unsigned* p)              { return __hip_atomic_load(p, __ATOMIC_RELAXED, __HIP_MEMORY_SCOPE_AGENT); }
__device__ __forceinline__ unsigned xb_add(unsigned* p, unsigned v) { return __hip_atomic_fetch_add(p, v, __ATOMIC_RELAXED, __HIP_MEMORY_SCOPE_AGENT); }
__device__ __forceinline__ unsigned xb_xcc_id() { return (unsigned)__builtin_amdgcn_s_getreg((3 << 11) | 20) & 0xFu; }
#define XB_SPIN(cond, bar) do { unsigned _sp = 0; while (cond) { __builtin_amdgcn_s_sleep(1); \
    if ((++_sp & 255u) == 0u) { if (xb_ld(&(bar)[XB_TMO])) break; if (_sp > XB_SPIN_CAP) { atomicAdd(&(bar)[XB_TMO], 1u); break; } } } } while (0)
struct XcdBarrier { unsigned* bar; unsigned x; volatile LAS unsigned* st; };
__device__ __forceinline__ XcdBarrier xcd_barrier_post(unsigned* bar, volatile LAS unsigned* st) {
  XcdBarrier b; b.bar = bar; b.x = xb_xcc_id(); b.st = st;
  if (threadIdx.x == 0) (void)xb_add(&bar[XB_XCNT(b.x)], 1u);
  return b;
}
__device__ __forceinline__ void xcd_barrier_complete(unsigned* bar, unsigned x, unsigned& nloc, unsigned& nx) {
  const unsigned G = gridDim.x * gridDim.y * gridDim.z;
  unsigned sum, cnt, mine, sp = 0u;
  for (;;) {
    sum = 0u; cnt = 0u; mine = 0u;
#pragma unroll
    for (unsigned j = 0; j < 16; ++j) { const unsigned c = xb_ld(&bar[XB_XCNT(j)]); sum += c; cnt += (c > 0u) ? 1u : 0u; mine = (j == x) ? c : mine; }
    if (sum == G) break;
    __builtin_amdgcn_s_sleep(1);
    if ((++sp & 255u) == 0u) { if (xb_ld(&bar[XB_TMO])) break; if (sp > XB_SPIN_CAP) { atomicAdd(&bar[XB_TMO], 1u); break; } }
  }
  nloc = mine > 0u ? mine : 1u; nx = cnt > 0u ? cnt : 1u;
}
__device__ __forceinline__ void xcd_barrier(const XcdBarrier& b) {
  asm volatile("s_waitcnt vmcnt(0)" ::: "memory");
  __syncthreads();
  if (threadIdx.x == 0) {
    unsigned* bar = b.bar;
    __builtin_amdgcn_s_waitcnt(0);
    unsigned nloc = b.st[0], nx = b.st[1];
    if (nloc == 0u) { xcd_barrier_complete(bar, b.x, nloc, nx); b.st[0] = nloc; b.st[1] = nx; }
    const unsigned old = xb_add(&bar[XB_XSUB(b.x)], 1u);
    const unsigned gen = old / nloc;
    if (old + 1u == (gen + 1u) * nloc) {
      __builtin_amdgcn_fence(__ATOMIC_RELEASE, "agent");
      asm volatile("s_waitcnt vmcnt(0)" ::: "memory");
      const unsigned og = xb_add(&bar[XB_TOP], 1u);
      const unsigned tg = og / nx;
      if (og + 1u == (tg + 1u) * nx) xb_add(&bar[XB_TOPGEN], 1u);
      else XB_SPIN(xb_ld(&bar[XB_TOPGEN]) == tg, bar);
      __builtin_amdgcn_fence(__ATOMIC_ACQUIRE, "agent");
      xb_add(&bar[XB_XGEN(b.x)], 1u);
      asm volatile("s_waitcnt vmcnt(0)" ::: "memory");
    } else {
      XB_SPIN(xb_ld(&bar[XB_XGEN(b.x)]) == gen, bar);
      __builtin_amdgcn_fence(__ATOMIC_ACQUIRE, "agent");
      asm volatile("s_waitcnt vmcnt(0)" ::: "memory");
    }
  }
  __syncthreads();
}
#define CTL_BAR_WORD 4096
#define CTL_ZERO_BYTES 65536
#define LDS_BAR_OFF 66432

#define LDS_TOTAL (2 * HALF_LDS + 128)
__global__ void __launch_bounds__(512, 2) mega(Params p) {
  extern __shared__ __attribute__((aligned(16))) char smem_all[];
  cg::grid_group grid = cg::this_grid();
  char* const smem = smem_all + VHALF * HALF_LDS;
  volatile LAS unsigned* bst = (volatile LAS unsigned*)(LAS char*)(smem_all + WG_LDS_OFF);
  int* const slot = (int*)(smem_all + WG_LDS_OFF + 16);
  if (threadIdx.x < 2) { bst[threadIdx.x] = 0u; ((int*)(smem_all + WG_LDS_OFF + 32))[threadIdx.x] = 0; }
  __syncthreads();
  const XcdBarrier bar = xcd_barrier_post((unsigned*)(p.ws + OFF_CTL) + CTL_BAR_WORD, bst);
  phase_rope(p);
  if (p.ws == nullptr) grid.sync();
  xcd_barrier(bar);
  phase_inproj(p, smem_all);
  xcd_barrier(bar);
  phase_prep_a(p);
  xcd_barrier(bar);
  phase_prep(p, smem);
  xcd_barrier(bar);
  phase_scan(p, smem);
  phase_convert(p, smem);
  xcd_barrier(bar);
  phase_post(p);
  xcd_barrier(bar);
  phase_outproj(p, smem_all);
  xcd_barrier(bar);
  phase_ln1(p);
  xcd_barrier(bar);
  phase_router_gemm(p, smem);
  xcd_barrier(bar);
  phase_topk(p);
  xcd_barrier(bar);
  phase_moe_prefix(p);
  xcd_barrier(bar);
  phase_moe(p, smem_all, slot);
  xcd_barrier(bar);
  phase_final(p, smem);
}

extern "C" void kernel_launch(void* const* d_in, const int* in_sizes, int n_in, void* d_out, int out_size, void* d_ws, size_t ws_size,
                              hipStream_t stream) {
  static int grid_blocks = 0;
  if (grid_blocks == 0) {
    if (ws_size < WS_NEED || n_in != 26) { fprintf(stderr, "kernel_launch: bad ws/n_in: %zu < %zu, n_in %d\n", ws_size, (size_t)WS_NEED, n_in); grid_blocks = -1; return; }
    int dev = 0, cus = 0, per_cu = 0;
    (void)hipGetDevice(&dev);
    (void)hipDeviceGetAttribute(&cus, hipDeviceAttributeMultiprocessorCount, dev);
    (void)hipFuncSetAttribute((const void*)mega, hipFuncAttributeMaxDynamicSharedMemorySize, LDS_TOTAL);
    (void)hipOccupancyMaxActiveBlocksPerMultiprocessor(&per_cu, (const void*)mega, 512, LDS_TOTAL);
    if (per_cu < 1) { fprintf(stderr, "kernel_launch: occupancy query returned %d\n", per_cu); grid_blocks = -1; return; }
    if (per_cu > 1) per_cu = 1;
    grid_blocks = cus * per_cu;
    if (grid_blocks > 256) grid_blocks = 256;
    fprintf(stderr, "kernel_launch: cus %d per_cu %d grid %d\n", cus, per_cu, grid_blocks);
  }
  if (grid_blocks < 0) return;
  if (hipMemsetAsync((char*)d_ws + OFF_CTL, 0, CTL_ZERO_BYTES, stream) != hipSuccess) { fprintf(stderr, "kernel_launch: memset failed\n"); return; }
  Params p{};
  for (int i = 0; i < 26; ++i) p.in[i] = (const float*)d_in[i];
  p.out = (float*)d_out;
  p.ws = (char*)d_ws;
  void* args[] = {&p};
  hipError_t e = hipLaunchCooperativeKernel((const void*)mega, dim3(grid_blocks), dim3(512), args, LDS_TOTAL, stream);
  if (e != hipSuccess) fprintf(stderr, "cooperative launch failed: %s (grid %d)\n", hipGetErrorString(e), grid_blocks);
}
```

```cpp
#include <hip/hip_runtime.h>
#include <hip/hip_bf16.h>
#include <hip/hip_cooperative_groups.h>
#include <stdint.h>
#include <stdio.h>

typedef unsigned short bf16_t;

#define T_TOK 32768
#define SEQ 4096
#define DM 1024
#define INW 3360
#define FEW 1824
#define NEXP 256
#define ALPHA_F 1.189207115002721f
#define LN_EPS_F 1e-5f
#define GN_EPS_F 64e-5f

__device__ __forceinline__ float bf2f(bf16_t v) { return __uint_as_float(((unsigned)v) << 16); }
__device__ __forceinline__ bf16_t f2bf(float f) { unsigned u = __float_as_uint(f); return (bf16_t)((u + 0x7fffu + ((u >> 16) & 1u)) >> 16); }
__device__ __forceinline__ float sigmoidf_(float x) { return 1.f / (1.f + __expf(-x)); }
__device__ __forceinline__ float wave_sum(float v) {
#pragma unroll
  for (int o = 32; o >= 1; o >>= 1) v += __shfl_xor(v, o, 64);
  return v;
}

constexpr size_t SZ_T512_BF = (size_t)T_TOK * 512 * 2;
constexpr size_t OFF_EW1 = 0;
constexpr size_t OFF_EW2 = OFF_EW1 + (size_t)257 * 512 * 1024 * 2;
constexpr size_t LBASE = OFF_EW2 + (size_t)257 * 1024 * 256 * 2;
constexpr size_t OFF_XB = 0;
constexpr size_t OFF_FEATS = OFF_XB + (size_t)T_TOK * 1024 * 2;
constexpr size_t OFF_WINT = OFF_FEATS + (size_t)T_TOK * FEW * 2;
constexpr size_t OFF_ROPE = OFF_WINT + (size_t)3584 * 1024 * 2;
static_assert(OFF_ROPE + (size_t)4096 * 32 * 2 * 4 <= LBASE, "early region E overlay");
constexpr size_t OFF_Q = LBASE;
constexpr size_t OFF_K = OFF_Q + SZ_T512_BF;
constexpr size_t OFF_V = OFF_K + SZ_T512_BF;
constexpr size_t OFF_R = OFF_V + SZ_T512_BF;
constexpr size_t OFF_K2 = OFF_R + SZ_T512_BF;
constexpr size_t OFF_V2 = OFF_K2 + SZ_T512_BF;
constexpr size_t OFF_A = OFF_V2 + SZ_T512_BF;
constexpr size_t OFF_B = OFF_A + SZ_T512_BF;
constexpr size_t OFF_W = OFF_B + SZ_T512_BF;
constexpr size_t OFF_G = OFF_W + (size_t)T_TOK * 512 * 4;
constexpr size_t OFF_SB = OFF_G + SZ_T512_BF;
constexpr size_t OFF_YS = OFF_SB + (size_t)T_TOK * 8 * 4;
constexpr size_t OFF_OP = OFF_YS + (size_t)T_TOK * 512 * 4;
constexpr size_t OFF_LSE = OFF_OP + 3 * SZ_T512_BF;
constexpr size_t OFF_MIXED = OFF_LSE + (size_t)3 * T_TOK * 8 * 4;
constexpr size_t OFF_WOUTT = OFF_MIXED + (size_t)T_TOK * 1024 * 2;
constexpr size_t EARLY_END = OFF_WOUTT + (size_t)1024 * 1024 * 2;
constexpr size_t OFF_Y = LBASE;
constexpr size_t OFF_AFF = LBASE + (size_t)T_TOK * 1024 * 2;
constexpr size_t OFF_X1B = OFF_Y + (size_t)8 * T_TOK * 1024 * 2;
#define LCAP 16384
constexpr size_t OFF_LIST = OFF_X1B + (size_t)T_TOK * 1024 * 2;
constexpr size_t OFF_GATEW = OFF_LIST + (size_t)NEXP * LCAP * 4;
constexpr size_t OFF_HSCR = OFF_GATEW + (size_t)8 * T_TOK * 4;
constexpr size_t OFF_ACT = OFF_HSCR;
static_assert((size_t)T_TOK * 320 * 2 <= (size_t)512 * 128 * 256 * 2, "ACT fits the HSCR space");
constexpr size_t OFF_CTL = OFF_HSCR + (size_t)512 * 128 * 256 * 2;
constexpr size_t CTL_BYTES = 1u << 20;
constexpr size_t WS_NEED = OFF_CTL + CTL_BYTES;
static_assert(EARLY_END <= OFF_HSCR, "early buffers must stay below the per-block scratch / control words");
static_assert(WS_NEED <= (size_t)1073741824, "workspace must fit 1 GiB");
#define CTL_CONVQ 512
#define CTL_CNT 8192
#define CNT(e) (CTL_CNT + 32 * (e))

typedef short bf16x8 __attribute__((ext_vector_type(8)));
typedef float f32x4 __attribute__((ext_vector_type(4)));
typedef float f32x16 __attribute__((ext_vector_type(16)));
typedef float f32x2_t __attribute__((ext_vector_type(2)));
typedef __bf16 bf16x2_t __attribute__((ext_vector_type(2)));
__device__ __forceinline__ unsigned cvtpk(float lo, float hi) { f32x2_t v = {lo, hi}; bf16x2_t b = __builtin_convertvector(v, bf16x2_t); return __builtin_bit_cast(unsigned, b); }

__device__ const double INVF[32] = {
1, 0.74989420933245587, 0.56234132519034907, 0.42169650342858223, 0.31622776601683794, 0.23713737056616552,
0.17782794100389229, 0.1333521432163324, 0.10000000000000001, 0.074989420933245579, 0.056234132519034911,
0.042169650342858224, 0.031622776601683791, 0.023713737056616554, 0.017782794100389229, 0.013335214321633241,
0.01, 0.0074989420933245579, 0.005623413251903491, 0.0042169650342858229, 0.0031622776601683794,
0.0023713737056616554, 0.0017782794100389228, 0.0013335214321633241, 0.001, 0.00074989420933245586,
0.0005623413251903491, 0.00042169650342858224, 0.00031622776601683794, 0.00023713737056616554,
0.00017782794100389227, 0.0001333521432163324};

namespace cg = cooperative_groups;

struct Params {
  const float* in[26];
  float* out;
  char* ws;
};

#define NTHR 256
#define VTID ((int)(threadIdx.x & 255))
#define VHALF (__builtin_amdgcn_readfirstlane((int)(threadIdx.x >> 8)))
#define VBID ((int)(blockIdx.x * 2) + VHALF)
#define VGRID ((int)(gridDim.x * 2))
#define HALF_LDS 66560
extern __shared__ __attribute__((aligned(16))) char g_lds[];
#define WG_LDS_OFF (2 * HALF_LDS)
__device__ __forceinline__ void half_sync() {
  asm volatile("s_waitcnt vmcnt(0) lgkmcnt(0)" ::: "memory");
  int* cnt = (int*)(g_lds + WG_LDS_OFF + 32) + VHALF;
  if ((threadIdx.x & 63) == 0) {
    const int old = __hip_atomic_fetch_add(cnt, 1, __ATOMIC_RELAXED, __HIP_MEMORY_SCOPE_WORKGROUP);
    const int target = (old & ~3) + 4;
    while (__hip_atomic_load(cnt, __ATOMIC_RELAXED, __HIP_MEMORY_SCOPE_WORKGROUP) < target) __builtin_amdgcn_s_sleep(1);
  }
  __builtin_amdgcn_fence(__ATOMIC_ACQUIRE, "workgroup");
  asm volatile("s_waitcnt lgkmcnt(0)" ::: "memory");
}
#define HSYNC() half_sync()

#define LDS_BYTES 66560

__device__ __forceinline__ void phase_rope(const Params& p) {
  float* tab = (float*)(p.ws + OFF_ROPE);
  for (int i = VBID * NTHR + VTID; i < 4096 * 32; i += VGRID * NTHR) {
    int pos = i >> 5, f = i & 31;
    double ang = (double)pos * INVF[f];
    const double TWO_PI = 6.283185307179586476925286766559;
    double n = rint(ang / TWO_PI);
    double r = ang - n * TWO_PI;
    double r2 = r * r;
    double sn = r, cs = 1.0, ts = r, tc = 1.0;
#pragma unroll 1
    for (int k = 1; k <= 16; ++k) {
      tc = -tc * r2 / (double)((2 * k - 1) * (2 * k));
      ts = -ts * r2 / (double)((2 * k) * (2 * k + 1));
      cs += tc; sn += ts;
    }
    tab[i * 2] = (float)cs; tab[i * 2 + 1] = (float)sn;
  }
  {
    const float* __restrict__ w_in = p.in[1]; const float* __restrict__ w_out = p.in[13];
    uint4* wint = (uint4*)(p.ws + OFF_WINT); uint4* woutt = (uint4*)(p.ws + OFF_WOUTT);
    const int NJ1 = 3584 * 128, NJ2 = 1024 * 128;
    for (int i = VBID * NTHR + VTID; i < NJ1 + NJ2; i += VGRID * NTHR) {
      const bool second = i >= NJ1;
      const int q = second ? i - NJ1 : i;
      const int N = second ? 1024 : 3584, NV = second ? 1024 : INW;
      const int s = q % N, ko = q / N;
      const int n = second ? s : ((s & ~63) + (((s & 63) >> 3) << 2) + (s & 3) + (((s >> 2) & 1) << 5));
      const float* __restrict__ src = second ? w_out : w_in;
      float f[8];
#pragma unroll
      for (int u = 0; u < 8; ++u) f[u] = (n < NV) ? src[(size_t)(ko * 8 + u) * NV + n] : 0.f;
      uint4 w; w.x = cvtpk(f[0], f[1]); w.y = cvtpk(f[2], f[3]); w.z = cvtpk(f[4], f[5]); w.w = cvtpk(f[6], f[7]);
      (second ? woutt : wint)[(size_t)s * 128 + ko] = w;
    }
  }
  {
    const float4* __restrict__ x4 = (const float4*)p.in[0];
    uint4* xb = (uint4*)(p.ws + OFF_XB);
    for (size_t i = (size_t)VBID * NTHR + VTID; i < (size_t)T_TOK * DM / 8; i += (size_t)VGRID * NTHR) {
      float4 a = x4[2 * i], b = x4[2 * i + 1];
      uint4 w; w.x = cvtpk(a.x, a.y); w.y = cvtpk(a.z, a.w); w.z = cvtpk(b.x, b.y); w.w = cvtpk(b.z, b.w);
      xb[i] = w;
    }
  }
}

template <class AF, class BF>
__device__ __forceinline__ void gemm64_naive(float* As, float* Bs, float* Cs, int K, AF af, BF bf) {
  int tid_l_ = VTID; asm volatile("" : "+v"(tid_l_)); const int tid = tid_l_, tx = tid & 15, ty = tid >> 4;
  float acc[4][4];
#pragma unroll
  for (int i = 0; i < 4; ++i)
#pragma unroll
    for (int j = 0; j < 4; ++j) acc[i][j] = 0.f;
  for (int k0 = 0; k0 < K; k0 += 16) {
#pragma unroll
    for (int u = 0; u < 4; ++u) { int i = tid + u * 256; int r = i >> 4, kk = i & 15; As[kk * 68 + r] = af(r, k0 + kk); }
#pragma unroll
    for (int u = 0; u < 4; ++u) { int i = tid + u * 256; int kk = i >> 6, c = i & 63; Bs[kk * 68 + c] = bf(k0 + kk, c); }
    HSYNC();
#pragma unroll
    for (int kk = 0; kk < 16; ++kk) {
      float a[4], b[4];
#pragma unroll
      for (int i = 0; i < 4; ++i) { a[i] = As[kk * 68 + ty * 4 + i]; b[i] = Bs[kk * 68 + tx * 4 + i]; }
#pragma unroll
      for (int i = 0; i < 4; ++i)
#pragma unroll
        for (int j = 0; j < 4; ++j) acc[i][j] += a[i] * b[j];
    }
    HSYNC();
  }
#pragma unroll
  for (int i = 0; i < 4; ++i)
#pragma unroll
    for (int j = 0; j < 4; ++j) Cs[(ty * 4 + i) * 65 + tx * 4 + j] = acc[i][j];
  HSYNC();
}


__device__ __forceinline__ int lds_off(int row, int chunk) { return row * 128 + ((chunk ^ ((row >> 1) & 7)) << 4); }

template <int BMODE>
__device__ __forceinline__ unsigned cvtpk_m(float a, float b, const bool lo = false) {
  if (BMODE == 0 || (BMODE == 2 && !lo)) return cvtpk(a, b);
  const unsigned h = cvtpk(a, b);
  const float ah = __uint_as_float(h << 16), bh = __uint_as_float(h & 0xffff0000u);
  return cvtpk(a - ah, b - bh);
}
#define G128_MMA(bufoff) { \
    _Pragma("unroll") for (int kk = 0; kk < 2; ++kk) { \
      bf16x8 af[4], bfr[4]; \
      _Pragma("unroll") for (int m = 0; m < 4; ++m) af[m] = *(const bf16x8*)(smem + (bufoff) + lds_off(wr * 64 + m * 16 + fr, kk * 4 + fq)); \
      _Pragma("unroll") for (int n = 0; n < 4; ++n) bfr[n] = *(const bf16x8*)(smem + (bufoff) + 16384 + lds_off(wc * 64 + n * 16 + fr, kk * 4 + fq)); \
      _Pragma("unroll") for (int m = 0; m < 4; ++m) \
        _Pragma("unroll") for (int n = 0; n < 4; ++n) acc[m][n] = __builtin_amdgcn_mfma_f32_16x16x32_bf16(bfr[n], af[m], acc[m][n], 0, 0, 0); \
    } }
template <int BMODE, bool KCLAMP, class ALoad, class BPtr>
__device__ __forceinline__ void gemm128_acc(f32x4 (&acc)[4][4], char* smem, const int nk, ALoad aload, BPtr bptr, const int ldb, const int kvalid) {
  int tid_l_ = VTID; asm volatile("" : "+v"(tid_l_)); const int tid = tid_l_, lane = tid & 63, wid = tid >> 6;
  const int wr = wid >> 1, wc = wid & 1, fr = lane & 15, fq = lane >> 4;
  const int achunk = tid & 7, arow0 = tid >> 3;
  const int nq = tid & 31, ko = tid >> 5;
  const float* bp0 = bptr(nq);
  const int oa0 = lds_off(arow0, achunk), oa1 = lds_off(arow0 + 32, achunk), oa2 = lds_off(arow0 + 64, achunk), oa3 = lds_off(arow0 + 96, achunk);
  const int ob0 = 16384 + lds_off(nq * 4 + 0, ko), ob1 = 16384 + lds_off(nq * 4 + 1, ko), ob2 = 16384 + lds_off(nq * 4 + 2, ko), ob3 = 16384 + lds_off(nq * 4 + 3, ko);
  uint4 ra0, ra1, ra2, ra3; float4 rb0, rb1, rb2, rb3, rb4, rb5, rb6, rb7;
#define G128_LOAD(kt) { \
    ra0 = aload(0, arow0, (kt) * 8 + achunk); ra1 = aload(1, arow0 + 32, (kt) * 8 + achunk); \
    ra2 = aload(2, arow0 + 64, (kt) * 8 + achunk); ra3 = aload(3, arow0 + 96, (kt) * 8 + achunk); \
    int kr_ = (kt) * 64 + ko * 8; \
    if (KCLAMP) kr_ = min(kr_, kvalid - 8);     \
    { \
      const float* b2_ = bp0 + (size_t)((BMODE == 2) ? (kr_ & 1023) : kr_) * ldb; \
      rb0 = *(const float4*)(b2_); rb1 = *(const float4*)(b2_ + (size_t)1 * ldb); rb2 = *(const float4*)(b2_ + (size_t)2 * ldb); \
      rb3 = *(const float4*)(b2_ + (size_t)3 * ldb); rb4 = *(const float4*)(b2_ + (size_t)4 * ldb); rb5 = *(const float4*)(b2_ + (size_t)5 * ldb); \
      rb6 = *(const float4*)(b2_ + (size_t)6 * ldb); rb7 = *(const float4*)(b2_ + (size_t)7 * ldb); \
    } }
#define G128_STORE(bufoff, lo_) { \
    char* const sb_ = smem + (bufoff); \
    *(uint4*)(sb_ + oa0) = ra0; *(uint4*)(sb_ + oa1) = ra1; *(uint4*)(sb_ + oa2) = ra2; *(uint4*)(sb_ + oa3) = ra3; \
    uint4 w; \
    w.x = cvtpk_m<BMODE>(rb0.x, rb1.x, lo_); w.y = cvtpk_m<BMODE>(rb2.x, rb3.x, lo_); w.z = cvtpk_m<BMODE>(rb4.x, rb5.x, lo_); w.w = cvtpk_m<BMODE>(rb6.x, rb7.x, lo_); \
    *(uint4*)(sb_ + ob0) = w; \
    w.x = cvtpk_m<BMODE>(rb0.y, rb1.y, lo_); w.y = cvtpk_m<BMODE>(rb2.y, rb3.y, lo_); w.z = cvtpk_m<BMODE>(rb4.y, rb5.y, lo_); w.w = cvtpk_m<BMODE>(rb6.y, rb7.y, lo_); \
    *(uint4*)(sb_ + ob1) = w; \
    w.x = cvtpk_m<BMODE>(rb0.z, rb1.z, lo_); w.y = cvtpk_m<BMODE>(rb2.z, rb3.z, lo_); w.z = cvtpk_m<BMODE>(rb4.z, rb5.z, lo_); w.w = cvtpk_m<BMODE>(rb6.z, rb7.z, lo_); \
    *(uint4*)(sb_ + ob2) = w; \
    w.x = cvtpk_m<BMODE>(rb0.w, rb1.w, lo_); w.y = cvtpk_m<BMODE>(rb2.w, rb3.w, lo_); w.z = cvtpk_m<BMODE>(rb4.w, rb5.w, lo_); w.w = cvtpk_m<BMODE>(rb6.w, rb7.w, lo_); \
    *(uint4*)(sb_ + ob3) = w; }
  G128_LOAD(0)
  G128_STORE(0, false)
  if (nk > 1) G128_LOAD(1)
  HSYNC();
  for (int kt = 0; kt < nk; ++kt) {
    const int cur = (kt & 1) * 32768;
    __builtin_amdgcn_sched_barrier(0);
    G128_MMA(cur)
    __builtin_amdgcn_sched_barrier(0);
    if (kt + 1 < nk) {
      G128_STORE(cur ^ 32768, (kt + 1) >= kvalid)
      __builtin_amdgcn_sched_barrier(0);
      if (kt + 2 < nk) G128_LOAD(kt + 2)
    }
    __builtin_amdgcn_sched_barrier(0);
    HSYNC();
  }
#undef G128_LOAD
#undef G128_STORE
}
__device__ __forceinline__ void acc_zero(f32x4 (&acc)[4][4]) {
#pragma unroll
  for (int m = 0; m < 4; ++m)
#pragma unroll
    for (int n = 0; n < 4; ++n) acc[m][n] = (f32x4){0.f, 0.f, 0.f, 0.f};
}
template <class ARow, class BPtr, class Epi>
__device__ __forceinline__ void gemm128(char* smem, const int K, ARow arow, BPtr bptr, const int ldb, Epi epi) {
  int tid_l_ = VTID; asm volatile("" : "+v"(tid_l_)); const int tid = tid_l_, lane = tid & 63, wid = tid >> 6;
  const int arow0 = tid >> 3;
  const bf16_t* ap0 = arow(arow0);
  const bf16_t* ap1 = arow(arow0 + 32);
  const bf16_t* ap2 = arow(arow0 + 64);
  const bf16_t* ap3 = arow(arow0 + 96);
  f32x4 acc[4][4];
  acc_zero(acc);
  gemm128_acc<0, false>(acc, smem, K >> 6,
      [=](int u, int, int kc) { const bf16_t* q = (u == 0) ? ap0 : (u == 1) ? ap1 : (u == 2) ? ap2 : ap3; return *(const uint4*)(q + kc * 8); },
      bptr, ldb, 0);
  epi(acc, wid >> 1, wid & 1, lane & 15, lane >> 4);
}


template <class ALoad, class BLoad>
__device__ __forceinline__ void gemm128_acc_bb(f32x4 (&acc)[4][4], char* smem, const int nk, ALoad aload, BLoad bload) {
  int tid_l_ = VTID; asm volatile("" : "+v"(tid_l_)); const int tid = tid_l_, lane = tid & 63, wid = tid >> 6;
  const int wr = wid >> 1, wc = wid & 1, fr = lane & 15, fq = lane >> 4;
  const int achunk = tid & 7, arow0 = tid >> 3;
  const int oa0 = lds_off(arow0, achunk), oa1 = lds_off(arow0 + 32, achunk), oa2 = lds_off(arow0 + 64, achunk), oa3 = lds_off(arow0 + 96, achunk);
  uint4 ra0, ra1, ra2, ra3, rb0, rb1, rb2, rb3;
#define G128_LOADBB(kt) { \
    ra0 = aload(0, arow0, (kt) * 8 + achunk); ra1 = aload(1, arow0 + 32, (kt) * 8 + achunk); \
    ra2 = aload(2, arow0 + 64, (kt) * 8 + achunk); ra3 = aload(3, arow0 + 96, (kt) * 8 + achunk); \
    rb0 = bload(0, arow0, (kt) * 8 + achunk); rb1 = bload(1, arow0 + 32, (kt) * 8 + achunk); \
    rb2 = bload(2, arow0 + 64, (kt) * 8 + achunk); rb3 = bload(3, arow0 + 96, (kt) * 8 + achunk); }
#define G128_STOREBB(bufoff) { \
    char* const sb_ = smem + (bufoff); \
    *(uint4*)(sb_ + oa0) = ra0; *(uint4*)(sb_ + oa1) = ra1; *(uint4*)(sb_ + oa2) = ra2; *(uint4*)(sb_ + oa3) = ra3; \
    *(uint4*)(sb_ + 16384 + oa0) = rb0; *(uint4*)(sb_ + 16384 + oa1) = rb1; *(uint4*)(sb_ + 16384 + oa2) = rb2; *(uint4*)(sb_ + 16384 + oa3) = rb3; }
  G128_LOADBB(0)
  G128_STOREBB(0)
  if (nk > 1) G128_LOADBB(1)
  HSYNC();
  for (int kt = 0; kt < nk; ++kt) {
    const int cur = (kt & 1) * 32768;
    __builtin_amdgcn_sched_barrier(0);
    G128_MMA(cur)
    __builtin_amdgcn_sched_barrier(0);
    if (kt + 1 < nk) {
      G128_STOREBB(cur ^ 32768)
      __builtin_amdgcn_sched_barrier(0);
      if (kt + 2 < nk) G128_LOADBB(kt + 2)
    }
    __builtin_amdgcn_sched_barrier(0);
    HSYNC();
  }
#undef G128_LOADBB
#undef G128_STOREBB
}
template <class ARow, class BRow, class Epi>
__device__ __forceinline__ void gemm128_bb(char* smem, const int K, ARow arow, BRow brow, Epi epi) {
  int tid_l_ = VTID; asm volatile("" : "+v"(tid_l_)); const int tid = tid_l_, lane = tid & 63, wid = tid >> 6;
  const int arow0 = tid >> 3;
  const bf16_t* ap0 = arow(arow0); const bf16_t* ap1 = arow(arow0 + 32); const bf16_t* ap2 = arow(arow0 + 64); const bf16_t* ap3 = arow(arow0 + 96);
  const bf16_t* bp0 = brow(arow0); const bf16_t* bp1 = brow(arow0 + 32); const bf16_t* bp2 = brow(arow0 + 64); const bf16_t* bp3 = brow(arow0 + 96);
  f32x4 acc[4][4];
  acc_zero(acc);
  gemm128_acc_bb(acc, smem, K >> 6,
      [=](int u, int, int kc) { const bf16_t* q = (u == 0) ? ap0 : (u == 1) ? ap1 : (u == 2) ? ap2 : ap3; return *(const uint4*)(q + kc * 8); },
      [=](int u, int, int kc) { const bf16_t* q = (u == 0) ? bp0 : (u == 1) ? bp1 : (u == 2) ? bp2 : bp3; return *(const uint4*)(q + kc * 8); });
  epi(acc, wid >> 1, wid & 1, lane & 15, lane >> 4);
}


#define GAS1 __attribute__((address_space(1)))
#define LAS3 __attribute__((address_space(3)))
__device__ __forceinline__ void glds16(const void* g, char* l) {
  __builtin_amdgcn_global_load_lds((const GAS1 void*)g, (LAS3 void*)l, 16, 0, 0);
}
template <class ARow, class BRow, class Epi>
__device__ __forceinline__ void gemm128_glds(char* smem, const int K, ARow arow, BRow brow, Epi epi) {
  int tid_l_ = VTID; asm volatile("" : "+v"(tid_l_)); const int tid = tid_l_, lane = tid & 63, wid = tid >> 6;
  const int wr = wid >> 1, wc = wid & 1, fr = lane & 15, fq = lane >> 4;
  const int r0 = tid >> 3;
  const int cl = (tid & 7) ^ ((tid >> 4) & 7);
  const bf16_t* ga0 = arow(r0) + cl * 8; const bf16_t* ga1 = arow(r0 + 32) + cl * 8; const bf16_t* ga2 = arow(r0 + 64) + cl * 8; const bf16_t* ga3 = arow(r0 + 96) + cl * 8;
  const bf16_t* gb0 = brow(r0) + cl * 8; const bf16_t* gb1 = brow(r0 + 32) + cl * 8; const bf16_t* gb2 = brow(r0 + 64) + cl * 8; const bf16_t* gb3 = brow(r0 + 96) + cl * 8;
  char* const lbase = smem + tid * 16;
#define GL_STAGE(bufoff, kt) { \
    char* const d_ = lbase + (bufoff); const int ko_ = (kt) * 64; \
    glds16(ga0 + ko_, d_); glds16(ga1 + ko_, d_ + 4096); glds16(ga2 + ko_, d_ + 8192); glds16(ga3 + ko_, d_ + 12288); \
    glds16(gb0 + ko_, d_ + 16384); glds16(gb1 + ko_, d_ + 20480); glds16(gb2 + ko_, d_ + 24576); glds16(gb3 + ko_, d_ + 28672); }
  f32x4 acc[4][4];
  acc_zero(acc);
  const int nk = K >> 6;
  GL_STAGE(0, 0)
  asm volatile("s_waitcnt vmcnt(0)" ::: "memory");
  HSYNC();
  for (int kt = 0; kt < nk; ++kt) {
    const int cur = (kt & 1) * 32768;
    if (kt + 1 < nk) GL_STAGE(cur ^ 32768, kt + 1)
    G128_MMA(cur)
    asm volatile("s_waitcnt vmcnt(0)" ::: "memory");
    HSYNC();
  }
#undef GL_STAGE
  epi(acc, wr, wc, fr, fq);
}


template <int NCALL, int NK, class ARow, class BRow, class Epi>
__device__ __forceinline__ void gemm128_glds_multi(char* smem, ARow arow, BRow brow, const size_t bstride, Epi epi) {
  int tid_l_ = VTID; asm volatile("" : "+v"(tid_l_)); const int tid = tid_l_, lane = tid & 63, wid = tid >> 6;
  const int wr = wid >> 1, wc = wid & 1, fr = lane & 15, fq = lane >> 4;
  const int r0 = tid >> 3;
  const int cl = (tid & 7) ^ ((tid >> 4) & 7);
  const bf16_t* ga0 = arow(r0) + cl * 8; const bf16_t* ga1 = arow(r0 + 32) + cl * 8; const bf16_t* ga2 = arow(r0 + 64) + cl * 8; const bf16_t* ga3 = arow(r0 + 96) + cl * 8;
  const bf16_t* gb0 = brow(r0) + cl * 8; const bf16_t* gb1 = brow(r0 + 32) + cl * 8; const bf16_t* gb2 = brow(r0 + 64) + cl * 8; const bf16_t* gb3 = brow(r0 + 96) + cl * 8;
  char* const lbase = smem + tid * 16;
#define GM_STAGE(bufoff, g) { \
    char* const d_ = lbase + (bufoff); const int ko_ = ((g) % NK) * 64; const size_t bo_ = (size_t)((g) / NK) * bstride + ko_; \
    glds16(ga0 + ko_, d_); glds16(ga1 + ko_, d_ + 4096); glds16(ga2 + ko_, d_ + 8192); glds16(ga3 + ko_, d_ + 12288); \
    glds16(gb0 + bo_, d_ + 16384); glds16(gb1 + bo_, d_ + 20480); glds16(gb2 + bo_, d_ + 24576); glds16(gb3 + bo_, d_ + 28672); }
  f32x4 acc[4][4];
  acc_zero(acc);
  constexpr int G = NCALL * NK;
  GM_STAGE(0, 0)
  asm volatile("s_waitcnt vmcnt(0)" ::: "memory");
  HSYNC();
#pragma unroll 1
  for (int g = 0; g < G; ++g) {
    const int cur = (g & 1) * 32768;
    if (g + 1 < G) GM_STAGE(cur ^ 32768, g + 1)
    G128_MMA(cur)
    if ((g % NK) == NK - 1) {
      epi(g / NK, acc, wr, wc, fr, fq);
      acc_zero(acc);
    }
    asm volatile("s_waitcnt vmcnt(0)" ::: "memory");
    HSYNC();
  }
#undef GM_STAGE
}


namespace pg8 {
#define PG8_LAS __attribute__((address_space(3)))
typedef unsigned short bf16_t;
typedef short bf16x8 __attribute__((ext_vector_type(8)));
typedef float f32x4 __attribute__((ext_vector_type(4)));
typedef unsigned u32x4 __attribute__((ext_vector_type(4)));
constexpr int BM = 256, BK = 64, HALF = 128, HTB = HALF * BK * 2  , STAGE_BYTES = 8 * HTB, NXCD = 8, WGM = 8;

__host__ __device__ __forceinline__ int lds_byte(int r, int c) { const int st = (r >> 4) * 2 + (c >> 5), rr = r & 15, cc = c & 31, ob = rr * 64 + cc * 2; return st * 1024 + (ob ^ (((ob >> 9) & 1) << 5)); }
__host__ __device__ __forceinline__ void stage_rc(int b, int& R, int& C) { const int st = b / 1024, sb = b % 1024, swz = sb ^ (((sb >> 9) & 1) << 5); R = (st >> 1) * 16 + swz / 64; C = (st & 1) * 32 + (swz % 64) / 2; }
__host__ __device__ __forceinline__ int perm32(int rho) { const int n = rho >> 4, i = rho & 15; return 8 * (i >> 2) + 4 * n + (i & 3); }

struct Unit { int pm, pn; };
struct Gemm { const bf16_t* A; const bf16_t* Bt; int M, N, K; };

struct StaticOrder {
    int nM, nN, nwg, G, c;
    __host__ __device__ void init(int M, int N, int G_, int c_) { nM = M / BM; nN = N / BM; nwg = nM * nN; G = G_; c = c_; }
    __host__ __device__ bool next(int i, Unit& u) const {
        const long L = (long)i * G + c; if (L >= nwg) return false;
        int wgid = (int)L; { const int q = nwg / NXCD, r = nwg % NXCD, xcd = wgid % NXCD, off = wgid / NXCD; wgid = (xcd < r ? xcd * (q + 1) : r * (q + 1) + (xcd - r) * q) + off; }
        const int nig = WGM * nN, gid = wgid / nig, fm = gid * WGM, gsz = (nM - fm) < WGM ? (nM - fm) : WGM;
        u.pm = fm + ((wgid % nig) % gsz); u.pn = (wgid % nig) / gsz; return true;
    }
    __device__ __forceinline__ void a_ready(const Unit&) const {}
    __device__ __forceinline__ void done(const Unit&) const {}
};
template <class Epi, class Sched, bool ALIGN_EPI = false, bool SP2 = false, bool GATHER = false>
__device__ __forceinline__ void gemm_phase(PG8_LAS unsigned char* lds, const Gemm g, const Sched& S, const Epi& E, const int* rowidx = nullptr) {
    int tid_ = threadIdx.x; asm volatile("" : "+v"(tid_));
    const int tid = tid_, wid = __builtin_amdgcn_readfirstlane(tid >> 6), lane = tid & 63, wr = wid >> 2, wc = wid & 3, fr = lane & 15, fq = lane >> 4;
    const int K = g.K, nt = K / BK;
    unsigned voffA[2], voffA1[2], voffB[2];
#pragma unroll
    for (int i = 0; i < 2; ++i) { int R, C; stage_rc(tid * 16 + i * 8192, R, C); const int Rb = Epi::PERM ? ((R & ~31) + perm32(R & 31)) : R;
        if (GATHER) { voffA[i] = ((unsigned)rowidx[R] * (unsigned)K + (unsigned)C) * 2u; voffA1[i] = ((unsigned)rowidx[128 + R] * (unsigned)K + (unsigned)C) * 2u; }
        else { voffA[i] = (unsigned)(R * K + C) * 2u; voffA1[i] = voffA[i]; }
        voffB[i] = (unsigned)(Rb * K + C) * 2u; }
    const size_t hstepA = GATHER ? (size_t)0 : (size_t)HALF * K * 2;
    const size_t kstep = (size_t)(BK * 2);
    const size_t hstep = (size_t)HALF * K * 2;
    const size_t tstep = 2 * hstep;
    const unsigned ldsw = (unsigned)wid * 1024u;
    const int aoff = lds_byte(wr * 64 + fr, fq * 8), boff = lds_byte(wc * 32 + fr, fq * 8);
#define PG8_SA(b, h) (((b) * 2 + (h)) * HTB)
#define PG8_SB(b, h) ((4 + (b) * 2 + (h)) * HTB)
#define PG8_STAGE(bufoff, gbase, voff) do { _Pragma("unroll") for (int _i = 0; _i < 2; ++_i) \
        __builtin_amdgcn_global_load_lds((const unsigned*)((const char*)(gbase) + (voff)[_i]), (PG8_LAS unsigned*)(lds + (bufoff) + ldsw + _i * 8192), 16, 0, 0); } while (0)
#define PG8_LDA(dst, b, h) do { _Pragma("unroll") for (int m = 0; m < 4; ++m) _Pragma("unroll") for (int k = 0; k < 2; ++k) dst[m][k] = *(const PG8_LAS bf16x8*)(lds + PG8_SA(b, h) + aoff + m * 2048 + k * 1024); } while (0)
#define PG8_LDB(dst, b, h) do { _Pragma("unroll") for (int n = 0; n < 2; ++n) _Pragma("unroll") for (int k = 0; k < 2; ++k) dst[n][k] = *(const PG8_LAS bf16x8*)(lds + PG8_SB(b, h) + boff + n * 2048 + k * 1024); } while (0)
#define PG8_MMA(ai, bj, At, Bt) do { __builtin_amdgcn_s_setprio(1); _Pragma("unroll") for (int m = 0; m < 4; ++m) _Pragma("unroll") for (int n = 0; n < 2; ++n) _Pragma("unroll") for (int k = 0; k < 2; ++k) \
        acc[ai][bj][m][n] = __builtin_amdgcn_mfma_f32_16x16x32_bf16(Bt[n][k], At[m][k], acc[ai][bj][m][n], 0, 0, 0); __builtin_amdgcn_s_setprio(0); } while (0)
#define PG8_WAIT_V(n) asm volatile("s_waitcnt vmcnt(" #n ")" ::: "memory")
#define PG8_WAIT_L(n) asm volatile("s_waitcnt lgkmcnt(" #n ")" ::: "memory")
#define PG8_BAR __builtin_amdgcn_s_barrier()
#define PG8_SCHED __builtin_amdgcn_sched_barrier(0)
    Unit cur, nxt; int ui = 0;
    if (!S.next(0, cur)) return;
    f32x4 acc[2][2][4][2];
#pragma unroll
    for (int a = 0; a < 2; ++a)
#pragma unroll
        for (int b = 0; b < 2; ++b)
#pragma unroll
            for (int m = 0; m < 4; ++m)
#pragma unroll
                for (int n = 0; n < 2; ++n) acc[a][b][m][n] = (f32x4){0.f, 0.f, 0.f, 0.f};
    bf16x8 At[4][2], B0[2][2], B1[2][2];
    const char* cA = (const char*)g.A + (size_t)cur.pm * tstep; const char* cB = (const char*)g.Bt + (size_t)cur.pn * tstep;
    S.a_ready(cur);
    if constexpr (SP2) {
        PG8_STAGE(PG8_SB(0, 0), cB, voffB); PG8_STAGE(PG8_SB(0, 1), cB + hstep, voffB); PG8_STAGE(PG8_SA(0, 0), cA, voffA); PG8_STAGE(PG8_SA(0, 1), cA + hstepA, voffA1);
        if (wr == 1) PG8_BAR;
        PG8_WAIT_V(2); PG8_BAR;
        PG8_STAGE(PG8_SB(1, 0), cB + kstep, voffB); PG8_STAGE(PG8_SA(1, 0), cA + kstep, voffA); PG8_STAGE(PG8_SB(1, 1), cB + hstep + kstep, voffB);
        PG8_WAIT_V(6); PG8_BAR;
    } else {
        PG8_STAGE(PG8_SB(0, 0), cB, voffB); PG8_STAGE(PG8_SA(0, 0), cA, voffA); PG8_STAGE(PG8_SB(0, 1), cB + hstep, voffB); PG8_STAGE(PG8_SA(0, 1), cA + hstepA, voffA1);
        if (wr == 1) PG8_BAR;
        PG8_WAIT_V(4); PG8_BAR;
        PG8_STAGE(PG8_SB(1, 0), cB + kstep, voffB); PG8_STAGE(PG8_SA(1, 0), cA + kstep, voffA); PG8_STAGE(PG8_SB(1, 1), cB + hstep + kstep, voffB);
        PG8_WAIT_V(6); PG8_BAR;
    }
    for (;;) {
        const bool has_next = S.next(ui + 1, nxt);
        const char* nA = has_next ? (const char*)g.A + (size_t)nxt.pm * tstep : cA; const char* nB = has_next ? (const char*)g.Bt + (size_t)nxt.pn * tstep : cB;
        for (int t = 0; t < nt; t += 2) {
            const bool last = (t == nt - 2);
            const char* a1 = cA + (size_t)(t + 1) * kstep;
            const char* a2 = last ? nA : cA + (size_t)(t + 2) * kstep; const char* b2 = last ? nB : cB + (size_t)(t + 2) * kstep;
            const char* a3 = a2 + kstep; const char* b3 = b2 + kstep;
            if (last && has_next) S.a_ready(nxt);
            if constexpr (SP2) {
            PG8_LDB(B0, 0, 0); PG8_LDB(B1, 0, 1); PG8_SCHED; PG8_LDA(At, 0, 0); PG8_STAGE(PG8_SA(1, 1), a1 + hstepA, voffA1);
            PG8_WAIT_V(8); PG8_WAIT_L(0); PG8_BAR; PG8_MMA(0, 0, At, B0); PG8_MMA(0, 1, At, B1); PG8_BAR; PG8_SCHED;
            PG8_LDA(At, 0, 1); PG8_STAGE(PG8_SB(0, 0), b2, voffB); PG8_STAGE(PG8_SB(0, 1), b2 + hstep, voffB); PG8_STAGE(PG8_SA(0, 0), a2, voffA);
            PG8_WAIT_V(8); PG8_WAIT_L(0); PG8_BAR; PG8_MMA(1, 0, At, B0); PG8_MMA(1, 1, At, B1); PG8_BAR; PG8_SCHED;
            PG8_LDB(B0, 1, 0); PG8_LDB(B1, 1, 1); PG8_SCHED; PG8_LDA(At, 1, 0); PG8_STAGE(PG8_SA(0, 1), a2 + hstepA, voffA1);
            PG8_WAIT_V(8); PG8_WAIT_L(0); PG8_BAR; PG8_MMA(0, 0, At, B0); PG8_MMA(0, 1, At, B1); PG8_BAR; PG8_SCHED;
            PG8_LDA(At, 1, 1); PG8_STAGE(PG8_SB(1, 0), b3, voffB); PG8_STAGE(PG8_SB(1, 1), b3 + hstep, voffB); PG8_STAGE(PG8_SA(1, 0), a3, voffA);
            PG8_WAIT_V(8); PG8_WAIT_L(0); PG8_BAR; PG8_MMA(1, 0, At, B0); PG8_MMA(1, 1, At, B1); PG8_BAR; PG8_SCHED;
            } else {
            PG8_LDB(B0, 0, 0); PG8_SCHED; PG8_LDA(At, 0, 0); PG8_STAGE(PG8_SA(1, 1), a1 + hstepA, voffA1);
            PG8_WAIT_L(8); PG8_BAR; PG8_WAIT_L(0); PG8_MMA(0, 0, At, B0); PG8_BAR; PG8_SCHED;
            PG8_LDB(B1, 0, 1); PG8_STAGE(PG8_SB(0, 0), b2, voffB);
            PG8_BAR; PG8_WAIT_L(0); PG8_MMA(0, 1, At, B1); PG8_BAR;
            PG8_LDA(At, 0, 1); PG8_STAGE(PG8_SA(0, 0), a2, voffA);
            PG8_BAR; PG8_WAIT_L(0); PG8_MMA(1, 0, At, B0); PG8_BAR; PG8_SCHED;
            PG8_STAGE(PG8_SB(0, 1), b2 + hstep, voffB);
            PG8_WAIT_V(6); PG8_BAR; PG8_MMA(1, 1, At, B1); PG8_BAR;
            PG8_LDB(B0, 1, 0); PG8_SCHED; PG8_LDA(At, 1, 0); PG8_STAGE(PG8_SA(0, 1), a2 + hstepA, voffA1);
            PG8_WAIT_L(8); PG8_BAR; PG8_WAIT_L(0); PG8_MMA(0, 0, At, B0); PG8_BAR; PG8_SCHED;
            PG8_LDB(B1, 1, 1); PG8_STAGE(PG8_SB(1, 0), b3, voffB);
            PG8_BAR; PG8_WAIT_L(0); PG8_MMA(0, 1, At, B1); PG8_BAR;
            PG8_LDA(At, 1, 1); PG8_STAGE(PG8_SA(1, 0), a3, voffA);
            PG8_BAR; PG8_WAIT_L(0); PG8_MMA(1, 0, At, B0); PG8_BAR; PG8_SCHED;
            PG8_STAGE(PG8_SB(1, 1), b3 + hstep, voffB);
            PG8_WAIT_V(6); PG8_BAR; PG8_MMA(1, 1, At, B1); PG8_BAR;
            }
        }
        if constexpr (ALIGN_EPI) { if (wr == 0) PG8_BAR; }
        if constexpr (!Epi::AFTER_DRAIN) { E(acc, cur, wr, wc, fr, fq); S.done(cur); }
        if (!has_next) break;
#pragma unroll
        for (int a = 0; a < 2; ++a)
#pragma unroll
            for (int b = 0; b < 2; ++b)
#pragma unroll
                for (int m = 0; m < 4; ++m)
#pragma unroll
                    for (int n = 0; n < 2; ++n) acc[a][b][m][n] = (f32x4){0.f, 0.f, 0.f, 0.f};
        cur = nxt; cA = nA; cB = nB; ++ui;
        if constexpr (ALIGN_EPI) { if (wr == 1) PG8_BAR; }
    }
    PG8_WAIT_V(0);
    if constexpr (!ALIGN_EPI) { if (wr == 0) PG8_BAR; }
    PG8_BAR;
    if constexpr (Epi::AFTER_DRAIN) { E.fused(acc, cur, wr, wc, fr, fq, lds, wid, lane); S.done(cur); }
#undef PG8_SA
#undef PG8_SB
#undef PG8_STAGE
#undef PG8_LDA
#undef PG8_LDB
#undef PG8_MMA
#undef PG8_WAIT_V
#undef PG8_WAIT_L
#undef PG8_BAR
#undef PG8_SCHED
}
}
#define DPP_F(v, ctrl) __builtin_bit_cast(float, __builtin_amdgcn_update_dpp(0, __builtin_bit_cast(int, (v)), (ctrl), 0xF, 0xF, true))
__device__ __forceinline__ float rdlane_f(float v, int l) { return __builtin_bit_cast(float, __builtin_amdgcn_readlane(__builtin_bit_cast(int, v), l)); }
__device__ __forceinline__ float dpp_sum16x(float v) {
  v += DPP_F(v, 0xB1); v += DPP_F(v, 0x4E); v += DPP_F(v, 0x141); v += DPP_F(v, 0x140);
  return v;
}
__device__ __forceinline__ float dpp_max16x(float v) {
  v = fmaxf(v, DPP_F(v, 0xB1)); v = fmaxf(v, DPP_F(v, 0x4E)); v = fmaxf(v, DPP_F(v, 0x141)); v = fmaxf(v, DPP_F(v, 0x140));
  return v;
}
__device__ __forceinline__ float wave_sum_fast(float v) {
  v = dpp_sum16x(v);
  return (rdlane_f(v, 0) + rdlane_f(v, 16)) + (rdlane_f(v, 32) + rdlane_f(v, 48));
}
__device__ __forceinline__ float wave_max_fast(float v) {
  v = dpp_max16x(v);
  return fmaxf(fmaxf(rdlane_f(v, 0), rdlane_f(v, 16)), fmaxf(rdlane_f(v, 32), rdlane_f(v, 48)));
}
__device__ __forceinline__ float fast_tanh(float x) { const float e = __expf(2.f * x); return 1.f - 2.f / (e + 1.f); }


__device__ __forceinline__ float4 bf4_to_f4(uint2 u) {
  float4 r;
  r.x = __uint_as_float(u.x << 16); r.y = __uint_as_float(u.x & 0xffff0000u);
  r.z = __uint_as_float(u.y << 16); r.w = __uint_as_float(u.y & 0xffff0000u);
  return r;
}
__device__ __forceinline__ uint2 pack4(float a, float b, float c, float d) { uint2 r; r.x = cvtpk(a, b); r.y = cvtpk(c, d); return r; }
#define XCD_GROUP (VBID & 7)
#define XCD_LB (VBID >> 3)
#define XCD_NB ((VGRID + 7 - (VBID & 7)) >> 3)

struct EpiInproj {
  static constexpr bool PERM = true, AFTER_DRAIN = false;
  const float* rope; bf16_t* Q; bf16_t* K; bf16_t* V; bf16_t* FE;
  __device__ __forceinline__ void operator()(const pg8::f32x4 (&acc)[2][2][4][2], const pg8::Unit& u, int wr, int wc, int fr, int fq) const {
#pragma unroll
    for (int bj = 0; bj < 2; ++bj) {
      const int s0 = u.pn * 256 + bj * 128 + wc * 32 + 8 * fq;
      const int hb = s0 & ~63, f0 = ((s0 & 63) >> 3) << 2;
      if (hb + f0 >= INW) continue;
#pragma unroll
      for (int ai = 0; ai < 2; ++ai)
#pragma unroll
        for (int m = 0; m < 4; ++m) {
          const int t = u.pm * 256 + ai * 128 + wr * 64 + m * 16 + fr;
          const pg8::f32x4 v0 = acc[ai][bj][m][0], v1 = acc[ai][bj][m][1];
          if (hb < 1024) {
            const int pos = t & (SEQ - 1);
            const float4 c01 = *(const float4*)(rope + (size_t)(pos * 32 + f0) * 2);
            const float4 c23 = *(const float4*)(rope + (size_t)(pos * 32 + f0) * 2 + 4);
            const float cs[4] = {c01.x, c01.z, c23.x, c23.z}, sn[4] = {c01.y, c01.w, c23.y, c23.w};
            const float sc = (hb < 512) ? 0.125f : 1.f;
            float o1[4], o2[4];
#pragma unroll
            for (int j = 0; j < 4; ++j) { o1[j] = (v0[j] * cs[j] - v1[j] * sn[j]) * sc; o2[j] = (v1[j] * cs[j] + v0[j] * sn[j]) * sc; }
            bf16_t* dst = (hb < 512) ? (Q + (size_t)t * 512 + hb + f0) : (K + (size_t)t * 512 + (hb - 512) + f0);
            *(uint2*)dst = pack4(o1[0], o1[1], o1[2], o1[3]);
            *(uint2*)(dst + 32) = pack4(o2[0], o2[1], o2[2], o2[3]);
          } else if (hb < 1536) {
            bf16_t* dst = V + (size_t)t * 512 + (hb - 1024) + f0;
            *(uint2*)dst = pack4(v0[0], v0[1], v0[2], v0[3]);
            *(uint2*)(dst + 32) = pack4(v1[0], v1[1], v1[2], v1[3]);
          } else {
            bf16_t* dst = FE + (size_t)t * FEW + (hb - 1536) + f0;
            *(uint2*)dst = pack4(v0[0], v0[1], v0[2], v0[3]);
            if (hb + f0 + 32 < INW) *(uint2*)(dst + 32) = pack4(v1[0], v1[1], v1[2], v1[3]);
          }
        }
    }
  }
};
__device__ __forceinline__ void phase_inproj(const Params& p, char* smem_all) {
  pg8::Gemm g{(const pg8::bf16_t*)(p.ws + OFF_XB), (const pg8::bf16_t*)(p.ws + OFF_WINT), T_TOK, 3584, DM};
  pg8::StaticOrder S; S.init(T_TOK, 3584, (int)gridDim.x, (int)blockIdx.x);
  EpiInproj E{(const float*)(p.ws + OFF_ROPE), (bf16_t*)(p.ws + OFF_Q), (bf16_t*)(p.ws + OFF_K), (bf16_t*)(p.ws + OFF_V), (bf16_t*)(p.ws + OFF_FEATS)};
  pg8::gemm_phase<EpiInproj, pg8::StaticOrder, true, true>((PG8_LAS unsigned char*)smem_all, g, S, E);
}

__device__ __forceinline__ void phase_prep_a(const Params& p) {
  const bf16_t* __restrict__ FE = (const bf16_t*)(p.ws + OFF_FEATS);
  const float* __restrict__ mu = p.in[2];
  bf16_t* R = (bf16_t*)(p.ws + OFF_R); bf16_t* K2 = (bf16_t*)(p.ws + OFF_K2); bf16_t* V2 = (bf16_t*)(p.ws + OFF_V2);
  bf16_t* ACT = (bf16_t*)(p.ws + OFF_ACT);
  for (size_t i = (size_t)VBID * NTHR + VTID; i < (size_t)T_TOK * 232; i += (size_t)VGRID * NTHR) {
    const int t = (int)(i / 232), ch = (int)(i - (size_t)t * 232);
    if (ch >= 228) { *(uint4*)(ACT + (size_t)t * 320 + 288 + (ch - 228) * 8) = make_uint4(0u, 0u, 0u, 0u); continue; }
    const int col = ch * 8;
    const uint4 cu = *(const uint4*)(FE + (size_t)t * FEW + col);
    uint4 pv = make_uint4(0u, 0u, 0u, 0u);
    if ((t & (SEQ - 1)) != 0) pv = *(const uint4*)(FE + (size_t)(t - 1) * FEW + col);
    const float4 m0 = *(const float4*)(mu + col), m1 = *(const float4*)(mu + col + 4);
    const unsigned cw[4] = {cu.x, cu.y, cu.z, cu.w}, pw[4] = {pv.x, pv.y, pv.z, pv.w};
    const float mm[8] = {m0.x, m0.y, m0.z, m0.w, m1.x, m1.y, m1.z, m1.w};
    float f[8];
#pragma unroll
    for (int q = 0; q < 4; ++q) {
      const float c0 = __uint_as_float(cw[q] << 16), c1 = __uint_as_float(cw[q] & 0xffff0000u);
      const float p0 = __uint_as_float(pw[q] << 16), p1 = __uint_as_float(pw[q] & 0xffff0000u);
      f[2 * q] = c0 + (p0 - c0) * mm[2 * q];
      f[2 * q + 1] = c1 + (p1 - c1) * mm[2 * q + 1];
    }
    bf16_t* dst;
    if (col < 512) dst = R + (size_t)t * 512 + col;
    else if (col < 1024) dst = K2 + (size_t)t * 512 + (col - 512);
    else if (col < 1536) dst = V2 + (size_t)t * 512 + (col - 1024);
    else {
      dst = ACT + (size_t)t * 320 + (col - 1536);
      if (col < 1600) {
#pragma unroll
        for (int q = 0; q < 8; ++q) f[q] = fast_tanh(f[q]);
      } else if (col >= 1664) {
#pragma unroll
        for (int q = 0; q < 8; ++q) f[q] = sigmoidf_(f[q]);
      }
    }
    uint4 w; w.x = cvtpk(f[0], f[1]); w.y = cvtpk(f[2], f[3]); w.z = cvtpk(f[4], f[5]); w.w = cvtpk(f[6], f[7]);
    *(uint4*)dst = w;
  }
}

template <int PASS>
__device__ __forceinline__ void prep_item(const Params& p, char* smem, const int row0, const int col0) {
  const bf16_t* __restrict__ ACT = (const bf16_t*)(p.ws + OFF_ACT);
  constexpr int ACOL = PASS * 64;
  constexpr int NK = (PASS == 2) ? 3 : 1;
  const float* __restrict__ Wm = (PASS == 0) ? p.in[4] : (PASS == 1) ? p.in[6] : p.in[7];
  f32x4 acc[4][4];
  acc_zero(acc);
  gemm128_acc<0, (PASS == 2)>(acc, smem, NK,
      [=](int, int rowl, int kc) { return *(const uint4*)(ACT + (size_t)(row0 + rowl) * 320 + ACOL + kc * 8); },
      [=](int nq) { return Wm + col0 + nq * 4; }, 512, 160);
  int tid_l_ = VTID; asm volatile("" : "+v"(tid_l_)); const int tid = tid_l_, lane = tid & 63, wid = tid >> 6;
  const int wr = wid >> 1, wc = wid & 1, fr = lane & 15, fq = lane >> 4;
  const int cb = col0 + wc * 64;
  if (PASS == 0) {
    const float* __restrict__ w0 = p.in[3];
    float* W = (float*)(p.ws + OFF_W);
#pragma unroll
    for (int n = 0; n < 4; ++n) {
      const int c = cb + n * 16 + fq * 4;
      const float4 w04 = *(const float4*)(w0 + c);
      const float w0c[4] = {w04.x, w04.y, w04.z, w04.w};
#pragma unroll
      for (int m = 0; m < 4; ++m) {
        const int t = row0 + wr * 64 + m * 16 + fr;
        float d[4];
#pragma unroll
        for (int j = 0; j < 4; ++j) {
          const float nz = -(w0c[j] + acc[m][n][j]);
          const float sp = fmaxf(nz, 0.f) + __logf(1.f + __expf(-fabsf(nz)));
          d[j] = __expf(-__expf(-sp - 0.5f));
        }
        *(float4*)(W + (size_t)t * 512 + c) = make_float4(d[0], d[1], d[2], d[3]);
      }
    }
  } else if (PASS == 2) {
    bf16_t* G = (bf16_t*)(p.ws + OFF_G);
#pragma unroll
    for (int m = 0; m < 4; ++m) {
      const int t = row0 + wr * 64 + m * 16 + fr;
#pragma unroll
      for (int n = 0; n < 4; ++n)
        *(uint2*)(G + (size_t)t * 512 + cb + n * 16 + fq * 4) = pack4(acc[m][n][0], acc[m][n][1], acc[m][n][2], acc[m][n][3]);
    }
  } else {
    const float* __restrict__ a0 = p.in[5]; const float* __restrict__ k_k = p.in[8]; const float* __restrict__ k_a = p.in[9];
    const float* __restrict__ r_k = p.in[10];
    const bf16_t* __restrict__ R = (const bf16_t*)(p.ws + OFF_R); bf16_t* K2 = (bf16_t*)(p.ws + OFF_K2);
    bf16_t* A = (bf16_t*)(p.ws + OFF_A); bf16_t* B = (bf16_t*)(p.ws + OFF_B); float* SB = (float*)(p.ws + OFF_SB);
#pragma unroll
    for (int m = 0; m < 4; ++m) {
      __builtin_amdgcn_sched_barrier(0);
      const int t = row0 + wr * 64 + m * 16 + fr;
      float kk[4][4];
      float ssp = 0.f, sbp = 0.f;
#pragma unroll
      for (int n = 0; n < 4; ++n) {
        const int c = cb + n * 16 + fq * 4;
        const size_t o = (size_t)t * 512 + c;
        const float4 rr4 = bf4_to_f4(*(const uint2*)(R + o)), kx4 = bf4_to_f4(*(const uint2*)(K2 + o));
        const float rr[4] = {rr4.x, rr4.y, rr4.z, rr4.w}, kx[4] = {kx4.x, kx4.y, kx4.z, kx4.w};
        const float4 a04 = *(const float4*)(a0 + c), kk4 = *(const float4*)(k_k + c), ka4 = *(const float4*)(k_a + c), rk4 = *(const float4*)(r_k + c);
        const float a0c[4] = {a04.x, a04.y, a04.z, a04.w}, kkc[4] = {kk4.x, kk4.y, kk4.z, kk4.w}, kac[4] = {ka4.x, ka4.y, ka4.z, ka4.w};
        const float rkc[4] = {rk4.x, rk4.y, rk4.z, rk4.w};
        float k2[4];
#pragma unroll
        for (int j = 0; j < 4; ++j) {
          const float av = sigmoidf_(a0c[j] + acc[m][n][j]);
          acc[m][n][j] = av;
          kk[n][j] = kx[j] * kkc[j];
          k2[j] = kx[j] * (1.f + (av - 1.f) * kac[j]);
          ssp += kk[n][j] * kk[n][j];
          sbp += rr[j] * k2[j] * rkc[j];
        }
        *(uint2*)(K2 + o) = pack4(k2[0], k2[1], k2[2], k2[3]);
      }
      ssp += __shfl_xor(ssp, 16, 64); ssp += __shfl_xor(ssp, 32, 64);
      sbp += __shfl_xor(sbp, 16, 64); sbp += __shfl_xor(sbp, 32, 64);
      const float inv = 1.f / fmaxf(sqrtf(ssp), 1e-12f);
#pragma unroll
      for (int n = 0; n < 4; ++n) {
        const size_t o = (size_t)t * 512 + cb + n * 16 + fq * 4;
        *(uint2*)(A + o) = pack4(-kk[n][0] * inv, -kk[n][1] * inv, -kk[n][2] * inv, -kk[n][3] * inv);
        *(uint2*)(B + o) = pack4(kk[n][0] * inv * acc[m][n][0], kk[n][1] * inv * acc[m][n][1], kk[n][2] * inv * acc[m][n][2], kk[n][3] * inv * acc[m][n][3]);
      }
      if (fq == 0) SB[(size_t)t * 8 + (cb >> 6)] = sbp;
    }
  }
}
__device__ __forceinline__ void phase_prep(const Params& p, char* smem) {
  for (int item = VBID; item < (T_TOK / 128) * 8; item += VGRID) {
    const int pass = item >> 10, mt = (item & 1023) >> 2, nt = item & 3;
    if (pass == 0) prep_item<0>(p, smem, mt * 128, nt * 128);
    else prep_item<1>(p, smem, mt * 128, nt * 128);
  }
}

__device__ __forceinline__ float dpp_sum16(float v) {
  v += __builtin_bit_cast(float, __builtin_amdgcn_update_dpp(0, __builtin_bit_cast(int, v), 0xB1, 0xF, 0xF, true));
  v += __builtin_bit_cast(float, __builtin_amdgcn_update_dpp(0, __builtin_bit_cast(int, v), 0x4E, 0xF, 0xF, true));
  v += __builtin_bit_cast(float, __builtin_amdgcn_update_dpp(0, __builtin_bit_cast(int, v), 0x141, 0xF, 0xF, true));
  v += __builtin_bit_cast(float, __builtin_amdgcn_update_dpp(0, __builtin_bit_cast(int, v), 0x140, 0xF, 0xF, true));
  return v;
}
#define SC_CH 16
#define SC_ARR (SC_CH * 64 * 4)
#define SC_BUF (5 * SC_ARR + SC_CH * 16 * 4)
__device__ __forceinline__ void phase_scan(const Params& p, char* smem) {
  if (VHALF != 0 || blockIdx.x >= 256) return;
  const bf16_t* __restrict__ R = (const bf16_t*)(p.ws + OFF_R); const bf16_t* __restrict__ K2 = (const bf16_t*)(p.ws + OFF_K2);
  const bf16_t* __restrict__ V2 = (const bf16_t*)(p.ws + OFF_V2); const bf16_t* __restrict__ A = (const bf16_t*)(p.ws + OFF_A);
  const bf16_t* __restrict__ B = (const bf16_t*)(p.ws + OFF_B); const float* __restrict__ W = (const float*)(p.ws + OFF_W);
  float* YS = (float*)(p.ws + OFF_YS);
  const int bh = (int)blockIdx.x >> 2, rg = (int)blockIdx.x & 3, b = bh >> 3, h = bh & 7;
  int tid_l_ = VTID; asm volatile("" : "+v"(tid_l_)); const int tid = tid_l_, lane = tid & 63, wid = tid >> 6, j = lane & 15, rq = lane >> 4;
  const int rowl = wid * 4 + rq;
  const int ls = tid >> 4, lc = tid & 15;
  const int vs = (tid >> 2) & 15, vq = tid & 3;
  const size_t tb = (size_t)b * SEQ;
  const size_t goff = (tb + ls) * 512 + h * 64 + lc * 4;
  const size_t voff = (tb + vs) * 512 + h * 64 + rg * 16 + vq * 4;
  uint2 ga, gb, gk, gr, gv; float4 gw;
  gv = make_uint2(0u, 0u);
  ga = *(const uint2*)(A + goff); gb = *(const uint2*)(B + goff); gk = *(const uint2*)(K2 + goff); gr = *(const uint2*)(R + goff);
  gw = *(const float4*)(W + goff);
  if (tid < 64) gv = *(const uint2*)(V2 + voff);
  {
    char* bf = smem;
    *(float4*)(bf + 0 * SC_ARR + ls * 256 + lc * 16) = bf4_to_f4(ga);
    *(float4*)(bf + 1 * SC_ARR + ls * 256 + lc * 16) = gw;
    *(float4*)(bf + 2 * SC_ARR + ls * 256 + lc * 16) = bf4_to_f4(gb);
    *(float4*)(bf + 3 * SC_ARR + ls * 256 + lc * 16) = bf4_to_f4(gk);
    *(float4*)(bf + 4 * SC_ARR + ls * 256 + lc * 16) = bf4_to_f4(gr);
    if (tid < 64) *(float4*)(bf + 5 * SC_ARR + vs * 64 + vq * 16) = bf4_to_f4(gv);
  }
  HSYNC();
  float s0 = 0.f, s1 = 0.f, s2 = 0.f, s3 = 0.f;
  const int NCH = SEQ / SC_CH;
  for (int c = 0; c < NCH; ++c) {
    if (c + 1 < NCH) {
      const size_t o2 = goff + (size_t)(c + 1) * SC_CH * 512;
      ga = *(const uint2*)(A + o2); gb = *(const uint2*)(B + o2); gk = *(const uint2*)(K2 + o2); gr = *(const uint2*)(R + o2);
      gw = *(const float4*)(W + o2);
      if (tid < 64) gv = *(const uint2*)(V2 + voff + (size_t)(c + 1) * SC_CH * 512);
    }
    const char* bf = smem + (c & 1) * SC_BUF;
    float ykeep = 0.f;
#pragma unroll
    for (int s = 0; s < SC_CH; ++s) {
      const float4 a4 = *(const float4*)(bf + 0 * SC_ARR + s * 256 + j * 16);
      const float4 w4 = *(const float4*)(bf + 1 * SC_ARR + s * 256 + j * 16);
      const float4 b4 = *(const float4*)(bf + 2 * SC_ARR + s * 256 + j * 16);
      const float4 k4 = *(const float4*)(bf + 3 * SC_ARR + s * 256 + j * 16);
      const float4 r4 = *(const float4*)(bf + 4 * SC_ARR + s * 256 + j * 16);
      const float vv = *(const float*)(bf + 5 * SC_ARR + s * 64 + rowl * 4);
      float sa = (s0 * a4.x + s1 * a4.y) + (s2 * a4.z + s3 * a4.w);
      sa = dpp_sum16(sa);
      s0 = s0 * w4.x + (sa * b4.x + vv * k4.x);
      s1 = s1 * w4.y + (sa * b4.y + vv * k4.y);
      s2 = s2 * w4.z + (sa * b4.z + vv * k4.z);
      s3 = s3 * w4.w + (sa * b4.w + vv * k4.w);
      float y = (s0 * r4.x + s1 * r4.y) + (s2 * r4.z + s3 * r4.w);
      y = dpp_sum16(y);
      ykeep = (j == s) ? y : ykeep;
    }
    YS[(tb + (size_t)c * SC_CH + j) * 512 + h * 64 + rg * 16 + rowl] = ykeep;
    if (c + 1 < NCH) {
      char* bn = smem + ((c + 1) & 1) * SC_BUF;
      *(float4*)(bn + 0 * SC_ARR + ls * 256 + lc * 16) = bf4_to_f4(ga);
      *(float4*)(bn + 1 * SC_ARR + ls * 256 + lc * 16) = gw;
      *(float4*)(bn + 2 * SC_ARR + ls * 256 + lc * 16) = bf4_to_f4(gb);
      *(float4*)(bn + 3 * SC_ARR + ls * 256 + lc * 16) = bf4_to_f4(gk);
      *(float4*)(bn + 4 * SC_ARR + ls * 256 + lc * 16) = bf4_to_f4(gr);
      if (tid < 64) *(float4*)(bn + 5 * SC_ARR + vs * 64 + vq * 16) = bf4_to_f4(gv);
    }
    HSYNC();
  }
}


#define CONV_TILES (257 * 96)
struct ConvDesc { const float* src; bf16_t* dst; int ldn, k0, n0, kdim, part; };
__device__ __forceinline__ ConvDesc conv_desc(const Params& p, const int ti) {
  ConvDesc d;
  const int e = ti / 96, q = ti - e * 96, part = q >> 5, w = q & 31;
  d.part = part;
  if (part < 2) {
    d.src = (e < NEXP) ? p.in[18 + part] + (size_t)e * DM * 256 : p.in[21 + part];
    d.ldn = 256; d.k0 = (w >> 1) * 64; d.n0 = (w & 1) * 128; d.kdim = 1024;
    d.dst = (bf16_t*)(p.ws + OFF_EW1) + (size_t)e * 512 * 1024;
  } else {
    d.src = (e < NEXP) ? p.in[20] + (size_t)e * 256 * DM : p.in[23];
    d.ldn = 1024; d.k0 = (w >> 3) * 64; d.n0 = (w & 7) * 128; d.kdim = 256;
    d.dst = (bf16_t*)(p.ws + OFF_EW2) + (size_t)e * 1024 * 256;
  }
  return d;
}
#define CV_LOAD(d, r) { \
    const float* bp_ = (d).src + (size_t)((d).k0 + ko * 8) * (d).ldn + (d).n0 + nq * 4; \
    r##0 = *(const float4*)(bp_); r##1 = *(const float4*)(bp_ + (size_t)1 * (d).ldn); r##2 = *(const float4*)(bp_ + (size_t)2 * (d).ldn); \
    r##3 = *(const float4*)(bp_ + (size_t)3 * (d).ldn); r##4 = *(const float4*)(bp_ + (size_t)4 * (d).ldn); r##5 = *(const float4*)(bp_ + (size_t)5 * (d).ldn); \
    r##6 = *(const float4*)(bp_ + (size_t)6 * (d).ldn); r##7 = *(const float4*)(bp_ + (size_t)7 * (d).ldn); }
#define CV_LDS(r, base) { \
    uint4 v; \
    v.x = cvtpk((r##0).x, (r##1).x); v.y = cvtpk((r##2).x, (r##3).x); v.z = cvtpk((r##4).x, (r##5).x); v.w = cvtpk((r##6).x, (r##7).x); *(uint4*)((base) + lds_off(nq * 4 + 0, ko)) = v; \
    v.x = cvtpk((r##0).y, (r##1).y); v.y = cvtpk((r##2).y, (r##3).y); v.z = cvtpk((r##4).y, (r##5).y); v.w = cvtpk((r##6).y, (r##7).y); *(uint4*)((base) + lds_off(nq * 4 + 1, ko)) = v; \
    v.x = cvtpk((r##0).z, (r##1).z); v.y = cvtpk((r##2).z, (r##3).z); v.z = cvtpk((r##4).z, (r##5).z); v.w = cvtpk((r##6).z, (r##7).z); *(uint4*)((base) + lds_off(nq * 4 + 2, ko)) = v; \
    v.x = cvtpk((r##0).w, (r##1).w); v.y = cvtpk((r##2).w, (r##3).w); v.z = cvtpk((r##4).w, (r##5).w); v.w = cvtpk((r##6).w, (r##7).w); *(uint4*)((base) + lds_off(nq * 4 + 3, ko)) = v; }
#define CV_OUT(d, base) { \
    _Pragma("unroll") for (int u = 0; u < 4; ++u) { \
      const int row = (tid >> 3) + 32 * u, chunk = tid & 7; \
      const int c = (d).n0 + row; \
      const int orow = ((d).part < 2) ? ((c >> 7) * 256 + (d).part * 128 + (c & 127)) : c;     \
      *(uint4*)((d).dst + (size_t)orow * (d).kdim + (d).k0 + chunk * 8) = *(const uint4*)((base) + lds_off(row, chunk)); } }
__device__ __forceinline__ void convert_tile2(const Params& p, char* smem, const int t2) {
  int tid_l_ = VTID; asm volatile("" : "+v"(tid_l_)); const int tid = tid_l_, nq = tid & 31, ko = tid >> 5;
  const ConvDesc da = conv_desc(p, 2 * t2), db = conv_desc(p, 2 * t2 + 1);
  float4 ra0, ra1, ra2, ra3, ra4, ra5, ra6, ra7, rb0, rb1, rb2, rb3, rb4, rb5, rb6, rb7;
  CV_LOAD(da, ra)
  CV_LOAD(db, rb)
  CV_LDS(ra, smem)
  CV_LDS(rb, smem + 16384)
  HSYNC();
  CV_OUT(da, smem)
  CV_OUT(db, smem + 16384)
  HSYNC();
}
#undef CV_LOAD
#undef CV_LDS
#undef CV_OUT

__device__ __forceinline__ int vt_off(int d, int key) { const int swz = ((d >> 2) & 15) ^ ((d & 3) << 3); return d * 512 + (((key >> 2) ^ swz) << 3); }
__device__ __forceinline__ void attn_item(const Params& p, char* smem, const int item) {
  const bf16_t* __restrict__ Q = (const bf16_t*)(p.ws + OFF_Q); const bf16_t* __restrict__ K = (const bf16_t*)(p.ws + OFF_K);
  const bf16_t* __restrict__ V = (const bf16_t*)(p.ws + OFF_V);
  bf16_t* OP = (bf16_t*)(p.ws + OFF_OP); float* LSE = (float*)(p.ws + OFF_LSE);
  char* Ks = smem; char* VT = smem + 32768; float* linv_s = (float*)(smem + 65536);
  int tid_l_ = VTID; asm volatile("" : "+v"(tid_l_)); const int tid = tid_l_, lane = tid & 63, wid = tid >> 6, l31 = lane & 31, hi = lane >> 5;
  {
    const int pp = item >> 11, rem = item & 2047, bh = rem >> 5, sub = rem & 31;
    const int dsh = pp * 2, nbsh = 5 - dsh;
    const int r = sub >> nbsh, n = sub & ((1 << nbsh) - 1);
    const int b = bh >> 3, h = bh & 7, tb = b * SEQ;
    HSYNC();
#pragma unroll
    for (int u = 0; u < 8; ++u) {
      if (u == 4) __builtin_amdgcn_sched_barrier(0);
      const int row = (tid >> 3) + 32 * u, chunk = tid & 7;
      int ik = n * 128 - 128 + row; ik = ik < 0 ? 0 : ik;
      const int tok = tb + (ik << dsh) + r;
      *(uint4*)(Ks + lds_off(row, chunk)) = *(const uint4*)(K + (size_t)tok * 512 + h * 64 + chunk * 8);
    }
#pragma unroll
    for (int ps = 0; ps < 2; ++ps) {
      const int dq = tid & 15, kbase = ps * 128 + (tid >> 4) * 8;
      uint2 v0, v1, v2, v3, v4, v5, v6, v7;
#define LDV(i, dst) { int ik = n * 128 - 128 + kbase + i; ik = ik < 0 ? 0 : ik; const int tok = tb + (ik << dsh) + r; dst = *(const uint2*)(V + (size_t)tok * 512 + h * 64 + dq * 4); }
      LDV(0, v0) LDV(1, v1) LDV(2, v2) LDV(3, v3) LDV(4, v4) LDV(5, v5) LDV(6, v6) LDV(7, v7)
#undef LDV
      {
        uint2 w;
        w.x = (v0.x & 0xffffu) | (v1.x << 16); w.y = (v2.x & 0xffffu) | (v3.x << 16);
        *(uint2*)(VT + vt_off(dq * 4 + 0, kbase)) = w;
        w.x = (v4.x & 0xffffu) | (v5.x << 16); w.y = (v6.x & 0xffffu) | (v7.x << 16);
        *(uint2*)(VT + vt_off(dq * 4 + 0, kbase + 4)) = w;
        w.x = (v0.x >> 16) | (v1.x & 0xffff0000u); w.y = (v2.x >> 16) | (v3.x & 0xffff0000u);
        *(uint2*)(VT + vt_off(dq * 4 + 1, kbase)) = w;
        w.x = (v4.x >> 16) | (v5.x & 0xffff0000u); w.y = (v6.x >> 16) | (v7.x & 0xffff0000u);
        *(uint2*)(VT + vt_off(dq * 4 + 1, kbase + 4)) = w;
        w.x = (v0.y & 0xffffu) | (v1.y << 16); w.y = (v2.y & 0xffffu) | (v3.y << 16);
        *(uint2*)(VT + vt_off(dq * 4 + 2, kbase)) = w;
        w.x = (v4.y & 0xffffu) | (v5.y << 16); w.y = (v6.y & 0xffffu) | (v7.y << 16);
        *(uint2*)(VT + vt_off(dq * 4 + 2, kbase + 4)) = w;
        w.x = (v0.y >> 16) | (v1.y & 0xffff0000u); w.y = (v2.y >> 16) | (v3.y & 0xffff0000u);
        *(uint2*)(VT + vt_off(dq * 4 + 3, kbase)) = w;
        w.x = (v4.y >> 16) | (v5.y & 0xffff0000u); w.y = (v6.y >> 16) | (v7.y & 0xffff0000u);
        *(uint2*)(VT + vt_off(dq * 4 + 3, kbase + 4)) = w;
      }
    }
    HSYNC();
    const int iq = n * 128 + wid * 32 + l31;
    const int tq = tb + (iq << dsh) + r;
    bf16x8 qf[4];
#pragma unroll
    for (int ks = 0; ks < 4; ++ks) qf[ks] = *(const bf16x8*)(Q + (size_t)tq * 512 + h * 64 + ks * 16 + hi * 8);
    f32x16 st[5];
#pragma unroll
    for (int kb = 0; kb < 5; ++kb) {
      st[kb] = (f32x16){0.f, 0.f, 0.f, 0.f, 0.f, 0.f, 0.f, 0.f, 0.f, 0.f, 0.f, 0.f, 0.f, 0.f, 0.f, 0.f};
#pragma unroll
      for (int ks = 0; ks < 4; ++ks) {
        const bf16x8 kf = *(const bf16x8*)(Ks + lds_off(32 * (wid + kb) + l31, 2 * ks + hi));
        st[kb] = __builtin_amdgcn_mfma_f32_32x32x16_bf16(kf, qf[ks], st[kb], 0, 0, 0);
      }
    }
    float m = -INFINITY;
#pragma unroll
    for (int kb = 0; kb < 5; ++kb)
#pragma unroll
      for (int i = 0; i < 16; ++i) {
        const int kirel = 32 * kb + (i & 3) + 8 * (i >> 2) + 4 * hi;
        const bool valid = (kirel >= l31) && (kirel <= l31 + 128) && (n > 0 || (32 * wid + kirel) >= 128);
        const float s = valid ? st[kb][i] : -INFINITY;
        st[kb][i] = s;
        m = fmaxf(m, s);
      }
    m = fmaxf(m, __shfl_xor(m, 32, 64));
    float l = 0.f;
#pragma unroll
    for (int kb = 0; kb < 5; ++kb)
#pragma unroll
      for (int i = 0; i < 16; ++i) { const float pe = __expf(st[kb][i] - m); st[kb][i] = pe; l += pe; }
    l += __shfl_xor(l, 32, 64);
    f32x16 o0 = (f32x16){0.f, 0.f, 0.f, 0.f, 0.f, 0.f, 0.f, 0.f, 0.f, 0.f, 0.f, 0.f, 0.f, 0.f, 0.f, 0.f};
    f32x16 o1 = o0;
#pragma unroll
    for (int kb = 0; kb < 5; ++kb)
#pragma unroll
      for (int s = 0; s < 2; ++s) {
        union { unsigned u[4]; bf16x8 v; } pa;
        pa.u[0] = cvtpk(st[kb][8 * s + 0], st[kb][8 * s + 1]); pa.u[1] = cvtpk(st[kb][8 * s + 2], st[kb][8 * s + 3]);
        pa.u[2] = cvtpk(st[kb][8 * s + 4], st[kb][8 * s + 5]); pa.u[3] = cvtpk(st[kb][8 * s + 6], st[kb][8 * s + 7]);
        const int key0 = 32 * (wid + kb) + 16 * s + 4 * hi;
        {
          union { uint2 u[2]; bf16x8 v; } vb;
          vb.u[0] = *(const uint2*)(VT + vt_off(l31, key0)); vb.u[1] = *(const uint2*)(VT + vt_off(l31, key0 + 8));
          o0 = __builtin_amdgcn_mfma_f32_32x32x16_bf16(pa.v, vb.v, o0, 0, 0, 0);
        }
        {
          union { uint2 u[2]; bf16x8 v; } vb;
          vb.u[0] = *(const uint2*)(VT + vt_off(32 + l31, key0)); vb.u[1] = *(const uint2*)(VT + vt_off(32 + l31, key0 + 8));
          o1 = __builtin_amdgcn_mfma_f32_32x32x16_bf16(pa.v, vb.v, o1, 0, 0, 0);
        }
      }
    if (hi == 0) {
      linv_s[wid * 32 + l31] = 1.f / l;
      LSE[((size_t)pp * T_TOK + tq) * 8 + h] = m + __logf(l);
    }
#pragma unroll
    for (int i = 0; i < 16; ++i) {
      const int qrel = (i & 3) + 8 * (i >> 2) + 4 * hi;
      const int iq2 = n * 128 + wid * 32 + qrel;
      const int tq2 = tb + (iq2 << dsh) + r;
      const float li = linv_s[wid * 32 + qrel];
      bf16_t* op = OP + ((size_t)pp * T_TOK + tq2) * 512 + h * 64 + l31;
      op[0] = f2bf(o0[i] * li);
      op[32] = f2bf(o1[i] * li);
    }
  }
}

__device__ __forceinline__ void phase_convert(const Params& p, char* smem) {
  int* ctl = (int*)(p.ws + OFF_CTL);
  int* slot = (int*)(smem + 66304);
  HSYNC();
  int ti;
  for (;;) {
    if (VTID == 0) *slot = atomicAdd(&ctl[CTL_CONVQ], 1);
    HSYNC();
    ti = *slot;
    HSYNC();
    if (ti >= 6144) break;
    attn_item(p, smem, ti);
  }
  __builtin_amdgcn_sched_barrier(0);
  for (;;) {
    if (ti >= 7168 + CONV_TILES / 2) break;
    if (ti < 7168) prep_item<2>(p, smem, ((ti - 6144) >> 2) * 128, ((ti - 6144) & 3) * 128);
    else convert_tile2(p, smem, ti - 7168);
    if (VTID == 0) *slot = atomicAdd(&ctl[CTL_CONVQ], 1);
    HSYNC();
    ti = *slot;
    HSYNC();
  }
}

__device__ __forceinline__ void unpack8(const uint4 u, float (&f)[8]) {
  f[0] = __uint_as_float(u.x << 16); f[1] = __uint_as_float(u.x & 0xffff0000u); f[2] = __uint_as_float(u.y << 16); f[3] = __uint_as_float(u.y & 0xffff0000u);
  f[4] = __uint_as_float(u.z << 16); f[5] = __uint_as_float(u.z & 0xffff0000u); f[6] = __uint_as_float(u.w << 16); f[7] = __uint_as_float(u.w & 0xffff0000u);
}
__device__ __forceinline__ float dpp_sum8(float v) {
  v += DPP_F(v, 0xB1); v += DPP_F(v, 0x4E); v += DPP_F(v, 0x141);
  return v;
}
__device__ __forceinline__ void phase_post(const Params& p) {
  const float* __restrict__ YS = (const float*)(p.ws + OFF_YS); const bf16_t* __restrict__ V2 = (const bf16_t*)(p.ws + OFF_V2);
  const bf16_t* __restrict__ G = (const bf16_t*)(p.ws + OFF_G); const float* __restrict__ SB = (const float*)(p.ws + OFF_SB);
  const bf16_t* __restrict__ OP = (const bf16_t*)(p.ws + OFF_OP); const float* __restrict__ LSE = (const float*)(p.ws + OFF_LSE);
  const float* __restrict__ lnx_g = p.in[11]; const float* __restrict__ lnx_b = p.in[12];
  bf16_t* MIXED = (bf16_t*)(p.ws + OFF_MIXED);
  const int lane = VTID & 63, wid = VTID >> 6;
  const int c = lane * 8, hh = lane >> 3;
  const float4 g0 = *(const float4*)(lnx_g + c), g1 = *(const float4*)(lnx_g + c + 4), b0 = *(const float4*)(lnx_b + c), b1 = *(const float4*)(lnx_b + c + 4);
  const float gg[8] = {g0.x, g0.y, g0.z, g0.w, g1.x, g1.y, g1.z, g1.w}, bb[8] = {b0.x, b0.y, b0.z, b0.w, b1.x, b1.y, b1.z, b1.w};
  for (int t = VBID * 4 + wid; t < T_TOK; t += VGRID * 4) {
    const size_t o = (size_t)t * 512 + c;
    const float4 y0 = *(const float4*)(YS + o), y1 = *(const float4*)(YS + o + 4);
    const float y[8] = {y0.x, y0.y, y0.z, y0.w, y1.x, y1.y, y1.z, y1.w};
    float s = 0.f;
#pragma unroll
    for (int i = 0; i < 8; ++i) s += y[i];
    const float mean = dpp_sum8(s) * (1.f / 64.f);
    float q = 0.f;
#pragma unroll
    for (int i = 0; i < 8; ++i) { const float d = y[i] - mean; q += d * d; }
    const float rs = rsqrtf(dpp_sum8(q) * (1.f / 64.f) + GN_EPS_F);
    float v2[8], gt[8];
    unpack8(*(const uint4*)(V2 + o), v2); unpack8(*(const uint4*)(G + o), gt);
    const float sb = SB[(size_t)t * 8 + hh];
    float res[8];
#pragma unroll
    for (int i = 0; i < 8; ++i) res[i] = ((y[i] - mean) * rs * gg[i] + bb[i] + sb * v2[i]) * gt[i];
    uint4 w; w.x = cvtpk(res[0], res[1]); w.y = cvtpk(res[2], res[3]); w.z = cvtpk(res[4], res[5]); w.w = cvtpk(res[6], res[7]);
    *(uint4*)(MIXED + (size_t)t * 1024 + 512 + c) = w;
    const float l0 = LSE[((size_t)0 * T_TOK + t) * 8 + hh], l1 = LSE[((size_t)1 * T_TOK + t) * 8 + hh], l2 = LSE[((size_t)2 * T_TOK + t) * 8 + hh];
    const float mx = fmaxf(l0, fmaxf(l1, l2));
    float e0 = __expf(l0 - mx), e1 = __expf(l1 - mx), e2 = __expf(l2 - mx);
    const float inv = 1.f / (e0 + e1 + e2);
    e0 *= inv; e1 *= inv; e2 *= inv;
    float o0[8], o1[8], o2[8];
    unpack8(*(const uint4*)(OP + (size_t)0 * T_TOK * 512 + o), o0); unpack8(*(const uint4*)(OP + (size_t)1 * T_TOK * 512 + o), o1);
    unpack8(*(const uint4*)(OP + (size_t)2 * T_TOK * 512 + o), o2);
    float av[8];
#pragma unroll
    for (int i = 0; i < 8; ++i) av[i] = e0 * o0[i] + e1 * o1[i] + e2 * o2[i];
    w.x = cvtpk(av[0], av[1]); w.y = cvtpk(av[2], av[3]); w.z = cvtpk(av[4], av[5]); w.w = cvtpk(av[6], av[7]);
    *(uint4*)(MIXED + (size_t)t * 1024 + c) = w;
  }
}

struct EpiOutproj {
  static constexpr bool PERM = true, AFTER_DRAIN = false;
  const float* x; float* U;
  __device__ __forceinline__ void operator()(const pg8::f32x4 (&acc)[2][2][4][2], const pg8::Unit& u, int wr, int wc, int fr, int fq) const {
#pragma unroll
    for (int ai = 0; ai < 2; ++ai)
#pragma unroll
      for (int m = 0; m < 4; ++m) {
        const int t = u.pm * 256 + ai * 128 + wr * 64 + m * 16 + fr;
#pragma unroll
        for (int bj = 0; bj < 2; ++bj) {
          const size_t o = (size_t)t * DM + u.pn * 256 + bj * 128 + wc * 32 + 8 * fq;
          const float4 x0 = *(const float4*)(x + o), x1 = *(const float4*)(x + o + 4);
          const pg8::f32x4 v0 = acc[ai][bj][m][0], v1 = acc[ai][bj][m][1];
          *(float4*)(U + o) = make_float4(ALPHA_F * x0.x + v0[0], ALPHA_F * x0.y + v0[1], ALPHA_F * x0.z + v0[2], ALPHA_F * x0.w + v0[3]);
          *(float4*)(U + o + 4) = make_float4(ALPHA_F * x1.x + v1[0], ALPHA_F * x1.y + v1[1], ALPHA_F * x1.z + v1[2], ALPHA_F * x1.w + v1[3]);
        }
      }
  }
};
__device__ __forceinline__ void phase_outproj(const Params& p, char* smem_all) {
  pg8::Gemm g{(const pg8::bf16_t*)(p.ws + OFF_MIXED), (const pg8::bf16_t*)(p.ws + OFF_WOUTT), T_TOK, DM, DM};
  pg8::StaticOrder S; S.init(T_TOK, DM, (int)gridDim.x, (int)blockIdx.x);
  EpiOutproj E{p.in[0], p.out};
  pg8::gemm_phase<EpiOutproj, pg8::StaticOrder, true, true>((PG8_LAS unsigned char*)smem_all, g, S, E);
}

__device__ __forceinline__ void phase_ln1(const Params& p) {
  float* X1 = p.out;
  const float* __restrict__ g1 = p.in[14]; const float* __restrict__ b1 = p.in[15];
  bf16_t* X1B = (bf16_t*)(p.ws + OFF_X1B);
  const int lane = VTID & 63, wid = VTID >> 6;
  for (int t = VBID * 4 + wid; t < T_TOK; t += VGRID * 4) {
    const size_t base = (size_t)t * DM;
    float4 v[4];
    float s = 0.f;
#pragma unroll
    for (int u = 0; u < 4; ++u) { v[u] = *(const float4*)(X1 + base + u * 256 + lane * 4); s += (v[u].x + v[u].y) + (v[u].z + v[u].w); }
    const float mean = wave_sum_fast(s) * (1.f / DM);
    float q = 0.f;
#pragma unroll
    for (int u = 0; u < 4; ++u) {
      const float d0 = v[u].x - mean, d1 = v[u].y - mean, d2 = v[u].z - mean, d3 = v[u].w - mean;
      q += (d0 * d0 + d1 * d1) + (d2 * d2 + d3 * d3);
    }
    const float rs = rsqrtf(wave_sum_fast(q) * (1.f / DM) + LN_EPS_F);
#pragma unroll
    for (int u = 0; u < 4; ++u) {
      const int c = u * 256 + lane * 4;
      const float4 g = *(const float4*)(g1 + c), bb = *(const float4*)(b1 + c);
      float4 y;
      y.x = (v[u].x - mean) * rs * g.x + bb.x; y.y = (v[u].y - mean) * rs * g.y + bb.y;
      y.z = (v[u].z - mean) * rs * g.z + bb.z; y.w = (v[u].w - mean) * rs * g.w + bb.w;
      *(float4*)(X1 + base + c) = y;
      uint2 hi; hi.x = cvtpk(y.x, y.y); hi.y = cvtpk(y.z, y.w);
      *(uint2*)(X1B + base + c) = hi;
    }
  }
}

__device__ __forceinline__ void phase_router_gemm(const Params& p, char* smem) {
  const bf16_t* __restrict__ X1B = (const bf16_t*)(p.ws + OFF_X1B);
  const float* __restrict__ router_w = p.in[16];
  float* AFF = (float*)(p.ws + OFF_AFF);
  for (int item = VBID; item < (T_TOK / 128) * 2; item += VGRID) {
    const int row0 = (item >> 1) * 128, col0 = (item & 1) * 128;
    f32x4 acc[4][4];
    acc_zero(acc);
    gemm128_acc<0, false>(acc, smem, 16,
        [=](int, int rowl, int kc) { return *(const uint4*)(X1B + (size_t)(row0 + rowl) * DM + kc * 8); },
        [=](int nq) { return router_w + col0 + nq * 4; }, NEXP, 0);
    int tid_l_ = VTID; asm volatile("" : "+v"(tid_l_)); const int tid = tid_l_, lane = tid & 63, wid = tid >> 6;
    const int wr = wid >> 1, wc = wid & 1, fr = lane & 15, fq = lane >> 4;
#pragma unroll
    for (int m = 0; m < 4; ++m) {
      const int t = row0 + wr * 64 + m * 16 + fr;
#pragma unroll
      for (int n = 0; n < 4; ++n)
        *(float4*)(AFF + (size_t)t * NEXP + col0 + wc * 64 + n * 16 + fq * 4) =
            make_float4(sigmoidf_(acc[m][n][0]), sigmoidf_(acc[m][n][1]), sigmoidf_(acc[m][n][2]), sigmoidf_(acc[m][n][3]));
    }
  }
}

__device__ __forceinline__ void phase_topk(const Params& p) {
  const float* __restrict__ AFF = (const float*)(p.ws + OFF_AFF);
  const float* __restrict__ router_bias = p.in[17];
  int* LIST = (int*)(p.ws + OFF_LIST); float* GATEW = (float*)(p.ws + OFF_GATEW);
  int* counts = (int*)(p.ws + OFF_CTL);
  const int lane = VTID & 63, wid = VTID >> 6;
  const float4 b4 = *(const float4*)(router_bias + lane * 4);
  for (int t = VBID * 4 + wid; t < T_TOK; t += VGRID * 4) {
    const float4 a4 = *(const float4*)(AFF + (size_t)t * NEXP + lane * 4);
    float s0 = a4.x + b4.x, s1 = a4.y + b4.y, s2 = a4.z + b4.z, s3 = a4.w + b4.w;
    const float hi01 = fmaxf(s0, s1), lo01 = fminf(s0, s1), hi23 = fmaxf(s2, s3), lo23 = fminf(s2, s3);
    float m1 = fmaxf(hi01, hi23), m2 = fmaxf(fminf(hi01, hi23), fmaxf(lo01, lo23));
    { const float o1 = DPP_F(m1, 0xB1), o2 = DPP_F(m2, 0xB1); const float n1 = fmaxf(m1, o1); m2 = fmaxf(fminf(m1, o1), fmaxf(m2, o2)); m1 = n1; }
    { const float o1 = DPP_F(m1, 0x4E), o2 = DPP_F(m2, 0x4E); const float n1 = fmaxf(m1, o1); m2 = fmaxf(fminf(m1, o1), fmaxf(m2, o2)); m1 = n1; }
    { const float o1 = DPP_F(m1, 0x141), o2 = DPP_F(m2, 0x141); const float n1 = fmaxf(m1, o1); m2 = fmaxf(fminf(m1, o1), fmaxf(m2, o2)); m1 = n1; }
    const float gs = m1 + m2;
    const int g = lane >> 3;
    int rank = 0;
#pragma unroll
    for (int gg = 0; gg < 8; ++gg) { const float G = rdlane_f(gs, gg * 8); rank += ((G > gs) || (G == gs && gg < g)) ? 1 : 0; }
    if (rank >= 4) { s0 = -INFINITY; s1 = -INFINITY; s2 = -INFINITY; s3 = -INFINITY; }
    int my_e = 0; float my_a = 0.f;
#pragma unroll 1
    for (int it = 0; it < 8; ++it) {
      const float lm = fmaxf(fmaxf(s0, s1), fmaxf(s2, s3));
      const float wm = wave_max_fast(lm);
      const unsigned long long bal = __ballot(lm == wm);
      const int win = __ffsll((long long)bal) - 1;
      const int wi = (s0 == wm) ? 0 : ((s1 == wm) ? 1 : ((s2 == wm) ? 2 : 3));
      const float wa = (wi == 0) ? a4.x : ((wi == 1) ? a4.y : ((wi == 2) ? a4.z : a4.w));
      const int e_w = __builtin_amdgcn_readlane(lane * 4 + wi, win);
      const float a_w = rdlane_f(wa, win);
      if (lane == win) { if (wi == 0) s0 = -INFINITY; else if (wi == 1) s1 = -INFINITY; else if (wi == 2) s2 = -INFINITY; else s3 = -INFINITY; }
      if (lane == it) { my_e = e_w; my_a = a_w; }
    }
    const float asum = rdlane_f(dpp_sum16x(my_a), 0);
    if (lane < 8) {
      const int pos = atomicAdd(&counts[CNT(my_e)], 1);
      if (pos < LCAP) LIST[(size_t)my_e * LCAP + pos] = lane * T_TOK + t;
      GATEW[(size_t)lane * T_TOK + t] = my_a * 2.5f / asum;
    }
  }
}

#define CTL_MOEPRE 1536
__device__ __forceinline__ void phase_moe_prefix(const Params& p) {
  if (VBID == 0 && VTID < 64) {
    int* ctl = (int*)(p.ws + OFF_CTL);
    const int l = VTID;
    const int t0 = (min(ctl[CNT(4 * l)], LCAP) + 255) >> 8, t1 = (min(ctl[CNT(4 * l + 1)], LCAP) + 255) >> 8;
    const int t2 = (min(ctl[CNT(4 * l + 2)], LCAP) + 255) >> 8, t3 = (min(ctl[CNT(4 * l + 3)], LCAP) + 255) >> 8;
    const int tot = t0 + t1 + t2 + t3;
    int inc = tot;
#pragma unroll
    for (int o = 1; o < 64; o <<= 1) { const int v = __shfl_up(inc, o, 64); if (l >= o) inc += v; }
    const int base = inc - tot;
    ctl[CTL_MOEPRE + 4 * l] = base; ctl[CTL_MOEPRE + 4 * l + 1] = base + t0; ctl[CTL_MOEPRE + 4 * l + 2] = base + t0 + t1; ctl[CTL_MOEPRE + 4 * l + 3] = base + t0 + t1 + t2;
    if (l == 63) { ctl[CTL_MOEPRE + NEXP] = inc; ctl[CTL_MOEPRE + NEXP + 1] = inc + T_TOK / 256; }
  }
}
struct SeqOrder {
  int n;
  __device__ __forceinline__ bool next(int i, pg8::Unit& u) const { if (i >= n) return false; u.pm = 0; u.pn = i; return true; }
  __device__ __forceinline__ void a_ready(const pg8::Unit&) const {}
  __device__ __forceinline__ void done(const pg8::Unit&) const {}
};
struct EpiMoe1 {
  static constexpr bool PERM = true, AFTER_DRAIN = false;
  bf16_t* HS;
  __device__ __forceinline__ void operator()(const pg8::f32x4 (&acc)[2][2][4][2], const pg8::Unit& u, int wr, int wc, int fr, int fq) const {
#pragma unroll
    for (int ai = 0; ai < 2; ++ai)
#pragma unroll
      for (int m = 0; m < 4; ++m) {
        __builtin_amdgcn_sched_barrier(0);
        const int row = ai * 128 + wr * 64 + m * 16 + fr;
        const pg8::f32x4 g0 = acc[ai][0][m][0], g1 = acc[ai][0][m][1], u0 = acc[ai][1][m][0], u1 = acc[ai][1][m][1];
        uint4 w;
        w.x = cvtpk(g0[0] * sigmoidf_(g0[0]) * u0[0], g0[1] * sigmoidf_(g0[1]) * u0[1]);
        w.y = cvtpk(g0[2] * sigmoidf_(g0[2]) * u0[2], g0[3] * sigmoidf_(g0[3]) * u0[3]);
        w.z = cvtpk(g1[0] * sigmoidf_(g1[0]) * u1[0], g1[1] * sigmoidf_(g1[1]) * u1[1]);
        w.w = cvtpk(g1[2] * sigmoidf_(g1[2]) * u1[2], g1[3] * sigmoidf_(g1[3]) * u1[3]);
        *(uint4*)(HS + (size_t)row * 256 + u.pn * 128 + wc * 32 + 8 * fq) = w;
      }
  }
};
struct EpiMoe2 {
  static constexpr bool PERM = true, AFTER_DRAIN = false;
  const int* asg; const float* GATEW; bf16_t* Y; float* X1;
  __device__ __forceinline__ void operator()(const pg8::f32x4 (&acc)[2][2][4][2], const pg8::Unit& u, int wr, int wc, int fr, int fq) const {
#pragma unroll
    for (int ai = 0; ai < 2; ++ai)
#pragma unroll
      for (int m = 0; m < 4; ++m) {
        __builtin_amdgcn_sched_barrier(0);
        const int a = asg[256 + ai * 128 + wr * 64 + m * 16 + fr];
        if (a < 0) continue;
        if (a < 8 * T_TOK) {
          const float gw = GATEW[a];
#pragma unroll
          for (int bj = 0; bj < 2; ++bj) {
            const pg8::f32x4 v0 = acc[ai][bj][m][0], v1 = acc[ai][bj][m][1];
            uint4 w; w.x = cvtpk(v0[0] * gw, v0[1] * gw); w.y = cvtpk(v0[2] * gw, v0[3] * gw); w.z = cvtpk(v1[0] * gw, v1[1] * gw); w.w = cvtpk(v1[2] * gw, v1[3] * gw);
            *(uint4*)(Y + (size_t)a * DM + u.pn * 256 + bj * 128 + wc * 32 + 8 * fq) = w;
          }
        } else {
          const int t = a - 8 * T_TOK;
#pragma unroll
          for (int bj = 0; bj < 2; ++bj) {
            float* xp = X1 + (size_t)t * DM + u.pn * 256 + bj * 128 + wc * 32 + 8 * fq;
            const float4 x0 = *(const float4*)xp, x1 = *(const float4*)(xp + 4);
            const pg8::f32x4 v0 = acc[ai][bj][m][0], v1 = acc[ai][bj][m][1];
            *(float4*)xp = make_float4(ALPHA_F * x0.x + v0[0], ALPHA_F * x0.y + v0[1], ALPHA_F * x0.z + v0[2], ALPHA_F * x0.w + v0[3]);
            *(float4*)(xp + 4) = make_float4(ALPHA_F * x1.x + v1[0], ALPHA_F * x1.y + v1[1], ALPHA_F * x1.z + v1[2], ALPHA_F * x1.w + v1[3]);
          }
        }
      }
  }
};
#define MOE_TAB_OFF 131072
__device__ __forceinline__ void phase_moe(const Params& p, char* smem_all, int* slot) {
  int* tab = (int*)(smem_all + MOE_TAB_OFF);
  const int* __restrict__ LIST = (const int*)(p.ws + OFF_LIST);
  const int* counts = (const int*)(p.ws + OFF_CTL);
  const int* pre = counts + CTL_MOEPRE;
  int* ctl = (int*)(p.ws + OFF_CTL);
  bf16_t* HS = (bf16_t*)(p.ws + OFF_HSCR) + (size_t)blockIdx.x * 256 * 256;
  const int nitems = pre[NEXP + 1];
  for (;;) {
    __syncthreads();
    if (threadIdx.x == 0) *slot = atomicAdd(&ctl[CTL_CONVQ + 1], 1);
    __syncthreads();
    const int i = *slot;
    if (i >= nitems) break;
    int lo = 0, hi = NEXP;
    while (lo < hi) { const int mid = (lo + hi + 1) >> 1; if (pre[mid] <= i) lo = mid; else hi = mid - 1; }
    const int e = lo;
    const int cnt = (e < NEXP) ? min(counts[CNT(e)], LCAP) : T_TOK;
    const int r0 = (i - pre[e]) * 256;
    if (threadIdx.x < 256) {
      const int r = r0 + (int)threadIdx.x;
      const int a = (r < cnt) ? ((e < NEXP) ? LIST[(size_t)e * LCAP + r] : (8 * T_TOK + r)) : -1;
      tab[256 + threadIdx.x] = a;
      tab[threadIdx.x] = (a >= 0 ? a : 0) & (T_TOK - 1);
    }
    __syncthreads();
    {
      int k1 = DM; asm volatile("" : "+s"(k1));
      pg8::Gemm g{(const pg8::bf16_t*)(p.ws + OFF_X1B), (const pg8::bf16_t*)(p.ws + OFF_EW1) + (size_t)e * 512 * 1024, 256, 512, k1};
      SeqOrder S{2};
      EpiMoe1 E{HS};
      pg8::gemm_phase<EpiMoe1, SeqOrder, true, true, true>((PG8_LAS unsigned char*)smem_all, g, S, E, tab);
    }
    {
      int k2 = 256; asm volatile("" : "+s"(k2));
      pg8::Gemm g{(const pg8::bf16_t*)HS, (const pg8::bf16_t*)(p.ws + OFF_EW2) + (size_t)e * 1024 * 256, 256, DM, k2};
      SeqOrder S{4};
      EpiMoe2 E{tab, (const float*)(p.ws + OFF_GATEW), (bf16_t*)(p.ws + OFF_Y), p.out};
      pg8::gemm_phase<EpiMoe2, SeqOrder, true, true, false>((PG8_LAS unsigned char*)smem_all, g, S, E);
    }
  }
}

__device__ __forceinline__ void phase_final(const Params& p, char* smem) {
  float* OUT = p.out;
  const bf16_t* __restrict__ Y = (const bf16_t*)(p.ws + OFF_Y);
  const float* __restrict__ g2 = p.in[24]; const float* __restrict__ b2 = p.in[25];
  const int lane = VTID & 63, wid = VTID >> 6;
  for (int t = VBID * 4 + wid; t < T_TOK; t += VGRID * 4) {
    const size_t base = (size_t)t * DM;
    float4 v[4];
    float s = 0.f;
#pragma unroll
    for (int u = 0; u < 4; ++u) {
      const int c = u * 256 + lane * 4;
      const float4 xv = *(const float4*)(OUT + base + c);
      float a0 = 0.f, a1 = 0.f, a2 = 0.f, a3 = 0.f;
#pragma unroll
      for (int sl = 0; sl < 8; ++sl) {
        const float4 yv = bf4_to_f4(*(const uint2*)(Y + ((size_t)sl * T_TOK + t) * DM + c));
        a0 += yv.x; a1 += yv.y; a2 += yv.z; a3 += yv.w;
      }
      v[u] = make_float4(xv.x + a0, xv.y + a1, xv.z + a2, xv.w + a3);
      s += (v[u].x + v[u].y) + (v[u].z + v[u].w);
    }
    const float mean = wave_sum_fast(s) * (1.f / DM);
    float q = 0.f;
#pragma unroll
    for (int u = 0; u < 4; ++u) {
      const float d0 = v[u].x - mean, d1 = v[u].y - mean, d2 = v[u].z - mean, d3 = v[u].w - mean;
      q += (d0 * d0 + d1 * d1) + (d2 * d2 + d3 * d3);
    }
    const float rs = rsqrtf(wave_sum_fast(q) * (1.f / DM) + LN_EPS_F);
#pragma unroll
    for (int u = 0; u < 4; ++u) {
      const int c = u * 256 + lane * 4;
      const float4 g = *(const float4*)(g2 + c), bb = *(const float4*)(b2 + c);
      *(float4*)(OUT + base + c) = make_float4((v[u].x - mean) * rs * g.x + bb.x, (v[u].y - mean) * rs * g.y + bb.y,
                                               (v[u].z - mean) * rs * g.z + bb.z, (v[u].w - mean) * rs * g.w + bb.w);
    }
  }
}

#define LAS __attribute__((address_space(3)))
#define XB_TMO      128
#define XB_XCNT(j)  (256  + 64 * (j))
#define XB_XSUB(j)  (1280 + 64 * (j))
#define XB_XGEN(j)  (2304 + 64 * (j))
#define XB_TOP      3328
#define XB_TOPGEN   3392
#define XCD_BAR_WORDS 3456
#define XB_SPIN_CAP (1u << 22)
__device__ __forceinline__ unsigned xb_ld(unsigned* p)              { return __hip_atomic_load(p, __ATOMIC_RELAXED, __HIP_MEMORY_SCOPE_AGENT); }
__device__ __forceinline__ unsigned xb_add(unsigned* p, unsigned v) { return __hip_atomic_fetch_add(p, v, __ATOMIC_RELAXED, __HIP_MEMORY_SCOPE_AGENT); }
__device__ __forceinline__ unsigned xb_xcc_id() { return (unsigned)__builtin_amdgcn_s_getreg((3 << 11) | 20) & 0xFu; }
#define XB_SPIN(cond, bar) do { unsigned _sp = 0; while (cond) { __builtin_amdgcn_s_sleep(1); \
    if ((++_sp & 255u) == 0u) { if (xb_ld(&(bar)[XB_TMO])) break; if (_sp > XB_SPIN_CAP) { atomicAdd(&(bar)[XB_TMO], 1u); break; } } } } while (0)
struct XcdBarrier { unsigned* bar; unsigned x; volatile LAS unsigned* st; };
__device__ __forceinline__ XcdBarrier xcd_barrier_post(unsigned* bar, volatile LAS unsigned* st) {
  XcdBarrier b; b.bar = bar; b.x = xb_xcc_id(); b.st = st;
  if (threadIdx.x == 0) (void)xb_add(&bar[XB_XCNT(b.x)], 1u);
  return b;
}
__device__ __forceinline__ void xcd_barrier_complete(unsigned* bar, unsigned x, unsigned& nloc, unsigned& nx) {
  const unsigned G = gridDim.x * gridDim.y * gridDim.z;
  unsigned sum, cnt, mine, sp = 0u;
  for (;;) {
    sum = 0u; cnt = 0u; mine = 0u;
#pragma unroll
    for (unsigned j = 0; j < 16; ++j) { const unsigned c = xb_ld(&bar[XB_XCNT(j)]); sum += c; cnt += (c > 0u) ? 1u : 0u; mine = (j == x) ? c : mine; }
    if (sum == G) break;
    __builtin_amdgcn_s_sleep(1);
    if ((++sp & 255u) == 0u) { if (xb_ld(&bar[XB_TMO])) break; if (sp > XB_SPIN_CAP) { atomicAdd(&bar[XB_TMO], 1u); break; } }
  }
  nloc = mine > 0u ? mine : 1u; nx = cnt > 0u ? cnt : 1u;
}
__device__ __forceinline__ void xcd_barrier(const XcdBarrier& b) {
  asm volatile("s_waitcnt vmcnt(0)" ::: "memory");
  __syncthreads();
  if (threadIdx.x == 0) {
    unsigned* bar = b.bar;
    __builtin_amdgcn_s_waitcnt(0);
    unsigned nloc = b.st[0], nx = b.st[1];
    if (nloc == 0u) { xcd_barrier_complete(bar, b.x, nloc, nx); b.st[0] = nloc; b.st[1] = nx; }
    const unsigned old = xb_add(&bar[XB_XSUB(b.x)], 1u);
    const unsigned gen = old / nloc;
    if (old + 1u == (gen + 1u) * nloc) {
      __builtin_amdgcn_fence(__ATOMIC_RELEASE, "agent");
      asm volatile("s_waitcnt vmcnt(0)" ::: "memory");
      const unsigned og = xb_add(&bar[XB_TOP], 1u);
      const unsigned tg = og / nx;
      if (og + 1u == (tg + 1u) * nx) xb_add(&bar[XB_TOPGEN], 1u);
      else XB_SPIN(xb_ld(&bar[XB_TOPGEN]) == tg, bar);
      __builtin_amdgcn_fence(__ATOMIC_ACQUIRE, "agent");
      xb_add(&bar[XB_XGEN(b.x)], 1u);
      asm volatile("s_waitcnt vmcnt(0)" ::: "memory");
    } else {
      XB_SPIN(xb_ld(&bar[XB_XGEN(b.x)]) == gen, bar);
      __builtin_amdgcn_fence(__ATOMIC_ACQUIRE, "agent");
      asm volatile("s_waitcnt vmcnt(0)" ::: "memory");
    }
  }
  __syncthreads();
}
#define CTL_BAR_WORD 4096
#define CTL_ZERO_BYTES 65536
#define LDS_BAR_OFF 66432

#define LDS_TOTAL (2 * HALF_LDS + 128)
__global__ void __launch_bounds__(512, 2) mega(Params p) {
  extern __shared__ __attribute__((aligned(16))) char smem_all[];
  cg::grid_group grid = cg::this_grid();
  char* const smem = smem_all + VHALF * HALF_LDS;
  volatile LAS unsigned* bst = (volatile LAS unsigned*)(LAS char*)(smem_all + WG_LDS_OFF);
  int* const slot = (int*)(smem_all + WG_LDS_OFF + 16);
  if (threadIdx.x < 2) { bst[threadIdx.x] = 0u; ((int*)(smem_all + WG_LDS_OFF + 32))[threadIdx.x] = 0; }
  __syncthreads();
  const XcdBarrier bar = xcd_barrier_post((unsigned*)(p.ws + OFF_CTL) + CTL_BAR_WORD, bst);
  phase_rope(p);
  if (p.ws == nullptr) grid.sync();
  xcd_barrier(bar);
  phase_inproj(p, smem_all);
  xcd_barrier(bar);
  phase_prep_a(p);
  xcd_barrier(bar);
  phase_prep(p, smem);
  xcd_barrier(bar);
  phase_scan(p, smem);
  phase_convert(p, smem);
  xcd_barrier(bar);
  phase_post(p);
  xcd_barrier(bar);
  phase_outproj(p, smem_all);
  xcd_barrier(bar);
  phase_ln1(p);
  xcd_barrier(bar);
  phase_router_gemm(p, smem);
  xcd_barrier(bar);
  phase_topk(p);
  xcd_barrier(bar);
  phase_moe_prefix(p);
  xcd_barrier(bar);
  phase_moe(p, smem_all, slot);
  xcd_barrier(bar);
  phase_final(p, smem);
}

extern "C" void kernel_launch(void* const* d_in, const int* in_sizes, int n_in, void* d_out, int out_size, void* d_ws, size_t ws_size,
                              hipStream_t stream) {
  static int grid_blocks = 0;
  if (grid_blocks == 0) {
    if (ws_size < WS_NEED || n_in != 26) { fprintf(stderr, "kernel_launch: bad ws/n_in: %zu < %zu, n_in %d\n", ws_size, (size_t)WS_NEED, n_in); grid_blocks = -1; return; }
    int dev = 0, cus = 0, per_cu = 0;
    (void)hipGetDevice(&dev);
    (void)hipDeviceGetAttribute(&cus, hipDeviceAttributeMultiprocessorCount, dev);
    (void)hipFuncSetAttribute((const void*)mega, hipFuncAttributeMaxDynamicSharedMemorySize, LDS_TOTAL);
    (void)hipOccupancyMaxActiveBlocksPerMultiprocessor(&per_cu, (const void*)mega, 512, LDS_TOTAL);
    if (per_cu < 1) { fprintf(stderr, "kernel_launch: occupancy query returned %d\n", per_cu); grid_blocks = -1; return; }
    if (per_cu > 1) per_cu = 1;
    grid_blocks = cus * per_cu;
    if (grid_blocks > 256) grid_blocks = 256;
    fprintf(stderr, "kernel_launch: cus %d per_cu %d grid %d\n", cus, per_cu, grid_blocks);
  }
  if (grid_blocks < 0) return;
  if (hipMemsetAsync((char*)d_ws + OFF_CTL, 0, CTL_ZERO_BYTES, stream) != hipSuccess) { fprintf(stderr, "kernel_launch: memset failed\n"); return; }
  Params p{};
  for (int i = 0; i < 26; ++i) p.in[i] = (const float*)d_in[i];
  p.out = (float*)d_out;
  p.ws = (char*)d_ws;
  void* args[] = {&p};
  hipError_t e = hipLaunchCooperativeKernel((const void*)mega, dim3(grid_blocks), dim3(512), args, LDS_TOTAL, stream);
  if (e != hipSuccess) fprintf(stderr, "cooperative launch failed: %s (grid %d)\n", hipGetErrorString(e), grid_blocks);
}
```

```cpp
#include <hip/hip_runtime.h>
#include <hip/hip_bf16.h>
#include <hip/hip_cooperative_groups.h>
#include <stdint.h>
#include <stdio.h>

typedef unsigned short bf16_t;

#define T_TOK 32768
#define SEQ 4096
#define DM 1024
#define INW 3360
#define FEW 1824
#define NEXP 256
#define ALPHA_F 1.189207115002721f
#define LN_EPS_F 1e-5f
#define GN_EPS_F 64e-5f

__device__ __forceinline__ float bf2f(bf16_t v) { return __uint_as_float(((unsigned)v) << 16); }
__device__ __forceinline__ bf16_t f2bf(float f) { unsigned u = __float_as_uint(f); return (bf16_t)((u + 0x7fffu + ((u >> 16) & 1u)) >> 16); }
__device__ __forceinline__ float sigmoidf_(float x) { return 1.f / (1.f + __expf(-x)); }
__device__ __forceinline__ float wave_sum(float v) {
#pragma unroll
  for (int o = 32; o >= 1; o >>= 1) v += __shfl_xor(v, o, 64);
  return v;
}

constexpr size_t SZ_T512_BF = (size_t)T_TOK * 512 * 2;
constexpr size_t OFF_EW1 = 0;
constexpr size_t OFF_EW2 = OFF_EW1 + (size_t)257 * 512 * 1024 * 2;
constexpr size_t LBASE = OFF_EW2 + (size_t)257 * 1024 * 256 * 2;
constexpr size_t OFF_X1F8 = OFF_EW1 + (size_t)257 * 512 * 1024;
static_assert(OFF_X1F8 + (size_t)T_TOK * 1024 <= OFF_EW2, "X1F8 fits behind the fp8 EW1");
constexpr size_t OFF_XB = 0;
constexpr size_t OFF_FEATS = OFF_XB + (size_t)T_TOK * 1024 * 2;
constexpr size_t OFF_WINT = OFF_FEATS + (size_t)T_TOK * FEW * 2;
constexpr size_t OFF_ROPE = OFF_WINT + (size_t)3584 * 1024 * 2;
static_assert(OFF_ROPE + (size_t)4096 * 32 * 2 * 4 <= LBASE, "early region E overlay");
constexpr size_t OFF_Q = LBASE;
constexpr size_t OFF_K = OFF_Q + SZ_T512_BF;
constexpr size_t OFF_V = OFF_K + SZ_T512_BF;
constexpr size_t OFF_R = OFF_V + SZ_T512_BF;
constexpr size_t OFF_K2 = OFF_R + SZ_T512_BF;
constexpr size_t OFF_V2 = OFF_K2 + SZ_T512_BF;
constexpr size_t OFF_A = OFF_V2 + SZ_T512_BF;
constexpr size_t OFF_B = OFF_A + SZ_T512_BF;
constexpr size_t OFF_W = OFF_B + SZ_T512_BF;
constexpr size_t OFF_G = OFF_W + (size_t)T_TOK * 512 * 4;
constexpr size_t OFF_SB = OFF_G + SZ_T512_BF;
constexpr size_t OFF_YS = OFF_SB + (size_t)T_TOK * 8 * 4;
constexpr size_t OFF_OP = OFF_YS + (size_t)T_TOK * 512 * 4;
constexpr size_t OFF_LSE = OFF_OP + 3 * SZ_T512_BF;
constexpr size_t OFF_MIXED = OFF_LSE + (size_t)3 * T_TOK * 8 * 4;
constexpr size_t OFF_WOUTT = OFF_MIXED + (size_t)T_TOK * 1024 * 2;
constexpr size_t EARLY_END = OFF_WOUTT + (size_t)1024 * 1024 * 2;
constexpr size_t OFF_Y = LBASE;
constexpr size_t OFF_AFF = LBASE + (size_t)T_TOK * 1024 * 2;
constexpr size_t OFF_X1B = OFF_Y + (size_t)8 * T_TOK * 1024 * 2;
#define LCAP 16384
constexpr size_t OFF_LIST = OFF_X1B + (size_t)T_TOK * 1024 * 2;
constexpr size_t OFF_GATEW = OFF_LIST + (size_t)NEXP * LCAP * 4;
constexpr size_t OFF_HSCR = OFF_GATEW + (size_t)8 * T_TOK * 4;
constexpr size_t OFF_ACT = OFF_HSCR;
static_assert((size_t)T_TOK * 320 * 2 <= (size_t)512 * 128 * 256 * 2, "ACT fits the HSCR space");
constexpr size_t OFF_CTL = OFF_HSCR + (size_t)512 * 128 * 256 * 2;
constexpr size_t CTL_BYTES = 1u << 20;
constexpr size_t WS_NEED = OFF_CTL + CTL_BYTES;
static_assert(EARLY_END <= OFF_HSCR, "early buffers must stay below the per-block scratch / control words");
static_assert(WS_NEED <= (size_t)1073741824, "workspace must fit 1 GiB");
#define CTL_CONVQ 512
#define CTL_CNT 8192
#define CNT(e) (CTL_CNT + 32 * (e))

typedef short bf16x8 __attribute__((ext_vector_type(8)));
typedef float f32x4 __attribute__((ext_vector_type(4)));
typedef float f32x16 __attribute__((ext_vector_type(16)));
typedef float f32x2_t __attribute__((ext_vector_type(2)));
typedef __bf16 bf16x2_t __attribute__((ext_vector_type(2)));
__device__ __forceinline__ unsigned cvtpk(float lo, float hi) { f32x2_t v = {lo, hi}; bf16x2_t b = __builtin_convertvector(v, bf16x2_t); return __builtin_bit_cast(unsigned, b); }

__device__ __forceinline__ unsigned pk4_fp8c(float a, float b, float c, float d) {
  a = __builtin_amdgcn_fmed3f(a, -440.f, 440.f); b = __builtin_amdgcn_fmed3f(b, -440.f, 440.f);
  c = __builtin_amdgcn_fmed3f(c, -440.f, 440.f); d = __builtin_amdgcn_fmed3f(d, -440.f, 440.f);
  int v = __builtin_amdgcn_cvt_pk_fp8_f32(a, b, 0, false);
  v = __builtin_amdgcn_cvt_pk_fp8_f32(c, d, v, true);
  return (unsigned)v;
}
#define W_SCALE 256.f
#define X_SCALE 16.f
#define H_SCALE 16.f
#define MOE1_UNSCALE (1.f / (X_SCALE * W_SCALE))
#define MOE2_UNSCALE (1.f / (H_SCALE * W_SCALE))
#define Y_SCALE 32.f
__device__ const double INVF[32] = {
1, 0.74989420933245587, 0.56234132519034907, 0.42169650342858223, 0.31622776601683794, 0.23713737056616552,
0.17782794100389229, 0.1333521432163324, 0.10000000000000001, 0.074989420933245579, 0.056234132519034911,
0.042169650342858224, 0.031622776601683791, 0.023713737056616554, 0.017782794100389229, 0.013335214321633241,
0.01, 0.0074989420933245579, 0.005623413251903491, 0.0042169650342858229, 0.0031622776601683794,
0.0023713737056616554, 0.0017782794100389228, 0.0013335214321633241, 0.001, 0.00074989420933245586,
0.0005623413251903491, 0.00042169650342858224, 0.00031622776601683794, 0.00023713737056616554,
0.00017782794100389227, 0.0001333521432163324};

namespace cg = cooperative_groups;

struct Params {
  const float* in[26];
  float* out;
  char* ws;
};

#define NTHR 256
#define VTID ((int)(threadIdx.x & 255))
#define VHALF (__builtin_amdgcn_readfirstlane((int)(threadIdx.x >> 8)))
#define VBID ((int)(blockIdx.x * 2) + VHALF)
#define VGRID ((int)(gridDim.x * 2))
#define HALF_LDS 66560
extern __shared__ __attribute__((aligned(16))) char g_lds[];
#define WG_LDS_OFF (2 * HALF_LDS)
__device__ __forceinline__ void half_sync() {
  asm volatile("s_waitcnt vmcnt(0) lgkmcnt(0)" ::: "memory");
  int* cnt = (int*)(g_lds + WG_LDS_OFF + 32) + VHALF;
  if ((threadIdx.x & 63) == 0) {
    const int old = __hip_atomic_fetch_add(cnt, 1, __ATOMIC_RELAXED, __HIP_MEMORY_SCOPE_WORKGROUP);
    const int target = (old & ~3) + 4;
    while (__hip_atomic_load(cnt, __ATOMIC_RELAXED, __HIP_MEMORY_SCOPE_WORKGROUP) < target) __builtin_amdgcn_s_sleep(1);
  }
  __builtin_amdgcn_fence(__ATOMIC_ACQUIRE, "workgroup");
  asm volatile("s_waitcnt lgkmcnt(0)" ::: "memory");
}
#define HSYNC() half_sync()
__device__ __forceinline__ void half_sync_lds() {
  asm volatile("s_waitcnt lgkmcnt(0)" ::: "memory");
  int* cnt = (int*)(g_lds + WG_LDS_OFF + 32) + VHALF;
  if ((threadIdx.x & 63) == 0) {
    const int old = __hip_atomic_fetch_add(cnt, 1, __ATOMIC_RELAXED, __HIP_MEMORY_SCOPE_WORKGROUP);
    const int target = (old & ~3) + 4;
    while (__hip_atomic_load(cnt, __ATOMIC_RELAXED, __HIP_MEMORY_SCOPE_WORKGROUP) < target) __builtin_amdgcn_s_sleep(1);
  }
  __builtin_amdgcn_fence(__ATOMIC_ACQUIRE, "workgroup");
  asm volatile("s_waitcnt lgkmcnt(0)" ::: "memory");
}
#define HSYNCL() half_sync_lds()

#define LDS_BYTES 66560

__device__ __forceinline__ void phase_rope(const Params& p) {
  float* tab = (float*)(p.ws + OFF_ROPE);
  for (int i = VBID * NTHR + VTID; i < 4096 * 32; i += VGRID * NTHR) {
    int pos = i >> 5, f = i & 31;
    double ang = (double)pos * INVF[f];
    const double TWO_PI = 6.283185307179586476925286766559;
    double n = rint(ang / TWO_PI);
    double r = ang - n * TWO_PI;
    double r2 = r * r;
    double sn = r, cs = 1.0, ts = r, tc = 1.0;
#pragma unroll 1
    for (int k = 1; k <= 16; ++k) {
      tc = -tc * r2 / (double)((2 * k - 1) * (2 * k));
      ts = -ts * r2 / (double)((2 * k) * (2 * k + 1));
      cs += tc; sn += ts;
    }
    tab[i * 2] = (float)cs; tab[i * 2 + 1] = (float)sn;
  }
  {
    const float* __restrict__ w_in = p.in[1]; const float* __restrict__ w_out = p.in[13];
    uint4* wint = (uint4*)(p.ws + OFF_WINT); uint4* woutt = (uint4*)(p.ws + OFF_WOUTT);
    const int NJ1 = 3584 * 128, NJ2 = 1024 * 128;
    for (int i = VBID * NTHR + VTID; i < NJ1 + NJ2; i += VGRID * NTHR) {
      const bool second = i >= NJ1;
      const int q = second ? i - NJ1 : i;
      const int N = second ? 1024 : 3584, NV = second ? 1024 : INW;
      const int s = q % N, ko = q / N;
      const int n = second ? s : ((s & ~63) + (((s & 63) >> 3) << 2) + (s & 3) + (((s >> 2) & 1) << 5));
      const float* __restrict__ src = second ? w_out : w_in;
      float f[8];
#pragma unroll
      for (int u = 0; u < 8; ++u) f[u] = (n < NV) ? src[(size_t)(ko * 8 + u) * NV + n] : 0.f;
      if (second) {
        uint2 w; w.x = pk4_fp8c(W_SCALE * f[0], W_SCALE * f[1], W_SCALE * f[2], W_SCALE * f[3]); w.y = pk4_fp8c(W_SCALE * f[4], W_SCALE * f[5], W_SCALE * f[6], W_SCALE * f[7]);
        ((uint2*)woutt)[(size_t)s * 128 + ko] = w;
      } else { uint4 w; w.x = cvtpk(f[0], f[1]); w.y = cvtpk(f[2], f[3]); w.z = cvtpk(f[4], f[5]); w.w = cvtpk(f[6], f[7]); wint[(size_t)s * 128 + ko] = w; }
    }
  }
  {
    const float4* __restrict__ x4 = (const float4*)p.in[0];
    uint4* xb = (uint4*)(p.ws + OFF_XB);
    for (size_t i = (size_t)VBID * NTHR + VTID; i < (size_t)T_TOK * DM / 8; i += (size_t)VGRID * NTHR) {
      float4 a = x4[2 * i], b = x4[2 * i + 1];
      uint4 w; w.x = cvtpk(a.x, a.y); w.y = cvtpk(a.z, a.w); w.z = cvtpk(b.x, b.y); w.w = cvtpk(b.z, b.w);
      xb[i] = w;
    }
  }
}

template <class AF, class BF>
__device__ __forceinline__ void gemm64_naive(float* As, float* Bs, float* Cs, int K, AF af, BF bf) {
  int tid_l_ = VTID; asm volatile("" : "+v"(tid_l_)); const int tid = tid_l_, tx = tid & 15, ty = tid >> 4;
  float acc[4][4];
#pragma unroll
  for (int i = 0; i < 4; ++i)
#pragma unroll
    for (int j = 0; j < 4; ++j) acc[i][j] = 0.f;
  for (int k0 = 0; k0 < K; k0 += 16) {
#pragma unroll
    for (int u = 0; u < 4; ++u) { int i = tid + u * 256; int r = i >> 4, kk = i & 15; As[kk * 68 + r] = af(r, k0 + kk); }
#pragma unroll
    for (int u = 0; u < 4; ++u) { int i = tid + u * 256; int kk = i >> 6, c = i & 63; Bs[kk * 68 + c] = bf(k0 + kk, c); }
    HSYNC();
#pragma unroll
    for (int kk = 0; kk < 16; ++kk) {
      float a[4], b[4];
#pragma unroll
      for (int i = 0; i < 4; ++i) { a[i] = As[kk * 68 + ty * 4 + i]; b[i] = Bs[kk * 68 + tx * 4 + i]; }
#pragma unroll
      for (int i = 0; i < 4; ++i)
#pragma unroll
        for (int j = 0; j < 4; ++j) acc[i][j] += a[i] * b[j];
    }
    HSYNC();
  }
#pragma unroll
  for (int i = 0; i < 4; ++i)
#pragma unroll
    for (int j = 0; j < 4; ++j) Cs[(ty * 4 + i) * 65 + tx * 4 + j] = acc[i][j];
  HSYNC();
}


__device__ __forceinline__ int lds_off(int row, int chunk) { return row * 128 + ((chunk ^ ((row >> 1) & 7)) << 4); }

template <int BMODE>
__device__ __forceinline__ unsigned cvtpk_m(float a, float b, const bool lo = false) {
  if (BMODE == 0 || (BMODE == 2 && !lo)) return cvtpk(a, b);
  const unsigned h = cvtpk(a, b);
  const float ah = __uint_as_float(h << 16), bh = __uint_as_float(h & 0xffff0000u);
  return cvtpk(a - ah, b - bh);
}
#define G128_MMA(bufoff) { \
    _Pragma("unroll") for (int kk = 0; kk < 2; ++kk) { \
      bf16x8 af[4], bfr[4]; \
      _Pragma("unroll") for (int m = 0; m < 4; ++m) af[m] = *(const bf16x8*)(smem + (bufoff) + lds_off(wr * 64 + m * 16 + fr, kk * 4 + fq)); \
      _Pragma("unroll") for (int n = 0; n < 4; ++n) bfr[n] = *(const bf16x8*)(smem + (bufoff) + 16384 + lds_off(wc * 64 + n * 16 + fr, kk * 4 + fq)); \
      _Pragma("unroll") for (int m = 0; m < 4; ++m) \
        _Pragma("unroll") for (int n = 0; n < 4; ++n) acc[m][n] = __builtin_amdgcn_mfma_f32_16x16x32_bf16(bfr[n], af[m], acc[m][n], 0, 0, 0); \
    } }
template <int BMODE, bool KCLAMP, class ALoad, class BPtr>
__device__ __forceinline__ void gemm128_acc(f32x4 (&acc)[4][4], char* smem, const int nk, ALoad aload, BPtr bptr, const int ldb, const int kvalid) {
  int tid_l_ = VTID; asm volatile("" : "+v"(tid_l_)); const int tid = tid_l_, lane = tid & 63, wid = tid >> 6;
  const int wr = wid >> 1, wc = wid & 1, fr = lane & 15, fq = lane >> 4;
  const int achunk = tid & 7, arow0 = tid >> 3;
  const int nq = tid & 31, ko = tid >> 5;
  const float* bp0 = bptr(nq);
  const int oa0 = lds_off(arow0, achunk), oa1 = lds_off(arow0 + 32, achunk), oa2 = lds_off(arow0 + 64, achunk), oa3 = lds_off(arow0 + 96, achunk);
  const int ob0 = 16384 + lds_off(nq * 4 + 0, ko), ob1 = 16384 + lds_off(nq * 4 + 1, ko), ob2 = 16384 + lds_off(nq * 4 + 2, ko), ob3 = 16384 + lds_off(nq * 4 + 3, ko);
  uint4 ra0, ra1, ra2, ra3; float4 rb0, rb1, rb2, rb3, rb4, rb5, rb6, rb7;
#define G128_LOAD(kt) { \
    ra0 = aload(0, arow0, (kt) * 8 + achunk); ra1 = aload(1, arow0 + 32, (kt) * 8 + achunk); \
    ra2 = aload(2, arow0 + 64, (kt) * 8 + achunk); ra3 = aload(3, arow0 + 96, (kt) * 8 + achunk); \
    int kr_ = (kt) * 64 + ko * 8; \
    if (KCLAMP) kr_ = min(kr_, kvalid - 8);     \
    { \
      const float* b2_ = bp0 + (size_t)((BMODE == 2) ? (kr_ & 1023) : kr_) * ldb; \
      rb0 = *(const float4*)(b2_); rb1 = *(const float4*)(b2_ + (size_t)1 * ldb); rb2 = *(const float4*)(b2_ + (size_t)2 * ldb); \
      rb3 = *(const float4*)(b2_ + (size_t)3 * ldb); rb4 = *(const float4*)(b2_ + (size_t)4 * ldb); rb5 = *(const float4*)(b2_ + (size_t)5 * ldb); \
      rb6 = *(const float4*)(b2_ + (size_t)6 * ldb); rb7 = *(const float4*)(b2_ + (size_t)7 * ldb); \
    } }
#define G128_STORE(bufoff, lo_) { \
    char* const sb_ = smem + (bufoff); \
    *(uint4*)(sb_ + oa0) = ra0; *(uint4*)(sb_ + oa1) = ra1; *(uint4*)(sb_ + oa2) = ra2; *(uint4*)(sb_ + oa3) = ra3; \
    uint4 w; \
    w.x = cvtpk_m<BMODE>(rb0.x, rb1.x, lo_); w.y = cvtpk_m<BMODE>(rb2.x, rb3.x, lo_); w.z = cvtpk_m<BMODE>(rb4.x, rb5.x, lo_); w.w = cvtpk_m<BMODE>(rb6.x, rb7.x, lo_); \
    *(uint4*)(sb_ + ob0) = w; \
    w.x = cvtpk_m<BMODE>(rb0.y, rb1.y, lo_); w.y = cvtpk_m<BMODE>(rb2.y, rb3.y, lo_); w.z = cvtpk_m<BMODE>(rb4.y, rb5.y, lo_); w.w = cvtpk_m<BMODE>(rb6.y, rb7.y, lo_); \
    *(uint4*)(sb_ + ob1) = w; \
    w.x = cvtpk_m<BMODE>(rb0.z, rb1.z, lo_); w.y = cvtpk_m<BMODE>(rb2.z, rb3.z, lo_); w.z = cvtpk_m<BMODE>(rb4.z, rb5.z, lo_); w.w = cvtpk_m<BMODE>(rb6.z, rb7.z, lo_); \
    *(uint4*)(sb_ + ob2) = w; \
    w.x = cvtpk_m<BMODE>(rb0.w, rb1.w, lo_); w.y = cvtpk_m<BMODE>(rb2.w, rb3.w, lo_); w.z = cvtpk_m<BMODE>(rb4.w, rb5.w, lo_); w.w = cvtpk_m<BMODE>(rb6.w, rb7.w, lo_); \
    *(uint4*)(sb_ + ob3) = w; }
  G128_LOAD(0)
  G128_STORE(0, false)
  if (nk > 1) G128_LOAD(1)
  HSYNC();
  for (int kt = 0; kt < nk; ++kt) {
    const int cur = (kt & 1) * 32768;
    __builtin_amdgcn_sched_barrier(0);
    G128_MMA(cur)
    __builtin_amdgcn_sched_barrier(0);
    if (kt + 1 < nk) {
      G128_STORE(cur ^ 32768, (kt + 1) >= kvalid)
      __builtin_amdgcn_sched_barrier(0);
      if (kt + 2 < nk) G128_LOAD(kt + 2)
    }
    __builtin_amdgcn_sched_barrier(0);
    HSYNC();
  }
#undef G128_LOAD
#undef G128_STORE
}
__device__ __forceinline__ void acc_zero(f32x4 (&acc)[4][4]) {
#pragma unroll
  for (int m = 0; m < 4; ++m)
#pragma unroll
    for (int n = 0; n < 4; ++n) acc[m][n] = (f32x4){0.f, 0.f, 0.f, 0.f};
}
template <class ARow, class BPtr, class Epi>
__device__ __forceinline__ void gemm128(char* smem, const int K, ARow arow, BPtr bptr, const int ldb, Epi epi) {
  int tid_l_ = VTID; asm volatile("" : "+v"(tid_l_)); const int tid = tid_l_, lane = tid & 63, wid = tid >> 6;
  const int arow0 = tid >> 3;
  const bf16_t* ap0 = arow(arow0);
  const bf16_t* ap1 = arow(arow0 + 32);
  const bf16_t* ap2 = arow(arow0 + 64);
  const bf16_t* ap3 = arow(arow0 + 96);
  f32x4 acc[4][4];
  acc_zero(acc);
  gemm128_acc<0, false>(acc, smem, K >> 6,
      [=](int u, int, int kc) { const bf16_t* q = (u == 0) ? ap0 : (u == 1) ? ap1 : (u == 2) ? ap2 : ap3; return *(const uint4*)(q + kc * 8); },
      bptr, ldb, 0);
  epi(acc, wid >> 1, wid & 1, lane & 15, lane >> 4);
}


template <class ALoad, class BLoad>
__device__ __forceinline__ void gemm128_acc_bb(f32x4 (&acc)[4][4], char* smem, const int nk, ALoad aload, BLoad bload) {
  int tid_l_ = VTID; asm volatile("" : "+v"(tid_l_)); const int tid = tid_l_, lane = tid & 63, wid = tid >> 6;
  const int wr = wid >> 1, wc = wid & 1, fr = lane & 15, fq = lane >> 4;
  const int achunk = tid & 7, arow0 = tid >> 3;
  const int oa0 = lds_off(arow0, achunk), oa1 = lds_off(arow0 + 32, achunk), oa2 = lds_off(arow0 + 64, achunk), oa3 = lds_off(arow0 + 96, achunk);
  uint4 ra0, ra1, ra2, ra3, rb0, rb1, rb2, rb3;
#define G128_LOADBB(kt) { \
    ra0 = aload(0, arow0, (kt) * 8 + achunk); ra1 = aload(1, arow0 + 32, (kt) * 8 + achunk); \
    ra2 = aload(2, arow0 + 64, (kt) * 8 + achunk); ra3 = aload(3, arow0 + 96, (kt) * 8 + achunk); \
    rb0 = bload(0, arow0, (kt) * 8 + achunk); rb1 = bload(1, arow0 + 32, (kt) * 8 + achunk); \
    rb2 = bload(2, arow0 + 64, (kt) * 8 + achunk); rb3 = bload(3, arow0 + 96, (kt) * 8 + achunk); }
#define G128_STOREBB(bufoff) { \
    char* const sb_ = smem + (bufoff); \
    *(uint4*)(sb_ + oa0) = ra0; *(uint4*)(sb_ + oa1) = ra1; *(uint4*)(sb_ + oa2) = ra2; *(uint4*)(sb_ + oa3) = ra3; \
    *(uint4*)(sb_ + 16384 + oa0) = rb0; *(uint4*)(sb_ + 16384 + oa1) = rb1; *(uint4*)(sb_ + 16384 + oa2) = rb2; *(uint4*)(sb_ + 16384 + oa3) = rb3; }
  G128_LOADBB(0)
  G128_STOREBB(0)
  if (nk > 1) G128_LOADBB(1)
  HSYNC();
  for (int kt = 0; kt < nk; ++kt) {
    const int cur = (kt & 1) * 32768;
    __builtin_amdgcn_sched_barrier(0);
    G128_MMA(cur)
    __builtin_amdgcn_sched_barrier(0);
    if (kt + 1 < nk) {
      G128_STOREBB(cur ^ 32768)
      __builtin_amdgcn_sched_barrier(0);
      if (kt + 2 < nk) G128_LOADBB(kt + 2)
    }
    __builtin_amdgcn_sched_barrier(0);
    HSYNC();
  }
#undef G128_LOADBB
#undef G128_STOREBB
}
template <class ARow, class BRow, class Epi>
__device__ __forceinline__ void gemm128_bb(char* smem, const int K, ARow arow, BRow brow, Epi epi) {
  int tid_l_ = VTID; asm volatile("" : "+v"(tid_l_)); const int tid = tid_l_, lane = tid & 63, wid = tid >> 6;
  const int arow0 = tid >> 3;
  const bf16_t* ap0 = arow(arow0); const bf16_t* ap1 = arow(arow0 + 32); const bf16_t* ap2 = arow(arow0 + 64); const bf16_t* ap3 = arow(arow0 + 96);
  const bf16_t* bp0 = brow(arow0); const bf16_t* bp1 = brow(arow0 + 32); const bf16_t* bp2 = brow(arow0 + 64); const bf16_t* bp3 = brow(arow0 + 96);
  f32x4 acc[4][4];
  acc_zero(acc);
  gemm128_acc_bb(acc, smem, K >> 6,
      [=](int u, int, int kc) { const bf16_t* q = (u == 0) ? ap0 : (u == 1) ? ap1 : (u == 2) ? ap2 : ap3; return *(const uint4*)(q + kc * 8); },
      [=](int u, int, int kc) { const bf16_t* q = (u == 0) ? bp0 : (u == 1) ? bp1 : (u == 2) ? bp2 : bp3; return *(const uint4*)(q + kc * 8); });
  epi(acc, wid >> 1, wid & 1, lane & 15, lane >> 4);
}


#define GAS1 __attribute__((address_space(1)))
#define LAS3 __attribute__((address_space(3)))
__device__ __forceinline__ void glds16(const void* g, char* l) {
  __builtin_amdgcn_global_load_lds((const GAS1 void*)g, (LAS3 void*)l, 16, 0, 0);
}
template <class ARow, class BRow, class Epi>
__device__ __forceinline__ void gemm128_glds(char* smem, const int K, ARow arow, BRow brow, Epi epi) {
  int tid_l_ = VTID; asm volatile("" : "+v"(tid_l_)); const int tid = tid_l_, lane = tid & 63, wid = tid >> 6;
  const int wr = wid >> 1, wc = wid & 1, fr = lane & 15, fq = lane >> 4;
  const int r0 = tid >> 3;
  const int cl = (tid & 7) ^ ((tid >> 4) & 7);
  const bf16_t* ga0 = arow(r0) + cl * 8; const bf16_t* ga1 = arow(r0 + 32) + cl * 8; const bf16_t* ga2 = arow(r0 + 64) + cl * 8; const bf16_t* ga3 = arow(r0 + 96) + cl * 8;
  const bf16_t* gb0 = brow(r0) + cl * 8; const bf16_t* gb1 = brow(r0 + 32) + cl * 8; const bf16_t* gb2 = brow(r0 + 64) + cl * 8; const bf16_t* gb3 = brow(r0 + 96) + cl * 8;
  char* const lbase = smem + tid * 16;
#define GL_STAGE(bufoff, kt) { \
    char* const d_ = lbase + (bufoff); const int ko_ = (kt) * 64; \
    glds16(ga0 + ko_, d_); glds16(ga1 + ko_, d_ + 4096); glds16(ga2 + ko_, d_ + 8192); glds16(ga3 + ko_, d_ + 12288); \
    glds16(gb0 + ko_, d_ + 16384); glds16(gb1 + ko_, d_ + 20480); glds16(gb2 + ko_, d_ + 24576); glds16(gb3 + ko_, d_ + 28672); }
  f32x4 acc[4][4];
  acc_zero(acc);
  const int nk = K >> 6;
  GL_STAGE(0, 0)
  asm volatile("s_waitcnt vmcnt(0)" ::: "memory");
  HSYNC();
  for (int kt = 0; kt < nk; ++kt) {
    const int cur = (kt & 1) * 32768;
    if (kt + 1 < nk) GL_STAGE(cur ^ 32768, kt + 1)
    G128_MMA(cur)
    asm volatile("s_waitcnt vmcnt(0)" ::: "memory");
    HSYNC();
  }
#undef GL_STAGE
  epi(acc, wr, wc, fr, fq);
}


template <int NCALL, int NK, class ARow, class BRow, class Epi>
__device__ __forceinline__ void gemm128_glds_multi(char* smem, ARow arow, BRow brow, const size_t bstride, Epi epi) {
  int tid_l_ = VTID; asm volatile("" : "+v"(tid_l_)); const int tid = tid_l_, lane = tid & 63, wid = tid >> 6;
  const int wr = wid >> 1, wc = wid & 1, fr = lane & 15, fq = lane >> 4;
  const int r0 = tid >> 3;
  const int cl = (tid & 7) ^ ((tid >> 4) & 7);
  const bf16_t* ga0 = arow(r0) + cl * 8; const bf16_t* ga1 = arow(r0 + 32) + cl * 8; const bf16_t* ga2 = arow(r0 + 64) + cl * 8; const bf16_t* ga3 = arow(r0 + 96) + cl * 8;
  const bf16_t* gb0 = brow(r0) + cl * 8; const bf16_t* gb1 = brow(r0 + 32) + cl * 8; const bf16_t* gb2 = brow(r0 + 64) + cl * 8; const bf16_t* gb3 = brow(r0 + 96) + cl * 8;
  char* const lbase = smem + tid * 16;
#define GM_STAGE(bufoff, g) { \
    char* const d_ = lbase + (bufoff); const int ko_ = ((g) % NK) * 64; const size_t bo_ = (size_t)((g) / NK) * bstride + ko_; \
    glds16(ga0 + ko_, d_); glds16(ga1 + ko_, d_ + 4096); glds16(ga2 + ko_, d_ + 8192); glds16(ga3 + ko_, d_ + 12288); \
    glds16(gb0 + bo_, d_ + 16384); glds16(gb1 + bo_, d_ + 20480); glds16(gb2 + bo_, d_ + 24576); glds16(gb3 + bo_, d_ + 28672); }
  f32x4 acc[4][4];
  acc_zero(acc);
  constexpr int G = NCALL * NK;
  GM_STAGE(0, 0)
  asm volatile("s_waitcnt vmcnt(0)" ::: "memory");
  HSYNC();
#pragma unroll 1
  for (int g = 0; g < G; ++g) {
    const int cur = (g & 1) * 32768;
    if (g + 1 < G) GM_STAGE(cur ^ 32768, g + 1)
    G128_MMA(cur)
    if ((g % NK) == NK - 1) {
      epi(g / NK, acc, wr, wc, fr, fq);
      acc_zero(acc);
    }
    asm volatile("s_waitcnt vmcnt(0)" ::: "memory");
    HSYNC();
  }
#undef GM_STAGE
}


namespace pg8 {
#define PG8_LAS __attribute__((address_space(3)))
typedef unsigned short bf16_t;
typedef short bf16x8 __attribute__((ext_vector_type(8)));
typedef float f32x4 __attribute__((ext_vector_type(4)));
typedef unsigned u32x4 __attribute__((ext_vector_type(4)));
typedef int i32x4 __attribute__((ext_vector_type(4)));
typedef int i32x8 __attribute__((ext_vector_type(8)));
constexpr int BM = 256, BK = 64, HALF = 128, HTB = HALF * BK * 2  , STAGE_BYTES = 8 * HTB, NXCD = 8, WGM = 8;

__host__ __device__ __forceinline__ int lds_byte(int r, int c) { const int st = (r >> 4) * 2 + (c >> 5), rr = r & 15, cc = c & 31, ob = rr * 64 + cc * 2; return st * 1024 + (ob ^ (((ob >> 9) & 1) << 5)); }
__host__ __device__ __forceinline__ void stage_rc(int b, int& R, int& C) { const int st = b / 1024, sb = b % 1024, swz = sb ^ (((sb >> 9) & 1) << 5); R = (st >> 1) * 16 + swz / 64; C = (st & 1) * 32 + (swz % 64) / 2; }
__host__ __device__ __forceinline__ int perm32(int rho) { const int n = rho >> 4, i = rho & 15; return 8 * (i >> 2) + 4 * n + (i & 3); }

struct Unit { int pm, pn; };
struct Gemm { const bf16_t* A; const bf16_t* Bt; int M, N, K; };

struct StaticOrder {
    int nM, nN, nwg, G, c;
    __host__ __device__ void init(int M, int N, int G_, int c_) { nM = M / BM; nN = N / BM; nwg = nM * nN; G = G_; c = c_; }
    __host__ __device__ bool next(int i, Unit& u) const {
        const long L = (long)i * G + c; if (L >= nwg) return false;
        int wgid = (int)L; { const int q = nwg / NXCD, r = nwg % NXCD, xcd = wgid % NXCD, off = wgid / NXCD; wgid = (xcd < r ? xcd * (q + 1) : r * (q + 1) + (xcd - r) * q) + off; }
        const int nig = WGM * nN, gid = wgid / nig, fm = gid * WGM, gsz = (nM - fm) < WGM ? (nM - fm) : WGM;
        u.pm = fm + ((wgid % nig) % gsz); u.pn = (wgid % nig) / gsz; return true;
    }
    __device__ __forceinline__ void a_ready(const Unit&) const {}
    __device__ __forceinline__ void done(const Unit&) const {}
};
template <class Epi, class Sched, bool ALIGN_EPI = false, bool SP2 = false, bool GATHER = false, bool FP8 = false>
__device__ __forceinline__ void gemm_phase(PG8_LAS unsigned char* lds, const Gemm g, const Sched& S, const Epi& E, const int* rowidx = nullptr) {
    int tid_ = threadIdx.x; asm volatile("" : "+v"(tid_));
    const int tid = tid_, wid = __builtin_amdgcn_readfirstlane(tid >> 6), lane = tid & 63, wr = wid >> 2, wc = wid & 3, fr = lane & 15, fq = lane >> 4;
    const int K = g.K, nt = K / BK;
    unsigned voffA[2], voffA1[2], voffB[2];
#pragma unroll
    for (int i = 0; i < 2; ++i) { int R, C; stage_rc(tid * 16 + i * 8192, R, C); const int Rb = Epi::PERM ? ((R & ~31) + perm32(R & 31)) : R;
        if (GATHER) { voffA[i] = ((unsigned)rowidx[R] * (unsigned)K + (unsigned)C) * 2u; voffA1[i] = ((unsigned)rowidx[128 + R] * (unsigned)K + (unsigned)C) * 2u; }
        else { voffA[i] = (unsigned)(R * K + C) * 2u; voffA1[i] = voffA[i]; }
        voffB[i] = (unsigned)(Rb * K + C) * 2u; }
    const size_t hstepA = GATHER ? (size_t)0 : (size_t)HALF * K * 2;
    const size_t kstep = (size_t)(BK * 2);
    const size_t hstep = (size_t)HALF * K * 2;
    const size_t tstep = 2 * hstep;
    const unsigned ldsw = (unsigned)wid * 1024u;
    const int aoff = lds_byte(wr * 64 + fr, fq * 8), boff = lds_byte(wc * 32 + fr, fq * 8);
#define PG8_SA(b, h) (((b) * 2 + (h)) * HTB)
#define PG8_SB(b, h) ((4 + (b) * 2 + (h)) * HTB)
#define PG8_STAGE(bufoff, gbase, voff) do { _Pragma("unroll") for (int _i = 0; _i < 2; ++_i) \
        __builtin_amdgcn_global_load_lds((const unsigned*)((const char*)(gbase) + (voff)[_i]), (PG8_LAS unsigned*)(lds + (bufoff) + ldsw + _i * 8192), 16, 0, 0); } while (0)
#define PG8_LDA(dst, b, h) do { _Pragma("unroll") for (int m = 0; m < 4; ++m) _Pragma("unroll") for (int k = 0; k < 2; ++k) dst[m][k] = *(const PG8_LAS bf16x8*)(lds + PG8_SA(b, h) + aoff + m * 2048 + k * 1024); } while (0)
#define PG8_LDB(dst, b, h) do { _Pragma("unroll") for (int n = 0; n < 2; ++n) _Pragma("unroll") for (int k = 0; k < 2; ++k) dst[n][k] = *(const PG8_LAS bf16x8*)(lds + PG8_SB(b, h) + boff + n * 2048 + k * 1024); } while (0)
#define PG8_MMA(ai, bj, At, Bt) do { __builtin_amdgcn_s_setprio(1); _Pragma("unroll") for (int m = 0; m < 4; ++m) _Pragma("unroll") for (int n = 0; n < 2; ++n) _Pragma("unroll") for (int k = 0; k < 2; ++k) \
        acc[ai][bj][m][n] = __builtin_amdgcn_mfma_f32_16x16x32_bf16(Bt[n][k], At[m][k], acc[ai][bj][m][n], 0, 0, 0); __builtin_amdgcn_s_setprio(0); } while (0)
#define PG8_LD8(off) __builtin_shufflevector(*(const PG8_LAS i32x4*)(lds + (off)), *(const PG8_LAS i32x4*)(lds + (off) + 1024), 0, 1, 2, 3, 4, 5, 6, 7)
#define PG8_LDA_F(dst, b, h) do { if constexpr (FP8) { A8[0] = PG8_LD8(PG8_SA(b, h) + aoff); A8[1] = PG8_LD8(PG8_SA(b, h) + aoff + 2048); } else PG8_LDA(dst, b, h); } while (0)
#define PG8_LDB_F(dst, b, h) do { if constexpr (FP8) { dst##8[0] = PG8_LD8(PG8_SB(b, h) + boff); dst##8[1] = PG8_LD8(PG8_SB(b, h) + boff + 2048); } else PG8_LDB(dst, b, h); } while (0)
#define PG8_MFMA8(ai, bj, m, n, Bt) asm volatile("v_mfma_scale_f32_16x16x128_f8f6f4 %0, %1, %2, %0, %3, %3 op_sel_hi:[0,0,0]" : "+v"(acc[ai][bj][m][n]) : "v"(Bt##8[n]), "v"(A8[(m) & 1]), "v"(one8))
#define PG8_MMA_PAIR(ai, b, h) do { if constexpr (FP8) { __builtin_amdgcn_s_setprio(1); \
        PG8_MFMA8(ai, 0, 0, 0, B0); PG8_MFMA8(ai, 0, 0, 1, B0); PG8_MFMA8(ai, 1, 0, 0, B1); PG8_MFMA8(ai, 1, 0, 1, B1); \
        PG8_MFMA8(ai, 0, 1, 0, B0); PG8_MFMA8(ai, 0, 1, 1, B0); PG8_MFMA8(ai, 1, 1, 0, B1); PG8_MFMA8(ai, 1, 1, 1, B1); \
        PG8_SCHED; A8[0] = PG8_LD8(PG8_SA(b, h) + aoff + 4096); A8[1] = PG8_LD8(PG8_SA(b, h) + aoff + 6144); PG8_WAIT_L(0); PG8_SCHED; \
        PG8_MFMA8(ai, 0, 2, 0, B0); PG8_MFMA8(ai, 0, 2, 1, B0); PG8_MFMA8(ai, 1, 2, 0, B1); PG8_MFMA8(ai, 1, 2, 1, B1); \
        PG8_MFMA8(ai, 0, 3, 0, B0); PG8_MFMA8(ai, 0, 3, 1, B0); PG8_MFMA8(ai, 1, 3, 0, B1); PG8_MFMA8(ai, 1, 3, 1, B1); \
        __builtin_amdgcn_s_setprio(0); } else { PG8_MMA(ai, 0, At, B0); PG8_MMA(ai, 1, At, B1); } } while (0)
#define PG8_WAIT_V(n) asm volatile("s_waitcnt vmcnt(" #n ")" ::: "memory")
#define PG8_WAIT_L(n) asm volatile("s_waitcnt lgkmcnt(" #n ")" ::: "memory")
#define PG8_BAR __builtin_amdgcn_s_barrier()
#define PG8_SCHED __builtin_amdgcn_sched_barrier(0)
    Unit cur, nxt; int ui = 0;
    if (!S.next(0, cur)) return;
    f32x4 acc[2][2][4][2];
#pragma unroll
    for (int a = 0; a < 2; ++a)
#pragma unroll
        for (int b = 0; b < 2; ++b)
#pragma unroll
            for (int m = 0; m < 4; ++m)
#pragma unroll
                for (int n = 0; n < 2; ++n) acc[a][b][m][n] = (f32x4){0.f, 0.f, 0.f, 0.f};
    bf16x8 At[4][2], B0[2][2], B1[2][2];
    i32x8 A8[2], B08[2], B18[2];
    int one8 = 0x7F7F7F7F; asm volatile("" : "+v"(one8));
    static_assert(!FP8 || SP2, "the fp8 path exists in the SP2 schedule only");
    const char* cA = (const char*)g.A + (size_t)cur.pm * tstep; const char* cB = (const char*)g.Bt + (size_t)cur.pn * tstep;
    S.a_ready(cur);
    if constexpr (SP2) {
        PG8_STAGE(PG8_SB(0, 0), cB, voffB); PG8_STAGE(PG8_SB(0, 1), cB + hstep, voffB); PG8_STAGE(PG8_SA(0, 0), cA, voffA); PG8_STAGE(PG8_SA(0, 1), cA + hstepA, voffA1);
        if (wr == 1) PG8_BAR;
        PG8_WAIT_V(2); PG8_BAR;
        PG8_STAGE(PG8_SB(1, 0), cB + kstep, voffB); PG8_STAGE(PG8_SA(1, 0), cA + kstep, voffA); PG8_STAGE(PG8_SB(1, 1), cB + hstep + kstep, voffB);
        PG8_WAIT_V(6); PG8_BAR;
    } else {
        PG8_STAGE(PG8_SB(0, 0), cB, voffB); PG8_STAGE(PG8_SA(0, 0), cA, voffA); PG8_STAGE(PG8_SB(0, 1), cB + hstep, voffB); PG8_STAGE(PG8_SA(0, 1), cA + hstepA, voffA1);
        if (wr == 1) PG8_BAR;
        PG8_WAIT_V(4); PG8_BAR;
        PG8_STAGE(PG8_SB(1, 0), cB + kstep, voffB); PG8_STAGE(PG8_SA(1, 0), cA + kstep, voffA); PG8_STAGE(PG8_SB(1, 1), cB + hstep + kstep, voffB);
        PG8_WAIT_V(6); PG8_BAR;
    }
    for (;;) {
        const bool has_next = S.next(ui + 1, nxt);
        const char* nA = has_next ? (const char*)g.A + (size_t)nxt.pm * tstep : cA; const char* nB = has_next ? (const char*)g.Bt + (size_t)nxt.pn * tstep : cB;
        for (int t = 0; t < nt; t += 2) {
            const bool last = (t == nt - 2);
            const char* a1 = cA + (size_t)(t + 1) * kstep;
            const char* a2 = last ? nA : cA + (size_t)(t + 2) * kstep; const char* b2 = last ? nB : cB + (size_t)(t + 2) * kstep;
            const char* a3 = a2 + kstep; const char* b3 = b2 + kstep;
            if (last && has_next) S.a_ready(nxt);
            if constexpr (SP2) {
            PG8_LDB_F(B0, 0, 0); PG8_LDB_F(B1, 0, 1); PG8_SCHED; PG8_LDA_F(At, 0, 0); PG8_STAGE(PG8_SA(1, 1), a1 + hstepA, voffA1);
            PG8_WAIT_V(8); PG8_WAIT_L(0); PG8_BAR; PG8_MMA_PAIR(0, 0, 0); PG8_BAR; PG8_SCHED;
            PG8_LDA_F(At, 0, 1); PG8_STAGE(PG8_SB(0, 0), b2, voffB); PG8_STAGE(PG8_SB(0, 1), b2 + hstep, voffB); PG8_STAGE(PG8_SA(0, 0), a2, voffA);
            PG8_WAIT_V(8); PG8_WAIT_L(0); PG8_BAR; PG8_MMA_PAIR(1, 0, 1); PG8_BAR; PG8_SCHED;
            PG8_LDB_F(B0, 1, 0); PG8_LDB_F(B1, 1, 1); PG8_SCHED; PG8_LDA_F(At, 1, 0); PG8_STAGE(PG8_SA(0, 1), a2 + hstepA, voffA1);
            PG8_WAIT_V(8); PG8_WAIT_L(0); PG8_BAR; PG8_MMA_PAIR(0, 1, 0); PG8_BAR; PG8_SCHED;
            PG8_LDA_F(At, 1, 1); PG8_STAGE(PG8_SB(1, 0), b3, voffB); PG8_STAGE(PG8_SB(1, 1), b3 + hstep, voffB); PG8_STAGE(PG8_SA(1, 0), a3, voffA);
            PG8_WAIT_V(8); PG8_WAIT_L(0); PG8_BAR; PG8_MMA_PAIR(1, 1, 1); PG8_BAR; PG8_SCHED;
            } else {
            PG8_LDB(B0, 0, 0); PG8_SCHED; PG8_LDA(At, 0, 0); PG8_STAGE(PG8_SA(1, 1), a1 + hstepA, voffA1);
            PG8_WAIT_L(8); PG8_BAR; PG8_WAIT_L(0); PG8_MMA(0, 0, At, B0); PG8_BAR; PG8_SCHED;
            PG8_LDB(B1, 0, 1); PG8_STAGE(PG8_SB(0, 0), b2, voffB);
            PG8_BAR; PG8_WAIT_L(0); PG8_MMA(0, 1, At, B1); PG8_BAR;
            PG8_LDA(At, 0, 1); PG8_STAGE(PG8_SA(0, 0), a2, voffA);
            PG8_BAR; PG8_WAIT_L(0); PG8_MMA(1, 0, At, B0); PG8_BAR; PG8_SCHED;
            PG8_STAGE(PG8_SB(0, 1), b2 + hstep, voffB);
            PG8_WAIT_V(6); PG8_BAR; PG8_MMA(1, 1, At, B1); PG8_BAR;
            PG8_LDB(B0, 1, 0); PG8_SCHED; PG8_LDA(At, 1, 0); PG8_STAGE(PG8_SA(0, 1), a2 + hstepA, voffA1);
            PG8_WAIT_L(8); PG8_BAR; PG8_WAIT_L(0); PG8_MMA(0, 0, At, B0); PG8_BAR; PG8_SCHED;
            PG8_LDB(B1, 1, 1); PG8_STAGE(PG8_SB(1, 0), b3, voffB);
            PG8_BAR; PG8_WAIT_L(0); PG8_MMA(0, 1, At, B1); PG8_BAR;
            PG8_LDA(At, 1, 1); PG8_STAGE(PG8_SA(1, 0), a3, voffA);
            PG8_BAR; PG8_WAIT_L(0); PG8_MMA(1, 0, At, B0); PG8_BAR; PG8_SCHED;
            PG8_STAGE(PG8_SB(1, 1), b3 + hstep, voffB);
            PG8_WAIT_V(6); PG8_BAR; PG8_MMA(1, 1, At, B1); PG8_BAR;
            }
        }
        if constexpr (ALIGN_EPI) { if (wr == 0) PG8_BAR; }
        if constexpr (FP8) asm volatile("s_nop 15\n\ts_nop 15" ::: "memory");
        if constexpr (!Epi::AFTER_DRAIN) { E(acc, cur, wr, wc, fr, fq); S.done(cur); }
        if (!has_next) break;
#pragma unroll
        for (int a = 0; a < 2; ++a)
#pragma unroll
            for (int b = 0; b < 2; ++b)
#pragma unroll
                for (int m = 0; m < 4; ++m)
#pragma unroll
                    for (int n = 0; n < 2; ++n) acc[a][b][m][n] = (f32x4){0.f, 0.f, 0.f, 0.f};
        cur = nxt; cA = nA; cB = nB; ++ui;
        if constexpr (ALIGN_EPI) { if (wr == 1) PG8_BAR; }
    }
    PG8_WAIT_V(0);
    if constexpr (!ALIGN_EPI) { if (wr == 0) PG8_BAR; }
    PG8_BAR;
    if constexpr (Epi::AFTER_DRAIN) { E.fused(acc, cur, wr, wc, fr, fq, lds, wid, lane); S.done(cur); }
#undef PG8_SA
#undef PG8_SB
#undef PG8_STAGE
#undef PG8_LDA
#undef PG8_LD8
#undef PG8_LDA_F
#undef PG8_LDB_F
#undef PG8_MFMA8
#undef PG8_MMA_PAIR
#undef PG8_LDB
#undef PG8_MMA
#undef PG8_WAIT_V
#undef PG8_WAIT_L
#undef PG8_BAR
#undef PG8_SCHED
}
}
#define DPP_F(v, ctrl) __builtin_bit_cast(float, __builtin_amdgcn_update_dpp(0, __builtin_bit_cast(int, (v)), (ctrl), 0xF, 0xF, true))
__device__ __forceinline__ float rdlane_f(float v, int l) { return __builtin_bit_cast(float, __builtin_amdgcn_readlane(__builtin_bit_cast(int, v), l)); }
__device__ __forceinline__ float dpp_sum16x(float v) {
  v += DPP_F(v, 0xB1); v += DPP_F(v, 0x4E); v += DPP_F(v, 0x141); v += DPP_F(v, 0x140);
  return v;
}
__device__ __forceinline__ float dpp_max16x(float v) {
  v = fmaxf(v, DPP_F(v, 0xB1)); v = fmaxf(v, DPP_F(v, 0x4E)); v = fmaxf(v, DPP_F(v, 0x141)); v = fmaxf(v, DPP_F(v, 0x140));
  return v;
}
__device__ __forceinline__ float wave_sum_fast(float v) {
  v = dpp_sum16x(v);
  return (rdlane_f(v, 0) + rdlane_f(v, 16)) + (rdlane_f(v, 32) + rdlane_f(v, 48));
}
__device__ __forceinline__ float wave_max_fast(float v) {
  v = dpp_max16x(v);
  return fmaxf(fmaxf(rdlane_f(v, 0), rdlane_f(v, 16)), fmaxf(rdlane_f(v, 32), rdlane_f(v, 48)));
}
__device__ __forceinline__ float fast_tanh(float x) { const float e = __expf(2.f * x); return 1.f - 2.f / (e + 1.f); }


__device__ __forceinline__ float4 bf4_to_f4(uint2 u) {
  float4 r;
  r.x = __uint_as_float(u.x << 16); r.y = __uint_as_float(u.x & 0xffff0000u);
  r.z = __uint_as_float(u.y << 16); r.w = __uint_as_float(u.y & 0xffff0000u);
  return r;
}
__device__ __forceinline__ uint2 pack4(float a, float b, float c, float d) { uint2 r; r.x = cvtpk(a, b); r.y = cvtpk(c, d); return r; }
#define XCD_GROUP (VBID & 7)
#define XCD_LB (VBID >> 3)
#define XCD_NB ((VGRID + 7 - (VBID & 7)) >> 3)

struct EpiInproj {
  static constexpr bool PERM = true, AFTER_DRAIN = false;
  const float* rope; bf16_t* Q; bf16_t* K; bf16_t* V; bf16_t* FE;
  __device__ __forceinline__ void operator()(const pg8::f32x4 (&acc)[2][2][4][2], const pg8::Unit& u, int wr, int wc, int fr, int fq) const {
#pragma unroll
    for (int bj = 0; bj < 2; ++bj) {
      const int s0 = u.pn * 256 + bj * 128 + wc * 32 + 8 * fq;
      const int hb = s0 & ~63, f0 = ((s0 & 63) >> 3) << 2;
      if (hb + f0 >= INW) continue;
#pragma unroll
      for (int ai = 0; ai < 2; ++ai)
#pragma unroll
        for (int m = 0; m < 4; ++m) {
          const int t = u.pm * 256 + ai * 128 + wr * 64 + m * 16 + fr;
          const pg8::f32x4 v0 = acc[ai][bj][m][0], v1 = acc[ai][bj][m][1];
          if (hb < 1024) {
            const int pos = t & (SEQ - 1);
            const float4 c01 = *(const float4*)(rope + (size_t)(pos * 32 + f0) * 2);
            const float4 c23 = *(const float4*)(rope + (size_t)(pos * 32 + f0) * 2 + 4);
            const float cs[4] = {c01.x, c01.z, c23.x, c23.z}, sn[4] = {c01.y, c01.w, c23.y, c23.w};
            const float sc = (hb < 512) ? 0.125f : 1.f;
            float o1[4], o2[4];
#pragma unroll
            for (int j = 0; j < 4; ++j) { o1[j] = (v0[j] * cs[j] - v1[j] * sn[j]) * sc; o2[j] = (v1[j] * cs[j] + v0[j] * sn[j]) * sc; }
            bf16_t* dst = (hb < 512) ? (Q + (size_t)t * 512 + hb + f0) : (K + (size_t)t * 512 + (hb - 512) + f0);
            *(uint2*)dst = pack4(o1[0], o1[1], o1[2], o1[3]);
            *(uint2*)(dst + 32) = pack4(o2[0], o2[1], o2[2], o2[3]);
          } else if (hb < 1536) {
            bf16_t* dst = V + (size_t)t * 512 + (hb - 1024) + f0;
            *(uint2*)dst = pack4(v0[0], v0[1], v0[2], v0[3]);
            *(uint2*)(dst + 32) = pack4(v1[0], v1[1], v1[2], v1[3]);
          } else {
            bf16_t* dst = FE + (size_t)t * FEW + (hb - 1536) + f0;
            *(uint2*)dst = pack4(v0[0], v0[1], v0[2], v0[3]);
            if (hb + f0 + 32 < INW) *(uint2*)(dst + 32) = pack4(v1[0], v1[1], v1[2], v1[3]);
          }
        }
    }
  }
};
__device__ __forceinline__ void phase_inproj(const Params& p, char* smem_all) {
  pg8::Gemm g{(const pg8::bf16_t*)(p.ws + OFF_XB), (const pg8::bf16_t*)(p.ws + OFF_WINT), T_TOK, 3584, DM};
  pg8::StaticOrder S; S.init(T_TOK, 3584, (int)gridDim.x, (int)blockIdx.x);
  EpiInproj E{(const float*)(p.ws + OFF_ROPE), (bf16_t*)(p.ws + OFF_Q), (bf16_t*)(p.ws + OFF_K), (bf16_t*)(p.ws + OFF_V), (bf16_t*)(p.ws + OFF_FEATS)};
  pg8::gemm_phase<EpiInproj, pg8::StaticOrder, true, true>((PG8_LAS unsigned char*)smem_all, g, S, E);
}

__device__ __forceinline__ void phase_prep_a(const Params& p) {
  const bf16_t* __restrict__ FE = (const bf16_t*)(p.ws + OFF_FEATS);
  const float* __restrict__ mu = p.in[2];
  bf16_t* R = (bf16_t*)(p.ws + OFF_R); bf16_t* K2 = (bf16_t*)(p.ws + OFF_K2); bf16_t* V2 = (bf16_t*)(p.ws + OFF_V2);
  bf16_t* ACT = (bf16_t*)(p.ws + OFF_ACT);
  for (size_t i = (size_t)VBID * NTHR + VTID; i < (size_t)T_TOK * 232; i += (size_t)VGRID * NTHR) {
    const int t = (int)(i / 232), ch = (int)(i - (size_t)t * 232);
    if (ch >= 228) { *(uint4*)(ACT + (size_t)t * 320 + 288 + (ch - 228) * 8) = make_uint4(0u, 0u, 0u, 0u); continue; }
    const int col = ch * 8;
    const uint4 cu = *(const uint4*)(FE + (size_t)t * FEW + col);
    uint4 pv = make_uint4(0u, 0u, 0u, 0u);
    if ((t & (SEQ - 1)) != 0) pv = *(const uint4*)(FE + (size_t)(t - 1) * FEW + col);
    const float4 m0 = *(const float4*)(mu + col), m1 = *(const float4*)(mu + col + 4);
    const unsigned cw[4] = {cu.x, cu.y, cu.z, cu.w}, pw[4] = {pv.x, pv.y, pv.z, pv.w};
    const float mm[8] = {m0.x, m0.y, m0.z, m0.w, m1.x, m1.y, m1.z, m1.w};
    float f[8];
#pragma unroll
    for (int q = 0; q < 4; ++q) {
      const float c0 = __uint_as_float(cw[q] << 16), c1 = __uint_as_float(cw[q] & 0xffff0000u);
      const float p0 = __uint_as_float(pw[q] << 16), p1 = __uint_as_float(pw[q] & 0xffff0000u);
      f[2 * q] = c0 + (p0 - c0) * mm[2 * q];
      f[2 * q + 1] = c1 + (p1 - c1) * mm[2 * q + 1];
    }
    bf16_t* dst;
    if (col < 512) dst = R + (size_t)t * 512 + col;
    else if (col < 1024) dst = K2 + (size_t)t * 512 + (col - 512);
    else if (col < 1536) dst = V2 + (size_t)t * 512 + (col - 1024);
    else {
      dst = ACT + (size_t)t * 320 + (col - 1536);
      if (col < 1600) {
#pragma unroll
        for (int q = 0; q < 8; ++q) f[q] = fast_tanh(f[q]);
      } else if (col >= 1664) {
#pragma unroll
        for (int q = 0; q < 8; ++q) f[q] = sigmoidf_(f[q]);
      }
    }
    uint4 w; w.x = cvtpk(f[0], f[1]); w.y = cvtpk(f[2], f[3]); w.z = cvtpk(f[4], f[5]); w.w = cvtpk(f[6], f[7]);
    *(uint4*)dst = w;
  }
}

template <int PASS>
__device__ __forceinline__ void prep_item(const Params& p, char* smem, const int row0, const int col0) {
  const bf16_t* __restrict__ ACT = (const bf16_t*)(p.ws + OFF_ACT);
  constexpr int ACOL = PASS * 64;
  constexpr int NK = (PASS == 2) ? 3 : 1;
  const float* __restrict__ Wm = (PASS == 0) ? p.in[4] : (PASS == 1) ? p.in[6] : p.in[7];
  f32x4 acc[4][4];
  acc_zero(acc);
  gemm128_acc<0, (PASS == 2)>(acc, smem, NK,
      [=](int, int rowl, int kc) { return *(const uint4*)(ACT + (size_t)(row0 + rowl) * 320 + ACOL + kc * 8); },
      [=](int nq) { return Wm + col0 + nq * 4; }, 512, 160);
  int tid_l_ = VTID; asm volatile("" : "+v"(tid_l_)); const int tid = tid_l_, lane = tid & 63, wid = tid >> 6;
  const int wr = wid >> 1, wc = wid & 1, fr = lane & 15, fq = lane >> 4;
  const int cb = col0 + wc * 64;
  if (PASS == 0) {
    const float* __restrict__ w0 = p.in[3];
    float* W = (float*)(p.ws + OFF_W);
#pragma unroll
    for (int n = 0; n < 4; ++n) {
      const int c = cb + n * 16 + fq * 4;
      const float4 w04 = *(const float4*)(w0 + c);
      const float w0c[4] = {w04.x, w04.y, w04.z, w04.w};
#pragma unroll
      for (int m = 0; m < 4; ++m) {
        const int t = row0 + wr * 64 + m * 16 + fr;
        float d[4];
#pragma unroll
        for (int j = 0; j < 4; ++j) {
          const float nz = -(w0c[j] + acc[m][n][j]);
          const float sp = fmaxf(nz, 0.f) + __logf(1.f + __expf(-fabsf(nz)));
          d[j] = -__expf(-sp - 0.5f);
        }
        *(float4*)(W + (size_t)t * 512 + c) = make_float4(d[0], d[1], d[2], d[3]);
      }
    }
  } else if (PASS == 2) {
    bf16_t* G = (bf16_t*)(p.ws + OFF_G);
#pragma unroll
    for (int m = 0; m < 4; ++m) {
      const int t = row0 + wr * 64 + m * 16 + fr;
#pragma unroll
      for (int n = 0; n < 4; ++n)
        *(uint2*)(G + (size_t)t * 512 + cb + n * 16 + fq * 4) = pack4(acc[m][n][0], acc[m][n][1], acc[m][n][2], acc[m][n][3]);
    }
  } else {
    const float* __restrict__ a0 = p.in[5]; const float* __restrict__ k_k = p.in[8]; const float* __restrict__ k_a = p.in[9];
    const float* __restrict__ r_k = p.in[10];
    const bf16_t* __restrict__ R = (const bf16_t*)(p.ws + OFF_R); bf16_t* K2 = (bf16_t*)(p.ws + OFF_K2);
    bf16_t* A = (bf16_t*)(p.ws + OFF_A); bf16_t* B = (bf16_t*)(p.ws + OFF_B); float* SB = (float*)(p.ws + OFF_SB);
#pragma unroll
    for (int m = 0; m < 4; ++m) {
      __builtin_amdgcn_sched_barrier(0);
      const int t = row0 + wr * 64 + m * 16 + fr;
      float kk[4][4];
      float ssp = 0.f, sbp = 0.f;
#pragma unroll
      for (int n = 0; n < 4; ++n) {
        const int c = cb + n * 16 + fq * 4;
        const size_t o = (size_t)t * 512 + c;
        const float4 rr4 = bf4_to_f4(*(const uint2*)(R + o)), kx4 = bf4_to_f4(*(const uint2*)(K2 + o));
        const float rr[4] = {rr4.x, rr4.y, rr4.z, rr4.w}, kx[4] = {kx4.x, kx4.y, kx4.z, kx4.w};
        const float4 a04 = *(const float4*)(a0 + c), kk4 = *(const float4*)(k_k + c), ka4 = *(const float4*)(k_a + c), rk4 = *(const float4*)(r_k + c);
        const float a0c[4] = {a04.x, a04.y, a04.z, a04.w}, kkc[4] = {kk4.x, kk4.y, kk4.z, kk4.w}, kac[4] = {ka4.x, ka4.y, ka4.z, ka4.w};
        const float rkc[4] = {rk4.x, rk4.y, rk4.z, rk4.w};
        float k2[4];
#pragma unroll
        for (int j = 0; j < 4; ++j) {
          const float av = sigmoidf_(a0c[j] + acc[m][n][j]);
          acc[m][n][j] = av;
          kk[n][j] = kx[j] * kkc[j];
          k2[j] = kx[j] * (1.f + (av - 1.f) * kac[j]);
          ssp += kk[n][j] * kk[n][j];
          sbp += rr[j] * k2[j] * rkc[j];
        }
        *(uint2*)(K2 + o) = pack4(k2[0], k2[1], k2[2], k2[3]);
      }
      ssp += __shfl_xor(ssp, 16, 64); ssp += __shfl_xor(ssp, 32, 64);
      sbp += __shfl_xor(sbp, 16, 64); sbp += __shfl_xor(sbp, 32, 64);
      const float inv = 1.f / fmaxf(sqrtf(ssp), 1e-12f);
#pragma unroll
      for (int n = 0; n < 4; ++n) {
        const size_t o = (size_t)t * 512 + cb + n * 16 + fq * 4;
        *(uint2*)(A + o) = pack4(-kk[n][0] * inv, -kk[n][1] * inv, -kk[n][2] * inv, -kk[n][3] * inv);
        *(uint2*)(B + o) = pack4(kk[n][0] * inv * acc[m][n][0], kk[n][1] * inv * acc[m][n][1], kk[n][2] * inv * acc[m][n][2], kk[n][3] * inv * acc[m][n][3]);
      }
      if (fq == 0) SB[(size_t)t * 8 + (cb >> 6)] = sbp;
    }
  }
}
__device__ __forceinline__ void phase_prep(const Params& p, char* smem) {
  for (int item = VBID; item < (T_TOK / 128) * 8; item += VGRID) {
    const int pass = item >> 10, mt = (item & 1023) >> 2, nt = item & 3;
    if (pass == 0) prep_item<0>(p, smem, mt * 128, nt * 128);
    else prep_item<1>(p, smem, mt * 128, nt * 128);
  }
}

#define CK_AR 0
#define CK_BK 9216
#define CK_BKT 18432
#define CK_UVT 27648
#define CK_LM 36864
#define CK_XR 46080
#define CK_LABT 54784
#define CK_WUT 58880
#define CK_PC 64000
constexpr size_t CK_GA_OFF = 0;
constexpr size_t CK_HA_OFF = (size_t)8192 * 8192;
constexpr size_t OFF_RA = OFF_MIXED;
constexpr size_t OFF_Y1A = OFF_MIXED + (size_t)8192 * 4096;
#define CK_MMA(x, y, c) __builtin_amdgcn_mfma_f32_16x16x32_bf16((x), (y), (c), 0, 0, 0)
#define CK_FRAG(off) (*(const bf16x8*)(smem + (off)))
#define CK_LOADS(it_) { \
    const int hd_ = (it_) >> 7, ch_ = (it_) & 127; \
    const size_t tok_ = (size_t)(hd_ >> 3) * SEQ + (size_t)ch_ * 32; \
    const size_t g1_ = (tok_ + t1) * 512 + (hd_ & 7) * 64 + j8; \
    ua = *(const uint4*)(A + g1_); ub = *(const uint4*)(B + g1_); uk = *(const uint4*)(K2 + g1_); ur = *(const uint4*)(R + g1_); \
    lw0 = *(const float4*)(W + g1_); lw1 = *(const float4*)(W + g1_ + 4); \
    const bf16_t* vp_ = V2 + (tok_ + 8 * w) * 512 + (hd_ & 7) * 64 + lane; \
    v0 = vp_[0]; v1 = vp_[512]; v2 = vp_[1024]; v3 = vp_[1536]; v4 = vp_[2048]; v5 = vp_[2560]; v6 = vp_[3072]; v7 = vp_[3584]; }
__device__ __forceinline__ void phase_chunk_pre(const Params& p, char* smem) {
  const bf16_t* __restrict__ R = (const bf16_t*)(p.ws + OFF_R); const bf16_t* __restrict__ K2 = (const bf16_t*)(p.ws + OFF_K2);
  const bf16_t* __restrict__ V2 = (const bf16_t*)(p.ws + OFF_V2); const bf16_t* __restrict__ A = (const bf16_t*)(p.ws + OFF_A);
  const bf16_t* __restrict__ B = (const bf16_t*)(p.ws + OFF_B); const float* __restrict__ W = (const float*)(p.ws + OFF_W);
  int tid_l_ = VTID; asm volatile("" : "+v"(tid_l_)); const int tid = tid_l_, lane = tid & 63, q = lane >> 4, c16 = lane & 15;
  const int w = __builtin_amdgcn_readfirstlane(tid >> 6);
  const int t1 = tid >> 3, j8 = (tid & 7) * 8;
  uint4 ua, ub, uk, ur; float4 lw0, lw1; unsigned v0, v1, v2, v3, v4, v5, v6, v7;
  int item = VBID;
  if (item < 64 * 128) CK_LOADS(item)
  for (; item < 64 * 128; item += VGRID) {
  *(float4*)(smem + CK_LM + t1 * 256 + j8 * 4) = lw0;
  *(float4*)(smem + CK_LM + t1 * 256 + j8 * 4 + 16) = lw1;
  HSYNCL();
  {
    float lv[32];
#pragma unroll
    for (int s = 0; s < 32; ++s) lv[s] = *(const float*)(smem + CK_LM + s * 256 + lane * 4);
    float acc = 0.f;
#pragma unroll
    for (int blk = 0; blk < 4; ++blk) {
#pragma unroll
      for (int i = 0; i < 8; ++i) { acc += lv[8 * blk + i]; lv[8 * blk + i] = acc; }
      if (blk == w) {
#pragma unroll
        for (int i = 0; i < 8; ++i) *(float*)(smem + CK_XR + (8 * blk + i) * 272 + lane * 4) = lv[8 * blk + i];
      }
    }
    if (w == 3) *(float*)(smem + CK_PC + lane * 4) = __expf(acc);
    uint4 vv; vv.x = v0 | (v1 << 16); vv.y = v2 | (v3 << 16); vv.z = v4 | (v5 << 16); vv.w = v6 | (v7 << 16);
    *(uint4*)(smem + CK_UVT + lane * 144 + (32 + 8 * w) * 2) = vv;
  }
  HSYNCL();
  {
    const float4 c1a = *(const float4*)(smem + CK_XR + t1 * 272 + j8 * 4), c1b = *(const float4*)(smem + CK_XR + t1 * 272 + j8 * 4 + 16);
    float4 c0a = make_float4(0.f, 0.f, 0.f, 0.f), c0b = make_float4(0.f, 0.f, 0.f, 0.f);
    if (t1 > 0) { c0a = *(const float4*)(smem + CK_XR + (t1 - 1) * 272 + j8 * 4); c0b = *(const float4*)(smem + CK_XR + (t1 - 1) * 272 + j8 * 4 + 16); }
    const float cl1[8] = {c1a.x, c1a.y, c1a.z, c1a.w, c1b.x, c1b.y, c1b.z, c1b.w};
    const float cl0[8] = {c0a.x, c0a.y, c0a.z, c0a.w, c0b.x, c0b.y, c0b.z, c0b.w};
    const unsigned wa[4] = {ua.x, ua.y, ua.z, ua.w}, wb[4] = {ub.x, ub.y, ub.z, ub.w}, wk[4] = {uk.x, uk.y, uk.z, uk.w}, wr[4] = {ur.x, ur.y, ur.z, ur.w};
    unsigned oa[4], ob[4], ok[4], orr[4];
#pragma unroll
    for (int i = 0; i < 4; ++i) {
      const float e0l = __expf(cl0[2 * i]), e0h = __expf(cl0[2 * i + 1]);
      const float e1l = __expf(cl1[2 * i]), e1h = __expf(cl1[2 * i + 1]);
      const float e2l = __expf(-cl1[2 * i]), e2h = __expf(-cl1[2 * i + 1]);
      oa[i] = cvtpk(__uint_as_float(wa[i] << 16) * e0l, __uint_as_float(wa[i] & 0xffff0000u) * e0h);
      orr[i] = cvtpk(__uint_as_float(wr[i] << 16) * e1l, __uint_as_float(wr[i] & 0xffff0000u) * e1h);
      ob[i] = cvtpk(__uint_as_float(wb[i] << 16) * e2l, __uint_as_float(wb[i] & 0xffff0000u) * e2h);
      ok[i] = cvtpk(__uint_as_float(wk[i] << 16) * e2l, __uint_as_float(wk[i] & 0xffff0000u) * e2h);
    }
    *(uint4*)(smem + CK_AR + t1 * 144 + j8 * 2) = make_uint4(oa[0], oa[1], oa[2], oa[3]);
    *(uint4*)(smem + CK_AR + (32 + t1) * 144 + j8 * 2) = make_uint4(orr[0], orr[1], orr[2], orr[3]);
    *(uint4*)(smem + CK_BK + t1 * 144 + j8 * 2) = make_uint4(ob[0], ob[1], ob[2], ob[3]);
    *(uint4*)(smem + CK_BK + (32 + t1) * 144 + j8 * 2) = make_uint4(ok[0], ok[1], ok[2], ok[3]);
  }
  if (item + VGRID < 64 * 128) CK_LOADS(item + VGRID)
  HSYNCL();
  {
    f32x4 acc[4];
#pragma unroll
    for (int nb = 0; nb < 4; ++nb) acc[nb] = (f32x4){0.f, 0.f, 0.f, 0.f};
#pragma unroll
    for (int ks = 0; ks < 2; ++ks) {
      const bf16x8 xa = CK_FRAG(CK_AR + (16 * w + c16) * 144 + ks * 64 + q * 16);
#pragma unroll
      for (int nb = 0; nb < 4; ++nb) acc[nb] = CK_MMA(CK_FRAG(CK_BK + (16 * nb + c16) * 144 + ks * 64 + q * 16), xa, acc[nb]);
    }
    const int tt = (16 * w + c16) & 31;
#pragma unroll
    for (int nb = 0; nb < 4; ++nb) {
      float val[4];
#pragma unroll
      for (int r = 0; r < 4; ++r) {
        const int s = (16 * nb + 4 * q + r) & 31;
        const bool keep = (w < 2) ? (s < tt) : (s <= tt);
        val[r] = keep ? acc[nb][r] : 0.f;
        if (w < 2 && nb < 2) *(float*)(smem + CK_LABT + s * 128 + tt * 4) = val[r];
      }
      *(uint2*)(smem + CK_LM + (16 * w + c16) * 144 + (16 * nb + 4 * q) * 2) = pack4(val[0], val[1], val[2], val[3]);
    }
  }
  HSYNCL();
  {
    const int mb = w & 1;
    const bf16x8 xa = CK_FRAG(CK_LM + (16 * mb + c16) * 144 + 64 + q * 16);
#pragma unroll
    for (int u = 0; u < 2; ++u) {
      const int nb = 2 * (w >> 1) + u;
      f32x4 acc = (f32x4){0.f, 0.f, 0.f, 0.f};
      acc = CK_MMA(CK_FRAG(CK_UVT + (16 * nb + c16) * 144 + 64 + q * 16), xa, acc);
      *(float4*)(smem + CK_XR + (16 * mb + c16) * 272 + (16 * nb + 4 * q) * 4) = make_float4(acc[0], acc[1], acc[2], acc[3]);
    }
  }
  HSYNCL();
  if (w < 2) {
    float x[32];
    if (w == 0) {
#pragma unroll
      for (int t = 0; t < 32; ++t) x[t] = bf2f(*(const bf16_t*)(smem + CK_AR + t * 144 + lane * 2));
    } else {
#pragma unroll
      for (int t = 0; t < 32; ++t) x[t] = *(const float*)(smem + CK_XR + t * 272 + lane * 4);
    }
    char* const dst = (w == 0) ? (smem + CK_WUT + lane * 80) : (smem + CK_UVT + lane * 144);
    const int bstr = (w == 0) ? 80 : 144;
    char* const xrows = (w == 0) ? (smem + CK_WUT) : (smem + CK_UVT);
    char* const tb = (w == 0) ? (smem + CK_AR) : (smem + CK_XR);
    float4 lc[2][4];
    int lofs = CK_LABT; asm volatile("" : "+v"(lofs)); const char* const lbase = smem + lofs;
#define CK_LCOL(s_, g0_) { _Pragma("unroll") for (int g_ = 0; g_ < 4; ++g_) if (4 * (g_ + (g0_)) + 3 > (s_)) lc[(s_) & 1][g_] = *(const float4*)(lbase + (s_) * 128 + (g_ + (g0_)) * 16); }
#define CK_SWEEP(s0_, g0_) { \
    CK_LCOL(s0_, g0_) \
    _Pragma("unroll") for (int s = (s0_); s < (s0_) + 15; ++s) { \
      if (s + 1 < (s0_) + 15) CK_LCOL(s + 1, g0_) \
      __builtin_amdgcn_sched_barrier(0); \
      _Pragma("unroll") for (int g = 0; g < 4; ++g) { \
        if (4 * (g + (g0_)) + 3 > s) { \
          const float4 l4 = lc[s & 1][g]; \
          if (4 * (g + (g0_)) + 0 > s) x[4 * (g + (g0_)) + 0] = fmaf(l4.x, x[s], x[4 * (g + (g0_)) + 0]); \
          if (4 * (g + (g0_)) + 1 > s) x[4 * (g + (g0_)) + 1] = fmaf(l4.y, x[s], x[4 * (g + (g0_)) + 1]); \
          if (4 * (g + (g0_)) + 2 > s) x[4 * (g + (g0_)) + 2] = fmaf(l4.z, x[s], x[4 * (g + (g0_)) + 2]); \
          if (4 * (g + (g0_)) + 3 > s) x[4 * (g + (g0_)) + 3] = fmaf(l4.w, x[s], x[4 * (g + (g0_)) + 3]); \
        } \
      } \
      __builtin_amdgcn_sched_barrier(0); \
    } }
    CK_SWEEP(0, 0)
#pragma unroll
    for (int g = 0; g < 2; ++g)
      *(uint4*)(dst + g * 16) = make_uint4(cvtpk(x[8 * g], x[8 * g + 1]), cvtpk(x[8 * g + 2], x[8 * g + 3]), cvtpk(x[8 * g + 4], x[8 * g + 5]), cvtpk(x[8 * g + 6], x[8 * g + 7]));
    asm volatile("s_waitcnt lgkmcnt(0)" ::: "memory");
    {
      const bf16x8 zf = {0, 0, 0, 0, 0, 0, 0, 0};
      const bf16x8 la = (q < 2) ? CK_FRAG(CK_LM + (16 + c16) * 144 + q * 16) : zf;
#pragma unroll
      for (int nb = 0; nb < 4; ++nb) {
        const bf16x8 xb = (q < 2) ? *(const bf16x8*)(xrows + (16 * nb + c16) * bstr + q * 16) : zf;
        f32x4 d = (f32x4){0.f, 0.f, 0.f, 0.f};
        d = CK_MMA(la, xb, d);
#pragma unroll
        for (int r = 0; r < 4; ++r) *(float*)(tb + (4 * q + r) * 272 + (16 * nb + c16) * 4) = d[r];
      }
    }
    asm volatile("s_waitcnt lgkmcnt(0)" ::: "memory");
#pragma unroll
    for (int t = 0; t < 16; ++t) x[16 + t] += *(const float*)(tb + t * 272 + lane * 4);
    CK_SWEEP(16, 4)
#undef CK_SWEEP
#undef CK_LCOL
#pragma unroll
    for (int g = 2; g < 4; ++g)
      *(uint4*)(dst + g * 16) = make_uint4(cvtpk(x[8 * g], x[8 * g + 1]), cvtpk(x[8 * g + 2], x[8 * g + 3]), cvtpk(x[8 * g + 4], x[8 * g + 5]), cvtpk(x[8 * g + 6], x[8 * g + 7]));
  } else {
    const int rb = (w - 2) * 32;
#pragma unroll
    for (int g = 0; g < 4; ++g) {
      unsigned e[8];
#pragma unroll
      for (int i = 0; i < 8; ++i) e[i] = *(const bf16_t*)(smem + CK_BK + (rb + 8 * g + i) * 144 + lane * 2);
      *(uint4*)(smem + CK_BKT + lane * 144 + (rb + 8 * g) * 2) = make_uint4(e[0] | (e[1] << 16), e[2] | (e[3] << 16), e[4] | (e[5] << 16), e[6] | (e[7] << 16));
    }
  }
  HSYNCL();
  {
    char* const GA = (char*)p.out + CK_GA_OFF + (size_t)item * 8192;
    char* const HA = (char*)p.out + CK_HA_OFF + (size_t)item * 8192;
    char* const RA = p.ws + OFF_RA + (size_t)item * 4096;
    char* const Y1A = p.ws + OFF_Y1A + (size_t)item * 4096;
    const bf16x8 xw = CK_FRAG(CK_WUT + (16 * w + c16) * 80 + q * 16);
#pragma unroll
    for (int nb = 0; nb < 4; ++nb) {
      f32x4 acc = (f32x4){0.f, 0.f, 0.f, 0.f};
      acc = CK_MMA(xw, CK_FRAG(CK_BKT + (16 * nb + c16) * 144 + q * 16), acc);
      const float pc = *(const float*)(smem + CK_PC + (16 * nb + c16) * 4);
      float g[4];
#pragma unroll
      for (int r = 0; r < 4; ++r) g[r] = (acc[r] + ((16 * w + 4 * q + r) == (16 * nb + c16) ? 1.f : 0.f)) * pc;
      *(uint2*)(GA + ((((nb * 2 + (w >> 1)) * 64 + lane) * 8 + 4 * (w & 1)) << 1)) = pack4(g[0], g[1], g[2], g[3]);
    }
#pragma unroll
    for (int nb = 0; nb < 2; ++nb) {
      f32x4 acc = (f32x4){0.f, 0.f, 0.f, 0.f};
      acc = CK_MMA(xw, CK_FRAG(CK_LM + (32 + 16 * nb + c16) * 144 + q * 16), acc);
      const float4 rt = bf4_to_f4(*(const uint2*)(smem + CK_AR + (32 + 16 * nb + c16) * 144 + (16 * w + 4 * q) * 2));
      *(uint2*)(RA + ((((nb * 2 + (w >> 1)) * 64 + lane) * 8 + 4 * (w & 1)) << 1)) = pack4(acc[0] + rt.x, acc[1] + rt.y, acc[2] + rt.z, acc[3] + rt.w);
    }
    {
      const bf16x8 xb0 = CK_FRAG(CK_BKT + (16 * w + c16) * 144 + q * 16), xb1 = CK_FRAG(CK_BKT + (16 * w + c16) * 144 + 64 + q * 16);
      const float4 pc4 = *(const float4*)(smem + CK_PC + (16 * w + 4 * q) * 4);
#pragma unroll
      for (int nb = 0; nb < 4; ++nb) {
        f32x4 acc = (f32x4){0.f, 0.f, 0.f, 0.f};
        acc = CK_MMA(xb0, CK_FRAG(CK_UVT + (16 * nb + c16) * 144 + q * 16), acc);
        acc = CK_MMA(xb1, CK_FRAG(CK_UVT + (16 * nb + c16) * 144 + 64 + q * 16), acc);
        *(uint2*)(HA + (((nb * 4 + w) * 64 + lane) << 3)) = pack4(acc[0] * pc4.x, acc[1] * pc4.y, acc[2] * pc4.z, acc[3] * pc4.w);
      }
    }
    {
      const int mb = w & 1;
      const bf16x8 xm0 = CK_FRAG(CK_LM + (32 + 16 * mb + c16) * 144 + q * 16), xm1 = CK_FRAG(CK_LM + (32 + 16 * mb + c16) * 144 + 64 + q * 16);
#pragma unroll
      for (int u = 0; u < 2; ++u) {
        const int nb = 2 * (w >> 1) + u;
        f32x4 acc = (f32x4){0.f, 0.f, 0.f, 0.f};
        acc = CK_MMA(xm0, CK_FRAG(CK_UVT + (16 * nb + c16) * 144 + q * 16), acc);
        acc = CK_MMA(xm1, CK_FRAG(CK_UVT + (16 * nb + c16) * 144 + 64 + q * 16), acc);
        *(uint2*)(Y1A + (((nb * 2 + mb) * 64 + lane) << 3)) = pack4(acc[0], acc[1], acc[2], acc[3]);
      }
    }
  }
  HSYNCL();
  }
}

struct SeqSet { uint4 ga[8]; uint4 ra[4]; uint2 ha[4]; uint2 y1[2]; };
__device__ __forceinline__ bf16x8 as_frag(const uint4 u) { return __builtin_bit_cast(bf16x8, u); }
__device__ __forceinline__ f32x4 bf4_to_acc(const uint2 u) {
  return (f32x4){__uint_as_float(u.x << 16), __uint_as_float(u.x & 0xffff0000u), __uint_as_float(u.y << 16), __uint_as_float(u.y & 0xffff0000u)};
}
#define SQ_LOAD(S, it) { \
    const char* ga_ = GA0 + (size_t)(it) * 8192 + lane * 16; const char* ra_ = RA0 + (size_t)(it) * 4096 + lane * 16; \
    const char* ha_ = HA0 + (size_t)(it) * 8192 + (rg * 4 * 64 + lane) * 8; const char* y1_ = Y10 + (size_t)(it) * 4096 + (rg * 2 * 64 + lane) * 8; \
    _Pragma("unroll") for (int i_ = 0; i_ < 8; ++i_) S.ga[i_] = *(const uint4*)(ga_ + i_ * 1024); \
    _Pragma("unroll") for (int i_ = 0; i_ < 4; ++i_) S.ra[i_] = *(const uint4*)(ra_ + i_ * 1024); \
    _Pragma("unroll") for (int i_ = 0; i_ < 4; ++i_) S.ha[i_] = *(const uint2*)(ha_ + i_ * 512); \
    _Pragma("unroll") for (int i_ = 0; i_ < 2; ++i_) S.y1[i_] = *(const uint2*)(y1_ + i_ * 512); }
#define SQ_STEP(S, cidx) { \
    const bf16x8 b0 = as_frag(make_uint4(cvtpk(acc0[0], acc0[1]), cvtpk(acc0[2], acc0[3]), cvtpk(acc1[0], acc1[1]), cvtpk(acc1[2], acc1[3]))); \
    const bf16x8 b1 = as_frag(make_uint4(cvtpk(acc2[0], acc2[1]), cvtpk(acc2[2], acc2[3]), cvtpk(acc3[0], acc3[1]), cvtpk(acc3[2], acc3[3]))); \
    f32x4 y0 = bf4_to_acc(S.y1[0]), y1v = bf4_to_acc(S.y1[1]); \
    y0 = CK_MMA(as_frag(S.ra[0]), b0, y0); y0 = CK_MMA(as_frag(S.ra[1]), b1, y0); \
    y1v = CK_MMA(as_frag(S.ra[2]), b0, y1v); y1v = CK_MMA(as_frag(S.ra[3]), b1, y1v); \
    f32x4 n0 = bf4_to_acc(S.ha[0]), n1 = bf4_to_acc(S.ha[1]), n2 = bf4_to_acc(S.ha[2]), n3 = bf4_to_acc(S.ha[3]); \
    n0 = CK_MMA(as_frag(S.ga[0]), b0, n0); n0 = CK_MMA(as_frag(S.ga[1]), b1, n0); \
    n1 = CK_MMA(as_frag(S.ga[2]), b0, n1); n1 = CK_MMA(as_frag(S.ga[3]), b1, n1); \
    n2 = CK_MMA(as_frag(S.ga[4]), b0, n2); n2 = CK_MMA(as_frag(S.ga[5]), b1, n2); \
    n3 = CK_MMA(as_frag(S.ga[6]), b0, n3); n3 = CK_MMA(as_frag(S.ga[7]), b1, n3); \
    bf16_t* yo_ = YS0 + (size_t)(cidx) * 32 * 512; \
    _Pragma("unroll") for (int r_ = 0; r_ < 4; ++r_) { yo_[(size_t)(4 * q + r_) * 512] = f2bf(y0[r_]); yo_[(size_t)(16 + 4 * q + r_) * 512] = f2bf(y1v[r_]); } \
    acc0 = n0; acc1 = n1; acc2 = n2; acc3 = n3; }
__device__ __forceinline__ void phase_seq(const Params& p) {
  if (VHALF != 0) return;
  int tid_l_ = VTID; asm volatile("" : "+v"(tid_l_)); const int tid = tid_l_, lane = tid & 63, q = lane >> 4, c16 = lane & 15;
  const int rg = __builtin_amdgcn_readfirstlane(tid >> 6);
  const char* const GA0 = (const char*)p.out + CK_GA_OFF; const char* const HA0 = (const char*)p.out + CK_HA_OFF;
  const char* const RA0 = p.ws + OFF_RA; const char* const Y10 = p.ws + OFF_Y1A;
  for (int hd = (int)blockIdx.x; hd < 64; hd += (int)gridDim.x) {
    const int b = hd >> 3, h = hd & 7;
    bf16_t* const YS0 = (bf16_t*)(p.ws + OFF_YS) + (size_t)b * SEQ * 512 + h * 64 + rg * 16 + c16;
    f32x4 acc0 = (f32x4){0.f, 0.f, 0.f, 0.f}, acc1 = acc0, acc2 = acc0, acc3 = acc0;
    SeqSet sa, sb;
    SQ_LOAD(sa, hd * 128)
    for (int c = 0; c < 128; c += 2) {
      SQ_LOAD(sb, hd * 128 + c + 1)
      SQ_STEP(sa, c)
      if (c + 2 < 128) SQ_LOAD(sa, hd * 128 + c + 2)
      SQ_STEP(sb, c + 1)
    }
  }
}


#define CONV_TILES (257 * 96)
struct ConvDesc { const float* src; bf16_t* dst; int ldn, k0, n0, kdim, part; };
__device__ __forceinline__ ConvDesc conv_desc(const Params& p, const int ti) {
  ConvDesc d;
  const int e = ti / 96, q = ti - e * 96, part = q >> 5, w = q & 31;
  d.part = part;
  if (part < 2) {
    d.src = (e < NEXP) ? p.in[18 + part] + (size_t)e * DM * 256 : p.in[21 + part];
    d.ldn = 256; d.k0 = (w >> 1) * 64; d.n0 = (w & 1) * 128; d.kdim = 1024;
    d.dst = (bf16_t*)(p.ws + OFF_EW1 + (size_t)e * 512 * 1024);
  } else {
    d.src = (e < NEXP) ? p.in[20] + (size_t)e * 256 * DM : p.in[23];
    d.ldn = 1024; d.k0 = (w >> 3) * 64; d.n0 = (w & 7) * 128; d.kdim = 256;
    d.dst = (bf16_t*)(p.ws + OFF_EW2 + (size_t)e * 1024 * 256);
  }
  return d;
}
#define CV_LOAD(d, r) { \
    const float* bp_ = (d).src + (size_t)((d).k0 + ko * 8) * (d).ldn + (d).n0 + nq * 4; \
    r##0 = *(const float4*)(bp_); r##1 = *(const float4*)(bp_ + (size_t)1 * (d).ldn); r##2 = *(const float4*)(bp_ + (size_t)2 * (d).ldn); \
    r##3 = *(const float4*)(bp_ + (size_t)3 * (d).ldn); r##4 = *(const float4*)(bp_ + (size_t)4 * (d).ldn); r##5 = *(const float4*)(bp_ + (size_t)5 * (d).ldn); \
    r##6 = *(const float4*)(bp_ + (size_t)6 * (d).ldn); r##7 = *(const float4*)(bp_ + (size_t)7 * (d).ldn); }
#define CV_LDS(r, base) { \
    uint4 v; \
    v.x = cvtpk((r##0).x, (r##1).x); v.y = cvtpk((r##2).x, (r##3).x); v.z = cvtpk((r##4).x, (r##5).x); v.w = cvtpk((r##6).x, (r##7).x); *(uint4*)((base) + lds_off(nq * 4 + 0, ko)) = v; \
    v.x = cvtpk((r##0).y, (r##1).y); v.y = cvtpk((r##2).y, (r##3).y); v.z = cvtpk((r##4).y, (r##5).y); v.w = cvtpk((r##6).y, (r##7).y); *(uint4*)((base) + lds_off(nq * 4 + 1, ko)) = v; \
    v.x = cvtpk((r##0).z, (r##1).z); v.y = cvtpk((r##2).z, (r##3).z); v.z = cvtpk((r##4).z, (r##5).z); v.w = cvtpk((r##6).z, (r##7).z); *(uint4*)((base) + lds_off(nq * 4 + 2, ko)) = v; \
    v.x = cvtpk((r##0).w, (r##1).w); v.y = cvtpk((r##2).w, (r##3).w); v.z = cvtpk((r##4).w, (r##5).w); v.w = cvtpk((r##6).w, (r##7).w); *(uint4*)((base) + lds_off(nq * 4 + 3, ko)) = v; }
#define CV_OUT(d, base) { \
    _Pragma("unroll") for (int u = 0; u < 4; ++u) { \
      const int row = (tid >> 3) + 32 * u, chunk = tid & 7; \
      const int c = (d).n0 + row; \
      const int orow = ((d).part < 2) ? ((c >> 7) * 256 + (d).part * 128 + (c & 127)) : c;     \
      *(uint4*)((d).dst + (size_t)orow * (d).kdim + (d).k0 + chunk * 8) = *(const uint4*)((base) + lds_off(row, chunk)); } }
#define CV8_LDS(r, base, SC) { \
    uint2 v; \
    v.x = pk4_fp8c((r##0).x * SC, (r##1).x * SC, (r##2).x * SC, (r##3).x * SC); v.y = pk4_fp8c((r##4).x * SC, (r##5).x * SC, (r##6).x * SC, (r##7).x * SC); \
    *(uint2*)((base) + (nq * 4 + 0) * 64 + ((ko ^ (nq & 7)) << 3)) = v; \
    v.x = pk4_fp8c((r##0).y * SC, (r##1).y * SC, (r##2).y * SC, (r##3).y * SC); v.y = pk4_fp8c((r##4).y * SC, (r##5).y * SC, (r##6).y * SC, (r##7).y * SC); \
    *(uint2*)((base) + (nq * 4 + 1) * 64 + ((ko ^ (nq & 7)) << 3)) = v; \
    v.x = pk4_fp8c((r##0).z * SC, (r##1).z * SC, (r##2).z * SC, (r##3).z * SC); v.y = pk4_fp8c((r##4).z * SC, (r##5).z * SC, (r##6).z * SC, (r##7).z * SC); \
    *(uint2*)((base) + (nq * 4 + 2) * 64 + ((ko ^ (nq & 7)) << 3)) = v; \
    v.x = pk4_fp8c((r##0).w * SC, (r##1).w * SC, (r##2).w * SC, (r##3).w * SC); v.y = pk4_fp8c((r##4).w * SC, (r##5).w * SC, (r##6).w * SC, (r##7).w * SC); \
    *(uint2*)((base) + (nq * 4 + 3) * 64 + ((ko ^ (nq & 7)) << 3)) = v; }
#define CV8_OUT(d, base) { \
    _Pragma("unroll") for (int u = 0; u < 2; ++u) { \
      const int row = (tid >> 2) + 64 * u, c16_ = tid & 3, f_ = (row >> 2) & 7; \
      const uint2 s0 = *(const uint2*)((base) + row * 64 + (((2 * c16_) ^ f_) << 3)), s1 = *(const uint2*)((base) + row * 64 + (((2 * c16_ + 1) ^ f_) << 3)); \
      const int c = (d).n0 + row; \
      const int orow = ((d).part < 2) ? ((c >> 7) * 256 + (d).part * 128 + (c & 127)) : c; \
      *(uint4*)((char*)(d).dst + (size_t)orow * (d).kdim + (d).k0 + c16_ * 16) = make_uint4(s0.x, s0.y, s1.x, s1.y); } }
__device__ __forceinline__ void convert_tile2(const Params& p, char* smem, const int t2) {
  int tid_l_ = VTID; asm volatile("" : "+v"(tid_l_)); const int tid = tid_l_, nq = tid & 31, ko = tid >> 5;
  const ConvDesc da = conv_desc(p, 2 * t2), db = conv_desc(p, 2 * t2 + 1);
  float4 ra0, ra1, ra2, ra3, ra4, ra5, ra6, ra7, rb0, rb1, rb2, rb3, rb4, rb5, rb6, rb7;
  CV_LOAD(da, ra)
  CV_LOAD(db, rb)
  CV8_LDS(ra, smem, W_SCALE)
  CV8_LDS(rb, smem + 16384, W_SCALE)
  HSYNC();
  CV8_OUT(da, smem)
  CV8_OUT(db, smem + 16384)
  HSYNC();
}
#undef CV_LOAD
#undef CV_LDS
#undef CV_OUT

__device__ __forceinline__ int vt_off(int d, int key) { const int swz = ((d >> 2) & 15) ^ ((d & 3) << 3); return d * 512 + (((key >> 2) ^ swz) << 3); }
__device__ __forceinline__ void attn_item(const Params& p, char* smem, const int item) {
  const bf16_t* __restrict__ Q = (const bf16_t*)(p.ws + OFF_Q); const bf16_t* __restrict__ K = (const bf16_t*)(p.ws + OFF_K);
  const bf16_t* __restrict__ V = (const bf16_t*)(p.ws + OFF_V);
  bf16_t* OP = (bf16_t*)(p.ws + OFF_OP); float* LSE = (float*)(p.ws + OFF_LSE);
  char* Ks = smem; char* VT = smem + 32768; float* linv_s = (float*)(smem + 65536);
  int tid_l_ = VTID; asm volatile("" : "+v"(tid_l_)); const int tid = tid_l_, lane = tid & 63, wid = tid >> 6, l31 = lane & 31, hi = lane >> 5;
  {
    const int pp = item >> 11, rem = item & 2047, bh = rem >> 5, sub = rem & 31;
    const int dsh = pp * 2, nbsh = 5 - dsh;
    const int r = sub >> nbsh, n = sub & ((1 << nbsh) - 1);
    const int b = bh >> 3, h = bh & 7, tb = b * SEQ;
    HSYNC();
#pragma unroll
    for (int u = 0; u < 8; ++u) {
      if (u == 4) __builtin_amdgcn_sched_barrier(0);
      const int row = (tid >> 3) + 32 * u, chunk = tid & 7;
      int ik = n * 128 - 128 + row; ik = ik < 0 ? 0 : ik;
      const int tok = tb + (ik << dsh) + r;
      *(uint4*)(Ks + lds_off(row, chunk)) = *(const uint4*)(K + (size_t)tok * 512 + h * 64 + chunk * 8);
    }
#pragma unroll
    for (int ps = 0; ps < 2; ++ps) {
      const int dq = tid & 15, kbase = ps * 128 + (tid >> 4) * 8;
      uint2 v0, v1, v2, v3, v4, v5, v6, v7;
#define LDV(i, dst) { int ik = n * 128 - 128 + kbase + i; ik = ik < 0 ? 0 : ik; const int tok = tb + (ik << dsh) + r; dst = *(const uint2*)(V + (size_t)tok * 512 + h * 64 + dq * 4); }
      LDV(0, v0) LDV(1, v1) LDV(2, v2) LDV(3, v3) LDV(4, v4) LDV(5, v5) LDV(6, v6) LDV(7, v7)
#undef LDV
      {
        uint2 w;
        w.x = (v0.x & 0xffffu) | (v1.x << 16); w.y = (v2.x & 0xffffu) | (v3.x << 16);
        *(uint2*)(VT + vt_off(dq * 4 + 0, kbase)) = w;
        w.x = (v4.x & 0xffffu) | (v5.x << 16); w.y = (v6.x & 0xffffu) | (v7.x << 16);
        *(uint2*)(VT + vt_off(dq * 4 + 0, kbase + 4)) = w;
        w.x = (v0.x >> 16) | (v1.x & 0xffff0000u); w.y = (v2.x >> 16) | (v3.x & 0xffff0000u);
        *(uint2*)(VT + vt_off(dq * 4 + 1, kbase)) = w;
        w.x = (v4.x >> 16) | (v5.x & 0xffff0000u); w.y = (v6.x >> 16) | (v7.x & 0xffff0000u);
        *(uint2*)(VT + vt_off(dq * 4 + 1, kbase + 4)) = w;
        w.x = (v0.y & 0xffffu) | (v1.y << 16); w.y = (v2.y & 0xffffu) | (v3.y << 16);
        *(uint2*)(VT + vt_off(dq * 4 + 2, kbase)) = w;
        w.x = (v4.y & 0xffffu) | (v5.y << 16); w.y = (v6.y & 0xffffu) | (v7.y << 16);
        *(uint2*)(VT + vt_off(dq * 4 + 2, kbase + 4)) = w;
        w.x = (v0.y >> 16) | (v1.y & 0xffff0000u); w.y = (v2.y >> 16) | (v3.y & 0xffff0000u);
        *(uint2*)(VT + vt_off(dq * 4 + 3, kbase)) = w;
        w.x = (v4.y >> 16) | (v5.y & 0xffff0000u); w.y = (v6.y >> 16) | (v7.y & 0xffff0000u);
        *(uint2*)(VT + vt_off(dq * 4 + 3, kbase + 4)) = w;
      }
    }
    HSYNC();
    const int iq = n * 128 + wid * 32 + l31;
    const int tq = tb + (iq << dsh) + r;
    bf16x8 qf[4];
#pragma unroll
    for (int ks = 0; ks < 4; ++ks) qf[ks] = *(const bf16x8*)(Q + (size_t)tq * 512 + h * 64 + ks * 16 + hi * 8);
    f32x16 st[5];
#pragma unroll
    for (int kb = 0; kb < 5; ++kb) {
      st[kb] = (f32x16){0.f, 0.f, 0.f, 0.f, 0.f, 0.f, 0.f, 0.f, 0.f, 0.f, 0.f, 0.f, 0.f, 0.f, 0.f, 0.f};
#pragma unroll
      for (int ks = 0; ks < 4; ++ks) {
        const bf16x8 kf = *(const bf16x8*)(Ks + lds_off(32 * (wid + kb) + l31, 2 * ks + hi));
        st[kb] = __builtin_amdgcn_mfma_f32_32x32x16_bf16(kf, qf[ks], st[kb], 0, 0, 0);
      }
    }
    float m = -INFINITY;
#pragma unroll
    for (int kb = 0; kb < 5; ++kb)
#pragma unroll
      for (int i = 0; i < 16; ++i) {
        const int kirel = 32 * kb + (i & 3) + 8 * (i >> 2) + 4 * hi;
        const bool valid = (kirel >= l31) && (kirel <= l31 + 128) && (n > 0 || (32 * wid + kirel) >= 128);
        const float s = valid ? st[kb][i] : -INFINITY;
        st[kb][i] = s;
        m = fmaxf(m, s);
      }
    m = fmaxf(m, __shfl_xor(m, 32, 64));
    float l = 0.f;
#pragma unroll
    for (int kb = 0; kb < 5; ++kb)
#pragma unroll
      for (int i = 0; i < 16; ++i) { const float pe = __expf(st[kb][i] - m); st[kb][i] = pe; l += pe; }
    l += __shfl_xor(l, 32, 64);
    f32x16 o0 = (f32x16){0.f, 0.f, 0.f, 0.f, 0.f, 0.f, 0.f, 0.f, 0.f, 0.f, 0.f, 0.f, 0.f, 0.f, 0.f, 0.f};
    f32x16 o1 = o0;
#pragma unroll
    for (int kb = 0; kb < 5; ++kb)
#pragma unroll
      for (int s = 0; s < 2; ++s) {
        union { unsigned u[4]; bf16x8 v; } pa;
        pa.u[0] = cvtpk(st[kb][8 * s + 0], st[kb][8 * s + 1]); pa.u[1] = cvtpk(st[kb][8 * s + 2], st[kb][8 * s + 3]);
        pa.u[2] = cvtpk(st[kb][8 * s + 4], st[kb][8 * s + 5]); pa.u[3] = cvtpk(st[kb][8 * s + 6], st[kb][8 * s + 7]);
        const int key0 = 32 * (wid + kb) + 16 * s + 4 * hi;
        {
          union { uint2 u[2]; bf16x8 v; } vb;
          vb.u[0] = *(const uint2*)(VT + vt_off(l31, key0)); vb.u[1] = *(const uint2*)(VT + vt_off(l31, key0 + 8));
          o0 = __builtin_amdgcn_mfma_f32_32x32x16_bf16(pa.v, vb.v, o0, 0, 0, 0);
        }
        {
          union { uint2 u[2]; bf16x8 v; } vb;
          vb.u[0] = *(const uint2*)(VT + vt_off(32 + l31, key0)); vb.u[1] = *(const uint2*)(VT + vt_off(32 + l31, key0 + 8));
          o1 = __builtin_amdgcn_mfma_f32_32x32x16_bf16(pa.v, vb.v, o1, 0, 0, 0);
        }
      }
    if (hi == 0) {
      linv_s[wid * 32 + l31] = 1.f / l;
      LSE[((size_t)pp * T_TOK + tq) * 8 + h] = m + __logf(l);
    }
#pragma unroll
    for (int i = 0; i < 16; ++i) {
      const int qrel = (i & 3) + 8 * (i >> 2) + 4 * hi;
      const int iq2 = n * 128 + wid * 32 + qrel;
      const int tq2 = tb + (iq2 << dsh) + r;
      const float li = linv_s[wid * 32 + qrel];
      bf16_t* op = OP + ((size_t)pp * T_TOK + tq2) * 512 + h * 64 + l31;
      op[0] = f2bf(o0[i] * li);
      op[32] = f2bf(o1[i] * li);
    }
  }
}

__device__ __forceinline__ void phase_convert(const Params& p, char* smem) {
  int* ctl = (int*)(p.ws + OFF_CTL);
  int* slot = (int*)(smem + 66304);
  HSYNC();
  constexpr int NATT = 6144, NGATE = 1024, NTOT = NATT + NGATE;
  for (;;) {
    if (VTID == 0) *slot = atomicAdd(&ctl[CTL_CONVQ], 1);
    HSYNC();
    const int ti = *slot;
    HSYNC();
    if (ti >= NTOT) break;
    if (ti < NATT) attn_item(p, smem, ti);
    else prep_item<2>(p, smem, ((ti - NATT) >> 2) * 128, ((ti - NATT) & 3) * 128);
    __builtin_amdgcn_sched_barrier(0);
  }
}

__device__ __forceinline__ void unpack8(const uint4 u, float (&f)[8]) {
  f[0] = __uint_as_float(u.x << 16); f[1] = __uint_as_float(u.x & 0xffff0000u); f[2] = __uint_as_float(u.y << 16); f[3] = __uint_as_float(u.y & 0xffff0000u);
  f[4] = __uint_as_float(u.z << 16); f[5] = __uint_as_float(u.z & 0xffff0000u); f[6] = __uint_as_float(u.w << 16); f[7] = __uint_as_float(u.w & 0xffff0000u);
}
__device__ __forceinline__ float dpp_sum8(float v) {
  v += DPP_F(v, 0xB1); v += DPP_F(v, 0x4E); v += DPP_F(v, 0x141);
  return v;
}
__device__ __forceinline__ void phase_post(const Params& p) {
  const bf16_t* __restrict__ YS = (const bf16_t*)(p.ws + OFF_YS); const bf16_t* __restrict__ V2 = (const bf16_t*)(p.ws + OFF_V2);
  const bf16_t* __restrict__ G = (const bf16_t*)(p.ws + OFF_G); const float* __restrict__ SB = (const float*)(p.ws + OFF_SB);
  const bf16_t* __restrict__ OP = (const bf16_t*)(p.ws + OFF_OP); const float* __restrict__ LSE = (const float*)(p.ws + OFF_LSE);
  const float* __restrict__ lnx_g = p.in[11]; const float* __restrict__ lnx_b = p.in[12];
  unsigned char* MIXED = (unsigned char*)(p.ws + OFF_MIXED);
  const int lane = VTID & 63, wid = VTID >> 6;
  const int c = lane * 8, hh = lane >> 3;
  const float4 g0 = *(const float4*)(lnx_g + c), g1 = *(const float4*)(lnx_g + c + 4), b0 = *(const float4*)(lnx_b + c), b1 = *(const float4*)(lnx_b + c + 4);
  const float gg[8] = {g0.x, g0.y, g0.z, g0.w, g1.x, g1.y, g1.z, g1.w}, bb[8] = {b0.x, b0.y, b0.z, b0.w, b1.x, b1.y, b1.z, b1.w};
  for (int t = VBID * 4 + wid; t < T_TOK; t += VGRID * 4) {
    const size_t o = (size_t)t * 512 + c;
    float y[8];
    unpack8(*(const uint4*)(YS + o), y);
    float s = 0.f;
#pragma unroll
    for (int i = 0; i < 8; ++i) s += y[i];
    const float mean = dpp_sum8(s) * (1.f / 64.f);
    float q = 0.f;
#pragma unroll
    for (int i = 0; i < 8; ++i) { const float d = y[i] - mean; q += d * d; }
    const float rs = rsqrtf(dpp_sum8(q) * (1.f / 64.f) + GN_EPS_F);
    float v2[8], gt[8];
    unpack8(*(const uint4*)(V2 + o), v2); unpack8(*(const uint4*)(G + o), gt);
    const float sb = SB[(size_t)t * 8 + hh];
    float res[8];
#pragma unroll
    for (int i = 0; i < 8; ++i) res[i] = ((y[i] - mean) * rs * gg[i] + bb[i] + sb * v2[i]) * gt[i];
    uint2 w; w.x = pk4_fp8c(X_SCALE * res[0], X_SCALE * res[1], X_SCALE * res[2], X_SCALE * res[3]); w.y = pk4_fp8c(X_SCALE * res[4], X_SCALE * res[5], X_SCALE * res[6], X_SCALE * res[7]);
    *(uint2*)(MIXED + (size_t)t * 1024 + 512 + c) = w;
    const float l0 = LSE[((size_t)0 * T_TOK + t) * 8 + hh], l1 = LSE[((size_t)1 * T_TOK + t) * 8 + hh], l2 = LSE[((size_t)2 * T_TOK + t) * 8 + hh];
    const float mx = fmaxf(l0, fmaxf(l1, l2));
    float e0 = __expf(l0 - mx), e1 = __expf(l1 - mx), e2 = __expf(l2 - mx);
    const float inv = 1.f / (e0 + e1 + e2);
    e0 *= inv; e1 *= inv; e2 *= inv;
    float o0[8], o1[8], o2[8];
    unpack8(*(const uint4*)(OP + (size_t)0 * T_TOK * 512 + o), o0); unpack8(*(const uint4*)(OP + (size_t)1 * T_TOK * 512 + o), o1);
    unpack8(*(const uint4*)(OP + (size_t)2 * T_TOK * 512 + o), o2);
    float av[8];
#pragma unroll
    for (int i = 0; i < 8; ++i) av[i] = e0 * o0[i] + e1 * o1[i] + e2 * o2[i];
    w.x = pk4_fp8c(X_SCALE * av[0], X_SCALE * av[1], X_SCALE * av[2], X_SCALE * av[3]); w.y = pk4_fp8c(X_SCALE * av[4], X_SCALE * av[5], X_SCALE * av[6], X_SCALE * av[7]);
    *(uint2*)(MIXED + (size_t)t * 1024 + c) = w;
  }
}

struct EpiOutproj {
  static constexpr bool PERM = true, AFTER_DRAIN = false;
  const float* x; bf16_t* U;
  __device__ __forceinline__ void operator()(const pg8::f32x4 (&acc)[2][2][4][2], const pg8::Unit& u, int wr, int wc, int fr, int fq) const {
#pragma unroll
    for (int ai = 0; ai < 2; ++ai)
#pragma unroll
      for (int m = 0; m < 4; ++m) {
        const int t = u.pm * 256 + ai * 128 + wr * 64 + m * 16 + fr;
#pragma unroll
        for (int bj = 0; bj < 2; ++bj) {
          const size_t o = (size_t)t * DM + u.pn * 256 + bj * 128 + wc * 32 + 8 * fq;
          const float4 x0 = *(const float4*)(x + o), x1 = *(const float4*)(x + o + 4);
          const pg8::f32x4 v0 = acc[ai][bj][m][0] * MOE1_UNSCALE, v1 = acc[ai][bj][m][1] * MOE1_UNSCALE;
          uint4 w;
          w.x = cvtpk(ALPHA_F * x0.x + v0[0], ALPHA_F * x0.y + v0[1]); w.y = cvtpk(ALPHA_F * x0.z + v0[2], ALPHA_F * x0.w + v0[3]);
          w.z = cvtpk(ALPHA_F * x1.x + v1[0], ALPHA_F * x1.y + v1[1]); w.w = cvtpk(ALPHA_F * x1.z + v1[2], ALPHA_F * x1.w + v1[3]);
          *(uint4*)(U + o) = w;
        }
      }
  }
};
__device__ __forceinline__ void phase_outproj(const Params& p, char* smem_all) {
  pg8::Gemm g{(const pg8::bf16_t*)(p.ws + OFF_MIXED), (const pg8::bf16_t*)(p.ws + OFF_WOUTT), T_TOK, DM, DM / 2};
  pg8::StaticOrder S; S.init(T_TOK, DM, (int)gridDim.x, (int)blockIdx.x);
  EpiOutproj E{p.in[0], (bf16_t*)p.out};
  pg8::gemm_phase<EpiOutproj, pg8::StaticOrder, true, true, false, true>((PG8_LAS unsigned char*)smem_all, g, S, E);
}

__device__ __forceinline__ void phase_ln1(const Params& p) {
  const bf16_t* __restrict__ U = (const bf16_t*)p.out;
  const float* __restrict__ g1 = p.in[14]; const float* __restrict__ b1 = p.in[15];
  bf16_t* X1B = (bf16_t*)(p.ws + OFF_X1B);
  unsigned char* X1F8 = (unsigned char*)(p.ws + OFF_X1F8);
  const int lane = VTID & 63, wid = VTID >> 6;
  for (int t = VBID * 4 + wid; t < T_TOK; t += VGRID * 4) {
    const size_t base = (size_t)t * DM;
    float4 v[4];
    float s = 0.f;
#pragma unroll
    for (int u = 0; u < 4; ++u) { v[u] = bf4_to_f4(*(const uint2*)(U + base + u * 256 + lane * 4)); s += (v[u].x + v[u].y) + (v[u].z + v[u].w); }
    const float mean = wave_sum_fast(s) * (1.f / DM);
    float q = 0.f;
#pragma unroll
    for (int u = 0; u < 4; ++u) {
      const float d0 = v[u].x - mean, d1 = v[u].y - mean, d2 = v[u].z - mean, d3 = v[u].w - mean;
      q += (d0 * d0 + d1 * d1) + (d2 * d2 + d3 * d3);
    }
    const float rs = rsqrtf(wave_sum_fast(q) * (1.f / DM) + LN_EPS_F);
#pragma unroll
    for (int u = 0; u < 4; ++u) {
      const int c = u * 256 + lane * 4;
      const float4 g = *(const float4*)(g1 + c), bb = *(const float4*)(b1 + c);
      float4 y;
      y.x = (v[u].x - mean) * rs * g.x + bb.x; y.y = (v[u].y - mean) * rs * g.y + bb.y;
      y.z = (v[u].z - mean) * rs * g.z + bb.z; y.w = (v[u].w - mean) * rs * g.w + bb.w;
      uint2 hi; hi.x = cvtpk(y.x, y.y); hi.y = cvtpk(y.z, y.w);
      *(uint2*)(X1B + base + c) = hi;
      *(unsigned*)(X1F8 + base + c) = pk4_fp8c(X_SCALE * y.x, X_SCALE * y.y, X_SCALE * y.z, X_SCALE * y.w);
    }
  }
}

__device__ __forceinline__ void phase_router_gemm(const Params& p, char* smem) {
  const bf16_t* __restrict__ X1B = (const bf16_t*)(p.ws + OFF_X1B);
  const float* __restrict__ router_w = p.in[16];
  float* AFF = (float*)(p.ws + OFF_AFF);
  for (int item = VBID; item < (T_TOK / 128) * 2; item += VGRID) {
    const int row0 = (item >> 1) * 128, col0 = (item & 1) * 128;
    f32x4 acc[4][4];
    acc_zero(acc);
    gemm128_acc<0, false>(acc, smem, 16,
        [=](int, int rowl, int kc) { return *(const uint4*)(X1B + (size_t)(row0 + rowl) * DM + kc * 8); },
        [=](int nq) { return router_w + col0 + nq * 4; }, NEXP, 0);
    int tid_l_ = VTID; asm volatile("" : "+v"(tid_l_)); const int tid = tid_l_, lane = tid & 63, wid = tid >> 6;
    const int wr = wid >> 1, wc = wid & 1, fr = lane & 15, fq = lane >> 4;
#pragma unroll
    for (int m = 0; m < 4; ++m) {
      const int t = row0 + wr * 64 + m * 16 + fr;
#pragma unroll
      for (int n = 0; n < 4; ++n)
        *(float4*)(AFF + (size_t)t * NEXP + col0 + wc * 64 + n * 16 + fq * 4) =
            make_float4(sigmoidf_(acc[m][n][0]), sigmoidf_(acc[m][n][1]), sigmoidf_(acc[m][n][2]), sigmoidf_(acc[m][n][3]));
    }
  }
}

__device__ __forceinline__ void phase_topk(const Params& p, char* smem) {
  const float* __restrict__ AFF = (const float*)(p.ws + OFF_AFF);
  const float* __restrict__ router_bias = p.in[17];
  int* LIST = (int*)(p.ws + OFF_LIST); float* GATEW = (float*)(p.ws + OFF_GATEW);
  int* counts = (int*)(p.ws + OFF_CTL);
  const int lane = VTID & 63, wid = VTID >> 6;
  const float4 b4 = *(const float4*)(router_bias + lane * 4);
  const int t0 = VBID * 4 + wid, tstep = VGRID * 4;
  float4 a4n = make_float4(0.f, 0.f, 0.f, 0.f);
  if (t0 < T_TOK) a4n = *(const float4*)(AFF + (size_t)t0 * NEXP + lane * 4);
  int pend_e = 0, pend_pos = LCAP, pend_t = 0;
  const int nround = (T_TOK + tstep - 1) / tstep, npp = (CONV_TILES / 2) / VGRID;
  int cvdone = 0;
  for (int t = t0, kr = 0; kr < nround; t += tstep, ++kr) {
    if (t < T_TOK) {
    const float4 a4 = a4n;
    if (t + tstep < T_TOK) a4n = *(const float4*)(AFF + (size_t)(t + tstep) * NEXP + lane * 4);
    float s0 = a4.x + b4.x, s1 = a4.y + b4.y, s2 = a4.z + b4.z, s3 = a4.w + b4.w;
    const float hi01 = fmaxf(s0, s1), lo01 = fminf(s0, s1), hi23 = fmaxf(s2, s3), lo23 = fminf(s2, s3);
    float m1 = fmaxf(hi01, hi23), m2 = fmaxf(fminf(hi01, hi23), fmaxf(lo01, lo23));
    { const float o1 = DPP_F(m1, 0xB1), o2 = DPP_F(m2, 0xB1); const float n1 = fmaxf(m1, o1); m2 = fmaxf(fminf(m1, o1), fmaxf(m2, o2)); m1 = n1; }
    { const float o1 = DPP_F(m1, 0x4E), o2 = DPP_F(m2, 0x4E); const float n1 = fmaxf(m1, o1); m2 = fmaxf(fminf(m1, o1), fmaxf(m2, o2)); m1 = n1; }
    { const float o1 = DPP_F(m1, 0x141), o2 = DPP_F(m2, 0x141); const float n1 = fmaxf(m1, o1); m2 = fmaxf(fminf(m1, o1), fmaxf(m2, o2)); m1 = n1; }
    const float gs = m1 + m2;
    const int g = lane >> 3;
    int rank = 0;
#pragma unroll
    for (int gg = 0; gg < 8; ++gg) { const float G = rdlane_f(gs, gg * 8); rank += ((G > gs) || (G == gs && gg < g)) ? 1 : 0; }
    if (rank >= 4) { s0 = -INFINITY; s1 = -INFINITY; s2 = -INFINITY; s3 = -INFINITY; }
    int my_e = 0; float my_a = 0.f;
#pragma unroll 1
    for (int it = 0; it < 8; ++it) {
      const float lm = fmaxf(fmaxf(s0, s1), fmaxf(s2, s3));
      const float wm = wave_max_fast(lm);
      const unsigned long long bal = __ballot(lm == wm);
      const int win = __ffsll((long long)bal) - 1;
      const int wi = (s0 == wm) ? 0 : ((s1 == wm) ? 1 : ((s2 == wm) ? 2 : 3));
      const float wa = (wi == 0) ? a4.x : ((wi == 1) ? a4.y : ((wi == 2) ? a4.z : a4.w));
      const int e_w = __builtin_amdgcn_readlane(lane * 4 + wi, win);
      const float a_w = rdlane_f(wa, win);
      if (lane == win) { if (wi == 0) s0 = -INFINITY; else if (wi == 1) s1 = -INFINITY; else if (wi == 2) s2 = -INFINITY; else s3 = -INFINITY; }
      if (lane == it) { my_e = e_w; my_a = a_w; }
    }
    const float asum = rdlane_f(dpp_sum16x(my_a), 0);
    __builtin_amdgcn_sched_barrier(0);
    if (lane < 8) {
      if (pend_pos < LCAP) LIST[(size_t)pend_e * LCAP + pend_pos] = lane * T_TOK + pend_t;
      pend_pos = atomicAdd(&counts[CNT(my_e)], 1); pend_e = my_e; pend_t = t;
      GATEW[(size_t)lane * T_TOK + t] = my_a * 2.5f / asum;
    }
    }
    const int cvto = (kr + 1) * npp / nround;
    for (; cvdone < cvto; ++cvdone) convert_tile2(p, smem, VBID * npp + cvdone);
  }
  if (lane < 8 && pend_pos < LCAP) LIST[(size_t)pend_e * LCAP + pend_pos] = lane * T_TOK + pend_t;
  { const int rem = npp * VGRID + VBID; if (rem < CONV_TILES / 2) convert_tile2(p, smem, rem); }
}

#define CTL_MOEPRE 1536
struct SeqOrder {
  int n;
  __device__ __forceinline__ bool next(int i, pg8::Unit& u) const { if (i >= n) return false; u.pm = 0; u.pn = i; return true; }
  __device__ __forceinline__ void a_ready(const pg8::Unit&) const {}
  __device__ __forceinline__ void done(const pg8::Unit&) const {}
};
struct EpiMoe1 {
  static constexpr bool PERM = true, AFTER_DRAIN = false;
  bf16_t* HS;
  __device__ __forceinline__ void operator()(const pg8::f32x4 (&acc)[2][2][4][2], const pg8::Unit& u, int wr, int wc, int fr, int fq) const {
#pragma unroll
    for (int ai = 0; ai < 2; ++ai)
#pragma unroll
      for (int m = 0; m < 4; ++m) {
        __builtin_amdgcn_sched_barrier(0);
        const int row = ai * 128 + wr * 64 + m * 16 + fr;
        const pg8::f32x4 g0 = acc[ai][0][m][0] * MOE1_UNSCALE, g1 = acc[ai][0][m][1] * MOE1_UNSCALE, u0 = acc[ai][1][m][0] * MOE1_UNSCALE, u1 = acc[ai][1][m][1] * MOE1_UNSCALE;
        uint2 w;
        w.x = pk4_fp8c(H_SCALE * g0[0] * sigmoidf_(g0[0]) * u0[0], H_SCALE * g0[1] * sigmoidf_(g0[1]) * u0[1], H_SCALE * g0[2] * sigmoidf_(g0[2]) * u0[2], H_SCALE * g0[3] * sigmoidf_(g0[3]) * u0[3]);
        w.y = pk4_fp8c(H_SCALE * g1[0] * sigmoidf_(g1[0]) * u1[0], H_SCALE * g1[1] * sigmoidf_(g1[1]) * u1[1], H_SCALE * g1[2] * sigmoidf_(g1[2]) * u1[2], H_SCALE * g1[3] * sigmoidf_(g1[3]) * u1[3]);
        *(uint2*)((char*)HS + (size_t)row * 256 + u.pn * 128 + wc * 32 + 8 * fq) = w;
      }
  }
};
struct EpiMoe2 {
  static constexpr bool PERM = true, AFTER_DRAIN = false;
  const int* asg; bf16_t* Y;
  __device__ __forceinline__ void operator()(const pg8::f32x4 (&acc)[2][2][4][2], const pg8::Unit& u, int wr, int wc, int fr, int fq) const {
#pragma unroll
    for (int ai = 0; ai < 2; ++ai)
#pragma unroll
      for (int m = 0; m < 4; ++m) {
        __builtin_amdgcn_sched_barrier(0);
        const int a = asg[256 + ai * 128 + wr * 64 + m * 16 + fr];
        if (a < 0) continue;
        {
          const float gw = __int_as_float(asg[512 + ai * 128 + wr * 64 + m * 16 + fr]) * (Y_SCALE * MOE2_UNSCALE);
#pragma unroll
          for (int bj = 0; bj < 2; ++bj) {
            const pg8::f32x4 v0 = acc[ai][bj][m][0], v1 = acc[ai][bj][m][1];
            uint2 w; w.x = pk4_fp8c(v0[0] * gw, v0[1] * gw, v0[2] * gw, v0[3] * gw); w.y = pk4_fp8c(v1[0] * gw, v1[1] * gw, v1[2] * gw, v1[3] * gw);
            *(uint2*)((unsigned char*)Y + (size_t)a * DM + u.pn * 256 + bj * 128 + wc * 32 + 8 * fq) = w;
          }
        }
      }
  }
};
#define MOE_TAB_OFF (WG_LDS_OFF + 128 + 1152)
__device__ __forceinline__ unsigned xb_xcc_id();
#define CTL_MOEQ 1536
__device__ __forceinline__ void phase_moe(const Params& p, char* smem_all, int* slot) {
  int* tab = (int*)(smem_all + MOE_TAB_OFF);
  int* ctl = (int*)(p.ws + OFF_CTL);
  int* pre = (int*)(smem_all + WG_LDS_OFF + 128);
  if (threadIdx.x < 64) {
    const int l = threadIdx.x, g0 = l >> 3, i0 = (4 * l) & 31;
    const int t0 = (min(ctl[CNT((i0 + 0) * 8 + g0)], LCAP) + 255) >> 8, t1 = (min(ctl[CNT((i0 + 1) * 8 + g0)], LCAP) + 255) >> 8;
    const int t2 = (min(ctl[CNT((i0 + 2) * 8 + g0)], LCAP) + 255) >> 8, t3 = (min(ctl[CNT((i0 + 3) * 8 + g0)], LCAP) + 255) >> 8;
    const int tot = t0 + t1 + t2 + t3;
    int inc = tot;
#pragma unroll
    for (int o = 1; o < 64; o <<= 1) { const int v = __shfl_up(inc, o, 64); if (l >= o) inc += v; }
    const int base = inc - tot;
    pre[4 * l] = base; pre[4 * l + 1] = base + t0; pre[4 * l + 2] = base + t0 + t1; pre[4 * l + 3] = base + t0 + t1 + t2;
    if (l == 63) { pre[NEXP] = inc; pre[NEXP + 1] = inc + T_TOK / 256; }
  }
  if (threadIdx.x == 0) { slot[1] = (int)(xb_xcc_id() & 7u); slot[2] = 0; }
  __syncthreads();
  bf16_t* HS = (bf16_t*)(p.ws + OFF_HSCR) + (size_t)blockIdx.x * 256 * 256;
#define MOE_DRAW(CTLP) { if (threadIdx.x == 0) { \
    int g_ = slot[1], tried_ = slot[2], it_ = -1; \
    while (tried_ < 8) { \
      const int r0_ = pre[32 * g_], nr_ = pre[32 * g_ + 32] - r0_;                                   \
      const int t_ = atomicAdd(&(CTLP)[CTL_MOEQ + 32 * g_], 1); \
      if (t_ < nr_ + 16) { it_ = (t_ < nr_) ? (r0_ + t_) : (pre[NEXP] + 16 * g_ + (t_ - nr_)); break; } \
      g_ = (g_ + 1) & 7; ++tried_; \
    } \
    slot[0] = it_; slot[1] = g_; slot[2] = tried_; } }
#define MOE_FETCH(i_, e_, a_, LISTP, CNTP) { \
    e_ = 0; a_ = -1; \
    if ((i_) >= 0) { \
      int lo = 0, hi = NEXP;                               \
      while (lo < hi) { const int mid = (lo + hi + 1) >> 1; if (pre[mid] <= (i_)) lo = mid; else hi = mid - 1; } \
      e_ = (lo < NEXP) ? ((lo & 31) * 8 + (lo >> 5)) : NEXP; \
      const int cnt_ = (e_ < NEXP) ? min((CNTP)[CNT(e_)], LCAP) : T_TOK; \
      const int r_ = ((i_) - pre[lo]) * 256 + (int)(threadIdx.x & 255); \
      a_ = (r_ < cnt_) ? ((e_ < NEXP) ? (LISTP)[(size_t)e_ * LCAP + r_] : (8 * T_TOK + r_)) : -1; \
    } }
  MOE_DRAW(ctl)
  __syncthreads();
  int i = *slot, e, a;
  { const int* __restrict__ LIST0 = (const int*)(p.ws + OFF_LIST); const int* counts0 = (const int*)(p.ws + OFF_CTL); MOE_FETCH(i, e, a, LIST0, counts0) }
  for (;;) {
    if (i < 0) break;
    const __attribute__((address_space(4))) char* ka_ = (const __attribute__((address_space(4))) char*)__builtin_amdgcn_kernarg_segment_ptr();
    asm volatile("" : "+s"(ka_));
    char* const wsl = *(char* const __attribute__((address_space(4)))*)(ka_ + __builtin_offsetof(Params, ws));
    const int* __restrict__ LISTl = (const int*)(wsl + OFF_LIST); const int* countsl = (const int*)(wsl + OFF_CTL); const float* __restrict__ GATEWl = (const float*)(wsl + OFF_GATEW);
    __syncthreads();
    if (threadIdx.x < 256) {
      tab[256 + threadIdx.x] = a;
      tab[threadIdx.x] = (a >= 0 ? a : 0) & (T_TOK - 1);
      tab[512 + threadIdx.x] = __float_as_int((a >= 0 && a < 8 * T_TOK) ? GATEWl[a] : 1.f);
    }
    __syncthreads();
    {
      int k1 = DM / 2; asm volatile("" : "+s"(k1));
      pg8::Gemm g{(const pg8::bf16_t*)(wsl + OFF_X1F8), (const pg8::bf16_t*)(wsl + OFF_EW1 + (size_t)e * 512 * 1024), 256, 512, k1};
      SeqOrder S{2};
      EpiMoe1 E{HS};
      pg8::gemm_phase<EpiMoe1, SeqOrder, true, true, true, true>((PG8_LAS unsigned char*)smem_all, g, S, E, tab);
    }
    const int e_cur = e;
    MOE_DRAW((int*)(wsl + OFF_CTL))
    __syncthreads();
    i = *slot;
    MOE_FETCH(i, e, a, LISTl, countsl)
    {
      int k2 = 128; asm volatile("" : "+s"(k2));
      pg8::Gemm g{(const pg8::bf16_t*)HS, (const pg8::bf16_t*)(wsl + OFF_EW2 + (size_t)e_cur * 1024 * 256), 256, DM, k2};
      SeqOrder S{4};
      EpiMoe2 E{tab, (bf16_t*)(wsl + OFF_Y)};
      pg8::gemm_phase<EpiMoe2, SeqOrder, true, true, false, true>((PG8_LAS unsigned char*)smem_all, g, S, E);
    }
  }
#undef MOE_FETCH
#undef MOE_DRAW
}

__device__ __forceinline__ void phase_final(const Params& p, char* smem) {
  float* OUT = p.out;
  const unsigned char* __restrict__ Y = (const unsigned char*)(p.ws + OFF_Y);
  const bf16_t* __restrict__ X1B = (const bf16_t*)(p.ws + OFF_X1B);
  const float* __restrict__ g2 = p.in[24]; const float* __restrict__ b2 = p.in[25];
  const int lane = VTID & 63, wid = VTID >> 6;
  for (int t = VBID * 4 + wid; t < T_TOK; t += VGRID * 4) {
    const size_t base = (size_t)t * DM;
    float4 v[4];
    float s = 0.f;
#pragma unroll
    for (int u = 0; u < 2; ++u) {
      const int c = u * 512 + lane * 8;
      float xf[8];
      unpack8(*(const uint4*)(X1B + base + c), xf);
      float a0 = 0.f, a1 = 0.f, a2 = 0.f, a3 = 0.f, a4 = 0.f, a5 = 0.f, a6 = 0.f, a7 = 0.f;
#pragma unroll
      for (int sl = 0; sl < 9; ++sl) {
        const uint2 yw = *(const uint2*)(Y + ((size_t)sl * T_TOK + t) * DM + c);
        const f32x2_t y01 = __builtin_amdgcn_cvt_pk_f32_fp8((int)yw.x, false), y23 = __builtin_amdgcn_cvt_pk_f32_fp8((int)yw.x, true);
        const f32x2_t y45 = __builtin_amdgcn_cvt_pk_f32_fp8((int)yw.y, false), y67 = __builtin_amdgcn_cvt_pk_f32_fp8((int)yw.y, true);
        a0 += y01[0]; a1 += y01[1]; a2 += y23[0]; a3 += y23[1]; a4 += y45[0]; a5 += y45[1]; a6 += y67[0]; a7 += y67[1];
      }
      const float iy = 1.f / Y_SCALE;
      v[2 * u] = make_float4(ALPHA_F * xf[0] + iy * a0, ALPHA_F * xf[1] + iy * a1, ALPHA_F * xf[2] + iy * a2, ALPHA_F * xf[3] + iy * a3);
      v[2 * u + 1] = make_float4(ALPHA_F * xf[4] + iy * a4, ALPHA_F * xf[5] + iy * a5, ALPHA_F * xf[6] + iy * a6, ALPHA_F * xf[7] + iy * a7);
      s += ((v[2 * u].x + v[2 * u].y) + (v[2 * u].z + v[2 * u].w)) + ((v[2 * u + 1].x + v[2 * u + 1].y) + (v[2 * u + 1].z + v[2 * u + 1].w));
    }
    const float mean = wave_sum_fast(s) * (1.f / DM);
    float q = 0.f;
#pragma unroll
    for (int u = 0; u < 4; ++u) {
      const float d0 = v[u].x - mean, d1 = v[u].y - mean, d2 = v[u].z - mean, d3 = v[u].w - mean;
      q += (d0 * d0 + d1 * d1) + (d2 * d2 + d3 * d3);
    }
    const float rs = rsqrtf(wave_sum_fast(q) * (1.f / DM) + LN_EPS_F);
#pragma unroll
    for (int u = 0; u < 4; ++u) {
      const int c = (u >> 1) * 512 + lane * 8 + (u & 1) * 4;
      const float4 g = *(const float4*)(g2 + c), bb = *(const float4*)(b2 + c);
      *(float4*)(OUT + base + c) = make_float4((v[u].x - mean) * rs * g.x + bb.x, (v[u].y - mean) * rs * g.y + bb.y,
                                               (v[u].z - mean) * rs * g.z + bb.z, (v[u].w - mean) * rs * g.w + bb.w);
    }
  }
}

#define LAS __attribute__((address_space(3)))
#define XB_TMO      128
#define XB_XCNT(j)  (256  + 64 * (j))
#define XB_XSUB(j)  (1280 + 64 * (j))
#define XB_XGEN(j)  (2304 + 64 * (j))
#define XB_TOP      3328
#define XB_TOPGEN   3392
#define XCD_BAR_WORDS 3456
#define XB_SPIN_CAP (1u << 22)
__device__ __forceinline__ unsigned xb_ld(unsigned* p)              { return __hip_atomic_load(p, __ATOMIC_RELAXED, __HIP_MEMORY_SCOPE_AGENT); }
__device__ __forceinline__ unsigned xb_add(unsigned* p, unsigned v) { return __hip_atomic_fetch_add(p, v, __ATOMIC_RELAXED, __HIP_MEMORY_SCOPE_AGENT); }
__device__ __forceinline__ unsigned xb_xcc_id() { return (unsigned)__builtin_amdgcn_s_getreg((3 << 11) | 20) & 0xFu; }
#define XB_SPIN(cond, bar) do { unsigned _sp = 0; while (cond) { __builtin_amdgcn_s_sleep(1); \
    if ((++_sp & 255u) == 0u) { if (xb_ld(&(bar)[XB_TMO])) break; if (_sp > XB_SPIN_CAP) { atomicAdd(&(bar)[XB_TMO], 1u); break; } } } } while (0)
struct XcdBarrier { unsigned* bar; unsigned x; volatile LAS unsigned* st; };
__device__ __forceinline__ XcdBarrier xcd_barrier_post(unsigned* bar, volatile LAS unsigned* st) {
  XcdBarrier b; b.bar = bar; b.x = xb_xcc_id(); b.st = st;
  if (threadIdx.x == 0) (void)xb_add(&bar[XB_XCNT(b.x)], 1u);
  return b;
}
__device__ __forceinline__ void xcd_barrier_complete(unsigned* bar, unsigned x, unsigned& nloc, unsigned& nx) {
  const unsigned G = gridDim.x * gridDim.y * gridDim.z;
  unsigned sum, cnt, mine, sp = 0u;
  for (;;) {
    sum = 0u; cnt = 0u; mine = 0u;
#pragma unroll
    for (unsigned j = 0; j < 16; ++j) { const unsigned c = xb_ld(&bar[XB_XCNT(j)]); sum += c; cnt += (c > 0u) ? 1u : 0u; mine = (j == x) ? c : mine; }
    if (sum == G) break;
    __builtin_amdgcn_s_sleep(1);
    if ((++sp & 255u) == 0u) { if (xb_ld(&bar[XB_TMO])) break; if (sp > XB_SPIN_CAP) { atomicAdd(&bar[XB_TMO], 1u); break; } }
  }
  nloc = mine > 0u ? mine : 1u; nx = cnt > 0u ? cnt : 1u;
}
__device__ __forceinline__ void xcd_barrier(const XcdBarrier& b) {
  asm volatile("s_waitcnt vmcnt(0)" ::: "memory");
  __syncthreads();
  if (threadIdx.x == 0) {
    unsigned* bar = b.bar;
    __builtin_amdgcn_s_waitcnt(0);
    unsigned nloc = b.st[0], nx = b.st[1];
    if (nloc == 0u) { xcd_barrier_complete(bar, b.x, nloc, nx); b.st[0] = nloc; b.st[1] = nx; }
    const unsigned old = xb_add(&bar[XB_XSUB(b.x)], 1u);
    const unsigned gen = old / nloc;
    if (old + 1u == (gen + 1u) * nloc) {
      __builtin_amdgcn_fence(__ATOMIC_RELEASE, "agent");
      asm volatile("s_waitcnt vmcnt(0)" ::: "memory");
      const unsigned og = xb_add(&bar[XB_TOP], 1u);
      const unsigned tg = og / nx;
      if (og + 1u == (tg + 1u) * nx) xb_add(&bar[XB_TOPGEN], 1u);
      else XB_SPIN(xb_ld(&bar[XB_TOPGEN]) == tg, bar);
      __builtin_amdgcn_fence(__ATOMIC_ACQUIRE, "agent");
      xb_add(&bar[XB_XGEN(b.x)], 1u);
      asm volatile("s_waitcnt vmcnt(0)" ::: "memory");
    } else {
      XB_SPIN(xb_ld(&bar[XB_XGEN(b.x)]) == gen, bar);
      __builtin_amdgcn_fence(__ATOMIC_ACQUIRE, "agent");
      asm volatile("s_waitcnt vmcnt(0)" ::: "memory");
    }
  }
  __syncthreads();
}
#define CTL_BAR_WORD 4096
#define CTL_ZERO_BYTES 65536
#define LDS_BAR_OFF 66432

#define LDS_TOTAL (2 * HALF_LDS + 128 + 1152 + 3072)
__global__ void __launch_bounds__(512, 2) mega(Params p) {
  extern __shared__ __attribute__((aligned(16))) char smem_all[];
  cg::grid_group grid = cg::this_grid();
  char* const smem = smem_all + VHALF * HALF_LDS;
  volatile LAS unsigned* bst = (volatile LAS unsigned*)(LAS char*)(smem_all + WG_LDS_OFF);
  int* const slot = (int*)(smem_all + WG_LDS_OFF + 16);
  if (threadIdx.x < 2) { bst[threadIdx.x] = 0u; ((int*)(smem_all + WG_LDS_OFF + 32))[threadIdx.x] = 0; }
  __syncthreads();
  const XcdBarrier bar = xcd_barrier_post((unsigned*)(p.ws + OFF_CTL) + CTL_BAR_WORD, bst);
  phase_rope(p);
  if (p.ws == nullptr) grid.sync();
  xcd_barrier(bar);
  phase_inproj(p, smem_all);
  xcd_barrier(bar);
  phase_prep_a(p);
  xcd_barrier(bar);
  phase_prep(p, smem);
  xcd_barrier(bar);
  phase_chunk_pre(p, smem);
  xcd_barrier(bar);
  phase_seq(p);
  phase_convert(p, smem);
  xcd_barrier(bar);
  phase_post(p);
  xcd_barrier(bar);
  phase_outproj(p, smem_all);
  xcd_barrier(bar);
  phase_ln1(p);
  xcd_barrier(bar);
  phase_router_gemm(p, smem);
  xcd_barrier(bar);
  phase_topk(p, smem);
  xcd_barrier(bar);
  phase_moe(p, smem_all, slot);
  xcd_barrier(bar);
  phase_final(p, smem);
}

extern "C" void kernel_launch(void* const* d_in, const int* in_sizes, int n_in, void* d_out, int out_size, void* d_ws, size_t ws_size,
                              hipStream_t stream) {
  static int grid_blocks = 0;
  if (grid_blocks == 0) {
    if (ws_size < WS_NEED || n_in != 26) { fprintf(stderr, "kernel_launch: bad ws/n_in: %zu < %zu, n_in %d\n", ws_size, (size_t)WS_NEED, n_in); grid_blocks = -1; return; }
    int dev = 0, cus = 0, per_cu = 0;
    (void)hipGetDevice(&dev);
    (void)hipDeviceGetAttribute(&cus, hipDeviceAttributeMultiprocessorCount, dev);
    (void)hipFuncSetAttribute((const void*)mega, hipFuncAttributeMaxDynamicSharedMemorySize, LDS_TOTAL);
    (void)hipOccupancyMaxActiveBlocksPerMultiprocessor(&per_cu, (const void*)mega, 512, LDS_TOTAL);
    if (per_cu < 1) { fprintf(stderr, "kernel_launch: occupancy query returned %d\n", per_cu); grid_blocks = -1; return; }
    if (per_cu > 1) per_cu = 1;
    grid_blocks = cus * per_cu;
    if (grid_blocks > 256) grid_blocks = 256;
    fprintf(stderr, "kernel_launch: cus %d per_cu %d grid %d\n", cus, per_cu, grid_blocks);
  }
  if (grid_blocks < 0) return;
  if (hipMemsetAsync((char*)d_ws + OFF_CTL, 0, CTL_ZERO_BYTES, stream) != hipSuccess) { fprintf(stderr, "kernel_launch: memset failed\n"); return; }
  Params p{};
  for (int i = 0; i < 26; ++i) p.in[i] = (const float*)d_in[i];
  p.out = (float*)d_out;
  p.ws = (char*)d_ws;
  void* args[] = {&p};
  hipError_t e = hipLaunchCooperativeKernel((const void*)mega, dim3(grid_blocks), dim3(512), args, LDS_TOTAL, stream);
  if (e != hipSuccess) fprintf(stderr, "cooperative launch failed: %s (grid %d)\n", hipGetErrorString(e), grid_blocks);
}
```

```cpp
#include <hip/hip_runtime.h>
#include <hip/hip_bf16.h>
#include <hip/hip_cooperative_groups.h>
#include <stdint.h>
#include <stdio.h>

typedef unsigned short bf16_t;

#define T_TOK 32768
#define SEQ 4096
#define DM 1024
#define INW 3360
#define FEW 1824
#define NEXP 256
#define ALPHA_F 1.189207115002721f
#define LN_EPS_F 1e-5f
#define GN_EPS_F 64e-5f

__device__ __forceinline__ float bf2f(bf16_t v) { return __uint_as_float(((unsigned)v) << 16); }
__device__ __forceinline__ bf16_t f2bf(float f) { unsigned u = __float_as_uint(f); return (bf16_t)((u + 0x7fffu + ((u >> 16) & 1u)) >> 16); }
__device__ __forceinline__ float sigmoidf_(float x) { return 1.f / (1.f + __expf(-x)); }
__device__ __forceinline__ float wave_sum(float v) {
#pragma unroll
  for (int o = 32; o >= 1; o >>= 1) v += __shfl_xor(v, o, 64);
  return v;
}

constexpr size_t SZ_T512_BF = (size_t)T_TOK * 512 * 2;
constexpr size_t OFF_EW1 = 0;
constexpr size_t OFF_EW2 = OFF_EW1 + (size_t)257 * 512 * 1024 * 2;
constexpr size_t LBASE = OFF_EW2 + (size_t)257 * 1024 * 256 * 2;
constexpr size_t OFF_X1F8 = OFF_EW1 + (size_t)257 * 512 * 1024;
static_assert(OFF_X1F8 + (size_t)T_TOK * 1024 <= OFF_EW2, "X1F8 fits behind the fp8 EW1");
constexpr size_t OFF_XB = 0;
constexpr size_t OFF_FEATS = OFF_XB + (size_t)T_TOK * 1024 * 2;
constexpr size_t OFF_WINT = OFF_FEATS + (size_t)T_TOK * FEW * 2;
constexpr size_t OFF_ROPE = OFF_WINT + (size_t)3584 * 1024 * 2;
static_assert(OFF_ROPE + (size_t)4096 * 32 * 2 * 4 <= LBASE, "early region E overlay");
constexpr size_t OFF_Q = LBASE;
constexpr size_t OFF_K = OFF_Q + SZ_T512_BF;
constexpr size_t OFF_V = OFF_K + SZ_T512_BF;
constexpr size_t OFF_R = OFF_V + SZ_T512_BF;
constexpr size_t OFF_K2 = OFF_R + SZ_T512_BF;
constexpr size_t OFF_V2 = OFF_K2 + SZ_T512_BF;
constexpr size_t OFF_A = OFF_V2 + SZ_T512_BF;
constexpr size_t OFF_B = OFF_A + SZ_T512_BF;
constexpr size_t OFF_W = OFF_B + SZ_T512_BF;
constexpr size_t OFF_G = OFF_W + (size_t)T_TOK * 512 * 4;
constexpr size_t OFF_SB = OFF_G + SZ_T512_BF;
constexpr size_t OFF_YS = OFF_SB + (size_t)T_TOK * 8 * 4;
constexpr size_t OFF_OP = OFF_YS + (size_t)T_TOK * 512 * 4;
constexpr size_t OFF_LSE = OFF_OP + 3 * SZ_T512_BF;
constexpr size_t OFF_MIXED = OFF_LSE + (size_t)3 * T_TOK * 8 * 4;
constexpr size_t OFF_WOUTT = OFF_MIXED + (size_t)T_TOK * 1024 * 2;
constexpr size_t EARLY_END = OFF_WOUTT + (size_t)1024 * 1024 * 2;
constexpr size_t OFF_Y = LBASE;
constexpr size_t OFF_AFF = LBASE + (size_t)T_TOK * 1024 * 2;
constexpr size_t OFF_X1B = OFF_Y + (size_t)8 * T_TOK * 1024 * 2;
#define LCAP 16384
constexpr size_t OFF_LIST = OFF_X1B + (size_t)T_TOK * 1024 * 2;
constexpr size_t OFF_GATEW = OFF_LIST + (size_t)NEXP * LCAP * 4;
constexpr size_t OFF_HSCR = OFF_GATEW + (size_t)8 * T_TOK * 4;
constexpr size_t OFF_ACT = OFF_HSCR;
static_assert((size_t)T_TOK * 320 * 2 <= (size_t)512 * 128 * 256 * 2, "ACT fits the HSCR space");
constexpr size_t OFF_CTL = OFF_HSCR + (size_t)512 * 128 * 256 * 2;
constexpr size_t CTL_BYTES = 1u << 20;
constexpr size_t WS_NEED = OFF_CTL + CTL_BYTES;
static_assert(EARLY_END <= OFF_HSCR, "early buffers must stay below the per-block scratch / control words");
static_assert(WS_NEED <= (size_t)1073741824, "workspace must fit 1 GiB");
#define CTL_CONVQ 512
#define CTL_CNT 8192
#define CNT(e) (CTL_CNT + 32 * (e))

typedef short bf16x8 __attribute__((ext_vector_type(8)));
typedef float f32x4 __attribute__((ext_vector_type(4)));
typedef float f32x16 __attribute__((ext_vector_type(16)));
typedef float f32x2_t __attribute__((ext_vector_type(2)));
typedef __bf16 bf16x2_t __attribute__((ext_vector_type(2)));
__device__ __forceinline__ unsigned cvtpk(float lo, float hi) { f32x2_t v = {lo, hi}; bf16x2_t b = __builtin_convertvector(v, bf16x2_t); return __builtin_bit_cast(unsigned, b); }

__device__ __forceinline__ unsigned pk4_fp8c(float a, float b, float c, float d) {
  a = __builtin_amdgcn_fmed3f(a, -440.f, 440.f); b = __builtin_amdgcn_fmed3f(b, -440.f, 440.f);
  c = __builtin_amdgcn_fmed3f(c, -440.f, 440.f); d = __builtin_amdgcn_fmed3f(d, -440.f, 440.f);
  int v = __builtin_amdgcn_cvt_pk_fp8_f32(a, b, 0, false);
  v = __builtin_amdgcn_cvt_pk_fp8_f32(c, d, v, true);
  return (unsigned)v;
}
#define W_SCALE 256.f
#define X_SCALE 16.f
#define H_SCALE 16.f
#define MOE1_UNSCALE (1.f / (X_SCALE * W_SCALE))
#define MOE2_UNSCALE (1.f / (H_SCALE * W_SCALE))
#define Y_SCALE 32.f
__device__ const double INVF[32] = {
1, 0.74989420933245587, 0.56234132519034907, 0.42169650342858223, 0.31622776601683794, 0.23713737056616552,
0.17782794100389229, 0.1333521432163324, 0.10000000000000001, 0.074989420933245579, 0.056234132519034911,
0.042169650342858224, 0.031622776601683791, 0.023713737056616554, 0.017782794100389229, 0.013335214321633241,
0.01, 0.0074989420933245579, 0.005623413251903491, 0.0042169650342858229, 0.0031622776601683794,
0.0023713737056616554, 0.0017782794100389228, 0.0013335214321633241, 0.001, 0.00074989420933245586,
0.0005623413251903491, 0.00042169650342858224, 0.00031622776601683794, 0.00023713737056616554,
0.00017782794100389227, 0.0001333521432163324};

namespace cg = cooperative_groups;

struct Params {
  const float* in[26];
  float* out;
  char* ws;
};

#define NTHR 256
#define VTID ((int)(threadIdx.x & 255))
#define VHALF (__builtin_amdgcn_readfirstlane((int)(threadIdx.x >> 8)))
#define VBID ((int)(blockIdx.x * 2) + VHALF)
#define VGRID ((int)(gridDim.x * 2))
#define HALF_LDS 66560
extern __shared__ __attribute__((aligned(16))) char g_lds[];
#define WG_LDS_OFF (2 * HALF_LDS)
__device__ __forceinline__ void half_sync() {
  asm volatile("s_waitcnt vmcnt(0) lgkmcnt(0)" ::: "memory");
  int* cnt = (int*)(g_lds + WG_LDS_OFF + 32) + VHALF;
  if ((threadIdx.x & 63) == 0) {
    const int old = __hip_atomic_fetch_add(cnt, 1, __ATOMIC_RELAXED, __HIP_MEMORY_SCOPE_WORKGROUP);
    const int target = (old & ~3) + 4;
    while (__hip_atomic_load(cnt, __ATOMIC_RELAXED, __HIP_MEMORY_SCOPE_WORKGROUP) < target) __builtin_amdgcn_s_sleep(1);
  }
  __builtin_amdgcn_fence(__ATOMIC_ACQUIRE, "workgroup");
  asm volatile("s_waitcnt lgkmcnt(0)" ::: "memory");
}
#define HSYNC() half_sync()
__device__ __forceinline__ void half_sync_lds() {
  asm volatile("s_waitcnt lgkmcnt(0)" ::: "memory");
  int* cnt = (int*)(g_lds + WG_LDS_OFF + 32) + VHALF;
  if ((threadIdx.x & 63) == 0) {
    const int old = __hip_atomic_fetch_add(cnt, 1, __ATOMIC_RELAXED, __HIP_MEMORY_SCOPE_WORKGROUP);
    const int target = (old & ~3) + 4;
    while (__hip_atomic_load(cnt, __ATOMIC_RELAXED, __HIP_MEMORY_SCOPE_WORKGROUP) < target) __builtin_amdgcn_s_sleep(1);
  }
  __builtin_amdgcn_fence(__ATOMIC_ACQUIRE, "workgroup");
  asm volatile("s_waitcnt lgkmcnt(0)" ::: "memory");
}
#define HSYNCL() half_sync_lds()

#define LDS_BYTES 66560

__device__ __forceinline__ void phase_rope(const Params& p) {
  float* tab = (float*)(p.ws + OFF_ROPE);
  for (int i = VBID * NTHR + VTID; i < 4096 * 32; i += VGRID * NTHR) {
    int pos = i >> 5, f = i & 31;
    double ang = (double)pos * INVF[f];
    const double TWO_PI = 6.283185307179586476925286766559;
    double n = rint(ang / TWO_PI);
    double r = ang - n * TWO_PI;
    double r2 = r * r;
    double sn = r, cs = 1.0, ts = r, tc = 1.0;
#pragma unroll 1
    for (int k = 1; k <= 16; ++k) {
      tc = -tc * r2 / (double)((2 * k - 1) * (2 * k));
      ts = -ts * r2 / (double)((2 * k) * (2 * k + 1));
      cs += tc; sn += ts;
    }
    tab[i * 2] = (float)cs; tab[i * 2 + 1] = (float)sn;
  }
  {
    const float* __restrict__ w_in = p.in[1]; const float* __restrict__ w_out = p.in[13];
    uint4* wint = (uint4*)(p.ws + OFF_WINT); uint4* woutt = (uint4*)(p.ws + OFF_WOUTT);
    const int NJ1 = 3584 * 128, NJ2 = 1024 * 128;
    for (int i = VBID * NTHR + VTID; i < NJ1 + NJ2; i += VGRID * NTHR) {
      const bool second = i >= NJ1;
      const int q = second ? i - NJ1 : i;
      const int N = second ? 1024 : 3584, NV = second ? 1024 : INW;
      const int s = q % N, ko = q / N;
      const int n = second ? s : ((s & ~63) + (((s & 63) >> 3) << 2) + (s & 3) + (((s >> 2) & 1) << 5));
      const float* __restrict__ src = second ? w_out : w_in;
      float f[8];
#pragma unroll
      for (int u = 0; u < 8; ++u) f[u] = (n < NV) ? src[(size_t)(ko * 8 + u) * NV + n] : 0.f;
      if (second) {
        uint2 w; w.x = pk4_fp8c(W_SCALE * f[0], W_SCALE * f[1], W_SCALE * f[2], W_SCALE * f[3]); w.y = pk4_fp8c(W_SCALE * f[4], W_SCALE * f[5], W_SCALE * f[6], W_SCALE * f[7]);
        ((uint2*)woutt)[(size_t)s * 128 + ko] = w;
      } else { uint4 w; w.x = cvtpk(f[0], f[1]); w.y = cvtpk(f[2], f[3]); w.z = cvtpk(f[4], f[5]); w.w = cvtpk(f[6], f[7]); wint[(size_t)s * 128 + ko] = w; }
    }
  }
  {
    const float4* __restrict__ x4 = (const float4*)p.in[0];
    uint4* xb = (uint4*)(p.ws + OFF_XB);
    for (size_t i = (size_t)VBID * NTHR + VTID; i < (size_t)T_TOK * DM / 8; i += (size_t)VGRID * NTHR) {
      float4 a = x4[2 * i], b = x4[2 * i + 1];
      uint4 w; w.x = cvtpk(a.x, a.y); w.y = cvtpk(a.z, a.w); w.z = cvtpk(b.x, b.y); w.w = cvtpk(b.z, b.w);
      xb[i] = w;
    }
  }
}

template <class AF, class BF>
__device__ __forceinline__ void gemm64_naive(float* As, float* Bs, float* Cs, int K, AF af, BF bf) {
  int tid_l_ = VTID; asm volatile("" : "+v"(tid_l_)); const int tid = tid_l_, tx = tid & 15, ty = tid >> 4;
  float acc[4][4];
#pragma unroll
  for (int i = 0; i < 4; ++i)
#pragma unroll
    for (int j = 0; j < 4; ++j) acc[i][j] = 0.f;
  for (int k0 = 0; k0 < K; k0 += 16) {
#pragma unroll
    for (int u = 0; u < 4; ++u) { int i = tid + u * 256; int r = i >> 4, kk = i & 15; As[kk * 68 + r] = af(r, k0 + kk); }
#pragma unroll
    for (int u = 0; u < 4; ++u) { int i = tid + u * 256; int kk = i >> 6, c = i & 63; Bs[kk * 68 + c] = bf(k0 + kk, c); }
    HSYNC();
#pragma unroll
    for (int kk = 0; kk < 16; ++kk) {
      float a[4], b[4];
#pragma unroll
      for (int i = 0; i < 4; ++i) { a[i] = As[kk * 68 + ty * 4 + i]; b[i] = Bs[kk * 68 + tx * 4 + i]; }
#pragma unroll
      for (int i = 0; i < 4; ++i)
#pragma unroll
        for (int j = 0; j < 4; ++j) acc[i][j] += a[i] * b[j];
    }
    HSYNC();
  }
#pragma unroll
  for (int i = 0; i < 4; ++i)
#pragma unroll
    for (int j = 0; j < 4; ++j) Cs[(ty * 4 + i) * 65 + tx * 4 + j] = acc[i][j];
  HSYNC();
}


__device__ __forceinline__ int lds_off(int row, int chunk) { return row * 128 + ((chunk ^ ((row >> 1) & 7)) << 4); }

template <int BMODE>
__device__ __forceinline__ unsigned cvtpk_m(float a, float b, const bool lo = false) {
  if (BMODE == 0 || (BMODE == 2 && !lo)) return cvtpk(a, b);
  const unsigned h = cvtpk(a, b);
  const float ah = __uint_as_float(h << 16), bh = __uint_as_float(h & 0xffff0000u);
  return cvtpk(a - ah, b - bh);
}
#define G128_MMA(bufoff) { \
    _Pragma("unroll") for (int kk = 0; kk < 2; ++kk) { \
      bf16x8 af[4], bfr[4]; \
      _Pragma("unroll") for (int m = 0; m < 4; ++m) af[m] = *(const bf16x8*)(smem + (bufoff) + lds_off(wr * 64 + m * 16 + fr, kk * 4 + fq)); \
      _Pragma("unroll") for (int n = 0; n < 4; ++n) bfr[n] = *(const bf16x8*)(smem + (bufoff) + 16384 + lds_off(wc * 64 + n * 16 + fr, kk * 4 + fq)); \
      _Pragma("unroll") for (int m = 0; m < 4; ++m) \
        _Pragma("unroll") for (int n = 0; n < 4; ++n) acc[m][n] = __builtin_amdgcn_mfma_f32_16x16x32_bf16(bfr[n], af[m], acc[m][n], 0, 0, 0); \
    } }
template <int BMODE, bool KCLAMP, class ALoad, class BPtr>
__device__ __forceinline__ void gemm128_acc(f32x4 (&acc)[4][4], char* smem, const int nk, ALoad aload, BPtr bptr, const int ldb, const int kvalid) {
  int tid_l_ = VTID; asm volatile("" : "+v"(tid_l_)); const int tid = tid_l_, lane = tid & 63, wid = tid >> 6;
  const int wr = wid >> 1, wc = wid & 1, fr = lane & 15, fq = lane >> 4;
  const int achunk = tid & 7, arow0 = tid >> 3;
  const int nq = tid & 31, ko = tid >> 5;
  const float* bp0 = bptr(nq);
  const int oa0 = lds_off(arow0, achunk), oa1 = lds_off(arow0 + 32, achunk), oa2 = lds_off(arow0 + 64, achunk), oa3 = lds_off(arow0 + 96, achunk);
  const int ob0 = 16384 + lds_off(nq * 4 + 0, ko), ob1 = 16384 + lds_off(nq * 4 + 1, ko), ob2 = 16384 + lds_off(nq * 4 + 2, ko), ob3 = 16384 + lds_off(nq * 4 + 3, ko);
  uint4 ra0, ra1, ra2, ra3; float4 rb0, rb1, rb2, rb3, rb4, rb5, rb6, rb7;
#define G128_LOAD(kt) { \
    ra0 = aload(0, arow0, (kt) * 8 + achunk); ra1 = aload(1, arow0 + 32, (kt) * 8 + achunk); \
    ra2 = aload(2, arow0 + 64, (kt) * 8 + achunk); ra3 = aload(3, arow0 + 96, (kt) * 8 + achunk); \
    int kr_ = (kt) * 64 + ko * 8; \
    if (KCLAMP) kr_ = min(kr_, kvalid - 8);     \
    { \
      const float* b2_ = bp0 + (size_t)((BMODE == 2) ? (kr_ & 1023) : kr_) * ldb; \
      rb0 = *(const float4*)(b2_); rb1 = *(const float4*)(b2_ + (size_t)1 * ldb); rb2 = *(const float4*)(b2_ + (size_t)2 * ldb); \
      rb3 = *(const float4*)(b2_ + (size_t)3 * ldb); rb4 = *(const float4*)(b2_ + (size_t)4 * ldb); rb5 = *(const float4*)(b2_ + (size_t)5 * ldb); \
      rb6 = *(const float4*)(b2_ + (size_t)6 * ldb); rb7 = *(const float4*)(b2_ + (size_t)7 * ldb); \
    } }
#define G128_STORE(bufoff, lo_) { \
    char* const sb_ = smem + (bufoff); \
    *(uint4*)(sb_ + oa0) = ra0; *(uint4*)(sb_ + oa1) = ra1; *(uint4*)(sb_ + oa2) = ra2; *(uint4*)(sb_ + oa3) = ra3; \
    uint4 w; \
    w.x = cvtpk_m<BMODE>(rb0.x, rb1.x, lo_); w.y = cvtpk_m<BMODE>(rb2.x, rb3.x, lo_); w.z = cvtpk_m<BMODE>(rb4.x, rb5.x, lo_); w.w = cvtpk_m<BMODE>(rb6.x, rb7.x, lo_); \
    *(uint4*)(sb_ + ob0) = w; \
    w.x = cvtpk_m<BMODE>(rb0.y, rb1.y, lo_); w.y = cvtpk_m<BMODE>(rb2.y, rb3.y, lo_); w.z = cvtpk_m<BMODE>(rb4.y, rb5.y, lo_); w.w = cvtpk_m<BMODE>(rb6.y, rb7.y, lo_); \
    *(uint4*)(sb_ + ob1) = w; \
    w.x = cvtpk_m<BMODE>(rb0.z, rb1.z, lo_); w.y = cvtpk_m<BMODE>(rb2.z, rb3.z, lo_); w.z = cvtpk_m<BMODE>(rb4.z, rb5.z, lo_); w.w = cvtpk_m<BMODE>(rb6.z, rb7.z, lo_); \
    *(uint4*)(sb_ + ob2) = w; \
    w.x = cvtpk_m<BMODE>(rb0.w, rb1.w, lo_); w.y = cvtpk_m<BMODE>(rb2.w, rb3.w, lo_); w.z = cvtpk_m<BMODE>(rb4.w, rb5.w, lo_); w.w = cvtpk_m<BMODE>(rb6.w, rb7.w, lo_); \
    *(uint4*)(sb_ + ob3) = w; }
  G128_LOAD(0)
  G128_STORE(0, false)
  if (nk > 1) G128_LOAD(1)
  HSYNC();
  for (int kt = 0; kt < nk; ++kt) {
    const int cur = (kt & 1) * 32768;
    __builtin_amdgcn_sched_barrier(0);
    G128_MMA(cur)
    __builtin_amdgcn_sched_barrier(0);
    if (kt + 1 < nk) {
      G128_STORE(cur ^ 32768, (kt + 1) >= kvalid)
      __builtin_amdgcn_sched_barrier(0);
      if (kt + 2 < nk) G128_LOAD(kt + 2)
    }
    __builtin_amdgcn_sched_barrier(0);
    HSYNC();
  }
#undef G128_LOAD
#undef G128_STORE
}
__device__ __forceinline__ void acc_zero(f32x4 (&acc)[4][4]) {
#pragma unroll
  for (int m = 0; m < 4; ++m)
#pragma unroll
    for (int n = 0; n < 4; ++n) acc[m][n] = (f32x4){0.f, 0.f, 0.f, 0.f};
}
template <class ARow, class BPtr, class Epi>
__device__ __forceinline__ void gemm128(char* smem, const int K, ARow arow, BPtr bptr, const int ldb, Epi epi) {
  int tid_l_ = VTID; asm volatile("" : "+v"(tid_l_)); const int tid = tid_l_, lane = tid & 63, wid = tid >> 6;
  const int arow0 = tid >> 3;
  const bf16_t* ap0 = arow(arow0);
  const bf16_t* ap1 = arow(arow0 + 32);
  const bf16_t* ap2 = arow(arow0 + 64);
  const bf16_t* ap3 = arow(arow0 + 96);
  f32x4 acc[4][4];
  acc_zero(acc);
  gemm128_acc<0, false>(acc, smem, K >> 6,
      [=](int u, int, int kc) { const bf16_t* q = (u == 0) ? ap0 : (u == 1) ? ap1 : (u == 2) ? ap2 : ap3; return *(const uint4*)(q + kc * 8); },
      bptr, ldb, 0);
  epi(acc, wid >> 1, wid & 1, lane & 15, lane >> 4);
}


template <class ALoad, class BLoad>
__device__ __forceinline__ void gemm128_acc_bb(f32x4 (&acc)[4][4], char* smem, const int nk, ALoad aload, BLoad bload) {
  int tid_l_ = VTID; asm volatile("" : "+v"(tid_l_)); const int tid = tid_l_, lane = tid & 63, wid = tid >> 6;
  const int wr = wid >> 1, wc = wid & 1, fr = lane & 15, fq = lane >> 4;
  const int achunk = tid & 7, arow0 = tid >> 3;
  const int oa0 = lds_off(arow0, achunk), oa1 = lds_off(arow0 + 32, achunk), oa2 = lds_off(arow0 + 64, achunk), oa3 = lds_off(arow0 + 96, achunk);
  uint4 ra0, ra1, ra2, ra3, rb0, rb1, rb2, rb3;
#define G128_LOADBB(kt) { \
    ra0 = aload(0, arow0, (kt) * 8 + achunk); ra1 = aload(1, arow0 + 32, (kt) * 8 + achunk); \
    ra2 = aload(2, arow0 + 64, (kt) * 8 + achunk); ra3 = aload(3, arow0 + 96, (kt) * 8 + achunk); \
    rb0 = bload(0, arow0, (kt) * 8 + achunk); rb1 = bload(1, arow0 + 32, (kt) * 8 + achunk); \
    rb2 = bload(2, arow0 + 64, (kt) * 8 + achunk); rb3 = bload(3, arow0 + 96, (kt) * 8 + achunk); }
#define G128_STOREBB(bufoff) { \
    char* const sb_ = smem + (bufoff); \
    *(uint4*)(sb_ + oa0) = ra0; *(uint4*)(sb_ + oa1) = ra1; *(uint4*)(sb_ + oa2) = ra2; *(uint4*)(sb_ + oa3) = ra3; \
    *(uint4*)(sb_ + 16384 + oa0) = rb0; *(uint4*)(sb_ + 16384 + oa1) = rb1; *(uint4*)(sb_ + 16384 + oa2) = rb2; *(uint4*)(sb_ + 16384 + oa3) = rb3; }
  G128_LOADBB(0)
  G128_STOREBB(0)
  if (nk > 1) G128_LOADBB(1)
  HSYNC();
  for (int kt = 0; kt < nk; ++kt) {
    const int cur = (kt & 1) * 32768;
    __builtin_amdgcn_sched_barrier(0);
    G128_MMA(cur)
    __builtin_amdgcn_sched_barrier(0);
    if (kt + 1 < nk) {
      G128_STOREBB(cur ^ 32768)
      __builtin_amdgcn_sched_barrier(0);
      if (kt + 2 < nk) G128_LOADBB(kt + 2)
    }
    __builtin_amdgcn_sched_barrier(0);
    HSYNC();
  }
#undef G128_LOADBB
#undef G128_STOREBB
}
template <class ARow, class BRow, class Epi>
__device__ __forceinline__ void gemm128_bb(char* smem, const int K, ARow arow, BRow brow, Epi epi) {
  int tid_l_ = VTID; asm volatile("" : "+v"(tid_l_)); const int tid = tid_l_, lane = tid & 63, wid = tid >> 6;
  const int arow0 = tid >> 3;
  const bf16_t* ap0 = arow(arow0); const bf16_t* ap1 = arow(arow0 + 32); const bf16_t* ap2 = arow(arow0 + 64); const bf16_t* ap3 = arow(arow0 + 96);
  const bf16_t* bp0 = brow(arow0); const bf16_t* bp1 = brow(arow0 + 32); const bf16_t* bp2 = brow(arow0 + 64); const bf16_t* bp3 = brow(arow0 + 96);
  f32x4 acc[4][4];
  acc_zero(acc);
  gemm128_acc_bb(acc, smem, K >> 6,
      [=](int u, int, int kc) { const bf16_t* q = (u == 0) ? ap0 : (u == 1) ? ap1 : (u == 2) ? ap2 : ap3; return *(const uint4*)(q + kc * 8); },
      [=](int u, int, int kc) { const bf16_t* q = (u == 0) ? bp0 : (u == 1) ? bp1 : (u == 2) ? bp2 : bp3; return *(const uint4*)(q + kc * 8); });
  epi(acc, wid >> 1, wid & 1, lane & 15, lane >> 4);
}


#define GAS1 __attribute__((address_space(1)))
#define LAS3 __attribute__((address_space(3)))
__device__ __forceinline__ void glds16(const void* g, char* l) {
  __builtin_amdgcn_global_load_lds((const GAS1 void*)g, (LAS3 void*)l, 16, 0, 0);
}
template <class ARow, class BRow, class Epi>
__device__ __forceinline__ void gemm128_glds(char* smem, const int K, ARow arow, BRow brow, Epi epi) {
  int tid_l_ = VTID; asm volatile("" : "+v"(tid_l_)); const int tid = tid_l_, lane = tid & 63, wid = tid >> 6;
  const int wr = wid >> 1, wc = wid & 1, fr = lane & 15, fq = lane >> 4;
  const int r0 = tid >> 3;
  const int cl = (tid & 7) ^ ((tid >> 4) & 7);
  const bf16_t* ga0 = arow(r0) + cl * 8; const bf16_t* ga1 = arow(r0 + 32) + cl * 8; const bf16_t* ga2 = arow(r0 + 64) + cl * 8; const bf16_t* ga3 = arow(r0 + 96) + cl * 8;
  const bf16_t* gb0 = brow(r0) + cl * 8; const bf16_t* gb1 = brow(r0 + 32) + cl * 8; const bf16_t* gb2 = brow(r0 + 64) + cl * 8; const bf16_t* gb3 = brow(r0 + 96) + cl * 8;
  char* const lbase = smem + tid * 16;
#define GL_STAGE(bufoff, kt) { \
    char* const d_ = lbase + (bufoff); const int ko_ = (kt) * 64; \
    glds16(ga0 + ko_, d_); glds16(ga1 + ko_, d_ + 4096); glds16(ga2 + ko_, d_ + 8192); glds16(ga3 + ko_, d_ + 12288); \
    glds16(gb0 + ko_, d_ + 16384); glds16(gb1 + ko_, d_ + 20480); glds16(gb2 + ko_, d_ + 24576); glds16(gb3 + ko_, d_ + 28672); }
  f32x4 acc[4][4];
  acc_zero(acc);
  const int nk = K >> 6;
  GL_STAGE(0, 0)
  asm volatile("s_waitcnt vmcnt(0)" ::: "memory");
  HSYNC();
  for (int kt = 0; kt < nk; ++kt) {
    const int cur = (kt & 1) * 32768;
    if (kt + 1 < nk) GL_STAGE(cur ^ 32768, kt + 1)
    G128_MMA(cur)
    asm volatile("s_waitcnt vmcnt(0)" ::: "memory");
    HSYNC();
  }
#undef GL_STAGE
  epi(acc, wr, wc, fr, fq);
}


template <int NCALL, int NK, class ARow, class BRow, class Epi>
__device__ __forceinline__ void gemm128_glds_multi(char* smem, ARow arow, BRow brow, const size_t bstride, Epi epi) {
  int tid_l_ = VTID; asm volatile("" : "+v"(tid_l_)); const int tid = tid_l_, lane = tid & 63, wid = tid >> 6;
  const int wr = wid >> 1, wc = wid & 1, fr = lane & 15, fq = lane >> 4;
  const int r0 = tid >> 3;
  const int cl = (tid & 7) ^ ((tid >> 4) & 7);
  const bf16_t* ga0 = arow(r0) + cl * 8; const bf16_t* ga1 = arow(r0 + 32) + cl * 8; const bf16_t* ga2 = arow(r0 + 64) + cl * 8; const bf16_t* ga3 = arow(r0 + 96) + cl * 8;
  const bf16_t* gb0 = brow(r0) + cl * 8; const bf16_t* gb1 = brow(r0 + 32) + cl * 8; const bf16_t* gb2 = brow(r0 + 64) + cl * 8; const bf16_t* gb3 = brow(r0 + 96) + cl * 8;
  char* const lbase = smem + tid * 16;
#define GM_STAGE(bufoff, g) { \
    char* const d_ = lbase + (bufoff); const int ko_ = ((g) % NK) * 64; const size_t bo_ = (size_t)((g) / NK) * bstride + ko_; \
    glds16(ga0 + ko_, d_); glds16(ga1 + ko_, d_ + 4096); glds16(ga2 + ko_, d_ + 8192); glds16(ga3 + ko_, d_ + 12288); \
    glds16(gb0 + bo_, d_ + 16384); glds16(gb1 + bo_, d_ + 20480); glds16(gb2 + bo_, d_ + 24576); glds16(gb3 + bo_, d_ + 28672); }
  f32x4 acc[4][4];
  acc_zero(acc);
  constexpr int G = NCALL * NK;
  GM_STAGE(0, 0)
  asm volatile("s_waitcnt vmcnt(0)" ::: "memory");
  HSYNC();
#pragma unroll 1
  for (int g = 0; g < G; ++g) {
    const int cur = (g & 1) * 32768;
    if (g + 1 < G) GM_STAGE(cur ^ 32768, g + 1)
    G128_MMA(cur)
    if ((g % NK) == NK - 1) {
      epi(g / NK, acc, wr, wc, fr, fq);
      acc_zero(acc);
    }
    asm volatile("s_waitcnt vmcnt(0)" ::: "memory");
    HSYNC();
  }
#undef GM_STAGE
}


namespace pg8 {
#define PG8_LAS __attribute__((address_space(3)))
typedef unsigned short bf16_t;
typedef short bf16x8 __attribute__((ext_vector_type(8)));
typedef float f32x4 __attribute__((ext_vector_type(4)));
typedef unsigned u32x4 __attribute__((ext_vector_type(4)));
typedef int i32x4 __attribute__((ext_vector_type(4)));
typedef int i32x8 __attribute__((ext_vector_type(8)));
constexpr int BM = 256, BK = 64, HALF = 128, HTB = HALF * BK * 2  , STAGE_BYTES = 8 * HTB, NXCD = 8, WGM = 8;

__host__ __device__ __forceinline__ int lds_byte(int r, int c) { const int st = (r >> 4) * 2 + (c >> 5), rr = r & 15, cc = c & 31, ob = rr * 64 + cc * 2; return st * 1024 + (ob ^ (((ob >> 9) & 1) << 5)); }
__host__ __device__ __forceinline__ void stage_rc(int b, int& R, int& C) { const int st = b / 1024, sb = b % 1024, swz = sb ^ (((sb >> 9) & 1) << 5); R = (st >> 1) * 16 + swz / 64; C = (st & 1) * 32 + (swz % 64) / 2; }
__host__ __device__ __forceinline__ int perm32(int rho) { const int n = rho >> 4, i = rho & 15; return 8 * (i >> 2) + 4 * n + (i & 3); }

struct Unit { int pm, pn; };
struct Gemm { const bf16_t* A; const bf16_t* Bt; int M, N, K; };

struct StaticOrder {
    int nM, nN, nwg, G, c;
    __host__ __device__ void init(int M, int N, int G_, int c_) { nM = M / BM; nN = N / BM; nwg = nM * nN; G = G_; c = c_; }
    __host__ __device__ bool next(int i, Unit& u) const {
        const long L = (long)i * G + c; if (L >= nwg) return false;
        int wgid = (int)L; { const int q = nwg / NXCD, r = nwg % NXCD, xcd = wgid % NXCD, off = wgid / NXCD; wgid = (xcd < r ? xcd * (q + 1) : r * (q + 1) + (xcd - r) * q) + off; }
        const int nig = WGM * nN, gid = wgid / nig, fm = gid * WGM, gsz = (nM - fm) < WGM ? (nM - fm) : WGM;
        u.pm = fm + ((wgid % nig) % gsz); u.pn = (wgid % nig) / gsz; return true;
    }
    __device__ __forceinline__ void a_ready(const Unit&) const {}
    __device__ __forceinline__ void done(const Unit&) const {}
};
template <class Epi, class Sched, bool ALIGN_EPI = false, bool SP2 = false, bool GATHER = false, bool FP8 = false>
__device__ __forceinline__ void gemm_phase(PG8_LAS unsigned char* lds, const Gemm g, const Sched& S, const Epi& E, const int* rowidx = nullptr) {
    int tid_ = threadIdx.x; asm volatile("" : "+v"(tid_));
    const int tid = tid_, wid = __builtin_amdgcn_readfirstlane(tid >> 6), lane = tid & 63, wr = wid >> 2, wc = wid & 3, fr = lane & 15, fq = lane >> 4;
    const int K = g.K, nt = K / BK;
    unsigned voffA[2], voffA1[2], voffB[2];
#pragma unroll
    for (int i = 0; i < 2; ++i) { int R, C; stage_rc(tid * 16 + i * 8192, R, C); const int Rb = Epi::PERM ? ((R & ~31) + perm32(R & 31)) : R;
        if (GATHER) { voffA[i] = ((unsigned)rowidx[R] * (unsigned)K + (unsigned)C) * 2u; voffA1[i] = ((unsigned)rowidx[128 + R] * (unsigned)K + (unsigned)C) * 2u; }
        else { voffA[i] = (unsigned)(R * K + C) * 2u; voffA1[i] = voffA[i]; }
        voffB[i] = (unsigned)(Rb * K + C) * 2u; }
    const size_t hstepA = GATHER ? (size_t)0 : (size_t)HALF * K * 2;
    const size_t kstep = (size_t)(BK * 2);
    const size_t hstep = (size_t)HALF * K * 2;
    const size_t tstep = 2 * hstep;
    const unsigned ldsw = (unsigned)wid * 1024u;
    const int aoff = lds_byte(wr * 64 + fr, fq * 8), boff = lds_byte(wc * 32 + fr, fq * 8);
#define PG8_SA(b, h) (((b) * 2 + (h)) * HTB)
#define PG8_SB(b, h) ((4 + (b) * 2 + (h)) * HTB)
#define PG8_STAGE(bufoff, gbase, voff) do { _Pragma("unroll") for (int _i = 0; _i < 2; ++_i) \
        __builtin_amdgcn_global_load_lds((const unsigned*)((const char*)(gbase) + (voff)[_i]), (PG8_LAS unsigned*)(lds + (bufoff) + ldsw + _i * 8192), 16, 0, 0); } while (0)
#define PG8_LDA(dst, b, h) do { _Pragma("unroll") for (int m = 0; m < 4; ++m) _Pragma("unroll") for (int k = 0; k < 2; ++k) dst[m][k] = *(const PG8_LAS bf16x8*)(lds + PG8_SA(b, h) + aoff + m * 2048 + k * 1024); } while (0)
#define PG8_LDB(dst, b, h) do { _Pragma("unroll") for (int n = 0; n < 2; ++n) _Pragma("unroll") for (int k = 0; k < 2; ++k) dst[n][k] = *(const PG8_LAS bf16x8*)(lds + PG8_SB(b, h) + boff + n * 2048 + k * 1024); } while (0)
#define PG8_MMA(ai, bj, At, Bt) do { __builtin_amdgcn_s_setprio(1); _Pragma("unroll") for (int m = 0; m < 4; ++m) _Pragma("unroll") for (int n = 0; n < 2; ++n) _Pragma("unroll") for (int k = 0; k < 2; ++k) \
        acc[ai][bj][m][n] = __builtin_amdgcn_mfma_f32_16x16x32_bf16(Bt[n][k], At[m][k], acc[ai][bj][m][n], 0, 0, 0); __builtin_amdgcn_s_setprio(0); } while (0)
#define PG8_LD8(off) __builtin_shufflevector(*(const PG8_LAS i32x4*)(lds + (off)), *(const PG8_LAS i32x4*)(lds + (off) + 1024), 0, 1, 2, 3, 4, 5, 6, 7)
#define PG8_LDA_F(dst, b, h) do { if constexpr (FP8) { A8[0] = PG8_LD8(PG8_SA(b, h) + aoff); A8[1] = PG8_LD8(PG8_SA(b, h) + aoff + 2048); } else PG8_LDA(dst, b, h); } while (0)
#define PG8_LDB_F(dst, b, h) do { if constexpr (FP8) { dst##8[0] = PG8_LD8(PG8_SB(b, h) + boff); dst##8[1] = PG8_LD8(PG8_SB(b, h) + boff + 2048); } else PG8_LDB(dst, b, h); } while (0)
#define PG8_MFMA8(ai, bj, m, n, Bt) asm volatile("v_mfma_scale_f32_16x16x128_f8f6f4 %0, %1, %2, %0, %3, %3 op_sel_hi:[0,0,0]" : "+v"(acc[ai][bj][m][n]) : "v"(Bt##8[n]), "v"(A8[(m) & 1]), "v"(one8))
#define PG8_MMA_PAIR(ai, b, h) do { if constexpr (FP8) { __builtin_amdgcn_s_setprio(1); \
        PG8_MFMA8(ai, 0, 0, 0, B0); PG8_MFMA8(ai, 0, 0, 1, B0); PG8_MFMA8(ai, 1, 0, 0, B1); PG8_MFMA8(ai, 1, 0, 1, B1); \
        PG8_MFMA8(ai, 0, 1, 0, B0); PG8_MFMA8(ai, 0, 1, 1, B0); PG8_MFMA8(ai, 1, 1, 0, B1); PG8_MFMA8(ai, 1, 1, 1, B1); \
        PG8_SCHED; A8[0] = PG8_LD8(PG8_SA(b, h) + aoff + 4096); A8[1] = PG8_LD8(PG8_SA(b, h) + aoff + 6144); PG8_WAIT_L(0); PG8_SCHED; \
        PG8_MFMA8(ai, 0, 2, 0, B0); PG8_MFMA8(ai, 0, 2, 1, B0); PG8_MFMA8(ai, 1, 2, 0, B1); PG8_MFMA8(ai, 1, 2, 1, B1); \
        PG8_MFMA8(ai, 0, 3, 0, B0); PG8_MFMA8(ai, 0, 3, 1, B0); PG8_MFMA8(ai, 1, 3, 0, B1); PG8_MFMA8(ai, 1, 3, 1, B1); \
        __builtin_amdgcn_s_setprio(0); } else { PG8_MMA(ai, 0, At, B0); PG8_MMA(ai, 1, At, B1); } } while (0)
#define PG8_WAIT_V(n) asm volatile("s_waitcnt vmcnt(" #n ")" ::: "memory")
#define PG8_WAIT_L(n) asm volatile("s_waitcnt lgkmcnt(" #n ")" ::: "memory")
#define PG8_BAR __builtin_amdgcn_s_barrier()
#define PG8_SCHED __builtin_amdgcn_sched_barrier(0)
    Unit cur, nxt; int ui = 0;
    if (!S.next(0, cur)) return;
    f32x4 acc[2][2][4][2];
#pragma unroll
    for (int a = 0; a < 2; ++a)
#pragma unroll
        for (int b = 0; b < 2; ++b)
#pragma unroll
            for (int m = 0; m < 4; ++m)
#pragma unroll
                for (int n = 0; n < 2; ++n) acc[a][b][m][n] = (f32x4){0.f, 0.f, 0.f, 0.f};
    bf16x8 At[4][2], B0[2][2], B1[2][2];
    i32x8 A8[2], B08[2], B18[2];
    int one8 = 0x7F7F7F7F; asm volatile("" : "+v"(one8));
    static_assert(!FP8 || SP2, "the fp8 path exists in the SP2 schedule only");
    const char* cA = (const char*)g.A + (size_t)cur.pm * tstep; const char* cB = (const char*)g.Bt + (size_t)cur.pn * tstep;
    S.a_ready(cur);
    if constexpr (SP2) {
        PG8_STAGE(PG8_SB(0, 0), cB, voffB); PG8_STAGE(PG8_SB(0, 1), cB + hstep, voffB); PG8_STAGE(PG8_SA(0, 0), cA, voffA); PG8_STAGE(PG8_SA(0, 1), cA + hstepA, voffA1);
        if (wr == 1) PG8_BAR;
        PG8_WAIT_V(2); PG8_BAR;
        PG8_STAGE(PG8_SB(1, 0), cB + kstep, voffB); PG8_STAGE(PG8_SA(1, 0), cA + kstep, voffA); PG8_STAGE(PG8_SB(1, 1), cB + hstep + kstep, voffB);
        PG8_WAIT_V(6); PG8_BAR;
    } else {
        PG8_STAGE(PG8_SB(0, 0), cB, voffB); PG8_STAGE(PG8_SA(0, 0), cA, voffA); PG8_STAGE(PG8_SB(0, 1), cB + hstep, voffB); PG8_STAGE(PG8_SA(0, 1), cA + hstepA, voffA1);
        if (wr == 1) PG8_BAR;
        PG8_WAIT_V(4); PG8_BAR;
        PG8_STAGE(PG8_SB(1, 0), cB + kstep, voffB); PG8_STAGE(PG8_SA(1, 0), cA + kstep, voffA); PG8_STAGE(PG8_SB(1, 1), cB + hstep + kstep, voffB);
        PG8_WAIT_V(6); PG8_BAR;
    }
    for (;;) {
        const bool has_next = S.next(ui + 1, nxt);
        const char* nA = has_next ? (const char*)g.A + (size_t)nxt.pm * tstep : cA; const char* nB = has_next ? (const char*)g.Bt + (size_t)nxt.pn * tstep : cB;
        for (int t = 0; t < nt; t += 2) {
            const bool last = (t == nt - 2);
            const char* a1 = cA + (size_t)(t + 1) * kstep;
            const char* a2 = last ? nA : cA + (size_t)(t + 2) * kstep; const char* b2 = last ? nB : cB + (size_t)(t + 2) * kstep;
            const char* a3 = a2 + kstep; const char* b3 = b2 + kstep;
            if (last && has_next) S.a_ready(nxt);
            if constexpr (SP2) {
            PG8_LDB_F(B0, 0, 0); PG8_LDB_F(B1, 0, 1); PG8_SCHED; PG8_LDA_F(At, 0, 0); PG8_STAGE(PG8_SA(1, 1), a1 + hstepA, voffA1);
            PG8_WAIT_V(8); PG8_WAIT_L(0); PG8_BAR; PG8_MMA_PAIR(0, 0, 0); PG8_BAR; PG8_SCHED;
            PG8_LDA_F(At, 0, 1); PG8_STAGE(PG8_SB(0, 0), b2, voffB); PG8_STAGE(PG8_SB(0, 1), b2 + hstep, voffB); PG8_STAGE(PG8_SA(0, 0), a2, voffA);
            PG8_WAIT_V(8); PG8_WAIT_L(0); PG8_BAR; PG8_MMA_PAIR(1, 0, 1); PG8_BAR; PG8_SCHED;
            PG8_LDB_F(B0, 1, 0); PG8_LDB_F(B1, 1, 1); PG8_SCHED; PG8_LDA_F(At, 1, 0); PG8_STAGE(PG8_SA(0, 1), a2 + hstepA, voffA1);
            PG8_WAIT_V(8); PG8_WAIT_L(0); PG8_BAR; PG8_MMA_PAIR(0, 1, 0); PG8_BAR; PG8_SCHED;
            PG8_LDA_F(At, 1, 1); PG8_STAGE(PG8_SB(1, 0), b3, voffB); PG8_STAGE(PG8_SB(1, 1), b3 + hstep, voffB); PG8_STAGE(PG8_SA(1, 0), a3, voffA);
            PG8_WAIT_V(8); PG8_WAIT_L(0); PG8_BAR; PG8_MMA_PAIR(1, 1, 1); PG8_BAR; PG8_SCHED;
            } else {
            PG8_LDB(B0, 0, 0); PG8_SCHED; PG8_LDA(At, 0, 0); PG8_STAGE(PG8_SA(1, 1), a1 + hstepA, voffA1);
            PG8_WAIT_L(8); PG8_BAR; PG8_WAIT_L(0); PG8_MMA(0, 0, At, B0); PG8_BAR; PG8_SCHED;
            PG8_LDB(B1, 0, 1); PG8_STAGE(PG8_SB(0, 0), b2, voffB);
            PG8_BAR; PG8_WAIT_L(0); PG8_MMA(0, 1, At, B1); PG8_BAR;
            PG8_LDA(At, 0, 1); PG8_STAGE(PG8_SA(0, 0), a2, voffA);
            PG8_BAR; PG8_WAIT_L(0); PG8_MMA(1, 0, At, B0); PG8_BAR; PG8_SCHED;
            PG8_STAGE(PG8_SB(0, 1), b2 + hstep, voffB);
            PG8_WAIT_V(6); PG8_BAR; PG8_MMA(1, 1, At, B1); PG8_BAR;
            PG8_LDB(B0, 1, 0); PG8_SCHED; PG8_LDA(At, 1, 0); PG8_STAGE(PG8_SA(0, 1), a2 + hstepA, voffA1);
            PG8_WAIT_L(8); PG8_BAR; PG8_WAIT_L(0); PG8_MMA(0, 0, At, B0); PG8_BAR; PG8_SCHED;
            PG8_LDB(B1, 1, 1); PG8_STAGE(PG8_SB(1, 0), b3, voffB);
            PG8_BAR; PG8_WAIT_L(0); PG8_MMA(0, 1, At, B1); PG8_BAR;
            PG8_LDA(At, 1, 1); PG8_STAGE(PG8_SA(1, 0), a3, voffA);
            PG8_BAR; PG8_WAIT_L(0); PG8_MMA(1, 0, At, B0); PG8_BAR; PG8_SCHED;
            PG8_STAGE(PG8_SB(1, 1), b3 + hstep, voffB);
            PG8_WAIT_V(6); PG8_BAR; PG8_MMA(1, 1, At, B1); PG8_BAR;
            }
        }
        if constexpr (ALIGN_EPI) { if (wr == 0) PG8_BAR; }
        if constexpr (FP8) asm volatile("s_nop 15\n\ts_nop 15" ::: "memory");
        if constexpr (!Epi::AFTER_DRAIN) { E(acc, cur, wr, wc, fr, fq); S.done(cur); }
        if (!has_next) break;
#pragma unroll
        for (int a = 0; a < 2; ++a)
#pragma unroll
            for (int b = 0; b < 2; ++b)
#pragma unroll
                for (int m = 0; m < 4; ++m)
#pragma unroll
                    for (int n = 0; n < 2; ++n) acc[a][b][m][n] = (f32x4){0.f, 0.f, 0.f, 0.f};
        cur = nxt; cA = nA; cB = nB; ++ui;
        if constexpr (ALIGN_EPI) { if (wr == 1) PG8_BAR; }
    }
    PG8_WAIT_V(0);
    if constexpr (!ALIGN_EPI) { if (wr == 0) PG8_BAR; }
    PG8_BAR;
    if constexpr (Epi::AFTER_DRAIN) { E.fused(acc, cur, wr, wc, fr, fq, lds, wid, lane); S.done(cur); }
#undef PG8_SA
#undef PG8_SB
#undef PG8_STAGE
#undef PG8_LDA
#undef PG8_LD8
#undef PG8_LDA_F
#undef PG8_LDB_F
#undef PG8_MFMA8
#undef PG8_MMA_PAIR
#undef PG8_LDB
#undef PG8_MMA
#undef PG8_WAIT_V
#undef PG8_WAIT_L
#undef PG8_BAR
#undef PG8_SCHED
}
}
#define DPP_F(v, ctrl) __builtin_bit_cast(float, __builtin_amdgcn_update_dpp(0, __builtin_bit_cast(int, (v)), (ctrl), 0xF, 0xF, true))
__device__ __forceinline__ float rdlane_f(float v, int l) { return __builtin_bit_cast(float, __builtin_amdgcn_readlane(__builtin_bit_cast(int, v), l)); }
__device__ __forceinline__ float dpp_sum16x(float v) {
  v += DPP_F(v, 0xB1); v += DPP_F(v, 0x4E); v += DPP_F(v, 0x141); v += DPP_F(v, 0x140);
  return v;
}
__device__ __forceinline__ float dpp_max16x(float v) {
  v = fmaxf(v, DPP_F(v, 0xB1)); v = fmaxf(v, DPP_F(v, 0x4E)); v = fmaxf(v, DPP_F(v, 0x141)); v = fmaxf(v, DPP_F(v, 0x140));
  return v;
}
__device__ __forceinline__ float wave_sum_fast(float v) {
  v = dpp_sum16x(v);
  return (rdlane_f(v, 0) + rdlane_f(v, 16)) + (rdlane_f(v, 32) + rdlane_f(v, 48));
}
__device__ __forceinline__ float wave_max_fast(float v) {
  v = dpp_max16x(v);
  return fmaxf(fmaxf(rdlane_f(v, 0), rdlane_f(v, 16)), fmaxf(rdlane_f(v, 32), rdlane_f(v, 48)));
}
__device__ __forceinline__ float fast_tanh(float x) { const float e = __expf(2.f * x); return 1.f - 2.f / (e + 1.f); }


__device__ __forceinline__ float4 bf4_to_f4(uint2 u) {
  float4 r;
  r.x = __uint_as_float(u.x << 16); r.y = __uint_as_float(u.x & 0xffff0000u);
  r.z = __uint_as_float(u.y << 16); r.w = __uint_as_float(u.y & 0xffff0000u);
  return r;
}
__device__ __forceinline__ uint2 pack4(float a, float b, float c, float d) { uint2 r; r.x = cvtpk(a, b); r.y = cvtpk(c, d); return r; }
#define XCD_GROUP (VBID & 7)
#define XCD_LB (VBID >> 3)
#define XCD_NB ((VGRID + 7 - (VBID & 7)) >> 3)

struct EpiInproj {
  static constexpr bool PERM = true, AFTER_DRAIN = false;
  const float* rope; bf16_t* Q; bf16_t* K; bf16_t* V; bf16_t* FE;
  __device__ __forceinline__ void operator()(const pg8::f32x4 (&acc)[2][2][4][2], const pg8::Unit& u, int wr, int wc, int fr, int fq) const {
#pragma unroll
    for (int bj = 0; bj < 2; ++bj) {
      const int s0 = u.pn * 256 + bj * 128 + wc * 32 + 8 * fq;
      const int hb = s0 & ~63, f0 = ((s0 & 63) >> 3) << 2;
      if (hb + f0 >= INW) continue;
#pragma unroll
      for (int ai = 0; ai < 2; ++ai)
#pragma unroll
        for (int m = 0; m < 4; ++m) {
          const int t = u.pm * 256 + ai * 128 + wr * 64 + m * 16 + fr;
          const pg8::f32x4 v0 = acc[ai][bj][m][0], v1 = acc[ai][bj][m][1];
          if (hb < 1024) {
            const int pos = t & (SEQ - 1);
            const float4 c01 = *(const float4*)(rope + (size_t)(pos * 32 + f0) * 2);
            const float4 c23 = *(const float4*)(rope + (size_t)(pos * 32 + f0) * 2 + 4);
            const float cs[4] = {c01.x, c01.z, c23.x, c23.z}, sn[4] = {c01.y, c01.w, c23.y, c23.w};
            const float sc = (hb < 512) ? 0.125f : 1.f;
            float o1[4], o2[4];
#pragma unroll
            for (int j = 0; j < 4; ++j) { o1[j] = (v0[j] * cs[j] - v1[j] * sn[j]) * sc; o2[j] = (v1[j] * cs[j] + v0[j] * sn[j]) * sc; }
            bf16_t* dst = (hb < 512) ? (Q + (size_t)t * 512 + hb + f0) : (K + (size_t)t * 512 + (hb - 512) + f0);
            *(uint2*)dst = pack4(o1[0], o1[1], o1[2], o1[3]);
            *(uint2*)(dst + 32) = pack4(o2[0], o2[1], o2[2], o2[3]);
          } else if (hb < 1536) {
            bf16_t* dst = V + (size_t)t * 512 + (hb - 1024) + f0;
            *(uint2*)dst = pack4(v0[0], v0[1], v0[2], v0[3]);
            *(uint2*)(dst + 32) = pack4(v1[0], v1[1], v1[2], v1[3]);
          } else {
            bf16_t* dst = FE + (size_t)t * FEW + (hb - 1536) + f0;
            *(uint2*)dst = pack4(v0[0], v0[1], v0[2], v0[3]);
            if (hb + f0 + 32 < INW) *(uint2*)(dst + 32) = pack4(v1[0], v1[1], v1[2], v1[3]);
          }
        }
    }
  }
};
__device__ __forceinline__ void phase_inproj(const Params& p, char* smem_all) {
  pg8::Gemm g{(const pg8::bf16_t*)(p.ws + OFF_XB), (const pg8::bf16_t*)(p.ws + OFF_WINT), T_TOK, 3584, DM};
  pg8::StaticOrder S; S.init(T_TOK, 3584, (int)gridDim.x, (int)blockIdx.x);
  EpiInproj E{(const float*)(p.ws + OFF_ROPE), (bf16_t*)(p.ws + OFF_Q), (bf16_t*)(p.ws + OFF_K), (bf16_t*)(p.ws + OFF_V), (bf16_t*)(p.ws + OFF_FEATS)};
  pg8::gemm_phase<EpiInproj, pg8::StaticOrder, true, true>((PG8_LAS unsigned char*)smem_all, g, S, E);
}

__device__ __forceinline__ void phase_prep_a(const Params& p) {
  const bf16_t* __restrict__ FE = (const bf16_t*)(p.ws + OFF_FEATS);
  const float* __restrict__ mu = p.in[2];
  bf16_t* R = (bf16_t*)(p.ws + OFF_R); bf16_t* K2 = (bf16_t*)(p.ws + OFF_K2); bf16_t* V2 = (bf16_t*)(p.ws + OFF_V2);
  bf16_t* ACT = (bf16_t*)(p.ws + OFF_ACT);
  for (size_t i = (size_t)VBID * NTHR + VTID; i < (size_t)T_TOK * 232; i += (size_t)VGRID * NTHR) {
    const int t = (int)(i / 232), ch = (int)(i - (size_t)t * 232);
    if (ch >= 228) { *(uint4*)(ACT + (size_t)t * 320 + 288 + (ch - 228) * 8) = make_uint4(0u, 0u, 0u, 0u); continue; }
    const int col = ch * 8;
    const uint4 cu = *(const uint4*)(FE + (size_t)t * FEW + col);
    uint4 pv = make_uint4(0u, 0u, 0u, 0u);
    if ((t & (SEQ - 1)) != 0) pv = *(const uint4*)(FE + (size_t)(t - 1) * FEW + col);
    const float4 m0 = *(const float4*)(mu + col), m1 = *(const float4*)(mu + col + 4);
    const unsigned cw[4] = {cu.x, cu.y, cu.z, cu.w}, pw[4] = {pv.x, pv.y, pv.z, pv.w};
    const float mm[8] = {m0.x, m0.y, m0.z, m0.w, m1.x, m1.y, m1.z, m1.w};
    float f[8];
#pragma unroll
    for (int q = 0; q < 4; ++q) {
      const float c0 = __uint_as_float(cw[q] << 16), c1 = __uint_as_float(cw[q] & 0xffff0000u);
      const float p0 = __uint_as_float(pw[q] << 16), p1 = __uint_as_float(pw[q] & 0xffff0000u);
      f[2 * q] = c0 + (p0 - c0) * mm[2 * q];
      f[2 * q + 1] = c1 + (p1 - c1) * mm[2 * q + 1];
    }
    bf16_t* dst;
    if (col < 512) dst = R + (size_t)t * 512 + col;
    else if (col < 1024) dst = K2 + (size_t)t * 512 + (col - 512);
    else if (col < 1536) dst = V2 + (size_t)t * 512 + (col - 1024);
    else {
      dst = ACT + (size_t)t * 320 + (col - 1536);
      if (col < 1600) {
#pragma unroll
        for (int q = 0; q < 8; ++q) f[q] = fast_tanh(f[q]);
      } else if (col >= 1664) {
#pragma unroll
        for (int q = 0; q < 8; ++q) f[q] = sigmoidf_(f[q]);
      }
    }
    uint4 w; w.x = cvtpk(f[0], f[1]); w.y = cvtpk(f[2], f[3]); w.z = cvtpk(f[4], f[5]); w.w = cvtpk(f[6], f[7]);
    *(uint4*)dst = w;
  }
}

template <int PASS>
__device__ __forceinline__ void prep_item(const Params& p, char* smem, const int row0, const int col0) {
  const bf16_t* __restrict__ ACT = (const bf16_t*)(p.ws + OFF_ACT);
  constexpr int ACOL = PASS * 64;
  constexpr int NK = (PASS == 2) ? 3 : 1;
  const float* __restrict__ Wm = (PASS == 0) ? p.in[4] : (PASS == 1) ? p.in[6] : p.in[7];
  f32x4 acc[4][4];
  acc_zero(acc);
  gemm128_acc<0, (PASS == 2)>(acc, smem, NK,
      [=](int, int rowl, int kc) { return *(const uint4*)(ACT + (size_t)(row0 + rowl) * 320 + ACOL + kc * 8); },
      [=](int nq) { return Wm + col0 + nq * 4; }, 512, 160);
  int tid_l_ = VTID; asm volatile("" : "+v"(tid_l_)); const int tid = tid_l_, lane = tid & 63, wid = tid >> 6;
  const int wr = wid >> 1, wc = wid & 1, fr = lane & 15, fq = lane >> 4;
  const int cb = col0 + wc * 64;
  if (PASS == 0) {
    const float* __restrict__ w0 = p.in[3];
    float* W = (float*)(p.ws + OFF_W);
#pragma unroll
    for (int n = 0; n < 4; ++n) {
      const int c = cb + n * 16 + fq * 4;
      const float4 w04 = *(const float4*)(w0 + c);
      const float w0c[4] = {w04.x, w04.y, w04.z, w04.w};
#pragma unroll
      for (int m = 0; m < 4; ++m) {
        const int t = row0 + wr * 64 + m * 16 + fr;
        float d[4];
#pragma unroll
        for (int j = 0; j < 4; ++j) {
          const float nz = -(w0c[j] + acc[m][n][j]);
          const float sp = fmaxf(nz, 0.f) + __logf(1.f + __expf(-fabsf(nz)));
          d[j] = -__expf(-sp - 0.5f);
        }
        *(float4*)(W + (size_t)t * 512 + c) = make_float4(d[0], d[1], d[2], d[3]);
      }
    }
  } else if (PASS == 2) {
    bf16_t* G = (bf16_t*)(p.ws + OFF_G);
#pragma unroll
    for (int m = 0; m < 4; ++m) {
      const int t = row0 + wr * 64 + m * 16 + fr;
#pragma unroll
      for (int n = 0; n < 4; ++n)
        *(uint2*)(G + (size_t)t * 512 + cb + n * 16 + fq * 4) = pack4(acc[m][n][0], acc[m][n][1], acc[m][n][2], acc[m][n][3]);
    }
  } else {
    const float* __restrict__ a0 = p.in[5]; const float* __restrict__ k_k = p.in[8]; const float* __restrict__ k_a = p.in[9];
    const float* __restrict__ r_k = p.in[10];
    const bf16_t* __restrict__ R = (const bf16_t*)(p.ws + OFF_R); bf16_t* K2 = (bf16_t*)(p.ws + OFF_K2);
    bf16_t* A = (bf16_t*)(p.ws + OFF_A); bf16_t* B = (bf16_t*)(p.ws + OFF_B); float* SB = (float*)(p.ws + OFF_SB);
#pragma unroll
    for (int m = 0; m < 4; ++m) {
      __builtin_amdgcn_sched_barrier(0);
      const int t = row0 + wr * 64 + m * 16 + fr;
      float kk[4][4];
      float ssp = 0.f, sbp = 0.f;
#pragma unroll
      for (int n = 0; n < 4; ++n) {
        const int c = cb + n * 16 + fq * 4;
        const size_t o = (size_t)t * 512 + c;
        const float4 rr4 = bf4_to_f4(*(const uint2*)(R + o)), kx4 = bf4_to_f4(*(const uint2*)(K2 + o));
        const float rr[4] = {rr4.x, rr4.y, rr4.z, rr4.w}, kx[4] = {kx4.x, kx4.y, kx4.z, kx4.w};
        const float4 a04 = *(const float4*)(a0 + c), kk4 = *(const float4*)(k_k + c), ka4 = *(const float4*)(k_a + c), rk4 = *(const float4*)(r_k + c);
        const float a0c[4] = {a04.x, a04.y, a04.z, a04.w}, kkc[4] = {kk4.x, kk4.y, kk4.z, kk4.w}, kac[4] = {ka4.x, ka4.y, ka4.z, ka4.w};
        const float rkc[4] = {rk4.x, rk4.y, rk4.z, rk4.w};
        float k2[4];
#pragma unroll
        for (int j = 0; j < 4; ++j) {
          const float av = sigmoidf_(a0c[j] + acc[m][n][j]);
          acc[m][n][j] = av;
          kk[n][j] = kx[j] * kkc[j];
          k2[j] = kx[j] * (1.f + (av - 1.f) * kac[j]);
          ssp += kk[n][j] * kk[n][j];
          sbp += rr[j] * k2[j] * rkc[j];
        }
        *(uint2*)(K2 + o) = pack4(k2[0], k2[1], k2[2], k2[3]);
      }
      ssp += __shfl_xor(ssp, 16, 64); ssp += __shfl_xor(ssp, 32, 64);
      sbp += __shfl_xor(sbp, 16, 64); sbp += __shfl_xor(sbp, 32, 64);
      const float inv = 1.f / fmaxf(sqrtf(ssp), 1e-12f);
#pragma unroll
      for (int n = 0; n < 4; ++n) {
        const size_t o = (size_t)t * 512 + cb + n * 16 + fq * 4;
        *(uint2*)(A + o) = pack4(-kk[n][0] * inv, -kk[n][1] * inv, -kk[n][2] * inv, -kk[n][3] * inv);
        *(uint2*)(B + o) = pack4(kk[n][0] * inv * acc[m][n][0], kk[n][1] * inv * acc[m][n][1], kk[n][2] * inv * acc[m][n][2], kk[n][3] * inv * acc[m][n][3]);
      }
      if (fq == 0) SB[(size_t)t * 8 + (cb >> 6)] = sbp;
    }
  }
}
__device__ __forceinline__ void phase_prep(const Params& p, char* smem) {
  for (int item = VBID; item < (T_TOK / 128) * 8; item += VGRID) {
    const int pass = item >> 10, mt = (item & 1023) >> 2, nt = item & 3;
    if (pass == 0) prep_item<0>(p, smem, mt * 128, nt * 128);
    else prep_item<1>(p, smem, mt * 128, nt * 128);
  }
}

#define CK_AR 0
#define CK_BK 9216
#define CK_BKT 18432
#define CK_UVT 27648
#define CK_LM 36864
#define CK_XR 46080
#define CK_LABT 54784
#define CK_WUT 58880
#define CK_PC 64000
constexpr size_t CK_GA_OFF = 0;
constexpr size_t CK_HA_OFF = (size_t)8192 * 8192;
constexpr size_t OFF_RA = OFF_MIXED;
constexpr size_t OFF_Y1A = OFF_MIXED + (size_t)8192 * 4096;
#define CK_MMA(x, y, c) __builtin_amdgcn_mfma_f32_16x16x32_bf16((x), (y), (c), 0, 0, 0)
#define CK_FRAG(off) (*(const bf16x8*)(smem + (off)))
#define CK_LOADS(it_) { \
    const int hd_ = (it_) >> 7, ch_ = (it_) & 127; \
    const size_t tok_ = (size_t)(hd_ >> 3) * SEQ + (size_t)ch_ * 32; \
    const size_t g1_ = (tok_ + t1) * 512 + (hd_ & 7) * 64 + j8; \
    ua = *(const uint4*)(A + g1_); ub = *(const uint4*)(B + g1_); uk = *(const uint4*)(K2 + g1_); ur = *(const uint4*)(R + g1_); \
    lw0 = *(const float4*)(W + g1_); lw1 = *(const float4*)(W + g1_ + 4); \
    const bf16_t* vp_ = V2 + (tok_ + 8 * w) * 512 + (hd_ & 7) * 64 + lane; \
    v0 = vp_[0]; v1 = vp_[512]; v2 = vp_[1024]; v3 = vp_[1536]; v4 = vp_[2048]; v5 = vp_[2560]; v6 = vp_[3072]; v7 = vp_[3584]; }
__device__ __forceinline__ void phase_chunk_pre(const Params& p, char* smem) {
  const bf16_t* __restrict__ R = (const bf16_t*)(p.ws + OFF_R); const bf16_t* __restrict__ K2 = (const bf16_t*)(p.ws + OFF_K2);
  const bf16_t* __restrict__ V2 = (const bf16_t*)(p.ws + OFF_V2); const bf16_t* __restrict__ A = (const bf16_t*)(p.ws + OFF_A);
  const bf16_t* __restrict__ B = (const bf16_t*)(p.ws + OFF_B); const float* __restrict__ W = (const float*)(p.ws + OFF_W);
  int tid_l_ = VTID; asm volatile("" : "+v"(tid_l_)); const int tid = tid_l_, lane = tid & 63, q = lane >> 4, c16 = lane & 15;
  const int w = __builtin_amdgcn_readfirstlane(tid >> 6);
  const int t1 = tid >> 3, j8 = (tid & 7) * 8;
  uint4 ua, ub, uk, ur; float4 lw0, lw1; unsigned v0, v1, v2, v3, v4, v5, v6, v7;
  int item = VBID;
  if (item < 64 * 128) CK_LOADS(item)
  for (; item < 64 * 128; item += VGRID) {
  *(float4*)(smem + CK_LM + t1 * 256 + j8 * 4) = lw0;
  *(float4*)(smem + CK_LM + t1 * 256 + j8 * 4 + 16) = lw1;
  HSYNCL();
  {
    float lv[32];
#pragma unroll
    for (int s = 0; s < 32; ++s) lv[s] = *(const float*)(smem + CK_LM + s * 256 + lane * 4);
    float acc = 0.f;
#pragma unroll
    for (int blk = 0; blk < 4; ++blk) {
#pragma unroll
      for (int i = 0; i < 8; ++i) { acc += lv[8 * blk + i]; lv[8 * blk + i] = acc; }
      if (blk == w) {
#pragma unroll
        for (int i = 0; i < 8; ++i) *(float*)(smem + CK_XR + (8 * blk + i) * 272 + lane * 4) = lv[8 * blk + i];
      }
    }
    if (w == 3) *(float*)(smem + CK_PC + lane * 4) = __expf(acc);
    uint4 vv; vv.x = v0 | (v1 << 16); vv.y = v2 | (v3 << 16); vv.z = v4 | (v5 << 16); vv.w = v6 | (v7 << 16);
    *(uint4*)(smem + CK_UVT + lane * 144 + (32 + 8 * w) * 2) = vv;
  }
  HSYNCL();
  {
    const float4 c1a = *(const float4*)(smem + CK_XR + t1 * 272 + j8 * 4), c1b = *(const float4*)(smem + CK_XR + t1 * 272 + j8 * 4 + 16);
    float4 c0a = make_float4(0.f, 0.f, 0.f, 0.f), c0b = make_float4(0.f, 0.f, 0.f, 0.f);
    if (t1 > 0) { c0a = *(const float4*)(smem + CK_XR + (t1 - 1) * 272 + j8 * 4); c0b = *(const float4*)(smem + CK_XR + (t1 - 1) * 272 + j8 * 4 + 16); }
    const float cl1[8] = {c1a.x, c1a.y, c1a.z, c1a.w, c1b.x, c1b.y, c1b.z, c1b.w};
    const float cl0[8] = {c0a.x, c0a.y, c0a.z, c0a.w, c0b.x, c0b.y, c0b.z, c0b.w};
    const unsigned wa[4] = {ua.x, ua.y, ua.z, ua.w}, wb[4] = {ub.x, ub.y, ub.z, ub.w}, wk[4] = {uk.x, uk.y, uk.z, uk.w}, wr[4] = {ur.x, ur.y, ur.z, ur.w};
    unsigned oa[4], ob[4], ok[4], orr[4];
#pragma unroll
    for (int i = 0; i < 4; ++i) {
      const float e0l = __expf(cl0[2 * i]), e0h = __expf(cl0[2 * i + 1]);
      const float e1l = __expf(cl1[2 * i]), e1h = __expf(cl1[2 * i + 1]);
      const float e2l = __expf(-cl1[2 * i]), e2h = __expf(-cl1[2 * i + 1]);
      oa[i] = cvtpk(__uint_as_float(wa[i] << 16) * e0l, __uint_as_float(wa[i] & 0xffff0000u) * e0h);
      orr[i] = cvtpk(__uint_as_float(wr[i] << 16) * e1l, __uint_as_float(wr[i] & 0xffff0000u) * e1h);
      ob[i] = cvtpk(__uint_as_float(wb[i] << 16) * e2l, __uint_as_float(wb[i] & 0xffff0000u) * e2h);
      ok[i] = cvtpk(__uint_as_float(wk[i] << 16) * e2l, __uint_as_float(wk[i] & 0xffff0000u) * e2h);
    }
    *(uint4*)(smem + CK_AR + t1 * 144 + j8 * 2) = make_uint4(oa[0], oa[1], oa[2], oa[3]);
    *(uint4*)(smem + CK_AR + (32 + t1) * 144 + j8 * 2) = make_uint4(orr[0], orr[1], orr[2], orr[3]);
    *(uint4*)(smem + CK_BK + t1 * 144 + j8 * 2) = make_uint4(ob[0], ob[1], ob[2], ob[3]);
    *(uint4*)(smem + CK_BK + (32 + t1) * 144 + j8 * 2) = make_uint4(ok[0], ok[1], ok[2], ok[3]);
  }
  if (item + VGRID < 64 * 128) CK_LOADS(item + VGRID)
  HSYNCL();
  {
    f32x4 acc[4];
#pragma unroll
    for (int nb = 0; nb < 4; ++nb) acc[nb] = (f32x4){0.f, 0.f, 0.f, 0.f};
#pragma unroll
    for (int ks = 0; ks < 2; ++ks) {
      const bf16x8 xa = CK_FRAG(CK_AR + (16 * w + c16) * 144 + ks * 64 + q * 16);
#pragma unroll
      for (int nb = 0; nb < 4; ++nb) acc[nb] = CK_MMA(CK_FRAG(CK_BK + (16 * nb + c16) * 144 + ks * 64 + q * 16), xa, acc[nb]);
    }
    const int tt = (16 * w + c16) & 31;
#pragma unroll
    for (int nb = 0; nb < 4; ++nb) {
      float val[4];
#pragma unroll
      for (int r = 0; r < 4; ++r) {
        const int s = (16 * nb + 4 * q + r) & 31;
        const bool keep = (w < 2) ? (s < tt) : (s <= tt);
        val[r] = keep ? acc[nb][r] : 0.f;
        if (w < 2 && nb < 2) *(float*)(smem + CK_LABT + s * 128 + tt * 4) = val[r];
      }
      *(uint2*)(smem + CK_LM + (16 * w + c16) * 144 + (16 * nb + 4 * q) * 2) = pack4(val[0], val[1], val[2], val[3]);
    }
  }
  HSYNCL();
  {
    const int mb = w & 1;
    const bf16x8 xa = CK_FRAG(CK_LM + (16 * mb + c16) * 144 + 64 + q * 16);
#pragma unroll
    for (int u = 0; u < 2; ++u) {
      const int nb = 2 * (w >> 1) + u;
      f32x4 acc = (f32x4){0.f, 0.f, 0.f, 0.f};
      acc = CK_MMA(CK_FRAG(CK_UVT + (16 * nb + c16) * 144 + 64 + q * 16), xa, acc);
      *(float4*)(smem + CK_XR + (16 * mb + c16) * 272 + (16 * nb + 4 * q) * 4) = make_float4(acc[0], acc[1], acc[2], acc[3]);
    }
  }
  HSYNCL();
  if (w < 2) {
    float x[32];
    if (w == 0) {
#pragma unroll
      for (int t = 0; t < 32; ++t) x[t] = bf2f(*(const bf16_t*)(smem + CK_AR + t * 144 + lane * 2));
    } else {
#pragma unroll
      for (int t = 0; t < 32; ++t) x[t] = *(const float*)(smem + CK_XR + t * 272 + lane * 4);
    }
    char* const dst = (w == 0) ? (smem + CK_WUT + lane * 80) : (smem + CK_UVT + lane * 144);
    const int bstr = (w == 0) ? 80 : 144;
    char* const xrows = (w == 0) ? (smem + CK_WUT) : (smem + CK_UVT);
    char* const tb = (w == 0) ? (smem + CK_AR) : (smem + CK_XR);
    float4 lc[2][4];
    int lofs = CK_LABT; asm volatile("" : "+v"(lofs)); const char* const lbase = smem + lofs;
#define CK_LCOL(s_, g0_) { _Pragma("unroll") for (int g_ = 0; g_ < 4; ++g_) if (4 * (g_ + (g0_)) + 3 > (s_)) lc[(s_) & 1][g_] = *(const float4*)(lbase + (s_) * 128 + (g_ + (g0_)) * 16); }
#define CK_SWEEP(s0_, g0_) { \
    CK_LCOL(s0_, g0_) \
    _Pragma("unroll") for (int s = (s0_); s < (s0_) + 15; ++s) { \
      if (s + 1 < (s0_) + 15) CK_LCOL(s + 1, g0_) \
      __builtin_amdgcn_sched_barrier(0); \
      _Pragma("unroll") for (int g = 0; g < 4; ++g) { \
        if (4 * (g + (g0_)) + 3 > s) { \
          const float4 l4 = lc[s & 1][g]; \
          if (4 * (g + (g0_)) + 0 > s) x[4 * (g + (g0_)) + 0] = fmaf(l4.x, x[s], x[4 * (g + (g0_)) + 0]); \
          if (4 * (g + (g0_)) + 1 > s) x[4 * (g + (g0_)) + 1] = fmaf(l4.y, x[s], x[4 * (g + (g0_)) + 1]); \
          if (4 * (g + (g0_)) + 2 > s) x[4 * (g + (g0_)) + 2] = fmaf(l4.z, x[s], x[4 * (g + (g0_)) + 2]); \
          if (4 * (g + (g0_)) + 3 > s) x[4 * (g + (g0_)) + 3] = fmaf(l4.w, x[s], x[4 * (g + (g0_)) + 3]); \
        } \
      } \
      __builtin_amdgcn_sched_barrier(0); \
    } }
    CK_SWEEP(0, 0)
#pragma unroll
    for (int g = 0; g < 2; ++g)
      *(uint4*)(dst + g * 16) = make_uint4(cvtpk(x[8 * g], x[8 * g + 1]), cvtpk(x[8 * g + 2], x[8 * g + 3]), cvtpk(x[8 * g + 4], x[8 * g + 5]), cvtpk(x[8 * g + 6], x[8 * g + 7]));
    asm volatile("s_waitcnt lgkmcnt(0)" ::: "memory");
    {
      const bf16x8 zf = {0, 0, 0, 0, 0, 0, 0, 0};
      const bf16x8 la = (q < 2) ? CK_FRAG(CK_LM + (16 + c16) * 144 + q * 16) : zf;
#pragma unroll
      for (int nb = 0; nb < 4; ++nb) {
        const bf16x8 xb = (q < 2) ? *(const bf16x8*)(xrows + (16 * nb + c16) * bstr + q * 16) : zf;
        f32x4 d = (f32x4){0.f, 0.f, 0.f, 0.f};
        d = CK_MMA(la, xb, d);
#pragma unroll
        for (int r = 0; r < 4; ++r) *(float*)(tb + (4 * q + r) * 272 + (16 * nb + c16) * 4) = d[r];
      }
    }
    asm volatile("s_waitcnt lgkmcnt(0)" ::: "memory");
#pragma unroll
    for (int t = 0; t < 16; ++t) x[16 + t] += *(const float*)(tb + t * 272 + lane * 4);
    CK_SWEEP(16, 4)
#undef CK_SWEEP
#undef CK_LCOL
#pragma unroll
    for (int g = 2; g < 4; ++g)
      *(uint4*)(dst + g * 16) = make_uint4(cvtpk(x[8 * g], x[8 * g + 1]), cvtpk(x[8 * g + 2], x[8 * g + 3]), cvtpk(x[8 * g + 4], x[8 * g + 5]), cvtpk(x[8 * g + 6], x[8 * g + 7]));
  } else {
    const int rb = (w - 2) * 32;
#pragma unroll
    for (int g = 0; g < 4; ++g) {
      unsigned e[8];
#pragma unroll
      for (int i = 0; i < 8; ++i) e[i] = *(const bf16_t*)(smem + CK_BK + (rb + 8 * g + i) * 144 + lane * 2);
      *(uint4*)(smem + CK_BKT + lane * 144 + (rb + 8 * g) * 2) = make_uint4(e[0] | (e[1] << 16), e[2] | (e[3] << 16), e[4] | (e[5] << 16), e[6] | (e[7] << 16));
    }
  }
  HSYNCL();
  {
    char* const GA = (char*)p.out + CK_GA_OFF + (size_t)item * 8192;
    char* const HA = (char*)p.out + CK_HA_OFF + (size_t)item * 8192;
    char* const RA = p.ws + OFF_RA + (size_t)item * 4096;
    char* const Y1A = p.ws + OFF_Y1A + (size_t)item * 4096;
    const bf16x8 xw = CK_FRAG(CK_WUT + (16 * w + c16) * 80 + q * 16);
#pragma unroll
    for (int nb = 0; nb < 4; ++nb) {
      f32x4 acc = (f32x4){0.f, 0.f, 0.f, 0.f};
      acc = CK_MMA(xw, CK_FRAG(CK_BKT + (16 * nb + c16) * 144 + q * 16), acc);
      const float pc = *(const float*)(smem + CK_PC + (16 * nb + c16) * 4);
      float g[4];
#pragma unroll
      for (int r = 0; r < 4; ++r) g[r] = (acc[r] + ((16 * w + 4 * q + r) == (16 * nb + c16) ? 1.f : 0.f)) * pc;
      *(uint2*)(GA + ((((nb * 2 + (w >> 1)) * 64 + lane) * 8 + 4 * (w & 1)) << 1)) = pack4(g[0], g[1], g[2], g[3]);
    }
#pragma unroll
    for (int nb = 0; nb < 2; ++nb) {
      f32x4 acc = (f32x4){0.f, 0.f, 0.f, 0.f};
      acc = CK_MMA(xw, CK_FRAG(CK_LM + (32 + 16 * nb + c16) * 144 + q * 16), acc);
      const float4 rt = bf4_to_f4(*(const uint2*)(smem + CK_AR + (32 + 16 * nb + c16) * 144 + (16 * w + 4 * q) * 2));
      *(uint2*)(RA + ((((nb * 2 + (w >> 1)) * 64 + lane) * 8 + 4 * (w & 1)) << 1)) = pack4(acc[0] + rt.x, acc[1] + rt.y, acc[2] + rt.z, acc[3] + rt.w);
    }
    {
      const bf16x8 xb0 = CK_FRAG(CK_BKT + (16 * w + c16) * 144 + q * 16), xb1 = CK_FRAG(CK_BKT + (16 * w + c16) * 144 + 64 + q * 16);
      const float4 pc4 = *(const float4*)(smem + CK_PC + (16 * w + 4 * q) * 4);
#pragma unroll
      for (int nb = 0; nb < 4; ++nb) {
        f32x4 acc = (f32x4){0.f, 0.f, 0.f, 0.f};
        acc = CK_MMA(xb0, CK_FRAG(CK_UVT + (16 * nb + c16) * 144 + q * 16), acc);
        acc = CK_MMA(xb1, CK_FRAG(CK_UVT + (16 * nb + c16) * 144 + 64 + q * 16), acc);
        *(uint2*)(HA + (((nb * 4 + w) * 64 + lane) << 3)) = pack4(acc[0] * pc4.x, acc[1] * pc4.y, acc[2] * pc4.z, acc[3] * pc4.w);
      }
    }
    {
      const int mb = w & 1;
      const bf16x8 xm0 = CK_FRAG(CK_LM + (32 + 16 * mb + c16) * 144 + q * 16), xm1 = CK_FRAG(CK_LM + (32 + 16 * mb + c16) * 144 + 64 + q * 16);
#pragma unroll
      for (int u = 0; u < 2; ++u) {
        const int nb = 2 * (w >> 1) + u;
        f32x4 acc = (f32x4){0.f, 0.f, 0.f, 0.f};
        acc = CK_MMA(xm0, CK_FRAG(CK_UVT + (16 * nb + c16) * 144 + q * 16), acc);
        acc = CK_MMA(xm1, CK_FRAG(CK_UVT + (16 * nb + c16) * 144 + 64 + q * 16), acc);
        *(uint2*)(Y1A + (((nb * 2 + mb) * 64 + lane) << 3)) = pack4(acc[0], acc[1], acc[2], acc[3]);
      }
    }
  }
  HSYNCL();
  }
}

struct SeqSet { uint4 ga[8]; uint4 ra[4]; uint2 ha[4]; uint2 y1[2]; };
__device__ __forceinline__ bf16x8 as_frag(const uint4 u) { return __builtin_bit_cast(bf16x8, u); }
__device__ __forceinline__ f32x4 bf4_to_acc(const uint2 u) {
  return (f32x4){__uint_as_float(u.x << 16), __uint_as_float(u.x & 0xffff0000u), __uint_as_float(u.y << 16), __uint_as_float(u.y & 0xffff0000u)};
}
#define SQ_LOAD(S, it) { \
    const char* ga_ = GA0 + (size_t)(it) * 8192 + lane * 16; const char* ra_ = RA0 + (size_t)(it) * 4096 + lane * 16; \
    const char* ha_ = HA0 + (size_t)(it) * 8192 + (rg * 4 * 64 + lane) * 8; const char* y1_ = Y10 + (size_t)(it) * 4096 + (rg * 2 * 64 + lane) * 8; \
    _Pragma("unroll") for (int i_ = 0; i_ < 8; ++i_) S.ga[i_] = *(const uint4*)(ga_ + i_ * 1024); \
    _Pragma("unroll") for (int i_ = 0; i_ < 4; ++i_) S.ra[i_] = *(const uint4*)(ra_ + i_ * 1024); \
    _Pragma("unroll") for (int i_ = 0; i_ < 4; ++i_) S.ha[i_] = *(const uint2*)(ha_ + i_ * 512); \
    _Pragma("unroll") for (int i_ = 0; i_ < 2; ++i_) S.y1[i_] = *(const uint2*)(y1_ + i_ * 512); }
#define SQ_STEP(S, cidx) { \
    const bf16x8 b0 = as_frag(make_uint4(cvtpk(acc0[0], acc0[1]), cvtpk(acc0[2], acc0[3]), cvtpk(acc1[0], acc1[1]), cvtpk(acc1[2], acc1[3]))); \
    const bf16x8 b1 = as_frag(make_uint4(cvtpk(acc2[0], acc2[1]), cvtpk(acc2[2], acc2[3]), cvtpk(acc3[0], acc3[1]), cvtpk(acc3[2], acc3[3]))); \
    f32x4 y0 = bf4_to_acc(S.y1[0]), y1v = bf4_to_acc(S.y1[1]); \
    y0 = CK_MMA(as_frag(S.ra[0]), b0, y0); y0 = CK_MMA(as_frag(S.ra[1]), b1, y0); \
    y1v = CK_MMA(as_frag(S.ra[2]), b0, y1v); y1v = CK_MMA(as_frag(S.ra[3]), b1, y1v); \
    f32x4 n0 = bf4_to_acc(S.ha[0]), n1 = bf4_to_acc(S.ha[1]), n2 = bf4_to_acc(S.ha[2]), n3 = bf4_to_acc(S.ha[3]); \
    n0 = CK_MMA(as_frag(S.ga[0]), b0, n0); n0 = CK_MMA(as_frag(S.ga[1]), b1, n0); \
    n1 = CK_MMA(as_frag(S.ga[2]), b0, n1); n1 = CK_MMA(as_frag(S.ga[3]), b1, n1); \
    n2 = CK_MMA(as_frag(S.ga[4]), b0, n2); n2 = CK_MMA(as_frag(S.ga[5]), b1, n2); \
    n3 = CK_MMA(as_frag(S.ga[6]), b0, n3); n3 = CK_MMA(as_frag(S.ga[7]), b1, n3); \
    bf16_t* yo_ = YS0 + (size_t)(cidx) * 32 * 512; \
    _Pragma("unroll") for (int r_ = 0; r_ < 4; ++r_) { yo_[(size_t)(4 * q + r_) * 512] = f2bf(y0[r_]); yo_[(size_t)(16 + 4 * q + r_) * 512] = f2bf(y1v[r_]); } \
    acc0 = n0; acc1 = n1; acc2 = n2; acc3 = n3; }
__device__ __forceinline__ void phase_seq(const Params& p) {
  if (VHALF != 0) return;
  int tid_l_ = VTID; asm volatile("" : "+v"(tid_l_)); const int tid = tid_l_, lane = tid & 63, q = lane >> 4, c16 = lane & 15;
  const int rg = __builtin_amdgcn_readfirstlane(tid >> 6);
  const char* const GA0 = (const char*)p.out + CK_GA_OFF; const char* const HA0 = (const char*)p.out + CK_HA_OFF;
  const char* const RA0 = p.ws + OFF_RA; const char* const Y10 = p.ws + OFF_Y1A;
  for (int hd = (int)blockIdx.x; hd < 64; hd += (int)gridDim.x) {
    const int b = hd >> 3, h = hd & 7;
    bf16_t* const YS0 = (bf16_t*)(p.ws + OFF_YS) + (size_t)b * SEQ * 512 + h * 64 + rg * 16 + c16;
    f32x4 acc0 = (f32x4){0.f, 0.f, 0.f, 0.f}, acc1 = acc0, acc2 = acc0, acc3 = acc0;
    SeqSet sa, sb;
    SQ_LOAD(sa, hd * 128)
    for (int c = 0; c < 128; c += 2) {
      SQ_LOAD(sb, hd * 128 + c + 1)
      SQ_STEP(sa, c)
      if (c + 2 < 128) SQ_LOAD(sa, hd * 128 + c + 2)
      SQ_STEP(sb, c + 1)
    }
  }
}


#define CONV_TILES (257 * 96)
struct ConvDesc { const float* src; bf16_t* dst; int ldn, k0, n0, kdim, part; };
__device__ __forceinline__ ConvDesc conv_desc(const Params& p, const int ti) {
  ConvDesc d;
  const int e = ti / 96, q = ti - e * 96, part = q >> 5, w = q & 31;
  d.part = part;
  if (part < 2) {
    d.src = (e < NEXP) ? p.in[18 + part] + (size_t)e * DM * 256 : p.in[21 + part];
    d.ldn = 256; d.k0 = (w >> 1) * 64; d.n0 = (w & 1) * 128; d.kdim = 1024;
    d.dst = (bf16_t*)(p.ws + OFF_EW1 + (size_t)e * 512 * 1024);
  } else {
    d.src = (e < NEXP) ? p.in[20] + (size_t)e * 256 * DM : p.in[23];
    d.ldn = 1024; d.k0 = (w >> 3) * 64; d.n0 = (w & 7) * 128; d.kdim = 256;
    d.dst = (bf16_t*)(p.ws + OFF_EW2 + (size_t)e * 1024 * 256);
  }
  return d;
}
#define CV_LOAD(d, r) { \
    const float* bp_ = (d).src + (size_t)((d).k0 + ko * 8) * (d).ldn + (d).n0 + nq * 4; \
    r##0 = *(const float4*)(bp_); r##1 = *(const float4*)(bp_ + (size_t)1 * (d).ldn); r##2 = *(const float4*)(bp_ + (size_t)2 * (d).ldn); \
    r##3 = *(const float4*)(bp_ + (size_t)3 * (d).ldn); r##4 = *(const float4*)(bp_ + (size_t)4 * (d).ldn); r##5 = *(const float4*)(bp_ + (size_t)5 * (d).ldn); \
    r##6 = *(const float4*)(bp_ + (size_t)6 * (d).ldn); r##7 = *(const float4*)(bp_ + (size_t)7 * (d).ldn); }
#define CV_LDS(r, base) { \
    uint4 v; \
    v.x = cvtpk((r##0).x, (r##1).x); v.y = cvtpk((r##2).x, (r##3).x); v.z = cvtpk((r##4).x, (r##5).x); v.w = cvtpk((r##6).x, (r##7).x); *(uint4*)((base) + lds_off(nq * 4 + 0, ko)) = v; \
    v.x = cvtpk((r##0).y, (r##1).y); v.y = cvtpk((r##2).y, (r##3).y); v.z = cvtpk((r##4).y, (r##5).y); v.w = cvtpk((r##6).y, (r##7).y); *(uint4*)((base) + lds_off(nq * 4 + 1, ko)) = v; \
    v.x = cvtpk((r##0).z, (r##1).z); v.y = cvtpk((r##2).z, (r##3).z); v.z = cvtpk((r##4).z, (r##5).z); v.w = cvtpk((r##6).z, (r##7).z); *(uint4*)((base) + lds_off(nq * 4 + 2, ko)) = v; \
    v.x = cvtpk((r##0).w, (r##1).w); v.y = cvtpk((r##2).w, (r##3).w); v.z = cvtpk((r##4).w, (r##5).w); v.w = cvtpk((r##6).w, (r##7).w); *(uint4*)((base) + lds_off(nq * 4 + 3, ko)) = v; }
#define CV_OUT(d, base) { \
    _Pragma("unroll") for (int u = 0; u < 4; ++u) { \
      const int row = (tid >> 3) + 32 * u, chunk = tid & 7; \
      const int c = (d).n0 + row; \
      const int orow = ((d).part < 2) ? ((c >> 7) * 256 + (d).part * 128 + (c & 127)) : c;     \
      *(uint4*)((d).dst + (size_t)orow * (d).kdim + (d).k0 + chunk * 8) = *(const uint4*)((base) + lds_off(row, chunk)); } }
#define CV8_LDS(r, base, SC) { \
    uint2 v; \
    v.x = pk4_fp8c((r##0).x * SC, (r##1).x * SC, (r##2).x * SC, (r##3).x * SC); v.y = pk4_fp8c((r##4).x * SC, (r##5).x * SC, (r##6).x * SC, (r##7).x * SC); \
    *(uint2*)((base) + (nq * 4 + 0) * 64 + ((ko ^ (nq & 7)) << 3)) = v; \
    v.x = pk4_fp8c((r##0).y * SC, (r##1).y * SC, (r##2).y * SC, (r##3).y * SC); v.y = pk4_fp8c((r##4).y * SC, (r##5).y * SC, (r##6).y * SC, (r##7).y * SC); \
    *(uint2*)((base) + (nq * 4 + 1) * 64 + ((ko ^ (nq & 7)) << 3)) = v; \
    v.x = pk4_fp8c((r##0).z * SC, (r##1).z * SC, (r##2).z * SC, (r##3).z * SC); v.y = pk4_fp8c((r##4).z * SC, (r##5).z * SC, (r##6).z * SC, (r##7).z * SC); \
    *(uint2*)((base) + (nq * 4 + 2) * 64 + ((ko ^ (nq & 7)) << 3)) = v; \
    v.x = pk4_fp8c((r##0).w * SC, (r##1).w * SC, (r##2).w * SC, (r##3).w * SC); v.y = pk4_fp8c((r##4).w * SC, (r##5).w * SC, (r##6).w * SC, (r##7).w * SC); \
    *(uint2*)((base) + (nq * 4 + 3) * 64 + ((ko ^ (nq & 7)) << 3)) = v; }
#define CV8_OUT(d, base) { \
    _Pragma("unroll") for (int u = 0; u < 2; ++u) { \
      const int row = (tid >> 2) + 64 * u, c16_ = tid & 3, f_ = (row >> 2) & 7; \
      const uint2 s0 = *(const uint2*)((base) + row * 64 + (((2 * c16_) ^ f_) << 3)), s1 = *(const uint2*)((base) + row * 64 + (((2 * c16_ + 1) ^ f_) << 3)); \
      const int c = (d).n0 + row; \
      const int orow = ((d).part < 2) ? ((c >> 7) * 256 + (d).part * 128 + (c & 127)) : c; \
      *(uint4*)((char*)(d).dst + (size_t)orow * (d).kdim + (d).k0 + c16_ * 16) = make_uint4(s0.x, s0.y, s1.x, s1.y); } }
__device__ __forceinline__ void convert_tile2(const Params& p, char* smem, const int t2) {
  int tid_l_ = VTID; asm volatile("" : "+v"(tid_l_)); const int tid = tid_l_, nq = tid & 31, ko = tid >> 5;
  const ConvDesc da = conv_desc(p, 2 * t2), db = conv_desc(p, 2 * t2 + 1);
  float4 ra0, ra1, ra2, ra3, ra4, ra5, ra6, ra7, rb0, rb1, rb2, rb3, rb4, rb5, rb6, rb7;
  CV_LOAD(da, ra)
  CV_LOAD(db, rb)
  CV8_LDS(ra, smem, W_SCALE)
  CV8_LDS(rb, smem + 16384, W_SCALE)
  HSYNC();
  CV8_OUT(da, smem)
  CV8_OUT(db, smem + 16384)
  HSYNC();
}
#undef CV_LOAD
#undef CV_LDS
#undef CV_OUT

__device__ __forceinline__ int vt_off(int d, int key) { const int swz = ((d >> 2) & 15) ^ ((d & 3) << 3); return d * 512 + (((key >> 2) ^ swz) << 3); }
__device__ __forceinline__ void attn_item(const Params& p, char* smem, const int item) {
  const bf16_t* __restrict__ Q = (const bf16_t*)(p.ws + OFF_Q); const bf16_t* __restrict__ K = (const bf16_t*)(p.ws + OFF_K);
  const bf16_t* __restrict__ V = (const bf16_t*)(p.ws + OFF_V);
  bf16_t* OP = (bf16_t*)(p.ws + OFF_OP); float* LSE = (float*)(p.ws + OFF_LSE);
  char* Ks = smem; char* VT = smem + 32768; float* linv_s = (float*)(smem + 65536);
  int tid_l_ = VTID; asm volatile("" : "+v"(tid_l_)); const int tid = tid_l_, lane = tid & 63, wid = tid >> 6, l31 = lane & 31, hi = lane >> 5;
  {
    const int pp = item >> 11, rem = item & 2047, bh = rem >> 5, sub = rem & 31;
    const int dsh = pp * 2, nbsh = 5 - dsh;
    const int r = sub >> nbsh, n = sub & ((1 << nbsh) - 1);
    const int b = bh >> 3, h = bh & 7, tb = b * SEQ;
    HSYNC();
#pragma unroll
    for (int u = 0; u < 8; ++u) {
      if (u == 4) __builtin_amdgcn_sched_barrier(0);
      const int row = (tid >> 3) + 32 * u, chunk = tid & 7;
      int ik = n * 128 - 128 + row; ik = ik < 0 ? 0 : ik;
      const int tok = tb + (ik << dsh) + r;
      *(uint4*)(Ks + lds_off(row, chunk)) = *(const uint4*)(K + (size_t)tok * 512 + h * 64 + chunk * 8);
    }
#pragma unroll
    for (int ps = 0; ps < 2; ++ps) {
      const int dq = tid & 15, kbase = ps * 128 + (tid >> 4) * 8;
      uint2 v0, v1, v2, v3, v4, v5, v6, v7;
#define LDV(i, dst) { int ik = n * 128 - 128 + kbase + i; ik = ik < 0 ? 0 : ik; const int tok = tb + (ik << dsh) + r; dst = *(const uint2*)(V + (size_t)tok * 512 + h * 64 + dq * 4); }
      LDV(0, v0) LDV(1, v1) LDV(2, v2) LDV(3, v3) LDV(4, v4) LDV(5, v5) LDV(6, v6) LDV(7, v7)
#undef LDV
      {
        uint2 w;
        w.x = (v0.x & 0xffffu) | (v1.x << 16); w.y = (v2.x & 0xffffu) | (v3.x << 16);
        *(uint2*)(VT + vt_off(dq * 4 + 0, kbase)) = w;
        w.x = (v4.x & 0xffffu) | (v5.x << 16); w.y = (v6.x & 0xffffu) | (v7.x << 16);
        *(uint2*)(VT + vt_off(dq * 4 + 0, kbase + 4)) = w;
        w.x = (v0.x >> 16) | (v1.x & 0xffff0000u); w.y = (v2.x >> 16) | (v3.x & 0xffff0000u);
        *(uint2*)(VT + vt_off(dq * 4 + 1, kbase)) = w;
        w.x = (v4.x >> 16) | (v5.x & 0xffff0000u); w.y = (v6.x >> 16) | (v7.x & 0xffff0000u);
        *(uint2*)(VT + vt_off(dq * 4 + 1, kbase + 4)) = w;
        w.x = (v0.y & 0xffffu) | (v1.y << 16); w.y = (v2.y & 0xffffu) | (v3.y << 16);
        *(uint2*)(VT + vt_off(dq * 4 + 2, kbase)) = w;
        w.x = (v4.y & 0xffffu) | (v5.y << 16); w.y = (v6.y & 0xffffu) | (v7.y << 16);
        *(uint2*)(VT + vt_off(dq * 4 + 2, kbase + 4)) = w;
        w.x = (v0.y >> 16) | (v1.y & 0xffff0000u); w.y = (v2.y >> 16) | (v3.y & 0xffff0000u);
        *(uint2*)(VT + vt_off(dq * 4 + 3, kbase)) = w;
        w.x = (v4.y >> 16) | (v5.y & 0xffff0000u); w.y = (v6.y >> 16) | (v7.y & 0xffff0000u);
        *(uint2*)(VT + vt_off(dq * 4 + 3, kbase + 4)) = w;
      }
    }
    HSYNC();
    const int iq = n * 128 + wid * 32 + l31;
    const int tq = tb + (iq << dsh) + r;
    bf16x8 qf[4];
#pragma unroll
    for (int ks = 0; ks < 4; ++ks) qf[ks] = *(const bf16x8*)(Q + (size_t)tq * 512 + h * 64 + ks * 16 + hi * 8);
    f32x16 st[5];
#pragma unroll
    for (int kb = 0; kb < 5; ++kb) {
      st[kb] = (f32x16){0.f, 0.f, 0.f, 0.f, 0.f, 0.f, 0.f, 0.f, 0.f, 0.f, 0.f, 0.f, 0.f, 0.f, 0.f, 0.f};
#pragma unroll
      for (int ks = 0; ks < 4; ++ks) {
        const bf16x8 kf = *(const bf16x8*)(Ks + lds_off(32 * (wid + kb) + l31, 2 * ks + hi));
        st[kb] = __builtin_amdgcn_mfma_f32_32x32x16_bf16(kf, qf[ks], st[kb], 0, 0, 0);
      }
    }
    float m = -INFINITY;
#pragma unroll
    for (int kb = 0; kb < 5; ++kb)
#pragma unroll
      for (int i = 0; i < 16; ++i) {
        const int kirel = 32 * kb + (i & 3) + 8 * (i >> 2) + 4 * hi;
        const bool valid = (kirel >= l31) && (kirel <= l31 + 128) && (n > 0 || (32 * wid + kirel) >= 128);
        const float s = valid ? st[kb][i] : -INFINITY;
        st[kb][i] = s;
        m = fmaxf(m, s);
      }
    m = fmaxf(m, __shfl_xor(m, 32, 64));
    float l = 0.f;
#pragma unroll
    for (int kb = 0; kb < 5; ++kb)
#pragma unroll
      for (int i = 0; i < 16; ++i) { const float pe = __expf(st[kb][i] - m); st[kb][i] = pe; l += pe; }
    l += __shfl_xor(l, 32, 64);
    f32x16 o0 = (f32x16){0.f, 0.f, 0.f, 0.f, 0.f, 0.f, 0.f, 0.f, 0.f, 0.f, 0.f, 0.f, 0.f, 0.f, 0.f, 0.f};
    f32x16 o1 = o0;
#pragma unroll
    for (int kb = 0; kb < 5; ++kb)
#pragma unroll
      for (int s = 0; s < 2; ++s) {
        union { unsigned u[4]; bf16x8 v; } pa;
        pa.u[0] = cvtpk(st[kb][8 * s + 0], st[kb][8 * s + 1]); pa.u[1] = cvtpk(st[kb][8 * s + 2], st[kb][8 * s + 3]);
        pa.u[2] = cvtpk(st[kb][8 * s + 4], st[kb][8 * s + 5]); pa.u[3] = cvtpk(st[kb][8 * s + 6], st[kb][8 * s + 7]);
        const int key0 = 32 * (wid + kb) + 16 * s + 4 * hi;
        {
          union { uint2 u[2]; bf16x8 v; } vb;
          vb.u[0] = *(const uint2*)(VT + vt_off(l31, key0)); vb.u[1] = *(const uint2*)(VT + vt_off(l31, key0 + 8));
          o0 = __builtin_amdgcn_mfma_f32_32x32x16_bf16(pa.v, vb.v, o0, 0, 0, 0);
        }
        {
          union { uint2 u[2]; bf16x8 v; } vb;
          vb.u[0] = *(const uint2*)(VT + vt_off(32 + l31, key0)); vb.u[1] = *(const uint2*)(VT + vt_off(32 + l31, key0 + 8));
          o1 = __builtin_amdgcn_mfma_f32_32x32x16_bf16(pa.v, vb.v, o1, 0, 0, 0);
        }
      }
    if (hi == 0) {
      linv_s[wid * 32 + l31] = 1.f / l;
      LSE[((size_t)pp * T_TOK + tq) * 8 + h] = m + __logf(l);
    }
#pragma unroll
    for (int i = 0; i < 16; ++i) {
      const int qrel = (i & 3) + 8 * (i >> 2) + 4 * hi;
      const int iq2 = n * 128 + wid * 32 + qrel;
      const int tq2 = tb + (iq2 << dsh) + r;
      const float li = linv_s[wid * 32 + qrel];
      bf16_t* op = OP + ((size_t)pp * T_TOK + tq2) * 512 + h * 64 + l31;
      op[0] = f2bf(o0[i] * li);
      op[32] = f2bf(o1[i] * li);
    }
  }
}

#define CTL_ATTQ 2048
__device__ __forceinline__ unsigned xb_xcc_id();
__device__ __forceinline__ void phase_convert(const Params& p, char* smem) {
  int* ctl = (int*)(p.ws + OFF_CTL);
  int* slot = (int*)(smem + 66304);
  HSYNC();
  if (VTID == 0) { slot[1] = (int)(xb_xcc_id() & 7u); slot[2] = 0; }
  for (;;) {
    if (VTID == 0) {
      int g_ = slot[1], tried_ = slot[2], it_ = -1;
      while (tried_ < 8) {
        const int t_ = atomicAdd(&ctl[CTL_ATTQ + 32 * g_], 1);
        if (t_ < 768) { const int j_ = t_ / 96, w_ = t_ - 96 * j_, pp_ = w_ >> 5, sub_ = w_ & 31; it_ = pp_ * 2048 + (g_ + 8 * j_) * 32 + sub_; break; }
        g_ = (g_ + 1) & 7; ++tried_;
      }
      slot[0] = it_; slot[1] = g_; slot[2] = tried_;
    }
    HSYNC();
    const int ai = slot[0];
    HSYNC();
    if (ai < 0) break;
    attn_item(p, smem, ai);
    __builtin_amdgcn_sched_barrier(0);
#pragma unroll 1
    for (int rep = 0; rep < 2; ++rep) {
      if (VTID == 0) slot[3] = atomicAdd(&ctl[CTL_CONVQ + 2], 1);
      HSYNC();
      const int cp = slot[3];
      HSYNC();
      if (cp < CONV_TILES / 2) convert_tile2(p, smem, cp);
    }
    __builtin_amdgcn_sched_barrier(0);
  }
  for (;;) {
    if (VTID == 0) *slot = atomicAdd(&ctl[CTL_CONVQ], 1);
    HSYNC();
    const int ti = *slot;
    HSYNC();
    if (ti >= 1024) break;
    prep_item<2>(p, smem, (ti >> 2) * 128, (ti & 3) * 128);
    __builtin_amdgcn_sched_barrier(0);
  }
  for (;;) {
    if (VTID == 0) slot[3] = atomicAdd(&ctl[CTL_CONVQ + 2], 1);
    HSYNC();
    const int cp = slot[3];
    HSYNC();
    if (cp >= CONV_TILES / 2) break;
    convert_tile2(p, smem, cp);
    __builtin_amdgcn_sched_barrier(0);
  }
}

__device__ __forceinline__ void unpack8(const uint4 u, float (&f)[8]) {
  f[0] = __uint_as_float(u.x << 16); f[1] = __uint_as_float(u.x & 0xffff0000u); f[2] = __uint_as_float(u.y << 16); f[3] = __uint_as_float(u.y & 0xffff0000u);
  f[4] = __uint_as_float(u.z << 16); f[5] = __uint_as_float(u.z & 0xffff0000u); f[6] = __uint_as_float(u.w << 16); f[7] = __uint_as_float(u.w & 0xffff0000u);
}
__device__ __forceinline__ float dpp_sum8(float v) {
  v += DPP_F(v, 0xB1); v += DPP_F(v, 0x4E); v += DPP_F(v, 0x141);
  return v;
}
__device__ __forceinline__ void phase_post(const Params& p) {
  const bf16_t* __restrict__ YS = (const bf16_t*)(p.ws + OFF_YS); const bf16_t* __restrict__ V2 = (const bf16_t*)(p.ws + OFF_V2);
  const bf16_t* __restrict__ G = (const bf16_t*)(p.ws + OFF_G); const float* __restrict__ SB = (const float*)(p.ws + OFF_SB);
  const bf16_t* __restrict__ OP = (const bf16_t*)(p.ws + OFF_OP); const float* __restrict__ LSE = (const float*)(p.ws + OFF_LSE);
  const float* __restrict__ lnx_g = p.in[11]; const float* __restrict__ lnx_b = p.in[12];
  unsigned char* MIXED = (unsigned char*)(p.ws + OFF_MIXED);
  const int lane = VTID & 63, wid = VTID >> 6;
  const int c = lane * 8, hh = lane >> 3;
  const float4 g0 = *(const float4*)(lnx_g + c), g1 = *(const float4*)(lnx_g + c + 4), b0 = *(const float4*)(lnx_b + c), b1 = *(const float4*)(lnx_b + c + 4);
  const float gg[8] = {g0.x, g0.y, g0.z, g0.w, g1.x, g1.y, g1.z, g1.w}, bb[8] = {b0.x, b0.y, b0.z, b0.w, b1.x, b1.y, b1.z, b1.w};
  for (int t = VBID * 4 + wid; t < T_TOK; t += VGRID * 4) {
    const size_t o = (size_t)t * 512 + c;
    float y[8];
    unpack8(*(const uint4*)(YS + o), y);
    float s = 0.f;
#pragma unroll
    for (int i = 0; i < 8; ++i) s += y[i];
    const float mean = dpp_sum8(s) * (1.f / 64.f);
    float q = 0.f;
#pragma unroll
    for (int i = 0; i < 8; ++i) { const float d = y[i] - mean; q += d * d; }
    const float rs = rsqrtf(dpp_sum8(q) * (1.f / 64.f) + GN_EPS_F);
    float v2[8], gt[8];
    unpack8(*(const uint4*)(V2 + o), v2); unpack8(*(const uint4*)(G + o), gt);
    const float sb = SB[(size_t)t * 8 + hh];
    float res[8];
#pragma unroll
    for (int i = 0; i < 8; ++i) res[i] = ((y[i] - mean) * rs * gg[i] + bb[i] + sb * v2[i]) * gt[i];
    uint2 w; w.x = pk4_fp8c(X_SCALE * res[0], X_SCALE * res[1], X_SCALE * res[2], X_SCALE * res[3]); w.y = pk4_fp8c(X_SCALE * res[4], X_SCALE * res[5], X_SCALE * res[6], X_SCALE * res[7]);
    *(uint2*)(MIXED + (size_t)t * 1024 + 512 + c) = w;
    const float l0 = LSE[((size_t)0 * T_TOK + t) * 8 + hh], l1 = LSE[((size_t)1 * T_TOK + t) * 8 + hh], l2 = LSE[((size_t)2 * T_TOK + t) * 8 + hh];
    const float mx = fmaxf(l0, fmaxf(l1, l2));
    float e0 = __expf(l0 - mx), e1 = __expf(l1 - mx), e2 = __expf(l2 - mx);
    const float inv = 1.f / (e0 + e1 + e2);
    e0 *= inv; e1 *= inv; e2 *= inv;
    float o0[8], o1[8], o2[8];
    unpack8(*(const uint4*)(OP + (size_t)0 * T_TOK * 512 + o), o0); unpack8(*(const uint4*)(OP + (size_t)1 * T_TOK * 512 + o), o1);
    unpack8(*(const uint4*)(OP + (size_t)2 * T_TOK * 512 + o), o2);
    float av[8];
#pragma unroll
    for (int i = 0; i < 8; ++i) av[i] = e0 * o0[i] + e1 * o1[i] + e2 * o2[i];
    w.x = pk4_fp8c(X_SCALE * av[0], X_SCALE * av[1], X_SCALE * av[2], X_SCALE * av[3]); w.y = pk4_fp8c(X_SCALE * av[4], X_SCALE * av[5], X_SCALE * av[6], X_SCALE * av[7]);
    *(uint2*)(MIXED + (size_t)t * 1024 + c) = w;
  }
}

struct EpiOutproj {
  static constexpr bool PERM = true, AFTER_DRAIN = false;
  const float* x; bf16_t* U;
  __device__ __forceinline__ void operator()(const pg8::f32x4 (&acc)[2][2][4][2], const pg8::Unit& u, int wr, int wc, int fr, int fq) const {
#pragma unroll
    for (int ai = 0; ai < 2; ++ai)
#pragma unroll
      for (int m = 0; m < 4; ++m) {
        const int t = u.pm * 256 + ai * 128 + wr * 64 + m * 16 + fr;
#pragma unroll
        for (int bj = 0; bj < 2; ++bj) {
          const size_t o = (size_t)t * DM + u.pn * 256 + bj * 128 + wc * 32 + 8 * fq;
          const float4 x0 = *(const float4*)(x + o), x1 = *(const float4*)(x + o + 4);
          const pg8::f32x4 v0 = acc[ai][bj][m][0] * MOE1_UNSCALE, v1 = acc[ai][bj][m][1] * MOE1_UNSCALE;
          uint4 w;
          w.x = cvtpk(ALPHA_F * x0.x + v0[0], ALPHA_F * x0.y + v0[1]); w.y = cvtpk(ALPHA_F * x0.z + v0[2], ALPHA_F * x0.w + v0[3]);
          w.z = cvtpk(ALPHA_F * x1.x + v1[0], ALPHA_F * x1.y + v1[1]); w.w = cvtpk(ALPHA_F * x1.z + v1[2], ALPHA_F * x1.w + v1[3]);
          *(uint4*)(U + o) = w;
        }
      }
  }
};
__device__ __forceinline__ void phase_outproj(const Params& p, char* smem_all) {
  pg8::Gemm g{(const pg8::bf16_t*)(p.ws + OFF_MIXED), (const pg8::bf16_t*)(p.ws + OFF_WOUTT), T_TOK, DM, DM / 2};
  pg8::StaticOrder S; S.init(T_TOK, DM, (int)gridDim.x, (int)blockIdx.x);
  EpiOutproj E{p.in[0], (bf16_t*)p.out};
  pg8::gemm_phase<EpiOutproj, pg8::StaticOrder, true, true, false, true>((PG8_LAS unsigned char*)smem_all, g, S, E);
}

__device__ __forceinline__ void phase_ln1(const Params& p) {
  const bf16_t* __restrict__ U = (const bf16_t*)p.out;
  const float* __restrict__ g1 = p.in[14]; const float* __restrict__ b1 = p.in[15];
  bf16_t* X1B = (bf16_t*)(p.ws + OFF_X1B);
  unsigned char* X1F8 = (unsigned char*)(p.ws + OFF_X1F8);
  const int lane = VTID & 63, wid = VTID >> 6;
  for (int t = VBID * 4 + wid; t < T_TOK; t += VGRID * 4) {
    const size_t base = (size_t)t * DM;
    float4 v[4];
    float s = 0.f;
#pragma unroll
    for (int u = 0; u < 4; ++u) { v[u] = bf4_to_f4(*(const uint2*)(U + base + u * 256 + lane * 4)); s += (v[u].x + v[u].y) + (v[u].z + v[u].w); }
    const float mean = wave_sum_fast(s) * (1.f / DM);
    float q = 0.f;
#pragma unroll
    for (int u = 0; u < 4; ++u) {
      const float d0 = v[u].x - mean, d1 = v[u].y - mean, d2 = v[u].z - mean, d3 = v[u].w - mean;
      q += (d0 * d0 + d1 * d1) + (d2 * d2 + d3 * d3);
    }
    const float rs = rsqrtf(wave_sum_fast(q) * (1.f / DM) + LN_EPS_F);
#pragma unroll
    for (int u = 0; u < 4; ++u) {
      const int c = u * 256 + lane * 4;
      const float4 g = *(const float4*)(g1 + c), bb = *(const float4*)(b1 + c);
      float4 y;
      y.x = (v[u].x - mean) * rs * g.x + bb.x; y.y = (v[u].y - mean) * rs * g.y + bb.y;
      y.z = (v[u].z - mean) * rs * g.z + bb.z; y.w = (v[u].w - mean) * rs * g.w + bb.w;
      uint2 hi; hi.x = cvtpk(y.x, y.y); hi.y = cvtpk(y.z, y.w);
      *(uint2*)(X1B + base + c) = hi;
      *(unsigned*)(X1F8 + base + c) = pk4_fp8c(X_SCALE * y.x, X_SCALE * y.y, X_SCALE * y.z, X_SCALE * y.w);
    }
  }
}

__device__ __forceinline__ void phase_router_gemm(const Params& p, char* smem) {
  const bf16_t* __restrict__ X1B = (const bf16_t*)(p.ws + OFF_X1B);
  const float* __restrict__ router_w = p.in[16];
  float* AFF = (float*)(p.ws + OFF_AFF);
  for (int item = VBID; item < (T_TOK / 128) * 2; item += VGRID) {
    const int row0 = (item >> 1) * 128, col0 = (item & 1) * 128;
    f32x4 acc[4][4];
    acc_zero(acc);
    gemm128_acc<0, false>(acc, smem, 16,
        [=](int, int rowl, int kc) { return *(const uint4*)(X1B + (size_t)(row0 + rowl) * DM + kc * 8); },
        [=](int nq) { return router_w + col0 + nq * 4; }, NEXP, 0);
    int tid_l_ = VTID; asm volatile("" : "+v"(tid_l_)); const int tid = tid_l_, lane = tid & 63, wid = tid >> 6;
    const int wr = wid >> 1, wc = wid & 1, fr = lane & 15, fq = lane >> 4;
#pragma unroll
    for (int m = 0; m < 4; ++m) {
      const int t = row0 + wr * 64 + m * 16 + fr;
#pragma unroll
      for (int n = 0; n < 4; ++n)
        *(float4*)(AFF + (size_t)t * NEXP + col0 + wc * 64 + n * 16 + fq * 4) =
            make_float4(sigmoidf_(acc[m][n][0]), sigmoidf_(acc[m][n][1]), sigmoidf_(acc[m][n][2]), sigmoidf_(acc[m][n][3]));
    }
  }
}

__device__ __forceinline__ void phase_topk(const Params& p) {
  const float* __restrict__ AFF = (const float*)(p.ws + OFF_AFF);
  const float* __restrict__ router_bias = p.in[17];
  int* LIST = (int*)(p.ws + OFF_LIST); float* GATEW = (float*)(p.ws + OFF_GATEW);
  int* counts = (int*)(p.ws + OFF_CTL);
  const int lane = VTID & 63, wid = VTID >> 6;
  const float4 b4 = *(const float4*)(router_bias + lane * 4);
  const int t0 = VBID * 4 + wid, tstep = VGRID * 4;
  float4 a4n = make_float4(0.f, 0.f, 0.f, 0.f);
  if (t0 < T_TOK) a4n = *(const float4*)(AFF + (size_t)t0 * NEXP + lane * 4);
  int pend_e = 0, pend_pos = LCAP, pend_t = 0;
  for (int t = t0; t < T_TOK; t += tstep) {
    const float4 a4 = a4n;
    if (t + tstep < T_TOK) a4n = *(const float4*)(AFF + (size_t)(t + tstep) * NEXP + lane * 4);
    float s0 = a4.x + b4.x, s1 = a4.y + b4.y, s2 = a4.z + b4.z, s3 = a4.w + b4.w;
    const float hi01 = fmaxf(s0, s1), lo01 = fminf(s0, s1), hi23 = fmaxf(s2, s3), lo23 = fminf(s2, s3);
    float m1 = fmaxf(hi01, hi23), m2 = fmaxf(fminf(hi01, hi23), fmaxf(lo01, lo23));
    { const float o1 = DPP_F(m1, 0xB1), o2 = DPP_F(m2, 0xB1); const float n1 = fmaxf(m1, o1); m2 = fmaxf(fminf(m1, o1), fmaxf(m2, o2)); m1 = n1; }
    { const float o1 = DPP_F(m1, 0x4E), o2 = DPP_F(m2, 0x4E); const float n1 = fmaxf(m1, o1); m2 = fmaxf(fminf(m1, o1), fmaxf(m2, o2)); m1 = n1; }
    { const float o1 = DPP_F(m1, 0x141), o2 = DPP_F(m2, 0x141); const float n1 = fmaxf(m1, o1); m2 = fmaxf(fminf(m1, o1), fmaxf(m2, o2)); m1 = n1; }
    const float gs = m1 + m2;
    const int g = lane >> 3;
    int rank = 0;
#pragma unroll
    for (int gg = 0; gg < 8; ++gg) { const float G = rdlane_f(gs, gg * 8); rank += ((G > gs) || (G == gs && gg < g)) ? 1 : 0; }
    if (rank >= 4) { s0 = -INFINITY; s1 = -INFINITY; s2 = -INFINITY; s3 = -INFINITY; }
    int my_e = 0; float my_a = 0.f;
#pragma unroll 1
    for (int it = 0; it < 8; ++it) {
      const float lm = fmaxf(fmaxf(s0, s1), fmaxf(s2, s3));
      const float wm = wave_max_fast(lm);
      const unsigned long long bal = __ballot(lm == wm);
      const int win = __ffsll((long long)bal) - 1;
      const int wi = (s0 == wm) ? 0 : ((s1 == wm) ? 1 : ((s2 == wm) ? 2 : 3));
      const float wa = (wi == 0) ? a4.x : ((wi == 1) ? a4.y : ((wi == 2) ? a4.z : a4.w));
      const int e_w = __builtin_amdgcn_readlane(lane * 4 + wi, win);
      const float a_w = rdlane_f(wa, win);
      if (lane == win) { if (wi == 0) s0 = -INFINITY; else if (wi == 1) s1 = -INFINITY; else if (wi == 2) s2 = -INFINITY; else s3 = -INFINITY; }
      if (lane == it) { my_e = e_w; my_a = a_w; }
    }
    const float asum = rdlane_f(dpp_sum16x(my_a), 0);
    __builtin_amdgcn_sched_barrier(0);
    if (lane < 8) {
      if (pend_pos < LCAP) LIST[(size_t)pend_e * LCAP + pend_pos] = lane * T_TOK + pend_t;
      pend_pos = atomicAdd(&counts[CNT(my_e)], 1); pend_e = my_e; pend_t = t;
      GATEW[(size_t)lane * T_TOK + t] = my_a * 2.5f / asum;
    }
  }
  if (lane < 8 && pend_pos < LCAP) LIST[(size_t)pend_e * LCAP + pend_pos] = lane * T_TOK + pend_t;
}

#define CTL_MOEPRE 1536
struct SeqOrder {
  int n;
  __device__ __forceinline__ bool next(int i, pg8::Unit& u) const { if (i >= n) return false; u.pm = 0; u.pn = i; return true; }
  __device__ __forceinline__ void a_ready(const pg8::Unit&) const {}
  __device__ __forceinline__ void done(const pg8::Unit&) const {}
};
struct EpiMoe1 {
  static constexpr bool PERM = true, AFTER_DRAIN = false;
  bf16_t* HS;
  __device__ __forceinline__ void operator()(const pg8::f32x4 (&acc)[2][2][4][2], const pg8::Unit& u, int wr, int wc, int fr, int fq) const {
#pragma unroll
    for (int ai = 0; ai < 2; ++ai)
#pragma unroll
      for (int m = 0; m < 4; ++m) {
        __builtin_amdgcn_sched_barrier(0);
        const int row = ai * 128 + wr * 64 + m * 16 + fr;
        const pg8::f32x4 g0 = acc[ai][0][m][0] * MOE1_UNSCALE, g1 = acc[ai][0][m][1] * MOE1_UNSCALE, u0 = acc[ai][1][m][0] * MOE1_UNSCALE, u1 = acc[ai][1][m][1] * MOE1_UNSCALE;
        uint2 w;
        w.x = pk4_fp8c(H_SCALE * g0[0] * sigmoidf_(g0[0]) * u0[0], H_SCALE * g0[1] * sigmoidf_(g0[1]) * u0[1], H_SCALE * g0[2] * sigmoidf_(g0[2]) * u0[2], H_SCALE * g0[3] * sigmoidf_(g0[3]) * u0[3]);
        w.y = pk4_fp8c(H_SCALE * g1[0] * sigmoidf_(g1[0]) * u1[0], H_SCALE * g1[1] * sigmoidf_(g1[1]) * u1[1], H_SCALE * g1[2] * sigmoidf_(g1[2]) * u1[2], H_SCALE * g1[3] * sigmoidf_(g1[3]) * u1[3]);
        *(uint2*)((char*)HS + (size_t)row * 256 + u.pn * 128 + wc * 32 + 8 * fq) = w;
      }
  }
};
struct EpiMoe2 {
  static constexpr bool PERM = true, AFTER_DRAIN = false;
  const int* asg; bf16_t* Y;
  __device__ __forceinline__ void operator()(const pg8::f32x4 (&acc)[2][2][4][2], const pg8::Unit& u, int wr, int wc, int fr, int fq) const {
#pragma unroll
    for (int ai = 0; ai < 2; ++ai)
#pragma unroll
      for (int m = 0; m < 4; ++m) {
        __builtin_amdgcn_sched_barrier(0);
        const int a = asg[256 + ai * 128 + wr * 64 + m * 16 + fr];
        if (a < 0) continue;
        {
          const float gw = __int_as_float(asg[512 + ai * 128 + wr * 64 + m * 16 + fr]) * (Y_SCALE * MOE2_UNSCALE);
#pragma unroll
          for (int bj = 0; bj < 2; ++bj) {
            const pg8::f32x4 v0 = acc[ai][bj][m][0], v1 = acc[ai][bj][m][1];
            uint2 w; w.x = pk4_fp8c(v0[0] * gw, v0[1] * gw, v0[2] * gw, v0[3] * gw); w.y = pk4_fp8c(v1[0] * gw, v1[1] * gw, v1[2] * gw, v1[3] * gw);
            *(uint2*)((unsigned char*)Y + (size_t)a * DM + u.pn * 256 + bj * 128 + wc * 32 + 8 * fq) = w;
          }
        }
      }
  }
};
#define MOE_TAB_OFF (WG_LDS_OFF + 128 + 1152)
__device__ __forceinline__ unsigned xb_xcc_id();
#define CTL_MOEQ 1536
__device__ __forceinline__ void phase_moe(const Params& p, char* smem_all, int* slot) {
  int* tab = (int*)(smem_all + MOE_TAB_OFF);
  int* ctl = (int*)(p.ws + OFF_CTL);
  int* pre = (int*)(smem_all + WG_LDS_OFF + 128);
  if (threadIdx.x < 64) {
    const int l = threadIdx.x, g0 = l >> 3, i0 = (4 * l) & 31;
    const int t0 = (min(ctl[CNT((i0 + 0) * 8 + g0)], LCAP) + 255) >> 8, t1 = (min(ctl[CNT((i0 + 1) * 8 + g0)], LCAP) + 255) >> 8;
    const int t2 = (min(ctl[CNT((i0 + 2) * 8 + g0)], LCAP) + 255) >> 8, t3 = (min(ctl[CNT((i0 + 3) * 8 + g0)], LCAP) + 255) >> 8;
    const int tot = t0 + t1 + t2 + t3;
    int inc = tot;
#pragma unroll
    for (int o = 1; o < 64; o <<= 1) { const int v = __shfl_up(inc, o, 64); if (l >= o) inc += v; }
    const int base = inc - tot;
    pre[4 * l] = base; pre[4 * l + 1] = base + t0; pre[4 * l + 2] = base + t0 + t1; pre[4 * l + 3] = base + t0 + t1 + t2;
    if (l == 63) { pre[NEXP] = inc; pre[NEXP + 1] = inc + T_TOK / 256; }
  }
  if (threadIdx.x == 0) { slot[1] = (int)(xb_xcc_id() & 7u); slot[2] = 0; }
  __syncthreads();
  bf16_t* HS = (bf16_t*)(p.ws + OFF_HSCR) + (size_t)blockIdx.x * 256 * 256;
#define MOE_DRAW(CTLP) { if (threadIdx.x == 0) { \
    int g_ = slot[1], tried_ = slot[2], it_ = -1; \
    while (tried_ < 8) { \
      const int r0_ = pre[32 * g_], nr_ = pre[32 * g_ + 32] - r0_;                                   \
      const int t_ = atomicAdd(&(CTLP)[CTL_MOEQ + 32 * g_], 1); \
      if (t_ < nr_ + 16) { it_ = (t_ < nr_) ? (r0_ + t_) : (pre[NEXP] + 16 * g_ + (t_ - nr_)); break; } \
      g_ = (g_ + 1) & 7; ++tried_; \
    } \
    slot[0] = it_; slot[1] = g_; slot[2] = tried_; } }
#define MOE_FETCH(i_, e_, a_, LISTP, CNTP) { \
    e_ = 0; a_ = -1; \
    if ((i_) >= 0) { \
      int lo = 0, hi = NEXP;                               \
      while (lo < hi) { const int mid = (lo + hi + 1) >> 1; if (pre[mid] <= (i_)) lo = mid; else hi = mid - 1; } \
      e_ = (lo < NEXP) ? ((lo & 31) * 8 + (lo >> 5)) : NEXP; \
      const int cnt_ = (e_ < NEXP) ? min((CNTP)[CNT(e_)], LCAP) : T_TOK; \
      const int r_ = ((i_) - pre[lo]) * 256 + (int)(threadIdx.x & 255); \
      a_ = (r_ < cnt_) ? ((e_ < NEXP) ? (LISTP)[(size_t)e_ * LCAP + r_] : (8 * T_TOK + r_)) : -1; \
    } }
  MOE_DRAW(ctl)
  __syncthreads();
  int i = *slot, e, a;
  { const int* __restrict__ LIST0 = (const int*)(p.ws + OFF_LIST); const int* counts0 = (const int*)(p.ws + OFF_CTL); MOE_FETCH(i, e, a, LIST0, counts0) }
  for (;;) {
    if (i < 0) break;
    const __attribute__((address_space(4))) char* ka_ = (const __attribute__((address_space(4))) char*)__builtin_amdgcn_kernarg_segment_ptr();
    asm volatile("" : "+s"(ka_));
    char* const wsl = *(char* const __attribute__((address_space(4)))*)(ka_ + __builtin_offsetof(Params, ws));
    const int* __restrict__ LISTl = (const int*)(wsl + OFF_LIST); const int* countsl = (const int*)(wsl + OFF_CTL); const float* __restrict__ GATEWl = (const float*)(wsl + OFF_GATEW);
    __syncthreads();
    if (threadIdx.x < 256) {
      tab[256 + threadIdx.x] = a;
      tab[threadIdx.x] = (a >= 0 ? a : 0) & (T_TOK - 1);
      tab[512 + threadIdx.x] = __float_as_int((a >= 0 && a < 8 * T_TOK) ? GATEWl[a] : 1.f);
    }
    __syncthreads();
    {
      int k1 = DM / 2; asm volatile("" : "+s"(k1));
      pg8::Gemm g{(const pg8::bf16_t*)(wsl + OFF_X1F8), (const pg8::bf16_t*)(wsl + OFF_EW1 + (size_t)e * 512 * 1024), 256, 512, k1};
      SeqOrder S{2};
      EpiMoe1 E{HS};
      pg8::gemm_phase<EpiMoe1, SeqOrder, true, true, true, true>((PG8_LAS unsigned char*)smem_all, g, S, E, tab);
    }
    const int e_cur = e;
    MOE_DRAW((int*)(wsl + OFF_CTL))
    __syncthreads();
    i = *slot;
    MOE_FETCH(i, e, a, LISTl, countsl)
    {
      int k2 = 128; asm volatile("" : "+s"(k2));
      pg8::Gemm g{(const pg8::bf16_t*)HS, (const pg8::bf16_t*)(wsl + OFF_EW2 + (size_t)e_cur * 1024 * 256), 256, DM, k2};
      SeqOrder S{4};
      EpiMoe2 E{tab, (bf16_t*)(wsl + OFF_Y)};
      pg8::gemm_phase<EpiMoe2, SeqOrder, true, true, false, true>((PG8_LAS unsigned char*)smem_all, g, S, E);
    }
  }
#undef MOE_FETCH
#undef MOE_DRAW
}

__device__ __forceinline__ void phase_final(const Params& p, char* smem) {
  float* OUT = p.out;
  const unsigned char* __restrict__ Y = (const unsigned char*)(p.ws + OFF_Y);
  const bf16_t* __restrict__ X1B = (const bf16_t*)(p.ws + OFF_X1B);
  const float* __restrict__ g2 = p.in[24]; const float* __restrict__ b2 = p.in[25];
  const int lane = VTID & 63, wid = VTID >> 6;
  for (int t = VBID * 4 + wid; t < T_TOK; t += VGRID * 4) {
    const size_t base = (size_t)t * DM;
    float4 v[4];
    float s = 0.f;
#pragma unroll
    for (int u = 0; u < 2; ++u) {
      const int c = u * 512 + lane * 8;
      float xf[8];
      unpack8(*(const uint4*)(X1B + base + c), xf);
      float a0 = 0.f, a1 = 0.f, a2 = 0.f, a3 = 0.f, a4 = 0.f, a5 = 0.f, a6 = 0.f, a7 = 0.f;
#pragma unroll
      for (int sl = 0; sl < 9; ++sl) {
        const uint2 yw = *(const uint2*)(Y + ((size_t)sl * T_TOK + t) * DM + c);
        const f32x2_t y01 = __builtin_amdgcn_cvt_pk_f32_fp8((int)yw.x, false), y23 = __builtin_amdgcn_cvt_pk_f32_fp8((int)yw.x, true);
        const f32x2_t y45 = __builtin_amdgcn_cvt_pk_f32_fp8((int)yw.y, false), y67 = __builtin_amdgcn_cvt_pk_f32_fp8((int)yw.y, true);
        a0 += y01[0]; a1 += y01[1]; a2 += y23[0]; a3 += y23[1]; a4 += y45[0]; a5 += y45[1]; a6 += y67[0]; a7 += y67[1];
      }
      const float iy = 1.f / Y_SCALE;
      v[2 * u] = make_float4(ALPHA_F * xf[0] + iy * a0, ALPHA_F * xf[1] + iy * a1, ALPHA_F * xf[2] + iy * a2, ALPHA_F * xf[3] + iy * a3);
      v[2 * u + 1] = make_float4(ALPHA_F * xf[4] + iy * a4, ALPHA_F * xf[5] + iy * a5, ALPHA_F * xf[6] + iy * a6, ALPHA_F * xf[7] + iy * a7);
      s += ((v[2 * u].x + v[2 * u].y) + (v[2 * u].z + v[2 * u].w)) + ((v[2 * u + 1].x + v[2 * u + 1].y) + (v[2 * u + 1].z + v[2 * u + 1].w));
    }
    const float mean = wave_sum_fast(s) * (1.f / DM);
    float q = 0.f;
#pragma unroll
    for (int u = 0; u < 4; ++u) {
      const float d0 = v[u].x - mean, d1 = v[u].y - mean, d2 = v[u].z - mean, d3 = v[u].w - mean;
      q += (d0 * d0 + d1 * d1) + (d2 * d2 + d3 * d3);
    }
    const float rs = rsqrtf(wave_sum_fast(q) * (1.f / DM) + LN_EPS_F);
#pragma unroll
    for (int u = 0; u < 4; ++u) {
      const int c = (u >> 1) * 512 + lane * 8 + (u & 1) * 4;
      const float4 g = *(const float4*)(g2 + c), bb = *(const float4*)(b2 + c);
      *(float4*)(OUT + base + c) = make_float4((v[u].x - mean) * rs * g.x + bb.x, (v[u].y - mean) * rs * g.y + bb.y,
                                               (v[u].z - mean) * rs * g.z + bb.z, (v[u].w - mean) * rs * g.w + bb.w);
    }
  }
}

#define LAS __attribute__((address_space(3)))
#define XB_TMO      128
#define XB_XCNT(j)  (256  + 64 * (j))
#define XB_XSUB(j)  (1280 + 64 * (j))
#define XB_XGEN(j)  (2304 + 64 * (j))
#define XB_TOP      3328
#define XB_TOPGEN   3392
#define XCD_BAR_WORDS 3456
#define XB_SPIN_CAP (1u << 22)
__device__ __forceinline__ unsigned xb_ld(unsigned* p)              { return __hip_atomic_load(p, __ATOMIC_RELAXED, __HIP_MEMORY_SCOPE_AGENT); }
__device__ __forceinline__ unsigned xb_add(unsigned* p, unsigned v) { return __hip_atomic_fetch_add(p, v, __ATOMIC_RELAXED, __HIP_MEMORY_SCOPE_AGENT); }
__device__ __forceinline__ unsigned xb_xcc_id() { return (unsigned)__builtin_amdgcn_s_getreg((3 << 11) | 20) & 0xFu; }
#define XB_SPIN(cond, bar) do { unsigned _sp = 0; while (cond) { __builtin_amdgcn_s_sleep(1); \
    if ((++_sp & 255u) == 0u) { if (xb_ld(&(bar)[XB_TMO])) break; if (_sp > XB_SPIN_CAP) { atomicAdd(&(bar)[XB_TMO], 1u); break; } } } } while (0)
struct XcdBarrier { unsigned* bar; unsigned x; volatile LAS unsigned* st; };
__device__ __forceinline__ XcdBarrier xcd_barrier_post(unsigned* bar, volatile LAS unsigned* st) {
  XcdBarrier b; b.bar = bar; b.x = xb_xcc_id(); b.st = st;
  if (threadIdx.x == 0) (void)xb_add(&bar[XB_XCNT(b.x)], 1u);
  return b;
}
__device__ __forceinline__ void xcd_barrier_complete(unsigned* bar, unsigned x, unsigned& nloc, unsigned& nx) {
  const unsigned G = gridDim.x * gridDim.y * gridDim.z;
  unsigned sum, cnt, mine, sp = 0u;
  for (;;) {
    sum = 0u; cnt = 0u; mine = 0u;
#pragma unroll
    for (unsigned j = 0; j < 16; ++j) { const unsigned c = xb_ld(&bar[XB_XCNT(j)]); sum += c; cnt += (c > 0u) ? 1u : 0u; mine = (j == x) ? c : mine; }
    if (sum == G) break;
    __builtin_amdgcn_s_sleep(1);
    if ((++sp & 255u) == 0u) { if (xb_ld(&bar[XB_TMO])) break; if (sp > XB_SPIN_CAP) { atomicAdd(&bar[XB_TMO], 1u); break; } }
  }
  nloc = mine > 0u ? mine : 1u; nx = cnt > 0u ? cnt : 1u;
}
__device__ __forceinline__ void xcd_barrier(const XcdBarrier& b) {
  asm volatile("s_waitcnt vmcnt(0)" ::: "memory");
  __syncthreads();
  if (threadIdx.x == 0) {
    unsigned* bar = b.bar;
    __builtin_amdgcn_s_waitcnt(0);
    unsigned nloc = b.st[0], nx = b.st[1];
    if (nloc == 0u) { xcd_barrier_complete(bar, b.x, nloc, nx); b.st[0] = nloc; b.st[1] = nx; }
    const unsigned old = xb_add(&bar[XB_XSUB(b.x)], 1u);
    const unsigned gen = old / nloc;
    if (old + 1u == (gen + 1u) * nloc) {
      __builtin_amdgcn_fence(__ATOMIC_RELEASE, "agent");
      asm volatile("s_waitcnt vmcnt(0)" ::: "memory");
      const unsigned og = xb_add(&bar[XB_TOP], 1u);
      const unsigned tg = og / nx;
      if (og + 1u == (tg + 1u) * nx) xb_add(&bar[XB_TOPGEN], 1u);
      else XB_SPIN(xb_ld(&bar[XB_TOPGEN]) == tg, bar);
      __builtin_amdgcn_fence(__ATOMIC_ACQUIRE, "agent");
      xb_add(&bar[XB_XGEN(b.x)], 1u);
      asm volatile("s_waitcnt vmcnt(0)" ::: "memory");
    } else {
      XB_SPIN(xb_ld(&bar[XB_XGEN(b.x)]) == gen, bar);
      __builtin_amdgcn_fence(__ATOMIC_ACQUIRE, "agent");
      asm volatile("s_waitcnt vmcnt(0)" ::: "memory");
    }
  }
  __syncthreads();
}
#define CTL_BAR_WORD 4096
#define CTL_ZERO_BYTES 65536
#define LDS_BAR_OFF 66432

#define LDS_TOTAL (2 * HALF_LDS + 128 + 1152 + 3072)
__global__ void __launch_bounds__(512, 2) mega(Params p) {
  extern __shared__ __attribute__((aligned(16))) char smem_all[];
  cg::grid_group grid = cg::this_grid();
  char* const smem = smem_all + VHALF * HALF_LDS;
  volatile LAS unsigned* bst = (volatile LAS unsigned*)(LAS char*)(smem_all + WG_LDS_OFF);
  int* const slot = (int*)(smem_all + WG_LDS_OFF + 16);
  if (threadIdx.x < 2) { bst[threadIdx.x] = 0u; ((int*)(smem_all + WG_LDS_OFF + 32))[threadIdx.x] = 0; }
  __syncthreads();
  const XcdBarrier bar = xcd_barrier_post((unsigned*)(p.ws + OFF_CTL) + CTL_BAR_WORD, bst);
  phase_rope(p);
  if (p.ws == nullptr) grid.sync();
  xcd_barrier(bar);
  phase_inproj(p, smem_all);
  xcd_barrier(bar);
  phase_prep_a(p);
  xcd_barrier(bar);
  phase_prep(p, smem);
  xcd_barrier(bar);
  phase_chunk_pre(p, smem);
  xcd_barrier(bar);
  phase_seq(p);
  phase_convert(p, smem);
  xcd_barrier(bar);
  phase_post(p);
  xcd_barrier(bar);
  phase_outproj(p, smem_all);
  xcd_barrier(bar);
  phase_ln1(p);
  xcd_barrier(bar);
  phase_router_gemm(p, smem);
  xcd_barrier(bar);
  phase_topk(p);
  xcd_barrier(bar);
  phase_moe(p, smem_all, slot);
  xcd_barrier(bar);
  phase_final(p, smem);
}

extern "C" void kernel_launch(void* const* d_in, const int* in_sizes, int n_in, void* d_out, int out_size, void* d_ws, size_t ws_size,
                              hipStream_t stream) {
  static int grid_blocks = 0;
  if (grid_blocks == 0) {
    if (ws_size < WS_NEED || n_in != 26) { fprintf(stderr, "kernel_launch: bad ws/n_in: %zu < %zu, n_in %d\n", ws_size, (size_t)WS_NEED, n_in); grid_blocks = -1; return; }
    int dev = 0, cus = 0, per_cu = 0;
    (void)hipGetDevice(&dev);
    (void)hipDeviceGetAttribute(&cus, hipDeviceAttributeMultiprocessorCount, dev);
    (void)hipFuncSetAttribute((const void*)mega, hipFuncAttributeMaxDynamicSharedMemorySize, LDS_TOTAL);
    (void)hipOccupancyMaxActiveBlocksPerMultiprocessor(&per_cu, (const void*)mega, 512, LDS_TOTAL);
    if (per_cu < 1) { fprintf(stderr, "kernel_launch: occupancy query returned %d\n", per_cu); grid_blocks = -1; return; }
    if (per_cu > 1) per_cu = 1;
    grid_blocks = cus * per_cu;
    if (grid_blocks > 256) grid_blocks = 256;
    fprintf(stderr, "kernel_launch: cus %d per_cu %d grid %d\n", cus, per_cu, grid_blocks);
  }
  if (grid_blocks < 0) return;
  if (hipMemsetAsync((char*)d_ws + OFF_CTL, 0, CTL_ZERO_BYTES, stream) != hipSuccess) { fprintf(stderr, "kernel_launch: memset failed\n"); return; }
  Params p{};
  for (int i = 0; i < 26; ++i) p.in[i] = (const float*)d_in[i];
  p.out = (float*)d_out;
  p.ws = (char*)d_ws;
  void* args[] = {&p};
  hipError_t e = hipLaunchCooperativeKernel((const void*)mega, dim3(grid_blocks), dim3(512), args, LDS_TOTAL, stream);
  if (e != hipSuccess) fprintf(stderr, "cooperative launch failed: %s (grid %d)\n", hipGetErrorString(e), grid_blocks);
}
```

```cpp
#include <hip/hip_runtime.h>
#include <hip/hip_bf16.h>
#include <hip/hip_cooperative_groups.h>
#include <stdint.h>
#include <stdio.h>

typedef unsigned short bf16_t;

#define T_TOK 32768
#define SEQ 4096
#define DM 1024
#define INW 3360
#define FEW 1824
#define NEXP 256
#define ALPHA_F 1.189207115002721f
#define LN_EPS_F 1e-5f
#define GN_EPS_F 64e-5f

__device__ __forceinline__ float bf2f(bf16_t v) { return __uint_as_float(((unsigned)v) << 16); }
__device__ __forceinline__ bf16_t f2bf(float f) { unsigned u = __float_as_uint(f); return (bf16_t)((u + 0x7fffu + ((u >> 16) & 1u)) >> 16); }
__device__ __forceinline__ float sigmoidf_(float x) { return 1.f / (1.f + __expf(-x)); }
__device__ __forceinline__ float wave_sum(float v) {
#pragma unroll
  for (int o = 32; o >= 1; o >>= 1) v += __shfl_xor(v, o, 64);
  return v;
}

constexpr size_t SZ_T512_BF = (size_t)T_TOK * 512 * 2;
constexpr size_t OFF_EW1 = 0;
constexpr size_t OFF_EW2 = OFF_EW1 + (size_t)257 * 512 * 1024 * 2;
constexpr size_t LBASE = OFF_EW2 + (size_t)257 * 1024 * 256 * 2;
constexpr size_t OFF_X1F8 = OFF_EW1 + (size_t)257 * 512 * 1024;
static_assert(OFF_X1F8 + (size_t)T_TOK * 1024 <= OFF_EW2, "X1F8 fits behind the fp8 EW1");
constexpr size_t OFF_XB = 0;
constexpr size_t OFF_FEATS = OFF_XB + (size_t)T_TOK * 1024 * 2;
constexpr size_t OFF_WINT = OFF_FEATS + (size_t)T_TOK * FEW * 2;
constexpr size_t OFF_ROPE = OFF_WINT + (size_t)3584 * 1024 * 2;
static_assert(OFF_ROPE + (size_t)4096 * 32 * 2 * 4 <= LBASE, "early region E overlay");
constexpr size_t OFF_Q = LBASE;
constexpr size_t OFF_K = OFF_Q + SZ_T512_BF;
constexpr size_t OFF_V = OFF_K + SZ_T512_BF;
constexpr size_t OFF_R = OFF_V + SZ_T512_BF;
constexpr size_t OFF_K2 = OFF_R + SZ_T512_BF;
constexpr size_t OFF_V2 = OFF_K2 + SZ_T512_BF;
constexpr size_t OFF_A = OFF_V2 + SZ_T512_BF;
constexpr size_t OFF_B = OFF_A + SZ_T512_BF;
constexpr size_t OFF_W = OFF_B + SZ_T512_BF;
constexpr size_t OFF_G = OFF_W + (size_t)T_TOK * 512 * 4;
constexpr size_t OFF_SB = OFF_G + SZ_T512_BF;
constexpr size_t OFF_YS = OFF_SB + (size_t)T_TOK * 8 * 4;
constexpr size_t OFF_OP = OFF_YS + (size_t)T_TOK * 512 * 4;
constexpr size_t OFF_LSE = OFF_OP + 3 * SZ_T512_BF;
constexpr size_t OFF_MIXED = OFF_LSE + (size_t)3 * T_TOK * 8 * 4;
constexpr size_t OFF_WOUTT = OFF_MIXED + (size_t)T_TOK * 1024 * 2;
constexpr size_t EARLY_END = OFF_WOUTT + (size_t)1024 * 1024 * 2;
constexpr size_t OFF_Y = LBASE;
constexpr size_t OFF_AFF = LBASE + (size_t)T_TOK * 1024 * 2;
constexpr size_t OFF_X1B = OFF_Y + (size_t)8 * T_TOK * 1024 * 2;
#define LCAP 16384
constexpr size_t OFF_LIST = OFF_X1B + (size_t)T_TOK * 1024 * 2;
constexpr size_t OFF_GATEW = OFF_LIST + (size_t)NEXP * LCAP * 4;
constexpr size_t OFF_HSCR = OFF_GATEW + (size_t)8 * T_TOK * 4;
constexpr size_t OFF_ACT = OFF_HSCR;
static_assert((size_t)T_TOK * 320 * 2 <= (size_t)512 * 128 * 256 * 2, "ACT fits the HSCR space");
constexpr size_t OFF_CTL = OFF_HSCR + (size_t)512 * 128 * 256 * 2;
constexpr size_t CTL_BYTES = 1u << 20;
constexpr size_t WS_NEED = OFF_CTL + CTL_BYTES;
static_assert(EARLY_END <= OFF_HSCR, "early buffers must stay below the per-block scratch / control words");
static_assert(WS_NEED <= (size_t)1073741824, "workspace must fit 1 GiB");
#define CTL_CONVQ 512
#define CTL_CNT 8192
#define CNT(e) (CTL_CNT + 32 * (e))

typedef short bf16x8 __attribute__((ext_vector_type(8)));
typedef float f32x4 __attribute__((ext_vector_type(4)));
typedef float f32x16 __attribute__((ext_vector_type(16)));
typedef float f32x2_t __attribute__((ext_vector_type(2)));
typedef __bf16 bf16x2_t __attribute__((ext_vector_type(2)));
__device__ __forceinline__ unsigned cvtpk(float lo, float hi) { f32x2_t v = {lo, hi}; bf16x2_t b = __builtin_convertvector(v, bf16x2_t); return __builtin_bit_cast(unsigned, b); }

__device__ __forceinline__ unsigned pk4_fp8c(float a, float b, float c, float d) {
  a = __builtin_amdgcn_fmed3f(a, -440.f, 440.f); b = __builtin_amdgcn_fmed3f(b, -440.f, 440.f);
  c = __builtin_amdgcn_fmed3f(c, -440.f, 440.f); d = __builtin_amdgcn_fmed3f(d, -440.f, 440.f);
  int v = __builtin_amdgcn_cvt_pk_fp8_f32(a, b, 0, false);
  v = __builtin_amdgcn_cvt_pk_fp8_f32(c, d, v, true);
  return (unsigned)v;
}
#define W_SCALE 256.f
#define X_SCALE 16.f
#define H_SCALE 16.f
#define MOE1_UNSCALE (1.f / (X_SCALE * W_SCALE))
#define MOE2_UNSCALE (1.f / (H_SCALE * W_SCALE))
#define Y_SCALE 32.f
__device__ const double INVF[32] = {
1, 0.74989420933245587, 0.56234132519034907, 0.42169650342858223, 0.31622776601683794, 0.23713737056616552,
0.17782794100389229, 0.1333521432163324, 0.10000000000000001, 0.074989420933245579, 0.056234132519034911,
0.042169650342858224, 0.031622776601683791, 0.023713737056616554, 0.017782794100389229, 0.013335214321633241,
0.01, 0.0074989420933245579, 0.005623413251903491, 0.0042169650342858229, 0.0031622776601683794,
0.0023713737056616554, 0.0017782794100389228, 0.0013335214321633241, 0.001, 0.00074989420933245586,
0.0005623413251903491, 0.00042169650342858224, 0.00031622776601683794, 0.00023713737056616554,
0.00017782794100389227, 0.0001333521432163324};

namespace cg = cooperative_groups;

struct Params {
  const float* in[26];
  float* out;
  char* ws;
};

#define NTHR 256
#define VTID ((int)(threadIdx.x & 255))
#define VHALF (__builtin_amdgcn_readfirstlane((int)(threadIdx.x >> 8)))
#define VBID ((int)(blockIdx.x * 2) + VHALF)
#define VGRID ((int)(gridDim.x * 2))
#define HALF_LDS 66560
extern __shared__ __attribute__((aligned(16))) char g_lds[];
#define WG_LDS_OFF (2 * HALF_LDS)
__device__ __forceinline__ void half_sync() {
  asm volatile("s_waitcnt vmcnt(0) lgkmcnt(0)" ::: "memory");
  int* cnt = (int*)(g_lds + WG_LDS_OFF + 32) + VHALF;
  if ((threadIdx.x & 63) == 0) {
    const int old = __hip_atomic_fetch_add(cnt, 1, __ATOMIC_RELAXED, __HIP_MEMORY_SCOPE_WORKGROUP);
    const int target = (old & ~3) + 4;
    while (__hip_atomic_load(cnt, __ATOMIC_RELAXED, __HIP_MEMORY_SCOPE_WORKGROUP) < target) __builtin_amdgcn_s_sleep(1);
  }
  __builtin_amdgcn_fence(__ATOMIC_ACQUIRE, "workgroup");
  asm volatile("s_waitcnt lgkmcnt(0)" ::: "memory");
}
#define HSYNC() half_sync()
__device__ __forceinline__ void half_sync_lds() {
  asm volatile("s_waitcnt lgkmcnt(0)" ::: "memory");
  int* cnt = (int*)(g_lds + WG_LDS_OFF + 32) + VHALF;
  if ((threadIdx.x & 63) == 0) {
    const int old = __hip_atomic_fetch_add(cnt, 1, __ATOMIC_RELAXED, __HIP_MEMORY_SCOPE_WORKGROUP);
    const int target = (old & ~3) + 4;
    while (__hip_atomic_load(cnt, __ATOMIC_RELAXED, __HIP_MEMORY_SCOPE_WORKGROUP) < target) __builtin_amdgcn_s_sleep(1);
  }
  __builtin_amdgcn_fence(__ATOMIC_ACQUIRE, "workgroup");
  asm volatile("s_waitcnt lgkmcnt(0)" ::: "memory");
}
#define HSYNCL() half_sync_lds()

#define LDS_BYTES 66560

__device__ __forceinline__ void phase_rope(const Params& p) {
  float* tab = (float*)(p.ws + OFF_ROPE);
  for (int i = VBID * NTHR + VTID; i < 4096 * 32; i += VGRID * NTHR) {
    int pos = i >> 5, f = i & 31;
    double ang = (double)pos * INVF[f];
    const double TWO_PI = 6.283185307179586476925286766559;
    double n = rint(ang / TWO_PI);
    double r = ang - n * TWO_PI;
    double r2 = r * r;
    double sn = r, cs = 1.0, ts = r, tc = 1.0;
#pragma unroll 1
    for (int k = 1; k <= 16; ++k) {
      tc = -tc * r2 / (double)((2 * k - 1) * (2 * k));
      ts = -ts * r2 / (double)((2 * k) * (2 * k + 1));
      cs += tc; sn += ts;
    }
    tab[i * 2] = (float)cs; tab[i * 2 + 1] = (float)sn;
  }
  {
    const float* __restrict__ w_in = p.in[1]; const float* __restrict__ w_out = p.in[13];
    uint4* wint = (uint4*)(p.ws + OFF_WINT); uint4* woutt = (uint4*)(p.ws + OFF_WOUTT);
    const int NJ1 = 3584 * 128, NJ2 = 1024 * 128;
    for (int i = VBID * NTHR + VTID; i < NJ1 + NJ2; i += VGRID * NTHR) {
      const bool second = i >= NJ1;
      const int q = second ? i - NJ1 : i;
      const int N = second ? 1024 : 3584, NV = second ? 1024 : INW;
      const int s = q % N, ko = q / N;
      const int n = second ? s : ((s & ~63) + (((s & 63) >> 3) << 2) + (s & 3) + (((s >> 2) & 1) << 5));
      const float* __restrict__ src = second ? w_out : w_in;
      float f[8];
#pragma unroll
      for (int u = 0; u < 8; ++u) f[u] = (n < NV) ? src[(size_t)(ko * 8 + u) * NV + n] : 0.f;
      if (second) {
        uint2 w; w.x = pk4_fp8c(W_SCALE * f[0], W_SCALE * f[1], W_SCALE * f[2], W_SCALE * f[3]); w.y = pk4_fp8c(W_SCALE * f[4], W_SCALE * f[5], W_SCALE * f[6], W_SCALE * f[7]);
        ((uint2*)woutt)[(size_t)s * 128 + ko] = w;
      } else { uint4 w; w.x = cvtpk(f[0], f[1]); w.y = cvtpk(f[2], f[3]); w.z = cvtpk(f[4], f[5]); w.w = cvtpk(f[6], f[7]); wint[(size_t)s * 128 + ko] = w; }
    }
  }
  {
    const float4* __restrict__ x4 = (const float4*)p.in[0];
    uint4* xb = (uint4*)(p.ws + OFF_XB);
    for (size_t i = (size_t)VBID * NTHR + VTID; i < (size_t)T_TOK * DM / 8; i += (size_t)VGRID * NTHR) {
      float4 a = x4[2 * i], b = x4[2 * i + 1];
      uint4 w; w.x = cvtpk(a.x, a.y); w.y = cvtpk(a.z, a.w); w.z = cvtpk(b.x, b.y); w.w = cvtpk(b.z, b.w);
      xb[i] = w;
    }
  }
}

template <class AF, class BF>
__device__ __forceinline__ void gemm64_naive(float* As, float* Bs, float* Cs, int K, AF af, BF bf) {
  int tid_l_ = VTID; asm volatile("" : "+v"(tid_l_)); const int tid = tid_l_, tx = tid & 15, ty = tid >> 4;
  float acc[4][4];
#pragma unroll
  for (int i = 0; i < 4; ++i)
#pragma unroll
    for (int j = 0; j < 4; ++j) acc[i][j] = 0.f;
  for (int k0 = 0; k0 < K; k0 += 16) {
#pragma unroll
    for (int u = 0; u < 4; ++u) { int i = tid + u * 256; int r = i >> 4, kk = i & 15; As[kk * 68 + r] = af(r, k0 + kk); }
#pragma unroll
    for (int u = 0; u < 4; ++u) { int i = tid + u * 256; int kk = i >> 6, c = i & 63; Bs[kk * 68 + c] = bf(k0 + kk, c); }
    HSYNC();
#pragma unroll
    for (int kk = 0; kk < 16; ++kk) {
      float a[4], b[4];
#pragma unroll
      for (int i = 0; i < 4; ++i) { a[i] = As[kk * 68 + ty * 4 + i]; b[i] = Bs[kk * 68 + tx * 4 + i]; }
#pragma unroll
      for (int i = 0; i < 4; ++i)
#pragma unroll
        for (int j = 0; j < 4; ++j) acc[i][j] += a[i] * b[j];
    }
    HSYNC();
  }
#pragma unroll
  for (int i = 0; i < 4; ++i)
#pragma unroll
    for (int j = 0; j < 4; ++j) Cs[(ty * 4 + i) * 65 + tx * 4 + j] = acc[i][j];
  HSYNC();
}


__device__ __forceinline__ int lds_off(int row, int chunk) { return row * 128 + ((chunk ^ ((row >> 1) & 7)) << 4); }

template <int BMODE>
__device__ __forceinline__ unsigned cvtpk_m(float a, float b, const bool lo = false) {
  if (BMODE == 0 || (BMODE == 2 && !lo)) return cvtpk(a, b);
  const unsigned h = cvtpk(a, b);
  const float ah = __uint_as_float(h << 16), bh = __uint_as_float(h & 0xffff0000u);
  return cvtpk(a - ah, b - bh);
}
#define G128_MMA(bufoff) { \
    _Pragma("unroll") for (int kk = 0; kk < 2; ++kk) { \
      bf16x8 af[4], bfr[4]; \
      _Pragma("unroll") for (int m = 0; m < 4; ++m) af[m] = *(const bf16x8*)(smem + (bufoff) + lds_off(wr * 64 + m * 16 + fr, kk * 4 + fq)); \
      _Pragma("unroll") for (int n = 0; n < 4; ++n) bfr[n] = *(const bf16x8*)(smem + (bufoff) + 16384 + lds_off(wc * 64 + n * 16 + fr, kk * 4 + fq)); \
      _Pragma("unroll") for (int m = 0; m < 4; ++m) \
        _Pragma("unroll") for (int n = 0; n < 4; ++n) acc[m][n] = __builtin_amdgcn_mfma_f32_16x16x32_bf16(bfr[n], af[m], acc[m][n], 0, 0, 0); \
    } }
template <int BMODE, bool KCLAMP, class ALoad, class BPtr>
__device__ __forceinline__ void gemm128_acc(f32x4 (&acc)[4][4], char* smem, const int nk, ALoad aload, BPtr bptr, const int ldb, const int kvalid) {
  int tid_l_ = VTID; asm volatile("" : "+v"(tid_l_)); const int tid = tid_l_, lane = tid & 63, wid = tid >> 6;
  const int wr = wid >> 1, wc = wid & 1, fr = lane & 15, fq = lane >> 4;
  const int achunk = tid & 7, arow0 = tid >> 3;
  const int nq = tid & 31, ko = tid >> 5;
  const float* bp0 = bptr(nq);
  const int oa0 = lds_off(arow0, achunk), oa1 = lds_off(arow0 + 32, achunk), oa2 = lds_off(arow0 + 64, achunk), oa3 = lds_off(arow0 + 96, achunk);
  const int ob0 = 16384 + lds_off(nq * 4 + 0, ko), ob1 = 16384 + lds_off(nq * 4 + 1, ko), ob2 = 16384 + lds_off(nq * 4 + 2, ko), ob3 = 16384 + lds_off(nq * 4 + 3, ko);
  uint4 ra0, ra1, ra2, ra3; float4 rb0, rb1, rb2, rb3, rb4, rb5, rb6, rb7;
#define G128_LOAD(kt) { \
    ra0 = aload(0, arow0, (kt) * 8 + achunk); ra1 = aload(1, arow0 + 32, (kt) * 8 + achunk); \
    ra2 = aload(2, arow0 + 64, (kt) * 8 + achunk); ra3 = aload(3, arow0 + 96, (kt) * 8 + achunk); \
    int kr_ = (kt) * 64 + ko * 8; \
    if (KCLAMP) kr_ = min(kr_, kvalid - 8);     \
    { \
      const float* b2_ = bp0 + (size_t)((BMODE == 2) ? (kr_ & 1023) : kr_) * ldb; \
      rb0 = *(const float4*)(b2_); rb1 = *(const float4*)(b2_ + (size_t)1 * ldb); rb2 = *(const float4*)(b2_ + (size_t)2 * ldb); \
      rb3 = *(const float4*)(b2_ + (size_t)3 * ldb); rb4 = *(const float4*)(b2_ + (size_t)4 * ldb); rb5 = *(const float4*)(b2_ + (size_t)5 * ldb); \
      rb6 = *(const float4*)(b2_ + (size_t)6 * ldb); rb7 = *(const float4*)(b2_ + (size_t)7 * ldb); \
    } }
#define G128_STORE(bufoff, lo_) { \
    char* const sb_ = smem + (bufoff); \
    *(uint4*)(sb_ + oa0) = ra0; *(uint4*)(sb_ + oa1) = ra1; *(uint4*)(sb_ + oa2) = ra2; *(uint4*)(sb_ + oa3) = ra3; \
    uint4 w; \
    w.x = cvtpk_m<BMODE>(rb0.x, rb1.x, lo_); w.y = cvtpk_m<BMODE>(rb2.x, rb3.x, lo_); w.z = cvtpk_m<BMODE>(rb4.x, rb5.x, lo_); w.w = cvtpk_m<BMODE>(rb6.x, rb7.x, lo_); \
    *(uint4*)(sb_ + ob0) = w; \
    w.x = cvtpk_m<BMODE>(rb0.y, rb1.y, lo_); w.y = cvtpk_m<BMODE>(rb2.y, rb3.y, lo_); w.z = cvtpk_m<BMODE>(rb4.y, rb5.y, lo_); w.w = cvtpk_m<BMODE>(rb6.y, rb7.y, lo_); \
    *(uint4*)(sb_ + ob1) = w; \
    w.x = cvtpk_m<BMODE>(rb0.z, rb1.z, lo_); w.y = cvtpk_m<BMODE>(rb2.z, rb3.z, lo_); w.z = cvtpk_m<BMODE>(rb4.z, rb5.z, lo_); w.w = cvtpk_m<BMODE>(rb6.z, rb7.z, lo_); \
    *(uint4*)(sb_ + ob2) = w; \
    w.x = cvtpk_m<BMODE>(rb0.w, rb1.w, lo_); w.y = cvtpk_m<BMODE>(rb2.w, rb3.w, lo_); w.z = cvtpk_m<BMODE>(rb4.w, rb5.w, lo_); w.w = cvtpk_m<BMODE>(rb6.w, rb7.w, lo_); \
    *(uint4*)(sb_ + ob3) = w; }
  G128_LOAD(0)
  G128_STORE(0, false)
  if (nk > 1) G128_LOAD(1)
  HSYNC();
  for (int kt = 0; kt < nk; ++kt) {
    const int cur = (kt & 1) * 32768;
    __builtin_amdgcn_sched_barrier(0);
    G128_MMA(cur)
    __builtin_amdgcn_sched_barrier(0);
    if (kt + 1 < nk) {
      G128_STORE(cur ^ 32768, (kt + 1) >= kvalid)
      __builtin_amdgcn_sched_barrier(0);
      if (kt + 2 < nk) G128_LOAD(kt + 2)
    }
    __builtin_amdgcn_sched_barrier(0);
    HSYNC();
  }
#undef G128_LOAD
#undef G128_STORE
}
__device__ __forceinline__ void acc_zero(f32x4 (&acc)[4][4]) {
#pragma unroll
  for (int m = 0; m < 4; ++m)
#pragma unroll
    for (int n = 0; n < 4; ++n) acc[m][n] = (f32x4){0.f, 0.f, 0.f, 0.f};
}
template <class ARow, class BPtr, class Epi>
__device__ __forceinline__ void gemm128(char* smem, const int K, ARow arow, BPtr bptr, const int ldb, Epi epi) {
  int tid_l_ = VTID; asm volatile("" : "+v"(tid_l_)); const int tid = tid_l_, lane = tid & 63, wid = tid >> 6;
  const int arow0 = tid >> 3;
  const bf16_t* ap0 = arow(arow0);
  const bf16_t* ap1 = arow(arow0 + 32);
  const bf16_t* ap2 = arow(arow0 + 64);
  const bf16_t* ap3 = arow(arow0 + 96);
  f32x4 acc[4][4];
  acc_zero(acc);
  gemm128_acc<0, false>(acc, smem, K >> 6,
      [=](int u, int, int kc) { const bf16_t* q = (u == 0) ? ap0 : (u == 1) ? ap1 : (u == 2) ? ap2 : ap3; return *(const uint4*)(q + kc * 8); },
      bptr, ldb, 0);
  epi(acc, wid >> 1, wid & 1, lane & 15, lane >> 4);
}


template <class ALoad, class BLoad>
__device__ __forceinline__ void gemm128_acc_bb(f32x4 (&acc)[4][4], char* smem, const int nk, ALoad aload, BLoad bload) {
  int tid_l_ = VTID; asm volatile("" : "+v"(tid_l_)); const int tid = tid_l_, lane = tid & 63, wid = tid >> 6;
  const int wr = wid >> 1, wc = wid & 1, fr = lane & 15, fq = lane >> 4;
  const int achunk = tid & 7, arow0 = tid >> 3;
  const int oa0 = lds_off(arow0, achunk), oa1 = lds_off(arow0 + 32, achunk), oa2 = lds_off(arow0 + 64, achunk), oa3 = lds_off(arow0 + 96, achunk);
  uint4 ra0, ra1, ra2, ra3, rb0, rb1, rb2, rb3;
#define G128_LOADBB(kt) { \
    ra0 = aload(0, arow0, (kt) * 8 + achunk); ra1 = aload(1, arow0 + 32, (kt) * 8 + achunk); \
    ra2 = aload(2, arow0 + 64, (kt) * 8 + achunk); ra3 = aload(3, arow0 + 96, (kt) * 8 + achunk); \
    rb0 = bload(0, arow0, (kt) * 8 + achunk); rb1 = bload(1, arow0 + 32, (kt) * 8 + achunk); \
    rb2 = bload(2, arow0 + 64, (kt) * 8 + achunk); rb3 = bload(3, arow0 + 96, (kt) * 8 + achunk); }
#define G128_STOREBB(bufoff) { \
    char* const sb_ = smem + (bufoff); \
    *(uint4*)(sb_ + oa0) = ra0; *(uint4*)(sb_ + oa1) = ra1; *(uint4*)(sb_ + oa2) = ra2; *(uint4*)(sb_ + oa3) = ra3; \
    *(uint4*)(sb_ + 16384 + oa0) = rb0; *(uint4*)(sb_ + 16384 + oa1) = rb1; *(uint4*)(sb_ + 16384 + oa2) = rb2; *(uint4*)(sb_ + 16384 + oa3) = rb3; }
  G128_LOADBB(0)
  G128_STOREBB(0)
  if (nk > 1) G128_LOADBB(1)
  HSYNC();
  for (int kt = 0; kt < nk; ++kt) {
    const int cur = (kt & 1) * 32768;
    __builtin_amdgcn_sched_barrier(0);
    G128_MMA(cur)
    __builtin_amdgcn_sched_barrier(0);
    if (kt + 1 < nk) {
      G128_STOREBB(cur ^ 32768)
      __builtin_amdgcn_sched_barrier(0);
      if (kt + 2 < nk) G128_LOADBB(kt + 2)
    }
    __builtin_amdgcn_sched_barrier(0);
    HSYNC();
  }
#undef G128_LOADBB
#undef G128_STOREBB
}
template <class ARow, class BRow, class Epi>
__device__ __forceinline__ void gemm128_bb(char* smem, const int K, ARow arow, BRow brow, Epi epi) {
  int tid_l_ = VTID; asm volatile("" : "+v"(tid_l_)); const int tid = tid_l_, lane = tid & 63, wid = tid >> 6;
  const int arow0 = tid >> 3;
  const bf16_t* ap0 = arow(arow0); const bf16_t* ap1 = arow(arow0 + 32); const bf16_t* ap2 = arow(arow0 + 64); const bf16_t* ap3 = arow(arow0 + 96);
  const bf16_t* bp0 = brow(arow0); const bf16_t* bp1 = brow(arow0 + 32); const bf16_t* bp2 = brow(arow0 + 64); const bf16_t* bp3 = brow(arow0 + 96);
  f32x4 acc[4][4];
  acc_zero(acc);
  gemm128_acc_bb(acc, smem, K >> 6,
      [=](int u, int, int kc) { const bf16_t* q = (u == 0) ? ap0 : (u == 1) ? ap1 : (u == 2) ? ap2 : ap3; return *(const uint4*)(q + kc * 8); },
      [=](int u, int, int kc) { const bf16_t* q = (u == 0) ? bp0 : (u == 1) ? bp1 : (u == 2) ? bp2 : bp3; return *(const uint4*)(q + kc * 8); });
  epi(acc, wid >> 1, wid & 1, lane & 15, lane >> 4);
}


#define GAS1 __attribute__((address_space(1)))
#define LAS3 __attribute__((address_space(3)))
__device__ __forceinline__ void glds16(const void* g, char* l) {
  __builtin_amdgcn_global_load_lds((const GAS1 void*)g, (LAS3 void*)l, 16, 0, 0);
}
template <class ARow, class BRow, class Epi>
__device__ __forceinline__ void gemm128_glds(char* smem, const int K, ARow arow, BRow brow, Epi epi) {
  int tid_l_ = VTID; asm volatile("" : "+v"(tid_l_)); const int tid = tid_l_, lane = tid & 63, wid = tid >> 6;
  const int wr = wid >> 1, wc = wid & 1, fr = lane & 15, fq = lane >> 4;
  const int r0 = tid >> 3;
  const int cl = (tid & 7) ^ ((tid >> 4) & 7);
  const bf16_t* ga0 = arow(r0) + cl * 8; const bf16_t* ga1 = arow(r0 + 32) + cl * 8; const bf16_t* ga2 = arow(r0 + 64) + cl * 8; const bf16_t* ga3 = arow(r0 + 96) + cl * 8;
  const bf16_t* gb0 = brow(r0) + cl * 8; const bf16_t* gb1 = brow(r0 + 32) + cl * 8; const bf16_t* gb2 = brow(r0 + 64) + cl * 8; const bf16_t* gb3 = brow(r0 + 96) + cl * 8;
  char* const lbase = smem + tid * 16;
#define GL_STAGE(bufoff, kt) { \
    char* const d_ = lbase + (bufoff); const int ko_ = (kt) * 64; \
    glds16(ga0 + ko_, d_); glds16(ga1 + ko_, d_ + 4096); glds16(ga2 + ko_, d_ + 8192); glds16(ga3 + ko_, d_ + 12288); \
    glds16(gb0 + ko_, d_ + 16384); glds16(gb1 + ko_, d_ + 20480); glds16(gb2 + ko_, d_ + 24576); glds16(gb3 + ko_, d_ + 28672); }
  f32x4 acc[4][4];
  acc_zero(acc);
  const int nk = K >> 6;
  GL_STAGE(0, 0)
  asm volatile("s_waitcnt vmcnt(0)" ::: "memory");
  HSYNC();
  for (int kt = 0; kt < nk; ++kt) {
    const int cur = (kt & 1) * 32768;
    if (kt + 1 < nk) GL_STAGE(cur ^ 32768, kt + 1)
    G128_MMA(cur)
    asm volatile("s_waitcnt vmcnt(0)" ::: "memory");
    HSYNC();
  }
#undef GL_STAGE
  epi(acc, wr, wc, fr, fq);
}


template <int NCALL, int NK, class ARow, class BRow, class Epi>
__device__ __forceinline__ void gemm128_glds_multi(char* smem, ARow arow, BRow brow, const size_t bstride, Epi epi) {
  int tid_l_ = VTID; asm volatile("" : "+v"(tid_l_)); const int tid = tid_l_, lane = tid & 63, wid = tid >> 6;
  const int wr = wid >> 1, wc = wid & 1, fr = lane & 15, fq = lane >> 4;
  const int r0 = tid >> 3;
  const int cl = (tid & 7) ^ ((tid >> 4) & 7);
  const bf16_t* ga0 = arow(r0) + cl * 8; const bf16_t* ga1 = arow(r0 + 32) + cl * 8; const bf16_t* ga2 = arow(r0 + 64) + cl * 8; const bf16_t* ga3 = arow(r0 + 96) + cl * 8;
  const bf16_t* gb0 = brow(r0) + cl * 8; const bf16_t* gb1 = brow(r0 + 32) + cl * 8; const bf16_t* gb2 = brow(r0 + 64) + cl * 8; const bf16_t* gb3 = brow(r0 + 96) + cl * 8;
  char* const lbase = smem + tid * 16;
#define GM_STAGE(bufoff, g) { \
    char* const d_ = lbase + (bufoff); const int ko_ = ((g) % NK) * 64; const size_t bo_ = (size_t)((g) / NK) * bstride + ko_; \
    glds16(ga0 + ko_, d_); glds16(ga1 + ko_, d_ + 4096); glds16(ga2 + ko_, d_ + 8192); glds16(ga3 + ko_, d_ + 12288); \
    glds16(gb0 + bo_, d_ + 16384); glds16(gb1 + bo_, d_ + 20480); glds16(gb2 + bo_, d_ + 24576); glds16(gb3 + bo_, d_ + 28672); }
  f32x4 acc[4][4];
  acc_zero(acc);
  constexpr int G = NCALL * NK;
  GM_STAGE(0, 0)
  asm volatile("s_waitcnt vmcnt(0)" ::: "memory");
  HSYNC();
#pragma unroll 1
  for (int g = 0; g < G; ++g) {
    const int cur = (g & 1) * 32768;
    if (g + 1 < G) GM_STAGE(cur ^ 32768, g + 1)
    G128_MMA(cur)
    if ((g % NK) == NK - 1) {
      epi(g / NK, acc, wr, wc, fr, fq);
      acc_zero(acc);
    }
    asm volatile("s_waitcnt vmcnt(0)" ::: "memory");
    HSYNC();
  }
#undef GM_STAGE
}


namespace pg8 {
#define PG8_LAS __attribute__((address_space(3)))
typedef unsigned short bf16_t;
typedef short bf16x8 __attribute__((ext_vector_type(8)));
typedef float f32x4 __attribute__((ext_vector_type(4)));
typedef unsigned u32x4 __attribute__((ext_vector_type(4)));
typedef int i32x4 __attribute__((ext_vector_type(4)));
typedef int i32x8 __attribute__((ext_vector_type(8)));
constexpr int BM = 256, BK = 64, HALF = 128, HTB = HALF * BK * 2  , STAGE_BYTES = 8 * HTB, NXCD = 8, WGM = 8;

__host__ __device__ __forceinline__ int lds_byte(int r, int c) { const int st = (r >> 4) * 2 + (c >> 5), rr = r & 15, cc = c & 31, ob = rr * 64 + cc * 2; return st * 1024 + (ob ^ (((ob >> 9) & 1) << 5)); }
__host__ __device__ __forceinline__ void stage_rc(int b, int& R, int& C) { const int st = b / 1024, sb = b % 1024, swz = sb ^ (((sb >> 9) & 1) << 5); R = (st >> 1) * 16 + swz / 64; C = (st & 1) * 32 + (swz % 64) / 2; }
__host__ __device__ __forceinline__ int perm32(int rho) { const int n = rho >> 4, i = rho & 15; return 8 * (i >> 2) + 4 * n + (i & 3); }

struct Unit { int pm, pn; };
struct Gemm { const bf16_t* A; const bf16_t* Bt; int M, N, K; };

struct StaticOrder {
    int nM, nN, nwg, G, c;
    __host__ __device__ void init(int M, int N, int G_, int c_) { nM = M / BM; nN = N / BM; nwg = nM * nN; G = G_; c = c_; }
    __host__ __device__ bool next(int i, Unit& u) const {
        const long L = (long)i * G + c; if (L >= nwg) return false;
        int wgid = (int)L; { const int q = nwg / NXCD, r = nwg % NXCD, xcd = wgid % NXCD, off = wgid / NXCD; wgid = (xcd < r ? xcd * (q + 1) : r * (q + 1) + (xcd - r) * q) + off; }
        const int nig = WGM * nN, gid = wgid / nig, fm = gid * WGM, gsz = (nM - fm) < WGM ? (nM - fm) : WGM;
        u.pm = fm + ((wgid % nig) % gsz); u.pn = (wgid % nig) / gsz; return true;
    }
    __device__ __forceinline__ void a_ready(const Unit&) const {}
    __device__ __forceinline__ void done(const Unit&) const {}
};
template <class Epi, class Sched, bool ALIGN_EPI = false, bool SP2 = false, bool GATHER = false, bool FP8 = false>
__device__ __forceinline__ void gemm_phase(PG8_LAS unsigned char* lds, const Gemm g, const Sched& S, const Epi& E, const int* rowidx = nullptr) {
    int tid_ = threadIdx.x; asm volatile("" : "+v"(tid_));
    const int tid = tid_, wid = __builtin_amdgcn_readfirstlane(tid >> 6), lane = tid & 63, wr = wid >> 2, wc = wid & 3, fr = lane & 15, fq = lane >> 4;
    const int K = g.K, nt = K / BK;
    unsigned voffA[2], voffA1[2], voffB[2];
#pragma unroll
    for (int i = 0; i < 2; ++i) { int R, C; stage_rc(tid * 16 + i * 8192, R, C); const int Rb = Epi::PERM ? ((R & ~31) + perm32(R & 31)) : R;
        if (GATHER) { voffA[i] = ((unsigned)rowidx[R] * (unsigned)K + (unsigned)C) * 2u; voffA1[i] = ((unsigned)rowidx[128 + R] * (unsigned)K + (unsigned)C) * 2u; }
        else { voffA[i] = (unsigned)(R * K + C) * 2u; voffA1[i] = voffA[i]; }
        voffB[i] = (unsigned)(Rb * K + C) * 2u; }
    const size_t hstepA = GATHER ? (size_t)0 : (size_t)HALF * K * 2;
    const size_t kstep = (size_t)(BK * 2);
    const size_t hstep = (size_t)HALF * K * 2;
    const size_t tstep = 2 * hstep;
    const unsigned ldsw = (unsigned)wid * 1024u;
    const int aoff = lds_byte(wr * 64 + fr, fq * 8), boff = lds_byte(wc * 32 + fr, fq * 8);
#define PG8_SA(b, h) (((b) * 2 + (h)) * HTB)
#define PG8_SB(b, h) ((4 + (b) * 2 + (h)) * HTB)
#define PG8_STAGE(bufoff, gbase, voff) do { _Pragma("unroll") for (int _i = 0; _i < 2; ++_i) \
        __builtin_amdgcn_global_load_lds((const unsigned*)((const char*)(gbase) + (voff)[_i]), (PG8_LAS unsigned*)(lds + (bufoff) + ldsw + _i * 8192), 16, 0, 0); } while (0)
#define PG8_LDA(dst, b, h) do { _Pragma("unroll") for (int m = 0; m < 4; ++m) _Pragma("unroll") for (int k = 0; k < 2; ++k) dst[m][k] = *(const PG8_LAS bf16x8*)(lds + PG8_SA(b, h) + aoff + m * 2048 + k * 1024); } while (0)
#define PG8_LDB(dst, b, h) do { _Pragma("unroll") for (int n = 0; n < 2; ++n) _Pragma("unroll") for (int k = 0; k < 2; ++k) dst[n][k] = *(const PG8_LAS bf16x8*)(lds + PG8_SB(b, h) + boff + n * 2048 + k * 1024); } while (0)
#define PG8_MMA(ai, bj, At, Bt) do { __builtin_amdgcn_s_setprio(1); _Pragma("unroll") for (int m = 0; m < 4; ++m) _Pragma("unroll") for (int n = 0; n < 2; ++n) _Pragma("unroll") for (int k = 0; k < 2; ++k) \
        acc[ai][bj][m][n] = __builtin_amdgcn_mfma_f32_16x16x32_bf16(Bt[n][k], At[m][k], acc[ai][bj][m][n], 0, 0, 0); __builtin_amdgcn_s_setprio(0); } while (0)
#define PG8_LD8(off) __builtin_shufflevector(*(const PG8_LAS i32x4*)(lds + (off)), *(const PG8_LAS i32x4*)(lds + (off) + 1024), 0, 1, 2, 3, 4, 5, 6, 7)
#define PG8_LDA_F(dst, b, h) do { if constexpr (FP8) { A8[0] = PG8_LD8(PG8_SA(b, h) + aoff); A8[1] = PG8_LD8(PG8_SA(b, h) + aoff + 2048); } else PG8_LDA(dst, b, h); } while (0)
#define PG8_LDB_F(dst, b, h) do { if constexpr (FP8) { dst##8[0] = PG8_LD8(PG8_SB(b, h) + boff); dst##8[1] = PG8_LD8(PG8_SB(b, h) + boff + 2048); } else PG8_LDB(dst, b, h); } while (0)
#define PG8_MFMA8(ai, bj, m, n, Bt) asm volatile("v_mfma_scale_f32_16x16x128_f8f6f4 %0, %1, %2, %0, %3, %3 op_sel_hi:[0,0,0]" : "+v"(acc[ai][bj][m][n]) : "v"(Bt##8[n]), "v"(A8[(m) & 1]), "v"(one8))
#define PG8_MMA_PAIR(ai, b, h) do { if constexpr (FP8) { __builtin_amdgcn_s_setprio(1); \
        PG8_MFMA8(ai, 0, 0, 0, B0); PG8_MFMA8(ai, 0, 0, 1, B0); PG8_MFMA8(ai, 1, 0, 0, B1); PG8_MFMA8(ai, 1, 0, 1, B1); \
        PG8_MFMA8(ai, 0, 1, 0, B0); PG8_MFMA8(ai, 0, 1, 1, B0); PG8_MFMA8(ai, 1, 1, 0, B1); PG8_MFMA8(ai, 1, 1, 1, B1); \
        PG8_SCHED; A8[0] = PG8_LD8(PG8_SA(b, h) + aoff + 4096); A8[1] = PG8_LD8(PG8_SA(b, h) + aoff + 6144); PG8_WAIT_L(0); PG8_SCHED; \
        PG8_MFMA8(ai, 0, 2, 0, B0); PG8_MFMA8(ai, 0, 2, 1, B0); PG8_MFMA8(ai, 1, 2, 0, B1); PG8_MFMA8(ai, 1, 2, 1, B1); \
        PG8_MFMA8(ai, 0, 3, 0, B0); PG8_MFMA8(ai, 0, 3, 1, B0); PG8_MFMA8(ai, 1, 3, 0, B1); PG8_MFMA8(ai, 1, 3, 1, B1); \
        __builtin_amdgcn_s_setprio(0); } else { PG8_MMA(ai, 0, At, B0); PG8_MMA(ai, 1, At, B1); } } while (0)
#define PG8_WAIT_V(n) asm volatile("s_waitcnt vmcnt(" #n ")" ::: "memory")
#define PG8_WAIT_L(n) asm volatile("s_waitcnt lgkmcnt(" #n ")" ::: "memory")
#define PG8_BAR __builtin_amdgcn_s_barrier()
#define PG8_SCHED __builtin_amdgcn_sched_barrier(0)
    Unit cur, nxt; int ui = 0;
    if (!S.next(0, cur)) return;
    f32x4 acc[2][2][4][2];
#pragma unroll
    for (int a = 0; a < 2; ++a)
#pragma unroll
        for (int b = 0; b < 2; ++b)
#pragma unroll
            for (int m = 0; m < 4; ++m)
#pragma unroll
                for (int n = 0; n < 2; ++n) acc[a][b][m][n] = (f32x4){0.f, 0.f, 0.f, 0.f};
    bf16x8 At[4][2], B0[2][2], B1[2][2];
    i32x8 A8[2], B08[2], B18[2];
    int one8 = 0x7F7F7F7F; asm volatile("" : "+v"(one8));
    static_assert(!FP8 || SP2, "the fp8 path exists in the SP2 schedule only");
    const char* cA = (const char*)g.A + (size_t)cur.pm * tstep; const char* cB = (const char*)g.Bt + (size_t)cur.pn * tstep;
    S.a_ready(cur);
    if constexpr (SP2) {
        PG8_STAGE(PG8_SB(0, 0), cB, voffB); PG8_STAGE(PG8_SB(0, 1), cB + hstep, voffB); PG8_STAGE(PG8_SA(0, 0), cA, voffA); PG8_STAGE(PG8_SA(0, 1), cA + hstepA, voffA1);
        if (wr == 1) PG8_BAR;
        PG8_WAIT_V(2); PG8_BAR;
        PG8_STAGE(PG8_SB(1, 0), cB + kstep, voffB); PG8_STAGE(PG8_SA(1, 0), cA + kstep, voffA); PG8_STAGE(PG8_SB(1, 1), cB + hstep + kstep, voffB);
        PG8_WAIT_V(6); PG8_BAR;
    } else {
        PG8_STAGE(PG8_SB(0, 0), cB, voffB); PG8_STAGE(PG8_SA(0, 0), cA, voffA); PG8_STAGE(PG8_SB(0, 1), cB + hstep, voffB); PG8_STAGE(PG8_SA(0, 1), cA + hstepA, voffA1);
        if (wr == 1) PG8_BAR;
        PG8_WAIT_V(4); PG8_BAR;
        PG8_STAGE(PG8_SB(1, 0), cB + kstep, voffB); PG8_STAGE(PG8_SA(1, 0), cA + kstep, voffA); PG8_STAGE(PG8_SB(1, 1), cB + hstep + kstep, voffB);
        PG8_WAIT_V(6); PG8_BAR;
    }
    for (;;) {
        const bool has_next = S.next(ui + 1, nxt);
        const char* nA = has_next ? (const char*)g.A + (size_t)nxt.pm * tstep : cA; const char* nB = has_next ? (const char*)g.Bt + (size_t)nxt.pn * tstep : cB;
        for (int t = 0; t < nt; t += 2) {
            const bool last = (t == nt - 2);
            const char* a1 = cA + (size_t)(t + 1) * kstep;
            const char* a2 = last ? nA : cA + (size_t)(t + 2) * kstep; const char* b2 = last ? nB : cB + (size_t)(t + 2) * kstep;
            const char* a3 = a2 + kstep; const char* b3 = b2 + kstep;
            if (last && has_next) S.a_ready(nxt);
            if constexpr (SP2) {
            PG8_LDB_F(B0, 0, 0); PG8_LDB_F(B1, 0, 1); PG8_SCHED; PG8_LDA_F(At, 0, 0); PG8_STAGE(PG8_SA(1, 1), a1 + hstepA, voffA1);
            PG8_WAIT_V(8); PG8_WAIT_L(0); PG8_BAR; PG8_MMA_PAIR(0, 0, 0); PG8_BAR; PG8_SCHED;
            PG8_LDA_F(At, 0, 1); PG8_STAGE(PG8_SB(0, 0), b2, voffB); PG8_STAGE(PG8_SB(0, 1), b2 + hstep, voffB); PG8_STAGE(PG8_SA(0, 0), a2, voffA);
            PG8_WAIT_V(8); PG8_WAIT_L(0); PG8_BAR; PG8_MMA_PAIR(1, 0, 1); PG8_BAR; PG8_SCHED;
            PG8_LDB_F(B0, 1, 0); PG8_LDB_F(B1, 1, 1); PG8_SCHED; PG8_LDA_F(At, 1, 0); PG8_STAGE(PG8_SA(0, 1), a2 + hstepA, voffA1);
            PG8_WAIT_V(8); PG8_WAIT_L(0); PG8_BAR; PG8_MMA_PAIR(0, 1, 0); PG8_BAR; PG8_SCHED;
            PG8_LDA_F(At, 1, 1); PG8_STAGE(PG8_SB(1, 0), b3, voffB); PG8_STAGE(PG8_SB(1, 1), b3 + hstep, voffB); PG8_STAGE(PG8_SA(1, 0), a3, voffA);
            PG8_WAIT_V(8); PG8_WAIT_L(0); PG8_BAR; PG8_MMA_PAIR(1, 1, 1); PG8_BAR; PG8_SCHED;
            } else {
            PG8_LDB(B0, 0, 0); PG8_SCHED; PG8_LDA(At, 0, 0); PG8_STAGE(PG8_SA(1, 1), a1 + hstepA, voffA1);
            PG8_WAIT_L(8); PG8_BAR; PG8_WAIT_L(0); PG8_MMA(0, 0, At, B0); PG8_BAR; PG8_SCHED;
            PG8_LDB(B1, 0, 1); PG8_STAGE(PG8_SB(0, 0), b2, voffB);
            PG8_BAR; PG8_WAIT_L(0); PG8_MMA(0, 1, At, B1); PG8_BAR;
            PG8_LDA(At, 0, 1); PG8_STAGE(PG8_SA(0, 0), a2, voffA);
            PG8_BAR; PG8_WAIT_L(0); PG8_MMA(1, 0, At, B0); PG8_BAR; PG8_SCHED;
            PG8_STAGE(PG8_SB(0, 1), b2 + hstep, voffB);
            PG8_WAIT_V(6); PG8_BAR; PG8_MMA(1, 1, At, B1); PG8_BAR;
            PG8_LDB(B0, 1, 0); PG8_SCHED; PG8_LDA(At, 1, 0); PG8_STAGE(PG8_SA(0, 1), a2 + hstepA, voffA1);
            PG8_WAIT_L(8); PG8_BAR; PG8_WAIT_L(0); PG8_MMA(0, 0, At, B0); PG8_BAR; PG8_SCHED;
            PG8_LDB(B1, 1, 1); PG8_STAGE(PG8_SB(1, 0), b3, voffB);
            PG8_BAR; PG8_WAIT_L(0); PG8_MMA(0, 1, At, B1); PG8_BAR;
            PG8_LDA(At, 1, 1); PG8_STAGE(PG8_SA(1, 0), a3, voffA);
            PG8_BAR; PG8_WAIT_L(0); PG8_MMA(1, 0, At, B0); PG8_BAR; PG8_SCHED;
            PG8_STAGE(PG8_SB(1, 1), b3 + hstep, voffB);
            PG8_WAIT_V(6); PG8_BAR; PG8_MMA(1, 1, At, B1); PG8_BAR;
            }
        }
        if constexpr (ALIGN_EPI) { if (wr == 0) PG8_BAR; }
        if constexpr (FP8) asm volatile("s_nop 15\n\ts_nop 15" ::: "memory");
        if constexpr (!Epi::AFTER_DRAIN) { E(acc, cur, wr, wc, fr, fq); S.done(cur); }
        if (!has_next) break;
#pragma unroll
        for (int a = 0; a < 2; ++a)
#pragma unroll
            for (int b = 0; b < 2; ++b)
#pragma unroll
                for (int m = 0; m < 4; ++m)
#pragma unroll
                    for (int n = 0; n < 2; ++n) acc[a][b][m][n] = (f32x4){0.f, 0.f, 0.f, 0.f};
        cur = nxt; cA = nA; cB = nB; ++ui;
        if constexpr (ALIGN_EPI) { if (wr == 1) PG8_BAR; }
    }
    PG8_WAIT_V(0);
    if constexpr (!ALIGN_EPI) { if (wr == 0) PG8_BAR; }
    PG8_BAR;
    if constexpr (Epi::AFTER_DRAIN) { E.fused(acc, cur, wr, wc, fr, fq, lds, wid, lane); S.done(cur); }
#undef PG8_SA
#undef PG8_SB
#undef PG8_STAGE
#undef PG8_LDA
#undef PG8_LD8
#undef PG8_LDA_F
#undef PG8_LDB_F
#undef PG8_MFMA8
#undef PG8_MMA_PAIR
#undef PG8_LDB
#undef PG8_MMA
#undef PG8_WAIT_V
#undef PG8_WAIT_L
#undef PG8_BAR
#undef PG8_SCHED
}
}
#define DPP_F(v, ctrl) __builtin_bit_cast(float, __builtin_amdgcn_update_dpp(0, __builtin_bit_cast(int, (v)), (ctrl), 0xF, 0xF, true))
__device__ __forceinline__ float rdlane_f(float v, int l) { return __builtin_bit_cast(float, __builtin_amdgcn_readlane(__builtin_bit_cast(int, v), l)); }
__device__ __forceinline__ float dpp_sum16x(float v) {
  v += DPP_F(v, 0xB1); v += DPP_F(v, 0x4E); v += DPP_F(v, 0x141); v += DPP_F(v, 0x140);
  return v;
}
__device__ __forceinline__ float dpp_max16x(float v) {
  v = fmaxf(v, DPP_F(v, 0xB1)); v = fmaxf(v, DPP_F(v, 0x4E)); v = fmaxf(v, DPP_F(v, 0x141)); v = fmaxf(v, DPP_F(v, 0x140));
  return v;
}
__device__ __forceinline__ float wave_sum_fast(float v) {
  v = dpp_sum16x(v);
  return (rdlane_f(v, 0) + rdlane_f(v, 16)) + (rdlane_f(v, 32) + rdlane_f(v, 48));
}
__device__ __forceinline__ float wave_max_fast(float v) {
  v = dpp_max16x(v);
  return fmaxf(fmaxf(rdlane_f(v, 0), rdlane_f(v, 16)), fmaxf(rdlane_f(v, 32), rdlane_f(v, 48)));
}
__device__ __forceinline__ float fast_tanh(float x) { const float e = __expf(2.f * x); return 1.f - 2.f / (e + 1.f); }


__device__ __forceinline__ float4 bf4_to_f4(uint2 u) {
  float4 r;
  r.x = __uint_as_float(u.x << 16); r.y = __uint_as_float(u.x & 0xffff0000u);
  r.z = __uint_as_float(u.y << 16); r.w = __uint_as_float(u.y & 0xffff0000u);
  return r;
}
__device__ __forceinline__ uint2 pack4(float a, float b, float c, float d) { uint2 r; r.x = cvtpk(a, b); r.y = cvtpk(c, d); return r; }
#define XCD_GROUP (VBID & 7)
#define XCD_LB (VBID >> 3)
#define XCD_NB ((VGRID + 7 - (VBID & 7)) >> 3)

struct EpiInproj {
  static constexpr bool PERM = true, AFTER_DRAIN = false;
  const float* rope; bf16_t* Q; bf16_t* K; bf16_t* V; bf16_t* FE;
  __device__ __forceinline__ void operator()(const pg8::f32x4 (&acc)[2][2][4][2], const pg8::Unit& u, int wr, int wc, int fr, int fq) const {
#pragma unroll
    for (int bj = 0; bj < 2; ++bj) {
      const int s0 = u.pn * 256 + bj * 128 + wc * 32 + 8 * fq;
      const int hb = s0 & ~63, f0 = ((s0 & 63) >> 3) << 2;
      if (hb + f0 >= INW) continue;
#pragma unroll
      for (int ai = 0; ai < 2; ++ai)
#pragma unroll
        for (int m = 0; m < 4; ++m) {
          const int t = u.pm * 256 + ai * 128 + wr * 64 + m * 16 + fr;
          const pg8::f32x4 v0 = acc[ai][bj][m][0], v1 = acc[ai][bj][m][1];
          if (hb < 1024) {
            const int pos = t & (SEQ - 1);
            const float4 c01 = *(const float4*)(rope + (size_t)(pos * 32 + f0) * 2);
            const float4 c23 = *(const float4*)(rope + (size_t)(pos * 32 + f0) * 2 + 4);
            const float cs[4] = {c01.x, c01.z, c23.x, c23.z}, sn[4] = {c01.y, c01.w, c23.y, c23.w};
            const float sc = (hb < 512) ? 0.125f : 1.f;
            float o1[4], o2[4];
#pragma unroll
            for (int j = 0; j < 4; ++j) { o1[j] = (v0[j] * cs[j] - v1[j] * sn[j]) * sc; o2[j] = (v1[j] * cs[j] + v0[j] * sn[j]) * sc; }
            bf16_t* dst = (hb < 512) ? (Q + (size_t)t * 512 + hb + f0) : (K + (size_t)t * 512 + (hb - 512) + f0);
            *(uint2*)dst = pack4(o1[0], o1[1], o1[2], o1[3]);
            *(uint2*)(dst + 32) = pack4(o2[0], o2[1], o2[2], o2[3]);
          } else if (hb < 1536) {
            bf16_t* dst = V + (size_t)t * 512 + (hb - 1024) + f0;
            *(uint2*)dst = pack4(v0[0], v0[1], v0[2], v0[3]);
            *(uint2*)(dst + 32) = pack4(v1[0], v1[1], v1[2], v1[3]);
          } else {
            bf16_t* dst = FE + (size_t)t * FEW + (hb - 1536) + f0;
            *(uint2*)dst = pack4(v0[0], v0[1], v0[2], v0[3]);
            if (hb + f0 + 32 < INW) *(uint2*)(dst + 32) = pack4(v1[0], v1[1], v1[2], v1[3]);
          }
        }
    }
  }
};
__device__ __forceinline__ void phase_inproj(const Params& p, char* smem_all) {
  pg8::Gemm g{(const pg8::bf16_t*)(p.ws + OFF_XB), (const pg8::bf16_t*)(p.ws + OFF_WINT), T_TOK, 3584, DM};
  pg8::StaticOrder S; S.init(T_TOK, 3584, (int)gridDim.x, (int)blockIdx.x);
  EpiInproj E{(const float*)(p.ws + OFF_ROPE), (bf16_t*)(p.ws + OFF_Q), (bf16_t*)(p.ws + OFF_K), (bf16_t*)(p.ws + OFF_V), (bf16_t*)(p.ws + OFF_FEATS)};
  pg8::gemm_phase<EpiInproj, pg8::StaticOrder, true, true>((PG8_LAS unsigned char*)smem_all, g, S, E);
}

__device__ __forceinline__ void phase_prep_a(const Params& p) {
  const bf16_t* __restrict__ FE = (const bf16_t*)(p.ws + OFF_FEATS);
  const float* __restrict__ mu = p.in[2];
  bf16_t* R = (bf16_t*)(p.ws + OFF_R); bf16_t* K2 = (bf16_t*)(p.ws + OFF_K2); bf16_t* V2 = (bf16_t*)(p.ws + OFF_V2);
  bf16_t* ACT = (bf16_t*)(p.ws + OFF_ACT);
  for (size_t i = (size_t)VBID * NTHR + VTID; i < (size_t)T_TOK * 232; i += (size_t)VGRID * NTHR) {
    const int t = (int)(i / 232), ch = (int)(i - (size_t)t * 232);
    if (ch >= 228) { *(uint4*)(ACT + (size_t)t * 320 + 288 + (ch - 228) * 8) = make_uint4(0u, 0u, 0u, 0u); continue; }
    const int col = ch * 8;
    const uint4 cu = *(const uint4*)(FE + (size_t)t * FEW + col);
    uint4 pv = make_uint4(0u, 0u, 0u, 0u);
    if ((t & (SEQ - 1)) != 0) pv = *(const uint4*)(FE + (size_t)(t - 1) * FEW + col);
    const float4 m0 = *(const float4*)(mu + col), m1 = *(const float4*)(mu + col + 4);
    const unsigned cw[4] = {cu.x, cu.y, cu.z, cu.w}, pw[4] = {pv.x, pv.y, pv.z, pv.w};
    const float mm[8] = {m0.x, m0.y, m0.z, m0.w, m1.x, m1.y, m1.z, m1.w};
    float f[8];
#pragma unroll
    for (int q = 0; q < 4; ++q) {
      const float c0 = __uint_as_float(cw[q] << 16), c1 = __uint_as_float(cw[q] & 0xffff0000u);
      const float p0 = __uint_as_float(pw[q] << 16), p1 = __uint_as_float(pw[q] & 0xffff0000u);
      f[2 * q] = c0 + (p0 - c0) * mm[2 * q];
      f[2 * q + 1] = c1 + (p1 - c1) * mm[2 * q + 1];
    }
    bf16_t* dst;
    if (col < 512) dst = R + (size_t)t * 512 + col;
    else if (col < 1024) dst = K2 + (size_t)t * 512 + (col - 512);
    else if (col < 1536) dst = V2 + (size_t)t * 512 + (col - 1024);
    else {
      dst = ACT + (size_t)t * 320 + (col - 1536);
      if (col < 1600) {
#pragma unroll
        for (int q = 0; q < 8; ++q) f[q] = fast_tanh(f[q]);
      } else if (col >= 1664) {
#pragma unroll
        for (int q = 0; q < 8; ++q) f[q] = sigmoidf_(f[q]);
      }
    }
    uint4 w; w.x = cvtpk(f[0], f[1]); w.y = cvtpk(f[2], f[3]); w.z = cvtpk(f[4], f[5]); w.w = cvtpk(f[6], f[7]);
    *(uint4*)dst = w;
  }
}

template <int PASS>
__device__ __forceinline__ void prep_item(const Params& p, char* smem, const int row0, const int col0) {
  const bf16_t* __restrict__ ACT = (const bf16_t*)(p.ws + OFF_ACT);
  constexpr int ACOL = PASS * 64;
  constexpr int NK = (PASS == 2) ? 3 : 1;
  const float* __restrict__ Wm = (PASS == 0) ? p.in[4] : (PASS == 1) ? p.in[6] : p.in[7];
  f32x4 acc[4][4];
  acc_zero(acc);
  gemm128_acc<0, (PASS == 2)>(acc, smem, NK,
      [=](int, int rowl, int kc) { return *(const uint4*)(ACT + (size_t)(row0 + rowl) * 320 + ACOL + kc * 8); },
      [=](int nq) { return Wm + col0 + nq * 4; }, 512, 160);
  int tid_l_ = VTID; asm volatile("" : "+v"(tid_l_)); const int tid = tid_l_, lane = tid & 63, wid = tid >> 6;
  const int wr = wid >> 1, wc = wid & 1, fr = lane & 15, fq = lane >> 4;
  const int cb = col0 + wc * 64;
  if (PASS == 0) {
    const float* __restrict__ w0 = p.in[3];
    float* W = (float*)(p.ws + OFF_W);
#pragma unroll
    for (int n = 0; n < 4; ++n) {
      const int c = cb + n * 16 + fq * 4;
      const float4 w04 = *(const float4*)(w0 + c);
      const float w0c[4] = {w04.x, w04.y, w04.z, w04.w};
#pragma unroll
      for (int m = 0; m < 4; ++m) {
        const int t = row0 + wr * 64 + m * 16 + fr;
        float d[4];
#pragma unroll
        for (int j = 0; j < 4; ++j) {
          const float nz = -(w0c[j] + acc[m][n][j]);
          const float sp = fmaxf(nz, 0.f) + __logf(1.f + __expf(-fabsf(nz)));
          d[j] = -__expf(-sp - 0.5f);
        }
        *(float4*)(W + (size_t)t * 512 + c) = make_float4(d[0], d[1], d[2], d[3]);
      }
    }
  } else if (PASS == 2) {
    bf16_t* G = (bf16_t*)(p.ws + OFF_G);
#pragma unroll
    for (int m = 0; m < 4; ++m) {
      const int t = row0 + wr * 64 + m * 16 + fr;
#pragma unroll
      for (int n = 0; n < 4; ++n)
        *(uint2*)(G + (size_t)t * 512 + cb + n * 16 + fq * 4) = pack4(acc[m][n][0], acc[m][n][1], acc[m][n][2], acc[m][n][3]);
    }
  } else {
    const float* __restrict__ a0 = p.in[5]; const float* __restrict__ k_k = p.in[8]; const float* __restrict__ k_a = p.in[9];
    const float* __restrict__ r_k = p.in[10];
    const bf16_t* __restrict__ R = (const bf16_t*)(p.ws + OFF_R); bf16_t* K2 = (bf16_t*)(p.ws + OFF_K2);
    bf16_t* A = (bf16_t*)(p.ws + OFF_A); bf16_t* B = (bf16_t*)(p.ws + OFF_B); float* SB = (float*)(p.ws + OFF_SB);
#pragma unroll
    for (int m = 0; m < 4; ++m) {
      __builtin_amdgcn_sched_barrier(0);
      const int t = row0 + wr * 64 + m * 16 + fr;
      float kk[4][4];
      float ssp = 0.f, sbp = 0.f;
#pragma unroll
      for (int n = 0; n < 4; ++n) {
        const int c = cb + n * 16 + fq * 4;
        const size_t o = (size_t)t * 512 + c;
        const float4 rr4 = bf4_to_f4(*(const uint2*)(R + o)), kx4 = bf4_to_f4(*(const uint2*)(K2 + o));
        const float rr[4] = {rr4.x, rr4.y, rr4.z, rr4.w}, kx[4] = {kx4.x, kx4.y, kx4.z, kx4.w};
        const float4 a04 = *(const float4*)(a0 + c), kk4 = *(const float4*)(k_k + c), ka4 = *(const float4*)(k_a + c), rk4 = *(const float4*)(r_k + c);
        const float a0c[4] = {a04.x, a04.y, a04.z, a04.w}, kkc[4] = {kk4.x, kk4.y, kk4.z, kk4.w}, kac[4] = {ka4.x, ka4.y, ka4.z, ka4.w};
        const float rkc[4] = {rk4.x, rk4.y, rk4.z, rk4.w};
        float k2[4];
#pragma unroll
        for (int j = 0; j < 4; ++j) {
          const float av = sigmoidf_(a0c[j] + acc[m][n][j]);
          acc[m][n][j] = av;
          kk[n][j] = kx[j] * kkc[j];
          k2[j] = kx[j] * (1.f + (av - 1.f) * kac[j]);
          ssp += kk[n][j] * kk[n][j];
          sbp += rr[j] * k2[j] * rkc[j];
        }
        *(uint2*)(K2 + o) = pack4(k2[0], k2[1], k2[2], k2[3]);
      }
      ssp += __shfl_xor(ssp, 16, 64); ssp += __shfl_xor(ssp, 32, 64);
      sbp += __shfl_xor(sbp, 16, 64); sbp += __shfl_xor(sbp, 32, 64);
      const float inv = 1.f / fmaxf(sqrtf(ssp), 1e-12f);
#pragma unroll
      for (int n = 0; n < 4; ++n) {
        const size_t o = (size_t)t * 512 + cb + n * 16 + fq * 4;
        *(uint2*)(A + o) = pack4(-kk[n][0] * inv, -kk[n][1] * inv, -kk[n][2] * inv, -kk[n][3] * inv);
        *(uint2*)(B + o) = pack4(kk[n][0] * inv * acc[m][n][0], kk[n][1] * inv * acc[m][n][1], kk[n][2] * inv * acc[m][n][2], kk[n][3] * inv * acc[m][n][3]);
      }
      if (fq == 0) SB[(size_t)t * 8 + (cb >> 6)] = sbp;
    }
  }
}
__device__ __forceinline__ void phase_prep(const Params& p, char* smem) {
  for (int item = VBID; item < (T_TOK / 128) * 8; item += VGRID) {
    const int pass = item >> 10, mt = (item & 1023) >> 2, nt = item & 3;
    if (pass == 0) prep_item<0>(p, smem, mt * 128, nt * 128);
    else prep_item<1>(p, smem, mt * 128, nt * 128);
  }
}

#define CK_AR 0
#define CK_BK 9216
#define CK_BKT 18432
#define CK_UVT 27648
#define CK_LM 36864
#define CK_XR 46080
#define CK_LABT 54784
#define CK_WUT 58880
#define CK_PC 64000
constexpr size_t CK_GA_OFF = 0;
constexpr size_t CK_HA_OFF = (size_t)8192 * 8192;
constexpr size_t OFF_RA = OFF_MIXED;
constexpr size_t OFF_Y1A = OFF_MIXED + (size_t)8192 * 4096;
#define CK_MMA(x, y, c) __builtin_amdgcn_mfma_f32_16x16x32_bf16((x), (y), (c), 0, 0, 0)
#define CK_FRAG(off) (*(const bf16x8*)(smem + (off)))
#define CK_LOADS(it_) { \
    const int hd_ = (it_) >> 7, ch_ = (it_) & 127; \
    const size_t tok_ = (size_t)(hd_ >> 3) * SEQ + (size_t)ch_ * 32; \
    const size_t g1_ = (tok_ + t1) * 512 + (hd_ & 7) * 64 + j8; \
    ua = *(const uint4*)(A + g1_); ub = *(const uint4*)(B + g1_); uk = *(const uint4*)(K2 + g1_); ur = *(const uint4*)(R + g1_); \
    lw0 = *(const float4*)(W + g1_); lw1 = *(const float4*)(W + g1_ + 4); \
    const bf16_t* vp_ = V2 + (tok_ + 8 * w) * 512 + (hd_ & 7) * 64 + lane; \
    v0 = vp_[0]; v1 = vp_[512]; v2 = vp_[1024]; v3 = vp_[1536]; v4 = vp_[2048]; v5 = vp_[2560]; v6 = vp_[3072]; v7 = vp_[3584]; }
__device__ __forceinline__ void phase_chunk_pre(const Params& p, char* smem) {
  const bf16_t* __restrict__ R = (const bf16_t*)(p.ws + OFF_R); const bf16_t* __restrict__ K2 = (const bf16_t*)(p.ws + OFF_K2);
  const bf16_t* __restrict__ V2 = (const bf16_t*)(p.ws + OFF_V2); const bf16_t* __restrict__ A = (const bf16_t*)(p.ws + OFF_A);
  const bf16_t* __restrict__ B = (const bf16_t*)(p.ws + OFF_B); const float* __restrict__ W = (const float*)(p.ws + OFF_W);
  int tid_l_ = VTID; asm volatile("" : "+v"(tid_l_)); const int tid = tid_l_, lane = tid & 63, q = lane >> 4, c16 = lane & 15;
  const int w = __builtin_amdgcn_readfirstlane(tid >> 6);
  const int t1 = tid >> 3, j8 = (tid & 7) * 8;
  uint4 ua, ub, uk, ur; float4 lw0, lw1; unsigned v0, v1, v2, v3, v4, v5, v6, v7;
  int item = VBID;
  if (item < 64 * 128) CK_LOADS(item)
  for (; item < 64 * 128; item += VGRID) {
  *(float4*)(smem + CK_LM + t1 * 256 + j8 * 4) = lw0;
  *(float4*)(smem + CK_LM + t1 * 256 + j8 * 4 + 16) = lw1;
  HSYNCL();
  {
    float lv[32];
#pragma unroll
    for (int s = 0; s < 32; ++s) lv[s] = *(const float*)(smem + CK_LM + s * 256 + lane * 4);
    float acc = 0.f;
#pragma unroll
    for (int blk = 0; blk < 4; ++blk) {
#pragma unroll
      for (int i = 0; i < 8; ++i) { acc += lv[8 * blk + i]; lv[8 * blk + i] = acc; }
      if (blk == w) {
#pragma unroll
        for (int i = 0; i < 8; ++i) *(float*)(smem + CK_XR + (8 * blk + i) * 272 + lane * 4) = lv[8 * blk + i];
      }
    }
    if (w == 3) *(float*)(smem + CK_PC + lane * 4) = __expf(acc);
    uint4 vv; vv.x = v0 | (v1 << 16); vv.y = v2 | (v3 << 16); vv.z = v4 | (v5 << 16); vv.w = v6 | (v7 << 16);
    *(uint4*)(smem + CK_UVT + lane * 144 + (32 + 8 * w) * 2) = vv;
  }
  HSYNCL();
  {
    const float4 c1a = *(const float4*)(smem + CK_XR + t1 * 272 + j8 * 4), c1b = *(const float4*)(smem + CK_XR + t1 * 272 + j8 * 4 + 16);
    float4 c0a = make_float4(0.f, 0.f, 0.f, 0.f), c0b = make_float4(0.f, 0.f, 0.f, 0.f);
    if (t1 > 0) { c0a = *(const float4*)(smem + CK_XR + (t1 - 1) * 272 + j8 * 4); c0b = *(const float4*)(smem + CK_XR + (t1 - 1) * 272 + j8 * 4 + 16); }
    const float cl1[8] = {c1a.x, c1a.y, c1a.z, c1a.w, c1b.x, c1b.y, c1b.z, c1b.w};
    const float cl0[8] = {c0a.x, c0a.y, c0a.z, c0a.w, c0b.x, c0b.y, c0b.z, c0b.w};
    const unsigned wa[4] = {ua.x, ua.y, ua.z, ua.w}, wb[4] = {ub.x, ub.y, ub.z, ub.w}, wk[4] = {uk.x, uk.y, uk.z, uk.w}, wr[4] = {ur.x, ur.y, ur.z, ur.w};
    unsigned oa[4], ob[4], ok[4], orr[4];
#pragma unroll
    for (int i = 0; i < 4; ++i) {
      const float e0l = __expf(cl0[2 * i]), e0h = __expf(cl0[2 * i + 1]);
      const float e1l = __expf(cl1[2 * i]), e1h = __expf(cl1[2 * i + 1]);
      const float e2l = __expf(-cl1[2 * i]), e2h = __expf(-cl1[2 * i + 1]);
      oa[i] = cvtpk(__uint_as_float(wa[i] << 16) * e0l, __uint_as_float(wa[i] & 0xffff0000u) * e0h);
      orr[i] = cvtpk(__uint_as_float(wr[i] << 16) * e1l, __uint_as_float(wr[i] & 0xffff0000u) * e1h);
      ob[i] = cvtpk(__uint_as_float(wb[i] << 16) * e2l, __uint_as_float(wb[i] & 0xffff0000u) * e2h);
      ok[i] = cvtpk(__uint_as_float(wk[i] << 16) * e2l, __uint_as_float(wk[i] & 0xffff0000u) * e2h);
    }
    *(uint4*)(smem + CK_AR + t1 * 144 + j8 * 2) = make_uint4(oa[0], oa[1], oa[2], oa[3]);
    *(uint4*)(smem + CK_AR + (32 + t1) * 144 + j8 * 2) = make_uint4(orr[0], orr[1], orr[2], orr[3]);
    *(uint4*)(smem + CK_BK + t1 * 144 + j8 * 2) = make_uint4(ob[0], ob[1], ob[2], ob[3]);
    *(uint4*)(smem + CK_BK + (32 + t1) * 144 + j8 * 2) = make_uint4(ok[0], ok[1], ok[2], ok[3]);
  }
  if (item + VGRID < 64 * 128) CK_LOADS(item + VGRID)
  HSYNCL();
  {
    f32x4 acc[4];
#pragma unroll
    for (int nb = 0; nb < 4; ++nb) acc[nb] = (f32x4){0.f, 0.f, 0.f, 0.f};
#pragma unroll
    for (int ks = 0; ks < 2; ++ks) {
      const bf16x8 xa = CK_FRAG(CK_AR + (16 * w + c16) * 144 + ks * 64 + q * 16);
#pragma unroll
      for (int nb = 0; nb < 4; ++nb) acc[nb] = CK_MMA(CK_FRAG(CK_BK + (16 * nb + c16) * 144 + ks * 64 + q * 16), xa, acc[nb]);
    }
    const int tt = (16 * w + c16) & 31;
#pragma unroll
    for (int nb = 0; nb < 4; ++nb) {
      float val[4];
#pragma unroll
      for (int r = 0; r < 4; ++r) {
        const int s = (16 * nb + 4 * q + r) & 31;
        const bool keep = (w < 2) ? (s < tt) : (s <= tt);
        val[r] = keep ? acc[nb][r] : 0.f;
        if (w < 2 && nb < 2) *(float*)(smem + CK_LABT + s * 128 + tt * 4) = val[r];
      }
      *(uint2*)(smem + CK_LM + (16 * w + c16) * 144 + (16 * nb + 4 * q) * 2) = pack4(val[0], val[1], val[2], val[3]);
    }
  }
  HSYNCL();
  {
    const int mb = w & 1;
    const bf16x8 xa = CK_FRAG(CK_LM + (16 * mb + c16) * 144 + 64 + q * 16);
#pragma unroll
    for (int u = 0; u < 2; ++u) {
      const int nb = 2 * (w >> 1) + u;
      f32x4 acc = (f32x4){0.f, 0.f, 0.f, 0.f};
      acc = CK_MMA(CK_FRAG(CK_UVT + (16 * nb + c16) * 144 + 64 + q * 16), xa, acc);
      *(float4*)(smem + CK_XR + (16 * mb + c16) * 272 + (16 * nb + 4 * q) * 4) = make_float4(acc[0], acc[1], acc[2], acc[3]);
    }
  }
  HSYNCL();
  if (w < 2) {
    float x[32];
    if (w == 0) {
#pragma unroll
      for (int t = 0; t < 32; ++t) x[t] = bf2f(*(const bf16_t*)(smem + CK_AR + t * 144 + lane * 2));
    } else {
#pragma unroll
      for (int t = 0; t < 32; ++t) x[t] = *(const float*)(smem + CK_XR + t * 272 + lane * 4);
    }
    char* const dst = (w == 0) ? (smem + CK_WUT + lane * 80) : (smem + CK_UVT + lane * 144);
    const int bstr = (w == 0) ? 80 : 144;
    char* const xrows = (w == 0) ? (smem + CK_WUT) : (smem + CK_UVT);
    char* const tb = (w == 0) ? (smem + CK_AR) : (smem + CK_XR);
    float4 lc[2][4];
    int lofs = CK_LABT; asm volatile("" : "+v"(lofs)); const char* const lbase = smem + lofs;
#define CK_LCOL(s_, g0_) { _Pragma("unroll") for (int g_ = 0; g_ < 4; ++g_) if (4 * (g_ + (g0_)) + 3 > (s_)) lc[(s_) & 1][g_] = *(const float4*)(lbase + (s_) * 128 + (g_ + (g0_)) * 16); }
#define CK_SWEEP(s0_, g0_) { \
    CK_LCOL(s0_, g0_) \
    _Pragma("unroll") for (int s = (s0_); s < (s0_) + 15; ++s) { \
      if (s + 1 < (s0_) + 15) CK_LCOL(s + 1, g0_) \
      __builtin_amdgcn_sched_barrier(0); \
      _Pragma("unroll") for (int g = 0; g < 4; ++g) { \
        if (4 * (g + (g0_)) + 3 > s) { \
          const float4 l4 = lc[s & 1][g]; \
          if (4 * (g + (g0_)) + 0 > s) x[4 * (g + (g0_)) + 0] = fmaf(l4.x, x[s], x[4 * (g + (g0_)) + 0]); \
          if (4 * (g + (g0_)) + 1 > s) x[4 * (g + (g0_)) + 1] = fmaf(l4.y, x[s], x[4 * (g + (g0_)) + 1]); \
          if (4 * (g + (g0_)) + 2 > s) x[4 * (g + (g0_)) + 2] = fmaf(l4.z, x[s], x[4 * (g + (g0_)) + 2]); \
          if (4 * (g + (g0_)) + 3 > s) x[4 * (g + (g0_)) + 3] = fmaf(l4.w, x[s], x[4 * (g + (g0_)) + 3]); \
        } \
      } \
      __builtin_amdgcn_sched_barrier(0); \
    } }
    CK_SWEEP(0, 0)
#pragma unroll
    for (int g = 0; g < 2; ++g)
      *(uint4*)(dst + g * 16) = make_uint4(cvtpk(x[8 * g], x[8 * g + 1]), cvtpk(x[8 * g + 2], x[8 * g + 3]), cvtpk(x[8 * g + 4], x[8 * g + 5]), cvtpk(x[8 * g + 6], x[8 * g + 7]));
    asm volatile("s_waitcnt lgkmcnt(0)" ::: "memory");
    {
      const bf16x8 zf = {0, 0, 0, 0, 0, 0, 0, 0};
      const bf16x8 la = (q < 2) ? CK_FRAG(CK_LM + (16 + c16) * 144 + q * 16) : zf;
#pragma unroll
      for (int nb = 0; nb < 4; ++nb) {
        const bf16x8 xb = (q < 2) ? *(const bf16x8*)(xrows + (16 * nb + c16) * bstr + q * 16) : zf;
        f32x4 d = (f32x4){0.f, 0.f, 0.f, 0.f};
        d = CK_MMA(la, xb, d);
#pragma unroll
        for (int r = 0; r < 4; ++r) *(float*)(tb + (4 * q + r) * 272 + (16 * nb + c16) * 4) = d[r];
      }
    }
    asm volatile("s_waitcnt lgkmcnt(0)" ::: "memory");
#pragma unroll
    for (int t = 0; t < 16; ++t) x[16 + t] += *(const float*)(tb + t * 272 + lane * 4);
    CK_SWEEP(16, 4)
#undef CK_SWEEP
#undef CK_LCOL
#pragma unroll
    for (int g = 2; g < 4; ++g)
      *(uint4*)(dst + g * 16) = make_uint4(cvtpk(x[8 * g], x[8 * g + 1]), cvtpk(x[8 * g + 2], x[8 * g + 3]), cvtpk(x[8 * g + 4], x[8 * g + 5]), cvtpk(x[8 * g + 6], x[8 * g + 7]));
  } else {
    const int rb = (w - 2) * 32;
#pragma unroll
    for (int g = 0; g < 4; ++g) {
      unsigned e[8];
#pragma unroll
      for (int i = 0; i < 8; ++i) e[i] = *(const bf16_t*)(smem + CK_BK + (rb + 8 * g + i) * 144 + lane * 2);
      *(uint4*)(smem + CK_BKT + lane * 144 + (rb + 8 * g) * 2) = make_uint4(e[0] | (e[1] << 16), e[2] | (e[3] << 16), e[4] | (e[5] << 16), e[6] | (e[7] << 16));
    }
  }
  HSYNCL();
  {
    char* const GA = (char*)p.out + CK_GA_OFF + (size_t)item * 8192;
    char* const HA = (char*)p.out + CK_HA_OFF + (size_t)item * 8192;
    char* const RA = p.ws + OFF_RA + (size_t)item * 4096;
    char* const Y1A = p.ws + OFF_Y1A + (size_t)item * 4096;
    const bf16x8 xw = CK_FRAG(CK_WUT + (16 * w + c16) * 80 + q * 16);
#pragma unroll
    for (int nb = 0; nb < 4; ++nb) {
      f32x4 acc = (f32x4){0.f, 0.f, 0.f, 0.f};
      acc = CK_MMA(xw, CK_FRAG(CK_BKT + (16 * nb + c16) * 144 + q * 16), acc);
      const float pc = *(const float*)(smem + CK_PC + (16 * nb + c16) * 4);
      float g[4];
#pragma unroll
      for (int r = 0; r < 4; ++r) g[r] = (acc[r] + ((16 * w + 4 * q + r) == (16 * nb + c16) ? 1.f : 0.f)) * pc;
      *(uint2*)(GA + ((((nb * 2 + (w >> 1)) * 64 + lane) * 8 + 4 * (w & 1)) << 1)) = pack4(g[0], g[1], g[2], g[3]);
    }
#pragma unroll
    for (int nb = 0; nb < 2; ++nb) {
      f32x4 acc = (f32x4){0.f, 0.f, 0.f, 0.f};
      acc = CK_MMA(xw, CK_FRAG(CK_LM + (32 + 16 * nb + c16) * 144 + q * 16), acc);
      const float4 rt = bf4_to_f4(*(const uint2*)(smem + CK_AR + (32 + 16 * nb + c16) * 144 + (16 * w + 4 * q) * 2));
      *(uint2*)(RA + ((((nb * 2 + (w >> 1)) * 64 + lane) * 8 + 4 * (w & 1)) << 1)) = pack4(acc[0] + rt.x, acc[1] + rt.y, acc[2] + rt.z, acc[3] + rt.w);
    }
    {
      const bf16x8 xb0 = CK_FRAG(CK_BKT + (16 * w + c16) * 144 + q * 16), xb1 = CK_FRAG(CK_BKT + (16 * w + c16) * 144 + 64 + q * 16);
      const float4 pc4 = *(const float4*)(smem + CK_PC + (16 * w + 4 * q) * 4);
#pragma unroll
      for (int nb = 0; nb < 4; ++nb) {
        f32x4 acc = (f32x4){0.f, 0.f, 0.f, 0.f};
        acc = CK_MMA(xb0, CK_FRAG(CK_UVT + (16 * nb + c16) * 144 + q * 16), acc);
        acc = CK_MMA(xb1, CK_FRAG(CK_UVT + (16 * nb + c16) * 144 + 64 + q * 16), acc);
        *(uint2*)(HA + (((nb * 4 + w) * 64 + lane) << 3)) = pack4(acc[0] * pc4.x, acc[1] * pc4.y, acc[2] * pc4.z, acc[3] * pc4.w);
      }
    }
    {
      const int mb = w & 1;
      const bf16x8 xm0 = CK_FRAG(CK_LM + (32 + 16 * mb + c16) * 144 + q * 16), xm1 = CK_FRAG(CK_LM + (32 + 16 * mb + c16) * 144 + 64 + q * 16);
#pragma unroll
      for (int u = 0; u < 2; ++u) {
        const int nb = 2 * (w >> 1) + u;
        f32x4 acc = (f32x4){0.f, 0.f, 0.f, 0.f};
        acc = CK_MMA(xm0, CK_FRAG(CK_UVT + (16 * nb + c16) * 144 + q * 16), acc);
        acc = CK_MMA(xm1, CK_FRAG(CK_UVT + (16 * nb + c16) * 144 + 64 + q * 16), acc);
        *(uint2*)(Y1A + (((nb * 2 + mb) * 64 + lane) << 3)) = pack4(acc[0], acc[1], acc[2], acc[3]);
      }
    }
  }
  HSYNCL();
  }
}

struct SeqSet { uint4 ga[8]; uint4 ra[4]; uint2 ha[4]; uint2 y1[2]; };
__device__ __forceinline__ bf16x8 as_frag(const uint4 u) { return __builtin_bit_cast(bf16x8, u); }
__device__ __forceinline__ f32x4 bf4_to_acc(const uint2 u) {
  return (f32x4){__uint_as_float(u.x << 16), __uint_as_float(u.x & 0xffff0000u), __uint_as_float(u.y << 16), __uint_as_float(u.y & 0xffff0000u)};
}
#define SQ_LOAD(S, it) { \
    const char* ga_ = GA0 + (size_t)(it) * 8192 + lane * 16; const char* ra_ = RA0 + (size_t)(it) * 4096 + lane * 16; \
    const char* ha_ = HA0 + (size_t)(it) * 8192 + (rg * 4 * 64 + lane) * 8; const char* y1_ = Y10 + (size_t)(it) * 4096 + (rg * 2 * 64 + lane) * 8; \
    _Pragma("unroll") for (int i_ = 0; i_ < 8; ++i_) S.ga[i_] = *(const uint4*)(ga_ + i_ * 1024); \
    _Pragma("unroll") for (int i_ = 0; i_ < 4; ++i_) S.ra[i_] = *(const uint4*)(ra_ + i_ * 1024); \
    _Pragma("unroll") for (int i_ = 0; i_ < 4; ++i_) S.ha[i_] = *(const uint2*)(ha_ + i_ * 512); \
    _Pragma("unroll") for (int i_ = 0; i_ < 2; ++i_) S.y1[i_] = *(const uint2*)(y1_ + i_ * 512); }
#define SQ_STEP(S, cidx) { \
    const bf16x8 b0 = as_frag(make_uint4(cvtpk(acc0[0], acc0[1]), cvtpk(acc0[2], acc0[3]), cvtpk(acc1[0], acc1[1]), cvtpk(acc1[2], acc1[3]))); \
    const bf16x8 b1 = as_frag(make_uint4(cvtpk(acc2[0], acc2[1]), cvtpk(acc2[2], acc2[3]), cvtpk(acc3[0], acc3[1]), cvtpk(acc3[2], acc3[3]))); \
    f32x4 y0 = bf4_to_acc(S.y1[0]), y1v = bf4_to_acc(S.y1[1]); \
    y0 = CK_MMA(as_frag(S.ra[0]), b0, y0); y0 = CK_MMA(as_frag(S.ra[1]), b1, y0); \
    y1v = CK_MMA(as_frag(S.ra[2]), b0, y1v); y1v = CK_MMA(as_frag(S.ra[3]), b1, y1v); \
    f32x4 n0 = bf4_to_acc(S.ha[0]), n1 = bf4_to_acc(S.ha[1]), n2 = bf4_to_acc(S.ha[2]), n3 = bf4_to_acc(S.ha[3]); \
    n0 = CK_MMA(as_frag(S.ga[0]), b0, n0); n0 = CK_MMA(as_frag(S.ga[1]), b1, n0); \
    n1 = CK_MMA(as_frag(S.ga[2]), b0, n1); n1 = CK_MMA(as_frag(S.ga[3]), b1, n1); \
    n2 = CK_MMA(as_frag(S.ga[4]), b0, n2); n2 = CK_MMA(as_frag(S.ga[5]), b1, n2); \
    n3 = CK_MMA(as_frag(S.ga[6]), b0, n3); n3 = CK_MMA(as_frag(S.ga[7]), b1, n3); \
    bf16_t* yo_ = YS0 + (size_t)(cidx) * 32 * 512; \
    _Pragma("unroll") for (int r_ = 0; r_ < 4; ++r_) { yo_[(size_t)(4 * q + r_) * 512] = f2bf(y0[r_]); yo_[(size_t)(16 + 4 * q + r_) * 512] = f2bf(y1v[r_]); } \
    acc0 = n0; acc1 = n1; acc2 = n2; acc3 = n3; }
__device__ __forceinline__ void phase_seq(const Params& p) {
  if (VHALF != 0) return;
  int tid_l_ = VTID; asm volatile("" : "+v"(tid_l_)); const int tid = tid_l_, lane = tid & 63, q = lane >> 4, c16 = lane & 15;
  const int rg = __builtin_amdgcn_readfirstlane(tid >> 6);
  const char* const GA0 = (const char*)p.out + CK_GA_OFF; const char* const HA0 = (const char*)p.out + CK_HA_OFF;
  const char* const RA0 = p.ws + OFF_RA; const char* const Y10 = p.ws + OFF_Y1A;
  for (int hd = (int)blockIdx.x; hd < 64; hd += (int)gridDim.x) {
    const int b = hd >> 3, h = hd & 7;
    bf16_t* const YS0 = (bf16_t*)(p.ws + OFF_YS) + (size_t)b * SEQ * 512 + h * 64 + rg * 16 + c16;
    f32x4 acc0 = (f32x4){0.f, 0.f, 0.f, 0.f}, acc1 = acc0, acc2 = acc0, acc3 = acc0;
    SeqSet sa, sb;
    SQ_LOAD(sa, hd * 128)
    for (int c = 0; c < 128; c += 2) {
      SQ_LOAD(sb, hd * 128 + c + 1)
      SQ_STEP(sa, c)
      if (c + 2 < 128) SQ_LOAD(sa, hd * 128 + c + 2)
      SQ_STEP(sb, c + 1)
    }
  }
}


#define CONV_TILES (257 * 96)
struct ConvDesc { const float* src; bf16_t* dst; int ldn, k0, n0, kdim, part; };
__device__ __forceinline__ ConvDesc conv_desc(const Params& p, const int ti) {
  ConvDesc d;
  const int e = ti / 96, q = ti - e * 96, part = q >> 5, w = q & 31;
  d.part = part;
  if (part < 2) {
    d.src = (e < NEXP) ? p.in[18 + part] + (size_t)e * DM * 256 : p.in[21 + part];
    d.ldn = 256; d.k0 = (w >> 1) * 64; d.n0 = (w & 1) * 128; d.kdim = 1024;
    d.dst = (bf16_t*)(p.ws + OFF_EW1 + (size_t)e * 512 * 1024);
  } else {
    d.src = (e < NEXP) ? p.in[20] + (size_t)e * 256 * DM : p.in[23];
    d.ldn = 1024; d.k0 = (w >> 3) * 64; d.n0 = (w & 7) * 128; d.kdim = 256;
    d.dst = (bf16_t*)(p.ws + OFF_EW2 + (size_t)e * 1024 * 256);
  }
  return d;
}
#define CV_LOAD(d, r) { \
    const float* bp_ = (d).src + (size_t)((d).k0 + ko * 8) * (d).ldn + (d).n0 + nq * 4; \
    r##0 = *(const float4*)(bp_); r##1 = *(const float4*)(bp_ + (size_t)1 * (d).ldn); r##2 = *(const float4*)(bp_ + (size_t)2 * (d).ldn); \
    r##3 = *(const float4*)(bp_ + (size_t)3 * (d).ldn); r##4 = *(const float4*)(bp_ + (size_t)4 * (d).ldn); r##5 = *(const float4*)(bp_ + (size_t)5 * (d).ldn); \
    r##6 = *(const float4*)(bp_ + (size_t)6 * (d).ldn); r##7 = *(const float4*)(bp_ + (size_t)7 * (d).ldn); }
#define CV_LDS(r, base) { \
    uint4 v; \
    v.x = cvtpk((r##0).x, (r##1).x); v.y = cvtpk((r##2).x, (r##3).x); v.z = cvtpk((r##4).x, (r##5).x); v.w = cvtpk((r##6).x, (r##7).x); *(uint4*)((base) + lds_off(nq * 4 + 0, ko)) = v; \
    v.x = cvtpk((r##0).y, (r##1).y); v.y = cvtpk((r##2).y, (r##3).y); v.z = cvtpk((r##4).y, (r##5).y); v.w = cvtpk((r##6).y, (r##7).y); *(uint4*)((base) + lds_off(nq * 4 + 1, ko)) = v; \
    v.x = cvtpk((r##0).z, (r##1).z); v.y = cvtpk((r##2).z, (r##3).z); v.z = cvtpk((r##4).z, (r##5).z); v.w = cvtpk((r##6).z, (r##7).z); *(uint4*)((base) + lds_off(nq * 4 + 2, ko)) = v; \
    v.x = cvtpk((r##0).w, (r##1).w); v.y = cvtpk((r##2).w, (r##3).w); v.z = cvtpk((r##4).w, (r##5).w); v.w = cvtpk((r##6).w, (r##7).w); *(uint4*)((base) + lds_off(nq * 4 + 3, ko)) = v; }
#define CV_OUT(d, base) { \
    _Pragma("unroll") for (int u = 0; u < 4; ++u) { \
      const int row = (tid >> 3) + 32 * u, chunk = tid & 7; \
      const int c = (d).n0 + row; \
      const int orow = ((d).part < 2) ? ((c >> 7) * 256 + (d).part * 128 + (c & 127)) : c;     \
      *(uint4*)((d).dst + (size_t)orow * (d).kdim + (d).k0 + chunk * 8) = *(const uint4*)((base) + lds_off(row, chunk)); } }
#define CV8_LDS(r, base, SC) { \
    uint2 v; \
    v.x = pk4_fp8c((r##0).x * SC, (r##1).x * SC, (r##2).x * SC, (r##3).x * SC); v.y = pk4_fp8c((r##4).x * SC, (r##5).x * SC, (r##6).x * SC, (r##7).x * SC); \
    *(uint2*)((base) + (nq * 4 + 0) * 64 + ((ko ^ (nq & 7)) << 3)) = v; \
    v.x = pk4_fp8c((r##0).y * SC, (r##1).y * SC, (r##2).y * SC, (r##3).y * SC); v.y = pk4_fp8c((r##4).y * SC, (r##5).y * SC, (r##6).y * SC, (r##7).y * SC); \
    *(uint2*)((base) + (nq * 4 + 1) * 64 + ((ko ^ (nq & 7)) << 3)) = v; \
    v.x = pk4_fp8c((r##0).z * SC, (r##1).z * SC, (r##2).z * SC, (r##3).z * SC); v.y = pk4_fp8c((r##4).z * SC, (r##5).z * SC, (r##6).z * SC, (r##7).z * SC); \
    *(uint2*)((base) + (nq * 4 + 2) * 64 + ((ko ^ (nq & 7)) << 3)) = v; \
    v.x = pk4_fp8c((r##0).w * SC, (r##1).w * SC, (r##2).w * SC, (r##3).w * SC); v.y = pk4_fp8c((r##4).w * SC, (r##5).w * SC, (r##6).w * SC, (r##7).w * SC); \
    *(uint2*)((base) + (nq * 4 + 3) * 64 + ((ko ^ (nq & 7)) << 3)) = v; }
#define CV8_OUT(d, base) { \
    _Pragma("unroll") for (int u = 0; u < 2; ++u) { \
      const int row = (tid >> 2) + 64 * u, c16_ = tid & 3, f_ = (row >> 2) & 7; \
      const uint2 s0 = *(const uint2*)((base) + row * 64 + (((2 * c16_) ^ f_) << 3)), s1 = *(const uint2*)((base) + row * 64 + (((2 * c16_ + 1) ^ f_) << 3)); \
      const int c = (d).n0 + row; \
      const int orow = ((d).part < 2) ? ((c >> 7) * 256 + (d).part * 128 + (c & 127)) : c; \
      *(uint4*)((char*)(d).dst + (size_t)orow * (d).kdim + (d).k0 + c16_ * 16) = make_uint4(s0.x, s0.y, s1.x, s1.y); } }
__device__ __forceinline__ void convert_tile2(const Params& p, char* smem, const int t2) {
  int tid_l_ = VTID; asm volatile("" : "+v"(tid_l_)); const int tid = tid_l_, nq = tid & 31, ko = tid >> 5;
  const ConvDesc da = conv_desc(p, 2 * t2), db = conv_desc(p, 2 * t2 + 1);
  float4 ra0, ra1, ra2, ra3, ra4, ra5, ra6, ra7, rb0, rb1, rb2, rb3, rb4, rb5, rb6, rb7;
  CV_LOAD(da, ra)
  CV_LOAD(db, rb)
  CV8_LDS(ra, smem, W_SCALE)
  CV8_LDS(rb, smem + 16384, W_SCALE)
  HSYNC();
  CV8_OUT(da, smem)
  CV8_OUT(db, smem + 16384)
  HSYNC();
}
#undef CV_LOAD
#undef CV_LDS
#undef CV_OUT

__device__ __forceinline__ int vt_off(int d, int key) { const int swz = ((d >> 2) & 15) ^ ((d & 3) << 3); return d * 512 + (((key >> 2) ^ swz) << 3); }
__device__ __forceinline__ void attn_item(const Params& p, char* smem, const int item) {
  const bf16_t* __restrict__ Q = (const bf16_t*)(p.ws + OFF_Q); const bf16_t* __restrict__ K = (const bf16_t*)(p.ws + OFF_K);
  const bf16_t* __restrict__ V = (const bf16_t*)(p.ws + OFF_V);
  bf16_t* OP = (bf16_t*)(p.ws + OFF_OP); float* LSE = (float*)(p.ws + OFF_LSE);
  char* Ks = smem; char* VT = smem + 32768; float* linv_s = (float*)(smem + 65536);
  int tid_l_ = VTID; asm volatile("" : "+v"(tid_l_)); const int tid = tid_l_, lane = tid & 63, wid = tid >> 6, l31 = lane & 31, hi = lane >> 5;
  {
    const int pp = item >> 11, rem = item & 2047, bh = rem >> 5, sub = rem & 31;
    const int dsh = pp * 2, nbsh = 5 - dsh;
    const int r = sub >> nbsh, n = sub & ((1 << nbsh) - 1);
    const int b = bh >> 3, h = bh & 7, tb = b * SEQ;
    HSYNC();
#pragma unroll
    for (int u = 0; u < 8; ++u) {
      if (u == 4) __builtin_amdgcn_sched_barrier(0);
      const int row = (tid >> 3) + 32 * u, chunk = tid & 7;
      int ik = n * 128 - 128 + row; ik = ik < 0 ? 0 : ik;
      const int tok = tb + (ik << dsh) + r;
      *(uint4*)(Ks + lds_off(row, chunk)) = *(const uint4*)(K + (size_t)tok * 512 + h * 64 + chunk * 8);
    }
#pragma unroll
    for (int ps = 0; ps < 2; ++ps) {
      const int dq = tid & 15, kbase = ps * 128 + (tid >> 4) * 8;
      uint2 v0, v1, v2, v3, v4, v5, v6, v7;
#define LDV(i, dst) { int ik = n * 128 - 128 + kbase + i; ik = ik < 0 ? 0 : ik; const int tok = tb + (ik << dsh) + r; dst = *(const uint2*)(V + (size_t)tok * 512 + h * 64 + dq * 4); }
      LDV(0, v0) LDV(1, v1) LDV(2, v2) LDV(3, v3) LDV(4, v4) LDV(5, v5) LDV(6, v6) LDV(7, v7)
#undef LDV
      {
        uint2 w;
        w.x = (v0.x & 0xffffu) | (v1.x << 16); w.y = (v2.x & 0xffffu) | (v3.x << 16);
        *(uint2*)(VT + vt_off(dq * 4 + 0, kbase)) = w;
        w.x = (v4.x & 0xffffu) | (v5.x << 16); w.y = (v6.x & 0xffffu) | (v7.x << 16);
        *(uint2*)(VT + vt_off(dq * 4 + 0, kbase + 4)) = w;
        w.x = (v0.x >> 16) | (v1.x & 0xffff0000u); w.y = (v2.x >> 16) | (v3.x & 0xffff0000u);
        *(uint2*)(VT + vt_off(dq * 4 + 1, kbase)) = w;
        w.x = (v4.x >> 16) | (v5.x & 0xffff0000u); w.y = (v6.x >> 16) | (v7.x & 0xffff0000u);
        *(uint2*)(VT + vt_off(dq * 4 + 1, kbase + 4)) = w;
        w.x = (v0.y & 0xffffu) | (v1.y << 16); w.y = (v2.y & 0xffffu) | (v3.y << 16);
        *(uint2*)(VT + vt_off(dq * 4 + 2, kbase)) = w;
        w.x = (v4.y & 0xffffu) | (v5.y << 16); w.y = (v6.y & 0xffffu) | (v7.y << 16);
        *(uint2*)(VT + vt_off(dq * 4 + 2, kbase + 4)) = w;
        w.x = (v0.y >> 16) | (v1.y & 0xffff0000u); w.y = (v2.y >> 16) | (v3.y & 0xffff0000u);
        *(uint2*)(VT + vt_off(dq * 4 + 3, kbase)) = w;
        w.x = (v4.y >> 16) | (v5.y & 0xffff0000u); w.y = (v6.y >> 16) | (v7.y & 0xffff0000u);
        *(uint2*)(VT + vt_off(dq * 4 + 3, kbase + 4)) = w;
      }
    }
    HSYNC();
    const int iq = n * 128 + wid * 32 + l31;
    const int tq = tb + (iq << dsh) + r;
    bf16x8 qf[4];
#pragma unroll
    for (int ks = 0; ks < 4; ++ks) qf[ks] = *(const bf16x8*)(Q + (size_t)tq * 512 + h * 64 + ks * 16 + hi * 8);
    f32x16 st[5];
#pragma unroll
    for (int kb = 0; kb < 5; ++kb) {
      st[kb] = (f32x16){0.f, 0.f, 0.f, 0.f, 0.f, 0.f, 0.f, 0.f, 0.f, 0.f, 0.f, 0.f, 0.f, 0.f, 0.f, 0.f};
#pragma unroll
      for (int ks = 0; ks < 4; ++ks) {
        const bf16x8 kf = *(const bf16x8*)(Ks + lds_off(32 * (wid + kb) + l31, 2 * ks + hi));
        st[kb] = __builtin_amdgcn_mfma_f32_32x32x16_bf16(kf, qf[ks], st[kb], 0, 0, 0);
      }
    }
    float m = -INFINITY;
#pragma unroll
    for (int kb = 0; kb < 5; ++kb)
#pragma unroll
      for (int i = 0; i < 16; ++i) {
        const int kirel = 32 * kb + (i & 3) + 8 * (i >> 2) + 4 * hi;
        const bool valid = (kirel >= l31) && (kirel <= l31 + 128) && (n > 0 || (32 * wid + kirel) >= 128);
        const float s = valid ? st[kb][i] : -INFINITY;
        st[kb][i] = s;
        m = fmaxf(m, s);
      }
    m = fmaxf(m, __shfl_xor(m, 32, 64));
    float l = 0.f;
#pragma unroll
    for (int kb = 0; kb < 5; ++kb)
#pragma unroll
      for (int i = 0; i < 16; ++i) { const float pe = __expf(st[kb][i] - m); st[kb][i] = pe; l += pe; }
    l += __shfl_xor(l, 32, 64);
    f32x16 o0 = (f32x16){0.f, 0.f, 0.f, 0.f, 0.f, 0.f, 0.f, 0.f, 0.f, 0.f, 0.f, 0.f, 0.f, 0.f, 0.f, 0.f};
    f32x16 o1 = o0;
#pragma unroll
    for (int kb = 0; kb < 5; ++kb)
#pragma unroll
      for (int s = 0; s < 2; ++s) {
        union { unsigned u[4]; bf16x8 v; } pa;
        pa.u[0] = cvtpk(st[kb][8 * s + 0], st[kb][8 * s + 1]); pa.u[1] = cvtpk(st[kb][8 * s + 2], st[kb][8 * s + 3]);
        pa.u[2] = cvtpk(st[kb][8 * s + 4], st[kb][8 * s + 5]); pa.u[3] = cvtpk(st[kb][8 * s + 6], st[kb][8 * s + 7]);
        const int key0 = 32 * (wid + kb) + 16 * s + 4 * hi;
        {
          union { uint2 u[2]; bf16x8 v; } vb;
          vb.u[0] = *(const uint2*)(VT + vt_off(l31, key0)); vb.u[1] = *(const uint2*)(VT + vt_off(l31, key0 + 8));
          o0 = __builtin_amdgcn_mfma_f32_32x32x16_bf16(pa.v, vb.v, o0, 0, 0, 0);
        }
        {
          union { uint2 u[2]; bf16x8 v; } vb;
          vb.u[0] = *(const uint2*)(VT + vt_off(32 + l31, key0)); vb.u[1] = *(const uint2*)(VT + vt_off(32 + l31, key0 + 8));
          o1 = __builtin_amdgcn_mfma_f32_32x32x16_bf16(pa.v, vb.v, o1, 0, 0, 0);
        }
      }
    if (hi == 0) {
      linv_s[wid * 32 + l31] = 1.f / l;
      LSE[((size_t)pp * T_TOK + tq) * 8 + h] = m + __logf(l);
    }
#pragma unroll
    for (int i = 0; i < 16; ++i) {
      const int qrel = (i & 3) + 8 * (i >> 2) + 4 * hi;
      const int iq2 = n * 128 + wid * 32 + qrel;
      const int tq2 = tb + (iq2 << dsh) + r;
      const float li = linv_s[wid * 32 + qrel];
      bf16_t* op = OP + ((size_t)pp * T_TOK + tq2) * 512 + h * 64 + l31;
      op[0] = f2bf(o0[i] * li);
      op[32] = f2bf(o1[i] * li);
    }
  }
}

#define CTL_ATTQ 2048
__device__ __forceinline__ unsigned xb_xcc_id();
__device__ __forceinline__ void phase_convert(const Params& p, char* smem) {
  int* ctl = (int*)(p.ws + OFF_CTL);
  int* slot = (int*)(smem + 66304);
  HSYNC();
  if (VTID == 0) { slot[1] = (int)(xb_xcc_id() & 7u); slot[2] = 0; }
  for (;;) {
    if (VTID == 0) {
      int g_ = slot[1], tried_ = slot[2], it_ = -1;
      while (tried_ < 8) {
        const int t_ = atomicAdd(&ctl[CTL_ATTQ + 32 * g_], 1);
        if (t_ < 768) { const int j_ = t_ / 96, w_ = t_ - 96 * j_, pp_ = w_ >> 5, sub_ = w_ & 31; it_ = pp_ * 2048 + (g_ + 8 * j_) * 32 + sub_; break; }
        g_ = (g_ + 1) & 7; ++tried_;
      }
      slot[0] = it_; slot[1] = g_; slot[2] = tried_;
    }
    HSYNC();
    const int ai = slot[0];
    HSYNC();
    if (ai < 0) break;
    attn_item(p, smem, ai);
    __builtin_amdgcn_sched_barrier(0);
#pragma unroll 1
    for (int rep = 0; rep < 2; ++rep) {
      if (VTID == 0) slot[3] = atomicAdd(&ctl[CTL_CONVQ + 2], 1);
      HSYNC();
      const int cp = slot[3];
      HSYNC();
      if (cp < CONV_TILES / 2) convert_tile2(p, smem, cp);
    }
    __builtin_amdgcn_sched_barrier(0);
  }
  for (;;) {
    if (VTID == 0) *slot = atomicAdd(&ctl[CTL_CONVQ], 1);
    HSYNC();
    const int ti = *slot;
    HSYNC();
    if (ti >= 1024) break;
    prep_item<2>(p, smem, (ti >> 2) * 128, (ti & 3) * 128);
    __builtin_amdgcn_sched_barrier(0);
  }
  for (;;) {
    if (VTID == 0) slot[3] = atomicAdd(&ctl[CTL_CONVQ + 2], 1);
    HSYNC();
    const int cp = slot[3];
    HSYNC();
    if (cp >= CONV_TILES / 2) break;
    convert_tile2(p, smem, cp);
    __builtin_amdgcn_sched_barrier(0);
  }
}

__device__ __forceinline__ void unpack8(const uint4 u, float (&f)[8]) {
  f[0] = __uint_as_float(u.x << 16); f[1] = __uint_as_float(u.x & 0xffff0000u); f[2] = __uint_as_float(u.y << 16); f[3] = __uint_as_float(u.y & 0xffff0000u);
  f[4] = __uint_as_float(u.z << 16); f[5] = __uint_as_float(u.z & 0xffff0000u); f[6] = __uint_as_float(u.w << 16); f[7] = __uint_as_float(u.w & 0xffff0000u);
}
__device__ __forceinline__ float dpp_sum8(float v) {
  v += DPP_F(v, 0xB1); v += DPP_F(v, 0x4E); v += DPP_F(v, 0x141);
  return v;
}
__device__ __forceinline__ void phase_post(const Params& p) {
  const bf16_t* __restrict__ YS = (const bf16_t*)(p.ws + OFF_YS); const bf16_t* __restrict__ V2 = (const bf16_t*)(p.ws + OFF_V2);
  const bf16_t* __restrict__ G = (const bf16_t*)(p.ws + OFF_G); const float* __restrict__ SB = (const float*)(p.ws + OFF_SB);
  const bf16_t* __restrict__ OP = (const bf16_t*)(p.ws + OFF_OP); const float* __restrict__ LSE = (const float*)(p.ws + OFF_LSE);
  const float* __restrict__ lnx_g = p.in[11]; const float* __restrict__ lnx_b = p.in[12];
  unsigned char* MIXED = (unsigned char*)(p.ws + OFF_MIXED);
  const int lane = VTID & 63, wid = VTID >> 6;
  const int c = lane * 8, hh = lane >> 3;
  const float4 g0 = *(const float4*)(lnx_g + c), g1 = *(const float4*)(lnx_g + c + 4), b0 = *(const float4*)(lnx_b + c), b1 = *(const float4*)(lnx_b + c + 4);
  const float gg[8] = {g0.x, g0.y, g0.z, g0.w, g1.x, g1.y, g1.z, g1.w}, bb[8] = {b0.x, b0.y, b0.z, b0.w, b1.x, b1.y, b1.z, b1.w};
  for (int t = VBID * 4 + wid; t < T_TOK; t += VGRID * 4) {
    const size_t o = (size_t)t * 512 + c;
    float y[8];
    unpack8(*(const uint4*)(YS + o), y);
    float s = 0.f;
#pragma unroll
    for (int i = 0; i < 8; ++i) s += y[i];
    const float mean = dpp_sum8(s) * (1.f / 64.f);
    float q = 0.f;
#pragma unroll
    for (int i = 0; i < 8; ++i) { const float d = y[i] - mean; q += d * d; }
    const float rs = rsqrtf(dpp_sum8(q) * (1.f / 64.f) + GN_EPS_F);
    float v2[8], gt[8];
    unpack8(*(const uint4*)(V2 + o), v2); unpack8(*(const uint4*)(G + o), gt);
    const float sb = SB[(size_t)t * 8 + hh];
    float res[8];
#pragma unroll
    for (int i = 0; i < 8; ++i) res[i] = ((y[i] - mean) * rs * gg[i] + bb[i] + sb * v2[i]) * gt[i];
    uint2 w; w.x = pk4_fp8c(X_SCALE * res[0], X_SCALE * res[1], X_SCALE * res[2], X_SCALE * res[3]); w.y = pk4_fp8c(X_SCALE * res[4], X_SCALE * res[5], X_SCALE * res[6], X_SCALE * res[7]);
    *(uint2*)(MIXED + (size_t)t * 1024 + 512 + c) = w;
    const float l0 = LSE[((size_t)0 * T_TOK + t) * 8 + hh], l1 = LSE[((size_t)1 * T_TOK + t) * 8 + hh], l2 = LSE[((size_t)2 * T_TOK + t) * 8 + hh];
    const float mx = fmaxf(l0, fmaxf(l1, l2));
    float e0 = __expf(l0 - mx), e1 = __expf(l1 - mx), e2 = __expf(l2 - mx);
    const float inv = 1.f / (e0 + e1 + e2);
    e0 *= inv; e1 *= inv; e2 *= inv;
    float o0[8], o1[8], o2[8];
    unpack8(*(const uint4*)(OP + (size_t)0 * T_TOK * 512 + o), o0); unpack8(*(const uint4*)(OP + (size_t)1 * T_TOK * 512 + o), o1);
    unpack8(*(const uint4*)(OP + (size_t)2 * T_TOK * 512 + o), o2);
    float av[8];
#pragma unroll
    for (int i = 0; i < 8; ++i) av[i] = e0 * o0[i] + e1 * o1[i] + e2 * o2[i];
    w.x = pk4_fp8c(X_SCALE * av[0], X_SCALE * av[1], X_SCALE * av[2], X_SCALE * av[3]); w.y = pk4_fp8c(X_SCALE * av[4], X_SCALE * av[5], X_SCALE * av[6], X_SCALE * av[7]);
    *(uint2*)(MIXED + (size_t)t * 1024 + c) = w;
  }
}

struct EpiOutproj {
  static constexpr bool PERM = true, AFTER_DRAIN = false;
  const float* x; bf16_t* U;
  __device__ __forceinline__ void operator()(const pg8::f32x4 (&acc)[2][2][4][2], const pg8::Unit& u, int wr, int wc, int fr, int fq) const {
#pragma unroll
    for (int ai = 0; ai < 2; ++ai)
#pragma unroll
      for (int m = 0; m < 4; ++m) {
        const int t = u.pm * 256 + ai * 128 + wr * 64 + m * 16 + fr;
#pragma unroll
        for (int bj = 0; bj < 2; ++bj) {
          const size_t o = (size_t)t * DM + u.pn * 256 + bj * 128 + wc * 32 + 8 * fq;
          const float4 x0 = *(const float4*)(x + o), x1 = *(const float4*)(x + o + 4);
          const pg8::f32x4 v0 = acc[ai][bj][m][0] * MOE1_UNSCALE, v1 = acc[ai][bj][m][1] * MOE1_UNSCALE;
          uint4 w;
          w.x = cvtpk(ALPHA_F * x0.x + v0[0], ALPHA_F * x0.y + v0[1]); w.y = cvtpk(ALPHA_F * x0.z + v0[2], ALPHA_F * x0.w + v0[3]);
          w.z = cvtpk(ALPHA_F * x1.x + v1[0], ALPHA_F * x1.y + v1[1]); w.w = cvtpk(ALPHA_F * x1.z + v1[2], ALPHA_F * x1.w + v1[3]);
          *(uint4*)(U + o) = w;
        }
      }
  }
};
__device__ __forceinline__ void phase_outproj(const Params& p, char* smem_all) {
  pg8::Gemm g{(const pg8::bf16_t*)(p.ws + OFF_MIXED), (const pg8::bf16_t*)(p.ws + OFF_WOUTT), T_TOK, DM, DM / 2};
  pg8::StaticOrder S; S.init(T_TOK, DM, (int)gridDim.x, (int)blockIdx.x);
  EpiOutproj E{p.in[0], (bf16_t*)p.out};
  pg8::gemm_phase<EpiOutproj, pg8::StaticOrder, true, true, false, true>((PG8_LAS unsigned char*)smem_all, g, S, E);
}

__device__ __forceinline__ void phase_ln1(const Params& p) {
  const bf16_t* __restrict__ U = (const bf16_t*)p.out;
  const float* __restrict__ g1 = p.in[14]; const float* __restrict__ b1 = p.in[15];
  bf16_t* X1B = (bf16_t*)(p.ws + OFF_X1B);
  unsigned char* X1F8 = (unsigned char*)(p.ws + OFF_X1F8);
  const int lane = VTID & 63, wid = VTID >> 6;
  for (int t = VBID * 4 + wid; t < T_TOK; t += VGRID * 4) {
    const size_t base = (size_t)t * DM;
    float4 v[4];
    float s = 0.f;
#pragma unroll
    for (int u = 0; u < 4; ++u) { v[u] = bf4_to_f4(*(const uint2*)(U + base + u * 256 + lane * 4)); s += (v[u].x + v[u].y) + (v[u].z + v[u].w); }
    const float mean = wave_sum_fast(s) * (1.f / DM);
    float q = 0.f;
#pragma unroll
    for (int u = 0; u < 4; ++u) {
      const float d0 = v[u].x - mean, d1 = v[u].y - mean, d2 = v[u].z - mean, d3 = v[u].w - mean;
      q += (d0 * d0 + d1 * d1) + (d2 * d2 + d3 * d3);
    }
    const float rs = rsqrtf(wave_sum_fast(q) * (1.f / DM) + LN_EPS_F);
#pragma unroll
    for (int u = 0; u < 4; ++u) {
      const int c = u * 256 + lane * 4;
      const float4 g = *(const float4*)(g1 + c), bb = *(const float4*)(b1 + c);
      float4 y;
      y.x = (v[u].x - mean) * rs * g.x + bb.x; y.y = (v[u].y - mean) * rs * g.y + bb.y;
      y.z = (v[u].z - mean) * rs * g.z + bb.z; y.w = (v[u].w - mean) * rs * g.w + bb.w;
      uint2 hi; hi.x = cvtpk(y.x, y.y); hi.y = cvtpk(y.z, y.w);
      *(uint2*)(X1B + base + c) = hi;
      *(unsigned*)(X1F8 + base + c) = pk4_fp8c(X_SCALE * y.x, X_SCALE * y.y, X_SCALE * y.z, X_SCALE * y.w);
    }
  }
}

__device__ __forceinline__ void phase_router_gemm(const Params& p, char* smem) {
  const bf16_t* __restrict__ X1B = (const bf16_t*)(p.ws + OFF_X1B);
  const float* __restrict__ router_w = p.in[16];
  float* AFF = (float*)(p.ws + OFF_AFF);
  for (int item = VBID; item < (T_TOK / 128) * 2; item += VGRID) {
    const int row0 = (item >> 1) * 128, col0 = (item & 1) * 128;
    f32x4 acc[4][4];
    acc_zero(acc);
    gemm128_acc<0, false>(acc, smem, 16,
        [=](int, int rowl, int kc) { return *(const uint4*)(X1B + (size_t)(row0 + rowl) * DM + kc * 8); },
        [=](int nq) { return router_w + col0 + nq * 4; }, NEXP, 0);
    int tid_l_ = VTID; asm volatile("" : "+v"(tid_l_)); const int tid = tid_l_, lane = tid & 63, wid = tid >> 6;
    const int wr = wid >> 1, wc = wid & 1, fr = lane & 15, fq = lane >> 4;
#pragma unroll
    for (int m = 0; m < 4; ++m) {
      const int t = row0 + wr * 64 + m * 16 + fr;
#pragma unroll
      for (int n = 0; n < 4; ++n)
        *(float4*)(AFF + (size_t)t * NEXP + col0 + wc * 64 + n * 16 + fq * 4) =
            make_float4(sigmoidf_(acc[m][n][0]), sigmoidf_(acc[m][n][1]), sigmoidf_(acc[m][n][2]), sigmoidf_(acc[m][n][3]));
    }
  }
}

__device__ __forceinline__ void phase_topk(const Params& p, char* smem_all) {
  const float* __restrict__ AFF = (const float*)(p.ws + OFF_AFF);
  const float* __restrict__ router_bias = p.in[17];
  int* LIST = (int*)(p.ws + OFF_LIST); float* GATEW = (float*)(p.ws + OFF_GATEW);
  int* counts = (int*)(p.ws + OFF_CTL);
  const int lane = VTID & 63, wid = VTID >> 6;
  const float4 b4 = *(const float4*)(router_bias + lane * 4);
  int* hist = (int*)smem_all; int* lbase = hist + 256; int* rec = lbase + 256;
  if (threadIdx.x < 256) hist[threadIdx.x] = 0;
  __syncthreads();
  const int t0 = VBID * 4 + wid, tstep = VGRID * 4;
  float4 a4n = make_float4(0.f, 0.f, 0.f, 0.f);
  if (t0 < T_TOK) a4n = *(const float4*)(AFF + (size_t)t0 * NEXP + lane * 4);
  int kr = 0;
  for (int t = t0; t < T_TOK; t += tstep, ++kr) {
    const float4 a4 = a4n;
    if (t + tstep < T_TOK) a4n = *(const float4*)(AFF + (size_t)(t + tstep) * NEXP + lane * 4);
    float s0 = a4.x + b4.x, s1 = a4.y + b4.y, s2 = a4.z + b4.z, s3 = a4.w + b4.w;
    const float hi01 = fmaxf(s0, s1), lo01 = fminf(s0, s1), hi23 = fmaxf(s2, s3), lo23 = fminf(s2, s3);
    float m1 = fmaxf(hi01, hi23), m2 = fmaxf(fminf(hi01, hi23), fmaxf(lo01, lo23));
    { const float o1 = DPP_F(m1, 0xB1), o2 = DPP_F(m2, 0xB1); const float n1 = fmaxf(m1, o1); m2 = fmaxf(fminf(m1, o1), fmaxf(m2, o2)); m1 = n1; }
    { const float o1 = DPP_F(m1, 0x4E), o2 = DPP_F(m2, 0x4E); const float n1 = fmaxf(m1, o1); m2 = fmaxf(fminf(m1, o1), fmaxf(m2, o2)); m1 = n1; }
    { const float o1 = DPP_F(m1, 0x141), o2 = DPP_F(m2, 0x141); const float n1 = fmaxf(m1, o1); m2 = fmaxf(fminf(m1, o1), fmaxf(m2, o2)); m1 = n1; }
    const float gs = m1 + m2;
    const int g = lane >> 3;
    int rank = 0;
#pragma unroll
    for (int gg = 0; gg < 8; ++gg) { const float G = rdlane_f(gs, gg * 8); rank += ((G > gs) || (G == gs && gg < g)) ? 1 : 0; }
    if (rank >= 4) { s0 = -INFINITY; s1 = -INFINITY; s2 = -INFINITY; s3 = -INFINITY; }
    int my_e = 0; float my_a = 0.f;
#pragma unroll 1
    for (int it = 0; it < 8; ++it) {
      const float lm = fmaxf(fmaxf(s0, s1), fmaxf(s2, s3));
      const float wm = wave_max_fast(lm);
      const unsigned long long bal = __ballot(lm == wm);
      const int win = __ffsll((long long)bal) - 1;
      const int wi = (s0 == wm) ? 0 : ((s1 == wm) ? 1 : ((s2 == wm) ? 2 : 3));
      const float wa = (wi == 0) ? a4.x : ((wi == 1) ? a4.y : ((wi == 2) ? a4.z : a4.w));
      const int e_w = __builtin_amdgcn_readlane(lane * 4 + wi, win);
      const float a_w = rdlane_f(wa, win);
      if (lane == win) { if (wi == 0) s0 = -INFINITY; else if (wi == 1) s1 = -INFINITY; else if (wi == 2) s2 = -INFINITY; else s3 = -INFINITY; }
      if (lane == it) { my_e = e_w; my_a = a_w; }
    }
    const float asum = rdlane_f(dpp_sum16x(my_a), 0);
    if (lane < 8) {
      const int lp = atomicAdd(&hist[my_e], 1);
      rec[(kr * 8 + (int)(threadIdx.x >> 6)) * 8 + lane] = my_e | (lp << 8);
      GATEW[(size_t)lane * T_TOK + t] = my_a * 2.5f / asum;
    }
  }
  __syncthreads();
  if (threadIdx.x < 256) { const int c = hist[threadIdx.x]; lbase[threadIdx.x] = (c > 0) ? atomicAdd(&counts[CNT(threadIdx.x)], c) : 0; }
  __syncthreads();
  kr = 0;
  for (int t = t0; t < T_TOK; t += tstep, ++kr) {
    if (lane < 8) {
      const int r = rec[(kr * 8 + (int)(threadIdx.x >> 6)) * 8 + lane], e = r & 255, pos = lbase[e] + (r >> 8);
      if (pos < LCAP) LIST[(size_t)e * LCAP + pos] = lane * T_TOK + t;
    }
  }
}

#define CTL_MOEPRE 1536
struct SeqOrder {
  int n;
  __device__ __forceinline__ bool next(int i, pg8::Unit& u) const { if (i >= n) return false; u.pm = 0; u.pn = i; return true; }
  __device__ __forceinline__ void a_ready(const pg8::Unit&) const {}
  __device__ __forceinline__ void done(const pg8::Unit&) const {}
};
struct EpiMoe1 {
  static constexpr bool PERM = true, AFTER_DRAIN = false;
  bf16_t* HS;
  __device__ __forceinline__ void operator()(const pg8::f32x4 (&acc)[2][2][4][2], const pg8::Unit& u, int wr, int wc, int fr, int fq) const {
#pragma unroll
    for (int ai = 0; ai < 2; ++ai)
#pragma unroll
      for (int m = 0; m < 4; ++m) {
        __builtin_amdgcn_sched_barrier(0);
        const int row = ai * 128 + wr * 64 + m * 16 + fr;
        const pg8::f32x4 g0 = acc[ai][0][m][0] * MOE1_UNSCALE, g1 = acc[ai][0][m][1] * MOE1_UNSCALE, u0 = acc[ai][1][m][0] * MOE1_UNSCALE, u1 = acc[ai][1][m][1] * MOE1_UNSCALE;
        uint2 w;
        w.x = pk4_fp8c(H_SCALE * g0[0] * sigmoidf_(g0[0]) * u0[0], H_SCALE * g0[1] * sigmoidf_(g0[1]) * u0[1], H_SCALE * g0[2] * sigmoidf_(g0[2]) * u0[2], H_SCALE * g0[3] * sigmoidf_(g0[3]) * u0[3]);
        w.y = pk4_fp8c(H_SCALE * g1[0] * sigmoidf_(g1[0]) * u1[0], H_SCALE * g1[1] * sigmoidf_(g1[1]) * u1[1], H_SCALE * g1[2] * sigmoidf_(g1[2]) * u1[2], H_SCALE * g1[3] * sigmoidf_(g1[3]) * u1[3]);
        *(uint2*)((char*)HS + (size_t)row * 256 + u.pn * 128 + wc * 32 + 8 * fq) = w;
      }
  }
};
struct EpiMoe2 {
  static constexpr bool PERM = true, AFTER_DRAIN = false;
  const int* asg; bf16_t* Y;
  __device__ __forceinline__ void operator()(const pg8::f32x4 (&acc)[2][2][4][2], const pg8::Unit& u, int wr, int wc, int fr, int fq) const {
#pragma unroll
    for (int ai = 0; ai < 2; ++ai)
#pragma unroll
      for (int m = 0; m < 4; ++m) {
        __builtin_amdgcn_sched_barrier(0);
        const int a = asg[256 + ai * 128 + wr * 64 + m * 16 + fr];
        if (a < 0) continue;
        {
          const float gw = __int_as_float(asg[512 + ai * 128 + wr * 64 + m * 16 + fr]) * (Y_SCALE * MOE2_UNSCALE);
#pragma unroll
          for (int bj = 0; bj < 2; ++bj) {
            const pg8::f32x4 v0 = acc[ai][bj][m][0], v1 = acc[ai][bj][m][1];
            uint2 w; w.x = pk4_fp8c(v0[0] * gw, v0[1] * gw, v0[2] * gw, v0[3] * gw); w.y = pk4_fp8c(v1[0] * gw, v1[1] * gw, v1[2] * gw, v1[3] * gw);
            *(uint2*)((unsigned char*)Y + (size_t)a * DM + u.pn * 256 + bj * 128 + wc * 32 + 8 * fq) = w;
          }
        }
      }
  }
};
#define MOE_TAB_OFF (WG_LDS_OFF + 128 + 1152)
__device__ __forceinline__ unsigned xb_xcc_id();
#define CTL_MOEQ 1536
__device__ __forceinline__ void phase_moe(const Params& p, char* smem_all, int* slot) {
  int* tab = (int*)(smem_all + MOE_TAB_OFF);
  int* ctl = (int*)(p.ws + OFF_CTL);
  int* pre = (int*)(smem_all + WG_LDS_OFF + 128);
  if (threadIdx.x < 64) {
    const int l = threadIdx.x, g0 = l >> 3, i0 = (4 * l) & 31;
    const int t0 = (min(ctl[CNT((i0 + 0) * 8 + g0)], LCAP) + 255) >> 8, t1 = (min(ctl[CNT((i0 + 1) * 8 + g0)], LCAP) + 255) >> 8;
    const int t2 = (min(ctl[CNT((i0 + 2) * 8 + g0)], LCAP) + 255) >> 8, t3 = (min(ctl[CNT((i0 + 3) * 8 + g0)], LCAP) + 255) >> 8;
    const int tot = t0 + t1 + t2 + t3;
    int inc = tot;
#pragma unroll
    for (int o = 1; o < 64; o <<= 1) { const int v = __shfl_up(inc, o, 64); if (l >= o) inc += v; }
    const int base = inc - tot;
    pre[4 * l] = base; pre[4 * l + 1] = base + t0; pre[4 * l + 2] = base + t0 + t1; pre[4 * l + 3] = base + t0 + t1 + t2;
    if (l == 63) { pre[NEXP] = inc; pre[NEXP + 1] = inc + T_TOK / 256; }
  }
  if (threadIdx.x == 0) { slot[1] = (int)(xb_xcc_id() & 7u); slot[2] = 0; }
  __syncthreads();
  bf16_t* HS = (bf16_t*)(p.ws + OFF_HSCR) + (size_t)blockIdx.x * 256 * 256;
#define MOE_DRAW(CTLP) { if (threadIdx.x == 0) { \
    int g_ = slot[1], tried_ = slot[2], it_ = -1; \
    while (tried_ < 8) { \
      const int r0_ = pre[32 * g_], nr_ = pre[32 * g_ + 32] - r0_;                                   \
      const int t_ = atomicAdd(&(CTLP)[CTL_MOEQ + 32 * g_], 1); \
      if (t_ < nr_ + 16) { it_ = (t_ < nr_) ? (r0_ + t_) : (pre[NEXP] + 16 * g_ + (t_ - nr_)); break; } \
      g_ = (g_ + 1) & 7; ++tried_; \
    } \
    slot[0] = it_; slot[1] = g_; slot[2] = tried_; } }
#define MOE_FETCH(i_, e_, a_, LISTP, CNTP) { \
    e_ = 0; a_ = -1; \
    if ((i_) >= 0) { \
      int lo = 0, hi = NEXP;                               \
      while (lo < hi) { const int mid = (lo + hi + 1) >> 1; if (pre[mid] <= (i_)) lo = mid; else hi = mid - 1; } \
      e_ = (lo < NEXP) ? ((lo & 31) * 8 + (lo >> 5)) : NEXP; \
      const int cnt_ = (e_ < NEXP) ? min((CNTP)[CNT(e_)], LCAP) : T_TOK; \
      const int r_ = ((i_) - pre[lo]) * 256 + (int)(threadIdx.x & 255); \
      a_ = (r_ < cnt_) ? ((e_ < NEXP) ? (LISTP)[(size_t)e_ * LCAP + r_] : (8 * T_TOK + r_)) : -1; \
    } }
  MOE_DRAW(ctl)
  __syncthreads();
  int i = *slot, e, a;
  { const int* __restrict__ LIST0 = (const int*)(p.ws + OFF_LIST); const int* counts0 = (const int*)(p.ws + OFF_CTL); MOE_FETCH(i, e, a, LIST0, counts0) }
  for (;;) {
    if (i < 0) break;
    const __attribute__((address_space(4))) char* ka_ = (const __attribute__((address_space(4))) char*)__builtin_amdgcn_kernarg_segment_ptr();
    asm volatile("" : "+s"(ka_));
    char* const wsl = *(char* const __attribute__((address_space(4)))*)(ka_ + __builtin_offsetof(Params, ws));
    const int* __restrict__ LISTl = (const int*)(wsl + OFF_LIST); const int* countsl = (const int*)(wsl + OFF_CTL); const float* __restrict__ GATEWl = (const float*)(wsl + OFF_GATEW);
    __syncthreads();
    if (threadIdx.x < 256) {
      tab[256 + threadIdx.x] = a;
      tab[threadIdx.x] = (a >= 0 ? a : 0) & (T_TOK - 1);
      tab[512 + threadIdx.x] = __float_as_int((a >= 0 && a < 8 * T_TOK) ? GATEWl[a] : 1.f);
    }
    __syncthreads();
    {
      int k1 = DM / 2; asm volatile("" : "+s"(k1));
      pg8::Gemm g{(const pg8::bf16_t*)(wsl + OFF_X1F8), (const pg8::bf16_t*)(wsl + OFF_EW1 + (size_t)e * 512 * 1024), 256, 512, k1};
      SeqOrder S{2};
      EpiMoe1 E{HS};
      pg8::gemm_phase<EpiMoe1, SeqOrder, true, true, true, true>((PG8_LAS unsigned char*)smem_all, g, S, E, tab);
    }
    const int e_cur = e;
    MOE_DRAW((int*)(wsl + OFF_CTL))
    __syncthreads();
    i = *slot;
    MOE_FETCH(i, e, a, LISTl, countsl)
    {
      int k2 = 128; asm volatile("" : "+s"(k2));
      pg8::Gemm g{(const pg8::bf16_t*)HS, (const pg8::bf16_t*)(wsl + OFF_EW2 + (size_t)e_cur * 1024 * 256), 256, DM, k2};
      SeqOrder S{4};
      EpiMoe2 E{tab, (bf16_t*)(wsl + OFF_Y)};
      pg8::gemm_phase<EpiMoe2, SeqOrder, true, true, false, true>((PG8_LAS unsigned char*)smem_all, g, S, E);
    }
  }
#undef MOE_FETCH
#undef MOE_DRAW
}

__device__ __forceinline__ void phase_final(const Params& p, char* smem) {
  float* OUT = p.out;
  const unsigned char* __restrict__ Y = (const unsigned char*)(p.ws + OFF_Y);
  const bf16_t* __restrict__ X1B = (const bf16_t*)(p.ws + OFF_X1B);
  const float* __restrict__ g2 = p.in[24]; const float* __restrict__ b2 = p.in[25];
  const int lane = VTID & 63, wid = VTID >> 6;
  for (int t = VBID * 4 + wid; t < T_TOK; t += VGRID * 4) {
    const size_t base = (size_t)t * DM;
    float4 v[4];
    float s = 0.f;
#pragma unroll
    for (int u = 0; u < 2; ++u) {
      const int c = u * 512 + lane * 8;
      float xf[8];
      unpack8(*(const uint4*)(X1B + base + c), xf);
      float a0 = 0.f, a1 = 0.f, a2 = 0.f, a3 = 0.f, a4 = 0.f, a5 = 0.f, a6 = 0.f, a7 = 0.f;
#pragma unroll
      for (int sl = 0; sl < 9; ++sl) {
        const uint2 yw = *(const uint2*)(Y + ((size_t)sl * T_TOK + t) * DM + c);
        const f32x2_t y01 = __builtin_amdgcn_cvt_pk_f32_fp8((int)yw.x, false), y23 = __builtin_amdgcn_cvt_pk_f32_fp8((int)yw.x, true);
        const f32x2_t y45 = __builtin_amdgcn_cvt_pk_f32_fp8((int)yw.y, false), y67 = __builtin_amdgcn_cvt_pk_f32_fp8((int)yw.y, true);
        a0 += y01[0]; a1 += y01[1]; a2 += y23[0]; a3 += y23[1]; a4 += y45[0]; a5 += y45[1]; a6 += y67[0]; a7 += y67[1];
      }
      const float iy = 1.f / Y_SCALE;
      v[2 * u] = make_float4(ALPHA_F * xf[0] + iy * a0, ALPHA_F * xf[1] + iy * a1, ALPHA_F * xf[2] + iy * a2, ALPHA_F * xf[3] + iy * a3);
      v[2 * u + 1] = make_float4(ALPHA_F * xf[4] + iy * a4, ALPHA_F * xf[5] + iy * a5, ALPHA_F * xf[6] + iy * a6, ALPHA_F * xf[7] + iy * a7);
      s += ((v[2 * u].x + v[2 * u].y) + (v[2 * u].z + v[2 * u].w)) + ((v[2 * u + 1].x + v[2 * u + 1].y) + (v[2 * u + 1].z + v[2 * u + 1].w));
    }
    const float mean = wave_sum_fast(s) * (1.f / DM);
    float q = 0.f;
#pragma unroll
    for (int u = 0; u < 4; ++u) {
      const float d0 = v[u].x - mean, d1 = v[u].y - mean, d2 = v[u].z - mean, d3 = v[u].w - mean;
      q += (d0 * d0 + d1 * d1) + (d2 * d2 + d3 * d3);
    }
    const float rs = rsqrtf(wave_sum_fast(q) * (1.f / DM) + LN_EPS_F);
#pragma unroll
    for (int u = 0; u < 4; ++u) {
      const int c = (u >> 1) * 512 + lane * 8 + (u & 1) * 4;
      const float4 g = *(const float4*)(g2 + c), bb = *(const float4*)(b2 + c);
      *(float4*)(OUT + base + c) = make_float4((v[u].x - mean) * rs * g.x + bb.x, (v[u].y - mean) * rs * g.y + bb.y,
                                               (v[u].z - mean) * rs * g.z + bb.z, (v[u].w - mean) * rs * g.w + bb.w);
    }
  }
}

#define LAS __attribute__((address_space(3)))
#define XB_TMO      128
#define XB_XCNT(j)  (256  + 64 * (j))
#define XB_XSUB(j)  (1280 + 64 * (j))
#define XB_XGEN(j)  (2304 + 64 * (j))
#define XB_TOP      3328
#define XB_TOPGEN   3392
#define XCD_BAR_WORDS 3456
#define XB_SPIN_CAP (1u << 22)
__device__ __forceinline__ unsigned xb_ld(unsigned* p)              { return __hip_atomic_load(p, __ATOMIC_RELAXED, __HIP_MEMORY_SCOPE_AGENT); }
__device__ __forceinline__ unsigned xb_add(unsigned* p, unsigned v) { return __hip_atomic_fetch_add(p, v, __ATOMIC_RELAXED, __HIP_MEMORY_SCOPE_AGENT); }
__device__ __forceinline__ unsigned xb_xcc_id() { return (unsigned)__builtin_amdgcn_s_getreg((3 << 11) | 20) & 0xFu; }
#define XB_SPIN(cond, bar) do { unsigned _sp = 0; while (cond) { __builtin_amdgcn_s_sleep(1); \
    if ((++_sp & 255u) == 0u) { if (xb_ld(&(bar)[XB_TMO])) break; if (_sp > XB_SPIN_CAP) { atomicAdd(&(bar)[XB_TMO], 1u); break; } } } } while (0)
struct XcdBarrier { unsigned* bar; unsigned x; volatile LAS unsigned* st; };
__device__ __forceinline__ XcdBarrier xcd_barrier_post(unsigned* bar, volatile LAS unsigned* st) {
  XcdBarrier b; b.bar = bar; b.x = xb_xcc_id(); b.st = st;
  if (threadIdx.x == 0) (void)xb_add(&bar[XB_XCNT(b.x)], 1u);
  return b;
}
__device__ __forceinline__ void xcd_barrier_complete(unsigned* bar, unsigned x, unsigned& nloc, unsigned& nx) {
  const unsigned G = gridDim.x * gridDim.y * gridDim.z;
  unsigned sum, cnt, mine, sp = 0u;
  for (;;) {
    sum = 0u; cnt = 0u; mine = 0u;
#pragma unroll
    for (unsigned j = 0; j < 16; ++j) { const unsigned c = xb_ld(&bar[XB_XCNT(j)]); sum += c; cnt += (c > 0u) ? 1u : 0u; mine = (j == x) ? c : mine; }
    if (sum == G) break;
    __builtin_amdgcn_s_sleep(1);
    if ((++sp & 255u) == 0u) { if (xb_ld(&bar[XB_TMO])) break; if (sp > XB_SPIN_CAP) { atomicAdd(&bar[XB_TMO], 1u); break; } }
  }
  nloc = mine > 0u ? mine : 1u; nx = cnt > 0u ? cnt : 1u;
}
__device__ __forceinline__ void xcd_barrier(const XcdBarrier& b) {
  asm volatile("s_waitcnt vmcnt(0)" ::: "memory");
  __syncthreads();
  if (threadIdx.x == 0) {
    unsigned* bar = b.bar;
    __builtin_amdgcn_s_waitcnt(0);
    unsigned nloc = b.st[0], nx = b.st[1];
    if (nloc == 0u) { xcd_barrier_complete(bar, b.x, nloc, nx); b.st[0] = nloc; b.st[1] = nx; }
    const unsigned old = xb_add(&bar[XB_XSUB(b.x)], 1u);
    const unsigned gen = old / nloc;
    if (old + 1u == (gen + 1u) * nloc) {
      __builtin_amdgcn_fence(__ATOMIC_RELEASE, "agent");
      asm volatile("s_waitcnt vmcnt(0)" ::: "memory");
      const unsigned og = xb_add(&bar[XB_TOP], 1u);
      const unsigned tg = og / nx;
      if (og + 1u == (tg + 1u) * nx) xb_add(&bar[XB_TOPGEN], 1u);
      else XB_SPIN(xb_ld(&bar[XB_TOPGEN]) == tg, bar);
      __builtin_amdgcn_fence(__ATOMIC_ACQUIRE, "agent");
      xb_add(&bar[XB_XGEN(b.x)], 1u);
      asm volatile("s_waitcnt vmcnt(0)" ::: "memory");
    } else {
      XB_SPIN(xb_ld(&bar[XB_XGEN(b.x)]) == gen, bar);
      __builtin_amdgcn_fence(__ATOMIC_ACQUIRE, "agent");
      asm volatile("s_waitcnt vmcnt(0)" ::: "memory");
    }
  }
  __syncthreads();
}
#define CTL_BAR_WORD 4096
#define CTL_ZERO_BYTES 65536
#define LDS_BAR_OFF 66432

#define LDS_TOTAL (2 * HALF_LDS + 128 + 1152 + 3072)
__global__ void __launch_bounds__(512, 2) mega(Params p) {
  extern __shared__ __attribute__((aligned(16))) char smem_all[];
  cg::grid_group grid = cg::this_grid();
  char* const smem = smem_all + VHALF * HALF_LDS;
  volatile LAS unsigned* bst = (volatile LAS unsigned*)(LAS char*)(smem_all + WG_LDS_OFF);
  int* const slot = (int*)(smem_all + WG_LDS_OFF + 16);
  if (threadIdx.x < 2) { bst[threadIdx.x] = 0u; ((int*)(smem_all + WG_LDS_OFF + 32))[threadIdx.x] = 0; }
  __syncthreads();
  const XcdBarrier bar = xcd_barrier_post((unsigned*)(p.ws + OFF_CTL) + CTL_BAR_WORD, bst);
  phase_rope(p);
  if (p.ws == nullptr) grid.sync();
  xcd_barrier(bar);
  phase_inproj(p, smem_all);
  xcd_barrier(bar);
  phase_prep_a(p);
  xcd_barrier(bar);
  phase_prep(p, smem);
  xcd_barrier(bar);
  phase_chunk_pre(p, smem);
  xcd_barrier(bar);
  phase_seq(p);
  phase_convert(p, smem);
  xcd_barrier(bar);
  phase_post(p);
  xcd_barrier(bar);
  phase_outproj(p, smem_all);
  xcd_barrier(bar);
  phase_ln1(p);
  xcd_barrier(bar);
  phase_router_gemm(p, smem);
  xcd_barrier(bar);
  phase_topk(p, smem_all);
  xcd_barrier(bar);
  phase_moe(p, smem_all, slot);
  xcd_barrier(bar);
  phase_final(p, smem);
}

extern "C" void kernel_launch(void* const* d_in, const int* in_sizes, int n_in, void* d_out, int out_size, void* d_ws, size_t ws_size,
                              hipStream_t stream) {
  static int grid_blocks = 0;
  if (grid_blocks == 0) {
    if (ws_size < WS_NEED || n_in != 26) { fprintf(stderr, "kernel_launch: bad ws/n_in: %zu < %zu, n_in %d\n", ws_size, (size_t)WS_NEED, n_in); grid_blocks = -1; return; }
    int dev = 0, cus = 0, per_cu = 0;
    (void)hipGetDevice(&dev);
    (void)hipDeviceGetAttribute(&cus, hipDeviceAttributeMultiprocessorCount, dev);
    (void)hipFuncSetAttribute((const void*)mega, hipFuncAttributeMaxDynamicSharedMemorySize, LDS_TOTAL);
    (void)hipOccupancyMaxActiveBlocksPerMultiprocessor(&per_cu, (const void*)mega, 512, LDS_TOTAL);
    if (per_cu < 1) { fprintf(stderr, "kernel_launch: occupancy query returned %d\n", per_cu); grid_blocks = -1; return; }
    if (per_cu > 1) per_cu = 1;
    grid_blocks = cus * per_cu;
    if (grid_blocks > 256) grid_blocks = 256;
    fprintf(stderr, "kernel_launch: cus %d per_cu %d grid %d\n", cus, per_cu, grid_blocks);
  }
  if (grid_blocks < 0) return;
  if (hipMemsetAsync((char*)d_ws + OFF_CTL, 0, CTL_ZERO_BYTES, stream) != hipSuccess) { fprintf(stderr, "kernel_launch: memset failed\n"); return; }
  Params p{};
  for (int i = 0; i < 26; ++i) p.in[i] = (const float*)d_in[i];
  p.out = (float*)d_out;
  p.ws = (char*)d_ws;
  void* args[] = {&p};
  hipError_t e = hipLaunchCooperativeKernel((const void*)mega, dim3(grid_blocks), dim3(512), args, LDS_TOTAL, stream);
  if (e != hipSuccess) fprintf(stderr, "cooperative launch failed: %s (grid %d)\n", hipGetErrorString(e), grid_blocks);
}
```
